# Optimizing an MI355X kernel written in HIP

```python
import math
import jax
import jax.numpy as jnp
from jax import lax
import numpy as np

D_MODEL = 1024
BATCH = 16
SEQ = 2048
DEPTH = 2

CTX_LEN = 256
GRID_W = 64
EPS = 1e-6

HEAD_DIM = 64
N_Q_HEADS = 8
N_KV_HEADS = 2
Q_PER_KV = N_Q_HEADS // N_KV_HEADS
AXIS_DIM = HEAD_DIM // 2
ROPE_THETA = 10000.0
Q_BLOCK = 128
ATTN_WIDTH = N_Q_HEADS * HEAD_DIM
KV_WIDTH = N_KV_HEADS * HEAD_DIM

GMLP_GROUPS = 8
GMLP_GROUP_DIM = 64
GMLP_WIDTH = GMLP_GROUPS * GMLP_GROUP_DIM
GMLP_CHUNK = 128

MIX_IN_WIDTH = ATTN_WIDTH + 2 * KV_WIDTH + 2 * GMLP_WIDTH
MIX_SPLITS = (ATTN_WIDTH, ATTN_WIDTH + KV_WIDTH, ATTN_WIDTH + 2 * KV_WIDTH,
              ATTN_WIDTH + 2 * KV_WIDTH + GMLP_WIDTH)
MIX_OUT_WIDTH = ATTN_WIDTH + GMLP_WIDTH

S5_GROUPS = 32
S5_GROUP_DIM = 16
S5_STATE = 64
S5_WIDTH = S5_GROUPS * S5_GROUP_DIM

N_EXPERT_GROUPS = 4
EXPERTS_PER_GROUP = 8
N_EXPERTS = N_EXPERT_GROUPS * EXPERTS_PER_GROUP
TOP_K_INNER = 2
EXPERT_HIDDEN = 512
MOE_BLOCK = 256

kernel_name = 'hybrid_flow_gqa_gmlp_s5_hmoe'


def rms_norm(x, g):
    x32 = x.astype(jnp.float32)
    y = x32 * lax.rsqrt(jnp.mean(x32 * x32, axis=-1, keepdims=True) + EPS)
    return (y * g.astype(jnp.float32)).astype(x.dtype)


def layer_norm(x, g):
    x32 = x.astype(jnp.float32)
    mu = jnp.mean(x32, axis=-1, keepdims=True)
    xc = x32 - mu
    y = xc * lax.rsqrt(jnp.mean(xc * xc, axis=-1, keepdims=True) + EPS)
    return (y * g.astype(jnp.float32)).astype(x.dtype)


def modulate(x, g, shift, scale):
    return rms_norm(x, g) * (1 + scale) + shift


def adaln(cond, w_mod, b_mod):
    m = jax.nn.silu(cond) @ w_mod + b_mod
    return jnp.split(m, 6, axis=-1)


def axial_rope_tables(n_tokens):
    rows = n_tokens // GRID_W
    row = jnp.repeat(jnp.arange(rows, dtype=jnp.int32), GRID_W).astype(jnp.float32)
    col = jnp.tile(jnp.arange(GRID_W, dtype=jnp.int32), rows).astype(jnp.float32)
    inv_freq = jnp.power(ROPE_THETA, -jnp.arange(0, AXIS_DIM, 2, dtype=jnp.float32) / AXIS_DIM)
    ang_r = row[:, None] * inv_freq[None, :]
    ang_c = col[:, None] * inv_freq[None, :]
    return (jnp.cos(ang_r), jnp.sin(ang_r), jnp.cos(ang_c), jnp.sin(ang_c))


def _rotate_half(x, cos, sin):
    x1, x2 = jnp.split(x, 2, axis=-1)
    return jnp.concatenate([x1 * cos - x2 * sin, x2 * cos + x1 * sin], axis=-1)


def apply_axial_rope(x, tables):
    shape = (x.shape[1],) + (1,) * (x.ndim - 3) + (AXIS_DIM // 2,)
    cr, sr, cc, sc = [t.reshape(shape) for t in tables]
    x32 = x.astype(jnp.float32)
    xr, xcl = jnp.split(x32, 2, axis=-1)
    out = jnp.concatenate([_rotate_half(xr, cr, sr), _rotate_half(xcl, cc, sc)], axis=-1)
    return out.astype(x.dtype)


def gqa_attend(q, k, v):
    s = jnp.einsum('bqhgd,bkhd->bhgqk', q, k).astype(jnp.float32) * (HEAD_DIM ** -0.5)
    p = jax.nn.softmax(s, axis=-1).astype(v.dtype)
    return jnp.einsum('bhgqk,bkhd->bqhgd', p, v)


def attn_gmlp_mixer(h_lat, h_ctx, rope, w_in, w_out, q_g, k_g, ln_g, w_sp, b_sp, with_ctx):
    B, S, _ = h_lat.shape
    C = h_ctx.shape[1]

    def project(h):
        L = h.shape[1]
        q, k, v, u, vg = jnp.split(h @ w_in, MIX_SPLITS, axis=-1)
        q = rms_norm(q.reshape(B, L, N_KV_HEADS, Q_PER_KV, HEAD_DIM), q_g)
        k = rms_norm(k.reshape(B, L, N_KV_HEADS, HEAD_DIM), k_g)
        v = v.reshape(B, L, N_KV_HEADS, HEAD_DIM)
        return q, k, v, u, vg

    def spatial_gate(u, vg):
        L = u.shape[1]
        u = jax.nn.gelu(u)
        vg = layer_norm(jax.nn.gelu(vg), ln_g)
        vc = vg.reshape(B, L // GMLP_CHUNK, GMLP_CHUNK, GMLP_GROUPS, GMLP_GROUP_DIM)
        mixed = jnp.einsum('gpq,bcqgd->bcpgd', w_sp, vc) + b_sp.T[:, :, None]
        return u * mixed.reshape(B, L, GMLP_WIDTH)

    q_l, k_l, v_l, u_l, g_l = project(h_lat)
    q_c, k_c, v_c, u_c, g_c = project(h_ctx)
    q_l = apply_axial_rope(q_l, rope)
    k_l = apply_axial_rope(k_l, rope)
    k_all = jnp.concatenate([k_c, k_l], axis=1)
    v_all = jnp.concatenate([v_c, v_l], axis=1)
    n_blk = S // Q_BLOCK
    q_blocks = q_l.reshape(B, n_blk, Q_BLOCK, N_KV_HEADS, Q_PER_KV, HEAD_DIM).swapaxes(0, 1)
    o_l = lax.map(lambda qb: gqa_attend(qb, k_all, v_all), q_blocks)
    o_l = o_l.swapaxes(0, 1).reshape(B, S, ATTN_WIDTH)
    y_lat = jnp.concatenate([o_l, spatial_gate(u_l, g_l)], axis=-1) @ w_out
    y_ctx = None
    if with_ctx:
        o_c = gqa_attend(q_c, k_c, v_c).reshape(B, C, ATTN_WIDTH)
        y_ctx = jnp.concatenate([o_c, spatial_gate(u_c, g_c)], axis=-1) @ w_out
    return y_lat, y_ctx


def s5_zoh(a_re, a_im, log_dt, b_re, b_im):
    lam = lax.complex(a_re.astype(jnp.float32), a_im.astype(jnp.float32))
    dt = jnp.exp(log_dt.astype(jnp.float32))[:, None]
    lam_bar = jnp.exp(lam * dt)
    b = lax.complex(b_re.astype(jnp.float32), b_im.astype(jnp.float32))
    b_bar = ((lam_bar - 1.0) / lam)[..., None] * b
    return lam_bar, b_bar


def s5_drive(b_bar, u):
    return jnp.einsum('gnp,blgp->blgn', b_bar, u.astype(jnp.float32).astype(jnp.complex64))


def s5_readout(c_mat, h):
    return jnp.real(jnp.einsum('gpn,blgn->blgp', c_mat, h))


def diag_scan(lam_bar, bu, reverse):
    a = jnp.broadcast_to(lam_bar, bu.shape)

    def combine(e1, e2):
        a1, b1 = e1
        a2, b2 = e2
        return a1 * a2, a2 * b1 + b2

    _, h = lax.associative_scan(combine, (a, bu), reverse=reverse, axis=1)
    return h


def s5_mixer(h_lat, h_ctx, w_in, a_re, a_im, log_dt, b_re, b_im, c_re, c_im, d_skip,
             w_glu, b_glu, w_out, with_ctx):
    B, S, _ = h_lat.shape
    C = h_ctx.shape[1]
    u_l = (h_lat @ w_in).reshape(B, S, S5_GROUPS, S5_GROUP_DIM)
    u_c = (h_ctx @ w_in).reshape(B, C, S5_GROUPS, S5_GROUP_DIM)
    d = d_skip.astype(jnp.float32).reshape(S5_GROUPS, S5_GROUP_DIM)
    y_l = d * u_l.astype(jnp.float32)
    y_c = d * u_c.astype(jnp.float32) if with_ctx else None
    for direction in range(2):
        reverse = direction == 1
        lam_bar, b_bar = s5_zoh(a_re[direction], a_im[direction], log_dt[direction],
                                b_re[direction], b_im[direction])
        c_mat = lax.complex(c_re[direction].astype(jnp.float32), c_im[direction].astype(jnp.float32))
        h_c = diag_scan(lam_bar, s5_drive(b_bar, u_c), reverse)
        h0 = h_c[:, 0] if reverse else h_c[:, -1]
        edge = -1 if reverse else 0
        bu_l = s5_drive(b_bar, u_l).at[:, edge].add(lam_bar * h0)
        h_l = diag_scan(lam_bar, bu_l, reverse)
        y_l = y_l + s5_readout(c_mat, h_l)
        if with_ctx:
            y_c = y_c + s5_readout(c_mat, h_c)

    def gated_out(y):
        y = y.reshape(y.shape[0], y.shape[1], S5_WIDTH).astype(h_lat.dtype)
        g = jax.nn.gelu(y)
        return (g * jax.nn.sigmoid(g @ w_glu + b_glu)) @ w_out

    y_ctx = gated_out(y_c) if with_ctx else None
    return gated_out(y_l), y_ctx


def hier_moe(h, w_grp, b_grp, w_rt, b_rt, w1, w3, w2):
    T, D = h.shape
    grp_prob = jax.nn.softmax((h @ w_grp + b_grp).astype(jnp.float32), axis=-1)
    g_w, g_idx = lax.top_k(grp_prob, 1)
    exp_logits = (h @ w_rt + b_rt).astype(jnp.float32).reshape(T, N_EXPERT_GROUPS, EXPERTS_PER_GROUP)
    sel = jnp.take_along_axis(exp_logits, g_idx[:, :, None], axis=1)[:, 0]
    top_v, top_i = lax.top_k(sel, TOP_K_INNER)
    wts = jax.nn.softmax(top_v, axis=-1) * g_w
    eid = (g_idx * EXPERTS_PER_GROUP + top_i).reshape(-1).astype(jnp.int32)
    wt = wts.reshape(-1)
    tok = jnp.repeat(jnp.arange(T, dtype=jnp.int32), TOP_K_INNER)
    n_assign = T * TOP_K_INNER
    order = jnp.argsort(eid)
    eid_s, tok_s, wt_s = eid[order], tok[order], wt[order]
    counts = jnp.bincount(eid, length=N_EXPERTS).astype(jnp.int32)
    start = jnp.cumsum(counts) - counts
    padded = (counts + MOE_BLOCK - 1) // MOE_BLOCK * MOE_BLOCK
    pstart = jnp.cumsum(padded) - padded
    pend = pstart + padded
    dest = pstart[eid_s] + jnp.arange(n_assign, dtype=jnp.int32) - start[eid_s]
    n_slots = (n_assign + MOE_BLOCK - 1) // MOE_BLOCK * MOE_BLOCK + N_EXPERTS * MOE_BLOCK
    n_blocks = n_slots // MOE_BLOCK
    buf_tok = jnp.zeros((n_slots,), jnp.int32).at[dest].set(tok_s)
    buf_w = jnp.zeros((n_slots,), jnp.float32).at[dest].set(wt_s)
    block_start = jnp.arange(n_blocks, dtype=jnp.int32) * MOE_BLOCK
    block_e = jnp.minimum(jnp.sum(block_start[:, None] >= pend[None, :], axis=1), N_EXPERTS - 1)
    xb = h[buf_tok].reshape(n_blocks, MOE_BLOCK, D)

    def expert_block(args):
        xblk, e = args
        return (jax.nn.silu(xblk @ w1[e]) * (xblk @ w3[e])) @ w2[e]

    yb = lax.map(expert_block, (xb, block_e)).reshape(n_slots, D)
    return jnp.zeros((T, D), h.dtype).at[buf_tok].add(yb * buf_w[:, None].astype(h.dtype))


def setup_inputs(seed: int = 0) -> dict:
    key = jax.random.key(seed)
    ks = iter(jax.random.split(key, 48))
    n_even = (DEPTH + 1) // 2
    n_odd = DEPTH // 2
    D = D_MODEL

    def nrm(shape, scale):
        return jax.random.normal(next(ks), shape, jnp.float32) * scale

    def gain(shape):
        return 1.0 + nrm(shape, 0.02)

    inp = {}
    inp['x'] = nrm((BATCH, SEQ, D), 1.0)
    inp['c'] = nrm((BATCH, D), 1.0)
    inp['ctx'] = nrm((BATCH, CTX_LEN, D), 1.0)
    inp['c_ctx'] = nrm((D,), 1.0)
    inp['w_mod'] = nrm((DEPTH, D, 6 * D), 0.5 * D ** -0.5)
    inp['b_mod'] = nrm((DEPTH, 6 * D), 0.02)
    inp['norm_mix_g'] = gain((DEPTH, D))
    inp['norm_ffn_g'] = gain((DEPTH, D))
    inp['mix_w_in'] = nrm((n_even, D, MIX_IN_WIDTH), D ** -0.5)
    inp['mix_w_out'] = nrm((n_even, MIX_OUT_WIDTH, D), MIX_OUT_WIDTH ** -0.5)
    inp['q_norm_g'] = gain((n_even, HEAD_DIM))
    inp['k_norm_g'] = gain((n_even, HEAD_DIM))
    inp['gmlp_norm_g'] = gain((n_even, GMLP_WIDTH))
    inp['gmlp_w_spatial'] = nrm((n_even, GMLP_GROUPS, GMLP_CHUNK, GMLP_CHUNK), GMLP_CHUNK ** -0.5)
    inp['gmlp_b_spatial'] = 1.0 + nrm((n_even, GMLP_GROUPS, GMLP_CHUNK), 0.02)
    inp['s5_w_in'] = nrm((n_odd, D, S5_WIDTH), D ** -0.5)
    inp['s5_a_re'] = -0.5 + nrm((n_odd, 2, S5_GROUPS, S5_STATE), 0.01)
    inp['s5_a_im'] = jnp.pi * jnp.arange(S5_STATE, dtype=jnp.float32) + nrm((n_odd, 2, S5_GROUPS, S5_STATE), 0.01)
    inp['s5_log_dt'] = jax.random.uniform(next(ks), (n_odd, 2, S5_GROUPS), jnp.float32,
                                          math.log(1e-3), math.log(1e-1))
    inp['s5_b_re'] = nrm((n_odd, 2, S5_GROUPS, S5_STATE, S5_GROUP_DIM), (2 * S5_GROUP_DIM) ** -0.5)
    inp['s5_b_im'] = nrm((n_odd, 2, S5_GROUPS, S5_STATE, S5_GROUP_DIM), (2 * S5_GROUP_DIM) ** -0.5)
    inp['s5_c_re'] = nrm((n_odd, 2, S5_GROUPS, S5_GROUP_DIM, S5_STATE), S5_STATE ** -0.5)
    inp['s5_c_im'] = nrm((n_odd, 2, S5_GROUPS, S5_GROUP_DIM, S5_STATE), S5_STATE ** -0.5)
    inp['s5_d'] = nrm((n_odd, S5_WIDTH), 1.0)
    inp['s5_w_glu'] = nrm((n_odd, S5_WIDTH, S5_WIDTH), S5_WIDTH ** -0.5)
    inp['s5_b_glu'] = nrm((n_odd, S5_WIDTH), 0.02)
    inp['s5_w_out'] = nrm((n_odd, S5_WIDTH, D), S5_WIDTH ** -0.5)
    inp['moe_w_group'] = nrm((DEPTH, D, N_EXPERT_GROUPS), D ** -0.5)
    inp['moe_b_group'] = nrm((DEPTH, N_EXPERT_GROUPS), 0.01)
    inp['moe_w_router'] = nrm((DEPTH, D, N_EXPERTS), D ** -0.5)
    inp['moe_b_router'] = nrm((DEPTH, N_EXPERTS), 0.01)
    inp['moe_w1'] = nrm((DEPTH, N_EXPERTS, D, EXPERT_HIDDEN), D ** -0.5)
    inp['moe_w3'] = nrm((DEPTH, N_EXPERTS, D, EXPERT_HIDDEN), D ** -0.5)
    inp['moe_w2'] = nrm((DEPTH, N_EXPERTS, EXPERT_HIDDEN, D), EXPERT_HIDDEN ** -0.5)
    inp['final_norm_g'] = gain((D,))
    return inp


def reference(x, c, ctx, c_ctx, w_mod, b_mod, norm_mix_g, norm_ffn_g, mix_w_in, mix_w_out,
              q_norm_g, k_norm_g, gmlp_norm_g, gmlp_w_spatial, gmlp_b_spatial,
              s5_w_in, s5_a_re, s5_a_im, s5_log_dt, s5_b_re, s5_b_im, s5_c_re, s5_c_im, s5_d,
              s5_w_glu, s5_b_glu, s5_w_out,
              moe_w_group, moe_b_group, moe_w_router, moe_b_router, moe_w1, moe_w3, moe_w2,
              final_norm_g):
    B, S, D = x.shape
    C = ctx.shape[1]
    rope = axial_rope_tables(S)
    for layer in range(DEPTH):
        last = layer == DEPTH - 1
        i = layer // 2
        m_lat = [m[:, None, :] for m in adaln(c, w_mod[layer], b_mod[layer])]
        m_ctx = adaln(c_ctx, w_mod[layer], b_mod[layer])
        h_lat = modulate(x, norm_mix_g[layer], m_lat[0], m_lat[1])
        h_ctx = modulate(ctx, norm_mix_g[layer], m_ctx[0], m_ctx[1])
        if layer % 2 == 0:
            y_lat, y_ctx = attn_gmlp_mixer(h_lat, h_ctx, rope, mix_w_in[i], mix_w_out[i],
                                           q_norm_g[i], k_norm_g[i], gmlp_norm_g[i],
                                           gmlp_w_spatial[i], gmlp_b_spatial[i], not last)
        else:
            y_lat, y_ctx = s5_mixer(h_lat, h_ctx, s5_w_in[i], s5_a_re[i], s5_a_im[i], s5_log_dt[i],
                                    s5_b_re[i], s5_b_im[i], s5_c_re[i], s5_c_im[i], s5_d[i],
                                    s5_w_glu[i], s5_b_glu[i], s5_w_out[i], not last)
        x = x + m_lat[2] * y_lat
        f_lat = modulate(x, norm_ffn_g[layer], m_lat[3], m_lat[4]).reshape(B * S, D)
        moe_args = (moe_w_group[layer], moe_b_group[layer], moe_w_router[layer], moe_b_router[layer],
                    moe_w1[layer], moe_w3[layer], moe_w2[layer])
        if last:
            x = x + m_lat[5] * hier_moe(f_lat, *moe_args).reshape(B, S, D)
        else:
            ctx = ctx + m_ctx[2] * y_ctx
            f_ctx = modulate(ctx, norm_ffn_g[layer], m_ctx[3], m_ctx[4]).reshape(B * C, D)
            f = hier_moe(jnp.concatenate([f_lat, f_ctx], axis=0), *moe_args)
            x = x + m_lat[5] * f[:B * S].reshape(B, S, D)
            ctx = ctx + m_ctx[5] * f[B * S:].reshape(B, C, D)
    return rms_norm(x, final_norm_g)
```

```cpp
#include <hip/hip_runtime.h>
#include <cstdio>
#include <cstdint>

#ifndef MK_ONE_LAUNCH
#define MK_ONE_LAUNCH 0
#endif

constexpr int D = 1024, NB = 16, SEQ = 2048, CTXL = 256;
constexpr int TL = NB * SEQ, TC = NB * CTXL, TT = TL + TC;
constexpr int KVL = CTXL + SEQ;
constexpr int MIXW = 1792, NEXP = 32, EH = 512;
constexpr int NSLOT = 81920;
constexpr float EPS = 1e-6f;
constexpr float QSCALE = 0.125f * 1.4426950408889634f;
constexpr int NTHR = 512, NWAVE = 8;
constexpr int NPHASE = 20;

constexpr size_t MiB = 1u << 20;
constexpr size_t WS_CTL = 0, CTL_BYTES = 1 * MiB;
constexpr size_t WS_MOD = 1 * MiB;
constexpr size_t WS_TAB = 2 * MiB;
constexpr size_t TAB_ROPE = 0, TAB_LAMB = 16384, TAB_BBAR = 65536;
constexpr size_t WS_ROUTE = 3 * MiB;
constexpr size_t RT_E = 0, RT_P = 320 * 1024, RT_W = 640 * 1024, RT_S = 960 * 1024, RT_TILE = 1280 * 1024, RT_NT = 1280 * 1024 + 4096;
constexpr size_t WS_WIN0 = 6 * MiB, WS_WOUT0 = 10 * MiB, WS_WS5IN = 12 * MiB, WS_WGLU = 13 * MiB, WS_WS5OUT = 14 * MiB;
constexpr size_t WS_W13 = 16 * MiB, WS_W2 = 80 * MiB;
constexpr size_t WS_XC = 112 * MiB;
constexpr size_t WS_H = 256 * MiB;
constexpr size_t WS_P = 328 * MiB;
constexpr size_t WS_Q = 454 * MiB, WS_K = 490 * MiB, WS_V = 499 * MiB;
constexpr size_t WS_XS = 328 * MiB;
constexpr size_t WS_G13 = 488 * MiB;
constexpr size_t WS_U = 328 * MiB, WS_GS = 364 * MiB, WS_GG = 396 * MiB, WS_YACC = 428 * MiB;
constexpr size_t WS_END = 568 * MiB;
constexpr int CW_CNT = 64;
constexpr int CW_BAR = 4096;

#define LAS __attribute__((address_space(3)))
typedef unsigned short bf16;
typedef unsigned v4u __attribute__((ext_vector_type(4)));
typedef unsigned v2u __attribute__((ext_vector_type(2)));
typedef float f32x4 __attribute__((ext_vector_type(4)));
typedef float f32x2 __attribute__((ext_vector_type(2)));
__device__ __forceinline__ float bf2f(unsigned u) { return __uint_as_float(u << 16); }
__device__ __forceinline__ unsigned f2bf(float f) { unsigned u = __float_as_uint(f); return (u + 0x7fffu + ((u >> 16) & 1u)) >> 16; }
__device__ __forceinline__ unsigned pk2(float lo, float hi) { return f2bf(lo) | (f2bf(hi) << 16); }
__device__ __forceinline__ float wave_sum(float v) {
#pragma unroll
    for (int o = 1; o < 64; o <<= 1) v += __shfl_xor(v, o);
    return v;
}
__device__ __forceinline__ float wave_max(float v) {
#pragma unroll
    for (int o = 1; o < 64; o <<= 1) v = fmaxf(v, __shfl_xor(v, o));
    return v;
}
__device__ __forceinline__ float gelu_tanh(float x) { const float u = 0.7978845608028654f * (x + 0.044715f * x * x * x); return 0.5f * x * (1.f + tanhf(u)); }
__device__ __forceinline__ float sigmoidf_(float x) { return 1.f / (1.f + __expf(-x)); }
__device__ __forceinline__ float silu_(float x) { return x / (1.f + __expf(-x)); }
__device__ __forceinline__ void unpack8(const v4u w, float* f) {
    f[0] = bf2f(w.x & 0xffffu); f[1] = bf2f(w.x >> 16); f[2] = bf2f(w.y & 0xffffu); f[3] = bf2f(w.y >> 16);
    f[4] = bf2f(w.z & 0xffffu); f[5] = bf2f(w.z >> 16); f[6] = bf2f(w.w & 0xffffu); f[7] = bf2f(w.w >> 16);
}

#define XB_TMO      128
#define XB_XCNT(j)  (256  + 64 * (j))
#define XB_XSUB(j)  (1280 + 64 * (j))
#define XB_XGEN(j)  (2304 + 64 * (j))
#define XB_TOP      3328
#define XB_TOPGEN   3392
#define XCD_BAR_WORDS 3456
#define XB_SPIN_CAP (1u << 28)
__device__ __forceinline__ unsigned xb_ld(unsigned* p)              { return __hip_atomic_load(p, __ATOMIC_RELAXED, __HIP_MEMORY_SCOPE_AGENT); }
__device__ __forceinline__ unsigned xb_add(unsigned* p, unsigned v) { return __hip_atomic_fetch_add(p, v, __ATOMIC_RELAXED, __HIP_MEMORY_SCOPE_AGENT); }
__device__ __forceinline__ unsigned xb_xcc_id() { return (unsigned)__builtin_amdgcn_s_getreg((3 << 11) | 20) & 0xFu; }
#define XB_SPIN(cond, bar) do { unsigned _sp = 0; while (cond) { __builtin_amdgcn_s_sleep(1); \
    if ((++_sp & 255u) == 0u) { if (xb_ld(&(bar)[XB_TMO])) break; if (_sp > XB_SPIN_CAP) { atomicAdd(&(bar)[XB_TMO], 1u); break; } } } } while (0)
struct XcdBarrier { unsigned* bar; unsigned x; volatile LAS unsigned* st; };
__device__ __forceinline__ XcdBarrier xcd_barrier_post(unsigned* bar, volatile LAS unsigned* st) {
    XcdBarrier b; b.bar = bar; b.x = xb_xcc_id(); b.st = st;
    if (threadIdx.x == 0) (void)xb_add(&bar[XB_XCNT(b.x)], 1u);
    return b;
}
__device__ __forceinline__ void xcd_barrier_complete(unsigned* bar, unsigned x, unsigned& nloc, unsigned& nx) {
    const unsigned G = gridDim.x * gridDim.y * gridDim.z;
    unsigned sum, cnt, mine, sp = 0u;
    for (;;) {
        sum = 0u; cnt = 0u; mine = 0u;
#pragma unroll
        for (unsigned j = 0; j < 16; ++j) { const unsigned c = xb_ld(&bar[XB_XCNT(j)]); sum += c; cnt += (c > 0u) ? 1u : 0u; mine = (j == x) ? c : mine; }
        if (sum == G) break;
        __builtin_amdgcn_s_sleep(1);
        if ((++sp & 255u) == 0u) { if (xb_ld(&bar[XB_TMO])) break; if (sp > XB_SPIN_CAP) { atomicAdd(&bar[XB_TMO], 1u); break; } }
    }
    nloc = mine > 0u ? mine : 1u; nx = cnt > 0u ? cnt : 1u;
}
__device__ __forceinline__ void xcd_barrier(const XcdBarrier& b) {
    asm volatile("s_waitcnt vmcnt(0)" ::: "memory");
    __syncthreads();
    if (threadIdx.x == 0) {
        unsigned* bar = b.bar;
        __builtin_amdgcn_s_waitcnt(0);
        unsigned nloc = b.st[0], nx = b.st[1];
        if (nloc == 0u) { xcd_barrier_complete(bar, b.x, nloc, nx); b.st[0] = nloc; b.st[1] = nx; }
        const unsigned old = xb_add(&bar[XB_XSUB(b.x)], 1u);
        const unsigned gen = old / nloc;
        if (old + 1u == (gen + 1u) * nloc) {
            __builtin_amdgcn_fence(__ATOMIC_RELEASE, "agent");
            asm volatile("s_waitcnt vmcnt(0)" ::: "memory");
            const unsigned og = xb_add(&bar[XB_TOP], 1u);
            const unsigned tg = og / nx;
            if (og + 1u == (tg + 1u) * nx) xb_add(&bar[XB_TOPGEN], 1u);
            else XB_SPIN(xb_ld(&bar[XB_TOPGEN]) == tg, bar);
            __builtin_amdgcn_fence(__ATOMIC_ACQUIRE, "agent");
            xb_add(&bar[XB_XGEN(b.x)], 1u);
            asm volatile("s_waitcnt vmcnt(0)" ::: "memory");
        } else {
            XB_SPIN(xb_ld(&bar[XB_XGEN(b.x)]) == gen, bar);
            __builtin_amdgcn_fence(__ATOMIC_ACQUIRE, "agent");
            asm volatile("s_waitcnt vmcnt(0)" ::: "memory");
        }
    }
    __syncthreads();
}

struct Params {
    const float* in[35];
    float* out;
    unsigned char* ws;
    int ph_lo, ph_hi;
};
enum { I_X = 0, I_C, I_CTX, I_CCTX, I_WMOD, I_BMOD, I_GMIX, I_GFFN, I_MIXWIN, I_MIXWOUT, I_QG, I_KG, I_LNG, I_WSP, I_BSP,
       I_S5WIN, I_ARE, I_AIM, I_LOGDT, I_BRE, I_BIM, I_CRE, I_CIM, I_S5D, I_WGLU, I_BGLU, I_S5WOUT,
       I_WGRP, I_BGRP, I_WRT, I_BRT, I_W1, I_W3, I_W2, I_FING };

struct Ctx {
    const Params* p;
    unsigned char* ws;
    LAS unsigned char* lds;
    int tid, lane, wave, gw, ngw;
};
__device__ __forceinline__ const float* xin_row(const Params& P, int r) { return r < TL ? P.in[I_X] + (size_t)r * D : P.in[I_CTX] + (size_t)(r - TL) * D; }
__device__ __forceinline__ int cond_of(int r) { return r < TL ? (r >> 11) : 16; }
__device__ __forceinline__ const float* mod_vec(const Ctx& C, int layer, int ci, int k) { return (const float*)(C.ws + WS_MOD) + ((size_t)(layer * 17 + ci) * 6 + k) * D; }

__device__ __forceinline__ void dsincos(double a, double& s, double& c) {
    const double TWO_PI_HI = 6.283185307179586, TWO_PI_LO = 2.4492935982947064e-16;
    const double k = rint(a * 0.15915494309189535);
    double r = fma(-k, TWO_PI_HI, a); r = fma(-k, TWO_PI_LO, r);
    const double r2 = r * r; double ct = 1.0, st = r, cs = 1.0, ss = r;
#pragma unroll 1
    for (int i = 1; i <= 15; ++i) { ct *= -r2 / (double)((2 * i - 1) * (2 * i)); cs += ct; st *= -r2 / (double)((2 * i) * (2 * i + 1)); ss += st; }
    s = ss; c = cs;
}

__device__ __forceinline__ void transpose_item(const float* src, int N, int k0, int n0, bf16* dst, int dpitch, LAS float* scr, int lane) {
#pragma unroll 8
    for (int i = 0; i < 32; ++i) { const int kk = 2 * i + (lane >> 5); scr[kk * 33 + (lane & 31)] = src[(size_t)(k0 + kk) * N + n0 + (lane & 31)]; }
    asm volatile("s_waitcnt lgkmcnt(0)" ::: "memory");
    const int c = lane & 7;
#pragma unroll
    for (int j = 0; j < 4; ++j) { const int n = (lane >> 3) + 8 * j; const LAS float* s = scr + (8 * c) * 33 + n;
        v4u o; o.x = pk2(s[0 * 33], s[1 * 33]); o.y = pk2(s[2 * 33], s[3 * 33]); o.z = pk2(s[4 * 33], s[5 * 33]); o.w = pk2(s[6 * 33], s[7 * 33]);
        *(v4u*)(dst + (size_t)n * dpitch + 8 * c) = o; }
    asm volatile("s_waitcnt lgkmcnt(0)" ::: "memory");
}
__device__ __forceinline__ void transpose_mat_item(const float* W, int K, int N, bf16* WT, int it, LAS float* scr, int lane) {
    const int nblk = N / 32, kb = it / nblk, nb = it % nblk;
    transpose_item(W, N, kb * 64, nb * 32, WT + (size_t)(nb * 32) * K + kb * 64, K, scr, lane);
}
constexpr int MOE_ITEMS = NEXP * 768;
__device__ __forceinline__ void moe_convert_item(const Ctx& C, int layer, int it, LAS float* scr) {
    const Params& P = *C.p;
    const int e = it / 768, r = it % 768, kind = r / 256, j = r % 256;
    if (kind < 2) {
        const float* src = (kind == 0 ? P.in[I_W1] : P.in[I_W3]) + ((size_t)layer * NEXP + e) * D * EH;
        const int kb = j / 16, nb = j % 16, k0 = kb * 64, n0 = nb * 32;
        const int drow = (n0 / 128) * 256 + (n0 % 128) + (kind == 1 ? 128 : 0);
        transpose_item(src, EH, k0, n0, (bf16*)(C.ws + WS_W13) + (size_t)e * 1024 * 1024 + (size_t)drow * 1024 + k0, 1024, scr, C.lane);
    } else {
        const float* src = P.in[I_W2] + ((size_t)layer * NEXP + e) * EH * D;
        const int kb = j / 32, nb = j % 32, k0 = kb * 64, n0 = nb * 32;
        transpose_item(src, D, k0, n0, (bf16*)(C.ws + WS_W2) + (size_t)e * 1024 * 512 + (size_t)n0 * 512 + k0, 512, scr, C.lane);
    }
}

__device__ __forceinline__ void phase_prologue(const Ctx& C) {
    const Params& P = *C.p;
    {
        LAS float* s = (LAS float*)C.lds;
        LAS float* red = (LAS float*)(C.lds + 17 * 1024 * 4);
        bool have_s = false;
        for (int u = blockIdx.x; u < 192; u += gridDim.x) {
            if (!have_s) {
                for (int i = C.tid; i < 17 * 1024; i += NTHR) { const int ci = i >> 10, k = i & 1023; const float v = ci < 16 ? P.in[I_C][ci * D + k] : P.in[I_CCTX][k]; s[i] = silu_(v); }
                have_s = true; __syncthreads();
            }
            const int layer = u / 96, jg = u % 96, kq = C.tid >> 6, jc = C.tid & 63;
            const float* w = P.in[I_WMOD] + (size_t)layer * D * 6144 + jg * 64 + jc;
            float acc[17];
#pragma unroll
            for (int i = 0; i < 17; ++i) acc[i] = 0.f;
            for (int k = kq * 128; k < kq * 128 + 128; ++k) { const float wv = w[(size_t)k * 6144];
#pragma unroll
                for (int i = 0; i < 17; ++i) acc[i] += s[i * 1024 + k] * wv; }
#pragma unroll
            for (int i = 0; i < 17; ++i) red[(kq * 17 + i) * 64 + jc] = acc[i];
            __syncthreads();
            for (int o = C.tid; o < 17 * 64; o += NTHR) { const int ci = o >> 6, c = o & 63; float v = 0.f;
#pragma unroll
                for (int q = 0; q < 8; ++q) v += red[(q * 17 + ci) * 64 + c];
                const int j = jg * 64 + c; v += P.in[I_BMOD][layer * 6144 + j];
                ((float*)(C.ws + WS_MOD))[((size_t)(layer * 17 + ci)) * 6144 + j] = v; }
            __syncthreads();
        }
        __syncthreads();
    }
    {
        const int gt = blockIdx.x * NTHR + C.tid, ngt = gridDim.x * NTHR;
        float2* rope = (float2*)(C.ws + WS_TAB + TAB_ROPE);
        for (int i = gt; i < 64 * 16; i += ngt) { const int pos = i >> 4, f = i & 15;
            const double th = exp(-(double)f * (9.210340371976184 / 16.0)); double s, c; dsincos((double)pos * th, s, c); rope[i] = make_float2((float)c, (float)s); }
        float2* lamb = (float2*)(C.ws + WS_TAB + TAB_LAMB); float2* bbar = (float2*)(C.ws + WS_TAB + TAB_BBAR);
        for (int i = gt; i < 2 * 32 * 64; i += ngt) {
            const int dg = i >> 6;
            const double are = P.in[I_ARE][i], aim = P.in[I_AIM][i], dt = exp((double)P.in[I_LOGDT][dg]);
            double s, c; dsincos(aim * dt, s, c); const double mag = exp(are * dt), lr = mag * c, li = mag * s;
            lamb[i] = make_float2((float)lr, (float)li);
            const double den = are * are + aim * aim, nr = lr - 1.0, ni = li;
            const double cr = (nr * are + ni * aim) / den, cim = (ni * are - nr * aim) / den;
            for (int p = 0; p < 16; ++p) { const double br = P.in[I_BRE][(size_t)i * 16 + p], bi = P.in[I_BIM][(size_t)i * 16 + p];
                bbar[(size_t)i * 16 + p] = make_float2((float)(cr * br - cim * bi), (float)(cr * bi + cim * br)); }
        }
    }
    {
        LAS float* scr = (LAS float*)(C.lds + C.wave * 16384);
        constexpr int I0 = 16 * 56, I1 = 16 * 32, I2 = 16 * 16, I3 = 8 * 16, I4 = 8 * 32;
        constexpr int NSMALL = I0 + I1 + I2 + I3 + I4;
        for (int it = C.gw; it < NSMALL + MOE_ITEMS; it += C.ngw) {
            int r = it;
            if (r < I0) { transpose_mat_item(P.in[I_MIXWIN], D, MIXW, (bf16*)(C.ws + WS_WIN0), r, scr, C.lane); continue; } r -= I0;
            if (r < I1) { transpose_mat_item(P.in[I_MIXWOUT], D, D, (bf16*)(C.ws + WS_WOUT0), r, scr, C.lane); continue; } r -= I1;
            if (r < I2) { transpose_mat_item(P.in[I_S5WIN], D, 512, (bf16*)(C.ws + WS_WS5IN), r, scr, C.lane); continue; } r -= I2;
            if (r < I3) { transpose_mat_item(P.in[I_WGLU], 512, 512, (bf16*)(C.ws + WS_WGLU), r, scr, C.lane); continue; } r -= I3;
            if (r < I4) { transpose_mat_item(P.in[I_S5WOUT], 512, D, (bf16*)(C.ws + WS_WS5OUT), r, scr, C.lane); continue; } r -= I4;
            moe_convert_item(C, 0, r, scr);
        }
    }
}

__device__ __forceinline__ void load_row16(const float* row, int lane, f32x4 (&v)[4]) {
#pragma unroll
    for (int j = 0; j < 4; ++j) v[j] = *(const f32x4*)(row + 4 * lane + 256 * j);
}
__device__ __forceinline__ float row_rstd(const f32x4 (&v)[4]) {
    float s = 0.f;
#pragma unroll
    for (int j = 0; j < 4; ++j) s += (v[j].x * v[j].x + v[j].y * v[j].y) + (v[j].z * v[j].z + v[j].w * v[j].w);
    return rsqrtf(wave_sum(s) * (1.f / D) + EPS);
}
__device__ __forceinline__ void modulate16(f32x4 (&v)[4], float rstd, const float* g, const float* scale, const float* shift, int lane) {
#pragma unroll
    for (int j = 0; j < 4; ++j) { const int c = 4 * lane + 256 * j; const f32x4 gg = *(const f32x4*)(g + c), sc = *(const f32x4*)(scale + c), sh = *(const f32x4*)(shift + c);
        v[j] = v[j] * rstd * gg * (sc + 1.f) + sh; }
}
__device__ __forceinline__ void store_row16_bf16(bf16* row, int lane, const f32x4 (&v)[4]) {
#pragma unroll
    for (int j = 0; j < 4; ++j) { v2u o; o.x = pk2(v[j].x, v[j].y); o.y = pk2(v[j].z, v[j].w); *(v2u*)(row + 4 * lane + 256 * j) = o; }
}

__device__ __forceinline__ void phase_norm_mix0(const Ctx& C) {
    const Params& P = *C.p; bf16* H = (bf16*)(C.ws + WS_H);
    for (int r = C.gw; r < TT; r += C.ngw) {
        f32x4 v[4]; load_row16(xin_row(P, r), C.lane, v);
        const float rstd = row_rstd(v); const int ci = cond_of(r);
        modulate16(v, rstd, P.in[I_GMIX], mod_vec(C, 0, ci, 1), mod_vec(C, 0, ci, 0), C.lane);
        store_row16_bf16(H + (size_t)r * D, C.lane, v);
    }
}

template <class Epi>
__device__ __forceinline__ void ngemm_unit(const Ctx& C, const bf16* A0, const bf16* B0, int K, int row0, int pn, const Epi& epi) {
    LAS float* As = (LAS float*)C.lds;
    LAS float* Bs = (LAS float*)(C.lds + 32 * 68 * 4);
    const int tid = C.tid, ty = tid >> 4, tx = tid & 15;
    float acc[2][16];
#pragma unroll
    for (int i = 0; i < 2; ++i)
#pragma unroll
        for (int j = 0; j < 16; ++j) acc[i][j] = 0.f;
    const int ar = tid >> 3, ak = (tid & 7) * 4, bn = tid >> 1, bk = (tid & 1) * 16;
    for (int k0 = 0; k0 < K; k0 += 32) {
        const v2u av = *(const v2u*)(A0 + (size_t)ar * K + k0 + ak);
        const v4u b0 = *(const v4u*)(B0 + (size_t)bn * K + k0 + bk), b1 = *(const v4u*)(B0 + (size_t)bn * K + k0 + bk + 8);
        __syncthreads();
        As[(ak + 0) * 68 + ar] = bf2f(av.x & 0xffffu); As[(ak + 1) * 68 + ar] = bf2f(av.x >> 16); As[(ak + 2) * 68 + ar] = bf2f(av.y & 0xffffu); As[(ak + 3) * 68 + ar] = bf2f(av.y >> 16);
        float bf[16]; unpack8(b0, bf); unpack8(b1, bf + 8);
#pragma unroll
        for (int i = 0; i < 16; ++i) Bs[(bk + i) * 260 + bn] = bf[i];
        __syncthreads();
#pragma unroll 4
        for (int k = 0; k < 32; ++k) {
            const float a0 = As[k * 68 + ty * 2], a1 = As[k * 68 + ty * 2 + 1];
            const f32x4 x0 = *(const LAS f32x4*)(Bs + k * 260 + tx * 8), x1 = *(const LAS f32x4*)(Bs + k * 260 + tx * 8 + 4);
            const f32x4 y0 = *(const LAS f32x4*)(Bs + k * 260 + 128 + tx * 8), y1 = *(const LAS f32x4*)(Bs + k * 260 + 128 + tx * 8 + 4);
            const float bb[16] = {x0.x, x0.y, x0.z, x0.w, x1.x, x1.y, x1.z, x1.w, y0.x, y0.y, y0.z, y0.w, y1.x, y1.y, y1.z, y1.w};
#pragma unroll
            for (int j = 0; j < 16; ++j) { acc[0][j] += a0 * bb[j]; acc[1][j] += a1 * bb[j]; }
        }
    }
#pragma unroll
    for (int i = 0; i < 2; ++i)
#pragma unroll
        for (int j = 0; j < 8; ++j) epi(row0 + ty * 2 + i, pn, tx * 8 + j, acc[i][j], acc[i][8 + j]);
    __syncthreads();
}
template <class Epi>
__device__ __forceinline__ void ngemm_dense(const Ctx& C, const bf16* A, const bf16* Bt, int M, int N, int K, const Epi& epi) {
    const int nN = N / 256, nU = (M / 64) * nN;
    for (int u = blockIdx.x; u < nU; u += gridDim.x) { const int tm = u / nN, pn = u % nN;
        ngemm_unit(C, A + (size_t)tm * 64 * K, Bt + (size_t)pn * 256 * K, K, tm * 64, pn, epi); }
}
template <class Epi>
__device__ __forceinline__ void ngemm_grouped(const Ctx& C, const bf16* A, const bf16* Bt, size_t estride, int N, int K, const Epi& epi) {
    const int* tile_e = (const int*)(C.ws + WS_ROUTE + RT_TILE); const int ntiles = *(const int*)(C.ws + WS_ROUTE + RT_NT);
    const int nN = N / 256, nU = ntiles * 4 * nN;
    for (int u = blockIdx.x; u < nU; u += gridDim.x) { const int pn = u % nN, tm = u / nN, e = tile_e[tm >> 2];
        ngemm_unit(C, A + (size_t)tm * 64 * K, Bt + (size_t)e * estride + (size_t)pn * 256 * K, K, tm * 64, pn, epi); }
}

struct EpiStoreBf16 { bf16* O; int ldc;
    __device__ __forceinline__ void operator()(int r, int pn, int c, float v0, float v1) const { bf16* o = O + (size_t)r * ldc + pn * 256 + c; o[0] = (bf16)f2bf(v0); o[128] = (bf16)f2bf(v1); } };
struct EpiResid0 { const Params* P; const float* mod; float* XC;
    __device__ __forceinline__ void operator()(int r, int pn, int c, float v0, float v1) const { const int n = pn * 256 + c; const float* xi = xin_row(*P, r); const float* g = mod + ((size_t)cond_of(r) * 6 + 2) * D;
        float* o = XC + (size_t)r * D; o[n] = xi[n] + g[n] * v0; o[n + 128] = xi[n + 128] + g[n + 128] * v1; } };
struct EpiResidAcc { const float* mod; float* XC;
    __device__ __forceinline__ void operator()(int r, int pn, int c, float v0, float v1) const { const int n = pn * 256 + c; const float* g = mod + ((size_t)cond_of(r) * 6 + 2) * D;
        float* o = XC + (size_t)r * D; o[n] += g[n] * v0; o[n + 128] += g[n + 128] * v1; } };
struct EpiSwiglu { bf16* G;
    __device__ __forceinline__ void operator()(int r, int pn, int c, float v0, float v1) const { G[(size_t)r * EH + pn * 128 + c] = (bf16)f2bf(silu_(v0) * v1); } };
struct EpiGlu { const bf16* GS; const float* b; bf16* GG;
    __device__ __forceinline__ void operator()(int r, int pn, int c, float v0, float v1) const { const int n = pn * 256 + c; const size_t o = (size_t)r * 512 + n;
        GG[o] = (bf16)f2bf(bf2f(GS[o]) * sigmoidf_(v0 + b[n])); GG[o + 128] = (bf16)f2bf(bf2f(GS[o + 128]) * sigmoidf_(v1 + b[n + 128])); } };

__device__ __forceinline__ void qk_norm_rope(float (&v)[8], const float* gain, bool lat, int t, int lane, const float2* rope) {
    float ss = 0.f;
#pragma unroll
    for (int j = 0; j < 8; ++j) ss += v[j] * v[j];
    ss += __shfl_xor(ss, 1); ss += __shfl_xor(ss, 2); ss += __shfl_xor(ss, 4);
    const float rstd = rsqrtf(ss * (1.f / 64.f) + EPS);
    const int l8 = lane & 7;
#pragma unroll
    for (int j = 0; j < 8; ++j) v[j] = v[j] * rstd * gain[l8 * 8 + j];
    const int quarter = l8 >> 1, pos = (quarter < 2) ? (t >> 6) : (t & 63);
#pragma unroll
    for (int j = 0; j < 8; ++j) {
        const float pv = __shfl_xor(v[j], 2);
        if (lat) { const float2 cs = rope[pos * 16 + (lane & 1) * 8 + j];
            v[j] = (quarter & 1) ? (v[j] * cs.x + pv * cs.y) : (v[j] * cs.x - pv * cs.y); }
    }
}
__device__ __forceinline__ void phase_qkprep(const Ctx& C) {
    const Params& P = *C.p; const bf16* Pb = (const bf16*)(C.ws + WS_P); bf16* Q = (bf16*)(C.ws + WS_Q); bf16* Kb = (bf16*)(C.ws + WS_K); bf16* Vb = (bf16*)(C.ws + WS_V);
    const float2* rope = (const float2*)(C.ws + WS_TAB + TAB_ROPE);
    for (int r = C.gw; r < TT; r += C.ngw) {
        const bool lat = r < TL; const int t = lat ? (r & 2047) : 0;
        const size_t kvrow = lat ? (size_t)(r >> 11) * KVL + CTXL + (r & 2047) : (size_t)((r - TL) >> 8) * KVL + ((r - TL) & 255);
        const bf16* pr = Pb + (size_t)r * MIXW;
        { float v[8]; unpack8(*(const v4u*)(pr + 8 * C.lane), v); qk_norm_rope(v, P.in[I_QG], lat, t, C.lane, rope);
          v4u o; o.x = pk2(v[0] * QSCALE, v[1] * QSCALE); o.y = pk2(v[2] * QSCALE, v[3] * QSCALE); o.z = pk2(v[4] * QSCALE, v[5] * QSCALE); o.w = pk2(v[6] * QSCALE, v[7] * QSCALE);
          *(v4u*)(Q + (size_t)r * 512 + 8 * C.lane) = o; }
        { const int l = C.lane & 15; float v[8]; unpack8(*(const v4u*)(pr + 512 + 8 * l), v); qk_norm_rope(v, P.in[I_KG], lat, t, C.lane, rope);
          if (C.lane < 16) { v4u o; o.x = pk2(v[0], v[1]); o.y = pk2(v[2], v[3]); o.z = pk2(v[4], v[5]); o.w = pk2(v[6], v[7]); *(v4u*)(Kb + kvrow * 128 + 8 * l) = o;
              *(v4u*)(Vb + kvrow * 128 + 8 * l) = *(const v4u*)(pr + 640 + 8 * l); } }
    }
}

__device__ __forceinline__ void phase_gmlp(const Ctx& C) {
    const Params& P = *C.p; const bf16* Pb = (const bf16*)(C.ws + WS_P); bf16* OG = (bf16*)(C.ws + WS_H);
    LAS bf16* VN = (LAS bf16*)C.lds; constexpr int VP = 520;
    const int g = __builtin_amdgcn_readfirstlane(C.tid >> 6);
    for (int ch = blockIdx.x; ch < TT / 128; ch += gridDim.x) {
        for (int i = 0; i < 16; ++i) { const int rl = C.wave * 16 + i; const bf16* pr = Pb + (size_t)(ch * 128 + rl) * MIXW + 1280 + 8 * C.lane;
            float v[8]; unpack8(*(const v4u*)pr, v); float s = 0.f;
#pragma unroll
            for (int j = 0; j < 8; ++j) { v[j] = gelu_tanh(v[j]); s += v[j]; }
            const float mean = wave_sum(s) * (1.f / 512.f); float q = 0.f;
#pragma unroll
            for (int j = 0; j < 8; ++j) { v[j] -= mean; q += v[j] * v[j]; }
            const float rstd = rsqrtf(wave_sum(q) * (1.f / 512.f) + EPS);
#pragma unroll
            for (int j = 0; j < 8; ++j) v[j] = v[j] * rstd * P.in[I_LNG][8 * C.lane + j];
            v4u o; o.x = pk2(v[0], v[1]); o.y = pk2(v[2], v[3]); o.z = pk2(v[4], v[5]); o.w = pk2(v[6], v[7]);
            *(LAS v4u*)(VN + rl * VP + 8 * C.lane) = o; }
        __syncthreads();
        const float* wsp = P.in[I_WSP] + (size_t)g * 128 * 128; const float* bsp = P.in[I_BSP] + g * 128;
        for (int pb = 0; pb < 16; ++pb) {
            float acc[8];
#pragma unroll
            for (int i = 0; i < 8; ++i) acc[i] = 0.f;
            for (int q = 0; q < 128; ++q) { const float v = bf2f(VN[q * VP + C.tid]);
#pragma unroll
                for (int i = 0; i < 8; ++i) acc[i] += wsp[(pb * 8 + i) * 128 + q] * v; }
#pragma unroll
            for (int i = 0; i < 8; ++i) { const int p = pb * 8 + i; const size_t row = (size_t)ch * 128 + p;
                const float u = gelu_tanh(bf2f(Pb[row * MIXW + 768 + C.tid]));
                OG[row * D + 512 + C.tid] = (bf16)f2bf(u * (acc[i] + bsp[p])); }
        }
        __syncthreads();
    }
}

__device__ __forceinline__ void attn_item(const Ctx& C, int b, int h, int qrow_g, int nk) {
    const bf16* Q = (const bf16*)(C.ws + WS_Q); const bf16* Kb = (const bf16*)(C.ws + WS_K) + (size_t)b * KVL * 128 + (h >> 2) * 64; const bf16* Vb = (const bf16*)(C.ws + WS_V) + (size_t)b * KVL * 128 + (h >> 2) * 64;
    bf16* OG = (bf16*)(C.ws + WS_H);
    float q[64];
#pragma unroll
    for (int i = 0; i < 8; ++i) unpack8(*(const v4u*)(Q + (size_t)qrow_g * 512 + h * 64 + 8 * i), q + 8 * i);
    float m = -INFINITY, l = 0.f, o = 0.f;
    for (int kt = 0; kt < nk; kt += 64) {
        const bf16* kr = Kb + (size_t)(kt + C.lane) * 128; float s = 0.f;
#pragma unroll
        for (int i = 0; i < 8; ++i) { float kf[8]; unpack8(*(const v4u*)(kr + 8 * i), kf);
#pragma unroll
            for (int j = 0; j < 8; ++j) s += q[8 * i + j] * kf[j]; }
        const float mn = fmaxf(m, wave_max(s)); const float p = exp2f(s - mn), corr = exp2f(m - mn);
        l = l * corr + wave_sum(p); o *= corr; m = mn;
#pragma unroll 8
        for (int jj = 0; jj < 64; ++jj) { const float pj = __shfl(p, jj); o += pj * bf2f(Vb[(size_t)(kt + jj) * 128 + C.lane]); }
    }
    OG[(size_t)qrow_g * D + h * 64 + C.lane] = (bf16)f2bf(o / l);
}
__device__ __forceinline__ void phase_attn(const Ctx& C) {
    for (int it = C.gw; it < NB * 8 * SEQ; it += C.ngw) { const int bh = it >> 11, t = it & 2047, b = bh >> 3, h = bh & 7; attn_item(C, b, h, b * SEQ + t, KVL); }
    for (int it = C.gw; it < NB * 8 * CTXL; it += C.ngw) { const int bh = it >> 8, t = it & 255, b = bh >> 3, h = bh & 7; attn_item(C, b, h, TL + b * CTXL + t, CTXL); }
}

__device__ __forceinline__ void phase_norm_ffn_router(const Ctx& C, int layer, int nrows) {
    const Params& P = *C.p; const float* XC = (const float*)(C.ws + WS_XC); bf16* F = (bf16*)(C.ws + WS_H);
    int* asg_e = (int*)(C.ws + WS_ROUTE + RT_E); int* asg_p = (int*)(C.ws + WS_ROUTE + RT_P); float* asg_w = (float*)(C.ws + WS_ROUTE + RT_W);
    unsigned* cnt = (unsigned*)(C.ws + WS_CTL) + CW_CNT + 64 * layer;
    const float* wg = P.in[I_WGRP] + (size_t)layer * D * 4; const float* wr = P.in[I_WRT] + (size_t)layer * D * 32;
    for (int r = C.gw; r < nrows; r += C.ngw) {
        f32x4 v[4]; load_row16(XC + (size_t)r * D, C.lane, v);
        const float rstd = row_rstd(v); const int ci = cond_of(r);
        modulate16(v, rstd, P.in[I_GFFN] + layer * D, mod_vec(C, layer, ci, 4), mod_vec(C, layer, ci, 3), C.lane);
        store_row16_bf16(F + (size_t)r * D, C.lane, v);
        float lg[4] = {0.f, 0.f, 0.f, 0.f}; float le[32];
#pragma unroll
        for (int i = 0; i < 32; ++i) le[i] = 0.f;
#pragma unroll
        for (int j = 0; j < 4; ++j)
#pragma unroll
            for (int i = 0; i < 4; ++i) { const int c = 4 * C.lane + 256 * j + i; const float f = v[j][i];
                const f32x4 g4 = *(const f32x4*)(wg + (size_t)c * 4); lg[0] += f * g4.x; lg[1] += f * g4.y; lg[2] += f * g4.z; lg[3] += f * g4.w;
#pragma unroll
                for (int e4 = 0; e4 < 8; ++e4) { const f32x4 w4 = *(const f32x4*)(wr + (size_t)c * 32 + e4 * 4); le[e4 * 4] += f * w4.x; le[e4 * 4 + 1] += f * w4.y; le[e4 * 4 + 2] += f * w4.z; le[e4 * 4 + 3] += f * w4.w; } }
#pragma unroll
        for (int i = 0; i < 4; ++i) lg[i] = wave_sum(lg[i]) + P.in[I_BGRP][layer * 4 + i];
#pragma unroll
        for (int i = 0; i < 32; ++i) le[i] = wave_sum(le[i]) + P.in[I_BRT][layer * 32 + i];
        int gi = 0; float gm = lg[0];
#pragma unroll
        for (int i = 1; i < 4; ++i) if (lg[i] > gm) { gm = lg[i]; gi = i; }
        float den = 0.f;
#pragma unroll
        for (int i = 0; i < 4; ++i) den += __expf(lg[i] - gm);
        const float gw_ = 1.f / den;
        float sel[8];
#pragma unroll
        for (int i = 0; i < 8; ++i) sel[i] = gi == 0 ? le[i] : gi == 1 ? le[8 + i] : gi == 2 ? le[16 + i] : le[24 + i];
        int i0 = 0; float v0 = sel[0];
#pragma unroll
        for (int i = 1; i < 8; ++i) if (sel[i] > v0) { v0 = sel[i]; i0 = i; }
        int i1 = -1; float v1 = -INFINITY;
#pragma unroll
        for (int i = 0; i < 8; ++i) if (i != i0 && sel[i] > v1) { v1 = sel[i]; i1 = i; }
        const float e1 = __expf(v1 - v0), w0 = gw_ / (1.f + e1), w1 = gw_ * e1 / (1.f + e1);
        if (C.lane == 0) {
            const int ea = gi * 8 + i0, eb = gi * 8 + i1;
            const unsigned pa = __hip_atomic_fetch_add(cnt + ea, 1u, __ATOMIC_RELAXED, __HIP_MEMORY_SCOPE_AGENT);
            const unsigned pb = __hip_atomic_fetch_add(cnt + eb, 1u, __ATOMIC_RELAXED, __HIP_MEMORY_SCOPE_AGENT);
            asg_e[2 * r] = ea; asg_e[2 * r + 1] = eb; asg_p[2 * r] = (int)pa; asg_p[2 * r + 1] = (int)pb; asg_w[2 * r] = w0; asg_w[2 * r + 1] = w1;
        }
    }
}
__device__ __forceinline__ void phase_gather(const Ctx& C, int layer, int nrows) {
    const bf16* F = (const bf16*)(C.ws + WS_H); bf16* XS = (bf16*)(C.ws + WS_XS);
    const int* asg_e = (const int*)(C.ws + WS_ROUTE + RT_E); const int* asg_p = (const int*)(C.ws + WS_ROUTE + RT_P); int* asg_s = (int*)(C.ws + WS_ROUTE + RT_S);
    int* tile_e = (int*)(C.ws + WS_ROUTE + RT_TILE); int* ntl = (int*)(C.ws + WS_ROUTE + RT_NT);
    unsigned* cnt = (unsigned*)(C.ws + WS_CTL) + CW_CNT + 64 * layer;
    const int mycnt = (C.lane < 32) ? (int)__hip_atomic_load(cnt + C.lane, __ATOMIC_RELAXED, __HIP_MEMORY_SCOPE_AGENT) : 0;
    const int mypad = (mycnt + 255) & ~255;
    int incl = mypad;
#pragma unroll
    for (int o = 1; o < 32; o <<= 1) { const int t = __shfl_up(incl, o); if ((C.lane & 31) >= o) incl += t; }
    const int ps = incl - mypad;
    for (int it = C.gw; it < nrows * 2; it += C.ngw) {
        const int e = asg_e[it], p = asg_p[it]; const int slot = __shfl(ps, e) + p;
        if (C.lane == 0) asg_s[it] = slot;
        const v4u* src = (const v4u*)(F + (size_t)(it >> 1) * D); v4u* dst = (v4u*)(XS + (size_t)slot * D);
        dst[C.lane] = src[C.lane]; dst[64 + C.lane] = src[64 + C.lane];
    }
    for (int e = C.gw; e < 33; e += C.ngw) {
        if (e < 32) { const int c0 = __shfl(mycnt, e), c1 = __shfl(mypad, e), base = __shfl(ps, e);
            for (int rr = c0; rr < c1; ++rr) { v4u* dst = (v4u*)(XS + (size_t)(base + rr) * D); const v4u z = {0u, 0u, 0u, 0u}; dst[C.lane] = z; dst[64 + C.lane] = z; } }
        else { if (C.lane < 32) { for (int t = ps / 256; t < (ps + mypad) / 256; ++t) tile_e[t] = C.lane; if (C.lane == 31) *ntl = (ps + mypad) / 256; } }
    }
}
__device__ __forceinline__ void moe_combine(const Ctx& C, int layer, int r, f32x4 (&v)[4]) {
    const bf16* Y2 = (const bf16*)(C.ws + WS_XS); const int* asg_s = (const int*)(C.ws + WS_ROUTE + RT_S); const float* asg_w = (const float*)(C.ws + WS_ROUTE + RT_W);
    const float* XC = (const float*)(C.ws + WS_XC);
    load_row16(XC + (size_t)r * D, C.lane, v);
    const int s0 = asg_s[2 * r], s1 = asg_s[2 * r + 1]; const float w0 = asg_w[2 * r], w1 = asg_w[2 * r + 1];
    const float* gate = mod_vec(C, layer, cond_of(r), 5);
#pragma unroll
    for (int j = 0; j < 4; ++j) { const int c = 4 * C.lane + 256 * j; const v2u a = *(const v2u*)(Y2 + (size_t)s0 * D + c), b = *(const v2u*)(Y2 + (size_t)s1 * D + c); const f32x4 g = *(const f32x4*)(gate + c);
        v[j].x += g.x * (w0 * bf2f(a.x & 0xffffu) + w1 * bf2f(b.x & 0xffffu)); v[j].y += g.y * (w0 * bf2f(a.x >> 16) + w1 * bf2f(b.x >> 16));
        v[j].z += g.z * (w0 * bf2f(a.y & 0xffffu) + w1 * bf2f(b.y & 0xffffu)); v[j].w += g.w * (w0 * bf2f(a.y >> 16) + w1 * bf2f(b.y >> 16)); }
}
__device__ __forceinline__ void phase_combine_norm_mix1(const Ctx& C) {
    const Params& P = *C.p; float* XC = (float*)(C.ws + WS_XC); bf16* H = (bf16*)(C.ws + WS_H);
    for (int r = C.gw; r < TT; r += C.ngw) {
        f32x4 v[4]; moe_combine(C, 0, r, v);
#pragma unroll
        for (int j = 0; j < 4; ++j) *(f32x4*)(XC + (size_t)r * D + 4 * C.lane + 256 * j) = v[j];
        const float rstd = row_rstd(v); const int ci = cond_of(r);
        modulate16(v, rstd, P.in[I_GMIX] + D, mod_vec(C, 1, ci, 1), mod_vec(C, 1, ci, 0), C.lane);
        store_row16_bf16(H + (size_t)r * D, C.lane, v);
    }
    LAS float* scr = (LAS float*)(C.lds + C.wave * 16384);
    for (int it = C.gw; it < MOE_ITEMS; it += C.ngw) moe_convert_item(C, 1, it, scr);
}
__device__ __forceinline__ void phase_final(const Ctx& C) {
    const Params& P = *C.p;
    for (int r = C.gw; r < TL; r += C.ngw) {
        f32x4 v[4]; moe_combine(C, 1, r, v);
        const float rstd = row_rstd(v);
#pragma unroll
        for (int j = 0; j < 4; ++j) { const int c = 4 * C.lane + 256 * j; const f32x4 g = *(const f32x4*)(P.in[I_FING] + c); *(f32x4*)(P.out + (size_t)r * D + c) = v[j] * rstd * g; }
    }
}

__device__ __forceinline__ void phase_s5(const Ctx& C) {
    const Params& P = *C.p; const bf16* U = (const bf16*)(C.ws + WS_U); bf16* GS = (bf16*)(C.ws + WS_GS); float* YA = (float*)(C.ws + WS_YACC);
    const float2* lamb = (const float2*)(C.ws + WS_TAB + TAB_LAMB); const float2* bbar = (const float2*)(C.ws + WS_TAB + TAB_BBAR);
    LAS f32x2* hb = (LAS f32x2*)(C.lds + C.wave * 8192);
    const int lane = C.lane;
    for (int it = C.gw; it < NB * 32; it += C.ngw) {
        const int b = it >> 5, g = it & 31;
        for (int dir = 0; dir < 2; ++dir) {
            const int dgn = ((dir * 32 + g) * 64 + lane);
            const float2 lam = lamb[dgn]; float2 bb[16];
#pragma unroll
            for (int p = 0; p < 16; ++p) bb[p] = bbar[(size_t)dgn * 16 + p];
            const float* cre = P.in[I_CRE] + (size_t)(dir * 32 + g) * 16 * 64; const float* cim = P.in[I_CIM] + (size_t)(dir * 32 + g) * 16 * 64;
            float hr = 0.f, hi = 0.f;
            for (int ck = 0; ck < 144; ++ck) {
                const bool isl = ck >= 16;
                const int tb = isl ? (dir == 0 ? (ck - 16) * 16 : (143 - ck) * 16) : (dir == 0 ? ck * 16 : (15 - ck) * 16);
                const size_t rowb = isl ? (size_t)b * SEQ + tb : (size_t)TL + (size_t)b * CTXL + tb;
                for (int sl = 0; sl < 16; ++sl) {
                    const int to = dir == 0 ? sl : 15 - sl;
                    const bf16* ur = U + (rowb + to) * 512 + g * 16; float uf[16]; unpack8(*(const v4u*)ur, uf); unpack8(*(const v4u*)(ur + 8), uf + 8);
                    float br = 0.f, bi = 0.f;
#pragma unroll
                    for (int p = 0; p < 16; ++p) { br += bb[p].x * uf[p]; bi += bb[p].y * uf[p]; }
                    const float nr = lam.x * hr - lam.y * hi + br, ni = lam.x * hi + lam.y * hr + bi; hr = nr; hi = ni;
                    if (isl) hb[to * 64 + lane] = (f32x2){hr, hi};
                }
                if (isl) {
                    asm volatile("s_waitcnt lgkmcnt(0)" ::: "memory");
                    const int p = lane & 15;
#pragma unroll
                    for (int i = 0; i < 4; ++i) { const int to = (lane >> 4) + 4 * i; float y = 0.f;
                        for (int n = 0; n < 64; ++n) { const f32x2 h = hb[to * 64 + n]; y += cre[p * 64 + n] * h.x - cim[p * 64 + n] * h.y; }
                        const size_t o = (rowb + to) * 512 + g * 16 + p;
                        if (dir == 0) YA[o] = y + P.in[I_S5D][g * 16 + p] * bf2f(U[o]);
                        else GS[o] = (bf16)f2bf(gelu_tanh(YA[o] + y)); }
                    asm volatile("s_waitcnt lgkmcnt(0)" ::: "memory");
                }
            }
        }
    }
}

__global__ void __launch_bounds__(NTHR, 2) fwd_kernel(Params prm) {
    extern __shared__ __attribute__((aligned(16))) unsigned char lds_raw[];
    Ctx C; C.p = &prm; C.ws = prm.ws; C.lds = (LAS unsigned char*)lds_raw;
    C.tid = threadIdx.x; C.lane = C.tid & 63; C.wave = __builtin_amdgcn_readfirstlane(C.tid >> 6);
    C.gw = blockIdx.x * NWAVE + C.wave; C.ngw = gridDim.x * NWAVE;
    constexpr int LDS_MISC = 147456 - 256;
    volatile LAS unsigned* misc = (volatile LAS unsigned*)(C.lds + LDS_MISC);
    if (C.tid < 64) misc[C.tid] = 0u;
    __syncthreads();
    unsigned* ctl = (unsigned*)(C.ws + WS_CTL);
    XcdBarrier bar; bar.bar = ctl + CW_BAR; bar.x = 0; bar.st = nullptr;
#if MK_ONE_LAUNCH
    bar = xcd_barrier_post(ctl + CW_BAR, misc + 8);
#define SEAM(k) do { if (lo <= (k) && (k) + 1 < hi) xcd_barrier(bar); } while (0)
#else
#define SEAM(k) do { } while (0)
#endif
    const int lo = prm.ph_lo, hi = prm.ph_hi;
#define IN(k) (lo <= (k) && (k) < hi)
    const Params& P = prm;
    bf16* Hb = (bf16*)(C.ws + WS_H); float* XC = (float*)(C.ws + WS_XC);
    if (IN(0)) { phase_prologue(C); SEAM(0); }
    if (IN(1)) { phase_norm_mix0(C); SEAM(1); }
    if (IN(2)) { EpiStoreBf16 E{(bf16*)(C.ws + WS_P), MIXW}; ngemm_dense(C, Hb, (const bf16*)(C.ws + WS_WIN0), TT, MIXW, D, E); SEAM(2); }
    if (IN(3)) { phase_qkprep(C); phase_gmlp(C); SEAM(3); }
    if (IN(4)) { phase_attn(C); SEAM(4); }
    if (IN(5)) { EpiResid0 E{&P, (const float*)(C.ws + WS_MOD), XC}; ngemm_dense(C, Hb, (const bf16*)(C.ws + WS_WOUT0), TT, D, D, E); SEAM(5); }
    if (IN(6)) { phase_norm_ffn_router(C, 0, TT); SEAM(6); }
    if (IN(7)) { phase_gather(C, 0, TT); SEAM(7); }
    if (IN(8)) { EpiSwiglu E{(bf16*)(C.ws + WS_G13)}; ngemm_grouped(C, (const bf16*)(C.ws + WS_XS), (const bf16*)(C.ws + WS_W13), (size_t)1024 * 1024, 1024, D, E); SEAM(8); }
    if (IN(9)) { EpiStoreBf16 E{(bf16*)(C.ws + WS_XS), D}; ngemm_grouped(C, (const bf16*)(C.ws + WS_G13), (const bf16*)(C.ws + WS_W2), (size_t)1024 * 512, 1024, EH, E); SEAM(9); }
    if (IN(10)) { phase_combine_norm_mix1(C); SEAM(10); }
    if (IN(11)) { EpiStoreBf16 E{(bf16*)(C.ws + WS_U), 512}; ngemm_dense(C, Hb, (const bf16*)(C.ws + WS_WS5IN), TT, 512, D, E); SEAM(11); }
    if (IN(12)) { phase_s5(C); SEAM(12); }
    if (IN(13)) { EpiGlu E{(const bf16*)(C.ws + WS_GS), P.in[I_BGLU], (bf16*)(C.ws + WS_GG)}; ngemm_dense(C, (const bf16*)(C.ws + WS_GS), (const bf16*)(C.ws + WS_WGLU), TL, 512, 512, E); SEAM(13); }
    if (IN(14)) { EpiResidAcc E{(const float*)(C.ws + WS_MOD) + (size_t)17 * 6 * D, XC}; ngemm_dense(C, (const bf16*)(C.ws + WS_GG), (const bf16*)(C.ws + WS_WS5OUT), TL, D, 512, E); SEAM(14); }
    if (IN(15)) { phase_norm_ffn_router(C, 1, TL); SEAM(15); }
    if (IN(16)) { phase_gather(C, 1, TL); SEAM(16); }
    if (IN(17)) { EpiSwiglu E{(bf16*)(C.ws + WS_G13)}; ngemm_grouped(C, (const bf16*)(C.ws + WS_XS), (const bf16*)(C.ws + WS_W13), (size_t)1024 * 1024, 1024, D, E); SEAM(17); }
    if (IN(18)) { EpiStoreBf16 E{(bf16*)(C.ws + WS_XS), D}; ngemm_grouped(C, (const bf16*)(C.ws + WS_G13), (const bf16*)(C.ws + WS_W2), (size_t)1024 * 512, 1024, EH, E); SEAM(18); }
    if (IN(19)) { phase_final(C); }
#undef IN
#undef SEAM
}

extern "C" void kernel_launch(void* const* d_in, const int* in_sizes, int n_in, void* d_out, int out_size, void* d_ws, size_t ws_size, hipStream_t stream) {
    constexpr int LDS_BYTES = 147456;
    static int grid = 0;
    if (grid == 0) {
        if (n_in != 35 || out_size != TL * D || ws_size < WS_END) { fprintf(stderr, "kernel_launch: unexpected shapes (n_in %d out %d ws %zu)\n", n_in, out_size, ws_size); grid = -1; return; }
        int dev = 0, cus = 0;
        if (hipGetDevice(&dev) != hipSuccess || hipDeviceGetAttribute(&cus, hipDeviceAttributeMultiprocessorCount, dev) != hipSuccess) { grid = -1; return; }
        if (hipFuncSetAttribute((const void*)fwd_kernel, hipFuncAttributeMaxDynamicSharedMemorySize, LDS_BYTES) != hipSuccess) { fprintf(stderr, "kernel_launch: hipFuncSetAttribute failed\n"); grid = -1; return; }
        (void)hipGetLastError();
        grid = cus;
    }
    if (grid < 0) return;
    (void)hipMemsetAsync((char*)d_ws + WS_CTL, 0, CTL_BYTES, stream);
    Params p{};
    for (int i = 0; i < 35; ++i) p.in[i] = (const float*)d_in[i];
    p.out = (float*)d_out; p.ws = (unsigned char*)d_ws;
#if MK_ONE_LAUNCH
    p.ph_lo = 0; p.ph_hi = NPHASE;
    hipLaunchKernelGGL(fwd_kernel, dim3(grid), dim3(NTHR), LDS_BYTES, stream, p);
#else
    for (int k = 0; k < NPHASE; ++k) { p.ph_lo = k; p.ph_hi = k + 1; hipLaunchKernelGGL(fwd_kernel, dim3(grid), dim3(NTHR), LDS_BYTES, stream, p); }
#endif
}
```

```cpp
#include <hip/hip_runtime.h>
#include <cstdio>
#include <cstdint>

#ifndef MK_ONE_LAUNCH
#define MK_ONE_LAUNCH 1
#endif

constexpr int D = 1024, NB = 16, SEQ = 2048, CTXL = 256;
constexpr int TL = NB * SEQ, TC = NB * CTXL, TT = TL + TC;
constexpr int KVL = CTXL + SEQ;
constexpr int MIXW = 1792, NEXP = 32, EH = 512;
constexpr int NSLOT = 81920;
constexpr float EPS = 1e-6f;
constexpr float QSCALE = 0.125f * 1.4426950408889634f;
constexpr int NTHR = 512, NWAVE = 8;
constexpr int NPHASE = 20;

constexpr size_t MiB = 1u << 20;
constexpr size_t WS_CTL = 0, CTL_BYTES = 1 * MiB;
constexpr size_t WS_MOD = 1 * MiB;
constexpr size_t WS_TAB = 2 * MiB;
constexpr size_t TAB_ROPE = 0, TAB_LAMB = 16384, TAB_BBAR = 65536;
constexpr size_t WS_ROUTE = 3 * MiB;
constexpr size_t RT_E = 0, RT_P = 320 * 1024, RT_W = 640 * 1024, RT_S = 960 * 1024, RT_TILE = 1280 * 1024, RT_NT = 1280 * 1024 + 4096;
constexpr size_t WS_WIN0 = 6 * MiB, WS_WOUT0 = 10 * MiB, WS_WS5IN = 12 * MiB, WS_WGLU = 13 * MiB, WS_WS5OUT = 14 * MiB;
constexpr size_t WS_W13 = 16 * MiB, WS_W2 = 80 * MiB;
constexpr size_t WS_XC = 112 * MiB;
constexpr size_t WS_H = 256 * MiB;
constexpr size_t WS_P = 328 * MiB;
constexpr size_t WS_Q = 454 * MiB, WS_K = 490 * MiB, WS_V = 499 * MiB;
constexpr size_t WS_XS = 328 * MiB;
constexpr size_t WS_G13 = 488 * MiB;
constexpr size_t WS_U = 328 * MiB, WS_GS = 364 * MiB, WS_GG = 396 * MiB, WS_YACC = 428 * MiB;
constexpr size_t WS_END = 568 * MiB;
constexpr int CW_CNT = 64;
constexpr int CW_BAR = 4096;

#define LAS __attribute__((address_space(3)))
typedef unsigned short bf16;
typedef unsigned v4u __attribute__((ext_vector_type(4)));
typedef unsigned v2u __attribute__((ext_vector_type(2)));
typedef float f32x4 __attribute__((ext_vector_type(4)));
typedef float f32x2 __attribute__((ext_vector_type(2)));
__device__ __forceinline__ float bf2f(unsigned u) { return __uint_as_float(u << 16); }
__device__ __forceinline__ unsigned f2bf(float f) { unsigned u = __float_as_uint(f); return (u + 0x7fffu + ((u >> 16) & 1u)) >> 16; }
__device__ __forceinline__ unsigned pk2(float lo, float hi) { return f2bf(lo) | (f2bf(hi) << 16); }
__device__ __forceinline__ float wave_sum(float v) {
#pragma unroll
    for (int o = 1; o < 64; o <<= 1) v += __shfl_xor(v, o);
    return v;
}
__device__ __forceinline__ float wave_max(float v) {
#pragma unroll
    for (int o = 1; o < 64; o <<= 1) v = fmaxf(v, __shfl_xor(v, o));
    return v;
}
__device__ __forceinline__ float gelu_tanh(float x) { const float u = 0.7978845608028654f * (x + 0.044715f * x * x * x); return 0.5f * x * (1.f + tanhf(u)); }
__device__ __forceinline__ float sigmoidf_(float x) { return 1.f / (1.f + __expf(-x)); }
__device__ __forceinline__ float silu_(float x) { return x / (1.f + __expf(-x)); }
__device__ __forceinline__ void unpack8(const v4u w, float* f) {
    f[0] = bf2f(w.x & 0xffffu); f[1] = bf2f(w.x >> 16); f[2] = bf2f(w.y & 0xffffu); f[3] = bf2f(w.y >> 16);
    f[4] = bf2f(w.z & 0xffffu); f[5] = bf2f(w.z >> 16); f[6] = bf2f(w.w & 0xffffu); f[7] = bf2f(w.w >> 16);
}

#define XB_TMO      128
#define XB_XCNT(j)  (256  + 64 * (j))
#define XB_XSUB(j)  (1280 + 64 * (j))
#define XB_XGEN(j)  (2304 + 64 * (j))
#define XB_TOP      3328
#define XB_TOPGEN   3392
#define XCD_BAR_WORDS 3456
#define XB_SPIN_CAP (1u << 28)
__device__ __forceinline__ unsigned xb_ld(unsigned* p)              { return __hip_atomic_load(p, __ATOMIC_RELAXED, __HIP_MEMORY_SCOPE_AGENT); }
__device__ __forceinline__ unsigned xb_add(unsigned* p, unsigned v) { return __hip_atomic_fetch_add(p, v, __ATOMIC_RELAXED, __HIP_MEMORY_SCOPE_AGENT); }
__device__ __forceinline__ unsigned xb_xcc_id() { return (unsigned)__builtin_amdgcn_s_getreg((3 << 11) | 20) & 0xFu; }
#define XB_SPIN(cond, bar) do { unsigned _sp = 0; while (cond) { __builtin_amdgcn_s_sleep(1); \
    if ((++_sp & 255u) == 0u) { if (xb_ld(&(bar)[XB_TMO])) break; if (_sp > XB_SPIN_CAP) { atomicAdd(&(bar)[XB_TMO], 1u); break; } } } } while (0)
struct XcdBarrier { unsigned* bar; unsigned x; volatile LAS unsigned* st; };
__device__ __forceinline__ XcdBarrier xcd_barrier_post(unsigned* bar, volatile LAS unsigned* st) {
    XcdBarrier b; b.bar = bar; b.x = xb_xcc_id(); b.st = st;
    if (threadIdx.x == 0) (void)xb_add(&bar[XB_XCNT(b.x)], 1u);
    return b;
}
__device__ __forceinline__ void xcd_barrier_complete(unsigned* bar, unsigned x, unsigned& nloc, unsigned& nx) {
    const unsigned G = gridDim.x * gridDim.y * gridDim.z;
    unsigned sum, cnt, mine, sp = 0u;
    for (;;) {
        sum = 0u; cnt = 0u; mine = 0u;
#pragma unroll
        for (unsigned j = 0; j < 16; ++j) { const unsigned c = xb_ld(&bar[XB_XCNT(j)]); sum += c; cnt += (c > 0u) ? 1u : 0u; mine = (j == x) ? c : mine; }
        if (sum == G) break;
        __builtin_amdgcn_s_sleep(1);
        if ((++sp & 255u) == 0u) { if (xb_ld(&bar[XB_TMO])) break; if (sp > XB_SPIN_CAP) { atomicAdd(&bar[XB_TMO], 1u); break; } }
    }
    nloc = mine > 0u ? mine : 1u; nx = cnt > 0u ? cnt : 1u;
}
__device__ __forceinline__ void xcd_barrier(const XcdBarrier& b) {
    asm volatile("s_waitcnt vmcnt(0)" ::: "memory");
    __syncthreads();
    if (threadIdx.x == 0) {
        unsigned* bar = b.bar;
        __builtin_amdgcn_s_waitcnt(0);
        unsigned nloc = b.st[0], nx = b.st[1];
        if (nloc == 0u) { xcd_barrier_complete(bar, b.x, nloc, nx); b.st[0] = nloc; b.st[1] = nx; }
        const unsigned old = xb_add(&bar[XB_XSUB(b.x)], 1u);
        const unsigned gen = old / nloc;
        if (old + 1u == (gen + 1u) * nloc) {
            __builtin_amdgcn_fence(__ATOMIC_RELEASE, "agent");
            asm volatile("s_waitcnt vmcnt(0)" ::: "memory");
            const unsigned og = xb_add(&bar[XB_TOP], 1u);
            const unsigned tg = og / nx;
            if (og + 1u == (tg + 1u) * nx) xb_add(&bar[XB_TOPGEN], 1u);
            else XB_SPIN(xb_ld(&bar[XB_TOPGEN]) == tg, bar);
            __builtin_amdgcn_fence(__ATOMIC_ACQUIRE, "agent");
            xb_add(&bar[XB_XGEN(b.x)], 1u);
            asm volatile("s_waitcnt vmcnt(0)" ::: "memory");
        } else {
            XB_SPIN(xb_ld(&bar[XB_XGEN(b.x)]) == gen, bar);
            __builtin_amdgcn_fence(__ATOMIC_ACQUIRE, "agent");
            asm volatile("s_waitcnt vmcnt(0)" ::: "memory");
        }
    }
    __syncthreads();
}

struct Params {
    const float* in[35];
    float* out;
    unsigned char* ws;
    int ph_lo, ph_hi;
};
enum { I_X = 0, I_C, I_CTX, I_CCTX, I_WMOD, I_BMOD, I_GMIX, I_GFFN, I_MIXWIN, I_MIXWOUT, I_QG, I_KG, I_LNG, I_WSP, I_BSP,
       I_S5WIN, I_ARE, I_AIM, I_LOGDT, I_BRE, I_BIM, I_CRE, I_CIM, I_S5D, I_WGLU, I_BGLU, I_S5WOUT,
       I_WGRP, I_BGRP, I_WRT, I_BRT, I_W1, I_W3, I_W2, I_FING };

struct Ctx {
    const Params* p;
    unsigned char* ws;
    LAS unsigned char* lds;
    int tid, lane, wave, gw, ngw;
};
__device__ __forceinline__ const float* xin_row(const Params& P, int r) { return r < TL ? P.in[I_X] + (size_t)r * D : P.in[I_CTX] + (size_t)(r - TL) * D; }
__device__ __forceinline__ int cond_of(int r) { return r < TL ? (r >> 11) : 16; }
__device__ __forceinline__ const float* mod_vec(const Ctx& C, int layer, int ci, int k) { return (const float*)(C.ws + WS_MOD) + ((size_t)(layer * 17 + ci) * 6 + k) * D; }

__device__ __forceinline__ void dsincos(double a, double& s, double& c) {
    const double TWO_PI_HI = 6.283185307179586, TWO_PI_LO = 2.4492935982947064e-16;
    const double k = rint(a * 0.15915494309189535);
    double r = fma(-k, TWO_PI_HI, a); r = fma(-k, TWO_PI_LO, r);
    const double r2 = r * r; double ct = 1.0, st = r, cs = 1.0, ss = r;
#pragma unroll 1
    for (int i = 1; i <= 15; ++i) { ct *= -r2 / (double)((2 * i - 1) * (2 * i)); cs += ct; st *= -r2 / (double)((2 * i) * (2 * i + 1)); ss += st; }
    s = ss; c = cs;
}

__device__ __forceinline__ void transpose_item(const float* src, int N, int k0, int n0, bf16* dst, int dpitch, LAS float* scr, int lane) {
#pragma unroll 8
    for (int i = 0; i < 32; ++i) { const int kk = 2 * i + (lane >> 5); scr[kk * 33 + (lane & 31)] = src[(size_t)(k0 + kk) * N + n0 + (lane & 31)]; }
    asm volatile("s_waitcnt lgkmcnt(0)" ::: "memory");
    const int c = lane & 7;
#pragma unroll
    for (int j = 0; j < 4; ++j) { const int n = (lane >> 3) + 8 * j; const LAS float* s = scr + (8 * c) * 33 + n;
        v4u o; o.x = pk2(s[0 * 33], s[1 * 33]); o.y = pk2(s[2 * 33], s[3 * 33]); o.z = pk2(s[4 * 33], s[5 * 33]); o.w = pk2(s[6 * 33], s[7 * 33]);
        *(v4u*)(dst + (size_t)n * dpitch + 8 * c) = o; }
    asm volatile("s_waitcnt lgkmcnt(0)" ::: "memory");
}
__device__ __forceinline__ void transpose_mat_item(const float* W, int K, int N, bf16* WT, int it, LAS float* scr, int lane) {
    const int nblk = N / 32, kb = it / nblk, nb = it % nblk;
    transpose_item(W, N, kb * 64, nb * 32, WT + (size_t)(nb * 32) * K + kb * 64, K, scr, lane);
}
constexpr int MOE_ITEMS = NEXP * 768;
__device__ __forceinline__ void moe_convert_item(const Ctx& C, int layer, int it, LAS float* scr) {
    const Params& P = *C.p;
    const int e = it / 768, r = it % 768, kind = r / 256, j = r % 256;
    if (kind < 2) {
        const float* src = (kind == 0 ? P.in[I_W1] : P.in[I_W3]) + ((size_t)layer * NEXP + e) * D * EH;
        const int kb = j / 16, nb = j % 16, k0 = kb * 64, n0 = nb * 32;
        const int drow = (n0 / 128) * 256 + (n0 % 128) + (kind == 1 ? 128 : 0);
        transpose_item(src, EH, k0, n0, (bf16*)(C.ws + WS_W13) + (size_t)e * 1024 * 1024 + (size_t)drow * 1024 + k0, 1024, scr, C.lane);
    } else {
        const float* src = P.in[I_W2] + ((size_t)layer * NEXP + e) * EH * D;
        const int kb = j / 32, nb = j % 32, k0 = kb * 64, n0 = nb * 32;
        transpose_item(src, D, k0, n0, (bf16*)(C.ws + WS_W2) + (size_t)e * 1024 * 512 + (size_t)n0 * 512 + k0, 512, scr, C.lane);
    }
}

__device__ __forceinline__ void phase_prologue(const Ctx& C) {
    const Params& P = *C.p;
    {
        LAS float* s = (LAS float*)C.lds;
        LAS float* red = (LAS float*)(C.lds + 17 * 1024 * 4);
        bool have_s = false;
        for (int u = blockIdx.x; u < 192; u += gridDim.x) {
            if (!have_s) {
                for (int i = C.tid; i < 17 * 1024; i += NTHR) { const int ci = i >> 10, k = i & 1023; const float v = ci < 16 ? P.in[I_C][ci * D + k] : P.in[I_CCTX][k]; s[i] = silu_(v); }
                have_s = true; __syncthreads();
            }
            const int layer = u / 96, jg = u % 96, kq = C.tid >> 6, jc = C.tid & 63;
            const float* w = P.in[I_WMOD] + (size_t)layer * D * 6144 + jg * 64 + jc;
            float acc[17];
#pragma unroll
            for (int i = 0; i < 17; ++i) acc[i] = 0.f;
            for (int k = kq * 128; k < kq * 128 + 128; ++k) { const float wv = w[(size_t)k * 6144];
#pragma unroll
                for (int i = 0; i < 17; ++i) acc[i] += s[i * 1024 + k] * wv; }
#pragma unroll
            for (int i = 0; i < 17; ++i) red[(kq * 17 + i) * 64 + jc] = acc[i];
            __syncthreads();
            for (int o = C.tid; o < 17 * 64; o += NTHR) { const int ci = o >> 6, c = o & 63; float v = 0.f;
#pragma unroll
                for (int q = 0; q < 8; ++q) v += red[(q * 17 + ci) * 64 + c];
                const int j = jg * 64 + c; v += P.in[I_BMOD][layer * 6144 + j];
                ((float*)(C.ws + WS_MOD))[((size_t)(layer * 17 + ci)) * 6144 + j] = v; }
            __syncthreads();
        }
        __syncthreads();
    }
    {
        const int gt = blockIdx.x * NTHR + C.tid, ngt = gridDim.x * NTHR;
        float2* rope = (float2*)(C.ws + WS_TAB + TAB_ROPE);
        for (int i = gt; i < 64 * 16; i += ngt) { const int pos = i >> 4, f = i & 15;
            const double th = exp(-(double)f * (9.210340371976184 / 16.0)); double s, c; dsincos((double)pos * th, s, c); rope[i] = make_float2((float)c, (float)s); }
        float2* lamb = (float2*)(C.ws + WS_TAB + TAB_LAMB); float2* bbar = (float2*)(C.ws + WS_TAB + TAB_BBAR);
        for (int i = gt; i < 2 * 32 * 64; i += ngt) {
            const int dg = i >> 6;
            const double are = P.in[I_ARE][i], aim = P.in[I_AIM][i], dt = exp((double)P.in[I_LOGDT][dg]);
            double s, c; dsincos(aim * dt, s, c); const double mag = exp(are * dt), lr = mag * c, li = mag * s;
            lamb[i] = make_float2((float)lr, (float)li);
            const double den = are * are + aim * aim, nr = lr - 1.0, ni = li;
            const double cr = (nr * are + ni * aim) / den, cim = (ni * are - nr * aim) / den;
            for (int p = 0; p < 16; ++p) { const double br = P.in[I_BRE][(size_t)i * 16 + p], bi = P.in[I_BIM][(size_t)i * 16 + p];
                bbar[(size_t)i * 16 + p] = make_float2((float)(cr * br - cim * bi), (float)(cr * bi + cim * br)); }
        }
    }
    {
        LAS float* scr = (LAS float*)(C.lds + C.wave * 16384);
        constexpr int I0 = 16 * 56, I1 = 16 * 32, I2 = 16 * 16, I3 = 8 * 16, I4 = 8 * 32;
        constexpr int NSMALL = I0 + I1 + I2 + I3 + I4;
        for (int it = C.gw; it < NSMALL + MOE_ITEMS; it += C.ngw) {
            int r = it;
            if (r < I0) { transpose_mat_item(P.in[I_MIXWIN], D, MIXW, (bf16*)(C.ws + WS_WIN0), r, scr, C.lane); continue; } r -= I0;
            if (r < I1) { transpose_mat_item(P.in[I_MIXWOUT], D, D, (bf16*)(C.ws + WS_WOUT0), r, scr, C.lane); continue; } r -= I1;
            if (r < I2) { transpose_mat_item(P.in[I_S5WIN], D, 512, (bf16*)(C.ws + WS_WS5IN), r, scr, C.lane); continue; } r -= I2;
            if (r < I3) { transpose_mat_item(P.in[I_WGLU], 512, 512, (bf16*)(C.ws + WS_WGLU), r, scr, C.lane); continue; } r -= I3;
            if (r < I4) { transpose_mat_item(P.in[I_S5WOUT], 512, D, (bf16*)(C.ws + WS_WS5OUT), r, scr, C.lane); continue; } r -= I4;
            moe_convert_item(C, 0, r, scr);
        }
    }
}

__device__ __forceinline__ void load_row16(const float* row, int lane, f32x4 (&v)[4]) {
#pragma unroll
    for (int j = 0; j < 4; ++j) v[j] = *(const f32x4*)(row + 4 * lane + 256 * j);
}
__device__ __forceinline__ float row_rstd(const f32x4 (&v)[4]) {
    float s = 0.f;
#pragma unroll
    for (int j = 0; j < 4; ++j) s += (v[j].x * v[j].x + v[j].y * v[j].y) + (v[j].z * v[j].z + v[j].w * v[j].w);
    return rsqrtf(wave_sum(s) * (1.f / D) + EPS);
}
__device__ __forceinline__ void modulate16(f32x4 (&v)[4], float rstd, const float* g, const float* scale, const float* shift, int lane) {
#pragma unroll
    for (int j = 0; j < 4; ++j) { const int c = 4 * lane + 256 * j; const f32x4 gg = *(const f32x4*)(g + c), sc = *(const f32x4*)(scale + c), sh = *(const f32x4*)(shift + c);
        v[j] = v[j] * rstd * gg * (sc + 1.f) + sh; }
}
__device__ __forceinline__ void store_row16_bf16(bf16* row, int lane, const f32x4 (&v)[4]) {
#pragma unroll
    for (int j = 0; j < 4; ++j) { v2u o; o.x = pk2(v[j].x, v[j].y); o.y = pk2(v[j].z, v[j].w); *(v2u*)(row + 4 * lane + 256 * j) = o; }
}

__device__ __forceinline__ void phase_norm_mix0(const Ctx& C) {
    const Params& P = *C.p; bf16* H = (bf16*)(C.ws + WS_H);
    for (int r = C.gw; r < TT; r += C.ngw) {
        f32x4 v[4]; load_row16(xin_row(P, r), C.lane, v);
        const float rstd = row_rstd(v); const int ci = cond_of(r);
        modulate16(v, rstd, P.in[I_GMIX], mod_vec(C, 0, ci, 1), mod_vec(C, 0, ci, 0), C.lane);
        store_row16_bf16(H + (size_t)r * D, C.lane, v);
    }
}

template <class Epi>
__device__ __forceinline__ void ngemm_unit(const Ctx& C, const bf16* A0, const bf16* B0, int K, int row0, int pn, const Epi& epi) {
    LAS float* As = (LAS float*)C.lds;
    LAS float* Bs = (LAS float*)(C.lds + 32 * 68 * 4);
    const int tid = C.tid, ty = tid >> 4, tx = tid & 15;
    float acc[2][16];
#pragma unroll
    for (int i = 0; i < 2; ++i)
#pragma unroll
        for (int j = 0; j < 16; ++j) acc[i][j] = 0.f;
    const int ar = tid >> 3, ak = (tid & 7) * 4, bn = tid >> 1, bk = (tid & 1) * 16;
    for (int k0 = 0; k0 < K; k0 += 32) {
        const v2u av = *(const v2u*)(A0 + (size_t)ar * K + k0 + ak);
        const v4u b0 = *(const v4u*)(B0 + (size_t)bn * K + k0 + bk), b1 = *(const v4u*)(B0 + (size_t)bn * K + k0 + bk + 8);
        __syncthreads();
        As[(ak + 0) * 68 + ar] = bf2f(av.x & 0xffffu); As[(ak + 1) * 68 + ar] = bf2f(av.x >> 16); As[(ak + 2) * 68 + ar] = bf2f(av.y & 0xffffu); As[(ak + 3) * 68 + ar] = bf2f(av.y >> 16);
        float bf[16]; unpack8(b0, bf); unpack8(b1, bf + 8);
#pragma unroll
        for (int i = 0; i < 16; ++i) Bs[(bk + i) * 260 + bn] = bf[i];
        __syncthreads();
#pragma unroll 4
        for (int k = 0; k < 32; ++k) {
            const float a0 = As[k * 68 + ty * 2], a1 = As[k * 68 + ty * 2 + 1];
            const f32x4 x0 = *(const LAS f32x4*)(Bs + k * 260 + tx * 8), x1 = *(const LAS f32x4*)(Bs + k * 260 + tx * 8 + 4);
            const f32x4 y0 = *(const LAS f32x4*)(Bs + k * 260 + 128 + tx * 8), y1 = *(const LAS f32x4*)(Bs + k * 260 + 128 + tx * 8 + 4);
            const float bb[16] = {x0.x, x0.y, x0.z, x0.w, x1.x, x1.y, x1.z, x1.w, y0.x, y0.y, y0.z, y0.w, y1.x, y1.y, y1.z, y1.w};
#pragma unroll
            for (int j = 0; j < 16; ++j) { acc[0][j] += a0 * bb[j]; acc[1][j] += a1 * bb[j]; }
        }
    }
#pragma unroll
    for (int i = 0; i < 2; ++i)
#pragma unroll
        for (int j = 0; j < 8; ++j) epi(row0 + ty * 2 + i, pn, tx * 8 + j, acc[i][j], acc[i][8 + j]);
    __syncthreads();
}
template <class Epi>
__device__ __forceinline__ void ngemm_dense(const Ctx& C, const bf16* A, const bf16* Bt, int M, int N, int K, const Epi& epi) {
    const int nN = N / 256, nU = (M / 64) * nN;
    for (int u = blockIdx.x; u < nU; u += gridDim.x) { const int tm = u / nN, pn = u % nN;
        ngemm_unit(C, A + (size_t)tm * 64 * K, Bt + (size_t)pn * 256 * K, K, tm * 64, pn, epi); }
}
template <class Epi>
__device__ __forceinline__ void ngemm_grouped(const Ctx& C, const bf16* A, const bf16* Bt, size_t estride, int N, int K, const Epi& epi) {
    const int* tile_e = (const int*)(C.ws + WS_ROUTE + RT_TILE); const int ntiles = *(const int*)(C.ws + WS_ROUTE + RT_NT);
    const int nN = N / 256, nU = ntiles * 4 * nN;
    for (int u = blockIdx.x; u < nU; u += gridDim.x) { const int pn = u % nN, tm = u / nN, e = tile_e[tm >> 2];
        ngemm_unit(C, A + (size_t)tm * 64 * K, Bt + (size_t)e * estride + (size_t)pn * 256 * K, K, tm * 64, pn, epi); }
}

struct EpiStoreBf16 { bf16* O; int ldc;
    __device__ __forceinline__ void operator()(int r, int pn, int c, float v0, float v1) const { bf16* o = O + (size_t)r * ldc + pn * 256 + c; o[0] = (bf16)f2bf(v0); o[128] = (bf16)f2bf(v1); } };
struct EpiResid0 { const Params* P; const float* mod; float* XC;
    __device__ __forceinline__ void operator()(int r, int pn, int c, float v0, float v1) const { const int n = pn * 256 + c; const float* xi = xin_row(*P, r); const float* g = mod + ((size_t)cond_of(r) * 6 + 2) * D;
        float* o = XC + (size_t)r * D; o[n] = xi[n] + g[n] * v0; o[n + 128] = xi[n + 128] + g[n + 128] * v1; } };
struct EpiResidAcc { const float* mod; float* XC;
    __device__ __forceinline__ void operator()(int r, int pn, int c, float v0, float v1) const { const int n = pn * 256 + c; const float* g = mod + ((size_t)cond_of(r) * 6 + 2) * D;
        float* o = XC + (size_t)r * D; o[n] += g[n] * v0; o[n + 128] += g[n + 128] * v1; } };
struct EpiSwiglu { bf16* G;
    __device__ __forceinline__ void operator()(int r, int pn, int c, float v0, float v1) const { G[(size_t)r * EH + pn * 128 + c] = (bf16)f2bf(silu_(v0) * v1); } };
struct EpiGlu { const bf16* GS; const float* b; bf16* GG;
    __device__ __forceinline__ void operator()(int r, int pn, int c, float v0, float v1) const { const int n = pn * 256 + c; const size_t o = (size_t)r * 512 + n;
        GG[o] = (bf16)f2bf(bf2f(GS[o]) * sigmoidf_(v0 + b[n])); GG[o + 128] = (bf16)f2bf(bf2f(GS[o + 128]) * sigmoidf_(v1 + b[n + 128])); } };

__device__ __forceinline__ void qk_norm_rope(float (&v)[8], const float* gain, bool lat, int t, int lane, const float2* rope) {
    float ss = 0.f;
#pragma unroll
    for (int j = 0; j < 8; ++j) ss += v[j] * v[j];
    ss += __shfl_xor(ss, 1); ss += __shfl_xor(ss, 2); ss += __shfl_xor(ss, 4);
    const float rstd = rsqrtf(ss * (1.f / 64.f) + EPS);
    const int l8 = lane & 7;
#pragma unroll
    for (int j = 0; j < 8; ++j) v[j] = v[j] * rstd * gain[l8 * 8 + j];
    const int quarter = l8 >> 1, pos = (quarter < 2) ? (t >> 6) : (t & 63);
#pragma unroll
    for (int j = 0; j < 8; ++j) {
        const float pv = __shfl_xor(v[j], 2);
        if (lat) { const float2 cs = rope[pos * 16 + (lane & 1) * 8 + j];
            v[j] = (quarter & 1) ? (v[j] * cs.x + pv * cs.y) : (v[j] * cs.x - pv * cs.y); }
    }
}
__device__ __forceinline__ void phase_qkprep(const Ctx& C) {
    const Params& P = *C.p; const bf16* Pb = (const bf16*)(C.ws + WS_P); bf16* Q = (bf16*)(C.ws + WS_Q); bf16* Kb = (bf16*)(C.ws + WS_K); bf16* Vb = (bf16*)(C.ws + WS_V);
    const float2* rope = (const float2*)(C.ws + WS_TAB + TAB_ROPE);
    for (int r = C.gw; r < TT; r += C.ngw) {
        const bool lat = r < TL; const int t = lat ? (r & 2047) : 0;
        const size_t kvrow = lat ? (size_t)(r >> 11) * KVL + CTXL + (r & 2047) : (size_t)((r - TL) >> 8) * KVL + ((r - TL) & 255);
        const bf16* pr = Pb + (size_t)r * MIXW;
        { float v[8]; unpack8(*(const v4u*)(pr + 8 * C.lane), v); qk_norm_rope(v, P.in[I_QG], lat, t, C.lane, rope);
          v4u o; o.x = pk2(v[0] * QSCALE, v[1] * QSCALE); o.y = pk2(v[2] * QSCALE, v[3] * QSCALE); o.z = pk2(v[4] * QSCALE, v[5] * QSCALE); o.w = pk2(v[6] * QSCALE, v[7] * QSCALE);
          *(v4u*)(Q + (size_t)r * 512 + 8 * C.lane) = o; }
        { const int l = C.lane & 15; float v[8]; unpack8(*(const v4u*)(pr + 512 + 8 * l), v); qk_norm_rope(v, P.in[I_KG], lat, t, C.lane, rope);
          if (C.lane < 16) { v4u o; o.x = pk2(v[0], v[1]); o.y = pk2(v[2], v[3]); o.z = pk2(v[4], v[5]); o.w = pk2(v[6], v[7]); *(v4u*)(Kb + kvrow * 128 + 8 * l) = o;
              *(v4u*)(Vb + kvrow * 128 + 8 * l) = *(const v4u*)(pr + 640 + 8 * l); } }
    }
}

__device__ __forceinline__ void phase_gmlp(const Ctx& C) {
    const Params& P = *C.p; const bf16* Pb = (const bf16*)(C.ws + WS_P); bf16* OG = (bf16*)(C.ws + WS_H);
    LAS bf16* VN = (LAS bf16*)C.lds; constexpr int VP = 520;
    const int g = __builtin_amdgcn_readfirstlane(C.tid >> 6);
    for (int ch = blockIdx.x; ch < TT / 128; ch += gridDim.x) {
        for (int i = 0; i < 16; ++i) { const int rl = C.wave * 16 + i; const bf16* pr = Pb + (size_t)(ch * 128 + rl) * MIXW + 1280 + 8 * C.lane;
            float v[8]; unpack8(*(const v4u*)pr, v); float s = 0.f;
#pragma unroll
            for (int j = 0; j < 8; ++j) { v[j] = gelu_tanh(v[j]); s += v[j]; }
            const float mean = wave_sum(s) * (1.f / 512.f); float q = 0.f;
#pragma unroll
            for (int j = 0; j < 8; ++j) { v[j] -= mean; q += v[j] * v[j]; }
            const float rstd = rsqrtf(wave_sum(q) * (1.f / 512.f) + EPS);
#pragma unroll
            for (int j = 0; j < 8; ++j) v[j] = v[j] * rstd * P.in[I_LNG][8 * C.lane + j];
            v4u o; o.x = pk2(v[0], v[1]); o.y = pk2(v[2], v[3]); o.z = pk2(v[4], v[5]); o.w = pk2(v[6], v[7]);
            *(LAS v4u*)(VN + rl * VP + 8 * C.lane) = o; }
        __syncthreads();
        const float* wsp = P.in[I_WSP] + (size_t)g * 128 * 128; const float* bsp = P.in[I_BSP] + g * 128;
        for (int pb = 0; pb < 16; ++pb) {
            float acc[8];
#pragma unroll
            for (int i = 0; i < 8; ++i) acc[i] = 0.f;
            for (int q = 0; q < 128; ++q) { const float v = bf2f(VN[q * VP + C.tid]);
#pragma unroll
                for (int i = 0; i < 8; ++i) acc[i] += wsp[(pb * 8 + i) * 128 + q] * v; }
#pragma unroll
            for (int i = 0; i < 8; ++i) { const int p = pb * 8 + i; const size_t row = (size_t)ch * 128 + p;
                const float u = gelu_tanh(bf2f(Pb[row * MIXW + 768 + C.tid]));
                OG[row * D + 512 + C.tid] = (bf16)f2bf(u * (acc[i] + bsp[p])); }
        }
        __syncthreads();
    }
}

__device__ __forceinline__ void attn_item(const Ctx& C, int b, int h, int qrow_g, int nk) {
    const bf16* Q = (const bf16*)(C.ws + WS_Q); const bf16* Kb = (const bf16*)(C.ws + WS_K) + (size_t)b * KVL * 128 + (h >> 2) * 64; const bf16* Vb = (const bf16*)(C.ws + WS_V) + (size_t)b * KVL * 128 + (h >> 2) * 64;
    bf16* OG = (bf16*)(C.ws + WS_H);
    float q[64];
#pragma unroll
    for (int i = 0; i < 8; ++i) unpack8(*(const v4u*)(Q + (size_t)qrow_g * 512 + h * 64 + 8 * i), q + 8 * i);
    float m = -INFINITY, l = 0.f, o = 0.f;
    for (int kt = 0; kt < nk; kt += 64) {
        const bf16* kr = Kb + (size_t)(kt + C.lane) * 128; float s = 0.f;
#pragma unroll
        for (int i = 0; i < 8; ++i) { float kf[8]; unpack8(*(const v4u*)(kr + 8 * i), kf);
#pragma unroll
            for (int j = 0; j < 8; ++j) s += q[8 * i + j] * kf[j]; }
        const float mn = fmaxf(m, wave_max(s)); const float p = exp2f(s - mn), corr = exp2f(m - mn);
        l = l * corr + wave_sum(p); o *= corr; m = mn;
#pragma unroll 8
        for (int jj = 0; jj < 64; ++jj) { const float pj = __shfl(p, jj); o += pj * bf2f(Vb[(size_t)(kt + jj) * 128 + C.lane]); }
    }
    OG[(size_t)qrow_g * D + h * 64 + C.lane] = (bf16)f2bf(o / l);
}
__device__ __forceinline__ void phase_attn(const Ctx& C) {
    for (int it = C.gw; it < NB * 8 * SEQ; it += C.ngw) { const int bh = it >> 11, t = it & 2047, b = bh >> 3, h = bh & 7; attn_item(C, b, h, b * SEQ + t, KVL); }
    for (int it = C.gw; it < NB * 8 * CTXL; it += C.ngw) { const int bh = it >> 8, t = it & 255, b = bh >> 3, h = bh & 7; attn_item(C, b, h, TL + b * CTXL + t, CTXL); }
}

__device__ __forceinline__ void phase_norm_ffn_router(const Ctx& C, int layer, int nrows) {
    const Params& P = *C.p; const float* XC = (const float*)(C.ws + WS_XC); bf16* F = (bf16*)(C.ws + WS_H);
    int* asg_e = (int*)(C.ws + WS_ROUTE + RT_E); int* asg_p = (int*)(C.ws + WS_ROUTE + RT_P); float* asg_w = (float*)(C.ws + WS_ROUTE + RT_W);
    unsigned* cnt = (unsigned*)(C.ws + WS_CTL) + CW_CNT + 64 * layer;
    const float* wg = P.in[I_WGRP] + (size_t)layer * D * 4; const float* wr = P.in[I_WRT] + (size_t)layer * D * 32;
    for (int r = C.gw; r < nrows; r += C.ngw) {
        f32x4 v[4]; load_row16(XC + (size_t)r * D, C.lane, v);
        const float rstd = row_rstd(v); const int ci = cond_of(r);
        modulate16(v, rstd, P.in[I_GFFN] + layer * D, mod_vec(C, layer, ci, 4), mod_vec(C, layer, ci, 3), C.lane);
        store_row16_bf16(F + (size_t)r * D, C.lane, v);
        float lg[4] = {0.f, 0.f, 0.f, 0.f}; float le[32];
#pragma unroll
        for (int i = 0; i < 32; ++i) le[i] = 0.f;
#pragma unroll
        for (int j = 0; j < 4; ++j)
#pragma unroll
            for (int i = 0; i < 4; ++i) { const int c = 4 * C.lane + 256 * j + i; const float f = v[j][i];
                const f32x4 g4 = *(const f32x4*)(wg + (size_t)c * 4); lg[0] += f * g4.x; lg[1] += f * g4.y; lg[2] += f * g4.z; lg[3] += f * g4.w;
#pragma unroll
                for (int e4 = 0; e4 < 8; ++e4) { const f32x4 w4 = *(const f32x4*)(wr + (size_t)c * 32 + e4 * 4); le[e4 * 4] += f * w4.x; le[e4 * 4 + 1] += f * w4.y; le[e4 * 4 + 2] += f * w4.z; le[e4 * 4 + 3] += f * w4.w; } }
#pragma unroll
        for (int i = 0; i < 4; ++i) lg[i] = wave_sum(lg[i]) + P.in[I_BGRP][layer * 4 + i];
#pragma unroll
        for (int i = 0; i < 32; ++i) le[i] = wave_sum(le[i]) + P.in[I_BRT][layer * 32 + i];
        int gi = 0; float gm = lg[0];
#pragma unroll
        for (int i = 1; i < 4; ++i) if (lg[i] > gm) { gm = lg[i]; gi = i; }
        float den = 0.f;
#pragma unroll
        for (int i = 0; i < 4; ++i) den += __expf(lg[i] - gm);
        const float gw_ = 1.f / den;
        float sel[8];
#pragma unroll
        for (int i = 0; i < 8; ++i) sel[i] = gi == 0 ? le[i] : gi == 1 ? le[8 + i] : gi == 2 ? le[16 + i] : le[24 + i];
        int i0 = 0; float v0 = sel[0];
#pragma unroll
        for (int i = 1; i < 8; ++i) if (sel[i] > v0) { v0 = sel[i]; i0 = i; }
        int i1 = -1; float v1 = -INFINITY;
#pragma unroll
        for (int i = 0; i < 8; ++i) if (i != i0 && sel[i] > v1) { v1 = sel[i]; i1 = i; }
        const float e1 = __expf(v1 - v0), w0 = gw_ / (1.f + e1), w1 = gw_ * e1 / (1.f + e1);
        if (C.lane == 0) {
            const int ea = gi * 8 + i0, eb = gi * 8 + i1;
            const unsigned pa = __hip_atomic_fetch_add(cnt + ea, 1u, __ATOMIC_RELAXED, __HIP_MEMORY_SCOPE_AGENT);
            const unsigned pb = __hip_atomic_fetch_add(cnt + eb, 1u, __ATOMIC_RELAXED, __HIP_MEMORY_SCOPE_AGENT);
            asg_e[2 * r] = ea; asg_e[2 * r + 1] = eb; asg_p[2 * r] = (int)pa; asg_p[2 * r + 1] = (int)pb; asg_w[2 * r] = w0; asg_w[2 * r + 1] = w1;
        }
    }
}
__device__ __forceinline__ void phase_gather(const Ctx& C, int layer, int nrows) {
    const bf16* F = (const bf16*)(C.ws + WS_H); bf16* XS = (bf16*)(C.ws + WS_XS);
    const int* asg_e = (const int*)(C.ws + WS_ROUTE + RT_E); const int* asg_p = (const int*)(C.ws + WS_ROUTE + RT_P); int* asg_s = (int*)(C.ws + WS_ROUTE + RT_S);
    int* tile_e = (int*)(C.ws + WS_ROUTE + RT_TILE); int* ntl = (int*)(C.ws + WS_ROUTE + RT_NT);
    unsigned* cnt = (unsigned*)(C.ws + WS_CTL) + CW_CNT + 64 * layer;
    const int mycnt = (C.lane < 32) ? (int)__hip_atomic_load(cnt + C.lane, __ATOMIC_RELAXED, __HIP_MEMORY_SCOPE_AGENT) : 0;
    const int mypad = (mycnt + 255) & ~255;
    int incl = mypad;
#pragma unroll
    for (int o = 1; o < 32; o <<= 1) { const int t = __shfl_up(incl, o); if ((C.lane & 31) >= o) incl += t; }
    const int ps = incl - mypad;
    for (int it = C.gw; it < nrows * 2; it += C.ngw) {
        const int e = asg_e[it], p = asg_p[it]; const int slot = __shfl(ps, e) + p;
        if (C.lane == 0) asg_s[it] = slot;
        const v4u* src = (const v4u*)(F + (size_t)(it >> 1) * D); v4u* dst = (v4u*)(XS + (size_t)slot * D);
        dst[C.lane] = src[C.lane]; dst[64 + C.lane] = src[64 + C.lane];
    }
    for (int e = C.gw; e < 33; e += C.ngw) {
        if (e < 32) { const int c0 = __shfl(mycnt, e), c1 = __shfl(mypad, e), base = __shfl(ps, e);
            for (int rr = c0; rr < c1; ++rr) { v4u* dst = (v4u*)(XS + (size_t)(base + rr) * D); const v4u z = {0u, 0u, 0u, 0u}; dst[C.lane] = z; dst[64 + C.lane] = z; } }
        else { if (C.lane < 32) { for (int t = ps / 256; t < (ps + mypad) / 256; ++t) tile_e[t] = C.lane; if (C.lane == 31) *ntl = (ps + mypad) / 256; } }
    }
}
__device__ __forceinline__ void moe_combine(const Ctx& C, int layer, int r, f32x4 (&v)[4]) {
    const bf16* Y2 = (const bf16*)(C.ws + WS_XS); const int* asg_s = (const int*)(C.ws + WS_ROUTE + RT_S); const float* asg_w = (const float*)(C.ws + WS_ROUTE + RT_W);
    const float* XC = (const float*)(C.ws + WS_XC);
    load_row16(XC + (size_t)r * D, C.lane, v);
    const int s0 = asg_s[2 * r], s1 = asg_s[2 * r + 1]; const float w0 = asg_w[2 * r], w1 = asg_w[2 * r + 1];
    const float* gate = mod_vec(C, layer, cond_of(r), 5);
#pragma unroll
    for (int j = 0; j < 4; ++j) { const int c = 4 * C.lane + 256 * j; const v2u a = *(const v2u*)(Y2 + (size_t)s0 * D + c), b = *(const v2u*)(Y2 + (size_t)s1 * D + c); const f32x4 g = *(const f32x4*)(gate + c);
        v[j].x += g.x * (w0 * bf2f(a.x & 0xffffu) + w1 * bf2f(b.x & 0xffffu)); v[j].y += g.y * (w0 * bf2f(a.x >> 16) + w1 * bf2f(b.x >> 16));
        v[j].z += g.z * (w0 * bf2f(a.y & 0xffffu) + w1 * bf2f(b.y & 0xffffu)); v[j].w += g.w * (w0 * bf2f(a.y >> 16) + w1 * bf2f(b.y >> 16)); }
}
__device__ __forceinline__ void phase_combine_norm_mix1(const Ctx& C) {
    const Params& P = *C.p; float* XC = (float*)(C.ws + WS_XC); bf16* H = (bf16*)(C.ws + WS_H);
    for (int r = C.gw; r < TT; r += C.ngw) {
        f32x4 v[4]; moe_combine(C, 0, r, v);
#pragma unroll
        for (int j = 0; j < 4; ++j) *(f32x4*)(XC + (size_t)r * D + 4 * C.lane + 256 * j) = v[j];
        const float rstd = row_rstd(v); const int ci = cond_of(r);
        modulate16(v, rstd, P.in[I_GMIX] + D, mod_vec(C, 1, ci, 1), mod_vec(C, 1, ci, 0), C.lane);
        store_row16_bf16(H + (size_t)r * D, C.lane, v);
    }
    LAS float* scr = (LAS float*)(C.lds + C.wave * 16384);
    for (int it = C.gw; it < MOE_ITEMS; it += C.ngw) moe_convert_item(C, 1, it, scr);
}
__device__ __forceinline__ void phase_final(const Ctx& C) {
    const Params& P = *C.p;
    for (int r = C.gw; r < TL; r += C.ngw) {
        f32x4 v[4]; moe_combine(C, 1, r, v);
        const float rstd = row_rstd(v);
#pragma unroll
        for (int j = 0; j < 4; ++j) { const int c = 4 * C.lane + 256 * j; const f32x4 g = *(const f32x4*)(P.in[I_FING] + c); *(f32x4*)(P.out + (size_t)r * D + c) = v[j] * rstd * g; }
    }
}

__device__ __forceinline__ void phase_s5(const Ctx& C) {
    const Params& P = *C.p; const bf16* U = (const bf16*)(C.ws + WS_U); bf16* GS = (bf16*)(C.ws + WS_GS); float* YA = (float*)(C.ws + WS_YACC);
    const float2* lamb = (const float2*)(C.ws + WS_TAB + TAB_LAMB); const float2* bbar = (const float2*)(C.ws + WS_TAB + TAB_BBAR);
    LAS f32x2* hb = (LAS f32x2*)(C.lds + C.wave * 8192);
    const int lane = C.lane;
    for (int it = C.gw; it < NB * 32; it += C.ngw) {
        const int b = it >> 5, g = it & 31;
        for (int dir = 0; dir < 2; ++dir) {
            const int dgn = ((dir * 32 + g) * 64 + lane);
            const float2 lam = lamb[dgn]; float2 bb[16];
#pragma unroll
            for (int p = 0; p < 16; ++p) bb[p] = bbar[(size_t)dgn * 16 + p];
            const float* cre = P.in[I_CRE] + (size_t)(dir * 32 + g) * 16 * 64; const float* cim = P.in[I_CIM] + (size_t)(dir * 32 + g) * 16 * 64;
            float hr = 0.f, hi = 0.f;
            for (int ck = 0; ck < 144; ++ck) {
                const bool isl = ck >= 16;
                const int tb = isl ? (dir == 0 ? (ck - 16) * 16 : (143 - ck) * 16) : (dir == 0 ? ck * 16 : (15 - ck) * 16);
                const size_t rowb = isl ? (size_t)b * SEQ + tb : (size_t)TL + (size_t)b * CTXL + tb;
                for (int sl = 0; sl < 16; ++sl) {
                    const int to = dir == 0 ? sl : 15 - sl;
                    const bf16* ur = U + (rowb + to) * 512 + g * 16; float uf[16]; unpack8(*(const v4u*)ur, uf); unpack8(*(const v4u*)(ur + 8), uf + 8);
                    float br = 0.f, bi = 0.f;
#pragma unroll
                    for (int p = 0; p < 16; ++p) { br += bb[p].x * uf[p]; bi += bb[p].y * uf[p]; }
                    const float nr = lam.x * hr - lam.y * hi + br, ni = lam.x * hi + lam.y * hr + bi; hr = nr; hi = ni;
                    if (isl) hb[to * 64 + lane] = (f32x2){hr, hi};
                }
                if (isl) {
                    asm volatile("s_waitcnt lgkmcnt(0)" ::: "memory");
                    const int p = lane & 15;
#pragma unroll
                    for (int i = 0; i < 4; ++i) { const int to = (lane >> 4) + 4 * i; float y = 0.f;
                        for (int n = 0; n < 64; ++n) { const f32x2 h = hb[to * 64 + n]; y += cre[p * 64 + n] * h.x - cim[p * 64 + n] * h.y; }
                        const size_t o = (rowb + to) * 512 + g * 16 + p;
                        if (dir == 0) YA[o] = y + P.in[I_S5D][g * 16 + p] * bf2f(U[o]);
                        else GS[o] = (bf16)f2bf(gelu_tanh(YA[o] + y)); }
                    asm volatile("s_waitcnt lgkmcnt(0)" ::: "memory");
                }
            }
        }
    }
}

__global__ void __launch_bounds__(NTHR, 2) fwd_kernel(Params prm) {
    extern __shared__ __attribute__((aligned(16))) unsigned char lds_raw[];
    Ctx C; C.p = &prm; C.ws = prm.ws; C.lds = (LAS unsigned char*)lds_raw;
    C.tid = threadIdx.x; C.lane = C.tid & 63; C.wave = __builtin_amdgcn_readfirstlane(C.tid >> 6);
    C.gw = blockIdx.x * NWAVE + C.wave; C.ngw = gridDim.x * NWAVE;
    constexpr int LDS_MISC = 147456 - 256;
    volatile LAS unsigned* misc = (volatile LAS unsigned*)(C.lds + LDS_MISC);
    if (C.tid < 64) misc[C.tid] = 0u;
    __syncthreads();
    unsigned* ctl = (unsigned*)(C.ws + WS_CTL);
    XcdBarrier bar; bar.bar = ctl + CW_BAR; bar.x = 0; bar.st = nullptr;
#if MK_ONE_LAUNCH
    bar = xcd_barrier_post(ctl + CW_BAR, misc + 8);
#define SEAM(k) do { if (lo <= (k) && (k) + 1 < hi) xcd_barrier(bar); } while (0)
#else
#define SEAM(k) do { } while (0)
#endif
    const int lo = prm.ph_lo, hi = prm.ph_hi;
#define IN(k) (lo <= (k) && (k) < hi)
    const Params& P = prm;
    bf16* Hb = (bf16*)(C.ws + WS_H); float* XC = (float*)(C.ws + WS_XC);
    if (IN(0)) { phase_prologue(C); SEAM(0); }
    if (IN(1)) { phase_norm_mix0(C); SEAM(1); }
    if (IN(2)) { EpiStoreBf16 E{(bf16*)(C.ws + WS_P), MIXW}; ngemm_dense(C, Hb, (const bf16*)(C.ws + WS_WIN0), TT, MIXW, D, E); SEAM(2); }
    if (IN(3)) { phase_qkprep(C); phase_gmlp(C); SEAM(3); }
    if (IN(4)) { phase_attn(C); SEAM(4); }
    if (IN(5)) { EpiResid0 E{&P, (const float*)(C.ws + WS_MOD), XC}; ngemm_dense(C, Hb, (const bf16*)(C.ws + WS_WOUT0), TT, D, D, E); SEAM(5); }
    if (IN(6)) { phase_norm_ffn_router(C, 0, TT); SEAM(6); }
    if (IN(7)) { phase_gather(C, 0, TT); SEAM(7); }
    if (IN(8)) { EpiSwiglu E{(bf16*)(C.ws + WS_G13)}; ngemm_grouped(C, (const bf16*)(C.ws + WS_XS), (const bf16*)(C.ws + WS_W13), (size_t)1024 * 1024, 1024, D, E); SEAM(8); }
    if (IN(9)) { EpiStoreBf16 E{(bf16*)(C.ws + WS_XS), D}; ngemm_grouped(C, (const bf16*)(C.ws + WS_G13), (const bf16*)(C.ws + WS_W2), (size_t)1024 * 512, 1024, EH, E); SEAM(9); }
    if (IN(10)) { phase_combine_norm_mix1(C); SEAM(10); }
    if (IN(11)) { EpiStoreBf16 E{(bf16*)(C.ws + WS_U), 512}; ngemm_dense(C, Hb, (const bf16*)(C.ws + WS_WS5IN), TT, 512, D, E); SEAM(11); }
    if (IN(12)) { phase_s5(C); SEAM(12); }
    if (IN(13)) { EpiGlu E{(const bf16*)(C.ws + WS_GS), P.in[I_BGLU], (bf16*)(C.ws + WS_GG)}; ngemm_dense(C, (const bf16*)(C.ws + WS_GS), (const bf16*)(C.ws + WS_WGLU), TL, 512, 512, E); SEAM(13); }
    if (IN(14)) { EpiResidAcc E{(const float*)(C.ws + WS_MOD) + (size_t)17 * 6 * D, XC}; ngemm_dense(C, (const bf16*)(C.ws + WS_GG), (const bf16*)(C.ws + WS_WS5OUT), TL, D, 512, E); SEAM(14); }
    if (IN(15)) { phase_norm_ffn_router(C, 1, TL); SEAM(15); }
    if (IN(16)) { phase_gather(C, 1, TL); SEAM(16); }
    if (IN(17)) { EpiSwiglu E{(bf16*)(C.ws + WS_G13)}; ngemm_grouped(C, (const bf16*)(C.ws + WS_XS), (const bf16*)(C.ws + WS_W13), (size_t)1024 * 1024, 1024, D, E); SEAM(17); }
    if (IN(18)) { EpiStoreBf16 E{(bf16*)(C.ws + WS_XS), D}; ngemm_grouped(C, (const bf16*)(C.ws + WS_G13), (const bf16*)(C.ws + WS_W2), (size_t)1024 * 512, 1024, EH, E); SEAM(18); }
    if (IN(19)) { phase_final(C); }
#undef IN
#undef SEAM
}

extern "C" void kernel_launch(void* const* d_in, const int* in_sizes, int n_in, void* d_out, int out_size, void* d_ws, size_t ws_size, hipStream_t stream) {
    constexpr int LDS_BYTES = 147456;
    static int grid = 0;
    if (grid == 0) {
        if (n_in != 35 || out_size != TL * D || ws_size < WS_END) { fprintf(stderr, "kernel_launch: unexpected shapes (n_in %d out %d ws %zu)\n", n_in, out_size, ws_size); grid = -1; return; }
        int dev = 0, cus = 0;
        if (hipGetDevice(&dev) != hipSuccess || hipDeviceGetAttribute(&cus, hipDeviceAttributeMultiprocessorCount, dev) != hipSuccess) { grid = -1; return; }
        if (hipFuncSetAttribute((const void*)fwd_kernel, hipFuncAttributeMaxDynamicSharedMemorySize, LDS_BYTES) != hipSuccess) { fprintf(stderr, "kernel_launch: hipFuncSetAttribute failed\n"); grid = -1; return; }
        (void)hipGetLastError();
        grid = cus;
    }
    if (grid < 0) return;
    (void)hipMemsetAsync((char*)d_ws + WS_CTL, 0, CTL_BYTES, stream);
    Params p{};
    for (int i = 0; i < 35; ++i) p.in[i] = (const float*)d_in[i];
    p.out = (float*)d_out; p.ws = (unsigned char*)d_ws;
#if MK_ONE_LAUNCH
    p.ph_lo = 0; p.ph_hi = NPHASE;
    hipLaunchKernelGGL(fwd_kernel, dim3(grid), dim3(NTHR), LDS_BYTES, stream, p);
#else
    for (int k = 0; k < NPHASE; ++k) { p.ph_lo = k; p.ph_hi = k + 1; hipLaunchKernelGGL(fwd_kernel, dim3(grid), dim3(NTHR), LDS_BYTES, stream, p); }
#endif
}
```

```cpp
#include <hip/hip_runtime.h>
#include <cstdio>
#include <cstdint>

#ifndef MK_ONE_LAUNCH
#define MK_ONE_LAUNCH 1
#endif

constexpr int D = 1024, NB = 16, SEQ = 2048, CTXL = 256;
constexpr int TL = NB * SEQ, TC = NB * CTXL, TT = TL + TC;
constexpr int KVL = CTXL + SEQ;
constexpr int MIXW = 1792, NEXP = 32, EH = 512;
constexpr int NSLOT = 81920;
constexpr float EPS = 1e-6f;
constexpr float QSCALE = 0.125f * 1.4426950408889634f;
constexpr int NTHR = 512, NWAVE = 8;
constexpr int NPHASE = 20;

constexpr size_t MiB = 1u << 20;
constexpr size_t WS_CTL = 0, CTL_BYTES = 1 * MiB;
constexpr size_t WS_MOD = 1 * MiB;
constexpr size_t WS_TAB = 2 * MiB;
constexpr size_t TAB_ROPE = 0, TAB_LAMB = 16384, TAB_BBAR = 65536;
constexpr size_t WS_ROUTE = 3 * MiB;
constexpr size_t RT_E = 0, RT_P = 320 * 1024, RT_W = 640 * 1024, RT_S = 960 * 1024, RT_TILE = 1280 * 1024, RT_NT = 1280 * 1024 + 4096;
constexpr size_t WS_WIN0 = 6 * MiB, WS_WOUT0 = 10 * MiB, WS_WS5IN = 12 * MiB, WS_WGLU = 13 * MiB, WS_WS5OUT = 14 * MiB;
constexpr size_t WS_W13 = 16 * MiB, WS_W2 = 80 * MiB;
constexpr size_t WS_XC = 112 * MiB;
constexpr size_t WS_H = 256 * MiB;
constexpr size_t WS_P = 328 * MiB;
constexpr size_t WS_Q = 454 * MiB, WS_K = 490 * MiB, WS_V = 499 * MiB;
constexpr size_t WS_XS = 328 * MiB;
constexpr size_t WS_G13 = 488 * MiB;
constexpr size_t WS_U = 328 * MiB, WS_GS = 364 * MiB, WS_GG = 396 * MiB, WS_YACC = 428 * MiB;
constexpr size_t WS_END = 568 * MiB;
constexpr int CW_CNT = 64;
constexpr int CW_BAR = 4096;

#define LAS __attribute__((address_space(3)))
typedef unsigned short bf16;
typedef unsigned v4u __attribute__((ext_vector_type(4)));
typedef unsigned v2u __attribute__((ext_vector_type(2)));
typedef float f32x4 __attribute__((ext_vector_type(4)));
typedef float f32x2 __attribute__((ext_vector_type(2)));
__device__ __forceinline__ float bf2f(unsigned u) { return __uint_as_float(u << 16); }
__device__ __forceinline__ unsigned f2bf(float f) { unsigned u = __float_as_uint(f); return (u + 0x7fffu + ((u >> 16) & 1u)) >> 16; }
__device__ __forceinline__ unsigned pk2(float lo, float hi) { return f2bf(lo) | (f2bf(hi) << 16); }
__device__ __forceinline__ float wave_sum(float v) {
#pragma unroll
    for (int o = 1; o < 64; o <<= 1) v += __shfl_xor(v, o);
    return v;
}
__device__ __forceinline__ float wave_max(float v) {
#pragma unroll
    for (int o = 1; o < 64; o <<= 1) v = fmaxf(v, __shfl_xor(v, o));
    return v;
}
__device__ __forceinline__ float gelu_tanh(float x) { const float u = 0.7978845608028654f * (x + 0.044715f * x * x * x); return 0.5f * x * (1.f + tanhf(u)); }
__device__ __forceinline__ float sigmoidf_(float x) { return 1.f / (1.f + __expf(-x)); }
__device__ __forceinline__ float silu_(float x) { return x / (1.f + __expf(-x)); }
__device__ __forceinline__ void unpack8(const v4u w, float* f) {
    f[0] = bf2f(w.x & 0xffffu); f[1] = bf2f(w.x >> 16); f[2] = bf2f(w.y & 0xffffu); f[3] = bf2f(w.y >> 16);
    f[4] = bf2f(w.z & 0xffffu); f[5] = bf2f(w.z >> 16); f[6] = bf2f(w.w & 0xffffu); f[7] = bf2f(w.w >> 16);
}

#define XB_TMO      128
#define XB_XCNT(j)  (256  + 64 * (j))
#define XB_XSUB(j)  (1280 + 64 * (j))
#define XB_XGEN(j)  (2304 + 64 * (j))
#define XB_TOP      3328
#define XB_TOPGEN   3392
#define XCD_BAR_WORDS 3456
#define XB_SPIN_CAP (1u << 28)
__device__ __forceinline__ unsigned xb_ld(unsigned* p)              { return __hip_atomic_load(p, __ATOMIC_RELAXED, __HIP_MEMORY_SCOPE_AGENT); }
__device__ __forceinline__ unsigned xb_add(unsigned* p, unsigned v) { return __hip_atomic_fetch_add(p, v, __ATOMIC_RELAXED, __HIP_MEMORY_SCOPE_AGENT); }
__device__ __forceinline__ unsigned xb_xcc_id() { return (unsigned)__builtin_amdgcn_s_getreg((3 << 11) | 20) & 0xFu; }
#define XB_SPIN(cond, bar) do { unsigned _sp = 0; while (cond) { __builtin_amdgcn_s_sleep(1); \
    if ((++_sp & 255u) == 0u) { if (xb_ld(&(bar)[XB_TMO])) break; if (_sp > XB_SPIN_CAP) { atomicAdd(&(bar)[XB_TMO], 1u); break; } } } } while (0)
struct XcdBarrier { unsigned* bar; unsigned x; volatile LAS unsigned* st; };
__device__ __forceinline__ XcdBarrier xcd_barrier_post(unsigned* bar, volatile LAS unsigned* st) {
    XcdBarrier b; b.bar = bar; b.x = xb_xcc_id(); b.st = st;
    if (threadIdx.x == 0) (void)xb_add(&bar[XB_XCNT(b.x)], 1u);
    return b;
}
__device__ __forceinline__ void xcd_barrier_complete(unsigned* bar, unsigned x, unsigned& nloc, unsigned& nx) {
    const unsigned G = gridDim.x * gridDim.y * gridDim.z;
    unsigned sum, cnt, mine, sp = 0u;
    for (;;) {
        sum = 0u; cnt = 0u; mine = 0u;
#pragma unroll
        for (unsigned j = 0; j < 16; ++j) { const unsigned c = xb_ld(&bar[XB_XCNT(j)]); sum += c; cnt += (c > 0u) ? 1u : 0u; mine = (j == x) ? c : mine; }
        if (sum == G) break;
        __builtin_amdgcn_s_sleep(1);
        if ((++sp & 255u) == 0u) { if (xb_ld(&bar[XB_TMO])) break; if (sp > XB_SPIN_CAP) { atomicAdd(&bar[XB_TMO], 1u); break; } }
    }
    nloc = mine > 0u ? mine : 1u; nx = cnt > 0u ? cnt : 1u;
}
__device__ __forceinline__ void xcd_barrier(const XcdBarrier& b) {
    asm volatile("s_waitcnt vmcnt(0)" ::: "memory");
    __syncthreads();
    if (threadIdx.x == 0) {
        unsigned* bar = b.bar;
        __builtin_amdgcn_s_waitcnt(0);
        unsigned nloc = b.st[0], nx = b.st[1];
        if (nloc == 0u) { xcd_barrier_complete(bar, b.x, nloc, nx); b.st[0] = nloc; b.st[1] = nx; }
        const unsigned old = xb_add(&bar[XB_XSUB(b.x)], 1u);
        const unsigned gen = old / nloc;
        if (old + 1u == (gen + 1u) * nloc) {
            __builtin_amdgcn_fence(__ATOMIC_RELEASE, "agent");
            asm volatile("s_waitcnt vmcnt(0)" ::: "memory");
            const unsigned og = xb_add(&bar[XB_TOP], 1u);
            const unsigned tg = og / nx;
            if (og + 1u == (tg + 1u) * nx) xb_add(&bar[XB_TOPGEN], 1u);
            else XB_SPIN(xb_ld(&bar[XB_TOPGEN]) == tg, bar);
            __builtin_amdgcn_fence(__ATOMIC_ACQUIRE, "agent");
            xb_add(&bar[XB_XGEN(b.x)], 1u);
            asm volatile("s_waitcnt vmcnt(0)" ::: "memory");
        } else {
            XB_SPIN(xb_ld(&bar[XB_XGEN(b.x)]) == gen, bar);
            __builtin_amdgcn_fence(__ATOMIC_ACQUIRE, "agent");
            asm volatile("s_waitcnt vmcnt(0)" ::: "memory");
        }
    }
    __syncthreads();
}

namespace pg8 {
#define PG8_LAS __attribute__((address_space(3)))
typedef unsigned short bf16_t;
typedef short bf16x8 __attribute__((ext_vector_type(8)));
typedef float f32x4 __attribute__((ext_vector_type(4)));
typedef unsigned u32x4 __attribute__((ext_vector_type(4)));
constexpr int BM = 256, BK = 64, HALF = 128, HTB = HALF * BK * 2  , STAGE_BYTES = 8 * HTB, NXCD = 8, WGM = 8;

__host__ __device__ __forceinline__ int lds_byte(int r, int c) { const int st = (r >> 4) * 2 + (c >> 5), rr = r & 15, cc = c & 31, ob = rr * 64 + cc * 2; return st * 1024 + (ob ^ (((ob >> 9) & 1) << 5)); }
__host__ __device__ __forceinline__ void stage_rc(int b, int& R, int& C) { const int st = b / 1024, sb = b % 1024, swz = sb ^ (((sb >> 9) & 1) << 5); R = (st >> 1) * 16 + swz / 64; C = (st & 1) * 32 + (swz % 64) / 2; }
__host__ __device__ __forceinline__ int perm32(int rho) { const int n = rho >> 4, i = rho & 15; return 8 * (i >> 2) + 4 * n + (i & 3); }

struct Unit { int pm, pn; size_t bo; };
struct Gemm { const bf16_t* A; const bf16_t* Bt; int M, N, K; };

struct StaticOrder {
    int nM, nN, nwg, G, c;
    __host__ __device__ void init(int M, int N, int G_, int c_) { nM = M / BM; nN = N / BM; nwg = nM * nN; G = G_; c = c_; }
    __host__ __device__ bool next(int i, Unit& u) const {
        const long L = (long)i * G + c; if (L >= nwg) return false;
        int wgid = (int)L; { const int q = nwg / NXCD, r = nwg % NXCD, xcd = wgid % NXCD, off = wgid / NXCD; wgid = (xcd < r ? xcd * (q + 1) : r * (q + 1) + (xcd - r) * q) + off; }
        const int nig = WGM * nN, gid = wgid / nig, fm = gid * WGM, gsz = (nM - fm) < WGM ? (nM - fm) : WGM;
        u.pm = fm + ((wgid % nig) % gsz); u.pn = (wgid % nig) / gsz; u.bo = 0; return true;
    }
    __device__ __forceinline__ void a_ready(const Unit&) const {}
    __device__ __forceinline__ void done(const Unit&) const {}
};

__device__ __forceinline__ unsigned cvt_pk_bf16(float lo, float hi) { unsigned r; asm volatile("v_cvt_pk_bf16_f32 %0, %1, %2" : "=v"(r) : "v"(lo), "v"(hi)); return r; }
typedef float f32x2 __attribute__((ext_vector_type(2)));
__device__ __forceinline__ f32x2 gelu_pk(f32x2 v) {
    const f32x2 av = __builtin_elementwise_abs(v), d = av * 0.2316418882f + 1.0f;
    f32x2 t; t.x = __builtin_amdgcn_rcpf(d.x); t.y = __builtin_amdgcn_rcpf(d.y);
    f32x2 q = t * 0.5307027145f + (-0.7265760135f); q = q * t + 0.7107068705f; q = q * t + (-0.142248368f); q = q * t + 0.127414796f; q = q * t;
    const f32x2 s = (v * v) * (-0.72134752044f);
    f32x2 e; e.x = __builtin_amdgcn_exp2f(s.x); e.y = __builtin_amdgcn_exp2f(s.y);
    const f32x2 m = v * (q * e), r = v - m;
    f32x2 o; o.x = v.x < 0.f ? m.x : r.x; o.y = v.y < 0.f ? m.y : r.y; return o;
}

template <class Epi, class Sched, bool ALIGN_EPI = false, bool SP2 = false>
__device__ __forceinline__ void gemm_phase(PG8_LAS unsigned char* lds, const Gemm g, const Sched& S, const Epi& E) {
    const int tid = threadIdx.x, wid = __builtin_amdgcn_readfirstlane(tid >> 6), lane = tid & 63, wr = wid >> 2, wc = wid & 3, fr = lane & 15, fq = lane >> 4;
    const int K = g.K, nt = K / BK;
    unsigned voffA[2], voffB[2];
#pragma unroll
    for (int i = 0; i < 2; ++i) { int R, C; stage_rc(tid * 16 + i * 8192, R, C); const int Rb = Epi::PERM ? ((R & ~31) + perm32(R & 31)) : R;
        voffA[i] = (unsigned)(R * K + C) * 2u; voffB[i] = (unsigned)(Rb * K + C) * 2u; }
    const size_t kstep = (size_t)(BK * 2);
    const size_t hstep = (size_t)HALF * K * 2;
    const size_t tstep = 2 * hstep;
    const unsigned ldsw = (unsigned)wid * 1024u;
    const int aoff = lds_byte(wr * 64 + fr, fq * 8), boff = lds_byte(wc * 32 + fr, fq * 8);
#define PG8_SA(b, h) (((b) * 2 + (h)) * HTB)
#define PG8_SB(b, h) ((4 + (b) * 2 + (h)) * HTB)
#define PG8_STAGE(bufoff, gbase, voff) do { _Pragma("unroll") for (int _i = 0; _i < 2; ++_i) \
        __builtin_amdgcn_global_load_lds((const unsigned*)((const char*)(gbase) + (voff)[_i]), (PG8_LAS unsigned*)(lds + (bufoff) + ldsw + _i * 8192), 16, 0, 0); } while (0)
#define PG8_LDA(dst, b, h) do { _Pragma("unroll") for (int m = 0; m < 4; ++m) _Pragma("unroll") for (int k = 0; k < 2; ++k) dst[m][k] = *(const PG8_LAS bf16x8*)(lds + PG8_SA(b, h) + aoff + m * 2048 + k * 1024); } while (0)
#define PG8_LDB(dst, b, h) do { _Pragma("unroll") for (int n = 0; n < 2; ++n) _Pragma("unroll") for (int k = 0; k < 2; ++k) dst[n][k] = *(const PG8_LAS bf16x8*)(lds + PG8_SB(b, h) + boff + n * 2048 + k * 1024); } while (0)
#define PG8_MMA(ai, bj, At, Bt) do { __builtin_amdgcn_s_setprio(1); _Pragma("unroll") for (int m = 0; m < 4; ++m) _Pragma("unroll") for (int n = 0; n < 2; ++n) _Pragma("unroll") for (int k = 0; k < 2; ++k) \
        acc[ai][bj][m][n] = __builtin_amdgcn_mfma_f32_16x16x32_bf16(Bt[n][k], At[m][k], acc[ai][bj][m][n], 0, 0, 0); __builtin_amdgcn_s_setprio(0); } while (0)
#define PG8_WAIT_V(n) asm volatile("s_waitcnt vmcnt(" #n ")" ::: "memory")
#define PG8_WAIT_L(n) asm volatile("s_waitcnt lgkmcnt(" #n ")" ::: "memory")
#define PG8_BAR __builtin_amdgcn_s_barrier()
#define PG8_SCHED __builtin_amdgcn_sched_barrier(0)
    Unit cur, nxt; int ui = 0;
    if (!S.next(0, cur)) return;
    f32x4 acc[2][2][4][2];
#pragma unroll
    for (int a = 0; a < 2; ++a)
#pragma unroll
        for (int b = 0; b < 2; ++b)
#pragma unroll
            for (int m = 0; m < 4; ++m)
#pragma unroll
                for (int n = 0; n < 2; ++n) acc[a][b][m][n] = (f32x4){0.f, 0.f, 0.f, 0.f};
    bf16x8 At[4][2], B0[2][2], B1[2][2];
    const char* cA = (const char*)g.A + (size_t)cur.pm * tstep; const char* cB = (const char*)g.Bt + cur.bo + (size_t)cur.pn * tstep;
    S.a_ready(cur);
    if constexpr (SP2) {
        PG8_STAGE(PG8_SB(0, 0), cB, voffB); PG8_STAGE(PG8_SB(0, 1), cB + hstep, voffB); PG8_STAGE(PG8_SA(0, 0), cA, voffA); PG8_STAGE(PG8_SA(0, 1), cA + hstep, voffA);
        if (wr == 1) PG8_BAR;
        PG8_WAIT_V(2); PG8_BAR;
        PG8_STAGE(PG8_SB(1, 0), cB + kstep, voffB); PG8_STAGE(PG8_SA(1, 0), cA + kstep, voffA); PG8_STAGE(PG8_SB(1, 1), cB + hstep + kstep, voffB);
        PG8_WAIT_V(6); PG8_BAR;
    } else {
        PG8_STAGE(PG8_SB(0, 0), cB, voffB); PG8_STAGE(PG8_SA(0, 0), cA, voffA); PG8_STAGE(PG8_SB(0, 1), cB + hstep, voffB); PG8_STAGE(PG8_SA(0, 1), cA + hstep, voffA);
        if (wr == 1) PG8_BAR;
        PG8_WAIT_V(4); PG8_BAR;
        PG8_STAGE(PG8_SB(1, 0), cB + kstep, voffB); PG8_STAGE(PG8_SA(1, 0), cA + kstep, voffA); PG8_STAGE(PG8_SB(1, 1), cB + hstep + kstep, voffB);
        PG8_WAIT_V(6); PG8_BAR;
    }
    for (;;) {
        const bool has_next = S.next(ui + 1, nxt);
        const char* nA = has_next ? (const char*)g.A + (size_t)nxt.pm * tstep : cA; const char* nB = has_next ? (const char*)g.Bt + nxt.bo + (size_t)nxt.pn * tstep : cB;
        for (int t = 0; t < nt; t += 2) {
            const bool last = (t == nt - 2);
            const char* a1 = cA + (size_t)(t + 1) * kstep;
            const char* a2 = last ? nA : cA + (size_t)(t + 2) * kstep; const char* b2 = last ? nB : cB + (size_t)(t + 2) * kstep;
            const char* a3 = a2 + kstep; const char* b3 = b2 + kstep;
            if (last && has_next) S.a_ready(nxt);
            if constexpr (SP2) {
            PG8_LDB(B0, 0, 0); PG8_LDB(B1, 0, 1); PG8_SCHED; PG8_LDA(At, 0, 0); PG8_STAGE(PG8_SA(1, 1), a1 + hstep, voffA);
            PG8_WAIT_V(8); PG8_WAIT_L(0); PG8_BAR; PG8_MMA(0, 0, At, B0); PG8_MMA(0, 1, At, B1); PG8_BAR; PG8_SCHED;
            PG8_LDA(At, 0, 1); PG8_STAGE(PG8_SB(0, 0), b2, voffB); PG8_STAGE(PG8_SB(0, 1), b2 + hstep, voffB); PG8_STAGE(PG8_SA(0, 0), a2, voffA);
            PG8_WAIT_V(8); PG8_WAIT_L(0); PG8_BAR; PG8_MMA(1, 0, At, B0); PG8_MMA(1, 1, At, B1); PG8_BAR; PG8_SCHED;
            PG8_LDB(B0, 1, 0); PG8_LDB(B1, 1, 1); PG8_SCHED; PG8_LDA(At, 1, 0); PG8_STAGE(PG8_SA(0, 1), a2 + hstep, voffA);
            PG8_WAIT_V(8); PG8_WAIT_L(0); PG8_BAR; PG8_MMA(0, 0, At, B0); PG8_MMA(0, 1, At, B1); PG8_BAR; PG8_SCHED;
            PG8_LDA(At, 1, 1); PG8_STAGE(PG8_SB(1, 0), b3, voffB); PG8_STAGE(PG8_SB(1, 1), b3 + hstep, voffB); PG8_STAGE(PG8_SA(1, 0), a3, voffA);
            PG8_WAIT_V(8); PG8_WAIT_L(0); PG8_BAR; PG8_MMA(1, 0, At, B0); PG8_MMA(1, 1, At, B1); PG8_BAR; PG8_SCHED;
            } else {
            PG8_LDB(B0, 0, 0); PG8_SCHED; PG8_LDA(At, 0, 0); PG8_STAGE(PG8_SA(1, 1), a1 + hstep, voffA);
            PG8_WAIT_L(8); PG8_BAR; PG8_WAIT_L(0); PG8_MMA(0, 0, At, B0); PG8_BAR; PG8_SCHED;
            PG8_LDB(B1, 0, 1); PG8_STAGE(PG8_SB(0, 0), b2, voffB);
            PG8_BAR; PG8_WAIT_L(0); PG8_MMA(0, 1, At, B1); PG8_BAR;
            PG8_LDA(At, 0, 1); PG8_STAGE(PG8_SA(0, 0), a2, voffA);
            PG8_BAR; PG8_WAIT_L(0); PG8_MMA(1, 0, At, B0); PG8_BAR; PG8_SCHED;
            PG8_STAGE(PG8_SB(0, 1), b2 + hstep, voffB);
            PG8_WAIT_V(6); PG8_BAR; PG8_MMA(1, 1, At, B1); PG8_BAR;
            PG8_LDB(B0, 1, 0); PG8_SCHED; PG8_LDA(At, 1, 0); PG8_STAGE(PG8_SA(0, 1), a2 + hstep, voffA);
            PG8_WAIT_L(8); PG8_BAR; PG8_WAIT_L(0); PG8_MMA(0, 0, At, B0); PG8_BAR; PG8_SCHED;
            PG8_LDB(B1, 1, 1); PG8_STAGE(PG8_SB(1, 0), b3, voffB);
            PG8_BAR; PG8_WAIT_L(0); PG8_MMA(0, 1, At, B1); PG8_BAR;
            PG8_LDA(At, 1, 1); PG8_STAGE(PG8_SA(1, 0), a3, voffA);
            PG8_BAR; PG8_WAIT_L(0); PG8_MMA(1, 0, At, B0); PG8_BAR; PG8_SCHED;
            PG8_STAGE(PG8_SB(1, 1), b3 + hstep, voffB);
            PG8_WAIT_V(6); PG8_BAR; PG8_MMA(1, 1, At, B1); PG8_BAR;
            }
        }
        if constexpr (ALIGN_EPI) { if (wr == 0) PG8_BAR; }
        if constexpr (!Epi::AFTER_DRAIN) { E(acc, cur, wr, wc, fr, fq); S.done(cur); }
        if (!has_next) break;
#pragma unroll
        for (int a = 0; a < 2; ++a)
#pragma unroll
            for (int b = 0; b < 2; ++b)
#pragma unroll
                for (int m = 0; m < 4; ++m)
#pragma unroll
                    for (int n = 0; n < 2; ++n) acc[a][b][m][n] = (f32x4){0.f, 0.f, 0.f, 0.f};
        cur = nxt; cA = nA; cB = nB; ++ui;
        if constexpr (ALIGN_EPI) { if (wr == 1) PG8_BAR; }
    }
    PG8_WAIT_V(0);
    if constexpr (!ALIGN_EPI) { if (wr == 0) PG8_BAR; }
    PG8_BAR;
    if constexpr (Epi::AFTER_DRAIN) { E.fused(acc, cur, wr, wc, fr, fq, lds, wid, lane); S.done(cur); }
#undef PG8_SA
#undef PG8_SB
#undef PG8_STAGE
#undef PG8_LDA
#undef PG8_LDB
#undef PG8_MMA
#undef PG8_WAIT_V
#undef PG8_WAIT_L
#undef PG8_BAR
#undef PG8_SCHED
}
}

namespace pg8 {
struct GroupedOrder {
    const int* tile_e; int nU, nN, G, c; size_t estride;
    __device__ __forceinline__ bool next(int i, Unit& u) const { const long L = (long)i * G + c; if (L >= nU) return false; const int t = (int)L / nN; u.pm = t; u.pn = (int)L % nN; u.bo = (size_t)tile_e[t] * estride; return true; }
    __device__ __forceinline__ void a_ready(const Unit&) const {}
    __device__ __forceinline__ void done(const Unit&) const {}
};
__device__ __forceinline__ u32x4 pack8(const f32x4 a, const f32x4 b) { u32x4 w; w.x = cvt_pk_bf16(a[0], a[1]); w.y = cvt_pk_bf16(a[2], a[3]); w.z = cvt_pk_bf16(b[0], b[1]); w.w = cvt_pk_bf16(b[2], b[3]); return w; }
struct EpiStore {
    static constexpr bool PERM = true, AFTER_DRAIN = false; bf16_t* O; int ldc;
    __device__ __forceinline__ void operator()(const f32x4 (&acc)[2][2][4][2], const Unit& u, int wr, int wc, int fr, int fq) const {
        const int row0 = u.pm * BM + wr * 64 + fr, col0 = u.pn * BM + wc * 32 + 8 * fq;
#pragma unroll
        for (int ai = 0; ai < 2; ++ai)
#pragma unroll
            for (int m = 0; m < 4; ++m) { bf16_t* rowp = O + (size_t)(row0 + ai * HALF + m * 16) * ldc + col0;
#pragma unroll
                for (int bj = 0; bj < 2; ++bj) *(u32x4*)(rowp + bj * HALF) = pack8(acc[ai][bj][m][0], acc[ai][bj][m][1]); }
    }
};
__device__ __forceinline__ f32x4 silu4(const f32x4 v) { f32x4 r;
#pragma unroll
    for (int i = 0; i < 4; ++i) r[i] = v[i] * __builtin_amdgcn_rcpf(1.f + __expf(-v[i])); return r; }
__device__ __forceinline__ f32x4 sigm4(const f32x4 v) { f32x4 r;
#pragma unroll
    for (int i = 0; i < 4; ++i) r[i] = __builtin_amdgcn_rcpf(1.f + __expf(-v[i])); return r; }
struct EpiSwiglu {
    static constexpr bool PERM = true, AFTER_DRAIN = false; bf16_t* G;
    __device__ __forceinline__ void operator()(const f32x4 (&acc)[2][2][4][2], const Unit& u, int wr, int wc, int fr, int fq) const {
        const int row0 = u.pm * BM + wr * 64 + fr, col0 = u.pn * HALF + wc * 32 + 8 * fq;
#pragma unroll
        for (int ai = 0; ai < 2; ++ai)
#pragma unroll
            for (int m = 0; m < 4; ++m) *(u32x4*)(G + (size_t)(row0 + ai * HALF + m * 16) * 512 + col0) = pack8(silu4(acc[ai][0][m][0]) * acc[ai][1][m][0], silu4(acc[ai][0][m][1]) * acc[ai][1][m][1]);
    }
};
__device__ __forceinline__ void unpack8f(const u32x4 w, f32x4& a, f32x4& b) {
    a[0] = __uint_as_float(w.x << 16); a[1] = __uint_as_float(w.x & 0xffff0000u); a[2] = __uint_as_float(w.y << 16); a[3] = __uint_as_float(w.y & 0xffff0000u);
    b[0] = __uint_as_float(w.z << 16); b[1] = __uint_as_float(w.z & 0xffff0000u); b[2] = __uint_as_float(w.w << 16); b[3] = __uint_as_float(w.w & 0xffff0000u); }
struct EpiGlu {
    static constexpr bool PERM = true, AFTER_DRAIN = false; const bf16_t* GS; const float* b; bf16_t* GG;
    __device__ __forceinline__ void operator()(const f32x4 (&acc)[2][2][4][2], const Unit& u, int wr, int wc, int fr, int fq) const {
        const int row0 = u.pm * BM + wr * 64 + fr, col0 = u.pn * BM + wc * 32 + 8 * fq;
#pragma unroll
        for (int bj = 0; bj < 2; ++bj) { const int c = col0 + bj * HALF; const f32x4 b0 = *(const f32x4*)(b + c), b1 = *(const f32x4*)(b + c + 4);
#pragma unroll
            for (int ai = 0; ai < 2; ++ai)
#pragma unroll
                for (int m = 0; m < 4; ++m) { const size_t o = (size_t)(row0 + ai * HALF + m * 16) * 512 + c; f32x4 g0, g1; unpack8f(*(const u32x4*)(GS + o), g0, g1);
                    *(u32x4*)(GG + o) = pack8(g0 * sigm4(acc[ai][bj][m][0] + b0), g1 * sigm4(acc[ai][bj][m][1] + b1)); } }
    }
};
struct EpiResid {
    static constexpr bool PERM = false, AFTER_DRAIN = false;
    const float* x; const float* ctx; const float* mod; float* XC; int inplace;
    __device__ __forceinline__ void operator()(const f32x4 (&acc)[2][2][4][2], const Unit& u, int wr, int wc, int fr, int fq) const {
        const int R0 = u.pm * BM; const int ci = R0 < 32768 ? (R0 >> 11) : 16;
        const float* base = inplace ? XC + (size_t)R0 * 1024 : (R0 < 32768 ? x + (size_t)R0 * 1024 : ctx + (size_t)(R0 - 32768) * 1024);
        float* out = XC + (size_t)R0 * 1024; const float* gate = mod + ((size_t)ci * 6 + 2) * 1024;
        const int rl0 = wr * 64 + fr, col0 = u.pn * BM + wc * 32 + 4 * fq;
#pragma unroll
        for (int bj = 0; bj < 2; ++bj)
#pragma unroll
            for (int n = 0; n < 2; ++n) { const int c = col0 + bj * HALF + n * 16; const f32x4 g4 = *(const f32x4*)(gate + c);
#pragma unroll
                for (int ai = 0; ai < 2; ++ai)
#pragma unroll
                    for (int m = 0; m < 4; ++m) { const size_t o = (size_t)(rl0 + ai * HALF + m * 16) * 1024 + c; *(f32x4*)(out + o) = *(const f32x4*)(base + o) + g4 * acc[ai][bj][m][n]; } }
    }
};
}

struct Params {
    const float* in[35];
    float* out;
    unsigned char* ws;
    int ph_lo, ph_hi;
};
enum { I_X = 0, I_C, I_CTX, I_CCTX, I_WMOD, I_BMOD, I_GMIX, I_GFFN, I_MIXWIN, I_MIXWOUT, I_QG, I_KG, I_LNG, I_WSP, I_BSP,
       I_S5WIN, I_ARE, I_AIM, I_LOGDT, I_BRE, I_BIM, I_CRE, I_CIM, I_S5D, I_WGLU, I_BGLU, I_S5WOUT,
       I_WGRP, I_BGRP, I_WRT, I_BRT, I_W1, I_W3, I_W2, I_FING };

struct Ctx {
    const Params* p;
    unsigned char* ws;
    LAS unsigned char* lds;
    int tid, lane, wave, gw, ngw;
};
__device__ __forceinline__ const float* xin_row(const Params& P, int r) { return r < TL ? P.in[I_X] + (size_t)r * D : P.in[I_CTX] + (size_t)(r - TL) * D; }
__device__ __forceinline__ int cond_of(int r) { return r < TL ? (r >> 11) : 16; }
__device__ __forceinline__ const float* mod_vec(const Ctx& C, int layer, int ci, int k) { return (const float*)(C.ws + WS_MOD) + ((size_t)(layer * 17 + ci) * 6 + k) * D; }

__device__ __forceinline__ void dsincos(double a, double& s, double& c) {
    const double TWO_PI_HI = 6.283185307179586, TWO_PI_LO = 2.4492935982947064e-16;
    const double k = rint(a * 0.15915494309189535);
    double r = fma(-k, TWO_PI_HI, a); r = fma(-k, TWO_PI_LO, r);
    const double r2 = r * r; double ct = 1.0, st = r, cs = 1.0, ss = r;
#pragma unroll 1
    for (int i = 1; i <= 15; ++i) { ct *= -r2 / (double)((2 * i - 1) * (2 * i)); cs += ct; st *= -r2 / (double)((2 * i) * (2 * i + 1)); ss += st; }
    s = ss; c = cs;
}

__device__ __forceinline__ void transpose_item(const float* src, int N, int k0, int n0, bf16* dst, int dpitch, LAS float* scr, int lane) {
#pragma unroll 8
    for (int i = 0; i < 32; ++i) { const int kk = 2 * i + (lane >> 5); scr[kk * 33 + (lane & 31)] = src[(size_t)(k0 + kk) * N + n0 + (lane & 31)]; }
    asm volatile("s_waitcnt lgkmcnt(0)" ::: "memory");
    const int c = lane & 7;
#pragma unroll
    for (int j = 0; j < 4; ++j) { const int n = (lane >> 3) + 8 * j; const LAS float* s = scr + (8 * c) * 33 + n;
        v4u o; o.x = pk2(s[0 * 33], s[1 * 33]); o.y = pk2(s[2 * 33], s[3 * 33]); o.z = pk2(s[4 * 33], s[5 * 33]); o.w = pk2(s[6 * 33], s[7 * 33]);
        *(v4u*)(dst + (size_t)n * dpitch + 8 * c) = o; }
    asm volatile("s_waitcnt lgkmcnt(0)" ::: "memory");
}
__device__ __forceinline__ void transpose_mat_item(const float* W, int K, int N, bf16* WT, int it, LAS float* scr, int lane) {
    const int nblk = N / 32, kb = it / nblk, nb = it % nblk;
    transpose_item(W, N, kb * 64, nb * 32, WT + (size_t)(nb * 32) * K + kb * 64, K, scr, lane);
}
constexpr int MOE_ITEMS = NEXP * 768;
__device__ __forceinline__ void moe_convert_item(const Ctx& C, int layer, int it, LAS float* scr) {
    const Params& P = *C.p;
    const int e = it / 768, r = it % 768, kind = r / 256, j = r % 256;
    if (kind < 2) {
        const float* src = (kind == 0 ? P.in[I_W1] : P.in[I_W3]) + ((size_t)layer * NEXP + e) * D * EH;
        const int kb = j / 16, nb = j % 16, k0 = kb * 64, n0 = nb * 32;
        const int drow = (n0 / 128) * 256 + (n0 % 128) + (kind == 1 ? 128 : 0);
        transpose_item(src, EH, k0, n0, (bf16*)(C.ws + WS_W13) + (size_t)e * 1024 * 1024 + (size_t)drow * 1024 + k0, 1024, scr, C.lane);
    } else {
        const float* src = P.in[I_W2] + ((size_t)layer * NEXP + e) * EH * D;
        const int kb = j / 32, nb = j % 32, k0 = kb * 64, n0 = nb * 32;
        transpose_item(src, D, k0, n0, (bf16*)(C.ws + WS_W2) + (size_t)e * 1024 * 512 + (size_t)n0 * 512 + k0, 512, scr, C.lane);
    }
}

__device__ __forceinline__ void phase_prologue(const Ctx& C) {
    const Params& P = *C.p;
    {
        LAS float* s = (LAS float*)C.lds;
        LAS float* red = (LAS float*)(C.lds + 17 * 1024 * 4);
        bool have_s = false;
        for (int u = blockIdx.x; u < 192; u += gridDim.x) {
            if (!have_s) {
                for (int i = C.tid; i < 17 * 1024; i += NTHR) { const int ci = i >> 10, k = i & 1023; const float v = ci < 16 ? P.in[I_C][ci * D + k] : P.in[I_CCTX][k]; s[i] = silu_(v); }
                have_s = true; __syncthreads();
            }
            const int layer = u / 96, jg = u % 96, kq = C.tid >> 6, jc = C.tid & 63;
            const float* w = P.in[I_WMOD] + (size_t)layer * D * 6144 + jg * 64 + jc;
            float acc[17];
#pragma unroll
            for (int i = 0; i < 17; ++i) acc[i] = 0.f;
            for (int k = kq * 128; k < kq * 128 + 128; ++k) { const float wv = w[(size_t)k * 6144];
#pragma unroll
                for (int i = 0; i < 17; ++i) acc[i] += s[i * 1024 + k] * wv; }
#pragma unroll
            for (int i = 0; i < 17; ++i) red[(kq * 17 + i) * 64 + jc] = acc[i];
            __syncthreads();
            for (int o = C.tid; o < 17 * 64; o += NTHR) { const int ci = o >> 6, c = o & 63; float v = 0.f;
#pragma unroll
                for (int q = 0; q < 8; ++q) v += red[(q * 17 + ci) * 64 + c];
                const int j = jg * 64 + c; v += P.in[I_BMOD][layer * 6144 + j];
                ((float*)(C.ws + WS_MOD))[((size_t)(layer * 17 + ci)) * 6144 + j] = v; }
            __syncthreads();
        }
        __syncthreads();
    }
    {
        const int gt = blockIdx.x * NTHR + C.tid, ngt = gridDim.x * NTHR;
        float2* rope = (float2*)(C.ws + WS_TAB + TAB_ROPE);
        for (int i = gt; i < 64 * 16; i += ngt) { const int pos = i >> 4, f = i & 15;
            const double th = exp(-(double)f * (9.210340371976184 / 16.0)); double s, c; dsincos((double)pos * th, s, c); rope[i] = make_float2((float)c, (float)s); }
        float2* lamb = (float2*)(C.ws + WS_TAB + TAB_LAMB); float2* bbar = (float2*)(C.ws + WS_TAB + TAB_BBAR);
        for (int i = gt; i < 2 * 32 * 64; i += ngt) {
            const int dg = i >> 6;
            const double are = P.in[I_ARE][i], aim = P.in[I_AIM][i], dt = exp((double)P.in[I_LOGDT][dg]);
            double s, c; dsincos(aim * dt, s, c); const double mag = exp(are * dt), lr = mag * c, li = mag * s;
            lamb[i] = make_float2((float)lr, (float)li);
            const double den = are * are + aim * aim, nr = lr - 1.0, ni = li;
            const double cr = (nr * are + ni * aim) / den, cim = (ni * are - nr * aim) / den;
            for (int p = 0; p < 16; ++p) { const double br = P.in[I_BRE][(size_t)i * 16 + p], bi = P.in[I_BIM][(size_t)i * 16 + p];
                bbar[(size_t)i * 16 + p] = make_float2((float)(cr * br - cim * bi), (float)(cr * bi + cim * br)); }
        }
    }
    {
        LAS float* scr = (LAS float*)(C.lds + C.wave * 16384);
        constexpr int I0 = 16 * 56, I1 = 16 * 32, I2 = 16 * 16, I3 = 8 * 16, I4 = 8 * 32;
        constexpr int NSMALL = I0 + I1 + I2 + I3 + I4;
        for (int it = C.gw; it < NSMALL + MOE_ITEMS; it += C.ngw) {
            int r = it;
            if (r < I0) { transpose_mat_item(P.in[I_MIXWIN], D, MIXW, (bf16*)(C.ws + WS_WIN0), r, scr, C.lane); continue; } r -= I0;
            if (r < I1) { transpose_mat_item(P.in[I_MIXWOUT], D, D, (bf16*)(C.ws + WS_WOUT0), r, scr, C.lane); continue; } r -= I1;
            if (r < I2) { transpose_mat_item(P.in[I_S5WIN], D, 512, (bf16*)(C.ws + WS_WS5IN), r, scr, C.lane); continue; } r -= I2;
            if (r < I3) { transpose_mat_item(P.in[I_WGLU], 512, 512, (bf16*)(C.ws + WS_WGLU), r, scr, C.lane); continue; } r -= I3;
            if (r < I4) { transpose_mat_item(P.in[I_S5WOUT], 512, D, (bf16*)(C.ws + WS_WS5OUT), r, scr, C.lane); continue; } r -= I4;
            moe_convert_item(C, 0, r, scr);
        }
    }
}

__device__ __forceinline__ void load_row16(const float* row, int lane, f32x4 (&v)[4]) {
#pragma unroll
    for (int j = 0; j < 4; ++j) v[j] = *(const f32x4*)(row + 4 * lane + 256 * j);
}
__device__ __forceinline__ float row_rstd(const f32x4 (&v)[4]) {
    float s = 0.f;
#pragma unroll
    for (int j = 0; j < 4; ++j) s += (v[j].x * v[j].x + v[j].y * v[j].y) + (v[j].z * v[j].z + v[j].w * v[j].w);
    return rsqrtf(wave_sum(s) * (1.f / D) + EPS);
}
__device__ __forceinline__ void modulate16(f32x4 (&v)[4], float rstd, const float* g, const float* scale, const float* shift, int lane) {
#pragma unroll
    for (int j = 0; j < 4; ++j) { const int c = 4 * lane + 256 * j; const f32x4 gg = *(const f32x4*)(g + c), sc = *(const f32x4*)(scale + c), sh = *(const f32x4*)(shift + c);
        v[j] = v[j] * rstd * gg * (sc + 1.f) + sh; }
}
__device__ __forceinline__ void store_row16_bf16(bf16* row, int lane, const f32x4 (&v)[4]) {
#pragma unroll
    for (int j = 0; j < 4; ++j) { v2u o; o.x = pk2(v[j].x, v[j].y); o.y = pk2(v[j].z, v[j].w); *(v2u*)(row + 4 * lane + 256 * j) = o; }
}

__device__ __forceinline__ void phase_norm_mix0(const Ctx& C) {
    const Params& P = *C.p; bf16* H = (bf16*)(C.ws + WS_H);
    for (int r = C.gw; r < TT; r += C.ngw) {
        f32x4 v[4]; load_row16(xin_row(P, r), C.lane, v);
        const float rstd = row_rstd(v); const int ci = cond_of(r);
        modulate16(v, rstd, P.in[I_GMIX], mod_vec(C, 0, ci, 1), mod_vec(C, 0, ci, 0), C.lane);
        store_row16_bf16(H + (size_t)r * D, C.lane, v);
    }
}

template <class Epi>
__device__ __forceinline__ void ngemm_unit(const Ctx& C, const bf16* A0, const bf16* B0, int K, int row0, int pn, const Epi& epi) {
    LAS float* As = (LAS float*)C.lds;
    LAS float* Bs = (LAS float*)(C.lds + 32 * 68 * 4);
    const int tid = C.tid, ty = tid >> 4, tx = tid & 15;
    float acc[2][16];
#pragma unroll
    for (int i = 0; i < 2; ++i)
#pragma unroll
        for (int j = 0; j < 16; ++j) acc[i][j] = 0.f;
    const int ar = tid >> 3, ak = (tid & 7) * 4, bn = tid >> 1, bk = (tid & 1) * 16;
    for (int k0 = 0; k0 < K; k0 += 32) {
        const v2u av = *(const v2u*)(A0 + (size_t)ar * K + k0 + ak);
        const v4u b0 = *(const v4u*)(B0 + (size_t)bn * K + k0 + bk), b1 = *(const v4u*)(B0 + (size_t)bn * K + k0 + bk + 8);
        __syncthreads();
        As[(ak + 0) * 68 + ar] = bf2f(av.x & 0xffffu); As[(ak + 1) * 68 + ar] = bf2f(av.x >> 16); As[(ak + 2) * 68 + ar] = bf2f(av.y & 0xffffu); As[(ak + 3) * 68 + ar] = bf2f(av.y >> 16);
        float bf[16]; unpack8(b0, bf); unpack8(b1, bf + 8);
#pragma unroll
        for (int i = 0; i < 16; ++i) Bs[(bk + i) * 260 + bn] = bf[i];
        __syncthreads();
#pragma unroll 4
        for (int k = 0; k < 32; ++k) {
            const float a0 = As[k * 68 + ty * 2], a1 = As[k * 68 + ty * 2 + 1];
            const f32x4 x0 = *(const LAS f32x4*)(Bs + k * 260 + tx * 8), x1 = *(const LAS f32x4*)(Bs + k * 260 + tx * 8 + 4);
            const f32x4 y0 = *(const LAS f32x4*)(Bs + k * 260 + 128 + tx * 8), y1 = *(const LAS f32x4*)(Bs + k * 260 + 128 + tx * 8 + 4);
            const float bb[16] = {x0.x, x0.y, x0.z, x0.w, x1.x, x1.y, x1.z, x1.w, y0.x, y0.y, y0.z, y0.w, y1.x, y1.y, y1.z, y1.w};
#pragma unroll
            for (int j = 0; j < 16; ++j) { acc[0][j] += a0 * bb[j]; acc[1][j] += a1 * bb[j]; }
        }
    }
#pragma unroll
    for (int i = 0; i < 2; ++i)
#pragma unroll
        for (int j = 0; j < 8; ++j) epi(row0 + ty * 2 + i, pn, tx * 8 + j, acc[i][j], acc[i][8 + j]);
    __syncthreads();
}
template <class Epi>
__device__ __forceinline__ void ngemm_dense(const Ctx& C, const bf16* A, const bf16* Bt, int M, int N, int K, const Epi& epi) {
    const int nN = N / 256, nU = (M / 64) * nN;
    for (int u = blockIdx.x; u < nU; u += gridDim.x) { const int tm = u / nN, pn = u % nN;
        ngemm_unit(C, A + (size_t)tm * 64 * K, Bt + (size_t)pn * 256 * K, K, tm * 64, pn, epi); }
}
template <class Epi>
__device__ __forceinline__ void ngemm_grouped(const Ctx& C, const bf16* A, const bf16* Bt, size_t estride, int N, int K, const Epi& epi) {
    const int* tile_e = (const int*)(C.ws + WS_ROUTE + RT_TILE); const int ntiles = *(const int*)(C.ws + WS_ROUTE + RT_NT);
    const int nN = N / 256, nU = ntiles * 4 * nN;
    for (int u = blockIdx.x; u < nU; u += gridDim.x) { const int pn = u % nN, tm = u / nN, e = tile_e[tm >> 2];
        ngemm_unit(C, A + (size_t)tm * 64 * K, Bt + (size_t)e * estride + (size_t)pn * 256 * K, K, tm * 64, pn, epi); }
}

struct EpiStoreBf16 { bf16* O; int ldc;
    __device__ __forceinline__ void operator()(int r, int pn, int c, float v0, float v1) const { bf16* o = O + (size_t)r * ldc + pn * 256 + c; o[0] = (bf16)f2bf(v0); o[128] = (bf16)f2bf(v1); } };
struct EpiResid0 { const Params* P; const float* mod; float* XC;
    __device__ __forceinline__ void operator()(int r, int pn, int c, float v0, float v1) const { const int n = pn * 256 + c; const float* xi = xin_row(*P, r); const float* g = mod + ((size_t)cond_of(r) * 6 + 2) * D;
        float* o = XC + (size_t)r * D; o[n] = xi[n] + g[n] * v0; o[n + 128] = xi[n + 128] + g[n + 128] * v1; } };
struct EpiResidAcc { const float* mod; float* XC;
    __device__ __forceinline__ void operator()(int r, int pn, int c, float v0, float v1) const { const int n = pn * 256 + c; const float* g = mod + ((size_t)cond_of(r) * 6 + 2) * D;
        float* o = XC + (size_t)r * D; o[n] += g[n] * v0; o[n + 128] += g[n + 128] * v1; } };
struct EpiSwiglu { bf16* G;
    __device__ __forceinline__ void operator()(int r, int pn, int c, float v0, float v1) const { G[(size_t)r * EH + pn * 128 + c] = (bf16)f2bf(silu_(v0) * v1); } };
struct EpiGlu { const bf16* GS; const float* b; bf16* GG;
    __device__ __forceinline__ void operator()(int r, int pn, int c, float v0, float v1) const { const int n = pn * 256 + c; const size_t o = (size_t)r * 512 + n;
        GG[o] = (bf16)f2bf(bf2f(GS[o]) * sigmoidf_(v0 + b[n])); GG[o + 128] = (bf16)f2bf(bf2f(GS[o + 128]) * sigmoidf_(v1 + b[n + 128])); } };

__device__ __forceinline__ void qk_norm_rope(float (&v)[8], const float* gain, bool lat, int t, int lane, const float2* rope) {
    float ss = 0.f;
#pragma unroll
    for (int j = 0; j < 8; ++j) ss += v[j] * v[j];
    ss += __shfl_xor(ss, 1); ss += __shfl_xor(ss, 2); ss += __shfl_xor(ss, 4);
    const float rstd = rsqrtf(ss * (1.f / 64.f) + EPS);
    const int l8 = lane & 7;
#pragma unroll
    for (int j = 0; j < 8; ++j) v[j] = v[j] * rstd * gain[l8 * 8 + j];
    const int quarter = l8 >> 1, pos = (quarter < 2) ? (t >> 6) : (t & 63);
#pragma unroll
    for (int j = 0; j < 8; ++j) {
        const float pv = __shfl_xor(v[j], 2);
        if (lat) { const float2 cs = rope[pos * 16 + (lane & 1) * 8 + j];
            v[j] = (quarter & 1) ? (v[j] * cs.x + pv * cs.y) : (v[j] * cs.x - pv * cs.y); }
    }
}
__device__ __forceinline__ void phase_qkprep(const Ctx& C) {
    const Params& P = *C.p; const bf16* Pb = (const bf16*)(C.ws + WS_P); bf16* Q = (bf16*)(C.ws + WS_Q); bf16* Kb = (bf16*)(C.ws + WS_K); bf16* Vb = (bf16*)(C.ws + WS_V);
    const float2* rope = (const float2*)(C.ws + WS_TAB + TAB_ROPE);
    for (int r = C.gw; r < TT; r += C.ngw) {
        const bool lat = r < TL; const int t = lat ? (r & 2047) : 0;
        const size_t kvrow = lat ? (size_t)(r >> 11) * KVL + CTXL + (r & 2047) : (size_t)((r - TL) >> 8) * KVL + ((r - TL) & 255);
        const bf16* pr = Pb + (size_t)r * MIXW;
        { float v[8]; unpack8(*(const v4u*)(pr + 8 * C.lane), v); qk_norm_rope(v, P.in[I_QG], lat, t, C.lane, rope);
          v4u o; o.x = pk2(v[0] * QSCALE, v[1] * QSCALE); o.y = pk2(v[2] * QSCALE, v[3] * QSCALE); o.z = pk2(v[4] * QSCALE, v[5] * QSCALE); o.w = pk2(v[6] * QSCALE, v[7] * QSCALE);
          *(v4u*)(Q + (size_t)r * 512 + 8 * C.lane) = o; }
        { const int l = C.lane & 15; float v[8]; unpack8(*(const v4u*)(pr + 512 + 8 * l), v); qk_norm_rope(v, P.in[I_KG], lat, t, C.lane, rope);
          if (C.lane < 16) { v4u o; o.x = pk2(v[0], v[1]); o.y = pk2(v[2], v[3]); o.z = pk2(v[4], v[5]); o.w = pk2(v[6], v[7]); *(v4u*)(Kb + kvrow * 128 + 8 * l) = o;
              *(v4u*)(Vb + kvrow * 128 + 8 * l) = *(const v4u*)(pr + 640 + 8 * l); } }
    }
}

__device__ __forceinline__ void phase_gmlp(const Ctx& C) {
    const Params& P = *C.p; const bf16* Pb = (const bf16*)(C.ws + WS_P); bf16* OG = (bf16*)(C.ws + WS_H);
    LAS bf16* VN = (LAS bf16*)C.lds; constexpr int VP = 520;
    const int g = __builtin_amdgcn_readfirstlane(C.tid >> 6);
    for (int ch = blockIdx.x; ch < TT / 128; ch += gridDim.x) {
        for (int i = 0; i < 16; ++i) { const int rl = C.wave * 16 + i; const bf16* pr = Pb + (size_t)(ch * 128 + rl) * MIXW + 1280 + 8 * C.lane;
            float v[8]; unpack8(*(const v4u*)pr, v); float s = 0.f;
#pragma unroll
            for (int j = 0; j < 8; ++j) { v[j] = gelu_tanh(v[j]); s += v[j]; }
            const float mean = wave_sum(s) * (1.f / 512.f); float q = 0.f;
#pragma unroll
            for (int j = 0; j < 8; ++j) { v[j] -= mean; q += v[j] * v[j]; }
            const float rstd = rsqrtf(wave_sum(q) * (1.f / 512.f) + EPS);
#pragma unroll
            for (int j = 0; j < 8; ++j) v[j] = v[j] * rstd * P.in[I_LNG][8 * C.lane + j];
            v4u o; o.x = pk2(v[0], v[1]); o.y = pk2(v[2], v[3]); o.z = pk2(v[4], v[5]); o.w = pk2(v[6], v[7]);
            *(LAS v4u*)(VN + rl * VP + 8 * C.lane) = o; }
        __syncthreads();
        const float* wsp = P.in[I_WSP] + (size_t)g * 128 * 128; const float* bsp = P.in[I_BSP] + g * 128;
        for (int pb = 0; pb < 16; ++pb) {
            float acc[8];
#pragma unroll
            for (int i = 0; i < 8; ++i) acc[i] = 0.f;
            for (int q = 0; q < 128; ++q) { const float v = bf2f(VN[q * VP + C.tid]);
#pragma unroll
                for (int i = 0; i < 8; ++i) acc[i] += wsp[(pb * 8 + i) * 128 + q] * v; }
#pragma unroll
            for (int i = 0; i < 8; ++i) { const int p = pb * 8 + i; const size_t row = (size_t)ch * 128 + p;
                const float u = gelu_tanh(bf2f(Pb[row * MIXW + 768 + C.tid]));
                OG[row * D + 512 + C.tid] = (bf16)f2bf(u * (acc[i] + bsp[p])); }
        }
        __syncthreads();
    }
}

__device__ __forceinline__ void attn_item(const Ctx& C, int b, int h, int qrow_g, int nk) {
    const bf16* Q = (const bf16*)(C.ws + WS_Q); const bf16* Kb = (const bf16*)(C.ws + WS_K) + (size_t)b * KVL * 128 + (h >> 2) * 64; const bf16* Vb = (const bf16*)(C.ws + WS_V) + (size_t)b * KVL * 128 + (h >> 2) * 64;
    bf16* OG = (bf16*)(C.ws + WS_H);
    float q[64];
#pragma unroll
    for (int i = 0; i < 8; ++i) unpack8(*(const v4u*)(Q + (size_t)qrow_g * 512 + h * 64 + 8 * i), q + 8 * i);
    float m = -INFINITY, l = 0.f, o = 0.f;
    for (int kt = 0; kt < nk; kt += 64) {
        const bf16* kr = Kb + (size_t)(kt + C.lane) * 128; float s = 0.f;
#pragma unroll
        for (int i = 0; i < 8; ++i) { float kf[8]; unpack8(*(const v4u*)(kr + 8 * i), kf);
#pragma unroll
            for (int j = 0; j < 8; ++j) s += q[8 * i + j] * kf[j]; }
        const float mn = fmaxf(m, wave_max(s)); const float p = exp2f(s - mn), corr = exp2f(m - mn);
        l = l * corr + wave_sum(p); o *= corr; m = mn;
#pragma unroll 8
        for (int jj = 0; jj < 64; ++jj) { const float pj = __shfl(p, jj); o += pj * bf2f(Vb[(size_t)(kt + jj) * 128 + C.lane]); }
    }
    OG[(size_t)qrow_g * D + h * 64 + C.lane] = (bf16)f2bf(o / l);
}
__device__ __forceinline__ void phase_attn(const Ctx& C) {
    for (int it = C.gw; it < NB * 8 * SEQ; it += C.ngw) { const int bh = it >> 11, t = it & 2047, b = bh >> 3, h = bh & 7; attn_item(C, b, h, b * SEQ + t, KVL); }
    for (int it = C.gw; it < NB * 8 * CTXL; it += C.ngw) { const int bh = it >> 8, t = it & 255, b = bh >> 3, h = bh & 7; attn_item(C, b, h, TL + b * CTXL + t, CTXL); }
}

__device__ __forceinline__ void phase_norm_ffn_router(const Ctx& C, int layer, int nrows) {
    const Params& P = *C.p; const float* XC = (const float*)(C.ws + WS_XC); bf16* F = (bf16*)(C.ws + WS_H);
    int* asg_e = (int*)(C.ws + WS_ROUTE + RT_E); int* asg_p = (int*)(C.ws + WS_ROUTE + RT_P); float* asg_w = (float*)(C.ws + WS_ROUTE + RT_W);
    unsigned* cnt = (unsigned*)(C.ws + WS_CTL) + CW_CNT + 64 * layer;
    const float* wg = P.in[I_WGRP] + (size_t)layer * D * 4; const float* wr = P.in[I_WRT] + (size_t)layer * D * 32;
    for (int r = C.gw; r < nrows; r += C.ngw) {
        f32x4 v[4]; load_row16(XC + (size_t)r * D, C.lane, v);
        const float rstd = row_rstd(v); const int ci = cond_of(r);
        modulate16(v, rstd, P.in[I_GFFN] + layer * D, mod_vec(C, layer, ci, 4), mod_vec(C, layer, ci, 3), C.lane);
        store_row16_bf16(F + (size_t)r * D, C.lane, v);
        float lg[4] = {0.f, 0.f, 0.f, 0.f}; float le[32];
#pragma unroll
        for (int i = 0; i < 32; ++i) le[i] = 0.f;
#pragma unroll
        for (int j = 0; j < 4; ++j)
#pragma unroll
            for (int i = 0; i < 4; ++i) { const int c = 4 * C.lane + 256 * j + i; const float f = v[j][i];
                const f32x4 g4 = *(const f32x4*)(wg + (size_t)c * 4); lg[0] += f * g4.x; lg[1] += f * g4.y; lg[2] += f * g4.z; lg[3] += f * g4.w;
#pragma unroll
                for (int e4 = 0; e4 < 8; ++e4) { const f32x4 w4 = *(const f32x4*)(wr + (size_t)c * 32 + e4 * 4); le[e4 * 4] += f * w4.x; le[e4 * 4 + 1] += f * w4.y; le[e4 * 4 + 2] += f * w4.z; le[e4 * 4 + 3] += f * w4.w; } }
#pragma unroll
        for (int i = 0; i < 4; ++i) lg[i] = wave_sum(lg[i]) + P.in[I_BGRP][layer * 4 + i];
#pragma unroll
        for (int i = 0; i < 32; ++i) le[i] = wave_sum(le[i]) + P.in[I_BRT][layer * 32 + i];
        int gi = 0; float gm = lg[0];
#pragma unroll
        for (int i = 1; i < 4; ++i) if (lg[i] > gm) { gm = lg[i]; gi = i; }
        float den = 0.f;
#pragma unroll
        for (int i = 0; i < 4; ++i) den += __expf(lg[i] - gm);
        const float gw_ = 1.f / den;
        float sel[8];
#pragma unroll
        for (int i = 0; i < 8; ++i) sel[i] = gi == 0 ? le[i] : gi == 1 ? le[8 + i] : gi == 2 ? le[16 + i] : le[24 + i];
        int i0 = 0; float v0 = sel[0];
#pragma unroll
        for (int i = 1; i < 8; ++i) if (sel[i] > v0) { v0 = sel[i]; i0 = i; }
        int i1 = -1; float v1 = -INFINITY;
#pragma unroll
        for (int i = 0; i < 8; ++i) if (i != i0 && sel[i] > v1) { v1 = sel[i]; i1 = i; }
        const float e1 = __expf(v1 - v0), w0 = gw_ / (1.f + e1), w1 = gw_ * e1 / (1.f + e1);
        if (C.lane == 0) {
            const int ea = gi * 8 + i0, eb = gi * 8 + i1;
            const unsigned pa = __hip_atomic_fetch_add(cnt + ea, 1u, __ATOMIC_RELAXED, __HIP_MEMORY_SCOPE_AGENT);
            const unsigned pb = __hip_atomic_fetch_add(cnt + eb, 1u, __ATOMIC_RELAXED, __HIP_MEMORY_SCOPE_AGENT);
            asg_e[2 * r] = ea; asg_e[2 * r + 1] = eb; asg_p[2 * r] = (int)pa; asg_p[2 * r + 1] = (int)pb; asg_w[2 * r] = w0; asg_w[2 * r + 1] = w1;
        }
    }
}
__device__ __forceinline__ void phase_gather(const Ctx& C, int layer, int nrows) {
    const bf16* F = (const bf16*)(C.ws + WS_H); bf16* XS = (bf16*)(C.ws + WS_XS);
    const int* asg_e = (const int*)(C.ws + WS_ROUTE + RT_E); const int* asg_p = (const int*)(C.ws + WS_ROUTE + RT_P); int* asg_s = (int*)(C.ws + WS_ROUTE + RT_S);
    int* tile_e = (int*)(C.ws + WS_ROUTE + RT_TILE); int* ntl = (int*)(C.ws + WS_ROUTE + RT_NT);
    unsigned* cnt = (unsigned*)(C.ws + WS_CTL) + CW_CNT + 64 * layer;
    const int mycnt = (C.lane < 32) ? (int)__hip_atomic_load(cnt + C.lane, __ATOMIC_RELAXED, __HIP_MEMORY_SCOPE_AGENT) : 0;
    const int mypad = (mycnt + 255) & ~255;
    int incl = mypad;
#pragma unroll
    for (int o = 1; o < 32; o <<= 1) { const int t = __shfl_up(incl, o); if ((C.lane & 31) >= o) incl += t; }
    const int ps = incl - mypad;
    for (int it = C.gw; it < nrows * 2; it += C.ngw) {
        const int e = asg_e[it], p = asg_p[it]; const int slot = __shfl(ps, e) + p;
        if (C.lane == 0) asg_s[it] = slot;
        const v4u* src = (const v4u*)(F + (size_t)(it >> 1) * D); v4u* dst = (v4u*)(XS + (size_t)slot * D);
        dst[C.lane] = src[C.lane]; dst[64 + C.lane] = src[64 + C.lane];
    }
    for (int e = C.gw; e < 33; e += C.ngw) {
        if (e < 32) { const int c0 = __shfl(mycnt, e), c1 = __shfl(mypad, e), base = __shfl(ps, e);
            for (int rr = c0; rr < c1; ++rr) { v4u* dst = (v4u*)(XS + (size_t)(base + rr) * D); const v4u z = {0u, 0u, 0u, 0u}; dst[C.lane] = z; dst[64 + C.lane] = z; } }
        else { if (C.lane < 32) { for (int t = ps / 256; t < (ps + mypad) / 256; ++t) tile_e[t] = C.lane; if (C.lane == 31) *ntl = (ps + mypad) / 256; } }
    }
}
__device__ __forceinline__ void moe_combine(const Ctx& C, int layer, int r, f32x4 (&v)[4]) {
    const bf16* Y2 = (const bf16*)(C.ws + WS_XS); const int* asg_s = (const int*)(C.ws + WS_ROUTE + RT_S); const float* asg_w = (const float*)(C.ws + WS_ROUTE + RT_W);
    const float* XC = (const float*)(C.ws + WS_XC);
    load_row16(XC + (size_t)r * D, C.lane, v);
    const int s0 = asg_s[2 * r], s1 = asg_s[2 * r + 1]; const float w0 = asg_w[2 * r], w1 = asg_w[2 * r + 1];
    const float* gate = mod_vec(C, layer, cond_of(r), 5);
#pragma unroll
    for (int j = 0; j < 4; ++j) { const int c = 4 * C.lane + 256 * j; const v2u a = *(const v2u*)(Y2 + (size_t)s0 * D + c), b = *(const v2u*)(Y2 + (size_t)s1 * D + c); const f32x4 g = *(const f32x4*)(gate + c);
        v[j].x += g.x * (w0 * bf2f(a.x & 0xffffu) + w1 * bf2f(b.x & 0xffffu)); v[j].y += g.y * (w0 * bf2f(a.x >> 16) + w1 * bf2f(b.x >> 16));
        v[j].z += g.z * (w0 * bf2f(a.y & 0xffffu) + w1 * bf2f(b.y & 0xffffu)); v[j].w += g.w * (w0 * bf2f(a.y >> 16) + w1 * bf2f(b.y >> 16)); }
}
__device__ __forceinline__ void phase_combine_norm_mix1(const Ctx& C) {
    const Params& P = *C.p; float* XC = (float*)(C.ws + WS_XC); bf16* H = (bf16*)(C.ws + WS_H);
    for (int r = C.gw; r < TT; r += C.ngw) {
        f32x4 v[4]; moe_combine(C, 0, r, v);
#pragma unroll
        for (int j = 0; j < 4; ++j) *(f32x4*)(XC + (size_t)r * D + 4 * C.lane + 256 * j) = v[j];
        const float rstd = row_rstd(v); const int ci = cond_of(r);
        modulate16(v, rstd, P.in[I_GMIX] + D, mod_vec(C, 1, ci, 1), mod_vec(C, 1, ci, 0), C.lane);
        store_row16_bf16(H + (size_t)r * D, C.lane, v);
    }
    LAS float* scr = (LAS float*)(C.lds + C.wave * 16384);
    for (int it = C.gw; it < MOE_ITEMS; it += C.ngw) moe_convert_item(C, 1, it, scr);
}
__device__ __forceinline__ void phase_final(const Ctx& C) {
    const Params& P = *C.p;
    for (int r = C.gw; r < TL; r += C.ngw) {
        f32x4 v[4]; moe_combine(C, 1, r, v);
        const float rstd = row_rstd(v);
#pragma unroll
        for (int j = 0; j < 4; ++j) { const int c = 4 * C.lane + 256 * j; const f32x4 g = *(const f32x4*)(P.in[I_FING] + c); *(f32x4*)(P.out + (size_t)r * D + c) = v[j] * rstd * g; }
    }
}

__device__ __forceinline__ void phase_s5(const Ctx& C) {
    const Params& P = *C.p; const bf16* U = (const bf16*)(C.ws + WS_U); bf16* GS = (bf16*)(C.ws + WS_GS); float* YA = (float*)(C.ws + WS_YACC);
    const float2* lamb = (const float2*)(C.ws + WS_TAB + TAB_LAMB); const float2* bbar = (const float2*)(C.ws + WS_TAB + TAB_BBAR);
    LAS f32x2* hb = (LAS f32x2*)(C.lds + C.wave * 8192);
    const int lane = C.lane;
    for (int it = C.gw; it < NB * 32; it += C.ngw) {
        const int b = it >> 5, g = it & 31;
        for (int dir = 0; dir < 2; ++dir) {
            const int dgn = ((dir * 32 + g) * 64 + lane);
            const float2 lam = lamb[dgn]; float2 bb[16];
#pragma unroll
            for (int p = 0; p < 16; ++p) bb[p] = bbar[(size_t)dgn * 16 + p];
            const float* cre = P.in[I_CRE] + (size_t)(dir * 32 + g) * 16 * 64; const float* cim = P.in[I_CIM] + (size_t)(dir * 32 + g) * 16 * 64;
            float hr = 0.f, hi = 0.f;
            for (int ck = 0; ck < 144; ++ck) {
                const bool isl = ck >= 16;
                const int tb = isl ? (dir == 0 ? (ck - 16) * 16 : (143 - ck) * 16) : (dir == 0 ? ck * 16 : (15 - ck) * 16);
                const size_t rowb = isl ? (size_t)b * SEQ + tb : (size_t)TL + (size_t)b * CTXL + tb;
                for (int sl = 0; sl < 16; ++sl) {
                    const int to = dir == 0 ? sl : 15 - sl;
                    const bf16* ur = U + (rowb + to) * 512 + g * 16; float uf[16]; unpack8(*(const v4u*)ur, uf); unpack8(*(const v4u*)(ur + 8), uf + 8);
                    float br = 0.f, bi = 0.f;
#pragma unroll
                    for (int p = 0; p < 16; ++p) { br += bb[p].x * uf[p]; bi += bb[p].y * uf[p]; }
                    const float nr = lam.x * hr - lam.y * hi + br, ni = lam.x * hi + lam.y * hr + bi; hr = nr; hi = ni;
                    if (isl) hb[to * 64 + lane] = (f32x2){hr, hi};
                }
                if (isl) {
                    asm volatile("s_waitcnt lgkmcnt(0)" ::: "memory");
                    const int p = lane & 15;
#pragma unroll
                    for (int i = 0; i < 4; ++i) { const int to = (lane >> 4) + 4 * i; float y = 0.f;
                        for (int n = 0; n < 64; ++n) { const f32x2 h = hb[to * 64 + n]; y += cre[p * 64 + n] * h.x - cim[p * 64 + n] * h.y; }
                        const size_t o = (rowb + to) * 512 + g * 16 + p;
                        if (dir == 0) YA[o] = y + P.in[I_S5D][g * 16 + p] * bf2f(U[o]);
                        else GS[o] = (bf16)f2bf(gelu_tanh(YA[o] + y)); }
                    asm volatile("s_waitcnt lgkmcnt(0)" ::: "memory");
                }
            }
        }
    }
}

__global__ void __launch_bounds__(NTHR, 2) fwd_kernel(Params prm) {
    extern __shared__ __attribute__((aligned(16))) unsigned char lds_raw[];
    Ctx C; C.p = &prm; C.ws = prm.ws; C.lds = (LAS unsigned char*)lds_raw;
    C.tid = threadIdx.x; C.lane = C.tid & 63; C.wave = __builtin_amdgcn_readfirstlane(C.tid >> 6);
    C.gw = blockIdx.x * NWAVE + C.wave; C.ngw = gridDim.x * NWAVE;
    constexpr int LDS_MISC = 147456 - 256;
    volatile LAS unsigned* misc = (volatile LAS unsigned*)(C.lds + LDS_MISC);
    if (C.tid < 64) misc[C.tid] = 0u;
    __syncthreads();
    unsigned* ctl = (unsigned*)(C.ws + WS_CTL);
    XcdBarrier bar; bar.bar = ctl + CW_BAR; bar.x = 0; bar.st = nullptr;
#if MK_ONE_LAUNCH
    bar = xcd_barrier_post(ctl + CW_BAR, misc + 8);
#define SEAM(k) do { if (lo <= (k) && (k) + 1 < hi) xcd_barrier(bar); } while (0)
#else
#define SEAM(k) do { } while (0)
#endif
    const int lo = prm.ph_lo, hi = prm.ph_hi;
#define IN(k) (lo <= (k) && (k) < hi)
    const Params& P = prm;
    bf16* Hb = (bf16*)(C.ws + WS_H); float* XC = (float*)(C.ws + WS_XC);
#define MOE_GEMM1() do { const int ntl_ = *(const int*)(C.ws + WS_ROUTE + RT_NT); pg8::Gemm g{(const bf16*)(C.ws + WS_XS), (const bf16*)(C.ws + WS_W13), 0, 1024, D}; \
        pg8::GroupedOrder S{(const int*)(C.ws + WS_ROUTE + RT_TILE), ntl_ * 4, 4, (int)gridDim.x, (int)blockIdx.x, (size_t)1024 * 1024 * 2}; pg8::EpiSwiglu E{(bf16*)(C.ws + WS_G13)}; \
        pg8::gemm_phase<pg8::EpiSwiglu, pg8::GroupedOrder, true, true>(C.lds, g, S, E); } while (0)
#define MOE_GEMM2() do { const int ntl_ = *(const int*)(C.ws + WS_ROUTE + RT_NT); pg8::Gemm g{(const bf16*)(C.ws + WS_G13), (const bf16*)(C.ws + WS_W2), 0, 1024, EH}; \
        pg8::GroupedOrder S{(const int*)(C.ws + WS_ROUTE + RT_TILE), ntl_ * 4, 4, (int)gridDim.x, (int)blockIdx.x, (size_t)1024 * 512 * 2}; pg8::EpiStore E{(bf16*)(C.ws + WS_XS), D}; \
        pg8::gemm_phase<pg8::EpiStore, pg8::GroupedOrder, true, true>(C.lds, g, S, E); } while (0)
    if (IN(0)) { phase_prologue(C); SEAM(0); }
    if (IN(1)) { phase_norm_mix0(C); SEAM(1); }
    if (IN(2)) { pg8::Gemm g{Hb, (const bf16*)(C.ws + WS_WIN0), TT, MIXW, D}; pg8::StaticOrder S; S.init(TT, MIXW, gridDim.x, blockIdx.x); pg8::EpiStore E{(bf16*)(C.ws + WS_P), MIXW};
        pg8::gemm_phase<pg8::EpiStore, pg8::StaticOrder, true, true>(C.lds, g, S, E); SEAM(2); }
    if (IN(3)) { phase_qkprep(C); phase_gmlp(C); SEAM(3); }
    if (IN(4)) { phase_attn(C); SEAM(4); }
    if (IN(5)) { pg8::Gemm g{Hb, (const bf16*)(C.ws + WS_WOUT0), TT, D, D}; pg8::StaticOrder S; S.init(TT, D, gridDim.x, blockIdx.x); pg8::EpiResid E{P.in[I_X], P.in[I_CTX], (const float*)(C.ws + WS_MOD), XC, 0};
        pg8::gemm_phase<pg8::EpiResid, pg8::StaticOrder, true, true>(C.lds, g, S, E); SEAM(5); }
    if (IN(6)) { phase_norm_ffn_router(C, 0, TT); SEAM(6); }
    if (IN(7)) { phase_gather(C, 0, TT); SEAM(7); }
    if (IN(8)) { MOE_GEMM1(); SEAM(8); }
    if (IN(9)) { MOE_GEMM2(); SEAM(9); }
    if (IN(10)) { phase_combine_norm_mix1(C); SEAM(10); }
    if (IN(11)) { pg8::Gemm g{Hb, (const bf16*)(C.ws + WS_WS5IN), TT, 512, D}; pg8::StaticOrder S; S.init(TT, 512, gridDim.x, blockIdx.x); pg8::EpiStore E{(bf16*)(C.ws + WS_U), 512};
        pg8::gemm_phase<pg8::EpiStore, pg8::StaticOrder, true, true>(C.lds, g, S, E); SEAM(11); }
    if (IN(12)) { phase_s5(C); SEAM(12); }
    if (IN(13)) { pg8::Gemm g{(const bf16*)(C.ws + WS_GS), (const bf16*)(C.ws + WS_WGLU), TL, 512, 512}; pg8::StaticOrder S; S.init(TL, 512, gridDim.x, blockIdx.x); pg8::EpiGlu E{(const bf16*)(C.ws + WS_GS), P.in[I_BGLU], (bf16*)(C.ws + WS_GG)};
        pg8::gemm_phase<pg8::EpiGlu, pg8::StaticOrder, true, true>(C.lds, g, S, E); SEAM(13); }
    if (IN(14)) { pg8::Gemm g{(const bf16*)(C.ws + WS_GG), (const bf16*)(C.ws + WS_WS5OUT), TL, D, 512}; pg8::StaticOrder S; S.init(TL, D, gridDim.x, blockIdx.x); pg8::EpiResid E{P.in[I_X], P.in[I_CTX], (const float*)(C.ws + WS_MOD) + (size_t)17 * 6 * D, XC, 1};
        pg8::gemm_phase<pg8::EpiResid, pg8::StaticOrder, true, true>(C.lds, g, S, E); SEAM(14); }
    if (IN(15)) { phase_norm_ffn_router(C, 1, TL); SEAM(15); }
    if (IN(16)) { phase_gather(C, 1, TL); SEAM(16); }
    if (IN(17)) { MOE_GEMM1(); SEAM(17); }
    if (IN(18)) { MOE_GEMM2(); SEAM(18); }
    if (IN(19)) { phase_final(C); }
#undef IN
#undef SEAM
}

extern "C" void kernel_launch(void* const* d_in, const int* in_sizes, int n_in, void* d_out, int out_size, void* d_ws, size_t ws_size, hipStream_t stream) {
    constexpr int LDS_BYTES = 147456;
    static int grid = 0;
    if (grid == 0) {
        if (n_in != 35 || out_size != TL * D || ws_size < WS_END) { fprintf(stderr, "kernel_launch: unexpected shapes (n_in %d out %d ws %zu)\n", n_in, out_size, ws_size); grid = -1; return; }
        int dev = 0, cus = 0;
        if (hipGetDevice(&dev) != hipSuccess || hipDeviceGetAttribute(&cus, hipDeviceAttributeMultiprocessorCount, dev) != hipSuccess) { grid = -1; return; }
        if (hipFuncSetAttribute((const void*)fwd_kernel, hipFuncAttributeMaxDynamicSharedMemorySize, LDS_BYTES) != hipSuccess) { fprintf(stderr, "kernel_launch: hipFuncSetAttribute failed\n"); grid = -1; return; }
        (void)hipGetLastError();
        grid = cus;
    }
    if (grid < 0) return;
    (void)hipMemsetAsync((char*)d_ws + WS_CTL, 0, CTL_BYTES, stream);
    Params p{};
    for (int i = 0; i < 35; ++i) p.in[i] = (const float*)d_in[i];
    p.out = (float*)d_out; p.ws = (unsigned char*)d_ws;
#if MK_ONE_LAUNCH
    p.ph_lo = 0; p.ph_hi = NPHASE;
    hipLaunchKernelGGL(fwd_kernel, dim3(grid), dim3(NTHR), LDS_BYTES, stream, p);
#else
    for (int k = 0; k < NPHASE; ++k) { p.ph_lo = k; p.ph_hi = k + 1; hipLaunchKernelGGL(fwd_kernel, dim3(grid), dim3(NTHR), LDS_BYTES, stream, p); }
#endif
}
```

```cpp
#include <hip/hip_runtime.h>
#include <cstdio>
#include <cstdint>

#ifndef MK_ONE_LAUNCH
#define MK_ONE_LAUNCH 1
#endif

constexpr int D = 1024, NB = 16, SEQ = 2048, CTXL = 256;
constexpr int TL = NB * SEQ, TC = NB * CTXL, TT = TL + TC;
constexpr int KVL = CTXL + SEQ;
constexpr int MIXW = 1792, NEXP = 32, EH = 512;
constexpr int NSLOT = 81920;
constexpr float EPS = 1e-6f;
constexpr float QSCALE = 0.125f * 1.4426950408889634f;
constexpr int NTHR = 512, NWAVE = 8;
constexpr int NPHASE = 20;

constexpr size_t MiB = 1u << 20;
constexpr size_t WS_CTL = 0, CTL_BYTES = 1 * MiB;
constexpr size_t WS_MOD = 1 * MiB;
constexpr size_t WS_TAB = 2 * MiB;
constexpr size_t TAB_ROPE = 0, TAB_LAMB = 16384, TAB_BBAR = 65536;
constexpr size_t WS_ROUTE = 3 * MiB;
constexpr size_t RT_E = 0, RT_P = 320 * 1024, RT_W = 640 * 1024, RT_S = 960 * 1024, RT_TILE = 1280 * 1024, RT_NT = 1280 * 1024 + 4096;
constexpr size_t WS_WIN0 = 6 * MiB, WS_WOUT0 = 10 * MiB, WS_WS5IN = 12 * MiB, WS_WGLU = 13 * MiB, WS_WS5OUT = 14 * MiB;
constexpr size_t WS_W13 = 16 * MiB, WS_W2 = 80 * MiB;
constexpr size_t WS_XC = 112 * MiB;
constexpr size_t WS_H = 256 * MiB;
constexpr size_t WS_P = 328 * MiB;
constexpr size_t WS_Q = 454 * MiB, WS_K = 490 * MiB, WS_V = 499 * MiB;
constexpr size_t WS_XS = 328 * MiB;
constexpr size_t WS_G13 = 488 * MiB;
constexpr size_t WS_U = 328 * MiB, WS_GS = 364 * MiB, WS_GG = 396 * MiB, WS_YACC = 428 * MiB;
constexpr size_t WS_END = 568 * MiB;
constexpr int CW_CNT = 64;
constexpr int CW_BAR = 4096;

#define LAS __attribute__((address_space(3)))
typedef unsigned short bf16;
typedef unsigned v4u __attribute__((ext_vector_type(4)));
typedef unsigned v2u __attribute__((ext_vector_type(2)));
typedef float f32x4 __attribute__((ext_vector_type(4)));
typedef float f32x2 __attribute__((ext_vector_type(2)));
__device__ __forceinline__ float bf2f(unsigned u) { return __uint_as_float(u << 16); }
__device__ __forceinline__ unsigned f2bf(float f) { unsigned u = __float_as_uint(f); return (u + 0x7fffu + ((u >> 16) & 1u)) >> 16; }
__device__ __forceinline__ unsigned pk2(float lo, float hi) { return f2bf(lo) | (f2bf(hi) << 16); }
__device__ __forceinline__ float wave_sum(float v) {
#pragma unroll
    for (int o = 1; o < 64; o <<= 1) v += __shfl_xor(v, o);
    return v;
}
__device__ __forceinline__ float wave_max(float v) {
#pragma unroll
    for (int o = 1; o < 64; o <<= 1) v = fmaxf(v, __shfl_xor(v, o));
    return v;
}
__device__ __forceinline__ float gelu_tanh(float x) { const float u = 0.7978845608028654f * (x + 0.044715f * x * x * x); return 0.5f * x * (1.f + tanhf(u)); }
__device__ __forceinline__ float sigmoidf_(float x) { return 1.f / (1.f + __expf(-x)); }
__device__ __forceinline__ float silu_(float x) { return x / (1.f + __expf(-x)); }
__device__ __forceinline__ void unpack8(const v4u w, float* f) {
    f[0] = bf2f(w.x & 0xffffu); f[1] = bf2f(w.x >> 16); f[2] = bf2f(w.y & 0xffffu); f[3] = bf2f(w.y >> 16);
    f[4] = bf2f(w.z & 0xffffu); f[5] = bf2f(w.z >> 16); f[6] = bf2f(w.w & 0xffffu); f[7] = bf2f(w.w >> 16);
}

#define XB_TMO      128
#define XB_XCNT(j)  (256  + 64 * (j))
#define XB_XSUB(j)  (1280 + 64 * (j))
#define XB_XGEN(j)  (2304 + 64 * (j))
#define XB_TOP      3328
#define XB_TOPGEN   3392
#define XCD_BAR_WORDS 3456
#define XB_SPIN_CAP (1u << 28)
__device__ __forceinline__ unsigned xb_ld(unsigned* p)              { return __hip_atomic_load(p, __ATOMIC_RELAXED, __HIP_MEMORY_SCOPE_AGENT); }
__device__ __forceinline__ unsigned xb_add(unsigned* p, unsigned v) { return __hip_atomic_fetch_add(p, v, __ATOMIC_RELAXED, __HIP_MEMORY_SCOPE_AGENT); }
__device__ __forceinline__ unsigned xb_xcc_id() { return (unsigned)__builtin_amdgcn_s_getreg((3 << 11) | 20) & 0xFu; }
#define XB_SPIN(cond, bar) do { unsigned _sp = 0; while (cond) { __builtin_amdgcn_s_sleep(1); \
    if ((++_sp & 255u) == 0u) { if (xb_ld(&(bar)[XB_TMO])) break; if (_sp > XB_SPIN_CAP) { atomicAdd(&(bar)[XB_TMO], 1u); break; } } } } while (0)
struct XcdBarrier { unsigned* bar; unsigned x; volatile LAS unsigned* st; };
__device__ __forceinline__ XcdBarrier xcd_barrier_post(unsigned* bar, volatile LAS unsigned* st) {
    XcdBarrier b; b.bar = bar; b.x = xb_xcc_id(); b.st = st;
    if (threadIdx.x == 0) (void)xb_add(&bar[XB_XCNT(b.x)], 1u);
    return b;
}
__device__ __forceinline__ void xcd_barrier_complete(unsigned* bar, unsigned x, unsigned& nloc, unsigned& nx) {
    const unsigned G = gridDim.x * gridDim.y * gridDim.z;
    unsigned sum, cnt, mine, sp = 0u;
    for (;;) {
        sum = 0u; cnt = 0u; mine = 0u;
#pragma unroll
        for (unsigned j = 0; j < 16; ++j) { const unsigned c = xb_ld(&bar[XB_XCNT(j)]); sum += c; cnt += (c > 0u) ? 1u : 0u; mine = (j == x) ? c : mine; }
        if (sum == G) break;
        __builtin_amdgcn_s_sleep(1);
        if ((++sp & 255u) == 0u) { if (xb_ld(&bar[XB_TMO])) break; if (sp > XB_SPIN_CAP) { atomicAdd(&bar[XB_TMO], 1u); break; } }
    }
    nloc = mine > 0u ? mine : 1u; nx = cnt > 0u ? cnt : 1u;
}
__device__ __forceinline__ void xcd_barrier(const XcdBarrier& b) {
    asm volatile("s_waitcnt vmcnt(0)" ::: "memory");
    __syncthreads();
    if (threadIdx.x == 0) {
        unsigned* bar = b.bar;
        __builtin_amdgcn_s_waitcnt(0);
        unsigned nloc = b.st[0], nx = b.st[1];
        if (nloc == 0u) { xcd_barrier_complete(bar, b.x, nloc, nx); b.st[0] = nloc; b.st[1] = nx; }
        const unsigned old = xb_add(&bar[XB_XSUB(b.x)], 1u);
        const unsigned gen = old / nloc;
        if (old + 1u == (gen + 1u) * nloc) {
            __builtin_amdgcn_fence(__ATOMIC_RELEASE, "agent");
            asm volatile("s_waitcnt vmcnt(0)" ::: "memory");
            const unsigned og = xb_add(&bar[XB_TOP], 1u);
            const unsigned tg = og / nx;
            if (og + 1u == (tg + 1u) * nx) xb_add(&bar[XB_TOPGEN], 1u);
            else XB_SPIN(xb_ld(&bar[XB_TOPGEN]) == tg, bar);
            __builtin_amdgcn_fence(__ATOMIC_ACQUIRE, "agent");
            xb_add(&bar[XB_XGEN(b.x)], 1u);
            asm volatile("s_waitcnt vmcnt(0)" ::: "memory");
        } else {
            XB_SPIN(xb_ld(&bar[XB_XGEN(b.x)]) == gen, bar);
            __builtin_amdgcn_fence(__ATOMIC_ACQUIRE, "agent");
            asm volatile("s_waitcnt vmcnt(0)" ::: "memory");
        }
    }
    __syncthreads();
}

namespace pg8 {
#define PG8_LAS __attribute__((address_space(3)))
typedef unsigned short bf16_t;
typedef short bf16x8 __attribute__((ext_vector_type(8)));
typedef float f32x4 __attribute__((ext_vector_type(4)));
typedef unsigned u32x4 __attribute__((ext_vector_type(4)));
constexpr int BM = 256, BK = 64, HALF = 128, HTB = HALF * BK * 2  , STAGE_BYTES = 8 * HTB, NXCD = 8, WGM = 8;

__host__ __device__ __forceinline__ int lds_byte(int r, int c) { const int st = (r >> 4) * 2 + (c >> 5), rr = r & 15, cc = c & 31, ob = rr * 64 + cc * 2; return st * 1024 + (ob ^ (((ob >> 9) & 1) << 5)); }
__host__ __device__ __forceinline__ void stage_rc(int b, int& R, int& C) { const int st = b / 1024, sb = b % 1024, swz = sb ^ (((sb >> 9) & 1) << 5); R = (st >> 1) * 16 + swz / 64; C = (st & 1) * 32 + (swz % 64) / 2; }
__host__ __device__ __forceinline__ int perm32(int rho) { const int n = rho >> 4, i = rho & 15; return 8 * (i >> 2) + 4 * n + (i & 3); }

struct Unit { int pm, pn; size_t bo; };
struct Gemm { const bf16_t* A; const bf16_t* Bt; int M, N, K; };

struct StaticOrder {
    int nM, nN, nwg, G, c;
    __host__ __device__ void init(int M, int N, int G_, int c_) { nM = M / BM; nN = N / BM; nwg = nM * nN; G = G_; c = c_; }
    __host__ __device__ bool next(int i, Unit& u) const {
        const long L = (long)i * G + c; if (L >= nwg) return false;
        int wgid = (int)L; { const int q = nwg / NXCD, r = nwg % NXCD, xcd = wgid % NXCD, off = wgid / NXCD; wgid = (xcd < r ? xcd * (q + 1) : r * (q + 1) + (xcd - r) * q) + off; }
        const int nig = WGM * nN, gid = wgid / nig, fm = gid * WGM, gsz = (nM - fm) < WGM ? (nM - fm) : WGM;
        u.pm = fm + ((wgid % nig) % gsz); u.pn = (wgid % nig) / gsz; u.bo = 0; return true;
    }
    __device__ __forceinline__ void a_ready(const Unit&) const {}
    __device__ __forceinline__ void done(const Unit&) const {}
};

__device__ __forceinline__ unsigned cvt_pk_bf16(float lo, float hi) { unsigned r; asm volatile("v_cvt_pk_bf16_f32 %0, %1, %2" : "=v"(r) : "v"(lo), "v"(hi)); return r; }
typedef float f32x2 __attribute__((ext_vector_type(2)));
__device__ __forceinline__ f32x2 gelu_pk(f32x2 v) {
    const f32x2 av = __builtin_elementwise_abs(v), d = av * 0.2316418882f + 1.0f;
    f32x2 t; t.x = __builtin_amdgcn_rcpf(d.x); t.y = __builtin_amdgcn_rcpf(d.y);
    f32x2 q = t * 0.5307027145f + (-0.7265760135f); q = q * t + 0.7107068705f; q = q * t + (-0.142248368f); q = q * t + 0.127414796f; q = q * t;
    const f32x2 s = (v * v) * (-0.72134752044f);
    f32x2 e; e.x = __builtin_amdgcn_exp2f(s.x); e.y = __builtin_amdgcn_exp2f(s.y);
    const f32x2 m = v * (q * e), r = v - m;
    f32x2 o; o.x = v.x < 0.f ? m.x : r.x; o.y = v.y < 0.f ? m.y : r.y; return o;
}

template <class Epi, class Sched, bool ALIGN_EPI = false, bool SP2 = false>
__device__ __forceinline__ void gemm_phase(PG8_LAS unsigned char* lds, const Gemm g, const Sched& S, const Epi& E) {
    const int tid = threadIdx.x, wid = __builtin_amdgcn_readfirstlane(tid >> 6), lane = tid & 63, wr = wid >> 2, wc = wid & 3, fr = lane & 15, fq = lane >> 4;
    const int K = g.K, nt = K / BK;
    unsigned voffA[2], voffB[2];
#pragma unroll
    for (int i = 0; i < 2; ++i) { int R, C; stage_rc(tid * 16 + i * 8192, R, C); const int Rb = Epi::PERM ? ((R & ~31) + perm32(R & 31)) : R;
        voffA[i] = (unsigned)(R * K + C) * 2u; voffB[i] = (unsigned)(Rb * K + C) * 2u; }
    const size_t kstep = (size_t)(BK * 2);
    const size_t hstep = (size_t)HALF * K * 2;
    const size_t tstep = 2 * hstep;
    const unsigned ldsw = (unsigned)wid * 1024u;
    const int aoff = lds_byte(wr * 64 + fr, fq * 8), boff = lds_byte(wc * 32 + fr, fq * 8);
#define PG8_SA(b, h) (((b) * 2 + (h)) * HTB)
#define PG8_SB(b, h) ((4 + (b) * 2 + (h)) * HTB)
#define PG8_STAGE(bufoff, gbase, voff) do { _Pragma("unroll") for (int _i = 0; _i < 2; ++_i) \
        __builtin_amdgcn_global_load_lds((const unsigned*)((const char*)(gbase) + (voff)[_i]), (PG8_LAS unsigned*)(lds + (bufoff) + ldsw + _i * 8192), 16, 0, 0); } while (0)
#define PG8_LDA(dst, b, h) do { _Pragma("unroll") for (int m = 0; m < 4; ++m) _Pragma("unroll") for (int k = 0; k < 2; ++k) dst[m][k] = *(const PG8_LAS bf16x8*)(lds + PG8_SA(b, h) + aoff + m * 2048 + k * 1024); } while (0)
#define PG8_LDB(dst, b, h) do { _Pragma("unroll") for (int n = 0; n < 2; ++n) _Pragma("unroll") for (int k = 0; k < 2; ++k) dst[n][k] = *(const PG8_LAS bf16x8*)(lds + PG8_SB(b, h) + boff + n * 2048 + k * 1024); } while (0)
#define PG8_MMA(ai, bj, At, Bt) do { __builtin_amdgcn_s_setprio(1); _Pragma("unroll") for (int m = 0; m < 4; ++m) _Pragma("unroll") for (int n = 0; n < 2; ++n) _Pragma("unroll") for (int k = 0; k < 2; ++k) \
        acc[ai][bj][m][n] = __builtin_amdgcn_mfma_f32_16x16x32_bf16(Bt[n][k], At[m][k], acc[ai][bj][m][n], 0, 0, 0); __builtin_amdgcn_s_setprio(0); } while (0)
#define PG8_WAIT_V(n) asm volatile("s_waitcnt vmcnt(" #n ")" ::: "memory")
#define PG8_WAIT_L(n) asm volatile("s_waitcnt lgkmcnt(" #n ")" ::: "memory")
#define PG8_BAR __builtin_amdgcn_s_barrier()
#define PG8_SCHED __builtin_amdgcn_sched_barrier(0)
    Unit cur, nxt; int ui = 0;
    if (!S.next(0, cur)) return;
    f32x4 acc[2][2][4][2];
#pragma unroll
    for (int a = 0; a < 2; ++a)
#pragma unroll
        for (int b = 0; b < 2; ++b)
#pragma unroll
            for (int m = 0; m < 4; ++m)
#pragma unroll
                for (int n = 0; n < 2; ++n) acc[a][b][m][n] = (f32x4){0.f, 0.f, 0.f, 0.f};
    bf16x8 At[4][2], B0[2][2], B1[2][2];
    const char* cA = (const char*)g.A + (size_t)cur.pm * tstep; const char* cB = (const char*)g.Bt + cur.bo + (size_t)cur.pn * tstep;
    S.a_ready(cur);
    if constexpr (SP2) {
        PG8_STAGE(PG8_SB(0, 0), cB, voffB); PG8_STAGE(PG8_SB(0, 1), cB + hstep, voffB); PG8_STAGE(PG8_SA(0, 0), cA, voffA); PG8_STAGE(PG8_SA(0, 1), cA + hstep, voffA);
        if (wr == 1) PG8_BAR;
        PG8_WAIT_V(2); PG8_BAR;
        PG8_STAGE(PG8_SB(1, 0), cB + kstep, voffB); PG8_STAGE(PG8_SA(1, 0), cA + kstep, voffA); PG8_STAGE(PG8_SB(1, 1), cB + hstep + kstep, voffB);
        PG8_WAIT_V(6); PG8_BAR;
    } else {
        PG8_STAGE(PG8_SB(0, 0), cB, voffB); PG8_STAGE(PG8_SA(0, 0), cA, voffA); PG8_STAGE(PG8_SB(0, 1), cB + hstep, voffB); PG8_STAGE(PG8_SA(0, 1), cA + hstep, voffA);
        if (wr == 1) PG8_BAR;
        PG8_WAIT_V(4); PG8_BAR;
        PG8_STAGE(PG8_SB(1, 0), cB + kstep, voffB); PG8_STAGE(PG8_SA(1, 0), cA + kstep, voffA); PG8_STAGE(PG8_SB(1, 1), cB + hstep + kstep, voffB);
        PG8_WAIT_V(6); PG8_BAR;
    }
    for (;;) {
        const bool has_next = S.next(ui + 1, nxt);
        const char* nA = has_next ? (const char*)g.A + (size_t)nxt.pm * tstep : cA; const char* nB = has_next ? (const char*)g.Bt + nxt.bo + (size_t)nxt.pn * tstep : cB;
        for (int t = 0; t < nt; t += 2) {
            const bool last = (t == nt - 2);
            const char* a1 = cA + (size_t)(t + 1) * kstep;
            const char* a2 = last ? nA : cA + (size_t)(t + 2) * kstep; const char* b2 = last ? nB : cB + (size_t)(t + 2) * kstep;
            const char* a3 = a2 + kstep; const char* b3 = b2 + kstep;
            if (last && has_next) S.a_ready(nxt);
            if constexpr (SP2) {
            PG8_LDB(B0, 0, 0); PG8_LDB(B1, 0, 1); PG8_SCHED; PG8_LDA(At, 0, 0); PG8_STAGE(PG8_SA(1, 1), a1 + hstep, voffA);
            PG8_WAIT_V(8); PG8_WAIT_L(0); PG8_BAR; PG8_MMA(0, 0, At, B0); PG8_MMA(0, 1, At, B1); PG8_BAR; PG8_SCHED;
            PG8_LDA(At, 0, 1); PG8_STAGE(PG8_SB(0, 0), b2, voffB); PG8_STAGE(PG8_SB(0, 1), b2 + hstep, voffB); PG8_STAGE(PG8_SA(0, 0), a2, voffA);
            PG8_WAIT_V(8); PG8_WAIT_L(0); PG8_BAR; PG8_MMA(1, 0, At, B0); PG8_MMA(1, 1, At, B1); PG8_BAR; PG8_SCHED;
            PG8_LDB(B0, 1, 0); PG8_LDB(B1, 1, 1); PG8_SCHED; PG8_LDA(At, 1, 0); PG8_STAGE(PG8_SA(0, 1), a2 + hstep, voffA);
            PG8_WAIT_V(8); PG8_WAIT_L(0); PG8_BAR; PG8_MMA(0, 0, At, B0); PG8_MMA(0, 1, At, B1); PG8_BAR; PG8_SCHED;
            PG8_LDA(At, 1, 1); PG8_STAGE(PG8_SB(1, 0), b3, voffB); PG8_STAGE(PG8_SB(1, 1), b3 + hstep, voffB); PG8_STAGE(PG8_SA(1, 0), a3, voffA);
            PG8_WAIT_V(8); PG8_WAIT_L(0); PG8_BAR; PG8_MMA(1, 0, At, B0); PG8_MMA(1, 1, At, B1); PG8_BAR; PG8_SCHED;
            } else {
            PG8_LDB(B0, 0, 0); PG8_SCHED; PG8_LDA(At, 0, 0); PG8_STAGE(PG8_SA(1, 1), a1 + hstep, voffA);
            PG8_WAIT_L(8); PG8_BAR; PG8_WAIT_L(0); PG8_MMA(0, 0, At, B0); PG8_BAR; PG8_SCHED;
            PG8_LDB(B1, 0, 1); PG8_STAGE(PG8_SB(0, 0), b2, voffB);
            PG8_BAR; PG8_WAIT_L(0); PG8_MMA(0, 1, At, B1); PG8_BAR;
            PG8_LDA(At, 0, 1); PG8_STAGE(PG8_SA(0, 0), a2, voffA);
            PG8_BAR; PG8_WAIT_L(0); PG8_MMA(1, 0, At, B0); PG8_BAR; PG8_SCHED;
            PG8_STAGE(PG8_SB(0, 1), b2 + hstep, voffB);
            PG8_WAIT_V(6); PG8_BAR; PG8_MMA(1, 1, At, B1); PG8_BAR;
            PG8_LDB(B0, 1, 0); PG8_SCHED; PG8_LDA(At, 1, 0); PG8_STAGE(PG8_SA(0, 1), a2 + hstep, voffA);
            PG8_WAIT_L(8); PG8_BAR; PG8_WAIT_L(0); PG8_MMA(0, 0, At, B0); PG8_BAR; PG8_SCHED;
            PG8_LDB(B1, 1, 1); PG8_STAGE(PG8_SB(1, 0), b3, voffB);
            PG8_BAR; PG8_WAIT_L(0); PG8_MMA(0, 1, At, B1); PG8_BAR;
            PG8_LDA(At, 1, 1); PG8_STAGE(PG8_SA(1, 0), a3, voffA);
            PG8_BAR; PG8_WAIT_L(0); PG8_MMA(1, 0, At, B0); PG8_BAR; PG8_SCHED;
            PG8_STAGE(PG8_SB(1, 1), b3 + hstep, voffB);
            PG8_WAIT_V(6); PG8_BAR; PG8_MMA(1, 1, At, B1); PG8_BAR;
            }
        }
        if constexpr (ALIGN_EPI) { if (wr == 0) PG8_BAR; }
        if constexpr (!Epi::AFTER_DRAIN) { E(acc, cur, wr, wc, fr, fq); S.done(cur); }
        if (!has_next) break;
#pragma unroll
        for (int a = 0; a < 2; ++a)
#pragma unroll
            for (int b = 0; b < 2; ++b)
#pragma unroll
                for (int m = 0; m < 4; ++m)
#pragma unroll
                    for (int n = 0; n < 2; ++n) acc[a][b][m][n] = (f32x4){0.f, 0.f, 0.f, 0.f};
        cur = nxt; cA = nA; cB = nB; ++ui;
        if constexpr (ALIGN_EPI) { if (wr == 1) PG8_BAR; }
    }
    PG8_WAIT_V(0);
    if constexpr (!ALIGN_EPI) { if (wr == 0) PG8_BAR; }
    PG8_BAR;
    if constexpr (Epi::AFTER_DRAIN) { E.fused(acc, cur, wr, wc, fr, fq, lds, wid, lane); S.done(cur); }
#undef PG8_SA
#undef PG8_SB
#undef PG8_STAGE
#undef PG8_LDA
#undef PG8_LDB
#undef PG8_MMA
#undef PG8_WAIT_V
#undef PG8_WAIT_L
#undef PG8_BAR
#undef PG8_SCHED
}
}

namespace pg8 {
struct GroupedOrder {
    const int* tile_e; int nU, nN, G, c; size_t estride;
    __device__ __forceinline__ bool next(int i, Unit& u) const { const long L = (long)i * G + c; if (L >= nU) return false; const int t = (int)L / nN; u.pm = t; u.pn = (int)L % nN; u.bo = (size_t)tile_e[t] * estride; return true; }
    __device__ __forceinline__ void a_ready(const Unit&) const {}
    __device__ __forceinline__ void done(const Unit&) const {}
};
__device__ __forceinline__ u32x4 pack8(const f32x4 a, const f32x4 b) { u32x4 w; w.x = cvt_pk_bf16(a[0], a[1]); w.y = cvt_pk_bf16(a[2], a[3]); w.z = cvt_pk_bf16(b[0], b[1]); w.w = cvt_pk_bf16(b[2], b[3]); return w; }
struct EpiStore {
    static constexpr bool PERM = true, AFTER_DRAIN = false; bf16_t* O; int ldc;
    __device__ __forceinline__ void operator()(const f32x4 (&acc)[2][2][4][2], const Unit& u, int wr, int wc, int fr, int fq) const {
        const int row0 = u.pm * BM + wr * 64 + fr, col0 = u.pn * BM + wc * 32 + 8 * fq;
#pragma unroll
        for (int ai = 0; ai < 2; ++ai)
#pragma unroll
            for (int m = 0; m < 4; ++m) { bf16_t* rowp = O + (size_t)(row0 + ai * HALF + m * 16) * ldc + col0;
#pragma unroll
                for (int bj = 0; bj < 2; ++bj) *(u32x4*)(rowp + bj * HALF) = pack8(acc[ai][bj][m][0], acc[ai][bj][m][1]); }
    }
};
__device__ __forceinline__ f32x4 silu4(const f32x4 v) { f32x4 r;
#pragma unroll
    for (int i = 0; i < 4; ++i) r[i] = v[i] * __builtin_amdgcn_rcpf(1.f + __expf(-v[i])); return r; }
__device__ __forceinline__ f32x4 sigm4(const f32x4 v) { f32x4 r;
#pragma unroll
    for (int i = 0; i < 4; ++i) r[i] = __builtin_amdgcn_rcpf(1.f + __expf(-v[i])); return r; }
struct EpiSwiglu {
    static constexpr bool PERM = true, AFTER_DRAIN = false; bf16_t* G;
    __device__ __forceinline__ void operator()(const f32x4 (&acc)[2][2][4][2], const Unit& u, int wr, int wc, int fr, int fq) const {
        const int row0 = u.pm * BM + wr * 64 + fr, col0 = u.pn * HALF + wc * 32 + 8 * fq;
#pragma unroll
        for (int ai = 0; ai < 2; ++ai)
#pragma unroll
            for (int m = 0; m < 4; ++m) *(u32x4*)(G + (size_t)(row0 + ai * HALF + m * 16) * 512 + col0) = pack8(silu4(acc[ai][0][m][0]) * acc[ai][1][m][0], silu4(acc[ai][0][m][1]) * acc[ai][1][m][1]);
    }
};
__device__ __forceinline__ void unpack8f(const u32x4 w, f32x4& a, f32x4& b) {
    a[0] = __uint_as_float(w.x << 16); a[1] = __uint_as_float(w.x & 0xffff0000u); a[2] = __uint_as_float(w.y << 16); a[3] = __uint_as_float(w.y & 0xffff0000u);
    b[0] = __uint_as_float(w.z << 16); b[1] = __uint_as_float(w.z & 0xffff0000u); b[2] = __uint_as_float(w.w << 16); b[3] = __uint_as_float(w.w & 0xffff0000u); }
struct EpiGlu {
    static constexpr bool PERM = true, AFTER_DRAIN = false; const bf16_t* GS; const float* b; bf16_t* GG;
    __device__ __forceinline__ void operator()(const f32x4 (&acc)[2][2][4][2], const Unit& u, int wr, int wc, int fr, int fq) const {
        const int row0 = u.pm * BM + wr * 64 + fr, col0 = u.pn * BM + wc * 32 + 8 * fq;
#pragma unroll
        for (int bj = 0; bj < 2; ++bj) { const int c = col0 + bj * HALF; const f32x4 b0 = *(const f32x4*)(b + c), b1 = *(const f32x4*)(b + c + 4);
#pragma unroll
            for (int ai = 0; ai < 2; ++ai)
#pragma unroll
                for (int m = 0; m < 4; ++m) { const size_t o = (size_t)(row0 + ai * HALF + m * 16) * 512 + c; f32x4 g0, g1; unpack8f(*(const u32x4*)(GS + o), g0, g1);
                    *(u32x4*)(GG + o) = pack8(g0 * sigm4(acc[ai][bj][m][0] + b0), g1 * sigm4(acc[ai][bj][m][1] + b1)); } }
    }
};
struct EpiResid {
    static constexpr bool PERM = false, AFTER_DRAIN = false;
    const float* x; const float* ctx; const float* mod; float* XC; int inplace;
    __device__ __forceinline__ void operator()(const f32x4 (&acc)[2][2][4][2], const Unit& u, int wr, int wc, int fr, int fq) const {
        const int R0 = u.pm * BM; const int ci = R0 < 32768 ? (R0 >> 11) : 16;
        const float* base = inplace ? XC + (size_t)R0 * 1024 : (R0 < 32768 ? x + (size_t)R0 * 1024 : ctx + (size_t)(R0 - 32768) * 1024);
        float* out = XC + (size_t)R0 * 1024; const float* gate = mod + ((size_t)ci * 6 + 2) * 1024;
        const int rl0 = wr * 64 + fr, col0 = u.pn * BM + wc * 32 + 4 * fq;
#pragma unroll
        for (int bj = 0; bj < 2; ++bj)
#pragma unroll
            for (int n = 0; n < 2; ++n) { const int c = col0 + bj * HALF + n * 16; const f32x4 g4 = *(const f32x4*)(gate + c);
#pragma unroll
                for (int ai = 0; ai < 2; ++ai)
#pragma unroll
                    for (int m = 0; m < 4; ++m) { const size_t o = (size_t)(rl0 + ai * HALF + m * 16) * 1024 + c; *(f32x4*)(out + o) = *(const f32x4*)(base + o) + g4 * acc[ai][bj][m][n]; } }
    }
};
}

#include <hip/hip_bf16.h>
#include <cmath>
namespace attn_body {
using bf16=__hip_bfloat16;
using bf16x8=__attribute__((ext_vector_type(8)))short;
using s16x4=__attribute__((ext_vector_type(4)))short;
using f32x16=__attribute__((ext_vector_type(16)))float;
using u32x4=__attribute__((ext_vector_type(4)))unsigned;
constexpr int D=64,QP=512,KP=128,OP=1024;
constexpr int NW=8,QBLK=32,QB=QBLK*NW,KVBLK=64;
constexpr int ATTN_UNIT_ROWS=QB;
__device__ __forceinline__ int crow(int r,int hi){return (r&3)+8*(r>>2)+4*hi;}
#define SBAR() __builtin_amdgcn_sched_barrier(0)
__device__ __forceinline__ void cmask(f32x16&p0,f32x16&p1,int jb,int qrel,int hi){
  const float NEG=-INFINITY; int kb=64*jb+4*hi;
  #pragma unroll
  for(int r=0;r<16;++r){int kv=kb+(r&3)+8*(r>>2); if(kv>qrel)p0[r]=NEG; if(kv+32>qrel)p1[r]=NEG;}
}

constexpr int NSLOT=3, SLOTB=8192;
constexpr int LDS_K=0, LDS_V=NSLOT*SLOTB, LDS_WS=2*NSLOT*SLOTB, LDS_OST=LDS_WS+NW*64*4, LDS_BYTES=LDS_OST+NW*4096;
constexpr float C2=0.125f*1.4426950408889634f;
__device__ __forceinline__ void glds16(const void*gsrc,unsigned lds_dst){unsigned keep;
  asm volatile("s_mov_b32 %0, m0\n\ts_mov_b32 m0, %2\n\ts_nop 0\n\tglobal_load_lds_dwordx4 %1, off\n\ts_mov_b32 m0, %0":"=&s"(keep):"v"(gsrc),"s"(lds_dst):"memory");}
__device__ __forceinline__ float max3f(float a,float b,float c){float r;asm("v_max3_f32 %0, %1, %2, %3":"=v"(r):"v"(a),"v"(b),"v"(c));return r;}
__device__ __forceinline__ float max2f(float a,float b){float r;asm("v_max_f32_e32 %0, %1, %2":"=v"(r):"v"(a),"v"(b));return r;}
__device__ __forceinline__ float fadd_s(float a,float b){float r;asm("v_add_f32_e32 %0, %1, %2":"=v"(r):"v"(a),"v"(b));return r;}
__device__ __forceinline__ float fsub_s(float a,float b){float r;asm("v_sub_f32_e32 %0, %1, %2":"=v"(r):"v"(a),"v"(b));return r;}
typedef float f32x2_t __attribute__((ext_vector_type(2))); typedef __bf16 bf16x2_t __attribute__((ext_vector_type(2)));
__device__ __forceinline__ unsigned cvtpk_s(float lo,float hi){f32x2_t v={lo,hi};bf16x2_t b=__builtin_convertvector(v,bf16x2_t);return __builtin_bit_cast(unsigned,b);}
#define WAIT_BAR(N) asm volatile("s_waitcnt vmcnt(" #N ") lgkmcnt(0)\n\ts_barrier":::"memory")

__device__ __forceinline__ void qkt(f32x16&p0,f32x16&p1,const char*Kslot,const bf16x8*qr,const f32x16&negm,int r32,int hi){
  const char*kb=Kslot+hi*1024+r32*16;
  #pragma unroll
  for(int d0=0;d0<4;++d0){
    const bf16x8 b0=*reinterpret_cast<const bf16x8*>(kb+d0*2048);
    const bf16x8 b1=*reinterpret_cast<const bf16x8*>(kb+d0*2048+512);
    if(d0==0){p0=__builtin_amdgcn_mfma_f32_32x32x16_bf16(b0,qr[0],negm,0,0,0);p1=__builtin_amdgcn_mfma_f32_32x32x16_bf16(b1,qr[0],negm,0,0,0);}
    else{p0=__builtin_amdgcn_mfma_f32_32x32x16_bf16(b0,qr[d0],p0,0,0,0);p1=__builtin_amdgcn_mfma_f32_32x32x16_bf16(b1,qr[d0],p1,0,0,0);}}
}
typedef __attribute__((address_space(3))) const char* lds_cptr;
typedef short v4i16_t __attribute__((ext_vector_type(4)));
__device__ __forceinline__ void kload8(bf16x8*kf,lds_cptr kp){
  kf[0]=*(const __attribute__((address_space(3))) bf16x8*)(kp);      kf[1]=*(const __attribute__((address_space(3))) bf16x8*)(kp+512);
  kf[2]=*(const __attribute__((address_space(3))) bf16x8*)(kp+2048); kf[3]=*(const __attribute__((address_space(3))) bf16x8*)(kp+2560);
  kf[4]=*(const __attribute__((address_space(3))) bf16x8*)(kp+4096); kf[5]=*(const __attribute__((address_space(3))) bf16x8*)(kp+4608);
  kf[6]=*(const __attribute__((address_space(3))) bf16x8*)(kp+6144); kf[7]=*(const __attribute__((address_space(3))) bf16x8*)(kp+6656);
}
__device__ __forceinline__ void kload2(bf16x8*kf,lds_cptr kp,int j){ kf[2*j]=*(const __attribute__((address_space(3))) bf16x8*)(kp+j*2048); kf[2*j+1]=*(const __attribute__((address_space(3))) bf16x8*)(kp+j*2048+512); }
__device__ __forceinline__ s16x4 vtr(lds_cptr p){ return __builtin_bit_cast(s16x4,__builtin_amdgcn_ds_read_tr16_b64_v4i16((__attribute__((address_space(3))) v4i16_t*)p)); }
__device__ __forceinline__ float rowmax(const f32x16&p0,const f32x16&p1){
  float a=max3f(p0[0],p0[1],p1[0]),b=max3f(p0[2],p0[3],p1[1]);a=max3f(a,p1[2],p1[3]);
  #pragma unroll
  for(int r=4;r<16;r+=4){a=max3f(a,p0[r],p0[r+1]);b=max3f(b,p0[r+2],p0[r+3]);a=max3f(a,p1[r],p1[r+1]);b=max3f(b,p1[r+2],p1[r+3]);}
  const float m=max2f(a,b);
  auto rr=__builtin_amdgcn_permlane32_swap(__float_as_uint(m),__float_as_uint(m),false,false);
  return max2f(__uint_as_float(rr[0]),__uint_as_float(rr[1]));
}
__device__ __forceinline__ void pv(f32x16*o,int vb,bf16x8 pa0,bf16x8 pa1,bf16x8 pa2,bf16x8 pa3){
  #pragma unroll
  for(int d0=0;d0<2;++d0){s16x4 lo[4],hi[4];
    #pragma unroll
    for(int ks=0;ks<4;++ks){
      asm volatile("ds_read_b64_tr_b16 %0,%1 offset:%c2":"=&v"(lo[ks]):"v"(vb),"i"(d0*4096+ks*1024):"memory");
      asm volatile("ds_read_b64_tr_b16 %0,%1 offset:%c2":"=&v"(hi[ks]):"v"(vb),"i"(d0*4096+ks*1024+512):"memory");}
    asm volatile("s_waitcnt lgkmcnt(0)":::"memory");SBAR();
    #define PK(k) (bf16x8){lo[k][0],lo[k][1],lo[k][2],lo[k][3],hi[k][0],hi[k][1],hi[k][2],hi[k][3]}
    o[d0]=__builtin_amdgcn_mfma_f32_32x32x16_bf16(pa0,PK(0),o[d0],0,0,0);
    o[d0]=__builtin_amdgcn_mfma_f32_32x32x16_bf16(pa1,PK(1),o[d0],0,0,0);
    o[d0]=__builtin_amdgcn_mfma_f32_32x32x16_bf16(pa2,PK(2),o[d0],0,0,0);
    o[d0]=__builtin_amdgcn_mfma_f32_32x32x16_bf16(pa3,PK(3),o[d0],0,0,0);
    #undef PK
  }
}

#ifndef ATTN_STORE16
#define ATTN_STORE16(p,v) (*(u32x4*)(p)=(v))
#endif
template<int THRL> __device__ __forceinline__ void attn_unit(const bf16*Q0,const bf16*__restrict__ Kh,const bf16*__restrict__ Vh,bf16*O0,const int NT,char*shm){
  const int tid=threadIdx.x,lane=tid&63,r32=lane&31,hi=lane>>5; const int wid=__builtin_amdgcn_readfirstlane(tid>>6);
  const bf16*Qw=Q0+(long)(wid*QBLK)*QP;
  const unsigned lds0=(unsigned)(uintptr_t)shm;
  float*wsf=(float*)(shm+LDS_WS)+wid*64;
  const bf16*ksrc=Kh+(long)lane*KP+wid*8;
  const bf16*vsrc=Vh+(long)(16*(wid&3)+(lane>>2))*KP+(wid>>2)*32+(lane&3)*8;
  const unsigned kdst=lds0+LDS_K+wid*1024, vdst=lds0+LDS_V+wid*1024;
  #define DMA_K(t,slot) glds16(ksrc+(long)(t)*KVBLK*KP,(unsigned)__builtin_amdgcn_readfirstlane(kdst+(slot)))
  #define DMA_V(t,slot) glds16(vsrc+(long)(t)*KVBLK*KP,(unsigned)__builtin_amdgcn_readfirstlane(vdst+(slot)))
  const int vb0=(int)(lds0+LDS_V)+((lane>>4)&1)*32+(lane&3)*8+(4*hi+((lane&15)>>2))*64;
  const char*Kbase=shm+LDS_K; bf16x8 kf[8];
  const lds_cptr shm3=(lds_cptr)shm; const lds_cptr kp0=shm3+LDS_K+hi*1024+r32*16; const lds_cptr vp0=shm3+LDS_V+((lane>>4)&1)*32+(lane&3)*8+(4*hi+((lane&15)>>2))*64;
  DMA_K(0,0);DMA_V(0,0);DMA_K(1,SLOTB);
  bf16x8 qr[4];
  #pragma unroll
  for(int d0=0;d0<4;++d0)qr[d0]=*reinterpret_cast<const bf16x8*>(&Qw[(long)r32*QP+d0*16+hi*8]);
  float mhat=0.f,l_reg=0.f;f32x16 o[2];o[0]=f32x16{};o[1]=f32x16{};f32x16 negm=f32x16{};asm volatile("":"+v"(negm));
  #define CMASK(P0,P1,t) do{}while(0)
  bool resc=false;
  #define START(P0,P1) do{ const float rm=rowmax(P0,P1); resc=false; \
    { const float dl=rm; mhat=fadd_s(mhat,dl); \
      _Pragma("unroll") for(int r=0;r<16;++r){P0[r]=fsub_s(P0[r],dl);P1[r]=fsub_s(P1[r],dl);} \
      _Pragma("unroll") for(int r=0;r<16;++r)negm[r]=-mhat; asm volatile("":"+v"(negm)); } \
    _Pragma("unroll") for(int r=0;r<16;++r)P0[r]=__builtin_amdgcn_exp2f(P0[r]); }while(0)
  #define RESC() do{ if(resc){ asm volatile("s_waitcnt lgkmcnt(0)":::"memory"); \
      _Pragma("unroll") for(int d_=0;d_<2;++d_) _Pragma("unroll") for(int r=0;r<16;++r)o[d_][r]*=wsf[crow(r,hi)]; } }while(0)
  f32x16 pA0,pA1,pB0,pB1;
  int sl_prev=0,sl_cur=0,sl_next=SLOTB;
  #define ROT() do{sl_prev=sl_cur;sl_cur=sl_next;sl_next=(sl_next==(NSLOT-1)*SLOTB)?0:sl_next+SLOTB;}while(0)
  DMA_K(2,2*SLOTB);
  WAIT_BAR(3);
  qkt(pA0,pA1,Kbase,qr,negm,r32,hi);asm volatile("s_nop 15\n\ts_nop 7":"+v"(pA0),"+v"(pA1));CMASK(pA0,pA1,0);
  START(pA0,pA1);
  _Pragma("unroll") for(int r=0;r<16;++r)pA1[r]=__builtin_amdgcn_exp2f(pA1[r]);
  WAIT_BAR(0);
  DMA_K(3,0);DMA_V(1,SLOTB);
  ROT();
  kload8(kf,kp0+sl_cur);
  WAIT_BAR(2);
  s16x4 vlo[8],vhi[8]; u32x4 pw0,pw1,pw2,pw3;
  #define PKW(P,B) cvtpk_s(P[B],P[B+1])
  #define PAF(k) __builtin_bit_cast(bf16x8,pw##k)
  #define VFR(i) (bf16x8){vlo[i][0],vlo[i][1],vlo[i][2],vlo[i][3],vhi[i][0],vhi[i][1],vhi[i][2],vhi[i][3]}
  #define PIN(x) asm volatile("":"+v"(x))
  #define MX3(a,b,c) __builtin_fmaxf(__builtin_fmaxf((a),(b)),(c))
  #define GAPA(MF,A0,A1,A2,A3,W0,W1,PW) do{ MF; sacc+=A0; sacc+=A1; sacc+=A2; sacc+=A3; PIN(sacc); W0; W1; PIN(PW); SBAR(); }while(0)
  #define EX(v) __builtin_amdgcn_exp2f(v)
  #define GAPB(MF,X,B) do{ MF; X[B]=EX(X[B]); X[B+1]=EX(X[B+1]); X[B+2]=EX(X[B+2]); X[B+3]=EX(X[B+3]); PIN(X); SBAR(); }while(0)
  #define VRD(i) do{ vlo[i]=vtr(vp_+(((i)>>2)*4096+((i)&3)*1024)); vhi[i]=vtr(vp_+(((i)>>2)*4096+((i)&3)*1024+512)); }while(0)
  #define KRD(G,j) do{ if(G){ kload2(kf,kp0+sl_next,j); SBAR(); } }while(0)
  #define STEP(C0,C1,P0,P1,t,GK,GV,GL) do{ SBAR(); \
    const lds_cptr vp_=vp0+sl_prev; \
    VRD(0); SBAR(); float sacc=(P0[0]+P0[1]); \
    GAPA(C0=__builtin_amdgcn_mfma_f32_32x32x16_bf16(kf[0],qr[0],negm,0,0,0), P0[2],P0[3],P0[4],P0[5],     pw0[0]=PKW(P0,0), pw0[1]=PKW(P0,2), pw0); \
    VRD(4); SBAR(); GAPA(C1=__builtin_amdgcn_mfma_f32_32x32x16_bf16(kf[1],qr[0],negm,0,0,0), P0[6],P0[7],P0[8],P0[9],     pw0[2]=PKW(P0,4), pw0[3]=PKW(P0,6), pw0); \
    VRD(1); SBAR(); GAPA(C0=__builtin_amdgcn_mfma_f32_32x32x16_bf16(kf[2],qr[1],C0,0,0,0),   P0[10],P0[11],P0[12],P0[13], pw1[0]=PKW(P0,8), pw1[1]=PKW(P0,10), pw1); \
    VRD(5); SBAR(); GAPA(C1=__builtin_amdgcn_mfma_f32_32x32x16_bf16(kf[3],qr[1],C1,0,0,0),   P0[14],P0[15],P1[0],P1[1],   pw1[2]=PKW(P0,12),pw1[3]=PKW(P0,14), pw1); \
    VRD(2); SBAR(); GAPA(C0=__builtin_amdgcn_mfma_f32_32x32x16_bf16(kf[4],qr[2],C0,0,0,0),   P1[2],P1[3],P1[4],P1[5],     pw2[0]=PKW(P1,0), pw2[1]=PKW(P1,2), pw2); \
    VRD(6); SBAR(); GAPA(C1=__builtin_amdgcn_mfma_f32_32x32x16_bf16(kf[5],qr[2],C1,0,0,0),   P1[6],P1[7],P1[8],P1[9],     pw2[2]=PKW(P1,4), pw2[3]=PKW(P1,6), pw2); \
    VRD(3); SBAR(); GAPA(C0=__builtin_amdgcn_mfma_f32_32x32x16_bf16(kf[6],qr[3],C0,0,0,0),   P1[10],P1[11],P1[12],P1[13], pw3[0]=PKW(P1,8), pw3[1]=PKW(P1,10), pw3); \
    VRD(7); SBAR(); GAPA(C1=__builtin_amdgcn_mfma_f32_32x32x16_bf16(kf[7],qr[3],C1,0,0,0),   P1[14],P1[15],0.f,0.f,       pw3[2]=PKW(P1,12),pw3[3]=PKW(P1,14), pw3); \
    l_reg+=sacc; \
    if(GK){DMA_K((t)+3,sl_cur);} if(GV){DMA_V((t)+1,sl_next);} \
    CMASK(C0,C1,t); \
    { float a=MX3(C0[0],C0[1],C1[0]),b=MX3(C0[2],C0[3],C1[1]); a=MX3(a,C1[2],C1[3]); \
      _Pragma("unroll") for(int r=4;r<16;r+=4){a=MX3(a,C0[r],C0[r+1]);b=MX3(b,C0[r+2],C0[r+3]);a=MX3(a,C1[r],C1[r+1]);b=MX3(b,C1[r+2],C1[r+3]);} \
      float rm=__builtin_fmaxf(a,b); { auto rr=__builtin_amdgcn_permlane32_swap(__float_as_uint(rm),__float_as_uint(rm),false,false); rm=__builtin_fmaxf(__uint_as_float(rr[0]),__uint_as_float(rr[1])); } \
      resc=false; \
      if(__builtin_expect(__any(rm>(float)THRL),0)){ const float dl=__builtin_fmaxf(rm,0.f); mhat+=dl; \
        _Pragma("unroll") for(int r=0;r<16;++r){C0[r]-=dl;C1[r]-=dl;} \
        _Pragma("unroll") for(int r=0;r<16;++r)negm[r]=-mhat; asm volatile("":"+v"(negm)); \
        const float f=__builtin_amdgcn_exp2f(-dl); l_reg*=f; if(hi==0)wsf[r32]=f; resc=true; } } \
    SBAR(); \
    GAPB(o[0]=__builtin_amdgcn_mfma_f32_32x32x16_bf16(PAF(0),VFR(0),o[0],0,0,0), C0,0); \
    GAPB(o[1]=__builtin_amdgcn_mfma_f32_32x32x16_bf16(PAF(0),VFR(4),o[1],0,0,0), C0,4); \
    KRD(GL,0); GAPB(o[0]=__builtin_amdgcn_mfma_f32_32x32x16_bf16(PAF(1),VFR(1),o[0],0,0,0), C0,8); \
    KRD(GL,1); GAPB(o[1]=__builtin_amdgcn_mfma_f32_32x32x16_bf16(PAF(1),VFR(5),o[1],0,0,0), C0,12); \
    KRD(GL,2); GAPB(o[0]=__builtin_amdgcn_mfma_f32_32x32x16_bf16(PAF(2),VFR(2),o[0],0,0,0), C1,0); \
    KRD(GL,3); GAPB(o[1]=__builtin_amdgcn_mfma_f32_32x32x16_bf16(PAF(2),VFR(6),o[1],0,0,0), C1,4); \
    GAPB(o[0]=__builtin_amdgcn_mfma_f32_32x32x16_bf16(PAF(3),VFR(3),o[0],0,0,0), C1,8); \
    GAPB(o[1]=__builtin_amdgcn_mfma_f32_32x32x16_bf16(PAF(3),VFR(7),o[1],0,0,0), C1,12); \
    }while(0)
  int t=1;
  #undef CMASK
  #define CMASK(P0,P1,t) do{}while(0)
  for(;t+5<NT;t+=2){
    STEP(pB0,pB1,pA0,pA1,t,true,true,true);     WAIT_BAR(2); RESC(); ROT();
    STEP(pA0,pA1,pB0,pB1,t+1,true,true,true);   WAIT_BAR(2); RESC(); ROT();
  }
  #undef CMASK
  #define CMASK(P0,P1,t) do{}while(0)
  #define ENDW(tt) do{ if((tt)+3<NT){WAIT_BAR(2);} else if((tt)+2<NT){WAIT_BAR(1);} else {WAIT_BAR(0);} }while(0)
  for(;t+1<NT;t+=2){
    STEP(pB0,pB1,pA0,pA1,t,(t+3<NT),(t+1<NT),(t+1<NT));       ENDW(t);   RESC(); ROT();
    STEP(pA0,pA1,pB0,pB1,t+1,(t+4<NT),(t+2<NT),(t+2<NT));     ENDW(t+1); RESC(); ROT();
  }
  STEP(pB0,pB1,pA0,pA1,NT-1,false,false,false); RESC();
  { float sacc=pB0[0]+pB0[1]; _Pragma("unroll") for(int r=2;r<16;++r)sacc+=pB0[r]; _Pragma("unroll") for(int r=0;r<16;++r)sacc+=pB1[r]; l_reg+=sacc;
    pw0=(u32x4){PKW(pB0,0),PKW(pB0,2),PKW(pB0,4),PKW(pB0,6)};pw1=(u32x4){PKW(pB0,8),PKW(pB0,10),PKW(pB0,12),PKW(pB0,14)};pw2=(u32x4){PKW(pB1,0),PKW(pB1,2),PKW(pB1,4),PKW(pB1,6)};pw3=(u32x4){PKW(pB1,8),PKW(pB1,10),PKW(pB1,12),PKW(pB1,14)};
    SBAR(); pv(o,vb0+sl_cur,PAF(0),PAF(1),PAF(2),PAF(3)); }
  #undef PKW
  #undef PAF
  #undef VFR
  #undef PIN
  #undef MX3
  #undef GAPA
  #undef GAPB
  #undef EX
  #undef VRD
  #undef KRD
  #undef STEP
  #undef ENDW
  {auto rr=__builtin_amdgcn_permlane32_swap(__float_as_uint(l_reg),__float_as_uint(l_reg),false,false);l_reg=__uint_as_float(rr[0])+__uint_as_float(rr[1]);}
  if(hi==0)wsf[32+r32]=l_reg;asm volatile("s_waitcnt lgkmcnt(0)":::"memory");
  float rli[16];
  #pragma unroll
  for(int r=0;r<16;++r)rli[r]=__builtin_amdgcn_rcpf(wsf[32+crow(r,hi)]);
  bf16*Ow=O0+(long)(wid*QBLK)*OP;
  { bf16*stg=(bf16*)(shm+LDS_OST)+wid*2048;
    #pragma unroll
    for(int r=0;r<16;++r){const int orow=crow(r,hi);
      #pragma unroll
      for(int d0=0;d0<2;++d0)stg[orow*64+d0*32+r32]=__float2bfloat16(o[d0][r]*rli[r]);}
    asm volatile("s_waitcnt lgkmcnt(0)":::"memory");
    #pragma unroll
    for(int i=0;i<4;++i){const int row=i*8+(lane>>3),ch=lane&7; const u32x4 v=*(const u32x4*)(stg+row*64+ch*8); ATTN_STORE16(Ow+(long)row*OP+ch*8,v);} }
  asm volatile("s_waitcnt lgkmcnt(0)\n\ts_barrier":::"memory");
  #undef DMA_K
  #undef DMA_V
  #undef CMASK
  #undef START
  #undef RESC
  #undef ROT
}
constexpr int ATTN_LDS_BYTES=LDS_BYTES;
#undef SBAR
#undef WAIT_BAR
}

struct Params {
    const float* in[35];
    float* out;
    unsigned char* ws;
    int ph_lo, ph_hi;
};
enum { I_X = 0, I_C, I_CTX, I_CCTX, I_WMOD, I_BMOD, I_GMIX, I_GFFN, I_MIXWIN, I_MIXWOUT, I_QG, I_KG, I_LNG, I_WSP, I_BSP,
       I_S5WIN, I_ARE, I_AIM, I_LOGDT, I_BRE, I_BIM, I_CRE, I_CIM, I_S5D, I_WGLU, I_BGLU, I_S5WOUT,
       I_WGRP, I_BGRP, I_WRT, I_BRT, I_W1, I_W3, I_W2, I_FING };

struct Ctx {
    const Params* p;
    unsigned char* ws;
    LAS unsigned char* lds;
    int tid, lane, wave, gw, ngw;
};
__device__ __forceinline__ const float* xin_row(const Params& P, int r) { return r < TL ? P.in[I_X] + (size_t)r * D : P.in[I_CTX] + (size_t)(r - TL) * D; }
__device__ __forceinline__ int cond_of(int r) { return r < TL ? (r >> 11) : 16; }
__device__ __forceinline__ const float* mod_vec(const Ctx& C, int layer, int ci, int k) { return (const float*)(C.ws + WS_MOD) + ((size_t)(layer * 17 + ci) * 6 + k) * D; }

__device__ __forceinline__ void dsincos(double a, double& s, double& c) {
    const double TWO_PI_HI = 6.283185307179586, TWO_PI_LO = 2.4492935982947064e-16;
    const double k = rint(a * 0.15915494309189535);
    double r = fma(-k, TWO_PI_HI, a); r = fma(-k, TWO_PI_LO, r);
    const double r2 = r * r; double ct = 1.0, st = r, cs = 1.0, ss = r;
#pragma unroll 1
    for (int i = 1; i <= 15; ++i) { ct *= -r2 / (double)((2 * i - 1) * (2 * i)); cs += ct; st *= -r2 / (double)((2 * i) * (2 * i + 1)); ss += st; }
    s = ss; c = cs;
}

__device__ __forceinline__ void transpose_item(const float* src, int N, int k0, int n0, bf16* dst, int dpitch, LAS float* scr, int lane) {
#pragma unroll 8
    for (int i = 0; i < 32; ++i) { const int kk = 2 * i + (lane >> 5); scr[kk * 33 + (lane & 31)] = src[(size_t)(k0 + kk) * N + n0 + (lane & 31)]; }
    asm volatile("s_waitcnt lgkmcnt(0)" ::: "memory");
    const int c = lane & 7;
#pragma unroll
    for (int j = 0; j < 4; ++j) { const int n = (lane >> 3) + 8 * j; const LAS float* s = scr + (8 * c) * 33 + n;
        v4u o; o.x = pk2(s[0 * 33], s[1 * 33]); o.y = pk2(s[2 * 33], s[3 * 33]); o.z = pk2(s[4 * 33], s[5 * 33]); o.w = pk2(s[6 * 33], s[7 * 33]);
        *(v4u*)(dst + (size_t)n * dpitch + 8 * c) = o; }
    asm volatile("s_waitcnt lgkmcnt(0)" ::: "memory");
}
__device__ __forceinline__ void transpose_mat_item(const float* W, int K, int N, bf16* WT, int it, LAS float* scr, int lane) {
    const int nblk = N / 32, kb = it / nblk, nb = it % nblk;
    transpose_item(W, N, kb * 64, nb * 32, WT + (size_t)(nb * 32) * K + kb * 64, K, scr, lane);
}
constexpr int MOE_ITEMS = NEXP * 768;
__device__ __forceinline__ void moe_convert_item(const Ctx& C, int layer, int it, LAS float* scr) {
    const Params& P = *C.p;
    const int e = it / 768, r = it % 768, kind = r / 256, j = r % 256;
    if (kind < 2) {
        const float* src = (kind == 0 ? P.in[I_W1] : P.in[I_W3]) + ((size_t)layer * NEXP + e) * D * EH;
        const int kb = j / 16, nb = j % 16, k0 = kb * 64, n0 = nb * 32;
        const int drow = (n0 / 128) * 256 + (n0 % 128) + (kind == 1 ? 128 : 0);
        transpose_item(src, EH, k0, n0, (bf16*)(C.ws + WS_W13) + (size_t)e * 1024 * 1024 + (size_t)drow * 1024 + k0, 1024, scr, C.lane);
    } else {
        const float* src = P.in[I_W2] + ((size_t)layer * NEXP + e) * EH * D;
        const int kb = j / 32, nb = j % 32, k0 = kb * 64, n0 = nb * 32;
        transpose_item(src, D, k0, n0, (bf16*)(C.ws + WS_W2) + (size_t)e * 1024 * 512 + (size_t)n0 * 512 + k0, 512, scr, C.lane);
    }
}

__device__ __forceinline__ void phase_prologue(const Ctx& C) {
    const Params& P = *C.p;
    {
        LAS float* s = (LAS float*)C.lds;
        LAS float* red = (LAS float*)(C.lds + 17 * 1024 * 4);
        bool have_s = false;
        for (int u = blockIdx.x; u < 192; u += gridDim.x) {
            if (!have_s) {
                for (int i = C.tid; i < 17 * 1024; i += NTHR) { const int ci = i >> 10, k = i & 1023; const float v = ci < 16 ? P.in[I_C][ci * D + k] : P.in[I_CCTX][k]; s[i] = silu_(v); }
                have_s = true; __syncthreads();
            }
            const int layer = u / 96, jg = u % 96, kq = C.tid >> 6, jc = C.tid & 63;
            const float* w = P.in[I_WMOD] + (size_t)layer * D * 6144 + jg * 64 + jc;
            float acc[17];
#pragma unroll
            for (int i = 0; i < 17; ++i) acc[i] = 0.f;
            for (int k = kq * 128; k < kq * 128 + 128; ++k) { const float wv = w[(size_t)k * 6144];
#pragma unroll
                for (int i = 0; i < 17; ++i) acc[i] += s[i * 1024 + k] * wv; }
#pragma unroll
            for (int i = 0; i < 17; ++i) red[(kq * 17 + i) * 64 + jc] = acc[i];
            __syncthreads();
            for (int o = C.tid; o < 17 * 64; o += NTHR) { const int ci = o >> 6, c = o & 63; float v = 0.f;
#pragma unroll
                for (int q = 0; q < 8; ++q) v += red[(q * 17 + ci) * 64 + c];
                const int j = jg * 64 + c; v += P.in[I_BMOD][layer * 6144 + j];
                ((float*)(C.ws + WS_MOD))[((size_t)(layer * 17 + ci)) * 6144 + j] = v; }
            __syncthreads();
        }
        __syncthreads();
    }
    {
        const int gt = blockIdx.x * NTHR + C.tid, ngt = gridDim.x * NTHR;
        float2* rope = (float2*)(C.ws + WS_TAB + TAB_ROPE);
        for (int i = gt; i < 64 * 16; i += ngt) { const int pos = i >> 4, f = i & 15;
            const double th = exp(-(double)f * (9.210340371976184 / 16.0)); double s, c; dsincos((double)pos * th, s, c); rope[i] = make_float2((float)c, (float)s); }
        float2* lamb = (float2*)(C.ws + WS_TAB + TAB_LAMB); float2* bbar = (float2*)(C.ws + WS_TAB + TAB_BBAR);
        for (int i = gt; i < 2 * 32 * 64; i += ngt) {
            const int dg = i >> 6;
            const double are = P.in[I_ARE][i], aim = P.in[I_AIM][i], dt = exp((double)P.in[I_LOGDT][dg]);
            double s, c; dsincos(aim * dt, s, c); const double mag = exp(are * dt), lr = mag * c, li = mag * s;
            lamb[i] = make_float2((float)lr, (float)li);
            const double den = are * are + aim * aim, nr = lr - 1.0, ni = li;
            const double cr = (nr * are + ni * aim) / den, cim = (ni * are - nr * aim) / den;
            for (int p = 0; p < 16; ++p) { const double br = P.in[I_BRE][(size_t)i * 16 + p], bi = P.in[I_BIM][(size_t)i * 16 + p];
                bbar[(size_t)i * 16 + p] = make_float2((float)(cr * br - cim * bi), (float)(cr * bi + cim * br)); }
        }
    }
    {
        LAS float* scr = (LAS float*)(C.lds + C.wave * 16384);
        constexpr int I0 = 16 * 56, I1 = 16 * 32, I2 = 16 * 16, I3 = 8 * 16, I4 = 8 * 32;
        constexpr int NSMALL = I0 + I1 + I2 + I3 + I4;
        for (int it = C.gw; it < NSMALL + MOE_ITEMS; it += C.ngw) {
            int r = it;
            if (r < I0) { transpose_mat_item(P.in[I_MIXWIN], D, MIXW, (bf16*)(C.ws + WS_WIN0), r, scr, C.lane); continue; } r -= I0;
            if (r < I1) { transpose_mat_item(P.in[I_MIXWOUT], D, D, (bf16*)(C.ws + WS_WOUT0), r, scr, C.lane); continue; } r -= I1;
            if (r < I2) { transpose_mat_item(P.in[I_S5WIN], D, 512, (bf16*)(C.ws + WS_WS5IN), r, scr, C.lane); continue; } r -= I2;
            if (r < I3) { transpose_mat_item(P.in[I_WGLU], 512, 512, (bf16*)(C.ws + WS_WGLU), r, scr, C.lane); continue; } r -= I3;
            if (r < I4) { transpose_mat_item(P.in[I_S5WOUT], 512, D, (bf16*)(C.ws + WS_WS5OUT), r, scr, C.lane); continue; } r -= I4;
            moe_convert_item(C, 0, r, scr);
        }
    }
}

__device__ __forceinline__ void load_row16(const float* row, int lane, f32x4 (&v)[4]) {
#pragma unroll
    for (int j = 0; j < 4; ++j) v[j] = *(const f32x4*)(row + 4 * lane + 256 * j);
}
__device__ __forceinline__ float row_rstd(const f32x4 (&v)[4]) {
    float s = 0.f;
#pragma unroll
    for (int j = 0; j < 4; ++j) s += (v[j].x * v[j].x + v[j].y * v[j].y) + (v[j].z * v[j].z + v[j].w * v[j].w);
    return rsqrtf(wave_sum(s) * (1.f / D) + EPS);
}
__device__ __forceinline__ void modulate16(f32x4 (&v)[4], float rstd, const float* g, const float* scale, const float* shift, int lane) {
#pragma unroll
    for (int j = 0; j < 4; ++j) { const int c = 4 * lane + 256 * j; const f32x4 gg = *(const f32x4*)(g + c), sc = *(const f32x4*)(scale + c), sh = *(const f32x4*)(shift + c);
        v[j] = v[j] * rstd * gg * (sc + 1.f) + sh; }
}
__device__ __forceinline__ void store_row16_bf16(bf16* row, int lane, const f32x4 (&v)[4]) {
#pragma unroll
    for (int j = 0; j < 4; ++j) { v2u o; o.x = pk2(v[j].x, v[j].y); o.y = pk2(v[j].z, v[j].w); *(v2u*)(row + 4 * lane + 256 * j) = o; }
}

__device__ __forceinline__ void phase_norm_mix0(const Ctx& C) {
    const Params& P = *C.p; bf16* H = (bf16*)(C.ws + WS_H);
    for (int r = C.gw; r < TT; r += C.ngw) {
        f32x4 v[4]; load_row16(xin_row(P, r), C.lane, v);
        const float rstd = row_rstd(v); const int ci = cond_of(r);
        modulate16(v, rstd, P.in[I_GMIX], mod_vec(C, 0, ci, 1), mod_vec(C, 0, ci, 0), C.lane);
        store_row16_bf16(H + (size_t)r * D, C.lane, v);
    }
}

template <class Epi>
__device__ __forceinline__ void ngemm_unit(const Ctx& C, const bf16* A0, const bf16* B0, int K, int row0, int pn, const Epi& epi) {
    LAS float* As = (LAS float*)C.lds;
    LAS float* Bs = (LAS float*)(C.lds + 32 * 68 * 4);
    const int tid = C.tid, ty = tid >> 4, tx = tid & 15;
    float acc[2][16];
#pragma unroll
    for (int i = 0; i < 2; ++i)
#pragma unroll
        for (int j = 0; j < 16; ++j) acc[i][j] = 0.f;
    const int ar = tid >> 3, ak = (tid & 7) * 4, bn = tid >> 1, bk = (tid & 1) * 16;
    for (int k0 = 0; k0 < K; k0 += 32) {
        const v2u av = *(const v2u*)(A0 + (size_t)ar * K + k0 + ak);
        const v4u b0 = *(const v4u*)(B0 + (size_t)bn * K + k0 + bk), b1 = *(const v4u*)(B0 + (size_t)bn * K + k0 + bk + 8);
        __syncthreads();
        As[(ak + 0) * 68 + ar] = bf2f(av.x & 0xffffu); As[(ak + 1) * 68 + ar] = bf2f(av.x >> 16); As[(ak + 2) * 68 + ar] = bf2f(av.y & 0xffffu); As[(ak + 3) * 68 + ar] = bf2f(av.y >> 16);
        float bf[16]; unpack8(b0, bf); unpack8(b1, bf + 8);
#pragma unroll
        for (int i = 0; i < 16; ++i) Bs[(bk + i) * 260 + bn] = bf[i];
        __syncthreads();
#pragma unroll 4
        for (int k = 0; k < 32; ++k) {
            const float a0 = As[k * 68 + ty * 2], a1 = As[k * 68 + ty * 2 + 1];
            const f32x4 x0 = *(const LAS f32x4*)(Bs + k * 260 + tx * 8), x1 = *(const LAS f32x4*)(Bs + k * 260 + tx * 8 + 4);
            const f32x4 y0 = *(const LAS f32x4*)(Bs + k * 260 + 128 + tx * 8), y1 = *(const LAS f32x4*)(Bs + k * 260 + 128 + tx * 8 + 4);
            const float bb[16] = {x0.x, x0.y, x0.z, x0.w, x1.x, x1.y, x1.z, x1.w, y0.x, y0.y, y0.z, y0.w, y1.x, y1.y, y1.z, y1.w};
#pragma unroll
            for (int j = 0; j < 16; ++j) { acc[0][j] += a0 * bb[j]; acc[1][j] += a1 * bb[j]; }
        }
    }
#pragma unroll
    for (int i = 0; i < 2; ++i)
#pragma unroll
        for (int j = 0; j < 8; ++j) epi(row0 + ty * 2 + i, pn, tx * 8 + j, acc[i][j], acc[i][8 + j]);
    __syncthreads();
}
template <class Epi>
__device__ __forceinline__ void ngemm_dense(const Ctx& C, const bf16* A, const bf16* Bt, int M, int N, int K, const Epi& epi) {
    const int nN = N / 256, nU = (M / 64) * nN;
    for (int u = blockIdx.x; u < nU; u += gridDim.x) { const int tm = u / nN, pn = u % nN;
        ngemm_unit(C, A + (size_t)tm * 64 * K, Bt + (size_t)pn * 256 * K, K, tm * 64, pn, epi); }
}
template <class Epi>
__device__ __forceinline__ void ngemm_grouped(const Ctx& C, const bf16* A, const bf16* Bt, size_t estride, int N, int K, const Epi& epi) {
    const int* tile_e = (const int*)(C.ws + WS_ROUTE + RT_TILE); const int ntiles = *(const int*)(C.ws + WS_ROUTE + RT_NT);
    const int nN = N / 256, nU = ntiles * 4 * nN;
    for (int u = blockIdx.x; u < nU; u += gridDim.x) { const int pn = u % nN, tm = u / nN, e = tile_e[tm >> 2];
        ngemm_unit(C, A + (size_t)tm * 64 * K, Bt + (size_t)e * estride + (size_t)pn * 256 * K, K, tm * 64, pn, epi); }
}

struct EpiStoreBf16 { bf16* O; int ldc;
    __device__ __forceinline__ void operator()(int r, int pn, int c, float v0, float v1) const { bf16* o = O + (size_t)r * ldc + pn * 256 + c; o[0] = (bf16)f2bf(v0); o[128] = (bf16)f2bf(v1); } };
struct EpiResid0 { const Params* P; const float* mod; float* XC;
    __device__ __forceinline__ void operator()(int r, int pn, int c, float v0, float v1) const { const int n = pn * 256 + c; const float* xi = xin_row(*P, r); const float* g = mod + ((size_t)cond_of(r) * 6 + 2) * D;
        float* o = XC + (size_t)r * D; o[n] = xi[n] + g[n] * v0; o[n + 128] = xi[n + 128] + g[n + 128] * v1; } };
struct EpiResidAcc { const float* mod; float* XC;
    __device__ __forceinline__ void operator()(int r, int pn, int c, float v0, float v1) const { const int n = pn * 256 + c; const float* g = mod + ((size_t)cond_of(r) * 6 + 2) * D;
        float* o = XC + (size_t)r * D; o[n] += g[n] * v0; o[n + 128] += g[n + 128] * v1; } };
struct EpiSwiglu { bf16* G;
    __device__ __forceinline__ void operator()(int r, int pn, int c, float v0, float v1) const { G[(size_t)r * EH + pn * 128 + c] = (bf16)f2bf(silu_(v0) * v1); } };
struct EpiGlu { const bf16* GS; const float* b; bf16* GG;
    __device__ __forceinline__ void operator()(int r, int pn, int c, float v0, float v1) const { const int n = pn * 256 + c; const size_t o = (size_t)r * 512 + n;
        GG[o] = (bf16)f2bf(bf2f(GS[o]) * sigmoidf_(v0 + b[n])); GG[o + 128] = (bf16)f2bf(bf2f(GS[o + 128]) * sigmoidf_(v1 + b[n + 128])); } };

__device__ __forceinline__ void qk_norm_rope(float (&v)[8], const float* gain, bool lat, int t, int lane, const float2* rope) {
    float ss = 0.f;
#pragma unroll
    for (int j = 0; j < 8; ++j) ss += v[j] * v[j];
    ss += __shfl_xor(ss, 1); ss += __shfl_xor(ss, 2); ss += __shfl_xor(ss, 4);
    const float rstd = rsqrtf(ss * (1.f / 64.f) + EPS);
    const int l8 = lane & 7;
#pragma unroll
    for (int j = 0; j < 8; ++j) v[j] = v[j] * rstd * gain[l8 * 8 + j];
    const int quarter = l8 >> 1, pos = (quarter < 2) ? (t >> 6) : (t & 63);
#pragma unroll
    for (int j = 0; j < 8; ++j) {
        const float pv = __shfl_xor(v[j], 2);
        if (lat) { const float2 cs = rope[pos * 16 + (lane & 1) * 8 + j];
            v[j] = (quarter & 1) ? (v[j] * cs.x + pv * cs.y) : (v[j] * cs.x - pv * cs.y); }
    }
}
__device__ __forceinline__ void phase_qkprep(const Ctx& C) {
    const Params& P = *C.p; const bf16* Pb = (const bf16*)(C.ws + WS_P); bf16* Q = (bf16*)(C.ws + WS_Q); bf16* Kb = (bf16*)(C.ws + WS_K); bf16* Vb = (bf16*)(C.ws + WS_V);
    const float2* rope = (const float2*)(C.ws + WS_TAB + TAB_ROPE);
    for (int r = C.gw; r < TT; r += C.ngw) {
        const bool lat = r < TL; const int t = lat ? (r & 2047) : 0;
        const size_t kvrow = lat ? (size_t)(r >> 11) * KVL + CTXL + (r & 2047) : (size_t)((r - TL) >> 8) * KVL + ((r - TL) & 255);
        const bf16* pr = Pb + (size_t)r * MIXW;
        { float v[8]; unpack8(*(const v4u*)(pr + 8 * C.lane), v); qk_norm_rope(v, P.in[I_QG], lat, t, C.lane, rope);
          v4u o; o.x = pk2(v[0] * QSCALE, v[1] * QSCALE); o.y = pk2(v[2] * QSCALE, v[3] * QSCALE); o.z = pk2(v[4] * QSCALE, v[5] * QSCALE); o.w = pk2(v[6] * QSCALE, v[7] * QSCALE);
          *(v4u*)(Q + (size_t)r * 512 + 8 * C.lane) = o; }
        { const int l = C.lane & 15; float v[8]; unpack8(*(const v4u*)(pr + 512 + 8 * l), v); qk_norm_rope(v, P.in[I_KG], lat, t, C.lane, rope);
          if (C.lane < 16) { v4u o; o.x = pk2(v[0], v[1]); o.y = pk2(v[2], v[3]); o.z = pk2(v[4], v[5]); o.w = pk2(v[6], v[7]); *(v4u*)(Kb + kvrow * 128 + 8 * l) = o;
              *(v4u*)(Vb + kvrow * 128 + 8 * l) = *(const v4u*)(pr + 640 + 8 * l); } }
    }
}

__device__ __forceinline__ void phase_gmlp(const Ctx& C) {
    const Params& P = *C.p; const bf16* Pb = (const bf16*)(C.ws + WS_P); bf16* OG = (bf16*)(C.ws + WS_H);
    LAS bf16* VN = (LAS bf16*)C.lds; constexpr int VP = 520;
    const int g = __builtin_amdgcn_readfirstlane(C.tid >> 6);
    for (int ch = blockIdx.x; ch < TT / 128; ch += gridDim.x) {
        for (int i = 0; i < 16; ++i) { const int rl = C.wave * 16 + i; const bf16* pr = Pb + (size_t)(ch * 128 + rl) * MIXW + 1280 + 8 * C.lane;
            float v[8]; unpack8(*(const v4u*)pr, v); float s = 0.f;
#pragma unroll
            for (int j = 0; j < 8; ++j) { v[j] = gelu_tanh(v[j]); s += v[j]; }
            const float mean = wave_sum(s) * (1.f / 512.f); float q = 0.f;
#pragma unroll
            for (int j = 0; j < 8; ++j) { v[j] -= mean; q += v[j] * v[j]; }
            const float rstd = rsqrtf(wave_sum(q) * (1.f / 512.f) + EPS);
#pragma unroll
            for (int j = 0; j < 8; ++j) v[j] = v[j] * rstd * P.in[I_LNG][8 * C.lane + j];
            v4u o; o.x = pk2(v[0], v[1]); o.y = pk2(v[2], v[3]); o.z = pk2(v[4], v[5]); o.w = pk2(v[6], v[7]);
            *(LAS v4u*)(VN + rl * VP + 8 * C.lane) = o; }
        __syncthreads();
        const float* wsp = P.in[I_WSP] + (size_t)g * 128 * 128; const float* bsp = P.in[I_BSP] + g * 128;
        for (int pb = 0; pb < 16; ++pb) {
            float acc[8];
#pragma unroll
            for (int i = 0; i < 8; ++i) acc[i] = 0.f;
            for (int q = 0; q < 128; ++q) { const float v = bf2f(VN[q * VP + C.tid]);
#pragma unroll
                for (int i = 0; i < 8; ++i) acc[i] += wsp[(pb * 8 + i) * 128 + q] * v; }
#pragma unroll
            for (int i = 0; i < 8; ++i) { const int p = pb * 8 + i; const size_t row = (size_t)ch * 128 + p;
                const float u = gelu_tanh(bf2f(Pb[row * MIXW + 768 + C.tid]));
                OG[row * D + 512 + C.tid] = (bf16)f2bf(u * (acc[i] + bsp[p])); }
        }
        __syncthreads();
    }
}

__device__ __forceinline__ void attn_item(const Ctx& C, int b, int h, int qrow_g, int nk) {
    const bf16* Q = (const bf16*)(C.ws + WS_Q); const bf16* Kb = (const bf16*)(C.ws + WS_K) + (size_t)b * KVL * 128 + (h >> 2) * 64; const bf16* Vb = (const bf16*)(C.ws + WS_V) + (size_t)b * KVL * 128 + (h >> 2) * 64;
    bf16* OG = (bf16*)(C.ws + WS_H);
    float q[64];
#pragma unroll
    for (int i = 0; i < 8; ++i) unpack8(*(const v4u*)(Q + (size_t)qrow_g * 512 + h * 64 + 8 * i), q + 8 * i);
    float m = -INFINITY, l = 0.f, o = 0.f;
    for (int kt = 0; kt < nk; kt += 64) {
        const bf16* kr = Kb + (size_t)(kt + C.lane) * 128; float s = 0.f;
#pragma unroll
        for (int i = 0; i < 8; ++i) { float kf[8]; unpack8(*(const v4u*)(kr + 8 * i), kf);
#pragma unroll
            for (int j = 0; j < 8; ++j) s += q[8 * i + j] * kf[j]; }
        const float mn = fmaxf(m, wave_max(s)); const float p = exp2f(s - mn), corr = exp2f(m - mn);
        l = l * corr + wave_sum(p); o *= corr; m = mn;
#pragma unroll 8
        for (int jj = 0; jj < 64; ++jj) { const float pj = __shfl(p, jj); o += pj * bf2f(Vb[(size_t)(kt + jj) * 128 + C.lane]); }
    }
    OG[(size_t)qrow_g * D + h * 64 + C.lane] = (bf16)f2bf(o / l);
}
__device__ __forceinline__ void phase_attn(const Ctx& C) {
    for (int it = C.gw; it < NB * 8 * SEQ; it += C.ngw) { const int bh = it >> 11, t = it & 2047, b = bh >> 3, h = bh & 7; attn_item(C, b, h, b * SEQ + t, KVL); }
    for (int it = C.gw; it < NB * 8 * CTXL; it += C.ngw) { const int bh = it >> 8, t = it & 255, b = bh >> 3, h = bh & 7; attn_item(C, b, h, TL + b * CTXL + t, CTXL); }
}


__device__ __forceinline__ void phase_attn_fast(const Ctx& C, char* lds_generic) {
    typedef attn_body::bf16 abf;
    const abf* Q = (const abf*)(C.ws + WS_Q); const abf* Kb = (const abf*)(C.ws + WS_K); const abf* Vb = (const abf*)(C.ws + WS_V); abf* OG = (abf*)(C.ws + WS_H);
    const int G = gridDim.x, bx = blockIdx.x; const int vcu = (G % 8 == 0) ? (bx % 8) * (G / 8) + bx / 8 : bx;
    const int per = (1024 + G - 1) / G, perc = (128 + G - 1) / G;
    for (int i = 0; i < per + perc; ++i) {
        int b, h, nt; size_t qrow;
        if (i < per) { const int u = vcu * per + i; if (u >= 1024) continue; const int qb = u & 7, hg = (u >> 3) & 3, bk = u >> 5; b = bk >> 1; h = (bk & 1) * 4 + hg; qrow = (size_t)b * SEQ + qb * 256; nt = KVL / 64; }
        else { const int u = vcu + (i - per) * G; if (u >= 128) continue; b = u >> 3; h = u & 7; qrow = (size_t)TL + (size_t)b * CTXL; nt = CTXL / 64; }
        const size_t kvo = (size_t)b * KVL * 128 + (h >> 2) * 64;
        attn_body::attn_unit<8>(Q + qrow * 512 + h * 64, Kb + kvo, Vb + kvo, OG + qrow * 1024 + h * 64, nt, lds_generic);
    }
}

__device__ __forceinline__ void phase_norm_ffn_router(const Ctx& C, int layer, int nrows) {
    const Params& P = *C.p; const float* XC = (const float*)(C.ws + WS_XC); bf16* F = (bf16*)(C.ws + WS_H);
    int* asg_e = (int*)(C.ws + WS_ROUTE + RT_E); int* asg_p = (int*)(C.ws + WS_ROUTE + RT_P); float* asg_w = (float*)(C.ws + WS_ROUTE + RT_W);
    unsigned* cnt = (unsigned*)(C.ws + WS_CTL) + CW_CNT + 64 * layer;
    const float* wg = P.in[I_WGRP] + (size_t)layer * D * 4; const float* wr = P.in[I_WRT] + (size_t)layer * D * 32;
    for (int r = C.gw; r < nrows; r += C.ngw) {
        f32x4 v[4]; load_row16(XC + (size_t)r * D, C.lane, v);
        const float rstd = row_rstd(v); const int ci = cond_of(r);
        modulate16(v, rstd, P.in[I_GFFN] + layer * D, mod_vec(C, layer, ci, 4), mod_vec(C, layer, ci, 3), C.lane);
        store_row16_bf16(F + (size_t)r * D, C.lane, v);
        float lg[4] = {0.f, 0.f, 0.f, 0.f}; float le[32];
#pragma unroll
        for (int i = 0; i < 32; ++i) le[i] = 0.f;
#pragma unroll
        for (int j = 0; j < 4; ++j)
#pragma unroll
            for (int i = 0; i < 4; ++i) { const int c = 4 * C.lane + 256 * j + i; const float f = v[j][i];
                const f32x4 g4 = *(const f32x4*)(wg + (size_t)c * 4); lg[0] += f * g4.x; lg[1] += f * g4.y; lg[2] += f * g4.z; lg[3] += f * g4.w;
#pragma unroll
                for (int e4 = 0; e4 < 8; ++e4) { const f32x4 w4 = *(const f32x4*)(wr + (size_t)c * 32 + e4 * 4); le[e4 * 4] += f * w4.x; le[e4 * 4 + 1] += f * w4.y; le[e4 * 4 + 2] += f * w4.z; le[e4 * 4 + 3] += f * w4.w; } }
#pragma unroll
        for (int i = 0; i < 4; ++i) lg[i] = wave_sum(lg[i]) + P.in[I_BGRP][layer * 4 + i];
#pragma unroll
        for (int i = 0; i < 32; ++i) le[i] = wave_sum(le[i]) + P.in[I_BRT][layer * 32 + i];
        int gi = 0; float gm = lg[0];
#pragma unroll
        for (int i = 1; i < 4; ++i) if (lg[i] > gm) { gm = lg[i]; gi = i; }
        float den = 0.f;
#pragma unroll
        for (int i = 0; i < 4; ++i) den += __expf(lg[i] - gm);
        const float gw_ = 1.f / den;
        float sel[8];
#pragma unroll
        for (int i = 0; i < 8; ++i) sel[i] = gi == 0 ? le[i] : gi == 1 ? le[8 + i] : gi == 2 ? le[16 + i] : le[24 + i];
        int i0 = 0; float v0 = sel[0];
#pragma unroll
        for (int i = 1; i < 8; ++i) if (sel[i] > v0) { v0 = sel[i]; i0 = i; }
        int i1 = -1; float v1 = -INFINITY;
#pragma unroll
        for (int i = 0; i < 8; ++i) if (i != i0 && sel[i] > v1) { v1 = sel[i]; i1 = i; }
        const float e1 = __expf(v1 - v0), w0 = gw_ / (1.f + e1), w1 = gw_ * e1 / (1.f + e1);
        if (C.lane == 0) {
            const int ea = gi * 8 + i0, eb = gi * 8 + i1;
            const unsigned pa = __hip_atomic_fetch_add(cnt + ea, 1u, __ATOMIC_RELAXED, __HIP_MEMORY_SCOPE_AGENT);
            const unsigned pb = __hip_atomic_fetch_add(cnt + eb, 1u, __ATOMIC_RELAXED, __HIP_MEMORY_SCOPE_AGENT);
            asg_e[2 * r] = ea; asg_e[2 * r + 1] = eb; asg_p[2 * r] = (int)pa; asg_p[2 * r + 1] = (int)pb; asg_w[2 * r] = w0; asg_w[2 * r + 1] = w1;
        }
    }
}
__device__ __forceinline__ void phase_gather(const Ctx& C, int layer, int nrows) {
    const bf16* F = (const bf16*)(C.ws + WS_H); bf16* XS = (bf16*)(C.ws + WS_XS);
    const int* asg_e = (const int*)(C.ws + WS_ROUTE + RT_E); const int* asg_p = (const int*)(C.ws + WS_ROUTE + RT_P); int* asg_s = (int*)(C.ws + WS_ROUTE + RT_S);
    int* tile_e = (int*)(C.ws + WS_ROUTE + RT_TILE); int* ntl = (int*)(C.ws + WS_ROUTE + RT_NT);
    unsigned* cnt = (unsigned*)(C.ws + WS_CTL) + CW_CNT + 64 * layer;
    const int mycnt = (C.lane < 32) ? (int)__hip_atomic_load(cnt + C.lane, __ATOMIC_RELAXED, __HIP_MEMORY_SCOPE_AGENT) : 0;
    const int mypad = (mycnt + 255) & ~255;
    int incl = mypad;
#pragma unroll
    for (int o = 1; o < 32; o <<= 1) { const int t = __shfl_up(incl, o); if ((C.lane & 31) >= o) incl += t; }
    const int ps = incl - mypad;
    for (int it = C.gw; it < nrows * 2; it += C.ngw) {
        const int e = asg_e[it], p = asg_p[it]; const int slot = __shfl(ps, e) + p;
        if (C.lane == 0) asg_s[it] = slot;
        const v4u* src = (const v4u*)(F + (size_t)(it >> 1) * D); v4u* dst = (v4u*)(XS + (size_t)slot * D);
        dst[C.lane] = src[C.lane]; dst[64 + C.lane] = src[64 + C.lane];
    }
    for (int e = C.gw; e < 33; e += C.ngw) {
        if (e < 32) { const int c0 = __shfl(mycnt, e), c1 = __shfl(mypad, e), base = __shfl(ps, e);
            for (int rr = c0; rr < c1; ++rr) { v4u* dst = (v4u*)(XS + (size_t)(base + rr) * D); const v4u z = {0u, 0u, 0u, 0u}; dst[C.lane] = z; dst[64 + C.lane] = z; } }
        else { if (C.lane < 32) { for (int t = ps / 256; t < (ps + mypad) / 256; ++t) tile_e[t] = C.lane; if (C.lane == 31) *ntl = (ps + mypad) / 256; } }
    }
}
__device__ __forceinline__ void moe_combine(const Ctx& C, int layer, int r, f32x4 (&v)[4]) {
    const bf16* Y2 = (const bf16*)(C.ws + WS_XS); const int* asg_s = (const int*)(C.ws + WS_ROUTE + RT_S); const float* asg_w = (const float*)(C.ws + WS_ROUTE + RT_W);
    const float* XC = (const float*)(C.ws + WS_XC);
    load_row16(XC + (size_t)r * D, C.lane, v);
    const int s0 = asg_s[2 * r], s1 = asg_s[2 * r + 1]; const float w0 = asg_w[2 * r], w1 = asg_w[2 * r + 1];
    const float* gate = mod_vec(C, layer, cond_of(r), 5);
#pragma unroll
    for (int j = 0; j < 4; ++j) { const int c = 4 * C.lane + 256 * j; const v2u a = *(const v2u*)(Y2 + (size_t)s0 * D + c), b = *(const v2u*)(Y2 + (size_t)s1 * D + c); const f32x4 g = *(const f32x4*)(gate + c);
        v[j].x += g.x * (w0 * bf2f(a.x & 0xffffu) + w1 * bf2f(b.x & 0xffffu)); v[j].y += g.y * (w0 * bf2f(a.x >> 16) + w1 * bf2f(b.x >> 16));
        v[j].z += g.z * (w0 * bf2f(a.y & 0xffffu) + w1 * bf2f(b.y & 0xffffu)); v[j].w += g.w * (w0 * bf2f(a.y >> 16) + w1 * bf2f(b.y >> 16)); }
}
__device__ __forceinline__ void phase_combine_norm_mix1(const Ctx& C) {
    const Params& P = *C.p; float* XC = (float*)(C.ws + WS_XC); bf16* H = (bf16*)(C.ws + WS_H);
    for (int r = C.gw; r < TT; r += C.ngw) {
        f32x4 v[4]; moe_combine(C, 0, r, v);
#pragma unroll
        for (int j = 0; j < 4; ++j) *(f32x4*)(XC + (size_t)r * D + 4 * C.lane + 256 * j) = v[j];
        const float rstd = row_rstd(v); const int ci = cond_of(r);
        modulate16(v, rstd, P.in[I_GMIX] + D, mod_vec(C, 1, ci, 1), mod_vec(C, 1, ci, 0), C.lane);
        store_row16_bf16(H + (size_t)r * D, C.lane, v);
    }
    LAS float* scr = (LAS float*)(C.lds + C.wave * 16384);
    for (int it = C.gw; it < MOE_ITEMS; it += C.ngw) moe_convert_item(C, 1, it, scr);
}
__device__ __forceinline__ void phase_final(const Ctx& C) {
    const Params& P = *C.p;
    for (int r = C.gw; r < TL; r += C.ngw) {
        f32x4 v[4]; moe_combine(C, 1, r, v);
        const float rstd = row_rstd(v);
#pragma unroll
        for (int j = 0; j < 4; ++j) { const int c = 4 * C.lane + 256 * j; const f32x4 g = *(const f32x4*)(P.in[I_FING] + c); *(f32x4*)(P.out + (size_t)r * D + c) = v[j] * rstd * g; }
    }
}

__device__ __forceinline__ void phase_s5(const Ctx& C) {
    const Params& P = *C.p; const bf16* U = (const bf16*)(C.ws + WS_U); bf16* GS = (bf16*)(C.ws + WS_GS); float* YA = (float*)(C.ws + WS_YACC);
    const float2* lamb = (const float2*)(C.ws + WS_TAB + TAB_LAMB); const float2* bbar = (const float2*)(C.ws + WS_TAB + TAB_BBAR);
    LAS f32x2* hb = (LAS f32x2*)(C.lds + C.wave * 8192);
    const int lane = C.lane;
    for (int it = C.gw; it < NB * 32; it += C.ngw) {
        const int b = it >> 5, g = it & 31;
        for (int dir = 0; dir < 2; ++dir) {
            const int dgn = ((dir * 32 + g) * 64 + lane);
            const float2 lam = lamb[dgn]; float2 bb[16];
#pragma unroll
            for (int p = 0; p < 16; ++p) bb[p] = bbar[(size_t)dgn * 16 + p];
            const float* cre = P.in[I_CRE] + (size_t)(dir * 32 + g) * 16 * 64; const float* cim = P.in[I_CIM] + (size_t)(dir * 32 + g) * 16 * 64;
            float hr = 0.f, hi = 0.f;
            for (int ck = 0; ck < 144; ++ck) {
                const bool isl = ck >= 16;
                const int tb = isl ? (dir == 0 ? (ck - 16) * 16 : (143 - ck) * 16) : (dir == 0 ? ck * 16 : (15 - ck) * 16);
                const size_t rowb = isl ? (size_t)b * SEQ + tb : (size_t)TL + (size_t)b * CTXL + tb;
                for (int sl = 0; sl < 16; ++sl) {
                    const int to = dir == 0 ? sl : 15 - sl;
                    const bf16* ur = U + (rowb + to) * 512 + g * 16; float uf[16]; unpack8(*(const v4u*)ur, uf); unpack8(*(const v4u*)(ur + 8), uf + 8);
                    float br = 0.f, bi = 0.f;
#pragma unroll
                    for (int p = 0; p < 16; ++p) { br += bb[p].x * uf[p]; bi += bb[p].y * uf[p]; }
                    const float nr = lam.x * hr - lam.y * hi + br, ni = lam.x * hi + lam.y * hr + bi; hr = nr; hi = ni;
                    if (isl) hb[to * 64 + lane] = (f32x2){hr, hi};
                }
                if (isl) {
                    asm volatile("s_waitcnt lgkmcnt(0)" ::: "memory");
                    const int p = lane & 15;
#pragma unroll
                    for (int i = 0; i < 4; ++i) { const int to = (lane >> 4) + 4 * i; float y = 0.f;
                        for (int n = 0; n < 64; ++n) { const f32x2 h = hb[to * 64 + n]; y += cre[p * 64 + n] * h.x - cim[p * 64 + n] * h.y; }
                        const size_t o = (rowb + to) * 512 + g * 16 + p;
                        if (dir == 0) YA[o] = y + P.in[I_S5D][g * 16 + p] * bf2f(U[o]);
                        else GS[o] = (bf16)f2bf(gelu_tanh(YA[o] + y)); }
                    asm volatile("s_waitcnt lgkmcnt(0)" ::: "memory");
                }
            }
        }
    }
}

__global__ void __launch_bounds__(NTHR, 2) fwd_kernel(Params prm) {
    extern __shared__ __attribute__((aligned(16))) unsigned char lds_raw[];
    Ctx C; C.p = &prm; C.ws = prm.ws; C.lds = (LAS unsigned char*)lds_raw;
    C.tid = threadIdx.x; C.lane = C.tid & 63; C.wave = __builtin_amdgcn_readfirstlane(C.tid >> 6);
    C.gw = blockIdx.x * NWAVE + C.wave; C.ngw = gridDim.x * NWAVE;
    constexpr int LDS_MISC = 147456 - 256;
    volatile LAS unsigned* misc = (volatile LAS unsigned*)(C.lds + LDS_MISC);
    if (C.tid < 64) misc[C.tid] = 0u;
    __syncthreads();
    unsigned* ctl = (unsigned*)(C.ws + WS_CTL);
    XcdBarrier bar; bar.bar = ctl + CW_BAR; bar.x = 0; bar.st = nullptr;
#if MK_ONE_LAUNCH
    bar = xcd_barrier_post(ctl + CW_BAR, misc + 8);
#define SEAM(k) do { if (lo <= (k) && (k) + 1 < hi) xcd_barrier(bar); } while (0)
#else
#define SEAM(k) do { } while (0)
#endif
    const int lo = prm.ph_lo, hi = prm.ph_hi;
#define IN(k) (lo <= (k) && (k) < hi)
    const Params& P = prm;
    bf16* Hb = (bf16*)(C.ws + WS_H); float* XC = (float*)(C.ws + WS_XC);
#define MOE_GEMM1() do { const int ntl_ = *(const int*)(C.ws + WS_ROUTE + RT_NT); pg8::Gemm g{(const bf16*)(C.ws + WS_XS), (const bf16*)(C.ws + WS_W13), 0, 1024, D}; \
        pg8::GroupedOrder S{(const int*)(C.ws + WS_ROUTE + RT_TILE), ntl_ * 4, 4, (int)gridDim.x, (int)blockIdx.x, (size_t)1024 * 1024 * 2}; pg8::EpiSwiglu E{(bf16*)(C.ws + WS_G13)}; \
        pg8::gemm_phase<pg8::EpiSwiglu, pg8::GroupedOrder, true, true>(C.lds, g, S, E); } while (0)
#define MOE_GEMM2() do { const int ntl_ = *(const int*)(C.ws + WS_ROUTE + RT_NT); pg8::Gemm g{(const bf16*)(C.ws + WS_G13), (const bf16*)(C.ws + WS_W2), 0, 1024, EH}; \
        pg8::GroupedOrder S{(const int*)(C.ws + WS_ROUTE + RT_TILE), ntl_ * 4, 4, (int)gridDim.x, (int)blockIdx.x, (size_t)1024 * 512 * 2}; pg8::EpiStore E{(bf16*)(C.ws + WS_XS), D}; \
        pg8::gemm_phase<pg8::EpiStore, pg8::GroupedOrder, true, true>(C.lds, g, S, E); } while (0)
    if (IN(0)) { phase_prologue(C); SEAM(0); }
    if (IN(1)) { phase_norm_mix0(C); SEAM(1); }
    if (IN(2)) { pg8::Gemm g{Hb, (const bf16*)(C.ws + WS_WIN0), TT, MIXW, D}; pg8::StaticOrder S; S.init(TT, MIXW, gridDim.x, blockIdx.x); pg8::EpiStore E{(bf16*)(C.ws + WS_P), MIXW};
        pg8::gemm_phase<pg8::EpiStore, pg8::StaticOrder, true, true>(C.lds, g, S, E); SEAM(2); }
    if (IN(3)) { phase_qkprep(C); phase_gmlp(C); SEAM(3); }
    if (IN(4)) { phase_attn_fast(C, (char*)lds_raw); SEAM(4); }
    if (IN(5)) { pg8::Gemm g{Hb, (const bf16*)(C.ws + WS_WOUT0), TT, D, D}; pg8::StaticOrder S; S.init(TT, D, gridDim.x, blockIdx.x); pg8::EpiResid E{P.in[I_X], P.in[I_CTX], (const float*)(C.ws + WS_MOD), XC, 0};
        pg8::gemm_phase<pg8::EpiResid, pg8::StaticOrder, true, true>(C.lds, g, S, E); SEAM(5); }
    if (IN(6)) { phase_norm_ffn_router(C, 0, TT); SEAM(6); }
    if (IN(7)) { phase_gather(C, 0, TT); SEAM(7); }
    if (IN(8)) { MOE_GEMM1(); SEAM(8); }
    if (IN(9)) { MOE_GEMM2(); SEAM(9); }
    if (IN(10)) { phase_combine_norm_mix1(C); SEAM(10); }
    if (IN(11)) { pg8::Gemm g{Hb, (const bf16*)(C.ws + WS_WS5IN), TT, 512, D}; pg8::StaticOrder S; S.init(TT, 512, gridDim.x, blockIdx.x); pg8::EpiStore E{(bf16*)(C.ws + WS_U), 512};
        pg8::gemm_phase<pg8::EpiStore, pg8::StaticOrder, true, true>(C.lds, g, S, E); SEAM(11); }
    if (IN(12)) { phase_s5(C); SEAM(12); }
    if (IN(13)) { pg8::Gemm g{(const bf16*)(C.ws + WS_GS), (const bf16*)(C.ws + WS_WGLU), TL, 512, 512}; pg8::StaticOrder S; S.init(TL, 512, gridDim.x, blockIdx.x); pg8::EpiGlu E{(const bf16*)(C.ws + WS_GS), P.in[I_BGLU], (bf16*)(C.ws + WS_GG)};
        pg8::gemm_phase<pg8::EpiGlu, pg8::StaticOrder, true, true>(C.lds, g, S, E); SEAM(13); }
    if (IN(14)) { pg8::Gemm g{(const bf16*)(C.ws + WS_GG), (const bf16*)(C.ws + WS_WS5OUT), TL, D, 512}; pg8::StaticOrder S; S.init(TL, D, gridDim.x, blockIdx.x); pg8::EpiResid E{P.in[I_X], P.in[I_CTX], (const float*)(C.ws + WS_MOD) + (size_t)17 * 6 * D, XC, 1};
        pg8::gemm_phase<pg8::EpiResid, pg8::StaticOrder, true, true>(C.lds, g, S, E); SEAM(14); }
    if (IN(15)) { phase_norm_ffn_router(C, 1, TL); SEAM(15); }
    if (IN(16)) { phase_gather(C, 1, TL); SEAM(16); }
    if (IN(17)) { MOE_GEMM1(); SEAM(17); }
    if (IN(18)) { MOE_GEMM2(); SEAM(18); }
    if (IN(19)) { phase_final(C); }
#undef IN
#undef SEAM
}

extern "C" void kernel_launch(void* const* d_in, const int* in_sizes, int n_in, void* d_out, int out_size, void* d_ws, size_t ws_size, hipStream_t stream) {
    constexpr int LDS_BYTES = 147456;
    static int grid = 0;
    if (grid == 0) {
        if (n_in != 35 || out_size != TL * D || ws_size < WS_END) { fprintf(stderr, "kernel_launch: unexpected shapes (n_in %d out %d ws %zu)\n", n_in, out_size, ws_size); grid = -1; return; }
        int dev = 0, cus = 0;
        if (hipGetDevice(&dev) != hipSuccess || hipDeviceGetAttribute(&cus, hipDeviceAttributeMultiprocessorCount, dev) != hipSuccess) { grid = -1; return; }
        if (hipFuncSetAttribute((const void*)fwd_kernel, hipFuncAttributeMaxDynamicSharedMemorySize, LDS_BYTES) != hipSuccess) { fprintf(stderr, "kernel_launch: hipFuncSetAttribute failed\n"); grid = -1; return; }
        (void)hipGetLastError();
        grid = cus;
    }
    if (grid < 0) return;
    (void)hipMemsetAsync((char*)d_ws + WS_CTL, 0, CTL_BYTES, stream);
    Params p{};
    for (int i = 0; i < 35; ++i) p.in[i] = (const float*)d_in[i];
    p.out = (float*)d_out; p.ws = (unsigned char*)d_ws;
#if MK_ONE_LAUNCH
    p.ph_lo = 0; p.ph_hi = NPHASE;
    hipLaunchKernelGGL(fwd_kernel, dim3(grid), dim3(NTHR), LDS_BYTES, stream, p);
#else
    for (int k = 0; k < NPHASE; ++k) { p.ph_lo = k; p.ph_hi = k + 1; hipLaunchKernelGGL(fwd_kernel, dim3(grid), dim3(NTHR), LDS_BYTES, stream, p); }
#endif
}
```

```cpp
#include <hip/hip_runtime.h>
#include <cstdio>
#include <cstdint>

#ifndef MK_ONE_LAUNCH
#define MK_ONE_LAUNCH 1
#endif

constexpr int D = 1024, NB = 16, SEQ = 2048, CTXL = 256;
constexpr int TL = NB * SEQ, TC = NB * CTXL, TT = TL + TC;
constexpr int KVL = CTXL + SEQ;
constexpr int MIXW = 1792, NEXP = 32, EH = 512;
constexpr int NSLOT = 81920;
constexpr float EPS = 1e-6f;
constexpr float QSCALE = 0.125f * 1.4426950408889634f;
constexpr int NTHR = 512, NWAVE = 8;
constexpr int NPHASE = 20;

constexpr size_t MiB = 1u << 20;
constexpr size_t WS_CTL = 0, CTL_BYTES = 1 * MiB;
constexpr size_t WS_MOD = 1 * MiB;
constexpr size_t WS_TAB = 2 * MiB;
constexpr size_t TAB_ROPE = 0, TAB_LAMB = 16384, TAB_BBAR = 65536;
constexpr size_t WS_ROUTE = 3 * MiB;
constexpr size_t RT_E = 0, RT_P = 320 * 1024, RT_W = 640 * 1024, RT_S = 960 * 1024, RT_TILE = 1280 * 1024, RT_NT = 1280 * 1024 + 4096;
constexpr size_t WS_WIN0 = 6 * MiB, WS_WOUT0 = 10 * MiB, WS_WS5IN = 12 * MiB, WS_WGLU = 13 * MiB, WS_WS5OUT = 14 * MiB;
constexpr size_t WS_W13 = 16 * MiB, WS_W2 = 80 * MiB;
constexpr size_t WS_XC = 112 * MiB;
constexpr size_t WS_H = 256 * MiB;
constexpr size_t WS_P = 328 * MiB;
constexpr size_t WS_Q = 454 * MiB, WS_K = 490 * MiB, WS_V = 499 * MiB;
constexpr size_t WS_XS = 328 * MiB;
constexpr size_t WS_G13 = 488 * MiB;
constexpr size_t WS_U = 328 * MiB, WS_GS = 364 * MiB, WS_GG = 396 * MiB, WS_YACC = 428 * MiB;
constexpr size_t WS_END = 568 * MiB;
constexpr int CW_CNT = 64;
constexpr int CW_BAR = 4096;

#define LAS __attribute__((address_space(3)))
typedef unsigned short bf16;
typedef unsigned v4u __attribute__((ext_vector_type(4)));
typedef unsigned v2u __attribute__((ext_vector_type(2)));
typedef float f32x4 __attribute__((ext_vector_type(4)));
typedef float f32x2 __attribute__((ext_vector_type(2)));
__device__ __forceinline__ float bf2f(unsigned u) { return __uint_as_float(u << 16); }
__device__ __forceinline__ unsigned f2bf(float f) { unsigned u = __float_as_uint(f); return (u + 0x7fffu + ((u >> 16) & 1u)) >> 16; }
__device__ __forceinline__ unsigned pk2(float lo, float hi) { return f2bf(lo) | (f2bf(hi) << 16); }
__device__ __forceinline__ float wave_sum(float v) {
#pragma unroll
    for (int o = 1; o < 64; o <<= 1) v += __shfl_xor(v, o);
    return v;
}
__device__ __forceinline__ float wave_max(float v) {
#pragma unroll
    for (int o = 1; o < 64; o <<= 1) v = fmaxf(v, __shfl_xor(v, o));
    return v;
}
__device__ __forceinline__ float gelu_tanh(float x) { const float u = 0.7978845608028654f * (x + 0.044715f * x * x * x); return 0.5f * x * (1.f + tanhf(u)); }
__device__ __forceinline__ float sigmoidf_(float x) { return 1.f / (1.f + __expf(-x)); }
__device__ __forceinline__ float silu_(float x) { return x / (1.f + __expf(-x)); }
__device__ __forceinline__ void unpack8(const v4u w, float* f) {
    f[0] = bf2f(w.x & 0xffffu); f[1] = bf2f(w.x >> 16); f[2] = bf2f(w.y & 0xffffu); f[3] = bf2f(w.y >> 16);
    f[4] = bf2f(w.z & 0xffffu); f[5] = bf2f(w.z >> 16); f[6] = bf2f(w.w & 0xffffu); f[7] = bf2f(w.w >> 16);
}

#define XB_TMO      128
#define XB_XCNT(j)  (256  + 64 * (j))
#define XB_XSUB(j)  (1280 + 64 * (j))
#define XB_XGEN(j)  (2304 + 64 * (j))
#define XB_TOP      3328
#define XB_TOPGEN   3392
#define XCD_BAR_WORDS 3456
#define XB_SPIN_CAP (1u << 28)
__device__ __forceinline__ unsigned xb_ld(unsigned* p)              { return __hip_atomic_load(p, __ATOMIC_RELAXED, __HIP_MEMORY_SCOPE_AGENT); }
__device__ __forceinline__ unsigned xb_add(unsigned* p, unsigned v) { return __hip_atomic_fetch_add(p, v, __ATOMIC_RELAXED, __HIP_MEMORY_SCOPE_AGENT); }
__device__ __forceinline__ unsigned xb_xcc_id() { return (unsigned)__builtin_amdgcn_s_getreg((3 << 11) | 20) & 0xFu; }
#define XB_SPIN(cond, bar) do { unsigned _sp = 0; while (cond) { __builtin_amdgcn_s_sleep(1); \
    if ((++_sp & 255u) == 0u) { if (xb_ld(&(bar)[XB_TMO])) break; if (_sp > XB_SPIN_CAP) { atomicAdd(&(bar)[XB_TMO], 1u); break; } } } } while (0)
struct XcdBarrier { unsigned* bar; unsigned x; volatile LAS unsigned* st; };
__device__ __forceinline__ XcdBarrier xcd_barrier_post(unsigned* bar, volatile LAS unsigned* st) {
    XcdBarrier b; b.bar = bar; b.x = xb_xcc_id(); b.st = st;
    if (threadIdx.x == 0) (void)xb_add(&bar[XB_XCNT(b.x)], 1u);
    return b;
}
__device__ __forceinline__ void xcd_barrier_complete(unsigned* bar, unsigned x, unsigned& nloc, unsigned& nx) {
    const unsigned G = gridDim.x * gridDim.y * gridDim.z;
    unsigned sum, cnt, mine, sp = 0u;
    for (;;) {
        sum = 0u; cnt = 0u; mine = 0u;
#pragma unroll
        for (unsigned j = 0; j < 16; ++j) { const unsigned c = xb_ld(&bar[XB_XCNT(j)]); sum += c; cnt += (c > 0u) ? 1u : 0u; mine = (j == x) ? c : mine; }
        if (sum == G) break;
        __builtin_amdgcn_s_sleep(1);
        if ((++sp & 255u) == 0u) { if (xb_ld(&bar[XB_TMO])) break; if (sp > XB_SPIN_CAP) { atomicAdd(&bar[XB_TMO], 1u); break; } }
    }
    nloc = mine > 0u ? mine : 1u; nx = cnt > 0u ? cnt : 1u;
}
__device__ __forceinline__ void xcd_barrier(const XcdBarrier& b) {
    asm volatile("s_waitcnt vmcnt(0)" ::: "memory");
    __syncthreads();
    if (threadIdx.x == 0) {
        unsigned* bar = b.bar;
        __builtin_amdgcn_s_waitcnt(0);
        unsigned nloc = b.st[0], nx = b.st[1];
        if (nloc == 0u) { xcd_barrier_complete(bar, b.x, nloc, nx); b.st[0] = nloc; b.st[1] = nx; }
        const unsigned old = xb_add(&bar[XB_XSUB(b.x)], 1u);
        const unsigned gen = old / nloc;
        if (old + 1u == (gen + 1u) * nloc) {
            __builtin_amdgcn_fence(__ATOMIC_RELEASE, "agent");
            asm volatile("s_waitcnt vmcnt(0)" ::: "memory");
            const unsigned og = xb_add(&bar[XB_TOP], 1u);
            const unsigned tg = og / nx;
            if (og + 1u == (tg + 1u) * nx) xb_add(&bar[XB_TOPGEN], 1u);
            else XB_SPIN(xb_ld(&bar[XB_TOPGEN]) == tg, bar);
            __builtin_amdgcn_fence(__ATOMIC_ACQUIRE, "agent");
            xb_add(&bar[XB_XGEN(b.x)], 1u);
            asm volatile("s_waitcnt vmcnt(0)" ::: "memory");
        } else {
            XB_SPIN(xb_ld(&bar[XB_XGEN(b.x)]) == gen, bar);
            __builtin_amdgcn_fence(__ATOMIC_ACQUIRE, "agent");
            asm volatile("s_waitcnt vmcnt(0)" ::: "memory");
        }
    }
    __syncthreads();
}

namespace pg8 {
#define PG8_LAS __attribute__((address_space(3)))
typedef unsigned short bf16_t;
typedef short bf16x8 __attribute__((ext_vector_type(8)));
typedef float f32x4 __attribute__((ext_vector_type(4)));
typedef unsigned u32x4 __attribute__((ext_vector_type(4)));
constexpr int BM = 256, BK = 64, HALF = 128, HTB = HALF * BK * 2  , STAGE_BYTES = 8 * HTB, NXCD = 8, WGM = 8;

__host__ __device__ __forceinline__ int lds_byte(int r, int c) { const int st = (r >> 4) * 2 + (c >> 5), rr = r & 15, cc = c & 31, ob = rr * 64 + cc * 2; return st * 1024 + (ob ^ (((ob >> 9) & 1) << 5)); }
__host__ __device__ __forceinline__ void stage_rc(int b, int& R, int& C) { const int st = b / 1024, sb = b % 1024, swz = sb ^ (((sb >> 9) & 1) << 5); R = (st >> 1) * 16 + swz / 64; C = (st & 1) * 32 + (swz % 64) / 2; }
__host__ __device__ __forceinline__ int perm32(int rho) { const int n = rho >> 4, i = rho & 15; return 8 * (i >> 2) + 4 * n + (i & 3); }

struct Unit { int pm, pn; size_t bo; };
struct Gemm { const bf16_t* A; const bf16_t* Bt; int M, N, K; };

struct StaticOrder {
    int nM, nN, nwg, G, c;
    __host__ __device__ void init(int M, int N, int G_, int c_) { nM = M / BM; nN = N / BM; nwg = nM * nN; G = G_; c = c_; }
    __host__ __device__ bool next(int i, Unit& u) const {
        const long L = (long)i * G + c; if (L >= nwg) return false;
        int wgid = (int)L; { const int q = nwg / NXCD, r = nwg % NXCD, xcd = wgid % NXCD, off = wgid / NXCD; wgid = (xcd < r ? xcd * (q + 1) : r * (q + 1) + (xcd - r) * q) + off; }
        const int nig = WGM * nN, gid = wgid / nig, fm = gid * WGM, gsz = (nM - fm) < WGM ? (nM - fm) : WGM;
        u.pm = fm + ((wgid % nig) % gsz); u.pn = (wgid % nig) / gsz; u.bo = 0; return true;
    }
    __device__ __forceinline__ void a_ready(const Unit&) const {}
    __device__ __forceinline__ void done(const Unit&) const {}
};

__device__ __forceinline__ unsigned cvt_pk_bf16(float lo, float hi) { unsigned r; asm volatile("v_cvt_pk_bf16_f32 %0, %1, %2" : "=v"(r) : "v"(lo), "v"(hi)); return r; }
typedef float f32x2 __attribute__((ext_vector_type(2)));
__device__ __forceinline__ f32x2 gelu_pk(f32x2 v) {
    const f32x2 av = __builtin_elementwise_abs(v), d = av * 0.2316418882f + 1.0f;
    f32x2 t; t.x = __builtin_amdgcn_rcpf(d.x); t.y = __builtin_amdgcn_rcpf(d.y);
    f32x2 q = t * 0.5307027145f + (-0.7265760135f); q = q * t + 0.7107068705f; q = q * t + (-0.142248368f); q = q * t + 0.127414796f; q = q * t;
    const f32x2 s = (v * v) * (-0.72134752044f);
    f32x2 e; e.x = __builtin_amdgcn_exp2f(s.x); e.y = __builtin_amdgcn_exp2f(s.y);
    const f32x2 m = v * (q * e), r = v - m;
    f32x2 o; o.x = v.x < 0.f ? m.x : r.x; o.y = v.y < 0.f ? m.y : r.y; return o;
}

template <class Epi, class Sched, bool ALIGN_EPI = false, bool SP2 = false>
__device__ __forceinline__ void gemm_phase(PG8_LAS unsigned char* lds, const Gemm g, const Sched& S, const Epi& E) {
    const int tid = threadIdx.x, wid = __builtin_amdgcn_readfirstlane(tid >> 6), lane = tid & 63, wr = wid >> 2, wc = wid & 3, fr = lane & 15, fq = lane >> 4;
    const int K = g.K, nt = K / BK;
    unsigned voffA[2], voffB[2];
#pragma unroll
    for (int i = 0; i < 2; ++i) { int R, C; stage_rc(tid * 16 + i * 8192, R, C); const int Rb = Epi::PERM ? ((R & ~31) + perm32(R & 31)) : R;
        voffA[i] = (unsigned)(R * K + C) * 2u; voffB[i] = (unsigned)(Rb * K + C) * 2u; }
    const size_t kstep = (size_t)(BK * 2);
    const size_t hstep = (size_t)HALF * K * 2;
    const size_t tstep = 2 * hstep;
    const unsigned ldsw = (unsigned)wid * 1024u;
    const int aoff = lds_byte(wr * 64 + fr, fq * 8), boff = lds_byte(wc * 32 + fr, fq * 8);
#define PG8_SA(b, h) (((b) * 2 + (h)) * HTB)
#define PG8_SB(b, h) ((4 + (b) * 2 + (h)) * HTB)
#define PG8_STAGE(bufoff, gbase, voff) do { _Pragma("unroll") for (int _i = 0; _i < 2; ++_i) \
        __builtin_amdgcn_global_load_lds((const unsigned*)((const char*)(gbase) + (voff)[_i]), (PG8_LAS unsigned*)(lds + (bufoff) + ldsw + _i * 8192), 16, 0, 0); } while (0)
#define PG8_LDA(dst, b, h) do { _Pragma("unroll") for (int m = 0; m < 4; ++m) _Pragma("unroll") for (int k = 0; k < 2; ++k) dst[m][k] = *(const PG8_LAS bf16x8*)(lds + PG8_SA(b, h) + aoff + m * 2048 + k * 1024); } while (0)
#define PG8_LDB(dst, b, h) do { _Pragma("unroll") for (int n = 0; n < 2; ++n) _Pragma("unroll") for (int k = 0; k < 2; ++k) dst[n][k] = *(const PG8_LAS bf16x8*)(lds + PG8_SB(b, h) + boff + n * 2048 + k * 1024); } while (0)
#define PG8_MMA(ai, bj, At, Bt) do { __builtin_amdgcn_s_setprio(1); _Pragma("unroll") for (int m = 0; m < 4; ++m) _Pragma("unroll") for (int n = 0; n < 2; ++n) _Pragma("unroll") for (int k = 0; k < 2; ++k) \
        acc[ai][bj][m][n] = __builtin_amdgcn_mfma_f32_16x16x32_bf16(Bt[n][k], At[m][k], acc[ai][bj][m][n], 0, 0, 0); __builtin_amdgcn_s_setprio(0); } while (0)
#define PG8_WAIT_V(n) asm volatile("s_waitcnt vmcnt(" #n ")" ::: "memory")
#define PG8_WAIT_L(n) asm volatile("s_waitcnt lgkmcnt(" #n ")" ::: "memory")
#define PG8_BAR __builtin_amdgcn_s_barrier()
#define PG8_SCHED __builtin_amdgcn_sched_barrier(0)
    Unit cur, nxt; int ui = 0;
    if (!S.next(0, cur)) return;
    f32x4 acc[2][2][4][2];
#pragma unroll
    for (int a = 0; a < 2; ++a)
#pragma unroll
        for (int b = 0; b < 2; ++b)
#pragma unroll
            for (int m = 0; m < 4; ++m)
#pragma unroll
                for (int n = 0; n < 2; ++n) acc[a][b][m][n] = (f32x4){0.f, 0.f, 0.f, 0.f};
    bf16x8 At[4][2], B0[2][2], B1[2][2];
    const char* cA = (const char*)g.A + (size_t)cur.pm * tstep; const char* cB = (const char*)g.Bt + cur.bo + (size_t)cur.pn * tstep;
    S.a_ready(cur);
    if constexpr (SP2) {
        PG8_STAGE(PG8_SB(0, 0), cB, voffB); PG8_STAGE(PG8_SB(0, 1), cB + hstep, voffB); PG8_STAGE(PG8_SA(0, 0), cA, voffA); PG8_STAGE(PG8_SA(0, 1), cA + hstep, voffA);
        if (wr == 1) PG8_BAR;
        PG8_WAIT_V(2); PG8_BAR;
        PG8_STAGE(PG8_SB(1, 0), cB + kstep, voffB); PG8_STAGE(PG8_SA(1, 0), cA + kstep, voffA); PG8_STAGE(PG8_SB(1, 1), cB + hstep + kstep, voffB);
        PG8_WAIT_V(6); PG8_BAR;
    } else {
        PG8_STAGE(PG8_SB(0, 0), cB, voffB); PG8_STAGE(PG8_SA(0, 0), cA, voffA); PG8_STAGE(PG8_SB(0, 1), cB + hstep, voffB); PG8_STAGE(PG8_SA(0, 1), cA + hstep, voffA);
        if (wr == 1) PG8_BAR;
        PG8_WAIT_V(4); PG8_BAR;
        PG8_STAGE(PG8_SB(1, 0), cB + kstep, voffB); PG8_STAGE(PG8_SA(1, 0), cA + kstep, voffA); PG8_STAGE(PG8_SB(1, 1), cB + hstep + kstep, voffB);
        PG8_WAIT_V(6); PG8_BAR;
    }
    for (;;) {
        const bool has_next = S.next(ui + 1, nxt);
        const char* nA = has_next ? (const char*)g.A + (size_t)nxt.pm * tstep : cA; const char* nB = has_next ? (const char*)g.Bt + nxt.bo + (size_t)nxt.pn * tstep : cB;
        for (int t = 0; t < nt; t += 2) {
            const bool last = (t == nt - 2);
            const char* a1 = cA + (size_t)(t + 1) * kstep;
            const char* a2 = last ? nA : cA + (size_t)(t + 2) * kstep; const char* b2 = last ? nB : cB + (size_t)(t + 2) * kstep;
            const char* a3 = a2 + kstep; const char* b3 = b2 + kstep;
            if (last && has_next) S.a_ready(nxt);
            if constexpr (SP2) {
            PG8_LDB(B0, 0, 0); PG8_LDB(B1, 0, 1); PG8_SCHED; PG8_LDA(At, 0, 0); PG8_STAGE(PG8_SA(1, 1), a1 + hstep, voffA);
            PG8_WAIT_V(8); PG8_WAIT_L(0); PG8_BAR; PG8_MMA(0, 0, At, B0); PG8_MMA(0, 1, At, B1); PG8_BAR; PG8_SCHED;
            PG8_LDA(At, 0, 1); PG8_STAGE(PG8_SB(0, 0), b2, voffB); PG8_STAGE(PG8_SB(0, 1), b2 + hstep, voffB); PG8_STAGE(PG8_SA(0, 0), a2, voffA);
            PG8_WAIT_V(8); PG8_WAIT_L(0); PG8_BAR; PG8_MMA(1, 0, At, B0); PG8_MMA(1, 1, At, B1); PG8_BAR; PG8_SCHED;
            PG8_LDB(B0, 1, 0); PG8_LDB(B1, 1, 1); PG8_SCHED; PG8_LDA(At, 1, 0); PG8_STAGE(PG8_SA(0, 1), a2 + hstep, voffA);
            PG8_WAIT_V(8); PG8_WAIT_L(0); PG8_BAR; PG8_MMA(0, 0, At, B0); PG8_MMA(0, 1, At, B1); PG8_BAR; PG8_SCHED;
            PG8_LDA(At, 1, 1); PG8_STAGE(PG8_SB(1, 0), b3, voffB); PG8_STAGE(PG8_SB(1, 1), b3 + hstep, voffB); PG8_STAGE(PG8_SA(1, 0), a3, voffA);
            PG8_WAIT_V(8); PG8_WAIT_L(0); PG8_BAR; PG8_MMA(1, 0, At, B0); PG8_MMA(1, 1, At, B1); PG8_BAR; PG8_SCHED;
            } else {
            PG8_LDB(B0, 0, 0); PG8_SCHED; PG8_LDA(At, 0, 0); PG8_STAGE(PG8_SA(1, 1), a1 + hstep, voffA);
            PG8_WAIT_L(8); PG8_BAR; PG8_WAIT_L(0); PG8_MMA(0, 0, At, B0); PG8_BAR; PG8_SCHED;
            PG8_LDB(B1, 0, 1); PG8_STAGE(PG8_SB(0, 0), b2, voffB);
            PG8_BAR; PG8_WAIT_L(0); PG8_MMA(0, 1, At, B1); PG8_BAR;
            PG8_LDA(At, 0, 1); PG8_STAGE(PG8_SA(0, 0), a2, voffA);
            PG8_BAR; PG8_WAIT_L(0); PG8_MMA(1, 0, At, B0); PG8_BAR; PG8_SCHED;
            PG8_STAGE(PG8_SB(0, 1), b2 + hstep, voffB);
            PG8_WAIT_V(6); PG8_BAR; PG8_MMA(1, 1, At, B1); PG8_BAR;
            PG8_LDB(B0, 1, 0); PG8_SCHED; PG8_LDA(At, 1, 0); PG8_STAGE(PG8_SA(0, 1), a2 + hstep, voffA);
            PG8_WAIT_L(8); PG8_BAR; PG8_WAIT_L(0); PG8_MMA(0, 0, At, B0); PG8_BAR; PG8_SCHED;
            PG8_LDB(B1, 1, 1); PG8_STAGE(PG8_SB(1, 0), b3, voffB);
            PG8_BAR; PG8_WAIT_L(0); PG8_MMA(0, 1, At, B1); PG8_BAR;
            PG8_LDA(At, 1, 1); PG8_STAGE(PG8_SA(1, 0), a3, voffA);
            PG8_BAR; PG8_WAIT_L(0); PG8_MMA(1, 0, At, B0); PG8_BAR; PG8_SCHED;
            PG8_STAGE(PG8_SB(1, 1), b3 + hstep, voffB);
            PG8_WAIT_V(6); PG8_BAR; PG8_MMA(1, 1, At, B1); PG8_BAR;
            }
        }
        if constexpr (ALIGN_EPI) { if (wr == 0) PG8_BAR; }
        if constexpr (!Epi::AFTER_DRAIN) { E(acc, cur, wr, wc, fr, fq); S.done(cur); }
        if (!has_next) break;
#pragma unroll
        for (int a = 0; a < 2; ++a)
#pragma unroll
            for (int b = 0; b < 2; ++b)
#pragma unroll
                for (int m = 0; m < 4; ++m)
#pragma unroll
                    for (int n = 0; n < 2; ++n) acc[a][b][m][n] = (f32x4){0.f, 0.f, 0.f, 0.f};
        cur = nxt; cA = nA; cB = nB; ++ui;
        if constexpr (ALIGN_EPI) { if (wr == 1) PG8_BAR; }
    }
    PG8_WAIT_V(0);
    if constexpr (!ALIGN_EPI) { if (wr == 0) PG8_BAR; }
    PG8_BAR;
    if constexpr (Epi::AFTER_DRAIN) { E.fused(acc, cur, wr, wc, fr, fq, lds, wid, lane); S.done(cur); }
#undef PG8_SA
#undef PG8_SB
#undef PG8_STAGE
#undef PG8_LDA
#undef PG8_LDB
#undef PG8_MMA
#undef PG8_WAIT_V
#undef PG8_WAIT_L
#undef PG8_BAR
#undef PG8_SCHED
}
}

namespace pg8 {
struct GroupedOrder {
    const int* tile_e; int nU, nN, G, c; size_t estride;
    __device__ __forceinline__ bool next(int i, Unit& u) const { const long L = (long)i * G + c; if (L >= nU) return false; const int t = (int)L / nN; u.pm = t; u.pn = (int)L % nN; u.bo = (size_t)tile_e[t] * estride; return true; }
    __device__ __forceinline__ void a_ready(const Unit&) const {}
    __device__ __forceinline__ void done(const Unit&) const {}
};
__device__ __forceinline__ u32x4 pack8(const f32x4 a, const f32x4 b) { u32x4 w; w.x = cvt_pk_bf16(a[0], a[1]); w.y = cvt_pk_bf16(a[2], a[3]); w.z = cvt_pk_bf16(b[0], b[1]); w.w = cvt_pk_bf16(b[2], b[3]); return w; }
struct EpiStore {
    static constexpr bool PERM = true, AFTER_DRAIN = false; bf16_t* O; int ldc;
    __device__ __forceinline__ void operator()(const f32x4 (&acc)[2][2][4][2], const Unit& u, int wr, int wc, int fr, int fq) const {
        const int row0 = u.pm * BM + wr * 64 + fr, col0 = u.pn * BM + wc * 32 + 8 * fq;
#pragma unroll
        for (int ai = 0; ai < 2; ++ai)
#pragma unroll
            for (int m = 0; m < 4; ++m) { bf16_t* rowp = O + (size_t)(row0 + ai * HALF + m * 16) * ldc + col0;
#pragma unroll
                for (int bj = 0; bj < 2; ++bj) *(u32x4*)(rowp + bj * HALF) = pack8(acc[ai][bj][m][0], acc[ai][bj][m][1]); }
    }
};
__device__ __forceinline__ f32x4 silu4(const f32x4 v) { f32x4 r;
#pragma unroll
    for (int i = 0; i < 4; ++i) r[i] = v[i] * __builtin_amdgcn_rcpf(1.f + __expf(-v[i])); return r; }
__device__ __forceinline__ f32x4 sigm4(const f32x4 v) { f32x4 r;
#pragma unroll
    for (int i = 0; i < 4; ++i) r[i] = __builtin_amdgcn_rcpf(1.f + __expf(-v[i])); return r; }
struct EpiSwiglu {
    static constexpr bool PERM = true, AFTER_DRAIN = false; bf16_t* G;
    __device__ __forceinline__ void operator()(const f32x4 (&acc)[2][2][4][2], const Unit& u, int wr, int wc, int fr, int fq) const {
        const int row0 = u.pm * BM + wr * 64 + fr, col0 = u.pn * HALF + wc * 32 + 8 * fq;
#pragma unroll
        for (int ai = 0; ai < 2; ++ai)
#pragma unroll
            for (int m = 0; m < 4; ++m) *(u32x4*)(G + (size_t)(row0 + ai * HALF + m * 16) * 512 + col0) = pack8(silu4(acc[ai][0][m][0]) * acc[ai][1][m][0], silu4(acc[ai][0][m][1]) * acc[ai][1][m][1]);
    }
};
__device__ __forceinline__ void unpack8f(const u32x4 w, f32x4& a, f32x4& b) {
    a[0] = __uint_as_float(w.x << 16); a[1] = __uint_as_float(w.x & 0xffff0000u); a[2] = __uint_as_float(w.y << 16); a[3] = __uint_as_float(w.y & 0xffff0000u);
    b[0] = __uint_as_float(w.z << 16); b[1] = __uint_as_float(w.z & 0xffff0000u); b[2] = __uint_as_float(w.w << 16); b[3] = __uint_as_float(w.w & 0xffff0000u); }
struct EpiGlu {
    static constexpr bool PERM = true, AFTER_DRAIN = false; const bf16_t* GS; const float* b; bf16_t* GG;
    __device__ __forceinline__ void operator()(const f32x4 (&acc)[2][2][4][2], const Unit& u, int wr, int wc, int fr, int fq) const {
        const int row0 = u.pm * BM + wr * 64 + fr, col0 = u.pn * BM + wc * 32 + 8 * fq;
#pragma unroll
        for (int bj = 0; bj < 2; ++bj) { const int c = col0 + bj * HALF; const f32x4 b0 = *(const f32x4*)(b + c), b1 = *(const f32x4*)(b + c + 4);
#pragma unroll
            for (int ai = 0; ai < 2; ++ai)
#pragma unroll
                for (int m = 0; m < 4; ++m) { const size_t o = (size_t)(row0 + ai * HALF + m * 16) * 512 + c; f32x4 g0, g1; unpack8f(*(const u32x4*)(GS + o), g0, g1);
                    *(u32x4*)(GG + o) = pack8(g0 * sigm4(acc[ai][bj][m][0] + b0), g1 * sigm4(acc[ai][bj][m][1] + b1)); } }
    }
};
struct EpiResid {
    static constexpr bool PERM = false, AFTER_DRAIN = false;
    const float* x; const float* ctx; const float* mod; float* XC; int inplace;
    __device__ __forceinline__ void operator()(const f32x4 (&acc)[2][2][4][2], const Unit& u, int wr, int wc, int fr, int fq) const {
        const int R0 = u.pm * BM; const int ci = R0 < 32768 ? (R0 >> 11) : 16;
        const float* base = inplace ? XC + (size_t)R0 * 1024 : (R0 < 32768 ? x + (size_t)R0 * 1024 : ctx + (size_t)(R0 - 32768) * 1024);
        float* out = XC + (size_t)R0 * 1024; const float* gate = mod + ((size_t)ci * 6 + 2) * 1024;
        const int rl0 = wr * 64 + fr, col0 = u.pn * BM + wc * 32 + 4 * fq;
#pragma unroll
        for (int bj = 0; bj < 2; ++bj)
#pragma unroll
            for (int n = 0; n < 2; ++n) { const int c = col0 + bj * HALF + n * 16; const f32x4 g4 = *(const f32x4*)(gate + c);
#pragma unroll
                for (int ai = 0; ai < 2; ++ai)
#pragma unroll
                    for (int m = 0; m < 4; ++m) { const size_t o = (size_t)(rl0 + ai * HALF + m * 16) * 1024 + c; *(f32x4*)(out + o) = *(const f32x4*)(base + o) + g4 * acc[ai][bj][m][n]; } }
    }
};
}

#include <hip/hip_bf16.h>
#include <cmath>
namespace attn_body {
using bf16=__hip_bfloat16;
using bf16x8=__attribute__((ext_vector_type(8)))short;
using s16x4=__attribute__((ext_vector_type(4)))short;
using f32x16=__attribute__((ext_vector_type(16)))float;
using u32x4=__attribute__((ext_vector_type(4)))unsigned;
constexpr int D=64,QP=512,KP=128,OP=1024;
constexpr int NW=8,QBLK=32,QB=QBLK*NW,KVBLK=64;
constexpr int ATTN_UNIT_ROWS=QB;
__device__ __forceinline__ int crow(int r,int hi){return (r&3)+8*(r>>2)+4*hi;}
#define SBAR() __builtin_amdgcn_sched_barrier(0)
__device__ __forceinline__ void cmask(f32x16&p0,f32x16&p1,int jb,int qrel,int hi){
  const float NEG=-INFINITY; int kb=64*jb+4*hi;
  #pragma unroll
  for(int r=0;r<16;++r){int kv=kb+(r&3)+8*(r>>2); if(kv>qrel)p0[r]=NEG; if(kv+32>qrel)p1[r]=NEG;}
}

constexpr int NSLOT=3, SLOTB=8192;
constexpr int LDS_K=0, LDS_V=NSLOT*SLOTB, LDS_WS=2*NSLOT*SLOTB, LDS_OST=LDS_WS+NW*64*4, LDS_BYTES=LDS_OST+NW*4096;
constexpr float C2=0.125f*1.4426950408889634f;
__device__ __forceinline__ void glds16(const void*gsrc,unsigned lds_dst){unsigned keep;
  asm volatile("s_mov_b32 %0, m0\n\ts_mov_b32 m0, %2\n\ts_nop 0\n\tglobal_load_lds_dwordx4 %1, off\n\ts_mov_b32 m0, %0":"=&s"(keep):"v"(gsrc),"s"(lds_dst):"memory");}
__device__ __forceinline__ float max3f(float a,float b,float c){float r;asm("v_max3_f32 %0, %1, %2, %3":"=v"(r):"v"(a),"v"(b),"v"(c));return r;}
__device__ __forceinline__ float max2f(float a,float b){float r;asm("v_max_f32_e32 %0, %1, %2":"=v"(r):"v"(a),"v"(b));return r;}
__device__ __forceinline__ float fadd_s(float a,float b){float r;asm("v_add_f32_e32 %0, %1, %2":"=v"(r):"v"(a),"v"(b));return r;}
__device__ __forceinline__ float fsub_s(float a,float b){float r;asm("v_sub_f32_e32 %0, %1, %2":"=v"(r):"v"(a),"v"(b));return r;}
typedef float f32x2_t __attribute__((ext_vector_type(2))); typedef __bf16 bf16x2_t __attribute__((ext_vector_type(2)));
__device__ __forceinline__ unsigned cvtpk_s(float lo,float hi){f32x2_t v={lo,hi};bf16x2_t b=__builtin_convertvector(v,bf16x2_t);return __builtin_bit_cast(unsigned,b);}
#define WAIT_BAR(N) asm volatile("s_waitcnt vmcnt(" #N ") lgkmcnt(0)\n\ts_barrier":::"memory")

__device__ __forceinline__ void qkt(f32x16&p0,f32x16&p1,const char*Kslot,const bf16x8*qr,const f32x16&negm,int r32,int hi){
  const char*kb=Kslot+hi*1024+r32*16;
  #pragma unroll
  for(int d0=0;d0<4;++d0){
    const bf16x8 b0=*reinterpret_cast<const bf16x8*>(kb+d0*2048);
    const bf16x8 b1=*reinterpret_cast<const bf16x8*>(kb+d0*2048+512);
    if(d0==0){p0=__builtin_amdgcn_mfma_f32_32x32x16_bf16(b0,qr[0],negm,0,0,0);p1=__builtin_amdgcn_mfma_f32_32x32x16_bf16(b1,qr[0],negm,0,0,0);}
    else{p0=__builtin_amdgcn_mfma_f32_32x32x16_bf16(b0,qr[d0],p0,0,0,0);p1=__builtin_amdgcn_mfma_f32_32x32x16_bf16(b1,qr[d0],p1,0,0,0);}}
}
typedef __attribute__((address_space(3))) const char* lds_cptr;
typedef short v4i16_t __attribute__((ext_vector_type(4)));
__device__ __forceinline__ void kload8(bf16x8*kf,lds_cptr kp){
  kf[0]=*(const __attribute__((address_space(3))) bf16x8*)(kp);      kf[1]=*(const __attribute__((address_space(3))) bf16x8*)(kp+512);
  kf[2]=*(const __attribute__((address_space(3))) bf16x8*)(kp+2048); kf[3]=*(const __attribute__((address_space(3))) bf16x8*)(kp+2560);
  kf[4]=*(const __attribute__((address_space(3))) bf16x8*)(kp+4096); kf[5]=*(const __attribute__((address_space(3))) bf16x8*)(kp+4608);
  kf[6]=*(const __attribute__((address_space(3))) bf16x8*)(kp+6144); kf[7]=*(const __attribute__((address_space(3))) bf16x8*)(kp+6656);
}
__device__ __forceinline__ void kload2(bf16x8*kf,lds_cptr kp,int j){ kf[2*j]=*(const __attribute__((address_space(3))) bf16x8*)(kp+j*2048); kf[2*j+1]=*(const __attribute__((address_space(3))) bf16x8*)(kp+j*2048+512); }
__device__ __forceinline__ s16x4 vtr(lds_cptr p){ return __builtin_bit_cast(s16x4,__builtin_amdgcn_ds_read_tr16_b64_v4i16((__attribute__((address_space(3))) v4i16_t*)p)); }
__device__ __forceinline__ float rowmax(const f32x16&p0,const f32x16&p1){
  float a=max3f(p0[0],p0[1],p1[0]),b=max3f(p0[2],p0[3],p1[1]);a=max3f(a,p1[2],p1[3]);
  #pragma unroll
  for(int r=4;r<16;r+=4){a=max3f(a,p0[r],p0[r+1]);b=max3f(b,p0[r+2],p0[r+3]);a=max3f(a,p1[r],p1[r+1]);b=max3f(b,p1[r+2],p1[r+3]);}
  const float m=max2f(a,b);
  auto rr=__builtin_amdgcn_permlane32_swap(__float_as_uint(m),__float_as_uint(m),false,false);
  return max2f(__uint_as_float(rr[0]),__uint_as_float(rr[1]));
}
__device__ __forceinline__ void pv(f32x16*o,int vb,bf16x8 pa0,bf16x8 pa1,bf16x8 pa2,bf16x8 pa3){
  #pragma unroll
  for(int d0=0;d0<2;++d0){s16x4 lo[4],hi[4];
    #pragma unroll
    for(int ks=0;ks<4;++ks){
      asm volatile("ds_read_b64_tr_b16 %0,%1 offset:%c2":"=&v"(lo[ks]):"v"(vb),"i"(d0*4096+ks*1024):"memory");
      asm volatile("ds_read_b64_tr_b16 %0,%1 offset:%c2":"=&v"(hi[ks]):"v"(vb),"i"(d0*4096+ks*1024+512):"memory");}
    asm volatile("s_waitcnt lgkmcnt(0)":::"memory");SBAR();
    #define PK(k) (bf16x8){lo[k][0],lo[k][1],lo[k][2],lo[k][3],hi[k][0],hi[k][1],hi[k][2],hi[k][3]}
    o[d0]=__builtin_amdgcn_mfma_f32_32x32x16_bf16(pa0,PK(0),o[d0],0,0,0);
    o[d0]=__builtin_amdgcn_mfma_f32_32x32x16_bf16(pa1,PK(1),o[d0],0,0,0);
    o[d0]=__builtin_amdgcn_mfma_f32_32x32x16_bf16(pa2,PK(2),o[d0],0,0,0);
    o[d0]=__builtin_amdgcn_mfma_f32_32x32x16_bf16(pa3,PK(3),o[d0],0,0,0);
    #undef PK
  }
}

#ifndef ATTN_STORE16
#define ATTN_STORE16(p,v) (*(u32x4*)(p)=(v))
#endif
template<int THRL> __device__ __forceinline__ void attn_unit(const bf16*Q0,const bf16*__restrict__ Kh,const bf16*__restrict__ Vh,bf16*O0,const int NT,char*shm){
  const int tid=threadIdx.x,lane=tid&63,r32=lane&31,hi=lane>>5; const int wid=__builtin_amdgcn_readfirstlane(tid>>6);
  const bf16*Qw=Q0+(long)(wid*QBLK)*QP;
  const unsigned lds0=(unsigned)(uintptr_t)shm;
  float*wsf=(float*)(shm+LDS_WS)+wid*64;
  const bf16*ksrc=Kh+(long)lane*KP+wid*8;
  const bf16*vsrc=Vh+(long)(16*(wid&3)+(lane>>2))*KP+(wid>>2)*32+(lane&3)*8;
  const unsigned kdst=lds0+LDS_K+wid*1024, vdst=lds0+LDS_V+wid*1024;
  #define DMA_K(t,slot) glds16(ksrc+(long)(t)*KVBLK*KP,(unsigned)__builtin_amdgcn_readfirstlane(kdst+(slot)))
  #define DMA_V(t,slot) glds16(vsrc+(long)(t)*KVBLK*KP,(unsigned)__builtin_amdgcn_readfirstlane(vdst+(slot)))
  const int vb0=(int)(lds0+LDS_V)+((lane>>4)&1)*32+(lane&3)*8+(4*hi+((lane&15)>>2))*64;
  const char*Kbase=shm+LDS_K; bf16x8 kf[8];
  const lds_cptr shm3=(lds_cptr)shm; const lds_cptr kp0=shm3+LDS_K+hi*1024+r32*16; const lds_cptr vp0=shm3+LDS_V+((lane>>4)&1)*32+(lane&3)*8+(4*hi+((lane&15)>>2))*64;
  DMA_K(0,0);DMA_V(0,0);DMA_K(1,SLOTB);
  bf16x8 qr[4];
  #pragma unroll
  for(int d0=0;d0<4;++d0)qr[d0]=*reinterpret_cast<const bf16x8*>(&Qw[(long)r32*QP+d0*16+hi*8]);
  float mhat=0.f,l_reg=0.f;f32x16 o[2];o[0]=f32x16{};o[1]=f32x16{};f32x16 negm=f32x16{};asm volatile("":"+v"(negm));
  #define CMASK(P0,P1,t) do{}while(0)
  bool resc=false;
  #define START(P0,P1) do{ const float rm=rowmax(P0,P1); resc=false; \
    { const float dl=rm; mhat=fadd_s(mhat,dl); \
      _Pragma("unroll") for(int r=0;r<16;++r){P0[r]=fsub_s(P0[r],dl);P1[r]=fsub_s(P1[r],dl);} \
      _Pragma("unroll") for(int r=0;r<16;++r)negm[r]=-mhat; asm volatile("":"+v"(negm)); } \
    _Pragma("unroll") for(int r=0;r<16;++r)P0[r]=__builtin_amdgcn_exp2f(P0[r]); }while(0)
  #define RESC() do{ if(resc){ asm volatile("s_waitcnt lgkmcnt(0)":::"memory"); \
      _Pragma("unroll") for(int d_=0;d_<2;++d_) _Pragma("unroll") for(int r=0;r<16;++r)o[d_][r]*=wsf[crow(r,hi)]; } }while(0)
  f32x16 pA0,pA1,pB0,pB1;
  int sl_prev=0,sl_cur=0,sl_next=SLOTB;
  #define ROT() do{sl_prev=sl_cur;sl_cur=sl_next;sl_next=(sl_next==(NSLOT-1)*SLOTB)?0:sl_next+SLOTB;}while(0)
  DMA_K(2,2*SLOTB);
  WAIT_BAR(3);
  qkt(pA0,pA1,Kbase,qr,negm,r32,hi);asm volatile("s_nop 15\n\ts_nop 7":"+v"(pA0),"+v"(pA1));CMASK(pA0,pA1,0);
  START(pA0,pA1);
  _Pragma("unroll") for(int r=0;r<16;++r)pA1[r]=__builtin_amdgcn_exp2f(pA1[r]);
  WAIT_BAR(0);
  DMA_K(3,0);DMA_V(1,SLOTB);
  ROT();
  kload8(kf,kp0+sl_cur);
  WAIT_BAR(2);
  s16x4 vlo[8],vhi[8]; u32x4 pw0,pw1,pw2,pw3;
  #define PKW(P,B) cvtpk_s(P[B],P[B+1])
  #define PAF(k) __builtin_bit_cast(bf16x8,pw##k)
  #define VFR(i) (bf16x8){vlo[i][0],vlo[i][1],vlo[i][2],vlo[i][3],vhi[i][0],vhi[i][1],vhi[i][2],vhi[i][3]}
  #define PIN(x) asm volatile("":"+v"(x))
  #define MX3(a,b,c) __builtin_fmaxf(__builtin_fmaxf((a),(b)),(c))
  #define GAPA(MF,A0,A1,A2,A3,W0,W1,PW) do{ MF; sacc+=A0; sacc+=A1; sacc+=A2; sacc+=A3; PIN(sacc); W0; W1; PIN(PW); SBAR(); }while(0)
  #define EX(v) __builtin_amdgcn_exp2f(v)
  #define GAPB(MF,X,B) do{ MF; X[B]=EX(X[B]); X[B+1]=EX(X[B+1]); X[B+2]=EX(X[B+2]); X[B+3]=EX(X[B+3]); PIN(X); SBAR(); }while(0)
  #define VRD(i) do{ vlo[i]=vtr(vp_+(((i)>>2)*4096+((i)&3)*1024)); vhi[i]=vtr(vp_+(((i)>>2)*4096+((i)&3)*1024+512)); }while(0)
  #define KRD(G,j) do{ if(G){ kload2(kf,kp0+sl_next,j); SBAR(); } }while(0)
  #define STEP(C0,C1,P0,P1,t,GK,GV,GL) do{ SBAR(); \
    const lds_cptr vp_=vp0+sl_prev; \
    VRD(0); SBAR(); float sacc=(P0[0]+P0[1]); \
    GAPA(C0=__builtin_amdgcn_mfma_f32_32x32x16_bf16(kf[0],qr[0],negm,0,0,0), P0[2],P0[3],P0[4],P0[5],     pw0[0]=PKW(P0,0), pw0[1]=PKW(P0,2), pw0); \
    VRD(4); SBAR(); GAPA(C1=__builtin_amdgcn_mfma_f32_32x32x16_bf16(kf[1],qr[0],negm,0,0,0), P0[6],P0[7],P0[8],P0[9],     pw0[2]=PKW(P0,4), pw0[3]=PKW(P0,6), pw0); \
    VRD(1); SBAR(); GAPA(C0=__builtin_amdgcn_mfma_f32_32x32x16_bf16(kf[2],qr[1],C0,0,0,0),   P0[10],P0[11],P0[12],P0[13], pw1[0]=PKW(P0,8), pw1[1]=PKW(P0,10), pw1); \
    VRD(5); SBAR(); GAPA(C1=__builtin_amdgcn_mfma_f32_32x32x16_bf16(kf[3],qr[1],C1,0,0,0),   P0[14],P0[15],P1[0],P1[1],   pw1[2]=PKW(P0,12),pw1[3]=PKW(P0,14), pw1); \
    VRD(2); SBAR(); GAPA(C0=__builtin_amdgcn_mfma_f32_32x32x16_bf16(kf[4],qr[2],C0,0,0,0),   P1[2],P1[3],P1[4],P1[5],     pw2[0]=PKW(P1,0), pw2[1]=PKW(P1,2), pw2); \
    VRD(6); SBAR(); GAPA(C1=__builtin_amdgcn_mfma_f32_32x32x16_bf16(kf[5],qr[2],C1,0,0,0),   P1[6],P1[7],P1[8],P1[9],     pw2[2]=PKW(P1,4), pw2[3]=PKW(P1,6), pw2); \
    VRD(3); SBAR(); GAPA(C0=__builtin_amdgcn_mfma_f32_32x32x16_bf16(kf[6],qr[3],C0,0,0,0),   P1[10],P1[11],P1[12],P1[13], pw3[0]=PKW(P1,8), pw3[1]=PKW(P1,10), pw3); \
    VRD(7); SBAR(); GAPA(C1=__builtin_amdgcn_mfma_f32_32x32x16_bf16(kf[7],qr[3],C1,0,0,0),   P1[14],P1[15],0.f,0.f,       pw3[2]=PKW(P1,12),pw3[3]=PKW(P1,14), pw3); \
    l_reg+=sacc; \
    if(GK){DMA_K((t)+3,sl_cur);} if(GV){DMA_V((t)+1,sl_next);} \
    CMASK(C0,C1,t); \
    { float a=MX3(C0[0],C0[1],C1[0]),b=MX3(C0[2],C0[3],C1[1]); a=MX3(a,C1[2],C1[3]); \
      _Pragma("unroll") for(int r=4;r<16;r+=4){a=MX3(a,C0[r],C0[r+1]);b=MX3(b,C0[r+2],C0[r+3]);a=MX3(a,C1[r],C1[r+1]);b=MX3(b,C1[r+2],C1[r+3]);} \
      float rm=__builtin_fmaxf(a,b); { auto rr=__builtin_amdgcn_permlane32_swap(__float_as_uint(rm),__float_as_uint(rm),false,false); rm=__builtin_fmaxf(__uint_as_float(rr[0]),__uint_as_float(rr[1])); } \
      resc=false; \
      if(__builtin_expect(__any(rm>(float)THRL),0)){ const float dl=__builtin_fmaxf(rm,0.f); mhat+=dl; \
        _Pragma("unroll") for(int r=0;r<16;++r){C0[r]-=dl;C1[r]-=dl;} \
        _Pragma("unroll") for(int r=0;r<16;++r)negm[r]=-mhat; asm volatile("":"+v"(negm)); \
        const float f=__builtin_amdgcn_exp2f(-dl); l_reg*=f; if(hi==0)wsf[r32]=f; resc=true; } } \
    SBAR(); \
    GAPB(o[0]=__builtin_amdgcn_mfma_f32_32x32x16_bf16(PAF(0),VFR(0),o[0],0,0,0), C0,0); \
    GAPB(o[1]=__builtin_amdgcn_mfma_f32_32x32x16_bf16(PAF(0),VFR(4),o[1],0,0,0), C0,4); \
    KRD(GL,0); GAPB(o[0]=__builtin_amdgcn_mfma_f32_32x32x16_bf16(PAF(1),VFR(1),o[0],0,0,0), C0,8); \
    KRD(GL,1); GAPB(o[1]=__builtin_amdgcn_mfma_f32_32x32x16_bf16(PAF(1),VFR(5),o[1],0,0,0), C0,12); \
    KRD(GL,2); GAPB(o[0]=__builtin_amdgcn_mfma_f32_32x32x16_bf16(PAF(2),VFR(2),o[0],0,0,0), C1,0); \
    KRD(GL,3); GAPB(o[1]=__builtin_amdgcn_mfma_f32_32x32x16_bf16(PAF(2),VFR(6),o[1],0,0,0), C1,4); \
    GAPB(o[0]=__builtin_amdgcn_mfma_f32_32x32x16_bf16(PAF(3),VFR(3),o[0],0,0,0), C1,8); \
    GAPB(o[1]=__builtin_amdgcn_mfma_f32_32x32x16_bf16(PAF(3),VFR(7),o[1],0,0,0), C1,12); \
    }while(0)
  int t=1;
  #undef CMASK
  #define CMASK(P0,P1,t) do{}while(0)
  for(;t+5<NT;t+=2){
    STEP(pB0,pB1,pA0,pA1,t,true,true,true);     WAIT_BAR(2); RESC(); ROT();
    STEP(pA0,pA1,pB0,pB1,t+1,true,true,true);   WAIT_BAR(2); RESC(); ROT();
  }
  #undef CMASK
  #define CMASK(P0,P1,t) do{}while(0)
  #define ENDW(tt) do{ if((tt)+3<NT){WAIT_BAR(2);} else if((tt)+2<NT){WAIT_BAR(1);} else {WAIT_BAR(0);} }while(0)
  for(;t+1<NT;t+=2){
    STEP(pB0,pB1,pA0,pA1,t,(t+3<NT),(t+1<NT),(t+1<NT));       ENDW(t);   RESC(); ROT();
    STEP(pA0,pA1,pB0,pB1,t+1,(t+4<NT),(t+2<NT),(t+2<NT));     ENDW(t+1); RESC(); ROT();
  }
  STEP(pB0,pB1,pA0,pA1,NT-1,false,false,false); RESC();
  { float sacc=pB0[0]+pB0[1]; _Pragma("unroll") for(int r=2;r<16;++r)sacc+=pB0[r]; _Pragma("unroll") for(int r=0;r<16;++r)sacc+=pB1[r]; l_reg+=sacc;
    pw0=(u32x4){PKW(pB0,0),PKW(pB0,2),PKW(pB0,4),PKW(pB0,6)};pw1=(u32x4){PKW(pB0,8),PKW(pB0,10),PKW(pB0,12),PKW(pB0,14)};pw2=(u32x4){PKW(pB1,0),PKW(pB1,2),PKW(pB1,4),PKW(pB1,6)};pw3=(u32x4){PKW(pB1,8),PKW(pB1,10),PKW(pB1,12),PKW(pB1,14)};
    SBAR(); pv(o,vb0+sl_cur,PAF(0),PAF(1),PAF(2),PAF(3)); }
  #undef PKW
  #undef PAF
  #undef VFR
  #undef PIN
  #undef MX3
  #undef GAPA
  #undef GAPB
  #undef EX
  #undef VRD
  #undef KRD
  #undef STEP
  #undef ENDW
  {auto rr=__builtin_amdgcn_permlane32_swap(__float_as_uint(l_reg),__float_as_uint(l_reg),false,false);l_reg=__uint_as_float(rr[0])+__uint_as_float(rr[1]);}
  if(hi==0)wsf[32+r32]=l_reg;asm volatile("s_waitcnt lgkmcnt(0)":::"memory");
  float rli[16];
  #pragma unroll
  for(int r=0;r<16;++r)rli[r]=__builtin_amdgcn_rcpf(wsf[32+crow(r,hi)]);
  bf16*Ow=O0+(long)(wid*QBLK)*OP;
  { bf16*stg=(bf16*)(shm+LDS_OST)+wid*2048;
    #pragma unroll
    for(int r=0;r<16;++r){const int orow=crow(r,hi);
      #pragma unroll
      for(int d0=0;d0<2;++d0)stg[orow*64+d0*32+r32]=__float2bfloat16(o[d0][r]*rli[r]);}
    asm volatile("s_waitcnt lgkmcnt(0)":::"memory");
    #pragma unroll
    for(int i=0;i<4;++i){const int row=i*8+(lane>>3),ch=lane&7; const u32x4 v=*(const u32x4*)(stg+row*64+ch*8); ATTN_STORE16(Ow+(long)row*OP+ch*8,v);} }
  asm volatile("s_waitcnt lgkmcnt(0)\n\ts_barrier":::"memory");
  #undef DMA_K
  #undef DMA_V
  #undef CMASK
  #undef START
  #undef RESC
  #undef ROT
}
constexpr int ATTN_LDS_BYTES=LDS_BYTES;
#undef SBAR
#undef WAIT_BAR
}

struct Params {
    const float* in[35];
    float* out;
    unsigned char* ws;
    int ph_lo, ph_hi;
};
enum { I_X = 0, I_C, I_CTX, I_CCTX, I_WMOD, I_BMOD, I_GMIX, I_GFFN, I_MIXWIN, I_MIXWOUT, I_QG, I_KG, I_LNG, I_WSP, I_BSP,
       I_S5WIN, I_ARE, I_AIM, I_LOGDT, I_BRE, I_BIM, I_CRE, I_CIM, I_S5D, I_WGLU, I_BGLU, I_S5WOUT,
       I_WGRP, I_BGRP, I_WRT, I_BRT, I_W1, I_W3, I_W2, I_FING };

struct Ctx {
    const Params* p;
    unsigned char* ws;
    LAS unsigned char* lds;
    int tid, lane, wave, gw, ngw;
};
__device__ __forceinline__ const float* xin_row(const Params& P, int r) { return r < TL ? P.in[I_X] + (size_t)r * D : P.in[I_CTX] + (size_t)(r - TL) * D; }
__device__ __forceinline__ int cond_of(int r) { return r < TL ? (r >> 11) : 16; }
__device__ __forceinline__ const float* mod_vec(const Ctx& C, int layer, int ci, int k) { return (const float*)(C.ws + WS_MOD) + ((size_t)(layer * 17 + ci) * 6 + k) * D; }

__device__ __forceinline__ void dsincos(double a, double& s, double& c) {
    const double TWO_PI_HI = 6.283185307179586, TWO_PI_LO = 2.4492935982947064e-16;
    const double k = rint(a * 0.15915494309189535);
    double r = fma(-k, TWO_PI_HI, a); r = fma(-k, TWO_PI_LO, r);
    const double r2 = r * r; double ct = 1.0, st = r, cs = 1.0, ss = r;
#pragma unroll 1
    for (int i = 1; i <= 15; ++i) { ct *= -r2 / (double)((2 * i - 1) * (2 * i)); cs += ct; st *= -r2 / (double)((2 * i) * (2 * i + 1)); ss += st; }
    s = ss; c = cs;
}

__device__ __forceinline__ void transpose_item(const float* src, int N, int k0, int n0, bf16* dst, int dpitch, LAS float* scr, int lane) {
#pragma unroll 8
    for (int i = 0; i < 32; ++i) { const int kk = 2 * i + (lane >> 5); scr[kk * 33 + (lane & 31)] = src[(size_t)(k0 + kk) * N + n0 + (lane & 31)]; }
    asm volatile("s_waitcnt lgkmcnt(0)" ::: "memory");
    const int c = lane & 7;
#pragma unroll
    for (int j = 0; j < 4; ++j) { const int n = (lane >> 3) + 8 * j; const LAS float* s = scr + (8 * c) * 33 + n;
        v4u o; o.x = pk2(s[0 * 33], s[1 * 33]); o.y = pk2(s[2 * 33], s[3 * 33]); o.z = pk2(s[4 * 33], s[5 * 33]); o.w = pk2(s[6 * 33], s[7 * 33]);
        *(v4u*)(dst + (size_t)n * dpitch + 8 * c) = o; }
    asm volatile("s_waitcnt lgkmcnt(0)" ::: "memory");
}
__device__ __forceinline__ void transpose_mat_item(const float* W, int K, int N, bf16* WT, int it, LAS float* scr, int lane) {
    const int nblk = N / 32, kb = it / nblk, nb = it % nblk;
    transpose_item(W, N, kb * 64, nb * 32, WT + (size_t)(nb * 32) * K + kb * 64, K, scr, lane);
}
constexpr int MOE_ITEMS = NEXP * 768;
__device__ __forceinline__ void moe_convert_item(const Ctx& C, int layer, int it, LAS float* scr) {
    const Params& P = *C.p;
    const int e = it / 768, r = it % 768, kind = r / 256, j = r % 256;
    if (kind < 2) {
        const float* src = (kind == 0 ? P.in[I_W1] : P.in[I_W3]) + ((size_t)layer * NEXP + e) * D * EH;
        const int kb = j / 16, nb = j % 16, k0 = kb * 64, n0 = nb * 32;
        const int drow = (n0 / 128) * 256 + (n0 % 128) + (kind == 1 ? 128 : 0);
        transpose_item(src, EH, k0, n0, (bf16*)(C.ws + WS_W13) + (size_t)e * 1024 * 1024 + (size_t)drow * 1024 + k0, 1024, scr, C.lane);
    } else {
        const float* src = P.in[I_W2] + ((size_t)layer * NEXP + e) * EH * D;
        const int kb = j / 32, nb = j % 32, k0 = kb * 64, n0 = nb * 32;
        transpose_item(src, D, k0, n0, (bf16*)(C.ws + WS_W2) + (size_t)e * 1024 * 512 + (size_t)n0 * 512 + k0, 512, scr, C.lane);
    }
}

__device__ __forceinline__ void phase_prologue(const Ctx& C) {
    const Params& P = *C.p;
    {
        LAS float* s = (LAS float*)C.lds;
        LAS float* red = (LAS float*)(C.lds + 17 * 1024 * 4);
        bool have_s = false;
        for (int u = blockIdx.x; u < 192; u += gridDim.x) {
            if (!have_s) {
                for (int i = C.tid; i < 17 * 1024; i += NTHR) { const int ci = i >> 10, k = i & 1023; const float v = ci < 16 ? P.in[I_C][ci * D + k] : P.in[I_CCTX][k]; s[i] = silu_(v); }
                have_s = true; __syncthreads();
            }
            const int layer = u / 96, jg = u % 96, kq = C.tid >> 6, jc = C.tid & 63;
            const float* w = P.in[I_WMOD] + (size_t)layer * D * 6144 + jg * 64 + jc;
            float acc[17];
#pragma unroll
            for (int i = 0; i < 17; ++i) acc[i] = 0.f;
            for (int k = kq * 128; k < kq * 128 + 128; ++k) { const float wv = w[(size_t)k * 6144];
#pragma unroll
                for (int i = 0; i < 17; ++i) acc[i] += s[i * 1024 + k] * wv; }
#pragma unroll
            for (int i = 0; i < 17; ++i) red[(kq * 17 + i) * 64 + jc] = acc[i];
            __syncthreads();
            for (int o = C.tid; o < 17 * 64; o += NTHR) { const int ci = o >> 6, c = o & 63; float v = 0.f;
#pragma unroll
                for (int q = 0; q < 8; ++q) v += red[(q * 17 + ci) * 64 + c];
                const int j = jg * 64 + c; v += P.in[I_BMOD][layer * 6144 + j];
                ((float*)(C.ws + WS_MOD))[((size_t)(layer * 17 + ci)) * 6144 + j] = v; }
            __syncthreads();
        }
        __syncthreads();
    }
    {
        const int gt = blockIdx.x * NTHR + C.tid, ngt = gridDim.x * NTHR;
        float2* rope = (float2*)(C.ws + WS_TAB + TAB_ROPE);
        for (int i = gt; i < 64 * 16; i += ngt) { const int pos = i >> 4, f = i & 15;
            const double th = exp(-(double)f * (9.210340371976184 / 16.0)); double s, c; dsincos((double)pos * th, s, c); rope[i] = make_float2((float)c, (float)s); }
        float2* lamb = (float2*)(C.ws + WS_TAB + TAB_LAMB); float2* bbar = (float2*)(C.ws + WS_TAB + TAB_BBAR);
        for (int i = gt; i < 2 * 32 * 64; i += ngt) {
            const int dg = i >> 6;
            const double are = P.in[I_ARE][i], aim = P.in[I_AIM][i], dt = exp((double)P.in[I_LOGDT][dg]);
            double s, c; dsincos(aim * dt, s, c); const double mag = exp(are * dt), lr = mag * c, li = mag * s;
            lamb[i] = make_float2((float)lr, (float)li);
            const double den = are * are + aim * aim, nr = lr - 1.0, ni = li;
            const double cr = (nr * are + ni * aim) / den, cim = (ni * are - nr * aim) / den;
            for (int p = 0; p < 16; ++p) { const double br = P.in[I_BRE][(size_t)i * 16 + p], bi = P.in[I_BIM][(size_t)i * 16 + p];
                bbar[(size_t)i * 16 + p] = make_float2((float)(cr * br - cim * bi), (float)(cr * bi + cim * br)); }
        }
    }
    {
        LAS float* scr = (LAS float*)(C.lds + C.wave * 16384);
        constexpr int I0 = 16 * 56, I1 = 16 * 32, I2 = 16 * 16, I3 = 8 * 16, I4 = 8 * 32;
        constexpr int NSMALL = I0 + I1 + I2 + I3 + I4;
        for (int it = C.gw; it < NSMALL + MOE_ITEMS; it += C.ngw) {
            int r = it;
            if (r < I0) { transpose_mat_item(P.in[I_MIXWIN], D, MIXW, (bf16*)(C.ws + WS_WIN0), r, scr, C.lane); continue; } r -= I0;
            if (r < I1) { transpose_mat_item(P.in[I_MIXWOUT], D, D, (bf16*)(C.ws + WS_WOUT0), r, scr, C.lane); continue; } r -= I1;
            if (r < I2) { transpose_mat_item(P.in[I_S5WIN], D, 512, (bf16*)(C.ws + WS_WS5IN), r, scr, C.lane); continue; } r -= I2;
            if (r < I3) { transpose_mat_item(P.in[I_WGLU], 512, 512, (bf16*)(C.ws + WS_WGLU), r, scr, C.lane); continue; } r -= I3;
            if (r < I4) { transpose_mat_item(P.in[I_S5WOUT], 512, D, (bf16*)(C.ws + WS_WS5OUT), r, scr, C.lane); continue; } r -= I4;
            moe_convert_item(C, 0, r, scr);
        }
    }
}

__device__ __forceinline__ void load_row16(const float* row, int lane, f32x4 (&v)[4]) {
#pragma unroll
    for (int j = 0; j < 4; ++j) v[j] = *(const f32x4*)(row + 4 * lane + 256 * j);
}
__device__ __forceinline__ float row_rstd(const f32x4 (&v)[4]) {
    float s = 0.f;
#pragma unroll
    for (int j = 0; j < 4; ++j) s += (v[j].x * v[j].x + v[j].y * v[j].y) + (v[j].z * v[j].z + v[j].w * v[j].w);
    return rsqrtf(wave_sum(s) * (1.f / D) + EPS);
}
__device__ __forceinline__ void modulate16(f32x4 (&v)[4], float rstd, const float* g, const float* scale, const float* shift, int lane) {
#pragma unroll
    for (int j = 0; j < 4; ++j) { const int c = 4 * lane + 256 * j; const f32x4 gg = *(const f32x4*)(g + c), sc = *(const f32x4*)(scale + c), sh = *(const f32x4*)(shift + c);
        v[j] = v[j] * rstd * gg * (sc + 1.f) + sh; }
}
__device__ __forceinline__ void store_row16_bf16(bf16* row, int lane, const f32x4 (&v)[4]) {
#pragma unroll
    for (int j = 0; j < 4; ++j) { v2u o; o.x = pk2(v[j].x, v[j].y); o.y = pk2(v[j].z, v[j].w); *(v2u*)(row + 4 * lane + 256 * j) = o; }
}

__device__ __forceinline__ void phase_norm_mix0(const Ctx& C) {
    const Params& P = *C.p; bf16* H = (bf16*)(C.ws + WS_H);
    for (int r = C.gw; r < TT; r += C.ngw) {
        f32x4 v[4]; load_row16(xin_row(P, r), C.lane, v);
        const float rstd = row_rstd(v); const int ci = cond_of(r);
        modulate16(v, rstd, P.in[I_GMIX], mod_vec(C, 0, ci, 1), mod_vec(C, 0, ci, 0), C.lane);
        store_row16_bf16(H + (size_t)r * D, C.lane, v);
    }
}

template <class Epi>
__device__ __forceinline__ void ngemm_unit(const Ctx& C, const bf16* A0, const bf16* B0, int K, int row0, int pn, const Epi& epi) {
    LAS float* As = (LAS float*)C.lds;
    LAS float* Bs = (LAS float*)(C.lds + 32 * 68 * 4);
    const int tid = C.tid, ty = tid >> 4, tx = tid & 15;
    float acc[2][16];
#pragma unroll
    for (int i = 0; i < 2; ++i)
#pragma unroll
        for (int j = 0; j < 16; ++j) acc[i][j] = 0.f;
    const int ar = tid >> 3, ak = (tid & 7) * 4, bn = tid >> 1, bk = (tid & 1) * 16;
    for (int k0 = 0; k0 < K; k0 += 32) {
        const v2u av = *(const v2u*)(A0 + (size_t)ar * K + k0 + ak);
        const v4u b0 = *(const v4u*)(B0 + (size_t)bn * K + k0 + bk), b1 = *(const v4u*)(B0 + (size_t)bn * K + k0 + bk + 8);
        __syncthreads();
        As[(ak + 0) * 68 + ar] = bf2f(av.x & 0xffffu); As[(ak + 1) * 68 + ar] = bf2f(av.x >> 16); As[(ak + 2) * 68 + ar] = bf2f(av.y & 0xffffu); As[(ak + 3) * 68 + ar] = bf2f(av.y >> 16);
        float bf[16]; unpack8(b0, bf); unpack8(b1, bf + 8);
#pragma unroll
        for (int i = 0; i < 16; ++i) Bs[(bk + i) * 260 + bn] = bf[i];
        __syncthreads();
#pragma unroll 4
        for (int k = 0; k < 32; ++k) {
            const float a0 = As[k * 68 + ty * 2], a1 = As[k * 68 + ty * 2 + 1];
            const f32x4 x0 = *(const LAS f32x4*)(Bs + k * 260 + tx * 8), x1 = *(const LAS f32x4*)(Bs + k * 260 + tx * 8 + 4);
            const f32x4 y0 = *(const LAS f32x4*)(Bs + k * 260 + 128 + tx * 8), y1 = *(const LAS f32x4*)(Bs + k * 260 + 128 + tx * 8 + 4);
            const float bb[16] = {x0.x, x0.y, x0.z, x0.w, x1.x, x1.y, x1.z, x1.w, y0.x, y0.y, y0.z, y0.w, y1.x, y1.y, y1.z, y1.w};
#pragma unroll
            for (int j = 0; j < 16; ++j) { acc[0][j] += a0 * bb[j]; acc[1][j] += a1 * bb[j]; }
        }
    }
#pragma unroll
    for (int i = 0; i < 2; ++i)
#pragma unroll
        for (int j = 0; j < 8; ++j) epi(row0 + ty * 2 + i, pn, tx * 8 + j, acc[i][j], acc[i][8 + j]);
    __syncthreads();
}
template <class Epi>
__device__ __forceinline__ void ngemm_dense(const Ctx& C, const bf16* A, const bf16* Bt, int M, int N, int K, const Epi& epi) {
    const int nN = N / 256, nU = (M / 64) * nN;
    for (int u = blockIdx.x; u < nU; u += gridDim.x) { const int tm = u / nN, pn = u % nN;
        ngemm_unit(C, A + (size_t)tm * 64 * K, Bt + (size_t)pn * 256 * K, K, tm * 64, pn, epi); }
}
template <class Epi>
__device__ __forceinline__ void ngemm_grouped(const Ctx& C, const bf16* A, const bf16* Bt, size_t estride, int N, int K, const Epi& epi) {
    const int* tile_e = (const int*)(C.ws + WS_ROUTE + RT_TILE); const int ntiles = *(const int*)(C.ws + WS_ROUTE + RT_NT);
    const int nN = N / 256, nU = ntiles * 4 * nN;
    for (int u = blockIdx.x; u < nU; u += gridDim.x) { const int pn = u % nN, tm = u / nN, e = tile_e[tm >> 2];
        ngemm_unit(C, A + (size_t)tm * 64 * K, Bt + (size_t)e * estride + (size_t)pn * 256 * K, K, tm * 64, pn, epi); }
}

struct EpiStoreBf16 { bf16* O; int ldc;
    __device__ __forceinline__ void operator()(int r, int pn, int c, float v0, float v1) const { bf16* o = O + (size_t)r * ldc + pn * 256 + c; o[0] = (bf16)f2bf(v0); o[128] = (bf16)f2bf(v1); } };
struct EpiResid0 { const Params* P; const float* mod; float* XC;
    __device__ __forceinline__ void operator()(int r, int pn, int c, float v0, float v1) const { const int n = pn * 256 + c; const float* xi = xin_row(*P, r); const float* g = mod + ((size_t)cond_of(r) * 6 + 2) * D;
        float* o = XC + (size_t)r * D; o[n] = xi[n] + g[n] * v0; o[n + 128] = xi[n + 128] + g[n + 128] * v1; } };
struct EpiResidAcc { const float* mod; float* XC;
    __device__ __forceinline__ void operator()(int r, int pn, int c, float v0, float v1) const { const int n = pn * 256 + c; const float* g = mod + ((size_t)cond_of(r) * 6 + 2) * D;
        float* o = XC + (size_t)r * D; o[n] += g[n] * v0; o[n + 128] += g[n + 128] * v1; } };
struct EpiSwiglu { bf16* G;
    __device__ __forceinline__ void operator()(int r, int pn, int c, float v0, float v1) const { G[(size_t)r * EH + pn * 128 + c] = (bf16)f2bf(silu_(v0) * v1); } };
struct EpiGlu { const bf16* GS; const float* b; bf16* GG;
    __device__ __forceinline__ void operator()(int r, int pn, int c, float v0, float v1) const { const int n = pn * 256 + c; const size_t o = (size_t)r * 512 + n;
        GG[o] = (bf16)f2bf(bf2f(GS[o]) * sigmoidf_(v0 + b[n])); GG[o + 128] = (bf16)f2bf(bf2f(GS[o + 128]) * sigmoidf_(v1 + b[n + 128])); } };

__device__ __forceinline__ void qk_norm_rope(float (&v)[8], const float* gain, bool lat, int t, int lane, const float2* rope) {
    float ss = 0.f;
#pragma unroll
    for (int j = 0; j < 8; ++j) ss += v[j] * v[j];
    ss += __shfl_xor(ss, 1); ss += __shfl_xor(ss, 2); ss += __shfl_xor(ss, 4);
    const float rstd = rsqrtf(ss * (1.f / 64.f) + EPS);
    const int l8 = lane & 7;
#pragma unroll
    for (int j = 0; j < 8; ++j) v[j] = v[j] * rstd * gain[l8 * 8 + j];
    const int quarter = l8 >> 1, pos = (quarter < 2) ? (t >> 6) : (t & 63);
#pragma unroll
    for (int j = 0; j < 8; ++j) {
        const float pv = __shfl_xor(v[j], 2);
        if (lat) { const float2 cs = rope[pos * 16 + (lane & 1) * 8 + j];
            v[j] = (quarter & 1) ? (v[j] * cs.x + pv * cs.y) : (v[j] * cs.x - pv * cs.y); }
    }
}
__device__ __forceinline__ void phase_qkprep(const Ctx& C) {
    const Params& P = *C.p; const bf16* Pb = (const bf16*)(C.ws + WS_P); bf16* Q = (bf16*)(C.ws + WS_Q); bf16* Kb = (bf16*)(C.ws + WS_K); bf16* Vb = (bf16*)(C.ws + WS_V);
    const float2* rope = (const float2*)(C.ws + WS_TAB + TAB_ROPE);
    for (int r = C.gw; r < TT; r += C.ngw) {
        const bool lat = r < TL; const int t = lat ? (r & 2047) : 0;
        const size_t kvrow = lat ? (size_t)(r >> 11) * KVL + CTXL + (r & 2047) : (size_t)((r - TL) >> 8) * KVL + ((r - TL) & 255);
        const bf16* pr = Pb + (size_t)r * MIXW;
        { float v[8]; unpack8(*(const v4u*)(pr + 8 * C.lane), v); qk_norm_rope(v, P.in[I_QG], lat, t, C.lane, rope);
          v4u o; o.x = pk2(v[0] * QSCALE, v[1] * QSCALE); o.y = pk2(v[2] * QSCALE, v[3] * QSCALE); o.z = pk2(v[4] * QSCALE, v[5] * QSCALE); o.w = pk2(v[6] * QSCALE, v[7] * QSCALE);
          *(v4u*)(Q + (size_t)r * 512 + 8 * C.lane) = o; }
        { const int l = C.lane & 15; float v[8]; unpack8(*(const v4u*)(pr + 512 + 8 * l), v); qk_norm_rope(v, P.in[I_KG], lat, t, C.lane, rope);
          if (C.lane < 16) { v4u o; o.x = pk2(v[0], v[1]); o.y = pk2(v[2], v[3]); o.z = pk2(v[4], v[5]); o.w = pk2(v[6], v[7]); *(v4u*)(Kb + kvrow * 128 + 8 * l) = o;
              *(v4u*)(Vb + kvrow * 128 + 8 * l) = *(const v4u*)(pr + 640 + 8 * l); } }
    }
}

__device__ __forceinline__ void phase_gmlp(const Ctx& C) {
    const Params& P = *C.p; const bf16* Pb = (const bf16*)(C.ws + WS_P); bf16* OG = (bf16*)(C.ws + WS_H);
    LAS bf16* VN = (LAS bf16*)C.lds; constexpr int VP = 520;
    const int g = __builtin_amdgcn_readfirstlane(C.tid >> 6);
    for (int ch = blockIdx.x; ch < TT / 128; ch += gridDim.x) {
        for (int i = 0; i < 16; ++i) { const int rl = C.wave * 16 + i; const bf16* pr = Pb + (size_t)(ch * 128 + rl) * MIXW + 1280 + 8 * C.lane;
            float v[8]; unpack8(*(const v4u*)pr, v); float s = 0.f;
#pragma unroll
            for (int j = 0; j < 8; ++j) { v[j] = gelu_tanh(v[j]); s += v[j]; }
            const float mean = wave_sum(s) * (1.f / 512.f); float q = 0.f;
#pragma unroll
            for (int j = 0; j < 8; ++j) { v[j] -= mean; q += v[j] * v[j]; }
            const float rstd = rsqrtf(wave_sum(q) * (1.f / 512.f) + EPS);
#pragma unroll
            for (int j = 0; j < 8; ++j) v[j] = v[j] * rstd * P.in[I_LNG][8 * C.lane + j];
            v4u o; o.x = pk2(v[0], v[1]); o.y = pk2(v[2], v[3]); o.z = pk2(v[4], v[5]); o.w = pk2(v[6], v[7]);
            *(LAS v4u*)(VN + rl * VP + 8 * C.lane) = o; }
        __syncthreads();
        const float* wsp = P.in[I_WSP] + (size_t)g * 128 * 128; const float* bsp = P.in[I_BSP] + g * 128;
        for (int pb = 0; pb < 16; ++pb) {
            float acc[8];
#pragma unroll
            for (int i = 0; i < 8; ++i) acc[i] = 0.f;
            for (int q = 0; q < 128; ++q) { const float v = bf2f(VN[q * VP + C.tid]);
#pragma unroll
                for (int i = 0; i < 8; ++i) acc[i] += wsp[(pb * 8 + i) * 128 + q] * v; }
#pragma unroll
            for (int i = 0; i < 8; ++i) { const int p = pb * 8 + i; const size_t row = (size_t)ch * 128 + p;
                const float u = gelu_tanh(bf2f(Pb[row * MIXW + 768 + C.tid]));
                OG[row * D + 512 + C.tid] = (bf16)f2bf(u * (acc[i] + bsp[p])); }
        }
        __syncthreads();
    }
}

__device__ __forceinline__ void attn_item(const Ctx& C, int b, int h, int qrow_g, int nk) {
    const bf16* Q = (const bf16*)(C.ws + WS_Q); const bf16* Kb = (const bf16*)(C.ws + WS_K) + (size_t)b * KVL * 128 + (h >> 2) * 64; const bf16* Vb = (const bf16*)(C.ws + WS_V) + (size_t)b * KVL * 128 + (h >> 2) * 64;
    bf16* OG = (bf16*)(C.ws + WS_H);
    float q[64];
#pragma unroll
    for (int i = 0; i < 8; ++i) unpack8(*(const v4u*)(Q + (size_t)qrow_g * 512 + h * 64 + 8 * i), q + 8 * i);
    float m = -INFINITY, l = 0.f, o = 0.f;
    for (int kt = 0; kt < nk; kt += 64) {
        const bf16* kr = Kb + (size_t)(kt + C.lane) * 128; float s = 0.f;
#pragma unroll
        for (int i = 0; i < 8; ++i) { float kf[8]; unpack8(*(const v4u*)(kr + 8 * i), kf);
#pragma unroll
            for (int j = 0; j < 8; ++j) s += q[8 * i + j] * kf[j]; }
        const float mn = fmaxf(m, wave_max(s)); const float p = exp2f(s - mn), corr = exp2f(m - mn);
        l = l * corr + wave_sum(p); o *= corr; m = mn;
#pragma unroll 8
        for (int jj = 0; jj < 64; ++jj) { const float pj = __shfl(p, jj); o += pj * bf2f(Vb[(size_t)(kt + jj) * 128 + C.lane]); }
    }
    OG[(size_t)qrow_g * D + h * 64 + C.lane] = (bf16)f2bf(o / l);
}
__device__ __forceinline__ void phase_attn(const Ctx& C) {
    for (int it = C.gw; it < NB * 8 * SEQ; it += C.ngw) { const int bh = it >> 11, t = it & 2047, b = bh >> 3, h = bh & 7; attn_item(C, b, h, b * SEQ + t, KVL); }
    for (int it = C.gw; it < NB * 8 * CTXL; it += C.ngw) { const int bh = it >> 8, t = it & 255, b = bh >> 3, h = bh & 7; attn_item(C, b, h, TL + b * CTXL + t, CTXL); }
}


__device__ __forceinline__ void phase_attn_fast(const Ctx& C, char* lds_generic) {
    typedef attn_body::bf16 abf;
    const abf* Q = (const abf*)(C.ws + WS_Q); const abf* Kb = (const abf*)(C.ws + WS_K); const abf* Vb = (const abf*)(C.ws + WS_V); abf* OG = (abf*)(C.ws + WS_H);
    const int G = gridDim.x, bx = blockIdx.x; const int vcu = (G % 8 == 0) ? (bx % 8) * (G / 8) + bx / 8 : bx;
    const int per = (1024 + G - 1) / G, perc = (128 + G - 1) / G;
    for (int i = 0; i < per + perc; ++i) {
        int b, h, nt; size_t qrow;
        if (i < per) { const int u = vcu * per + i; if (u >= 1024) continue; const int qb = u & 7, hg = (u >> 3) & 3, bk = u >> 5; b = bk >> 1; h = (bk & 1) * 4 + hg; qrow = (size_t)b * SEQ + qb * 256; nt = KVL / 64; }
        else { const int u = vcu + (i - per) * G; if (u >= 128) continue; b = u >> 3; h = u & 7; qrow = (size_t)TL + (size_t)b * CTXL; nt = CTXL / 64; }
        const size_t kvo = (size_t)b * KVL * 128 + (h >> 2) * 64;
        attn_body::attn_unit<8>(Q + qrow * 512 + h * 64, Kb + kvo, Vb + kvo, OG + qrow * 1024 + h * 64, nt, lds_generic);
    }
}

__device__ __forceinline__ void phase_norm_ffn_router(const Ctx& C, int layer, int nrows) {
    const Params& P = *C.p; const float* XC = (const float*)(C.ws + WS_XC); bf16* F = (bf16*)(C.ws + WS_H);
    int* asg_e = (int*)(C.ws + WS_ROUTE + RT_E); int* asg_p = (int*)(C.ws + WS_ROUTE + RT_P); float* asg_w = (float*)(C.ws + WS_ROUTE + RT_W);
    unsigned* cnt = (unsigned*)(C.ws + WS_CTL) + CW_CNT + 64 * layer;
    const float* wg = P.in[I_WGRP] + (size_t)layer * D * 4; const float* wr = P.in[I_WRT] + (size_t)layer * D * 32;
    for (int r = C.gw; r < nrows; r += C.ngw) {
        f32x4 v[4]; load_row16(XC + (size_t)r * D, C.lane, v);
        const float rstd = row_rstd(v); const int ci = cond_of(r);
        modulate16(v, rstd, P.in[I_GFFN] + layer * D, mod_vec(C, layer, ci, 4), mod_vec(C, layer, ci, 3), C.lane);
        store_row16_bf16(F + (size_t)r * D, C.lane, v);
        float lg[4] = {0.f, 0.f, 0.f, 0.f}; float le[32];
#pragma unroll
        for (int i = 0; i < 32; ++i) le[i] = 0.f;
#pragma unroll
        for (int j = 0; j < 4; ++j)
#pragma unroll
            for (int i = 0; i < 4; ++i) { const int c = 4 * C.lane + 256 * j + i; const float f = v[j][i];
                const f32x4 g4 = *(const f32x4*)(wg + (size_t)c * 4); lg[0] += f * g4.x; lg[1] += f * g4.y; lg[2] += f * g4.z; lg[3] += f * g4.w;
#pragma unroll
                for (int e4 = 0; e4 < 8; ++e4) { const f32x4 w4 = *(const f32x4*)(wr + (size_t)c * 32 + e4 * 4); le[e4 * 4] += f * w4.x; le[e4 * 4 + 1] += f * w4.y; le[e4 * 4 + 2] += f * w4.z; le[e4 * 4 + 3] += f * w4.w; } }
#pragma unroll
        for (int i = 0; i < 4; ++i) lg[i] = wave_sum(lg[i]) + P.in[I_BGRP][layer * 4 + i];
#pragma unroll
        for (int i = 0; i < 32; ++i) le[i] = wave_sum(le[i]) + P.in[I_BRT][layer * 32 + i];
        int gi = 0; float gm = lg[0];
#pragma unroll
        for (int i = 1; i < 4; ++i) if (lg[i] > gm) { gm = lg[i]; gi = i; }
        float den = 0.f;
#pragma unroll
        for (int i = 0; i < 4; ++i) den += __expf(lg[i] - gm);
        const float gw_ = 1.f / den;
        float sel[8];
#pragma unroll
        for (int i = 0; i < 8; ++i) sel[i] = gi == 0 ? le[i] : gi == 1 ? le[8 + i] : gi == 2 ? le[16 + i] : le[24 + i];
        int i0 = 0; float v0 = sel[0];
#pragma unroll
        for (int i = 1; i < 8; ++i) if (sel[i] > v0) { v0 = sel[i]; i0 = i; }
        int i1 = -1; float v1 = -INFINITY;
#pragma unroll
        for (int i = 0; i < 8; ++i) if (i != i0 && sel[i] > v1) { v1 = sel[i]; i1 = i; }
        const float e1 = __expf(v1 - v0), w0 = gw_ / (1.f + e1), w1 = gw_ * e1 / (1.f + e1);
        if (C.lane == 0) {
            const int ea = gi * 8 + i0, eb = gi * 8 + i1;
            const unsigned pa = __hip_atomic_fetch_add(cnt + ea, 1u, __ATOMIC_RELAXED, __HIP_MEMORY_SCOPE_AGENT);
            const unsigned pb = __hip_atomic_fetch_add(cnt + eb, 1u, __ATOMIC_RELAXED, __HIP_MEMORY_SCOPE_AGENT);
            asg_e[2 * r] = ea; asg_e[2 * r + 1] = eb; asg_p[2 * r] = (int)pa; asg_p[2 * r + 1] = (int)pb; asg_w[2 * r] = w0; asg_w[2 * r + 1] = w1;
        }
    }
}
__device__ __forceinline__ void phase_gather(const Ctx& C, int layer, int nrows) {
    const bf16* F = (const bf16*)(C.ws + WS_H); bf16* XS = (bf16*)(C.ws + WS_XS);
    const int* asg_e = (const int*)(C.ws + WS_ROUTE + RT_E); const int* asg_p = (const int*)(C.ws + WS_ROUTE + RT_P); int* asg_s = (int*)(C.ws + WS_ROUTE + RT_S);
    int* tile_e = (int*)(C.ws + WS_ROUTE + RT_TILE); int* ntl = (int*)(C.ws + WS_ROUTE + RT_NT);
    unsigned* cnt = (unsigned*)(C.ws + WS_CTL) + CW_CNT + 64 * layer;
    const int mycnt = (C.lane < 32) ? (int)__hip_atomic_load(cnt + C.lane, __ATOMIC_RELAXED, __HIP_MEMORY_SCOPE_AGENT) : 0;
    const int mypad = (mycnt + 255) & ~255;
    int incl = mypad;
#pragma unroll
    for (int o = 1; o < 32; o <<= 1) { const int t = __shfl_up(incl, o); if ((C.lane & 31) >= o) incl += t; }
    const int ps = incl - mypad;
    for (int it = C.gw; it < nrows * 2; it += C.ngw) {
        const int e = asg_e[it], p = asg_p[it]; const int slot = __shfl(ps, e) + p;
        if (C.lane == 0) asg_s[it] = slot;
        const v4u* src = (const v4u*)(F + (size_t)(it >> 1) * D); v4u* dst = (v4u*)(XS + (size_t)slot * D);
        dst[C.lane] = src[C.lane]; dst[64 + C.lane] = src[64 + C.lane];
    }
    for (int e = C.gw; e < 33; e += C.ngw) {
        if (e < 32) { const int c0 = __shfl(mycnt, e), c1 = __shfl(mypad, e), base = __shfl(ps, e);
            for (int rr = c0; rr < c1; ++rr) { v4u* dst = (v4u*)(XS + (size_t)(base + rr) * D); const v4u z = {0u, 0u, 0u, 0u}; dst[C.lane] = z; dst[64 + C.lane] = z; } }
        else { if (C.lane < 32) { for (int t = ps / 256; t < (ps + mypad) / 256; ++t) tile_e[t] = C.lane; if (C.lane == 31) *ntl = (ps + mypad) / 256; } }
    }
}
__device__ __forceinline__ void moe_combine(const Ctx& C, int layer, int r, f32x4 (&v)[4]) {
    const bf16* Y2 = (const bf16*)(C.ws + WS_XS); const int* asg_s = (const int*)(C.ws + WS_ROUTE + RT_S); const float* asg_w = (const float*)(C.ws + WS_ROUTE + RT_W);
    const float* XC = (const float*)(C.ws + WS_XC);
    load_row16(XC + (size_t)r * D, C.lane, v);
    const int s0 = asg_s[2 * r], s1 = asg_s[2 * r + 1]; const float w0 = asg_w[2 * r], w1 = asg_w[2 * r + 1];
    const float* gate = mod_vec(C, layer, cond_of(r), 5);
#pragma unroll
    for (int j = 0; j < 4; ++j) { const int c = 4 * C.lane + 256 * j; const v2u a = *(const v2u*)(Y2 + (size_t)s0 * D + c), b = *(const v2u*)(Y2 + (size_t)s1 * D + c); const f32x4 g = *(const f32x4*)(gate + c);
        v[j].x += g.x * (w0 * bf2f(a.x & 0xffffu) + w1 * bf2f(b.x & 0xffffu)); v[j].y += g.y * (w0 * bf2f(a.x >> 16) + w1 * bf2f(b.x >> 16));
        v[j].z += g.z * (w0 * bf2f(a.y & 0xffffu) + w1 * bf2f(b.y & 0xffffu)); v[j].w += g.w * (w0 * bf2f(a.y >> 16) + w1 * bf2f(b.y >> 16)); }
}
__device__ __forceinline__ void phase_combine_norm_mix1(const Ctx& C) {
    const Params& P = *C.p; float* XC = (float*)(C.ws + WS_XC); bf16* H = (bf16*)(C.ws + WS_H);
    for (int r = C.gw; r < TT; r += C.ngw) {
        f32x4 v[4]; moe_combine(C, 0, r, v);
#pragma unroll
        for (int j = 0; j < 4; ++j) *(f32x4*)(XC + (size_t)r * D + 4 * C.lane + 256 * j) = v[j];
        const float rstd = row_rstd(v); const int ci = cond_of(r);
        modulate16(v, rstd, P.in[I_GMIX] + D, mod_vec(C, 1, ci, 1), mod_vec(C, 1, ci, 0), C.lane);
        store_row16_bf16(H + (size_t)r * D, C.lane, v);
    }
    LAS float* scr = (LAS float*)(C.lds + C.wave * 16384);
    for (int it = C.gw; it < MOE_ITEMS; it += C.ngw) moe_convert_item(C, 1, it, scr);
}
__device__ __forceinline__ void phase_final(const Ctx& C) {
    const Params& P = *C.p;
    for (int r = C.gw; r < TL; r += C.ngw) {
        f32x4 v[4]; moe_combine(C, 1, r, v);
        const float rstd = row_rstd(v);
#pragma unroll
        for (int j = 0; j < 4; ++j) { const int c = 4 * C.lane + 256 * j; const f32x4 g = *(const f32x4*)(P.in[I_FING] + c); *(f32x4*)(P.out + (size_t)r * D + c) = v[j] * rstd * g; }
    }
}

__device__ __forceinline__ void phase_s5(const Ctx& C) {
    const Params& P = *C.p; const bf16* U = (const bf16*)(C.ws + WS_U); bf16* GS = (bf16*)(C.ws + WS_GS); float* YA = (float*)(C.ws + WS_YACC);
    const float2* lamb = (const float2*)(C.ws + WS_TAB + TAB_LAMB); const float2* bbar = (const float2*)(C.ws + WS_TAB + TAB_BBAR);
    LAS f32x2* hb = (LAS f32x2*)(C.lds + C.wave * 8192);
    const int lane = C.lane;
    for (int it = C.gw; it < NB * 32; it += C.ngw) {
        const int b = it >> 5, g = it & 31;
        for (int dir = 0; dir < 2; ++dir) {
            const int dgn = ((dir * 32 + g) * 64 + lane);
            const float2 lam = lamb[dgn]; float2 bb[16];
#pragma unroll
            for (int p = 0; p < 16; ++p) bb[p] = bbar[(size_t)dgn * 16 + p];
            const float* cre = P.in[I_CRE] + (size_t)(dir * 32 + g) * 16 * 64; const float* cim = P.in[I_CIM] + (size_t)(dir * 32 + g) * 16 * 64;
            float hr = 0.f, hi = 0.f;
            for (int ck = 0; ck < 144; ++ck) {
                const bool isl = ck >= 16;
                const int tb = isl ? (dir == 0 ? (ck - 16) * 16 : (143 - ck) * 16) : (dir == 0 ? ck * 16 : (15 - ck) * 16);
                const size_t rowb = isl ? (size_t)b * SEQ + tb : (size_t)TL + (size_t)b * CTXL + tb;
                for (int sl = 0; sl < 16; ++sl) {
                    const int to = dir == 0 ? sl : 15 - sl;
                    const bf16* ur = U + (rowb + to) * 512 + g * 16; float uf[16]; unpack8(*(const v4u*)ur, uf); unpack8(*(const v4u*)(ur + 8), uf + 8);
                    float br = 0.f, bi = 0.f;
#pragma unroll
                    for (int p = 0; p < 16; ++p) { br += bb[p].x * uf[p]; bi += bb[p].y * uf[p]; }
                    const float nr = lam.x * hr - lam.y * hi + br, ni = lam.x * hi + lam.y * hr + bi; hr = nr; hi = ni;
                    if (isl) hb[to * 64 + lane] = (f32x2){hr, hi};
                }
                if (isl) {
                    asm volatile("s_waitcnt lgkmcnt(0)" ::: "memory");
                    const int p = lane & 15;
#pragma unroll
                    for (int i = 0; i < 4; ++i) { const int to = (lane >> 4) + 4 * i; float y = 0.f;
                        for (int n = 0; n < 64; ++n) { const f32x2 h = hb[to * 64 + n]; y += cre[p * 64 + n] * h.x - cim[p * 64 + n] * h.y; }
                        const size_t o = (rowb + to) * 512 + g * 16 + p;
                        if (dir == 0) YA[o] = y + P.in[I_S5D][g * 16 + p] * bf2f(U[o]);
                        else GS[o] = (bf16)f2bf(gelu_tanh(YA[o] + y)); }
                    asm volatile("s_waitcnt lgkmcnt(0)" ::: "memory");
                }
            }
        }
    }
}


__device__ __forceinline__ void phase_s5_fast(const Ctx& C) {
    typedef short bf16x8 __attribute__((ext_vector_type(8)));
    typedef float f32x16 __attribute__((ext_vector_type(16)));
    const Params& P = *C.p; const bf16* U = (const bf16*)(C.ws + WS_U); bf16* GS = (bf16*)(C.ws + WS_GS); float* YA = (float*)(C.ws + WS_YACC);
    const float2* lamb = (const float2*)(C.ws + WS_TAB + TAB_LAMB); const float2* bbar = (const float2*)(C.ws + WS_TAB + TAB_BBAR);
    constexpr int HP = 272;
    const int lane = C.lane, w = C.wave, il = w >> 2, dir = (w >> 1) & 1, nh = w & 1;
    const int l31 = lane & 31, hi = lane >> 5, l15 = lane & 15, q4 = lane >> 4;
    LAS unsigned char* Hb = C.lds + (il * 2 + dir) * (2 * 32 * HP);
    const int srow = (l31 & 3) + 4 * (l31 >> 3) + 16 * ((l31 >> 2) & 1);
    for (int it0 = blockIdx.x; it0 < NB * 16; it0 += gridDim.x) {
        const int item = it0 * 2 + il, b = item >> 5, g = item & 31;
        const int dg = dir * 32 + g, n = nh * 32 + l31;
        const float2 lam = lamb[dg * 64 + n];
        float lpr[16], lpi[16]; { float pr = lam.x, pi = lam.y;
#pragma unroll
            for (int r = 0; r < 16; ++r) { lpr[r] = pr; lpi[r] = pi; const float nr = pr * lam.x - pi * lam.y, ni = pr * lam.y + pi * lam.x; pr = nr; pi = ni; } }
        bf16x8 bre, bim; { const float2* bp = bbar + ((size_t)(dg * 64 + n)) * 16 + 8 * hi;
#pragma unroll
            for (int e = 0; e < 8; ++e) { const float2 v = bp[e]; bre[e] = (short)f2bf(v.x); bim[e] = (short)f2bf(v.y); } }
        bf16x8 cf[4]; { const float* cre = P.in[I_CRE] + ((size_t)dg * 16 + l15) * 64; const float* cim = P.in[I_CIM] + ((size_t)dg * 16 + l15) * 64;
#pragma unroll
            for (int ks = 0; ks < 4; ++ks) { const f32x4 a = *(const f32x4*)(cre + 16 * ks + 4 * q4), m = *(const f32x4*)(cim + 16 * ks + 4 * q4);
                cf[ks][0] = (short)f2bf(a.x); cf[ks][1] = (short)f2bf(-m.x); cf[ks][2] = (short)f2bf(a.y); cf[ks][3] = (short)f2bf(-m.y);
                cf[ks][4] = (short)f2bf(a.z); cf[ks][5] = (short)f2bf(-m.z); cf[ks][6] = (short)f2bf(a.w); cf[ks][7] = (short)f2bf(-m.w); } }
        const f32x4 dsk = *(const f32x4*)(P.in[I_S5D] + g * 16 + 4 * q4);
        float cr = 0.f, ci = 0.f;
        for (int k = 0; k < 72; ++k) {
            { const int S = 32 * k + srow; size_t row;
              if (S < CTXL) row = (size_t)TL + (size_t)b * CTXL + (dir == 0 ? S : CTXL - 1 - S); else row = (size_t)b * SEQ + (dir == 0 ? S - CTXL : SEQ - 1 - (S - CTXL));
              const bf16x8 ua = *(const bf16x8*)(U + row * 512 + g * 16 + 8 * hi);
              f32x16 br = {}, bi = {};
              br = __builtin_amdgcn_mfma_f32_32x32x16_bf16(ua, bre, br, 0, 0, 0);
              bi = __builtin_amdgcn_mfma_f32_32x32x16_bf16(ua, bim, bi, 0, 0, 0);
              float sr = hi ? 0.f : cr, si = hi ? 0.f : ci;
#pragma unroll
              for (int r = 0; r < 16; ++r) { const float nr = lam.x * sr - lam.y * si + br[r], ni = lam.x * si + lam.y * sr + bi[r]; sr = nr; si = ni; br[r] = sr; bi[r] = si; }
              float er = __shfl_xor(sr, 32), ei = __shfl_xor(si, 32); if (!hi) { er = 0.f; ei = 0.f; }
#pragma unroll
              for (int r = 0; r < 16; ++r) { br[r] += lpr[r] * er - lpi[r] * ei; bi[r] += lpr[r] * ei + lpi[r] * er; }
              cr = __shfl_xor(br[15], 32); ci = __shfl_xor(bi[15], 32);
              LAS unsigned char* hb = Hb + (k & 1) * (32 * HP) + (16 * hi) * HP + 4 * n;
#pragma unroll
              for (int r = 0; r < 16; ++r) *(LAS unsigned*)(hb + r * HP) = pk2(br[r], bi[r]);
            }
            asm volatile("s_waitcnt vmcnt(0) lgkmcnt(0)\n\ts_barrier" ::: "memory");
            if (k >= 8) {
                const LAS unsigned char* hr = Hb + (k & 1) * (32 * HP) + (16 * nh + l15) * HP + 16 * q4;
                f32x4 y = {0.f, 0.f, 0.f, 0.f};
#pragma unroll
                for (int ks = 0; ks < 4; ++ks) { const bf16x8 hf = *(const LAS bf16x8*)(hr + 64 * ks); y = __builtin_amdgcn_mfma_f32_16x16x32_bf16(cf[ks], hf, y, 0, 0, 0); }
                const int sl = 32 * (k - 8) + 16 * nh + l15;
                const int tok = dir == 0 ? sl : SEQ - 1 - sl; const int lt = tok >> 5;
                const size_t o = ((size_t)b * SEQ + tok) * 512 + g * 16 + 4 * q4;
                const bool first = dir == 0 ? (lt < 32) : (lt >= 32);
                if (first) { *(f32x4*)(YA + o) = y; }
                else {
                    f32x4 p; p.x = __hip_atomic_load(YA + o, __ATOMIC_RELAXED, __HIP_MEMORY_SCOPE_AGENT); p.y = __hip_atomic_load(YA + o + 1, __ATOMIC_RELAXED, __HIP_MEMORY_SCOPE_AGENT);
                    p.z = __hip_atomic_load(YA + o + 2, __ATOMIC_RELAXED, __HIP_MEMORY_SCOPE_AGENT); p.w = __hip_atomic_load(YA + o + 3, __ATOMIC_RELAXED, __HIP_MEMORY_SCOPE_AGENT);
                    const v2u uu = *(const v2u*)(U + o);
                    const f32x4 uf = {bf2f(uu.x & 0xffffu), bf2f(uu.x >> 16), bf2f(uu.y & 0xffffu), bf2f(uu.y >> 16)};
                    const f32x4 t = y + p + dsk * uf;
                    v2u ov; ov.x = pk2(gelu_tanh(t.x), gelu_tanh(t.y)); ov.y = pk2(gelu_tanh(t.z), gelu_tanh(t.w)); *(v2u*)(GS + o) = ov;
                }
            }
        }
        asm volatile("s_waitcnt vmcnt(0) lgkmcnt(0)\n\ts_barrier" ::: "memory");
    }
}

__global__ void __launch_bounds__(NTHR, 2) fwd_kernel(Params prm) {
    extern __shared__ __attribute__((aligned(16))) unsigned char lds_raw[];
    Ctx C; C.p = &prm; C.ws = prm.ws; C.lds = (LAS unsigned char*)lds_raw;
    C.tid = threadIdx.x; C.lane = C.tid & 63; C.wave = __builtin_amdgcn_readfirstlane(C.tid >> 6);
    C.gw = blockIdx.x * NWAVE + C.wave; C.ngw = gridDim.x * NWAVE;
    constexpr int LDS_MISC = 147456 - 256;
    volatile LAS unsigned* misc = (volatile LAS unsigned*)(C.lds + LDS_MISC);
    if (C.tid < 64) misc[C.tid] = 0u;
    __syncthreads();
    unsigned* ctl = (unsigned*)(C.ws + WS_CTL);
    XcdBarrier bar; bar.bar = ctl + CW_BAR; bar.x = 0; bar.st = nullptr;
#if MK_ONE_LAUNCH
    bar = xcd_barrier_post(ctl + CW_BAR, misc + 8);
#define SEAM(k) do { if (lo <= (k) && (k) + 1 < hi) xcd_barrier(bar); } while (0)
#else
#define SEAM(k) do { } while (0)
#endif
    const int lo = prm.ph_lo, hi = prm.ph_hi;
#define IN(k) (lo <= (k) && (k) < hi)
    const Params& P = prm;
    bf16* Hb = (bf16*)(C.ws + WS_H); float* XC = (float*)(C.ws + WS_XC);
#define MOE_GEMM1() do { const int ntl_ = *(const int*)(C.ws + WS_ROUTE + RT_NT); pg8::Gemm g{(const bf16*)(C.ws + WS_XS), (const bf16*)(C.ws + WS_W13), 0, 1024, D}; \
        pg8::GroupedOrder S{(const int*)(C.ws + WS_ROUTE + RT_TILE), ntl_ * 4, 4, (int)gridDim.x, (int)blockIdx.x, (size_t)1024 * 1024 * 2}; pg8::EpiSwiglu E{(bf16*)(C.ws + WS_G13)}; \
        pg8::gemm_phase<pg8::EpiSwiglu, pg8::GroupedOrder, true, true>(C.lds, g, S, E); } while (0)
#define MOE_GEMM2() do { const int ntl_ = *(const int*)(C.ws + WS_ROUTE + RT_NT); pg8::Gemm g{(const bf16*)(C.ws + WS_G13), (const bf16*)(C.ws + WS_W2), 0, 1024, EH}; \
        pg8::GroupedOrder S{(const int*)(C.ws + WS_ROUTE + RT_TILE), ntl_ * 4, 4, (int)gridDim.x, (int)blockIdx.x, (size_t)1024 * 512 * 2}; pg8::EpiStore E{(bf16*)(C.ws + WS_XS), D}; \
        pg8::gemm_phase<pg8::EpiStore, pg8::GroupedOrder, true, true>(C.lds, g, S, E); } while (0)
    if (IN(0)) { phase_prologue(C); SEAM(0); }
    if (IN(1)) { phase_norm_mix0(C); SEAM(1); }
    if (IN(2)) { pg8::Gemm g{Hb, (const bf16*)(C.ws + WS_WIN0), TT, MIXW, D}; pg8::StaticOrder S; S.init(TT, MIXW, gridDim.x, blockIdx.x); pg8::EpiStore E{(bf16*)(C.ws + WS_P), MIXW};
        pg8::gemm_phase<pg8::EpiStore, pg8::StaticOrder, true, true>(C.lds, g, S, E); SEAM(2); }
    if (IN(3)) { phase_qkprep(C); phase_gmlp(C); SEAM(3); }
    if (IN(4)) { phase_attn_fast(C, (char*)lds_raw); SEAM(4); }
    if (IN(5)) { pg8::Gemm g{Hb, (const bf16*)(C.ws + WS_WOUT0), TT, D, D}; pg8::StaticOrder S; S.init(TT, D, gridDim.x, blockIdx.x); pg8::EpiResid E{P.in[I_X], P.in[I_CTX], (const float*)(C.ws + WS_MOD), XC, 0};
        pg8::gemm_phase<pg8::EpiResid, pg8::StaticOrder, true, true>(C.lds, g, S, E); SEAM(5); }
    if (IN(6)) { phase_norm_ffn_router(C, 0, TT); SEAM(6); }
    if (IN(7)) { phase_gather(C, 0, TT); SEAM(7); }
    if (IN(8)) { MOE_GEMM1(); SEAM(8); }
    if (IN(9)) { MOE_GEMM2(); SEAM(9); }
    if (IN(10)) { phase_combine_norm_mix1(C); SEAM(10); }
    if (IN(11)) { pg8::Gemm g{Hb, (const bf16*)(C.ws + WS_WS5IN), TT, 512, D}; pg8::StaticOrder S; S.init(TT, 512, gridDim.x, blockIdx.x); pg8::EpiStore E{(bf16*)(C.ws + WS_U), 512};
        pg8::gemm_phase<pg8::EpiStore, pg8::StaticOrder, true, true>(C.lds, g, S, E); SEAM(11); }
    if (IN(12)) { phase_s5_fast(C); SEAM(12); }
    if (IN(13)) { pg8::Gemm g{(const bf16*)(C.ws + WS_GS), (const bf16*)(C.ws + WS_WGLU), TL, 512, 512}; pg8::StaticOrder S; S.init(TL, 512, gridDim.x, blockIdx.x); pg8::EpiGlu E{(const bf16*)(C.ws + WS_GS), P.in[I_BGLU], (bf16*)(C.ws + WS_GG)};
        pg8::gemm_phase<pg8::EpiGlu, pg8::StaticOrder, true, true>(C.lds, g, S, E); SEAM(13); }
    if (IN(14)) { pg8::Gemm g{(const bf16*)(C.ws + WS_GG), (const bf16*)(C.ws + WS_WS5OUT), TL, D, 512}; pg8::StaticOrder S; S.init(TL, D, gridDim.x, blockIdx.x); pg8::EpiResid E{P.in[I_X], P.in[I_CTX], (const float*)(C.ws + WS_MOD) + (size_t)17 * 6 * D, XC, 1};
        pg8::gemm_phase<pg8::EpiResid, pg8::StaticOrder, true, true>(C.lds, g, S, E); SEAM(14); }
    if (IN(15)) { phase_norm_ffn_router(C, 1, TL); SEAM(15); }
    if (IN(16)) { phase_gather(C, 1, TL); SEAM(16); }
    if (IN(17)) { MOE_GEMM1(); SEAM(17); }
    if (IN(18)) { MOE_GEMM2(); SEAM(18); }
    if (IN(19)) { phase_final(C); }
#undef IN
#undef SEAM
}

extern "C" void kernel_launch(void* const* d_in, const int* in_sizes, int n_in, void* d_out, int out_size, void* d_ws, size_t ws_size, hipStream_t stream) {
    constexpr int LDS_BYTES = 147456;
    static int grid = 0;
    if (grid == 0) {
        if (n_in != 35 || out_size != TL * D || ws_size < WS_END) { fprintf(stderr, "kernel_launch: unexpected shapes (n_in %d out %d ws %zu)\n", n_in, out_size, ws_size); grid = -1; return; }
        int dev = 0, cus = 0;
        if (hipGetDevice(&dev) != hipSuccess || hipDeviceGetAttribute(&cus, hipDeviceAttributeMultiprocessorCount, dev) != hipSuccess) { grid = -1; return; }
        if (hipFuncSetAttribute((const void*)fwd_kernel, hipFuncAttributeMaxDynamicSharedMemorySize, LDS_BYTES) != hipSuccess) { fprintf(stderr, "kernel_launch: hipFuncSetAttribute failed\n"); grid = -1; return; }
        (void)hipGetLastError();
        grid = cus;
    }
    if (grid < 0) return;
    (void)hipMemsetAsync((char*)d_ws + WS_CTL, 0, CTL_BYTES, stream);
    Params p{};
    for (int i = 0; i < 35; ++i) p.in[i] = (const float*)d_in[i];
    p.out = (float*)d_out; p.ws = (unsigned char*)d_ws;
#if MK_ONE_LAUNCH
    p.ph_lo = 0; p.ph_hi = NPHASE;
    hipLaunchKernelGGL(fwd_kernel, dim3(grid), dim3(NTHR), LDS_BYTES, stream, p);
#else
    for (int k = 0; k < NPHASE; ++k) { p.ph_lo = k; p.ph_hi = k + 1; hipLaunchKernelGGL(fwd_kernel, dim3(grid), dim3(NTHR), LDS_BYTES, stream, p); }
#endif
}
```

```cpp
#include <hip/hip_runtime.h>
#include <cstdio>
#include <cstdint>

#ifndef MK_ONE_LAUNCH
#define MK_ONE_LAUNCH 1
#endif

constexpr int D = 1024, NB = 16, SEQ = 2048, CTXL = 256;
constexpr int TL = NB * SEQ, TC = NB * CTXL, TT = TL + TC;
constexpr int KVL = CTXL + SEQ;
constexpr int MIXW = 1792, NEXP = 32, EH = 512;
constexpr int NSLOT = 81920;
constexpr float EPS = 1e-6f;
constexpr float QSCALE = 0.125f * 1.4426950408889634f;
constexpr int NTHR = 512, NWAVE = 8;
constexpr int NPHASE = 20;

constexpr size_t MiB = 1u << 20;
constexpr size_t WS_CTL = 0, CTL_BYTES = 1 * MiB;
constexpr size_t WS_MOD = 1 * MiB;
constexpr size_t WS_TAB = 2 * MiB;
constexpr size_t TAB_ROPE = 0, TAB_LAMB = 16384, TAB_BBAR = 65536, TAB_WR = 640 * 1024;
constexpr size_t WS_ROUTE = 3 * MiB;
constexpr size_t RT_E = 0, RT_P = 320 * 1024, RT_W = 640 * 1024, RT_S = 960 * 1024, RT_TILE = 1280 * 1024, RT_NT = 1280 * 1024 + 4096;
constexpr size_t WS_WIN0 = 6 * MiB, WS_WOUT0 = 10 * MiB, WS_WS5IN = 12 * MiB, WS_WGLU = 13 * MiB, WS_WS5OUT = 14 * MiB;
constexpr size_t WS_W13 = 16 * MiB, WS_W2 = 80 * MiB;
constexpr size_t WS_XC = 112 * MiB;
constexpr size_t WS_H = 256 * MiB;
constexpr size_t WS_P = 328 * MiB;
constexpr size_t WS_Q = 454 * MiB, WS_K = 490 * MiB, WS_V = 499 * MiB;
constexpr size_t WS_XS = 328 * MiB;
constexpr size_t WS_G13 = 488 * MiB;
constexpr size_t WS_U = 328 * MiB, WS_GS = 364 * MiB, WS_GG = 396 * MiB, WS_YACC = 428 * MiB;
constexpr size_t WS_LIST = 568 * MiB;
constexpr int LCAP = 36864;
constexpr size_t WS_END = 574 * MiB;
constexpr int CW_CNT = 64;
constexpr int CW_BAR = 4096;

#define LAS __attribute__((address_space(3)))
typedef unsigned short bf16;
typedef unsigned v4u __attribute__((ext_vector_type(4)));
typedef unsigned v2u __attribute__((ext_vector_type(2)));
typedef float f32x4 __attribute__((ext_vector_type(4)));
typedef float f32x2 __attribute__((ext_vector_type(2)));
__device__ __forceinline__ float bf2f(unsigned u) { return __uint_as_float(u << 16); }
__device__ __forceinline__ unsigned f2bf(float f) { unsigned u = __float_as_uint(f); return (u + 0x7fffu + ((u >> 16) & 1u)) >> 16; }
__device__ __forceinline__ unsigned pk2(float lo, float hi) { return f2bf(lo) | (f2bf(hi) << 16); }
__device__ __forceinline__ float wave_sum(float v) {
#pragma unroll
    for (int o = 1; o < 64; o <<= 1) v += __shfl_xor(v, o);
    return v;
}
__device__ __forceinline__ float wave_max(float v) {
#pragma unroll
    for (int o = 1; o < 64; o <<= 1) v = fmaxf(v, __shfl_xor(v, o));
    return v;
}
__device__ __forceinline__ float gelu_tanh(float x) { const float u = 0.7978845608028654f * (x + 0.044715f * x * x * x); return 0.5f * x * (1.f + tanhf(u)); }
__device__ __forceinline__ float sigmoidf_(float x) { return 1.f / (1.f + __expf(-x)); }
__device__ __forceinline__ float silu_(float x) { return x / (1.f + __expf(-x)); }
__device__ __forceinline__ void unpack8(const v4u w, float* f) {
    f[0] = bf2f(w.x & 0xffffu); f[1] = bf2f(w.x >> 16); f[2] = bf2f(w.y & 0xffffu); f[3] = bf2f(w.y >> 16);
    f[4] = bf2f(w.z & 0xffffu); f[5] = bf2f(w.z >> 16); f[6] = bf2f(w.w & 0xffffu); f[7] = bf2f(w.w >> 16);
}

#define XB_TMO      128
#define XB_XCNT(j)  (256  + 64 * (j))
#define XB_XSUB(j)  (1280 + 64 * (j))
#define XB_XGEN(j)  (2304 + 64 * (j))
#define XB_TOP      3328
#define XB_TOPGEN   3392
#define XCD_BAR_WORDS 3456
#define XB_SPIN_CAP (1u << 28)
__device__ __forceinline__ unsigned xb_ld(unsigned* p)              { return __hip_atomic_load(p, __ATOMIC_RELAXED, __HIP_MEMORY_SCOPE_AGENT); }
__device__ __forceinline__ unsigned xb_add(unsigned* p, unsigned v) { return __hip_atomic_fetch_add(p, v, __ATOMIC_RELAXED, __HIP_MEMORY_SCOPE_AGENT); }
__device__ __forceinline__ unsigned xb_xcc_id() { return (unsigned)__builtin_amdgcn_s_getreg((3 << 11) | 20) & 0xFu; }
#define XB_SPIN(cond, bar) do { unsigned _sp = 0; while (cond) { __builtin_amdgcn_s_sleep(1); \
    if ((++_sp & 255u) == 0u) { if (xb_ld(&(bar)[XB_TMO])) break; if (_sp > XB_SPIN_CAP) { atomicAdd(&(bar)[XB_TMO], 1u); break; } } } } while (0)
struct XcdBarrier { unsigned* bar; unsigned x; volatile LAS unsigned* st; };
__device__ __forceinline__ XcdBarrier xcd_barrier_post(unsigned* bar, volatile LAS unsigned* st) {
    XcdBarrier b; b.bar = bar; b.x = xb_xcc_id(); b.st = st;
    if (threadIdx.x == 0) (void)xb_add(&bar[XB_XCNT(b.x)], 1u);
    return b;
}
__device__ __forceinline__ void xcd_barrier_complete(unsigned* bar, unsigned x, unsigned& nloc, unsigned& nx) {
    const unsigned G = gridDim.x * gridDim.y * gridDim.z;
    unsigned sum, cnt, mine, sp = 0u;
    for (;;) {
        sum = 0u; cnt = 0u; mine = 0u;
#pragma unroll
        for (unsigned j = 0; j < 16; ++j) { const unsigned c = xb_ld(&bar[XB_XCNT(j)]); sum += c; cnt += (c > 0u) ? 1u : 0u; mine = (j == x) ? c : mine; }
        if (sum == G) break;
        __builtin_amdgcn_s_sleep(1);
        if ((++sp & 255u) == 0u) { if (xb_ld(&bar[XB_TMO])) break; if (sp > XB_SPIN_CAP) { atomicAdd(&bar[XB_TMO], 1u); break; } }
    }
    nloc = mine > 0u ? mine : 1u; nx = cnt > 0u ? cnt : 1u;
}
__device__ __forceinline__ void xcd_barrier(const XcdBarrier& b) {
    asm volatile("s_waitcnt vmcnt(0)" ::: "memory");
    __syncthreads();
    if (threadIdx.x == 0) {
        unsigned* bar = b.bar;
        __builtin_amdgcn_s_waitcnt(0);
        unsigned nloc = b.st[0], nx = b.st[1];
        if (nloc == 0u) { xcd_barrier_complete(bar, b.x, nloc, nx); b.st[0] = nloc; b.st[1] = nx; }
        const unsigned old = xb_add(&bar[XB_XSUB(b.x)], 1u);
        const unsigned gen = old / nloc;
        if (old + 1u == (gen + 1u) * nloc) {
            __builtin_amdgcn_fence(__ATOMIC_RELEASE, "agent");
            asm volatile("s_waitcnt vmcnt(0)" ::: "memory");
            const unsigned og = xb_add(&bar[XB_TOP], 1u);
            const unsigned tg = og / nx;
            if (og + 1u == (tg + 1u) * nx) xb_add(&bar[XB_TOPGEN], 1u);
            else XB_SPIN(xb_ld(&bar[XB_TOPGEN]) == tg, bar);
            __builtin_amdgcn_fence(__ATOMIC_ACQUIRE, "agent");
            xb_add(&bar[XB_XGEN(b.x)], 1u);
            asm volatile("s_waitcnt vmcnt(0)" ::: "memory");
        } else {
            XB_SPIN(xb_ld(&bar[XB_XGEN(b.x)]) == gen, bar);
            __builtin_amdgcn_fence(__ATOMIC_ACQUIRE, "agent");
            asm volatile("s_waitcnt vmcnt(0)" ::: "memory");
        }
    }
    __syncthreads();
}

namespace pg8 {
#define PG8_LAS __attribute__((address_space(3)))
typedef unsigned short bf16_t;
typedef short bf16x8 __attribute__((ext_vector_type(8)));
typedef float f32x4 __attribute__((ext_vector_type(4)));
typedef unsigned u32x4 __attribute__((ext_vector_type(4)));
constexpr int BM = 256, BK = 64, HALF = 128, HTB = HALF * BK * 2  , STAGE_BYTES = 8 * HTB, NXCD = 8, WGM = 8;

__host__ __device__ __forceinline__ int lds_byte(int r, int c) { const int st = (r >> 4) * 2 + (c >> 5), rr = r & 15, cc = c & 31, ob = rr * 64 + cc * 2; return st * 1024 + (ob ^ (((ob >> 9) & 1) << 5)); }
__host__ __device__ __forceinline__ void stage_rc(int b, int& R, int& C) { const int st = b / 1024, sb = b % 1024, swz = sb ^ (((sb >> 9) & 1) << 5); R = (st >> 1) * 16 + swz / 64; C = (st & 1) * 32 + (swz % 64) / 2; }
__host__ __device__ __forceinline__ int perm32(int rho) { const int n = rho >> 4, i = rho & 15; return 8 * (i >> 2) + 4 * n + (i & 3); }

struct Unit { int pm, pn; size_t bo; int aux; };
struct Gemm { const bf16_t* A; const bf16_t* Bt; int M, N, K; };

struct StaticOrder {
    static constexpr bool GATHER = false;
    int nM, nN, nwg, G, c;
    __host__ __device__ void init(int M, int N, int G_, int c_) { nM = M / BM; nN = N / BM; nwg = nM * nN; G = G_; c = c_; }
    __host__ __device__ bool next(int i, Unit& u) const {
        const long L = (long)i * G + c; if (L >= nwg) return false;
        int wgid = (int)L; { const int q = nwg / NXCD, r = nwg % NXCD, xcd = wgid % NXCD, off = wgid / NXCD; wgid = (xcd < r ? xcd * (q + 1) : r * (q + 1) + (xcd - r) * q) + off; }
        const int nig = WGM * nN, gid = wgid / nig, fm = gid * WGM, gsz = (nM - fm) < WGM ? (nM - fm) : WGM;
        u.pm = fm + ((wgid % nig) % gsz); u.pn = (wgid % nig) / gsz; u.bo = 0; u.aux = 0; return true;
    }
    __device__ __forceinline__ void a_ready(const Unit&) const {}
    __device__ __forceinline__ void done(const Unit&) const {}
};

__device__ __forceinline__ unsigned cvt_pk_bf16(float lo, float hi) { unsigned r; asm volatile("v_cvt_pk_bf16_f32 %0, %1, %2" : "=v"(r) : "v"(lo), "v"(hi)); return r; }
typedef float f32x2 __attribute__((ext_vector_type(2)));
__device__ __forceinline__ f32x2 gelu_pk(f32x2 v) {
    const f32x2 av = __builtin_elementwise_abs(v), d = av * 0.2316418882f + 1.0f;
    f32x2 t; t.x = __builtin_amdgcn_rcpf(d.x); t.y = __builtin_amdgcn_rcpf(d.y);
    f32x2 q = t * 0.5307027145f + (-0.7265760135f); q = q * t + 0.7107068705f; q = q * t + (-0.142248368f); q = q * t + 0.127414796f; q = q * t;
    const f32x2 s = (v * v) * (-0.72134752044f);
    f32x2 e; e.x = __builtin_amdgcn_exp2f(s.x); e.y = __builtin_amdgcn_exp2f(s.y);
    const f32x2 m = v * (q * e), r = v - m;
    f32x2 o; o.x = v.x < 0.f ? m.x : r.x; o.y = v.y < 0.f ? m.y : r.y; return o;
}

template <class Epi, class Sched, bool ALIGN_EPI = false, bool SP2 = false>
__device__ __forceinline__ void gemm_phase(PG8_LAS unsigned char* lds, const Gemm g, const Sched& S, const Epi& E) {
    const int tid = threadIdx.x, wid = __builtin_amdgcn_readfirstlane(tid >> 6), lane = tid & 63, wr = wid >> 2, wc = wid & 3, fr = lane & 15, fq = lane >> 4;
    const int K = g.K, nt = K / BK;
    unsigned voffA[2], voffB[2];
    unsigned vC[2][2], vN[2][2];
#pragma unroll
    for (int i = 0; i < 2; ++i) { int R, C; stage_rc(tid * 16 + i * 8192, R, C); const int Rb = Epi::PERM ? ((R & ~31) + perm32(R & 31)) : R;
        voffA[i] = (unsigned)(R * K + C) * 2u; voffB[i] = (unsigned)(Rb * K + C) * 2u; }
    const size_t kstep = (size_t)(BK * 2);
    const size_t hstep = (size_t)HALF * K * 2;
    const size_t tstep = 2 * hstep;
    const unsigned ldsw = (unsigned)wid * 1024u;
    const int aoff = lds_byte(wr * 64 + fr, fq * 8), boff = lds_byte(wc * 32 + fr, fq * 8);
#define PG8_SA(b, h) (((b) * 2 + (h)) * HTB)
#define PG8_SB(b, h) ((4 + (b) * 2 + (h)) * HTB)
#define PG8_STAGE(bufoff, gbase, voff) do { _Pragma("unroll") for (int _i = 0; _i < 2; ++_i) \
        __builtin_amdgcn_global_load_lds((const unsigned*)((const char*)(gbase) + (voff)[_i]), (PG8_LAS unsigned*)(lds + (bufoff) + ldsw + _i * 8192), 16, 0, 0); } while (0)
#define PG8_STAGE_A(bufoff, gbase, h, nx) do { _Pragma("unroll") for (int _i = 0; _i < 2; ++_i) { \
        const unsigned _vo = Sched::GATHER ? ((nx) ? vN[h][_i] : vC[h][_i]) : (unsigned)((h) * hstep) + voffA[_i]; \
        __builtin_amdgcn_global_load_lds((const unsigned*)((const char*)(gbase) + _vo), (PG8_LAS unsigned*)(lds + (bufoff) + ldsw + _i * 8192), 16, 0, 0); } } while (0)
#define PG8_LDA(dst, b, h) do { _Pragma("unroll") for (int m = 0; m < 4; ++m) _Pragma("unroll") for (int k = 0; k < 2; ++k) dst[m][k] = *(const PG8_LAS bf16x8*)(lds + PG8_SA(b, h) + aoff + m * 2048 + k * 1024); } while (0)
#define PG8_LDB(dst, b, h) do { _Pragma("unroll") for (int n = 0; n < 2; ++n) _Pragma("unroll") for (int k = 0; k < 2; ++k) dst[n][k] = *(const PG8_LAS bf16x8*)(lds + PG8_SB(b, h) + boff + n * 2048 + k * 1024); } while (0)
#define PG8_MMA(ai, bj, At, Bt) do { __builtin_amdgcn_s_setprio(1); _Pragma("unroll") for (int m = 0; m < 4; ++m) _Pragma("unroll") for (int n = 0; n < 2; ++n) _Pragma("unroll") for (int k = 0; k < 2; ++k) \
        acc[ai][bj][m][n] = __builtin_amdgcn_mfma_f32_16x16x32_bf16(Bt[n][k], At[m][k], acc[ai][bj][m][n], 0, 0, 0); __builtin_amdgcn_s_setprio(0); } while (0)
#define PG8_WAIT_V(n) asm volatile("s_waitcnt vmcnt(" #n ")" ::: "memory")
#define PG8_WAIT_L(n) asm volatile("s_waitcnt lgkmcnt(" #n ")" ::: "memory")
#define PG8_BAR __builtin_amdgcn_s_barrier()
#define PG8_SCHED __builtin_amdgcn_sched_barrier(0)
    Unit cur, nxt; int ui = 0;
    if (!S.next(0, cur)) return;
    f32x4 acc[2][2][4][2];
#pragma unroll
    for (int a = 0; a < 2; ++a)
#pragma unroll
        for (int b = 0; b < 2; ++b)
#pragma unroll
            for (int m = 0; m < 4; ++m)
#pragma unroll
                for (int n = 0; n < 2; ++n) acc[a][b][m][n] = (f32x4){0.f, 0.f, 0.f, 0.f};
    bf16x8 At[4][2], B0[2][2], B1[2][2];
    const char* cA = (const char*)g.A + (Sched::GATHER ? (size_t)0 : (size_t)cur.pm * tstep); const char* cB = (const char*)g.Bt + cur.bo + (size_t)cur.pn * tstep;
    S.a_ready(cur);
#define PG8_VOFF(dst, un) do { _Pragma("unroll") for (int _h = 0; _h < 2; ++_h) _Pragma("unroll") for (int _i = 0; _i < 2; ++_i) { int R_, C_; stage_rc(tid * 16 + _i * 8192, R_, C_); dst[_h][_i] = S.a_off(un, _h * HALF + R_) + (unsigned)C_ * 2u; } } while (0)
    if constexpr (Sched::GATHER) { PG8_VOFF(vC, cur); }
    if constexpr (SP2) {
        PG8_STAGE(PG8_SB(0, 0), cB, voffB); PG8_STAGE(PG8_SB(0, 1), cB + hstep, voffB); PG8_STAGE_A(PG8_SA(0, 0), cA, 0, false); PG8_STAGE_A(PG8_SA(0, 1), cA, 1, false);
        if (wr == 1) PG8_BAR;
        PG8_WAIT_V(2); PG8_BAR;
        PG8_STAGE(PG8_SB(1, 0), cB + kstep, voffB); PG8_STAGE_A(PG8_SA(1, 0), cA + kstep, 0, false); PG8_STAGE(PG8_SB(1, 1), cB + hstep + kstep, voffB);
        PG8_WAIT_V(6); PG8_BAR;
    } else {
        PG8_STAGE(PG8_SB(0, 0), cB, voffB); PG8_STAGE_A(PG8_SA(0, 0), cA, 0, false); PG8_STAGE(PG8_SB(0, 1), cB + hstep, voffB); PG8_STAGE_A(PG8_SA(0, 1), cA, 1, false);
        if (wr == 1) PG8_BAR;
        PG8_WAIT_V(4); PG8_BAR;
        PG8_STAGE(PG8_SB(1, 0), cB + kstep, voffB); PG8_STAGE_A(PG8_SA(1, 0), cA + kstep, 0, false); PG8_STAGE(PG8_SB(1, 1), cB + hstep + kstep, voffB);
        PG8_WAIT_V(6); PG8_BAR;
    }
    for (;;) {
        const bool has_next = S.next(ui + 1, nxt);
        if constexpr (Sched::GATHER) { if (has_next) { PG8_VOFF(vN, nxt); } else { vN[0][0] = vC[0][0]; vN[0][1] = vC[0][1]; vN[1][0] = vC[1][0]; vN[1][1] = vC[1][1]; } }
        const char* nA = (has_next && !Sched::GATHER) ? (const char*)g.A + (size_t)nxt.pm * tstep : cA; const char* nB = has_next ? (const char*)g.Bt + nxt.bo + (size_t)nxt.pn * tstep : cB;
        for (int t = 0; t < nt; t += 2) {
            const bool last = (t == nt - 2);
            const char* a1 = cA + (size_t)(t + 1) * kstep;
            const char* a2 = last ? nA : cA + (size_t)(t + 2) * kstep; const char* b2 = last ? nB : cB + (size_t)(t + 2) * kstep;
            const char* a3 = a2 + kstep; const char* b3 = b2 + kstep;
            if (last && has_next) S.a_ready(nxt);
            if constexpr (SP2) {
            PG8_LDB(B0, 0, 0); PG8_LDB(B1, 0, 1); PG8_SCHED; PG8_LDA(At, 0, 0); PG8_STAGE_A(PG8_SA(1, 1), a1, 1, false);
            PG8_WAIT_V(8); PG8_WAIT_L(0); PG8_BAR; PG8_MMA(0, 0, At, B0); PG8_MMA(0, 1, At, B1); PG8_BAR; PG8_SCHED;
            PG8_LDA(At, 0, 1); PG8_STAGE(PG8_SB(0, 0), b2, voffB); PG8_STAGE(PG8_SB(0, 1), b2 + hstep, voffB); PG8_STAGE_A(PG8_SA(0, 0), a2, 0, last);
            PG8_WAIT_V(8); PG8_WAIT_L(0); PG8_BAR; PG8_MMA(1, 0, At, B0); PG8_MMA(1, 1, At, B1); PG8_BAR; PG8_SCHED;
            PG8_LDB(B0, 1, 0); PG8_LDB(B1, 1, 1); PG8_SCHED; PG8_LDA(At, 1, 0); PG8_STAGE_A(PG8_SA(0, 1), a2, 1, last);
            PG8_WAIT_V(8); PG8_WAIT_L(0); PG8_BAR; PG8_MMA(0, 0, At, B0); PG8_MMA(0, 1, At, B1); PG8_BAR; PG8_SCHED;
            PG8_LDA(At, 1, 1); PG8_STAGE(PG8_SB(1, 0), b3, voffB); PG8_STAGE(PG8_SB(1, 1), b3 + hstep, voffB); PG8_STAGE_A(PG8_SA(1, 0), a3, 0, last);
            PG8_WAIT_V(8); PG8_WAIT_L(0); PG8_BAR; PG8_MMA(1, 0, At, B0); PG8_MMA(1, 1, At, B1); PG8_BAR; PG8_SCHED;
            } else {
            PG8_LDB(B0, 0, 0); PG8_SCHED; PG8_LDA(At, 0, 0); PG8_STAGE_A(PG8_SA(1, 1), a1, 1, false);
            PG8_WAIT_L(8); PG8_BAR; PG8_WAIT_L(0); PG8_MMA(0, 0, At, B0); PG8_BAR; PG8_SCHED;
            PG8_LDB(B1, 0, 1); PG8_STAGE(PG8_SB(0, 0), b2, voffB);
            PG8_BAR; PG8_WAIT_L(0); PG8_MMA(0, 1, At, B1); PG8_BAR;
            PG8_LDA(At, 0, 1); PG8_STAGE_A(PG8_SA(0, 0), a2, 0, last);
            PG8_BAR; PG8_WAIT_L(0); PG8_MMA(1, 0, At, B0); PG8_BAR; PG8_SCHED;
            PG8_STAGE(PG8_SB(0, 1), b2 + hstep, voffB);
            PG8_WAIT_V(6); PG8_BAR; PG8_MMA(1, 1, At, B1); PG8_BAR;
            PG8_LDB(B0, 1, 0); PG8_SCHED; PG8_LDA(At, 1, 0); PG8_STAGE_A(PG8_SA(0, 1), a2, 1, last);
            PG8_WAIT_L(8); PG8_BAR; PG8_WAIT_L(0); PG8_MMA(0, 0, At, B0); PG8_BAR; PG8_SCHED;
            PG8_LDB(B1, 1, 1); PG8_STAGE(PG8_SB(1, 0), b3, voffB);
            PG8_BAR; PG8_WAIT_L(0); PG8_MMA(0, 1, At, B1); PG8_BAR;
            PG8_LDA(At, 1, 1); PG8_STAGE_A(PG8_SA(1, 0), a3, 0, last);
            PG8_BAR; PG8_WAIT_L(0); PG8_MMA(1, 0, At, B0); PG8_BAR; PG8_SCHED;
            PG8_STAGE(PG8_SB(1, 1), b3 + hstep, voffB);
            PG8_WAIT_V(6); PG8_BAR; PG8_MMA(1, 1, At, B1); PG8_BAR;
            }
        }
        if constexpr (ALIGN_EPI) { if (wr == 0) PG8_BAR; }
        if constexpr (!Epi::AFTER_DRAIN) { E(acc, cur, wr, wc, fr, fq); S.done(cur); }
        if (!has_next) break;
#pragma unroll
        for (int a = 0; a < 2; ++a)
#pragma unroll
            for (int b = 0; b < 2; ++b)
#pragma unroll
                for (int m = 0; m < 4; ++m)
#pragma unroll
                    for (int n = 0; n < 2; ++n) acc[a][b][m][n] = (f32x4){0.f, 0.f, 0.f, 0.f};
        cur = nxt; cA = nA; cB = nB; ++ui;
        if constexpr (Sched::GATHER) { vC[0][0] = vN[0][0]; vC[0][1] = vN[0][1]; vC[1][0] = vN[1][0]; vC[1][1] = vN[1][1]; }
        if constexpr (ALIGN_EPI) { if (wr == 1) PG8_BAR; }
    }
    PG8_WAIT_V(0);
    if constexpr (!ALIGN_EPI) { if (wr == 0) PG8_BAR; }
    PG8_BAR;
    if constexpr (Epi::AFTER_DRAIN) { E.fused(acc, cur, wr, wc, fr, fq, lds, wid, lane); S.done(cur); }
#undef PG8_VOFF
#undef PG8_SA
#undef PG8_SB
#undef PG8_STAGE
#undef PG8_STAGE_A
#undef PG8_LDA
#undef PG8_LDB
#undef PG8_MMA
#undef PG8_WAIT_V
#undef PG8_WAIT_L
#undef PG8_BAR
#undef PG8_SCHED
}
}

namespace pg8 {
template <bool GATHER_>
struct GroupedOrder {
    static constexpr bool GATHER = GATHER_;
    const PG8_LAS int* tmap; const PG8_LAS int* cntl; const int* list; int nU, nN, G, c, lcap, rowbytes; size_t estride;
    __device__ __forceinline__ bool next(int i, Unit& u) const { const long L = (long)i * G + c; if (L >= nU) return false; const int t = (int)L / nN; const int m = __builtin_amdgcn_readfirstlane(tmap[t]);
        u.pm = t; u.pn = (int)L % nN; u.bo = (size_t)(m & 255) * estride; u.aux = m; return true; }
    __device__ __forceinline__ unsigned a_off(const Unit& u, int R) const { const int e = u.aux & 255, p0 = u.aux >> 8, ce = cntl[e]; int p = p0 + R; p = p < ce ? p : ce - 1; return (unsigned)list[(size_t)e * lcap + p] * (unsigned)rowbytes; }
    __device__ __forceinline__ void a_ready(const Unit&) const {}
    __device__ __forceinline__ void done(const Unit&) const {}
};
__device__ __forceinline__ u32x4 pack8(const f32x4 a, const f32x4 b) { u32x4 w; w.x = cvt_pk_bf16(a[0], a[1]); w.y = cvt_pk_bf16(a[2], a[3]); w.z = cvt_pk_bf16(b[0], b[1]); w.w = cvt_pk_bf16(b[2], b[3]); return w; }
struct EpiStore {
    static constexpr bool PERM = true, AFTER_DRAIN = false; bf16_t* O; int ldc;
    __device__ __forceinline__ void operator()(const f32x4 (&acc)[2][2][4][2], const Unit& u, int wr, int wc, int fr, int fq) const {
        const int row0 = u.pm * BM + wr * 64 + fr, col0 = u.pn * BM + wc * 32 + 8 * fq;
#pragma unroll
        for (int ai = 0; ai < 2; ++ai)
#pragma unroll
            for (int m = 0; m < 4; ++m) { bf16_t* rowp = O + (size_t)(row0 + ai * HALF + m * 16) * ldc + col0;
#pragma unroll
                for (int bj = 0; bj < 2; ++bj) *(u32x4*)(rowp + bj * HALF) = pack8(acc[ai][bj][m][0], acc[ai][bj][m][1]); }
    }
};
__device__ __forceinline__ f32x4 silu4(const f32x4 v) { f32x4 r;
#pragma unroll
    for (int i = 0; i < 4; ++i) r[i] = v[i] * __builtin_amdgcn_rcpf(1.f + __expf(-v[i])); return r; }
__device__ __forceinline__ f32x4 sigm4(const f32x4 v) { f32x4 r;
#pragma unroll
    for (int i = 0; i < 4; ++i) r[i] = __builtin_amdgcn_rcpf(1.f + __expf(-v[i])); return r; }
struct EpiSwiglu {
    static constexpr bool PERM = true, AFTER_DRAIN = false; bf16_t* G;
    __device__ __forceinline__ void operator()(const f32x4 (&acc)[2][2][4][2], const Unit& u, int wr, int wc, int fr, int fq) const {
        const int row0 = u.pm * BM + wr * 64 + fr, col0 = u.pn * HALF + wc * 32 + 8 * fq;
#pragma unroll
        for (int ai = 0; ai < 2; ++ai)
#pragma unroll
            for (int m = 0; m < 4; ++m) *(u32x4*)(G + (size_t)(row0 + ai * HALF + m * 16) * 512 + col0) = pack8(silu4(acc[ai][0][m][0]) * acc[ai][1][m][0], silu4(acc[ai][0][m][1]) * acc[ai][1][m][1]);
    }
};
__device__ __forceinline__ void unpack8f(const u32x4 w, f32x4& a, f32x4& b) {
    a[0] = __uint_as_float(w.x << 16); a[1] = __uint_as_float(w.x & 0xffff0000u); a[2] = __uint_as_float(w.y << 16); a[3] = __uint_as_float(w.y & 0xffff0000u);
    b[0] = __uint_as_float(w.z << 16); b[1] = __uint_as_float(w.z & 0xffff0000u); b[2] = __uint_as_float(w.w << 16); b[3] = __uint_as_float(w.w & 0xffff0000u); }
struct EpiGlu {
    static constexpr bool PERM = true, AFTER_DRAIN = false; const bf16_t* GS; const float* b; bf16_t* GG;
    __device__ __forceinline__ void operator()(const f32x4 (&acc)[2][2][4][2], const Unit& u, int wr, int wc, int fr, int fq) const {
        const int row0 = u.pm * BM + wr * 64 + fr, col0 = u.pn * BM + wc * 32 + 8 * fq;
#pragma unroll
        for (int bj = 0; bj < 2; ++bj) { const int c = col0 + bj * HALF; const f32x4 b0 = *(const f32x4*)(b + c), b1 = *(const f32x4*)(b + c + 4);
#pragma unroll
            for (int ai = 0; ai < 2; ++ai)
#pragma unroll
                for (int m = 0; m < 4; ++m) { const size_t o = (size_t)(row0 + ai * HALF + m * 16) * 512 + c; f32x4 g0, g1; unpack8f(*(const u32x4*)(GS + o), g0, g1);
                    *(u32x4*)(GG + o) = pack8(g0 * sigm4(acc[ai][bj][m][0] + b0), g1 * sigm4(acc[ai][bj][m][1] + b1)); } }
    }
};
struct EpiResid {
    static constexpr bool PERM = false, AFTER_DRAIN = false;
    const float* x; const float* ctx; const float* mod; float* XC; int inplace;
    __device__ __forceinline__ void operator()(const f32x4 (&acc)[2][2][4][2], const Unit& u, int wr, int wc, int fr, int fq) const {
        const int R0 = u.pm * BM; const int ci = R0 < 32768 ? (R0 >> 11) : 16;
        const float* base = inplace ? XC + (size_t)R0 * 1024 : (R0 < 32768 ? x + (size_t)R0 * 1024 : ctx + (size_t)(R0 - 32768) * 1024);
        float* out = XC + (size_t)R0 * 1024; const float* gate = mod + ((size_t)ci * 6 + 2) * 1024;
        const int rl0 = wr * 64 + fr, col0 = u.pn * BM + wc * 32 + 4 * fq;
#pragma unroll
        for (int bj = 0; bj < 2; ++bj)
#pragma unroll
            for (int n = 0; n < 2; ++n) { const int c = col0 + bj * HALF + n * 16; const f32x4 g4 = *(const f32x4*)(gate + c);
#pragma unroll
                for (int ai = 0; ai < 2; ++ai)
#pragma unroll
                    for (int m = 0; m < 4; ++m) { const size_t o = (size_t)(rl0 + ai * HALF + m * 16) * 1024 + c; *(f32x4*)(out + o) = *(const f32x4*)(base + o) + g4 * acc[ai][bj][m][n]; } }
    }
};
}

#include <hip/hip_bf16.h>
#include <cmath>
namespace attn_body {
using bf16=__hip_bfloat16;
using bf16x8=__attribute__((ext_vector_type(8)))short;
using s16x4=__attribute__((ext_vector_type(4)))short;
using f32x16=__attribute__((ext_vector_type(16)))float;
using u32x4=__attribute__((ext_vector_type(4)))unsigned;
constexpr int D=64,QP=512,KP=128,OP=1024;
constexpr int NW=8,QBLK=32,QB=QBLK*NW,KVBLK=64;
constexpr int ATTN_UNIT_ROWS=QB;
__device__ __forceinline__ int crow(int r,int hi){return (r&3)+8*(r>>2)+4*hi;}
#define SBAR() __builtin_amdgcn_sched_barrier(0)
__device__ __forceinline__ void cmask(f32x16&p0,f32x16&p1,int jb,int qrel,int hi){
  const float NEG=-INFINITY; int kb=64*jb+4*hi;
  #pragma unroll
  for(int r=0;r<16;++r){int kv=kb+(r&3)+8*(r>>2); if(kv>qrel)p0[r]=NEG; if(kv+32>qrel)p1[r]=NEG;}
}

constexpr int NSLOT=3, SLOTB=8192;
constexpr int LDS_K=0, LDS_V=NSLOT*SLOTB, LDS_WS=2*NSLOT*SLOTB, LDS_OST=LDS_WS+NW*64*4, LDS_BYTES=LDS_OST+NW*4096;
constexpr float C2=0.125f*1.4426950408889634f;
__device__ __forceinline__ void glds16(const void*gsrc,unsigned lds_dst){unsigned keep;
  asm volatile("s_mov_b32 %0, m0\n\ts_mov_b32 m0, %2\n\ts_nop 0\n\tglobal_load_lds_dwordx4 %1, off\n\ts_mov_b32 m0, %0":"=&s"(keep):"v"(gsrc),"s"(lds_dst):"memory");}
__device__ __forceinline__ float max3f(float a,float b,float c){float r;asm("v_max3_f32 %0, %1, %2, %3":"=v"(r):"v"(a),"v"(b),"v"(c));return r;}
__device__ __forceinline__ float max2f(float a,float b){float r;asm("v_max_f32_e32 %0, %1, %2":"=v"(r):"v"(a),"v"(b));return r;}
__device__ __forceinline__ float fadd_s(float a,float b){float r;asm("v_add_f32_e32 %0, %1, %2":"=v"(r):"v"(a),"v"(b));return r;}
__device__ __forceinline__ float fsub_s(float a,float b){float r;asm("v_sub_f32_e32 %0, %1, %2":"=v"(r):"v"(a),"v"(b));return r;}
typedef float f32x2_t __attribute__((ext_vector_type(2))); typedef __bf16 bf16x2_t __attribute__((ext_vector_type(2)));
__device__ __forceinline__ unsigned cvtpk_s(float lo,float hi){f32x2_t v={lo,hi};bf16x2_t b=__builtin_convertvector(v,bf16x2_t);return __builtin_bit_cast(unsigned,b);}
#define WAIT_BAR(N) asm volatile("s_waitcnt vmcnt(" #N ") lgkmcnt(0)\n\ts_barrier":::"memory")

__device__ __forceinline__ void qkt(f32x16&p0,f32x16&p1,const char*Kslot,const bf16x8*qr,const f32x16&negm,int r32,int hi){
  const char*kb=Kslot+hi*1024+r32*16;
  #pragma unroll
  for(int d0=0;d0<4;++d0){
    const bf16x8 b0=*reinterpret_cast<const bf16x8*>(kb+d0*2048);
    const bf16x8 b1=*reinterpret_cast<const bf16x8*>(kb+d0*2048+512);
    if(d0==0){p0=__builtin_amdgcn_mfma_f32_32x32x16_bf16(b0,qr[0],negm,0,0,0);p1=__builtin_amdgcn_mfma_f32_32x32x16_bf16(b1,qr[0],negm,0,0,0);}
    else{p0=__builtin_amdgcn_mfma_f32_32x32x16_bf16(b0,qr[d0],p0,0,0,0);p1=__builtin_amdgcn_mfma_f32_32x32x16_bf16(b1,qr[d0],p1,0,0,0);}}
}
typedef __attribute__((address_space(3))) const char* lds_cptr;
typedef short v4i16_t __attribute__((ext_vector_type(4)));
__device__ __forceinline__ void kload8(bf16x8*kf,lds_cptr kp){
  kf[0]=*(const __attribute__((address_space(3))) bf16x8*)(kp);      kf[1]=*(const __attribute__((address_space(3))) bf16x8*)(kp+512);
  kf[2]=*(const __attribute__((address_space(3))) bf16x8*)(kp+2048); kf[3]=*(const __attribute__((address_space(3))) bf16x8*)(kp+2560);
  kf[4]=*(const __attribute__((address_space(3))) bf16x8*)(kp+4096); kf[5]=*(const __attribute__((address_space(3))) bf16x8*)(kp+4608);
  kf[6]=*(const __attribute__((address_space(3))) bf16x8*)(kp+6144); kf[7]=*(const __attribute__((address_space(3))) bf16x8*)(kp+6656);
}
__device__ __forceinline__ void kload2(bf16x8*kf,lds_cptr kp,int j){ kf[2*j]=*(const __attribute__((address_space(3))) bf16x8*)(kp+j*2048); kf[2*j+1]=*(const __attribute__((address_space(3))) bf16x8*)(kp+j*2048+512); }
__device__ __forceinline__ s16x4 vtr(lds_cptr p){ return __builtin_bit_cast(s16x4,__builtin_amdgcn_ds_read_tr16_b64_v4i16((__attribute__((address_space(3))) v4i16_t*)p)); }
__device__ __forceinline__ float rowmax(const f32x16&p0,const f32x16&p1){
  float a=max3f(p0[0],p0[1],p1[0]),b=max3f(p0[2],p0[3],p1[1]);a=max3f(a,p1[2],p1[3]);
  #pragma unroll
  for(int r=4;r<16;r+=4){a=max3f(a,p0[r],p0[r+1]);b=max3f(b,p0[r+2],p0[r+3]);a=max3f(a,p1[r],p1[r+1]);b=max3f(b,p1[r+2],p1[r+3]);}
  const float m=max2f(a,b);
  auto rr=__builtin_amdgcn_permlane32_swap(__float_as_uint(m),__float_as_uint(m),false,false);
  return max2f(__uint_as_float(rr[0]),__uint_as_float(rr[1]));
}
__device__ __forceinline__ void pv(f32x16*o,int vb,bf16x8 pa0,bf16x8 pa1,bf16x8 pa2,bf16x8 pa3){
  #pragma unroll
  for(int d0=0;d0<2;++d0){s16x4 lo[4],hi[4];
    #pragma unroll
    for(int ks=0;ks<4;++ks){
      asm volatile("ds_read_b64_tr_b16 %0,%1 offset:%c2":"=&v"(lo[ks]):"v"(vb),"i"(d0*4096+ks*1024):"memory");
      asm volatile("ds_read_b64_tr_b16 %0,%1 offset:%c2":"=&v"(hi[ks]):"v"(vb),"i"(d0*4096+ks*1024+512):"memory");}
    asm volatile("s_waitcnt lgkmcnt(0)":::"memory");SBAR();
    #define PK(k) (bf16x8){lo[k][0],lo[k][1],lo[k][2],lo[k][3],hi[k][0],hi[k][1],hi[k][2],hi[k][3]}
    o[d0]=__builtin_amdgcn_mfma_f32_32x32x16_bf16(pa0,PK(0),o[d0],0,0,0);
    o[d0]=__builtin_amdgcn_mfma_f32_32x32x16_bf16(pa1,PK(1),o[d0],0,0,0);
    o[d0]=__builtin_amdgcn_mfma_f32_32x32x16_bf16(pa2,PK(2),o[d0],0,0,0);
    o[d0]=__builtin_amdgcn_mfma_f32_32x32x16_bf16(pa3,PK(3),o[d0],0,0,0);
    #undef PK
  }
}

#ifndef ATTN_STORE16
#define ATTN_STORE16(p,v) (*(u32x4*)(p)=(v))
#endif
template<int THRL> __device__ __forceinline__ void attn_unit(const bf16*Q0,const bf16*__restrict__ Kh,const bf16*__restrict__ Vh,bf16*O0,const int NT,char*shm){
  const int tid=threadIdx.x,lane=tid&63,r32=lane&31,hi=lane>>5; const int wid=__builtin_amdgcn_readfirstlane(tid>>6);
  const bf16*Qw=Q0+(long)(wid*QBLK)*QP;
  const unsigned lds0=(unsigned)(uintptr_t)shm;
  float*wsf=(float*)(shm+LDS_WS)+wid*64;
  const bf16*ksrc=Kh+(long)lane*KP+wid*8;
  const bf16*vsrc=Vh+(long)(16*(wid&3)+(lane>>2))*KP+(wid>>2)*32+(lane&3)*8;
  const unsigned kdst=lds0+LDS_K+wid*1024, vdst=lds0+LDS_V+wid*1024;
  #define DMA_K(t,slot) glds16(ksrc+(long)(t)*KVBLK*KP,(unsigned)__builtin_amdgcn_readfirstlane(kdst+(slot)))
  #define DMA_V(t,slot) glds16(vsrc+(long)(t)*KVBLK*KP,(unsigned)__builtin_amdgcn_readfirstlane(vdst+(slot)))
  const int vb0=(int)(lds0+LDS_V)+((lane>>4)&1)*32+(lane&3)*8+(4*hi+((lane&15)>>2))*64;
  const char*Kbase=shm+LDS_K; bf16x8 kf[8];
  const lds_cptr shm3=(lds_cptr)shm; const lds_cptr kp0=shm3+LDS_K+hi*1024+r32*16; const lds_cptr vp0=shm3+LDS_V+((lane>>4)&1)*32+(lane&3)*8+(4*hi+((lane&15)>>2))*64;
  DMA_K(0,0);DMA_V(0,0);DMA_K(1,SLOTB);
  bf16x8 qr[4];
  #pragma unroll
  for(int d0=0;d0<4;++d0)qr[d0]=*reinterpret_cast<const bf16x8*>(&Qw[(long)r32*QP+d0*16+hi*8]);
  float mhat=0.f,l_reg=0.f;f32x16 o[2];o[0]=f32x16{};o[1]=f32x16{};f32x16 negm=f32x16{};asm volatile("":"+v"(negm));
  #define CMASK(P0,P1,t) do{}while(0)
  bool resc=false;
  #define START(P0,P1) do{ const float rm=rowmax(P0,P1); resc=false; \
    { const float dl=rm; mhat=fadd_s(mhat,dl); \
      _Pragma("unroll") for(int r=0;r<16;++r){P0[r]=fsub_s(P0[r],dl);P1[r]=fsub_s(P1[r],dl);} \
      _Pragma("unroll") for(int r=0;r<16;++r)negm[r]=-mhat; asm volatile("":"+v"(negm)); } \
    _Pragma("unroll") for(int r=0;r<16;++r)P0[r]=__builtin_amdgcn_exp2f(P0[r]); }while(0)
  #define RESC() do{ if(resc){ asm volatile("s_waitcnt lgkmcnt(0)":::"memory"); \
      _Pragma("unroll") for(int d_=0;d_<2;++d_) _Pragma("unroll") for(int r=0;r<16;++r)o[d_][r]*=wsf[crow(r,hi)]; } }while(0)
  f32x16 pA0,pA1,pB0,pB1;
  int sl_prev=0,sl_cur=0,sl_next=SLOTB;
  #define ROT() do{sl_prev=sl_cur;sl_cur=sl_next;sl_next=(sl_next==(NSLOT-1)*SLOTB)?0:sl_next+SLOTB;}while(0)
  DMA_K(2,2*SLOTB);
  WAIT_BAR(3);
  qkt(pA0,pA1,Kbase,qr,negm,r32,hi);asm volatile("s_nop 15\n\ts_nop 7":"+v"(pA0),"+v"(pA1));CMASK(pA0,pA1,0);
  START(pA0,pA1);
  _Pragma("unroll") for(int r=0;r<16;++r)pA1[r]=__builtin_amdgcn_exp2f(pA1[r]);
  WAIT_BAR(0);
  DMA_K(3,0);DMA_V(1,SLOTB);
  ROT();
  kload8(kf,kp0+sl_cur);
  WAIT_BAR(2);
  s16x4 vlo[8],vhi[8]; u32x4 pw0,pw1,pw2,pw3;
  #define PKW(P,B) cvtpk_s(P[B],P[B+1])
  #define PAF(k) __builtin_bit_cast(bf16x8,pw##k)
  #define VFR(i) (bf16x8){vlo[i][0],vlo[i][1],vlo[i][2],vlo[i][3],vhi[i][0],vhi[i][1],vhi[i][2],vhi[i][3]}
  #define PIN(x) asm volatile("":"+v"(x))
  #define MX3(a,b,c) __builtin_fmaxf(__builtin_fmaxf((a),(b)),(c))
  #define GAPA(MF,A0,A1,A2,A3,W0,W1,PW) do{ MF; sacc+=A0; sacc+=A1; sacc+=A2; sacc+=A3; PIN(sacc); W0; W1; PIN(PW); SBAR(); }while(0)
  #define EX(v) __builtin_amdgcn_exp2f(v)
  #define GAPB(MF,X,B) do{ MF; X[B]=EX(X[B]); X[B+1]=EX(X[B+1]); X[B+2]=EX(X[B+2]); X[B+3]=EX(X[B+3]); PIN(X); SBAR(); }while(0)
  #define VRD(i) do{ vlo[i]=vtr(vp_+(((i)>>2)*4096+((i)&3)*1024)); vhi[i]=vtr(vp_+(((i)>>2)*4096+((i)&3)*1024+512)); }while(0)
  #define KRD(G,j) do{ if(G){ kload2(kf,kp0+sl_next,j); SBAR(); } }while(0)
  #define STEP(C0,C1,P0,P1,t,GK,GV,GL) do{ SBAR(); \
    const lds_cptr vp_=vp0+sl_prev; \
    VRD(0); SBAR(); float sacc=(P0[0]+P0[1]); \
    GAPA(C0=__builtin_amdgcn_mfma_f32_32x32x16_bf16(kf[0],qr[0],negm,0,0,0), P0[2],P0[3],P0[4],P0[5],     pw0[0]=PKW(P0,0), pw0[1]=PKW(P0,2), pw0); \
    VRD(4); SBAR(); GAPA(C1=__builtin_amdgcn_mfma_f32_32x32x16_bf16(kf[1],qr[0],negm,0,0,0), P0[6],P0[7],P0[8],P0[9],     pw0[2]=PKW(P0,4), pw0[3]=PKW(P0,6), pw0); \
    VRD(1); SBAR(); GAPA(C0=__builtin_amdgcn_mfma_f32_32x32x16_bf16(kf[2],qr[1],C0,0,0,0),   P0[10],P0[11],P0[12],P0[13], pw1[0]=PKW(P0,8), pw1[1]=PKW(P0,10), pw1); \
    VRD(5); SBAR(); GAPA(C1=__builtin_amdgcn_mfma_f32_32x32x16_bf16(kf[3],qr[1],C1,0,0,0),   P0[14],P0[15],P1[0],P1[1],   pw1[2]=PKW(P0,12),pw1[3]=PKW(P0,14), pw1); \
    VRD(2); SBAR(); GAPA(C0=__builtin_amdgcn_mfma_f32_32x32x16_bf16(kf[4],qr[2],C0,0,0,0),   P1[2],P1[3],P1[4],P1[5],     pw2[0]=PKW(P1,0), pw2[1]=PKW(P1,2), pw2); \
    VRD(6); SBAR(); GAPA(C1=__builtin_amdgcn_mfma_f32_32x32x16_bf16(kf[5],qr[2],C1,0,0,0),   P1[6],P1[7],P1[8],P1[9],     pw2[2]=PKW(P1,4), pw2[3]=PKW(P1,6), pw2); \
    VRD(3); SBAR(); GAPA(C0=__builtin_amdgcn_mfma_f32_32x32x16_bf16(kf[6],qr[3],C0,0,0,0),   P1[10],P1[11],P1[12],P1[13], pw3[0]=PKW(P1,8), pw3[1]=PKW(P1,10), pw3); \
    VRD(7); SBAR(); GAPA(C1=__builtin_amdgcn_mfma_f32_32x32x16_bf16(kf[7],qr[3],C1,0,0,0),   P1[14],P1[15],0.f,0.f,       pw3[2]=PKW(P1,12),pw3[3]=PKW(P1,14), pw3); \
    l_reg+=sacc; \
    if(GK){DMA_K((t)+3,sl_cur);} if(GV){DMA_V((t)+1,sl_next);} \
    CMASK(C0,C1,t); \
    { float a=MX3(C0[0],C0[1],C1[0]),b=MX3(C0[2],C0[3],C1[1]); a=MX3(a,C1[2],C1[3]); \
      _Pragma("unroll") for(int r=4;r<16;r+=4){a=MX3(a,C0[r],C0[r+1]);b=MX3(b,C0[r+2],C0[r+3]);a=MX3(a,C1[r],C1[r+1]);b=MX3(b,C1[r+2],C1[r+3]);} \
      float rm=__builtin_fmaxf(a,b); { auto rr=__builtin_amdgcn_permlane32_swap(__float_as_uint(rm),__float_as_uint(rm),false,false); rm=__builtin_fmaxf(__uint_as_float(rr[0]),__uint_as_float(rr[1])); } \
      resc=false; \
      if(__builtin_expect(__any(rm>(float)THRL),0)){ const float dl=__builtin_fmaxf(rm,0.f); mhat+=dl; \
        _Pragma("unroll") for(int r=0;r<16;++r){C0[r]-=dl;C1[r]-=dl;} \
        _Pragma("unroll") for(int r=0;r<16;++r)negm[r]=-mhat; asm volatile("":"+v"(negm)); \
        const float f=__builtin_amdgcn_exp2f(-dl); l_reg*=f; if(hi==0)wsf[r32]=f; resc=true; } } \
    SBAR(); \
    GAPB(o[0]=__builtin_amdgcn_mfma_f32_32x32x16_bf16(PAF(0),VFR(0),o[0],0,0,0), C0,0); \
    GAPB(o[1]=__builtin_amdgcn_mfma_f32_32x32x16_bf16(PAF(0),VFR(4),o[1],0,0,0), C0,4); \
    KRD(GL,0); GAPB(o[0]=__builtin_amdgcn_mfma_f32_32x32x16_bf16(PAF(1),VFR(1),o[0],0,0,0), C0,8); \
    KRD(GL,1); GAPB(o[1]=__builtin_amdgcn_mfma_f32_32x32x16_bf16(PAF(1),VFR(5),o[1],0,0,0), C0,12); \
    KRD(GL,2); GAPB(o[0]=__builtin_amdgcn_mfma_f32_32x32x16_bf16(PAF(2),VFR(2),o[0],0,0,0), C1,0); \
    KRD(GL,3); GAPB(o[1]=__builtin_amdgcn_mfma_f32_32x32x16_bf16(PAF(2),VFR(6),o[1],0,0,0), C1,4); \
    GAPB(o[0]=__builtin_amdgcn_mfma_f32_32x32x16_bf16(PAF(3),VFR(3),o[0],0,0,0), C1,8); \
    GAPB(o[1]=__builtin_amdgcn_mfma_f32_32x32x16_bf16(PAF(3),VFR(7),o[1],0,0,0), C1,12); \
    }while(0)
  int t=1;
  #undef CMASK
  #define CMASK(P0,P1,t) do{}while(0)
  for(;t+5<NT;t+=2){
    STEP(pB0,pB1,pA0,pA1,t,true,true,true);     WAIT_BAR(2); RESC(); ROT();
    STEP(pA0,pA1,pB0,pB1,t+1,true,true,true);   WAIT_BAR(2); RESC(); ROT();
  }
  #undef CMASK
  #define CMASK(P0,P1,t) do{}while(0)
  #define ENDW(tt) do{ if((tt)+3<NT){WAIT_BAR(2);} else if((tt)+2<NT){WAIT_BAR(1);} else {WAIT_BAR(0);} }while(0)
  for(;t+1<NT;t+=2){
    STEP(pB0,pB1,pA0,pA1,t,(t+3<NT),(t+1<NT),(t+1<NT));       ENDW(t);   RESC(); ROT();
    STEP(pA0,pA1,pB0,pB1,t+1,(t+4<NT),(t+2<NT),(t+2<NT));     ENDW(t+1); RESC(); ROT();
  }
  STEP(pB0,pB1,pA0,pA1,NT-1,false,false,false); RESC();
  { float sacc=pB0[0]+pB0[1]; _Pragma("unroll") for(int r=2;r<16;++r)sacc+=pB0[r]; _Pragma("unroll") for(int r=0;r<16;++r)sacc+=pB1[r]; l_reg+=sacc;
    pw0=(u32x4){PKW(pB0,0),PKW(pB0,2),PKW(pB0,4),PKW(pB0,6)};pw1=(u32x4){PKW(pB0,8),PKW(pB0,10),PKW(pB0,12),PKW(pB0,14)};pw2=(u32x4){PKW(pB1,0),PKW(pB1,2),PKW(pB1,4),PKW(pB1,6)};pw3=(u32x4){PKW(pB1,8),PKW(pB1,10),PKW(pB1,12),PKW(pB1,14)};
    SBAR(); pv(o,vb0+sl_cur,PAF(0),PAF(1),PAF(2),PAF(3)); }
  #undef PKW
  #undef PAF
  #undef VFR
  #undef PIN
  #undef MX3
  #undef GAPA
  #undef GAPB
  #undef EX
  #undef VRD
  #undef KRD
  #undef STEP
  #undef ENDW
  {auto rr=__builtin_amdgcn_permlane32_swap(__float_as_uint(l_reg),__float_as_uint(l_reg),false,false);l_reg=__uint_as_float(rr[0])+__uint_as_float(rr[1]);}
  if(hi==0)wsf[32+r32]=l_reg;asm volatile("s_waitcnt lgkmcnt(0)":::"memory");
  float rli[16];
  #pragma unroll
  for(int r=0;r<16;++r)rli[r]=__builtin_amdgcn_rcpf(wsf[32+crow(r,hi)]);
  bf16*Ow=O0+(long)(wid*QBLK)*OP;
  { bf16*stg=(bf16*)(shm+LDS_OST)+wid*2048;
    #pragma unroll
    for(int r=0;r<16;++r){const int orow=crow(r,hi);
      #pragma unroll
      for(int d0=0;d0<2;++d0)stg[orow*64+d0*32+r32]=__float2bfloat16(o[d0][r]*rli[r]);}
    asm volatile("s_waitcnt lgkmcnt(0)":::"memory");
    #pragma unroll
    for(int i=0;i<4;++i){const int row=i*8+(lane>>3),ch=lane&7; const u32x4 v=*(const u32x4*)(stg+row*64+ch*8); ATTN_STORE16(Ow+(long)row*OP+ch*8,v);} }
  asm volatile("s_waitcnt lgkmcnt(0)\n\ts_barrier":::"memory");
  #undef DMA_K
  #undef DMA_V
  #undef CMASK
  #undef START
  #undef RESC
  #undef ROT
}
constexpr int ATTN_LDS_BYTES=LDS_BYTES;
#undef SBAR
#undef WAIT_BAR
}

struct Params {
    const float* in[35];
    float* out;
    unsigned char* ws;
    int ph_lo, ph_hi;
};
enum { I_X = 0, I_C, I_CTX, I_CCTX, I_WMOD, I_BMOD, I_GMIX, I_GFFN, I_MIXWIN, I_MIXWOUT, I_QG, I_KG, I_LNG, I_WSP, I_BSP,
       I_S5WIN, I_ARE, I_AIM, I_LOGDT, I_BRE, I_BIM, I_CRE, I_CIM, I_S5D, I_WGLU, I_BGLU, I_S5WOUT,
       I_WGRP, I_BGRP, I_WRT, I_BRT, I_W1, I_W3, I_W2, I_FING };

struct Ctx {
    const Params* p;
    unsigned char* ws;
    LAS unsigned char* lds;
    int tid, lane, wave, gw, ngw;
};
__device__ __forceinline__ const float* xin_row(const Params& P, int r) { return r < TL ? P.in[I_X] + (size_t)r * D : P.in[I_CTX] + (size_t)(r - TL) * D; }
__device__ __forceinline__ int cond_of(int r) { return r < TL ? (r >> 11) : 16; }
__device__ __forceinline__ const float* mod_vec(const Ctx& C, int layer, int ci, int k) { return (const float*)(C.ws + WS_MOD) + ((size_t)(layer * 17 + ci) * 6 + k) * D; }

__device__ __forceinline__ void dsincos(double a, double& s, double& c) {
    const double TWO_PI_HI = 6.283185307179586, TWO_PI_LO = 2.4492935982947064e-16;
    const double k = rint(a * 0.15915494309189535);
    double r = fma(-k, TWO_PI_HI, a); r = fma(-k, TWO_PI_LO, r);
    const double r2 = r * r; double ct = 1.0, st = r, cs = 1.0, ss = r;
#pragma unroll 1
    for (int i = 1; i <= 15; ++i) { ct *= -r2 / (double)((2 * i - 1) * (2 * i)); cs += ct; st *= -r2 / (double)((2 * i) * (2 * i + 1)); ss += st; }
    s = ss; c = cs;
}

__device__ __forceinline__ void transpose_item(const float* src, int N, int k0, int n0, bf16* dst, int dpitch, LAS float* scr, int lane) {
#pragma unroll 8
    for (int i = 0; i < 32; ++i) { const int kk = 2 * i + (lane >> 5); scr[kk * 33 + (lane & 31)] = src[(size_t)(k0 + kk) * N + n0 + (lane & 31)]; }
    asm volatile("s_waitcnt lgkmcnt(0)" ::: "memory");
    const int c = lane & 7;
#pragma unroll
    for (int j = 0; j < 4; ++j) { const int n = (lane >> 3) + 8 * j; const LAS float* s = scr + (8 * c) * 33 + n;
        v4u o; o.x = pk2(s[0 * 33], s[1 * 33]); o.y = pk2(s[2 * 33], s[3 * 33]); o.z = pk2(s[4 * 33], s[5 * 33]); o.w = pk2(s[6 * 33], s[7 * 33]);
        *(v4u*)(dst + (size_t)n * dpitch + 8 * c) = o; }
    asm volatile("s_waitcnt lgkmcnt(0)" ::: "memory");
}
__device__ __forceinline__ void transpose_mat_item(const float* W, int K, int N, bf16* WT, int it, LAS float* scr, int lane) {
    const int nblk = N / 32, kb = it / nblk, nb = it % nblk;
    transpose_item(W, N, kb * 64, nb * 32, WT + (size_t)(nb * 32) * K + kb * 64, K, scr, lane);
}
constexpr int MOE_ITEMS = NEXP * 768;
__device__ __forceinline__ void moe_convert_item(const Ctx& C, int layer, int it, LAS float* scr) {
    const Params& P = *C.p;
    const int e = it / 768, r = it % 768, kind = r / 256, j = r % 256;
    if (kind < 2) {
        const float* src = (kind == 0 ? P.in[I_W1] : P.in[I_W3]) + ((size_t)layer * NEXP + e) * D * EH;
        const int kb = j / 16, nb = j % 16, k0 = kb * 64, n0 = nb * 32;
        const int drow = (n0 / 128) * 256 + (n0 % 128) + (kind == 1 ? 128 : 0);
        transpose_item(src, EH, k0, n0, (bf16*)(C.ws + WS_W13) + (size_t)e * 1024 * 1024 + (size_t)drow * 1024 + k0, 1024, scr, C.lane);
    } else {
        const float* src = P.in[I_W2] + ((size_t)layer * NEXP + e) * EH * D;
        const int kb = j / 32, nb = j % 32, k0 = kb * 64, n0 = nb * 32;
        transpose_item(src, D, k0, n0, (bf16*)(C.ws + WS_W2) + (size_t)e * 1024 * 512 + (size_t)n0 * 512 + k0, 512, scr, C.lane);
    }
}

__device__ __forceinline__ void phase_prologue(const Ctx& C) {
    const Params& P = *C.p;
    {
        LAS float* s = (LAS float*)C.lds;
        LAS float* red = (LAS float*)(C.lds + 17 * 1024 * 4);
        bool have_s = false;
        for (int u = blockIdx.x; u < 192; u += gridDim.x) {
            if (!have_s) {
                for (int i = C.tid; i < 17 * 1024; i += NTHR) { const int ci = i >> 10, k = i & 1023; const float v = ci < 16 ? P.in[I_C][ci * D + k] : P.in[I_CCTX][k]; s[i] = silu_(v); }
                have_s = true; __syncthreads();
            }
            const int layer = u / 96, jg = u % 96, kq = C.tid >> 6, jc = C.tid & 63;
            const float* w = P.in[I_WMOD] + (size_t)layer * D * 6144 + jg * 64 + jc;
            float acc[17];
#pragma unroll
            for (int i = 0; i < 17; ++i) acc[i] = 0.f;
            for (int k = kq * 128; k < kq * 128 + 128; ++k) { const float wv = w[(size_t)k * 6144];
#pragma unroll
                for (int i = 0; i < 17; ++i) acc[i] += s[i * 1024 + k] * wv; }
#pragma unroll
            for (int i = 0; i < 17; ++i) red[(kq * 17 + i) * 64 + jc] = acc[i];
            __syncthreads();
            for (int o = C.tid; o < 17 * 64; o += NTHR) { const int ci = o >> 6, c = o & 63; float v = 0.f;
#pragma unroll
                for (int q = 0; q < 8; ++q) v += red[(q * 17 + ci) * 64 + c];
                const int j = jg * 64 + c; v += P.in[I_BMOD][layer * 6144 + j];
                ((float*)(C.ws + WS_MOD))[((size_t)(layer * 17 + ci)) * 6144 + j] = v; }
            __syncthreads();
        }
        __syncthreads();
    }
    {
        const int gt = blockIdx.x * NTHR + C.tid, ngt = gridDim.x * NTHR;
        float2* rope = (float2*)(C.ws + WS_TAB + TAB_ROPE);
        for (int i = gt; i < 64 * 16; i += ngt) { const int pos = i >> 4, f = i & 15;
            const double th = exp(-(double)f * (9.210340371976184 / 16.0)); double s, c; dsincos((double)pos * th, s, c); rope[i] = make_float2((float)c, (float)s); }
        float2* lamb = (float2*)(C.ws + WS_TAB + TAB_LAMB); float2* bbar = (float2*)(C.ws + WS_TAB + TAB_BBAR);
        for (int i = gt; i < 2 * 32 * 64; i += ngt) {
            const int dg = i >> 6;
            const double are = P.in[I_ARE][i], aim = P.in[I_AIM][i], dt = exp((double)P.in[I_LOGDT][dg]);
            double s, c; dsincos(aim * dt, s, c); const double mag = exp(are * dt), lr = mag * c, li = mag * s;
            lamb[i] = make_float2((float)lr, (float)li);
            const double den = are * are + aim * aim, nr = lr - 1.0, ni = li;
            const double cr = (nr * are + ni * aim) / den, cim = (ni * are - nr * aim) / den;
            for (int p = 0; p < 16; ++p) { const double br = P.in[I_BRE][(size_t)i * 16 + p], bi = P.in[I_BIM][(size_t)i * 16 + p];
                bbar[(size_t)i * 16 + p] = make_float2((float)(cr * br - cim * bi), (float)(cr * bi + cim * br)); }
        }
    }
    {
        const int gt = blockIdx.x * NTHR + C.tid, ngt = gridDim.x * NTHR;
        bf16* wrt = (bf16*)(C.ws + WS_TAB + TAB_WR);
        for (int idx = gt; idx < 2 * 32 * 3 * 64; idx += ngt) {
            const int ln = idx & 63, jb = (idx >> 6) % 3, kk = (idx / 192) & 31, l = idx / (192 * 32);
            const int i = ln & 15, q = ln >> 4, grp = i >> 2, r = i & 3;
            float hi8[8], lo8[8];
#pragma unroll
            for (int e = 0; e < 8; ++e) { const int k = 32 * kk + 8 * q + e;
                const float w = jb < 2 ? P.in[I_WRT][((size_t)l * D + k) * 32 + grp * 8 + jb * 4 + r] : (r == 0 ? P.in[I_WGRP][((size_t)l * D + k) * 4 + grp] : 0.f);
                const float h = bf2f(f2bf(w)); hi8[e] = h; lo8[e] = w - h; }
            v4u oh, ol; oh.x = pk2(hi8[0], hi8[1]); oh.y = pk2(hi8[2], hi8[3]); oh.z = pk2(hi8[4], hi8[5]); oh.w = pk2(hi8[6], hi8[7]);
            ol.x = pk2(lo8[0], lo8[1]); ol.y = pk2(lo8[2], lo8[3]); ol.z = pk2(lo8[4], lo8[5]); ol.w = pk2(lo8[6], lo8[7]);
            const size_t base = ((((size_t)l * 32 + kk) * 3 + jb) * 2) * 64 + ln;
            *(v4u*)(wrt + base * 8) = oh; *(v4u*)(wrt + (base + 64) * 8) = ol;
        }
    }
    {
        LAS float* scr = (LAS float*)(C.lds + C.wave * 16384);
        constexpr int I0 = 16 * 56, I1 = 16 * 32, I2 = 16 * 16, I3 = 8 * 16, I4 = 8 * 32;
        constexpr int NSMALL = I0 + I1 + I2 + I3 + I4;
        for (int it = C.gw; it < NSMALL + MOE_ITEMS; it += C.ngw) {
            int r = it;
            if (r < I0) { transpose_mat_item(P.in[I_MIXWIN], D, MIXW, (bf16*)(C.ws + WS_WIN0), r, scr, C.lane); continue; } r -= I0;
            if (r < I1) { transpose_mat_item(P.in[I_MIXWOUT], D, D, (bf16*)(C.ws + WS_WOUT0), r, scr, C.lane); continue; } r -= I1;
            if (r < I2) { transpose_mat_item(P.in[I_S5WIN], D, 512, (bf16*)(C.ws + WS_WS5IN), r, scr, C.lane); continue; } r -= I2;
            if (r < I3) { transpose_mat_item(P.in[I_WGLU], 512, 512, (bf16*)(C.ws + WS_WGLU), r, scr, C.lane); continue; } r -= I3;
            if (r < I4) { transpose_mat_item(P.in[I_S5WOUT], 512, D, (bf16*)(C.ws + WS_WS5OUT), r, scr, C.lane); continue; } r -= I4;
            moe_convert_item(C, 0, r, scr);
        }
    }
}

__device__ __forceinline__ void load_row16(const float* row, int lane, f32x4 (&v)[4]) {
#pragma unroll
    for (int j = 0; j < 4; ++j) v[j] = *(const f32x4*)(row + 4 * lane + 256 * j);
}
__device__ __forceinline__ float row_rstd(const f32x4 (&v)[4]) {
    float s = 0.f;
#pragma unroll
    for (int j = 0; j < 4; ++j) s += (v[j].x * v[j].x + v[j].y * v[j].y) + (v[j].z * v[j].z + v[j].w * v[j].w);
    return rsqrtf(wave_sum(s) * (1.f / D) + EPS);
}
__device__ __forceinline__ void modulate16(f32x4 (&v)[4], float rstd, const float* g, const float* scale, const float* shift, int lane) {
#pragma unroll
    for (int j = 0; j < 4; ++j) { const int c = 4 * lane + 256 * j; const f32x4 gg = *(const f32x4*)(g + c), sc = *(const f32x4*)(scale + c), sh = *(const f32x4*)(shift + c);
        v[j] = v[j] * rstd * gg * (sc + 1.f) + sh; }
}
__device__ __forceinline__ void store_row16_bf16(bf16* row, int lane, const f32x4 (&v)[4]) {
#pragma unroll
    for (int j = 0; j < 4; ++j) { v2u o; o.x = pk2(v[j].x, v[j].y); o.y = pk2(v[j].z, v[j].w); *(v2u*)(row + 4 * lane + 256 * j) = o; }
}

__device__ __forceinline__ void phase_norm_mix0(const Ctx& C) {
    const Params& P = *C.p; bf16* H = (bf16*)(C.ws + WS_H);
    for (int r = C.gw; r < TT; r += C.ngw) {
        f32x4 v[4]; load_row16(xin_row(P, r), C.lane, v);
        const float rstd = row_rstd(v); const int ci = cond_of(r);
        modulate16(v, rstd, P.in[I_GMIX], mod_vec(C, 0, ci, 1), mod_vec(C, 0, ci, 0), C.lane);
        store_row16_bf16(H + (size_t)r * D, C.lane, v);
    }
}

template <class Epi>
__device__ __forceinline__ void ngemm_unit(const Ctx& C, const bf16* A0, const bf16* B0, int K, int row0, int pn, const Epi& epi) {
    LAS float* As = (LAS float*)C.lds;
    LAS float* Bs = (LAS float*)(C.lds + 32 * 68 * 4);
    const int tid = C.tid, ty = tid >> 4, tx = tid & 15;
    float acc[2][16];
#pragma unroll
    for (int i = 0; i < 2; ++i)
#pragma unroll
        for (int j = 0; j < 16; ++j) acc[i][j] = 0.f;
    const int ar = tid >> 3, ak = (tid & 7) * 4, bn = tid >> 1, bk = (tid & 1) * 16;
    for (int k0 = 0; k0 < K; k0 += 32) {
        const v2u av = *(const v2u*)(A0 + (size_t)ar * K + k0 + ak);
        const v4u b0 = *(const v4u*)(B0 + (size_t)bn * K + k0 + bk), b1 = *(const v4u*)(B0 + (size_t)bn * K + k0 + bk + 8);
        __syncthreads();
        As[(ak + 0) * 68 + ar] = bf2f(av.x & 0xffffu); As[(ak + 1) * 68 + ar] = bf2f(av.x >> 16); As[(ak + 2) * 68 + ar] = bf2f(av.y & 0xffffu); As[(ak + 3) * 68 + ar] = bf2f(av.y >> 16);
        float bf[16]; unpack8(b0, bf); unpack8(b1, bf + 8);
#pragma unroll
        for (int i = 0; i < 16; ++i) Bs[(bk + i) * 260 + bn] = bf[i];
        __syncthreads();
#pragma unroll 4
        for (int k = 0; k < 32; ++k) {
            const float a0 = As[k * 68 + ty * 2], a1 = As[k * 68 + ty * 2 + 1];
            const f32x4 x0 = *(const LAS f32x4*)(Bs + k * 260 + tx * 8), x1 = *(const LAS f32x4*)(Bs + k * 260 + tx * 8 + 4);
            const f32x4 y0 = *(const LAS f32x4*)(Bs + k * 260 + 128 + tx * 8), y1 = *(const LAS f32x4*)(Bs + k * 260 + 128 + tx * 8 + 4);
            const float bb[16] = {x0.x, x0.y, x0.z, x0.w, x1.x, x1.y, x1.z, x1.w, y0.x, y0.y, y0.z, y0.w, y1.x, y1.y, y1.z, y1.w};
#pragma unroll
            for (int j = 0; j < 16; ++j) { acc[0][j] += a0 * bb[j]; acc[1][j] += a1 * bb[j]; }
        }
    }
#pragma unroll
    for (int i = 0; i < 2; ++i)
#pragma unroll
        for (int j = 0; j < 8; ++j) epi(row0 + ty * 2 + i, pn, tx * 8 + j, acc[i][j], acc[i][8 + j]);
    __syncthreads();
}
template <class Epi>
__device__ __forceinline__ void ngemm_dense(const Ctx& C, const bf16* A, const bf16* Bt, int M, int N, int K, const Epi& epi) {
    const int nN = N / 256, nU = (M / 64) * nN;
    for (int u = blockIdx.x; u < nU; u += gridDim.x) { const int tm = u / nN, pn = u % nN;
        ngemm_unit(C, A + (size_t)tm * 64 * K, Bt + (size_t)pn * 256 * K, K, tm * 64, pn, epi); }
}
template <class Epi>
__device__ __forceinline__ void ngemm_grouped(const Ctx& C, const bf16* A, const bf16* Bt, size_t estride, int N, int K, const Epi& epi) {
    const int* tile_e = (const int*)(C.ws + WS_ROUTE + RT_TILE); const int ntiles = *(const int*)(C.ws + WS_ROUTE + RT_NT);
    const int nN = N / 256, nU = ntiles * 4 * nN;
    for (int u = blockIdx.x; u < nU; u += gridDim.x) { const int pn = u % nN, tm = u / nN, e = tile_e[tm >> 2];
        ngemm_unit(C, A + (size_t)tm * 64 * K, Bt + (size_t)e * estride + (size_t)pn * 256 * K, K, tm * 64, pn, epi); }
}

struct EpiStoreBf16 { bf16* O; int ldc;
    __device__ __forceinline__ void operator()(int r, int pn, int c, float v0, float v1) const { bf16* o = O + (size_t)r * ldc + pn * 256 + c; o[0] = (bf16)f2bf(v0); o[128] = (bf16)f2bf(v1); } };
struct EpiResid0 { const Params* P; const float* mod; float* XC;
    __device__ __forceinline__ void operator()(int r, int pn, int c, float v0, float v1) const { const int n = pn * 256 + c; const float* xi = xin_row(*P, r); const float* g = mod + ((size_t)cond_of(r) * 6 + 2) * D;
        float* o = XC + (size_t)r * D; o[n] = xi[n] + g[n] * v0; o[n + 128] = xi[n + 128] + g[n + 128] * v1; } };
struct EpiResidAcc { const float* mod; float* XC;
    __device__ __forceinline__ void operator()(int r, int pn, int c, float v0, float v1) const { const int n = pn * 256 + c; const float* g = mod + ((size_t)cond_of(r) * 6 + 2) * D;
        float* o = XC + (size_t)r * D; o[n] += g[n] * v0; o[n + 128] += g[n + 128] * v1; } };
struct EpiSwiglu { bf16* G;
    __device__ __forceinline__ void operator()(int r, int pn, int c, float v0, float v1) const { G[(size_t)r * EH + pn * 128 + c] = (bf16)f2bf(silu_(v0) * v1); } };
struct EpiGlu { const bf16* GS; const float* b; bf16* GG;
    __device__ __forceinline__ void operator()(int r, int pn, int c, float v0, float v1) const { const int n = pn * 256 + c; const size_t o = (size_t)r * 512 + n;
        GG[o] = (bf16)f2bf(bf2f(GS[o]) * sigmoidf_(v0 + b[n])); GG[o + 128] = (bf16)f2bf(bf2f(GS[o + 128]) * sigmoidf_(v1 + b[n + 128])); } };

__device__ __forceinline__ void qk_norm_rope(float (&v)[8], const float* gain, bool lat, int t, int lane, const float2* rope) {
    float ss = 0.f;
#pragma unroll
    for (int j = 0; j < 8; ++j) ss += v[j] * v[j];
    ss += __shfl_xor(ss, 1); ss += __shfl_xor(ss, 2); ss += __shfl_xor(ss, 4);
    const float rstd = rsqrtf(ss * (1.f / 64.f) + EPS);
    const int l8 = lane & 7;
#pragma unroll
    for (int j = 0; j < 8; ++j) v[j] = v[j] * rstd * gain[l8 * 8 + j];
    const int quarter = l8 >> 1, pos = (quarter < 2) ? (t >> 6) : (t & 63);
#pragma unroll
    for (int j = 0; j < 8; ++j) {
        const float pv = __shfl_xor(v[j], 2);
        if (lat) { const float2 cs = rope[pos * 16 + (lane & 1) * 8 + j];
            v[j] = (quarter & 1) ? (v[j] * cs.x + pv * cs.y) : (v[j] * cs.x - pv * cs.y); }
    }
}
__device__ __forceinline__ void phase_qkprep(const Ctx& C) {
    const Params& P = *C.p; const bf16* Pb = (const bf16*)(C.ws + WS_P); bf16* Q = (bf16*)(C.ws + WS_Q); bf16* Kb = (bf16*)(C.ws + WS_K); bf16* Vb = (bf16*)(C.ws + WS_V);
    const float2* rope = (const float2*)(C.ws + WS_TAB + TAB_ROPE);
    for (int r = C.gw; r < TT; r += C.ngw) {
        const bool lat = r < TL; const int t = lat ? (r & 2047) : 0;
        const size_t kvrow = lat ? (size_t)(r >> 11) * KVL + CTXL + (r & 2047) : (size_t)((r - TL) >> 8) * KVL + ((r - TL) & 255);
        const bf16* pr = Pb + (size_t)r * MIXW;
        { float v[8]; unpack8(*(const v4u*)(pr + 8 * C.lane), v); qk_norm_rope(v, P.in[I_QG], lat, t, C.lane, rope);
          v4u o; o.x = pk2(v[0] * QSCALE, v[1] * QSCALE); o.y = pk2(v[2] * QSCALE, v[3] * QSCALE); o.z = pk2(v[4] * QSCALE, v[5] * QSCALE); o.w = pk2(v[6] * QSCALE, v[7] * QSCALE);
          *(v4u*)(Q + (size_t)r * 512 + 8 * C.lane) = o; }
        { const int l = C.lane & 15; float v[8]; unpack8(*(const v4u*)(pr + 512 + 8 * l), v); qk_norm_rope(v, P.in[I_KG], lat, t, C.lane, rope);
          if (C.lane < 16) { v4u o; o.x = pk2(v[0], v[1]); o.y = pk2(v[2], v[3]); o.z = pk2(v[4], v[5]); o.w = pk2(v[6], v[7]); *(v4u*)(Kb + kvrow * 128 + 8 * l) = o;
              *(v4u*)(Vb + kvrow * 128 + 8 * l) = *(const v4u*)(pr + 640 + 8 * l); } }
    }
}

__device__ __forceinline__ void phase_gmlp(const Ctx& C) {
    const Params& P = *C.p; const bf16* Pb = (const bf16*)(C.ws + WS_P); bf16* OG = (bf16*)(C.ws + WS_H);
    LAS bf16* VN = (LAS bf16*)C.lds; constexpr int VP = 520;
    const int g = __builtin_amdgcn_readfirstlane(C.tid >> 6);
    for (int ch = blockIdx.x; ch < TT / 128; ch += gridDim.x) {
        for (int i = 0; i < 16; ++i) { const int rl = C.wave * 16 + i; const bf16* pr = Pb + (size_t)(ch * 128 + rl) * MIXW + 1280 + 8 * C.lane;
            float v[8]; unpack8(*(const v4u*)pr, v); float s = 0.f;
#pragma unroll
            for (int j = 0; j < 8; ++j) { v[j] = gelu_tanh(v[j]); s += v[j]; }
            const float mean = wave_sum(s) * (1.f / 512.f); float q = 0.f;
#pragma unroll
            for (int j = 0; j < 8; ++j) { v[j] -= mean; q += v[j] * v[j]; }
            const float rstd = rsqrtf(wave_sum(q) * (1.f / 512.f) + EPS);
#pragma unroll
            for (int j = 0; j < 8; ++j) v[j] = v[j] * rstd * P.in[I_LNG][8 * C.lane + j];
            v4u o; o.x = pk2(v[0], v[1]); o.y = pk2(v[2], v[3]); o.z = pk2(v[4], v[5]); o.w = pk2(v[6], v[7]);
            *(LAS v4u*)(VN + rl * VP + 8 * C.lane) = o; }
        __syncthreads();
        const float* wsp = P.in[I_WSP] + (size_t)g * 128 * 128; const float* bsp = P.in[I_BSP] + g * 128;
        for (int pb = 0; pb < 16; ++pb) {
            float acc[8];
#pragma unroll
            for (int i = 0; i < 8; ++i) acc[i] = 0.f;
            for (int q = 0; q < 128; ++q) { const float v = bf2f(VN[q * VP + C.tid]);
#pragma unroll
                for (int i = 0; i < 8; ++i) acc[i] += wsp[(pb * 8 + i) * 128 + q] * v; }
#pragma unroll
            for (int i = 0; i < 8; ++i) { const int p = pb * 8 + i; const size_t row = (size_t)ch * 128 + p;
                const float u = gelu_tanh(bf2f(Pb[row * MIXW + 768 + C.tid]));
                OG[row * D + 512 + C.tid] = (bf16)f2bf(u * (acc[i] + bsp[p])); }
        }
        __syncthreads();
    }
}

__device__ __forceinline__ void attn_item(const Ctx& C, int b, int h, int qrow_g, int nk) {
    const bf16* Q = (const bf16*)(C.ws + WS_Q); const bf16* Kb = (const bf16*)(C.ws + WS_K) + (size_t)b * KVL * 128 + (h >> 2) * 64; const bf16* Vb = (const bf16*)(C.ws + WS_V) + (size_t)b * KVL * 128 + (h >> 2) * 64;
    bf16* OG = (bf16*)(C.ws + WS_H);
    float q[64];
#pragma unroll
    for (int i = 0; i < 8; ++i) unpack8(*(const v4u*)(Q + (size_t)qrow_g * 512 + h * 64 + 8 * i), q + 8 * i);
    float m = -INFINITY, l = 0.f, o = 0.f;
    for (int kt = 0; kt < nk; kt += 64) {
        const bf16* kr = Kb + (size_t)(kt + C.lane) * 128; float s = 0.f;
#pragma unroll
        for (int i = 0; i < 8; ++i) { float kf[8]; unpack8(*(const v4u*)(kr + 8 * i), kf);
#pragma unroll
            for (int j = 0; j < 8; ++j) s += q[8 * i + j] * kf[j]; }
        const float mn = fmaxf(m, wave_max(s)); const float p = exp2f(s - mn), corr = exp2f(m - mn);
        l = l * corr + wave_sum(p); o *= corr; m = mn;
#pragma unroll 8
        for (int jj = 0; jj < 64; ++jj) { const float pj = __shfl(p, jj); o += pj * bf2f(Vb[(size_t)(kt + jj) * 128 + C.lane]); }
    }
    OG[(size_t)qrow_g * D + h * 64 + C.lane] = (bf16)f2bf(o / l);
}
__device__ __forceinline__ void phase_attn(const Ctx& C) {
    for (int it = C.gw; it < NB * 8 * SEQ; it += C.ngw) { const int bh = it >> 11, t = it & 2047, b = bh >> 3, h = bh & 7; attn_item(C, b, h, b * SEQ + t, KVL); }
    for (int it = C.gw; it < NB * 8 * CTXL; it += C.ngw) { const int bh = it >> 8, t = it & 255, b = bh >> 3, h = bh & 7; attn_item(C, b, h, TL + b * CTXL + t, CTXL); }
}


__device__ __forceinline__ void phase_attn_fast(const Ctx& C, char* lds_generic) {
    typedef attn_body::bf16 abf;
    const abf* Q = (const abf*)(C.ws + WS_Q); const abf* Kb = (const abf*)(C.ws + WS_K); const abf* Vb = (const abf*)(C.ws + WS_V); abf* OG = (abf*)(C.ws + WS_H);
    const int G = gridDim.x, bx = blockIdx.x; const int vcu = (G % 8 == 0) ? (bx % 8) * (G / 8) + bx / 8 : bx;
    const int per = (1024 + G - 1) / G, perc = (128 + G - 1) / G;
    for (int i = 0; i < per + perc; ++i) {
        int b, h, nt; size_t qrow;
        if (i < per) { const int u = vcu * per + i; if (u >= 1024) continue; const int qb = u & 7, hg = (u >> 3) & 3, bk = u >> 5; b = bk >> 1; h = (bk & 1) * 4 + hg; qrow = (size_t)b * SEQ + qb * 256; nt = KVL / 64; }
        else { const int u = vcu + (i - per) * G; if (u >= 128) continue; b = u >> 3; h = u & 7; qrow = (size_t)TL + (size_t)b * CTXL; nt = CTXL / 64; }
        const size_t kvo = (size_t)b * KVL * 128 + (h >> 2) * 64;
        attn_body::attn_unit<8>(Q + qrow * 512 + h * 64, Kb + kvo, Vb + kvo, OG + qrow * 1024 + h * 64, nt, lds_generic);
    }
}

__device__ __forceinline__ void phase_norm_ffn_router(const Ctx& C, int layer, int nrows) {
    const Params& P = *C.p; const float* XC = (const float*)(C.ws + WS_XC); bf16* F = (bf16*)(C.ws + WS_H);
    int* asg_e = (int*)(C.ws + WS_ROUTE + RT_E); int* asg_p = (int*)(C.ws + WS_ROUTE + RT_P); float* asg_w = (float*)(C.ws + WS_ROUTE + RT_W);
    unsigned* cnt = (unsigned*)(C.ws + WS_CTL) + CW_CNT + 64 * layer;
    const float* wg = P.in[I_WGRP] + (size_t)layer * D * 4; const float* wr = P.in[I_WRT] + (size_t)layer * D * 32;
    for (int r = C.gw; r < nrows; r += C.ngw) {
        f32x4 v[4]; load_row16(XC + (size_t)r * D, C.lane, v);
        const float rstd = row_rstd(v); const int ci = cond_of(r);
        modulate16(v, rstd, P.in[I_GFFN] + layer * D, mod_vec(C, layer, ci, 4), mod_vec(C, layer, ci, 3), C.lane);
        store_row16_bf16(F + (size_t)r * D, C.lane, v);
        float lg[4] = {0.f, 0.f, 0.f, 0.f}; float le[32];
#pragma unroll
        for (int i = 0; i < 32; ++i) le[i] = 0.f;
#pragma unroll
        for (int j = 0; j < 4; ++j)
#pragma unroll
            for (int i = 0; i < 4; ++i) { const int c = 4 * C.lane + 256 * j + i; const float f = v[j][i];
                const f32x4 g4 = *(const f32x4*)(wg + (size_t)c * 4); lg[0] += f * g4.x; lg[1] += f * g4.y; lg[2] += f * g4.z; lg[3] += f * g4.w;
#pragma unroll
                for (int e4 = 0; e4 < 8; ++e4) { const f32x4 w4 = *(const f32x4*)(wr + (size_t)c * 32 + e4 * 4); le[e4 * 4] += f * w4.x; le[e4 * 4 + 1] += f * w4.y; le[e4 * 4 + 2] += f * w4.z; le[e4 * 4 + 3] += f * w4.w; } }
#pragma unroll
        for (int i = 0; i < 4; ++i) lg[i] = wave_sum(lg[i]) + P.in[I_BGRP][layer * 4 + i];
#pragma unroll
        for (int i = 0; i < 32; ++i) le[i] = wave_sum(le[i]) + P.in[I_BRT][layer * 32 + i];
        int gi = 0; float gm = lg[0];
#pragma unroll
        for (int i = 1; i < 4; ++i) if (lg[i] > gm) { gm = lg[i]; gi = i; }
        float den = 0.f;
#pragma unroll
        for (int i = 0; i < 4; ++i) den += __expf(lg[i] - gm);
        const float gw_ = 1.f / den;
        float sel[8];
#pragma unroll
        for (int i = 0; i < 8; ++i) sel[i] = gi == 0 ? le[i] : gi == 1 ? le[8 + i] : gi == 2 ? le[16 + i] : le[24 + i];
        int i0 = 0; float v0 = sel[0];
#pragma unroll
        for (int i = 1; i < 8; ++i) if (sel[i] > v0) { v0 = sel[i]; i0 = i; }
        int i1 = -1; float v1 = -INFINITY;
#pragma unroll
        for (int i = 0; i < 8; ++i) if (i != i0 && sel[i] > v1) { v1 = sel[i]; i1 = i; }
        const float e1 = __expf(v1 - v0), w0 = gw_ / (1.f + e1), w1 = gw_ * e1 / (1.f + e1);
        if (C.lane == 0) {
            const int ea = gi * 8 + i0, eb = gi * 8 + i1;
            const unsigned pa = __hip_atomic_fetch_add(cnt + ea, 1u, __ATOMIC_RELAXED, __HIP_MEMORY_SCOPE_AGENT);
            const unsigned pb = __hip_atomic_fetch_add(cnt + eb, 1u, __ATOMIC_RELAXED, __HIP_MEMORY_SCOPE_AGENT);
            asg_e[2 * r] = ea; asg_e[2 * r + 1] = eb; asg_p[2 * r] = (int)pa; asg_p[2 * r + 1] = (int)pb; asg_w[2 * r] = w0; asg_w[2 * r + 1] = w1;
        }
    }
}

__device__ __forceinline__ void phase_router_fast(const Ctx& C, int layer, int nrows) {
    typedef short bf16x8 __attribute__((ext_vector_type(8)));
    const Params& P = *C.p; const float* XC = (const float*)(C.ws + WS_XC); bf16* F = (bf16*)(C.ws + WS_H);
    int* asg_e = (int*)(C.ws + WS_ROUTE + RT_E); int* asg_p = (int*)(C.ws + WS_ROUTE + RT_P); float* asg_w = (float*)(C.ws + WS_ROUTE + RT_W); int* list = (int*)(C.ws + WS_LIST);
    unsigned* cnt = (unsigned*)(C.ws + WS_CTL) + CW_CNT + 64 * layer;
    const bf16x8* WR = (const bf16x8*)(C.ws + WS_TAB + TAB_WR) + (size_t)layer * (32 * 3 * 2 * 64) + C.lane;
    const int l15 = C.lane & 15, q4 = C.lane >> 4;
    const float* gg = P.in[I_GFFN] + layer * D + 8 * q4;
    for (int it = C.gw; it < nrows / 16; it += C.ngw) {
        const int row = it * 16 + l15, ci = cond_of(it * 16);
        const float* xr = XC + (size_t)row * D + 8 * q4; const float* sc = mod_vec(C, layer, ci, 4) + 8 * q4; const float* sh = mod_vec(C, layer, ci, 3) + 8 * q4;
        float ss = 0.f;
#pragma unroll 8
        for (int kk = 0; kk < 32; ++kk) { const f32x4 a = *(const f32x4*)(xr + 32 * kk), b = *(const f32x4*)(xr + 32 * kk + 4); ss += (a.x * a.x + a.y * a.y) + (a.z * a.z + a.w * a.w) + (b.x * b.x + b.y * b.y) + (b.z * b.z + b.w * b.w); }
        ss += __shfl_xor(ss, 16); ss += __shfl_xor(ss, 32);
        const float rstd = rsqrtf(ss * (1.f / D) + EPS);
        f32x4 acc[3]; acc[0] = (f32x4){0.f, 0.f, 0.f, 0.f}; acc[1] = acc[0]; acc[2] = acc[0];
        bf16* frow = F + (size_t)row * D + 8 * q4;
#pragma unroll 2
        for (int kk = 0; kk < 32; ++kk) {
            const int c = 32 * kk;
            f32x4 f0 = *(const f32x4*)(xr + c) * rstd * *(const f32x4*)(gg + c) * (*(const f32x4*)(sc + c) + 1.f) + *(const f32x4*)(sh + c);
            f32x4 f1 = *(const f32x4*)(xr + c + 4) * rstd * *(const f32x4*)(gg + c + 4) * (*(const f32x4*)(sc + c + 4) + 1.f) + *(const f32x4*)(sh + c + 4);
            const pg8::u32x4 fh = pg8::pack8(f0, f1); *(pg8::u32x4*)(frow + c) = fh;
            pg8::f32x4 r0, r1; pg8::unpack8f(fh, r0, r1);
            const pg8::u32x4 fl = pg8::pack8(f0 - r0, f1 - r1);
            const bf16x8 ah = __builtin_bit_cast(bf16x8, fh), al = __builtin_bit_cast(bf16x8, fl);
#pragma unroll
            for (int jb = 0; jb < 3; ++jb) { const bf16x8 wh = WR[((kk * 3 + jb) * 2) * 64], wl = WR[((kk * 3 + jb) * 2 + 1) * 64];
                acc[jb] = __builtin_amdgcn_mfma_f32_16x16x32_bf16(wh, ah, acc[jb], 0, 0, 0);
                acc[jb] = __builtin_amdgcn_mfma_f32_16x16x32_bf16(wh, al, acc[jb], 0, 0, 0);
                acc[jb] = __builtin_amdgcn_mfma_f32_16x16x32_bf16(wl, ah, acc[jb], 0, 0, 0); }
        }
        const float* brt = P.in[I_BRT] + layer * 32 + q4 * 8;
        float e[8];
#pragma unroll
        for (int r = 0; r < 4; ++r) { e[r] = acc[0][r] + brt[r]; e[4 + r] = acc[1][r] + brt[4 + r]; }
        const float gl = acc[2][0] + P.in[I_BGRP][layer * 4 + q4];
        float gm = gl; int gi = q4;
#pragma unroll
        for (int st = 16; st <= 32; st <<= 1) { const float og = __shfl_xor(gm, st); const int oi = __shfl_xor(gi, st); if (og > gm || (og == gm && oi < gi)) { gm = og; gi = oi; } }
        float den = __expf(gl - gm); den += __shfl_xor(den, 16); den += __shfl_xor(den, 32);
        if (q4 == gi) {
            const float gw_ = 1.f / den;
            int i0 = 0; float v0 = e[0];
#pragma unroll
            for (int i = 1; i < 8; ++i) if (e[i] > v0) { v0 = e[i]; i0 = i; }
            int i1 = -1; float v1 = -INFINITY;
#pragma unroll
            for (int i = 0; i < 8; ++i) if (i != i0 && e[i] > v1) { v1 = e[i]; i1 = i; }
            const float e1 = __expf(v1 - v0), w0 = gw_ / (1.f + e1), w1 = gw_ * e1 / (1.f + e1);
            const int ea = gi * 8 + i0, eb = gi * 8 + i1;
            const unsigned pa = __hip_atomic_fetch_add(cnt + ea, 1u, __ATOMIC_RELAXED, __HIP_MEMORY_SCOPE_AGENT);
            const unsigned pb = __hip_atomic_fetch_add(cnt + eb, 1u, __ATOMIC_RELAXED, __HIP_MEMORY_SCOPE_AGENT);
            asg_e[2 * row] = ea; asg_e[2 * row + 1] = eb; asg_p[2 * row] = (int)pa; asg_p[2 * row + 1] = (int)pb; asg_w[2 * row] = w0; asg_w[2 * row + 1] = w1;
            list[(size_t)ea * LCAP + pa] = row; list[(size_t)eb * LCAP + pb] = row;
        }
    }
}

__device__ __forceinline__ void phase_gather(const Ctx& C, int layer, int nrows) {
    const bf16* F = (const bf16*)(C.ws + WS_H); bf16* XS = (bf16*)(C.ws + WS_XS);
    const int* asg_e = (const int*)(C.ws + WS_ROUTE + RT_E); const int* asg_p = (const int*)(C.ws + WS_ROUTE + RT_P); int* asg_s = (int*)(C.ws + WS_ROUTE + RT_S);
    int* tile_e = (int*)(C.ws + WS_ROUTE + RT_TILE); int* ntl = (int*)(C.ws + WS_ROUTE + RT_NT);
    unsigned* cnt = (unsigned*)(C.ws + WS_CTL) + CW_CNT + 64 * layer;
    const int mycnt = (C.lane < 32) ? (int)__hip_atomic_load(cnt + C.lane, __ATOMIC_RELAXED, __HIP_MEMORY_SCOPE_AGENT) : 0;
    const int mypad = (mycnt + 255) & ~255;
    int incl = mypad;
#pragma unroll
    for (int o = 1; o < 32; o <<= 1) { const int t = __shfl_up(incl, o); if ((C.lane & 31) >= o) incl += t; }
    const int ps = incl - mypad;
    for (int it = C.gw; it < nrows * 2; it += C.ngw) {
        const int e = asg_e[it], p = asg_p[it]; const int slot = __shfl(ps, e) + p;
        if (C.lane == 0) asg_s[it] = slot;
        const v4u* src = (const v4u*)(F + (size_t)(it >> 1) * D); v4u* dst = (v4u*)(XS + (size_t)slot * D);
        dst[C.lane] = src[C.lane]; dst[64 + C.lane] = src[64 + C.lane];
    }
    for (int e = C.gw; e < 33; e += C.ngw) {
        if (e < 32) { const int c0 = __shfl(mycnt, e), c1 = __shfl(mypad, e), base = __shfl(ps, e);
            for (int rr = c0; rr < c1; ++rr) { v4u* dst = (v4u*)(XS + (size_t)(base + rr) * D); const v4u z = {0u, 0u, 0u, 0u}; dst[C.lane] = z; dst[64 + C.lane] = z; } }
        else { if (C.lane < 32) { for (int t = ps / 256; t < (ps + mypad) / 256; ++t) tile_e[t] = C.lane; if (C.lane == 31) *ntl = (ps + mypad) / 256; } }
    }
}
__device__ __forceinline__ int wave_pstart(const Ctx& C, int layer) {
    const unsigned* cnt = (const unsigned*)(C.ws + WS_CTL) + CW_CNT + 64 * layer;
    const int mc = C.lane < 32 ? (int)__hip_atomic_load(cnt + (C.lane & 31), __ATOMIC_RELAXED, __HIP_MEMORY_SCOPE_AGENT) : 0; const int mp = (mc + 255) & ~255; int in = mp;
#pragma unroll
    for (int o = 1; o < 32; o <<= 1) { const int t = __shfl_up(in, o); if ((C.lane & 31) >= o) in += t; }
    return in - mp;
}
__device__ __forceinline__ void moe_combine(const Ctx& C, int layer, int r, int ps, f32x4 (&v)[4]) {
    const bf16* Y2 = (const bf16*)(C.ws + WS_XS); const int* asg_s = (const int*)(C.ws + WS_ROUTE + RT_S); const float* asg_w = (const float*)(C.ws + WS_ROUTE + RT_W);
    const float* XC = (const float*)(C.ws + WS_XC);
    load_row16(XC + (size_t)r * D, C.lane, v);
    const int* asg_e = (const int*)(C.ws + WS_ROUTE + RT_E); const int* asg_p = (const int*)(C.ws + WS_ROUTE + RT_P); (void)asg_s;
    const int s0 = __shfl(ps, asg_e[2 * r]) + asg_p[2 * r], s1 = __shfl(ps, asg_e[2 * r + 1]) + asg_p[2 * r + 1]; const float w0 = asg_w[2 * r], w1 = asg_w[2 * r + 1];
    const float* gate = mod_vec(C, layer, cond_of(r), 5);
#pragma unroll
    for (int j = 0; j < 4; ++j) { const int c = 4 * C.lane + 256 * j; const v2u a = *(const v2u*)(Y2 + (size_t)s0 * D + c), b = *(const v2u*)(Y2 + (size_t)s1 * D + c); const f32x4 g = *(const f32x4*)(gate + c);
        v[j].x += g.x * (w0 * bf2f(a.x & 0xffffu) + w1 * bf2f(b.x & 0xffffu)); v[j].y += g.y * (w0 * bf2f(a.x >> 16) + w1 * bf2f(b.x >> 16));
        v[j].z += g.z * (w0 * bf2f(a.y & 0xffffu) + w1 * bf2f(b.y & 0xffffu)); v[j].w += g.w * (w0 * bf2f(a.y >> 16) + w1 * bf2f(b.y >> 16)); }
}
__device__ __forceinline__ void phase_combine_norm_mix1(const Ctx& C) {
    const Params& P = *C.p; float* XC = (float*)(C.ws + WS_XC); bf16* H = (bf16*)(C.ws + WS_H);
    const int ps = wave_pstart(C, 0);
    for (int r = C.gw; r < TT; r += C.ngw) {
        f32x4 v[4]; moe_combine(C, 0, r, ps, v);
#pragma unroll
        for (int j = 0; j < 4; ++j) *(f32x4*)(XC + (size_t)r * D + 4 * C.lane + 256 * j) = v[j];
        const float rstd = row_rstd(v); const int ci = cond_of(r);
        modulate16(v, rstd, P.in[I_GMIX] + D, mod_vec(C, 1, ci, 1), mod_vec(C, 1, ci, 0), C.lane);
        store_row16_bf16(H + (size_t)r * D, C.lane, v);
    }
    LAS float* scr = (LAS float*)(C.lds + C.wave * 16384);
    for (int it = C.gw; it < MOE_ITEMS; it += C.ngw) moe_convert_item(C, 1, it, scr);
}
__device__ __forceinline__ void phase_final(const Ctx& C) {
    const Params& P = *C.p;
    const int ps = wave_pstart(C, 1);
    for (int r = C.gw; r < TL; r += C.ngw) {
        f32x4 v[4]; moe_combine(C, 1, r, ps, v);
        const float rstd = row_rstd(v);
#pragma unroll
        for (int j = 0; j < 4; ++j) { const int c = 4 * C.lane + 256 * j; const f32x4 g = *(const f32x4*)(P.in[I_FING] + c); *(f32x4*)(P.out + (size_t)r * D + c) = v[j] * rstd * g; }
    }
}

__device__ __forceinline__ void phase_s5(const Ctx& C) {
    const Params& P = *C.p; const bf16* U = (const bf16*)(C.ws + WS_U); bf16* GS = (bf16*)(C.ws + WS_GS); float* YA = (float*)(C.ws + WS_YACC);
    const float2* lamb = (const float2*)(C.ws + WS_TAB + TAB_LAMB); const float2* bbar = (const float2*)(C.ws + WS_TAB + TAB_BBAR);
    LAS f32x2* hb = (LAS f32x2*)(C.lds + C.wave * 8192);
    const int lane = C.lane;
    for (int it = C.gw; it < NB * 32; it += C.ngw) {
        const int b = it >> 5, g = it & 31;
        for (int dir = 0; dir < 2; ++dir) {
            const int dgn = ((dir * 32 + g) * 64 + lane);
            const float2 lam = lamb[dgn]; float2 bb[16];
#pragma unroll
            for (int p = 0; p < 16; ++p) bb[p] = bbar[(size_t)dgn * 16 + p];
            const float* cre = P.in[I_CRE] + (size_t)(dir * 32 + g) * 16 * 64; const float* cim = P.in[I_CIM] + (size_t)(dir * 32 + g) * 16 * 64;
            float hr = 0.f, hi = 0.f;
            for (int ck = 0; ck < 144; ++ck) {
                const bool isl = ck >= 16;
                const int tb = isl ? (dir == 0 ? (ck - 16) * 16 : (143 - ck) * 16) : (dir == 0 ? ck * 16 : (15 - ck) * 16);
                const size_t rowb = isl ? (size_t)b * SEQ + tb : (size_t)TL + (size_t)b * CTXL + tb;
                for (int sl = 0; sl < 16; ++sl) {
                    const int to = dir == 0 ? sl : 15 - sl;
                    const bf16* ur = U + (rowb + to) * 512 + g * 16; float uf[16]; unpack8(*(const v4u*)ur, uf); unpack8(*(const v4u*)(ur + 8), uf + 8);
                    float br = 0.f, bi = 0.f;
#pragma unroll
                    for (int p = 0; p < 16; ++p) { br += bb[p].x * uf[p]; bi += bb[p].y * uf[p]; }
                    const float nr = lam.x * hr - lam.y * hi + br, ni = lam.x * hi + lam.y * hr + bi; hr = nr; hi = ni;
                    if (isl) hb[to * 64 + lane] = (f32x2){hr, hi};
                }
                if (isl) {
                    asm volatile("s_waitcnt lgkmcnt(0)" ::: "memory");
                    const int p = lane & 15;
#pragma unroll
                    for (int i = 0; i < 4; ++i) { const int to = (lane >> 4) + 4 * i; float y = 0.f;
                        for (int n = 0; n < 64; ++n) { const f32x2 h = hb[to * 64 + n]; y += cre[p * 64 + n] * h.x - cim[p * 64 + n] * h.y; }
                        const size_t o = (rowb + to) * 512 + g * 16 + p;
                        if (dir == 0) YA[o] = y + P.in[I_S5D][g * 16 + p] * bf2f(U[o]);
                        else GS[o] = (bf16)f2bf(gelu_tanh(YA[o] + y)); }
                    asm volatile("s_waitcnt lgkmcnt(0)" ::: "memory");
                }
            }
        }
    }
}


__device__ __forceinline__ void phase_s5_fast(const Ctx& C) {
    typedef short bf16x8 __attribute__((ext_vector_type(8)));
    typedef float f32x16 __attribute__((ext_vector_type(16)));
    const Params& P = *C.p; const bf16* U = (const bf16*)(C.ws + WS_U); bf16* GS = (bf16*)(C.ws + WS_GS); float* YA = (float*)(C.ws + WS_YACC);
    const float2* lamb = (const float2*)(C.ws + WS_TAB + TAB_LAMB); const float2* bbar = (const float2*)(C.ws + WS_TAB + TAB_BBAR);
    constexpr int HP = 272;
    const int lane = C.lane, w = C.wave, il = w >> 2, dir = (w >> 1) & 1, nh = w & 1;
    const int l31 = lane & 31, hi = lane >> 5, l15 = lane & 15, q4 = lane >> 4;
    LAS unsigned char* Hb = C.lds + (il * 2 + dir) * (2 * 32 * HP);
    const int srow = (l31 & 3) + 4 * (l31 >> 3) + 16 * ((l31 >> 2) & 1);
    for (int it0 = blockIdx.x; it0 < NB * 16; it0 += gridDim.x) {
        const int item = it0 * 2 + il, b = item >> 5, g = item & 31;
        const int dg = dir * 32 + g, n = nh * 32 + l31;
        const float2 lam = lamb[dg * 64 + n];
        float lpr[16], lpi[16]; { float pr = lam.x, pi = lam.y;
#pragma unroll
            for (int r = 0; r < 16; ++r) { lpr[r] = pr; lpi[r] = pi; const float nr = pr * lam.x - pi * lam.y, ni = pr * lam.y + pi * lam.x; pr = nr; pi = ni; } }
        bf16x8 bre, bim; { const float2* bp = bbar + ((size_t)(dg * 64 + n)) * 16 + 8 * hi;
#pragma unroll
            for (int e = 0; e < 8; ++e) { const float2 v = bp[e]; bre[e] = (short)f2bf(v.x); bim[e] = (short)f2bf(v.y); } }
        bf16x8 cf[4]; { const float* cre = P.in[I_CRE] + ((size_t)dg * 16 + l15) * 64; const float* cim = P.in[I_CIM] + ((size_t)dg * 16 + l15) * 64;
#pragma unroll
            for (int ks = 0; ks < 4; ++ks) { const f32x4 a = *(const f32x4*)(cre + 16 * ks + 4 * q4), m = *(const f32x4*)(cim + 16 * ks + 4 * q4);
                cf[ks][0] = (short)f2bf(a.x); cf[ks][1] = (short)f2bf(-m.x); cf[ks][2] = (short)f2bf(a.y); cf[ks][3] = (short)f2bf(-m.y);
                cf[ks][4] = (short)f2bf(a.z); cf[ks][5] = (short)f2bf(-m.z); cf[ks][6] = (short)f2bf(a.w); cf[ks][7] = (short)f2bf(-m.w); } }
        const f32x4 dsk = *(const f32x4*)(P.in[I_S5D] + g * 16 + 4 * q4);
        float cr = 0.f, ci = 0.f;
        for (int k = 0; k < 72; ++k) {
            { const int S = 32 * k + srow; size_t row;
              if (S < CTXL) row = (size_t)TL + (size_t)b * CTXL + (dir == 0 ? S : CTXL - 1 - S); else row = (size_t)b * SEQ + (dir == 0 ? S - CTXL : SEQ - 1 - (S - CTXL));
              const bf16x8 ua = *(const bf16x8*)(U + row * 512 + g * 16 + 8 * hi);
              f32x16 br = {}, bi = {};
              br = __builtin_amdgcn_mfma_f32_32x32x16_bf16(ua, bre, br, 0, 0, 0);
              bi = __builtin_amdgcn_mfma_f32_32x32x16_bf16(ua, bim, bi, 0, 0, 0);
              float sr = hi ? 0.f : cr, si = hi ? 0.f : ci;
#pragma unroll
              for (int r = 0; r < 16; ++r) { const float nr = lam.x * sr - lam.y * si + br[r], ni = lam.x * si + lam.y * sr + bi[r]; sr = nr; si = ni; br[r] = sr; bi[r] = si; }
              float er = __shfl_xor(sr, 32), ei = __shfl_xor(si, 32); if (!hi) { er = 0.f; ei = 0.f; }
#pragma unroll
              for (int r = 0; r < 16; ++r) { br[r] += lpr[r] * er - lpi[r] * ei; bi[r] += lpr[r] * ei + lpi[r] * er; }
              cr = __shfl_xor(br[15], 32); ci = __shfl_xor(bi[15], 32);
              LAS unsigned char* hb = Hb + (k & 1) * (32 * HP) + (16 * hi) * HP + 4 * n;
#pragma unroll
              for (int r = 0; r < 16; ++r) *(LAS unsigned*)(hb + r * HP) = pk2(br[r], bi[r]);
            }
            asm volatile("s_waitcnt vmcnt(0) lgkmcnt(0)\n\ts_barrier" ::: "memory");
            if (k >= 8) {
                const LAS unsigned char* hr = Hb + (k & 1) * (32 * HP) + (16 * nh + l15) * HP + 16 * q4;
                f32x4 y = {0.f, 0.f, 0.f, 0.f};
#pragma unroll
                for (int ks = 0; ks < 4; ++ks) { const bf16x8 hf = *(const LAS bf16x8*)(hr + 64 * ks); y = __builtin_amdgcn_mfma_f32_16x16x32_bf16(cf[ks], hf, y, 0, 0, 0); }
                const int sl = 32 * (k - 8) + 16 * nh + l15;
                const int tok = dir == 0 ? sl : SEQ - 1 - sl; const int lt = tok >> 5;
                const size_t o = ((size_t)b * SEQ + tok) * 512 + g * 16 + 4 * q4;
                const bool first = dir == 0 ? (lt < 32) : (lt >= 32);
                if (first) { *(f32x4*)(YA + o) = y; }
                else {
                    f32x4 p; p.x = __hip_atomic_load(YA + o, __ATOMIC_RELAXED, __HIP_MEMORY_SCOPE_AGENT); p.y = __hip_atomic_load(YA + o + 1, __ATOMIC_RELAXED, __HIP_MEMORY_SCOPE_AGENT);
                    p.z = __hip_atomic_load(YA + o + 2, __ATOMIC_RELAXED, __HIP_MEMORY_SCOPE_AGENT); p.w = __hip_atomic_load(YA + o + 3, __ATOMIC_RELAXED, __HIP_MEMORY_SCOPE_AGENT);
                    const v2u uu = *(const v2u*)(U + o);
                    const f32x4 uf = {bf2f(uu.x & 0xffffu), bf2f(uu.x >> 16), bf2f(uu.y & 0xffffu), bf2f(uu.y >> 16)};
                    const f32x4 t = y + p + dsk * uf;
                    v2u ov; ov.x = pk2(gelu_tanh(t.x), gelu_tanh(t.y)); ov.y = pk2(gelu_tanh(t.z), gelu_tanh(t.w)); *(v2u*)(GS + o) = ov;
                }
            }
        }
        asm volatile("s_waitcnt vmcnt(0) lgkmcnt(0)\n\ts_barrier" ::: "memory");
    }
}

__global__ void __launch_bounds__(NTHR, 2) fwd_kernel(Params prm) {
    extern __shared__ __attribute__((aligned(16))) unsigned char lds_raw[];
    Ctx C; C.p = &prm; C.ws = prm.ws; C.lds = (LAS unsigned char*)lds_raw;
    C.tid = threadIdx.x; C.lane = C.tid & 63; C.wave = __builtin_amdgcn_readfirstlane(C.tid >> 6);
    C.gw = blockIdx.x * NWAVE + C.wave; C.ngw = gridDim.x * NWAVE;
    constexpr int LDS_MISC = 147456 - 256;
    volatile LAS unsigned* misc = (volatile LAS unsigned*)(C.lds + LDS_MISC);
    if (C.tid < 64) misc[C.tid] = 0u;
    __syncthreads();
    unsigned* ctl = (unsigned*)(C.ws + WS_CTL);
    XcdBarrier bar; bar.bar = ctl + CW_BAR; bar.x = 0; bar.st = nullptr;
#if MK_ONE_LAUNCH
    bar = xcd_barrier_post(ctl + CW_BAR, misc + 8);
#define SEAM(k) do { if (lo <= (k) && (k) + 1 < hi) xcd_barrier(bar); } while (0)
#else
#define SEAM(k) do { } while (0)
#endif
    const int lo = prm.ph_lo, hi = prm.ph_hi;
#define IN(k) (lo <= (k) && (k) < hi)
    const Params& P = prm;
    bf16* Hb = (bf16*)(C.ws + WS_H); float* XC = (float*)(C.ws + WS_XC);
#define MOE_MAP(layer) do { LAS int* tm_ = (LAS int*)(C.lds + 131072); LAS int* cl_ = tm_ + 320; \
        if (C.wave == 0) { const unsigned* cnt_ = (const unsigned*)(C.ws + WS_CTL) + CW_CNT + 64 * (layer); const int mc_ = C.lane < 32 ? (int)__hip_atomic_load(cnt_ + (C.lane & 31), __ATOMIC_RELAXED, __HIP_MEMORY_SCOPE_AGENT) : 0; const int mp_ = (mc_ + 255) & ~255; int in_ = mp_; \
            _Pragma("unroll") for (int o_ = 1; o_ < 32; o_ <<= 1) { const int t_ = __shfl_up(in_, o_); if ((C.lane & 31) >= o_) in_ += t_; } const int ps_ = in_ - mp_; \
            if (C.lane < 32) { for (int t_ = ps_ / 256; t_ < (ps_ + mp_) / 256; ++t_) tm_[t_] = C.lane | ((t_ * 256 - ps_) << 8); cl_[C.lane] = mc_; if (C.lane == 31) cl_[32] = (ps_ + mp_) / 256; } } \
        __syncthreads(); } while (0)
#define MOE_GEMM1(layer) do { MOE_MAP(layer); const LAS int* tm_ = (const LAS int*)(C.lds + 131072); const int ntl_ = __builtin_amdgcn_readfirstlane(tm_[320 + 32]); pg8::Gemm g{Hb, (const bf16*)(C.ws + WS_W13), 0, 1024, D}; \
        pg8::GroupedOrder<true> S{tm_, tm_ + 320, (const int*)(C.ws + WS_LIST), ntl_ * 4, 4, (int)gridDim.x, (int)blockIdx.x, LCAP, D * 2, (size_t)1024 * 1024 * 2}; pg8::EpiSwiglu E{(bf16*)(C.ws + WS_G13)}; \
        pg8::gemm_phase<pg8::EpiSwiglu, pg8::GroupedOrder<true>, true, true>(C.lds, g, S, E); } while (0)
#define MOE_GEMM2(layer) do { MOE_MAP(layer); const LAS int* tm_ = (const LAS int*)(C.lds + 131072); const int ntl_ = __builtin_amdgcn_readfirstlane(tm_[320 + 32]); pg8::Gemm g{(const bf16*)(C.ws + WS_G13), (const bf16*)(C.ws + WS_W2), 0, 1024, EH}; \
        pg8::GroupedOrder<false> S{tm_, tm_ + 320, (const int*)(C.ws + WS_LIST), ntl_ * 4, 4, (int)gridDim.x, (int)blockIdx.x, LCAP, EH * 2, (size_t)1024 * 512 * 2}; pg8::EpiStore E{(bf16*)(C.ws + WS_XS), D}; \
        pg8::gemm_phase<pg8::EpiStore, pg8::GroupedOrder<false>, true, true>(C.lds, g, S, E); } while (0)
    if (IN(0)) { phase_prologue(C); SEAM(0); }
    if (IN(1)) { phase_norm_mix0(C); SEAM(1); }
    if (IN(2)) { pg8::Gemm g{Hb, (const bf16*)(C.ws + WS_WIN0), TT, MIXW, D}; pg8::StaticOrder S; S.init(TT, MIXW, gridDim.x, blockIdx.x); pg8::EpiStore E{(bf16*)(C.ws + WS_P), MIXW};
        pg8::gemm_phase<pg8::EpiStore, pg8::StaticOrder, true, true>(C.lds, g, S, E); SEAM(2); }
    if (IN(3)) { phase_qkprep(C); phase_gmlp(C); SEAM(3); }
    if (IN(4)) { phase_attn_fast(C, (char*)lds_raw); SEAM(4); }
    if (IN(5)) { pg8::Gemm g{Hb, (const bf16*)(C.ws + WS_WOUT0), TT, D, D}; pg8::StaticOrder S; S.init(TT, D, gridDim.x, blockIdx.x); pg8::EpiResid E{P.in[I_X], P.in[I_CTX], (const float*)(C.ws + WS_MOD), XC, 0};
        pg8::gemm_phase<pg8::EpiResid, pg8::StaticOrder, true, true>(C.lds, g, S, E); SEAM(5); }
    if (IN(6)) { phase_router_fast(C, 0, TT); SEAM(6); }
    if (IN(8)) { MOE_GEMM1(0); SEAM(8); }
    if (IN(9)) { MOE_GEMM2(0); SEAM(9); }
    if (IN(10)) { phase_combine_norm_mix1(C); SEAM(10); }
    if (IN(11)) { pg8::Gemm g{Hb, (const bf16*)(C.ws + WS_WS5IN), TT, 512, D}; pg8::StaticOrder S; S.init(TT, 512, gridDim.x, blockIdx.x); pg8::EpiStore E{(bf16*)(C.ws + WS_U), 512};
        pg8::gemm_phase<pg8::EpiStore, pg8::StaticOrder, true, true>(C.lds, g, S, E); SEAM(11); }
    if (IN(12)) { phase_s5_fast(C); SEAM(12); }
    if (IN(13)) { pg8::Gemm g{(const bf16*)(C.ws + WS_GS), (const bf16*)(C.ws + WS_WGLU), TL, 512, 512}; pg8::StaticOrder S; S.init(TL, 512, gridDim.x, blockIdx.x); pg8::EpiGlu E{(const bf16*)(C.ws + WS_GS), P.in[I_BGLU], (bf16*)(C.ws + WS_GG)};
        pg8::gemm_phase<pg8::EpiGlu, pg8::StaticOrder, true, true>(C.lds, g, S, E); SEAM(13); }
    if (IN(14)) { pg8::Gemm g{(const bf16*)(C.ws + WS_GG), (const bf16*)(C.ws + WS_WS5OUT), TL, D, 512}; pg8::StaticOrder S; S.init(TL, D, gridDim.x, blockIdx.x); pg8::EpiResid E{P.in[I_X], P.in[I_CTX], (const float*)(C.ws + WS_MOD) + (size_t)17 * 6 * D, XC, 1};
        pg8::gemm_phase<pg8::EpiResid, pg8::StaticOrder, true, true>(C.lds, g, S, E); SEAM(14); }
    if (IN(15)) { phase_router_fast(C, 1, TL); SEAM(15); }
    if (IN(17)) { MOE_GEMM1(1); SEAM(17); }
    if (IN(18)) { MOE_GEMM2(1); SEAM(18); }
    if (IN(19)) { phase_final(C); }
#undef IN
#undef SEAM
}

extern "C" void kernel_launch(void* const* d_in, const int* in_sizes, int n_in, void* d_out, int out_size, void* d_ws, size_t ws_size, hipStream_t stream) {
    constexpr int LDS_BYTES = 147456;
    static int grid = 0;
    if (grid == 0) {
        if (n_in != 35 || out_size != TL * D || ws_size < WS_END) { fprintf(stderr, "kernel_launch: unexpected shapes (n_in %d out %d ws %zu)\n", n_in, out_size, ws_size); grid = -1; return; }
        int dev = 0, cus = 0;
        if (hipGetDevice(&dev) != hipSuccess || hipDeviceGetAttribute(&cus, hipDeviceAttributeMultiprocessorCount, dev) != hipSuccess) { grid = -1; return; }
        if (hipFuncSetAttribute((const void*)fwd_kernel, hipFuncAttributeMaxDynamicSharedMemorySize, LDS_BYTES) != hipSuccess) { fprintf(stderr, "kernel_launch: hipFuncSetAttribute failed\n"); grid = -1; return; }
        (void)hipGetLastError();
        grid = cus;
    }
    if (grid < 0) return;
    (void)hipMemsetAsync((char*)d_ws + WS_CTL, 0, CTL_BYTES, stream);
    Params p{};
    for (int i = 0; i < 35; ++i) p.in[i] = (const float*)d_in[i];
    p.out = (float*)d_out; p.ws = (unsigned char*)d_ws;
#if MK_ONE_LAUNCH
    p.ph_lo = 0; p.ph_hi = NPHASE;
    hipLaunchKernelGGL(fwd_kernel, dim3(grid), dim3(NTHR), LDS_BYTES, stream, p);
#else
    for (int k = 0; k < NPHASE; ++k) { p.ph_lo = k; p.ph_hi = k + 1; hipLaunchKernelGGL(fwd_kernel, dim3(grid), dim3(NTHR), LDS_BYTES, stream, p); }
#endif
}
```

```cpp
#include <hip/hip_runtime.h>
#include <cstdio>
#include <cstdint>

#ifndef MK_ONE_LAUNCH
#define MK_ONE_LAUNCH 1
#endif

constexpr int D = 1024, NB = 16, SEQ = 2048, CTXL = 256;
constexpr int TL = NB * SEQ, TC = NB * CTXL, TT = TL + TC;
constexpr int KVL = CTXL + SEQ;
constexpr int MIXW = 1792, NEXP = 32, EH = 512;
constexpr int NSLOT = 81920;
constexpr float EPS = 1e-6f;
constexpr float QSCALE = 0.125f * 1.4426950408889634f;
constexpr int NTHR = 512, NWAVE = 8;
constexpr int NPHASE = 20;

constexpr size_t MiB = 1u << 20;
constexpr size_t WS_CTL = 0, CTL_BYTES = 1 * MiB;
constexpr size_t WS_MOD = 1 * MiB;
constexpr size_t WS_TAB = 2 * MiB;
constexpr size_t TAB_ROPE = 0, TAB_LAMB = 16384, TAB_BBAR = 65536, TAB_WR = 640 * 1024;
constexpr size_t WS_ROUTE = 3 * MiB;
constexpr size_t RT_E = 0, RT_P = 320 * 1024, RT_W = 640 * 1024, RT_S = 960 * 1024, RT_TILE = 1280 * 1024, RT_NT = 1280 * 1024 + 4096;
constexpr size_t WS_WIN0 = 6 * MiB, WS_WOUT0 = 10 * MiB, WS_WS5IN = 12 * MiB, WS_WGLU = 13 * MiB, WS_WS5OUT = 14 * MiB;
constexpr size_t WS_WSP = 15 * MiB;
constexpr size_t WS_W13 = 16 * MiB, WS_W2 = 80 * MiB;
constexpr size_t WS_XC = 112 * MiB;
constexpr size_t WS_H = 256 * MiB;
constexpr size_t WS_P = 328 * MiB;
constexpr size_t WS_Q = 454 * MiB, WS_K = 490 * MiB, WS_V = 499 * MiB;
constexpr size_t WS_XS = 328 * MiB;
constexpr size_t WS_G13 = 488 * MiB;
constexpr size_t WS_U = 328 * MiB, WS_GS = 364 * MiB, WS_GG = 396 * MiB, WS_YACC = 428 * MiB;
constexpr size_t WS_LIST = 568 * MiB;
constexpr int LCAP = 36864;
constexpr size_t WS_END = 574 * MiB;
constexpr int CW_CNT = 64;
constexpr int CW_BAR = 4096;

#define LAS __attribute__((address_space(3)))
typedef unsigned short bf16;
typedef unsigned v4u __attribute__((ext_vector_type(4)));
typedef unsigned v2u __attribute__((ext_vector_type(2)));
typedef float f32x4 __attribute__((ext_vector_type(4)));
typedef float f32x2 __attribute__((ext_vector_type(2)));
__device__ __forceinline__ float bf2f(unsigned u) { return __uint_as_float(u << 16); }
__device__ __forceinline__ unsigned f2bf(float f) { unsigned u = __float_as_uint(f); return (u + 0x7fffu + ((u >> 16) & 1u)) >> 16; }
__device__ __forceinline__ unsigned pk2(float lo, float hi) { return f2bf(lo) | (f2bf(hi) << 16); }
__device__ __forceinline__ float wave_sum(float v) {
#pragma unroll
    for (int o = 1; o < 64; o <<= 1) v += __shfl_xor(v, o);
    return v;
}
__device__ __forceinline__ float wave_max(float v) {
#pragma unroll
    for (int o = 1; o < 64; o <<= 1) v = fmaxf(v, __shfl_xor(v, o));
    return v;
}
__device__ __forceinline__ float gelu_tanh(float x) { const float u2 = -1.5957691216057308f * (x + 0.044715f * x * x * x); return x * __builtin_amdgcn_rcpf(1.f + __expf(u2)); }
__device__ __forceinline__ float sigmoidf_(float x) { return 1.f / (1.f + __expf(-x)); }
__device__ __forceinline__ float silu_(float x) { return x / (1.f + __expf(-x)); }
__device__ __forceinline__ void unpack8(const v4u w, float* f) {
    f[0] = bf2f(w.x & 0xffffu); f[1] = bf2f(w.x >> 16); f[2] = bf2f(w.y & 0xffffu); f[3] = bf2f(w.y >> 16);
    f[4] = bf2f(w.z & 0xffffu); f[5] = bf2f(w.z >> 16); f[6] = bf2f(w.w & 0xffffu); f[7] = bf2f(w.w >> 16);
}

#define XB_TMO      128
#define XB_XCNT(j)  (256  + 64 * (j))
#define XB_XSUB(j)  (1280 + 64 * (j))
#define XB_XGEN(j)  (2304 + 64 * (j))
#define XB_TOP      3328
#define XB_TOPGEN   3392
#define XCD_BAR_WORDS 3456
#define XB_SPIN_CAP (1u << 28)
__device__ __forceinline__ unsigned xb_ld(unsigned* p)              { return __hip_atomic_load(p, __ATOMIC_RELAXED, __HIP_MEMORY_SCOPE_AGENT); }
__device__ __forceinline__ unsigned xb_add(unsigned* p, unsigned v) { return __hip_atomic_fetch_add(p, v, __ATOMIC_RELAXED, __HIP_MEMORY_SCOPE_AGENT); }
__device__ __forceinline__ unsigned xb_xcc_id() { return (unsigned)__builtin_amdgcn_s_getreg((3 << 11) | 20) & 0xFu; }
#define XB_SPIN(cond, bar) do { unsigned _sp = 0; while (cond) { __builtin_amdgcn_s_sleep(1); \
    if ((++_sp & 255u) == 0u) { if (xb_ld(&(bar)[XB_TMO])) break; if (_sp > XB_SPIN_CAP) { atomicAdd(&(bar)[XB_TMO], 1u); break; } } } } while (0)
struct XcdBarrier { unsigned* bar; unsigned x; volatile LAS unsigned* st; };
__device__ __forceinline__ XcdBarrier xcd_barrier_post(unsigned* bar, volatile LAS unsigned* st) {
    XcdBarrier b; b.bar = bar; b.x = xb_xcc_id(); b.st = st;
    if (threadIdx.x == 0) (void)xb_add(&bar[XB_XCNT(b.x)], 1u);
    return b;
}
__device__ __forceinline__ void xcd_barrier_complete(unsigned* bar, unsigned x, unsigned& nloc, unsigned& nx) {
    const unsigned G = gridDim.x * gridDim.y * gridDim.z;
    unsigned sum, cnt, mine, sp = 0u;
    for (;;) {
        sum = 0u; cnt = 0u; mine = 0u;
#pragma unroll
        for (unsigned j = 0; j < 16; ++j) { const unsigned c = xb_ld(&bar[XB_XCNT(j)]); sum += c; cnt += (c > 0u) ? 1u : 0u; mine = (j == x) ? c : mine; }
        if (sum == G) break;
        __builtin_amdgcn_s_sleep(1);
        if ((++sp & 255u) == 0u) { if (xb_ld(&bar[XB_TMO])) break; if (sp > XB_SPIN_CAP) { atomicAdd(&bar[XB_TMO], 1u); break; } }
    }
    nloc = mine > 0u ? mine : 1u; nx = cnt > 0u ? cnt : 1u;
}
__device__ __forceinline__ void xcd_barrier(const XcdBarrier& b) {
    asm volatile("s_waitcnt vmcnt(0)" ::: "memory");
    __syncthreads();
    if (threadIdx.x == 0) {
        unsigned* bar = b.bar;
        __builtin_amdgcn_s_waitcnt(0);
        unsigned nloc = b.st[0], nx = b.st[1];
        if (nloc == 0u) { xcd_barrier_complete(bar, b.x, nloc, nx); b.st[0] = nloc; b.st[1] = nx; }
        const unsigned old = xb_add(&bar[XB_XSUB(b.x)], 1u);
        const unsigned gen = old / nloc;
        if (old + 1u == (gen + 1u) * nloc) {
            __builtin_amdgcn_fence(__ATOMIC_RELEASE, "agent");
            asm volatile("s_waitcnt vmcnt(0)" ::: "memory");
            const unsigned og = xb_add(&bar[XB_TOP], 1u);
            const unsigned tg = og / nx;
            if (og + 1u == (tg + 1u) * nx) xb_add(&bar[XB_TOPGEN], 1u);
            else XB_SPIN(xb_ld(&bar[XB_TOPGEN]) == tg, bar);
            __builtin_amdgcn_fence(__ATOMIC_ACQUIRE, "agent");
            xb_add(&bar[XB_XGEN(b.x)], 1u);
            asm volatile("s_waitcnt vmcnt(0)" ::: "memory");
        } else {
            XB_SPIN(xb_ld(&bar[XB_XGEN(b.x)]) == gen, bar);
            __builtin_amdgcn_fence(__ATOMIC_ACQUIRE, "agent");
            asm volatile("s_waitcnt vmcnt(0)" ::: "memory");
        }
    }
    __syncthreads();
}

namespace pg8 {
#define PG8_LAS __attribute__((address_space(3)))
typedef unsigned short bf16_t;
typedef short bf16x8 __attribute__((ext_vector_type(8)));
typedef float f32x4 __attribute__((ext_vector_type(4)));
typedef unsigned u32x4 __attribute__((ext_vector_type(4)));
constexpr int BM = 256, BK = 64, HALF = 128, HTB = HALF * BK * 2  , STAGE_BYTES = 8 * HTB, NXCD = 8, WGM = 8;

__host__ __device__ __forceinline__ int lds_byte(int r, int c) { const int st = (r >> 4) * 2 + (c >> 5), rr = r & 15, cc = c & 31, ob = rr * 64 + cc * 2; return st * 1024 + (ob ^ (((ob >> 9) & 1) << 5)); }
__host__ __device__ __forceinline__ void stage_rc(int b, int& R, int& C) { const int st = b / 1024, sb = b % 1024, swz = sb ^ (((sb >> 9) & 1) << 5); R = (st >> 1) * 16 + swz / 64; C = (st & 1) * 32 + (swz % 64) / 2; }
__host__ __device__ __forceinline__ int perm32(int rho) { const int n = rho >> 4, i = rho & 15; return 8 * (i >> 2) + 4 * n + (i & 3); }

struct Unit { int pm, pn; size_t bo; int aux; };
struct Gemm { const bf16_t* A; const bf16_t* Bt; int M, N, K; };

struct StaticOrder {
    static constexpr bool GATHER = false;
    int nM, nN, nwg, G, c;
    __host__ __device__ void init(int M, int N, int G_, int c_) { nM = M / BM; nN = N / BM; nwg = nM * nN; G = G_; c = c_; }
    __host__ __device__ bool next(int i, Unit& u) const {
        const long L = (long)i * G + c; if (L >= nwg) return false;
        int wgid = (int)L; { const int q = nwg / NXCD, r = nwg % NXCD, xcd = wgid % NXCD, off = wgid / NXCD; wgid = (xcd < r ? xcd * (q + 1) : r * (q + 1) + (xcd - r) * q) + off; }
        const int nig = WGM * nN, gid = wgid / nig, fm = gid * WGM, gsz = (nM - fm) < WGM ? (nM - fm) : WGM;
        u.pm = fm + ((wgid % nig) % gsz); u.pn = (wgid % nig) / gsz; u.bo = 0; u.aux = 0; return true;
    }
    __device__ __forceinline__ void a_ready(const Unit&) const {}
    __device__ __forceinline__ void done(const Unit&) const {}
};

__device__ __forceinline__ unsigned cvt_pk_bf16(float lo, float hi) { unsigned r; asm volatile("v_cvt_pk_bf16_f32 %0, %1, %2" : "=v"(r) : "v"(lo), "v"(hi)); return r; }
typedef float f32x2 __attribute__((ext_vector_type(2)));
__device__ __forceinline__ f32x2 gelu_pk(f32x2 v) {
    const f32x2 av = __builtin_elementwise_abs(v), d = av * 0.2316418882f + 1.0f;
    f32x2 t; t.x = __builtin_amdgcn_rcpf(d.x); t.y = __builtin_amdgcn_rcpf(d.y);
    f32x2 q = t * 0.5307027145f + (-0.7265760135f); q = q * t + 0.7107068705f; q = q * t + (-0.142248368f); q = q * t + 0.127414796f; q = q * t;
    const f32x2 s = (v * v) * (-0.72134752044f);
    f32x2 e; e.x = __builtin_amdgcn_exp2f(s.x); e.y = __builtin_amdgcn_exp2f(s.y);
    const f32x2 m = v * (q * e), r = v - m;
    f32x2 o; o.x = v.x < 0.f ? m.x : r.x; o.y = v.y < 0.f ? m.y : r.y; return o;
}

template <class Epi, class Sched, bool ALIGN_EPI = false, bool SP2 = false>
__device__ __forceinline__ void gemm_phase(PG8_LAS unsigned char* lds, const Gemm g, const Sched& S, const Epi& E) {
    const int tid = threadIdx.x, wid = __builtin_amdgcn_readfirstlane(tid >> 6), lane = tid & 63, wr = wid >> 2, wc = wid & 3, fr = lane & 15, fq = lane >> 4;
    const int K = g.K, nt = K / BK;
    unsigned voffA[2], voffB[2];
    unsigned vC[2][2], vN[2][2];
#pragma unroll
    for (int i = 0; i < 2; ++i) { int R, C; stage_rc(tid * 16 + i * 8192, R, C); const int Rb = Epi::PERM ? ((R & ~31) + perm32(R & 31)) : R;
        voffA[i] = (unsigned)(R * K + C) * 2u; voffB[i] = (unsigned)(Rb * K + C) * 2u; }
    const size_t kstep = (size_t)(BK * 2);
    const size_t hstep = (size_t)HALF * K * 2;
    const size_t tstep = 2 * hstep;
    const unsigned ldsw = (unsigned)wid * 1024u;
    const int aoff = lds_byte(wr * 64 + fr, fq * 8), boff = lds_byte(wc * 32 + fr, fq * 8);
#define PG8_SA(b, h) (((b) * 2 + (h)) * HTB)
#define PG8_SB(b, h) ((4 + (b) * 2 + (h)) * HTB)
#define PG8_STAGE(bufoff, gbase, voff) do { _Pragma("unroll") for (int _i = 0; _i < 2; ++_i) \
        __builtin_amdgcn_global_load_lds((const unsigned*)((const char*)(gbase) + (voff)[_i]), (PG8_LAS unsigned*)(lds + (bufoff) + ldsw + _i * 8192), 16, 0, 0); } while (0)
#define PG8_STAGE_A(bufoff, gbase, h, nx) do { _Pragma("unroll") for (int _i = 0; _i < 2; ++_i) { \
        const unsigned _vo = Sched::GATHER ? ((nx) ? vN[h][_i] : vC[h][_i]) : (unsigned)((h) * hstep) + voffA[_i]; \
        __builtin_amdgcn_global_load_lds((const unsigned*)((const char*)(gbase) + _vo), (PG8_LAS unsigned*)(lds + (bufoff) + ldsw + _i * 8192), 16, 0, 0); } } while (0)
#define PG8_LDA(dst, b, h) do { _Pragma("unroll") for (int m = 0; m < 4; ++m) _Pragma("unroll") for (int k = 0; k < 2; ++k) dst[m][k] = *(const PG8_LAS bf16x8*)(lds + PG8_SA(b, h) + aoff + m * 2048 + k * 1024); } while (0)
#define PG8_LDB(dst, b, h) do { _Pragma("unroll") for (int n = 0; n < 2; ++n) _Pragma("unroll") for (int k = 0; k < 2; ++k) dst[n][k] = *(const PG8_LAS bf16x8*)(lds + PG8_SB(b, h) + boff + n * 2048 + k * 1024); } while (0)
#define PG8_MMA(ai, bj, At, Bt) do { __builtin_amdgcn_s_setprio(1); _Pragma("unroll") for (int m = 0; m < 4; ++m) _Pragma("unroll") for (int n = 0; n < 2; ++n) _Pragma("unroll") for (int k = 0; k < 2; ++k) \
        acc[ai][bj][m][n] = __builtin_amdgcn_mfma_f32_16x16x32_bf16(Bt[n][k], At[m][k], acc[ai][bj][m][n], 0, 0, 0); __builtin_amdgcn_s_setprio(0); } while (0)
#define PG8_WAIT_V(n) asm volatile("s_waitcnt vmcnt(" #n ")" ::: "memory")
#define PG8_WAIT_L(n) asm volatile("s_waitcnt lgkmcnt(" #n ")" ::: "memory")
#define PG8_BAR __builtin_amdgcn_s_barrier()
#define PG8_SCHED __builtin_amdgcn_sched_barrier(0)
    Unit cur, nxt; int ui = 0;
    if (!S.next(0, cur)) return;
    f32x4 acc[2][2][4][2];
#pragma unroll
    for (int a = 0; a < 2; ++a)
#pragma unroll
        for (int b = 0; b < 2; ++b)
#pragma unroll
            for (int m = 0; m < 4; ++m)
#pragma unroll
                for (int n = 0; n < 2; ++n) acc[a][b][m][n] = (f32x4){0.f, 0.f, 0.f, 0.f};
    bf16x8 At[4][2], B0[2][2], B1[2][2];
    const char* cA = (const char*)g.A + (Sched::GATHER ? (size_t)0 : (size_t)cur.pm * tstep); const char* cB = (const char*)g.Bt + cur.bo + (size_t)cur.pn * tstep;
    S.a_ready(cur);
#define PG8_VOFF(dst, un) do { _Pragma("unroll") for (int _h = 0; _h < 2; ++_h) _Pragma("unroll") for (int _i = 0; _i < 2; ++_i) { int R_, C_; stage_rc(tid * 16 + _i * 8192, R_, C_); dst[_h][_i] = S.a_off(un, _h * HALF + R_) + (unsigned)C_ * 2u; } } while (0)
    if constexpr (Sched::GATHER) { PG8_VOFF(vC, cur); }
    if constexpr (SP2) {
        PG8_STAGE(PG8_SB(0, 0), cB, voffB); PG8_STAGE(PG8_SB(0, 1), cB + hstep, voffB); PG8_STAGE_A(PG8_SA(0, 0), cA, 0, false); PG8_STAGE_A(PG8_SA(0, 1), cA, 1, false);
        if (wr == 1) PG8_BAR;
        PG8_WAIT_V(2); PG8_BAR;
        PG8_STAGE(PG8_SB(1, 0), cB + kstep, voffB); PG8_STAGE_A(PG8_SA(1, 0), cA + kstep, 0, false); PG8_STAGE(PG8_SB(1, 1), cB + hstep + kstep, voffB);
        PG8_WAIT_V(6); PG8_BAR;
    } else {
        PG8_STAGE(PG8_SB(0, 0), cB, voffB); PG8_STAGE_A(PG8_SA(0, 0), cA, 0, false); PG8_STAGE(PG8_SB(0, 1), cB + hstep, voffB); PG8_STAGE_A(PG8_SA(0, 1), cA, 1, false);
        if (wr == 1) PG8_BAR;
        PG8_WAIT_V(4); PG8_BAR;
        PG8_STAGE(PG8_SB(1, 0), cB + kstep, voffB); PG8_STAGE_A(PG8_SA(1, 0), cA + kstep, 0, false); PG8_STAGE(PG8_SB(1, 1), cB + hstep + kstep, voffB);
        PG8_WAIT_V(6); PG8_BAR;
    }
    for (;;) {
        const bool has_next = S.next(ui + 1, nxt);
        if constexpr (Sched::GATHER) { if (has_next) { PG8_VOFF(vN, nxt); } else { vN[0][0] = vC[0][0]; vN[0][1] = vC[0][1]; vN[1][0] = vC[1][0]; vN[1][1] = vC[1][1]; } }
        const char* nA = (has_next && !Sched::GATHER) ? (const char*)g.A + (size_t)nxt.pm * tstep : cA; const char* nB = has_next ? (const char*)g.Bt + nxt.bo + (size_t)nxt.pn * tstep : cB;
        for (int t = 0; t < nt; t += 2) {
            const bool last = (t == nt - 2);
            const char* a1 = cA + (size_t)(t + 1) * kstep;
            const char* a2 = last ? nA : cA + (size_t)(t + 2) * kstep; const char* b2 = last ? nB : cB + (size_t)(t + 2) * kstep;
            const char* a3 = a2 + kstep; const char* b3 = b2 + kstep;
            if (last && has_next) S.a_ready(nxt);
            if constexpr (SP2) {
            PG8_LDB(B0, 0, 0); PG8_LDB(B1, 0, 1); PG8_SCHED; PG8_LDA(At, 0, 0); PG8_STAGE_A(PG8_SA(1, 1), a1, 1, false);
            PG8_WAIT_V(8); PG8_WAIT_L(0); PG8_BAR; PG8_MMA(0, 0, At, B0); PG8_MMA(0, 1, At, B1); PG8_BAR; PG8_SCHED;
            PG8_LDA(At, 0, 1); PG8_STAGE(PG8_SB(0, 0), b2, voffB); PG8_STAGE(PG8_SB(0, 1), b2 + hstep, voffB); PG8_STAGE_A(PG8_SA(0, 0), a2, 0, last);
            PG8_WAIT_V(8); PG8_WAIT_L(0); PG8_BAR; PG8_MMA(1, 0, At, B0); PG8_MMA(1, 1, At, B1); PG8_BAR; PG8_SCHED;
            PG8_LDB(B0, 1, 0); PG8_LDB(B1, 1, 1); PG8_SCHED; PG8_LDA(At, 1, 0); PG8_STAGE_A(PG8_SA(0, 1), a2, 1, last);
            PG8_WAIT_V(8); PG8_WAIT_L(0); PG8_BAR; PG8_MMA(0, 0, At, B0); PG8_MMA(0, 1, At, B1); PG8_BAR; PG8_SCHED;
            PG8_LDA(At, 1, 1); PG8_STAGE(PG8_SB(1, 0), b3, voffB); PG8_STAGE(PG8_SB(1, 1), b3 + hstep, voffB); PG8_STAGE_A(PG8_SA(1, 0), a3, 0, last);
            PG8_WAIT_V(8); PG8_WAIT_L(0); PG8_BAR; PG8_MMA(1, 0, At, B0); PG8_MMA(1, 1, At, B1); PG8_BAR; PG8_SCHED;
            } else {
            PG8_LDB(B0, 0, 0); PG8_SCHED; PG8_LDA(At, 0, 0); PG8_STAGE_A(PG8_SA(1, 1), a1, 1, false);
            PG8_WAIT_L(8); PG8_BAR; PG8_WAIT_L(0); PG8_MMA(0, 0, At, B0); PG8_BAR; PG8_SCHED;
            PG8_LDB(B1, 0, 1); PG8_STAGE(PG8_SB(0, 0), b2, voffB);
            PG8_BAR; PG8_WAIT_L(0); PG8_MMA(0, 1, At, B1); PG8_BAR;
            PG8_LDA(At, 0, 1); PG8_STAGE_A(PG8_SA(0, 0), a2, 0, last);
            PG8_BAR; PG8_WAIT_L(0); PG8_MMA(1, 0, At, B0); PG8_BAR; PG8_SCHED;
            PG8_STAGE(PG8_SB(0, 1), b2 + hstep, voffB);
            PG8_WAIT_V(6); PG8_BAR; PG8_MMA(1, 1, At, B1); PG8_BAR;
            PG8_LDB(B0, 1, 0); PG8_SCHED; PG8_LDA(At, 1, 0); PG8_STAGE_A(PG8_SA(0, 1), a2, 1, last);
            PG8_WAIT_L(8); PG8_BAR; PG8_WAIT_L(0); PG8_MMA(0, 0, At, B0); PG8_BAR; PG8_SCHED;
            PG8_LDB(B1, 1, 1); PG8_STAGE(PG8_SB(1, 0), b3, voffB);
            PG8_BAR; PG8_WAIT_L(0); PG8_MMA(0, 1, At, B1); PG8_BAR;
            PG8_LDA(At, 1, 1); PG8_STAGE_A(PG8_SA(1, 0), a3, 0, last);
            PG8_BAR; PG8_WAIT_L(0); PG8_MMA(1, 0, At, B0); PG8_BAR; PG8_SCHED;
            PG8_STAGE(PG8_SB(1, 1), b3 + hstep, voffB);
            PG8_WAIT_V(6); PG8_BAR; PG8_MMA(1, 1, At, B1); PG8_BAR;
            }
        }
        if constexpr (ALIGN_EPI) { if (wr == 0) PG8_BAR; }
        if constexpr (!Epi::AFTER_DRAIN) { E(acc, cur, wr, wc, fr, fq); S.done(cur); }
        if (!has_next) break;
#pragma unroll
        for (int a = 0; a < 2; ++a)
#pragma unroll
            for (int b = 0; b < 2; ++b)
#pragma unroll
                for (int m = 0; m < 4; ++m)
#pragma unroll
                    for (int n = 0; n < 2; ++n) acc[a][b][m][n] = (f32x4){0.f, 0.f, 0.f, 0.f};
        cur = nxt; cA = nA; cB = nB; ++ui;
        if constexpr (Sched::GATHER) { vC[0][0] = vN[0][0]; vC[0][1] = vN[0][1]; vC[1][0] = vN[1][0]; vC[1][1] = vN[1][1]; }
        if constexpr (ALIGN_EPI) { if (wr == 1) PG8_BAR; }
    }
    PG8_WAIT_V(0);
    if constexpr (!ALIGN_EPI) { if (wr == 0) PG8_BAR; }
    PG8_BAR;
    if constexpr (Epi::AFTER_DRAIN) { E.fused(acc, cur, wr, wc, fr, fq, lds, wid, lane); S.done(cur); }
#undef PG8_VOFF
#undef PG8_SA
#undef PG8_SB
#undef PG8_STAGE
#undef PG8_STAGE_A
#undef PG8_LDA
#undef PG8_LDB
#undef PG8_MMA
#undef PG8_WAIT_V
#undef PG8_WAIT_L
#undef PG8_BAR
#undef PG8_SCHED
}
}

namespace pg8 {
template <bool GATHER_>
struct GroupedOrder {
    static constexpr bool GATHER = GATHER_;
    const PG8_LAS int* tmap; const PG8_LAS int* cntl; const int* list; int nU, nN, G, c, lcap, rowbytes; size_t estride;
    __device__ __forceinline__ bool next(int i, Unit& u) const { const long L = (long)i * G + c; if (L >= nU) return false; const int t = (int)L / nN; const int m = __builtin_amdgcn_readfirstlane(tmap[t]);
        u.pm = t; u.pn = (int)L % nN; u.bo = (size_t)(m & 255) * estride; u.aux = m; return true; }
    __device__ __forceinline__ unsigned a_off(const Unit& u, int R) const { const int e = u.aux & 255, p0 = u.aux >> 8, ce = cntl[e]; int p = p0 + R; p = p < ce ? p : ce - 1; return (unsigned)list[(size_t)e * lcap + p] * (unsigned)rowbytes; }
    __device__ __forceinline__ void a_ready(const Unit&) const {}
    __device__ __forceinline__ void done(const Unit&) const {}
};
__device__ __forceinline__ u32x4 pack8(const f32x4 a, const f32x4 b) { u32x4 w; w.x = cvt_pk_bf16(a[0], a[1]); w.y = cvt_pk_bf16(a[2], a[3]); w.z = cvt_pk_bf16(b[0], b[1]); w.w = cvt_pk_bf16(b[2], b[3]); return w; }
struct EpiStore {
    static constexpr bool PERM = true, AFTER_DRAIN = false; bf16_t* O; int ldc;
    __device__ __forceinline__ void operator()(const f32x4 (&acc)[2][2][4][2], const Unit& u, int wr, int wc, int fr, int fq) const {
        const int row0 = u.pm * BM + wr * 64 + fr, col0 = u.pn * BM + wc * 32 + 8 * fq;
#pragma unroll
        for (int ai = 0; ai < 2; ++ai)
#pragma unroll
            for (int m = 0; m < 4; ++m) { bf16_t* rowp = O + (size_t)(row0 + ai * HALF + m * 16) * ldc + col0;
#pragma unroll
                for (int bj = 0; bj < 2; ++bj) *(u32x4*)(rowp + bj * HALF) = pack8(acc[ai][bj][m][0], acc[ai][bj][m][1]); }
    }
};
__device__ __forceinline__ f32x4 silu4(const f32x4 v) { f32x4 r;
#pragma unroll
    for (int i = 0; i < 4; ++i) r[i] = v[i] * __builtin_amdgcn_rcpf(1.f + __expf(-v[i])); return r; }
__device__ __forceinline__ f32x4 sigm4(const f32x4 v) { f32x4 r;
#pragma unroll
    for (int i = 0; i < 4; ++i) r[i] = __builtin_amdgcn_rcpf(1.f + __expf(-v[i])); return r; }
struct EpiSwiglu {
    static constexpr bool PERM = true, AFTER_DRAIN = false; bf16_t* G;
    __device__ __forceinline__ void operator()(const f32x4 (&acc)[2][2][4][2], const Unit& u, int wr, int wc, int fr, int fq) const {
        const int row0 = u.pm * BM + wr * 64 + fr, col0 = u.pn * HALF + wc * 32 + 8 * fq;
#pragma unroll
        for (int ai = 0; ai < 2; ++ai)
#pragma unroll
            for (int m = 0; m < 4; ++m) *(u32x4*)(G + (size_t)(row0 + ai * HALF + m * 16) * 512 + col0) = pack8(silu4(acc[ai][0][m][0]) * acc[ai][1][m][0], silu4(acc[ai][0][m][1]) * acc[ai][1][m][1]);
    }
};
__device__ __forceinline__ void unpack8f(const u32x4 w, f32x4& a, f32x4& b) {
    a[0] = __uint_as_float(w.x << 16); a[1] = __uint_as_float(w.x & 0xffff0000u); a[2] = __uint_as_float(w.y << 16); a[3] = __uint_as_float(w.y & 0xffff0000u);
    b[0] = __uint_as_float(w.z << 16); b[1] = __uint_as_float(w.z & 0xffff0000u); b[2] = __uint_as_float(w.w << 16); b[3] = __uint_as_float(w.w & 0xffff0000u); }
struct EpiGlu {
    static constexpr bool PERM = true, AFTER_DRAIN = false; const bf16_t* GS; const float* b; bf16_t* GG;
    __device__ __forceinline__ void operator()(const f32x4 (&acc)[2][2][4][2], const Unit& u, int wr, int wc, int fr, int fq) const {
        const int row0 = u.pm * BM + wr * 64 + fr, col0 = u.pn * BM + wc * 32 + 8 * fq;
#pragma unroll
        for (int bj = 0; bj < 2; ++bj) { const int c = col0 + bj * HALF; const f32x4 b0 = *(const f32x4*)(b + c), b1 = *(const f32x4*)(b + c + 4);
#pragma unroll
            for (int ai = 0; ai < 2; ++ai)
#pragma unroll
                for (int m = 0; m < 4; ++m) { const size_t o = (size_t)(row0 + ai * HALF + m * 16) * 512 + c; f32x4 g0, g1; unpack8f(*(const u32x4*)(GS + o), g0, g1);
                    *(u32x4*)(GG + o) = pack8(g0 * sigm4(acc[ai][bj][m][0] + b0), g1 * sigm4(acc[ai][bj][m][1] + b1)); } }
    }
};
struct EpiResid {
    static constexpr bool PERM = false, AFTER_DRAIN = false;
    const float* x; const float* ctx; const float* mod; float* XC; int inplace;
    __device__ __forceinline__ void operator()(const f32x4 (&acc)[2][2][4][2], const Unit& u, int wr, int wc, int fr, int fq) const {
        const int R0 = u.pm * BM; const int ci = R0 < 32768 ? (R0 >> 11) : 16;
        const float* base = inplace ? XC + (size_t)R0 * 1024 : (R0 < 32768 ? x + (size_t)R0 * 1024 : ctx + (size_t)(R0 - 32768) * 1024);
        float* out = XC + (size_t)R0 * 1024; const float* gate = mod + ((size_t)ci * 6 + 2) * 1024;
        const int rl0 = wr * 64 + fr, col0 = u.pn * BM + wc * 32 + 4 * fq;
#pragma unroll
        for (int bj = 0; bj < 2; ++bj)
#pragma unroll
            for (int n = 0; n < 2; ++n) { const int c = col0 + bj * HALF + n * 16; const f32x4 g4 = *(const f32x4*)(gate + c);
#pragma unroll
                for (int ai = 0; ai < 2; ++ai)
#pragma unroll
                    for (int m = 0; m < 4; ++m) { const size_t o = (size_t)(rl0 + ai * HALF + m * 16) * 1024 + c; *(f32x4*)(out + o) = *(const f32x4*)(base + o) + g4 * acc[ai][bj][m][n]; } }
    }
};
}

#include <hip/hip_bf16.h>
#include <cmath>
namespace attn_body {
using bf16=__hip_bfloat16;
using bf16x8=__attribute__((ext_vector_type(8)))short;
using s16x4=__attribute__((ext_vector_type(4)))short;
using f32x16=__attribute__((ext_vector_type(16)))float;
using u32x4=__attribute__((ext_vector_type(4)))unsigned;
constexpr int D=64,QP=512,KP=128,OP=1024;
constexpr int NW=8,QBLK=32,QB=QBLK*NW,KVBLK=64;
constexpr int ATTN_UNIT_ROWS=QB;
__device__ __forceinline__ int crow(int r,int hi){return (r&3)+8*(r>>2)+4*hi;}
#define SBAR() __builtin_amdgcn_sched_barrier(0)
__device__ __forceinline__ void cmask(f32x16&p0,f32x16&p1,int jb,int qrel,int hi){
  const float NEG=-INFINITY; int kb=64*jb+4*hi;
  #pragma unroll
  for(int r=0;r<16;++r){int kv=kb+(r&3)+8*(r>>2); if(kv>qrel)p0[r]=NEG; if(kv+32>qrel)p1[r]=NEG;}
}

constexpr int NSLOT=3, SLOTB=8192;
constexpr int LDS_K=0, LDS_V=NSLOT*SLOTB, LDS_WS=2*NSLOT*SLOTB, LDS_OST=LDS_WS+NW*64*4, LDS_BYTES=LDS_OST+NW*4096;
constexpr float C2=0.125f*1.4426950408889634f;
__device__ __forceinline__ void glds16(const void*gsrc,unsigned lds_dst){unsigned keep;
  asm volatile("s_mov_b32 %0, m0\n\ts_mov_b32 m0, %2\n\ts_nop 0\n\tglobal_load_lds_dwordx4 %1, off\n\ts_mov_b32 m0, %0":"=&s"(keep):"v"(gsrc),"s"(lds_dst):"memory");}
__device__ __forceinline__ float max3f(float a,float b,float c){float r;asm("v_max3_f32 %0, %1, %2, %3":"=v"(r):"v"(a),"v"(b),"v"(c));return r;}
__device__ __forceinline__ float max2f(float a,float b){float r;asm("v_max_f32_e32 %0, %1, %2":"=v"(r):"v"(a),"v"(b));return r;}
__device__ __forceinline__ float fadd_s(float a,float b){float r;asm("v_add_f32_e32 %0, %1, %2":"=v"(r):"v"(a),"v"(b));return r;}
__device__ __forceinline__ float fsub_s(float a,float b){float r;asm("v_sub_f32_e32 %0, %1, %2":"=v"(r):"v"(a),"v"(b));return r;}
typedef float f32x2_t __attribute__((ext_vector_type(2))); typedef __bf16 bf16x2_t __attribute__((ext_vector_type(2)));
__device__ __forceinline__ unsigned cvtpk_s(float lo,float hi){f32x2_t v={lo,hi};bf16x2_t b=__builtin_convertvector(v,bf16x2_t);return __builtin_bit_cast(unsigned,b);}
#define WAIT_BAR(N) asm volatile("s_waitcnt vmcnt(" #N ") lgkmcnt(0)\n\ts_barrier":::"memory")

__device__ __forceinline__ void qkt(f32x16&p0,f32x16&p1,const char*Kslot,const bf16x8*qr,const f32x16&negm,int r32,int hi){
  const char*kb=Kslot+hi*1024+r32*16;
  #pragma unroll
  for(int d0=0;d0<4;++d0){
    const bf16x8 b0=*reinterpret_cast<const bf16x8*>(kb+d0*2048);
    const bf16x8 b1=*reinterpret_cast<const bf16x8*>(kb+d0*2048+512);
    if(d0==0){p0=__builtin_amdgcn_mfma_f32_32x32x16_bf16(b0,qr[0],negm,0,0,0);p1=__builtin_amdgcn_mfma_f32_32x32x16_bf16(b1,qr[0],negm,0,0,0);}
    else{p0=__builtin_amdgcn_mfma_f32_32x32x16_bf16(b0,qr[d0],p0,0,0,0);p1=__builtin_amdgcn_mfma_f32_32x32x16_bf16(b1,qr[d0],p1,0,0,0);}}
}
typedef __attribute__((address_space(3))) const char* lds_cptr;
typedef short v4i16_t __attribute__((ext_vector_type(4)));
__device__ __forceinline__ void kload8(bf16x8*kf,lds_cptr kp){
  kf[0]=*(const __attribute__((address_space(3))) bf16x8*)(kp);      kf[1]=*(const __attribute__((address_space(3))) bf16x8*)(kp+512);
  kf[2]=*(const __attribute__((address_space(3))) bf16x8*)(kp+2048); kf[3]=*(const __attribute__((address_space(3))) bf16x8*)(kp+2560);
  kf[4]=*(const __attribute__((address_space(3))) bf16x8*)(kp+4096); kf[5]=*(const __attribute__((address_space(3))) bf16x8*)(kp+4608);
  kf[6]=*(const __attribute__((address_space(3))) bf16x8*)(kp+6144); kf[7]=*(const __attribute__((address_space(3))) bf16x8*)(kp+6656);
}
__device__ __forceinline__ void kload2(bf16x8*kf,lds_cptr kp,int j){ kf[2*j]=*(const __attribute__((address_space(3))) bf16x8*)(kp+j*2048); kf[2*j+1]=*(const __attribute__((address_space(3))) bf16x8*)(kp+j*2048+512); }
__device__ __forceinline__ s16x4 vtr(lds_cptr p){ return __builtin_bit_cast(s16x4,__builtin_amdgcn_ds_read_tr16_b64_v4i16((__attribute__((address_space(3))) v4i16_t*)p)); }
__device__ __forceinline__ float rowmax(const f32x16&p0,const f32x16&p1){
  float a=max3f(p0[0],p0[1],p1[0]),b=max3f(p0[2],p0[3],p1[1]);a=max3f(a,p1[2],p1[3]);
  #pragma unroll
  for(int r=4;r<16;r+=4){a=max3f(a,p0[r],p0[r+1]);b=max3f(b,p0[r+2],p0[r+3]);a=max3f(a,p1[r],p1[r+1]);b=max3f(b,p1[r+2],p1[r+3]);}
  const float m=max2f(a,b);
  auto rr=__builtin_amdgcn_permlane32_swap(__float_as_uint(m),__float_as_uint(m),false,false);
  return max2f(__uint_as_float(rr[0]),__uint_as_float(rr[1]));
}
__device__ __forceinline__ void pv(f32x16*o,int vb,bf16x8 pa0,bf16x8 pa1,bf16x8 pa2,bf16x8 pa3){
  #pragma unroll
  for(int d0=0;d0<2;++d0){s16x4 lo[4],hi[4];
    #pragma unroll
    for(int ks=0;ks<4;++ks){
      asm volatile("ds_read_b64_tr_b16 %0,%1 offset:%c2":"=&v"(lo[ks]):"v"(vb),"i"(d0*4096+ks*1024):"memory");
      asm volatile("ds_read_b64_tr_b16 %0,%1 offset:%c2":"=&v"(hi[ks]):"v"(vb),"i"(d0*4096+ks*1024+512):"memory");}
    asm volatile("s_waitcnt lgkmcnt(0)":::"memory");SBAR();
    #define PK(k) (bf16x8){lo[k][0],lo[k][1],lo[k][2],lo[k][3],hi[k][0],hi[k][1],hi[k][2],hi[k][3]}
    o[d0]=__builtin_amdgcn_mfma_f32_32x32x16_bf16(pa0,PK(0),o[d0],0,0,0);
    o[d0]=__builtin_amdgcn_mfma_f32_32x32x16_bf16(pa1,PK(1),o[d0],0,0,0);
    o[d0]=__builtin_amdgcn_mfma_f32_32x32x16_bf16(pa2,PK(2),o[d0],0,0,0);
    o[d0]=__builtin_amdgcn_mfma_f32_32x32x16_bf16(pa3,PK(3),o[d0],0,0,0);
    #undef PK
  }
}

#ifndef ATTN_STORE16
#define ATTN_STORE16(p,v) (*(u32x4*)(p)=(v))
#endif
template<int THRL> __device__ __forceinline__ void attn_unit(const bf16*Q0,const bf16*__restrict__ Kh,const bf16*__restrict__ Vh,bf16*O0,const int NT,char*shm){
  const int tid=threadIdx.x,lane=tid&63,r32=lane&31,hi=lane>>5; const int wid=__builtin_amdgcn_readfirstlane(tid>>6);
  const bf16*Qw=Q0+(long)(wid*QBLK)*QP;
  const unsigned lds0=(unsigned)(uintptr_t)shm;
  float*wsf=(float*)(shm+LDS_WS)+wid*64;
  const bf16*ksrc=Kh+(long)lane*KP+wid*8;
  const bf16*vsrc=Vh+(long)(16*(wid&3)+(lane>>2))*KP+(wid>>2)*32+(lane&3)*8;
  const unsigned kdst=lds0+LDS_K+wid*1024, vdst=lds0+LDS_V+wid*1024;
  #define DMA_K(t,slot) glds16(ksrc+(long)(t)*KVBLK*KP,(unsigned)__builtin_amdgcn_readfirstlane(kdst+(slot)))
  #define DMA_V(t,slot) glds16(vsrc+(long)(t)*KVBLK*KP,(unsigned)__builtin_amdgcn_readfirstlane(vdst+(slot)))
  const int vb0=(int)(lds0+LDS_V)+((lane>>4)&1)*32+(lane&3)*8+(4*hi+((lane&15)>>2))*64;
  const char*Kbase=shm+LDS_K; bf16x8 kf[8];
  const lds_cptr shm3=(lds_cptr)shm; const lds_cptr kp0=shm3+LDS_K+hi*1024+r32*16; const lds_cptr vp0=shm3+LDS_V+((lane>>4)&1)*32+(lane&3)*8+(4*hi+((lane&15)>>2))*64;
  DMA_K(0,0);DMA_V(0,0);DMA_K(1,SLOTB);
  bf16x8 qr[4];
  #pragma unroll
  for(int d0=0;d0<4;++d0)qr[d0]=*reinterpret_cast<const bf16x8*>(&Qw[(long)r32*QP+d0*16+hi*8]);
  float mhat=0.f,l_reg=0.f;f32x16 o[2];o[0]=f32x16{};o[1]=f32x16{};f32x16 negm=f32x16{};asm volatile("":"+v"(negm));
  #define CMASK(P0,P1,t) do{}while(0)
  bool resc=false;
  #define START(P0,P1) do{ const float rm=rowmax(P0,P1); resc=false; \
    { const float dl=rm; mhat=fadd_s(mhat,dl); \
      _Pragma("unroll") for(int r=0;r<16;++r){P0[r]=fsub_s(P0[r],dl);P1[r]=fsub_s(P1[r],dl);} \
      _Pragma("unroll") for(int r=0;r<16;++r)negm[r]=-mhat; asm volatile("":"+v"(negm)); } \
    _Pragma("unroll") for(int r=0;r<16;++r)P0[r]=__builtin_amdgcn_exp2f(P0[r]); }while(0)
  #define RESC() do{ if(resc){ asm volatile("s_waitcnt lgkmcnt(0)":::"memory"); \
      _Pragma("unroll") for(int d_=0;d_<2;++d_) _Pragma("unroll") for(int r=0;r<16;++r)o[d_][r]*=wsf[crow(r,hi)]; } }while(0)
  f32x16 pA0,pA1,pB0,pB1;
  int sl_prev=0,sl_cur=0,sl_next=SLOTB;
  #define ROT() do{sl_prev=sl_cur;sl_cur=sl_next;sl_next=(sl_next==(NSLOT-1)*SLOTB)?0:sl_next+SLOTB;}while(0)
  DMA_K(2,2*SLOTB);
  WAIT_BAR(3);
  qkt(pA0,pA1,Kbase,qr,negm,r32,hi);asm volatile("s_nop 15\n\ts_nop 7":"+v"(pA0),"+v"(pA1));CMASK(pA0,pA1,0);
  START(pA0,pA1);
  _Pragma("unroll") for(int r=0;r<16;++r)pA1[r]=__builtin_amdgcn_exp2f(pA1[r]);
  WAIT_BAR(0);
  DMA_K(3,0);DMA_V(1,SLOTB);
  ROT();
  kload8(kf,kp0+sl_cur);
  WAIT_BAR(2);
  s16x4 vlo[8],vhi[8]; u32x4 pw0,pw1,pw2,pw3;
  #define PKW(P,B) cvtpk_s(P[B],P[B+1])
  #define PAF(k) __builtin_bit_cast(bf16x8,pw##k)
  #define VFR(i) (bf16x8){vlo[i][0],vlo[i][1],vlo[i][2],vlo[i][3],vhi[i][0],vhi[i][1],vhi[i][2],vhi[i][3]}
  #define PIN(x) asm volatile("":"+v"(x))
  #define MX3(a,b,c) __builtin_fmaxf(__builtin_fmaxf((a),(b)),(c))
  #define GAPA(MF,A0,A1,A2,A3,W0,W1,PW) do{ MF; sacc+=A0; sacc+=A1; sacc+=A2; sacc+=A3; PIN(sacc); W0; W1; PIN(PW); SBAR(); }while(0)
  #define EX(v) __builtin_amdgcn_exp2f(v)
  #define GAPB(MF,X,B) do{ MF; X[B]=EX(X[B]); X[B+1]=EX(X[B+1]); X[B+2]=EX(X[B+2]); X[B+3]=EX(X[B+3]); PIN(X); SBAR(); }while(0)
  #define VRD(i) do{ vlo[i]=vtr(vp_+(((i)>>2)*4096+((i)&3)*1024)); vhi[i]=vtr(vp_+(((i)>>2)*4096+((i)&3)*1024+512)); }while(0)
  #define KRD(G,j) do{ if(G){ kload2(kf,kp0+sl_next,j); SBAR(); } }while(0)
  #define STEP(C0,C1,P0,P1,t,GK,GV,GL) do{ SBAR(); \
    const lds_cptr vp_=vp0+sl_prev; \
    VRD(0); SBAR(); float sacc=(P0[0]+P0[1]); \
    GAPA(C0=__builtin_amdgcn_mfma_f32_32x32x16_bf16(kf[0],qr[0],negm,0,0,0), P0[2],P0[3],P0[4],P0[5],     pw0[0]=PKW(P0,0), pw0[1]=PKW(P0,2), pw0); \
    VRD(4); SBAR(); GAPA(C1=__builtin_amdgcn_mfma_f32_32x32x16_bf16(kf[1],qr[0],negm,0,0,0), P0[6],P0[7],P0[8],P0[9],     pw0[2]=PKW(P0,4), pw0[3]=PKW(P0,6), pw0); \
    VRD(1); SBAR(); GAPA(C0=__builtin_amdgcn_mfma_f32_32x32x16_bf16(kf[2],qr[1],C0,0,0,0),   P0[10],P0[11],P0[12],P0[13], pw1[0]=PKW(P0,8), pw1[1]=PKW(P0,10), pw1); \
    VRD(5); SBAR(); GAPA(C1=__builtin_amdgcn_mfma_f32_32x32x16_bf16(kf[3],qr[1],C1,0,0,0),   P0[14],P0[15],P1[0],P1[1],   pw1[2]=PKW(P0,12),pw1[3]=PKW(P0,14), pw1); \
    VRD(2); SBAR(); GAPA(C0=__builtin_amdgcn_mfma_f32_32x32x16_bf16(kf[4],qr[2],C0,0,0,0),   P1[2],P1[3],P1[4],P1[5],     pw2[0]=PKW(P1,0), pw2[1]=PKW(P1,2), pw2); \
    VRD(6); SBAR(); GAPA(C1=__builtin_amdgcn_mfma_f32_32x32x16_bf16(kf[5],qr[2],C1,0,0,0),   P1[6],P1[7],P1[8],P1[9],     pw2[2]=PKW(P1,4), pw2[3]=PKW(P1,6), pw2); \
    VRD(3); SBAR(); GAPA(C0=__builtin_amdgcn_mfma_f32_32x32x16_bf16(kf[6],qr[3],C0,0,0,0),   P1[10],P1[11],P1[12],P1[13], pw3[0]=PKW(P1,8), pw3[1]=PKW(P1,10), pw3); \
    VRD(7); SBAR(); GAPA(C1=__builtin_amdgcn_mfma_f32_32x32x16_bf16(kf[7],qr[3],C1,0,0,0),   P1[14],P1[15],0.f,0.f,       pw3[2]=PKW(P1,12),pw3[3]=PKW(P1,14), pw3); \
    l_reg+=sacc; \
    if(GK){DMA_K((t)+3,sl_cur);} if(GV){DMA_V((t)+1,sl_next);} \
    CMASK(C0,C1,t); \
    { float a=MX3(C0[0],C0[1],C1[0]),b=MX3(C0[2],C0[3],C1[1]); a=MX3(a,C1[2],C1[3]); \
      _Pragma("unroll") for(int r=4;r<16;r+=4){a=MX3(a,C0[r],C0[r+1]);b=MX3(b,C0[r+2],C0[r+3]);a=MX3(a,C1[r],C1[r+1]);b=MX3(b,C1[r+2],C1[r+3]);} \
      float rm=__builtin_fmaxf(a,b); { auto rr=__builtin_amdgcn_permlane32_swap(__float_as_uint(rm),__float_as_uint(rm),false,false); rm=__builtin_fmaxf(__uint_as_float(rr[0]),__uint_as_float(rr[1])); } \
      resc=false; \
      if(__builtin_expect(__any(rm>(float)THRL),0)){ const float dl=__builtin_fmaxf(rm,0.f); mhat+=dl; \
        _Pragma("unroll") for(int r=0;r<16;++r){C0[r]-=dl;C1[r]-=dl;} \
        _Pragma("unroll") for(int r=0;r<16;++r)negm[r]=-mhat; asm volatile("":"+v"(negm)); \
        const float f=__builtin_amdgcn_exp2f(-dl); l_reg*=f; if(hi==0)wsf[r32]=f; resc=true; } } \
    SBAR(); \
    GAPB(o[0]=__builtin_amdgcn_mfma_f32_32x32x16_bf16(PAF(0),VFR(0),o[0],0,0,0), C0,0); \
    GAPB(o[1]=__builtin_amdgcn_mfma_f32_32x32x16_bf16(PAF(0),VFR(4),o[1],0,0,0), C0,4); \
    KRD(GL,0); GAPB(o[0]=__builtin_amdgcn_mfma_f32_32x32x16_bf16(PAF(1),VFR(1),o[0],0,0,0), C0,8); \
    KRD(GL,1); GAPB(o[1]=__builtin_amdgcn_mfma_f32_32x32x16_bf16(PAF(1),VFR(5),o[1],0,0,0), C0,12); \
    KRD(GL,2); GAPB(o[0]=__builtin_amdgcn_mfma_f32_32x32x16_bf16(PAF(2),VFR(2),o[0],0,0,0), C1,0); \
    KRD(GL,3); GAPB(o[1]=__builtin_amdgcn_mfma_f32_32x32x16_bf16(PAF(2),VFR(6),o[1],0,0,0), C1,4); \
    GAPB(o[0]=__builtin_amdgcn_mfma_f32_32x32x16_bf16(PAF(3),VFR(3),o[0],0,0,0), C1,8); \
    GAPB(o[1]=__builtin_amdgcn_mfma_f32_32x32x16_bf16(PAF(3),VFR(7),o[1],0,0,0), C1,12); \
    }while(0)
  int t=1;
  #undef CMASK
  #define CMASK(P0,P1,t) do{}while(0)
  for(;t+5<NT;t+=2){
    STEP(pB0,pB1,pA0,pA1,t,true,true,true);     WAIT_BAR(2); RESC(); ROT();
    STEP(pA0,pA1,pB0,pB1,t+1,true,true,true);   WAIT_BAR(2); RESC(); ROT();
  }
  #undef CMASK
  #define CMASK(P0,P1,t) do{}while(0)
  #define ENDW(tt) do{ if((tt)+3<NT){WAIT_BAR(2);} else if((tt)+2<NT){WAIT_BAR(1);} else {WAIT_BAR(0);} }while(0)
  for(;t+1<NT;t+=2){
    STEP(pB0,pB1,pA0,pA1,t,(t+3<NT),(t+1<NT),(t+1<NT));       ENDW(t);   RESC(); ROT();
    STEP(pA0,pA1,pB0,pB1,t+1,(t+4<NT),(t+2<NT),(t+2<NT));     ENDW(t+1); RESC(); ROT();
  }
  STEP(pB0,pB1,pA0,pA1,NT-1,false,false,false); RESC();
  { float sacc=pB0[0]+pB0[1]; _Pragma("unroll") for(int r=2;r<16;++r)sacc+=pB0[r]; _Pragma("unroll") for(int r=0;r<16;++r)sacc+=pB1[r]; l_reg+=sacc;
    pw0=(u32x4){PKW(pB0,0),PKW(pB0,2),PKW(pB0,4),PKW(pB0,6)};pw1=(u32x4){PKW(pB0,8),PKW(pB0,10),PKW(pB0,12),PKW(pB0,14)};pw2=(u32x4){PKW(pB1,0),PKW(pB1,2),PKW(pB1,4),PKW(pB1,6)};pw3=(u32x4){PKW(pB1,8),PKW(pB1,10),PKW(pB1,12),PKW(pB1,14)};
    SBAR(); pv(o,vb0+sl_cur,PAF(0),PAF(1),PAF(2),PAF(3)); }
  #undef PKW
  #undef PAF
  #undef VFR
  #undef PIN
  #undef MX3
  #undef GAPA
  #undef GAPB
  #undef EX
  #undef VRD
  #undef KRD
  #undef STEP
  #undef ENDW
  {auto rr=__builtin_amdgcn_permlane32_swap(__float_as_uint(l_reg),__float_as_uint(l_reg),false,false);l_reg=__uint_as_float(rr[0])+__uint_as_float(rr[1]);}
  if(hi==0)wsf[32+r32]=l_reg;asm volatile("s_waitcnt lgkmcnt(0)":::"memory");
  float rli[16];
  #pragma unroll
  for(int r=0;r<16;++r)rli[r]=__builtin_amdgcn_rcpf(wsf[32+crow(r,hi)]);
  bf16*Ow=O0+(long)(wid*QBLK)*OP;
  { bf16*stg=(bf16*)(shm+LDS_OST)+wid*2048;
    #pragma unroll
    for(int r=0;r<16;++r){const int orow=crow(r,hi);
      #pragma unroll
      for(int d0=0;d0<2;++d0)stg[orow*64+d0*32+r32]=__float2bfloat16(o[d0][r]*rli[r]);}
    asm volatile("s_waitcnt lgkmcnt(0)":::"memory");
    #pragma unroll
    for(int i=0;i<4;++i){const int row=i*8+(lane>>3),ch=lane&7; const u32x4 v=*(const u32x4*)(stg+row*64+ch*8); ATTN_STORE16(Ow+(long)row*OP+ch*8,v);} }
  asm volatile("s_waitcnt lgkmcnt(0)\n\ts_barrier":::"memory");
  #undef DMA_K
  #undef DMA_V
  #undef CMASK
  #undef START
  #undef RESC
  #undef ROT
}
constexpr int ATTN_LDS_BYTES=LDS_BYTES;
#undef SBAR
#undef WAIT_BAR
}

struct Params {
    const float* in[35];
    float* out;
    unsigned char* ws;
    int ph_lo, ph_hi;
};
enum { I_X = 0, I_C, I_CTX, I_CCTX, I_WMOD, I_BMOD, I_GMIX, I_GFFN, I_MIXWIN, I_MIXWOUT, I_QG, I_KG, I_LNG, I_WSP, I_BSP,
       I_S5WIN, I_ARE, I_AIM, I_LOGDT, I_BRE, I_BIM, I_CRE, I_CIM, I_S5D, I_WGLU, I_BGLU, I_S5WOUT,
       I_WGRP, I_BGRP, I_WRT, I_BRT, I_W1, I_W3, I_W2, I_FING };

struct Ctx {
    const Params* p;
    unsigned char* ws;
    LAS unsigned char* lds;
    int tid, lane, wave, gw, ngw;
};
__device__ __forceinline__ const float* xin_row(const Params& P, int r) { return r < TL ? P.in[I_X] + (size_t)r * D : P.in[I_CTX] + (size_t)(r - TL) * D; }
__device__ __forceinline__ int cond_of(int r) { return r < TL ? (r >> 11) : 16; }
__device__ __forceinline__ const float* mod_vec(const Ctx& C, int layer, int ci, int k) { return (const float*)(C.ws + WS_MOD) + ((size_t)(layer * 17 + ci) * 6 + k) * D; }

__device__ __forceinline__ void dsincos(double a, double& s, double& c) {
    const double TWO_PI_HI = 6.283185307179586, TWO_PI_LO = 2.4492935982947064e-16;
    const double k = rint(a * 0.15915494309189535);
    double r = fma(-k, TWO_PI_HI, a); r = fma(-k, TWO_PI_LO, r);
    const double r2 = r * r; double ct = 1.0, st = r, cs = 1.0, ss = r;
#pragma unroll 1
    for (int i = 1; i <= 15; ++i) { ct *= -r2 / (double)((2 * i - 1) * (2 * i)); cs += ct; st *= -r2 / (double)((2 * i) * (2 * i + 1)); ss += st; }
    s = ss; c = cs;
}

__device__ __forceinline__ void transpose_item(const float* src, int N, int k0, int n0, bf16* dst, int dpitch, LAS float* scr, int lane) {
#pragma unroll 8
    for (int i = 0; i < 32; ++i) { const int kk = 2 * i + (lane >> 5); scr[kk * 33 + (lane & 31)] = src[(size_t)(k0 + kk) * N + n0 + (lane & 31)]; }
    asm volatile("s_waitcnt lgkmcnt(0)" ::: "memory");
    const int c = lane & 7;
#pragma unroll
    for (int j = 0; j < 4; ++j) { const int n = (lane >> 3) + 8 * j; const LAS float* s = scr + (8 * c) * 33 + n;
        v4u o; o.x = pk2(s[0 * 33], s[1 * 33]); o.y = pk2(s[2 * 33], s[3 * 33]); o.z = pk2(s[4 * 33], s[5 * 33]); o.w = pk2(s[6 * 33], s[7 * 33]);
        *(v4u*)(dst + (size_t)n * dpitch + 8 * c) = o; }
    asm volatile("s_waitcnt lgkmcnt(0)" ::: "memory");
}
__device__ __forceinline__ void transpose_mat_item(const float* W, int K, int N, bf16* WT, int it, LAS float* scr, int lane) {
    const int nblk = N / 32, kb = it / nblk, nb = it % nblk;
    transpose_item(W, N, kb * 64, nb * 32, WT + (size_t)(nb * 32) * K + kb * 64, K, scr, lane);
}
constexpr int MOE_ITEMS = NEXP * 768;
__device__ __forceinline__ void moe_convert_item(const Ctx& C, int layer, int it, LAS float* scr) {
    const Params& P = *C.p;
    const int e = it / 768, r = it % 768, kind = r / 256, j = r % 256;
    if (kind < 2) {
        const float* src = (kind == 0 ? P.in[I_W1] : P.in[I_W3]) + ((size_t)layer * NEXP + e) * D * EH;
        const int kb = j / 16, nb = j % 16, k0 = kb * 64, n0 = nb * 32;
        const int drow = (n0 / 128) * 256 + (n0 % 128) + (kind == 1 ? 128 : 0);
        transpose_item(src, EH, k0, n0, (bf16*)(C.ws + WS_W13) + (size_t)e * 1024 * 1024 + (size_t)drow * 1024 + k0, 1024, scr, C.lane);
    } else {
        const float* src = P.in[I_W2] + ((size_t)layer * NEXP + e) * EH * D;
        const int kb = j / 32, nb = j % 32, k0 = kb * 64, n0 = nb * 32;
        transpose_item(src, D, k0, n0, (bf16*)(C.ws + WS_W2) + (size_t)e * 1024 * 512 + (size_t)n0 * 512 + k0, 512, scr, C.lane);
    }
}

__device__ __forceinline__ void phase_prologue(const Ctx& C) {
    const Params& P = *C.p;
    {
        LAS float* s = (LAS float*)C.lds;
        LAS float* red = (LAS float*)(C.lds + 17 * 1024 * 4);
        bool have_s = false;
        for (int u = blockIdx.x; u < 192; u += gridDim.x) {
            if (!have_s) {
                for (int i = C.tid; i < 17 * 1024; i += NTHR) { const int ci = i >> 10, k = i & 1023; const float v = ci < 16 ? P.in[I_C][ci * D + k] : P.in[I_CCTX][k]; s[i] = silu_(v); }
                have_s = true; __syncthreads();
            }
            const int layer = u / 96, jg = u % 96, kq = C.tid >> 6, jc = C.tid & 63;
            const float* w = P.in[I_WMOD] + (size_t)layer * D * 6144 + jg * 64 + jc;
            float acc[17];
#pragma unroll
            for (int i = 0; i < 17; ++i) acc[i] = 0.f;
            for (int k = kq * 128; k < kq * 128 + 128; ++k) { const float wv = w[(size_t)k * 6144];
#pragma unroll
                for (int i = 0; i < 17; ++i) acc[i] += s[i * 1024 + k] * wv; }
#pragma unroll
            for (int i = 0; i < 17; ++i) red[(kq * 17 + i) * 64 + jc] = acc[i];
            __syncthreads();
            for (int o = C.tid; o < 17 * 64; o += NTHR) { const int ci = o >> 6, c = o & 63; float v = 0.f;
#pragma unroll
                for (int q = 0; q < 8; ++q) v += red[(q * 17 + ci) * 64 + c];
                const int j = jg * 64 + c; v += P.in[I_BMOD][layer * 6144 + j];
                ((float*)(C.ws + WS_MOD))[((size_t)(layer * 17 + ci)) * 6144 + j] = v; }
            __syncthreads();
        }
        __syncthreads();
    }
    {
        const int gt = blockIdx.x * NTHR + C.tid, ngt = gridDim.x * NTHR;
        float2* rope = (float2*)(C.ws + WS_TAB + TAB_ROPE);
        for (int i = gt; i < 64 * 16; i += ngt) { const int pos = i >> 4, f = i & 15;
            const double th = exp(-(double)f * (9.210340371976184 / 16.0)); double s, c; dsincos((double)pos * th, s, c); rope[i] = make_float2((float)c, (float)s); }
        float2* lamb = (float2*)(C.ws + WS_TAB + TAB_LAMB); float2* bbar = (float2*)(C.ws + WS_TAB + TAB_BBAR);
        for (int i = gt; i < 2 * 32 * 64; i += ngt) {
            const int dg = i >> 6;
            const double are = P.in[I_ARE][i], aim = P.in[I_AIM][i], dt = exp((double)P.in[I_LOGDT][dg]);
            double s, c; dsincos(aim * dt, s, c); const double mag = exp(are * dt), lr = mag * c, li = mag * s;
            lamb[i] = make_float2((float)lr, (float)li);
            const double den = are * are + aim * aim, nr = lr - 1.0, ni = li;
            const double cr = (nr * are + ni * aim) / den, cim = (ni * are - nr * aim) / den;
            for (int p = 0; p < 16; ++p) { const double br = P.in[I_BRE][(size_t)i * 16 + p], bi = P.in[I_BIM][(size_t)i * 16 + p];
                bbar[(size_t)i * 16 + p] = make_float2((float)(cr * br - cim * bi), (float)(cr * bi + cim * br)); }
        }
    }
    {
        const int gt = blockIdx.x * NTHR + C.tid, ngt = gridDim.x * NTHR;
        bf16* wrt = (bf16*)(C.ws + WS_TAB + TAB_WR);
        for (int idx = gt; idx < 2 * 32 * 3 * 64; idx += ngt) {
            const int ln = idx & 63, jb = (idx >> 6) % 3, kk = (idx / 192) & 31, l = idx / (192 * 32);
            const int i = ln & 15, q = ln >> 4, grp = i >> 2, r = i & 3;
            float hi8[8], lo8[8];
#pragma unroll
            for (int e = 0; e < 8; ++e) { const int k = 32 * kk + 8 * q + e;
                const float w = jb < 2 ? P.in[I_WRT][((size_t)l * D + k) * 32 + grp * 8 + jb * 4 + r] : (r == 0 ? P.in[I_WGRP][((size_t)l * D + k) * 4 + grp] : 0.f);
                const float h = bf2f(f2bf(w)); hi8[e] = h; lo8[e] = w - h; }
            v4u oh, ol; oh.x = pk2(hi8[0], hi8[1]); oh.y = pk2(hi8[2], hi8[3]); oh.z = pk2(hi8[4], hi8[5]); oh.w = pk2(hi8[6], hi8[7]);
            ol.x = pk2(lo8[0], lo8[1]); ol.y = pk2(lo8[2], lo8[3]); ol.z = pk2(lo8[4], lo8[5]); ol.w = pk2(lo8[6], lo8[7]);
            const size_t base = ((((size_t)l * 32 + kk) * 3 + jb) * 2) * 64 + ln;
            *(v4u*)(wrt + base * 8) = oh; *(v4u*)(wrt + (base + 64) * 8) = ol;
        }
    }
    {
        const int gt = blockIdx.x * NTHR + C.tid, ngt = gridDim.x * NTHR; bf16* w16 = (bf16*)(C.ws + WS_WSP);
        for (int i = gt; i < 8 * 128 * 128 / 4; i += ngt) { const f32x4 v = *(const f32x4*)(P.in[I_WSP] + 4 * (size_t)i); v2u o; o.x = pk2(v.x, v.y); o.y = pk2(v.z, v.w); *(v2u*)(w16 + 4 * (size_t)i) = o; }
    }
    {
        LAS float* scr = (LAS float*)(C.lds + C.wave * 16384);
        constexpr int I0 = 16 * 56, I1 = 16 * 32, I2 = 16 * 16, I3 = 8 * 16, I4 = 8 * 32;
        constexpr int NSMALL = I0 + I1 + I2 + I3 + I4;
        for (int it = C.gw; it < NSMALL + MOE_ITEMS; it += C.ngw) {
            int r = it;
            if (r < I0) { transpose_mat_item(P.in[I_MIXWIN], D, MIXW, (bf16*)(C.ws + WS_WIN0), r, scr, C.lane); continue; } r -= I0;
            if (r < I1) { transpose_mat_item(P.in[I_MIXWOUT], D, D, (bf16*)(C.ws + WS_WOUT0), r, scr, C.lane); continue; } r -= I1;
            if (r < I2) { transpose_mat_item(P.in[I_S5WIN], D, 512, (bf16*)(C.ws + WS_WS5IN), r, scr, C.lane); continue; } r -= I2;
            if (r < I3) { transpose_mat_item(P.in[I_WGLU], 512, 512, (bf16*)(C.ws + WS_WGLU), r, scr, C.lane); continue; } r -= I3;
            if (r < I4) { transpose_mat_item(P.in[I_S5WOUT], 512, D, (bf16*)(C.ws + WS_WS5OUT), r, scr, C.lane); continue; } r -= I4;
            moe_convert_item(C, 0, r, scr);
        }
    }
}

__device__ __forceinline__ void load_row16(const float* row, int lane, f32x4 (&v)[4]) {
#pragma unroll
    for (int j = 0; j < 4; ++j) v[j] = *(const f32x4*)(row + 4 * lane + 256 * j);
}
__device__ __forceinline__ float row_rstd(const f32x4 (&v)[4]) {
    float s = 0.f;
#pragma unroll
    for (int j = 0; j < 4; ++j) s += (v[j].x * v[j].x + v[j].y * v[j].y) + (v[j].z * v[j].z + v[j].w * v[j].w);
    return rsqrtf(wave_sum(s) * (1.f / D) + EPS);
}
__device__ __forceinline__ void modulate16(f32x4 (&v)[4], float rstd, const float* g, const float* scale, const float* shift, int lane) {
#pragma unroll
    for (int j = 0; j < 4; ++j) { const int c = 4 * lane + 256 * j; const f32x4 gg = *(const f32x4*)(g + c), sc = *(const f32x4*)(scale + c), sh = *(const f32x4*)(shift + c);
        v[j] = v[j] * rstd * gg * (sc + 1.f) + sh; }
}
__device__ __forceinline__ void store_row16_bf16(bf16* row, int lane, const f32x4 (&v)[4]) {
#pragma unroll
    for (int j = 0; j < 4; ++j) { v2u o; o.x = pk2(v[j].x, v[j].y); o.y = pk2(v[j].z, v[j].w); *(v2u*)(row + 4 * lane + 256 * j) = o; }
}

__device__ __forceinline__ void phase_norm_mix0(const Ctx& C) {
    const Params& P = *C.p; bf16* H = (bf16*)(C.ws + WS_H);
    for (int r = C.gw; r < TT; r += C.ngw) {
        f32x4 v[4]; load_row16(xin_row(P, r), C.lane, v);
        const float rstd = row_rstd(v); const int ci = cond_of(r);
        modulate16(v, rstd, P.in[I_GMIX], mod_vec(C, 0, ci, 1), mod_vec(C, 0, ci, 0), C.lane);
        store_row16_bf16(H + (size_t)r * D, C.lane, v);
    }
}

template <class Epi>
__device__ __forceinline__ void ngemm_unit(const Ctx& C, const bf16* A0, const bf16* B0, int K, int row0, int pn, const Epi& epi) {
    LAS float* As = (LAS float*)C.lds;
    LAS float* Bs = (LAS float*)(C.lds + 32 * 68 * 4);
    const int tid = C.tid, ty = tid >> 4, tx = tid & 15;
    float acc[2][16];
#pragma unroll
    for (int i = 0; i < 2; ++i)
#pragma unroll
        for (int j = 0; j < 16; ++j) acc[i][j] = 0.f;
    const int ar = tid >> 3, ak = (tid & 7) * 4, bn = tid >> 1, bk = (tid & 1) * 16;
    for (int k0 = 0; k0 < K; k0 += 32) {
        const v2u av = *(const v2u*)(A0 + (size_t)ar * K + k0 + ak);
        const v4u b0 = *(const v4u*)(B0 + (size_t)bn * K + k0 + bk), b1 = *(const v4u*)(B0 + (size_t)bn * K + k0 + bk + 8);
        __syncthreads();
        As[(ak + 0) * 68 + ar] = bf2f(av.x & 0xffffu); As[(ak + 1) * 68 + ar] = bf2f(av.x >> 16); As[(ak + 2) * 68 + ar] = bf2f(av.y & 0xffffu); As[(ak + 3) * 68 + ar] = bf2f(av.y >> 16);
        float bf[16]; unpack8(b0, bf); unpack8(b1, bf + 8);
#pragma unroll
        for (int i = 0; i < 16; ++i) Bs[(bk + i) * 260 + bn] = bf[i];
        __syncthreads();
#pragma unroll 4
        for (int k = 0; k < 32; ++k) {
            const float a0 = As[k * 68 + ty * 2], a1 = As[k * 68 + ty * 2 + 1];
            const f32x4 x0 = *(const LAS f32x4*)(Bs + k * 260 + tx * 8), x1 = *(const LAS f32x4*)(Bs + k * 260 + tx * 8 + 4);
            const f32x4 y0 = *(const LAS f32x4*)(Bs + k * 260 + 128 + tx * 8), y1 = *(const LAS f32x4*)(Bs + k * 260 + 128 + tx * 8 + 4);
            const float bb[16] = {x0.x, x0.y, x0.z, x0.w, x1.x, x1.y, x1.z, x1.w, y0.x, y0.y, y0.z, y0.w, y1.x, y1.y, y1.z, y1.w};
#pragma unroll
            for (int j = 0; j < 16; ++j) { acc[0][j] += a0 * bb[j]; acc[1][j] += a1 * bb[j]; }
        }
    }
#pragma unroll
    for (int i = 0; i < 2; ++i)
#pragma unroll
        for (int j = 0; j < 8; ++j) epi(row0 + ty * 2 + i, pn, tx * 8 + j, acc[i][j], acc[i][8 + j]);
    __syncthreads();
}
template <class Epi>
__device__ __forceinline__ void ngemm_dense(const Ctx& C, const bf16* A, const bf16* Bt, int M, int N, int K, const Epi& epi) {
    const int nN = N / 256, nU = (M / 64) * nN;
    for (int u = blockIdx.x; u < nU; u += gridDim.x) { const int tm = u / nN, pn = u % nN;
        ngemm_unit(C, A + (size_t)tm * 64 * K, Bt + (size_t)pn * 256 * K, K, tm * 64, pn, epi); }
}
template <class Epi>
__device__ __forceinline__ void ngemm_grouped(const Ctx& C, const bf16* A, const bf16* Bt, size_t estride, int N, int K, const Epi& epi) {
    const int* tile_e = (const int*)(C.ws + WS_ROUTE + RT_TILE); const int ntiles = *(const int*)(C.ws + WS_ROUTE + RT_NT);
    const int nN = N / 256, nU = ntiles * 4 * nN;
    for (int u = blockIdx.x; u < nU; u += gridDim.x) { const int pn = u % nN, tm = u / nN, e = tile_e[tm >> 2];
        ngemm_unit(C, A + (size_t)tm * 64 * K, Bt + (size_t)e * estride + (size_t)pn * 256 * K, K, tm * 64, pn, epi); }
}

struct EpiStoreBf16 { bf16* O; int ldc;
    __device__ __forceinline__ void operator()(int r, int pn, int c, float v0, float v1) const { bf16* o = O + (size_t)r * ldc + pn * 256 + c; o[0] = (bf16)f2bf(v0); o[128] = (bf16)f2bf(v1); } };
struct EpiResid0 { const Params* P; const float* mod; float* XC;
    __device__ __forceinline__ void operator()(int r, int pn, int c, float v0, float v1) const { const int n = pn * 256 + c; const float* xi = xin_row(*P, r); const float* g = mod + ((size_t)cond_of(r) * 6 + 2) * D;
        float* o = XC + (size_t)r * D; o[n] = xi[n] + g[n] * v0; o[n + 128] = xi[n + 128] + g[n + 128] * v1; } };
struct EpiResidAcc { const float* mod; float* XC;
    __device__ __forceinline__ void operator()(int r, int pn, int c, float v0, float v1) const { const int n = pn * 256 + c; const float* g = mod + ((size_t)cond_of(r) * 6 + 2) * D;
        float* o = XC + (size_t)r * D; o[n] += g[n] * v0; o[n + 128] += g[n + 128] * v1; } };
struct EpiSwiglu { bf16* G;
    __device__ __forceinline__ void operator()(int r, int pn, int c, float v0, float v1) const { G[(size_t)r * EH + pn * 128 + c] = (bf16)f2bf(silu_(v0) * v1); } };
struct EpiGlu { const bf16* GS; const float* b; bf16* GG;
    __device__ __forceinline__ void operator()(int r, int pn, int c, float v0, float v1) const { const int n = pn * 256 + c; const size_t o = (size_t)r * 512 + n;
        GG[o] = (bf16)f2bf(bf2f(GS[o]) * sigmoidf_(v0 + b[n])); GG[o + 128] = (bf16)f2bf(bf2f(GS[o + 128]) * sigmoidf_(v1 + b[n + 128])); } };

__device__ __forceinline__ void qk_norm_rope(float (&v)[8], const float* gain, bool lat, int t, int lane, const float2* rope) {
    float ss = 0.f;
#pragma unroll
    for (int j = 0; j < 8; ++j) ss += v[j] * v[j];
    ss += __shfl_xor(ss, 1); ss += __shfl_xor(ss, 2); ss += __shfl_xor(ss, 4);
    const float rstd = rsqrtf(ss * (1.f / 64.f) + EPS);
    const int l8 = lane & 7;
#pragma unroll
    for (int j = 0; j < 8; ++j) v[j] = v[j] * rstd * gain[l8 * 8 + j];
    const int quarter = l8 >> 1, pos = (quarter < 2) ? (t >> 6) : (t & 63);
#pragma unroll
    for (int j = 0; j < 8; ++j) {
        const float pv = __shfl_xor(v[j], 2);
        if (lat) { const float2 cs = rope[pos * 16 + (lane & 1) * 8 + j];
            v[j] = (quarter & 1) ? (v[j] * cs.x + pv * cs.y) : (v[j] * cs.x - pv * cs.y); }
    }
}
__device__ __forceinline__ void phase_qkprep(const Ctx& C) {
    const Params& P = *C.p; const bf16* Pb = (const bf16*)(C.ws + WS_P); bf16* Q = (bf16*)(C.ws + WS_Q); bf16* Kb = (bf16*)(C.ws + WS_K); bf16* Vb = (bf16*)(C.ws + WS_V);
    const float2* rope = (const float2*)(C.ws + WS_TAB + TAB_ROPE);
    for (int r = C.gw; r < TT; r += C.ngw) {
        const bool lat = r < TL; const int t = lat ? (r & 2047) : 0;
        const size_t kvrow = lat ? (size_t)(r >> 11) * KVL + CTXL + (r & 2047) : (size_t)((r - TL) >> 8) * KVL + ((r - TL) & 255);
        const bf16* pr = Pb + (size_t)r * MIXW;
        { float v[8]; unpack8(*(const v4u*)(pr + 8 * C.lane), v); qk_norm_rope(v, P.in[I_QG], lat, t, C.lane, rope);
          v4u o; o.x = pk2(v[0] * QSCALE, v[1] * QSCALE); o.y = pk2(v[2] * QSCALE, v[3] * QSCALE); o.z = pk2(v[4] * QSCALE, v[5] * QSCALE); o.w = pk2(v[6] * QSCALE, v[7] * QSCALE);
          *(v4u*)(Q + (size_t)r * 512 + 8 * C.lane) = o; }
        { const int l = C.lane & 15; float v[8]; unpack8(*(const v4u*)(pr + 512 + 8 * l), v); qk_norm_rope(v, P.in[I_KG], lat, t, C.lane, rope);
          if (C.lane < 16) { v4u o; o.x = pk2(v[0], v[1]); o.y = pk2(v[2], v[3]); o.z = pk2(v[4], v[5]); o.w = pk2(v[6], v[7]); *(v4u*)(Kb + kvrow * 128 + 8 * l) = o;
              *(v4u*)(Vb + kvrow * 128 + 8 * l) = *(const v4u*)(pr + 640 + 8 * l); } }
        { float v[8]; unpack8(*(const v4u*)(pr + 1280 + 8 * C.lane), v); float sm = 0.f;
#pragma unroll
          for (int j = 0; j < 8; ++j) { v[j] = gelu_tanh(v[j]); sm += v[j]; }
          const float mean = wave_sum(sm) * (1.f / 512.f); float qq = 0.f;
#pragma unroll
          for (int j = 0; j < 8; ++j) { const float d = v[j] - mean; qq += d * d; }
          const float rstd = rsqrtf(wave_sum(qq) * (1.f / 512.f) + EPS);
          if (C.lane == 0) ((float2*)(C.ws + WS_ROUTE + RT_S))[r] = make_float2(mean, rstd); }
    }
}

__device__ __forceinline__ void phase_gmlp(const Ctx& C) {
    const Params& P = *C.p; const bf16* Pb = (const bf16*)(C.ws + WS_P); bf16* OG = (bf16*)(C.ws + WS_H);
    LAS bf16* VN = (LAS bf16*)C.lds; constexpr int VP = 520;
    const int g = __builtin_amdgcn_readfirstlane(C.tid >> 6);
    for (int ch = blockIdx.x; ch < TT / 128; ch += gridDim.x) {
        for (int i = 0; i < 16; ++i) { const int rl = C.wave * 16 + i; const bf16* pr = Pb + (size_t)(ch * 128 + rl) * MIXW + 1280 + 8 * C.lane;
            float v[8]; unpack8(*(const v4u*)pr, v); float s = 0.f;
#pragma unroll
            for (int j = 0; j < 8; ++j) { v[j] = gelu_tanh(v[j]); s += v[j]; }
            const float mean = wave_sum(s) * (1.f / 512.f); float q = 0.f;
#pragma unroll
            for (int j = 0; j < 8; ++j) { v[j] -= mean; q += v[j] * v[j]; }
            const float rstd = rsqrtf(wave_sum(q) * (1.f / 512.f) + EPS);
#pragma unroll
            for (int j = 0; j < 8; ++j) v[j] = v[j] * rstd * P.in[I_LNG][8 * C.lane + j];
            v4u o; o.x = pk2(v[0], v[1]); o.y = pk2(v[2], v[3]); o.z = pk2(v[4], v[5]); o.w = pk2(v[6], v[7]);
            *(LAS v4u*)(VN + rl * VP + 8 * C.lane) = o; }
        __syncthreads();
        const float* wsp = P.in[I_WSP] + (size_t)g * 128 * 128; const float* bsp = P.in[I_BSP] + g * 128;
        for (int pb = 0; pb < 16; ++pb) {
            float acc[8];
#pragma unroll
            for (int i = 0; i < 8; ++i) acc[i] = 0.f;
            for (int q = 0; q < 128; ++q) { const float v = bf2f(VN[q * VP + C.tid]);
#pragma unroll
                for (int i = 0; i < 8; ++i) acc[i] += wsp[(pb * 8 + i) * 128 + q] * v; }
#pragma unroll
            for (int i = 0; i < 8; ++i) { const int p = pb * 8 + i; const size_t row = (size_t)ch * 128 + p;
                const float u = gelu_tanh(bf2f(Pb[row * MIXW + 768 + C.tid]));
                OG[row * D + 512 + C.tid] = (bf16)f2bf(u * (acc[i] + bsp[p])); }
        }
        __syncthreads();
    }
}


__device__ __forceinline__ unsigned gm_off_b(unsigned row, unsigned ch) { return 256u * row + 16u * (ch ^ (((row & 3u) << 2) | ((row >> 2) & 3u))); }
__device__ __forceinline__ void phase_gmlp_fast(const Ctx& C) {
    typedef short bf16x8 __attribute__((ext_vector_type(8)));
    typedef short s16x4 __attribute__((ext_vector_type(4)));
    typedef float f32x16 __attribute__((ext_vector_type(16)));
    const Params& P = *C.p; const bf16* Pb = (const bf16*)(C.ws + WS_P); bf16* OG = (bf16*)(C.ws + WS_H); const bf16* W16 = (const bf16*)(C.ws + WS_WSP);
    const float2* lns = (const float2*)(C.ws + WS_ROUTE + RT_S);
    const int tid = C.tid, lane = C.lane, w = C.wave, l31 = lane & 31, hi = lane >> 5;
    const int gsel = w >> 2, pb = w & 3;
    for (int u = blockIdx.x; u < (TT / 128) * 4; u += gridDim.x) {
        const int ch_ = u >> 2, gp = u & 3;
        { const int row = tid >> 2; const size_t grow = (size_t)ch_ * 128 + row; const float2 st = lns[grow];
#pragma unroll
          for (int i = 0; i < 4; ++i) { const int c16 = (tid & 3) + 4 * i; float v[8]; unpack8(*(const v4u*)(Pb + grow * MIXW + 1280 + 128 * gp + 8 * c16), v);
              const float* lg = P.in[I_LNG] + 128 * gp + 8 * c16;
#pragma unroll
              for (int j = 0; j < 8; ++j) v[j] = (gelu_tanh(v[j]) - st.x) * st.y * lg[j];
              v4u o; o.x = pk2(v[0], v[1]); o.y = pk2(v[2], v[3]); o.z = pk2(v[4], v[5]); o.w = pk2(v[6], v[7]);
              *(LAS v4u*)(C.lds + (row >> 5) * 8192 + gm_off_b(row & 31, c16)) = o; } }
        __syncthreads();
        const int g = 2 * gp + gsel;
        f32x16 acc[2]; acc[0] = f32x16{}; acc[1] = f32x16{};
        const bf16* wrow = W16 + ((size_t)g * 128 + 32 * pb + l31) * 128 + 8 * hi;
#pragma unroll
        for (int k8 = 0; k8 < 8; ++k8) {
            const bf16x8 xf = *(const bf16x8*)(wrow + 16 * k8);
            const unsigned rb = k8 >> 1, ks = k8 & 1;
#pragma unroll
            for (int db = 0; db < 2; ++db) { const unsigned c = 2 * gsel + db, blk = (lane >> 4) & 1, q = (lane & 15) >> 2, p2 = lane & 3;
                s16x4 t0, t1;
                { const unsigned a0 = rb * 8192 + gm_off_b(16 * ks + 8 * hi + q, 4 * c + 2 * blk + (p2 >> 1)) + 8 * (p2 & 1);
                  const unsigned a1 = rb * 8192 + gm_off_b(16 * ks + 8 * hi + 4 + q, 4 * c + 2 * blk + (p2 >> 1)) + 8 * (p2 & 1);
                  t0 = __builtin_bit_cast(s16x4, __builtin_amdgcn_ds_read_tr16_b64_v4i16((LAS s16x4*)(C.lds + a0)));
                  t1 = __builtin_bit_cast(s16x4, __builtin_amdgcn_ds_read_tr16_b64_v4i16((LAS s16x4*)(C.lds + a1))); }
                const bf16x8 yf = {t0[0], t0[1], t0[2], t0[3], t1[0], t1[1], t1[2], t1[3]};
                acc[db] = __builtin_amdgcn_mfma_f32_32x32x16_bf16(xf, yf, acc[db], 0, 0, 0); }
        }
        const float* bsp = P.in[I_BSP] + g * 128 + 32 * pb;
#pragma unroll
        for (int r = 0; r < 16; ++r) { const int pl = (r & 3) + 8 * (r >> 2) + 4 * hi; const size_t grow = (size_t)ch_ * 128 + 32 * pb + pl; const float bb = bsp[pl];
#pragma unroll
            for (int db = 0; db < 2; ++db) { const int col = 64 * g + 32 * db + l31; const float uu = gelu_tanh(bf2f(Pb[grow * MIXW + 768 + col]));
                OG[grow * D + 512 + col] = (bf16)f2bf(uu * (acc[db][r] + bb)); } }
        __syncthreads();
    }
}

__device__ __forceinline__ void attn_item(const Ctx& C, int b, int h, int qrow_g, int nk) {
    const bf16* Q = (const bf16*)(C.ws + WS_Q); const bf16* Kb = (const bf16*)(C.ws + WS_K) + (size_t)b * KVL * 128 + (h >> 2) * 64; const bf16* Vb = (const bf16*)(C.ws + WS_V) + (size_t)b * KVL * 128 + (h >> 2) * 64;
    bf16* OG = (bf16*)(C.ws + WS_H);
    float q[64];
#pragma unroll
    for (int i = 0; i < 8; ++i) unpack8(*(const v4u*)(Q + (size_t)qrow_g * 512 + h * 64 + 8 * i), q + 8 * i);
    float m = -INFINITY, l = 0.f, o = 0.f;
    for (int kt = 0; kt < nk; kt += 64) {
        const bf16* kr = Kb + (size_t)(kt + C.lane) * 128; float s = 0.f;
#pragma unroll
        for (int i = 0; i < 8; ++i) { float kf[8]; unpack8(*(const v4u*)(kr + 8 * i), kf);
#pragma unroll
            for (int j = 0; j < 8; ++j) s += q[8 * i + j] * kf[j]; }
        const float mn = fmaxf(m, wave_max(s)); const float p = exp2f(s - mn), corr = exp2f(m - mn);
        l = l * corr + wave_sum(p); o *= corr; m = mn;
#pragma unroll 8
        for (int jj = 0; jj < 64; ++jj) { const float pj = __shfl(p, jj); o += pj * bf2f(Vb[(size_t)(kt + jj) * 128 + C.lane]); }
    }
    OG[(size_t)qrow_g * D + h * 64 + C.lane] = (bf16)f2bf(o / l);
}
__device__ __forceinline__ void phase_attn(const Ctx& C) {
    for (int it = C.gw; it < NB * 8 * SEQ; it += C.ngw) { const int bh = it >> 11, t = it & 2047, b = bh >> 3, h = bh & 7; attn_item(C, b, h, b * SEQ + t, KVL); }
    for (int it = C.gw; it < NB * 8 * CTXL; it += C.ngw) { const int bh = it >> 8, t = it & 255, b = bh >> 3, h = bh & 7; attn_item(C, b, h, TL + b * CTXL + t, CTXL); }
}


__device__ __forceinline__ void phase_attn_fast(const Ctx& C, char* lds_generic) {
    typedef attn_body::bf16 abf;
    const abf* Q = (const abf*)(C.ws + WS_Q); const abf* Kb = (const abf*)(C.ws + WS_K); const abf* Vb = (const abf*)(C.ws + WS_V); abf* OG = (abf*)(C.ws + WS_H);
    const int G = gridDim.x, bx = blockIdx.x; const int vcu = (G % 8 == 0) ? (bx % 8) * (G / 8) + bx / 8 : bx;
    const int per = (1024 + G - 1) / G, perc = (128 + G - 1) / G;
    for (int i = 0; i < per + perc; ++i) {
        int b, h, nt; size_t qrow;
        if (i < per) { const int u = vcu * per + i; if (u >= 1024) continue; const int qb = u & 7, hg = (u >> 3) & 3, bk = u >> 5; b = bk >> 1; h = (bk & 1) * 4 + hg; qrow = (size_t)b * SEQ + qb * 256; nt = KVL / 64; }
        else { const int u = vcu + (i - per) * G; if (u >= 128) continue; b = u >> 3; h = u & 7; qrow = (size_t)TL + (size_t)b * CTXL; nt = CTXL / 64; }
        const size_t kvo = (size_t)b * KVL * 128 + (h >> 2) * 64;
        attn_body::attn_unit<8>(Q + qrow * 512 + h * 64, Kb + kvo, Vb + kvo, OG + qrow * 1024 + h * 64, nt, lds_generic);
    }
}

__device__ __forceinline__ void phase_norm_ffn_router(const Ctx& C, int layer, int nrows) {
    const Params& P = *C.p; const float* XC = (const float*)(C.ws + WS_XC); bf16* F = (bf16*)(C.ws + WS_H);
    int* asg_e = (int*)(C.ws + WS_ROUTE + RT_E); int* asg_p = (int*)(C.ws + WS_ROUTE + RT_P); float* asg_w = (float*)(C.ws + WS_ROUTE + RT_W);
    unsigned* cnt = (unsigned*)(C.ws + WS_CTL) + CW_CNT + 64 * layer;
    const float* wg = P.in[I_WGRP] + (size_t)layer * D * 4; const float* wr = P.in[I_WRT] + (size_t)layer * D * 32;
    for (int r = C.gw; r < nrows; r += C.ngw) {
        f32x4 v[4]; load_row16(XC + (size_t)r * D, C.lane, v);
        const float rstd = row_rstd(v); const int ci = cond_of(r);
        modulate16(v, rstd, P.in[I_GFFN] + layer * D, mod_vec(C, layer, ci, 4), mod_vec(C, layer, ci, 3), C.lane);
        store_row16_bf16(F + (size_t)r * D, C.lane, v);
        float lg[4] = {0.f, 0.f, 0.f, 0.f}; float le[32];
#pragma unroll
        for (int i = 0; i < 32; ++i) le[i] = 0.f;
#pragma unroll
        for (int j = 0; j < 4; ++j)
#pragma unroll
            for (int i = 0; i < 4; ++i) { const int c = 4 * C.lane + 256 * j + i; const float f = v[j][i];
                const f32x4 g4 = *(const f32x4*)(wg + (size_t)c * 4); lg[0] += f * g4.x; lg[1] += f * g4.y; lg[2] += f * g4.z; lg[3] += f * g4.w;
#pragma unroll
                for (int e4 = 0; e4 < 8; ++e4) { const f32x4 w4 = *(const f32x4*)(wr + (size_t)c * 32 + e4 * 4); le[e4 * 4] += f * w4.x; le[e4 * 4 + 1] += f * w4.y; le[e4 * 4 + 2] += f * w4.z; le[e4 * 4 + 3] += f * w4.w; } }
#pragma unroll
        for (int i = 0; i < 4; ++i) lg[i] = wave_sum(lg[i]) + P.in[I_BGRP][layer * 4 + i];
#pragma unroll
        for (int i = 0; i < 32; ++i) le[i] = wave_sum(le[i]) + P.in[I_BRT][layer * 32 + i];
        int gi = 0; float gm = lg[0];
#pragma unroll
        for (int i = 1; i < 4; ++i) if (lg[i] > gm) { gm = lg[i]; gi = i; }
        float den = 0.f;
#pragma unroll
        for (int i = 0; i < 4; ++i) den += __expf(lg[i] - gm);
        const float gw_ = 1.f / den;
        float sel[8];
#pragma unroll
        for (int i = 0; i < 8; ++i) sel[i] = gi == 0 ? le[i] : gi == 1 ? le[8 + i] : gi == 2 ? le[16 + i] : le[24 + i];
        int i0 = 0; float v0 = sel[0];
#pragma unroll
        for (int i = 1; i < 8; ++i) if (sel[i] > v0) { v0 = sel[i]; i0 = i; }
        int i1 = -1; float v1 = -INFINITY;
#pragma unroll
        for (int i = 0; i < 8; ++i) if (i != i0 && sel[i] > v1) { v1 = sel[i]; i1 = i; }
        const float e1 = __expf(v1 - v0), w0 = gw_ / (1.f + e1), w1 = gw_ * e1 / (1.f + e1);
        if (C.lane == 0) {
            const int ea = gi * 8 + i0, eb = gi * 8 + i1;
            const unsigned pa = __hip_atomic_fetch_add(cnt + ea, 1u, __ATOMIC_RELAXED, __HIP_MEMORY_SCOPE_AGENT);
            const unsigned pb = __hip_atomic_fetch_add(cnt + eb, 1u, __ATOMIC_RELAXED, __HIP_MEMORY_SCOPE_AGENT);
            asg_e[2 * r] = ea; asg_e[2 * r + 1] = eb; asg_p[2 * r] = (int)pa; asg_p[2 * r + 1] = (int)pb; asg_w[2 * r] = w0; asg_w[2 * r + 1] = w1;
        }
    }
}

__device__ __forceinline__ void phase_router_fast(const Ctx& C, int layer, int nrows) {
    typedef short bf16x8 __attribute__((ext_vector_type(8)));
    const Params& P = *C.p; const float* XC = (const float*)(C.ws + WS_XC); bf16* F = (bf16*)(C.ws + WS_H);
    int* asg_e = (int*)(C.ws + WS_ROUTE + RT_E); int* asg_p = (int*)(C.ws + WS_ROUTE + RT_P); float* asg_w = (float*)(C.ws + WS_ROUTE + RT_W); int* list = (int*)(C.ws + WS_LIST);
    unsigned* cnt = (unsigned*)(C.ws + WS_CTL) + CW_CNT + 64 * layer;
    const bf16x8* WR = (const bf16x8*)(C.ws + WS_TAB + TAB_WR) + (size_t)layer * (32 * 3 * 2 * 64) + C.lane;
    const int l15 = C.lane & 15, q4 = C.lane >> 4;
    const float* gg = P.in[I_GFFN] + layer * D + 8 * q4;
    for (int it = C.gw; it < nrows / 16; it += C.ngw) {
        const int row = it * 16 + l15, ci = cond_of(it * 16);
        const float* xr = XC + (size_t)row * D + 8 * q4; const float* sc = mod_vec(C, layer, ci, 4) + 8 * q4; const float* sh = mod_vec(C, layer, ci, 3) + 8 * q4;
        float ss = 0.f;
#pragma unroll 8
        for (int kk = 0; kk < 32; ++kk) { const f32x4 a = *(const f32x4*)(xr + 32 * kk), b = *(const f32x4*)(xr + 32 * kk + 4); ss += (a.x * a.x + a.y * a.y) + (a.z * a.z + a.w * a.w) + (b.x * b.x + b.y * b.y) + (b.z * b.z + b.w * b.w); }
        ss += __shfl_xor(ss, 16); ss += __shfl_xor(ss, 32);
        const float rstd = rsqrtf(ss * (1.f / D) + EPS);
        f32x4 acc[3]; acc[0] = (f32x4){0.f, 0.f, 0.f, 0.f}; acc[1] = acc[0]; acc[2] = acc[0];
        bf16* frow = F + (size_t)row * D + 8 * q4;
#pragma unroll 2
        for (int kk = 0; kk < 32; ++kk) {
            const int c = 32 * kk;
            f32x4 f0 = *(const f32x4*)(xr + c) * rstd * *(const f32x4*)(gg + c) * (*(const f32x4*)(sc + c) + 1.f) + *(const f32x4*)(sh + c);
            f32x4 f1 = *(const f32x4*)(xr + c + 4) * rstd * *(const f32x4*)(gg + c + 4) * (*(const f32x4*)(sc + c + 4) + 1.f) + *(const f32x4*)(sh + c + 4);
            const pg8::u32x4 fh = pg8::pack8(f0, f1); *(pg8::u32x4*)(frow + c) = fh;
            pg8::f32x4 r0, r1; pg8::unpack8f(fh, r0, r1);
            const pg8::u32x4 fl = pg8::pack8(f0 - r0, f1 - r1);
            const bf16x8 ah = __builtin_bit_cast(bf16x8, fh), al = __builtin_bit_cast(bf16x8, fl);
#pragma unroll
            for (int jb = 0; jb < 3; ++jb) { const bf16x8 wh = WR[((kk * 3 + jb) * 2) * 64], wl = WR[((kk * 3 + jb) * 2 + 1) * 64];
                acc[jb] = __builtin_amdgcn_mfma_f32_16x16x32_bf16(wh, ah, acc[jb], 0, 0, 0);
                acc[jb] = __builtin_amdgcn_mfma_f32_16x16x32_bf16(wh, al, acc[jb], 0, 0, 0);
                acc[jb] = __builtin_amdgcn_mfma_f32_16x16x32_bf16(wl, ah, acc[jb], 0, 0, 0); }
        }
        const float* brt = P.in[I_BRT] + layer * 32 + q4 * 8;
        float e[8];
#pragma unroll
        for (int r = 0; r < 4; ++r) { e[r] = acc[0][r] + brt[r]; e[4 + r] = acc[1][r] + brt[4 + r]; }
        const float gl = acc[2][0] + P.in[I_BGRP][layer * 4 + q4];
        float gm = gl; int gi = q4;
#pragma unroll
        for (int st = 16; st <= 32; st <<= 1) { const float og = __shfl_xor(gm, st); const int oi = __shfl_xor(gi, st); if (og > gm || (og == gm && oi < gi)) { gm = og; gi = oi; } }
        float den = __expf(gl - gm); den += __shfl_xor(den, 16); den += __shfl_xor(den, 32);
        if (q4 == gi) {
            const float gw_ = 1.f / den;
            int i0 = 0; float v0 = e[0];
#pragma unroll
            for (int i = 1; i < 8; ++i) if (e[i] > v0) { v0 = e[i]; i0 = i; }
            int i1 = -1; float v1 = -INFINITY;
#pragma unroll
            for (int i = 0; i < 8; ++i) if (i != i0 && e[i] > v1) { v1 = e[i]; i1 = i; }
            const float e1 = __expf(v1 - v0), w0 = gw_ / (1.f + e1), w1 = gw_ * e1 / (1.f + e1);
            const int ea = gi * 8 + i0, eb = gi * 8 + i1;
            const unsigned pa = __hip_atomic_fetch_add(cnt + ea, 1u, __ATOMIC_RELAXED, __HIP_MEMORY_SCOPE_AGENT);
            const unsigned pb = __hip_atomic_fetch_add(cnt + eb, 1u, __ATOMIC_RELAXED, __HIP_MEMORY_SCOPE_AGENT);
            asg_e[2 * row] = ea; asg_e[2 * row + 1] = eb; asg_p[2 * row] = (int)pa; asg_p[2 * row + 1] = (int)pb; asg_w[2 * row] = w0; asg_w[2 * row + 1] = w1;
            list[(size_t)ea * LCAP + pa] = row; list[(size_t)eb * LCAP + pb] = row;
        }
    }
}

__device__ __forceinline__ void phase_gather(const Ctx& C, int layer, int nrows) {
    const bf16* F = (const bf16*)(C.ws + WS_H); bf16* XS = (bf16*)(C.ws + WS_XS);
    const int* asg_e = (const int*)(C.ws + WS_ROUTE + RT_E); const int* asg_p = (const int*)(C.ws + WS_ROUTE + RT_P); int* asg_s = (int*)(C.ws + WS_ROUTE + RT_S);
    int* tile_e = (int*)(C.ws + WS_ROUTE + RT_TILE); int* ntl = (int*)(C.ws + WS_ROUTE + RT_NT);
    unsigned* cnt = (unsigned*)(C.ws + WS_CTL) + CW_CNT + 64 * layer;
    const int mycnt = (C.lane < 32) ? (int)__hip_atomic_load(cnt + C.lane, __ATOMIC_RELAXED, __HIP_MEMORY_SCOPE_AGENT) : 0;
    const int mypad = (mycnt + 255) & ~255;
    int incl = mypad;
#pragma unroll
    for (int o = 1; o < 32; o <<= 1) { const int t = __shfl_up(incl, o); if ((C.lane & 31) >= o) incl += t; }
    const int ps = incl - mypad;
    for (int it = C.gw; it < nrows * 2; it += C.ngw) {
        const int e = asg_e[it], p = asg_p[it]; const int slot = __shfl(ps, e) + p;
        if (C.lane == 0) asg_s[it] = slot;
        const v4u* src = (const v4u*)(F + (size_t)(it >> 1) * D); v4u* dst = (v4u*)(XS + (size_t)slot * D);
        dst[C.lane] = src[C.lane]; dst[64 + C.lane] = src[64 + C.lane];
    }
    for (int e = C.gw; e < 33; e += C.ngw) {
        if (e < 32) { const int c0 = __shfl(mycnt, e), c1 = __shfl(mypad, e), base = __shfl(ps, e);
            for (int rr = c0; rr < c1; ++rr) { v4u* dst = (v4u*)(XS + (size_t)(base + rr) * D); const v4u z = {0u, 0u, 0u, 0u}; dst[C.lane] = z; dst[64 + C.lane] = z; } }
        else { if (C.lane < 32) { for (int t = ps / 256; t < (ps + mypad) / 256; ++t) tile_e[t] = C.lane; if (C.lane == 31) *ntl = (ps + mypad) / 256; } }
    }
}
__device__ __forceinline__ int wave_pstart(const Ctx& C, int layer) {
    const unsigned* cnt = (const unsigned*)(C.ws + WS_CTL) + CW_CNT + 64 * layer;
    const int mc = C.lane < 32 ? (int)__hip_atomic_load(cnt + (C.lane & 31), __ATOMIC_RELAXED, __HIP_MEMORY_SCOPE_AGENT) : 0; const int mp = (mc + 255) & ~255; int in = mp;
#pragma unroll
    for (int o = 1; o < 32; o <<= 1) { const int t = __shfl_up(in, o); if ((C.lane & 31) >= o) in += t; }
    return in - mp;
}
__device__ __forceinline__ void moe_combine(const Ctx& C, int layer, int r, int ps, f32x4 (&v)[4]) {
    const bf16* Y2 = (const bf16*)(C.ws + WS_XS); const int* asg_s = (const int*)(C.ws + WS_ROUTE + RT_S); const float* asg_w = (const float*)(C.ws + WS_ROUTE + RT_W);
    const float* XC = (const float*)(C.ws + WS_XC);
    load_row16(XC + (size_t)r * D, C.lane, v);
    const int* asg_e = (const int*)(C.ws + WS_ROUTE + RT_E); const int* asg_p = (const int*)(C.ws + WS_ROUTE + RT_P); (void)asg_s;
    const int s0 = __shfl(ps, asg_e[2 * r]) + asg_p[2 * r], s1 = __shfl(ps, asg_e[2 * r + 1]) + asg_p[2 * r + 1]; const float w0 = asg_w[2 * r], w1 = asg_w[2 * r + 1];
    const float* gate = mod_vec(C, layer, cond_of(r), 5);
#pragma unroll
    for (int j = 0; j < 4; ++j) { const int c = 4 * C.lane + 256 * j; const v2u a = *(const v2u*)(Y2 + (size_t)s0 * D + c), b = *(const v2u*)(Y2 + (size_t)s1 * D + c); const f32x4 g = *(const f32x4*)(gate + c);
        v[j].x += g.x * (w0 * bf2f(a.x & 0xffffu) + w1 * bf2f(b.x & 0xffffu)); v[j].y += g.y * (w0 * bf2f(a.x >> 16) + w1 * bf2f(b.x >> 16));
        v[j].z += g.z * (w0 * bf2f(a.y & 0xffffu) + w1 * bf2f(b.y & 0xffffu)); v[j].w += g.w * (w0 * bf2f(a.y >> 16) + w1 * bf2f(b.y >> 16)); }
}
__device__ __forceinline__ void phase_combine_norm_mix1(const Ctx& C) {
    const Params& P = *C.p; float* XC = (float*)(C.ws + WS_XC); bf16* H = (bf16*)(C.ws + WS_H);
    const int ps = wave_pstart(C, 0);
    for (int r = C.gw; r < TT; r += C.ngw) {
        f32x4 v[4]; moe_combine(C, 0, r, ps, v);
#pragma unroll
        for (int j = 0; j < 4; ++j) *(f32x4*)(XC + (size_t)r * D + 4 * C.lane + 256 * j) = v[j];
        const float rstd = row_rstd(v); const int ci = cond_of(r);
        modulate16(v, rstd, P.in[I_GMIX] + D, mod_vec(C, 1, ci, 1), mod_vec(C, 1, ci, 0), C.lane);
        store_row16_bf16(H + (size_t)r * D, C.lane, v);
    }
    LAS float* scr = (LAS float*)(C.lds + C.wave * 16384);
    for (int it = C.gw; it < MOE_ITEMS; it += C.ngw) moe_convert_item(C, 1, it, scr);
}
__device__ __forceinline__ void phase_final(const Ctx& C) {
    const Params& P = *C.p;
    const int ps = wave_pstart(C, 1);
    for (int r = C.gw; r < TL; r += C.ngw) {
        f32x4 v[4]; moe_combine(C, 1, r, ps, v);
        const float rstd = row_rstd(v);
#pragma unroll
        for (int j = 0; j < 4; ++j) { const int c = 4 * C.lane + 256 * j; const f32x4 g = *(const f32x4*)(P.in[I_FING] + c); *(f32x4*)(P.out + (size_t)r * D + c) = v[j] * rstd * g; }
    }
}

__device__ __forceinline__ void phase_s5(const Ctx& C) {
    const Params& P = *C.p; const bf16* U = (const bf16*)(C.ws + WS_U); bf16* GS = (bf16*)(C.ws + WS_GS); float* YA = (float*)(C.ws + WS_YACC);
    const float2* lamb = (const float2*)(C.ws + WS_TAB + TAB_LAMB); const float2* bbar = (const float2*)(C.ws + WS_TAB + TAB_BBAR);
    LAS f32x2* hb = (LAS f32x2*)(C.lds + C.wave * 8192);
    const int lane = C.lane;
    for (int it = C.gw; it < NB * 32; it += C.ngw) {
        const int b = it >> 5, g = it & 31;
        for (int dir = 0; dir < 2; ++dir) {
            const int dgn = ((dir * 32 + g) * 64 + lane);
            const float2 lam = lamb[dgn]; float2 bb[16];
#pragma unroll
            for (int p = 0; p < 16; ++p) bb[p] = bbar[(size_t)dgn * 16 + p];
            const float* cre = P.in[I_CRE] + (size_t)(dir * 32 + g) * 16 * 64; const float* cim = P.in[I_CIM] + (size_t)(dir * 32 + g) * 16 * 64;
            float hr = 0.f, hi = 0.f;
            for (int ck = 0; ck < 144; ++ck) {
                const bool isl = ck >= 16;
                const int tb = isl ? (dir == 0 ? (ck - 16) * 16 : (143 - ck) * 16) : (dir == 0 ? ck * 16 : (15 - ck) * 16);
                const size_t rowb = isl ? (size_t)b * SEQ + tb : (size_t)TL + (size_t)b * CTXL + tb;
                for (int sl = 0; sl < 16; ++sl) {
                    const int to = dir == 0 ? sl : 15 - sl;
                    const bf16* ur = U + (rowb + to) * 512 + g * 16; float uf[16]; unpack8(*(const v4u*)ur, uf); unpack8(*(const v4u*)(ur + 8), uf + 8);
                    float br = 0.f, bi = 0.f;
#pragma unroll
                    for (int p = 0; p < 16; ++p) { br += bb[p].x * uf[p]; bi += bb[p].y * uf[p]; }
                    const float nr = lam.x * hr - lam.y * hi + br, ni = lam.x * hi + lam.y * hr + bi; hr = nr; hi = ni;
                    if (isl) hb[to * 64 + lane] = (f32x2){hr, hi};
                }
                if (isl) {
                    asm volatile("s_waitcnt lgkmcnt(0)" ::: "memory");
                    const int p = lane & 15;
#pragma unroll
                    for (int i = 0; i < 4; ++i) { const int to = (lane >> 4) + 4 * i; float y = 0.f;
                        for (int n = 0; n < 64; ++n) { const f32x2 h = hb[to * 64 + n]; y += cre[p * 64 + n] * h.x - cim[p * 64 + n] * h.y; }
                        const size_t o = (rowb + to) * 512 + g * 16 + p;
                        if (dir == 0) YA[o] = y + P.in[I_S5D][g * 16 + p] * bf2f(U[o]);
                        else GS[o] = (bf16)f2bf(gelu_tanh(YA[o] + y)); }
                    asm volatile("s_waitcnt lgkmcnt(0)" ::: "memory");
                }
            }
        }
    }
}


__device__ __forceinline__ void phase_s5_fast(const Ctx& C) {
    typedef short bf16x8 __attribute__((ext_vector_type(8)));
    typedef float f32x16 __attribute__((ext_vector_type(16)));
    const Params& P = *C.p; const bf16* U = (const bf16*)(C.ws + WS_U); bf16* GS = (bf16*)(C.ws + WS_GS); float* YA = (float*)(C.ws + WS_YACC);
    const float2* lamb = (const float2*)(C.ws + WS_TAB + TAB_LAMB); const float2* bbar = (const float2*)(C.ws + WS_TAB + TAB_BBAR);
    constexpr int HP = 272;
    const int lane = C.lane, w = C.wave, il = w >> 2, dir = (w >> 1) & 1, nh = w & 1;
    const int l31 = lane & 31, hi = lane >> 5, l15 = lane & 15, q4 = lane >> 4;
    LAS unsigned char* Hb = C.lds + (il * 2 + dir) * (2 * 32 * HP);
    const int srow = (l31 & 3) + 4 * (l31 >> 3) + 16 * ((l31 >> 2) & 1);
    for (int it0 = blockIdx.x; it0 < NB * 16; it0 += gridDim.x) {
        const int item = it0 * 2 + il, b = item >> 5, g = item & 31;
        const int dg = dir * 32 + g, n = nh * 32 + l31;
        const float2 lam = lamb[dg * 64 + n];
        float lpr[16], lpi[16]; { float pr = lam.x, pi = lam.y;
#pragma unroll
            for (int r = 0; r < 16; ++r) { lpr[r] = pr; lpi[r] = pi; const float nr = pr * lam.x - pi * lam.y, ni = pr * lam.y + pi * lam.x; pr = nr; pi = ni; } }
        bf16x8 bre, bim; { const float2* bp = bbar + ((size_t)(dg * 64 + n)) * 16 + 8 * hi;
#pragma unroll
            for (int e = 0; e < 8; ++e) { const float2 v = bp[e]; bre[e] = (short)f2bf(v.x); bim[e] = (short)f2bf(v.y); } }
        bf16x8 cf[4]; { const float* cre = P.in[I_CRE] + ((size_t)dg * 16 + l15) * 64; const float* cim = P.in[I_CIM] + ((size_t)dg * 16 + l15) * 64;
#pragma unroll
            for (int ks = 0; ks < 4; ++ks) { const f32x4 a = *(const f32x4*)(cre + 16 * ks + 4 * q4), m = *(const f32x4*)(cim + 16 * ks + 4 * q4);
                cf[ks][0] = (short)f2bf(a.x); cf[ks][1] = (short)f2bf(-m.x); cf[ks][2] = (short)f2bf(a.y); cf[ks][3] = (short)f2bf(-m.y);
                cf[ks][4] = (short)f2bf(a.z); cf[ks][5] = (short)f2bf(-m.z); cf[ks][6] = (short)f2bf(a.w); cf[ks][7] = (short)f2bf(-m.w); } }
        const f32x4 dsk = *(const f32x4*)(P.in[I_S5D] + g * 16 + 4 * q4);
        float cr = 0.f, ci = 0.f;
        for (int k = 0; k < 72; ++k) {
            { const int S = 32 * k + srow; size_t row;
              if (S < CTXL) row = (size_t)TL + (size_t)b * CTXL + (dir == 0 ? S : CTXL - 1 - S); else row = (size_t)b * SEQ + (dir == 0 ? S - CTXL : SEQ - 1 - (S - CTXL));
              const bf16x8 ua = *(const bf16x8*)(U + row * 512 + g * 16 + 8 * hi);
              f32x16 br = {}, bi = {};
              br = __builtin_amdgcn_mfma_f32_32x32x16_bf16(ua, bre, br, 0, 0, 0);
              bi = __builtin_amdgcn_mfma_f32_32x32x16_bf16(ua, bim, bi, 0, 0, 0);
              float sr = hi ? 0.f : cr, si = hi ? 0.f : ci;
#pragma unroll
              for (int r = 0; r < 16; ++r) { const float nr = lam.x * sr - lam.y * si + br[r], ni = lam.x * si + lam.y * sr + bi[r]; sr = nr; si = ni; br[r] = sr; bi[r] = si; }
              float er = __shfl_xor(sr, 32), ei = __shfl_xor(si, 32); if (!hi) { er = 0.f; ei = 0.f; }
#pragma unroll
              for (int r = 0; r < 16; ++r) { br[r] += lpr[r] * er - lpi[r] * ei; bi[r] += lpr[r] * ei + lpi[r] * er; }
              cr = __shfl_xor(br[15], 32); ci = __shfl_xor(bi[15], 32);
              LAS unsigned char* hb = Hb + (k & 1) * (32 * HP) + (16 * hi) * HP + 4 * n;
#pragma unroll
              for (int r = 0; r < 16; ++r) *(LAS unsigned*)(hb + r * HP) = pk2(br[r], bi[r]);
            }
            asm volatile("s_waitcnt vmcnt(0) lgkmcnt(0)\n\ts_barrier" ::: "memory");
            if (k >= 8) {
                const LAS unsigned char* hr = Hb + (k & 1) * (32 * HP) + (16 * nh + l15) * HP + 16 * q4;
                f32x4 y = {0.f, 0.f, 0.f, 0.f};
#pragma unroll
                for (int ks = 0; ks < 4; ++ks) { const bf16x8 hf = *(const LAS bf16x8*)(hr + 64 * ks); y = __builtin_amdgcn_mfma_f32_16x16x32_bf16(cf[ks], hf, y, 0, 0, 0); }
                const int sl = 32 * (k - 8) + 16 * nh + l15;
                const int tok = dir == 0 ? sl : SEQ - 1 - sl; const int lt = tok >> 5;
                const size_t o = ((size_t)b * SEQ + tok) * 512 + g * 16 + 4 * q4;
                const bool first = dir == 0 ? (lt < 32) : (lt >= 32);
                if (first) { *(f32x4*)(YA + o) = y; }
                else {
                    f32x4 p; p.x = __hip_atomic_load(YA + o, __ATOMIC_RELAXED, __HIP_MEMORY_SCOPE_AGENT); p.y = __hip_atomic_load(YA + o + 1, __ATOMIC_RELAXED, __HIP_MEMORY_SCOPE_AGENT);
                    p.z = __hip_atomic_load(YA + o + 2, __ATOMIC_RELAXED, __HIP_MEMORY_SCOPE_AGENT); p.w = __hip_atomic_load(YA + o + 3, __ATOMIC_RELAXED, __HIP_MEMORY_SCOPE_AGENT);
                    const v2u uu = *(const v2u*)(U + o);
                    const f32x4 uf = {bf2f(uu.x & 0xffffu), bf2f(uu.x >> 16), bf2f(uu.y & 0xffffu), bf2f(uu.y >> 16)};
                    const f32x4 t = y + p + dsk * uf;
                    v2u ov; ov.x = pk2(gelu_tanh(t.x), gelu_tanh(t.y)); ov.y = pk2(gelu_tanh(t.z), gelu_tanh(t.w)); *(v2u*)(GS + o) = ov;
                }
            }
        }
        asm volatile("s_waitcnt vmcnt(0) lgkmcnt(0)\n\ts_barrier" ::: "memory");
    }
}

__global__ void __launch_bounds__(NTHR, 2) fwd_kernel(Params prm) {
    extern __shared__ __attribute__((aligned(16))) unsigned char lds_raw[];
    Ctx C; C.p = &prm; C.ws = prm.ws; C.lds = (LAS unsigned char*)lds_raw;
    C.tid = threadIdx.x; C.lane = C.tid & 63; C.wave = __builtin_amdgcn_readfirstlane(C.tid >> 6);
    C.gw = blockIdx.x * NWAVE + C.wave; C.ngw = gridDim.x * NWAVE;
    constexpr int LDS_MISC = 147456 - 256;
    volatile LAS unsigned* misc = (volatile LAS unsigned*)(C.lds + LDS_MISC);
    if (C.tid < 64) misc[C.tid] = 0u;
    __syncthreads();
    unsigned* ctl = (unsigned*)(C.ws + WS_CTL);
    XcdBarrier bar; bar.bar = ctl + CW_BAR; bar.x = 0; bar.st = nullptr;
#if MK_ONE_LAUNCH
    bar = xcd_barrier_post(ctl + CW_BAR, misc + 8);
#define SEAM(k) do { if (lo <= (k) && (k) + 1 < hi) xcd_barrier(bar); } while (0)
#else
#define SEAM(k) do { } while (0)
#endif
    const int lo = prm.ph_lo, hi = prm.ph_hi;
#define IN(k) (lo <= (k) && (k) < hi)
    const Params& P = prm;
    bf16* Hb = (bf16*)(C.ws + WS_H); float* XC = (float*)(C.ws + WS_XC);
#define MOE_MAP(layer) do { LAS int* tm_ = (LAS int*)(C.lds + 131072); LAS int* cl_ = tm_ + 320; \
        if (C.wave == 0) { const unsigned* cnt_ = (const unsigned*)(C.ws + WS_CTL) + CW_CNT + 64 * (layer); const int mc_ = C.lane < 32 ? (int)__hip_atomic_load(cnt_ + (C.lane & 31), __ATOMIC_RELAXED, __HIP_MEMORY_SCOPE_AGENT) : 0; const int mp_ = (mc_ + 255) & ~255; int in_ = mp_; \
            _Pragma("unroll") for (int o_ = 1; o_ < 32; o_ <<= 1) { const int t_ = __shfl_up(in_, o_); if ((C.lane & 31) >= o_) in_ += t_; } const int ps_ = in_ - mp_; \
            if (C.lane < 32) { for (int t_ = ps_ / 256; t_ < (ps_ + mp_) / 256; ++t_) tm_[t_] = C.lane | ((t_ * 256 - ps_) << 8); cl_[C.lane] = mc_; if (C.lane == 31) cl_[32] = (ps_ + mp_) / 256; } } \
        __syncthreads(); } while (0)
#define MOE_GEMM1(layer) do { MOE_MAP(layer); const LAS int* tm_ = (const LAS int*)(C.lds + 131072); const int ntl_ = __builtin_amdgcn_readfirstlane(tm_[320 + 32]); pg8::Gemm g{Hb, (const bf16*)(C.ws + WS_W13), 0, 1024, D}; \
        pg8::GroupedOrder<true> S{tm_, tm_ + 320, (const int*)(C.ws + WS_LIST), ntl_ * 4, 4, (int)gridDim.x, (int)blockIdx.x, LCAP, D * 2, (size_t)1024 * 1024 * 2}; pg8::EpiSwiglu E{(bf16*)(C.ws + WS_G13)}; \
        pg8::gemm_phase<pg8::EpiSwiglu, pg8::GroupedOrder<true>, true, true>(C.lds, g, S, E); } while (0)
#define MOE_GEMM2(layer) do { MOE_MAP(layer); const LAS int* tm_ = (const LAS int*)(C.lds + 131072); const int ntl_ = __builtin_amdgcn_readfirstlane(tm_[320 + 32]); pg8::Gemm g{(const bf16*)(C.ws + WS_G13), (const bf16*)(C.ws + WS_W2), 0, 1024, EH}; \
        pg8::GroupedOrder<false> S{tm_, tm_ + 320, (const int*)(C.ws + WS_LIST), ntl_ * 4, 4, (int)gridDim.x, (int)blockIdx.x, LCAP, EH * 2, (size_t)1024 * 512 * 2}; pg8::EpiStore E{(bf16*)(C.ws + WS_XS), D}; \
        pg8::gemm_phase<pg8::EpiStore, pg8::GroupedOrder<false>, true, true>(C.lds, g, S, E); } while (0)
    if (IN(0)) { phase_prologue(C); SEAM(0); }
    if (IN(1)) { phase_norm_mix0(C); SEAM(1); }
    if (IN(2)) { pg8::Gemm g{Hb, (const bf16*)(C.ws + WS_WIN0), TT, MIXW, D}; pg8::StaticOrder S; S.init(TT, MIXW, gridDim.x, blockIdx.x); pg8::EpiStore E{(bf16*)(C.ws + WS_P), MIXW};
        pg8::gemm_phase<pg8::EpiStore, pg8::StaticOrder, true, true>(C.lds, g, S, E); SEAM(2); }
    if (IN(3)) { phase_qkprep(C); SEAM(3); }
    if (IN(4)) { phase_gmlp_fast(C); phase_attn_fast(C, (char*)lds_raw); SEAM(4); }
    if (IN(5)) { pg8::Gemm g{Hb, (const bf16*)(C.ws + WS_WOUT0), TT, D, D}; pg8::StaticOrder S; S.init(TT, D, gridDim.x, blockIdx.x); pg8::EpiResid E{P.in[I_X], P.in[I_CTX], (const float*)(C.ws + WS_MOD), XC, 0};
        pg8::gemm_phase<pg8::EpiResid, pg8::StaticOrder, true, true>(C.lds, g, S, E); SEAM(5); }
    if (IN(6)) { phase_router_fast(C, 0, TT); SEAM(6); }
    if (IN(8)) { MOE_GEMM1(0); SEAM(8); }
    if (IN(9)) { MOE_GEMM2(0); SEAM(9); }
    if (IN(10)) { phase_combine_norm_mix1(C); SEAM(10); }
    if (IN(11)) { pg8::Gemm g{Hb, (const bf16*)(C.ws + WS_WS5IN), TT, 512, D}; pg8::StaticOrder S; S.init(TT, 512, gridDim.x, blockIdx.x); pg8::EpiStore E{(bf16*)(C.ws + WS_U), 512};
        pg8::gemm_phase<pg8::EpiStore, pg8::StaticOrder, true, true>(C.lds, g, S, E); SEAM(11); }
    if (IN(12)) { phase_s5_fast(C); SEAM(12); }
    if (IN(13)) { pg8::Gemm g{(const bf16*)(C.ws + WS_GS), (const bf16*)(C.ws + WS_WGLU), TL, 512, 512}; pg8::StaticOrder S; S.init(TL, 512, gridDim.x, blockIdx.x); pg8::EpiGlu E{(const bf16*)(C.ws + WS_GS), P.in[I_BGLU], (bf16*)(C.ws + WS_GG)};
        pg8::gemm_phase<pg8::EpiGlu, pg8::StaticOrder, true, true>(C.lds, g, S, E); SEAM(13); }
    if (IN(14)) { pg8::Gemm g{(const bf16*)(C.ws + WS_GG), (const bf16*)(C.ws + WS_WS5OUT), TL, D, 512}; pg8::StaticOrder S; S.init(TL, D, gridDim.x, blockIdx.x); pg8::EpiResid E{P.in[I_X], P.in[I_CTX], (const float*)(C.ws + WS_MOD) + (size_t)17 * 6 * D, XC, 1};
        pg8::gemm_phase<pg8::EpiResid, pg8::StaticOrder, true, true>(C.lds, g, S, E); SEAM(14); }
    if (IN(15)) { phase_router_fast(C, 1, TL); SEAM(15); }
    if (IN(17)) { MOE_GEMM1(1); SEAM(17); }
    if (IN(18)) { MOE_GEMM2(1); SEAM(18); }
    if (IN(19)) { phase_final(C); }
#undef IN
#undef SEAM
}

extern "C" void kernel_launch(void* const* d_in, const int* in_sizes, int n_in, void* d_out, int out_size, void* d_ws, size_t ws_size, hipStream_t stream) {
    constexpr int LDS_BYTES = 147456;
    static int grid = 0;
    if (grid == 0) {
        if (n_in != 35 || out_size != TL * D || ws_size < WS_END) { fprintf(stderr, "kernel_launch: unexpected shapes (n_in %d out %d ws %zu)\n", n_in, out_size, ws_size); grid = -1; return; }
        int dev = 0, cus = 0;
        if (hipGetDevice(&dev) != hipSuccess || hipDeviceGetAttribute(&cus, hipDeviceAttributeMultiprocessorCount, dev) != hipSuccess) { grid = -1; return; }
        if (hipFuncSetAttribute((const void*)fwd_kernel, hipFuncAttributeMaxDynamicSharedMemorySize, LDS_BYTES) != hipSuccess) { fprintf(stderr, "kernel_launch: hipFuncSetAttribute failed\n"); grid = -1; return; }
        (void)hipGetLastError();
        grid = cus;
    }
    if (grid < 0) return;
    (void)hipMemsetAsync((char*)d_ws + WS_CTL, 0, CTL_BYTES, stream);
    Params p{};
    for (int i = 0; i < 35; ++i) p.in[i] = (const float*)d_in[i];
    p.out = (float*)d_out; p.ws = (unsigned char*)d_ws;
#if MK_ONE_LAUNCH
    p.ph_lo = 0; p.ph_hi = NPHASE;
    hipLaunchKernelGGL(fwd_kernel, dim3(grid), dim3(NTHR), LDS_BYTES, stream, p);
#else
    for (int k = 0; k < NPHASE; ++k) { p.ph_lo = k; p.ph_hi = k + 1; hipLaunchKernelGGL(fwd_kernel, dim3(grid), dim3(NTHR), LDS_BYTES, stream, p); }
#endif
}
```

```cpp
#include <hip/hip_runtime.h>
#include <cstdio>
#include <cstdint>

#ifndef MK_ONE_LAUNCH
#define MK_ONE_LAUNCH 1
#endif
#ifndef MK_SIMPLE_ORDER
#define MK_SIMPLE_ORDER 0
#endif
#ifndef MK_KROT
#define MK_KROT 0
#endif
#ifndef MK_PROBE
#define MK_PROBE 0
#endif
#define PROBE_A_LO 4
#define PROBE_A_HI 4
#define PROBE_B_LO 8
#define PROBE_B_HI 9

constexpr int D = 1024, NB = 16, SEQ = 2048, CTXL = 256;
constexpr int TL = NB * SEQ, TC = NB * CTXL, TT = TL + TC;
constexpr int KVL = CTXL + SEQ;
constexpr int MIXW = 1792, NEXP = 32, EH = 512;
constexpr int NSLOT = 81920;
constexpr float EPS = 1e-6f;
constexpr float QSCALE = 0.125f * 1.4426950408889634f;
constexpr int NTHR = 512, NWAVE = 8;
constexpr int NPHASE = 20;

constexpr size_t MiB = 1u << 20;
constexpr size_t WS_CTL = 0, CTL_BYTES = 1 * MiB;
constexpr size_t WS_MOD = 1 * MiB;
constexpr size_t WS_TAB = 2 * MiB;
constexpr size_t TAB_ROPE = 0, TAB_LAMB = 16384, TAB_BBAR = 65536, TAB_WR = 640 * 1024;
constexpr size_t WS_ROUTE = 3 * MiB;
constexpr size_t RT_E = 0, RT_P = 320 * 1024, RT_W = 640 * 1024, RT_S = 960 * 1024, RT_TILE = 1280 * 1024, RT_NT = 1280 * 1024 + 4096;
constexpr size_t WS_WIN0 = 6 * MiB, WS_WOUT0 = 10 * MiB, WS_WS5IN = 12 * MiB, WS_WGLU = 13 * MiB, WS_WS5OUT = 14 * MiB;
constexpr size_t WS_WSP = 15 * MiB;
constexpr size_t WS_W13 = 16 * MiB, WS_W2 = 80 * MiB;
constexpr size_t WS_XC = 112 * MiB;
constexpr size_t WS_H = 256 * MiB;
constexpr size_t WS_P = 328 * MiB;
constexpr size_t WS_Q = 454 * MiB, WS_K = 490 * MiB, WS_V = 499 * MiB;
constexpr size_t WS_XS = 328 * MiB;
constexpr size_t WS_G13 = 488 * MiB;
constexpr size_t WS_U = 328 * MiB, WS_GS = 364 * MiB, WS_GG = 396 * MiB, WS_YACC = 428 * MiB;
constexpr size_t WS_LIST = 568 * MiB;
constexpr int LCAP = 36864;
constexpr size_t WS_END = 574 * MiB;
constexpr int CW_CNT = 64;
constexpr int CW_BAR = 4096;

#define LAS __attribute__((address_space(3)))
typedef unsigned short bf16;
typedef unsigned v4u __attribute__((ext_vector_type(4)));
typedef unsigned v2u __attribute__((ext_vector_type(2)));
typedef float f32x4 __attribute__((ext_vector_type(4)));
typedef float f32x2 __attribute__((ext_vector_type(2)));
__device__ __forceinline__ float bf2f(unsigned u) { return __uint_as_float(u << 16); }
__device__ __forceinline__ unsigned pk2(float lo, float hi) { unsigned r; asm("v_cvt_pk_bf16_f32 %0, %1, %2" : "=v"(r) : "v"(lo), "v"(hi)); return r; }
__device__ __forceinline__ unsigned f2bf(float f) { return pk2(f, 0.f) & 0xffffu; }
__device__ __forceinline__ float wave_sum(float v) {
#pragma unroll
    for (int o = 1; o < 64; o <<= 1) v += __shfl_xor(v, o);
    return v;
}
__device__ __forceinline__ float wave_max(float v) {
#pragma unroll
    for (int o = 1; o < 64; o <<= 1) v = fmaxf(v, __shfl_xor(v, o));
    return v;
}
__device__ __forceinline__ float gelu_tanh(float x) { const float u2 = -1.5957691216057308f * (x + 0.044715f * x * x * x); return x * __builtin_amdgcn_rcpf(1.f + __expf(u2)); }
__device__ __forceinline__ float sigmoidf_(float x) { return 1.f / (1.f + __expf(-x)); }
__device__ __forceinline__ float silu_(float x) { return x / (1.f + __expf(-x)); }
__device__ __forceinline__ void unpack8(const v4u w, float* f) {
    f[0] = bf2f(w.x & 0xffffu); f[1] = bf2f(w.x >> 16); f[2] = bf2f(w.y & 0xffffu); f[3] = bf2f(w.y >> 16);
    f[4] = bf2f(w.z & 0xffffu); f[5] = bf2f(w.z >> 16); f[6] = bf2f(w.w & 0xffffu); f[7] = bf2f(w.w >> 16);
}

#define XB_TMO      128
#define XB_XCNT(j)  (256  + 64 * (j))
#define XB_XSUB(j)  (1280 + 64 * (j))
#define XB_XGEN(j)  (2304 + 64 * (j))
#define XB_TOP      3328
#define XB_TOPGEN   3392
#define XCD_BAR_WORDS 3456
#define XB_SPIN_CAP (1u << 28)
__device__ __forceinline__ unsigned xb_ld(unsigned* p)              { return __hip_atomic_load(p, __ATOMIC_RELAXED, __HIP_MEMORY_SCOPE_AGENT); }
__device__ __forceinline__ unsigned xb_add(unsigned* p, unsigned v) { return __hip_atomic_fetch_add(p, v, __ATOMIC_RELAXED, __HIP_MEMORY_SCOPE_AGENT); }
__device__ __forceinline__ unsigned xb_xcc_id() { return (unsigned)__builtin_amdgcn_s_getreg((3 << 11) | 20) & 0xFu; }
#define XB_SPIN(cond, bar) do { unsigned _sp = 0; while (cond) { __builtin_amdgcn_s_sleep(1); \
    if ((++_sp & 255u) == 0u) { if (xb_ld(&(bar)[XB_TMO])) break; if (_sp > XB_SPIN_CAP) { atomicAdd(&(bar)[XB_TMO], 1u); break; } } } } while (0)
struct XcdBarrier { unsigned* bar; unsigned x; volatile LAS unsigned* st; };
__device__ __forceinline__ XcdBarrier xcd_barrier_post(unsigned* bar, volatile LAS unsigned* st) {
    XcdBarrier b; b.bar = bar; b.x = xb_xcc_id(); b.st = st;
    if (threadIdx.x == 0) (void)xb_add(&bar[XB_XCNT(b.x)], 1u);
    return b;
}
__device__ __forceinline__ void xcd_barrier_complete(unsigned* bar, unsigned x, unsigned& nloc, unsigned& nx) {
    const unsigned G = gridDim.x * gridDim.y * gridDim.z;
    unsigned sum, cnt, mine, sp = 0u;
    for (;;) {
        sum = 0u; cnt = 0u; mine = 0u;
#pragma unroll
        for (unsigned j = 0; j < 16; ++j) { const unsigned c = xb_ld(&bar[XB_XCNT(j)]); sum += c; cnt += (c > 0u) ? 1u : 0u; mine = (j == x) ? c : mine; }
        if (sum == G) break;
        __builtin_amdgcn_s_sleep(1);
        if ((++sp & 255u) == 0u) { if (xb_ld(&bar[XB_TMO])) break; if (sp > XB_SPIN_CAP) { atomicAdd(&bar[XB_TMO], 1u); break; } }
    }
    nloc = mine > 0u ? mine : 1u; nx = cnt > 0u ? cnt : 1u;
}
__device__ __forceinline__ void xcd_barrier(const XcdBarrier& b) {
    asm volatile("s_waitcnt vmcnt(0)" ::: "memory");
    __syncthreads();
    if (threadIdx.x == 0) {
        unsigned* bar = b.bar;
        __builtin_amdgcn_s_waitcnt(0);
        unsigned nloc = b.st[0], nx = b.st[1];
        if (nloc == 0u) { xcd_barrier_complete(bar, b.x, nloc, nx); b.st[0] = nloc; b.st[1] = nx; }
        const unsigned old = xb_add(&bar[XB_XSUB(b.x)], 1u);
        const unsigned gen = old / nloc;
        if (old + 1u == (gen + 1u) * nloc) {
            __builtin_amdgcn_fence(__ATOMIC_RELEASE, "agent");
            asm volatile("s_waitcnt vmcnt(0)" ::: "memory");
            const unsigned og = xb_add(&bar[XB_TOP], 1u);
            const unsigned tg = og / nx;
            if (og + 1u == (tg + 1u) * nx) xb_add(&bar[XB_TOPGEN], 1u);
            else XB_SPIN(xb_ld(&bar[XB_TOPGEN]) == tg, bar);
            __builtin_amdgcn_fence(__ATOMIC_ACQUIRE, "agent");
            xb_add(&bar[XB_XGEN(b.x)], 1u);
            asm volatile("s_waitcnt vmcnt(0)" ::: "memory");
        } else {
            XB_SPIN(xb_ld(&bar[XB_XGEN(b.x)]) == gen, bar);
            __builtin_amdgcn_fence(__ATOMIC_ACQUIRE, "agent");
            asm volatile("s_waitcnt vmcnt(0)" ::: "memory");
        }
    }
    __syncthreads();
}

namespace pg8 {
#define PG8_LAS __attribute__((address_space(3)))
typedef unsigned short bf16_t;
typedef short bf16x8 __attribute__((ext_vector_type(8)));
typedef float f32x4 __attribute__((ext_vector_type(4)));
typedef unsigned u32x4 __attribute__((ext_vector_type(4)));
constexpr int BM = 256, BK = 64, HALF = 128, HTB = HALF * BK * 2  , STAGE_BYTES = 8 * HTB, NXCD = 8, WGM = 8;

__host__ __device__ __forceinline__ int lds_byte(int r, int c) { const int st = (r >> 4) * 2 + (c >> 5), rr = r & 15, cc = c & 31, ob = rr * 64 + cc * 2; return st * 1024 + (ob ^ (((ob >> 9) & 1) << 5)); }
__host__ __device__ __forceinline__ void stage_rc(int b, int& R, int& C) { const int st = b / 1024, sb = b % 1024, swz = sb ^ (((sb >> 9) & 1) << 5); R = (st >> 1) * 16 + swz / 64; C = (st & 1) * 32 + (swz % 64) / 2; }
__host__ __device__ __forceinline__ int perm32(int rho) { const int n = rho >> 4, i = rho & 15; return 8 * (i >> 2) + 4 * n + (i & 3); }

struct Unit { int pm, pn; size_t bo; int aux; };
struct Gemm { const bf16_t* A; const bf16_t* Bt; int M, N, K; };

struct StaticOrder {
    static constexpr bool GATHER = false;
    int nM, nN, nwg, G, c;
    __host__ __device__ void init(int M, int N, int G_, int c_) { nM = M / BM; nN = N / BM; nwg = nM * nN; G = G_; c = c_; }
    __host__ __device__ bool next(int i, Unit& u) const {
        const long L = (long)i * G + c; if (L >= nwg) return false;
        if (MK_SIMPLE_ORDER) { u.pm = (int)L / nN; u.pn = (int)L % nN; u.bo = 0; u.aux = 0; return true; }
        int wgid = (int)L; { const int q = nwg / NXCD, r = nwg % NXCD, xcd = wgid % NXCD, off = wgid / NXCD; wgid = (xcd < r ? xcd * (q + 1) : r * (q + 1) + (xcd - r) * q) + off; }
        const int nig = WGM * nN, gid = wgid / nig, fm = gid * WGM, gsz = (nM - fm) < WGM ? (nM - fm) : WGM;
        u.pm = fm + ((wgid % nig) % gsz); u.pn = (wgid % nig) / gsz; u.bo = 0; u.aux = 0; return true;
    }
    __device__ __forceinline__ void a_ready(const Unit&) const {}
    __device__ __forceinline__ void done(const Unit&) const {}
};

__device__ __forceinline__ unsigned cvt_pk_bf16(float lo, float hi) { unsigned r; asm volatile("v_cvt_pk_bf16_f32 %0, %1, %2" : "=v"(r) : "v"(lo), "v"(hi)); return r; }
typedef float f32x2 __attribute__((ext_vector_type(2)));
__device__ __forceinline__ f32x2 gelu_pk(f32x2 v) {
    const f32x2 av = __builtin_elementwise_abs(v), d = av * 0.2316418882f + 1.0f;
    f32x2 t; t.x = __builtin_amdgcn_rcpf(d.x); t.y = __builtin_amdgcn_rcpf(d.y);
    f32x2 q = t * 0.5307027145f + (-0.7265760135f); q = q * t + 0.7107068705f; q = q * t + (-0.142248368f); q = q * t + 0.127414796f; q = q * t;
    const f32x2 s = (v * v) * (-0.72134752044f);
    f32x2 e; e.x = __builtin_amdgcn_exp2f(s.x); e.y = __builtin_amdgcn_exp2f(s.y);
    const f32x2 m = v * (q * e), r = v - m;
    f32x2 o; o.x = v.x < 0.f ? m.x : r.x; o.y = v.y < 0.f ? m.y : r.y; return o;
}

template <class Epi, class Sched, bool ALIGN_EPI = false, bool SP2 = false, bool KROT = false>
__device__ __forceinline__ void gemm_phase(PG8_LAS unsigned char* lds, const Gemm g, const Sched& S, const Epi& E) {
    const int tid = threadIdx.x, wid = __builtin_amdgcn_readfirstlane(tid >> 6), lane = tid & 63, wr = wid >> 2, wc = wid & 3, fr = lane & 15, fq = lane >> 4;
    const int K = g.K, nt = K / BK;
    const int kmask = nt - 1, rot = (MK_KROT && KROT) ? (int)((blockIdx.x * 3u + (blockIdx.x >> 3)) & (unsigned)kmask) : 0;
#define PG8_KO(j) ((size_t)(((j) + rot) & kmask) * kstep)
    unsigned voffA[2], voffB[2];
    unsigned vC[2][2], vN[2][2];
#pragma unroll
    for (int i = 0; i < 2; ++i) { int R, C; stage_rc(tid * 16 + i * 8192, R, C); const int Rb = Epi::PERM ? ((R & ~31) + perm32(R & 31)) : R;
        voffA[i] = (unsigned)(R * K + C) * 2u; voffB[i] = (unsigned)(Rb * K + C) * 2u; }
    const size_t kstep = (size_t)(BK * 2);
    const size_t hstep = (size_t)HALF * K * 2;
    const size_t tstep = 2 * hstep;
    const unsigned ldsw = (unsigned)wid * 1024u;
    const int aoff = lds_byte(wr * 64 + fr, fq * 8), boff = lds_byte(wc * 32 + fr, fq * 8);
#define PG8_SA(b, h) (((b) * 2 + (h)) * HTB)
#define PG8_SB(b, h) ((4 + (b) * 2 + (h)) * HTB)
#define PG8_STAGE(bufoff, gbase, voff) do { _Pragma("unroll") for (int _i = 0; _i < 2; ++_i) \
        __builtin_amdgcn_global_load_lds((const unsigned*)((const char*)(gbase) + (voff)[_i]), (PG8_LAS unsigned*)(lds + (bufoff) + ldsw + _i * 8192), 16, 0, 0); } while (0)
#define PG8_STAGE_A(bufoff, gbase, h, nx) do { _Pragma("unroll") for (int _i = 0; _i < 2; ++_i) { \
        const unsigned _vo = Sched::GATHER ? ((nx) ? vN[h][_i] : vC[h][_i]) : (unsigned)((h) * hstep) + voffA[_i]; \
        __builtin_amdgcn_global_load_lds((const unsigned*)((const char*)(gbase) + _vo), (PG8_LAS unsigned*)(lds + (bufoff) + ldsw + _i * 8192), 16, 0, 0); } } while (0)
#define PG8_LDA(dst, b, h) do { _Pragma("unroll") for (int m = 0; m < 4; ++m) _Pragma("unroll") for (int k = 0; k < 2; ++k) dst[m][k] = *(const PG8_LAS bf16x8*)(lds + PG8_SA(b, h) + aoff + m * 2048 + k * 1024); } while (0)
#define PG8_LDB(dst, b, h) do { _Pragma("unroll") for (int n = 0; n < 2; ++n) _Pragma("unroll") for (int k = 0; k < 2; ++k) dst[n][k] = *(const PG8_LAS bf16x8*)(lds + PG8_SB(b, h) + boff + n * 2048 + k * 1024); } while (0)
#define PG8_MMA(ai, bj, At, Bt) do { __builtin_amdgcn_s_setprio(1); _Pragma("unroll") for (int m = 0; m < 4; ++m) _Pragma("unroll") for (int n = 0; n < 2; ++n) _Pragma("unroll") for (int k = 0; k < 2; ++k) \
        acc[ai][bj][m][n] = __builtin_amdgcn_mfma_f32_16x16x32_bf16(Bt[n][k], At[m][k], acc[ai][bj][m][n], 0, 0, 0); __builtin_amdgcn_s_setprio(0); } while (0)
#define PG8_WAIT_V(n) asm volatile("s_waitcnt vmcnt(" #n ")" ::: "memory")
#define PG8_WAIT_L(n) asm volatile("s_waitcnt lgkmcnt(" #n ")" ::: "memory")
#define PG8_BAR __builtin_amdgcn_s_barrier()
#define PG8_SCHED __builtin_amdgcn_sched_barrier(0)
    Unit cur, nxt; int ui = 0;
    if (!S.next(0, cur)) return;
    f32x4 acc[2][2][4][2];
#pragma unroll
    for (int a = 0; a < 2; ++a)
#pragma unroll
        for (int b = 0; b < 2; ++b)
#pragma unroll
            for (int m = 0; m < 4; ++m)
#pragma unroll
                for (int n = 0; n < 2; ++n) acc[a][b][m][n] = (f32x4){0.f, 0.f, 0.f, 0.f};
    bf16x8 At[4][2], B0[2][2], B1[2][2];
    const char* cA = (const char*)g.A + (Sched::GATHER ? (size_t)0 : (size_t)cur.pm * tstep); const char* cB = (const char*)g.Bt + cur.bo + (size_t)cur.pn * tstep;
    S.a_ready(cur);
#define PG8_VOFF(dst, un) do { _Pragma("unroll") for (int _h = 0; _h < 2; ++_h) _Pragma("unroll") for (int _i = 0; _i < 2; ++_i) { int R_, C_; stage_rc(tid * 16 + _i * 8192, R_, C_); dst[_h][_i] = S.a_off(un, _h * HALF + R_) + (unsigned)C_ * 2u; } } while (0)
    if constexpr (Sched::GATHER) { PG8_VOFF(vC, cur); }
    if constexpr (SP2) {
        PG8_STAGE(PG8_SB(0, 0), cB + PG8_KO(0), voffB); PG8_STAGE(PG8_SB(0, 1), cB + hstep + PG8_KO(0), voffB); PG8_STAGE_A(PG8_SA(0, 0), cA + PG8_KO(0), 0, false); PG8_STAGE_A(PG8_SA(0, 1), cA + PG8_KO(0), 1, false);
        if (wr == 1) PG8_BAR;
        PG8_WAIT_V(2); PG8_BAR;
        PG8_STAGE(PG8_SB(1, 0), cB + PG8_KO(1), voffB); PG8_STAGE_A(PG8_SA(1, 0), cA + PG8_KO(1), 0, false); PG8_STAGE(PG8_SB(1, 1), cB + hstep + PG8_KO(1), voffB);
        PG8_WAIT_V(6); PG8_BAR;
    } else {
        PG8_STAGE(PG8_SB(0, 0), cB, voffB); PG8_STAGE_A(PG8_SA(0, 0), cA, 0, false); PG8_STAGE(PG8_SB(0, 1), cB + hstep, voffB); PG8_STAGE_A(PG8_SA(0, 1), cA, 1, false);
        if (wr == 1) PG8_BAR;
        PG8_WAIT_V(4); PG8_BAR;
        PG8_STAGE(PG8_SB(1, 0), cB + PG8_KO(1), voffB); PG8_STAGE_A(PG8_SA(1, 0), cA + PG8_KO(1), 0, false); PG8_STAGE(PG8_SB(1, 1), cB + hstep + PG8_KO(1), voffB);
        PG8_WAIT_V(6); PG8_BAR;
    }
    for (;;) {
        const bool has_next = S.next(ui + 1, nxt);
        if constexpr (Sched::GATHER) { if (has_next) { PG8_VOFF(vN, nxt); } else { vN[0][0] = vC[0][0]; vN[0][1] = vC[0][1]; vN[1][0] = vC[1][0]; vN[1][1] = vC[1][1]; } }
        const char* nA = (has_next && !Sched::GATHER) ? (const char*)g.A + (size_t)nxt.pm * tstep : cA; const char* nB = has_next ? (const char*)g.Bt + nxt.bo + (size_t)nxt.pn * tstep : cB;
        for (int t = 0; t < nt; t += 2) {
            const bool last = (t == nt - 2);
            const char* a1 = cA + PG8_KO(t + 1);
            const char* a2 = last ? nA + PG8_KO(0) : cA + PG8_KO(t + 2); const char* b2 = last ? nB + PG8_KO(0) : cB + PG8_KO(t + 2);
            const char* a3 = last ? nA + PG8_KO(1) : cA + PG8_KO(t + 3); const char* b3 = last ? nB + PG8_KO(1) : cB + PG8_KO(t + 3);
            if (last && has_next) S.a_ready(nxt);
            if constexpr (SP2) {
            PG8_LDB(B0, 0, 0); PG8_LDB(B1, 0, 1); PG8_SCHED; PG8_LDA(At, 0, 0); PG8_STAGE_A(PG8_SA(1, 1), a1, 1, false);
            PG8_WAIT_V(8); PG8_WAIT_L(0); PG8_BAR; PG8_MMA(0, 0, At, B0); PG8_MMA(0, 1, At, B1); PG8_BAR; PG8_SCHED;
            PG8_LDA(At, 0, 1); PG8_STAGE(PG8_SB(0, 0), b2, voffB); PG8_STAGE(PG8_SB(0, 1), b2 + hstep, voffB); PG8_STAGE_A(PG8_SA(0, 0), a2, 0, last);
            PG8_WAIT_V(8); PG8_WAIT_L(0); PG8_BAR; PG8_MMA(1, 0, At, B0); PG8_MMA(1, 1, At, B1); PG8_BAR; PG8_SCHED;
            PG8_LDB(B0, 1, 0); PG8_LDB(B1, 1, 1); PG8_SCHED; PG8_LDA(At, 1, 0); PG8_STAGE_A(PG8_SA(0, 1), a2, 1, last);
            PG8_WAIT_V(8); PG8_WAIT_L(0); PG8_BAR; PG8_MMA(0, 0, At, B0); PG8_MMA(0, 1, At, B1); PG8_BAR; PG8_SCHED;
            PG8_LDA(At, 1, 1); PG8_STAGE(PG8_SB(1, 0), b3, voffB); PG8_STAGE(PG8_SB(1, 1), b3 + hstep, voffB); PG8_STAGE_A(PG8_SA(1, 0), a3, 0, last);
            PG8_WAIT_V(8); PG8_WAIT_L(0); PG8_BAR; PG8_MMA(1, 0, At, B0); PG8_MMA(1, 1, At, B1); PG8_BAR; PG8_SCHED;
            } else {
            PG8_LDB(B0, 0, 0); PG8_SCHED; PG8_LDA(At, 0, 0); PG8_STAGE_A(PG8_SA(1, 1), a1, 1, false);
            PG8_WAIT_L(8); PG8_BAR; PG8_WAIT_L(0); PG8_MMA(0, 0, At, B0); PG8_BAR; PG8_SCHED;
            PG8_LDB(B1, 0, 1); PG8_STAGE(PG8_SB(0, 0), b2, voffB);
            PG8_BAR; PG8_WAIT_L(0); PG8_MMA(0, 1, At, B1); PG8_BAR;
            PG8_LDA(At, 0, 1); PG8_STAGE_A(PG8_SA(0, 0), a2, 0, last);
            PG8_BAR; PG8_WAIT_L(0); PG8_MMA(1, 0, At, B0); PG8_BAR; PG8_SCHED;
            PG8_STAGE(PG8_SB(0, 1), b2 + hstep, voffB);
            PG8_WAIT_V(6); PG8_BAR; PG8_MMA(1, 1, At, B1); PG8_BAR;
            PG8_LDB(B0, 1, 0); PG8_SCHED; PG8_LDA(At, 1, 0); PG8_STAGE_A(PG8_SA(0, 1), a2, 1, last);
            PG8_WAIT_L(8); PG8_BAR; PG8_WAIT_L(0); PG8_MMA(0, 0, At, B0); PG8_BAR; PG8_SCHED;
            PG8_LDB(B1, 1, 1); PG8_STAGE(PG8_SB(1, 0), b3, voffB);
            PG8_BAR; PG8_WAIT_L(0); PG8_MMA(0, 1, At, B1); PG8_BAR;
            PG8_LDA(At, 1, 1); PG8_STAGE_A(PG8_SA(1, 0), a3, 0, last);
            PG8_BAR; PG8_WAIT_L(0); PG8_MMA(1, 0, At, B0); PG8_BAR; PG8_SCHED;
            PG8_STAGE(PG8_SB(1, 1), b3 + hstep, voffB);
            PG8_WAIT_V(6); PG8_BAR; PG8_MMA(1, 1, At, B1); PG8_BAR;
            }
        }
        if constexpr (ALIGN_EPI) { if (wr == 0) PG8_BAR; }
        if constexpr (!Epi::AFTER_DRAIN) { E(acc, cur, wr, wc, fr, fq); S.done(cur); }
        if (!has_next) break;
#pragma unroll
        for (int a = 0; a < 2; ++a)
#pragma unroll
            for (int b = 0; b < 2; ++b)
#pragma unroll
                for (int m = 0; m < 4; ++m)
#pragma unroll
                    for (int n = 0; n < 2; ++n) acc[a][b][m][n] = (f32x4){0.f, 0.f, 0.f, 0.f};
        cur = nxt; cA = nA; cB = nB; ++ui;
        if constexpr (Sched::GATHER) { vC[0][0] = vN[0][0]; vC[0][1] = vN[0][1]; vC[1][0] = vN[1][0]; vC[1][1] = vN[1][1]; }
        if constexpr (ALIGN_EPI) { if (wr == 1) PG8_BAR; }
    }
    PG8_WAIT_V(0);
    if constexpr (!ALIGN_EPI) { if (wr == 0) PG8_BAR; }
    PG8_BAR;
    if constexpr (Epi::AFTER_DRAIN) { E.fused(acc, cur, wr, wc, fr, fq, lds, wid, lane); S.done(cur); }
#undef PG8_VOFF
#undef PG8_KO
#undef PG8_SA
#undef PG8_SB
#undef PG8_STAGE
#undef PG8_STAGE_A
#undef PG8_LDA
#undef PG8_LDB
#undef PG8_MMA
#undef PG8_WAIT_V
#undef PG8_WAIT_L
#undef PG8_BAR
#undef PG8_SCHED
}
}

namespace pg8 {
template <bool GATHER_>
struct GroupedOrder {
    static constexpr bool GATHER = GATHER_;
    const PG8_LAS int* tmap; const PG8_LAS int* cntl; const int* list; int nU, nN, G, c, lcap, rowbytes; size_t estride;
    __device__ __forceinline__ bool next(int i, Unit& u) const { const long L = (long)i * G + c; if (L >= nU) return false; const int t = (int)L / nN; const int m = __builtin_amdgcn_readfirstlane(tmap[t]);
        u.pm = t; u.pn = (int)L % nN; u.bo = (size_t)(m & 255) * estride; u.aux = m; return true; }
    __device__ __forceinline__ unsigned a_off(const Unit& u, int R) const { const int e = u.aux & 255, p0 = u.aux >> 8, ce = cntl[e]; int p = p0 + R; p = p < ce ? p : ce - 1; return (unsigned)list[(size_t)e * lcap + p] * (unsigned)rowbytes; }
    __device__ __forceinline__ void a_ready(const Unit&) const {}
    __device__ __forceinline__ void done(const Unit&) const {}
};
__device__ __forceinline__ u32x4 pack8(const f32x4 a, const f32x4 b) { u32x4 w; w.x = cvt_pk_bf16(a[0], a[1]); w.y = cvt_pk_bf16(a[2], a[3]); w.z = cvt_pk_bf16(b[0], b[1]); w.w = cvt_pk_bf16(b[2], b[3]); return w; }
struct EpiStore {
    static constexpr bool PERM = true, AFTER_DRAIN = false; bf16_t* O; int ldc;
    __device__ __forceinline__ void operator()(const f32x4 (&acc)[2][2][4][2], const Unit& u, int wr, int wc, int fr, int fq) const {
        const int row0 = u.pm * BM + wr * 64 + fr, col0 = u.pn * BM + wc * 32 + 8 * fq;
#pragma unroll
        for (int ai = 0; ai < 2; ++ai)
#pragma unroll
            for (int m = 0; m < 4; ++m) { bf16_t* rowp = O + (size_t)(row0 + ai * HALF + m * 16) * ldc + col0;
#pragma unroll
                for (int bj = 0; bj < 2; ++bj) *(u32x4*)(rowp + bj * HALF) = pack8(acc[ai][bj][m][0], acc[ai][bj][m][1]); }
    }
};
__device__ __forceinline__ f32x4 silu4(const f32x4 v) { f32x4 r;
#pragma unroll
    for (int i = 0; i < 4; ++i) r[i] = v[i] * __builtin_amdgcn_rcpf(1.f + __expf(-v[i])); return r; }
__device__ __forceinline__ f32x4 sigm4(const f32x4 v) { f32x4 r;
#pragma unroll
    for (int i = 0; i < 4; ++i) r[i] = __builtin_amdgcn_rcpf(1.f + __expf(-v[i])); return r; }
struct EpiSwiglu {
    static constexpr bool PERM = true, AFTER_DRAIN = false; bf16_t* G;
    __device__ __forceinline__ void operator()(const f32x4 (&acc)[2][2][4][2], const Unit& u, int wr, int wc, int fr, int fq) const {
        const int row0 = u.pm * BM + wr * 64 + fr, col0 = u.pn * HALF + wc * 32 + 8 * fq;
#pragma unroll
        for (int ai = 0; ai < 2; ++ai)
#pragma unroll
            for (int m = 0; m < 4; ++m) *(u32x4*)(G + (size_t)(row0 + ai * HALF + m * 16) * 512 + col0) = pack8(silu4(acc[ai][0][m][0]) * acc[ai][1][m][0], silu4(acc[ai][0][m][1]) * acc[ai][1][m][1]);
    }
};
__device__ __forceinline__ void unpack8f(const u32x4 w, f32x4& a, f32x4& b) {
    a[0] = __uint_as_float(w.x << 16); a[1] = __uint_as_float(w.x & 0xffff0000u); a[2] = __uint_as_float(w.y << 16); a[3] = __uint_as_float(w.y & 0xffff0000u);
    b[0] = __uint_as_float(w.z << 16); b[1] = __uint_as_float(w.z & 0xffff0000u); b[2] = __uint_as_float(w.w << 16); b[3] = __uint_as_float(w.w & 0xffff0000u); }
struct EpiGlu {
    static constexpr bool PERM = true, AFTER_DRAIN = false; const bf16_t* GS; const float* b; bf16_t* GG;
    __device__ __forceinline__ void operator()(const f32x4 (&acc)[2][2][4][2], const Unit& u, int wr, int wc, int fr, int fq) const {
        const int row0 = u.pm * BM + wr * 64 + fr, col0 = u.pn * BM + wc * 32 + 8 * fq;
#pragma unroll
        for (int bj = 0; bj < 2; ++bj) { const int c = col0 + bj * HALF; const f32x4 b0 = *(const f32x4*)(b + c), b1 = *(const f32x4*)(b + c + 4);
#pragma unroll
            for (int ai = 0; ai < 2; ++ai)
#pragma unroll
                for (int m = 0; m < 4; ++m) { const size_t o = (size_t)(row0 + ai * HALF + m * 16) * 512 + c; f32x4 g0, g1; unpack8f(*(const u32x4*)(GS + o), g0, g1);
                    *(u32x4*)(GG + o) = pack8(g0 * sigm4(acc[ai][bj][m][0] + b0), g1 * sigm4(acc[ai][bj][m][1] + b1)); } }
    }
};
struct EpiResid {
    static constexpr bool PERM = false, AFTER_DRAIN = false;
    const float* x; const float* ctx; const float* mod; float* XC; int inplace;
    __device__ __forceinline__ void operator()(const f32x4 (&acc)[2][2][4][2], const Unit& u, int wr, int wc, int fr, int fq) const {
        const int R0 = u.pm * BM; const int ci = R0 < 32768 ? (R0 >> 11) : 16;
        const float* base = inplace ? XC + (size_t)R0 * 1024 : (R0 < 32768 ? x + (size_t)R0 * 1024 : ctx + (size_t)(R0 - 32768) * 1024);
        float* out = XC + (size_t)R0 * 1024; const float* gate = mod + ((size_t)ci * 6 + 2) * 1024;
        const int rl0 = wr * 64 + fr, col0 = u.pn * BM + wc * 32 + 4 * fq;
#pragma unroll
        for (int bj = 0; bj < 2; ++bj)
#pragma unroll
            for (int n = 0; n < 2; ++n) { const int c = col0 + bj * HALF + n * 16; const f32x4 g4 = *(const f32x4*)(gate + c);
#pragma unroll
                for (int ai = 0; ai < 2; ++ai)
#pragma unroll
                    for (int m = 0; m < 4; ++m) { const size_t o = (size_t)(rl0 + ai * HALF + m * 16) * 1024 + c; *(f32x4*)(out + o) = *(const f32x4*)(base + o) + g4 * acc[ai][bj][m][n]; } }
    }
};
}

#include <hip/hip_bf16.h>
#include <cmath>
namespace attn_body {
using bf16=__hip_bfloat16;
using bf16x8=__attribute__((ext_vector_type(8)))short;
using s16x4=__attribute__((ext_vector_type(4)))short;
using f32x16=__attribute__((ext_vector_type(16)))float;
using u32x4=__attribute__((ext_vector_type(4)))unsigned;
constexpr int D=64,QP=512,KP=128,OP=1024;
constexpr int NW=8,QBLK=32,QB=QBLK*NW,KVBLK=64;
constexpr int ATTN_UNIT_ROWS=QB;
__device__ __forceinline__ int crow(int r,int hi){return (r&3)+8*(r>>2)+4*hi;}
#define SBAR() __builtin_amdgcn_sched_barrier(0)
__device__ __forceinline__ void cmask(f32x16&p0,f32x16&p1,int jb,int qrel,int hi){
  const float NEG=-INFINITY; int kb=64*jb+4*hi;
  #pragma unroll
  for(int r=0;r<16;++r){int kv=kb+(r&3)+8*(r>>2); if(kv>qrel)p0[r]=NEG; if(kv+32>qrel)p1[r]=NEG;}
}

constexpr int NSLOT=3, SLOTB=8192;
constexpr int LDS_K=0, LDS_V=NSLOT*SLOTB, LDS_WS=2*NSLOT*SLOTB, LDS_OST=LDS_WS+NW*64*4, LDS_BYTES=LDS_OST+NW*4096;
constexpr float C2=0.125f*1.4426950408889634f;
__device__ __forceinline__ void glds16(const void*gsrc,unsigned lds_dst){unsigned keep;
  asm volatile("s_mov_b32 %0, m0\n\ts_mov_b32 m0, %2\n\ts_nop 0\n\tglobal_load_lds_dwordx4 %1, off\n\ts_mov_b32 m0, %0":"=&s"(keep):"v"(gsrc),"s"(lds_dst):"memory");}
__device__ __forceinline__ float max3f(float a,float b,float c){float r;asm("v_max3_f32 %0, %1, %2, %3":"=v"(r):"v"(a),"v"(b),"v"(c));return r;}
__device__ __forceinline__ float max2f(float a,float b){float r;asm("v_max_f32_e32 %0, %1, %2":"=v"(r):"v"(a),"v"(b));return r;}
__device__ __forceinline__ float fadd_s(float a,float b){float r;asm("v_add_f32_e32 %0, %1, %2":"=v"(r):"v"(a),"v"(b));return r;}
__device__ __forceinline__ float fsub_s(float a,float b){float r;asm("v_sub_f32_e32 %0, %1, %2":"=v"(r):"v"(a),"v"(b));return r;}
typedef float f32x2_t __attribute__((ext_vector_type(2))); typedef __bf16 bf16x2_t __attribute__((ext_vector_type(2)));
__device__ __forceinline__ unsigned cvtpk_s(float lo,float hi){f32x2_t v={lo,hi};bf16x2_t b=__builtin_convertvector(v,bf16x2_t);return __builtin_bit_cast(unsigned,b);}
#define WAIT_BAR(N) asm volatile("s_waitcnt vmcnt(" #N ") lgkmcnt(0)\n\ts_barrier":::"memory")

__device__ __forceinline__ void qkt(f32x16&p0,f32x16&p1,const char*Kslot,const bf16x8*qr,const f32x16&negm,int r32,int hi){
  const char*kb=Kslot+hi*1024+r32*16;
  #pragma unroll
  for(int d0=0;d0<4;++d0){
    const bf16x8 b0=*reinterpret_cast<const bf16x8*>(kb+d0*2048);
    const bf16x8 b1=*reinterpret_cast<const bf16x8*>(kb+d0*2048+512);
    if(d0==0){p0=__builtin_amdgcn_mfma_f32_32x32x16_bf16(b0,qr[0],negm,0,0,0);p1=__builtin_amdgcn_mfma_f32_32x32x16_bf16(b1,qr[0],negm,0,0,0);}
    else{p0=__builtin_amdgcn_mfma_f32_32x32x16_bf16(b0,qr[d0],p0,0,0,0);p1=__builtin_amdgcn_mfma_f32_32x32x16_bf16(b1,qr[d0],p1,0,0,0);}}
}
typedef __attribute__((address_space(3))) const char* lds_cptr;
typedef short v4i16_t __attribute__((ext_vector_type(4)));
__device__ __forceinline__ void kload8(bf16x8*kf,lds_cptr kp){
  kf[0]=*(const __attribute__((address_space(3))) bf16x8*)(kp);      kf[1]=*(const __attribute__((address_space(3))) bf16x8*)(kp+512);
  kf[2]=*(const __attribute__((address_space(3))) bf16x8*)(kp+2048); kf[3]=*(const __attribute__((address_space(3))) bf16x8*)(kp+2560);
  kf[4]=*(const __attribute__((address_space(3))) bf16x8*)(kp+4096); kf[5]=*(const __attribute__((address_space(3))) bf16x8*)(kp+4608);
  kf[6]=*(const __attribute__((address_space(3))) bf16x8*)(kp+6144); kf[7]=*(const __attribute__((address_space(3))) bf16x8*)(kp+6656);
}
__device__ __forceinline__ void kload2(bf16x8*kf,lds_cptr kp,int j){ kf[2*j]=*(const __attribute__((address_space(3))) bf16x8*)(kp+j*2048); kf[2*j+1]=*(const __attribute__((address_space(3))) bf16x8*)(kp+j*2048+512); }
__device__ __forceinline__ s16x4 vtr(lds_cptr p){ return __builtin_bit_cast(s16x4,__builtin_amdgcn_ds_read_tr16_b64_v4i16((__attribute__((address_space(3))) v4i16_t*)p)); }
__device__ __forceinline__ float rowmax(const f32x16&p0,const f32x16&p1){
  float a=max3f(p0[0],p0[1],p1[0]),b=max3f(p0[2],p0[3],p1[1]);a=max3f(a,p1[2],p1[3]);
  #pragma unroll
  for(int r=4;r<16;r+=4){a=max3f(a,p0[r],p0[r+1]);b=max3f(b,p0[r+2],p0[r+3]);a=max3f(a,p1[r],p1[r+1]);b=max3f(b,p1[r+2],p1[r+3]);}
  const float m=max2f(a,b);
  auto rr=__builtin_amdgcn_permlane32_swap(__float_as_uint(m),__float_as_uint(m),false,false);
  return max2f(__uint_as_float(rr[0]),__uint_as_float(rr[1]));
}
__device__ __forceinline__ void pv(f32x16*o,int vb,bf16x8 pa0,bf16x8 pa1,bf16x8 pa2,bf16x8 pa3){
  #pragma unroll
  for(int d0=0;d0<2;++d0){s16x4 lo[4],hi[4];
    #pragma unroll
    for(int ks=0;ks<4;++ks){
      asm volatile("ds_read_b64_tr_b16 %0,%1 offset:%c2":"=&v"(lo[ks]):"v"(vb),"i"(d0*4096+ks*1024):"memory");
      asm volatile("ds_read_b64_tr_b16 %0,%1 offset:%c2":"=&v"(hi[ks]):"v"(vb),"i"(d0*4096+ks*1024+512):"memory");}
    asm volatile("s_waitcnt lgkmcnt(0)":::"memory");SBAR();
    #define PK(k) (bf16x8){lo[k][0],lo[k][1],lo[k][2],lo[k][3],hi[k][0],hi[k][1],hi[k][2],hi[k][3]}
    o[d0]=__builtin_amdgcn_mfma_f32_32x32x16_bf16(pa0,PK(0),o[d0],0,0,0);
    o[d0]=__builtin_amdgcn_mfma_f32_32x32x16_bf16(pa1,PK(1),o[d0],0,0,0);
    o[d0]=__builtin_amdgcn_mfma_f32_32x32x16_bf16(pa2,PK(2),o[d0],0,0,0);
    o[d0]=__builtin_amdgcn_mfma_f32_32x32x16_bf16(pa3,PK(3),o[d0],0,0,0);
    #undef PK
  }
}

#ifndef ATTN_STORE16
#define ATTN_STORE16(p,v) (*(u32x4*)(p)=(v))
#endif
template<int THRL> __device__ __forceinline__ void attn_unit(const bf16*Q0,const bf16*__restrict__ Kh,const bf16*__restrict__ Vh,bf16*O0,const int NT,char*shm){
  const int tid=threadIdx.x,lane=tid&63,r32=lane&31,hi=lane>>5; const int wid=__builtin_amdgcn_readfirstlane(tid>>6);
  const bf16*Qw=Q0+(long)(wid*QBLK)*QP;
  const unsigned lds0=(unsigned)(uintptr_t)shm;
  float*wsf=(float*)(shm+LDS_WS)+wid*64;
  const bf16*ksrc=Kh+(long)lane*KP+wid*8;
  const bf16*vsrc=Vh+(long)(16*(wid&3)+(lane>>2))*KP+(wid>>2)*32+(lane&3)*8;
  const unsigned kdst=lds0+LDS_K+wid*1024, vdst=lds0+LDS_V+wid*1024;
  #define DMA_K(t,slot) glds16(ksrc+(long)(t)*KVBLK*KP,(unsigned)__builtin_amdgcn_readfirstlane(kdst+(slot)))
  #define DMA_V(t,slot) glds16(vsrc+(long)(t)*KVBLK*KP,(unsigned)__builtin_amdgcn_readfirstlane(vdst+(slot)))
  const int vb0=(int)(lds0+LDS_V)+((lane>>4)&1)*32+(lane&3)*8+(4*hi+((lane&15)>>2))*64;
  const char*Kbase=shm+LDS_K; bf16x8 kf[8];
  const lds_cptr shm3=(lds_cptr)shm; const lds_cptr kp0=shm3+LDS_K+hi*1024+r32*16; const lds_cptr vp0=shm3+LDS_V+((lane>>4)&1)*32+(lane&3)*8+(4*hi+((lane&15)>>2))*64;
  DMA_K(0,0);DMA_V(0,0);DMA_K(1,SLOTB);
  bf16x8 qr[4];
  #pragma unroll
  for(int d0=0;d0<4;++d0)qr[d0]=*reinterpret_cast<const bf16x8*>(&Qw[(long)r32*QP+d0*16+hi*8]);
  float mhat=0.f,l_reg=0.f;f32x16 o[2];o[0]=f32x16{};o[1]=f32x16{};f32x16 negm=f32x16{};asm volatile("":"+v"(negm));
  #define CMASK(P0,P1,t) do{}while(0)
  bool resc=false;
  #define START(P0,P1) do{ const float rm=rowmax(P0,P1); resc=false; \
    { const float dl=rm; mhat=fadd_s(mhat,dl); \
      _Pragma("unroll") for(int r=0;r<16;++r){P0[r]=fsub_s(P0[r],dl);P1[r]=fsub_s(P1[r],dl);} \
      _Pragma("unroll") for(int r=0;r<16;++r)negm[r]=-mhat; asm volatile("":"+v"(negm)); } \
    _Pragma("unroll") for(int r=0;r<16;++r)P0[r]=__builtin_amdgcn_exp2f(P0[r]); }while(0)
  #define RESC() do{ if(resc){ asm volatile("s_waitcnt lgkmcnt(0)":::"memory"); \
      _Pragma("unroll") for(int d_=0;d_<2;++d_) _Pragma("unroll") for(int r=0;r<16;++r)o[d_][r]*=wsf[crow(r,hi)]; } }while(0)
  f32x16 pA0,pA1,pB0,pB1;
  int sl_prev=0,sl_cur=0,sl_next=SLOTB;
  #define ROT() do{sl_prev=sl_cur;sl_cur=sl_next;sl_next=(sl_next==(NSLOT-1)*SLOTB)?0:sl_next+SLOTB;}while(0)
  DMA_K(2,2*SLOTB);
  WAIT_BAR(3);
  qkt(pA0,pA1,Kbase,qr,negm,r32,hi);asm volatile("s_nop 15\n\ts_nop 7":"+v"(pA0),"+v"(pA1));CMASK(pA0,pA1,0);
  START(pA0,pA1);
  _Pragma("unroll") for(int r=0;r<16;++r)pA1[r]=__builtin_amdgcn_exp2f(pA1[r]);
  WAIT_BAR(0);
  DMA_K(3,0);DMA_V(1,SLOTB);
  ROT();
  kload8(kf,kp0+sl_cur);
  WAIT_BAR(2);
  s16x4 vlo[8],vhi[8]; u32x4 pw0,pw1,pw2,pw3;
  #define PKW(P,B) cvtpk_s(P[B],P[B+1])
  #define PAF(k) __builtin_bit_cast(bf16x8,pw##k)
  #define VFR(i) (bf16x8){vlo[i][0],vlo[i][1],vlo[i][2],vlo[i][3],vhi[i][0],vhi[i][1],vhi[i][2],vhi[i][3]}
  #define PIN(x) asm volatile("":"+v"(x))
  #define MX3(a,b,c) __builtin_fmaxf(__builtin_fmaxf((a),(b)),(c))
  #define GAPA(MF,A0,A1,A2,A3,W0,W1,PW) do{ MF; sacc+=A0; sacc+=A1; sacc+=A2; sacc+=A3; PIN(sacc); W0; W1; PIN(PW); SBAR(); }while(0)
  #define EX(v) __builtin_amdgcn_exp2f(v)
  #define GAPB(MF,X,B) do{ MF; X[B]=EX(X[B]); X[B+1]=EX(X[B+1]); X[B+2]=EX(X[B+2]); X[B+3]=EX(X[B+3]); PIN(X); SBAR(); }while(0)
  #define VRD(i) do{ vlo[i]=vtr(vp_+(((i)>>2)*4096+((i)&3)*1024)); vhi[i]=vtr(vp_+(((i)>>2)*4096+((i)&3)*1024+512)); }while(0)
  #define KRD(G,j) do{ if(G){ kload2(kf,kp0+sl_next,j); SBAR(); } }while(0)
  #define STEP(C0,C1,P0,P1,t,GK,GV,GL) do{ SBAR(); \
    const lds_cptr vp_=vp0+sl_prev; \
    VRD(0); SBAR(); float sacc=(P0[0]+P0[1]); \
    GAPA(C0=__builtin_amdgcn_mfma_f32_32x32x16_bf16(kf[0],qr[0],negm,0,0,0), P0[2],P0[3],P0[4],P0[5],     pw0[0]=PKW(P0,0), pw0[1]=PKW(P0,2), pw0); \
    VRD(4); SBAR(); GAPA(C1=__builtin_amdgcn_mfma_f32_32x32x16_bf16(kf[1],qr[0],negm,0,0,0), P0[6],P0[7],P0[8],P0[9],     pw0[2]=PKW(P0,4), pw0[3]=PKW(P0,6), pw0); \
    VRD(1); SBAR(); GAPA(C0=__builtin_amdgcn_mfma_f32_32x32x16_bf16(kf[2],qr[1],C0,0,0,0),   P0[10],P0[11],P0[12],P0[13], pw1[0]=PKW(P0,8), pw1[1]=PKW(P0,10), pw1); \
    VRD(5); SBAR(); GAPA(C1=__builtin_amdgcn_mfma_f32_32x32x16_bf16(kf[3],qr[1],C1,0,0,0),   P0[14],P0[15],P1[0],P1[1],   pw1[2]=PKW(P0,12),pw1[3]=PKW(P0,14), pw1); \
    VRD(2); SBAR(); GAPA(C0=__builtin_amdgcn_mfma_f32_32x32x16_bf16(kf[4],qr[2],C0,0,0,0),   P1[2],P1[3],P1[4],P1[5],     pw2[0]=PKW(P1,0), pw2[1]=PKW(P1,2), pw2); \
    VRD(6); SBAR(); GAPA(C1=__builtin_amdgcn_mfma_f32_32x32x16_bf16(kf[5],qr[2],C1,0,0,0),   P1[6],P1[7],P1[8],P1[9],     pw2[2]=PKW(P1,4), pw2[3]=PKW(P1,6), pw2); \
    VRD(3); SBAR(); GAPA(C0=__builtin_amdgcn_mfma_f32_32x32x16_bf16(kf[6],qr[3],C0,0,0,0),   P1[10],P1[11],P1[12],P1[13], pw3[0]=PKW(P1,8), pw3[1]=PKW(P1,10), pw3); \
    VRD(7); SBAR(); GAPA(C1=__builtin_amdgcn_mfma_f32_32x32x16_bf16(kf[7],qr[3],C1,0,0,0),   P1[14],P1[15],0.f,0.f,       pw3[2]=PKW(P1,12),pw3[3]=PKW(P1,14), pw3); \
    l_reg+=sacc; \
    if(GK){DMA_K((t)+3,sl_cur);} if(GV){DMA_V((t)+1,sl_next);} \
    CMASK(C0,C1,t); \
    { float a=MX3(C0[0],C0[1],C1[0]),b=MX3(C0[2],C0[3],C1[1]); a=MX3(a,C1[2],C1[3]); \
      _Pragma("unroll") for(int r=4;r<16;r+=4){a=MX3(a,C0[r],C0[r+1]);b=MX3(b,C0[r+2],C0[r+3]);a=MX3(a,C1[r],C1[r+1]);b=MX3(b,C1[r+2],C1[r+3]);} \
      float rm=__builtin_fmaxf(a,b); { auto rr=__builtin_amdgcn_permlane32_swap(__float_as_uint(rm),__float_as_uint(rm),false,false); rm=__builtin_fmaxf(__uint_as_float(rr[0]),__uint_as_float(rr[1])); } \
      resc=false; \
      if(__builtin_expect(__any(rm>(float)THRL),0)){ const float dl=__builtin_fmaxf(rm,0.f); mhat+=dl; \
        _Pragma("unroll") for(int r=0;r<16;++r){C0[r]-=dl;C1[r]-=dl;} \
        _Pragma("unroll") for(int r=0;r<16;++r)negm[r]=-mhat; asm volatile("":"+v"(negm)); \
        const float f=__builtin_amdgcn_exp2f(-dl); l_reg*=f; if(hi==0)wsf[r32]=f; resc=true; } } \
    SBAR(); \
    GAPB(o[0]=__builtin_amdgcn_mfma_f32_32x32x16_bf16(PAF(0),VFR(0),o[0],0,0,0), C0,0); \
    GAPB(o[1]=__builtin_amdgcn_mfma_f32_32x32x16_bf16(PAF(0),VFR(4),o[1],0,0,0), C0,4); \
    KRD(GL,0); GAPB(o[0]=__builtin_amdgcn_mfma_f32_32x32x16_bf16(PAF(1),VFR(1),o[0],0,0,0), C0,8); \
    KRD(GL,1); GAPB(o[1]=__builtin_amdgcn_mfma_f32_32x32x16_bf16(PAF(1),VFR(5),o[1],0,0,0), C0,12); \
    KRD(GL,2); GAPB(o[0]=__builtin_amdgcn_mfma_f32_32x32x16_bf16(PAF(2),VFR(2),o[0],0,0,0), C1,0); \
    KRD(GL,3); GAPB(o[1]=__builtin_amdgcn_mfma_f32_32x32x16_bf16(PAF(2),VFR(6),o[1],0,0,0), C1,4); \
    GAPB(o[0]=__builtin_amdgcn_mfma_f32_32x32x16_bf16(PAF(3),VFR(3),o[0],0,0,0), C1,8); \
    GAPB(o[1]=__builtin_amdgcn_mfma_f32_32x32x16_bf16(PAF(3),VFR(7),o[1],0,0,0), C1,12); \
    }while(0)
  int t=1;
  #undef CMASK
  #define CMASK(P0,P1,t) do{}while(0)
  for(;t+5<NT;t+=2){
    STEP(pB0,pB1,pA0,pA1,t,true,true,true);     WAIT_BAR(2); RESC(); ROT();
    STEP(pA0,pA1,pB0,pB1,t+1,true,true,true);   WAIT_BAR(2); RESC(); ROT();
  }
  #undef CMASK
  #define CMASK(P0,P1,t) do{}while(0)
  #define ENDW(tt) do{ if((tt)+3<NT){WAIT_BAR(2);} else if((tt)+2<NT){WAIT_BAR(1);} else {WAIT_BAR(0);} }while(0)
  for(;t+1<NT;t+=2){
    STEP(pB0,pB1,pA0,pA1,t,(t+3<NT),(t+1<NT),(t+1<NT));       ENDW(t);   RESC(); ROT();
    STEP(pA0,pA1,pB0,pB1,t+1,(t+4<NT),(t+2<NT),(t+2<NT));     ENDW(t+1); RESC(); ROT();
  }
  STEP(pB0,pB1,pA0,pA1,NT-1,false,false,false); RESC();
  { float sacc=pB0[0]+pB0[1]; _Pragma("unroll") for(int r=2;r<16;++r)sacc+=pB0[r]; _Pragma("unroll") for(int r=0;r<16;++r)sacc+=pB1[r]; l_reg+=sacc;
    pw0=(u32x4){PKW(pB0,0),PKW(pB0,2),PKW(pB0,4),PKW(pB0,6)};pw1=(u32x4){PKW(pB0,8),PKW(pB0,10),PKW(pB0,12),PKW(pB0,14)};pw2=(u32x4){PKW(pB1,0),PKW(pB1,2),PKW(pB1,4),PKW(pB1,6)};pw3=(u32x4){PKW(pB1,8),PKW(pB1,10),PKW(pB1,12),PKW(pB1,14)};
    SBAR(); pv(o,vb0+sl_cur,PAF(0),PAF(1),PAF(2),PAF(3)); }
  #undef PKW
  #undef PAF
  #undef VFR
  #undef PIN
  #undef MX3
  #undef GAPA
  #undef GAPB
  #undef EX
  #undef VRD
  #undef KRD
  #undef STEP
  #undef ENDW
  {auto rr=__builtin_amdgcn_permlane32_swap(__float_as_uint(l_reg),__float_as_uint(l_reg),false,false);l_reg=__uint_as_float(rr[0])+__uint_as_float(rr[1]);}
  if(hi==0)wsf[32+r32]=l_reg;asm volatile("s_waitcnt lgkmcnt(0)":::"memory");
  float rli[16];
  #pragma unroll
  for(int r=0;r<16;++r)rli[r]=__builtin_amdgcn_rcpf(wsf[32+crow(r,hi)]);
  bf16*Ow=O0+(long)(wid*QBLK)*OP;
  { bf16*stg=(bf16*)(shm+LDS_OST)+wid*2048;
    #pragma unroll
    for(int r=0;r<16;++r){const int orow=crow(r,hi);
      #pragma unroll
      for(int d0=0;d0<2;++d0)stg[orow*64+d0*32+r32]=__float2bfloat16(o[d0][r]*rli[r]);}
    asm volatile("s_waitcnt lgkmcnt(0)":::"memory");
    #pragma unroll
    for(int i=0;i<4;++i){const int row=i*8+(lane>>3),ch=lane&7; const u32x4 v=*(const u32x4*)(stg+row*64+ch*8); ATTN_STORE16(Ow+(long)row*OP+ch*8,v);} }
  asm volatile("s_waitcnt lgkmcnt(0)\n\ts_barrier":::"memory");
  #undef DMA_K
  #undef DMA_V
  #undef CMASK
  #undef START
  #undef RESC
  #undef ROT
}
constexpr int ATTN_LDS_BYTES=LDS_BYTES;
#undef SBAR
#undef WAIT_BAR
}

struct Params {
    const float* in[35];
    float* out;
    unsigned char* ws;
    int ph_lo, ph_hi;
};
enum { I_X = 0, I_C, I_CTX, I_CCTX, I_WMOD, I_BMOD, I_GMIX, I_GFFN, I_MIXWIN, I_MIXWOUT, I_QG, I_KG, I_LNG, I_WSP, I_BSP,
       I_S5WIN, I_ARE, I_AIM, I_LOGDT, I_BRE, I_BIM, I_CRE, I_CIM, I_S5D, I_WGLU, I_BGLU, I_S5WOUT,
       I_WGRP, I_BGRP, I_WRT, I_BRT, I_W1, I_W3, I_W2, I_FING };

struct Ctx {
    const Params* p;
    unsigned char* ws;
    LAS unsigned char* lds;
    int tid, lane, wave, gw, ngw;
};
__device__ __forceinline__ const float* xin_row(const Params& P, int r) { return r < TL ? P.in[I_X] + (size_t)r * D : P.in[I_CTX] + (size_t)(r - TL) * D; }
__device__ __forceinline__ int cond_of(int r) { return r < TL ? (r >> 11) : 16; }
__device__ __forceinline__ const float* mod_vec(const Ctx& C, int layer, int ci, int k) { return (const float*)(C.ws + WS_MOD) + ((size_t)(layer * 17 + ci) * 6 + k) * D; }

__device__ __forceinline__ void dsincos(double a, double& s, double& c) {
    const double TWO_PI_HI = 6.283185307179586, TWO_PI_LO = 2.4492935982947064e-16;
    const double k = rint(a * 0.15915494309189535);
    double r = fma(-k, TWO_PI_HI, a); r = fma(-k, TWO_PI_LO, r);
    const double r2 = r * r; double ct = 1.0, st = r, cs = 1.0, ss = r;
#pragma unroll 1
    for (int i = 1; i <= 15; ++i) { ct *= -r2 / (double)((2 * i - 1) * (2 * i)); cs += ct; st *= -r2 / (double)((2 * i) * (2 * i + 1)); ss += st; }
    s = ss; c = cs;
}

__device__ __forceinline__ void transpose_item(const float* src, int N, int k0, int n0, bf16* dst, int dpitch, LAS float* scr, int lane) {
#pragma unroll 8
    for (int i = 0; i < 32; ++i) { const int kk = 2 * i + (lane >> 5); scr[kk * 33 + (lane & 31)] = src[(size_t)(k0 + kk) * N + n0 + (lane & 31)]; }
    asm volatile("s_waitcnt lgkmcnt(0)" ::: "memory");
    const int c = lane & 7;
#pragma unroll
    for (int j = 0; j < 4; ++j) { const int n = (lane >> 3) + 8 * j; const LAS float* s = scr + (8 * c) * 33 + n;
        v4u o; o.x = pk2(s[0 * 33], s[1 * 33]); o.y = pk2(s[2 * 33], s[3 * 33]); o.z = pk2(s[4 * 33], s[5 * 33]); o.w = pk2(s[6 * 33], s[7 * 33]);
        *(v4u*)(dst + (size_t)n * dpitch + 8 * c) = o; }
    asm volatile("s_waitcnt lgkmcnt(0)" ::: "memory");
}
__device__ __forceinline__ void transpose_mat_item(const float* W, int K, int N, bf16* WT, int it, LAS float* scr, int lane) {
    const int nblk = N / 32, kb = it / nblk, nb = it % nblk;
    transpose_item(W, N, kb * 64, nb * 32, WT + (size_t)(nb * 32) * K + kb * 64, K, scr, lane);
}
constexpr int MOE_ITEMS = NEXP * 768;
__device__ __forceinline__ void moe_convert_item(const Ctx& C, int layer, int it, LAS float* scr) {
    const Params& P = *C.p;
    const int e = it / 768, r = it % 768, kind = r / 256, j = r % 256;
    if (kind < 2) {
        const float* src = (kind == 0 ? P.in[I_W1] : P.in[I_W3]) + ((size_t)layer * NEXP + e) * D * EH;
        const int kb = j / 16, nb = j % 16, k0 = kb * 64, n0 = nb * 32;
        const int drow = (n0 / 128) * 256 + (n0 % 128) + (kind == 1 ? 128 : 0);
        transpose_item(src, EH, k0, n0, (bf16*)(C.ws + WS_W13) + (size_t)e * 1024 * 1024 + (size_t)drow * 1024 + k0, 1024, scr, C.lane);
    } else {
        const float* src = P.in[I_W2] + ((size_t)layer * NEXP + e) * EH * D;
        const int kb = j / 32, nb = j % 32, k0 = kb * 64, n0 = nb * 32;
        transpose_item(src, D, k0, n0, (bf16*)(C.ws + WS_W2) + (size_t)e * 1024 * 512 + (size_t)n0 * 512 + k0, 512, scr, C.lane);
    }
}

__device__ __forceinline__ void phase_prologue(const Ctx& C) {
    const Params& P = *C.p;
    {
        LAS float* s = (LAS float*)C.lds;
        LAS float* red = (LAS float*)(C.lds + 17 * 1024 * 4);
        bool have_s = false;
        for (int u = blockIdx.x; u < 192; u += gridDim.x) {
            if (!have_s) {
                for (int i = C.tid; i < 17 * 1024; i += NTHR) { const int ci = i >> 10, k = i & 1023; const float v = ci < 16 ? P.in[I_C][ci * D + k] : P.in[I_CCTX][k]; s[i] = silu_(v); }
                have_s = true; __syncthreads();
            }
            const int layer = u / 96, jg = u % 96, kq = C.tid >> 6, jc = C.tid & 63;
            const float* w = P.in[I_WMOD] + (size_t)layer * D * 6144 + jg * 64 + jc;
            float acc[17];
#pragma unroll
            for (int i = 0; i < 17; ++i) acc[i] = 0.f;
            for (int k = kq * 128; k < kq * 128 + 128; ++k) { const float wv = w[(size_t)k * 6144];
#pragma unroll
                for (int i = 0; i < 17; ++i) acc[i] += s[i * 1024 + k] * wv; }
#pragma unroll
            for (int i = 0; i < 17; ++i) red[(kq * 17 + i) * 64 + jc] = acc[i];
            __syncthreads();
            for (int o = C.tid; o < 17 * 64; o += NTHR) { const int ci = o >> 6, c = o & 63; float v = 0.f;
#pragma unroll
                for (int q = 0; q < 8; ++q) v += red[(q * 17 + ci) * 64 + c];
                const int j = jg * 64 + c; v += P.in[I_BMOD][layer * 6144 + j];
                ((float*)(C.ws + WS_MOD))[((size_t)(layer * 17 + ci)) * 6144 + j] = v; }
            __syncthreads();
        }
        __syncthreads();
    }
    {
        const int gt = blockIdx.x * NTHR + C.tid, ngt = gridDim.x * NTHR;
        float2* rope = (float2*)(C.ws + WS_TAB + TAB_ROPE);
        for (int i = gt; i < 64 * 16; i += ngt) { const int pos = i >> 4, f = i & 15;
            const double th = exp(-(double)f * (9.210340371976184 / 16.0)); double s, c; dsincos((double)pos * th, s, c); rope[i] = make_float2((float)c, (float)s); }
        float2* lamb = (float2*)(C.ws + WS_TAB + TAB_LAMB); float2* bbar = (float2*)(C.ws + WS_TAB + TAB_BBAR);
        for (int i = gt; i < 2 * 32 * 64; i += ngt) {
            const int dg = i >> 6;
            const double are = P.in[I_ARE][i], aim = P.in[I_AIM][i], dt = exp((double)P.in[I_LOGDT][dg]);
            double s, c; dsincos(aim * dt, s, c); const double mag = exp(are * dt), lr = mag * c, li = mag * s;
            lamb[i] = make_float2((float)lr, (float)li);
            const double den = are * are + aim * aim, nr = lr - 1.0, ni = li;
            const double cr = (nr * are + ni * aim) / den, cim = (ni * are - nr * aim) / den;
            for (int p = 0; p < 16; ++p) { const double br = P.in[I_BRE][(size_t)i * 16 + p], bi = P.in[I_BIM][(size_t)i * 16 + p];
                bbar[(size_t)i * 16 + p] = make_float2((float)(cr * br - cim * bi), (float)(cr * bi + cim * br)); }
        }
    }
    {
        const int gt = blockIdx.x * NTHR + C.tid, ngt = gridDim.x * NTHR;
        bf16* wrt = (bf16*)(C.ws + WS_TAB + TAB_WR);
        for (int idx = gt; idx < 2 * 32 * 3 * 64; idx += ngt) {
            const int ln = idx & 63, jb = (idx >> 6) % 3, kk = (idx / 192) & 31, l = idx / (192 * 32);
            const int i = ln & 15, q = ln >> 4, grp = i >> 2, r = i & 3;
            float hi8[8], lo8[8];
#pragma unroll
            for (int e = 0; e < 8; ++e) { const int k = 32 * kk + 8 * q + e;
                const float w = jb < 2 ? P.in[I_WRT][((size_t)l * D + k) * 32 + grp * 8 + jb * 4 + r] : (r == 0 ? P.in[I_WGRP][((size_t)l * D + k) * 4 + grp] : 0.f);
                const float h = bf2f(f2bf(w)); hi8[e] = h; lo8[e] = w - h; }
            v4u oh, ol; oh.x = pk2(hi8[0], hi8[1]); oh.y = pk2(hi8[2], hi8[3]); oh.z = pk2(hi8[4], hi8[5]); oh.w = pk2(hi8[6], hi8[7]);
            ol.x = pk2(lo8[0], lo8[1]); ol.y = pk2(lo8[2], lo8[3]); ol.z = pk2(lo8[4], lo8[5]); ol.w = pk2(lo8[6], lo8[7]);
            const size_t base = ((((size_t)l * 32 + kk) * 3 + jb) * 2) * 64 + ln;
            *(v4u*)(wrt + base * 8) = oh; *(v4u*)(wrt + (base + 64) * 8) = ol;
        }
    }
    {
        const int gt = blockIdx.x * NTHR + C.tid, ngt = gridDim.x * NTHR; bf16* w16 = (bf16*)(C.ws + WS_WSP);
        for (int i = gt; i < 8 * 128 * 128 / 4; i += ngt) { const f32x4 v = *(const f32x4*)(P.in[I_WSP] + 4 * (size_t)i); v2u o; o.x = pk2(v.x, v.y); o.y = pk2(v.z, v.w); *(v2u*)(w16 + 4 * (size_t)i) = o; }
    }
    {
        LAS float* scr = (LAS float*)(C.lds + C.wave * 16384);
        constexpr int I0 = 16 * 56, I1 = 16 * 32, I2 = 16 * 16, I3 = 8 * 16, I4 = 8 * 32;
        constexpr int NSMALL = I0 + I1 + I2 + I3 + I4;
        for (int it = C.gw; it < NSMALL + MOE_ITEMS; it += C.ngw) {
            int r = it;
            if (r < I0) { transpose_mat_item(P.in[I_MIXWIN], D, MIXW, (bf16*)(C.ws + WS_WIN0), r, scr, C.lane); continue; } r -= I0;
            if (r < I1) { transpose_mat_item(P.in[I_MIXWOUT], D, D, (bf16*)(C.ws + WS_WOUT0), r, scr, C.lane); continue; } r -= I1;
            if (r < I2) { transpose_mat_item(P.in[I_S5WIN], D, 512, (bf16*)(C.ws + WS_WS5IN), r, scr, C.lane); continue; } r -= I2;
            if (r < I3) { transpose_mat_item(P.in[I_WGLU], 512, 512, (bf16*)(C.ws + WS_WGLU), r, scr, C.lane); continue; } r -= I3;
            if (r < I4) { transpose_mat_item(P.in[I_S5WOUT], 512, D, (bf16*)(C.ws + WS_WS5OUT), r, scr, C.lane); continue; } r -= I4;
            moe_convert_item(C, 0, r, scr);
        }
    }
}

__device__ __forceinline__ void load_row16(const float* row, int lane, f32x4 (&v)[4]) {
#pragma unroll
    for (int j = 0; j < 4; ++j) v[j] = *(const f32x4*)(row + 4 * lane + 256 * j);
}
__device__ __forceinline__ float row_rstd(const f32x4 (&v)[4]) {
    float s = 0.f;
#pragma unroll
    for (int j = 0; j < 4; ++j) s += (v[j].x * v[j].x + v[j].y * v[j].y) + (v[j].z * v[j].z + v[j].w * v[j].w);
    return rsqrtf(wave_sum(s) * (1.f / D) + EPS);
}
__device__ __forceinline__ void modulate16(f32x4 (&v)[4], float rstd, const float* g, const float* scale, const float* shift, int lane) {
#pragma unroll
    for (int j = 0; j < 4; ++j) { const int c = 4 * lane + 256 * j; const f32x4 gg = *(const f32x4*)(g + c), sc = *(const f32x4*)(scale + c), sh = *(const f32x4*)(shift + c);
        v[j] = v[j] * rstd * gg * (sc + 1.f) + sh; }
}
__device__ __forceinline__ void store_row16_bf16(bf16* row, int lane, const f32x4 (&v)[4]) {
#pragma unroll
    for (int j = 0; j < 4; ++j) { v2u o; o.x = pk2(v[j].x, v[j].y); o.y = pk2(v[j].z, v[j].w); *(v2u*)(row + 4 * lane + 256 * j) = o; }
}

__device__ __forceinline__ void phase_norm_mix0(const Ctx& C) {
    const Params& P = *C.p; bf16* H = (bf16*)(C.ws + WS_H);
    for (int r = C.gw; r < TT; r += C.ngw) {
        f32x4 v[4]; load_row16(xin_row(P, r), C.lane, v);
        const float rstd = row_rstd(v); const int ci = cond_of(r);
        modulate16(v, rstd, P.in[I_GMIX], mod_vec(C, 0, ci, 1), mod_vec(C, 0, ci, 0), C.lane);
        store_row16_bf16(H + (size_t)r * D, C.lane, v);
    }
}

template <class Epi>
__device__ __forceinline__ void ngemm_unit(const Ctx& C, const bf16* A0, const bf16* B0, int K, int row0, int pn, const Epi& epi) {
    LAS float* As = (LAS float*)C.lds;
    LAS float* Bs = (LAS float*)(C.lds + 32 * 68 * 4);
    const int tid = C.tid, ty = tid >> 4, tx = tid & 15;
    float acc[2][16];
#pragma unroll
    for (int i = 0; i < 2; ++i)
#pragma unroll
        for (int j = 0; j < 16; ++j) acc[i][j] = 0.f;
    const int ar = tid >> 3, ak = (tid & 7) * 4, bn = tid >> 1, bk = (tid & 1) * 16;
    for (int k0 = 0; k0 < K; k0 += 32) {
        const v2u av = *(const v2u*)(A0 + (size_t)ar * K + k0 + ak);
        const v4u b0 = *(const v4u*)(B0 + (size_t)bn * K + k0 + bk), b1 = *(const v4u*)(B0 + (size_t)bn * K + k0 + bk + 8);
        __syncthreads();
        As[(ak + 0) * 68 + ar] = bf2f(av.x & 0xffffu); As[(ak + 1) * 68 + ar] = bf2f(av.x >> 16); As[(ak + 2) * 68 + ar] = bf2f(av.y & 0xffffu); As[(ak + 3) * 68 + ar] = bf2f(av.y >> 16);
        float bf[16]; unpack8(b0, bf); unpack8(b1, bf + 8);
#pragma unroll
        for (int i = 0; i < 16; ++i) Bs[(bk + i) * 260 + bn] = bf[i];
        __syncthreads();
#pragma unroll 4
        for (int k = 0; k < 32; ++k) {
            const float a0 = As[k * 68 + ty * 2], a1 = As[k * 68 + ty * 2 + 1];
            const f32x4 x0 = *(const LAS f32x4*)(Bs + k * 260 + tx * 8), x1 = *(const LAS f32x4*)(Bs + k * 260 + tx * 8 + 4);
            const f32x4 y0 = *(const LAS f32x4*)(Bs + k * 260 + 128 + tx * 8), y1 = *(const LAS f32x4*)(Bs + k * 260 + 128 + tx * 8 + 4);
            const float bb[16] = {x0.x, x0.y, x0.z, x0.w, x1.x, x1.y, x1.z, x1.w, y0.x, y0.y, y0.z, y0.w, y1.x, y1.y, y1.z, y1.w};
#pragma unroll
            for (int j = 0; j < 16; ++j) { acc[0][j] += a0 * bb[j]; acc[1][j] += a1 * bb[j]; }
        }
    }
#pragma unroll
    for (int i = 0; i < 2; ++i)
#pragma unroll
        for (int j = 0; j < 8; ++j) epi(row0 + ty * 2 + i, pn, tx * 8 + j, acc[i][j], acc[i][8 + j]);
    __syncthreads();
}
template <class Epi>
__device__ __forceinline__ void ngemm_dense(const Ctx& C, const bf16* A, const bf16* Bt, int M, int N, int K, const Epi& epi) {
    const int nN = N / 256, nU = (M / 64) * nN;
    for (int u = blockIdx.x; u < nU; u += gridDim.x) { const int tm = u / nN, pn = u % nN;
        ngemm_unit(C, A + (size_t)tm * 64 * K, Bt + (size_t)pn * 256 * K, K, tm * 64, pn, epi); }
}
template <class Epi>
__device__ __forceinline__ void ngemm_grouped(const Ctx& C, const bf16* A, const bf16* Bt, size_t estride, int N, int K, const Epi& epi) {
    const int* tile_e = (const int*)(C.ws + WS_ROUTE + RT_TILE); const int ntiles = *(const int*)(C.ws + WS_ROUTE + RT_NT);
    const int nN = N / 256, nU = ntiles * 4 * nN;
    for (int u = blockIdx.x; u < nU; u += gridDim.x) { const int pn = u % nN, tm = u / nN, e = tile_e[tm >> 2];
        ngemm_unit(C, A + (size_t)tm * 64 * K, Bt + (size_t)e * estride + (size_t)pn * 256 * K, K, tm * 64, pn, epi); }
}

struct EpiStoreBf16 { bf16* O; int ldc;
    __device__ __forceinline__ void operator()(int r, int pn, int c, float v0, float v1) const { bf16* o = O + (size_t)r * ldc + pn * 256 + c; o[0] = (bf16)f2bf(v0); o[128] = (bf16)f2bf(v1); } };
struct EpiResid0 { const Params* P; const float* mod; float* XC;
    __device__ __forceinline__ void operator()(int r, int pn, int c, float v0, float v1) const { const int n = pn * 256 + c; const float* xi = xin_row(*P, r); const float* g = mod + ((size_t)cond_of(r) * 6 + 2) * D;
        float* o = XC + (size_t)r * D; o[n] = xi[n] + g[n] * v0; o[n + 128] = xi[n + 128] + g[n + 128] * v1; } };
struct EpiResidAcc { const float* mod; float* XC;
    __device__ __forceinline__ void operator()(int r, int pn, int c, float v0, float v1) const { const int n = pn * 256 + c; const float* g = mod + ((size_t)cond_of(r) * 6 + 2) * D;
        float* o = XC + (size_t)r * D; o[n] += g[n] * v0; o[n + 128] += g[n + 128] * v1; } };
struct EpiSwiglu { bf16* G;
    __device__ __forceinline__ void operator()(int r, int pn, int c, float v0, float v1) const { G[(size_t)r * EH + pn * 128 + c] = (bf16)f2bf(silu_(v0) * v1); } };
struct EpiGlu { const bf16* GS; const float* b; bf16* GG;
    __device__ __forceinline__ void operator()(int r, int pn, int c, float v0, float v1) const { const int n = pn * 256 + c; const size_t o = (size_t)r * 512 + n;
        GG[o] = (bf16)f2bf(bf2f(GS[o]) * sigmoidf_(v0 + b[n])); GG[o + 128] = (bf16)f2bf(bf2f(GS[o + 128]) * sigmoidf_(v1 + b[n + 128])); } };

__device__ __forceinline__ void qk_norm_rope(float (&v)[8], const float* gain, bool lat, int t, int lane, const float2* rope) {
    float ss = 0.f;
#pragma unroll
    for (int j = 0; j < 8; ++j) ss += v[j] * v[j];
    ss += __shfl_xor(ss, 1); ss += __shfl_xor(ss, 2); ss += __shfl_xor(ss, 4);
    const float rstd = rsqrtf(ss * (1.f / 64.f) + EPS);
    const int l8 = lane & 7;
#pragma unroll
    for (int j = 0; j < 8; ++j) v[j] = v[j] * rstd * gain[l8 * 8 + j];
    const int quarter = l8 >> 1, pos = (quarter < 2) ? (t >> 6) : (t & 63);
#pragma unroll
    for (int j = 0; j < 8; ++j) {
        const float pv = __shfl_xor(v[j], 2);
        if (lat) { const float2 cs = rope[pos * 16 + (lane & 1) * 8 + j];
            v[j] = (quarter & 1) ? (v[j] * cs.x + pv * cs.y) : (v[j] * cs.x - pv * cs.y); }
    }
}
__device__ __forceinline__ void phase_qkprep(const Ctx& C) {
    const Params& P = *C.p; const bf16* Pb = (const bf16*)(C.ws + WS_P); bf16* Q = (bf16*)(C.ws + WS_Q); bf16* Kb = (bf16*)(C.ws + WS_K); bf16* Vb = (bf16*)(C.ws + WS_V);
    const float2* rope = (const float2*)(C.ws + WS_TAB + TAB_ROPE);
    for (int r = C.gw; r < TT; r += C.ngw) {
        const bool lat = r < TL; const int t = lat ? (r & 2047) : 0;
        const size_t kvrow = lat ? (size_t)(r >> 11) * KVL + CTXL + (r & 2047) : (size_t)((r - TL) >> 8) * KVL + ((r - TL) & 255);
        const bf16* pr = Pb + (size_t)r * MIXW;
        { float v[8]; unpack8(*(const v4u*)(pr + 8 * C.lane), v); qk_norm_rope(v, P.in[I_QG], lat, t, C.lane, rope);
          v4u o; o.x = pk2(v[0] * QSCALE, v[1] * QSCALE); o.y = pk2(v[2] * QSCALE, v[3] * QSCALE); o.z = pk2(v[4] * QSCALE, v[5] * QSCALE); o.w = pk2(v[6] * QSCALE, v[7] * QSCALE);
          *(v4u*)(Q + (size_t)r * 512 + 8 * C.lane) = o; }
        { const int l = C.lane & 15; float v[8]; unpack8(*(const v4u*)(pr + 512 + 8 * l), v); qk_norm_rope(v, P.in[I_KG], lat, t, C.lane, rope);
          if (C.lane < 16) { v4u o; o.x = pk2(v[0], v[1]); o.y = pk2(v[2], v[3]); o.z = pk2(v[4], v[5]); o.w = pk2(v[6], v[7]); *(v4u*)(Kb + kvrow * 128 + 8 * l) = o;
              *(v4u*)(Vb + kvrow * 128 + 8 * l) = *(const v4u*)(pr + 640 + 8 * l); } }
        { float v[8]; unpack8(*(const v4u*)(pr + 1280 + 8 * C.lane), v); float sm = 0.f;
#pragma unroll
          for (int j = 0; j < 8; ++j) { v[j] = gelu_tanh(v[j]); sm += v[j]; }
          const float mean = wave_sum(sm) * (1.f / 512.f); float qq = 0.f;
#pragma unroll
          for (int j = 0; j < 8; ++j) { const float d = v[j] - mean; qq += d * d; }
          const float rstd = rsqrtf(wave_sum(qq) * (1.f / 512.f) + EPS);
          if (C.lane == 0) ((float2*)(C.ws + WS_ROUTE + RT_S))[r] = make_float2(mean, rstd); }
    }
}

__device__ __forceinline__ void phase_gmlp(const Ctx& C) {
    const Params& P = *C.p; const bf16* Pb = (const bf16*)(C.ws + WS_P); bf16* OG = (bf16*)(C.ws + WS_H);
    LAS bf16* VN = (LAS bf16*)C.lds; constexpr int VP = 520;
    const int g = __builtin_amdgcn_readfirstlane(C.tid >> 6);
    for (int ch = blockIdx.x; ch < TT / 128; ch += gridDim.x) {
        for (int i = 0; i < 16; ++i) { const int rl = C.wave * 16 + i; const bf16* pr = Pb + (size_t)(ch * 128 + rl) * MIXW + 1280 + 8 * C.lane;
            float v[8]; unpack8(*(const v4u*)pr, v); float s = 0.f;
#pragma unroll
            for (int j = 0; j < 8; ++j) { v[j] = gelu_tanh(v[j]); s += v[j]; }
            const float mean = wave_sum(s) * (1.f / 512.f); float q = 0.f;
#pragma unroll
            for (int j = 0; j < 8; ++j) { v[j] -= mean; q += v[j] * v[j]; }
            const float rstd = rsqrtf(wave_sum(q) * (1.f / 512.f) + EPS);
#pragma unroll
            for (int j = 0; j < 8; ++j) v[j] = v[j] * rstd * P.in[I_LNG][8 * C.lane + j];
            v4u o; o.x = pk2(v[0], v[1]); o.y = pk2(v[2], v[3]); o.z = pk2(v[4], v[5]); o.w = pk2(v[6], v[7]);
            *(LAS v4u*)(VN + rl * VP + 8 * C.lane) = o; }
        __syncthreads();
        const float* wsp = P.in[I_WSP] + (size_t)g * 128 * 128; const float* bsp = P.in[I_BSP] + g * 128;
        for (int pb = 0; pb < 16; ++pb) {
            float acc[8];
#pragma unroll
            for (int i = 0; i < 8; ++i) acc[i] = 0.f;
            for (int q = 0; q < 128; ++q) { const float v = bf2f(VN[q * VP + C.tid]);
#pragma unroll
                for (int i = 0; i < 8; ++i) acc[i] += wsp[(pb * 8 + i) * 128 + q] * v; }
#pragma unroll
            for (int i = 0; i < 8; ++i) { const int p = pb * 8 + i; const size_t row = (size_t)ch * 128 + p;
                const float u = gelu_tanh(bf2f(Pb[row * MIXW + 768 + C.tid]));
                OG[row * D + 512 + C.tid] = (bf16)f2bf(u * (acc[i] + bsp[p])); }
        }
        __syncthreads();
    }
}


__device__ __forceinline__ unsigned gm_off_b(unsigned row, unsigned ch) { return 256u * row + 16u * (ch ^ (((row & 3u) << 2) | ((row >> 2) & 3u))); }
__device__ __forceinline__ void phase_gmlp_fast(const Ctx& C) {
    typedef short bf16x8 __attribute__((ext_vector_type(8)));
    typedef short s16x4 __attribute__((ext_vector_type(4)));
    typedef float f32x16 __attribute__((ext_vector_type(16)));
    const Params& P = *C.p; const bf16* Pb = (const bf16*)(C.ws + WS_P); bf16* OG = (bf16*)(C.ws + WS_H); const bf16* W16 = (const bf16*)(C.ws + WS_WSP);
    const float2* lns = (const float2*)(C.ws + WS_ROUTE + RT_S);
    const int tid = C.tid, lane = C.lane, w = C.wave, l31 = lane & 31, hi = lane >> 5;
    const int gsel = w >> 2, pb = w & 3;
    for (int u = blockIdx.x; u < (TT / 128) * 4; u += gridDim.x) {
        const int ch_ = u >> 2, gp = u & 3;
        { const int row = tid >> 2; const size_t grow = (size_t)ch_ * 128 + row; const float2 st = lns[grow];
#pragma unroll
          for (int i = 0; i < 4; ++i) { const int c16 = (tid & 3) + 4 * i; float v[8]; unpack8(*(const v4u*)(Pb + grow * MIXW + 1280 + 128 * gp + 8 * c16), v);
              const float* lg = P.in[I_LNG] + 128 * gp + 8 * c16;
#pragma unroll
              for (int j = 0; j < 8; ++j) v[j] = (gelu_tanh(v[j]) - st.x) * st.y * lg[j];
              v4u o; o.x = pk2(v[0], v[1]); o.y = pk2(v[2], v[3]); o.z = pk2(v[4], v[5]); o.w = pk2(v[6], v[7]);
              *(LAS v4u*)(C.lds + (row >> 5) * 8192 + gm_off_b(row & 31, c16)) = o; } }
        __syncthreads();
        const int g = 2 * gp + gsel;
        f32x16 acc[2]; acc[0] = f32x16{}; acc[1] = f32x16{};
        const bf16* wrow = W16 + ((size_t)g * 128 + 32 * pb + l31) * 128 + 8 * hi;
#pragma unroll
        for (int k8 = 0; k8 < 8; ++k8) {
            const bf16x8 xf = *(const bf16x8*)(wrow + 16 * k8);
            const unsigned rb = k8 >> 1, ks = k8 & 1;
#pragma unroll
            for (int db = 0; db < 2; ++db) { const unsigned c = 2 * gsel + db, blk = (lane >> 4) & 1, q = (lane & 15) >> 2, p2 = lane & 3;
                s16x4 t0, t1;
                { const unsigned a0 = rb * 8192 + gm_off_b(16 * ks + 8 * hi + q, 4 * c + 2 * blk + (p2 >> 1)) + 8 * (p2 & 1);
                  const unsigned a1 = rb * 8192 + gm_off_b(16 * ks + 8 * hi + 4 + q, 4 * c + 2 * blk + (p2 >> 1)) + 8 * (p2 & 1);
                  t0 = __builtin_bit_cast(s16x4, __builtin_amdgcn_ds_read_tr16_b64_v4i16((LAS s16x4*)(C.lds + a0)));
                  t1 = __builtin_bit_cast(s16x4, __builtin_amdgcn_ds_read_tr16_b64_v4i16((LAS s16x4*)(C.lds + a1))); }
                const bf16x8 yf = {t0[0], t0[1], t0[2], t0[3], t1[0], t1[1], t1[2], t1[3]};
                acc[db] = __builtin_amdgcn_mfma_f32_32x32x16_bf16(xf, yf, acc[db], 0, 0, 0); }
        }
        const float* bsp = P.in[I_BSP] + g * 128 + 32 * pb;
#pragma unroll
        for (int r = 0; r < 16; ++r) { const int pl = (r & 3) + 8 * (r >> 2) + 4 * hi; const size_t grow = (size_t)ch_ * 128 + 32 * pb + pl; const float bb = bsp[pl];
#pragma unroll
            for (int db = 0; db < 2; ++db) { const int col = 64 * g + 32 * db + l31; const float uu = gelu_tanh(bf2f(Pb[grow * MIXW + 768 + col]));
                OG[grow * D + 512 + col] = (bf16)f2bf(uu * (acc[db][r] + bb)); } }
        __syncthreads();
    }
}

__device__ __forceinline__ void attn_item(const Ctx& C, int b, int h, int qrow_g, int nk) {
    const bf16* Q = (const bf16*)(C.ws + WS_Q); const bf16* Kb = (const bf16*)(C.ws + WS_K) + (size_t)b * KVL * 128 + (h >> 2) * 64; const bf16* Vb = (const bf16*)(C.ws + WS_V) + (size_t)b * KVL * 128 + (h >> 2) * 64;
    bf16* OG = (bf16*)(C.ws + WS_H);
    float q[64];
#pragma unroll
    for (int i = 0; i < 8; ++i) unpack8(*(const v4u*)(Q + (size_t)qrow_g * 512 + h * 64 + 8 * i), q + 8 * i);
    float m = -INFINITY, l = 0.f, o = 0.f;
    for (int kt = 0; kt < nk; kt += 64) {
        const bf16* kr = Kb + (size_t)(kt + C.lane) * 128; float s = 0.f;
#pragma unroll
        for (int i = 0; i < 8; ++i) { float kf[8]; unpack8(*(const v4u*)(kr + 8 * i), kf);
#pragma unroll
            for (int j = 0; j < 8; ++j) s += q[8 * i + j] * kf[j]; }
        const float mn = fmaxf(m, wave_max(s)); const float p = exp2f(s - mn), corr = exp2f(m - mn);
        l = l * corr + wave_sum(p); o *= corr; m = mn;
#pragma unroll 8
        for (int jj = 0; jj < 64; ++jj) { const float pj = __shfl(p, jj); o += pj * bf2f(Vb[(size_t)(kt + jj) * 128 + C.lane]); }
    }
    OG[(size_t)qrow_g * D + h * 64 + C.lane] = (bf16)f2bf(o / l);
}
__device__ __forceinline__ void phase_attn(const Ctx& C) {
    for (int it = C.gw; it < NB * 8 * SEQ; it += C.ngw) { const int bh = it >> 11, t = it & 2047, b = bh >> 3, h = bh & 7; attn_item(C, b, h, b * SEQ + t, KVL); }
    for (int it = C.gw; it < NB * 8 * CTXL; it += C.ngw) { const int bh = it >> 8, t = it & 255, b = bh >> 3, h = bh & 7; attn_item(C, b, h, TL + b * CTXL + t, CTXL); }
}


__device__ __forceinline__ void phase_attn_fast(const Ctx& C, char* lds_generic) {
    typedef attn_body::bf16 abf;
    const abf* Q = (const abf*)(C.ws + WS_Q); const abf* Kb = (const abf*)(C.ws + WS_K); const abf* Vb = (const abf*)(C.ws + WS_V); abf* OG = (abf*)(C.ws + WS_H);
    const int G = gridDim.x, bx = blockIdx.x; const int vcu = (G % 8 == 0) ? (bx % 8) * (G / 8) + bx / 8 : bx;
    const int per = (1024 + G - 1) / G, perc = (128 + G - 1) / G;
    for (int i = 0; i < per + perc; ++i) {
        int b, h, nt; size_t qrow;
        if (i < per) { const int u = vcu * per + i; if (u >= 1024) continue; const int qb = u & 7, hg = (u >> 3) & 3, bk = u >> 5; b = bk >> 1; h = (bk & 1) * 4 + hg; qrow = (size_t)b * SEQ + qb * 256; nt = KVL / 64; }
        else { const int u = vcu + (i - per) * G; if (u >= 128) continue; b = u >> 3; h = u & 7; qrow = (size_t)TL + (size_t)b * CTXL; nt = CTXL / 64; }
        const size_t kvo = (size_t)b * KVL * 128 + (h >> 2) * 64;
        attn_body::attn_unit<8>(Q + qrow * 512 + h * 64, Kb + kvo, Vb + kvo, OG + qrow * 1024 + h * 64, nt, lds_generic);
    }
}

__device__ __forceinline__ void phase_norm_ffn_router(const Ctx& C, int layer, int nrows) {
    const Params& P = *C.p; const float* XC = (const float*)(C.ws + WS_XC); bf16* F = (bf16*)(C.ws + WS_H);
    int* asg_e = (int*)(C.ws + WS_ROUTE + RT_E); int* asg_p = (int*)(C.ws + WS_ROUTE + RT_P); float* asg_w = (float*)(C.ws + WS_ROUTE + RT_W);
    unsigned* cnt = (unsigned*)(C.ws + WS_CTL) + CW_CNT + 64 * layer;
    const float* wg = P.in[I_WGRP] + (size_t)layer * D * 4; const float* wr = P.in[I_WRT] + (size_t)layer * D * 32;
    for (int r = C.gw; r < nrows; r += C.ngw) {
        f32x4 v[4]; load_row16(XC + (size_t)r * D, C.lane, v);
        const float rstd = row_rstd(v); const int ci = cond_of(r);
        modulate16(v, rstd, P.in[I_GFFN] + layer * D, mod_vec(C, layer, ci, 4), mod_vec(C, layer, ci, 3), C.lane);
        store_row16_bf16(F + (size_t)r * D, C.lane, v);
        float lg[4] = {0.f, 0.f, 0.f, 0.f}; float le[32];
#pragma unroll
        for (int i = 0; i < 32; ++i) le[i] = 0.f;
#pragma unroll
        for (int j = 0; j < 4; ++j)
#pragma unroll
            for (int i = 0; i < 4; ++i) { const int c = 4 * C.lane + 256 * j + i; const float f = v[j][i];
                const f32x4 g4 = *(const f32x4*)(wg + (size_t)c * 4); lg[0] += f * g4.x; lg[1] += f * g4.y; lg[2] += f * g4.z; lg[3] += f * g4.w;
#pragma unroll
                for (int e4 = 0; e4 < 8; ++e4) { const f32x4 w4 = *(const f32x4*)(wr + (size_t)c * 32 + e4 * 4); le[e4 * 4] += f * w4.x; le[e4 * 4 + 1] += f * w4.y; le[e4 * 4 + 2] += f * w4.z; le[e4 * 4 + 3] += f * w4.w; } }
#pragma unroll
        for (int i = 0; i < 4; ++i) lg[i] = wave_sum(lg[i]) + P.in[I_BGRP][layer * 4 + i];
#pragma unroll
        for (int i = 0; i < 32; ++i) le[i] = wave_sum(le[i]) + P.in[I_BRT][layer * 32 + i];
        int gi = 0; float gm = lg[0];
#pragma unroll
        for (int i = 1; i < 4; ++i) if (lg[i] > gm) { gm = lg[i]; gi = i; }
        float den = 0.f;
#pragma unroll
        for (int i = 0; i < 4; ++i) den += __expf(lg[i] - gm);
        const float gw_ = 1.f / den;
        float sel[8];
#pragma unroll
        for (int i = 0; i < 8; ++i) sel[i] = gi == 0 ? le[i] : gi == 1 ? le[8 + i] : gi == 2 ? le[16 + i] : le[24 + i];
        int i0 = 0; float v0 = sel[0];
#pragma unroll
        for (int i = 1; i < 8; ++i) if (sel[i] > v0) { v0 = sel[i]; i0 = i; }
        int i1 = -1; float v1 = -INFINITY;
#pragma unroll
        for (int i = 0; i < 8; ++i) if (i != i0 && sel[i] > v1) { v1 = sel[i]; i1 = i; }
        const float e1 = __expf(v1 - v0), w0 = gw_ / (1.f + e1), w1 = gw_ * e1 / (1.f + e1);
        if (C.lane == 0) {
            const int ea = gi * 8 + i0, eb = gi * 8 + i1;
            const unsigned pa = __hip_atomic_fetch_add(cnt + ea, 1u, __ATOMIC_RELAXED, __HIP_MEMORY_SCOPE_AGENT);
            const unsigned pb = __hip_atomic_fetch_add(cnt + eb, 1u, __ATOMIC_RELAXED, __HIP_MEMORY_SCOPE_AGENT);
            asg_e[2 * r] = ea; asg_e[2 * r + 1] = eb; asg_p[2 * r] = (int)pa; asg_p[2 * r + 1] = (int)pb; asg_w[2 * r] = w0; asg_w[2 * r + 1] = w1;
        }
    }
}

__device__ __forceinline__ void phase_router_fast(const Ctx& C, int layer, int nrows) {
    typedef short bf16x8 __attribute__((ext_vector_type(8)));
    const Params& P = *C.p; const float* XC = (const float*)(C.ws + WS_XC); bf16* F = (bf16*)(C.ws + WS_H);
    int* asg_e = (int*)(C.ws + WS_ROUTE + RT_E); int* asg_p = (int*)(C.ws + WS_ROUTE + RT_P); float* asg_w = (float*)(C.ws + WS_ROUTE + RT_W); int* list = (int*)(C.ws + WS_LIST);
    unsigned* cnt = (unsigned*)(C.ws + WS_CTL) + CW_CNT + 64 * layer;
    const bf16x8* WR = (const bf16x8*)(C.ws + WS_TAB + TAB_WR) + (size_t)layer * (32 * 3 * 2 * 64) + C.lane;
    const int l15 = C.lane & 15, q4 = C.lane >> 4;
    const float* gg = P.in[I_GFFN] + layer * D + 8 * q4;
    for (int it = C.gw; it < nrows / 16; it += C.ngw) {
        const int row = it * 16 + l15, ci = cond_of(it * 16);
        const float* xr = XC + (size_t)row * D + 8 * q4; const float* sc = mod_vec(C, layer, ci, 4) + 8 * q4; const float* sh = mod_vec(C, layer, ci, 3) + 8 * q4;
        float ss = 0.f;
#pragma unroll 8
        for (int kk = 0; kk < 32; ++kk) { const f32x4 a = *(const f32x4*)(xr + 32 * kk), b = *(const f32x4*)(xr + 32 * kk + 4); ss += (a.x * a.x + a.y * a.y) + (a.z * a.z + a.w * a.w) + (b.x * b.x + b.y * b.y) + (b.z * b.z + b.w * b.w); }
        ss += __shfl_xor(ss, 16); ss += __shfl_xor(ss, 32);
        const float rstd = rsqrtf(ss * (1.f / D) + EPS);
        f32x4 acc[3]; acc[0] = (f32x4){0.f, 0.f, 0.f, 0.f}; acc[1] = acc[0]; acc[2] = acc[0];
        bf16* frow = F + (size_t)row * D + 8 * q4;
#pragma unroll 2
        for (int kk = 0; kk < 32; ++kk) {
            const int c = 32 * kk;
            f32x4 f0 = *(const f32x4*)(xr + c) * rstd * *(const f32x4*)(gg + c) * (*(const f32x4*)(sc + c) + 1.f) + *(const f32x4*)(sh + c);
            f32x4 f1 = *(const f32x4*)(xr + c + 4) * rstd * *(const f32x4*)(gg + c + 4) * (*(const f32x4*)(sc + c + 4) + 1.f) + *(const f32x4*)(sh + c + 4);
            const pg8::u32x4 fh = pg8::pack8(f0, f1); *(pg8::u32x4*)(frow + c) = fh;
            pg8::f32x4 r0, r1; pg8::unpack8f(fh, r0, r1);
            const pg8::u32x4 fl = pg8::pack8(f0 - r0, f1 - r1);
            const bf16x8 ah = __builtin_bit_cast(bf16x8, fh), al = __builtin_bit_cast(bf16x8, fl);
#pragma unroll
            for (int jb = 0; jb < 3; ++jb) { const bf16x8 wh = WR[((kk * 3 + jb) * 2) * 64], wl = WR[((kk * 3 + jb) * 2 + 1) * 64];
                acc[jb] = __builtin_amdgcn_mfma_f32_16x16x32_bf16(wh, ah, acc[jb], 0, 0, 0);
                acc[jb] = __builtin_amdgcn_mfma_f32_16x16x32_bf16(wh, al, acc[jb], 0, 0, 0);
                acc[jb] = __builtin_amdgcn_mfma_f32_16x16x32_bf16(wl, ah, acc[jb], 0, 0, 0); }
        }
        const float* brt = P.in[I_BRT] + layer * 32 + q4 * 8;
        float e[8];
#pragma unroll
        for (int r = 0; r < 4; ++r) { e[r] = acc[0][r] + brt[r]; e[4 + r] = acc[1][r] + brt[4 + r]; }
        const float gl = acc[2][0] + P.in[I_BGRP][layer * 4 + q4];
        float gm = gl; int gi = q4;
#pragma unroll
        for (int st = 16; st <= 32; st <<= 1) { const float og = __shfl_xor(gm, st); const int oi = __shfl_xor(gi, st); if (og > gm || (og == gm && oi < gi)) { gm = og; gi = oi; } }
        float den = __expf(gl - gm); den += __shfl_xor(den, 16); den += __shfl_xor(den, 32);
        if (q4 == gi) {
            const float gw_ = 1.f / den;
            int i0 = 0; float v0 = e[0];
#pragma unroll
            for (int i = 1; i < 8; ++i) if (e[i] > v0) { v0 = e[i]; i0 = i; }
            int i1 = -1; float v1 = -INFINITY;
#pragma unroll
            for (int i = 0; i < 8; ++i) if (i != i0 && e[i] > v1) { v1 = e[i]; i1 = i; }
            const float e1 = __expf(v1 - v0), w0 = gw_ / (1.f + e1), w1 = gw_ * e1 / (1.f + e1);
            const int ea = gi * 8 + i0, eb = gi * 8 + i1;
            const unsigned pa = __hip_atomic_fetch_add(cnt + ea, 1u, __ATOMIC_RELAXED, __HIP_MEMORY_SCOPE_AGENT);
            const unsigned pb = __hip_atomic_fetch_add(cnt + eb, 1u, __ATOMIC_RELAXED, __HIP_MEMORY_SCOPE_AGENT);
            asg_e[2 * row] = ea; asg_e[2 * row + 1] = eb; asg_p[2 * row] = (int)pa; asg_p[2 * row + 1] = (int)pb; asg_w[2 * row] = w0; asg_w[2 * row + 1] = w1;
            list[(size_t)ea * LCAP + pa] = row; list[(size_t)eb * LCAP + pb] = row;
        }
    }
}

__device__ __forceinline__ void phase_gather(const Ctx& C, int layer, int nrows) {
    const bf16* F = (const bf16*)(C.ws + WS_H); bf16* XS = (bf16*)(C.ws + WS_XS);
    const int* asg_e = (const int*)(C.ws + WS_ROUTE + RT_E); const int* asg_p = (const int*)(C.ws + WS_ROUTE + RT_P); int* asg_s = (int*)(C.ws + WS_ROUTE + RT_S);
    int* tile_e = (int*)(C.ws + WS_ROUTE + RT_TILE); int* ntl = (int*)(C.ws + WS_ROUTE + RT_NT);
    unsigned* cnt = (unsigned*)(C.ws + WS_CTL) + CW_CNT + 64 * layer;
    const int mycnt = (C.lane < 32) ? (int)__hip_atomic_load(cnt + C.lane, __ATOMIC_RELAXED, __HIP_MEMORY_SCOPE_AGENT) : 0;
    const int mypad = (mycnt + 255) & ~255;
    int incl = mypad;
#pragma unroll
    for (int o = 1; o < 32; o <<= 1) { const int t = __shfl_up(incl, o); if ((C.lane & 31) >= o) incl += t; }
    const int ps = incl - mypad;
    for (int it = C.gw; it < nrows * 2; it += C.ngw) {
        const int e = asg_e[it], p = asg_p[it]; const int slot = __shfl(ps, e) + p;
        if (C.lane == 0) asg_s[it] = slot;
        const v4u* src = (const v4u*)(F + (size_t)(it >> 1) * D); v4u* dst = (v4u*)(XS + (size_t)slot * D);
        dst[C.lane] = src[C.lane]; dst[64 + C.lane] = src[64 + C.lane];
    }
    for (int e = C.gw; e < 33; e += C.ngw) {
        if (e < 32) { const int c0 = __shfl(mycnt, e), c1 = __shfl(mypad, e), base = __shfl(ps, e);
            for (int rr = c0; rr < c1; ++rr) { v4u* dst = (v4u*)(XS + (size_t)(base + rr) * D); const v4u z = {0u, 0u, 0u, 0u}; dst[C.lane] = z; dst[64 + C.lane] = z; } }
        else { if (C.lane < 32) { for (int t = ps / 256; t < (ps + mypad) / 256; ++t) tile_e[t] = C.lane; if (C.lane == 31) *ntl = (ps + mypad) / 256; } }
    }
}
__device__ __forceinline__ int wave_pstart(const Ctx& C, int layer) {
    const unsigned* cnt = (const unsigned*)(C.ws + WS_CTL) + CW_CNT + 64 * layer;
    const int mc = C.lane < 32 ? (int)__hip_atomic_load(cnt + (C.lane & 31), __ATOMIC_RELAXED, __HIP_MEMORY_SCOPE_AGENT) : 0; const int mp = (mc + 255) & ~255; int in = mp;
#pragma unroll
    for (int o = 1; o < 32; o <<= 1) { const int t = __shfl_up(in, o); if ((C.lane & 31) >= o) in += t; }
    return in - mp;
}
__device__ __forceinline__ void moe_combine(const Ctx& C, int layer, int r, int ps, f32x4 (&v)[4]) {
    const bf16* Y2 = (const bf16*)(C.ws + WS_XS); const int* asg_s = (const int*)(C.ws + WS_ROUTE + RT_S); const float* asg_w = (const float*)(C.ws + WS_ROUTE + RT_W);
    const float* XC = (const float*)(C.ws + WS_XC);
    load_row16(XC + (size_t)r * D, C.lane, v);
    const int* asg_e = (const int*)(C.ws + WS_ROUTE + RT_E); const int* asg_p = (const int*)(C.ws + WS_ROUTE + RT_P); (void)asg_s;
    const int s0 = __shfl(ps, asg_e[2 * r]) + asg_p[2 * r], s1 = __shfl(ps, asg_e[2 * r + 1]) + asg_p[2 * r + 1]; const float w0 = asg_w[2 * r], w1 = asg_w[2 * r + 1];
    const float* gate = mod_vec(C, layer, cond_of(r), 5);
#pragma unroll
    for (int j = 0; j < 4; ++j) { const int c = 4 * C.lane + 256 * j; const v2u a = *(const v2u*)(Y2 + (size_t)s0 * D + c), b = *(const v2u*)(Y2 + (size_t)s1 * D + c); const f32x4 g = *(const f32x4*)(gate + c);
        v[j].x += g.x * (w0 * bf2f(a.x & 0xffffu) + w1 * bf2f(b.x & 0xffffu)); v[j].y += g.y * (w0 * bf2f(a.x >> 16) + w1 * bf2f(b.x >> 16));
        v[j].z += g.z * (w0 * bf2f(a.y & 0xffffu) + w1 * bf2f(b.y & 0xffffu)); v[j].w += g.w * (w0 * bf2f(a.y >> 16) + w1 * bf2f(b.y >> 16)); }
}
__device__ __forceinline__ void phase_combine_norm_mix1(const Ctx& C) {
    const Params& P = *C.p; float* XC = (float*)(C.ws + WS_XC); bf16* H = (bf16*)(C.ws + WS_H);
    const int ps = wave_pstart(C, 0);
    for (int r = C.gw; r < TT; r += C.ngw) {
        f32x4 v[4]; moe_combine(C, 0, r, ps, v);
#pragma unroll
        for (int j = 0; j < 4; ++j) *(f32x4*)(XC + (size_t)r * D + 4 * C.lane + 256 * j) = v[j];
        const float rstd = row_rstd(v); const int ci = cond_of(r);
        modulate16(v, rstd, P.in[I_GMIX] + D, mod_vec(C, 1, ci, 1), mod_vec(C, 1, ci, 0), C.lane);
        store_row16_bf16(H + (size_t)r * D, C.lane, v);
    }
    LAS float* scr = (LAS float*)(C.lds + C.wave * 16384);
    for (int it = C.gw; it < MOE_ITEMS; it += C.ngw) moe_convert_item(C, 1, it, scr);
}
__device__ __forceinline__ void phase_final(const Ctx& C) {
    const Params& P = *C.p;
    const int ps = wave_pstart(C, 1);
    for (int r = C.gw; r < TL; r += C.ngw) {
        f32x4 v[4]; moe_combine(C, 1, r, ps, v);
        const float rstd = row_rstd(v);
#pragma unroll
        for (int j = 0; j < 4; ++j) { const int c = 4 * C.lane + 256 * j; const f32x4 g = *(const f32x4*)(P.in[I_FING] + c); *(f32x4*)(P.out + (size_t)r * D + c) = v[j] * rstd * g; }
    }
}

__device__ __forceinline__ void phase_s5(const Ctx& C) {
    const Params& P = *C.p; const bf16* U = (const bf16*)(C.ws + WS_U); bf16* GS = (bf16*)(C.ws + WS_GS); float* YA = (float*)(C.ws + WS_YACC);
    const float2* lamb = (const float2*)(C.ws + WS_TAB + TAB_LAMB); const float2* bbar = (const float2*)(C.ws + WS_TAB + TAB_BBAR);
    LAS f32x2* hb = (LAS f32x2*)(C.lds + C.wave * 8192);
    const int lane = C.lane;
    for (int it = C.gw; it < NB * 32; it += C.ngw) {
        const int b = it >> 5, g = it & 31;
        for (int dir = 0; dir < 2; ++dir) {
            const int dgn = ((dir * 32 + g) * 64 + lane);
            const float2 lam = lamb[dgn]; float2 bb[16];
#pragma unroll
            for (int p = 0; p < 16; ++p) bb[p] = bbar[(size_t)dgn * 16 + p];
            const float* cre = P.in[I_CRE] + (size_t)(dir * 32 + g) * 16 * 64; const float* cim = P.in[I_CIM] + (size_t)(dir * 32 + g) * 16 * 64;
            float hr = 0.f, hi = 0.f;
            for (int ck = 0; ck < 144; ++ck) {
                const bool isl = ck >= 16;
                const int tb = isl ? (dir == 0 ? (ck - 16) * 16 : (143 - ck) * 16) : (dir == 0 ? ck * 16 : (15 - ck) * 16);
                const size_t rowb = isl ? (size_t)b * SEQ + tb : (size_t)TL + (size_t)b * CTXL + tb;
                for (int sl = 0; sl < 16; ++sl) {
                    const int to = dir == 0 ? sl : 15 - sl;
                    const bf16* ur = U + (rowb + to) * 512 + g * 16; float uf[16]; unpack8(*(const v4u*)ur, uf); unpack8(*(const v4u*)(ur + 8), uf + 8);
                    float br = 0.f, bi = 0.f;
#pragma unroll
                    for (int p = 0; p < 16; ++p) { br += bb[p].x * uf[p]; bi += bb[p].y * uf[p]; }
                    const float nr = lam.x * hr - lam.y * hi + br, ni = lam.x * hi + lam.y * hr + bi; hr = nr; hi = ni;
                    if (isl) hb[to * 64 + lane] = (f32x2){hr, hi};
                }
                if (isl) {
                    asm volatile("s_waitcnt lgkmcnt(0)" ::: "memory");
                    const int p = lane & 15;
#pragma unroll
                    for (int i = 0; i < 4; ++i) { const int to = (lane >> 4) + 4 * i; float y = 0.f;
                        for (int n = 0; n < 64; ++n) { const f32x2 h = hb[to * 64 + n]; y += cre[p * 64 + n] * h.x - cim[p * 64 + n] * h.y; }
                        const size_t o = (rowb + to) * 512 + g * 16 + p;
                        if (dir == 0) YA[o] = y + P.in[I_S5D][g * 16 + p] * bf2f(U[o]);
                        else GS[o] = (bf16)f2bf(gelu_tanh(YA[o] + y)); }
                    asm volatile("s_waitcnt lgkmcnt(0)" ::: "memory");
                }
            }
        }
    }
}


__device__ __forceinline__ void phase_s5_fast(const Ctx& C) {
    typedef short bf16x8 __attribute__((ext_vector_type(8)));
    typedef float f32x16 __attribute__((ext_vector_type(16)));
    const Params& P = *C.p; const bf16* U = (const bf16*)(C.ws + WS_U); bf16* GS = (bf16*)(C.ws + WS_GS); float* YA = (float*)(C.ws + WS_YACC);
    const float2* lamb = (const float2*)(C.ws + WS_TAB + TAB_LAMB); const float2* bbar = (const float2*)(C.ws + WS_TAB + TAB_BBAR);
    constexpr int HP = 272;
    const int lane = C.lane, w = C.wave, il = w >> 2, dir = (w >> 1) & 1, nh = w & 1;
    const int l31 = lane & 31, hi = lane >> 5, l15 = lane & 15, q4 = lane >> 4;
    LAS unsigned char* Hb = C.lds + (il * 2 + dir) * (2 * 32 * HP);
    const int srow = (l31 & 3) + 4 * (l31 >> 3) + 16 * ((l31 >> 2) & 1);
    for (int it0 = blockIdx.x; it0 < NB * 16; it0 += gridDim.x) {
        const int item = it0 * 2 + il, b = item >> 5, g = item & 31;
        const int dg = dir * 32 + g, n = nh * 32 + l31;
        const float2 lam = lamb[dg * 64 + n];
        float lpr[16], lpi[16]; { float pr = lam.x, pi = lam.y;
#pragma unroll
            for (int r = 0; r < 16; ++r) { lpr[r] = pr; lpi[r] = pi; const float nr = pr * lam.x - pi * lam.y, ni = pr * lam.y + pi * lam.x; pr = nr; pi = ni; } }
        bf16x8 bre, bim; { const float2* bp = bbar + ((size_t)(dg * 64 + n)) * 16 + 8 * hi;
#pragma unroll
            for (int e = 0; e < 8; ++e) { const float2 v = bp[e]; bre[e] = (short)f2bf(v.x); bim[e] = (short)f2bf(v.y); } }
        bf16x8 cf[4]; { const float* cre = P.in[I_CRE] + ((size_t)dg * 16 + l15) * 64; const float* cim = P.in[I_CIM] + ((size_t)dg * 16 + l15) * 64;
#pragma unroll
            for (int ks = 0; ks < 4; ++ks) { const f32x4 a = *(const f32x4*)(cre + 16 * ks + 4 * q4), m = *(const f32x4*)(cim + 16 * ks + 4 * q4);
                cf[ks][0] = (short)f2bf(a.x); cf[ks][1] = (short)f2bf(-m.x); cf[ks][2] = (short)f2bf(a.y); cf[ks][3] = (short)f2bf(-m.y);
                cf[ks][4] = (short)f2bf(a.z); cf[ks][5] = (short)f2bf(-m.z); cf[ks][6] = (short)f2bf(a.w); cf[ks][7] = (short)f2bf(-m.w); } }
        const f32x4 dsk = *(const f32x4*)(P.in[I_S5D] + g * 16 + 4 * q4);
        float cr = 0.f, ci = 0.f;
#define S5_UROW(kk) ({ const int S_ = 32 * (kk) + srow; (S_ < CTXL) ? ((size_t)TL + (size_t)b * CTXL + (dir == 0 ? S_ : CTXL - 1 - S_)) : ((size_t)b * SEQ + (dir == 0 ? S_ - CTXL : SEQ - 1 - (S_ - CTXL))); })
        bf16x8 ua_next = *(const bf16x8*)(U + S5_UROW(0) * 512 + g * 16 + 8 * hi);
        for (int k = 0; k < 72; ++k) {
            const bf16x8 ua = ua_next;
            if (k + 1 < 72) ua_next = *(const bf16x8*)(U + S5_UROW(k + 1) * 512 + g * 16 + 8 * hi);
            const int sl = 32 * (k - 8) + 16 * nh + l15;
            const int tok = dir == 0 ? sl : SEQ - 1 - sl; const int lt = tok >> 5;
            const size_t o = ((size_t)b * SEQ + (k >= 8 ? tok : 0)) * 512 + g * 16 + 4 * q4;
            const bool first = dir == 0 ? (lt < 32) : (lt >= 32);
            f32x4 pk = {0.f, 0.f, 0.f, 0.f}; v2u uu = {0u, 0u};
            if (k >= 8 && !first) {
                pk.x = __hip_atomic_load(YA + o, __ATOMIC_RELAXED, __HIP_MEMORY_SCOPE_AGENT); pk.y = __hip_atomic_load(YA + o + 1, __ATOMIC_RELAXED, __HIP_MEMORY_SCOPE_AGENT);
                pk.z = __hip_atomic_load(YA + o + 2, __ATOMIC_RELAXED, __HIP_MEMORY_SCOPE_AGENT); pk.w = __hip_atomic_load(YA + o + 3, __ATOMIC_RELAXED, __HIP_MEMORY_SCOPE_AGENT);
                uu = *(const v2u*)(U + o);
            }
            {
              f32x16 br = {}, bi = {};
              br = __builtin_amdgcn_mfma_f32_32x32x16_bf16(ua, bre, br, 0, 0, 0);
              bi = __builtin_amdgcn_mfma_f32_32x32x16_bf16(ua, bim, bi, 0, 0, 0);
              float sr = hi ? 0.f : cr, si = hi ? 0.f : ci;
#pragma unroll
              for (int r = 0; r < 16; ++r) { const float nr = lam.x * sr - lam.y * si + br[r], ni = lam.x * si + lam.y * sr + bi[r]; sr = nr; si = ni; br[r] = sr; bi[r] = si; }
              float er = __shfl_xor(sr, 32), ei = __shfl_xor(si, 32); if (!hi) { er = 0.f; ei = 0.f; }
              { const f32x2 er2 = {er, er}, ei2 = {ei, ei};
#pragma unroll
              for (int r = 0; r < 16; r += 2) { const f32x2 pr2 = {lpr[r], lpr[r + 1]}, pi2 = {lpi[r], lpi[r + 1]}; f32x2 b2 = {br[r], br[r + 1]}, i2 = {bi[r], bi[r + 1]};
                  b2 = b2 + pr2 * er2 - pi2 * ei2; i2 = i2 + pr2 * ei2 + pi2 * er2; br[r] = b2.x; br[r + 1] = b2.y; bi[r] = i2.x; bi[r + 1] = i2.y; } }
              cr = __shfl_xor(br[15], 32); ci = __shfl_xor(bi[15], 32);
              LAS unsigned char* hb = Hb + (k & 1) * (32 * HP) + (16 * hi) * HP + 4 * n;
#pragma unroll
              for (int r = 0; r < 16; ++r) *(LAS unsigned*)(hb + r * HP) = pk2(br[r], bi[r]);
            }
            asm volatile("s_waitcnt lgkmcnt(0)\n\ts_barrier" ::: "memory");
            if (k >= 8) {
                const LAS unsigned char* hr = Hb + (k & 1) * (32 * HP) + (16 * nh + l15) * HP + 16 * q4;
                f32x4 y = {0.f, 0.f, 0.f, 0.f};
#pragma unroll
                for (int ks = 0; ks < 4; ++ks) { const bf16x8 hf = *(const LAS bf16x8*)(hr + 64 * ks); y = __builtin_amdgcn_mfma_f32_16x16x32_bf16(cf[ks], hf, y, 0, 0, 0); }
                if (first) { *(f32x4*)(YA + o) = y; }
                else {
                    const f32x4 uf = {bf2f(uu.x & 0xffffu), bf2f(uu.x >> 16), bf2f(uu.y & 0xffffu), bf2f(uu.y >> 16)};
                    const f32x4 t = y + pk + dsk * uf;
                    v2u ov; ov.x = pk2(gelu_tanh(t.x), gelu_tanh(t.y)); ov.y = pk2(gelu_tanh(t.z), gelu_tanh(t.w)); *(v2u*)(GS + o) = ov;
                }
            }
            if (k == 39) asm volatile("s_waitcnt vmcnt(0)\n\ts_barrier" ::: "memory");
        }
#undef S5_UROW
        asm volatile("s_waitcnt vmcnt(0) lgkmcnt(0)\n\ts_barrier" ::: "memory");
    }
}

__global__ void __launch_bounds__(NTHR, 2) fwd_kernel(Params prm) {
    extern __shared__ __attribute__((aligned(16))) unsigned char lds_raw[];
    Ctx C; C.p = &prm; C.ws = prm.ws; C.lds = (LAS unsigned char*)lds_raw;
    C.tid = threadIdx.x; C.lane = C.tid & 63; C.wave = __builtin_amdgcn_readfirstlane(C.tid >> 6);
    C.gw = blockIdx.x * NWAVE + C.wave; C.ngw = gridDim.x * NWAVE;
    constexpr int LDS_MISC = 147456 - 512;
    volatile LAS unsigned* misc = (volatile LAS unsigned*)(C.lds + LDS_MISC);
    if (C.tid < 64) misc[C.tid] = 0u;
    __syncthreads();
    unsigned* ctl = (unsigned*)(C.ws + WS_CTL);
    XcdBarrier bar; bar.bar = ctl + CW_BAR; bar.x = 0; bar.st = nullptr;
#if MK_ONE_LAUNCH
    bar = xcd_barrier_post(ctl + CW_BAR, misc + 8);
#define SEAM(k) do { if (lo <= (k) && (k) + 1 < hi) xcd_barrier(bar); } while (0)
#else
#define SEAM(k) do { } while (0)
#endif
    const int lo = prm.ph_lo, hi = prm.ph_hi;
#define IN(k) (lo <= (k) && (k) < hi)
#if MK_PROBE
    volatile LAS unsigned long long* ts_ = (volatile LAS unsigned long long*)(C.lds + LDS_MISC + 64);
#define STAMP(k) do { if (blockIdx.x == 0 && C.tid == 0) ts_[(k) + 1] = __builtin_amdgcn_s_memrealtime(); } while (0)
    if (blockIdx.x == 0 && C.tid == 0) ts_[0] = __builtin_amdgcn_s_memrealtime();
#else
#define STAMP(k) do { } while (0)
#endif
    const Params& P = prm;
    bf16* Hb = (bf16*)(C.ws + WS_H); float* XC = (float*)(C.ws + WS_XC);
#define MOE_MAP(layer) do { LAS int* tm_ = (LAS int*)(C.lds + 131072); LAS int* cl_ = tm_ + 320; \
        if (C.wave == 0) { const unsigned* cnt_ = (const unsigned*)(C.ws + WS_CTL) + CW_CNT + 64 * (layer); const int mc_ = C.lane < 32 ? (int)__hip_atomic_load(cnt_ + (C.lane & 31), __ATOMIC_RELAXED, __HIP_MEMORY_SCOPE_AGENT) : 0; const int mp_ = (mc_ + 255) & ~255; int in_ = mp_; \
            _Pragma("unroll") for (int o_ = 1; o_ < 32; o_ <<= 1) { const int t_ = __shfl_up(in_, o_); if ((C.lane & 31) >= o_) in_ += t_; } const int ps_ = in_ - mp_; \
            if (C.lane < 32) { for (int t_ = ps_ / 256; t_ < (ps_ + mp_) / 256; ++t_) tm_[t_] = C.lane | ((t_ * 256 - ps_) << 8); cl_[C.lane] = mc_; if (C.lane == 31) cl_[32] = (ps_ + mp_) / 256; } } \
        __syncthreads(); } while (0)
#define MOE_GEMM1(layer) do { MOE_MAP(layer); const LAS int* tm_ = (const LAS int*)(C.lds + 131072); const int ntl_ = __builtin_amdgcn_readfirstlane(tm_[320 + 32]); pg8::Gemm g{Hb, (const bf16*)(C.ws + WS_W13), 0, 1024, D}; \
        pg8::GroupedOrder<true> S{tm_, tm_ + 320, (const int*)(C.ws + WS_LIST), ntl_ * 4, 4, (int)gridDim.x, (int)blockIdx.x, LCAP, D * 2, (size_t)1024 * 1024 * 2}; pg8::EpiSwiglu E{(bf16*)(C.ws + WS_G13)}; \
        pg8::gemm_phase<pg8::EpiSwiglu, pg8::GroupedOrder<true>, true, true>(C.lds, g, S, E); } while (0)
#define MOE_GEMM2(layer) do { MOE_MAP(layer); const LAS int* tm_ = (const LAS int*)(C.lds + 131072); const int ntl_ = __builtin_amdgcn_readfirstlane(tm_[320 + 32]); pg8::Gemm g{(const bf16*)(C.ws + WS_G13), (const bf16*)(C.ws + WS_W2), 0, 1024, EH}; \
        pg8::GroupedOrder<false> S{tm_, tm_ + 320, (const int*)(C.ws + WS_LIST), ntl_ * 4, 4, (int)gridDim.x, (int)blockIdx.x, LCAP, EH * 2, (size_t)1024 * 512 * 2}; pg8::EpiStore E{(bf16*)(C.ws + WS_XS), D}; \
        pg8::gemm_phase<pg8::EpiStore, pg8::GroupedOrder<false>, true, true>(C.lds, g, S, E); } while (0)
    if (IN(0)) { phase_prologue(C); SEAM(0); STAMP(0); }
    if (IN(1)) { phase_norm_mix0(C); SEAM(1); STAMP(1); }
    if (IN(2)) { pg8::Gemm g{Hb, (const bf16*)(C.ws + WS_WIN0), TT, MIXW, D}; pg8::StaticOrder S; S.init(TT, MIXW, gridDim.x, blockIdx.x); pg8::EpiStore E{(bf16*)(C.ws + WS_P), MIXW};
        pg8::gemm_phase<pg8::EpiStore, pg8::StaticOrder, true, true, true>(C.lds, g, S, E); SEAM(2); STAMP(2); }
    if (IN(3)) { phase_qkprep(C); SEAM(3); STAMP(3); }
    if (IN(4)) { phase_gmlp_fast(C); phase_attn_fast(C, (char*)lds_raw); SEAM(4); STAMP(4); }
    if (IN(5)) { pg8::Gemm g{Hb, (const bf16*)(C.ws + WS_WOUT0), TT, D, D}; pg8::StaticOrder S; S.init(TT, D, gridDim.x, blockIdx.x); pg8::EpiResid E{P.in[I_X], P.in[I_CTX], (const float*)(C.ws + WS_MOD), XC, 0};
        pg8::gemm_phase<pg8::EpiResid, pg8::StaticOrder, true, true, true>(C.lds, g, S, E); SEAM(5); STAMP(5); }
    if (IN(6)) { phase_router_fast(C, 0, TT); SEAM(6); STAMP(6); }
    if (IN(8)) { MOE_GEMM1(0); SEAM(8); STAMP(8); }
    if (IN(9)) { MOE_GEMM2(0); SEAM(9); STAMP(9); }
    if (IN(10)) { phase_combine_norm_mix1(C); SEAM(10); STAMP(10); }
    if (IN(11)) { pg8::Gemm g{Hb, (const bf16*)(C.ws + WS_WS5IN), TT, 512, D}; pg8::StaticOrder S; S.init(TT, 512, gridDim.x, blockIdx.x); pg8::EpiStore E{(bf16*)(C.ws + WS_U), 512};
        pg8::gemm_phase<pg8::EpiStore, pg8::StaticOrder, true, true, true>(C.lds, g, S, E); SEAM(11); STAMP(11); }
    if (IN(12)) { phase_s5_fast(C); SEAM(12); STAMP(12); }
    if (IN(13)) { pg8::Gemm g{(const bf16*)(C.ws + WS_GS), (const bf16*)(C.ws + WS_WGLU), TL, 512, 512}; pg8::StaticOrder S; S.init(TL, 512, gridDim.x, blockIdx.x); pg8::EpiGlu E{(const bf16*)(C.ws + WS_GS), P.in[I_BGLU], (bf16*)(C.ws + WS_GG)};
        pg8::gemm_phase<pg8::EpiGlu, pg8::StaticOrder, true, true, true>(C.lds, g, S, E); SEAM(13); STAMP(13); }
    if (IN(14)) { pg8::Gemm g{(const bf16*)(C.ws + WS_GG), (const bf16*)(C.ws + WS_WS5OUT), TL, D, 512}; pg8::StaticOrder S; S.init(TL, D, gridDim.x, blockIdx.x); pg8::EpiResid E{P.in[I_X], P.in[I_CTX], (const float*)(C.ws + WS_MOD) + (size_t)17 * 6 * D, XC, 1};
        pg8::gemm_phase<pg8::EpiResid, pg8::StaticOrder, true, true, true>(C.lds, g, S, E); SEAM(14); STAMP(14); }
    if (IN(15)) { phase_router_fast(C, 1, TL); SEAM(15); STAMP(15); }
    if (IN(17)) { MOE_GEMM1(1); SEAM(17); STAMP(17); }
    if (IN(18)) { MOE_GEMM2(1); SEAM(18); STAMP(18); }
    if (IN(19)) { phase_final(C); STAMP(19); }
#if MK_PROBE
    if (blockIdx.x == 0 && C.tid == 0) {
        ts_[8] = ts_[7]; ts_[17] = ts_[16];
        const unsigned long long tA = ts_[PROBE_A_HI + 1] - ts_[PROBE_A_LO], tB = ts_[PROBE_B_HI + 1] - ts_[PROBE_B_LO];
        const unsigned long long spin = 16ull * tA + 1000000ull * ((tB + 500ull) / 1000ull);
        const unsigned long long t0 = __builtin_amdgcn_s_memrealtime();
        while (__builtin_amdgcn_s_memrealtime() - t0 < spin) __builtin_amdgcn_s_sleep(8);
    }
#endif
#undef IN
#undef SEAM
}

extern "C" void kernel_launch(void* const* d_in, const int* in_sizes, int n_in, void* d_out, int out_size, void* d_ws, size_t ws_size, hipStream_t stream) {
    constexpr int LDS_BYTES = 147456;
    static int grid = 0;
    if (grid == 0) {
        if (n_in != 35 || out_size != TL * D || ws_size < WS_END) { fprintf(stderr, "kernel_launch: unexpected shapes (n_in %d out %d ws %zu)\n", n_in, out_size, ws_size); grid = -1; return; }
        int dev = 0, cus = 0;
        if (hipGetDevice(&dev) != hipSuccess || hipDeviceGetAttribute(&cus, hipDeviceAttributeMultiprocessorCount, dev) != hipSuccess) { grid = -1; return; }
        if (hipFuncSetAttribute((const void*)fwd_kernel, hipFuncAttributeMaxDynamicSharedMemorySize, LDS_BYTES) != hipSuccess) { fprintf(stderr, "kernel_launch: hipFuncSetAttribute failed\n"); grid = -1; return; }
        (void)hipGetLastError();
        grid = cus;
    }
    if (grid < 0) return;
    (void)hipMemsetAsync((char*)d_ws + WS_CTL, 0, CTL_BYTES, stream);
    Params p{};
    for (int i = 0; i < 35; ++i) p.in[i] = (const float*)d_in[i];
    p.out = (float*)d_out; p.ws = (unsigned char*)d_ws;
#if MK_ONE_LAUNCH
    p.ph_lo = 0; p.ph_hi = NPHASE;
    hipLaunchKernelGGL(fwd_kernel, dim3(grid), dim3(NTHR), LDS_BYTES, stream, p);
#else
    for (int k = 0; k < NPHASE; ++k) { p.ph_lo = k; p.ph_hi = k + 1; hipLaunchKernelGGL(fwd_kernel, dim3(grid), dim3(NTHR), LDS_BYTES, stream, p); }
#endif
}
```

```cpp
#include <hip/hip_runtime.h>
#include <cstdio>
#include <cstdint>

#ifndef MK_ONE_LAUNCH
#define MK_ONE_LAUNCH 1
#endif
#ifndef MK_SIMPLE_ORDER
#define MK_SIMPLE_ORDER 0
#endif
#ifndef MK_KROT
#define MK_KROT 0
#endif
#ifndef MK_PROBE
#define MK_PROBE 0
#endif
#define PROBE_A_LO 4
#define PROBE_A_HI 4
#define PROBE_B_LO 8
#define PROBE_B_HI 9

constexpr int D = 1024, NB = 16, SEQ = 2048, CTXL = 256;
constexpr int TL = NB * SEQ, TC = NB * CTXL, TT = TL + TC;
constexpr int KVL = CTXL + SEQ;
constexpr int MIXW = 1792, NEXP = 32, EH = 512;
constexpr int NSLOT = 81920;
constexpr float EPS = 1e-6f;
constexpr float QSCALE = 0.125f * 1.4426950408889634f;
constexpr int NTHR = 512, NWAVE = 8;
constexpr int NPHASE = 20;

constexpr size_t MiB = 1u << 20;
constexpr size_t WS_CTL = 0, CTL_BYTES = 1 * MiB;
constexpr size_t WS_MOD = 1 * MiB;
constexpr size_t WS_TAB = 2 * MiB;
constexpr size_t TAB_ROPE = 0, TAB_LAMB = 16384, TAB_BBAR = 65536, TAB_WR = 640 * 1024;
constexpr size_t WS_ROUTE = 3 * MiB;
constexpr size_t RT_E = 0, RT_P = 320 * 1024, RT_W = 640 * 1024, RT_S = 960 * 1024, RT_TILE = 1280 * 1024, RT_NT = 1280 * 1024 + 4096;
constexpr size_t WS_WIN0 = 6 * MiB, WS_WOUT0 = 10 * MiB, WS_WS5IN = 12 * MiB, WS_WGLU = 13 * MiB, WS_WS5OUT = 14 * MiB;
constexpr size_t WS_WSP = 15 * MiB;
constexpr size_t WS_W13 = 16 * MiB, WS_W2 = 80 * MiB;
constexpr size_t WS_XC = 112 * MiB;
constexpr size_t WS_H = 256 * MiB;
constexpr size_t WS_P = 328 * MiB;
constexpr size_t WS_Q = 454 * MiB, WS_K = 490 * MiB, WS_V = 499 * MiB;
constexpr size_t WS_XS = 328 * MiB;
constexpr size_t WS_G13 = 488 * MiB;
constexpr size_t WS_U = 328 * MiB, WS_GS = 364 * MiB, WS_GG = 396 * MiB, WS_YACC = 428 * MiB;
constexpr size_t WS_LIST = 568 * MiB;
constexpr int LCAP = 36864;
constexpr size_t WS_END = 574 * MiB;
constexpr int CW_CNT = 64;
constexpr int CW_BAR = 4096;

#define LAS __attribute__((address_space(3)))
typedef unsigned short bf16;
typedef unsigned v4u __attribute__((ext_vector_type(4)));
typedef unsigned v2u __attribute__((ext_vector_type(2)));
typedef float f32x4 __attribute__((ext_vector_type(4)));
typedef float f32x2 __attribute__((ext_vector_type(2)));
__device__ __forceinline__ float bf2f(unsigned u) { return __uint_as_float(u << 16); }
__device__ __forceinline__ unsigned pk2(float lo, float hi) { unsigned r; asm("v_cvt_pk_bf16_f32 %0, %1, %2" : "=v"(r) : "v"(lo), "v"(hi)); return r; }
__device__ __forceinline__ unsigned f2bf(float f) { return pk2(f, 0.f) & 0xffffu; }
__device__ __forceinline__ float wave_sum(float v) {
#pragma unroll
    for (int o = 1; o < 64; o <<= 1) v += __shfl_xor(v, o);
    return v;
}
__device__ __forceinline__ float wave_max(float v) {
#pragma unroll
    for (int o = 1; o < 64; o <<= 1) v = fmaxf(v, __shfl_xor(v, o));
    return v;
}
__device__ __forceinline__ float gelu_tanh(float x) { const float u2 = -1.5957691216057308f * (x + 0.044715f * x * x * x); return x * __builtin_amdgcn_rcpf(1.f + __expf(u2)); }
__device__ __forceinline__ float sigmoidf_(float x) { return 1.f / (1.f + __expf(-x)); }
__device__ __forceinline__ float silu_(float x) { return x / (1.f + __expf(-x)); }
__device__ __forceinline__ void unpack8(const v4u w, float* f) {
    f[0] = bf2f(w.x & 0xffffu); f[1] = bf2f(w.x >> 16); f[2] = bf2f(w.y & 0xffffu); f[3] = bf2f(w.y >> 16);
    f[4] = bf2f(w.z & 0xffffu); f[5] = bf2f(w.z >> 16); f[6] = bf2f(w.w & 0xffffu); f[7] = bf2f(w.w >> 16);
}

#define XB_TMO      128
#define XB_XCNT(j)  (256  + 64 * (j))
#define XB_XSUB(j)  (1280 + 64 * (j))
#define XB_XGEN(j)  (2304 + 64 * (j))
#define XB_TOP      3328
#define XB_TOPGEN   3392
#define XCD_BAR_WORDS 3456
#define XB_SPIN_CAP (1u << 28)
__device__ __forceinline__ unsigned xb_ld(unsigned* p)              { return __hip_atomic_load(p, __ATOMIC_RELAXED, __HIP_MEMORY_SCOPE_AGENT); }
__device__ __forceinline__ unsigned xb_add(unsigned* p, unsigned v) { return __hip_atomic_fetch_add(p, v, __ATOMIC_RELAXED, __HIP_MEMORY_SCOPE_AGENT); }
__device__ __forceinline__ unsigned xb_xcc_id() { return (unsigned)__builtin_amdgcn_s_getreg((3 << 11) | 20) & 0xFu; }
#define XB_SPIN(cond, bar) do { unsigned _sp = 0; while (cond) { __builtin_amdgcn_s_sleep(1); \
    if ((++_sp & 255u) == 0u) { if (xb_ld(&(bar)[XB_TMO])) break; if (_sp > XB_SPIN_CAP) { atomicAdd(&(bar)[XB_TMO], 1u); break; } } } } while (0)
struct XcdBarrier { unsigned* bar; unsigned x; volatile LAS unsigned* st; };
__device__ __forceinline__ XcdBarrier xcd_barrier_post(unsigned* bar, volatile LAS unsigned* st) {
    XcdBarrier b; b.bar = bar; b.x = xb_xcc_id(); b.st = st;
    if (threadIdx.x == 0) (void)xb_add(&bar[XB_XCNT(b.x)], 1u);
    return b;
}
__device__ __forceinline__ void xcd_barrier_complete(unsigned* bar, unsigned x, unsigned& nloc, unsigned& nx) {
    const unsigned G = gridDim.x * gridDim.y * gridDim.z;
    unsigned sum, cnt, mine, sp = 0u;
    for (;;) {
        sum = 0u; cnt = 0u; mine = 0u;
#pragma unroll
        for (unsigned j = 0; j < 16; ++j) { const unsigned c = xb_ld(&bar[XB_XCNT(j)]); sum += c; cnt += (c > 0u) ? 1u : 0u; mine = (j == x) ? c : mine; }
        if (sum == G) break;
        __builtin_amdgcn_s_sleep(1);
        if ((++sp & 255u) == 0u) { if (xb_ld(&bar[XB_TMO])) break; if (sp > XB_SPIN_CAP) { atomicAdd(&bar[XB_TMO], 1u); break; } }
    }
    nloc = mine > 0u ? mine : 1u; nx = cnt > 0u ? cnt : 1u;
}
__device__ __forceinline__ void xcd_barrier(const XcdBarrier& b) {
    asm volatile("s_waitcnt vmcnt(0)" ::: "memory");
    __syncthreads();
    if (threadIdx.x == 0) {
        unsigned* bar = b.bar;
        __builtin_amdgcn_s_waitcnt(0);
        unsigned nloc = b.st[0], nx = b.st[1];
        if (nloc == 0u) { xcd_barrier_complete(bar, b.x, nloc, nx); b.st[0] = nloc; b.st[1] = nx; }
        const unsigned old = xb_add(&bar[XB_XSUB(b.x)], 1u);
        const unsigned gen = old / nloc;
        if (old + 1u == (gen + 1u) * nloc) {
            __builtin_amdgcn_fence(__ATOMIC_RELEASE, "agent");
            asm volatile("s_waitcnt vmcnt(0)" ::: "memory");
            const unsigned og = xb_add(&bar[XB_TOP], 1u);
            const unsigned tg = og / nx;
            if (og + 1u == (tg + 1u) * nx) xb_add(&bar[XB_TOPGEN], 1u);
            else XB_SPIN(xb_ld(&bar[XB_TOPGEN]) == tg, bar);
            __builtin_amdgcn_fence(__ATOMIC_ACQUIRE, "agent");
            xb_add(&bar[XB_XGEN(b.x)], 1u);
            asm volatile("s_waitcnt vmcnt(0)" ::: "memory");
        } else {
            XB_SPIN(xb_ld(&bar[XB_XGEN(b.x)]) == gen, bar);
            __builtin_amdgcn_fence(__ATOMIC_ACQUIRE, "agent");
            asm volatile("s_waitcnt vmcnt(0)" ::: "memory");
        }
    }
    __syncthreads();
}

namespace pg8 {
#define PG8_LAS __attribute__((address_space(3)))
typedef unsigned short bf16_t;
typedef short bf16x8 __attribute__((ext_vector_type(8)));
typedef float f32x4 __attribute__((ext_vector_type(4)));
typedef unsigned u32x4 __attribute__((ext_vector_type(4)));
constexpr int BM = 256, BK = 64, HALF = 128, HTB = HALF * BK * 2  , STAGE_BYTES = 8 * HTB, NXCD = 8, WGM = 8;

__host__ __device__ __forceinline__ int lds_byte(int r, int c) { const int st = (r >> 4) * 2 + (c >> 5), rr = r & 15, cc = c & 31, ob = rr * 64 + cc * 2; return st * 1024 + (ob ^ (((ob >> 9) & 1) << 5)); }
__host__ __device__ __forceinline__ void stage_rc(int b, int& R, int& C) { const int st = b / 1024, sb = b % 1024, swz = sb ^ (((sb >> 9) & 1) << 5); R = (st >> 1) * 16 + swz / 64; C = (st & 1) * 32 + (swz % 64) / 2; }
__host__ __device__ __forceinline__ int perm32(int rho) { const int n = rho >> 4, i = rho & 15; return 8 * (i >> 2) + 4 * n + (i & 3); }

struct Unit { int pm, pn; size_t bo; int aux; };
struct Gemm { const bf16_t* A; const bf16_t* Bt; int M, N, K; };

struct StaticOrder {
    static constexpr bool GATHER = false;
    int nM, nN, nwg, G, c;
    __host__ __device__ void init(int M, int N, int G_, int c_) { nM = M / BM; nN = N / BM; nwg = nM * nN; G = G_; c = c_; }
    __host__ __device__ bool next(int i, Unit& u) const {
        const long L = (long)i * G + c; if (L >= nwg) return false;
        if (MK_SIMPLE_ORDER) { u.pm = (int)L / nN; u.pn = (int)L % nN; u.bo = 0; u.aux = 0; return true; }
        int wgid = (int)L; { const int q = nwg / NXCD, r = nwg % NXCD, xcd = wgid % NXCD, off = wgid / NXCD; wgid = (xcd < r ? xcd * (q + 1) : r * (q + 1) + (xcd - r) * q) + off; }
        const int nig = WGM * nN, gid = wgid / nig, fm = gid * WGM, gsz = (nM - fm) < WGM ? (nM - fm) : WGM;
        u.pm = fm + ((wgid % nig) % gsz); u.pn = (wgid % nig) / gsz; u.bo = 0; u.aux = 0; return true;
    }
    __device__ __forceinline__ void a_ready(const Unit&) const {}
    __device__ __forceinline__ void done(const Unit&) const {}
};

__device__ __forceinline__ unsigned cvt_pk_bf16(float lo, float hi) { unsigned r; asm volatile("v_cvt_pk_bf16_f32 %0, %1, %2" : "=v"(r) : "v"(lo), "v"(hi)); return r; }
typedef float f32x2 __attribute__((ext_vector_type(2)));
__device__ __forceinline__ f32x2 gelu_pk(f32x2 v) {
    const f32x2 av = __builtin_elementwise_abs(v), d = av * 0.2316418882f + 1.0f;
    f32x2 t; t.x = __builtin_amdgcn_rcpf(d.x); t.y = __builtin_amdgcn_rcpf(d.y);
    f32x2 q = t * 0.5307027145f + (-0.7265760135f); q = q * t + 0.7107068705f; q = q * t + (-0.142248368f); q = q * t + 0.127414796f; q = q * t;
    const f32x2 s = (v * v) * (-0.72134752044f);
    f32x2 e; e.x = __builtin_amdgcn_exp2f(s.x); e.y = __builtin_amdgcn_exp2f(s.y);
    const f32x2 m = v * (q * e), r = v - m;
    f32x2 o; o.x = v.x < 0.f ? m.x : r.x; o.y = v.y < 0.f ? m.y : r.y; return o;
}

template <class Epi, class Sched, bool ALIGN_EPI = false, bool SP2 = false, bool KROT = false>
__device__ __forceinline__ void gemm_phase(PG8_LAS unsigned char* lds, const Gemm g, const Sched& S, const Epi& E) {
    const int tid = threadIdx.x, wid = __builtin_amdgcn_readfirstlane(tid >> 6), lane = tid & 63, wr = wid >> 2, wc = wid & 3, fr = lane & 15, fq = lane >> 4;
    const int K = g.K, nt = K / BK;
    const int kmask = nt - 1, rot = (MK_KROT && KROT) ? (int)((blockIdx.x * 3u + (blockIdx.x >> 3)) & (unsigned)kmask) : 0;
#define PG8_KO(j) ((size_t)(((j) + rot) & kmask) * kstep)
    unsigned voffA[2], voffB[2];
    unsigned vC[2][2], vN[2][2];
#pragma unroll
    for (int i = 0; i < 2; ++i) { int R, C; stage_rc(tid * 16 + i * 8192, R, C); const int Rb = Epi::PERM ? ((R & ~31) + perm32(R & 31)) : R;
        voffA[i] = (unsigned)(R * K + C) * 2u; voffB[i] = (unsigned)(Rb * K + C) * 2u; }
    const size_t kstep = (size_t)(BK * 2);
    const size_t hstep = (size_t)HALF * K * 2;
    const size_t tstep = 2 * hstep;
    const unsigned ldsw = (unsigned)wid * 1024u;
    const int aoff = lds_byte(wr * 64 + fr, fq * 8), boff = lds_byte(wc * 32 + fr, fq * 8);
#define PG8_SA(b, h) (((b) * 2 + (h)) * HTB)
#define PG8_SB(b, h) ((4 + (b) * 2 + (h)) * HTB)
#define PG8_STAGE(bufoff, gbase, voff) do { _Pragma("unroll") for (int _i = 0; _i < 2; ++_i) \
        __builtin_amdgcn_global_load_lds((const unsigned*)((const char*)(gbase) + (voff)[_i]), (PG8_LAS unsigned*)(lds + (bufoff) + ldsw + _i * 8192), 16, 0, 0); } while (0)
#define PG8_STAGE_A(bufoff, gbase, h, nx) do { _Pragma("unroll") for (int _i = 0; _i < 2; ++_i) { \
        const unsigned _vo = Sched::GATHER ? ((nx) ? vN[h][_i] : vC[h][_i]) : (unsigned)((h) * hstep) + voffA[_i]; \
        __builtin_amdgcn_global_load_lds((const unsigned*)((const char*)(gbase) + _vo), (PG8_LAS unsigned*)(lds + (bufoff) + ldsw + _i * 8192), 16, 0, 0); } } while (0)
#define PG8_LDA(dst, b, h) do { _Pragma("unroll") for (int m = 0; m < 4; ++m) _Pragma("unroll") for (int k = 0; k < 2; ++k) dst[m][k] = *(const PG8_LAS bf16x8*)(lds + PG8_SA(b, h) + aoff + m * 2048 + k * 1024); } while (0)
#define PG8_LDB(dst, b, h) do { _Pragma("unroll") for (int n = 0; n < 2; ++n) _Pragma("unroll") for (int k = 0; k < 2; ++k) dst[n][k] = *(const PG8_LAS bf16x8*)(lds + PG8_SB(b, h) + boff + n * 2048 + k * 1024); } while (0)
#define PG8_MMA(ai, bj, At, Bt) do { __builtin_amdgcn_s_setprio(1); _Pragma("unroll") for (int m = 0; m < 4; ++m) _Pragma("unroll") for (int n = 0; n < 2; ++n) _Pragma("unroll") for (int k = 0; k < 2; ++k) \
        acc[ai][bj][m][n] = __builtin_amdgcn_mfma_f32_16x16x32_bf16(Bt[n][k], At[m][k], acc[ai][bj][m][n], 0, 0, 0); __builtin_amdgcn_s_setprio(0); } while (0)
#define PG8_WAIT_V(n) asm volatile("s_waitcnt vmcnt(" #n ")" ::: "memory")
#define PG8_WAIT_L(n) asm volatile("s_waitcnt lgkmcnt(" #n ")" ::: "memory")
#define PG8_BAR __builtin_amdgcn_s_barrier()
#define PG8_SCHED __builtin_amdgcn_sched_barrier(0)
    Unit cur, nxt; int ui = 0;
    if (!S.next(0, cur)) return;
    f32x4 acc[2][2][4][2];
#pragma unroll
    for (int a = 0; a < 2; ++a)
#pragma unroll
        for (int b = 0; b < 2; ++b)
#pragma unroll
            for (int m = 0; m < 4; ++m)
#pragma unroll
                for (int n = 0; n < 2; ++n) acc[a][b][m][n] = (f32x4){0.f, 0.f, 0.f, 0.f};
    bf16x8 At[4][2], B0[2][2], B1[2][2];
    const char* cA = (const char*)g.A + (Sched::GATHER ? (size_t)0 : (size_t)cur.pm * tstep); const char* cB = (const char*)g.Bt + cur.bo + (size_t)cur.pn * tstep;
    S.a_ready(cur);
#define PG8_VOFF(dst, un) do { _Pragma("unroll") for (int _h = 0; _h < 2; ++_h) _Pragma("unroll") for (int _i = 0; _i < 2; ++_i) { int R_, C_; stage_rc(tid * 16 + _i * 8192, R_, C_); dst[_h][_i] = S.a_off(un, _h * HALF + R_) + (unsigned)C_ * 2u; } } while (0)
    if constexpr (Sched::GATHER) { PG8_VOFF(vC, cur); }
    if constexpr (SP2) {
        PG8_STAGE(PG8_SB(0, 0), cB + PG8_KO(0), voffB); PG8_STAGE(PG8_SB(0, 1), cB + hstep + PG8_KO(0), voffB); PG8_STAGE_A(PG8_SA(0, 0), cA + PG8_KO(0), 0, false); PG8_STAGE_A(PG8_SA(0, 1), cA + PG8_KO(0), 1, false);
        if (wr == 1) PG8_BAR;
        PG8_WAIT_V(2); PG8_BAR;
        PG8_STAGE(PG8_SB(1, 0), cB + PG8_KO(1), voffB); PG8_STAGE_A(PG8_SA(1, 0), cA + PG8_KO(1), 0, false); PG8_STAGE(PG8_SB(1, 1), cB + hstep + PG8_KO(1), voffB);
        PG8_WAIT_V(6); PG8_BAR;
    } else {
        PG8_STAGE(PG8_SB(0, 0), cB, voffB); PG8_STAGE_A(PG8_SA(0, 0), cA, 0, false); PG8_STAGE(PG8_SB(0, 1), cB + hstep, voffB); PG8_STAGE_A(PG8_SA(0, 1), cA, 1, false);
        if (wr == 1) PG8_BAR;
        PG8_WAIT_V(4); PG8_BAR;
        PG8_STAGE(PG8_SB(1, 0), cB + PG8_KO(1), voffB); PG8_STAGE_A(PG8_SA(1, 0), cA + PG8_KO(1), 0, false); PG8_STAGE(PG8_SB(1, 1), cB + hstep + PG8_KO(1), voffB);
        PG8_WAIT_V(6); PG8_BAR;
    }
    for (;;) {
        const bool has_next = S.next(ui + 1, nxt);
        if constexpr (Sched::GATHER) { if (has_next) { PG8_VOFF(vN, nxt); } else { vN[0][0] = vC[0][0]; vN[0][1] = vC[0][1]; vN[1][0] = vC[1][0]; vN[1][1] = vC[1][1]; } }
        const char* nA = (has_next && !Sched::GATHER) ? (const char*)g.A + (size_t)nxt.pm * tstep : cA; const char* nB = has_next ? (const char*)g.Bt + nxt.bo + (size_t)nxt.pn * tstep : cB;
        for (int t = 0; t < nt; t += 2) {
            const bool last = (t == nt - 2);
            const char* a1 = cA + PG8_KO(t + 1);
            const char* a2 = last ? nA + PG8_KO(0) : cA + PG8_KO(t + 2); const char* b2 = last ? nB + PG8_KO(0) : cB + PG8_KO(t + 2);
            const char* a3 = last ? nA + PG8_KO(1) : cA + PG8_KO(t + 3); const char* b3 = last ? nB + PG8_KO(1) : cB + PG8_KO(t + 3);
            if (last && has_next) S.a_ready(nxt);
            if constexpr (SP2) {
            PG8_LDB(B0, 0, 0); PG8_LDB(B1, 0, 1); PG8_SCHED; PG8_LDA(At, 0, 0); PG8_STAGE_A(PG8_SA(1, 1), a1, 1, false);
            PG8_WAIT_V(8); PG8_WAIT_L(0); PG8_BAR; PG8_MMA(0, 0, At, B0); PG8_MMA(0, 1, At, B1); PG8_BAR; PG8_SCHED;
            PG8_LDA(At, 0, 1); PG8_STAGE(PG8_SB(0, 0), b2, voffB); PG8_STAGE(PG8_SB(0, 1), b2 + hstep, voffB); PG8_STAGE_A(PG8_SA(0, 0), a2, 0, last);
            PG8_WAIT_V(8); PG8_WAIT_L(0); PG8_BAR; PG8_MMA(1, 0, At, B0); PG8_MMA(1, 1, At, B1); PG8_BAR; PG8_SCHED;
            PG8_LDB(B0, 1, 0); PG8_LDB(B1, 1, 1); PG8_SCHED; PG8_LDA(At, 1, 0); PG8_STAGE_A(PG8_SA(0, 1), a2, 1, last);
            PG8_WAIT_V(8); PG8_WAIT_L(0); PG8_BAR; PG8_MMA(0, 0, At, B0); PG8_MMA(0, 1, At, B1); PG8_BAR; PG8_SCHED;
            PG8_LDA(At, 1, 1); PG8_STAGE(PG8_SB(1, 0), b3, voffB); PG8_STAGE(PG8_SB(1, 1), b3 + hstep, voffB); PG8_STAGE_A(PG8_SA(1, 0), a3, 0, last);
            PG8_WAIT_V(8); PG8_WAIT_L(0); PG8_BAR; PG8_MMA(1, 0, At, B0); PG8_MMA(1, 1, At, B1); PG8_BAR; PG8_SCHED;
            } else {
            PG8_LDB(B0, 0, 0); PG8_SCHED; PG8_LDA(At, 0, 0); PG8_STAGE_A(PG8_SA(1, 1), a1, 1, false);
            PG8_WAIT_L(8); PG8_BAR; PG8_WAIT_L(0); PG8_MMA(0, 0, At, B0); PG8_BAR; PG8_SCHED;
            PG8_LDB(B1, 0, 1); PG8_STAGE(PG8_SB(0, 0), b2, voffB);
            PG8_BAR; PG8_WAIT_L(0); PG8_MMA(0, 1, At, B1); PG8_BAR;
            PG8_LDA(At, 0, 1); PG8_STAGE_A(PG8_SA(0, 0), a2, 0, last);
            PG8_BAR; PG8_WAIT_L(0); PG8_MMA(1, 0, At, B0); PG8_BAR; PG8_SCHED;
            PG8_STAGE(PG8_SB(0, 1), b2 + hstep, voffB);
            PG8_WAIT_V(6); PG8_BAR; PG8_MMA(1, 1, At, B1); PG8_BAR;
            PG8_LDB(B0, 1, 0); PG8_SCHED; PG8_LDA(At, 1, 0); PG8_STAGE_A(PG8_SA(0, 1), a2, 1, last);
            PG8_WAIT_L(8); PG8_BAR; PG8_WAIT_L(0); PG8_MMA(0, 0, At, B0); PG8_BAR; PG8_SCHED;
            PG8_LDB(B1, 1, 1); PG8_STAGE(PG8_SB(1, 0), b3, voffB);
            PG8_BAR; PG8_WAIT_L(0); PG8_MMA(0, 1, At, B1); PG8_BAR;
            PG8_LDA(At, 1, 1); PG8_STAGE_A(PG8_SA(1, 0), a3, 0, last);
            PG8_BAR; PG8_WAIT_L(0); PG8_MMA(1, 0, At, B0); PG8_BAR; PG8_SCHED;
            PG8_STAGE(PG8_SB(1, 1), b3 + hstep, voffB);
            PG8_WAIT_V(6); PG8_BAR; PG8_MMA(1, 1, At, B1); PG8_BAR;
            }
        }
        if constexpr (ALIGN_EPI) { if (wr == 0) PG8_BAR; }
        if constexpr (!Epi::AFTER_DRAIN) { E(acc, cur, wr, wc, fr, fq); S.done(cur); }
        if (!has_next) break;
#pragma unroll
        for (int a = 0; a < 2; ++a)
#pragma unroll
            for (int b = 0; b < 2; ++b)
#pragma unroll
                for (int m = 0; m < 4; ++m)
#pragma unroll
                    for (int n = 0; n < 2; ++n) acc[a][b][m][n] = (f32x4){0.f, 0.f, 0.f, 0.f};
        cur = nxt; cA = nA; cB = nB; ++ui;
        if constexpr (Sched::GATHER) { vC[0][0] = vN[0][0]; vC[0][1] = vN[0][1]; vC[1][0] = vN[1][0]; vC[1][1] = vN[1][1]; }
        if constexpr (ALIGN_EPI) { if (wr == 1) PG8_BAR; }
    }
    PG8_WAIT_V(0);
    if constexpr (!ALIGN_EPI) { if (wr == 0) PG8_BAR; }
    PG8_BAR;
    if constexpr (Epi::AFTER_DRAIN) { E.fused(acc, cur, wr, wc, fr, fq, lds, wid, lane); S.done(cur); }
#undef PG8_VOFF
#undef PG8_KO
#undef PG8_SA
#undef PG8_SB
#undef PG8_STAGE
#undef PG8_STAGE_A
#undef PG8_LDA
#undef PG8_LDB
#undef PG8_MMA
#undef PG8_WAIT_V
#undef PG8_WAIT_L
#undef PG8_BAR
#undef PG8_SCHED
}
}

namespace pg8 {
template <bool GATHER_>
struct GroupedOrder {
    static constexpr bool GATHER = GATHER_;
    const PG8_LAS int* tmap; const PG8_LAS int* cntl; const int* list; int nU, nN, G, c, lcap, rowbytes; size_t estride;
    __device__ __forceinline__ bool next(int i, Unit& u) const { const long L = (long)i * G + c; if (L >= nU) return false; const int t = (int)L / nN; const int m = __builtin_amdgcn_readfirstlane(tmap[t]);
        u.pm = t; u.pn = (int)L % nN; u.bo = (size_t)(m & 255) * estride; u.aux = m; return true; }
    __device__ __forceinline__ unsigned a_off(const Unit& u, int R) const { const int e = u.aux & 255, p0 = u.aux >> 8, ce = cntl[e]; int p = p0 + R; p = p < ce ? p : ce - 1; return (unsigned)list[(size_t)e * lcap + p] * (unsigned)rowbytes; }
    __device__ __forceinline__ void a_ready(const Unit&) const {}
    __device__ __forceinline__ void done(const Unit&) const {}
};
__device__ __forceinline__ u32x4 pack8(const f32x4 a, const f32x4 b) { u32x4 w; w.x = cvt_pk_bf16(a[0], a[1]); w.y = cvt_pk_bf16(a[2], a[3]); w.z = cvt_pk_bf16(b[0], b[1]); w.w = cvt_pk_bf16(b[2], b[3]); return w; }
struct EpiStore {
    static constexpr bool PERM = true, AFTER_DRAIN = false; bf16_t* O; int ldc;
    __device__ __forceinline__ void operator()(const f32x4 (&acc)[2][2][4][2], const Unit& u, int wr, int wc, int fr, int fq) const {
        const int row0 = u.pm * BM + wr * 64 + fr, col0 = u.pn * BM + wc * 32 + 8 * fq;
#pragma unroll
        for (int ai = 0; ai < 2; ++ai)
#pragma unroll
            for (int m = 0; m < 4; ++m) { bf16_t* rowp = O + (size_t)(row0 + ai * HALF + m * 16) * ldc + col0;
#pragma unroll
                for (int bj = 0; bj < 2; ++bj) *(u32x4*)(rowp + bj * HALF) = pack8(acc[ai][bj][m][0], acc[ai][bj][m][1]); }
    }
};
__device__ __forceinline__ f32x4 silu4(const f32x4 v) { f32x4 r;
#pragma unroll
    for (int i = 0; i < 4; ++i) r[i] = v[i] * __builtin_amdgcn_rcpf(1.f + __expf(-v[i])); return r; }
__device__ __forceinline__ f32x4 sigm4(const f32x4 v) { f32x4 r;
#pragma unroll
    for (int i = 0; i < 4; ++i) r[i] = __builtin_amdgcn_rcpf(1.f + __expf(-v[i])); return r; }
struct EpiSwiglu {
    static constexpr bool PERM = true, AFTER_DRAIN = false; bf16_t* G;
    __device__ __forceinline__ void operator()(const f32x4 (&acc)[2][2][4][2], const Unit& u, int wr, int wc, int fr, int fq) const {
        const int row0 = u.pm * BM + wr * 64 + fr, col0 = u.pn * HALF + wc * 32 + 8 * fq;
#pragma unroll
        for (int ai = 0; ai < 2; ++ai)
#pragma unroll
            for (int m = 0; m < 4; ++m) *(u32x4*)(G + (size_t)(row0 + ai * HALF + m * 16) * 512 + col0) = pack8(silu4(acc[ai][0][m][0]) * acc[ai][1][m][0], silu4(acc[ai][0][m][1]) * acc[ai][1][m][1]);
    }
};
__device__ __forceinline__ void unpack8f(const u32x4 w, f32x4& a, f32x4& b) {
    a[0] = __uint_as_float(w.x << 16); a[1] = __uint_as_float(w.x & 0xffff0000u); a[2] = __uint_as_float(w.y << 16); a[3] = __uint_as_float(w.y & 0xffff0000u);
    b[0] = __uint_as_float(w.z << 16); b[1] = __uint_as_float(w.z & 0xffff0000u); b[2] = __uint_as_float(w.w << 16); b[3] = __uint_as_float(w.w & 0xffff0000u); }
struct EpiGlu {
    static constexpr bool PERM = true, AFTER_DRAIN = false; const bf16_t* GS; const float* b; bf16_t* GG;
    __device__ __forceinline__ void operator()(const f32x4 (&acc)[2][2][4][2], const Unit& u, int wr, int wc, int fr, int fq) const {
        const int row0 = u.pm * BM + wr * 64 + fr, col0 = u.pn * BM + wc * 32 + 8 * fq;
#pragma unroll
        for (int bj = 0; bj < 2; ++bj) { const int c = col0 + bj * HALF; const f32x4 b0 = *(const f32x4*)(b + c), b1 = *(const f32x4*)(b + c + 4);
#pragma unroll
            for (int ai = 0; ai < 2; ++ai)
#pragma unroll
                for (int m = 0; m < 4; ++m) { const size_t o = (size_t)(row0 + ai * HALF + m * 16) * 512 + c; f32x4 g0, g1; unpack8f(*(const u32x4*)(GS + o), g0, g1);
                    *(u32x4*)(GG + o) = pack8(g0 * sigm4(acc[ai][bj][m][0] + b0), g1 * sigm4(acc[ai][bj][m][1] + b1)); } }
    }
};
struct EpiResid {
    static constexpr bool PERM = true, AFTER_DRAIN = false;
    const float* x; const float* ctx; const float* mod; bf16_t* XC; int inplace;
    __device__ __forceinline__ void operator()(const f32x4 (&acc)[2][2][4][2], const Unit& u, int wr, int wc, int fr, int fq) const {
        const int R0 = u.pm * BM; const int ci = R0 < 32768 ? (R0 >> 11) : 16;
        const float* base = R0 < 32768 ? x + (size_t)R0 * 1024 : ctx + (size_t)(R0 - 32768) * 1024;
        bf16_t* out = XC + (size_t)R0 * 1024; const float* gate = mod + ((size_t)ci * 6 + 2) * 1024;
        const int rl0 = wr * 64 + fr, col0 = u.pn * BM + wc * 32 + 8 * fq;
#pragma unroll
        for (int bj = 0; bj < 2; ++bj) { const int c = col0 + bj * HALF; const f32x4 g0 = *(const f32x4*)(gate + c), g1 = *(const f32x4*)(gate + c + 4);
#pragma unroll
            for (int ai = 0; ai < 2; ++ai)
#pragma unroll
                for (int m = 0; m < 4; ++m) { const size_t o = (size_t)(rl0 + ai * HALF + m * 16) * 1024 + c; f32x4 b0, b1;
                    if (inplace) unpack8f(*(const u32x4*)(out + o), b0, b1); else { b0 = *(const f32x4*)(base + o); b1 = *(const f32x4*)(base + o + 4); }
                    *(u32x4*)(out + o) = pack8(b0 + g0 * acc[ai][bj][m][0], b1 + g1 * acc[ai][bj][m][1]); } }
    }
};
}

#include <hip/hip_bf16.h>
#include <cmath>
namespace attn_body {
using bf16=__hip_bfloat16;
using bf16x8=__attribute__((ext_vector_type(8)))short;
using s16x4=__attribute__((ext_vector_type(4)))short;
using f32x16=__attribute__((ext_vector_type(16)))float;
using u32x4=__attribute__((ext_vector_type(4)))unsigned;
constexpr int D=64,QP=512,KP=128,OP=1024;
constexpr int NW=8,QBLK=32,QB=QBLK*NW,KVBLK=64;
constexpr int ATTN_UNIT_ROWS=QB;
__device__ __forceinline__ int crow(int r,int hi){return (r&3)+8*(r>>2)+4*hi;}
#define SBAR() __builtin_amdgcn_sched_barrier(0)
__device__ __forceinline__ void cmask(f32x16&p0,f32x16&p1,int jb,int qrel,int hi){
  const float NEG=-INFINITY; int kb=64*jb+4*hi;
  #pragma unroll
  for(int r=0;r<16;++r){int kv=kb+(r&3)+8*(r>>2); if(kv>qrel)p0[r]=NEG; if(kv+32>qrel)p1[r]=NEG;}
}

constexpr int NSLOT=3, SLOTB=8192;
constexpr int LDS_K=0, LDS_V=NSLOT*SLOTB, LDS_WS=2*NSLOT*SLOTB, LDS_OST=LDS_WS+NW*64*4, LDS_BYTES=LDS_OST+NW*4096;
constexpr float C2=0.125f*1.4426950408889634f;
__device__ __forceinline__ void glds16(const void*gsrc,unsigned lds_dst){unsigned keep;
  asm volatile("s_mov_b32 %0, m0\n\ts_mov_b32 m0, %2\n\ts_nop 0\n\tglobal_load_lds_dwordx4 %1, off\n\ts_mov_b32 m0, %0":"=&s"(keep):"v"(gsrc),"s"(lds_dst):"memory");}
__device__ __forceinline__ float max3f(float a,float b,float c){float r;asm("v_max3_f32 %0, %1, %2, %3":"=v"(r):"v"(a),"v"(b),"v"(c));return r;}
__device__ __forceinline__ float max2f(float a,float b){float r;asm("v_max_f32_e32 %0, %1, %2":"=v"(r):"v"(a),"v"(b));return r;}
__device__ __forceinline__ float fadd_s(float a,float b){float r;asm("v_add_f32_e32 %0, %1, %2":"=v"(r):"v"(a),"v"(b));return r;}
__device__ __forceinline__ float fsub_s(float a,float b){float r;asm("v_sub_f32_e32 %0, %1, %2":"=v"(r):"v"(a),"v"(b));return r;}
typedef float f32x2_t __attribute__((ext_vector_type(2))); typedef __bf16 bf16x2_t __attribute__((ext_vector_type(2)));
__device__ __forceinline__ unsigned cvtpk_s(float lo,float hi){f32x2_t v={lo,hi};bf16x2_t b=__builtin_convertvector(v,bf16x2_t);return __builtin_bit_cast(unsigned,b);}
#define WAIT_BAR(N) asm volatile("s_waitcnt vmcnt(" #N ") lgkmcnt(0)\n\ts_barrier":::"memory")

__device__ __forceinline__ void qkt(f32x16&p0,f32x16&p1,const char*Kslot,const bf16x8*qr,const f32x16&negm,int r32,int hi){
  const char*kb=Kslot+hi*1024+r32*16;
  #pragma unroll
  for(int d0=0;d0<4;++d0){
    const bf16x8 b0=*reinterpret_cast<const bf16x8*>(kb+d0*2048);
    const bf16x8 b1=*reinterpret_cast<const bf16x8*>(kb+d0*2048+512);
    if(d0==0){p0=__builtin_amdgcn_mfma_f32_32x32x16_bf16(b0,qr[0],negm,0,0,0);p1=__builtin_amdgcn_mfma_f32_32x32x16_bf16(b1,qr[0],negm,0,0,0);}
    else{p0=__builtin_amdgcn_mfma_f32_32x32x16_bf16(b0,qr[d0],p0,0,0,0);p1=__builtin_amdgcn_mfma_f32_32x32x16_bf16(b1,qr[d0],p1,0,0,0);}}
}
typedef __attribute__((address_space(3))) const char* lds_cptr;
typedef short v4i16_t __attribute__((ext_vector_type(4)));
__device__ __forceinline__ void kload8(bf16x8*kf,lds_cptr kp){
  kf[0]=*(const __attribute__((address_space(3))) bf16x8*)(kp);      kf[1]=*(const __attribute__((address_space(3))) bf16x8*)(kp+512);
  kf[2]=*(const __attribute__((address_space(3))) bf16x8*)(kp+2048); kf[3]=*(const __attribute__((address_space(3))) bf16x8*)(kp+2560);
  kf[4]=*(const __attribute__((address_space(3))) bf16x8*)(kp+4096); kf[5]=*(const __attribute__((address_space(3))) bf16x8*)(kp+4608);
  kf[6]=*(const __attribute__((address_space(3))) bf16x8*)(kp+6144); kf[7]=*(const __attribute__((address_space(3))) bf16x8*)(kp+6656);
}
__device__ __forceinline__ void kload2(bf16x8*kf,lds_cptr kp,int j){ kf[2*j]=*(const __attribute__((address_space(3))) bf16x8*)(kp+j*2048); kf[2*j+1]=*(const __attribute__((address_space(3))) bf16x8*)(kp+j*2048+512); }
__device__ __forceinline__ s16x4 vtr(lds_cptr p){ return __builtin_bit_cast(s16x4,__builtin_amdgcn_ds_read_tr16_b64_v4i16((__attribute__((address_space(3))) v4i16_t*)p)); }
__device__ __forceinline__ float rowmax(const f32x16&p0,const f32x16&p1){
  float a=max3f(p0[0],p0[1],p1[0]),b=max3f(p0[2],p0[3],p1[1]);a=max3f(a,p1[2],p1[3]);
  #pragma unroll
  for(int r=4;r<16;r+=4){a=max3f(a,p0[r],p0[r+1]);b=max3f(b,p0[r+2],p0[r+3]);a=max3f(a,p1[r],p1[r+1]);b=max3f(b,p1[r+2],p1[r+3]);}
  const float m=max2f(a,b);
  auto rr=__builtin_amdgcn_permlane32_swap(__float_as_uint(m),__float_as_uint(m),false,false);
  return max2f(__uint_as_float(rr[0]),__uint_as_float(rr[1]));
}
__device__ __forceinline__ void pv(f32x16*o,int vb,bf16x8 pa0,bf16x8 pa1,bf16x8 pa2,bf16x8 pa3){
  #pragma unroll
  for(int d0=0;d0<2;++d0){s16x4 lo[4],hi[4];
    #pragma unroll
    for(int ks=0;ks<4;++ks){
      asm volatile("ds_read_b64_tr_b16 %0,%1 offset:%c2":"=&v"(lo[ks]):"v"(vb),"i"(d0*4096+ks*1024):"memory");
      asm volatile("ds_read_b64_tr_b16 %0,%1 offset:%c2":"=&v"(hi[ks]):"v"(vb),"i"(d0*4096+ks*1024+512):"memory");}
    asm volatile("s_waitcnt lgkmcnt(0)":::"memory");SBAR();
    #define PK(k) (bf16x8){lo[k][0],lo[k][1],lo[k][2],lo[k][3],hi[k][0],hi[k][1],hi[k][2],hi[k][3]}
    o[d0]=__builtin_amdgcn_mfma_f32_32x32x16_bf16(pa0,PK(0),o[d0],0,0,0);
    o[d0]=__builtin_amdgcn_mfma_f32_32x32x16_bf16(pa1,PK(1),o[d0],0,0,0);
    o[d0]=__builtin_amdgcn_mfma_f32_32x32x16_bf16(pa2,PK(2),o[d0],0,0,0);
    o[d0]=__builtin_amdgcn_mfma_f32_32x32x16_bf16(pa3,PK(3),o[d0],0,0,0);
    #undef PK
  }
}

#ifndef ATTN_STORE16
#define ATTN_STORE16(p,v) (*(u32x4*)(p)=(v))
#endif
template<int THRL> __device__ __forceinline__ void attn_unit(const bf16*Q0,const bf16*__restrict__ Kh,const bf16*__restrict__ Vh,bf16*O0,const int NT,char*shm){
  const int tid=threadIdx.x,lane=tid&63,r32=lane&31,hi=lane>>5; const int wid=__builtin_amdgcn_readfirstlane(tid>>6);
  const bf16*Qw=Q0+(long)(wid*QBLK)*QP;
  const unsigned lds0=(unsigned)(uintptr_t)shm;
  float*wsf=(float*)(shm+LDS_WS)+wid*64;
  const bf16*ksrc=Kh+(long)lane*KP+wid*8;
  const bf16*vsrc=Vh+(long)(16*(wid&3)+(lane>>2))*KP+(wid>>2)*32+(lane&3)*8;
  const unsigned kdst=lds0+LDS_K+wid*1024, vdst=lds0+LDS_V+wid*1024;
  #define DMA_K(t,slot) glds16(ksrc+(long)(t)*KVBLK*KP,(unsigned)__builtin_amdgcn_readfirstlane(kdst+(slot)))
  #define DMA_V(t,slot) glds16(vsrc+(long)(t)*KVBLK*KP,(unsigned)__builtin_amdgcn_readfirstlane(vdst+(slot)))
  const int vb0=(int)(lds0+LDS_V)+((lane>>4)&1)*32+(lane&3)*8+(4*hi+((lane&15)>>2))*64;
  const char*Kbase=shm+LDS_K; bf16x8 kf[8];
  const lds_cptr shm3=(lds_cptr)shm; const lds_cptr kp0=shm3+LDS_K+hi*1024+r32*16; const lds_cptr vp0=shm3+LDS_V+((lane>>4)&1)*32+(lane&3)*8+(4*hi+((lane&15)>>2))*64;
  DMA_K(0,0);DMA_V(0,0);DMA_K(1,SLOTB);
  bf16x8 qr[4];
  #pragma unroll
  for(int d0=0;d0<4;++d0)qr[d0]=*reinterpret_cast<const bf16x8*>(&Qw[(long)r32*QP+d0*16+hi*8]);
  float mhat=0.f,l_reg=0.f;f32x16 o[2];o[0]=f32x16{};o[1]=f32x16{};f32x16 negm=f32x16{};asm volatile("":"+v"(negm));
  #define CMASK(P0,P1,t) do{}while(0)
  bool resc=false;
  #define START(P0,P1) do{ const float rm=rowmax(P0,P1); resc=false; \
    { const float dl=rm; mhat=fadd_s(mhat,dl); \
      _Pragma("unroll") for(int r=0;r<16;++r){P0[r]=fsub_s(P0[r],dl);P1[r]=fsub_s(P1[r],dl);} \
      _Pragma("unroll") for(int r=0;r<16;++r)negm[r]=-mhat; asm volatile("":"+v"(negm)); } \
    _Pragma("unroll") for(int r=0;r<16;++r)P0[r]=__builtin_amdgcn_exp2f(P0[r]); }while(0)
  #define RESC() do{ if(resc){ asm volatile("s_waitcnt lgkmcnt(0)":::"memory"); \
      _Pragma("unroll") for(int d_=0;d_<2;++d_) _Pragma("unroll") for(int r=0;r<16;++r)o[d_][r]*=wsf[crow(r,hi)]; } }while(0)
  f32x16 pA0,pA1,pB0,pB1;
  int sl_prev=0,sl_cur=0,sl_next=SLOTB;
  #define ROT() do{sl_prev=sl_cur;sl_cur=sl_next;sl_next=(sl_next==(NSLOT-1)*SLOTB)?0:sl_next+SLOTB;}while(0)
  DMA_K(2,2*SLOTB);
  WAIT_BAR(3);
  qkt(pA0,pA1,Kbase,qr,negm,r32,hi);asm volatile("s_nop 15\n\ts_nop 7":"+v"(pA0),"+v"(pA1));CMASK(pA0,pA1,0);
  START(pA0,pA1);
  _Pragma("unroll") for(int r=0;r<16;++r)pA1[r]=__builtin_amdgcn_exp2f(pA1[r]);
  WAIT_BAR(0);
  DMA_K(3,0);DMA_V(1,SLOTB);
  ROT();
  kload8(kf,kp0+sl_cur);
  WAIT_BAR(2);
  s16x4 vlo[8],vhi[8]; u32x4 pw0,pw1,pw2,pw3;
  #define PKW(P,B) cvtpk_s(P[B],P[B+1])
  #define PAF(k) __builtin_bit_cast(bf16x8,pw##k)
  #define VFR(i) (bf16x8){vlo[i][0],vlo[i][1],vlo[i][2],vlo[i][3],vhi[i][0],vhi[i][1],vhi[i][2],vhi[i][3]}
  #define PIN(x) asm volatile("":"+v"(x))
  #define MX3(a,b,c) __builtin_fmaxf(__builtin_fmaxf((a),(b)),(c))
  #define GAPA(MF,A0,A1,A2,A3,W0,W1,PW) do{ MF; sacc+=A0; sacc+=A1; sacc+=A2; sacc+=A3; PIN(sacc); W0; W1; PIN(PW); SBAR(); }while(0)
  #define EX(v) __builtin_amdgcn_exp2f(v)
  #define GAPB(MF,X,B) do{ MF; X[B]=EX(X[B]); X[B+1]=EX(X[B+1]); X[B+2]=EX(X[B+2]); X[B+3]=EX(X[B+3]); PIN(X); SBAR(); }while(0)
  #define VRD(i) do{ vlo[i]=vtr(vp_+(((i)>>2)*4096+((i)&3)*1024)); vhi[i]=vtr(vp_+(((i)>>2)*4096+((i)&3)*1024+512)); }while(0)
  #define KRD(G,j) do{ if(G){ kload2(kf,kp0+sl_next,j); SBAR(); } }while(0)
  #define STEP(C0,C1,P0,P1,t,GK,GV,GL) do{ SBAR(); \
    const lds_cptr vp_=vp0+sl_prev; \
    VRD(0); SBAR(); float sacc=(P0[0]+P0[1]); \
    GAPA(C0=__builtin_amdgcn_mfma_f32_32x32x16_bf16(kf[0],qr[0],negm,0,0,0), P0[2],P0[3],P0[4],P0[5],     pw0[0]=PKW(P0,0), pw0[1]=PKW(P0,2), pw0); \
    VRD(4); SBAR(); GAPA(C1=__builtin_amdgcn_mfma_f32_32x32x16_bf16(kf[1],qr[0],negm,0,0,0), P0[6],P0[7],P0[8],P0[9],     pw0[2]=PKW(P0,4), pw0[3]=PKW(P0,6), pw0); \
    VRD(1); SBAR(); GAPA(C0=__builtin_amdgcn_mfma_f32_32x32x16_bf16(kf[2],qr[1],C0,0,0,0),   P0[10],P0[11],P0[12],P0[13], pw1[0]=PKW(P0,8), pw1[1]=PKW(P0,10), pw1); \
    VRD(5); SBAR(); GAPA(C1=__builtin_amdgcn_mfma_f32_32x32x16_bf16(kf[3],qr[1],C1,0,0,0),   P0[14],P0[15],P1[0],P1[1],   pw1[2]=PKW(P0,12),pw1[3]=PKW(P0,14), pw1); \
    VRD(2); SBAR(); GAPA(C0=__builtin_amdgcn_mfma_f32_32x32x16_bf16(kf[4],qr[2],C0,0,0,0),   P1[2],P1[3],P1[4],P1[5],     pw2[0]=PKW(P1,0), pw2[1]=PKW(P1,2), pw2); \
    VRD(6); SBAR(); GAPA(C1=__builtin_amdgcn_mfma_f32_32x32x16_bf16(kf[5],qr[2],C1,0,0,0),   P1[6],P1[7],P1[8],P1[9],     pw2[2]=PKW(P1,4), pw2[3]=PKW(P1,6), pw2); \
    VRD(3); SBAR(); GAPA(C0=__builtin_amdgcn_mfma_f32_32x32x16_bf16(kf[6],qr[3],C0,0,0,0),   P1[10],P1[11],P1[12],P1[13], pw3[0]=PKW(P1,8), pw3[1]=PKW(P1,10), pw3); \
    VRD(7); SBAR(); GAPA(C1=__builtin_amdgcn_mfma_f32_32x32x16_bf16(kf[7],qr[3],C1,0,0,0),   P1[14],P1[15],0.f,0.f,       pw3[2]=PKW(P1,12),pw3[3]=PKW(P1,14), pw3); \
    l_reg+=sacc; \
    if(GK){DMA_K((t)+3,sl_cur);} if(GV){DMA_V((t)+1,sl_next);} \
    CMASK(C0,C1,t); \
    { float a=MX3(C0[0],C0[1],C1[0]),b=MX3(C0[2],C0[3],C1[1]); a=MX3(a,C1[2],C1[3]); \
      _Pragma("unroll") for(int r=4;r<16;r+=4){a=MX3(a,C0[r],C0[r+1]);b=MX3(b,C0[r+2],C0[r+3]);a=MX3(a,C1[r],C1[r+1]);b=MX3(b,C1[r+2],C1[r+3]);} \
      float rm=__builtin_fmaxf(a,b); { auto rr=__builtin_amdgcn_permlane32_swap(__float_as_uint(rm),__float_as_uint(rm),false,false); rm=__builtin_fmaxf(__uint_as_float(rr[0]),__uint_as_float(rr[1])); } \
      resc=false; \
      if(__builtin_expect(__any(rm>(float)THRL),0)){ const float dl=__builtin_fmaxf(rm,0.f); mhat+=dl; \
        _Pragma("unroll") for(int r=0;r<16;++r){C0[r]-=dl;C1[r]-=dl;} \
        _Pragma("unroll") for(int r=0;r<16;++r)negm[r]=-mhat; asm volatile("":"+v"(negm)); \
        const float f=__builtin_amdgcn_exp2f(-dl); l_reg*=f; if(hi==0)wsf[r32]=f; resc=true; } } \
    SBAR(); \
    GAPB(o[0]=__builtin_amdgcn_mfma_f32_32x32x16_bf16(PAF(0),VFR(0),o[0],0,0,0), C0,0); \
    GAPB(o[1]=__builtin_amdgcn_mfma_f32_32x32x16_bf16(PAF(0),VFR(4),o[1],0,0,0), C0,4); \
    KRD(GL,0); GAPB(o[0]=__builtin_amdgcn_mfma_f32_32x32x16_bf16(PAF(1),VFR(1),o[0],0,0,0), C0,8); \
    KRD(GL,1); GAPB(o[1]=__builtin_amdgcn_mfma_f32_32x32x16_bf16(PAF(1),VFR(5),o[1],0,0,0), C0,12); \
    KRD(GL,2); GAPB(o[0]=__builtin_amdgcn_mfma_f32_32x32x16_bf16(PAF(2),VFR(2),o[0],0,0,0), C1,0); \
    KRD(GL,3); GAPB(o[1]=__builtin_amdgcn_mfma_f32_32x32x16_bf16(PAF(2),VFR(6),o[1],0,0,0), C1,4); \
    GAPB(o[0]=__builtin_amdgcn_mfma_f32_32x32x16_bf16(PAF(3),VFR(3),o[0],0,0,0), C1,8); \
    GAPB(o[1]=__builtin_amdgcn_mfma_f32_32x32x16_bf16(PAF(3),VFR(7),o[1],0,0,0), C1,12); \
    }while(0)
  int t=1;
  #undef CMASK
  #define CMASK(P0,P1,t) do{}while(0)
  for(;t+5<NT;t+=2){
    STEP(pB0,pB1,pA0,pA1,t,true,true,true);     WAIT_BAR(2); RESC(); ROT();
    STEP(pA0,pA1,pB0,pB1,t+1,true,true,true);   WAIT_BAR(2); RESC(); ROT();
  }
  #undef CMASK
  #define CMASK(P0,P1,t) do{}while(0)
  #define ENDW(tt) do{ if((tt)+3<NT){WAIT_BAR(2);} else if((tt)+2<NT){WAIT_BAR(1);} else {WAIT_BAR(0);} }while(0)
  for(;t+1<NT;t+=2){
    STEP(pB0,pB1,pA0,pA1,t,(t+3<NT),(t+1<NT),(t+1<NT));       ENDW(t);   RESC(); ROT();
    STEP(pA0,pA1,pB0,pB1,t+1,(t+4<NT),(t+2<NT),(t+2<NT));     ENDW(t+1); RESC(); ROT();
  }
  STEP(pB0,pB1,pA0,pA1,NT-1,false,false,false); RESC();
  { float sacc=pB0[0]+pB0[1]; _Pragma("unroll") for(int r=2;r<16;++r)sacc+=pB0[r]; _Pragma("unroll") for(int r=0;r<16;++r)sacc+=pB1[r]; l_reg+=sacc;
    pw0=(u32x4){PKW(pB0,0),PKW(pB0,2),PKW(pB0,4),PKW(pB0,6)};pw1=(u32x4){PKW(pB0,8),PKW(pB0,10),PKW(pB0,12),PKW(pB0,14)};pw2=(u32x4){PKW(pB1,0),PKW(pB1,2),PKW(pB1,4),PKW(pB1,6)};pw3=(u32x4){PKW(pB1,8),PKW(pB1,10),PKW(pB1,12),PKW(pB1,14)};
    SBAR(); pv(o,vb0+sl_cur,PAF(0),PAF(1),PAF(2),PAF(3)); }
  #undef PKW
  #undef PAF
  #undef VFR
  #undef PIN
  #undef MX3
  #undef GAPA
  #undef GAPB
  #undef EX
  #undef VRD
  #undef KRD
  #undef STEP
  #undef ENDW
  {auto rr=__builtin_amdgcn_permlane32_swap(__float_as_uint(l_reg),__float_as_uint(l_reg),false,false);l_reg=__uint_as_float(rr[0])+__uint_as_float(rr[1]);}
  if(hi==0)wsf[32+r32]=l_reg;asm volatile("s_waitcnt lgkmcnt(0)":::"memory");
  float rli[16];
  #pragma unroll
  for(int r=0;r<16;++r)rli[r]=__builtin_amdgcn_rcpf(wsf[32+crow(r,hi)]);
  bf16*Ow=O0+(long)(wid*QBLK)*OP;
  { bf16*stg=(bf16*)(shm+LDS_OST)+wid*2048;
    #pragma unroll
    for(int r=0;r<16;++r){const int orow=crow(r,hi);
      #pragma unroll
      for(int d0=0;d0<2;++d0)stg[orow*64+d0*32+r32]=__float2bfloat16(o[d0][r]*rli[r]);}
    asm volatile("s_waitcnt lgkmcnt(0)":::"memory");
    #pragma unroll
    for(int i=0;i<4;++i){const int row=i*8+(lane>>3),ch=lane&7; const u32x4 v=*(const u32x4*)(stg+row*64+ch*8); ATTN_STORE16(Ow+(long)row*OP+ch*8,v);} }
  asm volatile("s_waitcnt lgkmcnt(0)\n\ts_barrier":::"memory");
  #undef DMA_K
  #undef DMA_V
  #undef CMASK
  #undef START
  #undef RESC
  #undef ROT
}
constexpr int ATTN_LDS_BYTES=LDS_BYTES;
#undef SBAR
#undef WAIT_BAR
}

struct Params {
    const float* in[35];
    float* out;
    unsigned char* ws;
    int ph_lo, ph_hi;
};
enum { I_X = 0, I_C, I_CTX, I_CCTX, I_WMOD, I_BMOD, I_GMIX, I_GFFN, I_MIXWIN, I_MIXWOUT, I_QG, I_KG, I_LNG, I_WSP, I_BSP,
       I_S5WIN, I_ARE, I_AIM, I_LOGDT, I_BRE, I_BIM, I_CRE, I_CIM, I_S5D, I_WGLU, I_BGLU, I_S5WOUT,
       I_WGRP, I_BGRP, I_WRT, I_BRT, I_W1, I_W3, I_W2, I_FING };

struct Ctx {
    const Params* p;
    unsigned char* ws;
    LAS unsigned char* lds;
    int tid, lane, wave, gw, ngw;
};
__device__ __forceinline__ const float* xin_row(const Params& P, int r) { return r < TL ? P.in[I_X] + (size_t)r * D : P.in[I_CTX] + (size_t)(r - TL) * D; }
__device__ __forceinline__ int cond_of(int r) { return r < TL ? (r >> 11) : 16; }
__device__ __forceinline__ const float* mod_vec(const Ctx& C, int layer, int ci, int k) { return (const float*)(C.ws + WS_MOD) + ((size_t)(layer * 17 + ci) * 6 + k) * D; }

__device__ __forceinline__ void dsincos(double a, double& s, double& c) {
    const double TWO_PI_HI = 6.283185307179586, TWO_PI_LO = 2.4492935982947064e-16;
    const double k = rint(a * 0.15915494309189535);
    double r = fma(-k, TWO_PI_HI, a); r = fma(-k, TWO_PI_LO, r);
    const double r2 = r * r; double ct = 1.0, st = r, cs = 1.0, ss = r;
#pragma unroll 1
    for (int i = 1; i <= 15; ++i) { ct *= -r2 / (double)((2 * i - 1) * (2 * i)); cs += ct; st *= -r2 / (double)((2 * i) * (2 * i + 1)); ss += st; }
    s = ss; c = cs;
}

__device__ __forceinline__ void transpose_item(const float* src, int N, int k0, int n0, bf16* dst, int dpitch, LAS float* scr, int lane) {
#pragma unroll 8
    for (int i = 0; i < 32; ++i) { const int kk = 2 * i + (lane >> 5); scr[kk * 33 + (lane & 31)] = src[(size_t)(k0 + kk) * N + n0 + (lane & 31)]; }
    asm volatile("s_waitcnt lgkmcnt(0)" ::: "memory");
    const int c = lane & 7;
#pragma unroll
    for (int j = 0; j < 4; ++j) { const int n = (lane >> 3) + 8 * j; const LAS float* s = scr + (8 * c) * 33 + n;
        v4u o; o.x = pk2(s[0 * 33], s[1 * 33]); o.y = pk2(s[2 * 33], s[3 * 33]); o.z = pk2(s[4 * 33], s[5 * 33]); o.w = pk2(s[6 * 33], s[7 * 33]);
        *(v4u*)(dst + (size_t)n * dpitch + 8 * c) = o; }
    asm volatile("s_waitcnt lgkmcnt(0)" ::: "memory");
}
__device__ __forceinline__ void transpose_mat_item(const float* W, int K, int N, bf16* WT, int it, LAS float* scr, int lane) {
    const int nblk = N / 32, kb = it / nblk, nb = it % nblk;
    transpose_item(W, N, kb * 64, nb * 32, WT + (size_t)(nb * 32) * K + kb * 64, K, scr, lane);
}
constexpr int MOE_ITEMS = NEXP * 768;
__device__ __forceinline__ void moe_convert_item(const Ctx& C, int layer, int it, LAS float* scr) {
    const Params& P = *C.p;
    const int e = it / 768, r = it % 768, kind = r / 256, j = r % 256;
    if (kind < 2) {
        const float* src = (kind == 0 ? P.in[I_W1] : P.in[I_W3]) + ((size_t)layer * NEXP + e) * D * EH;
        const int kb = j / 16, nb = j % 16, k0 = kb * 64, n0 = nb * 32;
        const int drow = (n0 / 128) * 256 + (n0 % 128) + (kind == 1 ? 128 : 0);
        transpose_item(src, EH, k0, n0, (bf16*)(C.ws + WS_W13) + (size_t)e * 1024 * 1024 + (size_t)drow * 1024 + k0, 1024, scr, C.lane);
    } else {
        const float* src = P.in[I_W2] + ((size_t)layer * NEXP + e) * EH * D;
        const int kb = j / 32, nb = j % 32, k0 = kb * 64, n0 = nb * 32;
        transpose_item(src, D, k0, n0, (bf16*)(C.ws + WS_W2) + (size_t)e * 1024 * 512 + (size_t)n0 * 512 + k0, 512, scr, C.lane);
    }
}

__device__ __forceinline__ void phase_prologue(const Ctx& C) {
    const Params& P = *C.p;
    {
        LAS float* s = (LAS float*)C.lds;
        LAS float* red = (LAS float*)(C.lds + 17 * 1024 * 4);
        bool have_s = false;
        for (int u = blockIdx.x; u < 192; u += gridDim.x) {
            if (!have_s) {
                for (int i = C.tid; i < 17 * 1024; i += NTHR) { const int ci = i >> 10, k = i & 1023; const float v = ci < 16 ? P.in[I_C][ci * D + k] : P.in[I_CCTX][k]; s[i] = silu_(v); }
                have_s = true; __syncthreads();
            }
            const int layer = u / 96, jg = u % 96, kq = C.tid >> 6, jc = C.tid & 63;
            const float* w = P.in[I_WMOD] + (size_t)layer * D * 6144 + jg * 64 + jc;
            float acc[17];
#pragma unroll
            for (int i = 0; i < 17; ++i) acc[i] = 0.f;
            for (int k = kq * 128; k < kq * 128 + 128; ++k) { const float wv = w[(size_t)k * 6144];
#pragma unroll
                for (int i = 0; i < 17; ++i) acc[i] += s[i * 1024 + k] * wv; }
#pragma unroll
            for (int i = 0; i < 17; ++i) red[(kq * 17 + i) * 64 + jc] = acc[i];
            __syncthreads();
            for (int o = C.tid; o < 17 * 64; o += NTHR) { const int ci = o >> 6, c = o & 63; float v = 0.f;
#pragma unroll
                for (int q = 0; q < 8; ++q) v += red[(q * 17 + ci) * 64 + c];
                const int j = jg * 64 + c; v += P.in[I_BMOD][layer * 6144 + j];
                ((float*)(C.ws + WS_MOD))[((size_t)(layer * 17 + ci)) * 6144 + j] = v; }
            __syncthreads();
        }
        __syncthreads();
    }
    {
        const int gt = blockIdx.x * NTHR + C.tid, ngt = gridDim.x * NTHR;
        float2* rope = (float2*)(C.ws + WS_TAB + TAB_ROPE);
        for (int i = gt; i < 64 * 16; i += ngt) { const int pos = i >> 4, f = i & 15;
            const double th = exp(-(double)f * (9.210340371976184 / 16.0)); double s, c; dsincos((double)pos * th, s, c); rope[i] = make_float2((float)c, (float)s); }
        float2* lamb = (float2*)(C.ws + WS_TAB + TAB_LAMB); float2* bbar = (float2*)(C.ws + WS_TAB + TAB_BBAR);
        for (int i = gt; i < 2 * 32 * 64; i += ngt) {
            const int dg = i >> 6;
            const double are = P.in[I_ARE][i], aim = P.in[I_AIM][i], dt = exp((double)P.in[I_LOGDT][dg]);
            double s, c; dsincos(aim * dt, s, c); const double mag = exp(are * dt), lr = mag * c, li = mag * s;
            lamb[i] = make_float2((float)lr, (float)li);
            const double den = are * are + aim * aim, nr = lr - 1.0, ni = li;
            const double cr = (nr * are + ni * aim) / den, cim = (ni * are - nr * aim) / den;
            for (int p = 0; p < 16; ++p) { const double br = P.in[I_BRE][(size_t)i * 16 + p], bi = P.in[I_BIM][(size_t)i * 16 + p];
                bbar[(size_t)i * 16 + p] = make_float2((float)(cr * br - cim * bi), (float)(cr * bi + cim * br)); }
        }
    }
    {
        const int gt = blockIdx.x * NTHR + C.tid, ngt = gridDim.x * NTHR;
        bf16* wrt = (bf16*)(C.ws + WS_TAB + TAB_WR);
        for (int idx = gt; idx < 2 * 32 * 3 * 64; idx += ngt) {
            const int ln = idx & 63, jb = (idx >> 6) % 3, kk = (idx / 192) & 31, l = idx / (192 * 32);
            const int i = ln & 15, q = ln >> 4, grp = i >> 2, r = i & 3;
            float hi8[8], lo8[8];
#pragma unroll
            for (int e = 0; e < 8; ++e) { const int k = 32 * kk + 8 * q + e;
                const float w = jb < 2 ? P.in[I_WRT][((size_t)l * D + k) * 32 + grp * 8 + jb * 4 + r] : (r == 0 ? P.in[I_WGRP][((size_t)l * D + k) * 4 + grp] : 0.f);
                const float h = bf2f(f2bf(w)); hi8[e] = h; lo8[e] = w - h; }
            v4u oh, ol; oh.x = pk2(hi8[0], hi8[1]); oh.y = pk2(hi8[2], hi8[3]); oh.z = pk2(hi8[4], hi8[5]); oh.w = pk2(hi8[6], hi8[7]);
            ol.x = pk2(lo8[0], lo8[1]); ol.y = pk2(lo8[2], lo8[3]); ol.z = pk2(lo8[4], lo8[5]); ol.w = pk2(lo8[6], lo8[7]);
            const size_t base = ((((size_t)l * 32 + kk) * 3 + jb) * 2) * 64 + ln;
            *(v4u*)(wrt + base * 8) = oh; *(v4u*)(wrt + (base + 64) * 8) = ol;
        }
    }
    {
        const int gt = blockIdx.x * NTHR + C.tid, ngt = gridDim.x * NTHR; bf16* w16 = (bf16*)(C.ws + WS_WSP);
        for (int i = gt; i < 8 * 128 * 128 / 4; i += ngt) { const f32x4 v = *(const f32x4*)(P.in[I_WSP] + 4 * (size_t)i); v2u o; o.x = pk2(v.x, v.y); o.y = pk2(v.z, v.w); *(v2u*)(w16 + 4 * (size_t)i) = o; }
    }
    {
        LAS float* scr = (LAS float*)(C.lds + C.wave * 16384);
        constexpr int I0 = 16 * 56, I1 = 16 * 32, I2 = 16 * 16, I3 = 8 * 16, I4 = 8 * 32;
        constexpr int NSMALL = I0 + I1 + I2 + I3 + I4;
        for (int it = C.gw; it < NSMALL + MOE_ITEMS; it += C.ngw) {
            int r = it;
            if (r < I0) { transpose_mat_item(P.in[I_MIXWIN], D, MIXW, (bf16*)(C.ws + WS_WIN0), r, scr, C.lane); continue; } r -= I0;
            if (r < I1) { transpose_mat_item(P.in[I_MIXWOUT], D, D, (bf16*)(C.ws + WS_WOUT0), r, scr, C.lane); continue; } r -= I1;
            if (r < I2) { transpose_mat_item(P.in[I_S5WIN], D, 512, (bf16*)(C.ws + WS_WS5IN), r, scr, C.lane); continue; } r -= I2;
            if (r < I3) { transpose_mat_item(P.in[I_WGLU], 512, 512, (bf16*)(C.ws + WS_WGLU), r, scr, C.lane); continue; } r -= I3;
            if (r < I4) { transpose_mat_item(P.in[I_S5WOUT], 512, D, (bf16*)(C.ws + WS_WS5OUT), r, scr, C.lane); continue; } r -= I4;
            moe_convert_item(C, 0, r, scr);
        }
    }
}

__device__ __forceinline__ void load_row16(const float* row, int lane, f32x4 (&v)[4]) {
#pragma unroll
    for (int j = 0; j < 4; ++j) v[j] = *(const f32x4*)(row + 4 * lane + 256 * j);
}
__device__ __forceinline__ float row_rstd(const f32x4 (&v)[4]) {
    float s = 0.f;
#pragma unroll
    for (int j = 0; j < 4; ++j) s += (v[j].x * v[j].x + v[j].y * v[j].y) + (v[j].z * v[j].z + v[j].w * v[j].w);
    return rsqrtf(wave_sum(s) * (1.f / D) + EPS);
}
__device__ __forceinline__ void modulate16(f32x4 (&v)[4], float rstd, const float* g, const float* scale, const float* shift, int lane) {
#pragma unroll
    for (int j = 0; j < 4; ++j) { const int c = 4 * lane + 256 * j; const f32x4 gg = *(const f32x4*)(g + c), sc = *(const f32x4*)(scale + c), sh = *(const f32x4*)(shift + c);
        v[j] = v[j] * rstd * gg * (sc + 1.f) + sh; }
}
__device__ __forceinline__ void store_row16_bf16(bf16* row, int lane, const f32x4 (&v)[4]) {
#pragma unroll
    for (int j = 0; j < 4; ++j) { v2u o; o.x = pk2(v[j].x, v[j].y); o.y = pk2(v[j].z, v[j].w); *(v2u*)(row + 4 * lane + 256 * j) = o; }
}

__device__ __forceinline__ void phase_norm_mix0(const Ctx& C) {
    const Params& P = *C.p; bf16* H = (bf16*)(C.ws + WS_H);
    for (int r = C.gw; r < TT; r += C.ngw) {
        f32x4 v[4]; load_row16(xin_row(P, r), C.lane, v);
        const float rstd = row_rstd(v); const int ci = cond_of(r);
        modulate16(v, rstd, P.in[I_GMIX], mod_vec(C, 0, ci, 1), mod_vec(C, 0, ci, 0), C.lane);
        store_row16_bf16(H + (size_t)r * D, C.lane, v);
    }
}

__device__ __forceinline__ void qk_norm_rope(float (&v)[8], const float* gain, bool lat, int t, int lane, const float2* rope) {
    float ss = 0.f;
#pragma unroll
    for (int j = 0; j < 8; ++j) ss += v[j] * v[j];
    ss += __shfl_xor(ss, 1); ss += __shfl_xor(ss, 2); ss += __shfl_xor(ss, 4);
    const float rstd = rsqrtf(ss * (1.f / 64.f) + EPS);
    const int l8 = lane & 7;
#pragma unroll
    for (int j = 0; j < 8; ++j) v[j] = v[j] * rstd * gain[l8 * 8 + j];
    const int quarter = l8 >> 1, pos = (quarter < 2) ? (t >> 6) : (t & 63);
#pragma unroll
    for (int j = 0; j < 8; ++j) {
        const float pv = __shfl_xor(v[j], 2);
        if (lat) { const float2 cs = rope[pos * 16 + (lane & 1) * 8 + j];
            v[j] = (quarter & 1) ? (v[j] * cs.x + pv * cs.y) : (v[j] * cs.x - pv * cs.y); }
    }
}
__device__ __forceinline__ void phase_qkprep(const Ctx& C) {
    const Params& P = *C.p; const bf16* Pb = (const bf16*)(C.ws + WS_P); bf16* Q = (bf16*)(C.ws + WS_Q); bf16* Kb = (bf16*)(C.ws + WS_K); bf16* Vb = (bf16*)(C.ws + WS_V);
    const float2* rope = (const float2*)(C.ws + WS_TAB + TAB_ROPE);
    for (int r = C.gw; r < TT; r += C.ngw) {
        const bool lat = r < TL; const int t = lat ? (r & 2047) : 0;
        const size_t kvrow = lat ? (size_t)(r >> 11) * KVL + CTXL + (r & 2047) : (size_t)((r - TL) >> 8) * KVL + ((r - TL) & 255);
        const bf16* pr = Pb + (size_t)r * MIXW;
        { float v[8]; unpack8(*(const v4u*)(pr + 8 * C.lane), v); qk_norm_rope(v, P.in[I_QG], lat, t, C.lane, rope);
          v4u o; o.x = pk2(v[0] * QSCALE, v[1] * QSCALE); o.y = pk2(v[2] * QSCALE, v[3] * QSCALE); o.z = pk2(v[4] * QSCALE, v[5] * QSCALE); o.w = pk2(v[6] * QSCALE, v[7] * QSCALE);
          *(v4u*)(Q + (size_t)r * 512 + 8 * C.lane) = o; }
        { const int l = C.lane & 15; float v[8]; unpack8(*(const v4u*)(pr + 512 + 8 * l), v); qk_norm_rope(v, P.in[I_KG], lat, t, C.lane, rope);
          if (C.lane < 16) { v4u o; o.x = pk2(v[0], v[1]); o.y = pk2(v[2], v[3]); o.z = pk2(v[4], v[5]); o.w = pk2(v[6], v[7]); *(v4u*)(Kb + kvrow * 128 + 8 * l) = o;
              *(v4u*)(Vb + kvrow * 128 + 8 * l) = *(const v4u*)(pr + 640 + 8 * l); } }
        { float v[8]; unpack8(*(const v4u*)(pr + 1280 + 8 * C.lane), v); float sm = 0.f;
#pragma unroll
          for (int j = 0; j < 8; ++j) { v[j] = gelu_tanh(v[j]); sm += v[j]; }
          const float mean = wave_sum(sm) * (1.f / 512.f); float qq = 0.f;
#pragma unroll
          for (int j = 0; j < 8; ++j) { const float d = v[j] - mean; qq += d * d; }
          const float rstd = rsqrtf(wave_sum(qq) * (1.f / 512.f) + EPS);
          if (C.lane == 0) ((float2*)(C.ws + WS_ROUTE + RT_S))[r] = make_float2(mean, rstd); }
    }
}

__device__ __forceinline__ unsigned gm_off_b(unsigned row, unsigned ch) { return 256u * row + 16u * (ch ^ (((row & 3u) << 2) | ((row >> 2) & 3u))); }
__device__ __forceinline__ void phase_gmlp_fast(const Ctx& C) {
    typedef short bf16x8 __attribute__((ext_vector_type(8)));
    typedef short s16x4 __attribute__((ext_vector_type(4)));
    typedef float f32x16 __attribute__((ext_vector_type(16)));
    const Params& P = *C.p; const bf16* Pb = (const bf16*)(C.ws + WS_P); bf16* OG = (bf16*)(C.ws + WS_H); const bf16* W16 = (const bf16*)(C.ws + WS_WSP);
    const float2* lns = (const float2*)(C.ws + WS_ROUTE + RT_S);
    const int tid = C.tid, lane = C.lane, w = C.wave, l31 = lane & 31, hi = lane >> 5;
    const int gsel = w >> 2, pb = w & 3;
    for (int u = blockIdx.x; u < (TT / 128) * 4; u += gridDim.x) {
        const int ch_ = u >> 2, gp = u & 3;
        { const int row = tid >> 2; const size_t grow = (size_t)ch_ * 128 + row; const float2 st = lns[grow];
#pragma unroll
          for (int i = 0; i < 4; ++i) { const int c16 = (tid & 3) + 4 * i; float v[8]; unpack8(*(const v4u*)(Pb + grow * MIXW + 1280 + 128 * gp + 8 * c16), v);
              const float* lg = P.in[I_LNG] + 128 * gp + 8 * c16;
#pragma unroll
              for (int j = 0; j < 8; ++j) v[j] = (gelu_tanh(v[j]) - st.x) * st.y * lg[j];
              v4u o; o.x = pk2(v[0], v[1]); o.y = pk2(v[2], v[3]); o.z = pk2(v[4], v[5]); o.w = pk2(v[6], v[7]);
              *(LAS v4u*)(C.lds + (row >> 5) * 8192 + gm_off_b(row & 31, c16)) = o; } }
        __syncthreads();
        const int g = 2 * gp + gsel;
        f32x16 acc[2]; acc[0] = f32x16{}; acc[1] = f32x16{};
        const bf16* wrow = W16 + ((size_t)g * 128 + 32 * pb + l31) * 128 + 8 * hi;
#pragma unroll
        for (int k8 = 0; k8 < 8; ++k8) {
            const bf16x8 xf = *(const bf16x8*)(wrow + 16 * k8);
            const unsigned rb = k8 >> 1, ks = k8 & 1;
#pragma unroll
            for (int db = 0; db < 2; ++db) { const unsigned c = 2 * gsel + db, blk = (lane >> 4) & 1, q = (lane & 15) >> 2, p2 = lane & 3;
                s16x4 t0, t1;
                { const unsigned a0 = rb * 8192 + gm_off_b(16 * ks + 8 * hi + q, 4 * c + 2 * blk + (p2 >> 1)) + 8 * (p2 & 1);
                  const unsigned a1 = rb * 8192 + gm_off_b(16 * ks + 8 * hi + 4 + q, 4 * c + 2 * blk + (p2 >> 1)) + 8 * (p2 & 1);
                  t0 = __builtin_bit_cast(s16x4, __builtin_amdgcn_ds_read_tr16_b64_v4i16((LAS s16x4*)(C.lds + a0)));
                  t1 = __builtin_bit_cast(s16x4, __builtin_amdgcn_ds_read_tr16_b64_v4i16((LAS s16x4*)(C.lds + a1))); }
                const bf16x8 yf = {t0[0], t0[1], t0[2], t0[3], t1[0], t1[1], t1[2], t1[3]};
                acc[db] = __builtin_amdgcn_mfma_f32_32x32x16_bf16(xf, yf, acc[db], 0, 0, 0); }
        }
        const float* bsp = P.in[I_BSP] + g * 128 + 32 * pb;
#pragma unroll
        for (int r = 0; r < 16; ++r) { const int pl = (r & 3) + 8 * (r >> 2) + 4 * hi; const size_t grow = (size_t)ch_ * 128 + 32 * pb + pl; const float bb = bsp[pl];
#pragma unroll
            for (int db = 0; db < 2; ++db) { const int col = 64 * g + 32 * db + l31; const float uu = gelu_tanh(bf2f(Pb[grow * MIXW + 768 + col]));
                OG[grow * D + 512 + col] = (bf16)f2bf(uu * (acc[db][r] + bb)); } }
        __syncthreads();
    }
}

__device__ __forceinline__ void phase_attn_fast(const Ctx& C, char* lds_generic) {
    typedef attn_body::bf16 abf;
    const abf* Q = (const abf*)(C.ws + WS_Q); const abf* Kb = (const abf*)(C.ws + WS_K); const abf* Vb = (const abf*)(C.ws + WS_V); abf* OG = (abf*)(C.ws + WS_H);
    const int G = gridDim.x, bx = blockIdx.x; const int vcu = (G % 8 == 0) ? (bx % 8) * (G / 8) + bx / 8 : bx;
    const int per = (1024 + G - 1) / G, perc = (128 + G - 1) / G;
    for (int i = 0; i < per + perc; ++i) {
        int b, h, nt; size_t qrow;
        if (i < per) { const int u = vcu * per + i; if (u >= 1024) continue; const int qb = u & 7, hg = (u >> 3) & 3, bk = u >> 5; b = bk >> 1; h = (bk & 1) * 4 + hg; qrow = (size_t)b * SEQ + qb * 256; nt = KVL / 64; }
        else { const int u = vcu + (i - per) * G; if (u >= 128) continue; b = u >> 3; h = u & 7; qrow = (size_t)TL + (size_t)b * CTXL; nt = CTXL / 64; }
        const size_t kvo = (size_t)b * KVL * 128 + (h >> 2) * 64;
        attn_body::attn_unit<8>(Q + qrow * 512 + h * 64, Kb + kvo, Vb + kvo, OG + qrow * 1024 + h * 64, nt, lds_generic);
    }
}

__device__ __forceinline__ void phase_router_fast(const Ctx& C, int layer, int nrows) {
    typedef short bf16x8 __attribute__((ext_vector_type(8)));
    const Params& P = *C.p; const bf16* XC = (const bf16*)(C.ws + WS_XC); bf16* F = (bf16*)(C.ws + WS_H);
    int* asg_e = (int*)(C.ws + WS_ROUTE + RT_E); int* asg_p = (int*)(C.ws + WS_ROUTE + RT_P); float* asg_w = (float*)(C.ws + WS_ROUTE + RT_W); int* list = (int*)(C.ws + WS_LIST);
    unsigned* cnt = (unsigned*)(C.ws + WS_CTL) + CW_CNT + 64 * layer;
    const bf16x8* WR = (const bf16x8*)(C.ws + WS_TAB + TAB_WR) + (size_t)layer * (32 * 3 * 2 * 64) + C.lane;
    const int l15 = C.lane & 15, q4 = C.lane >> 4;
    const float* gg = P.in[I_GFFN] + layer * D + 8 * q4;
    for (int it = C.gw; it < nrows / 16; it += C.ngw) {
        const int row = it * 16 + l15, ci = cond_of(it * 16);
        const bf16* xr = XC + (size_t)row * D + 8 * q4; const float* sc = mod_vec(C, layer, ci, 4) + 8 * q4; const float* sh = mod_vec(C, layer, ci, 3) + 8 * q4;
        float ss = 0.f;
#pragma unroll 8
        for (int kk = 0; kk < 32; ++kk) { pg8::f32x4 a, b; pg8::unpack8f(*(const pg8::u32x4*)(xr + 32 * kk), a, b); ss += (a.x * a.x + a.y * a.y) + (a.z * a.z + a.w * a.w) + (b.x * b.x + b.y * b.y) + (b.z * b.z + b.w * b.w); }
        ss += __shfl_xor(ss, 16); ss += __shfl_xor(ss, 32);
        const float rstd = rsqrtf(ss * (1.f / D) + EPS);
        f32x4 acc[3]; acc[0] = (f32x4){0.f, 0.f, 0.f, 0.f}; acc[1] = acc[0]; acc[2] = acc[0];
        bf16* frow = F + (size_t)row * D + 8 * q4;
#pragma unroll 2
        for (int kk = 0; kk < 32; ++kk) {
            const int c = 32 * kk;
            pg8::f32x4 x0, x1; pg8::unpack8f(*(const pg8::u32x4*)(xr + c), x0, x1);
            f32x4 f0 = x0 * rstd * *(const f32x4*)(gg + c) * (*(const f32x4*)(sc + c) + 1.f) + *(const f32x4*)(sh + c);
            f32x4 f1 = x1 * rstd * *(const f32x4*)(gg + c + 4) * (*(const f32x4*)(sc + c + 4) + 1.f) + *(const f32x4*)(sh + c + 4);
            const pg8::u32x4 fh = pg8::pack8(f0, f1); *(pg8::u32x4*)(frow + c) = fh;
            pg8::f32x4 r0, r1; pg8::unpack8f(fh, r0, r1);
            const pg8::u32x4 fl = pg8::pack8(f0 - r0, f1 - r1);
            const bf16x8 ah = __builtin_bit_cast(bf16x8, fh), al = __builtin_bit_cast(bf16x8, fl);
#pragma unroll
            for (int jb = 0; jb < 3; ++jb) { const bf16x8 wh = WR[((kk * 3 + jb) * 2) * 64], wl = WR[((kk * 3 + jb) * 2 + 1) * 64];
                acc[jb] = __builtin_amdgcn_mfma_f32_16x16x32_bf16(wh, ah, acc[jb], 0, 0, 0);
                acc[jb] = __builtin_amdgcn_mfma_f32_16x16x32_bf16(wh, al, acc[jb], 0, 0, 0);
                acc[jb] = __builtin_amdgcn_mfma_f32_16x16x32_bf16(wl, ah, acc[jb], 0, 0, 0); }
        }
        const float* brt = P.in[I_BRT] + layer * 32 + q4 * 8;
        float e[8];
#pragma unroll
        for (int r = 0; r < 4; ++r) { e[r] = acc[0][r] + brt[r]; e[4 + r] = acc[1][r] + brt[4 + r]; }
        const float gl = acc[2][0] + P.in[I_BGRP][layer * 4 + q4];
        float gm = gl; int gi = q4;
#pragma unroll
        for (int st = 16; st <= 32; st <<= 1) { const float og = __shfl_xor(gm, st); const int oi = __shfl_xor(gi, st); if (og > gm || (og == gm && oi < gi)) { gm = og; gi = oi; } }
        float den = __expf(gl - gm); den += __shfl_xor(den, 16); den += __shfl_xor(den, 32);
        if (q4 == gi) {
            const float gw_ = 1.f / den;
            int i0 = 0; float v0 = e[0];
#pragma unroll
            for (int i = 1; i < 8; ++i) if (e[i] > v0) { v0 = e[i]; i0 = i; }
            int i1 = -1; float v1 = -INFINITY;
#pragma unroll
            for (int i = 0; i < 8; ++i) if (i != i0 && e[i] > v1) { v1 = e[i]; i1 = i; }
            const float e1 = __expf(v1 - v0), w0 = gw_ / (1.f + e1), w1 = gw_ * e1 / (1.f + e1);
            const int ea = gi * 8 + i0, eb = gi * 8 + i1;
            const unsigned pa = __hip_atomic_fetch_add(cnt + ea, 1u, __ATOMIC_RELAXED, __HIP_MEMORY_SCOPE_AGENT);
            const unsigned pb = __hip_atomic_fetch_add(cnt + eb, 1u, __ATOMIC_RELAXED, __HIP_MEMORY_SCOPE_AGENT);
            asg_e[2 * row] = ea; asg_e[2 * row + 1] = eb; asg_p[2 * row] = (int)pa; asg_p[2 * row + 1] = (int)pb; asg_w[2 * row] = w0; asg_w[2 * row + 1] = w1;
            list[(size_t)ea * LCAP + pa] = row; list[(size_t)eb * LCAP + pb] = row;
        }
    }
}

__device__ __forceinline__ int wave_pstart(const Ctx& C, int layer) {
    const unsigned* cnt = (const unsigned*)(C.ws + WS_CTL) + CW_CNT + 64 * layer;
    const int mc = C.lane < 32 ? (int)__hip_atomic_load(cnt + (C.lane & 31), __ATOMIC_RELAXED, __HIP_MEMORY_SCOPE_AGENT) : 0; const int mp = (mc + 255) & ~255; int in = mp;
#pragma unroll
    for (int o = 1; o < 32; o <<= 1) { const int t = __shfl_up(in, o); if ((C.lane & 31) >= o) in += t; }
    return in - mp;
}
__device__ __forceinline__ void moe_combine(const Ctx& C, int layer, int r, int ps, f32x4 (&v)[4]) {
    const bf16* Y2 = (const bf16*)(C.ws + WS_XS); const int* asg_s = (const int*)(C.ws + WS_ROUTE + RT_S); const float* asg_w = (const float*)(C.ws + WS_ROUTE + RT_W);
    const bf16* XC = (const bf16*)(C.ws + WS_XC);
#pragma unroll
    for (int j = 0; j < 4; ++j) { const v2u xx = *(const v2u*)(XC + (size_t)r * D + 4 * C.lane + 256 * j); v[j] = (f32x4){bf2f(xx.x & 0xffffu), bf2f(xx.x >> 16), bf2f(xx.y & 0xffffu), bf2f(xx.y >> 16)}; }
    const int* asg_e = (const int*)(C.ws + WS_ROUTE + RT_E); const int* asg_p = (const int*)(C.ws + WS_ROUTE + RT_P); (void)asg_s;
    const int s0 = __shfl(ps, asg_e[2 * r]) + asg_p[2 * r], s1 = __shfl(ps, asg_e[2 * r + 1]) + asg_p[2 * r + 1]; const float w0 = asg_w[2 * r], w1 = asg_w[2 * r + 1];
    const float* gate = mod_vec(C, layer, cond_of(r), 5);
#pragma unroll
    for (int j = 0; j < 4; ++j) { const int c = 4 * C.lane + 256 * j; const v2u a = *(const v2u*)(Y2 + (size_t)s0 * D + c), b = *(const v2u*)(Y2 + (size_t)s1 * D + c); const f32x4 g = *(const f32x4*)(gate + c);
        v[j].x += g.x * (w0 * bf2f(a.x & 0xffffu) + w1 * bf2f(b.x & 0xffffu)); v[j].y += g.y * (w0 * bf2f(a.x >> 16) + w1 * bf2f(b.x >> 16));
        v[j].z += g.z * (w0 * bf2f(a.y & 0xffffu) + w1 * bf2f(b.y & 0xffffu)); v[j].w += g.w * (w0 * bf2f(a.y >> 16) + w1 * bf2f(b.y >> 16)); }
}
__device__ __forceinline__ void phase_combine_norm_mix1(const Ctx& C) {
    const Params& P = *C.p; bf16* XC = (bf16*)(C.ws + WS_XC); bf16* H = (bf16*)(C.ws + WS_H);
    const int ps = wave_pstart(C, 0);
    for (int r = C.gw; r < TT; r += C.ngw) {
        f32x4 v[4]; moe_combine(C, 0, r, ps, v);
        store_row16_bf16(XC + (size_t)r * D, C.lane, v);
        const float rstd = row_rstd(v); const int ci = cond_of(r);
        modulate16(v, rstd, P.in[I_GMIX] + D, mod_vec(C, 1, ci, 1), mod_vec(C, 1, ci, 0), C.lane);
        store_row16_bf16(H + (size_t)r * D, C.lane, v);
    }
    LAS float* scr = (LAS float*)(C.lds + C.wave * 16384);
    for (int it = C.gw; it < MOE_ITEMS; it += C.ngw) moe_convert_item(C, 1, it, scr);
}
__device__ __forceinline__ void phase_final(const Ctx& C) {
    const Params& P = *C.p;
    const int ps = wave_pstart(C, 1);
    for (int r = C.gw; r < TL; r += C.ngw) {
        f32x4 v[4]; moe_combine(C, 1, r, ps, v);
        const float rstd = row_rstd(v);
#pragma unroll
        for (int j = 0; j < 4; ++j) { const int c = 4 * C.lane + 256 * j; const f32x4 g = *(const f32x4*)(P.in[I_FING] + c); *(f32x4*)(P.out + (size_t)r * D + c) = v[j] * rstd * g; }
    }
}

__device__ __forceinline__ void phase_s5_fast(const Ctx& C) {
    typedef short bf16x8 __attribute__((ext_vector_type(8)));
    typedef float f32x16 __attribute__((ext_vector_type(16)));
    const Params& P = *C.p; const bf16* U = (const bf16*)(C.ws + WS_U); bf16* GS = (bf16*)(C.ws + WS_GS); float* YA = (float*)(C.ws + WS_YACC);
    const float2* lamb = (const float2*)(C.ws + WS_TAB + TAB_LAMB); const float2* bbar = (const float2*)(C.ws + WS_TAB + TAB_BBAR);
    constexpr int HP = 272;
    const int lane = C.lane, w = C.wave, il = w >> 2, dir = (w >> 1) & 1, nh = w & 1;
    const int l31 = lane & 31, hi = lane >> 5, l15 = lane & 15, q4 = lane >> 4;
    LAS unsigned char* Hb = C.lds + (il * 2 + dir) * (2 * 32 * HP);
    const int srow = (l31 & 3) + 4 * (l31 >> 3) + 16 * ((l31 >> 2) & 1);
    for (int it0 = blockIdx.x; it0 < NB * 16; it0 += gridDim.x) {
        const int item = it0 * 2 + il, b = item >> 5, g = item & 31;
        const int dg = dir * 32 + g, n = nh * 32 + l31;
        const float2 lam = lamb[dg * 64 + n];
        float lpr[16], lpi[16]; { float pr = lam.x, pi = lam.y;
#pragma unroll
            for (int r = 0; r < 16; ++r) { lpr[r] = pr; lpi[r] = pi; const float nr = pr * lam.x - pi * lam.y, ni = pr * lam.y + pi * lam.x; pr = nr; pi = ni; } }
        bf16x8 bre, bim; { const float2* bp = bbar + ((size_t)(dg * 64 + n)) * 16 + 8 * hi;
#pragma unroll
            for (int e = 0; e < 8; ++e) { const float2 v = bp[e]; bre[e] = (short)f2bf(v.x); bim[e] = (short)f2bf(v.y); } }
        bf16x8 cf[4]; { const float* cre = P.in[I_CRE] + ((size_t)dg * 16 + l15) * 64; const float* cim = P.in[I_CIM] + ((size_t)dg * 16 + l15) * 64;
#pragma unroll
            for (int ks = 0; ks < 4; ++ks) { const f32x4 a = *(const f32x4*)(cre + 16 * ks + 4 * q4), m = *(const f32x4*)(cim + 16 * ks + 4 * q4);
                cf[ks][0] = (short)f2bf(a.x); cf[ks][1] = (short)f2bf(-m.x); cf[ks][2] = (short)f2bf(a.y); cf[ks][3] = (short)f2bf(-m.y);
                cf[ks][4] = (short)f2bf(a.z); cf[ks][5] = (short)f2bf(-m.z); cf[ks][6] = (short)f2bf(a.w); cf[ks][7] = (short)f2bf(-m.w); } }
        const f32x4 dsk = *(const f32x4*)(P.in[I_S5D] + g * 16 + 4 * q4);
        float cr = 0.f, ci = 0.f;
#define S5_UROW(kk) ({ const int S_ = 32 * (kk) + srow; (S_ < CTXL) ? ((size_t)TL + (size_t)b * CTXL + (dir == 0 ? S_ : CTXL - 1 - S_)) : ((size_t)b * SEQ + (dir == 0 ? S_ - CTXL : SEQ - 1 - (S_ - CTXL))); })
        bf16x8 ua_next = *(const bf16x8*)(U + S5_UROW(0) * 512 + g * 16 + 8 * hi);
        for (int k = 0; k < 72; ++k) {
            const bf16x8 ua = ua_next;
            if (k + 1 < 72) ua_next = *(const bf16x8*)(U + S5_UROW(k + 1) * 512 + g * 16 + 8 * hi);
            const int sl = 32 * (k - 8) + 16 * nh + l15;
            const int tok = dir == 0 ? sl : SEQ - 1 - sl; const int lt = tok >> 5;
            const size_t o = ((size_t)b * SEQ + (k >= 8 ? tok : 0)) * 512 + g * 16 + 4 * q4;
            const bool first = dir == 0 ? (lt < 32) : (lt >= 32);
            f32x4 pk = {0.f, 0.f, 0.f, 0.f}; v2u uu = {0u, 0u};
            if (k >= 8 && !first) {
                pk.x = __hip_atomic_load(YA + o, __ATOMIC_RELAXED, __HIP_MEMORY_SCOPE_AGENT); pk.y = __hip_atomic_load(YA + o + 1, __ATOMIC_RELAXED, __HIP_MEMORY_SCOPE_AGENT);
                pk.z = __hip_atomic_load(YA + o + 2, __ATOMIC_RELAXED, __HIP_MEMORY_SCOPE_AGENT); pk.w = __hip_atomic_load(YA + o + 3, __ATOMIC_RELAXED, __HIP_MEMORY_SCOPE_AGENT);
                uu = *(const v2u*)(U + o);
            }
            {
              f32x16 br = {}, bi = {};
              br = __builtin_amdgcn_mfma_f32_32x32x16_bf16(ua, bre, br, 0, 0, 0);
              bi = __builtin_amdgcn_mfma_f32_32x32x16_bf16(ua, bim, bi, 0, 0, 0);
              float sr = hi ? 0.f : cr, si = hi ? 0.f : ci;
#pragma unroll
              for (int r = 0; r < 16; ++r) { const float nr = lam.x * sr - lam.y * si + br[r], ni = lam.x * si + lam.y * sr + bi[r]; sr = nr; si = ni; br[r] = sr; bi[r] = si; }
              float er = __shfl_xor(sr, 32), ei = __shfl_xor(si, 32); if (!hi) { er = 0.f; ei = 0.f; }
              { const f32x2 er2 = {er, er}, ei2 = {ei, ei};
#pragma unroll
              for (int r = 0; r < 16; r += 2) { const f32x2 pr2 = {lpr[r], lpr[r + 1]}, pi2 = {lpi[r], lpi[r + 1]}; f32x2 b2 = {br[r], br[r + 1]}, i2 = {bi[r], bi[r + 1]};
                  b2 = b2 + pr2 * er2 - pi2 * ei2; i2 = i2 + pr2 * ei2 + pi2 * er2; br[r] = b2.x; br[r + 1] = b2.y; bi[r] = i2.x; bi[r + 1] = i2.y; } }
              cr = __shfl_xor(br[15], 32); ci = __shfl_xor(bi[15], 32);
              LAS unsigned char* hb = Hb + (k & 1) * (32 * HP) + (16 * hi) * HP + 4 * n;
#pragma unroll
              for (int r = 0; r < 16; ++r) *(LAS unsigned*)(hb + r * HP) = pk2(br[r], bi[r]);
            }
            asm volatile("s_waitcnt lgkmcnt(0)\n\ts_barrier" ::: "memory");
            if (k >= 8) {
                const LAS unsigned char* hr = Hb + (k & 1) * (32 * HP) + (16 * nh + l15) * HP + 16 * q4;
                f32x4 y = {0.f, 0.f, 0.f, 0.f};
#pragma unroll
                for (int ks = 0; ks < 4; ++ks) { const bf16x8 hf = *(const LAS bf16x8*)(hr + 64 * ks); y = __builtin_amdgcn_mfma_f32_16x16x32_bf16(cf[ks], hf, y, 0, 0, 0); }
                if (first) { *(f32x4*)(YA + o) = y; }
                else {
                    const f32x4 uf = {bf2f(uu.x & 0xffffu), bf2f(uu.x >> 16), bf2f(uu.y & 0xffffu), bf2f(uu.y >> 16)};
                    const f32x4 t = y + pk + dsk * uf;
                    v2u ov; ov.x = pk2(gelu_tanh(t.x), gelu_tanh(t.y)); ov.y = pk2(gelu_tanh(t.z), gelu_tanh(t.w)); *(v2u*)(GS + o) = ov;
                }
            }
            if (k == 39) asm volatile("s_waitcnt vmcnt(0)\n\ts_barrier" ::: "memory");
        }
#undef S5_UROW
        asm volatile("s_waitcnt vmcnt(0) lgkmcnt(0)\n\ts_barrier" ::: "memory");
    }
}

__global__ void __launch_bounds__(NTHR, 2) fwd_kernel(Params prm) {
    extern __shared__ __attribute__((aligned(16))) unsigned char lds_raw[];
    Ctx C; C.p = &prm; C.ws = prm.ws; C.lds = (LAS unsigned char*)lds_raw;
    C.tid = threadIdx.x; C.lane = C.tid & 63; C.wave = __builtin_amdgcn_readfirstlane(C.tid >> 6);
    C.gw = blockIdx.x * NWAVE + C.wave; C.ngw = gridDim.x * NWAVE;
    constexpr int LDS_MISC = 147456 - 512;
    volatile LAS unsigned* misc = (volatile LAS unsigned*)(C.lds + LDS_MISC);
    if (C.tid < 64) misc[C.tid] = 0u;
    __syncthreads();
    unsigned* ctl = (unsigned*)(C.ws + WS_CTL);
    XcdBarrier bar; bar.bar = ctl + CW_BAR; bar.x = 0; bar.st = nullptr;
#if MK_ONE_LAUNCH
    bar = xcd_barrier_post(ctl + CW_BAR, misc + 8);
#define SEAM(k) do { if (lo <= (k) && (k) + 1 < hi) xcd_barrier(bar); } while (0)
#else
#define SEAM(k) do { } while (0)
#endif
    const int lo = prm.ph_lo, hi = prm.ph_hi;
#define IN(k) (lo <= (k) && (k) < hi)
#if MK_PROBE
    volatile LAS unsigned long long* ts_ = (volatile LAS unsigned long long*)(C.lds + LDS_MISC + 64);
#define STAMP(k) do { if (blockIdx.x == 0 && C.tid == 0) ts_[(k) + 1] = __builtin_amdgcn_s_memrealtime(); } while (0)
    if (blockIdx.x == 0 && C.tid == 0) ts_[0] = __builtin_amdgcn_s_memrealtime();
#else
#define STAMP(k) do { } while (0)
#endif
    const Params& P = prm;
    bf16* Hb = (bf16*)(C.ws + WS_H); bf16* XC = (bf16*)(C.ws + WS_XC);
#define MOE_MAP(layer) do { LAS int* tm_ = (LAS int*)(C.lds + 131072); LAS int* cl_ = tm_ + 320; \
        if (C.wave == 0) { const unsigned* cnt_ = (const unsigned*)(C.ws + WS_CTL) + CW_CNT + 64 * (layer); const int mc_ = C.lane < 32 ? (int)__hip_atomic_load(cnt_ + (C.lane & 31), __ATOMIC_RELAXED, __HIP_MEMORY_SCOPE_AGENT) : 0; const int mp_ = (mc_ + 255) & ~255; int in_ = mp_; \
            _Pragma("unroll") for (int o_ = 1; o_ < 32; o_ <<= 1) { const int t_ = __shfl_up(in_, o_); if ((C.lane & 31) >= o_) in_ += t_; } const int ps_ = in_ - mp_; \
            if (C.lane < 32) { for (int t_ = ps_ / 256; t_ < (ps_ + mp_) / 256; ++t_) tm_[t_] = C.lane | ((t_ * 256 - ps_) << 8); cl_[C.lane] = mc_; if (C.lane == 31) cl_[32] = (ps_ + mp_) / 256; } } \
        __syncthreads(); } while (0)
#define MOE_GEMM1(layer) do { MOE_MAP(layer); const LAS int* tm_ = (const LAS int*)(C.lds + 131072); const int ntl_ = __builtin_amdgcn_readfirstlane(tm_[320 + 32]); pg8::Gemm g{Hb, (const bf16*)(C.ws + WS_W13), 0, 1024, D}; \
        pg8::GroupedOrder<true> S{tm_, tm_ + 320, (const int*)(C.ws + WS_LIST), ntl_ * 4, 4, (int)gridDim.x, (int)blockIdx.x, LCAP, D * 2, (size_t)1024 * 1024 * 2}; pg8::EpiSwiglu E{(bf16*)(C.ws + WS_G13)}; \
        pg8::gemm_phase<pg8::EpiSwiglu, pg8::GroupedOrder<true>, true, true>(C.lds, g, S, E); } while (0)
#define MOE_GEMM2(layer) do { MOE_MAP(layer); const LAS int* tm_ = (const LAS int*)(C.lds + 131072); const int ntl_ = __builtin_amdgcn_readfirstlane(tm_[320 + 32]); pg8::Gemm g{(const bf16*)(C.ws + WS_G13), (const bf16*)(C.ws + WS_W2), 0, 1024, EH}; \
        pg8::GroupedOrder<false> S{tm_, tm_ + 320, (const int*)(C.ws + WS_LIST), ntl_ * 4, 4, (int)gridDim.x, (int)blockIdx.x, LCAP, EH * 2, (size_t)1024 * 512 * 2}; pg8::EpiStore E{(bf16*)(C.ws + WS_XS), D}; \
        pg8::gemm_phase<pg8::EpiStore, pg8::GroupedOrder<false>, true, true>(C.lds, g, S, E); } while (0)
    if (IN(0)) { phase_prologue(C); SEAM(0); STAMP(0); }
    if (IN(1)) { phase_norm_mix0(C); SEAM(1); STAMP(1); }
    if (IN(2)) { pg8::Gemm g{Hb, (const bf16*)(C.ws + WS_WIN0), TT, MIXW, D}; pg8::StaticOrder S; S.init(TT, MIXW, gridDim.x, blockIdx.x); pg8::EpiStore E{(bf16*)(C.ws + WS_P), MIXW};
        pg8::gemm_phase<pg8::EpiStore, pg8::StaticOrder, true, true, true>(C.lds, g, S, E); SEAM(2); STAMP(2); }
    if (IN(3)) { phase_qkprep(C); SEAM(3); STAMP(3); }
    if (IN(4)) { phase_gmlp_fast(C); phase_attn_fast(C, (char*)lds_raw); SEAM(4); STAMP(4); }
    if (IN(5)) { pg8::Gemm g{Hb, (const bf16*)(C.ws + WS_WOUT0), TT, D, D}; pg8::StaticOrder S; S.init(TT, D, gridDim.x, blockIdx.x); pg8::EpiResid E{P.in[I_X], P.in[I_CTX], (const float*)(C.ws + WS_MOD), XC, 0};
        pg8::gemm_phase<pg8::EpiResid, pg8::StaticOrder, true, true, true>(C.lds, g, S, E); SEAM(5); STAMP(5); }
    if (IN(6)) { phase_router_fast(C, 0, TT); SEAM(6); STAMP(6); }
    if (IN(8)) { MOE_GEMM1(0); SEAM(8); STAMP(8); }
    if (IN(9)) { MOE_GEMM2(0); SEAM(9); STAMP(9); }
    if (IN(10)) { phase_combine_norm_mix1(C); SEAM(10); STAMP(10); }
    if (IN(11)) { pg8::Gemm g{Hb, (const bf16*)(C.ws + WS_WS5IN), TT, 512, D}; pg8::StaticOrder S; S.init(TT, 512, gridDim.x, blockIdx.x); pg8::EpiStore E{(bf16*)(C.ws + WS_U), 512};
        pg8::gemm_phase<pg8::EpiStore, pg8::StaticOrder, true, true, true>(C.lds, g, S, E); SEAM(11); STAMP(11); }
    if (IN(12)) { phase_s5_fast(C); SEAM(12); STAMP(12); }
    if (IN(13)) { pg8::Gemm g{(const bf16*)(C.ws + WS_GS), (const bf16*)(C.ws + WS_WGLU), TL, 512, 512}; pg8::StaticOrder S; S.init(TL, 512, gridDim.x, blockIdx.x); pg8::EpiGlu E{(const bf16*)(C.ws + WS_GS), P.in[I_BGLU], (bf16*)(C.ws + WS_GG)};
        pg8::gemm_phase<pg8::EpiGlu, pg8::StaticOrder, true, true, true>(C.lds, g, S, E); SEAM(13); STAMP(13); }
    if (IN(14)) { pg8::Gemm g{(const bf16*)(C.ws + WS_GG), (const bf16*)(C.ws + WS_WS5OUT), TL, D, 512}; pg8::StaticOrder S; S.init(TL, D, gridDim.x, blockIdx.x); pg8::EpiResid E{P.in[I_X], P.in[I_CTX], (const float*)(C.ws + WS_MOD) + (size_t)17 * 6 * D, XC, 1};
        pg8::gemm_phase<pg8::EpiResid, pg8::StaticOrder, true, true, true>(C.lds, g, S, E); SEAM(14); STAMP(14); }
    if (IN(15)) { phase_router_fast(C, 1, TL); SEAM(15); STAMP(15); }
    if (IN(17)) { MOE_GEMM1(1); SEAM(17); STAMP(17); }
    if (IN(18)) { MOE_GEMM2(1); SEAM(18); STAMP(18); }
    if (IN(19)) { phase_final(C); STAMP(19); }
#if MK_PROBE
    if (blockIdx.x == 0 && C.tid == 0) {
        ts_[8] = ts_[7]; ts_[17] = ts_[16];
        const unsigned long long tA = ts_[PROBE_A_HI + 1] - ts_[PROBE_A_LO], tB = ts_[PROBE_B_HI + 1] - ts_[PROBE_B_LO];
        const unsigned long long spin = 16ull * tA + 1000000ull * ((tB + 500ull) / 1000ull);
        const unsigned long long t0 = __builtin_amdgcn_s_memrealtime();
        while (__builtin_amdgcn_s_memrealtime() - t0 < spin) __builtin_amdgcn_s_sleep(8);
    }
#endif
#undef IN
#undef SEAM
}

extern "C" void kernel_launch(void* const* d_in, const int* in_sizes, int n_in, void* d_out, int out_size, void* d_ws, size_t ws_size, hipStream_t stream) {
    constexpr int LDS_BYTES = 147456;
    static int grid = 0;
    if (grid == 0) {
        if (n_in != 35 || out_size != TL * D || ws_size < WS_END) { fprintf(stderr, "kernel_launch: unexpected shapes (n_in %d out %d ws %zu)\n", n_in, out_size, ws_size); grid = -1; return; }
        int dev = 0, cus = 0;
        if (hipGetDevice(&dev) != hipSuccess || hipDeviceGetAttribute(&cus, hipDeviceAttributeMultiprocessorCount, dev) != hipSuccess) { grid = -1; return; }
        if (hipFuncSetAttribute((const void*)fwd_kernel, hipFuncAttributeMaxDynamicSharedMemorySize, LDS_BYTES) != hipSuccess) { fprintf(stderr, "kernel_launch: hipFuncSetAttribute failed\n"); grid = -1; return; }
        (void)hipGetLastError();
        grid = cus;
    }
    if (grid < 0) return;
    (void)hipMemsetAsync((char*)d_ws + WS_CTL, 0, CTL_BYTES, stream);
    Params p{};
    for (int i = 0; i < 35; ++i) p.in[i] = (const float*)d_in[i];
    p.out = (float*)d_out; p.ws = (unsigned char*)d_ws;
#if MK_ONE_LAUNCH
    p.ph_lo = 0; p.ph_hi = NPHASE;
    hipLaunchKernelGGL(fwd_kernel, dim3(grid), dim3(NTHR), LDS_BYTES, stream, p);
#else
    for (int k = 0; k < NPHASE; ++k) { p.ph_lo = k; p.ph_hi = k + 1; hipLaunchKernelGGL(fwd_kernel, dim3(grid), dim3(NTHR), LDS_BYTES, stream, p); }
#endif
}
```

```cpp
#include <hip/hip_runtime.h>
#include <cstdio>
#include <cstdint>

#ifndef MK_ONE_LAUNCH
#define MK_ONE_LAUNCH 1
#endif
#ifndef MK_SIMPLE_ORDER
#define MK_SIMPLE_ORDER 0
#endif
#ifndef MK_KROT
#define MK_KROT 0
#endif
#ifndef MK_PROBE
#define MK_PROBE 0
#endif
#define PROBE_A_LO 4
#define PROBE_A_HI 4
#define PROBE_B_LO 8
#define PROBE_B_HI 9

constexpr int D = 1024, NB = 16, SEQ = 2048, CTXL = 256;
constexpr int TL = NB * SEQ, TC = NB * CTXL, TT = TL + TC;
constexpr int KVL = CTXL + SEQ;
constexpr int MIXW = 1792, NEXP = 32, EH = 512;
constexpr int NSLOT = 81920;
constexpr float EPS = 1e-6f;
constexpr float QSCALE = 0.125f * 1.4426950408889634f;
constexpr int NTHR = 512, NWAVE = 8;
constexpr int NPHASE = 20;

constexpr size_t MiB = 1u << 20;
constexpr size_t WS_CTL = 0, CTL_BYTES = 1 * MiB;
constexpr size_t WS_MOD = 1 * MiB;
constexpr size_t WS_TAB = 2 * MiB;
constexpr size_t TAB_ROPE = 0, TAB_LAMB = 16384, TAB_BBAR = 65536, TAB_WR = 640 * 1024;
constexpr size_t WS_ROUTE = 3 * MiB;
constexpr size_t RT_E = 0, RT_P = 320 * 1024, RT_W = 640 * 1024, RT_S = 960 * 1024, RT_TILE = 1280 * 1024, RT_NT = 1280 * 1024 + 4096;
constexpr size_t WS_WIN0 = 6 * MiB, WS_WOUT0 = 10 * MiB, WS_WS5IN = 12 * MiB, WS_WGLU = 13 * MiB, WS_WS5OUT = 14 * MiB;
constexpr size_t WS_WSP = 15 * MiB;
constexpr size_t WS_W13 = 16 * MiB, WS_W2 = 80 * MiB;
constexpr size_t WS_XC = 112 * MiB;
constexpr size_t WS_H = 256 * MiB;
constexpr size_t WS_P = 328 * MiB;
constexpr size_t WS_Q = 454 * MiB, WS_K = 490 * MiB, WS_V = 499 * MiB;
constexpr size_t WS_XS = 328 * MiB;
constexpr size_t WS_G13 = 488 * MiB;
constexpr size_t WS_U = 328 * MiB, WS_GS = 364 * MiB, WS_GG = 396 * MiB, WS_YACC = 428 * MiB;
constexpr size_t WS_LIST = 568 * MiB;
constexpr int LCAP = 36864;
constexpr size_t WS_END = 574 * MiB;
constexpr int CW_CNT = 64;
constexpr int CW_BAR = 4096;

#define LAS __attribute__((address_space(3)))
typedef unsigned short bf16;
typedef unsigned v4u __attribute__((ext_vector_type(4)));
typedef unsigned v2u __attribute__((ext_vector_type(2)));
typedef float f32x4 __attribute__((ext_vector_type(4)));
typedef float f32x2 __attribute__((ext_vector_type(2)));
__device__ __forceinline__ float bf2f(unsigned u) { return __uint_as_float(u << 16); }
__device__ __forceinline__ unsigned pk2(float lo, float hi) { unsigned r; asm("v_cvt_pk_bf16_f32 %0, %1, %2" : "=v"(r) : "v"(lo), "v"(hi)); return r; }
__device__ __forceinline__ unsigned f2bf(float f) { return pk2(f, 0.f) & 0xffffu; }
__device__ __forceinline__ float wave_sum(float v) {
#pragma unroll
    for (int o = 1; o < 64; o <<= 1) v += __shfl_xor(v, o);
    return v;
}
__device__ __forceinline__ float wave_max(float v) {
#pragma unroll
    for (int o = 1; o < 64; o <<= 1) v = fmaxf(v, __shfl_xor(v, o));
    return v;
}
__device__ __forceinline__ float gelu_tanh(float x) { const float u2 = -1.5957691216057308f * (x + 0.044715f * x * x * x); return x * __builtin_amdgcn_rcpf(1.f + __expf(u2)); }
__device__ __forceinline__ float sigmoidf_(float x) { return 1.f / (1.f + __expf(-x)); }
__device__ __forceinline__ float silu_(float x) { return x / (1.f + __expf(-x)); }
__device__ __forceinline__ void unpack8(const v4u w, float* f) {
    f[0] = bf2f(w.x & 0xffffu); f[1] = bf2f(w.x >> 16); f[2] = bf2f(w.y & 0xffffu); f[3] = bf2f(w.y >> 16);
    f[4] = bf2f(w.z & 0xffffu); f[5] = bf2f(w.z >> 16); f[6] = bf2f(w.w & 0xffffu); f[7] = bf2f(w.w >> 16);
}

#define XB_TMO      128
#define XB_XCNT(j)  (256  + 64 * (j))
#define XB_XSUB(j)  (1280 + 64 * (j))
#define XB_XGEN(j)  (2304 + 64 * (j))
#define XB_TOP      3328
#define XB_TOPGEN   3392
#define XCD_BAR_WORDS 3456
#define XB_SPIN_CAP (1u << 28)
__device__ __forceinline__ unsigned xb_ld(unsigned* p)              { return __hip_atomic_load(p, __ATOMIC_RELAXED, __HIP_MEMORY_SCOPE_AGENT); }
__device__ __forceinline__ unsigned xb_add(unsigned* p, unsigned v) { return __hip_atomic_fetch_add(p, v, __ATOMIC_RELAXED, __HIP_MEMORY_SCOPE_AGENT); }
__device__ __forceinline__ unsigned xb_xcc_id() { return (unsigned)__builtin_amdgcn_s_getreg((3 << 11) | 20) & 0xFu; }
#define XB_SPIN(cond, bar) do { unsigned _sp = 0; while (cond) { __builtin_amdgcn_s_sleep(1); \
    if ((++_sp & 255u) == 0u) { if (xb_ld(&(bar)[XB_TMO])) break; if (_sp > XB_SPIN_CAP) { atomicAdd(&(bar)[XB_TMO], 1u); break; } } } } while (0)
struct XcdBarrier { unsigned* bar; unsigned x; volatile LAS unsigned* st; };
__device__ __forceinline__ XcdBarrier xcd_barrier_post(unsigned* bar, volatile LAS unsigned* st) {
    XcdBarrier b; b.bar = bar; b.x = xb_xcc_id(); b.st = st;
    if (threadIdx.x == 0) (void)xb_add(&bar[XB_XCNT(b.x)], 1u);
    return b;
}
__device__ __forceinline__ void xcd_barrier_complete(unsigned* bar, unsigned x, unsigned& nloc, unsigned& nx) {
    const unsigned G = gridDim.x * gridDim.y * gridDim.z;
    unsigned sum, cnt, mine, sp = 0u;
    for (;;) {
        sum = 0u; cnt = 0u; mine = 0u;
#pragma unroll
        for (unsigned j = 0; j < 16; ++j) { const unsigned c = xb_ld(&bar[XB_XCNT(j)]); sum += c; cnt += (c > 0u) ? 1u : 0u; mine = (j == x) ? c : mine; }
        if (sum == G) break;
        __builtin_amdgcn_s_sleep(1);
        if ((++sp & 255u) == 0u) { if (xb_ld(&bar[XB_TMO])) break; if (sp > XB_SPIN_CAP) { atomicAdd(&bar[XB_TMO], 1u); break; } }
    }
    nloc = mine > 0u ? mine : 1u; nx = cnt > 0u ? cnt : 1u;
}
__device__ __forceinline__ void xcd_barrier(const XcdBarrier& b) {
    asm volatile("s_waitcnt vmcnt(0)" ::: "memory");
    __syncthreads();
    if (threadIdx.x == 0) {
        unsigned* bar = b.bar;
        __builtin_amdgcn_s_waitcnt(0);
        unsigned nloc = b.st[0], nx = b.st[1];
        if (nloc == 0u) { xcd_barrier_complete(bar, b.x, nloc, nx); b.st[0] = nloc; b.st[1] = nx; }
        const unsigned old = xb_add(&bar[XB_XSUB(b.x)], 1u);
        const unsigned gen = old / nloc;
        if (old + 1u == (gen + 1u) * nloc) {
            __builtin_amdgcn_fence(__ATOMIC_RELEASE, "agent");
            asm volatile("s_waitcnt vmcnt(0)" ::: "memory");
            const unsigned og = xb_add(&bar[XB_TOP], 1u);
            const unsigned tg = og / nx;
            if (og + 1u == (tg + 1u) * nx) xb_add(&bar[XB_TOPGEN], 1u);
            else XB_SPIN(xb_ld(&bar[XB_TOPGEN]) == tg, bar);
            __builtin_amdgcn_fence(__ATOMIC_ACQUIRE, "agent");
            xb_add(&bar[XB_XGEN(b.x)], 1u);
            asm volatile("s_waitcnt vmcnt(0)" ::: "memory");
        } else {
            XB_SPIN(xb_ld(&bar[XB_XGEN(b.x)]) == gen, bar);
            __builtin_amdgcn_fence(__ATOMIC_ACQUIRE, "agent");
            asm volatile("s_waitcnt vmcnt(0)" ::: "memory");
        }
    }
    __syncthreads();
}

namespace pg8 {
#define PG8_LAS __attribute__((address_space(3)))
typedef unsigned short bf16_t;
typedef short bf16x8 __attribute__((ext_vector_type(8)));
typedef float f32x4 __attribute__((ext_vector_type(4)));
typedef unsigned u32x4 __attribute__((ext_vector_type(4)));
constexpr int BM = 256, BK = 64, HALF = 128, HTB = HALF * BK * 2  , STAGE_BYTES = 8 * HTB, NXCD = 8, WGM = 8;

__host__ __device__ __forceinline__ int lds_byte(int r, int c) { const int st = (r >> 4) * 2 + (c >> 5), rr = r & 15, cc = c & 31, ob = rr * 64 + cc * 2; return st * 1024 + (ob ^ (((ob >> 9) & 1) << 5)); }
__host__ __device__ __forceinline__ void stage_rc(int b, int& R, int& C) { const int st = b / 1024, sb = b % 1024, swz = sb ^ (((sb >> 9) & 1) << 5); R = (st >> 1) * 16 + swz / 64; C = (st & 1) * 32 + (swz % 64) / 2; }
__host__ __device__ __forceinline__ int perm32(int rho) { const int n = rho >> 4, i = rho & 15; return 8 * (i >> 2) + 4 * n + (i & 3); }

struct Unit { int pm, pn; size_t bo; int aux; };
struct Gemm { const bf16_t* A; const bf16_t* Bt; int M, N, K; };

struct StaticOrder {
    static constexpr bool GATHER = false;
    int nM, nN, nwg, G, c;
    __host__ __device__ void init(int M, int N, int G_, int c_) { nM = M / BM; nN = N / BM; nwg = nM * nN; G = G_; c = c_; }
    __host__ __device__ bool next(int i, Unit& u) const {
        const long L = (long)i * G + c; if (L >= nwg) return false;
        if (MK_SIMPLE_ORDER) { u.pm = (int)L / nN; u.pn = (int)L % nN; u.bo = 0; u.aux = 0; return true; }
        int wgid = (int)L; { const int q = nwg / NXCD, r = nwg % NXCD, xcd = wgid % NXCD, off = wgid / NXCD; wgid = (xcd < r ? xcd * (q + 1) : r * (q + 1) + (xcd - r) * q) + off; }
        const int nig = WGM * nN, gid = wgid / nig, fm = gid * WGM, gsz = (nM - fm) < WGM ? (nM - fm) : WGM;
        u.pm = fm + ((wgid % nig) % gsz); u.pn = (wgid % nig) / gsz; u.bo = 0; u.aux = 0; return true;
    }
    __device__ __forceinline__ void a_ready(const Unit&) const {}
    __device__ __forceinline__ void done(const Unit&) const {}
};

__device__ __forceinline__ unsigned cvt_pk_bf16(float lo, float hi) { unsigned r; asm volatile("v_cvt_pk_bf16_f32 %0, %1, %2" : "=v"(r) : "v"(lo), "v"(hi)); return r; }
typedef float f32x2 __attribute__((ext_vector_type(2)));
__device__ __forceinline__ f32x2 gelu_pk(f32x2 v) {
    const f32x2 av = __builtin_elementwise_abs(v), d = av * 0.2316418882f + 1.0f;
    f32x2 t; t.x = __builtin_amdgcn_rcpf(d.x); t.y = __builtin_amdgcn_rcpf(d.y);
    f32x2 q = t * 0.5307027145f + (-0.7265760135f); q = q * t + 0.7107068705f; q = q * t + (-0.142248368f); q = q * t + 0.127414796f; q = q * t;
    const f32x2 s = (v * v) * (-0.72134752044f);
    f32x2 e; e.x = __builtin_amdgcn_exp2f(s.x); e.y = __builtin_amdgcn_exp2f(s.y);
    const f32x2 m = v * (q * e), r = v - m;
    f32x2 o; o.x = v.x < 0.f ? m.x : r.x; o.y = v.y < 0.f ? m.y : r.y; return o;
}

template <class Epi, class Sched, bool ALIGN_EPI = false, bool SP2 = false, bool KROT = false>
__device__ __forceinline__ void gemm_phase(PG8_LAS unsigned char* lds, const Gemm g, const Sched& S, const Epi& E) {
    const int tid = threadIdx.x, wid = __builtin_amdgcn_readfirstlane(tid >> 6), lane = tid & 63, wr = wid >> 2, wc = wid & 3, fr = lane & 15, fq = lane >> 4;
    const int K = g.K, nt = K / BK;
    const int kmask = nt - 1, rot = (MK_KROT && KROT) ? (int)((blockIdx.x * 3u + (blockIdx.x >> 3)) & (unsigned)kmask) : 0;
#define PG8_KO(j) ((size_t)(((j) + rot) & kmask) * kstep)
    unsigned voffA[2], voffB[2];
    unsigned vC[2][2], vN[2][2];
#pragma unroll
    for (int i = 0; i < 2; ++i) { int R, C; stage_rc(tid * 16 + i * 8192, R, C); const int Rb = Epi::PERM ? ((R & ~31) + perm32(R & 31)) : R;
        voffA[i] = (unsigned)(R * K + C) * 2u; voffB[i] = (unsigned)(Rb * K + C) * 2u; }
    const size_t kstep = (size_t)(BK * 2);
    const size_t hstep = (size_t)HALF * K * 2;
    const size_t tstep = 2 * hstep;
    const unsigned ldsw = (unsigned)wid * 1024u;
    const int aoff = lds_byte(wr * 64 + fr, fq * 8), boff = lds_byte(wc * 32 + fr, fq * 8);
#define PG8_SA(b, h) (((b) * 2 + (h)) * HTB)
#define PG8_SB(b, h) ((4 + (b) * 2 + (h)) * HTB)
#define PG8_STAGE(bufoff, gbase, voff) do { _Pragma("unroll") for (int _i = 0; _i < 2; ++_i) \
        __builtin_amdgcn_global_load_lds((const unsigned*)((const char*)(gbase) + (voff)[_i]), (PG8_LAS unsigned*)(lds + (bufoff) + ldsw + _i * 8192), 16, 0, 0); } while (0)
#define PG8_STAGE_A(bufoff, gbase, h, nx) do { _Pragma("unroll") for (int _i = 0; _i < 2; ++_i) { \
        const unsigned _vo = Sched::GATHER ? ((nx) ? vN[h][_i] : vC[h][_i]) : (unsigned)((h) * hstep) + voffA[_i]; \
        __builtin_amdgcn_global_load_lds((const unsigned*)((const char*)(gbase) + _vo), (PG8_LAS unsigned*)(lds + (bufoff) + ldsw + _i * 8192), 16, 0, 0); } } while (0)
#define PG8_LDA(dst, b, h) do { _Pragma("unroll") for (int m = 0; m < 4; ++m) _Pragma("unroll") for (int k = 0; k < 2; ++k) dst[m][k] = *(const PG8_LAS bf16x8*)(lds + PG8_SA(b, h) + aoff + m * 2048 + k * 1024); } while (0)
#define PG8_LDB(dst, b, h) do { _Pragma("unroll") for (int n = 0; n < 2; ++n) _Pragma("unroll") for (int k = 0; k < 2; ++k) dst[n][k] = *(const PG8_LAS bf16x8*)(lds + PG8_SB(b, h) + boff + n * 2048 + k * 1024); } while (0)
#define PG8_MMA(ai, bj, At, Bt) do { __builtin_amdgcn_s_setprio(1); _Pragma("unroll") for (int m = 0; m < 4; ++m) _Pragma("unroll") for (int n = 0; n < 2; ++n) _Pragma("unroll") for (int k = 0; k < 2; ++k) \
        acc[ai][bj][m][n] = __builtin_amdgcn_mfma_f32_16x16x32_bf16(Bt[n][k], At[m][k], acc[ai][bj][m][n], 0, 0, 0); __builtin_amdgcn_s_setprio(0); } while (0)
#define PG8_WAIT_V(n) asm volatile("s_waitcnt vmcnt(" #n ")" ::: "memory")
#define PG8_WAIT_L(n) asm volatile("s_waitcnt lgkmcnt(" #n ")" ::: "memory")
#define PG8_BAR __builtin_amdgcn_s_barrier()
#define PG8_SCHED __builtin_amdgcn_sched_barrier(0)
    Unit cur, nxt; int ui = 0;
    if (!S.next(0, cur)) return;
    f32x4 acc[2][2][4][2];
#pragma unroll
    for (int a = 0; a < 2; ++a)
#pragma unroll
        for (int b = 0; b < 2; ++b)
#pragma unroll
            for (int m = 0; m < 4; ++m)
#pragma unroll
                for (int n = 0; n < 2; ++n) acc[a][b][m][n] = (f32x4){0.f, 0.f, 0.f, 0.f};
    bf16x8 At[4][2], B0[2][2], B1[2][2];
    const char* cA = (const char*)g.A + (Sched::GATHER ? (size_t)0 : (size_t)cur.pm * tstep); const char* cB = (const char*)g.Bt + cur.bo + (size_t)cur.pn * tstep;
    S.a_ready(cur);
#define PG8_VOFF(dst, un) do { _Pragma("unroll") for (int _h = 0; _h < 2; ++_h) _Pragma("unroll") for (int _i = 0; _i < 2; ++_i) { int R_, C_; stage_rc(tid * 16 + _i * 8192, R_, C_); dst[_h][_i] = S.a_off(un, _h * HALF + R_) + (unsigned)C_ * 2u; } } while (0)
    if constexpr (Sched::GATHER) { PG8_VOFF(vC, cur); }
    if constexpr (SP2) {
        PG8_STAGE(PG8_SB(0, 0), cB + PG8_KO(0), voffB); PG8_STAGE(PG8_SB(0, 1), cB + hstep + PG8_KO(0), voffB); PG8_STAGE_A(PG8_SA(0, 0), cA + PG8_KO(0), 0, false); PG8_STAGE_A(PG8_SA(0, 1), cA + PG8_KO(0), 1, false);
        if (wr == 1) PG8_BAR;
        PG8_WAIT_V(2); PG8_BAR;
        PG8_STAGE(PG8_SB(1, 0), cB + PG8_KO(1), voffB); PG8_STAGE_A(PG8_SA(1, 0), cA + PG8_KO(1), 0, false); PG8_STAGE(PG8_SB(1, 1), cB + hstep + PG8_KO(1), voffB);
        PG8_WAIT_V(6); PG8_BAR;
    } else {
        PG8_STAGE(PG8_SB(0, 0), cB, voffB); PG8_STAGE_A(PG8_SA(0, 0), cA, 0, false); PG8_STAGE(PG8_SB(0, 1), cB + hstep, voffB); PG8_STAGE_A(PG8_SA(0, 1), cA, 1, false);
        if (wr == 1) PG8_BAR;
        PG8_WAIT_V(4); PG8_BAR;
        PG8_STAGE(PG8_SB(1, 0), cB + PG8_KO(1), voffB); PG8_STAGE_A(PG8_SA(1, 0), cA + PG8_KO(1), 0, false); PG8_STAGE(PG8_SB(1, 1), cB + hstep + PG8_KO(1), voffB);
        PG8_WAIT_V(6); PG8_BAR;
    }
    for (;;) {
        const bool has_next = S.next(ui + 1, nxt);
        if constexpr (Sched::GATHER) { if (has_next) { PG8_VOFF(vN, nxt); } else { vN[0][0] = vC[0][0]; vN[0][1] = vC[0][1]; vN[1][0] = vC[1][0]; vN[1][1] = vC[1][1]; } }
        const char* nA = (has_next && !Sched::GATHER) ? (const char*)g.A + (size_t)nxt.pm * tstep : cA; const char* nB = has_next ? (const char*)g.Bt + nxt.bo + (size_t)nxt.pn * tstep : cB;
        for (int t = 0; t < nt; t += 2) {
            const bool last = (t == nt - 2);
            const char* a1 = cA + PG8_KO(t + 1);
            const char* a2 = last ? nA + PG8_KO(0) : cA + PG8_KO(t + 2); const char* b2 = last ? nB + PG8_KO(0) : cB + PG8_KO(t + 2);
            const char* a3 = last ? nA + PG8_KO(1) : cA + PG8_KO(t + 3); const char* b3 = last ? nB + PG8_KO(1) : cB + PG8_KO(t + 3);
            if (last && has_next) S.a_ready(nxt);
            if constexpr (SP2) {
            PG8_LDB(B0, 0, 0); PG8_LDB(B1, 0, 1); PG8_SCHED; PG8_LDA(At, 0, 0); PG8_STAGE_A(PG8_SA(1, 1), a1, 1, false);
            PG8_WAIT_V(8); PG8_WAIT_L(0); PG8_BAR; PG8_MMA(0, 0, At, B0); PG8_MMA(0, 1, At, B1); PG8_BAR; PG8_SCHED;
            PG8_LDA(At, 0, 1); PG8_STAGE(PG8_SB(0, 0), b2, voffB); PG8_STAGE(PG8_SB(0, 1), b2 + hstep, voffB); PG8_STAGE_A(PG8_SA(0, 0), a2, 0, last);
            PG8_WAIT_V(8); PG8_WAIT_L(0); PG8_BAR; PG8_MMA(1, 0, At, B0); PG8_MMA(1, 1, At, B1); PG8_BAR; PG8_SCHED;
            PG8_LDB(B0, 1, 0); PG8_LDB(B1, 1, 1); PG8_SCHED; PG8_LDA(At, 1, 0); PG8_STAGE_A(PG8_SA(0, 1), a2, 1, last);
            PG8_WAIT_V(8); PG8_WAIT_L(0); PG8_BAR; PG8_MMA(0, 0, At, B0); PG8_MMA(0, 1, At, B1); PG8_BAR; PG8_SCHED;
            PG8_LDA(At, 1, 1); PG8_STAGE(PG8_SB(1, 0), b3, voffB); PG8_STAGE(PG8_SB(1, 1), b3 + hstep, voffB); PG8_STAGE_A(PG8_SA(1, 0), a3, 0, last);
            PG8_WAIT_V(8); PG8_WAIT_L(0); PG8_BAR; PG8_MMA(1, 0, At, B0); PG8_MMA(1, 1, At, B1); PG8_BAR; PG8_SCHED;
            } else {
            PG8_LDB(B0, 0, 0); PG8_SCHED; PG8_LDA(At, 0, 0); PG8_STAGE_A(PG8_SA(1, 1), a1, 1, false);
            PG8_WAIT_L(8); PG8_BAR; PG8_WAIT_L(0); PG8_MMA(0, 0, At, B0); PG8_BAR; PG8_SCHED;
            PG8_LDB(B1, 0, 1); PG8_STAGE(PG8_SB(0, 0), b2, voffB);
            PG8_BAR; PG8_WAIT_L(0); PG8_MMA(0, 1, At, B1); PG8_BAR;
            PG8_LDA(At, 0, 1); PG8_STAGE_A(PG8_SA(0, 0), a2, 0, last);
            PG8_BAR; PG8_WAIT_L(0); PG8_MMA(1, 0, At, B0); PG8_BAR; PG8_SCHED;
            PG8_STAGE(PG8_SB(0, 1), b2 + hstep, voffB);
            PG8_WAIT_V(6); PG8_BAR; PG8_MMA(1, 1, At, B1); PG8_BAR;
            PG8_LDB(B0, 1, 0); PG8_SCHED; PG8_LDA(At, 1, 0); PG8_STAGE_A(PG8_SA(0, 1), a2, 1, last);
            PG8_WAIT_L(8); PG8_BAR; PG8_WAIT_L(0); PG8_MMA(0, 0, At, B0); PG8_BAR; PG8_SCHED;
            PG8_LDB(B1, 1, 1); PG8_STAGE(PG8_SB(1, 0), b3, voffB);
            PG8_BAR; PG8_WAIT_L(0); PG8_MMA(0, 1, At, B1); PG8_BAR;
            PG8_LDA(At, 1, 1); PG8_STAGE_A(PG8_SA(1, 0), a3, 0, last);
            PG8_BAR; PG8_WAIT_L(0); PG8_MMA(1, 0, At, B0); PG8_BAR; PG8_SCHED;
            PG8_STAGE(PG8_SB(1, 1), b3 + hstep, voffB);
            PG8_WAIT_V(6); PG8_BAR; PG8_MMA(1, 1, At, B1); PG8_BAR;
            }
        }
        if constexpr (ALIGN_EPI) { if (wr == 0) PG8_BAR; }
        if constexpr (!Epi::AFTER_DRAIN) { E(acc, cur, wr, wc, fr, fq); S.done(cur); }
        if (!has_next) break;
#pragma unroll
        for (int a = 0; a < 2; ++a)
#pragma unroll
            for (int b = 0; b < 2; ++b)
#pragma unroll
                for (int m = 0; m < 4; ++m)
#pragma unroll
                    for (int n = 0; n < 2; ++n) acc[a][b][m][n] = (f32x4){0.f, 0.f, 0.f, 0.f};
        cur = nxt; cA = nA; cB = nB; ++ui;
        if constexpr (Sched::GATHER) { vC[0][0] = vN[0][0]; vC[0][1] = vN[0][1]; vC[1][0] = vN[1][0]; vC[1][1] = vN[1][1]; }
        if constexpr (ALIGN_EPI) { if (wr == 1) PG8_BAR; }
    }
    PG8_WAIT_V(0);
    if constexpr (!ALIGN_EPI) { if (wr == 0) PG8_BAR; }
    PG8_BAR;
    if constexpr (Epi::AFTER_DRAIN) { E.fused(acc, cur, wr, wc, fr, fq, lds, wid, lane); S.done(cur); }
#undef PG8_VOFF
#undef PG8_KO
#undef PG8_SA
#undef PG8_SB
#undef PG8_STAGE
#undef PG8_STAGE_A
#undef PG8_LDA
#undef PG8_LDB
#undef PG8_MMA
#undef PG8_WAIT_V
#undef PG8_WAIT_L
#undef PG8_BAR
#undef PG8_SCHED
}
}

namespace pg8 {
template <bool GATHER_>
struct GroupedOrder {
    static constexpr bool GATHER = GATHER_;
    const PG8_LAS int* tmap; const PG8_LAS int* cntl; const int* list; int nU, nN, G, c, lcap, rowbytes; size_t estride;
    __device__ __forceinline__ bool next(int i, Unit& u) const { const long L = (long)i * G + c; if (L >= nU) return false; const int t = (int)L / nN; const int m = __builtin_amdgcn_readfirstlane(tmap[t]);
        u.pm = t; u.pn = (int)L % nN; u.bo = (size_t)(m & 255) * estride; u.aux = m; return true; }
    __device__ __forceinline__ unsigned a_off(const Unit& u, int R) const { const int e = u.aux & 255, p0 = u.aux >> 8, ce = cntl[e]; int p = p0 + R; p = p < ce ? p : ce - 1; return (unsigned)list[(size_t)e * lcap + p] * (unsigned)rowbytes; }
    __device__ __forceinline__ void a_ready(const Unit&) const {}
    __device__ __forceinline__ void done(const Unit&) const {}
};
__device__ __forceinline__ u32x4 pack8(const f32x4 a, const f32x4 b) { u32x4 w; w.x = cvt_pk_bf16(a[0], a[1]); w.y = cvt_pk_bf16(a[2], a[3]); w.z = cvt_pk_bf16(b[0], b[1]); w.w = cvt_pk_bf16(b[2], b[3]); return w; }
struct EpiStore {
    static constexpr bool PERM = true, AFTER_DRAIN = false; bf16_t* O; int ldc;
    __device__ __forceinline__ void operator()(const f32x4 (&acc)[2][2][4][2], const Unit& u, int wr, int wc, int fr, int fq) const {
        const int row0 = u.pm * BM + wr * 64 + fr, col0 = u.pn * BM + wc * 32 + 8 * fq;
#pragma unroll
        for (int ai = 0; ai < 2; ++ai)
#pragma unroll
            for (int m = 0; m < 4; ++m) { bf16_t* rowp = O + (size_t)(row0 + ai * HALF + m * 16) * ldc + col0;
#pragma unroll
                for (int bj = 0; bj < 2; ++bj) *(u32x4*)(rowp + bj * HALF) = pack8(acc[ai][bj][m][0], acc[ai][bj][m][1]); }
    }
};
__device__ __forceinline__ f32x4 silu4(const f32x4 v) { f32x4 r;
#pragma unroll
    for (int i = 0; i < 4; ++i) r[i] = v[i] * __builtin_amdgcn_rcpf(1.f + __expf(-v[i])); return r; }
__device__ __forceinline__ f32x4 sigm4(const f32x4 v) { f32x4 r;
#pragma unroll
    for (int i = 0; i < 4; ++i) r[i] = __builtin_amdgcn_rcpf(1.f + __expf(-v[i])); return r; }
struct EpiSwiglu {
    static constexpr bool PERM = true, AFTER_DRAIN = false; bf16_t* G;
    __device__ __forceinline__ void operator()(const f32x4 (&acc)[2][2][4][2], const Unit& u, int wr, int wc, int fr, int fq) const {
        const int row0 = u.pm * BM + wr * 64 + fr, col0 = u.pn * HALF + wc * 32 + 8 * fq;
#pragma unroll
        for (int ai = 0; ai < 2; ++ai)
#pragma unroll
            for (int m = 0; m < 4; ++m) *(u32x4*)(G + (size_t)(row0 + ai * HALF + m * 16) * 512 + col0) = pack8(silu4(acc[ai][0][m][0]) * acc[ai][1][m][0], silu4(acc[ai][0][m][1]) * acc[ai][1][m][1]);
    }
};
__device__ __forceinline__ void unpack8f(const u32x4 w, f32x4& a, f32x4& b) {
    a[0] = __uint_as_float(w.x << 16); a[1] = __uint_as_float(w.x & 0xffff0000u); a[2] = __uint_as_float(w.y << 16); a[3] = __uint_as_float(w.y & 0xffff0000u);
    b[0] = __uint_as_float(w.z << 16); b[1] = __uint_as_float(w.z & 0xffff0000u); b[2] = __uint_as_float(w.w << 16); b[3] = __uint_as_float(w.w & 0xffff0000u); }
struct EpiGlu {
    static constexpr bool PERM = true, AFTER_DRAIN = false; const bf16_t* GS; const float* b; bf16_t* GG;
    __device__ __forceinline__ void operator()(const f32x4 (&acc)[2][2][4][2], const Unit& u, int wr, int wc, int fr, int fq) const {
        const int row0 = u.pm * BM + wr * 64 + fr, col0 = u.pn * BM + wc * 32 + 8 * fq;
#pragma unroll
        for (int bj = 0; bj < 2; ++bj) { const int c = col0 + bj * HALF; const f32x4 b0 = *(const f32x4*)(b + c), b1 = *(const f32x4*)(b + c + 4);
#pragma unroll
            for (int ai = 0; ai < 2; ++ai)
#pragma unroll
                for (int m = 0; m < 4; ++m) { const size_t o = (size_t)(row0 + ai * HALF + m * 16) * 512 + c; f32x4 g0, g1; unpack8f(*(const u32x4*)(GS + o), g0, g1);
                    *(u32x4*)(GG + o) = pack8(g0 * sigm4(acc[ai][bj][m][0] + b0), g1 * sigm4(acc[ai][bj][m][1] + b1)); } }
    }
};
struct EpiResid {
    static constexpr bool PERM = true, AFTER_DRAIN = false;
    const float* x; const float* ctx; const float* mod; bf16_t* XC; int inplace;
    __device__ __forceinline__ void operator()(const f32x4 (&acc)[2][2][4][2], const Unit& u, int wr, int wc, int fr, int fq) const {
        const int R0 = u.pm * BM; const int ci = R0 < 32768 ? (R0 >> 11) : 16;
        const float* base = R0 < 32768 ? x + (size_t)R0 * 1024 : ctx + (size_t)(R0 - 32768) * 1024;
        bf16_t* out = XC + (size_t)R0 * 1024; const float* gate = mod + ((size_t)ci * 6 + 2) * 1024;
        const int rl0 = wr * 64 + fr, col0 = u.pn * BM + wc * 32 + 8 * fq;
#pragma unroll
        for (int bj = 0; bj < 2; ++bj) { const int c = col0 + bj * HALF; const f32x4 g0 = *(const f32x4*)(gate + c), g1 = *(const f32x4*)(gate + c + 4);
#pragma unroll
            for (int ai = 0; ai < 2; ++ai)
#pragma unroll
                for (int m = 0; m < 4; ++m) { const size_t o = (size_t)(rl0 + ai * HALF + m * 16) * 1024 + c; f32x4 b0, b1;
                    if (inplace) unpack8f(*(const u32x4*)(out + o), b0, b1); else { b0 = *(const f32x4*)(base + o); b1 = *(const f32x4*)(base + o + 4); }
                    *(u32x4*)(out + o) = pack8(b0 + g0 * acc[ai][bj][m][0], b1 + g1 * acc[ai][bj][m][1]); } }
    }
};
}

#include <hip/hip_bf16.h>
#include <cmath>
namespace attn_body {
using bf16=__hip_bfloat16;
using bf16x8=__attribute__((ext_vector_type(8)))short;
using s16x4=__attribute__((ext_vector_type(4)))short;
using f32x16=__attribute__((ext_vector_type(16)))float;
using u32x4=__attribute__((ext_vector_type(4)))unsigned;
constexpr int D=64,QP=512,KP=128,OP=1024;
constexpr int NW=8,QBLK=32,QB=QBLK*NW,KVBLK=64;
constexpr int ATTN_UNIT_ROWS=QB;
__device__ __forceinline__ int crow(int r,int hi){return (r&3)+8*(r>>2)+4*hi;}
#define SBAR() __builtin_amdgcn_sched_barrier(0)
__device__ __forceinline__ void cmask(f32x16&p0,f32x16&p1,int jb,int qrel,int hi){
  const float NEG=-INFINITY; int kb=64*jb+4*hi;
  #pragma unroll
  for(int r=0;r<16;++r){int kv=kb+(r&3)+8*(r>>2); if(kv>qrel)p0[r]=NEG; if(kv+32>qrel)p1[r]=NEG;}
}

constexpr int NSLOT=3, SLOTB=8192;
constexpr int LDS_K=0, LDS_V=NSLOT*SLOTB, LDS_WS=2*NSLOT*SLOTB, LDS_OST=LDS_WS+NW*64*4, LDS_BYTES=LDS_OST+NW*4096;
constexpr float C2=0.125f*1.4426950408889634f;
__device__ __forceinline__ void glds16(const void*gsrc,unsigned lds_dst){unsigned keep;
  asm volatile("s_mov_b32 %0, m0\n\ts_mov_b32 m0, %2\n\ts_nop 0\n\tglobal_load_lds_dwordx4 %1, off\n\ts_mov_b32 m0, %0":"=&s"(keep):"v"(gsrc),"s"(lds_dst):"memory");}
__device__ __forceinline__ float max3f(float a,float b,float c){float r;asm("v_max3_f32 %0, %1, %2, %3":"=v"(r):"v"(a),"v"(b),"v"(c));return r;}
__device__ __forceinline__ float max2f(float a,float b){float r;asm("v_max_f32_e32 %0, %1, %2":"=v"(r):"v"(a),"v"(b));return r;}
__device__ __forceinline__ float fadd_s(float a,float b){float r;asm("v_add_f32_e32 %0, %1, %2":"=v"(r):"v"(a),"v"(b));return r;}
__device__ __forceinline__ float fsub_s(float a,float b){float r;asm("v_sub_f32_e32 %0, %1, %2":"=v"(r):"v"(a),"v"(b));return r;}
typedef float f32x2_t __attribute__((ext_vector_type(2))); typedef __bf16 bf16x2_t __attribute__((ext_vector_type(2)));
__device__ __forceinline__ unsigned cvtpk_s(float lo,float hi){f32x2_t v={lo,hi};bf16x2_t b=__builtin_convertvector(v,bf16x2_t);return __builtin_bit_cast(unsigned,b);}
#define WAIT_BAR(N) asm volatile("s_waitcnt vmcnt(" #N ") lgkmcnt(0)\n\ts_barrier":::"memory")

__device__ __forceinline__ void qkt(f32x16&p0,f32x16&p1,const char*Kslot,const bf16x8*qr,const f32x16&negm,int r32,int hi){
  const char*kb=Kslot+hi*1024+r32*16;
  #pragma unroll
  for(int d0=0;d0<4;++d0){
    const bf16x8 b0=*reinterpret_cast<const bf16x8*>(kb+d0*2048);
    const bf16x8 b1=*reinterpret_cast<const bf16x8*>(kb+d0*2048+512);
    if(d0==0){p0=__builtin_amdgcn_mfma_f32_32x32x16_bf16(b0,qr[0],negm,0,0,0);p1=__builtin_amdgcn_mfma_f32_32x32x16_bf16(b1,qr[0],negm,0,0,0);}
    else{p0=__builtin_amdgcn_mfma_f32_32x32x16_bf16(b0,qr[d0],p0,0,0,0);p1=__builtin_amdgcn_mfma_f32_32x32x16_bf16(b1,qr[d0],p1,0,0,0);}}
}
typedef __attribute__((address_space(3))) const char* lds_cptr;
typedef short v4i16_t __attribute__((ext_vector_type(4)));
__device__ __forceinline__ void kload8(bf16x8*kf,lds_cptr kp){
  kf[0]=*(const __attribute__((address_space(3))) bf16x8*)(kp);      kf[1]=*(const __attribute__((address_space(3))) bf16x8*)(kp+512);
  kf[2]=*(const __attribute__((address_space(3))) bf16x8*)(kp+2048); kf[3]=*(const __attribute__((address_space(3))) bf16x8*)(kp+2560);
  kf[4]=*(const __attribute__((address_space(3))) bf16x8*)(kp+4096); kf[5]=*(const __attribute__((address_space(3))) bf16x8*)(kp+4608);
  kf[6]=*(const __attribute__((address_space(3))) bf16x8*)(kp+6144); kf[7]=*(const __attribute__((address_space(3))) bf16x8*)(kp+6656);
}
__device__ __forceinline__ void kload2(bf16x8*kf,lds_cptr kp,int j){ kf[2*j]=*(const __attribute__((address_space(3))) bf16x8*)(kp+j*2048); kf[2*j+1]=*(const __attribute__((address_space(3))) bf16x8*)(kp+j*2048+512); }
__device__ __forceinline__ s16x4 vtr(lds_cptr p){ return __builtin_bit_cast(s16x4,__builtin_amdgcn_ds_read_tr16_b64_v4i16((__attribute__((address_space(3))) v4i16_t*)p)); }
__device__ __forceinline__ float rowmax(const f32x16&p0,const f32x16&p1){
  float a=max3f(p0[0],p0[1],p1[0]),b=max3f(p0[2],p0[3],p1[1]);a=max3f(a,p1[2],p1[3]);
  #pragma unroll
  for(int r=4;r<16;r+=4){a=max3f(a,p0[r],p0[r+1]);b=max3f(b,p0[r+2],p0[r+3]);a=max3f(a,p1[r],p1[r+1]);b=max3f(b,p1[r+2],p1[r+3]);}
  const float m=max2f(a,b);
  auto rr=__builtin_amdgcn_permlane32_swap(__float_as_uint(m),__float_as_uint(m),false,false);
  return max2f(__uint_as_float(rr[0]),__uint_as_float(rr[1]));
}
__device__ __forceinline__ void pv(f32x16*o,int vb,bf16x8 pa0,bf16x8 pa1,bf16x8 pa2,bf16x8 pa3){
  #pragma unroll
  for(int d0=0;d0<2;++d0){s16x4 lo[4],hi[4];
    #pragma unroll
    for(int ks=0;ks<4;++ks){
      asm volatile("ds_read_b64_tr_b16 %0,%1 offset:%c2":"=&v"(lo[ks]):"v"(vb),"i"(d0*4096+ks*1024):"memory");
      asm volatile("ds_read_b64_tr_b16 %0,%1 offset:%c2":"=&v"(hi[ks]):"v"(vb),"i"(d0*4096+ks*1024+512):"memory");}
    asm volatile("s_waitcnt lgkmcnt(0)":::"memory");SBAR();
    #define PK(k) (bf16x8){lo[k][0],lo[k][1],lo[k][2],lo[k][3],hi[k][0],hi[k][1],hi[k][2],hi[k][3]}
    o[d0]=__builtin_amdgcn_mfma_f32_32x32x16_bf16(pa0,PK(0),o[d0],0,0,0);
    o[d0]=__builtin_amdgcn_mfma_f32_32x32x16_bf16(pa1,PK(1),o[d0],0,0,0);
    o[d0]=__builtin_amdgcn_mfma_f32_32x32x16_bf16(pa2,PK(2),o[d0],0,0,0);
    o[d0]=__builtin_amdgcn_mfma_f32_32x32x16_bf16(pa3,PK(3),o[d0],0,0,0);
    #undef PK
  }
}

#ifndef ATTN_STORE16
#define ATTN_STORE16(p,v) (*(u32x4*)(p)=(v))
#endif
template<int THRL> __device__ __forceinline__ void attn_unit(const bf16*Q0,const bf16*__restrict__ Kh,const bf16*__restrict__ Vh,bf16*O0,const int NT,char*shm){
  const int tid=threadIdx.x,lane=tid&63,r32=lane&31,hi=lane>>5; const int wid=__builtin_amdgcn_readfirstlane(tid>>6);
  const bf16*Qw=Q0+(long)(wid*QBLK)*QP;
  const unsigned lds0=(unsigned)(uintptr_t)shm;
  float*wsf=(float*)(shm+LDS_WS)+wid*64;
  const bf16*ksrc=Kh+(long)lane*KP+wid*8;
  const bf16*vsrc=Vh+(long)(16*(wid&3)+(lane>>2))*KP+(wid>>2)*32+(lane&3)*8;
  const unsigned kdst=lds0+LDS_K+wid*1024, vdst=lds0+LDS_V+wid*1024;
  #define DMA_K(t,slot) glds16(ksrc+(long)(t)*KVBLK*KP,(unsigned)__builtin_amdgcn_readfirstlane(kdst+(slot)))
  #define DMA_V(t,slot) glds16(vsrc+(long)(t)*KVBLK*KP,(unsigned)__builtin_amdgcn_readfirstlane(vdst+(slot)))
  const int vb0=(int)(lds0+LDS_V)+((lane>>4)&1)*32+(lane&3)*8+(4*hi+((lane&15)>>2))*64;
  const char*Kbase=shm+LDS_K; bf16x8 kf[8];
  const lds_cptr shm3=(lds_cptr)shm; const lds_cptr kp0=shm3+LDS_K+hi*1024+r32*16; const lds_cptr vp0=shm3+LDS_V+((lane>>4)&1)*32+(lane&3)*8+(4*hi+((lane&15)>>2))*64;
  DMA_K(0,0);DMA_V(0,0);DMA_K(1,SLOTB);
  bf16x8 qr[4];
  #pragma unroll
  for(int d0=0;d0<4;++d0)qr[d0]=*reinterpret_cast<const bf16x8*>(&Qw[(long)r32*QP+d0*16+hi*8]);
  float mhat=0.f,l_reg=0.f;f32x16 o[2];o[0]=f32x16{};o[1]=f32x16{};f32x16 negm=f32x16{};asm volatile("":"+v"(negm));
  #define CMASK(P0,P1,t) do{}while(0)
  bool resc=false;
  #define START(P0,P1) do{ const float rm=rowmax(P0,P1); resc=false; \
    { const float dl=rm; mhat=fadd_s(mhat,dl); \
      _Pragma("unroll") for(int r=0;r<16;++r){P0[r]=fsub_s(P0[r],dl);P1[r]=fsub_s(P1[r],dl);} \
      _Pragma("unroll") for(int r=0;r<16;++r)negm[r]=-mhat; asm volatile("":"+v"(negm)); } \
    _Pragma("unroll") for(int r=0;r<16;++r)P0[r]=__builtin_amdgcn_exp2f(P0[r]); }while(0)
  #define RESC() do{ if(resc){ asm volatile("s_waitcnt lgkmcnt(0)":::"memory"); \
      _Pragma("unroll") for(int d_=0;d_<2;++d_) _Pragma("unroll") for(int r=0;r<16;++r)o[d_][r]*=wsf[crow(r,hi)]; } }while(0)
  f32x16 pA0,pA1,pB0,pB1;
  int sl_prev=0,sl_cur=0,sl_next=SLOTB;
  #define ROT() do{sl_prev=sl_cur;sl_cur=sl_next;sl_next=(sl_next==(NSLOT-1)*SLOTB)?0:sl_next+SLOTB;}while(0)
  DMA_K(2,2*SLOTB);
  WAIT_BAR(3);
  qkt(pA0,pA1,Kbase,qr,negm,r32,hi);asm volatile("s_nop 15\n\ts_nop 7":"+v"(pA0),"+v"(pA1));CMASK(pA0,pA1,0);
  START(pA0,pA1);
  _Pragma("unroll") for(int r=0;r<16;++r)pA1[r]=__builtin_amdgcn_exp2f(pA1[r]);
  WAIT_BAR(0);
  DMA_K(3,0);DMA_V(1,SLOTB);
  ROT();
  kload8(kf,kp0+sl_cur);
  WAIT_BAR(2);
  s16x4 vlo[8],vhi[8]; u32x4 pw0,pw1,pw2,pw3;
  #define PKW(P,B) cvtpk_s(P[B],P[B+1])
  #define PAF(k) __builtin_bit_cast(bf16x8,pw##k)
  #define VFR(i) (bf16x8){vlo[i][0],vlo[i][1],vlo[i][2],vlo[i][3],vhi[i][0],vhi[i][1],vhi[i][2],vhi[i][3]}
  #define PIN(x) asm volatile("":"+v"(x))
  #define MX3(a,b,c) __builtin_fmaxf(__builtin_fmaxf((a),(b)),(c))
  #define GAPA(MF,A0,A1,A2,A3,W0,W1,PW) do{ MF; sacc+=A0; sacc+=A1; sacc+=A2; sacc+=A3; PIN(sacc); W0; W1; PIN(PW); SBAR(); }while(0)
  #define EX(v) __builtin_amdgcn_exp2f(v)
  #define GAPB(MF,X,B) do{ MF; X[B]=EX(X[B]); X[B+1]=EX(X[B+1]); X[B+2]=EX(X[B+2]); X[B+3]=EX(X[B+3]); PIN(X); SBAR(); }while(0)
  #define VRD(i) do{ vlo[i]=vtr(vp_+(((i)>>2)*4096+((i)&3)*1024)); vhi[i]=vtr(vp_+(((i)>>2)*4096+((i)&3)*1024+512)); }while(0)
  #define KRD(G,j) do{ if(G){ kload2(kf,kp0+sl_next,j); SBAR(); } }while(0)
  #define STEP(C0,C1,P0,P1,t,GK,GV,GL) do{ SBAR(); \
    const lds_cptr vp_=vp0+sl_prev; \
    VRD(0); SBAR(); float sacc=(P0[0]+P0[1]); \
    GAPA(C0=__builtin_amdgcn_mfma_f32_32x32x16_bf16(kf[0],qr[0],negm,0,0,0), P0[2],P0[3],P0[4],P0[5],     pw0[0]=PKW(P0,0), pw0[1]=PKW(P0,2), pw0); \
    VRD(4); SBAR(); GAPA(C1=__builtin_amdgcn_mfma_f32_32x32x16_bf16(kf[1],qr[0],negm,0,0,0), P0[6],P0[7],P0[8],P0[9],     pw0[2]=PKW(P0,4), pw0[3]=PKW(P0,6), pw0); \
    VRD(1); SBAR(); GAPA(C0=__builtin_amdgcn_mfma_f32_32x32x16_bf16(kf[2],qr[1],C0,0,0,0),   P0[10],P0[11],P0[12],P0[13], pw1[0]=PKW(P0,8), pw1[1]=PKW(P0,10), pw1); \
    VRD(5); SBAR(); GAPA(C1=__builtin_amdgcn_mfma_f32_32x32x16_bf16(kf[3],qr[1],C1,0,0,0),   P0[14],P0[15],P1[0],P1[1],   pw1[2]=PKW(P0,12),pw1[3]=PKW(P0,14), pw1); \
    VRD(2); SBAR(); GAPA(C0=__builtin_amdgcn_mfma_f32_32x32x16_bf16(kf[4],qr[2],C0,0,0,0),   P1[2],P1[3],P1[4],P1[5],     pw2[0]=PKW(P1,0), pw2[1]=PKW(P1,2), pw2); \
    VRD(6); SBAR(); GAPA(C1=__builtin_amdgcn_mfma_f32_32x32x16_bf16(kf[5],qr[2],C1,0,0,0),   P1[6],P1[7],P1[8],P1[9],     pw2[2]=PKW(P1,4), pw2[3]=PKW(P1,6), pw2); \
    VRD(3); SBAR(); GAPA(C0=__builtin_amdgcn_mfma_f32_32x32x16_bf16(kf[6],qr[3],C0,0,0,0),   P1[10],P1[11],P1[12],P1[13], pw3[0]=PKW(P1,8), pw3[1]=PKW(P1,10), pw3); \
    VRD(7); SBAR(); GAPA(C1=__builtin_amdgcn_mfma_f32_32x32x16_bf16(kf[7],qr[3],C1,0,0,0),   P1[14],P1[15],0.f,0.f,       pw3[2]=PKW(P1,12),pw3[3]=PKW(P1,14), pw3); \
    l_reg+=sacc; \
    if(GK){DMA_K((t)+3,sl_cur);} if(GV){DMA_V((t)+1,sl_next);} \
    CMASK(C0,C1,t); \
    { float a=MX3(C0[0],C0[1],C1[0]),b=MX3(C0[2],C0[3],C1[1]); a=MX3(a,C1[2],C1[3]); \
      _Pragma("unroll") for(int r=4;r<16;r+=4){a=MX3(a,C0[r],C0[r+1]);b=MX3(b,C0[r+2],C0[r+3]);a=MX3(a,C1[r],C1[r+1]);b=MX3(b,C1[r+2],C1[r+3]);} \
      float rm=__builtin_fmaxf(a,b); { auto rr=__builtin_amdgcn_permlane32_swap(__float_as_uint(rm),__float_as_uint(rm),false,false); rm=__builtin_fmaxf(__uint_as_float(rr[0]),__uint_as_float(rr[1])); } \
      resc=false; \
      if(__builtin_expect(__any(rm>(float)THRL),0)){ const float dl=__builtin_fmaxf(rm,0.f); mhat+=dl; \
        _Pragma("unroll") for(int r=0;r<16;++r){C0[r]-=dl;C1[r]-=dl;} \
        _Pragma("unroll") for(int r=0;r<16;++r)negm[r]=-mhat; asm volatile("":"+v"(negm)); \
        const float f=__builtin_amdgcn_exp2f(-dl); l_reg*=f; if(hi==0)wsf[r32]=f; resc=true; } } \
    SBAR(); \
    GAPB(o[0]=__builtin_amdgcn_mfma_f32_32x32x16_bf16(PAF(0),VFR(0),o[0],0,0,0), C0,0); \
    GAPB(o[1]=__builtin_amdgcn_mfma_f32_32x32x16_bf16(PAF(0),VFR(4),o[1],0,0,0), C0,4); \
    KRD(GL,0); GAPB(o[0]=__builtin_amdgcn_mfma_f32_32x32x16_bf16(PAF(1),VFR(1),o[0],0,0,0), C0,8); \
    KRD(GL,1); GAPB(o[1]=__builtin_amdgcn_mfma_f32_32x32x16_bf16(PAF(1),VFR(5),o[1],0,0,0), C0,12); \
    KRD(GL,2); GAPB(o[0]=__builtin_amdgcn_mfma_f32_32x32x16_bf16(PAF(2),VFR(2),o[0],0,0,0), C1,0); \
    KRD(GL,3); GAPB(o[1]=__builtin_amdgcn_mfma_f32_32x32x16_bf16(PAF(2),VFR(6),o[1],0,0,0), C1,4); \
    GAPB(o[0]=__builtin_amdgcn_mfma_f32_32x32x16_bf16(PAF(3),VFR(3),o[0],0,0,0), C1,8); \
    GAPB(o[1]=__builtin_amdgcn_mfma_f32_32x32x16_bf16(PAF(3),VFR(7),o[1],0,0,0), C1,12); \
    }while(0)
  int t=1;
  #undef CMASK
  #define CMASK(P0,P1,t) do{}while(0)
  for(;t+5<NT;t+=2){
    STEP(pB0,pB1,pA0,pA1,t,true,true,true);     WAIT_BAR(2); RESC(); ROT();
    STEP(pA0,pA1,pB0,pB1,t+1,true,true,true);   WAIT_BAR(2); RESC(); ROT();
  }
  #undef CMASK
  #define CMASK(P0,P1,t) do{}while(0)
  #define ENDW(tt) do{ if((tt)+3<NT){WAIT_BAR(2);} else if((tt)+2<NT){WAIT_BAR(1);} else {WAIT_BAR(0);} }while(0)
  for(;t+1<NT;t+=2){
    STEP(pB0,pB1,pA0,pA1,t,(t+3<NT),(t+1<NT),(t+1<NT));       ENDW(t);   RESC(); ROT();
    STEP(pA0,pA1,pB0,pB1,t+1,(t+4<NT),(t+2<NT),(t+2<NT));     ENDW(t+1); RESC(); ROT();
  }
  STEP(pB0,pB1,pA0,pA1,NT-1,false,false,false); RESC();
  { float sacc=pB0[0]+pB0[1]; _Pragma("unroll") for(int r=2;r<16;++r)sacc+=pB0[r]; _Pragma("unroll") for(int r=0;r<16;++r)sacc+=pB1[r]; l_reg+=sacc;
    pw0=(u32x4){PKW(pB0,0),PKW(pB0,2),PKW(pB0,4),PKW(pB0,6)};pw1=(u32x4){PKW(pB0,8),PKW(pB0,10),PKW(pB0,12),PKW(pB0,14)};pw2=(u32x4){PKW(pB1,0),PKW(pB1,2),PKW(pB1,4),PKW(pB1,6)};pw3=(u32x4){PKW(pB1,8),PKW(pB1,10),PKW(pB1,12),PKW(pB1,14)};
    SBAR(); pv(o,vb0+sl_cur,PAF(0),PAF(1),PAF(2),PAF(3)); }
  #undef PKW
  #undef PAF
  #undef VFR
  #undef PIN
  #undef MX3
  #undef GAPA
  #undef GAPB
  #undef EX
  #undef VRD
  #undef KRD
  #undef STEP
  #undef ENDW
  {auto rr=__builtin_amdgcn_permlane32_swap(__float_as_uint(l_reg),__float_as_uint(l_reg),false,false);l_reg=__uint_as_float(rr[0])+__uint_as_float(rr[1]);}
  if(hi==0)wsf[32+r32]=l_reg;asm volatile("s_waitcnt lgkmcnt(0)":::"memory");
  float rli[16];
  #pragma unroll
  for(int r=0;r<16;++r)rli[r]=__builtin_amdgcn_rcpf(wsf[32+crow(r,hi)]);
  bf16*Ow=O0+(long)(wid*QBLK)*OP;
  { bf16*stg=(bf16*)(shm+LDS_OST)+wid*2048;
    #pragma unroll
    for(int r=0;r<16;++r){const int orow=crow(r,hi);
      #pragma unroll
      for(int d0=0;d0<2;++d0)stg[orow*64+d0*32+r32]=__float2bfloat16(o[d0][r]*rli[r]);}
    asm volatile("s_waitcnt lgkmcnt(0)":::"memory");
    #pragma unroll
    for(int i=0;i<4;++i){const int row=i*8+(lane>>3),ch=lane&7; const u32x4 v=*(const u32x4*)(stg+row*64+ch*8); ATTN_STORE16(Ow+(long)row*OP+ch*8,v);} }
  asm volatile("s_waitcnt lgkmcnt(0)\n\ts_barrier":::"memory");
  #undef DMA_K
  #undef DMA_V
  #undef CMASK
  #undef START
  #undef RESC
  #undef ROT
}
constexpr int ATTN_LDS_BYTES=LDS_BYTES;
#undef SBAR
#undef WAIT_BAR
}

struct Params {
    const float* in[35];
    float* out;
    unsigned char* ws;
    int ph_lo, ph_hi;
};
enum { I_X = 0, I_C, I_CTX, I_CCTX, I_WMOD, I_BMOD, I_GMIX, I_GFFN, I_MIXWIN, I_MIXWOUT, I_QG, I_KG, I_LNG, I_WSP, I_BSP,
       I_S5WIN, I_ARE, I_AIM, I_LOGDT, I_BRE, I_BIM, I_CRE, I_CIM, I_S5D, I_WGLU, I_BGLU, I_S5WOUT,
       I_WGRP, I_BGRP, I_WRT, I_BRT, I_W1, I_W3, I_W2, I_FING };

struct Ctx {
    const Params* p;
    unsigned char* ws;
    LAS unsigned char* lds;
    int tid, lane, wave, gw, ngw;
};
__device__ __forceinline__ const float* xin_row(const Params& P, int r) { return r < TL ? P.in[I_X] + (size_t)r * D : P.in[I_CTX] + (size_t)(r - TL) * D; }
__device__ __forceinline__ int cond_of(int r) { return r < TL ? (r >> 11) : 16; }
__device__ __forceinline__ const float* mod_vec(const Ctx& C, int layer, int ci, int k) { return (const float*)(C.ws + WS_MOD) + ((size_t)(layer * 17 + ci) * 6 + k) * D; }

__device__ __forceinline__ void dsincos(double a, double& s, double& c) {
    const double TWO_PI_HI = 6.283185307179586, TWO_PI_LO = 2.4492935982947064e-16;
    const double k = rint(a * 0.15915494309189535);
    double r = fma(-k, TWO_PI_HI, a); r = fma(-k, TWO_PI_LO, r);
    const double r2 = r * r; double ct = 1.0, st = r, cs = 1.0, ss = r;
#pragma unroll 1
    for (int i = 1; i <= 15; ++i) { ct *= -r2 / (double)((2 * i - 1) * (2 * i)); cs += ct; st *= -r2 / (double)((2 * i) * (2 * i + 1)); ss += st; }
    s = ss; c = cs;
}

__device__ __forceinline__ void transpose_item(const float* src, int N, int k0, int n0, bf16* dst, int dpitch, LAS float* scr, int lane) {
#pragma unroll 8
    for (int i = 0; i < 32; ++i) { const int kk = 2 * i + (lane >> 5); scr[kk * 33 + (lane & 31)] = src[(size_t)(k0 + kk) * N + n0 + (lane & 31)]; }
    asm volatile("s_waitcnt lgkmcnt(0)" ::: "memory");
    const int c = lane & 7;
#pragma unroll
    for (int j = 0; j < 4; ++j) { const int n = (lane >> 3) + 8 * j; const LAS float* s = scr + (8 * c) * 33 + n;
        v4u o; o.x = pk2(s[0 * 33], s[1 * 33]); o.y = pk2(s[2 * 33], s[3 * 33]); o.z = pk2(s[4 * 33], s[5 * 33]); o.w = pk2(s[6 * 33], s[7 * 33]);
        *(v4u*)(dst + (size_t)n * dpitch + 8 * c) = o; }
    asm volatile("s_waitcnt lgkmcnt(0)" ::: "memory");
}
__device__ __forceinline__ void transpose_mat_item(const float* W, int K, int N, bf16* WT, int it, LAS float* scr, int lane) {
    const int nblk = N / 32, kb = it / nblk, nb = it % nblk;
    transpose_item(W, N, kb * 64, nb * 32, WT + (size_t)(nb * 32) * K + kb * 64, K, scr, lane);
}
constexpr int MOE_ITEMS = NEXP * 768;
__device__ __forceinline__ void moe_convert_item(const Ctx& C, int layer, int it, LAS float* scr) {
    const Params& P = *C.p;
    const int e = it / 768, r = it % 768, kind = r / 256, j = r % 256;
    if (kind < 2) {
        const float* src = (kind == 0 ? P.in[I_W1] : P.in[I_W3]) + ((size_t)layer * NEXP + e) * D * EH;
        const int kb = j / 16, nb = j % 16, k0 = kb * 64, n0 = nb * 32;
        const int drow = (n0 / 128) * 256 + (n0 % 128) + (kind == 1 ? 128 : 0);
        transpose_item(src, EH, k0, n0, (bf16*)(C.ws + WS_W13) + (size_t)e * 1024 * 1024 + (size_t)drow * 1024 + k0, 1024, scr, C.lane);
    } else {
        const float* src = P.in[I_W2] + ((size_t)layer * NEXP + e) * EH * D;
        const int kb = j / 32, nb = j % 32, k0 = kb * 64, n0 = nb * 32;
        transpose_item(src, D, k0, n0, (bf16*)(C.ws + WS_W2) + (size_t)e * 1024 * 512 + (size_t)n0 * 512 + k0, 512, scr, C.lane);
    }
}

__device__ __forceinline__ void phase_prologue(const Ctx& C) {
    const Params& P = *C.p;
    {
        LAS float* s = (LAS float*)C.lds;
        LAS float* red = (LAS float*)(C.lds + 17 * 1024 * 4);
        bool have_s = false;
        for (int u = blockIdx.x; u < 192; u += gridDim.x) {
            if (!have_s) {
                for (int i = C.tid; i < 17 * 1024; i += NTHR) { const int ci = i >> 10, k = i & 1023; const float v = ci < 16 ? P.in[I_C][ci * D + k] : P.in[I_CCTX][k]; s[i] = silu_(v); }
                have_s = true; __syncthreads();
            }
            const int layer = u / 96, jg = u % 96, kq = C.tid >> 6, jc = C.tid & 63;
            const float* w = P.in[I_WMOD] + (size_t)layer * D * 6144 + jg * 64 + jc;
            float acc[17];
#pragma unroll
            for (int i = 0; i < 17; ++i) acc[i] = 0.f;
            for (int k = kq * 128; k < kq * 128 + 128; ++k) { const float wv = w[(size_t)k * 6144];
#pragma unroll
                for (int i = 0; i < 17; ++i) acc[i] += s[i * 1024 + k] * wv; }
#pragma unroll
            for (int i = 0; i < 17; ++i) red[(kq * 17 + i) * 64 + jc] = acc[i];
            __syncthreads();
            for (int o = C.tid; o < 17 * 64; o += NTHR) { const int ci = o >> 6, c = o & 63; float v = 0.f;
#pragma unroll
                for (int q = 0; q < 8; ++q) v += red[(q * 17 + ci) * 64 + c];
                const int j = jg * 64 + c; v += P.in[I_BMOD][layer * 6144 + j];
                ((float*)(C.ws + WS_MOD))[((size_t)(layer * 17 + ci)) * 6144 + j] = v; }
            __syncthreads();
        }
        __syncthreads();
    }
    {
        const int gt = blockIdx.x * NTHR + C.tid, ngt = gridDim.x * NTHR;
        float2* rope = (float2*)(C.ws + WS_TAB + TAB_ROPE);
        for (int i = gt; i < 64 * 16; i += ngt) { const int pos = i >> 4, f = i & 15;
            const double th = exp(-(double)f * (9.210340371976184 / 16.0)); double s, c; dsincos((double)pos * th, s, c); rope[i] = make_float2((float)c, (float)s); }
        float2* lamb = (float2*)(C.ws + WS_TAB + TAB_LAMB); float2* bbar = (float2*)(C.ws + WS_TAB + TAB_BBAR);
        for (int i = gt; i < 2 * 32 * 64; i += ngt) {
            const int dg = i >> 6;
            const double are = P.in[I_ARE][i], aim = P.in[I_AIM][i], dt = exp((double)P.in[I_LOGDT][dg]);
            double s, c; dsincos(aim * dt, s, c); const double mag = exp(are * dt), lr = mag * c, li = mag * s;
            lamb[i] = make_float2((float)lr, (float)li);
            const double den = are * are + aim * aim, nr = lr - 1.0, ni = li;
            const double cr = (nr * are + ni * aim) / den, cim = (ni * are - nr * aim) / den;
            for (int p = 0; p < 16; ++p) { const double br = P.in[I_BRE][(size_t)i * 16 + p], bi = P.in[I_BIM][(size_t)i * 16 + p];
                bbar[(size_t)i * 16 + p] = make_float2((float)(cr * br - cim * bi), (float)(cr * bi + cim * br)); }
        }
    }
    {
        const int gt = blockIdx.x * NTHR + C.tid, ngt = gridDim.x * NTHR;
        bf16* wrt = (bf16*)(C.ws + WS_TAB + TAB_WR);
        for (int idx = gt; idx < 2 * 32 * 3 * 64; idx += ngt) {
            const int ln = idx & 63, jb = (idx >> 6) % 3, kk = (idx / 192) & 31, l = idx / (192 * 32);
            const int i = ln & 15, q = ln >> 4, grp = i >> 2, r = i & 3;
            float hi8[8], lo8[8];
#pragma unroll
            for (int e = 0; e < 8; ++e) { const int k = 32 * kk + 8 * q + e;
                const float w = jb < 2 ? P.in[I_WRT][((size_t)l * D + k) * 32 + grp * 8 + jb * 4 + r] : (r == 0 ? P.in[I_WGRP][((size_t)l * D + k) * 4 + grp] : 0.f);
                const float h = bf2f(f2bf(w)); hi8[e] = h; lo8[e] = w - h; }
            v4u oh, ol; oh.x = pk2(hi8[0], hi8[1]); oh.y = pk2(hi8[2], hi8[3]); oh.z = pk2(hi8[4], hi8[5]); oh.w = pk2(hi8[6], hi8[7]);
            ol.x = pk2(lo8[0], lo8[1]); ol.y = pk2(lo8[2], lo8[3]); ol.z = pk2(lo8[4], lo8[5]); ol.w = pk2(lo8[6], lo8[7]);
            const size_t base = ((((size_t)l * 32 + kk) * 3 + jb) * 2) * 64 + ln;
            *(v4u*)(wrt + base * 8) = oh; *(v4u*)(wrt + (base + 64) * 8) = ol;
        }
    }
    {
        const int gt = blockIdx.x * NTHR + C.tid, ngt = gridDim.x * NTHR; bf16* w16 = (bf16*)(C.ws + WS_WSP);
        for (int i = gt; i < 8 * 128 * 128 / 4; i += ngt) { const f32x4 v = *(const f32x4*)(P.in[I_WSP] + 4 * (size_t)i); v2u o; o.x = pk2(v.x, v.y); o.y = pk2(v.z, v.w); *(v2u*)(w16 + 4 * (size_t)i) = o; }
    }
    {
        LAS float* scr = (LAS float*)(C.lds + C.wave * 16384);
        constexpr int I0 = 16 * 56, I1 = 16 * 32, I2 = 16 * 16, I3 = 8 * 16, I4 = 8 * 32;
        constexpr int NSMALL = I0 + I1 + I2 + I3 + I4;
        for (int it = C.gw; it < NSMALL + MOE_ITEMS; it += C.ngw) {
            int r = it;
            if (r < I0) { transpose_mat_item(P.in[I_MIXWIN], D, MIXW, (bf16*)(C.ws + WS_WIN0), r, scr, C.lane); continue; } r -= I0;
            if (r < I1) { transpose_mat_item(P.in[I_MIXWOUT], D, D, (bf16*)(C.ws + WS_WOUT0), r, scr, C.lane); continue; } r -= I1;
            if (r < I2) { transpose_mat_item(P.in[I_S5WIN], D, 512, (bf16*)(C.ws + WS_WS5IN), r, scr, C.lane); continue; } r -= I2;
            if (r < I3) { transpose_mat_item(P.in[I_WGLU], 512, 512, (bf16*)(C.ws + WS_WGLU), r, scr, C.lane); continue; } r -= I3;
            if (r < I4) { transpose_mat_item(P.in[I_S5WOUT], 512, D, (bf16*)(C.ws + WS_WS5OUT), r, scr, C.lane); continue; } r -= I4;
            moe_convert_item(C, 0, r, scr);
        }
    }
}

__device__ __forceinline__ void load_row16(const float* row, int lane, f32x4 (&v)[4]) {
#pragma unroll
    for (int j = 0; j < 4; ++j) v[j] = *(const f32x4*)(row + 4 * lane + 256 * j);
}
__device__ __forceinline__ float row_rstd(const f32x4 (&v)[4]) {
    float s = 0.f;
#pragma unroll
    for (int j = 0; j < 4; ++j) s += (v[j].x * v[j].x + v[j].y * v[j].y) + (v[j].z * v[j].z + v[j].w * v[j].w);
    return rsqrtf(wave_sum(s) * (1.f / D) + EPS);
}
__device__ __forceinline__ void modulate16(f32x4 (&v)[4], float rstd, const float* g, const float* scale, const float* shift, int lane) {
#pragma unroll
    for (int j = 0; j < 4; ++j) { const int c = 4 * lane + 256 * j; const f32x4 gg = *(const f32x4*)(g + c), sc = *(const f32x4*)(scale + c), sh = *(const f32x4*)(shift + c);
        v[j] = v[j] * rstd * gg * (sc + 1.f) + sh; }
}
__device__ __forceinline__ void store_row16_bf16(bf16* row, int lane, const f32x4 (&v)[4]) {
#pragma unroll
    for (int j = 0; j < 4; ++j) { v2u o; o.x = pk2(v[j].x, v[j].y); o.y = pk2(v[j].z, v[j].w); *(v2u*)(row + 4 * lane + 256 * j) = o; }
}

__device__ __forceinline__ void phase_norm_mix0(const Ctx& C) {
    const Params& P = *C.p; bf16* H = (bf16*)(C.ws + WS_H);
    for (int r = C.gw; r < TT; r += C.ngw) {
        f32x4 v[4]; load_row16(xin_row(P, r), C.lane, v);
        const float rstd = row_rstd(v); const int ci = cond_of(r);
        modulate16(v, rstd, P.in[I_GMIX], mod_vec(C, 0, ci, 1), mod_vec(C, 0, ci, 0), C.lane);
        store_row16_bf16(H + (size_t)r * D, C.lane, v);
    }
}

__device__ __forceinline__ void qk_norm_rope(float (&v)[8], const float* gain, bool lat, int t, int lane, const float2* rope) {
    float ss = 0.f;
#pragma unroll
    for (int j = 0; j < 8; ++j) ss += v[j] * v[j];
    ss += __shfl_xor(ss, 1); ss += __shfl_xor(ss, 2); ss += __shfl_xor(ss, 4);
    const float rstd = rsqrtf(ss * (1.f / 64.f) + EPS);
    const int l8 = lane & 7;
#pragma unroll
    for (int j = 0; j < 8; ++j) v[j] = v[j] * rstd * gain[l8 * 8 + j];
    const int quarter = l8 >> 1, pos = (quarter < 2) ? (t >> 6) : (t & 63);
#pragma unroll
    for (int j = 0; j < 8; ++j) {
        const float pv = __shfl_xor(v[j], 2);
        if (lat) { const float2 cs = rope[pos * 16 + (lane & 1) * 8 + j];
            v[j] = (quarter & 1) ? (v[j] * cs.x + pv * cs.y) : (v[j] * cs.x - pv * cs.y); }
    }
}
__device__ __forceinline__ void phase_qkprep(const Ctx& C) {
    const Params& P = *C.p; const bf16* Pb = (const bf16*)(C.ws + WS_P); bf16* Q = (bf16*)(C.ws + WS_Q); bf16* Kb = (bf16*)(C.ws + WS_K); bf16* Vb = (bf16*)(C.ws + WS_V);
    const float2* rope = (const float2*)(C.ws + WS_TAB + TAB_ROPE);
    for (int r = C.gw; r < TT; r += C.ngw) {
        const bool lat = r < TL; const int t = lat ? (r & 2047) : 0;
        const size_t kvrow = lat ? (size_t)(r >> 11) * KVL + CTXL + (r & 2047) : (size_t)((r - TL) >> 8) * KVL + ((r - TL) & 255);
        const bf16* pr = Pb + (size_t)r * MIXW;
        { float v[8]; unpack8(*(const v4u*)(pr + 8 * C.lane), v); qk_norm_rope(v, P.in[I_QG], lat, t, C.lane, rope);
          v4u o; o.x = pk2(v[0] * QSCALE, v[1] * QSCALE); o.y = pk2(v[2] * QSCALE, v[3] * QSCALE); o.z = pk2(v[4] * QSCALE, v[5] * QSCALE); o.w = pk2(v[6] * QSCALE, v[7] * QSCALE);
          *(v4u*)(Q + (size_t)r * 512 + 8 * C.lane) = o; }
        { const int l = C.lane & 15; float v[8]; unpack8(*(const v4u*)(pr + 512 + 8 * l), v); qk_norm_rope(v, P.in[I_KG], lat, t, C.lane, rope);
          if (C.lane < 16) { v4u o; o.x = pk2(v[0], v[1]); o.y = pk2(v[2], v[3]); o.z = pk2(v[4], v[5]); o.w = pk2(v[6], v[7]); *(v4u*)(Kb + kvrow * 128 + 8 * l) = o;
              *(v4u*)(Vb + kvrow * 128 + 8 * l) = *(const v4u*)(pr + 640 + 8 * l); } }
        { float v[8]; unpack8(*(const v4u*)(pr + 1280 + 8 * C.lane), v); float sm = 0.f;
#pragma unroll
          for (int j = 0; j < 8; ++j) { v[j] = gelu_tanh(v[j]); sm += v[j]; }
          const float mean = wave_sum(sm) * (1.f / 512.f); float qq = 0.f;
#pragma unroll
          for (int j = 0; j < 8; ++j) { const float d = v[j] - mean; qq += d * d; }
          const float rstd = rsqrtf(wave_sum(qq) * (1.f / 512.f) + EPS);
          if (C.lane == 0) ((float2*)(C.ws + WS_ROUTE + RT_S))[r] = make_float2(mean, rstd); }
    }
}

__device__ __forceinline__ unsigned gm_off_b(unsigned row, unsigned ch) { return 256u * row + 16u * (ch ^ (((row & 3u) << 2) | ((row >> 2) & 3u))); }
__device__ __forceinline__ void phase_gmlp_fast(const Ctx& C) {
    typedef short bf16x8 __attribute__((ext_vector_type(8)));
    typedef short s16x4 __attribute__((ext_vector_type(4)));
    typedef float f32x16 __attribute__((ext_vector_type(16)));
    const Params& P = *C.p; const bf16* Pb = (const bf16*)(C.ws + WS_P); bf16* OG = (bf16*)(C.ws + WS_H); const bf16* W16 = (const bf16*)(C.ws + WS_WSP);
    const float2* lns = (const float2*)(C.ws + WS_ROUTE + RT_S);
    const int tid = C.tid, lane = C.lane, w = C.wave, l31 = lane & 31, hi = lane >> 5;
    const int gsel = w >> 2, pb = w & 3;
    for (int u = blockIdx.x; u < (TT / 128) * 4; u += gridDim.x) {
        const int ch_ = u >> 2, gp = u & 3;
        { const int row = tid >> 2; const size_t grow = (size_t)ch_ * 128 + row; const float2 st = lns[grow];
#pragma unroll
          for (int i = 0; i < 4; ++i) { const int c16 = (tid & 3) + 4 * i; float v[8]; unpack8(*(const v4u*)(Pb + grow * MIXW + 1280 + 128 * gp + 8 * c16), v);
              const float* lg = P.in[I_LNG] + 128 * gp + 8 * c16;
#pragma unroll
              for (int j = 0; j < 8; ++j) v[j] = (gelu_tanh(v[j]) - st.x) * st.y * lg[j];
              v4u o; o.x = pk2(v[0], v[1]); o.y = pk2(v[2], v[3]); o.z = pk2(v[4], v[5]); o.w = pk2(v[6], v[7]);
              *(LAS v4u*)(C.lds + (row >> 5) * 8192 + gm_off_b(row & 31, c16)) = o; } }
        __syncthreads();
        const int g = 2 * gp + gsel;
        f32x16 acc[2]; acc[0] = f32x16{}; acc[1] = f32x16{};
        const bf16* wrow = W16 + ((size_t)g * 128 + 32 * pb + l31) * 128 + 8 * hi;
#pragma unroll
        for (int k8 = 0; k8 < 8; ++k8) {
            const bf16x8 xf = *(const bf16x8*)(wrow + 16 * k8);
            const unsigned rb = k8 >> 1, ks = k8 & 1;
#pragma unroll
            for (int db = 0; db < 2; ++db) { const unsigned c = 2 * gsel + db, blk = (lane >> 4) & 1, q = (lane & 15) >> 2, p2 = lane & 3;
                s16x4 t0, t1;
                { const unsigned a0 = rb * 8192 + gm_off_b(16 * ks + 8 * hi + q, 4 * c + 2 * blk + (p2 >> 1)) + 8 * (p2 & 1);
                  const unsigned a1 = rb * 8192 + gm_off_b(16 * ks + 8 * hi + 4 + q, 4 * c + 2 * blk + (p2 >> 1)) + 8 * (p2 & 1);
                  t0 = __builtin_bit_cast(s16x4, __builtin_amdgcn_ds_read_tr16_b64_v4i16((LAS s16x4*)(C.lds + a0)));
                  t1 = __builtin_bit_cast(s16x4, __builtin_amdgcn_ds_read_tr16_b64_v4i16((LAS s16x4*)(C.lds + a1))); }
                const bf16x8 yf = {t0[0], t0[1], t0[2], t0[3], t1[0], t1[1], t1[2], t1[3]};
                acc[db] = __builtin_amdgcn_mfma_f32_32x32x16_bf16(xf, yf, acc[db], 0, 0, 0); }
        }
        const float* bsp = P.in[I_BSP] + g * 128 + 32 * pb;
#pragma unroll
        for (int r = 0; r < 16; ++r) { const int pl = (r & 3) + 8 * (r >> 2) + 4 * hi; const size_t grow = (size_t)ch_ * 128 + 32 * pb + pl; const float bb = bsp[pl];
#pragma unroll
            for (int db = 0; db < 2; ++db) { const int col = 64 * g + 32 * db + l31; const float uu = gelu_tanh(bf2f(Pb[grow * MIXW + 768 + col]));
                OG[grow * D + 512 + col] = (bf16)f2bf(uu * (acc[db][r] + bb)); } }
        __syncthreads();
    }
}

__device__ __forceinline__ void phase_attn_fast(const Ctx& C, char* lds_generic) {
    typedef attn_body::bf16 abf;
    const abf* Q = (const abf*)(C.ws + WS_Q); const abf* Kb = (const abf*)(C.ws + WS_K); const abf* Vb = (const abf*)(C.ws + WS_V); abf* OG = (abf*)(C.ws + WS_H);
    const int G = gridDim.x, bx = blockIdx.x; const int vcu = (G % 8 == 0) ? (bx % 8) * (G / 8) + bx / 8 : bx;
    const int per = (1024 + G - 1) / G, perc = (128 + G - 1) / G;
    for (int i = 0; i < per + perc; ++i) {
        int b, h, nt; size_t qrow;
        if (i < per) { const int u = vcu * per + i; if (u >= 1024) continue; const int qb = u & 7, hg = (u >> 3) & 3, bk = u >> 5; b = bk >> 1; h = (bk & 1) * 4 + hg; qrow = (size_t)b * SEQ + qb * 256; nt = KVL / 64; }
        else { const int u = vcu + (i - per) * G; if (u >= 128) continue; b = u >> 3; h = u & 7; qrow = (size_t)TL + (size_t)b * CTXL; nt = CTXL / 64; }
        const size_t kvo = (size_t)b * KVL * 128 + (h >> 2) * 64;
        attn_body::attn_unit<8>(Q + qrow * 512 + h * 64, Kb + kvo, Vb + kvo, OG + qrow * 1024 + h * 64, nt, lds_generic);
    }
}

__device__ __forceinline__ void phase_router_fast(const Ctx& C, int layer, int nrows) {
    typedef short bf16x8 __attribute__((ext_vector_type(8)));
    const Params& P = *C.p; const bf16* XC = (const bf16*)(C.ws + WS_XC); bf16* F = (bf16*)(C.ws + WS_H);
    int* asg_e = (int*)(C.ws + WS_ROUTE + RT_E); int* asg_p = (int*)(C.ws + WS_ROUTE + RT_P); float* asg_w = (float*)(C.ws + WS_ROUTE + RT_W); int* list = (int*)(C.ws + WS_LIST);
    unsigned* cnt = (unsigned*)(C.ws + WS_CTL) + CW_CNT + 64 * layer;
    const bf16x8* WR = (const bf16x8*)(C.ws + WS_TAB + TAB_WR) + (size_t)layer * (32 * 3 * 2 * 64) + C.lane;
    const int l15 = C.lane & 15, q4 = C.lane >> 4;
    LAS float* ab = (LAS float*)(C.lds + C.wave * 8192);
    LAS unsigned* lcnt = (LAS unsigned*)(C.lds + 65536);
    if (C.tid < 64) lcnt[C.tid] = 0u;
    __syncthreads();
    int cur_ci = -1;
    for (int it = C.gw; it < nrows / 16; it += C.ngw) {
        const int row = it * 16 + l15, ci = cond_of(it * 16);
        if (ci != cur_ci) {
            const float* sc = mod_vec(C, layer, ci, 4); const float* sh = mod_vec(C, layer, ci, 3); const float* g0 = P.in[I_GFFN] + layer * D;
#pragma unroll
            for (int j = 0; j < 4; ++j) { const int c = 4 * C.lane + 256 * j; const f32x4 g4 = *(const f32x4*)(g0 + c), s4 = *(const f32x4*)(sc + c), h4 = *(const f32x4*)(sh + c); const f32x4 a4 = g4 * (s4 + 1.f);
                *(LAS f32x4*)(ab + 2 * c) = (f32x4){a4.x, h4.x, a4.y, h4.y}; *(LAS f32x4*)(ab + 2 * c + 4) = (f32x4){a4.z, h4.z, a4.w, h4.w}; }
            asm volatile("s_waitcnt lgkmcnt(0)" ::: "memory"); cur_ci = ci;
        }
        const bf16* xr = XC + (size_t)row * D + 8 * q4;
        float ss = 0.f;
#pragma unroll 16
        for (int kk = 0; kk < 32; ++kk) { pg8::f32x4 a, b; pg8::unpack8f(*(const pg8::u32x4*)(xr + 32 * kk), a, b); ss += (a.x * a.x + a.y * a.y) + (a.z * a.z + a.w * a.w) + (b.x * b.x + b.y * b.y) + (b.z * b.z + b.w * b.w); }
        ss += __shfl_xor(ss, 16); ss += __shfl_xor(ss, 32);
        const float rstd = rsqrtf(ss * (1.f / D) + EPS);
        f32x4 acc[3]; acc[0] = (f32x4){0.f, 0.f, 0.f, 0.f}; acc[1] = acc[0]; acc[2] = acc[0];
        bf16* frow = F + (size_t)row * D + 8 * q4;
        const LAS float* abl = ab + 16 * q4;
#pragma unroll 1
        for (int k2 = 0; k2 < 16; ++k2) {
            const pg8::u32x4 xa = *(const pg8::u32x4*)(xr + 64 * k2), xb = *(const pg8::u32x4*)(xr + 64 * k2 + 32);
            bf16x8 wf[2][3][2];
#pragma unroll
            for (int h = 0; h < 2; ++h)
#pragma unroll
                for (int jb = 0; jb < 3; ++jb) { wf[h][jb][0] = WR[(((2 * k2 + h) * 3 + jb) * 2) * 64]; wf[h][jb][1] = WR[(((2 * k2 + h) * 3 + jb) * 2 + 1) * 64]; }
#pragma unroll
            for (int h = 0; h < 2; ++h) {
                const int c = 64 * k2 + 32 * h;
                pg8::f32x4 x0, x1; pg8::unpack8f(h ? xb : xa, x0, x1);
                const f32x4 t0 = *(const LAS f32x4*)(abl + 2 * c), t1 = *(const LAS f32x4*)(abl + 2 * c + 4), t2 = *(const LAS f32x4*)(abl + 2 * c + 8), t3 = *(const LAS f32x4*)(abl + 2 * c + 12);
                const f32x4 f0 = x0 * rstd * (f32x4){t0.x, t0.z, t1.x, t1.z} + (f32x4){t0.y, t0.w, t1.y, t1.w};
                const f32x4 f1 = x1 * rstd * (f32x4){t2.x, t2.z, t3.x, t3.z} + (f32x4){t2.y, t2.w, t3.y, t3.w};
                const pg8::u32x4 fh = pg8::pack8(f0, f1); *(pg8::u32x4*)(frow + c) = fh;
                pg8::f32x4 r0, r1; pg8::unpack8f(fh, r0, r1);
                const pg8::u32x4 fl = pg8::pack8(f0 - r0, f1 - r1);
                const bf16x8 ah = __builtin_bit_cast(bf16x8, fh), al = __builtin_bit_cast(bf16x8, fl);
#pragma unroll
                for (int jb = 0; jb < 3; ++jb) {
                    acc[jb] = __builtin_amdgcn_mfma_f32_16x16x32_bf16(wf[h][jb][0], ah, acc[jb], 0, 0, 0);
                    acc[jb] = __builtin_amdgcn_mfma_f32_16x16x32_bf16(wf[h][jb][0], al, acc[jb], 0, 0, 0);
                    acc[jb] = __builtin_amdgcn_mfma_f32_16x16x32_bf16(wf[h][jb][1], ah, acc[jb], 0, 0, 0); }
            }
        }
        const float* brt = P.in[I_BRT] + layer * 32 + q4 * 8;
        float e[8];
#pragma unroll
        for (int r = 0; r < 4; ++r) { e[r] = acc[0][r] + brt[r]; e[4 + r] = acc[1][r] + brt[4 + r]; }
        const float gl = acc[2][0] + P.in[I_BGRP][layer * 4 + q4];
        float gm = gl; int gi = q4;
#pragma unroll
        for (int st = 16; st <= 32; st <<= 1) { const float og = __shfl_xor(gm, st); const int oi = __shfl_xor(gi, st); if (og > gm || (og == gm && oi < gi)) { gm = og; gi = oi; } }
        float den = __expf(gl - gm); den += __shfl_xor(den, 16); den += __shfl_xor(den, 32);
        if (q4 == gi) {
            const float gw_ = 1.f / den;
            int i0 = 0; float v0 = e[0];
#pragma unroll
            for (int i = 1; i < 8; ++i) if (e[i] > v0) { v0 = e[i]; i0 = i; }
            int i1 = -1; float v1 = -INFINITY;
#pragma unroll
            for (int i = 0; i < 8; ++i) if (i != i0 && e[i] > v1) { v1 = e[i]; i1 = i; }
            const float e1 = __expf(v1 - v0), w0 = gw_ / (1.f + e1), w1 = gw_ * e1 / (1.f + e1);
            const int ea = gi * 8 + i0, eb = gi * 8 + i1;
            const unsigned pa = __hip_atomic_fetch_add(lcnt + ea, 1u, __ATOMIC_RELAXED, __HIP_MEMORY_SCOPE_WORKGROUP);
            const unsigned pb = __hip_atomic_fetch_add(lcnt + eb, 1u, __ATOMIC_RELAXED, __HIP_MEMORY_SCOPE_WORKGROUP);
            asg_e[2 * row] = ea; asg_e[2 * row + 1] = eb; asg_p[2 * row] = (int)pa; asg_p[2 * row + 1] = (int)pb; asg_w[2 * row] = w0; asg_w[2 * row + 1] = w1;
        }
    }
    asm volatile("s_waitcnt vmcnt(0) lgkmcnt(0)" ::: "memory");
    __syncthreads();
    if (C.tid < 32) { const unsigned n = lcnt[C.tid]; lcnt[32 + C.tid] = n ? __hip_atomic_fetch_add(cnt + C.tid, n, __ATOMIC_RELAXED, __HIP_MEMORY_SCOPE_AGENT) : 0u; }
    __syncthreads();
    for (int it = C.gw; it < nrows / 16; it += C.ngw) {
        if (C.lane < 32) { const int idx = 2 * (it * 16 + (C.lane & 15)) + (C.lane >> 4);
            const int e = __hip_atomic_load(asg_e + idx, __ATOMIC_RELAXED, __HIP_MEMORY_SCOPE_AGENT); const int p = __hip_atomic_load(asg_p + idx, __ATOMIC_RELAXED, __HIP_MEMORY_SCOPE_AGENT) + (int)lcnt[32 + e];
            asg_p[idx] = p; list[(size_t)e * LCAP + p] = idx >> 1; }
    }
}

__device__ __forceinline__ int wave_pstart(const Ctx& C, int layer) {
    const unsigned* cnt = (const unsigned*)(C.ws + WS_CTL) + CW_CNT + 64 * layer;
    const int mc = C.lane < 32 ? (int)__hip_atomic_load(cnt + (C.lane & 31), __ATOMIC_RELAXED, __HIP_MEMORY_SCOPE_AGENT) : 0; const int mp = (mc + 255) & ~255; int in = mp;
#pragma unroll
    for (int o = 1; o < 32; o <<= 1) { const int t = __shfl_up(in, o); if ((C.lane & 31) >= o) in += t; }
    return in - mp;
}
__device__ __forceinline__ void moe_combine(const Ctx& C, int layer, int r, int ps, f32x4 (&v)[4]) {
    const bf16* Y2 = (const bf16*)(C.ws + WS_XS); const int* asg_s = (const int*)(C.ws + WS_ROUTE + RT_S); const float* asg_w = (const float*)(C.ws + WS_ROUTE + RT_W);
    const bf16* XC = (const bf16*)(C.ws + WS_XC);
#pragma unroll
    for (int j = 0; j < 4; ++j) { const v2u xx = *(const v2u*)(XC + (size_t)r * D + 4 * C.lane + 256 * j); v[j] = (f32x4){bf2f(xx.x & 0xffffu), bf2f(xx.x >> 16), bf2f(xx.y & 0xffffu), bf2f(xx.y >> 16)}; }
    const int* asg_e = (const int*)(C.ws + WS_ROUTE + RT_E); const int* asg_p = (const int*)(C.ws + WS_ROUTE + RT_P); (void)asg_s;
    const int s0 = __shfl(ps, asg_e[2 * r]) + asg_p[2 * r], s1 = __shfl(ps, asg_e[2 * r + 1]) + asg_p[2 * r + 1]; const float w0 = asg_w[2 * r], w1 = asg_w[2 * r + 1];
    const float* gate = mod_vec(C, layer, cond_of(r), 5);
#pragma unroll
    for (int j = 0; j < 4; ++j) { const int c = 4 * C.lane + 256 * j; const v2u a = *(const v2u*)(Y2 + (size_t)s0 * D + c), b = *(const v2u*)(Y2 + (size_t)s1 * D + c); const f32x4 g = *(const f32x4*)(gate + c);
        v[j].x += g.x * (w0 * bf2f(a.x & 0xffffu) + w1 * bf2f(b.x & 0xffffu)); v[j].y += g.y * (w0 * bf2f(a.x >> 16) + w1 * bf2f(b.x >> 16));
        v[j].z += g.z * (w0 * bf2f(a.y & 0xffffu) + w1 * bf2f(b.y & 0xffffu)); v[j].w += g.w * (w0 * bf2f(a.y >> 16) + w1 * bf2f(b.y >> 16)); }
}
__device__ __forceinline__ void phase_combine_norm_mix1(const Ctx& C) {
    const Params& P = *C.p; bf16* XC = (bf16*)(C.ws + WS_XC); bf16* H = (bf16*)(C.ws + WS_H);
    const int ps = wave_pstart(C, 0);
    for (int r = C.gw; r < TT; r += C.ngw) {
        f32x4 v[4]; moe_combine(C, 0, r, ps, v);
        store_row16_bf16(XC + (size_t)r * D, C.lane, v);
        const float rstd = row_rstd(v); const int ci = cond_of(r);
        modulate16(v, rstd, P.in[I_GMIX] + D, mod_vec(C, 1, ci, 1), mod_vec(C, 1, ci, 0), C.lane);
        store_row16_bf16(H + (size_t)r * D, C.lane, v);
    }
    LAS float* scr = (LAS float*)(C.lds + C.wave * 16384);
    for (int it = C.gw; it < MOE_ITEMS; it += C.ngw) moe_convert_item(C, 1, it, scr);
}
__device__ __forceinline__ void phase_final(const Ctx& C) {
    const Params& P = *C.p;
    const int ps = wave_pstart(C, 1);
    for (int r = C.gw; r < TL; r += C.ngw) {
        f32x4 v[4]; moe_combine(C, 1, r, ps, v);
        const float rstd = row_rstd(v);
#pragma unroll
        for (int j = 0; j < 4; ++j) { const int c = 4 * C.lane + 256 * j; const f32x4 g = *(const f32x4*)(P.in[I_FING] + c); *(f32x4*)(P.out + (size_t)r * D + c) = v[j] * rstd * g; }
    }
}

__device__ __forceinline__ void phase_s5_fast(const Ctx& C) {
    typedef short bf16x8 __attribute__((ext_vector_type(8)));
    typedef float f32x16 __attribute__((ext_vector_type(16)));
    const Params& P = *C.p; const bf16* U = (const bf16*)(C.ws + WS_U); bf16* GS = (bf16*)(C.ws + WS_GS); float* YA = (float*)(C.ws + WS_YACC);
    const float2* lamb = (const float2*)(C.ws + WS_TAB + TAB_LAMB); const float2* bbar = (const float2*)(C.ws + WS_TAB + TAB_BBAR);
    constexpr int HP = 272;
    const int lane = C.lane, w = C.wave, il = w >> 2, dir = (w >> 1) & 1, nh = w & 1;
    const int l31 = lane & 31, hi = lane >> 5, l15 = lane & 15, q4 = lane >> 4;
    LAS unsigned char* Hb = C.lds + (il * 2 + dir) * (2 * 32 * HP);
    const int srow = (l31 & 3) + 4 * (l31 >> 3) + 16 * ((l31 >> 2) & 1);
    for (int it0 = blockIdx.x; it0 < NB * 16; it0 += gridDim.x) {
        const int item = it0 * 2 + il, b = item >> 5, g = item & 31;
        const int dg = dir * 32 + g, n = nh * 32 + l31;
        const float2 lam = lamb[dg * 64 + n];
        float lpr[16], lpi[16]; { float pr = lam.x, pi = lam.y;
#pragma unroll
            for (int r = 0; r < 16; ++r) { lpr[r] = pr; lpi[r] = pi; const float nr = pr * lam.x - pi * lam.y, ni = pr * lam.y + pi * lam.x; pr = nr; pi = ni; } }
        bf16x8 bre, bim; { const float2* bp = bbar + ((size_t)(dg * 64 + n)) * 16 + 8 * hi;
#pragma unroll
            for (int e = 0; e < 8; ++e) { const float2 v = bp[e]; bre[e] = (short)f2bf(v.x); bim[e] = (short)f2bf(v.y); } }
        bf16x8 cf[4]; { const float* cre = P.in[I_CRE] + ((size_t)dg * 16 + l15) * 64; const float* cim = P.in[I_CIM] + ((size_t)dg * 16 + l15) * 64;
#pragma unroll
            for (int ks = 0; ks < 4; ++ks) { const f32x4 a = *(const f32x4*)(cre + 16 * ks + 4 * q4), m = *(const f32x4*)(cim + 16 * ks + 4 * q4);
                cf[ks][0] = (short)f2bf(a.x); cf[ks][1] = (short)f2bf(-m.x); cf[ks][2] = (short)f2bf(a.y); cf[ks][3] = (short)f2bf(-m.y);
                cf[ks][4] = (short)f2bf(a.z); cf[ks][5] = (short)f2bf(-m.z); cf[ks][6] = (short)f2bf(a.w); cf[ks][7] = (short)f2bf(-m.w); } }
        const f32x4 dsk = *(const f32x4*)(P.in[I_S5D] + g * 16 + 4 * q4);
        float cr = 0.f, ci = 0.f;
#define S5_UROW(kk) ({ const int S_ = 32 * (kk) + srow; (S_ < CTXL) ? ((size_t)TL + (size_t)b * CTXL + (dir == 0 ? S_ : CTXL - 1 - S_)) : ((size_t)b * SEQ + (dir == 0 ? S_ - CTXL : SEQ - 1 - (S_ - CTXL))); })
        bf16x8 ua_next = *(const bf16x8*)(U + S5_UROW(0) * 512 + g * 16 + 8 * hi);
        for (int k = 0; k < 72; ++k) {
            const bf16x8 ua = ua_next;
            if (k + 1 < 72) ua_next = *(const bf16x8*)(U + S5_UROW(k + 1) * 512 + g * 16 + 8 * hi);
            const int sl = 32 * (k - 8) + 16 * nh + l15;
            const int tok = dir == 0 ? sl : SEQ - 1 - sl; const int lt = tok >> 5;
            const size_t o = ((size_t)b * SEQ + (k >= 8 ? tok : 0)) * 512 + g * 16 + 4 * q4;
            const bool first = dir == 0 ? (lt < 32) : (lt >= 32);
            f32x4 pk = {0.f, 0.f, 0.f, 0.f}; v2u uu = {0u, 0u};
            if (k >= 8 && !first) {
                pk.x = __hip_atomic_load(YA + o, __ATOMIC_RELAXED, __HIP_MEMORY_SCOPE_AGENT); pk.y = __hip_atomic_load(YA + o + 1, __ATOMIC_RELAXED, __HIP_MEMORY_SCOPE_AGENT);
                pk.z = __hip_atomic_load(YA + o + 2, __ATOMIC_RELAXED, __HIP_MEMORY_SCOPE_AGENT); pk.w = __hip_atomic_load(YA + o + 3, __ATOMIC_RELAXED, __HIP_MEMORY_SCOPE_AGENT);
                uu = *(const v2u*)(U + o);
            }
            {
              f32x16 br = {}, bi = {};
              br = __builtin_amdgcn_mfma_f32_32x32x16_bf16(ua, bre, br, 0, 0, 0);
              bi = __builtin_amdgcn_mfma_f32_32x32x16_bf16(ua, bim, bi, 0, 0, 0);
              float sr = hi ? 0.f : cr, si = hi ? 0.f : ci;
#pragma unroll
              for (int r = 0; r < 16; ++r) { const float nr = lam.x * sr - lam.y * si + br[r], ni = lam.x * si + lam.y * sr + bi[r]; sr = nr; si = ni; br[r] = sr; bi[r] = si; }
              float er = __shfl_xor(sr, 32), ei = __shfl_xor(si, 32); if (!hi) { er = 0.f; ei = 0.f; }
              { const f32x2 er2 = {er, er}, ei2 = {ei, ei};
#pragma unroll
              for (int r = 0; r < 16; r += 2) { const f32x2 pr2 = {lpr[r], lpr[r + 1]}, pi2 = {lpi[r], lpi[r + 1]}; f32x2 b2 = {br[r], br[r + 1]}, i2 = {bi[r], bi[r + 1]};
                  b2 = b2 + pr2 * er2 - pi2 * ei2; i2 = i2 + pr2 * ei2 + pi2 * er2; br[r] = b2.x; br[r + 1] = b2.y; bi[r] = i2.x; bi[r + 1] = i2.y; } }
              cr = __shfl_xor(br[15], 32); ci = __shfl_xor(bi[15], 32);
              LAS unsigned char* hb = Hb + (k & 1) * (32 * HP) + (16 * hi) * HP + 4 * n;
#pragma unroll
              for (int r = 0; r < 16; ++r) *(LAS unsigned*)(hb + r * HP) = pk2(br[r], bi[r]);
            }
            asm volatile("s_waitcnt lgkmcnt(0)\n\ts_barrier" ::: "memory");
            if (k >= 8) {
                const LAS unsigned char* hr = Hb + (k & 1) * (32 * HP) + (16 * nh + l15) * HP + 16 * q4;
                f32x4 y = {0.f, 0.f, 0.f, 0.f};
#pragma unroll
                for (int ks = 0; ks < 4; ++ks) { const bf16x8 hf = *(const LAS bf16x8*)(hr + 64 * ks); y = __builtin_amdgcn_mfma_f32_16x16x32_bf16(cf[ks], hf, y, 0, 0, 0); }
                if (first) { *(f32x4*)(YA + o) = y; }
                else {
                    const f32x4 uf = {bf2f(uu.x & 0xffffu), bf2f(uu.x >> 16), bf2f(uu.y & 0xffffu), bf2f(uu.y >> 16)};
                    const f32x4 t = y + pk + dsk * uf;
                    v2u ov; ov.x = pk2(gelu_tanh(t.x), gelu_tanh(t.y)); ov.y = pk2(gelu_tanh(t.z), gelu_tanh(t.w)); *(v2u*)(GS + o) = ov;
                }
            }
            if (k == 39) asm volatile("s_waitcnt vmcnt(0)\n\ts_barrier" ::: "memory");
        }
#undef S5_UROW
        asm volatile("s_waitcnt vmcnt(0) lgkmcnt(0)\n\ts_barrier" ::: "memory");
    }
}

__global__ void __launch_bounds__(NTHR, 2) fwd_kernel(Params prm) {
    extern __shared__ __attribute__((aligned(16))) unsigned char lds_raw[];
    Ctx C; C.p = &prm; C.ws = prm.ws; C.lds = (LAS unsigned char*)lds_raw;
    C.tid = threadIdx.x; C.lane = C.tid & 63; C.wave = __builtin_amdgcn_readfirstlane(C.tid >> 6);
    C.gw = blockIdx.x * NWAVE + C.wave; C.ngw = gridDim.x * NWAVE;
    constexpr int LDS_MISC = 147456 - 512;
    volatile LAS unsigned* misc = (volatile LAS unsigned*)(C.lds + LDS_MISC);
    if (C.tid < 64) misc[C.tid] = 0u;
    __syncthreads();
    unsigned* ctl = (unsigned*)(C.ws + WS_CTL);
    XcdBarrier bar; bar.bar = ctl + CW_BAR; bar.x = 0; bar.st = nullptr;
#if MK_ONE_LAUNCH
    bar = xcd_barrier_post(ctl + CW_BAR, misc + 8);
#define SEAM(k) do { if (lo <= (k) && (k) + 1 < hi) xcd_barrier(bar); } while (0)
#else
#define SEAM(k) do { } while (0)
#endif
    const int lo = prm.ph_lo, hi = prm.ph_hi;
#define IN(k) (lo <= (k) && (k) < hi)
#if MK_PROBE
    volatile LAS unsigned long long* ts_ = (volatile LAS unsigned long long*)(C.lds + LDS_MISC + 64);
#define STAMP(k) do { if (blockIdx.x == 0 && C.tid == 0) ts_[(k) + 1] = __builtin_amdgcn_s_memrealtime(); } while (0)
    if (blockIdx.x == 0 && C.tid == 0) ts_[0] = __builtin_amdgcn_s_memrealtime();
#else
#define STAMP(k) do { } while (0)
#endif
    const Params& P = prm;
    bf16* Hb = (bf16*)(C.ws + WS_H); bf16* XC = (bf16*)(C.ws + WS_XC);
#define MOE_MAP(layer) do { LAS int* tm_ = (LAS int*)(C.lds + 131072); LAS int* cl_ = tm_ + 320; \
        if (C.wave == 0) { const unsigned* cnt_ = (const unsigned*)(C.ws + WS_CTL) + CW_CNT + 64 * (layer); const int mc_ = C.lane < 32 ? (int)__hip_atomic_load(cnt_ + (C.lane & 31), __ATOMIC_RELAXED, __HIP_MEMORY_SCOPE_AGENT) : 0; const int mp_ = (mc_ + 255) & ~255; int in_ = mp_; \
            _Pragma("unroll") for (int o_ = 1; o_ < 32; o_ <<= 1) { const int t_ = __shfl_up(in_, o_); if ((C.lane & 31) >= o_) in_ += t_; } const int ps_ = in_ - mp_; \
            if (C.lane < 32) { for (int t_ = ps_ / 256; t_ < (ps_ + mp_) / 256; ++t_) tm_[t_] = C.lane | ((t_ * 256 - ps_) << 8); cl_[C.lane] = mc_; if (C.lane == 31) cl_[32] = (ps_ + mp_) / 256; } } \
        __syncthreads(); } while (0)
#define MOE_GEMM1(layer) do { MOE_MAP(layer); const LAS int* tm_ = (const LAS int*)(C.lds + 131072); const int ntl_ = __builtin_amdgcn_readfirstlane(tm_[320 + 32]); pg8::Gemm g{Hb, (const bf16*)(C.ws + WS_W13), 0, 1024, D}; \
        pg8::GroupedOrder<true> S{tm_, tm_ + 320, (const int*)(C.ws + WS_LIST), ntl_ * 4, 4, (int)gridDim.x, (int)blockIdx.x, LCAP, D * 2, (size_t)1024 * 1024 * 2}; pg8::EpiSwiglu E{(bf16*)(C.ws + WS_G13)}; \
        pg8::gemm_phase<pg8::EpiSwiglu, pg8::GroupedOrder<true>, true, true>(C.lds, g, S, E); } while (0)
#define MOE_GEMM2(layer) do { MOE_MAP(layer); const LAS int* tm_ = (const LAS int*)(C.lds + 131072); const int ntl_ = __builtin_amdgcn_readfirstlane(tm_[320 + 32]); pg8::Gemm g{(const bf16*)(C.ws + WS_G13), (const bf16*)(C.ws + WS_W2), 0, 1024, EH}; \
        pg8::GroupedOrder<false> S{tm_, tm_ + 320, (const int*)(C.ws + WS_LIST), ntl_ * 4, 4, (int)gridDim.x, (int)blockIdx.x, LCAP, EH * 2, (size_t)1024 * 512 * 2}; pg8::EpiStore E{(bf16*)(C.ws + WS_XS), D}; \
        pg8::gemm_phase<pg8::EpiStore, pg8::GroupedOrder<false>, true, true>(C.lds, g, S, E); } while (0)
    if (IN(0)) { phase_prologue(C); SEAM(0); STAMP(0); }
    if (IN(1)) { phase_norm_mix0(C); SEAM(1); STAMP(1); }
    if (IN(2)) { pg8::Gemm g{Hb, (const bf16*)(C.ws + WS_WIN0), TT, MIXW, D}; pg8::StaticOrder S; S.init(TT, MIXW, gridDim.x, blockIdx.x); pg8::EpiStore E{(bf16*)(C.ws + WS_P), MIXW};
        pg8::gemm_phase<pg8::EpiStore, pg8::StaticOrder, true, true, true>(C.lds, g, S, E); SEAM(2); STAMP(2); }
    if (IN(3)) { phase_qkprep(C); SEAM(3); STAMP(3); }
    if (IN(4)) { phase_gmlp_fast(C); phase_attn_fast(C, (char*)lds_raw); SEAM(4); STAMP(4); }
    if (IN(5)) { pg8::Gemm g{Hb, (const bf16*)(C.ws + WS_WOUT0), TT, D, D}; pg8::StaticOrder S; S.init(TT, D, gridDim.x, blockIdx.x); pg8::EpiResid E{P.in[I_X], P.in[I_CTX], (const float*)(C.ws + WS_MOD), XC, 0};
        pg8::gemm_phase<pg8::EpiResid, pg8::StaticOrder, true, true, true>(C.lds, g, S, E); SEAM(5); STAMP(5); }
    if (IN(6)) { phase_router_fast(C, 0, TT); SEAM(6); STAMP(6); }
    if (IN(8)) { MOE_GEMM1(0); SEAM(8); STAMP(8); }
    if (IN(9)) { MOE_GEMM2(0); SEAM(9); STAMP(9); }
    if (IN(10)) { phase_combine_norm_mix1(C); SEAM(10); STAMP(10); }
    if (IN(11)) { pg8::Gemm g{Hb, (const bf16*)(C.ws + WS_WS5IN), TT, 512, D}; pg8::StaticOrder S; S.init(TT, 512, gridDim.x, blockIdx.x); pg8::EpiStore E{(bf16*)(C.ws + WS_U), 512};
        pg8::gemm_phase<pg8::EpiStore, pg8::StaticOrder, true, true, true>(C.lds, g, S, E); SEAM(11); STAMP(11); }
    if (IN(12)) { phase_s5_fast(C); SEAM(12); STAMP(12); }
    if (IN(13)) { pg8::Gemm g{(const bf16*)(C.ws + WS_GS), (const bf16*)(C.ws + WS_WGLU), TL, 512, 512}; pg8::StaticOrder S; S.init(TL, 512, gridDim.x, blockIdx.x); pg8::EpiGlu E{(const bf16*)(C.ws + WS_GS), P.in[I_BGLU], (bf16*)(C.ws + WS_GG)};
        pg8::gemm_phase<pg8::EpiGlu, pg8::StaticOrder, true, true, true>(C.lds, g, S, E); SEAM(13); STAMP(13); }
    if (IN(14)) { pg8::Gemm g{(const bf16*)(C.ws + WS_GG), (const bf16*)(C.ws + WS_WS5OUT), TL, D, 512}; pg8::StaticOrder S; S.init(TL, D, gridDim.x, blockIdx.x); pg8::EpiResid E{P.in[I_X], P.in[I_CTX], (const float*)(C.ws + WS_MOD) + (size_t)17 * 6 * D, XC, 1};
        pg8::gemm_phase<pg8::EpiResid, pg8::StaticOrder, true, true, true>(C.lds, g, S, E); SEAM(14); STAMP(14); }
    if (IN(15)) { phase_router_fast(C, 1, TL); SEAM(15); STAMP(15); }
    if (IN(17)) { MOE_GEMM1(1); SEAM(17); STAMP(17); }
    if (IN(18)) { MOE_GEMM2(1); SEAM(18); STAMP(18); }
    if (IN(19)) { phase_final(C); STAMP(19); }
#if MK_PROBE
    if (blockIdx.x == 0 && C.tid == 0) {
        ts_[8] = ts_[7]; ts_[17] = ts_[16];
        const unsigned long long tA = ts_[PROBE_A_HI + 1] - ts_[PROBE_A_LO], tB = ts_[PROBE_B_HI + 1] - ts_[PROBE_B_LO];
        const unsigned long long spin = 16ull * tA + 1000000ull * ((tB + 500ull) / 1000ull);
        const unsigned long long t0 = __builtin_amdgcn_s_memrealtime();
        while (__builtin_amdgcn_s_memrealtime() - t0 < spin) __builtin_amdgcn_s_sleep(8);
    }
#endif
#undef IN
#undef SEAM
}

extern "C" void kernel_launch(void* const* d_in, const int* in_sizes, int n_in, void* d_out, int out_size, void* d_ws, size_t ws_size, hipStream_t stream) {
    constexpr int LDS_BYTES = 147456;
    static int grid = 0;
    if (grid == 0) {
        if (n_in != 35 || out_size != TL * D || ws_size < WS_END) { fprintf(stderr, "kernel_launch: unexpected shapes (n_in %d out %d ws %zu)\n", n_in, out_size, ws_size); grid = -1; return; }
        int dev = 0, cus = 0;
        if (hipGetDevice(&dev) != hipSuccess || hipDeviceGetAttribute(&cus, hipDeviceAttributeMultiprocessorCount, dev) != hipSuccess) { grid = -1; return; }
        if (hipFuncSetAttribute((const void*)fwd_kernel, hipFuncAttributeMaxDynamicSharedMemorySize, LDS_BYTES) != hipSuccess) { fprintf(stderr, "kernel_launch: hipFuncSetAttribute failed\n"); grid = -1; return; }
        (void)hipGetLastError();
        grid = cus;
    }
    if (grid < 0) return;
    (void)hipMemsetAsync((char*)d_ws + WS_CTL, 0, CTL_BYTES, stream);
    Params p{};
    for (int i = 0; i < 35; ++i) p.in[i] = (const float*)d_in[i];
    p.out = (float*)d_out; p.ws = (unsigned char*)d_ws;
#if MK_ONE_LAUNCH
    p.ph_lo = 0; p.ph_hi = NPHASE;
    hipLaunchKernelGGL(fwd_kernel, dim3(grid), dim3(NTHR), LDS_BYTES, stream, p);
#else
    for (int k = 0; k < NPHASE; ++k) { p.ph_lo = k; p.ph_hi = k + 1; hipLaunchKernelGGL(fwd_kernel, dim3(grid), dim3(NTHR), LDS_BYTES, stream, p); }
#endif
}
```

```cpp
#include <hip/hip_runtime.h>
#include <cstdio>
#include <cstdint>

#ifndef MK_ONE_LAUNCH
#define MK_ONE_LAUNCH 1
#endif
#ifndef MK_SIMPLE_ORDER
#define MK_SIMPLE_ORDER 0
#endif
#ifndef MK_KROT
#define MK_KROT 0
#endif
#ifndef MK_PROBE
#define MK_PROBE 0
#endif
#define PROBE_A_LO 4
#define PROBE_A_HI 4
#define PROBE_B_LO 8
#define PROBE_B_HI 9

constexpr int D = 1024, NB = 16, SEQ = 2048, CTXL = 256;
constexpr int TL = NB * SEQ, TC = NB * CTXL, TT = TL + TC;
constexpr int KVL = CTXL + SEQ;
constexpr int MIXW = 1792, NEXP = 32, EH = 512;
constexpr int NSLOT = 81920;
constexpr float EPS = 1e-6f;
constexpr float QSCALE = 0.125f * 1.4426950408889634f;
constexpr int NTHR = 512, NWAVE = 8;
constexpr int NPHASE = 20;

constexpr size_t MiB = 1u << 20;
constexpr size_t WS_CTL = 0, CTL_BYTES = 1 * MiB;
constexpr size_t WS_MOD = 1 * MiB;
constexpr size_t WS_TAB = 2 * MiB;
constexpr size_t TAB_ROPE = 0, TAB_LAMB = 16384, TAB_BBAR = 65536, TAB_WR = 640 * 1024;
constexpr size_t WS_ROUTE = 3 * MiB;
constexpr size_t RT_E = 0, RT_P = 320 * 1024, RT_W = 640 * 1024, RT_S = 960 * 1024, RT_TILE = 1280 * 1024, RT_NT = 1280 * 1024 + 4096;
constexpr size_t WS_WIN0 = 6 * MiB, WS_WOUT0 = 10 * MiB, WS_WS5IN = 12 * MiB, WS_WGLU = 13 * MiB, WS_WS5OUT = 14 * MiB;
constexpr size_t WS_WSP = 15 * MiB;
constexpr size_t WS_W13 = 16 * MiB, WS_W2 = 80 * MiB;
constexpr size_t WS_XC = 112 * MiB;
constexpr size_t WS_H = 256 * MiB;
constexpr size_t WS_P = 328 * MiB;
constexpr size_t WS_Q = 454 * MiB, WS_K = 490 * MiB, WS_V = 499 * MiB;
constexpr size_t WS_XS = 328 * MiB;
constexpr size_t WS_G13 = 488 * MiB;
constexpr size_t WS_U = 328 * MiB, WS_GS = 364 * MiB, WS_GG = 396 * MiB, WS_YACC = 428 * MiB;
constexpr size_t WS_LIST = 568 * MiB;
constexpr int LCAP = 36864;
constexpr size_t WS_END = 574 * MiB;
constexpr int CW_CNT = 64;
constexpr int CW_BAR = 4096;

#define LAS __attribute__((address_space(3)))
typedef unsigned short bf16;
typedef unsigned v4u __attribute__((ext_vector_type(4)));
typedef unsigned v2u __attribute__((ext_vector_type(2)));
typedef float f32x4 __attribute__((ext_vector_type(4)));
typedef float f32x2 __attribute__((ext_vector_type(2)));
__device__ __forceinline__ float bf2f(unsigned u) { return __uint_as_float(u << 16); }
__device__ __forceinline__ unsigned pk2(float lo, float hi) { unsigned r; asm("v_cvt_pk_bf16_f32 %0, %1, %2" : "=v"(r) : "v"(lo), "v"(hi)); return r; }
__device__ __forceinline__ unsigned f2bf(float f) { return pk2(f, 0.f) & 0xffffu; }
__device__ __forceinline__ float wave_sum(float v) {
#pragma unroll
    for (int o = 1; o < 64; o <<= 1) v += __shfl_xor(v, o);
    return v;
}
__device__ __forceinline__ float wave_max(float v) {
#pragma unroll
    for (int o = 1; o < 64; o <<= 1) v = fmaxf(v, __shfl_xor(v, o));
    return v;
}
__device__ __forceinline__ float gelu_tanh(float x) { const float u2 = -1.5957691216057308f * (x + 0.044715f * x * x * x); return x * __builtin_amdgcn_rcpf(1.f + __expf(u2)); }
__device__ __forceinline__ float sigmoidf_(float x) { return 1.f / (1.f + __expf(-x)); }
__device__ __forceinline__ float silu_(float x) { return x / (1.f + __expf(-x)); }
__device__ __forceinline__ void unpack8(const v4u w, float* f) {
    f[0] = bf2f(w.x & 0xffffu); f[1] = bf2f(w.x >> 16); f[2] = bf2f(w.y & 0xffffu); f[3] = bf2f(w.y >> 16);
    f[4] = bf2f(w.z & 0xffffu); f[5] = bf2f(w.z >> 16); f[6] = bf2f(w.w & 0xffffu); f[7] = bf2f(w.w >> 16);
}

#define XB_TMO      128
#define XB_XCNT(j)  (256  + 64 * (j))
#define XB_XSUB(j)  (1280 + 64 * (j))
#define XB_XGEN(j)  (2304 + 64 * (j))
#define XB_TOP      3328
#define XB_TOPGEN   3392
#define XCD_BAR_WORDS 3456
#define XB_SPIN_CAP (1u << 28)
__device__ __forceinline__ unsigned xb_ld(unsigned* p)              { return __hip_atomic_load(p, __ATOMIC_RELAXED, __HIP_MEMORY_SCOPE_AGENT); }
__device__ __forceinline__ unsigned xb_add(unsigned* p, unsigned v) { return __hip_atomic_fetch_add(p, v, __ATOMIC_RELAXED, __HIP_MEMORY_SCOPE_AGENT); }
__device__ __forceinline__ unsigned xb_xcc_id() { return (unsigned)__builtin_amdgcn_s_getreg((3 << 11) | 20) & 0xFu; }
#define XB_SPIN(cond, bar) do { unsigned _sp = 0; while (cond) { __builtin_amdgcn_s_sleep(1); \
    if ((++_sp & 255u) == 0u) { if (xb_ld(&(bar)[XB_TMO])) break; if (_sp > XB_SPIN_CAP) { atomicAdd(&(bar)[XB_TMO], 1u); break; } } } } while (0)
struct XcdBarrier { unsigned* bar; unsigned x; volatile LAS unsigned* st; };
__device__ __forceinline__ XcdBarrier xcd_barrier_post(unsigned* bar, volatile LAS unsigned* st) {
    XcdBarrier b; b.bar = bar; b.x = xb_xcc_id(); b.st = st;
    if (threadIdx.x == 0) (void)xb_add(&bar[XB_XCNT(b.x)], 1u);
    return b;
}
__device__ __forceinline__ void xcd_barrier_complete(unsigned* bar, unsigned x, unsigned& nloc, unsigned& nx) {
    const unsigned G = gridDim.x * gridDim.y * gridDim.z;
    unsigned sum, cnt, mine, sp = 0u;
    for (;;) {
        sum = 0u; cnt = 0u; mine = 0u;
#pragma unroll
        for (unsigned j = 0; j < 16; ++j) { const unsigned c = xb_ld(&bar[XB_XCNT(j)]); sum += c; cnt += (c > 0u) ? 1u : 0u; mine = (j == x) ? c : mine; }
        if (sum == G) break;
        __builtin_amdgcn_s_sleep(1);
        if ((++sp & 255u) == 0u) { if (xb_ld(&bar[XB_TMO])) break; if (sp > XB_SPIN_CAP) { atomicAdd(&bar[XB_TMO], 1u); break; } }
    }
    nloc = mine > 0u ? mine : 1u; nx = cnt > 0u ? cnt : 1u;
}
__device__ __forceinline__ void xcd_barrier(const XcdBarrier& b) {
    asm volatile("s_waitcnt vmcnt(0)" ::: "memory");
    __syncthreads();
    if (threadIdx.x == 0) {
        unsigned* bar = b.bar;
        __builtin_amdgcn_s_waitcnt(0);
        unsigned nloc = b.st[0], nx = b.st[1];
        if (nloc == 0u) { xcd_barrier_complete(bar, b.x, nloc, nx); b.st[0] = nloc; b.st[1] = nx; }
        const unsigned old = xb_add(&bar[XB_XSUB(b.x)], 1u);
        const unsigned gen = old / nloc;
        if (old + 1u == (gen + 1u) * nloc) {
            __builtin_amdgcn_fence(__ATOMIC_RELEASE, "agent");
            asm volatile("s_waitcnt vmcnt(0)" ::: "memory");
            const unsigned og = xb_add(&bar[XB_TOP], 1u);
            const unsigned tg = og / nx;
            if (og + 1u == (tg + 1u) * nx) xb_add(&bar[XB_TOPGEN], 1u);
            else XB_SPIN(xb_ld(&bar[XB_TOPGEN]) == tg, bar);
            __builtin_amdgcn_fence(__ATOMIC_ACQUIRE, "agent");
            xb_add(&bar[XB_XGEN(b.x)], 1u);
            asm volatile("s_waitcnt vmcnt(0)" ::: "memory");
        } else {
            XB_SPIN(xb_ld(&bar[XB_XGEN(b.x)]) == gen, bar);
            __builtin_amdgcn_fence(__ATOMIC_ACQUIRE, "agent");
            asm volatile("s_waitcnt vmcnt(0)" ::: "memory");
        }
    }
    __syncthreads();
}

namespace pg8 {
#define PG8_LAS __attribute__((address_space(3)))
typedef unsigned short bf16_t;
typedef short bf16x8 __attribute__((ext_vector_type(8)));
typedef float f32x4 __attribute__((ext_vector_type(4)));
typedef unsigned u32x4 __attribute__((ext_vector_type(4)));
constexpr int BM = 256, BK = 64, HALF = 128, HTB = HALF * BK * 2  , STAGE_BYTES = 8 * HTB, NXCD = 8, WGM = 8;

__host__ __device__ __forceinline__ int lds_byte(int r, int c) { const int st = (r >> 4) * 2 + (c >> 5), rr = r & 15, cc = c & 31, ob = rr * 64 + cc * 2; return st * 1024 + (ob ^ (((ob >> 9) & 1) << 5)); }
__host__ __device__ __forceinline__ void stage_rc(int b, int& R, int& C) { const int st = b / 1024, sb = b % 1024, swz = sb ^ (((sb >> 9) & 1) << 5); R = (st >> 1) * 16 + swz / 64; C = (st & 1) * 32 + (swz % 64) / 2; }
__host__ __device__ __forceinline__ int perm32(int rho) { const int n = rho >> 4, i = rho & 15; return 8 * (i >> 2) + 4 * n + (i & 3); }

struct Unit { int pm, pn; size_t bo; int aux; };
struct Gemm { const bf16_t* A; const bf16_t* Bt; int M, N, K; };

struct StaticOrder {
    static constexpr bool GATHER = false;
    int nM, nN, nwg, G, c;
    __host__ __device__ void init(int M, int N, int G_, int c_) { nM = M / BM; nN = N / BM; nwg = nM * nN; G = G_; c = c_; }
    __host__ __device__ bool next(int i, Unit& u) const {
        const long L = (long)i * G + c; if (L >= nwg) return false;
        if (MK_SIMPLE_ORDER) { u.pm = (int)L / nN; u.pn = (int)L % nN; u.bo = 0; u.aux = 0; return true; }
        int wgid = (int)L; { const int q = nwg / NXCD, r = nwg % NXCD, xcd = wgid % NXCD, off = wgid / NXCD; wgid = (xcd < r ? xcd * (q + 1) : r * (q + 1) + (xcd - r) * q) + off; }
        const int nig = WGM * nN, gid = wgid / nig, fm = gid * WGM, gsz = (nM - fm) < WGM ? (nM - fm) : WGM;
        u.pm = fm + ((wgid % nig) % gsz); u.pn = (wgid % nig) / gsz; u.bo = 0; u.aux = 0; return true;
    }
    __device__ __forceinline__ void a_ready(const Unit&) const {}
    __device__ __forceinline__ void done(const Unit&) const {}
};

__device__ __forceinline__ unsigned cvt_pk_bf16(float lo, float hi) { unsigned r; asm volatile("v_cvt_pk_bf16_f32 %0, %1, %2" : "=v"(r) : "v"(lo), "v"(hi)); return r; }
typedef float f32x2 __attribute__((ext_vector_type(2)));
__device__ __forceinline__ f32x2 gelu_pk(f32x2 v) {
    const f32x2 av = __builtin_elementwise_abs(v), d = av * 0.2316418882f + 1.0f;
    f32x2 t; t.x = __builtin_amdgcn_rcpf(d.x); t.y = __builtin_amdgcn_rcpf(d.y);
    f32x2 q = t * 0.5307027145f + (-0.7265760135f); q = q * t + 0.7107068705f; q = q * t + (-0.142248368f); q = q * t + 0.127414796f; q = q * t;
    const f32x2 s = (v * v) * (-0.72134752044f);
    f32x2 e; e.x = __builtin_amdgcn_exp2f(s.x); e.y = __builtin_amdgcn_exp2f(s.y);
    const f32x2 m = v * (q * e), r = v - m;
    f32x2 o; o.x = v.x < 0.f ? m.x : r.x; o.y = v.y < 0.f ? m.y : r.y; return o;
}

template <class Epi, class Sched, bool ALIGN_EPI = false, bool SP2 = false, bool KROT = false>
__device__ __forceinline__ void gemm_phase(PG8_LAS unsigned char* lds, const Gemm g, const Sched& S, const Epi& E) {
    const int tid = threadIdx.x, wid = __builtin_amdgcn_readfirstlane(tid >> 6), lane = tid & 63, wr = wid >> 2, wc = wid & 3, fr = lane & 15, fq = lane >> 4;
    const int K = g.K, nt = K / BK;
    const int kmask = nt - 1, rot = (MK_KROT && KROT) ? (int)((blockIdx.x * 3u + (blockIdx.x >> 3)) & (unsigned)kmask) : 0;
#define PG8_KO(j) ((size_t)(((j) + rot) & kmask) * kstep)
    unsigned voffA[2], voffB[2];
    unsigned vC[2][2], vN[2][2];
#pragma unroll
    for (int i = 0; i < 2; ++i) { int R, C; stage_rc(tid * 16 + i * 8192, R, C); const int Rb = Epi::PERM ? ((R & ~31) + perm32(R & 31)) : R;
        voffA[i] = (unsigned)(R * K + C) * 2u; voffB[i] = (unsigned)(Rb * K + C) * 2u; }
    const size_t kstep = (size_t)(BK * 2);
    const size_t hstep = (size_t)HALF * K * 2;
    const size_t tstep = 2 * hstep;
    const unsigned ldsw = (unsigned)wid * 1024u;
    const int aoff = lds_byte(wr * 64 + fr, fq * 8), boff = lds_byte(wc * 32 + fr, fq * 8);
#define PG8_SA(b, h) (((b) * 2 + (h)) * HTB)
#define PG8_SB(b, h) ((4 + (b) * 2 + (h)) * HTB)
#define PG8_STAGE(bufoff, gbase, voff) do { _Pragma("unroll") for (int _i = 0; _i < 2; ++_i) \
        __builtin_amdgcn_global_load_lds((const unsigned*)((const char*)(gbase) + (voff)[_i]), (PG8_LAS unsigned*)(lds + (bufoff) + ldsw + _i * 8192), 16, 0, 0); } while (0)
#define PG8_STAGE_A(bufoff, gbase, h, nx) do { _Pragma("unroll") for (int _i = 0; _i < 2; ++_i) { \
        const unsigned _vo = Sched::GATHER ? ((nx) ? vN[h][_i] : vC[h][_i]) : (unsigned)((h) * hstep) + voffA[_i]; \
        __builtin_amdgcn_global_load_lds((const unsigned*)((const char*)(gbase) + _vo), (PG8_LAS unsigned*)(lds + (bufoff) + ldsw + _i * 8192), 16, 0, 0); } } while (0)
#define PG8_LDA(dst, b, h) do { _Pragma("unroll") for (int m = 0; m < 4; ++m) _Pragma("unroll") for (int k = 0; k < 2; ++k) dst[m][k] = *(const PG8_LAS bf16x8*)(lds + PG8_SA(b, h) + aoff + m * 2048 + k * 1024); } while (0)
#define PG8_LDB(dst, b, h) do { _Pragma("unroll") for (int n = 0; n < 2; ++n) _Pragma("unroll") for (int k = 0; k < 2; ++k) dst[n][k] = *(const PG8_LAS bf16x8*)(lds + PG8_SB(b, h) + boff + n * 2048 + k * 1024); } while (0)
#define PG8_MMA(ai, bj, At, Bt) do { __builtin_amdgcn_s_setprio(1); _Pragma("unroll") for (int m = 0; m < 4; ++m) _Pragma("unroll") for (int n = 0; n < 2; ++n) _Pragma("unroll") for (int k = 0; k < 2; ++k) \
        acc[ai][bj][m][n] = __builtin_amdgcn_mfma_f32_16x16x32_bf16(Bt[n][k], At[m][k], acc[ai][bj][m][n], 0, 0, 0); __builtin_amdgcn_s_setprio(0); } while (0)
#define PG8_WAIT_V(n) asm volatile("s_waitcnt vmcnt(" #n ")" ::: "memory")
#define PG8_WAIT_L(n) asm volatile("s_waitcnt lgkmcnt(" #n ")" ::: "memory")
#define PG8_BAR __builtin_amdgcn_s_barrier()
#define PG8_SCHED __builtin_amdgcn_sched_barrier(0)
    Unit cur, nxt; int ui = 0;
    if (!S.next(0, cur)) return;
    f32x4 acc[2][2][4][2];
#pragma unroll
    for (int a = 0; a < 2; ++a)
#pragma unroll
        for (int b = 0; b < 2; ++b)
#pragma unroll
            for (int m = 0; m < 4; ++m)
#pragma unroll
                for (int n = 0; n < 2; ++n) acc[a][b][m][n] = (f32x4){0.f, 0.f, 0.f, 0.f};
    bf16x8 At[4][2], B0[2][2], B1[2][2];
    const char* cA = (const char*)g.A + (Sched::GATHER ? (size_t)0 : (size_t)cur.pm * tstep); const char* cB = (const char*)g.Bt + cur.bo + (size_t)cur.pn * tstep;
    S.a_ready(cur);
#define PG8_VOFF(dst, un) do { _Pragma("unroll") for (int _h = 0; _h < 2; ++_h) _Pragma("unroll") for (int _i = 0; _i < 2; ++_i) { int R_, C_; stage_rc(tid * 16 + _i * 8192, R_, C_); dst[_h][_i] = S.a_off(un, _h * HALF + R_) + (unsigned)C_ * 2u; } } while (0)
    if constexpr (Sched::GATHER) { PG8_VOFF(vC, cur); }
    if constexpr (SP2) {
        PG8_STAGE(PG8_SB(0, 0), cB + PG8_KO(0), voffB); PG8_STAGE(PG8_SB(0, 1), cB + hstep + PG8_KO(0), voffB); PG8_STAGE_A(PG8_SA(0, 0), cA + PG8_KO(0), 0, false); PG8_STAGE_A(PG8_SA(0, 1), cA + PG8_KO(0), 1, false);
        if (wr == 1) PG8_BAR;
        PG8_WAIT_V(2); PG8_BAR;
        PG8_STAGE(PG8_SB(1, 0), cB + PG8_KO(1), voffB); PG8_STAGE_A(PG8_SA(1, 0), cA + PG8_KO(1), 0, false); PG8_STAGE(PG8_SB(1, 1), cB + hstep + PG8_KO(1), voffB);
        PG8_WAIT_V(6); PG8_BAR;
    } else {
        PG8_STAGE(PG8_SB(0, 0), cB, voffB); PG8_STAGE_A(PG8_SA(0, 0), cA, 0, false); PG8_STAGE(PG8_SB(0, 1), cB + hstep, voffB); PG8_STAGE_A(PG8_SA(0, 1), cA, 1, false);
        if (wr == 1) PG8_BAR;
        PG8_WAIT_V(4); PG8_BAR;
        PG8_STAGE(PG8_SB(1, 0), cB + PG8_KO(1), voffB); PG8_STAGE_A(PG8_SA(1, 0), cA + PG8_KO(1), 0, false); PG8_STAGE(PG8_SB(1, 1), cB + hstep + PG8_KO(1), voffB);
        PG8_WAIT_V(6); PG8_BAR;
    }
    for (;;) {
        const bool has_next = S.next(ui + 1, nxt);
        if constexpr (Sched::GATHER) { if (has_next) { PG8_VOFF(vN, nxt); } else { vN[0][0] = vC[0][0]; vN[0][1] = vC[0][1]; vN[1][0] = vC[1][0]; vN[1][1] = vC[1][1]; } }
        const char* nA = (has_next && !Sched::GATHER) ? (const char*)g.A + (size_t)nxt.pm * tstep : cA; const char* nB = has_next ? (const char*)g.Bt + nxt.bo + (size_t)nxt.pn * tstep : cB;
        for (int t = 0; t < nt; t += 2) {
            const bool last = (t == nt - 2);
            const char* a1 = cA + PG8_KO(t + 1);
            const char* a2 = last ? nA + PG8_KO(0) : cA + PG8_KO(t + 2); const char* b2 = last ? nB + PG8_KO(0) : cB + PG8_KO(t + 2);
            const char* a3 = last ? nA + PG8_KO(1) : cA + PG8_KO(t + 3); const char* b3 = last ? nB + PG8_KO(1) : cB + PG8_KO(t + 3);
            if (last && has_next) S.a_ready(nxt);
            if constexpr (SP2) {
            PG8_LDB(B0, 0, 0); PG8_LDB(B1, 0, 1); PG8_SCHED; PG8_LDA(At, 0, 0); PG8_STAGE_A(PG8_SA(1, 1), a1, 1, false);
            PG8_WAIT_V(8); PG8_WAIT_L(0); PG8_BAR; PG8_MMA(0, 0, At, B0); PG8_MMA(0, 1, At, B1); PG8_BAR; PG8_SCHED;
            PG8_LDA(At, 0, 1); PG8_STAGE(PG8_SB(0, 0), b2, voffB); PG8_STAGE(PG8_SB(0, 1), b2 + hstep, voffB); PG8_STAGE_A(PG8_SA(0, 0), a2, 0, last);
            PG8_WAIT_V(8); PG8_WAIT_L(0); PG8_BAR; PG8_MMA(1, 0, At, B0); PG8_MMA(1, 1, At, B1); PG8_BAR; PG8_SCHED;
            PG8_LDB(B0, 1, 0); PG8_LDB(B1, 1, 1); PG8_SCHED; PG8_LDA(At, 1, 0); PG8_STAGE_A(PG8_SA(0, 1), a2, 1, last);
            PG8_WAIT_V(8); PG8_WAIT_L(0); PG8_BAR; PG8_MMA(0, 0, At, B0); PG8_MMA(0, 1, At, B1); PG8_BAR; PG8_SCHED;
            PG8_LDA(At, 1, 1); PG8_STAGE(PG8_SB(1, 0), b3, voffB); PG8_STAGE(PG8_SB(1, 1), b3 + hstep, voffB); PG8_STAGE_A(PG8_SA(1, 0), a3, 0, last);
            PG8_WAIT_V(8); PG8_WAIT_L(0); PG8_BAR; PG8_MMA(1, 0, At, B0); PG8_MMA(1, 1, At, B1); PG8_BAR; PG8_SCHED;
            } else {
            PG8_LDB(B0, 0, 0); PG8_SCHED; PG8_LDA(At, 0, 0); PG8_STAGE_A(PG8_SA(1, 1), a1, 1, false);
            PG8_WAIT_L(8); PG8_BAR; PG8_WAIT_L(0); PG8_MMA(0, 0, At, B0); PG8_BAR; PG8_SCHED;
            PG8_LDB(B1, 0, 1); PG8_STAGE(PG8_SB(0, 0), b2, voffB);
            PG8_BAR; PG8_WAIT_L(0); PG8_MMA(0, 1, At, B1); PG8_BAR;
            PG8_LDA(At, 0, 1); PG8_STAGE_A(PG8_SA(0, 0), a2, 0, last);
            PG8_BAR; PG8_WAIT_L(0); PG8_MMA(1, 0, At, B0); PG8_BAR; PG8_SCHED;
            PG8_STAGE(PG8_SB(0, 1), b2 + hstep, voffB);
            PG8_WAIT_V(6); PG8_BAR; PG8_MMA(1, 1, At, B1); PG8_BAR;
            PG8_LDB(B0, 1, 0); PG8_SCHED; PG8_LDA(At, 1, 0); PG8_STAGE_A(PG8_SA(0, 1), a2, 1, last);
            PG8_WAIT_L(8); PG8_BAR; PG8_WAIT_L(0); PG8_MMA(0, 0, At, B0); PG8_BAR; PG8_SCHED;
            PG8_LDB(B1, 1, 1); PG8_STAGE(PG8_SB(1, 0), b3, voffB);
            PG8_BAR; PG8_WAIT_L(0); PG8_MMA(0, 1, At, B1); PG8_BAR;
            PG8_LDA(At, 1, 1); PG8_STAGE_A(PG8_SA(1, 0), a3, 0, last);
            PG8_BAR; PG8_WAIT_L(0); PG8_MMA(1, 0, At, B0); PG8_BAR; PG8_SCHED;
            PG8_STAGE(PG8_SB(1, 1), b3 + hstep, voffB);
            PG8_WAIT_V(6); PG8_BAR; PG8_MMA(1, 1, At, B1); PG8_BAR;
            }
        }
        if constexpr (ALIGN_EPI) { if (wr == 0) PG8_BAR; }
        if constexpr (!Epi::AFTER_DRAIN) { E(acc, cur, wr, wc, fr, fq); S.done(cur); }
        if (!has_next) break;
#pragma unroll
        for (int a = 0; a < 2; ++a)
#pragma unroll
            for (int b = 0; b < 2; ++b)
#pragma unroll
                for (int m = 0; m < 4; ++m)
#pragma unroll
                    for (int n = 0; n < 2; ++n) acc[a][b][m][n] = (f32x4){0.f, 0.f, 0.f, 0.f};
        cur = nxt; cA = nA; cB = nB; ++ui;
        if constexpr (Sched::GATHER) { vC[0][0] = vN[0][0]; vC[0][1] = vN[0][1]; vC[1][0] = vN[1][0]; vC[1][1] = vN[1][1]; }
        if constexpr (ALIGN_EPI) { if (wr == 1) PG8_BAR; }
    }
    PG8_WAIT_V(0);
    if constexpr (!ALIGN_EPI) { if (wr == 0) PG8_BAR; }
    PG8_BAR;
    if constexpr (Epi::AFTER_DRAIN) { E.fused(acc, cur, wr, wc, fr, fq, lds, wid, lane); S.done(cur); }
#undef PG8_VOFF
#undef PG8_KO
#undef PG8_SA
#undef PG8_SB
#undef PG8_STAGE
#undef PG8_STAGE_A
#undef PG8_LDA
#undef PG8_LDB
#undef PG8_MMA
#undef PG8_WAIT_V
#undef PG8_WAIT_L
#undef PG8_BAR
#undef PG8_SCHED
}
}

namespace pg8 {
template <bool GATHER_>
struct GroupedOrder {
    static constexpr bool GATHER = GATHER_;
    const PG8_LAS int* tmap; const PG8_LAS int* cntl; const int* list; int nU, nN, G, c, lcap, rowbytes; size_t estride;
    __device__ __forceinline__ bool next(int i, Unit& u) const { const long L = (long)i * G + c; if (L >= nU) return false; const int t = (int)L / nN; const int m = __builtin_amdgcn_readfirstlane(tmap[t]);
        u.pm = t; u.pn = (int)L % nN; u.bo = (size_t)(m & 255) * estride; u.aux = m; return true; }
    __device__ __forceinline__ unsigned a_off(const Unit& u, int R) const { const int e = u.aux & 255, p0 = u.aux >> 8, ce = cntl[e]; int p = p0 + R; p = p < ce ? p : ce - 1; return (unsigned)list[(size_t)e * lcap + p] * (unsigned)rowbytes; }
    __device__ __forceinline__ void a_ready(const Unit&) const {}
    __device__ __forceinline__ void done(const Unit&) const {}
};
__device__ __forceinline__ u32x4 pack8(const f32x4 a, const f32x4 b) { u32x4 w; w.x = cvt_pk_bf16(a[0], a[1]); w.y = cvt_pk_bf16(a[2], a[3]); w.z = cvt_pk_bf16(b[0], b[1]); w.w = cvt_pk_bf16(b[2], b[3]); return w; }
struct EpiStore {
    static constexpr bool PERM = true, AFTER_DRAIN = false; bf16_t* O; int ldc;
    __device__ __forceinline__ void operator()(const f32x4 (&acc)[2][2][4][2], const Unit& u, int wr, int wc, int fr, int fq) const {
        const int row0 = u.pm * BM + wr * 64 + fr, col0 = u.pn * BM + wc * 32 + 8 * fq;
#pragma unroll
        for (int ai = 0; ai < 2; ++ai)
#pragma unroll
            for (int m = 0; m < 4; ++m) { bf16_t* rowp = O + (size_t)(row0 + ai * HALF + m * 16) * ldc + col0;
#pragma unroll
                for (int bj = 0; bj < 2; ++bj) *(u32x4*)(rowp + bj * HALF) = pack8(acc[ai][bj][m][0], acc[ai][bj][m][1]); }
    }
};
__device__ __forceinline__ f32x4 silu4(const f32x4 v) { f32x4 r;
#pragma unroll
    for (int i = 0; i < 4; ++i) r[i] = v[i] * __builtin_amdgcn_rcpf(1.f + __expf(-v[i])); return r; }
__device__ __forceinline__ f32x4 sigm4(const f32x4 v) { f32x4 r;
#pragma unroll
    for (int i = 0; i < 4; ++i) r[i] = __builtin_amdgcn_rcpf(1.f + __expf(-v[i])); return r; }
struct EpiSwiglu {
    static constexpr bool PERM = true, AFTER_DRAIN = false; bf16_t* G;
    __device__ __forceinline__ void operator()(const f32x4 (&acc)[2][2][4][2], const Unit& u, int wr, int wc, int fr, int fq) const {
        const int row0 = u.pm * BM + wr * 64 + fr, col0 = u.pn * HALF + wc * 32 + 8 * fq;
#pragma unroll
        for (int ai = 0; ai < 2; ++ai)
#pragma unroll
            for (int m = 0; m < 4; ++m) *(u32x4*)(G + (size_t)(row0 + ai * HALF + m * 16) * 512 + col0) = pack8(silu4(acc[ai][0][m][0]) * acc[ai][1][m][0], silu4(acc[ai][0][m][1]) * acc[ai][1][m][1]);
    }
};
__device__ __forceinline__ void unpack8f(const u32x4 w, f32x4& a, f32x4& b) {
    a[0] = __uint_as_float(w.x << 16); a[1] = __uint_as_float(w.x & 0xffff0000u); a[2] = __uint_as_float(w.y << 16); a[3] = __uint_as_float(w.y & 0xffff0000u);
    b[0] = __uint_as_float(w.z << 16); b[1] = __uint_as_float(w.z & 0xffff0000u); b[2] = __uint_as_float(w.w << 16); b[3] = __uint_as_float(w.w & 0xffff0000u); }
struct EpiGlu {
    static constexpr bool PERM = true, AFTER_DRAIN = false; const bf16_t* GS; const float* b; bf16_t* GG;
    __device__ __forceinline__ void operator()(const f32x4 (&acc)[2][2][4][2], const Unit& u, int wr, int wc, int fr, int fq) const {
        const int row0 = u.pm * BM + wr * 64 + fr, col0 = u.pn * BM + wc * 32 + 8 * fq;
#pragma unroll
        for (int bj = 0; bj < 2; ++bj) { const int c = col0 + bj * HALF; const f32x4 b0 = *(const f32x4*)(b + c), b1 = *(const f32x4*)(b + c + 4);
#pragma unroll
            for (int ai = 0; ai < 2; ++ai)
#pragma unroll
                for (int m = 0; m < 4; ++m) { const size_t o = (size_t)(row0 + ai * HALF + m * 16) * 512 + c; f32x4 g0, g1; unpack8f(*(const u32x4*)(GS + o), g0, g1);
                    *(u32x4*)(GG + o) = pack8(g0 * sigm4(acc[ai][bj][m][0] + b0), g1 * sigm4(acc[ai][bj][m][1] + b1)); } }
    }
};
struct EpiResid {
    static constexpr bool PERM = true, AFTER_DRAIN = false;
    const float* x; const float* ctx; const float* mod; bf16_t* XC; int inplace;
    __device__ __forceinline__ void operator()(const f32x4 (&acc)[2][2][4][2], const Unit& u, int wr, int wc, int fr, int fq) const {
        const int R0 = u.pm * BM; const int ci = R0 < 32768 ? (R0 >> 11) : 16;
        const float* base = R0 < 32768 ? x + (size_t)R0 * 1024 : ctx + (size_t)(R0 - 32768) * 1024;
        bf16_t* out = XC + (size_t)R0 * 1024; const float* gate = mod + ((size_t)ci * 6 + 2) * 1024;
        const int rl0 = wr * 64 + fr, col0 = u.pn * BM + wc * 32 + 8 * fq;
#pragma unroll
        for (int bj = 0; bj < 2; ++bj) { const int c = col0 + bj * HALF; const f32x4 g0 = *(const f32x4*)(gate + c), g1 = *(const f32x4*)(gate + c + 4);
#pragma unroll
            for (int ai = 0; ai < 2; ++ai)
#pragma unroll
                for (int m = 0; m < 4; ++m) { const size_t o = (size_t)(rl0 + ai * HALF + m * 16) * 1024 + c; f32x4 b0, b1;
                    if (inplace) unpack8f(*(const u32x4*)(out + o), b0, b1); else { b0 = *(const f32x4*)(base + o); b1 = *(const f32x4*)(base + o + 4); }
                    *(u32x4*)(out + o) = pack8(b0 + g0 * acc[ai][bj][m][0], b1 + g1 * acc[ai][bj][m][1]); } }
    }
};
}

#include <hip/hip_bf16.h>
#include <cmath>
namespace attn_body {
using bf16=__hip_bfloat16;
using bf16x8=__attribute__((ext_vector_type(8)))short;
using s16x4=__attribute__((ext_vector_type(4)))short;
using f32x16=__attribute__((ext_vector_type(16)))float;
using u32x4=__attribute__((ext_vector_type(4)))unsigned;
constexpr int D=64,QP=512,KP=128,OP=1024;
constexpr int NW=8,QBLK=32,QB=QBLK*NW,KVBLK=64;
constexpr int ATTN_UNIT_ROWS=QB;
__device__ __forceinline__ int crow(int r,int hi){return (r&3)+8*(r>>2)+4*hi;}
#define SBAR() __builtin_amdgcn_sched_barrier(0)
__device__ __forceinline__ void cmask(f32x16&p0,f32x16&p1,int jb,int qrel,int hi){
  const float NEG=-INFINITY; int kb=64*jb+4*hi;
  #pragma unroll
  for(int r=0;r<16;++r){int kv=kb+(r&3)+8*(r>>2); if(kv>qrel)p0[r]=NEG; if(kv+32>qrel)p1[r]=NEG;}
}

constexpr int NSLOT=3, SLOTB=8192;
constexpr int LDS_K=0, LDS_V=NSLOT*SLOTB, LDS_WS=2*NSLOT*SLOTB, LDS_OST=LDS_WS+NW*64*4, LDS_BYTES=LDS_OST+NW*4096;
constexpr float C2=0.125f*1.4426950408889634f;
__device__ __forceinline__ void glds16(const void*gsrc,unsigned lds_dst){unsigned keep;
  asm volatile("s_mov_b32 %0, m0\n\ts_mov_b32 m0, %2\n\ts_nop 0\n\tglobal_load_lds_dwordx4 %1, off\n\ts_mov_b32 m0, %0":"=&s"(keep):"v"(gsrc),"s"(lds_dst):"memory");}
__device__ __forceinline__ float max3f(float a,float b,float c){float r;asm("v_max3_f32 %0, %1, %2, %3":"=v"(r):"v"(a),"v"(b),"v"(c));return r;}
__device__ __forceinline__ float max2f(float a,float b){float r;asm("v_max_f32_e32 %0, %1, %2":"=v"(r):"v"(a),"v"(b));return r;}
__device__ __forceinline__ float fadd_s(float a,float b){float r;asm("v_add_f32_e32 %0, %1, %2":"=v"(r):"v"(a),"v"(b));return r;}
__device__ __forceinline__ float fsub_s(float a,float b){float r;asm("v_sub_f32_e32 %0, %1, %2":"=v"(r):"v"(a),"v"(b));return r;}
typedef float f32x2_t __attribute__((ext_vector_type(2))); typedef __bf16 bf16x2_t __attribute__((ext_vector_type(2)));
__device__ __forceinline__ unsigned cvtpk_s(float lo,float hi){f32x2_t v={lo,hi};bf16x2_t b=__builtin_convertvector(v,bf16x2_t);return __builtin_bit_cast(unsigned,b);}
#define WAIT_BAR(N) asm volatile("s_waitcnt vmcnt(" #N ") lgkmcnt(0)\n\ts_barrier":::"memory")

__device__ __forceinline__ void qkt(f32x16&p0,f32x16&p1,const char*Kslot,const bf16x8*qr,const f32x16&negm,int r32,int hi){
  const char*kb=Kslot+hi*1024+r32*16;
  #pragma unroll
  for(int d0=0;d0<4;++d0){
    const bf16x8 b0=*reinterpret_cast<const bf16x8*>(kb+d0*2048);
    const bf16x8 b1=*reinterpret_cast<const bf16x8*>(kb+d0*2048+512);
    if(d0==0){p0=__builtin_amdgcn_mfma_f32_32x32x16_bf16(b0,qr[0],negm,0,0,0);p1=__builtin_amdgcn_mfma_f32_32x32x16_bf16(b1,qr[0],negm,0,0,0);}
    else{p0=__builtin_amdgcn_mfma_f32_32x32x16_bf16(b0,qr[d0],p0,0,0,0);p1=__builtin_amdgcn_mfma_f32_32x32x16_bf16(b1,qr[d0],p1,0,0,0);}}
}
typedef __attribute__((address_space(3))) const char* lds_cptr;
typedef short v4i16_t __attribute__((ext_vector_type(4)));
__device__ __forceinline__ void kload8(bf16x8*kf,lds_cptr kp){
  kf[0]=*(const __attribute__((address_space(3))) bf16x8*)(kp);      kf[1]=*(const __attribute__((address_space(3))) bf16x8*)(kp+512);
  kf[2]=*(const __attribute__((address_space(3))) bf16x8*)(kp+2048); kf[3]=*(const __attribute__((address_space(3))) bf16x8*)(kp+2560);
  kf[4]=*(const __attribute__((address_space(3))) bf16x8*)(kp+4096); kf[5]=*(const __attribute__((address_space(3))) bf16x8*)(kp+4608);
  kf[6]=*(const __attribute__((address_space(3))) bf16x8*)(kp+6144); kf[7]=*(const __attribute__((address_space(3))) bf16x8*)(kp+6656);
}
__device__ __forceinline__ void kload2(bf16x8*kf,lds_cptr kp,int j){ kf[2*j]=*(const __attribute__((address_space(3))) bf16x8*)(kp+j*2048); kf[2*j+1]=*(const __attribute__((address_space(3))) bf16x8*)(kp+j*2048+512); }
__device__ __forceinline__ s16x4 vtr(lds_cptr p){ return __builtin_bit_cast(s16x4,__builtin_amdgcn_ds_read_tr16_b64_v4i16((__attribute__((address_space(3))) v4i16_t*)p)); }
__device__ __forceinline__ float rowmax(const f32x16&p0,const f32x16&p1){
  float a=max3f(p0[0],p0[1],p1[0]),b=max3f(p0[2],p0[3],p1[1]);a=max3f(a,p1[2],p1[3]);
  #pragma unroll
  for(int r=4;r<16;r+=4){a=max3f(a,p0[r],p0[r+1]);b=max3f(b,p0[r+2],p0[r+3]);a=max3f(a,p1[r],p1[r+1]);b=max3f(b,p1[r+2],p1[r+3]);}
  const float m=max2f(a,b);
  auto rr=__builtin_amdgcn_permlane32_swap(__float_as_uint(m),__float_as_uint(m),false,false);
  return max2f(__uint_as_float(rr[0]),__uint_as_float(rr[1]));
}
__device__ __forceinline__ void pv(f32x16*o,int vb,bf16x8 pa0,bf16x8 pa1,bf16x8 pa2,bf16x8 pa3){
  #pragma unroll
  for(int d0=0;d0<2;++d0){s16x4 lo[4],hi[4];
    #pragma unroll
    for(int ks=0;ks<4;++ks){
      asm volatile("ds_read_b64_tr_b16 %0,%1 offset:%c2":"=&v"(lo[ks]):"v"(vb),"i"(d0*4096+ks*1024):"memory");
      asm volatile("ds_read_b64_tr_b16 %0,%1 offset:%c2":"=&v"(hi[ks]):"v"(vb),"i"(d0*4096+ks*1024+512):"memory");}
    asm volatile("s_waitcnt lgkmcnt(0)":::"memory");SBAR();
    #define PK(k) (bf16x8){lo[k][0],lo[k][1],lo[k][2],lo[k][3],hi[k][0],hi[k][1],hi[k][2],hi[k][3]}
    o[d0]=__builtin_amdgcn_mfma_f32_32x32x16_bf16(pa0,PK(0),o[d0],0,0,0);
    o[d0]=__builtin_amdgcn_mfma_f32_32x32x16_bf16(pa1,PK(1),o[d0],0,0,0);
    o[d0]=__builtin_amdgcn_mfma_f32_32x32x16_bf16(pa2,PK(2),o[d0],0,0,0);
    o[d0]=__builtin_amdgcn_mfma_f32_32x32x16_bf16(pa3,PK(3),o[d0],0,0,0);
    #undef PK
  }
}

#ifndef ATTN_STORE16
#define ATTN_STORE16(p,v) (*(u32x4*)(p)=(v))
#endif
template<int THRL> __device__ __forceinline__ void attn_unit(const bf16*Q0,const bf16*__restrict__ Kh,const bf16*__restrict__ Vh,bf16*O0,const int NT,char*shm){
  const int tid=threadIdx.x,lane=tid&63,r32=lane&31,hi=lane>>5; const int wid=__builtin_amdgcn_readfirstlane(tid>>6);
  const bf16*Qw=Q0+(long)(wid*QBLK)*QP;
  const unsigned lds0=(unsigned)(uintptr_t)shm;
  float*wsf=(float*)(shm+LDS_WS)+wid*64;
  const bf16*ksrc=Kh+(long)lane*KP+wid*8;
  const bf16*vsrc=Vh+(long)(16*(wid&3)+(lane>>2))*KP+(wid>>2)*32+(lane&3)*8;
  const unsigned kdst=lds0+LDS_K+wid*1024, vdst=lds0+LDS_V+wid*1024;
  #define DMA_K(t,slot) glds16(ksrc+(long)(t)*KVBLK*KP,(unsigned)__builtin_amdgcn_readfirstlane(kdst+(slot)))
  #define DMA_V(t,slot) glds16(vsrc+(long)(t)*KVBLK*KP,(unsigned)__builtin_amdgcn_readfirstlane(vdst+(slot)))
  const int vb0=(int)(lds0+LDS_V)+((lane>>4)&1)*32+(lane&3)*8+(4*hi+((lane&15)>>2))*64;
  const char*Kbase=shm+LDS_K; bf16x8 kf[8];
  const lds_cptr shm3=(lds_cptr)shm; const lds_cptr kp0=shm3+LDS_K+hi*1024+r32*16; const lds_cptr vp0=shm3+LDS_V+((lane>>4)&1)*32+(lane&3)*8+(4*hi+((lane&15)>>2))*64;
  DMA_K(0,0);DMA_V(0,0);DMA_K(1,SLOTB);
  bf16x8 qr[4];
  #pragma unroll
  for(int d0=0;d0<4;++d0)qr[d0]=*reinterpret_cast<const bf16x8*>(&Qw[(long)r32*QP+d0*16+hi*8]);
  float mhat=0.f,l_reg=0.f;f32x16 o[2];o[0]=f32x16{};o[1]=f32x16{};f32x16 negm=f32x16{};asm volatile("":"+v"(negm));
  #define CMASK(P0,P1,t) do{}while(0)
  bool resc=false;
  #define START(P0,P1) do{ const float rm=rowmax(P0,P1); resc=false; \
    { const float dl=rm; mhat=fadd_s(mhat,dl); \
      _Pragma("unroll") for(int r=0;r<16;++r){P0[r]=fsub_s(P0[r],dl);P1[r]=fsub_s(P1[r],dl);} \
      _Pragma("unroll") for(int r=0;r<16;++r)negm[r]=-mhat; asm volatile("":"+v"(negm)); } \
    _Pragma("unroll") for(int r=0;r<16;++r)P0[r]=__builtin_amdgcn_exp2f(P0[r]); }while(0)
  #define RESC() do{ if(resc){ asm volatile("s_waitcnt lgkmcnt(0)":::"memory"); \
      _Pragma("unroll") for(int d_=0;d_<2;++d_) _Pragma("unroll") for(int r=0;r<16;++r)o[d_][r]*=wsf[crow(r,hi)]; } }while(0)
  f32x16 pA0,pA1,pB0,pB1;
  int sl_prev=0,sl_cur=0,sl_next=SLOTB;
  #define ROT() do{sl_prev=sl_cur;sl_cur=sl_next;sl_next=(sl_next==(NSLOT-1)*SLOTB)?0:sl_next+SLOTB;}while(0)
  DMA_K(2,2*SLOTB);
  WAIT_BAR(3);
  qkt(pA0,pA1,Kbase,qr,negm,r32,hi);asm volatile("s_nop 15\n\ts_nop 7":"+v"(pA0),"+v"(pA1));CMASK(pA0,pA1,0);
  START(pA0,pA1);
  _Pragma("unroll") for(int r=0;r<16;++r)pA1[r]=__builtin_amdgcn_exp2f(pA1[r]);
  WAIT_BAR(0);
  DMA_K(3,0);DMA_V(1,SLOTB);
  ROT();
  kload8(kf,kp0+sl_cur);
  WAIT_BAR(2);
  s16x4 vlo[8],vhi[8]; u32x4 pw0,pw1,pw2,pw3;
  #define PKW(P,B) cvtpk_s(P[B],P[B+1])
  #define PAF(k) __builtin_bit_cast(bf16x8,pw##k)
  #define VFR(i) (bf16x8){vlo[i][0],vlo[i][1],vlo[i][2],vlo[i][3],vhi[i][0],vhi[i][1],vhi[i][2],vhi[i][3]}
  #define PIN(x) asm volatile("":"+v"(x))
  #define MX3(a,b,c) __builtin_fmaxf(__builtin_fmaxf((a),(b)),(c))
  #define GAPA(MF,A0,A1,A2,A3,W0,W1,PW) do{ MF; sacc+=A0; sacc+=A1; sacc+=A2; sacc+=A3; PIN(sacc); W0; W1; PIN(PW); SBAR(); }while(0)
  #define EX(v) __builtin_amdgcn_exp2f(v)
  #define GAPB(MF,X,B) do{ MF; X[B]=EX(X[B]); X[B+1]=EX(X[B+1]); X[B+2]=EX(X[B+2]); X[B+3]=EX(X[B+3]); PIN(X); SBAR(); }while(0)
  #define VRD(i) do{ vlo[i]=vtr(vp_+(((i)>>2)*4096+((i)&3)*1024)); vhi[i]=vtr(vp_+(((i)>>2)*4096+((i)&3)*1024+512)); }while(0)
  #define KRD(G,j) do{ if(G){ kload2(kf,kp0+sl_next,j); SBAR(); } }while(0)
  #define STEP(C0,C1,P0,P1,t,GK,GV,GL) do{ SBAR(); \
    const lds_cptr vp_=vp0+sl_prev; \
    VRD(0); SBAR(); float sacc=(P0[0]+P0[1]); \
    GAPA(C0=__builtin_amdgcn_mfma_f32_32x32x16_bf16(kf[0],qr[0],negm,0,0,0), P0[2],P0[3],P0[4],P0[5],     pw0[0]=PKW(P0,0), pw0[1]=PKW(P0,2), pw0); \
    VRD(4); SBAR(); GAPA(C1=__builtin_amdgcn_mfma_f32_32x32x16_bf16(kf[1],qr[0],negm,0,0,0), P0[6],P0[7],P0[8],P0[9],     pw0[2]=PKW(P0,4), pw0[3]=PKW(P0,6), pw0); \
    VRD(1); SBAR(); GAPA(C0=__builtin_amdgcn_mfma_f32_32x32x16_bf16(kf[2],qr[1],C0,0,0,0),   P0[10],P0[11],P0[12],P0[13], pw1[0]=PKW(P0,8), pw1[1]=PKW(P0,10), pw1); \
    VRD(5); SBAR(); GAPA(C1=__builtin_amdgcn_mfma_f32_32x32x16_bf16(kf[3],qr[1],C1,0,0,0),   P0[14],P0[15],P1[0],P1[1],   pw1[2]=PKW(P0,12),pw1[3]=PKW(P0,14), pw1); \
    VRD(2); SBAR(); GAPA(C0=__builtin_amdgcn_mfma_f32_32x32x16_bf16(kf[4],qr[2],C0,0,0,0),   P1[2],P1[3],P1[4],P1[5],     pw2[0]=PKW(P1,0), pw2[1]=PKW(P1,2), pw2); \
    VRD(6); SBAR(); GAPA(C1=__builtin_amdgcn_mfma_f32_32x32x16_bf16(kf[5],qr[2],C1,0,0,0),   P1[6],P1[7],P1[8],P1[9],     pw2[2]=PKW(P1,4), pw2[3]=PKW(P1,6), pw2); \
    VRD(3); SBAR(); GAPA(C0=__builtin_amdgcn_mfma_f32_32x32x16_bf16(kf[6],qr[3],C0,0,0,0),   P1[10],P1[11],P1[12],P1[13], pw3[0]=PKW(P1,8), pw3[1]=PKW(P1,10), pw3); \
    VRD(7); SBAR(); GAPA(C1=__builtin_amdgcn_mfma_f32_32x32x16_bf16(kf[7],qr[3],C1,0,0,0),   P1[14],P1[15],0.f,0.f,       pw3[2]=PKW(P1,12),pw3[3]=PKW(P1,14), pw3); \
    l_reg+=sacc; \
    if(GK){DMA_K((t)+3,sl_cur);} if(GV){DMA_V((t)+1,sl_next);} \
    CMASK(C0,C1,t); \
    { float a=MX3(C0[0],C0[1],C1[0]),b=MX3(C0[2],C0[3],C1[1]); a=MX3(a,C1[2],C1[3]); \
      _Pragma("unroll") for(int r=4;r<16;r+=4){a=MX3(a,C0[r],C0[r+1]);b=MX3(b,C0[r+2],C0[r+3]);a=MX3(a,C1[r],C1[r+1]);b=MX3(b,C1[r+2],C1[r+3]);} \
      float rm=__builtin_fmaxf(a,b); { auto rr=__builtin_amdgcn_permlane32_swap(__float_as_uint(rm),__float_as_uint(rm),false,false); rm=__builtin_fmaxf(__uint_as_float(rr[0]),__uint_as_float(rr[1])); } \
      resc=false; \
      if(__builtin_expect(__any(rm>(float)THRL),0)){ const float dl=__builtin_fmaxf(rm,0.f); mhat+=dl; \
        _Pragma("unroll") for(int r=0;r<16;++r){C0[r]-=dl;C1[r]-=dl;} \
        _Pragma("unroll") for(int r=0;r<16;++r)negm[r]=-mhat; asm volatile("":"+v"(negm)); \
        const float f=__builtin_amdgcn_exp2f(-dl); l_reg*=f; if(hi==0)wsf[r32]=f; resc=true; } } \
    SBAR(); \
    GAPB(o[0]=__builtin_amdgcn_mfma_f32_32x32x16_bf16(PAF(0),VFR(0),o[0],0,0,0), C0,0); \
    GAPB(o[1]=__builtin_amdgcn_mfma_f32_32x32x16_bf16(PAF(0),VFR(4),o[1],0,0,0), C0,4); \
    KRD(GL,0); GAPB(o[0]=__builtin_amdgcn_mfma_f32_32x32x16_bf16(PAF(1),VFR(1),o[0],0,0,0), C0,8); \
    KRD(GL,1); GAPB(o[1]=__builtin_amdgcn_mfma_f32_32x32x16_bf16(PAF(1),VFR(5),o[1],0,0,0), C0,12); \
    KRD(GL,2); GAPB(o[0]=__builtin_amdgcn_mfma_f32_32x32x16_bf16(PAF(2),VFR(2),o[0],0,0,0), C1,0); \
    KRD(GL,3); GAPB(o[1]=__builtin_amdgcn_mfma_f32_32x32x16_bf16(PAF(2),VFR(6),o[1],0,0,0), C1,4); \
    GAPB(o[0]=__builtin_amdgcn_mfma_f32_32x32x16_bf16(PAF(3),VFR(3),o[0],0,0,0), C1,8); \
    GAPB(o[1]=__builtin_amdgcn_mfma_f32_32x32x16_bf16(PAF(3),VFR(7),o[1],0,0,0), C1,12); \
    }while(0)
  int t=1;
  #undef CMASK
  #define CMASK(P0,P1,t) do{}while(0)
  for(;t+5<NT;t+=2){
    STEP(pB0,pB1,pA0,pA1,t,true,true,true);     WAIT_BAR(2); RESC(); ROT();
    STEP(pA0,pA1,pB0,pB1,t+1,true,true,true);   WAIT_BAR(2); RESC(); ROT();
  }
  #undef CMASK
  #define CMASK(P0,P1,t) do{}while(0)
  #define ENDW(tt) do{ if((tt)+3<NT){WAIT_BAR(2);} else if((tt)+2<NT){WAIT_BAR(1);} else {WAIT_BAR(0);} }while(0)
  for(;t+1<NT;t+=2){
    STEP(pB0,pB1,pA0,pA1,t,(t+3<NT),(t+1<NT),(t+1<NT));       ENDW(t);   RESC(); ROT();
    STEP(pA0,pA1,pB0,pB1,t+1,(t+4<NT),(t+2<NT),(t+2<NT));     ENDW(t+1); RESC(); ROT();
  }
  STEP(pB0,pB1,pA0,pA1,NT-1,false,false,false); RESC();
  { float sacc=pB0[0]+pB0[1]; _Pragma("unroll") for(int r=2;r<16;++r)sacc+=pB0[r]; _Pragma("unroll") for(int r=0;r<16;++r)sacc+=pB1[r]; l_reg+=sacc;
    pw0=(u32x4){PKW(pB0,0),PKW(pB0,2),PKW(pB0,4),PKW(pB0,6)};pw1=(u32x4){PKW(pB0,8),PKW(pB0,10),PKW(pB0,12),PKW(pB0,14)};pw2=(u32x4){PKW(pB1,0),PKW(pB1,2),PKW(pB1,4),PKW(pB1,6)};pw3=(u32x4){PKW(pB1,8),PKW(pB1,10),PKW(pB1,12),PKW(pB1,14)};
    SBAR(); pv(o,vb0+sl_cur,PAF(0),PAF(1),PAF(2),PAF(3)); }
  #undef PKW
  #undef PAF
  #undef VFR
  #undef PIN
  #undef MX3
  #undef GAPA
  #undef GAPB
  #undef EX
  #undef VRD
  #undef KRD
  #undef STEP
  #undef ENDW
  {auto rr=__builtin_amdgcn_permlane32_swap(__float_as_uint(l_reg),__float_as_uint(l_reg),false,false);l_reg=__uint_as_float(rr[0])+__uint_as_float(rr[1]);}
  if(hi==0)wsf[32+r32]=l_reg;asm volatile("s_waitcnt lgkmcnt(0)":::"memory");
  float rli[16];
  #pragma unroll
  for(int r=0;r<16;++r)rli[r]=__builtin_amdgcn_rcpf(wsf[32+crow(r,hi)]);
  bf16*Ow=O0+(long)(wid*QBLK)*OP;
  { bf16*stg=(bf16*)(shm+LDS_OST)+wid*2048;
    #pragma unroll
    for(int r=0;r<16;++r){const int orow=crow(r,hi);
      #pragma unroll
      for(int d0=0;d0<2;++d0)stg[orow*64+d0*32+r32]=__float2bfloat16(o[d0][r]*rli[r]);}
    asm volatile("s_waitcnt lgkmcnt(0)":::"memory");
    #pragma unroll
    for(int i=0;i<4;++i){const int row=i*8+(lane>>3),ch=lane&7; const u32x4 v=*(const u32x4*)(stg+row*64+ch*8); ATTN_STORE16(Ow+(long)row*OP+ch*8,v);} }
  asm volatile("s_waitcnt lgkmcnt(0)\n\ts_barrier":::"memory");
  #undef DMA_K
  #undef DMA_V
  #undef CMASK
  #undef START
  #undef RESC
  #undef ROT
}
constexpr int ATTN_LDS_BYTES=LDS_BYTES;
#undef SBAR
#undef WAIT_BAR
}

struct Params {
    const float* in[35];
    float* out;
    unsigned char* ws;
    int ph_lo, ph_hi;
};
enum { I_X = 0, I_C, I_CTX, I_CCTX, I_WMOD, I_BMOD, I_GMIX, I_GFFN, I_MIXWIN, I_MIXWOUT, I_QG, I_KG, I_LNG, I_WSP, I_BSP,
       I_S5WIN, I_ARE, I_AIM, I_LOGDT, I_BRE, I_BIM, I_CRE, I_CIM, I_S5D, I_WGLU, I_BGLU, I_S5WOUT,
       I_WGRP, I_BGRP, I_WRT, I_BRT, I_W1, I_W3, I_W2, I_FING };

struct Ctx {
    const Params* p;
    unsigned char* ws;
    LAS unsigned char* lds;
    int tid, lane, wave, gw, ngw;
};
__device__ __forceinline__ const float* xin_row(const Params& P, int r) { return r < TL ? P.in[I_X] + (size_t)r * D : P.in[I_CTX] + (size_t)(r - TL) * D; }
__device__ __forceinline__ int cond_of(int r) { return r < TL ? (r >> 11) : 16; }
__device__ __forceinline__ const float* mod_vec(const Ctx& C, int layer, int ci, int k) { return (const float*)(C.ws + WS_MOD) + ((size_t)(layer * 17 + ci) * 6 + k) * D; }

__device__ __forceinline__ void dsincos(double a, double& s, double& c) {
    const double TWO_PI_HI = 6.283185307179586, TWO_PI_LO = 2.4492935982947064e-16;
    const double k = rint(a * 0.15915494309189535);
    double r = fma(-k, TWO_PI_HI, a); r = fma(-k, TWO_PI_LO, r);
    const double r2 = r * r; double ct = 1.0, st = r, cs = 1.0, ss = r;
#pragma unroll 1
    for (int i = 1; i <= 15; ++i) { ct *= -r2 / (double)((2 * i - 1) * (2 * i)); cs += ct; st *= -r2 / (double)((2 * i) * (2 * i + 1)); ss += st; }
    s = ss; c = cs;
}

__device__ __forceinline__ void transpose_item(const float* src, int N, int k0, int n0, bf16* dst, int dpitch, LAS float* scr, int lane) {
#pragma unroll 8
    for (int i = 0; i < 32; ++i) { const int kk = 2 * i + (lane >> 5); scr[kk * 33 + (lane & 31)] = src[(size_t)(k0 + kk) * N + n0 + (lane & 31)]; }
    asm volatile("s_waitcnt lgkmcnt(0)" ::: "memory");
    const int c = lane & 7;
#pragma unroll
    for (int j = 0; j < 4; ++j) { const int n = (lane >> 3) + 8 * j; const LAS float* s = scr + (8 * c) * 33 + n;
        v4u o; o.x = pk2(s[0 * 33], s[1 * 33]); o.y = pk2(s[2 * 33], s[3 * 33]); o.z = pk2(s[4 * 33], s[5 * 33]); o.w = pk2(s[6 * 33], s[7 * 33]);
        *(v4u*)(dst + (size_t)n * dpitch + 8 * c) = o; }
    asm volatile("s_waitcnt lgkmcnt(0)" ::: "memory");
}
__device__ __forceinline__ void transpose_mat_item(const float* W, int K, int N, bf16* WT, int it, LAS float* scr, int lane) {
    const int nblk = N / 32, kb = it / nblk, nb = it % nblk;
    transpose_item(W, N, kb * 64, nb * 32, WT + (size_t)(nb * 32) * K + kb * 64, K, scr, lane);
}
constexpr int MOE_ITEMS = NEXP * 768;
__device__ __forceinline__ void moe_convert_item(const Ctx& C, int layer, int it, LAS float* scr) {
    const Params& P = *C.p;
    const int e = it / 768, r = it % 768, kind = r / 256, j = r % 256;
    if (kind < 2) {
        const float* src = (kind == 0 ? P.in[I_W1] : P.in[I_W3]) + ((size_t)layer * NEXP + e) * D * EH;
        const int kb = j / 16, nb = j % 16, k0 = kb * 64, n0 = nb * 32;
        const int drow = (n0 / 128) * 256 + (n0 % 128) + (kind == 1 ? 128 : 0);
        transpose_item(src, EH, k0, n0, (bf16*)(C.ws + WS_W13) + (size_t)e * 1024 * 1024 + (size_t)drow * 1024 + k0, 1024, scr, C.lane);
    } else {
        const float* src = P.in[I_W2] + ((size_t)layer * NEXP + e) * EH * D;
        const int kb = j / 32, nb = j % 32, k0 = kb * 64, n0 = nb * 32;
        transpose_item(src, D, k0, n0, (bf16*)(C.ws + WS_W2) + (size_t)e * 1024 * 512 + (size_t)n0 * 512 + k0, 512, scr, C.lane);
    }
}

__device__ __forceinline__ void phase_prologue(const Ctx& C) {
    const Params& P = *C.p;
    {
        LAS float* s = (LAS float*)C.lds;
        LAS float* red = (LAS float*)(C.lds + 17 * 1024 * 4);
        bool have_s = false;
        for (int u = blockIdx.x; u < 192; u += gridDim.x) {
            if (!have_s) {
                for (int i = C.tid; i < 17 * 1024; i += NTHR) { const int ci = i >> 10, k = i & 1023; const float v = ci < 16 ? P.in[I_C][ci * D + k] : P.in[I_CCTX][k]; s[i] = silu_(v); }
                have_s = true; __syncthreads();
            }
            const int layer = u / 96, jg = u % 96, kq = C.tid >> 6, jc = C.tid & 63;
            const float* w = P.in[I_WMOD] + (size_t)layer * D * 6144 + jg * 64 + jc;
            float acc[17];
#pragma unroll
            for (int i = 0; i < 17; ++i) acc[i] = 0.f;
            for (int k = kq * 128; k < kq * 128 + 128; ++k) { const float wv = w[(size_t)k * 6144];
#pragma unroll
                for (int i = 0; i < 17; ++i) acc[i] += s[i * 1024 + k] * wv; }
#pragma unroll
            for (int i = 0; i < 17; ++i) red[(kq * 17 + i) * 64 + jc] = acc[i];
            __syncthreads();
            for (int o = C.tid; o < 17 * 64; o += NTHR) { const int ci = o >> 6, c = o & 63; float v = 0.f;
#pragma unroll
                for (int q = 0; q < 8; ++q) v += red[(q * 17 + ci) * 64 + c];
                const int j = jg * 64 + c; v += P.in[I_BMOD][layer * 6144 + j];
                ((float*)(C.ws + WS_MOD))[((size_t)(layer * 17 + ci)) * 6144 + j] = v; }
            __syncthreads();
        }
        __syncthreads();
    }
    {
        const int gt = blockIdx.x * NTHR + C.tid, ngt = gridDim.x * NTHR;
        float2* rope = (float2*)(C.ws + WS_TAB + TAB_ROPE);
        for (int i = gt; i < 64 * 16; i += ngt) { const int pos = i >> 4, f = i & 15;
            const double th = exp(-(double)f * (9.210340371976184 / 16.0)); double s, c; dsincos((double)pos * th, s, c); rope[i] = make_float2((float)c, (float)s); }
        float2* lamb = (float2*)(C.ws + WS_TAB + TAB_LAMB); float2* bbar = (float2*)(C.ws + WS_TAB + TAB_BBAR);
        for (int i = gt; i < 2 * 32 * 64; i += ngt) {
            const int dg = i >> 6;
            const double are = P.in[I_ARE][i], aim = P.in[I_AIM][i], dt = exp((double)P.in[I_LOGDT][dg]);
            double s, c; dsincos(aim * dt, s, c); const double mag = exp(are * dt), lr = mag * c, li = mag * s;
            lamb[i] = make_float2((float)lr, (float)li);
            const double den = are * are + aim * aim, nr = lr - 1.0, ni = li;
            const double cr = (nr * are + ni * aim) / den, cim = (ni * are - nr * aim) / den;
            for (int p = 0; p < 16; ++p) { const double br = P.in[I_BRE][(size_t)i * 16 + p], bi = P.in[I_BIM][(size_t)i * 16 + p];
                bbar[(size_t)i * 16 + p] = make_float2((float)(cr * br - cim * bi), (float)(cr * bi + cim * br)); }
        }
    }
    {
        const int gt = blockIdx.x * NTHR + C.tid, ngt = gridDim.x * NTHR;
        bf16* wrt = (bf16*)(C.ws + WS_TAB + TAB_WR);
        for (int idx = gt; idx < 2 * 32 * 3 * 64; idx += ngt) {
            const int ln = idx & 63, jb = (idx >> 6) % 3, kk = (idx / 192) & 31, l = idx / (192 * 32);
            const int i = ln & 15, q = ln >> 4, grp = i >> 2, r = i & 3;
            float hi8[8], lo8[8];
#pragma unroll
            for (int e = 0; e < 8; ++e) { const int k = 32 * kk + 8 * q + e;
                const float w = jb < 2 ? P.in[I_WRT][((size_t)l * D + k) * 32 + grp * 8 + jb * 4 + r] : (r == 0 ? P.in[I_WGRP][((size_t)l * D + k) * 4 + grp] : 0.f);
                const float h = bf2f(f2bf(w)); hi8[e] = h; lo8[e] = w - h; }
            v4u oh, ol; oh.x = pk2(hi8[0], hi8[1]); oh.y = pk2(hi8[2], hi8[3]); oh.z = pk2(hi8[4], hi8[5]); oh.w = pk2(hi8[6], hi8[7]);
            ol.x = pk2(lo8[0], lo8[1]); ol.y = pk2(lo8[2], lo8[3]); ol.z = pk2(lo8[4], lo8[5]); ol.w = pk2(lo8[6], lo8[7]);
            const size_t base = ((((size_t)l * 32 + kk) * 3 + jb) * 2) * 64 + ln;
            *(v4u*)(wrt + base * 8) = oh; *(v4u*)(wrt + (base + 64) * 8) = ol;
        }
    }
    {
        const int gt = blockIdx.x * NTHR + C.tid, ngt = gridDim.x * NTHR; bf16* w16 = (bf16*)(C.ws + WS_WSP);
        for (int i = gt; i < 8 * 128 * 128 / 4; i += ngt) { const f32x4 v = *(const f32x4*)(P.in[I_WSP] + 4 * (size_t)i); v2u o; o.x = pk2(v.x, v.y); o.y = pk2(v.z, v.w); *(v2u*)(w16 + 4 * (size_t)i) = o; }
    }
    {
        LAS float* scr = (LAS float*)(C.lds + C.wave * 16384);
        constexpr int I0 = 16 * 56, I1 = 16 * 32, I2 = 16 * 16, I3 = 8 * 16, I4 = 8 * 32;
        constexpr int NSMALL = I0 + I1 + I2 + I3 + I4;
        for (int it = C.gw; it < NSMALL + MOE_ITEMS; it += C.ngw) {
            int r = it;
            if (r < I0) { transpose_mat_item(P.in[I_MIXWIN], D, MIXW, (bf16*)(C.ws + WS_WIN0), r, scr, C.lane); continue; } r -= I0;
            if (r < I1) { transpose_mat_item(P.in[I_MIXWOUT], D, D, (bf16*)(C.ws + WS_WOUT0), r, scr, C.lane); continue; } r -= I1;
            if (r < I2) { transpose_mat_item(P.in[I_S5WIN], D, 512, (bf16*)(C.ws + WS_WS5IN), r, scr, C.lane); continue; } r -= I2;
            if (r < I3) { transpose_mat_item(P.in[I_WGLU], 512, 512, (bf16*)(C.ws + WS_WGLU), r, scr, C.lane); continue; } r -= I3;
            if (r < I4) { transpose_mat_item(P.in[I_S5WOUT], 512, D, (bf16*)(C.ws + WS_WS5OUT), r, scr, C.lane); continue; } r -= I4;
            moe_convert_item(C, 0, r, scr);
        }
    }
}

__device__ __forceinline__ void load_row16(const float* row, int lane, f32x4 (&v)[4]) {
#pragma unroll
    for (int j = 0; j < 4; ++j) v[j] = *(const f32x4*)(row + 4 * lane + 256 * j);
}
__device__ __forceinline__ float row_rstd(const f32x4 (&v)[4]) {
    float s = 0.f;
#pragma unroll
    for (int j = 0; j < 4; ++j) s += (v[j].x * v[j].x + v[j].y * v[j].y) + (v[j].z * v[j].z + v[j].w * v[j].w);
    return rsqrtf(wave_sum(s) * (1.f / D) + EPS);
}
__device__ __forceinline__ void modulate16(f32x4 (&v)[4], float rstd, const float* g, const float* scale, const float* shift, int lane) {
#pragma unroll
    for (int j = 0; j < 4; ++j) { const int c = 4 * lane + 256 * j; const f32x4 gg = *(const f32x4*)(g + c), sc = *(const f32x4*)(scale + c), sh = *(const f32x4*)(shift + c);
        v[j] = v[j] * rstd * gg * (sc + 1.f) + sh; }
}
__device__ __forceinline__ void store_row16_bf16(bf16* row, int lane, const f32x4 (&v)[4]) {
#pragma unroll
    for (int j = 0; j < 4; ++j) { v2u o; o.x = pk2(v[j].x, v[j].y); o.y = pk2(v[j].z, v[j].w); *(v2u*)(row + 4 * lane + 256 * j) = o; }
}

__device__ __forceinline__ void phase_norm_mix0(const Ctx& C) {
    const Params& P = *C.p; bf16* H = (bf16*)(C.ws + WS_H);
    f32x4 a[4], b[4]; const int n = C.ngw; int r = C.gw;
    if (r < TT) load_row16(xin_row(P, r), C.lane, a);
    if (r + n < TT) load_row16(xin_row(P, r + n), C.lane, b);
#define NM0_ROW(buf, rr, rnext) do { f32x4 v[4] = {buf[0], buf[1], buf[2], buf[3]}; if ((rnext) < TT) load_row16(xin_row(P, (rnext)), C.lane, buf); \
        const float rstd = row_rstd(v); const int ci = cond_of(rr); modulate16(v, rstd, P.in[I_GMIX], mod_vec(C, 0, ci, 1), mod_vec(C, 0, ci, 0), C.lane); store_row16_bf16(H + (size_t)(rr) * D, C.lane, v); } while (0)
    for (; r < TT; r += 2 * n) { NM0_ROW(a, r, r + 2 * n); if (r + n < TT) NM0_ROW(b, r + n, r + 3 * n); }
#undef NM0_ROW
}

__device__ __forceinline__ void qk_norm_rope(float (&v)[8], const float* gain, bool lat, int t, int lane, const float2* rope) {
    float ss = 0.f;
#pragma unroll
    for (int j = 0; j < 8; ++j) ss += v[j] * v[j];
    ss += __shfl_xor(ss, 1); ss += __shfl_xor(ss, 2); ss += __shfl_xor(ss, 4);
    const float rstd = rsqrtf(ss * (1.f / 64.f) + EPS);
    const int l8 = lane & 7;
#pragma unroll
    for (int j = 0; j < 8; ++j) v[j] = v[j] * rstd * gain[l8 * 8 + j];
    const int quarter = l8 >> 1, pos = (quarter < 2) ? (t >> 6) : (t & 63);
#pragma unroll
    for (int j = 0; j < 8; ++j) {
        const float pv = __shfl_xor(v[j], 2);
        if (lat) { const float2 cs = rope[pos * 16 + (lane & 1) * 8 + j];
            v[j] = (quarter & 1) ? (v[j] * cs.x + pv * cs.y) : (v[j] * cs.x - pv * cs.y); }
    }
}
__device__ __forceinline__ void phase_qkprep(const Ctx& C) {
    const Params& P = *C.p; const bf16* Pb = (const bf16*)(C.ws + WS_P); bf16* Q = (bf16*)(C.ws + WS_Q); bf16* Kb = (bf16*)(C.ws + WS_K); bf16* Vb = (bf16*)(C.ws + WS_V);
    const float2* rope = (const float2*)(C.ws + WS_TAB + TAB_ROPE);
    struct Raw { v4u q, k, v, g; };
    const int l16 = C.lane & 15, n = C.ngw;
#define QK_LOAD(dst, rr) do { const bf16* pr_ = Pb + (size_t)(rr) * MIXW; dst.q = *(const v4u*)(pr_ + 8 * C.lane); dst.k = *(const v4u*)(pr_ + 512 + 8 * l16); dst.v = *(const v4u*)(pr_ + 640 + 8 * l16); dst.g = *(const v4u*)(pr_ + 1280 + 8 * C.lane); } while (0)
#define QK_ROW(buf, rr, rnext) do { const Raw w_ = buf; if ((rnext) < TT) QK_LOAD(buf, (rnext)); const int r = (rr); \
        const bool lat = r < TL; const int t = lat ? (r & 2047) : 0; \
        const size_t kvrow = lat ? (size_t)(r >> 11) * KVL + CTXL + (r & 2047) : (size_t)((r - TL) >> 8) * KVL + ((r - TL) & 255); \
        { float v[8]; unpack8(w_.q, v); qk_norm_rope(v, P.in[I_QG], lat, t, C.lane, rope); \
          v4u o; o.x = pk2(v[0] * QSCALE, v[1] * QSCALE); o.y = pk2(v[2] * QSCALE, v[3] * QSCALE); o.z = pk2(v[4] * QSCALE, v[5] * QSCALE); o.w = pk2(v[6] * QSCALE, v[7] * QSCALE); \
          *(v4u*)(Q + (size_t)r * 512 + 8 * C.lane) = o; } \
        { float v[8]; unpack8(w_.k, v); qk_norm_rope(v, P.in[I_KG], lat, t, C.lane, rope); \
          if (C.lane < 16) { v4u o; o.x = pk2(v[0], v[1]); o.y = pk2(v[2], v[3]); o.z = pk2(v[4], v[5]); o.w = pk2(v[6], v[7]); *(v4u*)(Kb + kvrow * 128 + 8 * l16) = o; *(v4u*)(Vb + kvrow * 128 + 8 * l16) = w_.v; } } \
        { float v[8]; unpack8(w_.g, v); float sm = 0.f; \
          _Pragma("unroll") for (int j = 0; j < 8; ++j) { v[j] = gelu_tanh(v[j]); sm += v[j]; } \
          const float mean = wave_sum(sm) * (1.f / 512.f); float qq = 0.f; \
          _Pragma("unroll") for (int j = 0; j < 8; ++j) { const float d = v[j] - mean; qq += d * d; } \
          const float rstd = rsqrtf(wave_sum(qq) * (1.f / 512.f) + EPS); \
          if (C.lane == 0) ((float2*)(C.ws + WS_ROUTE + RT_S))[r] = make_float2(mean, rstd); } } while (0)
    Raw a, b; int r0 = C.gw;
    if (r0 < TT) QK_LOAD(a, r0);
    if (r0 + n < TT) QK_LOAD(b, r0 + n);
    for (; r0 < TT; r0 += 2 * n) { QK_ROW(a, r0, r0 + 2 * n); if (r0 + n < TT) QK_ROW(b, r0 + n, r0 + 3 * n); }
#undef QK_LOAD
#undef QK_ROW
}

__device__ __forceinline__ unsigned gm_off_b(unsigned row, unsigned ch) { return 256u * row + 16u * (ch ^ (((row & 3u) << 2) | ((row >> 2) & 3u))); }
__device__ __forceinline__ void phase_gmlp_fast(const Ctx& C) {
    typedef short bf16x8 __attribute__((ext_vector_type(8)));
    typedef short s16x4 __attribute__((ext_vector_type(4)));
    typedef float f32x16 __attribute__((ext_vector_type(16)));
    const Params& P = *C.p; const bf16* Pb = (const bf16*)(C.ws + WS_P); bf16* OG = (bf16*)(C.ws + WS_H); const bf16* W16 = (const bf16*)(C.ws + WS_WSP);
    const float2* lns = (const float2*)(C.ws + WS_ROUTE + RT_S);
    const int tid = C.tid, lane = C.lane, w = C.wave, l31 = lane & 31, hi = lane >> 5;
    const int gsel = w >> 2, pb = w & 3;
    for (int u = blockIdx.x; u < (TT / 128) * 4; u += gridDim.x) {
        const int ch_ = u >> 2, gp = u & 3;
        { const int row = tid >> 2; const size_t grow = (size_t)ch_ * 128 + row; const float2 st = lns[grow];
#pragma unroll
          for (int i = 0; i < 4; ++i) { const int c16 = (tid & 3) + 4 * i; float v[8]; unpack8(*(const v4u*)(Pb + grow * MIXW + 1280 + 128 * gp + 8 * c16), v);
              const float* lg = P.in[I_LNG] + 128 * gp + 8 * c16;
#pragma unroll
              for (int j = 0; j < 8; ++j) v[j] = (gelu_tanh(v[j]) - st.x) * st.y * lg[j];
              v4u o; o.x = pk2(v[0], v[1]); o.y = pk2(v[2], v[3]); o.z = pk2(v[4], v[5]); o.w = pk2(v[6], v[7]);
              *(LAS v4u*)(C.lds + (row >> 5) * 8192 + gm_off_b(row & 31, c16)) = o; } }
        __syncthreads();
        const int g = 2 * gp + gsel;
        f32x16 acc[2]; acc[0] = f32x16{}; acc[1] = f32x16{};
        const bf16* wrow = W16 + ((size_t)g * 128 + 32 * pb + l31) * 128 + 8 * hi;
#pragma unroll
        for (int k8 = 0; k8 < 8; ++k8) {
            const bf16x8 xf = *(const bf16x8*)(wrow + 16 * k8);
            const unsigned rb = k8 >> 1, ks = k8 & 1;
#pragma unroll
            for (int db = 0; db < 2; ++db) { const unsigned c = 2 * gsel + db, blk = (lane >> 4) & 1, q = (lane & 15) >> 2, p2 = lane & 3;
                s16x4 t0, t1;
                { const unsigned a0 = rb * 8192 + gm_off_b(16 * ks + 8 * hi + q, 4 * c + 2 * blk + (p2 >> 1)) + 8 * (p2 & 1);
                  const unsigned a1 = rb * 8192 + gm_off_b(16 * ks + 8 * hi + 4 + q, 4 * c + 2 * blk + (p2 >> 1)) + 8 * (p2 & 1);
                  t0 = __builtin_bit_cast(s16x4, __builtin_amdgcn_ds_read_tr16_b64_v4i16((LAS s16x4*)(C.lds + a0)));
                  t1 = __builtin_bit_cast(s16x4, __builtin_amdgcn_ds_read_tr16_b64_v4i16((LAS s16x4*)(C.lds + a1))); }
                const bf16x8 yf = {t0[0], t0[1], t0[2], t0[3], t1[0], t1[1], t1[2], t1[3]};
                acc[db] = __builtin_amdgcn_mfma_f32_32x32x16_bf16(xf, yf, acc[db], 0, 0, 0); }
        }
        const float* bsp = P.in[I_BSP] + g * 128 + 32 * pb;
#pragma unroll
        for (int r = 0; r < 16; ++r) { const int pl = (r & 3) + 8 * (r >> 2) + 4 * hi; const size_t grow = (size_t)ch_ * 128 + 32 * pb + pl; const float bb = bsp[pl];
#pragma unroll
            for (int db = 0; db < 2; ++db) { const int col = 64 * g + 32 * db + l31; const float uu = gelu_tanh(bf2f(Pb[grow * MIXW + 768 + col]));
                OG[grow * D + 512 + col] = (bf16)f2bf(uu * (acc[db][r] + bb)); } }
        __syncthreads();
    }
}

__device__ __forceinline__ void phase_attn_fast(const Ctx& C, char* lds_generic) {
    typedef attn_body::bf16 abf;
    const abf* Q = (const abf*)(C.ws + WS_Q); const abf* Kb = (const abf*)(C.ws + WS_K); const abf* Vb = (const abf*)(C.ws + WS_V); abf* OG = (abf*)(C.ws + WS_H);
    const int G = gridDim.x, bx = blockIdx.x; const int vcu = (G % 8 == 0) ? (bx % 8) * (G / 8) + bx / 8 : bx;
    const int per = (1024 + G - 1) / G, perc = (128 + G - 1) / G;
    for (int i = 0; i < per + perc; ++i) {
        int b, h, nt; size_t qrow;
        if (i < per) { const int u = vcu * per + i; if (u >= 1024) continue; const int qb = u & 7, hg = (u >> 3) & 3, bk = u >> 5; b = bk >> 1; h = (bk & 1) * 4 + hg; qrow = (size_t)b * SEQ + qb * 256; nt = KVL / 64; }
        else { const int u = vcu + (i - per) * G; if (u >= 128) continue; b = u >> 3; h = u & 7; qrow = (size_t)TL + (size_t)b * CTXL; nt = CTXL / 64; }
        const size_t kvo = (size_t)b * KVL * 128 + (h >> 2) * 64;
        attn_body::attn_unit<8>(Q + qrow * 512 + h * 64, Kb + kvo, Vb + kvo, OG + qrow * 1024 + h * 64, nt, lds_generic);
    }
}

__device__ __forceinline__ void phase_router_fast(const Ctx& C, int layer, int nrows) {
    typedef short bf16x8 __attribute__((ext_vector_type(8)));
    const Params& P = *C.p; const bf16* XC = (const bf16*)(C.ws + WS_XC); bf16* F = (bf16*)(C.ws + WS_H);
    int* asg_e = (int*)(C.ws + WS_ROUTE + RT_E); int* asg_p = (int*)(C.ws + WS_ROUTE + RT_P); float* asg_w = (float*)(C.ws + WS_ROUTE + RT_W); int* list = (int*)(C.ws + WS_LIST);
    unsigned* cnt = (unsigned*)(C.ws + WS_CTL) + CW_CNT + 64 * layer;
    const bf16x8* WR = (const bf16x8*)(C.ws + WS_TAB + TAB_WR) + (size_t)layer * (32 * 3 * 2 * 64) + C.lane;
    const int l15 = C.lane & 15, q4 = C.lane >> 4;
    LAS float* ab = (LAS float*)(C.lds + C.wave * 8192);
    LAS unsigned* lcnt = (LAS unsigned*)(C.lds + 65536);
    if (C.tid < 64) lcnt[C.tid] = 0u;
    __syncthreads();
    int cur_ci = -1;
    for (int it = C.gw; it < nrows / 16; it += C.ngw) {
        const int row = it * 16 + l15, ci = cond_of(it * 16);
        if (ci != cur_ci) {
            const float* sc = mod_vec(C, layer, ci, 4); const float* sh = mod_vec(C, layer, ci, 3); const float* g0 = P.in[I_GFFN] + layer * D;
#pragma unroll
            for (int j = 0; j < 4; ++j) { const int c = 4 * C.lane + 256 * j; const f32x4 g4 = *(const f32x4*)(g0 + c), s4 = *(const f32x4*)(sc + c), h4 = *(const f32x4*)(sh + c); const f32x4 a4 = g4 * (s4 + 1.f);
                *(LAS f32x4*)(ab + 2 * c) = (f32x4){a4.x, h4.x, a4.y, h4.y}; *(LAS f32x4*)(ab + 2 * c + 4) = (f32x4){a4.z, h4.z, a4.w, h4.w}; }
            asm volatile("s_waitcnt lgkmcnt(0)" ::: "memory"); cur_ci = ci;
        }
        const bf16* xr = XC + (size_t)row * D + 8 * q4;
        float ss = 0.f;
#pragma unroll 16
        for (int kk = 0; kk < 32; ++kk) { pg8::f32x4 a, b; pg8::unpack8f(*(const pg8::u32x4*)(xr + 32 * kk), a, b); ss += (a.x * a.x + a.y * a.y) + (a.z * a.z + a.w * a.w) + (b.x * b.x + b.y * b.y) + (b.z * b.z + b.w * b.w); }
        ss += __shfl_xor(ss, 16); ss += __shfl_xor(ss, 32);
        const float rstd = rsqrtf(ss * (1.f / D) + EPS);
        f32x4 acc[3]; acc[0] = (f32x4){0.f, 0.f, 0.f, 0.f}; acc[1] = acc[0]; acc[2] = acc[0];
        bf16* frow = F + (size_t)row * D + 8 * q4;
        const LAS float* abl = ab + 16 * q4;
#pragma unroll 1
        for (int k2 = 0; k2 < 16; ++k2) {
            const pg8::u32x4 xa = *(const pg8::u32x4*)(xr + 64 * k2), xb = *(const pg8::u32x4*)(xr + 64 * k2 + 32);
            bf16x8 wf[2][3][2];
#pragma unroll
            for (int h = 0; h < 2; ++h)
#pragma unroll
                for (int jb = 0; jb < 3; ++jb) { wf[h][jb][0] = WR[(((2 * k2 + h) * 3 + jb) * 2) * 64]; wf[h][jb][1] = WR[(((2 * k2 + h) * 3 + jb) * 2 + 1) * 64]; }
#pragma unroll
            for (int h = 0; h < 2; ++h) {
                const int c = 64 * k2 + 32 * h;
                pg8::f32x4 x0, x1; pg8::unpack8f(h ? xb : xa, x0, x1);
                const f32x4 t0 = *(const LAS f32x4*)(abl + 2 * c), t1 = *(const LAS f32x4*)(abl + 2 * c + 4), t2 = *(const LAS f32x4*)(abl + 2 * c + 8), t3 = *(const LAS f32x4*)(abl + 2 * c + 12);
                const f32x4 f0 = x0 * rstd * (f32x4){t0.x, t0.z, t1.x, t1.z} + (f32x4){t0.y, t0.w, t1.y, t1.w};
                const f32x4 f1 = x1 * rstd * (f32x4){t2.x, t2.z, t3.x, t3.z} + (f32x4){t2.y, t2.w, t3.y, t3.w};
                const pg8::u32x4 fh = pg8::pack8(f0, f1); *(pg8::u32x4*)(frow + c) = fh;
                pg8::f32x4 r0, r1; pg8::unpack8f(fh, r0, r1);
                const pg8::u32x4 fl = pg8::pack8(f0 - r0, f1 - r1);
                const bf16x8 ah = __builtin_bit_cast(bf16x8, fh), al = __builtin_bit_cast(bf16x8, fl);
#pragma unroll
                for (int jb = 0; jb < 3; ++jb) {
                    acc[jb] = __builtin_amdgcn_mfma_f32_16x16x32_bf16(wf[h][jb][0], ah, acc[jb], 0, 0, 0);
                    acc[jb] = __builtin_amdgcn_mfma_f32_16x16x32_bf16(wf[h][jb][0], al, acc[jb], 0, 0, 0);
                    acc[jb] = __builtin_amdgcn_mfma_f32_16x16x32_bf16(wf[h][jb][1], ah, acc[jb], 0, 0, 0); }
            }
        }
        const float* brt = P.in[I_BRT] + layer * 32 + q4 * 8;
        float e[8];
#pragma unroll
        for (int r = 0; r < 4; ++r) { e[r] = acc[0][r] + brt[r]; e[4 + r] = acc[1][r] + brt[4 + r]; }
        const float gl = acc[2][0] + P.in[I_BGRP][layer * 4 + q4];
        float gm = gl; int gi = q4;
#pragma unroll
        for (int st = 16; st <= 32; st <<= 1) { const float og = __shfl_xor(gm, st); const int oi = __shfl_xor(gi, st); if (og > gm || (og == gm && oi < gi)) { gm = og; gi = oi; } }
        float den = __expf(gl - gm); den += __shfl_xor(den, 16); den += __shfl_xor(den, 32);
        if (q4 == gi) {
            const float gw_ = 1.f / den;
            int i0 = 0; float v0 = e[0];
#pragma unroll
            for (int i = 1; i < 8; ++i) if (e[i] > v0) { v0 = e[i]; i0 = i; }
            int i1 = -1; float v1 = -INFINITY;
#pragma unroll
            for (int i = 0; i < 8; ++i) if (i != i0 && e[i] > v1) { v1 = e[i]; i1 = i; }
            const float e1 = __expf(v1 - v0), w0 = gw_ / (1.f + e1), w1 = gw_ * e1 / (1.f + e1);
            const int ea = gi * 8 + i0, eb = gi * 8 + i1;
            const unsigned pa = __hip_atomic_fetch_add(lcnt + ea, 1u, __ATOMIC_RELAXED, __HIP_MEMORY_SCOPE_WORKGROUP);
            const unsigned pb = __hip_atomic_fetch_add(lcnt + eb, 1u, __ATOMIC_RELAXED, __HIP_MEMORY_SCOPE_WORKGROUP);
            asg_e[2 * row] = ea; asg_e[2 * row + 1] = eb; asg_p[2 * row] = (int)pa; asg_p[2 * row + 1] = (int)pb; asg_w[2 * row] = w0; asg_w[2 * row + 1] = w1;
        }
    }
    asm volatile("s_waitcnt vmcnt(0) lgkmcnt(0)" ::: "memory");
    __syncthreads();
    if (C.tid < 32) { const unsigned n = lcnt[C.tid]; lcnt[32 + C.tid] = n ? __hip_atomic_fetch_add(cnt + C.tid, n, __ATOMIC_RELAXED, __HIP_MEMORY_SCOPE_AGENT) : 0u; }
    __syncthreads();
    for (int it = C.gw; it < nrows / 16; it += C.ngw) {
        if (C.lane < 32) { const int idx = 2 * (it * 16 + (C.lane & 15)) + (C.lane >> 4);
            const int e = __hip_atomic_load(asg_e + idx, __ATOMIC_RELAXED, __HIP_MEMORY_SCOPE_AGENT); const int p = __hip_atomic_load(asg_p + idx, __ATOMIC_RELAXED, __HIP_MEMORY_SCOPE_AGENT) + (int)lcnt[32 + e];
            asg_p[idx] = p; list[(size_t)e * LCAP + p] = idx >> 1; }
    }
}

__device__ __forceinline__ int wave_pstart(const Ctx& C, int layer) {
    const unsigned* cnt = (const unsigned*)(C.ws + WS_CTL) + CW_CNT + 64 * layer;
    const int mc = C.lane < 32 ? (int)__hip_atomic_load(cnt + (C.lane & 31), __ATOMIC_RELAXED, __HIP_MEMORY_SCOPE_AGENT) : 0; const int mp = (mc + 255) & ~255; int in = mp;
#pragma unroll
    for (int o = 1; o < 32; o <<= 1) { const int t = __shfl_up(in, o); if ((C.lane & 31) >= o) in += t; }
    return in - mp;
}
struct CombRaw { v2u x[4], ya[4], yb[4]; float w0, w1; };
__device__ __forceinline__ void comb_load(const Ctx& C, int r, int ps, CombRaw& o) {
    const bf16* Y2 = (const bf16*)(C.ws + WS_XS); const bf16* XC = (const bf16*)(C.ws + WS_XC); const float* asg_w = (const float*)(C.ws + WS_ROUTE + RT_W);
    const int* asg_e = (const int*)(C.ws + WS_ROUTE + RT_E); const int* asg_p = (const int*)(C.ws + WS_ROUTE + RT_P);
    const int s0 = __shfl(ps, asg_e[2 * r]) + asg_p[2 * r], s1 = __shfl(ps, asg_e[2 * r + 1]) + asg_p[2 * r + 1]; o.w0 = asg_w[2 * r]; o.w1 = asg_w[2 * r + 1];
#pragma unroll
    for (int j = 0; j < 4; ++j) { const int c = 4 * C.lane + 256 * j; o.x[j] = *(const v2u*)(XC + (size_t)r * D + c); o.ya[j] = *(const v2u*)(Y2 + (size_t)s0 * D + c); o.yb[j] = *(const v2u*)(Y2 + (size_t)s1 * D + c); }
}
__device__ __forceinline__ void comb_calc(const Ctx& C, int layer, int r, const CombRaw& w, f32x4 (&v)[4]) {
    const float* gate = mod_vec(C, layer, cond_of(r), 5); const float w0 = w.w0, w1 = w.w1;
#pragma unroll
    for (int j = 0; j < 4; ++j) { const int c = 4 * C.lane + 256 * j; const v2u xx = w.x[j], a = w.ya[j], b = w.yb[j]; const f32x4 g = *(const f32x4*)(gate + c);
        v[j].x = bf2f(xx.x & 0xffffu) + g.x * (w0 * bf2f(a.x & 0xffffu) + w1 * bf2f(b.x & 0xffffu)); v[j].y = bf2f(xx.x >> 16) + g.y * (w0 * bf2f(a.x >> 16) + w1 * bf2f(b.x >> 16));
        v[j].z = bf2f(xx.y & 0xffffu) + g.z * (w0 * bf2f(a.y & 0xffffu) + w1 * bf2f(b.y & 0xffffu)); v[j].w = bf2f(xx.y >> 16) + g.w * (w0 * bf2f(a.y >> 16) + w1 * bf2f(b.y >> 16)); }
}
__device__ __forceinline__ void phase_combine_norm_mix1(const Ctx& C) {
    const Params& P = *C.p; bf16* XC = (bf16*)(C.ws + WS_XC); bf16* H = (bf16*)(C.ws + WS_H);
    const int ps = wave_pstart(C, 0), n = C.ngw;
#define CN_ROW(buf, rr, rnext) do { const CombRaw w_ = buf; if ((rnext) < TT) comb_load(C, (rnext), ps, buf); f32x4 v[4]; comb_calc(C, 0, (rr), w_, v); \
        store_row16_bf16(XC + (size_t)(rr) * D, C.lane, v); const float rstd = row_rstd(v); const int ci = cond_of(rr); \
        modulate16(v, rstd, P.in[I_GMIX] + D, mod_vec(C, 1, ci, 1), mod_vec(C, 1, ci, 0), C.lane); store_row16_bf16(H + (size_t)(rr) * D, C.lane, v); } while (0)
    CombRaw a, b; int r = C.gw;
    if (r < TT) comb_load(C, r, ps, a);
    if (r + n < TT) comb_load(C, r + n, ps, b);
    for (; r < TT; r += 2 * n) { CN_ROW(a, r, r + 2 * n); if (r + n < TT) CN_ROW(b, r + n, r + 3 * n); }
#undef CN_ROW
    LAS float* scr = (LAS float*)(C.lds + C.wave * 16384);
    for (int it = C.gw; it < MOE_ITEMS; it += C.ngw) moe_convert_item(C, 1, it, scr);
}
__device__ __forceinline__ void phase_final(const Ctx& C) {
    const Params& P = *C.p;
    const int ps = wave_pstart(C, 1), n = C.ngw;
#define FN_ROW(buf, rr, rnext) do { const CombRaw w_ = buf; if ((rnext) < TL) comb_load(C, (rnext), ps, buf); f32x4 v[4]; comb_calc(C, 1, (rr), w_, v); const float rstd = row_rstd(v); \
        _Pragma("unroll") for (int j = 0; j < 4; ++j) { const int c = 4 * C.lane + 256 * j; const f32x4 g = *(const f32x4*)(P.in[I_FING] + c); *(f32x4*)(P.out + (size_t)(rr) * D + c) = v[j] * rstd * g; } } while (0)
    CombRaw a, b; int r = C.gw;
    if (r < TL) comb_load(C, r, ps, a);
    if (r + n < TL) comb_load(C, r + n, ps, b);
    for (; r < TL; r += 2 * n) { FN_ROW(a, r, r + 2 * n); if (r + n < TL) FN_ROW(b, r + n, r + 3 * n); }
#undef FN_ROW
}

__device__ __forceinline__ void phase_s5_fast(const Ctx& C) {
    typedef short bf16x8 __attribute__((ext_vector_type(8)));
    typedef float f32x16 __attribute__((ext_vector_type(16)));
    const Params& P = *C.p; const bf16* U = (const bf16*)(C.ws + WS_U); bf16* GS = (bf16*)(C.ws + WS_GS); float* YA = (float*)(C.ws + WS_YACC);
    const float2* lamb = (const float2*)(C.ws + WS_TAB + TAB_LAMB); const float2* bbar = (const float2*)(C.ws + WS_TAB + TAB_BBAR);
    constexpr int HP = 272;
    const int lane = C.lane, w = C.wave, il = w >> 2, dir = (w >> 1) & 1, nh = w & 1;
    const int l31 = lane & 31, hi = lane >> 5, l15 = lane & 15, q4 = lane >> 4;
    LAS unsigned char* Hb = C.lds + (il * 2 + dir) * (2 * 32 * HP);
    const int srow = (l31 & 3) + 4 * (l31 >> 3) + 16 * ((l31 >> 2) & 1);
    for (int it0 = blockIdx.x; it0 < NB * 16; it0 += gridDim.x) {
        const int item = it0 * 2 + il, b = item >> 5, g = item & 31;
        const int dg = dir * 32 + g, n = nh * 32 + l31;
        const float2 lam = lamb[dg * 64 + n];
        float lpr[16], lpi[16]; { float pr = lam.x, pi = lam.y;
#pragma unroll
            for (int r = 0; r < 16; ++r) { lpr[r] = pr; lpi[r] = pi; const float nr = pr * lam.x - pi * lam.y, ni = pr * lam.y + pi * lam.x; pr = nr; pi = ni; } }
        bf16x8 bre, bim; { const float2* bp = bbar + ((size_t)(dg * 64 + n)) * 16 + 8 * hi;
#pragma unroll
            for (int e = 0; e < 8; ++e) { const float2 v = bp[e]; bre[e] = (short)f2bf(v.x); bim[e] = (short)f2bf(v.y); } }
        bf16x8 cf[4]; { const float* cre = P.in[I_CRE] + ((size_t)dg * 16 + l15) * 64; const float* cim = P.in[I_CIM] + ((size_t)dg * 16 + l15) * 64;
#pragma unroll
            for (int ks = 0; ks < 4; ++ks) { const f32x4 a = *(const f32x4*)(cre + 16 * ks + 4 * q4), m = *(const f32x4*)(cim + 16 * ks + 4 * q4);
                cf[ks][0] = (short)f2bf(a.x); cf[ks][1] = (short)f2bf(-m.x); cf[ks][2] = (short)f2bf(a.y); cf[ks][3] = (short)f2bf(-m.y);
                cf[ks][4] = (short)f2bf(a.z); cf[ks][5] = (short)f2bf(-m.z); cf[ks][6] = (short)f2bf(a.w); cf[ks][7] = (short)f2bf(-m.w); } }
        const f32x4 dsk = *(const f32x4*)(P.in[I_S5D] + g * 16 + 4 * q4);
        float cr = 0.f, ci = 0.f;
#define S5_UROW(kk) ({ const int S_ = 32 * (kk) + srow; (S_ < CTXL) ? ((size_t)TL + (size_t)b * CTXL + (dir == 0 ? S_ : CTXL - 1 - S_)) : ((size_t)b * SEQ + (dir == 0 ? S_ - CTXL : SEQ - 1 - (S_ - CTXL))); })
        bf16x8 ua_next = *(const bf16x8*)(U + S5_UROW(0) * 512 + g * 16 + 8 * hi);
        for (int k = 0; k < 72; ++k) {
            const bf16x8 ua = ua_next;
            if (k + 1 < 72) ua_next = *(const bf16x8*)(U + S5_UROW(k + 1) * 512 + g * 16 + 8 * hi);
            const int sl = 32 * (k - 8) + 16 * nh + l15;
            const int tok = dir == 0 ? sl : SEQ - 1 - sl; const int lt = tok >> 5;
            const size_t o = ((size_t)b * SEQ + (k >= 8 ? tok : 0)) * 512 + g * 16 + 4 * q4;
            const bool first = dir == 0 ? (lt < 32) : (lt >= 32);
            f32x4 pk = {0.f, 0.f, 0.f, 0.f}; v2u uu = {0u, 0u};
            if (k >= 8 && !first) {
                pk.x = __hip_atomic_load(YA + o, __ATOMIC_RELAXED, __HIP_MEMORY_SCOPE_AGENT); pk.y = __hip_atomic_load(YA + o + 1, __ATOMIC_RELAXED, __HIP_MEMORY_SCOPE_AGENT);
                pk.z = __hip_atomic_load(YA + o + 2, __ATOMIC_RELAXED, __HIP_MEMORY_SCOPE_AGENT); pk.w = __hip_atomic_load(YA + o + 3, __ATOMIC_RELAXED, __HIP_MEMORY_SCOPE_AGENT);
                uu = *(const v2u*)(U + o);
            }
            {
              f32x16 br = {}, bi = {};
              br = __builtin_amdgcn_mfma_f32_32x32x16_bf16(ua, bre, br, 0, 0, 0);
              bi = __builtin_amdgcn_mfma_f32_32x32x16_bf16(ua, bim, bi, 0, 0, 0);
              float sr = hi ? 0.f : cr, si = hi ? 0.f : ci;
#pragma unroll
              for (int r = 0; r < 16; ++r) { const float nr = lam.x * sr - lam.y * si + br[r], ni = lam.x * si + lam.y * sr + bi[r]; sr = nr; si = ni; br[r] = sr; bi[r] = si; }
              float er = __shfl_xor(sr, 32), ei = __shfl_xor(si, 32); if (!hi) { er = 0.f; ei = 0.f; }
              { const f32x2 er2 = {er, er}, ei2 = {ei, ei};
#pragma unroll
              for (int r = 0; r < 16; r += 2) { const f32x2 pr2 = {lpr[r], lpr[r + 1]}, pi2 = {lpi[r], lpi[r + 1]}; f32x2 b2 = {br[r], br[r + 1]}, i2 = {bi[r], bi[r + 1]};
                  b2 = b2 + pr2 * er2 - pi2 * ei2; i2 = i2 + pr2 * ei2 + pi2 * er2; br[r] = b2.x; br[r + 1] = b2.y; bi[r] = i2.x; bi[r + 1] = i2.y; } }
              cr = __shfl_xor(br[15], 32); ci = __shfl_xor(bi[15], 32);
              LAS unsigned char* hb = Hb + (k & 1) * (32 * HP) + (16 * hi) * HP + 4 * n;
#pragma unroll
              for (int r = 0; r < 16; ++r) *(LAS unsigned*)(hb + r * HP) = pk2(br[r], bi[r]);
            }
            asm volatile("s_waitcnt lgkmcnt(0)\n\ts_barrier" ::: "memory");
            if (k >= 8) {
                const LAS unsigned char* hr = Hb + (k & 1) * (32 * HP) + (16 * nh + l15) * HP + 16 * q4;
                f32x4 y = {0.f, 0.f, 0.f, 0.f};
#pragma unroll
                for (int ks = 0; ks < 4; ++ks) { const bf16x8 hf = *(const LAS bf16x8*)(hr + 64 * ks); y = __builtin_amdgcn_mfma_f32_16x16x32_bf16(cf[ks], hf, y, 0, 0, 0); }
                if (first) { *(f32x4*)(YA + o) = y; }
                else {
                    const f32x4 uf = {bf2f(uu.x & 0xffffu), bf2f(uu.x >> 16), bf2f(uu.y & 0xffffu), bf2f(uu.y >> 16)};
                    const f32x4 t = y + pk + dsk * uf;
                    v2u ov; ov.x = pk2(gelu_tanh(t.x), gelu_tanh(t.y)); ov.y = pk2(gelu_tanh(t.z), gelu_tanh(t.w)); *(v2u*)(GS + o) = ov;
                }
            }
            if (k == 39) asm volatile("s_waitcnt vmcnt(0)\n\ts_barrier" ::: "memory");
        }
#undef S5_UROW
        asm volatile("s_waitcnt vmcnt(0) lgkmcnt(0)\n\ts_barrier" ::: "memory");
    }
}

__global__ void __launch_bounds__(NTHR, 2) fwd_kernel(Params prm) {
    extern __shared__ __attribute__((aligned(16))) unsigned char lds_raw[];
    Ctx C; C.p = &prm; C.ws = prm.ws; C.lds = (LAS unsigned char*)lds_raw;
    C.tid = threadIdx.x; C.lane = C.tid & 63; C.wave = __builtin_amdgcn_readfirstlane(C.tid >> 6);
    C.gw = blockIdx.x * NWAVE + C.wave; C.ngw = gridDim.x * NWAVE;
    constexpr int LDS_MISC = 147456 - 512;
    volatile LAS unsigned* misc = (volatile LAS unsigned*)(C.lds + LDS_MISC);
    if (C.tid < 64) misc[C.tid] = 0u;
    __syncthreads();
    unsigned* ctl = (unsigned*)(C.ws + WS_CTL);
    XcdBarrier bar; bar.bar = ctl + CW_BAR; bar.x = 0; bar.st = nullptr;
#if MK_ONE_LAUNCH
    bar = xcd_barrier_post(ctl + CW_BAR, misc + 8);
#define SEAM(k) do { if (lo <= (k) && (k) + 1 < hi) xcd_barrier(bar); } while (0)
#else
#define SEAM(k) do { } while (0)
#endif
    const int lo = prm.ph_lo, hi = prm.ph_hi;
#define IN(k) (lo <= (k) && (k) < hi)
#if MK_PROBE
    volatile LAS unsigned long long* ts_ = (volatile LAS unsigned long long*)(C.lds + LDS_MISC + 64);
#define STAMP(k) do { if (blockIdx.x == 0 && C.tid == 0) ts_[(k) + 1] = __builtin_amdgcn_s_memrealtime(); } while (0)
    if (blockIdx.x == 0 && C.tid == 0) ts_[0] = __builtin_amdgcn_s_memrealtime();
#else
#define STAMP(k) do { } while (0)
#endif
    const Params& P = prm;
    bf16* Hb = (bf16*)(C.ws + WS_H); bf16* XC = (bf16*)(C.ws + WS_XC);
#define MOE_MAP(layer) do { LAS int* tm_ = (LAS int*)(C.lds + 131072); LAS int* cl_ = tm_ + 320; \
        if (C.wave == 0) { const unsigned* cnt_ = (const unsigned*)(C.ws + WS_CTL) + CW_CNT + 64 * (layer); const int mc_ = C.lane < 32 ? (int)__hip_atomic_load(cnt_ + (C.lane & 31), __ATOMIC_RELAXED, __HIP_MEMORY_SCOPE_AGENT) : 0; const int mp_ = (mc_ + 255) & ~255; int in_ = mp_; \
            _Pragma("unroll") for (int o_ = 1; o_ < 32; o_ <<= 1) { const int t_ = __shfl_up(in_, o_); if ((C.lane & 31) >= o_) in_ += t_; } const int ps_ = in_ - mp_; \
            if (C.lane < 32) { for (int t_ = ps_ / 256; t_ < (ps_ + mp_) / 256; ++t_) tm_[t_] = C.lane | ((t_ * 256 - ps_) << 8); cl_[C.lane] = mc_; if (C.lane == 31) cl_[32] = (ps_ + mp_) / 256; } } \
        __syncthreads(); } while (0)
#define MOE_GEMM1(layer) do { MOE_MAP(layer); const LAS int* tm_ = (const LAS int*)(C.lds + 131072); const int ntl_ = __builtin_amdgcn_readfirstlane(tm_[320 + 32]); pg8::Gemm g{Hb, (const bf16*)(C.ws + WS_W13), 0, 1024, D}; \
        pg8::GroupedOrder<true> S{tm_, tm_ + 320, (const int*)(C.ws + WS_LIST), ntl_ * 4, 4, (int)gridDim.x, (int)blockIdx.x, LCAP, D * 2, (size_t)1024 * 1024 * 2}; pg8::EpiSwiglu E{(bf16*)(C.ws + WS_G13)}; \
        pg8::gemm_phase<pg8::EpiSwiglu, pg8::GroupedOrder<true>, true, true>(C.lds, g, S, E); } while (0)
#define MOE_GEMM2(layer) do { MOE_MAP(layer); const LAS int* tm_ = (const LAS int*)(C.lds + 131072); const int ntl_ = __builtin_amdgcn_readfirstlane(tm_[320 + 32]); pg8::Gemm g{(const bf16*)(C.ws + WS_G13), (const bf16*)(C.ws + WS_W2), 0, 1024, EH}; \
        pg8::GroupedOrder<false> S{tm_, tm_ + 320, (const int*)(C.ws + WS_LIST), ntl_ * 4, 4, (int)gridDim.x, (int)blockIdx.x, LCAP, EH * 2, (size_t)1024 * 512 * 2}; pg8::EpiStore E{(bf16*)(C.ws + WS_XS), D}; \
        pg8::gemm_phase<pg8::EpiStore, pg8::GroupedOrder<false>, true, true>(C.lds, g, S, E); } while (0)
    if (IN(0)) { phase_prologue(C); SEAM(0); STAMP(0); }
    if (IN(1)) { phase_norm_mix0(C); SEAM(1); STAMP(1); }
    if (IN(2)) { pg8::Gemm g{Hb, (const bf16*)(C.ws + WS_WIN0), TT, MIXW, D}; pg8::StaticOrder S; S.init(TT, MIXW, gridDim.x, blockIdx.x); pg8::EpiStore E{(bf16*)(C.ws + WS_P), MIXW};
        pg8::gemm_phase<pg8::EpiStore, pg8::StaticOrder, true, true, true>(C.lds, g, S, E); SEAM(2); STAMP(2); }
    if (IN(3)) { phase_qkprep(C); SEAM(3); STAMP(3); }
    if (IN(4)) { phase_gmlp_fast(C); phase_attn_fast(C, (char*)lds_raw); SEAM(4); STAMP(4); }
    if (IN(5)) { pg8::Gemm g{Hb, (const bf16*)(C.ws + WS_WOUT0), TT, D, D}; pg8::StaticOrder S; S.init(TT, D, gridDim.x, blockIdx.x); pg8::EpiResid E{P.in[I_X], P.in[I_CTX], (const float*)(C.ws + WS_MOD), XC, 0};
        pg8::gemm_phase<pg8::EpiResid, pg8::StaticOrder, true, true, true>(C.lds, g, S, E); SEAM(5); STAMP(5); }
    if (IN(6)) { phase_router_fast(C, 0, TT); SEAM(6); STAMP(6); }
    if (IN(8)) { MOE_GEMM1(0); SEAM(8); STAMP(8); }
    if (IN(9)) { MOE_GEMM2(0); SEAM(9); STAMP(9); }
    if (IN(10)) { phase_combine_norm_mix1(C); SEAM(10); STAMP(10); }
    if (IN(11)) { pg8::Gemm g{Hb, (const bf16*)(C.ws + WS_WS5IN), TT, 512, D}; pg8::StaticOrder S; S.init(TT, 512, gridDim.x, blockIdx.x); pg8::EpiStore E{(bf16*)(C.ws + WS_U), 512};
        pg8::gemm_phase<pg8::EpiStore, pg8::StaticOrder, true, true, true>(C.lds, g, S, E); SEAM(11); STAMP(11); }
    if (IN(12)) { phase_s5_fast(C); SEAM(12); STAMP(12); }
    if (IN(13)) { pg8::Gemm g{(const bf16*)(C.ws + WS_GS), (const bf16*)(C.ws + WS_WGLU), TL, 512, 512}; pg8::StaticOrder S; S.init(TL, 512, gridDim.x, blockIdx.x); pg8::EpiGlu E{(const bf16*)(C.ws + WS_GS), P.in[I_BGLU], (bf16*)(C.ws + WS_GG)};
        pg8::gemm_phase<pg8::EpiGlu, pg8::StaticOrder, true, true, true>(C.lds, g, S, E); SEAM(13); STAMP(13); }
    if (IN(14)) { pg8::Gemm g{(const bf16*)(C.ws + WS_GG), (const bf16*)(C.ws + WS_WS5OUT), TL, D, 512}; pg8::StaticOrder S; S.init(TL, D, gridDim.x, blockIdx.x); pg8::EpiResid E{P.in[I_X], P.in[I_CTX], (const float*)(C.ws + WS_MOD) + (size_t)17 * 6 * D, XC, 1};
        pg8::gemm_phase<pg8::EpiResid, pg8::StaticOrder, true, true, true>(C.lds, g, S, E); SEAM(14); STAMP(14); }
    if (IN(15)) { phase_router_fast(C, 1, TL); SEAM(15); STAMP(15); }
    if (IN(17)) { MOE_GEMM1(1); SEAM(17); STAMP(17); }
    if (IN(18)) { MOE_GEMM2(1); SEAM(18); STAMP(18); }
    if (IN(19)) { phase_final(C); STAMP(19); }
#if MK_PROBE
    if (blockIdx.x == 0 && C.tid == 0) {
        ts_[8] = ts_[7]; ts_[17] = ts_[16];
        const unsigned long long tA = ts_[PROBE_A_HI + 1] - ts_[PROBE_A_LO], tB = ts_[PROBE_B_HI + 1] - ts_[PROBE_B_LO];
        const unsigned long long spin = 16ull * tA + 1000000ull * ((tB + 500ull) / 1000ull);
        const unsigned long long t0 = __builtin_amdgcn_s_memrealtime();
        while (__builtin_amdgcn_s_memrealtime() - t0 < spin) __builtin_amdgcn_s_sleep(8);
    }
#endif
#undef IN
#undef SEAM
}

extern "C" void kernel_launch(void* const* d_in, const int* in_sizes, int n_in, void* d_out, int out_size, void* d_ws, size_t ws_size, hipStream_t stream) {
    constexpr int LDS_BYTES = 147456;
    static int grid = 0;
    if (grid == 0) {
        if (n_in != 35 || out_size != TL * D || ws_size < WS_END) { fprintf(stderr, "kernel_launch: unexpected shapes (n_in %d out %d ws %zu)\n", n_in, out_size, ws_size); grid = -1; return; }
        int dev = 0, cus = 0;
        if (hipGetDevice(&dev) != hipSuccess || hipDeviceGetAttribute(&cus, hipDeviceAttributeMultiprocessorCount, dev) != hipSuccess) { grid = -1; return; }
        if (hipFuncSetAttribute((const void*)fwd_kernel, hipFuncAttributeMaxDynamicSharedMemorySize, LDS_BYTES) != hipSuccess) { fprintf(stderr, "kernel_launch: hipFuncSetAttribute failed\n"); grid = -1; return; }
        (void)hipGetLastError();
        grid = cus;
    }
    if (grid < 0) return;
    (void)hipMemsetAsync((char*)d_ws + WS_CTL, 0, CTL_BYTES, stream);
    Params p{};
    for (int i = 0; i < 35; ++i) p.in[i] = (const float*)d_in[i];
    p.out = (float*)d_out; p.ws = (unsigned char*)d_ws;
#if MK_ONE_LAUNCH
    p.ph_lo = 0; p.ph_hi = NPHASE;
    hipLaunchKernelGGL(fwd_kernel, dim3(grid), dim3(NTHR), LDS_BYTES, stream, p);
#else
    for (int k = 0; k < NPHASE; ++k) { p.ph_lo = k; p.ph_hi = k + 1; hipLaunchKernelGGL(fwd_kernel, dim3(grid), dim3(NTHR), LDS_BYTES, stream, p); }
#endif
}
```

```cpp
#include <hip/hip_runtime.h>
#include <cstdio>
#include <cstdint>

#ifndef MK_ONE_LAUNCH
#define MK_ONE_LAUNCH 1
#endif
#ifndef MK_SIMPLE_ORDER
#define MK_SIMPLE_ORDER 0
#endif
#ifndef MK_KROT
#define MK_KROT 0
#endif
#ifndef MK_PROBE
#define MK_PROBE 0
#endif
#define PROBE_A_LO 4
#define PROBE_A_HI 4
#define PROBE_B_LO 8
#define PROBE_B_HI 9

constexpr int D = 1024, NB = 16, SEQ = 2048, CTXL = 256;
constexpr int TL = NB * SEQ, TC = NB * CTXL, TT = TL + TC;
constexpr int KVL = CTXL + SEQ;
constexpr int MIXW = 1792, NEXP = 32, EH = 512;
constexpr int NSLOT = 81920;
constexpr float EPS = 1e-6f;
constexpr float QSCALE = 0.125f * 1.4426950408889634f;
constexpr int NTHR = 512, NWAVE = 8;
constexpr int NPHASE = 20;

constexpr size_t MiB = 1u << 20;
constexpr size_t WS_CTL = 0, CTL_BYTES = 1 * MiB;
constexpr size_t WS_MOD = 1 * MiB;
constexpr size_t WS_TAB = 2 * MiB;
constexpr size_t TAB_ROPE = 0, TAB_LAMB = 16384, TAB_BBAR = 65536, TAB_WR = 640 * 1024;
constexpr size_t WS_ROUTE = 3 * MiB;
constexpr size_t RT_E = 0, RT_P = 320 * 1024, RT_W = 640 * 1024, RT_S = 960 * 1024, RT_TILE = 1280 * 1024, RT_NT = 1280 * 1024 + 4096;
constexpr size_t WS_WIN0 = 6 * MiB, WS_WOUT0 = 10 * MiB, WS_WS5IN = 12 * MiB, WS_WGLU = 13 * MiB, WS_WS5OUT = 14 * MiB;
constexpr size_t WS_WSP = 15 * MiB;
constexpr size_t WS_W13 = 16 * MiB, WS_W2 = 80 * MiB;
constexpr size_t WS_XC = 112 * MiB;
constexpr size_t WS_H = 256 * MiB;
constexpr size_t WS_P = 328 * MiB;
constexpr size_t WS_Q = 454 * MiB, WS_K = 490 * MiB, WS_V = 499 * MiB;
constexpr size_t WS_XS = 328 * MiB;
constexpr size_t WS_G13 = 488 * MiB;
constexpr size_t WS_U = 328 * MiB, WS_GS = 364 * MiB, WS_GG = 396 * MiB, WS_YACC = 428 * MiB;
constexpr size_t WS_LIST = 568 * MiB;
constexpr int LCAP = 36864;
constexpr size_t WS_END = 574 * MiB;
constexpr int CW_CNT = 64;
constexpr int CW_BAR = 4096;

#define LAS __attribute__((address_space(3)))
typedef unsigned short bf16;
typedef unsigned v4u __attribute__((ext_vector_type(4)));
typedef unsigned v2u __attribute__((ext_vector_type(2)));
typedef float f32x4 __attribute__((ext_vector_type(4)));
typedef float f32x2 __attribute__((ext_vector_type(2)));
__device__ __forceinline__ float bf2f(unsigned u) { return __uint_as_float(u << 16); }
__device__ __forceinline__ unsigned pk2(float lo, float hi) { unsigned r; asm("v_cvt_pk_bf16_f32 %0, %1, %2" : "=v"(r) : "v"(lo), "v"(hi)); return r; }
__device__ __forceinline__ unsigned f2bf(float f) { return pk2(f, 0.f) & 0xffffu; }
__device__ __forceinline__ float wave_sum(float v) {
#pragma unroll
    for (int o = 1; o < 64; o <<= 1) v += __shfl_xor(v, o);
    return v;
}
__device__ __forceinline__ float wave_max(float v) {
#pragma unroll
    for (int o = 1; o < 64; o <<= 1) v = fmaxf(v, __shfl_xor(v, o));
    return v;
}
__device__ __forceinline__ float gelu_tanh(float x) { const float u2 = -1.5957691216057308f * (x + 0.044715f * x * x * x); return x * __builtin_amdgcn_rcpf(1.f + __expf(u2)); }
__device__ __forceinline__ float sigmoidf_(float x) { return 1.f / (1.f + __expf(-x)); }
__device__ __forceinline__ float silu_(float x) { return x / (1.f + __expf(-x)); }
__device__ __forceinline__ void unpack8(const v4u w, float* f) {
    f[0] = bf2f(w.x & 0xffffu); f[1] = bf2f(w.x >> 16); f[2] = bf2f(w.y & 0xffffu); f[3] = bf2f(w.y >> 16);
    f[4] = bf2f(w.z & 0xffffu); f[5] = bf2f(w.z >> 16); f[6] = bf2f(w.w & 0xffffu); f[7] = bf2f(w.w >> 16);
}

#define XB_TMO      128
#define XB_XCNT(j)  (256  + 64 * (j))
#define XB_XSUB(j)  (1280 + 64 * (j))
#define XB_XGEN(j)  (2304 + 64 * (j))
#define XB_TOP      3328
#define XB_TOPGEN   3392
#define XCD_BAR_WORDS 3456
#define XB_SPIN_CAP (1u << 28)
__device__ __forceinline__ unsigned xb_ld(unsigned* p)              { return __hip_atomic_load(p, __ATOMIC_RELAXED, __HIP_MEMORY_SCOPE_AGENT); }
__device__ __forceinline__ unsigned xb_add(unsigned* p, unsigned v) { return __hip_atomic_fetch_add(p, v, __ATOMIC_RELAXED, __HIP_MEMORY_SCOPE_AGENT); }
__device__ __forceinline__ unsigned xb_xcc_id() { return (unsigned)__builtin_amdgcn_s_getreg((3 << 11) | 20) & 0xFu; }
#define XB_SPIN(cond, bar) do { unsigned _sp = 0; while (cond) { __builtin_amdgcn_s_sleep(1); \
    if ((++_sp & 255u) == 0u) { if (xb_ld(&(bar)[XB_TMO])) break; if (_sp > XB_SPIN_CAP) { atomicAdd(&(bar)[XB_TMO], 1u); break; } } } } while (0)
struct XcdBarrier { unsigned* bar; unsigned x; volatile LAS unsigned* st; };
__device__ __forceinline__ XcdBarrier xcd_barrier_post(unsigned* bar, volatile LAS unsigned* st) {
    XcdBarrier b; b.bar = bar; b.x = xb_xcc_id(); b.st = st;
    if (threadIdx.x == 0) (void)xb_add(&bar[XB_XCNT(b.x)], 1u);
    return b;
}
__device__ __forceinline__ void xcd_barrier_complete(unsigned* bar, unsigned x, unsigned& nloc, unsigned& nx) {
    const unsigned G = gridDim.x * gridDim.y * gridDim.z;
    unsigned sum, cnt, mine, sp = 0u;
    for (;;) {
        sum = 0u; cnt = 0u; mine = 0u;
#pragma unroll
        for (unsigned j = 0; j < 16; ++j) { const unsigned c = xb_ld(&bar[XB_XCNT(j)]); sum += c; cnt += (c > 0u) ? 1u : 0u; mine = (j == x) ? c : mine; }
        if (sum == G) break;
        __builtin_amdgcn_s_sleep(1);
        if ((++sp & 255u) == 0u) { if (xb_ld(&bar[XB_TMO])) break; if (sp > XB_SPIN_CAP) { atomicAdd(&bar[XB_TMO], 1u); break; } }
    }
    nloc = mine > 0u ? mine : 1u; nx = cnt > 0u ? cnt : 1u;
}
__device__ __forceinline__ void xcd_barrier(const XcdBarrier& b) {
    asm volatile("s_waitcnt vmcnt(0)" ::: "memory");
    __syncthreads();
    if (threadIdx.x == 0) {
        unsigned* bar = b.bar;
        __builtin_amdgcn_s_waitcnt(0);
        unsigned nloc = b.st[0], nx = b.st[1];
        if (nloc == 0u) { xcd_barrier_complete(bar, b.x, nloc, nx); b.st[0] = nloc; b.st[1] = nx; }
        const unsigned old = xb_add(&bar[XB_XSUB(b.x)], 1u);
        const unsigned gen = old / nloc;
        if (old + 1u == (gen + 1u) * nloc) {
            __builtin_amdgcn_fence(__ATOMIC_RELEASE, "agent");
            asm volatile("s_waitcnt vmcnt(0)" ::: "memory");
            const unsigned og = xb_add(&bar[XB_TOP], 1u);
            const unsigned tg = og / nx;
            if (og + 1u == (tg + 1u) * nx) xb_add(&bar[XB_TOPGEN], 1u);
            else XB_SPIN(xb_ld(&bar[XB_TOPGEN]) == tg, bar);
            __builtin_amdgcn_fence(__ATOMIC_ACQUIRE, "agent");
            xb_add(&bar[XB_XGEN(b.x)], 1u);
            asm volatile("s_waitcnt vmcnt(0)" ::: "memory");
        } else {
            XB_SPIN(xb_ld(&bar[XB_XGEN(b.x)]) == gen, bar);
            __builtin_amdgcn_fence(__ATOMIC_ACQUIRE, "agent");
            asm volatile("s_waitcnt vmcnt(0)" ::: "memory");
        }
    }
    __syncthreads();
}

namespace pg8 {
#define PG8_LAS __attribute__((address_space(3)))
typedef unsigned short bf16_t;
typedef short bf16x8 __attribute__((ext_vector_type(8)));
typedef float f32x4 __attribute__((ext_vector_type(4)));
typedef unsigned u32x4 __attribute__((ext_vector_type(4)));
constexpr int BM = 256, BK = 64, HALF = 128, HTB = HALF * BK * 2  , STAGE_BYTES = 8 * HTB, NXCD = 8, WGM = 8;

__host__ __device__ __forceinline__ int lds_byte(int r, int c) { const int st = (r >> 4) * 2 + (c >> 5), rr = r & 15, cc = c & 31, ob = rr * 64 + cc * 2; return st * 1024 + (ob ^ (((ob >> 9) & 1) << 5)); }
__host__ __device__ __forceinline__ void stage_rc(int b, int& R, int& C) { const int st = b / 1024, sb = b % 1024, swz = sb ^ (((sb >> 9) & 1) << 5); R = (st >> 1) * 16 + swz / 64; C = (st & 1) * 32 + (swz % 64) / 2; }
__host__ __device__ __forceinline__ int perm32(int rho) { const int n = rho >> 4, i = rho & 15; return 8 * (i >> 2) + 4 * n + (i & 3); }

struct Unit { int pm, pn; size_t bo; int aux; };
struct Gemm { const bf16_t* A; const bf16_t* Bt; int M, N, K; };

struct StaticOrder {
    static constexpr bool GATHER = false;
    int nM, nN, nwg, G, c;
    __host__ __device__ void init(int M, int N, int G_, int c_) { nM = M / BM; nN = N / BM; nwg = nM * nN; G = G_; c = c_; }
    __host__ __device__ bool next(int i, Unit& u) const {
        const long L = (long)i * G + c; if (L >= nwg) return false;
        if (MK_SIMPLE_ORDER) { u.pm = (int)L / nN; u.pn = (int)L % nN; u.bo = 0; u.aux = 0; return true; }
        int wgid = (int)L; { const int q = nwg / NXCD, r = nwg % NXCD, xcd = wgid % NXCD, off = wgid / NXCD; wgid = (xcd < r ? xcd * (q + 1) : r * (q + 1) + (xcd - r) * q) + off; }
        const int nig = WGM * nN, gid = wgid / nig, fm = gid * WGM, gsz = (nM - fm) < WGM ? (nM - fm) : WGM;
        u.pm = fm + ((wgid % nig) % gsz); u.pn = (wgid % nig) / gsz; u.bo = 0; u.aux = 0; return true;
    }
    __device__ __forceinline__ void a_ready(const Unit&) const {}
    __device__ __forceinline__ void done(const Unit&) const {}
};

__device__ __forceinline__ unsigned cvt_pk_bf16(float lo, float hi) { unsigned r; asm volatile("v_cvt_pk_bf16_f32 %0, %1, %2" : "=v"(r) : "v"(lo), "v"(hi)); return r; }
typedef float f32x2 __attribute__((ext_vector_type(2)));
__device__ __forceinline__ f32x2 gelu_pk(f32x2 v) {
    const f32x2 av = __builtin_elementwise_abs(v), d = av * 0.2316418882f + 1.0f;
    f32x2 t; t.x = __builtin_amdgcn_rcpf(d.x); t.y = __builtin_amdgcn_rcpf(d.y);
    f32x2 q = t * 0.5307027145f + (-0.7265760135f); q = q * t + 0.7107068705f; q = q * t + (-0.142248368f); q = q * t + 0.127414796f; q = q * t;
    const f32x2 s = (v * v) * (-0.72134752044f);
    f32x2 e; e.x = __builtin_amdgcn_exp2f(s.x); e.y = __builtin_amdgcn_exp2f(s.y);
    const f32x2 m = v * (q * e), r = v - m;
    f32x2 o; o.x = v.x < 0.f ? m.x : r.x; o.y = v.y < 0.f ? m.y : r.y; return o;
}

template <class Epi, class Sched, bool ALIGN_EPI = false, bool SP2 = false, bool KROT = false>
__device__ __forceinline__ void gemm_phase(PG8_LAS unsigned char* lds, const Gemm g, const Sched& S, const Epi& E) {
    const int tid = threadIdx.x, wid = __builtin_amdgcn_readfirstlane(tid >> 6), lane = tid & 63, wr = wid >> 2, wc = wid & 3, fr = lane & 15, fq = lane >> 4;
    const int K = g.K, nt = K / BK;
    const int kmask = nt - 1, rot = (MK_KROT && KROT) ? (int)((blockIdx.x * 3u + (blockIdx.x >> 3)) & (unsigned)kmask) : 0;
#define PG8_KO(j) ((size_t)(((j) + rot) & kmask) * kstep)
    unsigned voffA[2], voffB[2];
    unsigned vC[2][2], vN[2][2];
#pragma unroll
    for (int i = 0; i < 2; ++i) { int R, C; stage_rc(tid * 16 + i * 8192, R, C); const int Rb = Epi::PERM ? ((R & ~31) + perm32(R & 31)) : R;
        voffA[i] = (unsigned)(R * K + C) * 2u; voffB[i] = (unsigned)(Rb * K + C) * 2u; }
    const size_t kstep = (size_t)(BK * 2);
    const size_t hstep = (size_t)HALF * K * 2;
    const size_t tstep = 2 * hstep;
    const unsigned ldsw = (unsigned)wid * 1024u;
    const int aoff = lds_byte(wr * 64 + fr, fq * 8), boff = lds_byte(wc * 32 + fr, fq * 8);
#define PG8_SA(b, h) (((b) * 2 + (h)) * HTB)
#define PG8_SB(b, h) ((4 + (b) * 2 + (h)) * HTB)
#define PG8_STAGE(bufoff, gbase, voff) do { _Pragma("unroll") for (int _i = 0; _i < 2; ++_i) \
        __builtin_amdgcn_global_load_lds((const unsigned*)((const char*)(gbase) + (voff)[_i]), (PG8_LAS unsigned*)(lds + (bufoff) + ldsw + _i * 8192), 16, 0, 0); } while (0)
#define PG8_STAGE_A(bufoff, gbase, h, nx) do { _Pragma("unroll") for (int _i = 0; _i < 2; ++_i) { \
        const unsigned _vo = Sched::GATHER ? ((nx) ? vN[h][_i] : vC[h][_i]) : (unsigned)((h) * hstep) + voffA[_i]; \
        __builtin_amdgcn_global_load_lds((const unsigned*)((const char*)(gbase) + _vo), (PG8_LAS unsigned*)(lds + (bufoff) + ldsw + _i * 8192), 16, 0, 0); } } while (0)
#define PG8_LDA(dst, b, h) do { _Pragma("unroll") for (int m = 0; m < 4; ++m) _Pragma("unroll") for (int k = 0; k < 2; ++k) dst[m][k] = *(const PG8_LAS bf16x8*)(lds + PG8_SA(b, h) + aoff + m * 2048 + k * 1024); } while (0)
#define PG8_LDB(dst, b, h) do { _Pragma("unroll") for (int n = 0; n < 2; ++n) _Pragma("unroll") for (int k = 0; k < 2; ++k) dst[n][k] = *(const PG8_LAS bf16x8*)(lds + PG8_SB(b, h) + boff + n * 2048 + k * 1024); } while (0)
#define PG8_MMA(ai, bj, At, Bt) do { __builtin_amdgcn_s_setprio(1); _Pragma("unroll") for (int m = 0; m < 4; ++m) _Pragma("unroll") for (int n = 0; n < 2; ++n) _Pragma("unroll") for (int k = 0; k < 2; ++k) \
        acc[ai][bj][m][n] = __builtin_amdgcn_mfma_f32_16x16x32_bf16(Bt[n][k], At[m][k], acc[ai][bj][m][n], 0, 0, 0); __builtin_amdgcn_s_setprio(0); } while (0)
#define PG8_WAIT_V(n) asm volatile("s_waitcnt vmcnt(" #n ")" ::: "memory")
#define PG8_WAIT_L(n) asm volatile("s_waitcnt lgkmcnt(" #n ")" ::: "memory")
#define PG8_BAR __builtin_amdgcn_s_barrier()
#define PG8_SCHED __builtin_amdgcn_sched_barrier(0)
    Unit cur, nxt; int ui = 0;
    if (!S.next(0, cur)) return;
    f32x4 acc[2][2][4][2];
#pragma unroll
    for (int a = 0; a < 2; ++a)
#pragma unroll
        for (int b = 0; b < 2; ++b)
#pragma unroll
            for (int m = 0; m < 4; ++m)
#pragma unroll
                for (int n = 0; n < 2; ++n) acc[a][b][m][n] = (f32x4){0.f, 0.f, 0.f, 0.f};
    bf16x8 At[4][2], B0[2][2], B1[2][2];
    const char* cA = (const char*)g.A + (Sched::GATHER ? (size_t)0 : (size_t)cur.pm * tstep); const char* cB = (const char*)g.Bt + cur.bo + (size_t)cur.pn * tstep;
    S.a_ready(cur);
#define PG8_VOFF(dst, un) do { _Pragma("unroll") for (int _h = 0; _h < 2; ++_h) _Pragma("unroll") for (int _i = 0; _i < 2; ++_i) { int R_, C_; stage_rc(tid * 16 + _i * 8192, R_, C_); dst[_h][_i] = S.a_off(un, _h * HALF + R_) + (unsigned)C_ * 2u; } } while (0)
    if constexpr (Sched::GATHER) { PG8_VOFF(vC, cur); }
    if constexpr (SP2) {
        PG8_STAGE(PG8_SB(0, 0), cB + PG8_KO(0), voffB); PG8_STAGE(PG8_SB(0, 1), cB + hstep + PG8_KO(0), voffB); PG8_STAGE_A(PG8_SA(0, 0), cA + PG8_KO(0), 0, false); PG8_STAGE_A(PG8_SA(0, 1), cA + PG8_KO(0), 1, false);
        if (wr == 1) PG8_BAR;
        PG8_WAIT_V(2); PG8_BAR;
        PG8_STAGE(PG8_SB(1, 0), cB + PG8_KO(1), voffB); PG8_STAGE_A(PG8_SA(1, 0), cA + PG8_KO(1), 0, false); PG8_STAGE(PG8_SB(1, 1), cB + hstep + PG8_KO(1), voffB);
        PG8_WAIT_V(6); PG8_BAR;
    } else {
        PG8_STAGE(PG8_SB(0, 0), cB, voffB); PG8_STAGE_A(PG8_SA(0, 0), cA, 0, false); PG8_STAGE(PG8_SB(0, 1), cB + hstep, voffB); PG8_STAGE_A(PG8_SA(0, 1), cA, 1, false);
        if (wr == 1) PG8_BAR;
        PG8_WAIT_V(4); PG8_BAR;
        PG8_STAGE(PG8_SB(1, 0), cB + PG8_KO(1), voffB); PG8_STAGE_A(PG8_SA(1, 0), cA + PG8_KO(1), 0, false); PG8_STAGE(PG8_SB(1, 1), cB + hstep + PG8_KO(1), voffB);
        PG8_WAIT_V(6); PG8_BAR;
    }
    for (;;) {
        const bool has_next = S.next(ui + 1, nxt);
        if constexpr (Sched::GATHER) { if (has_next) { PG8_VOFF(vN, nxt); } else { vN[0][0] = vC[0][0]; vN[0][1] = vC[0][1]; vN[1][0] = vC[1][0]; vN[1][1] = vC[1][1]; } }
        const char* nA = (has_next && !Sched::GATHER) ? (const char*)g.A + (size_t)nxt.pm * tstep : cA; const char* nB = has_next ? (const char*)g.Bt + nxt.bo + (size_t)nxt.pn * tstep : cB;
        for (int t = 0; t < nt; t += 2) {
            const bool last = (t == nt - 2);
            const char* a1 = cA + PG8_KO(t + 1);
            const char* a2 = last ? nA + PG8_KO(0) : cA + PG8_KO(t + 2); const char* b2 = last ? nB + PG8_KO(0) : cB + PG8_KO(t + 2);
            const char* a3 = last ? nA + PG8_KO(1) : cA + PG8_KO(t + 3); const char* b3 = last ? nB + PG8_KO(1) : cB + PG8_KO(t + 3);
            if (last && has_next) S.a_ready(nxt);
            if constexpr (SP2) {
            PG8_LDB(B0, 0, 0); PG8_LDB(B1, 0, 1); PG8_SCHED; PG8_LDA(At, 0, 0); PG8_STAGE_A(PG8_SA(1, 1), a1, 1, false);
            PG8_WAIT_V(8); PG8_WAIT_L(0); PG8_BAR; PG8_MMA(0, 0, At, B0); PG8_MMA(0, 1, At, B1); PG8_BAR; PG8_SCHED;
            PG8_LDA(At, 0, 1); PG8_STAGE(PG8_SB(0, 0), b2, voffB); PG8_STAGE(PG8_SB(0, 1), b2 + hstep, voffB); PG8_STAGE_A(PG8_SA(0, 0), a2, 0, last);
            PG8_WAIT_V(8); PG8_WAIT_L(0); PG8_BAR; PG8_MMA(1, 0, At, B0); PG8_MMA(1, 1, At, B1); PG8_BAR; PG8_SCHED;
            PG8_LDB(B0, 1, 0); PG8_LDB(B1, 1, 1); PG8_SCHED; PG8_LDA(At, 1, 0); PG8_STAGE_A(PG8_SA(0, 1), a2, 1, last);
            PG8_WAIT_V(8); PG8_WAIT_L(0); PG8_BAR; PG8_MMA(0, 0, At, B0); PG8_MMA(0, 1, At, B1); PG8_BAR; PG8_SCHED;
            PG8_LDA(At, 1, 1); PG8_STAGE(PG8_SB(1, 0), b3, voffB); PG8_STAGE(PG8_SB(1, 1), b3 + hstep, voffB); PG8_STAGE_A(PG8_SA(1, 0), a3, 0, last);
            PG8_WAIT_V(8); PG8_WAIT_L(0); PG8_BAR; PG8_MMA(1, 0, At, B0); PG8_MMA(1, 1, At, B1); PG8_BAR; PG8_SCHED;
            } else {
            PG8_LDB(B0, 0, 0); PG8_SCHED; PG8_LDA(At, 0, 0); PG8_STAGE_A(PG8_SA(1, 1), a1, 1, false);
            PG8_WAIT_L(8); PG8_BAR; PG8_WAIT_L(0); PG8_MMA(0, 0, At, B0); PG8_BAR; PG8_SCHED;
            PG8_LDB(B1, 0, 1); PG8_STAGE(PG8_SB(0, 0), b2, voffB);
            PG8_BAR; PG8_WAIT_L(0); PG8_MMA(0, 1, At, B1); PG8_BAR;
            PG8_LDA(At, 0, 1); PG8_STAGE_A(PG8_SA(0, 0), a2, 0, last);
            PG8_BAR; PG8_WAIT_L(0); PG8_MMA(1, 0, At, B0); PG8_BAR; PG8_SCHED;
            PG8_STAGE(PG8_SB(0, 1), b2 + hstep, voffB);
            PG8_WAIT_V(6); PG8_BAR; PG8_MMA(1, 1, At, B1); PG8_BAR;
            PG8_LDB(B0, 1, 0); PG8_SCHED; PG8_LDA(At, 1, 0); PG8_STAGE_A(PG8_SA(0, 1), a2, 1, last);
            PG8_WAIT_L(8); PG8_BAR; PG8_WAIT_L(0); PG8_MMA(0, 0, At, B0); PG8_BAR; PG8_SCHED;
            PG8_LDB(B1, 1, 1); PG8_STAGE(PG8_SB(1, 0), b3, voffB);
            PG8_BAR; PG8_WAIT_L(0); PG8_MMA(0, 1, At, B1); PG8_BAR;
            PG8_LDA(At, 1, 1); PG8_STAGE_A(PG8_SA(1, 0), a3, 0, last);
            PG8_BAR; PG8_WAIT_L(0); PG8_MMA(1, 0, At, B0); PG8_BAR; PG8_SCHED;
            PG8_STAGE(PG8_SB(1, 1), b3 + hstep, voffB);
            PG8_WAIT_V(6); PG8_BAR; PG8_MMA(1, 1, At, B1); PG8_BAR;
            }
        }
        if constexpr (ALIGN_EPI) { if (wr == 0) PG8_BAR; }
        if constexpr (!Epi::AFTER_DRAIN) { E(acc, cur, wr, wc, fr, fq); S.done(cur); }
        if (!has_next) break;
#pragma unroll
        for (int a = 0; a < 2; ++a)
#pragma unroll
            for (int b = 0; b < 2; ++b)
#pragma unroll
                for (int m = 0; m < 4; ++m)
#pragma unroll
                    for (int n = 0; n < 2; ++n) acc[a][b][m][n] = (f32x4){0.f, 0.f, 0.f, 0.f};
        cur = nxt; cA = nA; cB = nB; ++ui;
        if constexpr (Sched::GATHER) { vC[0][0] = vN[0][0]; vC[0][1] = vN[0][1]; vC[1][0] = vN[1][0]; vC[1][1] = vN[1][1]; }
        if constexpr (ALIGN_EPI) { if (wr == 1) PG8_BAR; }
    }
    PG8_WAIT_V(0);
    if constexpr (!ALIGN_EPI) { if (wr == 0) PG8_BAR; }
    PG8_BAR;
    if constexpr (Epi::AFTER_DRAIN) { E.fused(acc, cur, wr, wc, fr, fq, lds, wid, lane); S.done(cur); }
#undef PG8_VOFF
#undef PG8_KO
#undef PG8_SA
#undef PG8_SB
#undef PG8_STAGE
#undef PG8_STAGE_A
#undef PG8_LDA
#undef PG8_LDB
#undef PG8_MMA
#undef PG8_WAIT_V
#undef PG8_WAIT_L
#undef PG8_BAR
#undef PG8_SCHED
}
}

namespace pg8 {
template <bool GATHER_>
struct GroupedOrder {
    static constexpr bool GATHER = GATHER_;
    const PG8_LAS int* tmap; const PG8_LAS int* cntl; const int* list; int nU, nN, G, c, lcap, rowbytes; size_t estride;
    __device__ __forceinline__ bool next(int i, Unit& u) const { const long L = (long)i * G + c; if (L >= nU) return false; const int t = (int)L / nN; const int m = __builtin_amdgcn_readfirstlane(tmap[t]);
        u.pm = t; u.pn = (int)L % nN; u.bo = (size_t)(m & 255) * estride; u.aux = m; return true; }
    __device__ __forceinline__ unsigned a_off(const Unit& u, int R) const { const int e = u.aux & 255, p0 = u.aux >> 8, ce = cntl[e]; int p = p0 + R; p = p < ce ? p : ce - 1; return (unsigned)list[(size_t)e * lcap + p] * (unsigned)rowbytes; }
    __device__ __forceinline__ void a_ready(const Unit&) const {}
    __device__ __forceinline__ void done(const Unit&) const {}
};
__device__ __forceinline__ u32x4 pack8(const f32x4 a, const f32x4 b) { u32x4 w; w.x = cvt_pk_bf16(a[0], a[1]); w.y = cvt_pk_bf16(a[2], a[3]); w.z = cvt_pk_bf16(b[0], b[1]); w.w = cvt_pk_bf16(b[2], b[3]); return w; }
struct EpiStore {
    static constexpr bool PERM = true, AFTER_DRAIN = false; bf16_t* O; int ldc;
    __device__ __forceinline__ void operator()(const f32x4 (&acc)[2][2][4][2], const Unit& u, int wr, int wc, int fr, int fq) const {
        const int row0 = u.pm * BM + wr * 64 + fr, col0 = u.pn * BM + wc * 32 + 8 * fq;
#pragma unroll
        for (int ai = 0; ai < 2; ++ai)
#pragma unroll
            for (int m = 0; m < 4; ++m) { bf16_t* rowp = O + (size_t)(row0 + ai * HALF + m * 16) * ldc + col0;
#pragma unroll
                for (int bj = 0; bj < 2; ++bj) *(u32x4*)(rowp + bj * HALF) = pack8(acc[ai][bj][m][0], acc[ai][bj][m][1]); }
    }
};
__device__ __forceinline__ f32x4 silu4(const f32x4 v) { f32x4 r;
#pragma unroll
    for (int i = 0; i < 4; ++i) r[i] = v[i] * __builtin_amdgcn_rcpf(1.f + __expf(-v[i])); return r; }
__device__ __forceinline__ f32x4 sigm4(const f32x4 v) { f32x4 r;
#pragma unroll
    for (int i = 0; i < 4; ++i) r[i] = __builtin_amdgcn_rcpf(1.f + __expf(-v[i])); return r; }
struct EpiSwiglu {
    static constexpr bool PERM = true, AFTER_DRAIN = false; bf16_t* G;
    __device__ __forceinline__ void operator()(const f32x4 (&acc)[2][2][4][2], const Unit& u, int wr, int wc, int fr, int fq) const {
        const int row0 = u.pm * BM + wr * 64 + fr, col0 = u.pn * HALF + wc * 32 + 8 * fq;
#pragma unroll
        for (int ai = 0; ai < 2; ++ai)
#pragma unroll
            for (int m = 0; m < 4; ++m) *(u32x4*)(G + (size_t)(row0 + ai * HALF + m * 16) * 512 + col0) = pack8(silu4(acc[ai][0][m][0]) * acc[ai][1][m][0], silu4(acc[ai][0][m][1]) * acc[ai][1][m][1]);
    }
};
__device__ __forceinline__ void unpack8f(const u32x4 w, f32x4& a, f32x4& b) {
    a[0] = __uint_as_float(w.x << 16); a[1] = __uint_as_float(w.x & 0xffff0000u); a[2] = __uint_as_float(w.y << 16); a[3] = __uint_as_float(w.y & 0xffff0000u);
    b[0] = __uint_as_float(w.z << 16); b[1] = __uint_as_float(w.z & 0xffff0000u); b[2] = __uint_as_float(w.w << 16); b[3] = __uint_as_float(w.w & 0xffff0000u); }
struct EpiGlu {
    static constexpr bool PERM = true, AFTER_DRAIN = false; const bf16_t* GS; const float* b; bf16_t* GG;
    __device__ __forceinline__ void operator()(const f32x4 (&acc)[2][2][4][2], const Unit& u, int wr, int wc, int fr, int fq) const {
        const int row0 = u.pm * BM + wr * 64 + fr, col0 = u.pn * BM + wc * 32 + 8 * fq;
#pragma unroll
        for (int bj = 0; bj < 2; ++bj) { const int c = col0 + bj * HALF; const f32x4 b0 = *(const f32x4*)(b + c), b1 = *(const f32x4*)(b + c + 4);
#pragma unroll
            for (int ai = 0; ai < 2; ++ai)
#pragma unroll
                for (int m = 0; m < 4; ++m) { const size_t o = (size_t)(row0 + ai * HALF + m * 16) * 512 + c; f32x4 g0, g1; unpack8f(*(const u32x4*)(GS + o), g0, g1);
                    *(u32x4*)(GG + o) = pack8(g0 * sigm4(acc[ai][bj][m][0] + b0), g1 * sigm4(acc[ai][bj][m][1] + b1)); } }
    }
};
struct EpiResid {
    static constexpr bool PERM = true, AFTER_DRAIN = false;
    const float* x; const float* ctx; const float* mod; bf16_t* XC; int inplace;
    __device__ __forceinline__ void operator()(const f32x4 (&acc)[2][2][4][2], const Unit& u, int wr, int wc, int fr, int fq) const {
        const int R0 = u.pm * BM; const int ci = R0 < 32768 ? (R0 >> 11) : 16;
        const float* base = R0 < 32768 ? x + (size_t)R0 * 1024 : ctx + (size_t)(R0 - 32768) * 1024;
        bf16_t* out = XC + (size_t)R0 * 1024; const float* gate = mod + ((size_t)ci * 6 + 2) * 1024;
        const int rl0 = wr * 64 + fr, col0 = u.pn * BM + wc * 32 + 8 * fq;
#pragma unroll
        for (int bj = 0; bj < 2; ++bj) { const int c = col0 + bj * HALF; const f32x4 g0 = *(const f32x4*)(gate + c), g1 = *(const f32x4*)(gate + c + 4);
#pragma unroll
            for (int ai = 0; ai < 2; ++ai)
#pragma unroll
                for (int m = 0; m < 4; ++m) { const size_t o = (size_t)(rl0 + ai * HALF + m * 16) * 1024 + c; f32x4 b0, b1;
                    if (inplace) unpack8f(*(const u32x4*)(out + o), b0, b1); else { b0 = *(const f32x4*)(base + o); b1 = *(const f32x4*)(base + o + 4); }
                    *(u32x4*)(out + o) = pack8(b0 + g0 * acc[ai][bj][m][0], b1 + g1 * acc[ai][bj][m][1]); } }
    }
};
}

#include <hip/hip_bf16.h>
#include <cmath>
namespace attn_body {
using bf16=__hip_bfloat16;
using bf16x8=__attribute__((ext_vector_type(8)))short;
using s16x4=__attribute__((ext_vector_type(4)))short;
using f32x16=__attribute__((ext_vector_type(16)))float;
using u32x4=__attribute__((ext_vector_type(4)))unsigned;
constexpr int D=64,QP=512,KP=128,OP=1024;
constexpr int NW=8,QBLK=32,QB=QBLK*NW,KVBLK=64;
constexpr int ATTN_UNIT_ROWS=QB;
__device__ __forceinline__ int crow(int r,int hi){return (r&3)+8*(r>>2)+4*hi;}
#define SBAR() __builtin_amdgcn_sched_barrier(0)
__device__ __forceinline__ void cmask(f32x16&p0,f32x16&p1,int jb,int qrel,int hi){
  const float NEG=-INFINITY; int kb=64*jb+4*hi;
  #pragma unroll
  for(int r=0;r<16;++r){int kv=kb+(r&3)+8*(r>>2); if(kv>qrel)p0[r]=NEG; if(kv+32>qrel)p1[r]=NEG;}
}

constexpr int NSLOT=3, SLOTB=8192;
constexpr int LDS_K=0, LDS_V=NSLOT*SLOTB, LDS_WS=2*NSLOT*SLOTB, LDS_OST=LDS_WS+NW*64*4, LDS_BYTES=LDS_OST+NW*4096;
constexpr float C2=0.125f*1.4426950408889634f;
__device__ __forceinline__ void glds16(const void*gsrc,unsigned lds_dst){unsigned keep;
  asm volatile("s_mov_b32 %0, m0\n\ts_mov_b32 m0, %2\n\ts_nop 0\n\tglobal_load_lds_dwordx4 %1, off\n\ts_mov_b32 m0, %0":"=&s"(keep):"v"(gsrc),"s"(lds_dst):"memory");}
__device__ __forceinline__ float max3f(float a,float b,float c){float r;asm("v_max3_f32 %0, %1, %2, %3":"=v"(r):"v"(a),"v"(b),"v"(c));return r;}
__device__ __forceinline__ float max2f(float a,float b){float r;asm("v_max_f32_e32 %0, %1, %2":"=v"(r):"v"(a),"v"(b));return r;}
__device__ __forceinline__ float fadd_s(float a,float b){float r;asm("v_add_f32_e32 %0, %1, %2":"=v"(r):"v"(a),"v"(b));return r;}
__device__ __forceinline__ float fsub_s(float a,float b){float r;asm("v_sub_f32_e32 %0, %1, %2":"=v"(r):"v"(a),"v"(b));return r;}
typedef float f32x2_t __attribute__((ext_vector_type(2))); typedef __bf16 bf16x2_t __attribute__((ext_vector_type(2)));
__device__ __forceinline__ unsigned cvtpk_s(float lo,float hi){f32x2_t v={lo,hi};bf16x2_t b=__builtin_convertvector(v,bf16x2_t);return __builtin_bit_cast(unsigned,b);}
#define WAIT_BAR(N) asm volatile("s_waitcnt vmcnt(" #N ") lgkmcnt(0)\n\ts_barrier":::"memory")

__device__ __forceinline__ void qkt(f32x16&p0,f32x16&p1,const char*Kslot,const bf16x8*qr,const f32x16&negm,int r32,int hi){
  const char*kb=Kslot+hi*1024+r32*16;
  #pragma unroll
  for(int d0=0;d0<4;++d0){
    const bf16x8 b0=*reinterpret_cast<const bf16x8*>(kb+d0*2048);
    const bf16x8 b1=*reinterpret_cast<const bf16x8*>(kb+d0*2048+512);
    if(d0==0){p0=__builtin_amdgcn_mfma_f32_32x32x16_bf16(b0,qr[0],negm,0,0,0);p1=__builtin_amdgcn_mfma_f32_32x32x16_bf16(b1,qr[0],negm,0,0,0);}
    else{p0=__builtin_amdgcn_mfma_f32_32x32x16_bf16(b0,qr[d0],p0,0,0,0);p1=__builtin_amdgcn_mfma_f32_32x32x16_bf16(b1,qr[d0],p1,0,0,0);}}
}
typedef __attribute__((address_space(3))) const char* lds_cptr;
typedef short v4i16_t __attribute__((ext_vector_type(4)));
__device__ __forceinline__ void kload8(bf16x8*kf,lds_cptr kp){
  kf[0]=*(const __attribute__((address_space(3))) bf16x8*)(kp);      kf[1]=*(const __attribute__((address_space(3))) bf16x8*)(kp+512);
  kf[2]=*(const __attribute__((address_space(3))) bf16x8*)(kp+2048); kf[3]=*(const __attribute__((address_space(3))) bf16x8*)(kp+2560);
  kf[4]=*(const __attribute__((address_space(3))) bf16x8*)(kp+4096); kf[5]=*(const __attribute__((address_space(3))) bf16x8*)(kp+4608);
  kf[6]=*(const __attribute__((address_space(3))) bf16x8*)(kp+6144); kf[7]=*(const __attribute__((address_space(3))) bf16x8*)(kp+6656);
}
__device__ __forceinline__ void kload2(bf16x8*kf,lds_cptr kp,int j){ kf[2*j]=*(const __attribute__((address_space(3))) bf16x8*)(kp+j*2048); kf[2*j+1]=*(const __attribute__((address_space(3))) bf16x8*)(kp+j*2048+512); }
__device__ __forceinline__ s16x4 vtr(lds_cptr p){ return __builtin_bit_cast(s16x4,__builtin_amdgcn_ds_read_tr16_b64_v4i16((__attribute__((address_space(3))) v4i16_t*)p)); }
__device__ __forceinline__ float rowmax(const f32x16&p0,const f32x16&p1){
  float a=max3f(p0[0],p0[1],p1[0]),b=max3f(p0[2],p0[3],p1[1]);a=max3f(a,p1[2],p1[3]);
  #pragma unroll
  for(int r=4;r<16;r+=4){a=max3f(a,p0[r],p0[r+1]);b=max3f(b,p0[r+2],p0[r+3]);a=max3f(a,p1[r],p1[r+1]);b=max3f(b,p1[r+2],p1[r+3]);}
  const float m=max2f(a,b);
  auto rr=__builtin_amdgcn_permlane32_swap(__float_as_uint(m),__float_as_uint(m),false,false);
  return max2f(__uint_as_float(rr[0]),__uint_as_float(rr[1]));
}
__device__ __forceinline__ void pv(f32x16*o,int vb,bf16x8 pa0,bf16x8 pa1,bf16x8 pa2,bf16x8 pa3){
  #pragma unroll
  for(int d0=0;d0<2;++d0){s16x4 lo[4],hi[4];
    #pragma unroll
    for(int ks=0;ks<4;++ks){
      asm volatile("ds_read_b64_tr_b16 %0,%1 offset:%c2":"=&v"(lo[ks]):"v"(vb),"i"(d0*4096+ks*1024):"memory");
      asm volatile("ds_read_b64_tr_b16 %0,%1 offset:%c2":"=&v"(hi[ks]):"v"(vb),"i"(d0*4096+ks*1024+512):"memory");}
    asm volatile("s_waitcnt lgkmcnt(0)":::"memory");SBAR();
    #define PK(k) (bf16x8){lo[k][0],lo[k][1],lo[k][2],lo[k][3],hi[k][0],hi[k][1],hi[k][2],hi[k][3]}
    o[d0]=__builtin_amdgcn_mfma_f32_32x32x16_bf16(pa0,PK(0),o[d0],0,0,0);
    o[d0]=__builtin_amdgcn_mfma_f32_32x32x16_bf16(pa1,PK(1),o[d0],0,0,0);
    o[d0]=__builtin_amdgcn_mfma_f32_32x32x16_bf16(pa2,PK(2),o[d0],0,0,0);
    o[d0]=__builtin_amdgcn_mfma_f32_32x32x16_bf16(pa3,PK(3),o[d0],0,0,0);
    #undef PK
  }
}

#ifndef ATTN_STORE16
#define ATTN_STORE16(p,v) (*(u32x4*)(p)=(v))
#endif
template<int THRL> __device__ __forceinline__ void attn_unit(const bf16*Q0,const bf16*__restrict__ Kh,const bf16*__restrict__ Vh,bf16*O0,const int NT,char*shm){
  const int tid=threadIdx.x,lane=tid&63,r32=lane&31,hi=lane>>5; const int wid=__builtin_amdgcn_readfirstlane(tid>>6);
  const bf16*Qw=Q0+(long)(wid*QBLK)*QP;
  const unsigned lds0=(unsigned)(uintptr_t)shm;
  float*wsf=(float*)(shm+LDS_WS)+wid*64;
  const bf16*ksrc=Kh+(long)lane*KP+wid*8;
  const bf16*vsrc=Vh+(long)(16*(wid&3)+(lane>>2))*KP+(wid>>2)*32+(lane&3)*8;
  const unsigned kdst=lds0+LDS_K+wid*1024, vdst=lds0+LDS_V+wid*1024;
  #define DMA_K(t,slot) glds16(ksrc+(long)(t)*KVBLK*KP,(unsigned)__builtin_amdgcn_readfirstlane(kdst+(slot)))
  #define DMA_V(t,slot) glds16(vsrc+(long)(t)*KVBLK*KP,(unsigned)__builtin_amdgcn_readfirstlane(vdst+(slot)))
  const int vb0=(int)(lds0+LDS_V)+((lane>>4)&1)*32+(lane&3)*8+(4*hi+((lane&15)>>2))*64;
  const char*Kbase=shm+LDS_K; bf16x8 kf[8];
  const lds_cptr shm3=(lds_cptr)shm; const lds_cptr kp0=shm3+LDS_K+hi*1024+r32*16; const lds_cptr vp0=shm3+LDS_V+((lane>>4)&1)*32+(lane&3)*8+(4*hi+((lane&15)>>2))*64;
  DMA_K(0,0);DMA_V(0,0);DMA_K(1,SLOTB);
  bf16x8 qr[4];
  #pragma unroll
  for(int d0=0;d0<4;++d0)qr[d0]=*reinterpret_cast<const bf16x8*>(&Qw[(long)r32*QP+d0*16+hi*8]);
  float mhat=0.f,l_reg=0.f;f32x16 o[2];o[0]=f32x16{};o[1]=f32x16{};f32x16 negm=f32x16{};asm volatile("":"+v"(negm));
  #define CMASK(P0,P1,t) do{}while(0)
  bool resc=false;
  #define START(P0,P1) do{ const float rm=rowmax(P0,P1); resc=false; \
    { const float dl=rm; mhat=fadd_s(mhat,dl); \
      _Pragma("unroll") for(int r=0;r<16;++r){P0[r]=fsub_s(P0[r],dl);P1[r]=fsub_s(P1[r],dl);} \
      _Pragma("unroll") for(int r=0;r<16;++r)negm[r]=-mhat; asm volatile("":"+v"(negm)); } \
    _Pragma("unroll") for(int r=0;r<16;++r)P0[r]=__builtin_amdgcn_exp2f(P0[r]); }while(0)
  #define RESC() do{ if(resc){ asm volatile("s_waitcnt lgkmcnt(0)":::"memory"); \
      _Pragma("unroll") for(int d_=0;d_<2;++d_) _Pragma("unroll") for(int r=0;r<16;++r)o[d_][r]*=wsf[crow(r,hi)]; } }while(0)
  f32x16 pA0,pA1,pB0,pB1;
  int sl_prev=0,sl_cur=0,sl_next=SLOTB;
  #define ROT() do{sl_prev=sl_cur;sl_cur=sl_next;sl_next=(sl_next==(NSLOT-1)*SLOTB)?0:sl_next+SLOTB;}while(0)
  DMA_K(2,2*SLOTB);
  WAIT_BAR(3);
  qkt(pA0,pA1,Kbase,qr,negm,r32,hi);asm volatile("s_nop 15\n\ts_nop 7":"+v"(pA0),"+v"(pA1));CMASK(pA0,pA1,0);
  START(pA0,pA1);
  _Pragma("unroll") for(int r=0;r<16;++r)pA1[r]=__builtin_amdgcn_exp2f(pA1[r]);
  WAIT_BAR(0);
  DMA_K(3,0);DMA_V(1,SLOTB);
  ROT();
  kload8(kf,kp0+sl_cur);
  WAIT_BAR(2);
  s16x4 vlo[8],vhi[8]; u32x4 pw0,pw1,pw2,pw3;
  #define PKW(P,B) cvtpk_s(P[B],P[B+1])
  #define PAF(k) __builtin_bit_cast(bf16x8,pw##k)
  #define VFR(i) (bf16x8){vlo[i][0],vlo[i][1],vlo[i][2],vlo[i][3],vhi[i][0],vhi[i][1],vhi[i][2],vhi[i][3]}
  #define PIN(x) asm volatile("":"+v"(x))
  #define MX3(a,b,c) __builtin_fmaxf(__builtin_fmaxf((a),(b)),(c))
  #define GAPA(MF,A0,A1,A2,A3,W0,W1,PW) do{ MF; sacc+=A0; sacc+=A1; sacc+=A2; sacc+=A3; PIN(sacc); W0; W1; PIN(PW); SBAR(); }while(0)
  #define EX(v) __builtin_amdgcn_exp2f(v)
  #define GAPB(MF,X,B) do{ MF; X[B]=EX(X[B]); X[B+1]=EX(X[B+1]); X[B+2]=EX(X[B+2]); X[B+3]=EX(X[B+3]); PIN(X); SBAR(); }while(0)
  #define VRD(i) do{ vlo[i]=vtr(vp_+(((i)>>2)*4096+((i)&3)*1024)); vhi[i]=vtr(vp_+(((i)>>2)*4096+((i)&3)*1024+512)); }while(0)
  #define KRD(G,j) do{ if(G){ kload2(kf,kp0+sl_next,j); SBAR(); } }while(0)
  #define STEP(C0,C1,P0,P1,t,GK,GV,GL) do{ SBAR(); \
    const lds_cptr vp_=vp0+sl_prev; \
    VRD(0); SBAR(); float sacc=(P0[0]+P0[1]); \
    GAPA(C0=__builtin_amdgcn_mfma_f32_32x32x16_bf16(kf[0],qr[0],negm,0,0,0), P0[2],P0[3],P0[4],P0[5],     pw0[0]=PKW(P0,0), pw0[1]=PKW(P0,2), pw0); \
    VRD(4); SBAR(); GAPA(C1=__builtin_amdgcn_mfma_f32_32x32x16_bf16(kf[1],qr[0],negm,0,0,0), P0[6],P0[7],P0[8],P0[9],     pw0[2]=PKW(P0,4), pw0[3]=PKW(P0,6), pw0); \
    VRD(1); SBAR(); GAPA(C0=__builtin_amdgcn_mfma_f32_32x32x16_bf16(kf[2],qr[1],C0,0,0,0),   P0[10],P0[11],P0[12],P0[13], pw1[0]=PKW(P0,8), pw1[1]=PKW(P0,10), pw1); \
    VRD(5); SBAR(); GAPA(C1=__builtin_amdgcn_mfma_f32_32x32x16_bf16(kf[3],qr[1],C1,0,0,0),   P0[14],P0[15],P1[0],P1[1],   pw1[2]=PKW(P0,12),pw1[3]=PKW(P0,14), pw1); \
    VRD(2); SBAR(); GAPA(C0=__builtin_amdgcn_mfma_f32_32x32x16_bf16(kf[4],qr[2],C0,0,0,0),   P1[2],P1[3],P1[4],P1[5],     pw2[0]=PKW(P1,0), pw2[1]=PKW(P1,2), pw2); \
    VRD(6); SBAR(); GAPA(C1=__builtin_amdgcn_mfma_f32_32x32x16_bf16(kf[5],qr[2],C1,0,0,0),   P1[6],P1[7],P1[8],P1[9],     pw2[2]=PKW(P1,4), pw2[3]=PKW(P1,6), pw2); \
    VRD(3); SBAR(); GAPA(C0=__builtin_amdgcn_mfma_f32_32x32x16_bf16(kf[6],qr[3],C0,0,0,0),   P1[10],P1[11],P1[12],P1[13], pw3[0]=PKW(P1,8), pw3[1]=PKW(P1,10), pw3); \
    VRD(7); SBAR(); GAPA(C1=__builtin_amdgcn_mfma_f32_32x32x16_bf16(kf[7],qr[3],C1,0,0,0),   P1[14],P1[15],0.f,0.f,       pw3[2]=PKW(P1,12),pw3[3]=PKW(P1,14), pw3); \
    l_reg+=sacc; \
    if(GK){DMA_K((t)+3,sl_cur);} if(GV){DMA_V((t)+1,sl_next);} \
    CMASK(C0,C1,t); \
    { float a=MX3(C0[0],C0[1],C1[0]),b=MX3(C0[2],C0[3],C1[1]); a=MX3(a,C1[2],C1[3]); \
      _Pragma("unroll") for(int r=4;r<16;r+=4){a=MX3(a,C0[r],C0[r+1]);b=MX3(b,C0[r+2],C0[r+3]);a=MX3(a,C1[r],C1[r+1]);b=MX3(b,C1[r+2],C1[r+3]);} \
      float rm=__builtin_fmaxf(a,b); { auto rr=__builtin_amdgcn_permlane32_swap(__float_as_uint(rm),__float_as_uint(rm),false,false); rm=__builtin_fmaxf(__uint_as_float(rr[0]),__uint_as_float(rr[1])); } \
      resc=false; \
      if(__builtin_expect(__any(rm>(float)THRL),0)){ const float dl=__builtin_fmaxf(rm,0.f); mhat+=dl; \
        _Pragma("unroll") for(int r=0;r<16;++r){C0[r]-=dl;C1[r]-=dl;} \
        _Pragma("unroll") for(int r=0;r<16;++r)negm[r]=-mhat; asm volatile("":"+v"(negm)); \
        const float f=__builtin_amdgcn_exp2f(-dl); l_reg*=f; if(hi==0)wsf[r32]=f; resc=true; } } \
    SBAR(); \
    GAPB(o[0]=__builtin_amdgcn_mfma_f32_32x32x16_bf16(PAF(0),VFR(0),o[0],0,0,0), C0,0); \
    GAPB(o[1]=__builtin_amdgcn_mfma_f32_32x32x16_bf16(PAF(0),VFR(4),o[1],0,0,0), C0,4); \
    KRD(GL,0); GAPB(o[0]=__builtin_amdgcn_mfma_f32_32x32x16_bf16(PAF(1),VFR(1),o[0],0,0,0), C0,8); \
    KRD(GL,1); GAPB(o[1]=__builtin_amdgcn_mfma_f32_32x32x16_bf16(PAF(1),VFR(5),o[1],0,0,0), C0,12); \
    KRD(GL,2); GAPB(o[0]=__builtin_amdgcn_mfma_f32_32x32x16_bf16(PAF(2),VFR(2),o[0],0,0,0), C1,0); \
    KRD(GL,3); GAPB(o[1]=__builtin_amdgcn_mfma_f32_32x32x16_bf16(PAF(2),VFR(6),o[1],0,0,0), C1,4); \
    GAPB(o[0]=__builtin_amdgcn_mfma_f32_32x32x16_bf16(PAF(3),VFR(3),o[0],0,0,0), C1,8); \
    GAPB(o[1]=__builtin_amdgcn_mfma_f32_32x32x16_bf16(PAF(3),VFR(7),o[1],0,0,0), C1,12); \
    }while(0)
  int t=1;
  #undef CMASK
  #define CMASK(P0,P1,t) do{}while(0)
  for(;t+5<NT;t+=2){
    STEP(pB0,pB1,pA0,pA1,t,true,true,true);     WAIT_BAR(2); RESC(); ROT();
    STEP(pA0,pA1,pB0,pB1,t+1,true,true,true);   WAIT_BAR(2); RESC(); ROT();
  }
  #undef CMASK
  #define CMASK(P0,P1,t) do{}while(0)
  #define ENDW(tt) do{ if((tt)+3<NT){WAIT_BAR(2);} else if((tt)+2<NT){WAIT_BAR(1);} else {WAIT_BAR(0);} }while(0)
  for(;t+1<NT;t+=2){
    STEP(pB0,pB1,pA0,pA1,t,(t+3<NT),(t+1<NT),(t+1<NT));       ENDW(t);   RESC(); ROT();
    STEP(pA0,pA1,pB0,pB1,t+1,(t+4<NT),(t+2<NT),(t+2<NT));     ENDW(t+1); RESC(); ROT();
  }
  STEP(pB0,pB1,pA0,pA1,NT-1,false,false,false); RESC();
  { float sacc=pB0[0]+pB0[1]; _Pragma("unroll") for(int r=2;r<16;++r)sacc+=pB0[r]; _Pragma("unroll") for(int r=0;r<16;++r)sacc+=pB1[r]; l_reg+=sacc;
    pw0=(u32x4){PKW(pB0,0),PKW(pB0,2),PKW(pB0,4),PKW(pB0,6)};pw1=(u32x4){PKW(pB0,8),PKW(pB0,10),PKW(pB0,12),PKW(pB0,14)};pw2=(u32x4){PKW(pB1,0),PKW(pB1,2),PKW(pB1,4),PKW(pB1,6)};pw3=(u32x4){PKW(pB1,8),PKW(pB1,10),PKW(pB1,12),PKW(pB1,14)};
    SBAR(); pv(o,vb0+sl_cur,PAF(0),PAF(1),PAF(2),PAF(3)); }
  #undef PKW
  #undef PAF
  #undef VFR
  #undef PIN
  #undef MX3
  #undef GAPA
  #undef GAPB
  #undef EX
  #undef VRD
  #undef KRD
  #undef STEP
  #undef ENDW
  {auto rr=__builtin_amdgcn_permlane32_swap(__float_as_uint(l_reg),__float_as_uint(l_reg),false,false);l_reg=__uint_as_float(rr[0])+__uint_as_float(rr[1]);}
  if(hi==0)wsf[32+r32]=l_reg;asm volatile("s_waitcnt lgkmcnt(0)":::"memory");
  float rli[16];
  #pragma unroll
  for(int r=0;r<16;++r)rli[r]=__builtin_amdgcn_rcpf(wsf[32+crow(r,hi)]);
  bf16*Ow=O0+(long)(wid*QBLK)*OP;
  { bf16*stg=(bf16*)(shm+LDS_OST)+wid*2048;
    #pragma unroll
    for(int r=0;r<16;++r){const int orow=crow(r,hi);
      #pragma unroll
      for(int d0=0;d0<2;++d0)stg[orow*64+d0*32+r32]=__float2bfloat16(o[d0][r]*rli[r]);}
    asm volatile("s_waitcnt lgkmcnt(0)":::"memory");
    #pragma unroll
    for(int i=0;i<4;++i){const int row=i*8+(lane>>3),ch=lane&7; const u32x4 v=*(const u32x4*)(stg+row*64+ch*8); ATTN_STORE16(Ow+(long)row*OP+ch*8,v);} }
  asm volatile("s_waitcnt lgkmcnt(0)\n\ts_barrier":::"memory");
  #undef DMA_K
  #undef DMA_V
  #undef CMASK
  #undef START
  #undef RESC
  #undef ROT
}
constexpr int ATTN_LDS_BYTES=LDS_BYTES;
#undef SBAR
#undef WAIT_BAR
}

struct Params {
    const float* in[35];
    float* out;
    unsigned char* ws;
    int ph_lo, ph_hi;
};
enum { I_X = 0, I_C, I_CTX, I_CCTX, I_WMOD, I_BMOD, I_GMIX, I_GFFN, I_MIXWIN, I_MIXWOUT, I_QG, I_KG, I_LNG, I_WSP, I_BSP,
       I_S5WIN, I_ARE, I_AIM, I_LOGDT, I_BRE, I_BIM, I_CRE, I_CIM, I_S5D, I_WGLU, I_BGLU, I_S5WOUT,
       I_WGRP, I_BGRP, I_WRT, I_BRT, I_W1, I_W3, I_W2, I_FING };

struct Ctx {
    const Params* p;
    unsigned char* ws;
    LAS unsigned char* lds;
    int tid, lane, wave, gw, ngw;
};
__device__ __forceinline__ const float* xin_row(const Params& P, int r) { return r < TL ? P.in[I_X] + (size_t)r * D : P.in[I_CTX] + (size_t)(r - TL) * D; }
__device__ __forceinline__ int cond_of(int r) { return r < TL ? (r >> 11) : 16; }
__device__ __forceinline__ const float* mod_vec(const Ctx& C, int layer, int ci, int k) { return (const float*)(C.ws + WS_MOD) + ((size_t)(layer * 17 + ci) * 6 + k) * D; }

__device__ __forceinline__ void dsincos(double a, double& s, double& c) {
    const double TWO_PI_HI = 6.283185307179586, TWO_PI_LO = 2.4492935982947064e-16;
    const double k = rint(a * 0.15915494309189535);
    double r = fma(-k, TWO_PI_HI, a); r = fma(-k, TWO_PI_LO, r);
    const double r2 = r * r; double ct = 1.0, st = r, cs = 1.0, ss = r;
#pragma unroll 1
    for (int i = 1; i <= 15; ++i) { ct *= -r2 / (double)((2 * i - 1) * (2 * i)); cs += ct; st *= -r2 / (double)((2 * i) * (2 * i + 1)); ss += st; }
    s = ss; c = cs;
}

struct TItem { const float* src; int N, k0, n0; bf16* dst; int dp; };
__device__ __forceinline__ void t_load(const TItem& t, int lane, float (&r)[32]) {
#pragma unroll
    for (int i = 0; i < 32; ++i) r[i] = t.src[(size_t)(t.k0 + 2 * i + (lane >> 5)) * t.N + t.n0 + (lane & 31)];
}
__device__ __forceinline__ void t_store(const TItem& t, int lane, const float (&r)[32], LAS float* scr) {
#pragma unroll
    for (int i = 0; i < 32; ++i) scr[(2 * i + (lane >> 5)) * 33 + (lane & 31)] = r[i];
    asm volatile("s_waitcnt lgkmcnt(0)" ::: "memory");
    const int c = lane & 7;
#pragma unroll
    for (int j = 0; j < 4; ++j) { const int n = (lane >> 3) + 8 * j; const LAS float* s = scr + (8 * c) * 33 + n;
        v4u o; o.x = pk2(s[0 * 33], s[1 * 33]); o.y = pk2(s[2 * 33], s[3 * 33]); o.z = pk2(s[4 * 33], s[5 * 33]); o.w = pk2(s[6 * 33], s[7 * 33]);
        *(v4u*)(t.dst + (size_t)n * t.dp + 8 * c) = o; }
    asm volatile("s_waitcnt lgkmcnt(0)" ::: "memory");
}
__device__ __forceinline__ TItem mat_item(const float* W, int K, int N, bf16* WT, int it) {
    const int nblk = N / 32, kb = it / nblk, nb = it % nblk;
    return TItem{W, N, kb * 64, nb * 32, WT + (size_t)(nb * 32) * K + kb * 64, K};
}
constexpr int MOE_ITEMS = NEXP * 768;
__device__ __forceinline__ TItem moe_item(const Ctx& C, int layer, int it) {
    const Params& P = *C.p;
    const int e = it / 768, r = it % 768, kind = r / 256, j = r % 256;
    if (kind < 2) {
        const float* src = (kind == 0 ? P.in[I_W1] : P.in[I_W3]) + ((size_t)layer * NEXP + e) * D * EH;
        const int kb = j / 16, nb = j % 16, k0 = kb * 64, n0 = nb * 32;
        const int drow = (n0 / 128) * 256 + (n0 % 128) + (kind == 1 ? 128 : 0);
        return TItem{src, EH, k0, n0, (bf16*)(C.ws + WS_W13) + (size_t)e * 1024 * 1024 + (size_t)drow * 1024 + k0, 1024};
    }
    const float* src = P.in[I_W2] + ((size_t)layer * NEXP + e) * EH * D;
    const int kb = j / 32, nb = j % 32, k0 = kb * 64, n0 = nb * 32;
    return TItem{src, D, k0, n0, (bf16*)(C.ws + WS_W2) + (size_t)e * 1024 * 512 + (size_t)n0 * 512 + k0, 512};
}
constexpr int TI0 = 16 * 56, TI1 = 16 * 32, TI2 = 16 * 16, TI3 = 8 * 16, TI4 = 8 * 32, NSMALL = TI0 + TI1 + TI2 + TI3 + TI4;
__device__ __forceinline__ TItem conv_item(const Ctx& C, int layer, int nsmall, int it) {
    const Params& P = *C.p; int r = it;
    if (r < nsmall) {
        if (r < TI0) return mat_item(P.in[I_MIXWIN], D, MIXW, (bf16*)(C.ws + WS_WIN0), r); r -= TI0;
        if (r < TI1) return mat_item(P.in[I_MIXWOUT], D, D, (bf16*)(C.ws + WS_WOUT0), r); r -= TI1;
        if (r < TI2) return mat_item(P.in[I_S5WIN], D, 512, (bf16*)(C.ws + WS_WS5IN), r); r -= TI2;
        if (r < TI3) return mat_item(P.in[I_WGLU], 512, 512, (bf16*)(C.ws + WS_WGLU), r); r -= TI3;
        return mat_item(P.in[I_S5WOUT], 512, D, (bf16*)(C.ws + WS_WS5OUT), r);
    }
    return moe_item(C, layer, r - nsmall);
}
__device__ __forceinline__ void convert_items(const Ctx& C, int layer, int nsmall) {
    LAS float* scr = (LAS float*)(C.lds + C.wave * 16384);
    const int total = nsmall + MOE_ITEMS, n = C.ngw;
    for (int it = C.gw; it < total; it += 2 * n) {
        const bool two = it + n < total;
        const TItem ta = conv_item(C, layer, nsmall, it), tb = conv_item(C, layer, nsmall, two ? it + n : it);
        float ra[32], rb[32];
        t_load(ta, C.lane, ra); if (two) t_load(tb, C.lane, rb);
        t_store(ta, C.lane, ra, scr); if (two) t_store(tb, C.lane, rb, scr);
    }
}

__device__ __forceinline__ void phase_prologue(const Ctx& C) {
    const Params& P = *C.p;
    {
        LAS float* s = (LAS float*)C.lds;
        LAS float* red = (LAS float*)(C.lds + 17 * 1024 * 4);
        bool have_s = false;
        for (int u = blockIdx.x; u < 192; u += gridDim.x) {
            if (!have_s) {
                for (int i = C.tid; i < 17 * 1024; i += NTHR) { const int ci = i >> 10, k = i & 1023; const float v = ci < 16 ? P.in[I_C][ci * D + k] : P.in[I_CCTX][k]; s[i] = silu_(v); }
                have_s = true; __syncthreads();
            }
            const int layer = u / 96, jg = u % 96, kq = C.tid >> 6, jc = C.tid & 63;
            const float* w = P.in[I_WMOD] + (size_t)layer * D * 6144 + jg * 64 + jc;
            float acc[17];
#pragma unroll
            for (int i = 0; i < 17; ++i) acc[i] = 0.f;
            for (int k0 = kq * 128; k0 < kq * 128 + 128; k0 += 16) {
                float wv[16];
#pragma unroll
                for (int j = 0; j < 16; ++j) wv[j] = w[(size_t)(k0 + j) * 6144];
#pragma unroll
                for (int j = 0; j < 16; ++j)
#pragma unroll
                    for (int i = 0; i < 17; ++i) acc[i] += s[i * 1024 + k0 + j] * wv[j]; }
#pragma unroll
            for (int i = 0; i < 17; ++i) red[(kq * 17 + i) * 64 + jc] = acc[i];
            __syncthreads();
            for (int o = C.tid; o < 17 * 64; o += NTHR) { const int ci = o >> 6, c = o & 63; float v = 0.f;
#pragma unroll
                for (int q = 0; q < 8; ++q) v += red[(q * 17 + ci) * 64 + c];
                const int j = jg * 64 + c; v += P.in[I_BMOD][layer * 6144 + j];
                ((float*)(C.ws + WS_MOD))[((size_t)(layer * 17 + ci)) * 6144 + j] = v; }
            __syncthreads();
        }
        __syncthreads();
    }
    {
        const int gt = blockIdx.x * NTHR + C.tid, ngt = gridDim.x * NTHR;
        float2* rope = (float2*)(C.ws + WS_TAB + TAB_ROPE);
        for (int i = gt; i < 64 * 16; i += ngt) { const int pos = i >> 4, f = i & 15;
            const double th = exp(-(double)f * (9.210340371976184 / 16.0)); double s, c; dsincos((double)pos * th, s, c); rope[i] = make_float2((float)c, (float)s); }
        float2* lamb = (float2*)(C.ws + WS_TAB + TAB_LAMB); float2* bbar = (float2*)(C.ws + WS_TAB + TAB_BBAR);
        for (int i = gt; i < 2 * 32 * 64; i += ngt) {
            const int dg = i >> 6;
            const double are = P.in[I_ARE][i], aim = P.in[I_AIM][i], dt = exp((double)P.in[I_LOGDT][dg]);
            double s, c; dsincos(aim * dt, s, c); const double mag = exp(are * dt), lr = mag * c, li = mag * s;
            lamb[i] = make_float2((float)lr, (float)li);
            const double den = are * are + aim * aim, nr = lr - 1.0, ni = li;
            const double cr = (nr * are + ni * aim) / den, cim = (ni * are - nr * aim) / den;
            for (int p = 0; p < 16; ++p) { const double br = P.in[I_BRE][(size_t)i * 16 + p], bi = P.in[I_BIM][(size_t)i * 16 + p];
                bbar[(size_t)i * 16 + p] = make_float2((float)(cr * br - cim * bi), (float)(cr * bi + cim * br)); }
        }
    }
    {
        const int gt = blockIdx.x * NTHR + C.tid, ngt = gridDim.x * NTHR;
        bf16* wrt = (bf16*)(C.ws + WS_TAB + TAB_WR);
        for (int idx = gt; idx < 2 * 32 * 3 * 64; idx += ngt) {
            const int ln = idx & 63, jb = (idx >> 6) % 3, kk = (idx / 192) & 31, l = idx / (192 * 32);
            const int i = ln & 15, q = ln >> 4, grp = i >> 2, r = i & 3;
            float hi8[8], lo8[8];
#pragma unroll
            for (int e = 0; e < 8; ++e) { const int k = 32 * kk + 8 * q + e;
                const float w = jb < 2 ? P.in[I_WRT][((size_t)l * D + k) * 32 + grp * 8 + jb * 4 + r] : (r == 0 ? P.in[I_WGRP][((size_t)l * D + k) * 4 + grp] : 0.f);
                const float h = bf2f(f2bf(w)); hi8[e] = h; lo8[e] = w - h; }
            v4u oh, ol; oh.x = pk2(hi8[0], hi8[1]); oh.y = pk2(hi8[2], hi8[3]); oh.z = pk2(hi8[4], hi8[5]); oh.w = pk2(hi8[6], hi8[7]);
            ol.x = pk2(lo8[0], lo8[1]); ol.y = pk2(lo8[2], lo8[3]); ol.z = pk2(lo8[4], lo8[5]); ol.w = pk2(lo8[6], lo8[7]);
            const size_t base = ((((size_t)l * 32 + kk) * 3 + jb) * 2) * 64 + ln;
            *(v4u*)(wrt + base * 8) = oh; *(v4u*)(wrt + (base + 64) * 8) = ol;
        }
    }
    {
        const int gt = blockIdx.x * NTHR + C.tid, ngt = gridDim.x * NTHR; bf16* w16 = (bf16*)(C.ws + WS_WSP);
        for (int i = gt; i < 8 * 128 * 128 / 4; i += ngt) { const f32x4 v = *(const f32x4*)(P.in[I_WSP] + 4 * (size_t)i); v2u o; o.x = pk2(v.x, v.y); o.y = pk2(v.z, v.w); *(v2u*)(w16 + 4 * (size_t)i) = o; }
    }
    convert_items(C, 0, NSMALL);
}

__device__ __forceinline__ void load_row16(const float* row, int lane, f32x4 (&v)[4]) {
#pragma unroll
    for (int j = 0; j < 4; ++j) v[j] = *(const f32x4*)(row + 4 * lane + 256 * j);
}
__device__ __forceinline__ float row_rstd(const f32x4 (&v)[4]) {
    float s = 0.f;
#pragma unroll
    for (int j = 0; j < 4; ++j) s += (v[j].x * v[j].x + v[j].y * v[j].y) + (v[j].z * v[j].z + v[j].w * v[j].w);
    return rsqrtf(wave_sum(s) * (1.f / D) + EPS);
}
__device__ __forceinline__ void modulate16(f32x4 (&v)[4], float rstd, const float* g, const float* scale, const float* shift, int lane) {
#pragma unroll
    for (int j = 0; j < 4; ++j) { const int c = 4 * lane + 256 * j; const f32x4 gg = *(const f32x4*)(g + c), sc = *(const f32x4*)(scale + c), sh = *(const f32x4*)(shift + c);
        v[j] = v[j] * rstd * gg * (sc + 1.f) + sh; }
}
__device__ __forceinline__ void store_row16_bf16(bf16* row, int lane, const f32x4 (&v)[4]) {
#pragma unroll
    for (int j = 0; j < 4; ++j) { v2u o; o.x = pk2(v[j].x, v[j].y); o.y = pk2(v[j].z, v[j].w); *(v2u*)(row + 4 * lane + 256 * j) = o; }
}

__device__ __forceinline__ void phase_norm_mix0(const Ctx& C) {
    const Params& P = *C.p; bf16* H = (bf16*)(C.ws + WS_H);
    f32x4 a[4], b[4]; const int n = C.ngw; int r = C.gw;
    if (r < TT) load_row16(xin_row(P, r), C.lane, a);
    if (r + n < TT) load_row16(xin_row(P, r + n), C.lane, b);
#define NM0_ROW(buf, rr, rnext) do { f32x4 v[4] = {buf[0], buf[1], buf[2], buf[3]}; if ((rnext) < TT) load_row16(xin_row(P, (rnext)), C.lane, buf); \
        const float rstd = row_rstd(v); const int ci = cond_of(rr); modulate16(v, rstd, P.in[I_GMIX], mod_vec(C, 0, ci, 1), mod_vec(C, 0, ci, 0), C.lane); store_row16_bf16(H + (size_t)(rr) * D, C.lane, v); } while (0)
    for (; r < TT; r += 2 * n) { NM0_ROW(a, r, r + 2 * n); if (r + n < TT) NM0_ROW(b, r + n, r + 3 * n); }
#undef NM0_ROW
}

__device__ __forceinline__ void qk_norm_rope(float (&v)[8], const float* gain, bool lat, int t, int lane, const float2* rope) {
    float ss = 0.f;
#pragma unroll
    for (int j = 0; j < 8; ++j) ss += v[j] * v[j];
    ss += __shfl_xor(ss, 1); ss += __shfl_xor(ss, 2); ss += __shfl_xor(ss, 4);
    const float rstd = rsqrtf(ss * (1.f / 64.f) + EPS);
    const int l8 = lane & 7;
#pragma unroll
    for (int j = 0; j < 8; ++j) v[j] = v[j] * rstd * gain[l8 * 8 + j];
    const int quarter = l8 >> 1, pos = (quarter < 2) ? (t >> 6) : (t & 63);
#pragma unroll
    for (int j = 0; j < 8; ++j) {
        const float pv = __shfl_xor(v[j], 2);
        if (lat) { const float2 cs = rope[pos * 16 + (lane & 1) * 8 + j];
            v[j] = (quarter & 1) ? (v[j] * cs.x + pv * cs.y) : (v[j] * cs.x - pv * cs.y); }
    }
}
__device__ __forceinline__ void phase_qkprep(const Ctx& C) {
    const Params& P = *C.p; const bf16* Pb = (const bf16*)(C.ws + WS_P); bf16* Q = (bf16*)(C.ws + WS_Q); bf16* Kb = (bf16*)(C.ws + WS_K); bf16* Vb = (bf16*)(C.ws + WS_V);
    const float2* rope = (const float2*)(C.ws + WS_TAB + TAB_ROPE);
    struct Raw { v4u q, k, v, g; };
    const int l16 = C.lane & 15, n = C.ngw;
#define QK_LOAD(dst, rr) do { const bf16* pr_ = Pb + (size_t)(rr) * MIXW; dst.q = *(const v4u*)(pr_ + 8 * C.lane); dst.k = *(const v4u*)(pr_ + 512 + 8 * l16); dst.v = *(const v4u*)(pr_ + 640 + 8 * l16); dst.g = *(const v4u*)(pr_ + 1280 + 8 * C.lane); } while (0)
#define QK_ROW(buf, rr, rnext) do { const Raw w_ = buf; if ((rnext) < TT) QK_LOAD(buf, (rnext)); const int r = (rr); \
        const bool lat = r < TL; const int t = lat ? (r & 2047) : 0; \
        const size_t kvrow = lat ? (size_t)(r >> 11) * KVL + CTXL + (r & 2047) : (size_t)((r - TL) >> 8) * KVL + ((r - TL) & 255); \
        { float v[8]; unpack8(w_.q, v); qk_norm_rope(v, P.in[I_QG], lat, t, C.lane, rope); \
          v4u o; o.x = pk2(v[0] * QSCALE, v[1] * QSCALE); o.y = pk2(v[2] * QSCALE, v[3] * QSCALE); o.z = pk2(v[4] * QSCALE, v[5] * QSCALE); o.w = pk2(v[6] * QSCALE, v[7] * QSCALE); \
          *(v4u*)(Q + (size_t)r * 512 + 8 * C.lane) = o; } \
        { float v[8]; unpack8(w_.k, v); qk_norm_rope(v, P.in[I_KG], lat, t, C.lane, rope); \
          if (C.lane < 16) { v4u o; o.x = pk2(v[0], v[1]); o.y = pk2(v[2], v[3]); o.z = pk2(v[4], v[5]); o.w = pk2(v[6], v[7]); *(v4u*)(Kb + kvrow * 128 + 8 * l16) = o; *(v4u*)(Vb + kvrow * 128 + 8 * l16) = w_.v; } } \
        { float v[8]; unpack8(w_.g, v); float sm = 0.f; \
          _Pragma("unroll") for (int j = 0; j < 8; ++j) { v[j] = gelu_tanh(v[j]); sm += v[j]; } \
          const float mean = wave_sum(sm) * (1.f / 512.f); float qq = 0.f; \
          _Pragma("unroll") for (int j = 0; j < 8; ++j) { const float d = v[j] - mean; qq += d * d; } \
          const float rstd = rsqrtf(wave_sum(qq) * (1.f / 512.f) + EPS); \
          if (C.lane == 0) ((float2*)(C.ws + WS_ROUTE + RT_S))[r] = make_float2(mean, rstd); } } while (0)
    Raw a, b; int r0 = C.gw;
    if (r0 < TT) QK_LOAD(a, r0);
    if (r0 + n < TT) QK_LOAD(b, r0 + n);
    for (; r0 < TT; r0 += 2 * n) { QK_ROW(a, r0, r0 + 2 * n); if (r0 + n < TT) QK_ROW(b, r0 + n, r0 + 3 * n); }
#undef QK_LOAD
#undef QK_ROW
}

__device__ __forceinline__ unsigned gm_off_b(unsigned row, unsigned ch) { return 256u * row + 16u * (ch ^ (((row & 3u) << 2) | ((row >> 2) & 3u))); }
__device__ __forceinline__ void phase_gmlp_fast(const Ctx& C) {
    typedef short bf16x8 __attribute__((ext_vector_type(8)));
    typedef short s16x4 __attribute__((ext_vector_type(4)));
    typedef float f32x16 __attribute__((ext_vector_type(16)));
    const Params& P = *C.p; const bf16* Pb = (const bf16*)(C.ws + WS_P); bf16* OG = (bf16*)(C.ws + WS_H); const bf16* W16 = (const bf16*)(C.ws + WS_WSP);
    const float2* lns = (const float2*)(C.ws + WS_ROUTE + RT_S);
    const int tid = C.tid, lane = C.lane, w = C.wave, l31 = lane & 31, hi = lane >> 5;
    const int gsel = w >> 2, pb = w & 3;
    for (int u = blockIdx.x; u < (TT / 128) * 4; u += gridDim.x) {
        const int ch_ = u >> 2, gp = u & 3;
        { const int row = tid >> 2; const size_t grow = (size_t)ch_ * 128 + row; const float2 st = lns[grow];
#pragma unroll
          for (int i = 0; i < 4; ++i) { const int c16 = (tid & 3) + 4 * i; float v[8]; unpack8(*(const v4u*)(Pb + grow * MIXW + 1280 + 128 * gp + 8 * c16), v);
              const float* lg = P.in[I_LNG] + 128 * gp + 8 * c16;
#pragma unroll
              for (int j = 0; j < 8; ++j) v[j] = (gelu_tanh(v[j]) - st.x) * st.y * lg[j];
              v4u o; o.x = pk2(v[0], v[1]); o.y = pk2(v[2], v[3]); o.z = pk2(v[4], v[5]); o.w = pk2(v[6], v[7]);
              *(LAS v4u*)(C.lds + (row >> 5) * 8192 + gm_off_b(row & 31, c16)) = o; } }
        __syncthreads();
        const int g = 2 * gp + gsel;
        f32x16 acc[2]; acc[0] = f32x16{}; acc[1] = f32x16{};
        const bf16* wrow = W16 + ((size_t)g * 128 + 32 * pb + l31) * 128 + 8 * hi;
#pragma unroll
        for (int k8 = 0; k8 < 8; ++k8) {
            const bf16x8 xf = *(const bf16x8*)(wrow + 16 * k8);
            const unsigned rb = k8 >> 1, ks = k8 & 1;
#pragma unroll
            for (int db = 0; db < 2; ++db) { const unsigned c = 2 * gsel + db, blk = (lane >> 4) & 1, q = (lane & 15) >> 2, p2 = lane & 3;
                s16x4 t0, t1;
                { const unsigned a0 = rb * 8192 + gm_off_b(16 * ks + 8 * hi + q, 4 * c + 2 * blk + (p2 >> 1)) + 8 * (p2 & 1);
                  const unsigned a1 = rb * 8192 + gm_off_b(16 * ks + 8 * hi + 4 + q, 4 * c + 2 * blk + (p2 >> 1)) + 8 * (p2 & 1);
                  t0 = __builtin_bit_cast(s16x4, __builtin_amdgcn_ds_read_tr16_b64_v4i16((LAS s16x4*)(C.lds + a0)));
                  t1 = __builtin_bit_cast(s16x4, __builtin_amdgcn_ds_read_tr16_b64_v4i16((LAS s16x4*)(C.lds + a1))); }
                const bf16x8 yf = {t0[0], t0[1], t0[2], t0[3], t1[0], t1[1], t1[2], t1[3]};
                acc[db] = __builtin_amdgcn_mfma_f32_32x32x16_bf16(xf, yf, acc[db], 0, 0, 0); }
        }
        const float* bsp = P.in[I_BSP] + g * 128 + 32 * pb;
#pragma unroll
        for (int r = 0; r < 16; ++r) { const int pl = (r & 3) + 8 * (r >> 2) + 4 * hi; const size_t grow = (size_t)ch_ * 128 + 32 * pb + pl; const float bb = bsp[pl];
#pragma unroll
            for (int db = 0; db < 2; ++db) { const int col = 64 * g + 32 * db + l31; const float uu = gelu_tanh(bf2f(Pb[grow * MIXW + 768 + col]));
                OG[grow * D + 512 + col] = (bf16)f2bf(uu * (acc[db][r] + bb)); } }
        __syncthreads();
    }
}

__device__ __forceinline__ void phase_attn_fast(const Ctx& C, char* lds_generic) {
    typedef attn_body::bf16 abf;
    const abf* Q = (const abf*)(C.ws + WS_Q); const abf* Kb = (const abf*)(C.ws + WS_K); const abf* Vb = (const abf*)(C.ws + WS_V); abf* OG = (abf*)(C.ws + WS_H);
    const int G = gridDim.x, bx = blockIdx.x; const int vcu = (G % 8 == 0) ? (bx % 8) * (G / 8) + bx / 8 : bx;
    const int per = (1024 + G - 1) / G, perc = (128 + G - 1) / G;
    for (int i = 0; i < per + perc; ++i) {
        int b, h, nt; size_t qrow;
        if (i < per) { const int u = vcu * per + i; if (u >= 1024) continue; const int qb = u & 7, hg = (u >> 3) & 3, bk = u >> 5; b = bk >> 1; h = (bk & 1) * 4 + hg; qrow = (size_t)b * SEQ + qb * 256; nt = KVL / 64; }
        else { const int u = vcu + (i - per) * G; if (u >= 128) continue; b = u >> 3; h = u & 7; qrow = (size_t)TL + (size_t)b * CTXL; nt = CTXL / 64; }
        const size_t kvo = (size_t)b * KVL * 128 + (h >> 2) * 64;
        attn_body::attn_unit<8>(Q + qrow * 512 + h * 64, Kb + kvo, Vb + kvo, OG + qrow * 1024 + h * 64, nt, lds_generic);
    }
}

__device__ __forceinline__ void phase_router_fast(const Ctx& C, int layer, int nrows) {
    typedef short bf16x8 __attribute__((ext_vector_type(8)));
    const Params& P = *C.p; const bf16* XC = (const bf16*)(C.ws + WS_XC); bf16* F = (bf16*)(C.ws + WS_H);
    int* asg_e = (int*)(C.ws + WS_ROUTE + RT_E); int* asg_p = (int*)(C.ws + WS_ROUTE + RT_P); float* asg_w = (float*)(C.ws + WS_ROUTE + RT_W); int* list = (int*)(C.ws + WS_LIST);
    unsigned* cnt = (unsigned*)(C.ws + WS_CTL) + CW_CNT + 64 * layer;
    const bf16x8* WR = (const bf16x8*)(C.ws + WS_TAB + TAB_WR) + (size_t)layer * (32 * 3 * 2 * 64) + C.lane;
    const int l15 = C.lane & 15, q4 = C.lane >> 4;
    LAS float* ab = (LAS float*)(C.lds + C.wave * 8192);
    LAS unsigned* lcnt = (LAS unsigned*)(C.lds + 65536);
    if (C.tid < 64) lcnt[C.tid] = 0u;
    __syncthreads();
    int cur_ci = -1;
    for (int it = C.gw; it < nrows / 16; it += C.ngw) {
        const int row = it * 16 + l15, ci = cond_of(it * 16);
        if (ci != cur_ci) {
            const float* sc = mod_vec(C, layer, ci, 4); const float* sh = mod_vec(C, layer, ci, 3); const float* g0 = P.in[I_GFFN] + layer * D;
#pragma unroll
            for (int j = 0; j < 4; ++j) { const int c = 4 * C.lane + 256 * j; const f32x4 g4 = *(const f32x4*)(g0 + c), s4 = *(const f32x4*)(sc + c), h4 = *(const f32x4*)(sh + c); const f32x4 a4 = g4 * (s4 + 1.f);
                *(LAS f32x4*)(ab + 2 * c) = (f32x4){a4.x, h4.x, a4.y, h4.y}; *(LAS f32x4*)(ab + 2 * c + 4) = (f32x4){a4.z, h4.z, a4.w, h4.w}; }
            asm volatile("s_waitcnt lgkmcnt(0)" ::: "memory"); cur_ci = ci;
        }
        const bf16* xr = XC + (size_t)row * D + 8 * q4;
        float ss = 0.f;
#pragma unroll 16
        for (int kk = 0; kk < 32; ++kk) { pg8::f32x4 a, b; pg8::unpack8f(*(const pg8::u32x4*)(xr + 32 * kk), a, b); ss += (a.x * a.x + a.y * a.y) + (a.z * a.z + a.w * a.w) + (b.x * b.x + b.y * b.y) + (b.z * b.z + b.w * b.w); }
        ss += __shfl_xor(ss, 16); ss += __shfl_xor(ss, 32);
        const float rstd = rsqrtf(ss * (1.f / D) + EPS);
        f32x4 acc[3]; acc[0] = (f32x4){0.f, 0.f, 0.f, 0.f}; acc[1] = acc[0]; acc[2] = acc[0];
        bf16* frow = F + (size_t)row * D + 8 * q4;
        const LAS float* abl = ab + 16 * q4;
#pragma unroll 1
        for (int k2 = 0; k2 < 16; ++k2) {
            const pg8::u32x4 xa = *(const pg8::u32x4*)(xr + 64 * k2), xb = *(const pg8::u32x4*)(xr + 64 * k2 + 32);
            bf16x8 wf[2][3][2];
#pragma unroll
            for (int h = 0; h < 2; ++h)
#pragma unroll
                for (int jb = 0; jb < 3; ++jb) { wf[h][jb][0] = WR[(((2 * k2 + h) * 3 + jb) * 2) * 64]; wf[h][jb][1] = WR[(((2 * k2 + h) * 3 + jb) * 2 + 1) * 64]; }
#pragma unroll
            for (int h = 0; h < 2; ++h) {
                const int c = 64 * k2 + 32 * h;
                pg8::f32x4 x0, x1; pg8::unpack8f(h ? xb : xa, x0, x1);
                const f32x4 t0 = *(const LAS f32x4*)(abl + 2 * c), t1 = *(const LAS f32x4*)(abl + 2 * c + 4), t2 = *(const LAS f32x4*)(abl + 2 * c + 8), t3 = *(const LAS f32x4*)(abl + 2 * c + 12);
                const f32x4 f0 = x0 * rstd * (f32x4){t0.x, t0.z, t1.x, t1.z} + (f32x4){t0.y, t0.w, t1.y, t1.w};
                const f32x4 f1 = x1 * rstd * (f32x4){t2.x, t2.z, t3.x, t3.z} + (f32x4){t2.y, t2.w, t3.y, t3.w};
                const pg8::u32x4 fh = pg8::pack8(f0, f1); *(pg8::u32x4*)(frow + c) = fh;
                pg8::f32x4 r0, r1; pg8::unpack8f(fh, r0, r1);
                const pg8::u32x4 fl = pg8::pack8(f0 - r0, f1 - r1);
                const bf16x8 ah = __builtin_bit_cast(bf16x8, fh), al = __builtin_bit_cast(bf16x8, fl);
#pragma unroll
                for (int jb = 0; jb < 3; ++jb) {
                    acc[jb] = __builtin_amdgcn_mfma_f32_16x16x32_bf16(wf[h][jb][0], ah, acc[jb], 0, 0, 0);
                    acc[jb] = __builtin_amdgcn_mfma_f32_16x16x32_bf16(wf[h][jb][0], al, acc[jb], 0, 0, 0);
                    acc[jb] = __builtin_amdgcn_mfma_f32_16x16x32_bf16(wf[h][jb][1], ah, acc[jb], 0, 0, 0); }
            }
        }
        const float* brt = P.in[I_BRT] + layer * 32 + q4 * 8;
        float e[8];
#pragma unroll
        for (int r = 0; r < 4; ++r) { e[r] = acc[0][r] + brt[r]; e[4 + r] = acc[1][r] + brt[4 + r]; }
        const float gl = acc[2][0] + P.in[I_BGRP][layer * 4 + q4];
        float gm = gl; int gi = q4;
#pragma unroll
        for (int st = 16; st <= 32; st <<= 1) { const float og = __shfl_xor(gm, st); const int oi = __shfl_xor(gi, st); if (og > gm || (og == gm && oi < gi)) { gm = og; gi = oi; } }
        float den = __expf(gl - gm); den += __shfl_xor(den, 16); den += __shfl_xor(den, 32);
        if (q4 == gi) {
            const float gw_ = 1.f / den;
            int i0 = 0; float v0 = e[0];
#pragma unroll
            for (int i = 1; i < 8; ++i) if (e[i] > v0) { v0 = e[i]; i0 = i; }
            int i1 = -1; float v1 = -INFINITY;
#pragma unroll
            for (int i = 0; i < 8; ++i) if (i != i0 && e[i] > v1) { v1 = e[i]; i1 = i; }
            const float e1 = __expf(v1 - v0), w0 = gw_ / (1.f + e1), w1 = gw_ * e1 / (1.f + e1);
            const int ea = gi * 8 + i0, eb = gi * 8 + i1;
            const unsigned pa = __hip_atomic_fetch_add(lcnt + ea, 1u, __ATOMIC_RELAXED, __HIP_MEMORY_SCOPE_WORKGROUP);
            const unsigned pb = __hip_atomic_fetch_add(lcnt + eb, 1u, __ATOMIC_RELAXED, __HIP_MEMORY_SCOPE_WORKGROUP);
            asg_e[2 * row] = ea; asg_e[2 * row + 1] = eb; asg_p[2 * row] = (int)pa; asg_p[2 * row + 1] = (int)pb; asg_w[2 * row] = w0; asg_w[2 * row + 1] = w1;
        }
    }
    asm volatile("s_waitcnt vmcnt(0) lgkmcnt(0)" ::: "memory");
    __syncthreads();
    if (C.tid < 32) { const unsigned n = lcnt[C.tid]; lcnt[32 + C.tid] = n ? __hip_atomic_fetch_add(cnt + C.tid, n, __ATOMIC_RELAXED, __HIP_MEMORY_SCOPE_AGENT) : 0u; }
    __syncthreads();
    for (int it = C.gw; it < nrows / 16; it += C.ngw) {
        if (C.lane < 32) { const int idx = 2 * (it * 16 + (C.lane & 15)) + (C.lane >> 4);
            const int e = __hip_atomic_load(asg_e + idx, __ATOMIC_RELAXED, __HIP_MEMORY_SCOPE_AGENT); const int p = __hip_atomic_load(asg_p + idx, __ATOMIC_RELAXED, __HIP_MEMORY_SCOPE_AGENT) + (int)lcnt[32 + e];
            asg_p[idx] = p; list[(size_t)e * LCAP + p] = idx >> 1; }
    }
}

__device__ __forceinline__ int wave_pstart(const Ctx& C, int layer) {
    const unsigned* cnt = (const unsigned*)(C.ws + WS_CTL) + CW_CNT + 64 * layer;
    const int mc = C.lane < 32 ? (int)__hip_atomic_load(cnt + (C.lane & 31), __ATOMIC_RELAXED, __HIP_MEMORY_SCOPE_AGENT) : 0; const int mp = (mc + 255) & ~255; int in = mp;
#pragma unroll
    for (int o = 1; o < 32; o <<= 1) { const int t = __shfl_up(in, o); if ((C.lane & 31) >= o) in += t; }
    return in - mp;
}
struct CombRaw { v2u x[4], ya[4], yb[4]; float w0, w1; };
__device__ __forceinline__ void comb_load(const Ctx& C, int r, int ps, CombRaw& o) {
    const bf16* Y2 = (const bf16*)(C.ws + WS_XS); const bf16* XC = (const bf16*)(C.ws + WS_XC); const float* asg_w = (const float*)(C.ws + WS_ROUTE + RT_W);
    const int* asg_e = (const int*)(C.ws + WS_ROUTE + RT_E); const int* asg_p = (const int*)(C.ws + WS_ROUTE + RT_P);
    const int s0 = __shfl(ps, asg_e[2 * r]) + asg_p[2 * r], s1 = __shfl(ps, asg_e[2 * r + 1]) + asg_p[2 * r + 1]; o.w0 = asg_w[2 * r]; o.w1 = asg_w[2 * r + 1];
#pragma unroll
    for (int j = 0; j < 4; ++j) { const int c = 4 * C.lane + 256 * j; o.x[j] = *(const v2u*)(XC + (size_t)r * D + c); o.ya[j] = *(const v2u*)(Y2 + (size_t)s0 * D + c); o.yb[j] = *(const v2u*)(Y2 + (size_t)s1 * D + c); }
}
__device__ __forceinline__ void comb_calc(const Ctx& C, int layer, int r, const CombRaw& w, f32x4 (&v)[4]) {
    const float* gate = mod_vec(C, layer, cond_of(r), 5); const float w0 = w.w0, w1 = w.w1;
#pragma unroll
    for (int j = 0; j < 4; ++j) { const int c = 4 * C.lane + 256 * j; const v2u xx = w.x[j], a = w.ya[j], b = w.yb[j]; const f32x4 g = *(const f32x4*)(gate + c);
        v[j].x = bf2f(xx.x & 0xffffu) + g.x * (w0 * bf2f(a.x & 0xffffu) + w1 * bf2f(b.x & 0xffffu)); v[j].y = bf2f(xx.x >> 16) + g.y * (w0 * bf2f(a.x >> 16) + w1 * bf2f(b.x >> 16));
        v[j].z = bf2f(xx.y & 0xffffu) + g.z * (w0 * bf2f(a.y & 0xffffu) + w1 * bf2f(b.y & 0xffffu)); v[j].w = bf2f(xx.y >> 16) + g.w * (w0 * bf2f(a.y >> 16) + w1 * bf2f(b.y >> 16)); }
}
__device__ __forceinline__ void phase_combine_norm_mix1(const Ctx& C) {
    const Params& P = *C.p; bf16* XC = (bf16*)(C.ws + WS_XC); bf16* H = (bf16*)(C.ws + WS_H);
    const int ps = wave_pstart(C, 0), n = C.ngw;
#define CN_ROW(buf, rr, rnext) do { const CombRaw w_ = buf; if ((rnext) < TT) comb_load(C, (rnext), ps, buf); f32x4 v[4]; comb_calc(C, 0, (rr), w_, v); \
        store_row16_bf16(XC + (size_t)(rr) * D, C.lane, v); const float rstd = row_rstd(v); const int ci = cond_of(rr); \
        modulate16(v, rstd, P.in[I_GMIX] + D, mod_vec(C, 1, ci, 1), mod_vec(C, 1, ci, 0), C.lane); store_row16_bf16(H + (size_t)(rr) * D, C.lane, v); } while (0)
    CombRaw a, b; int r = C.gw;
    if (r < TT) comb_load(C, r, ps, a);
    if (r + n < TT) comb_load(C, r + n, ps, b);
    for (; r < TT; r += 2 * n) { CN_ROW(a, r, r + 2 * n); if (r + n < TT) CN_ROW(b, r + n, r + 3 * n); }
#undef CN_ROW
    convert_items(C, 1, 0);
}
__device__ __forceinline__ void phase_final(const Ctx& C) {
    const Params& P = *C.p;
    const int ps = wave_pstart(C, 1), n = C.ngw;
#define FN_ROW(buf, rr, rnext) do { const CombRaw w_ = buf; if ((rnext) < TL) comb_load(C, (rnext), ps, buf); f32x4 v[4]; comb_calc(C, 1, (rr), w_, v); const float rstd = row_rstd(v); \
        _Pragma("unroll") for (int j = 0; j < 4; ++j) { const int c = 4 * C.lane + 256 * j; const f32x4 g = *(const f32x4*)(P.in[I_FING] + c); *(f32x4*)(P.out + (size_t)(rr) * D + c) = v[j] * rstd * g; } } while (0)
    CombRaw a, b; int r = C.gw;
    if (r < TL) comb_load(C, r, ps, a);
    if (r + n < TL) comb_load(C, r + n, ps, b);
    for (; r < TL; r += 2 * n) { FN_ROW(a, r, r + 2 * n); if (r + n < TL) FN_ROW(b, r + n, r + 3 * n); }
#undef FN_ROW
}

__device__ __forceinline__ void phase_s5_fast(const Ctx& C) {
    typedef short bf16x8 __attribute__((ext_vector_type(8)));
    typedef float f32x16 __attribute__((ext_vector_type(16)));
    const Params& P = *C.p; const bf16* U = (const bf16*)(C.ws + WS_U); bf16* GS = (bf16*)(C.ws + WS_GS); float* YA = (float*)(C.ws + WS_YACC);
    const float2* lamb = (const float2*)(C.ws + WS_TAB + TAB_LAMB); const float2* bbar = (const float2*)(C.ws + WS_TAB + TAB_BBAR);
    constexpr int HP = 272;
    const int lane = C.lane, w = C.wave, il = w >> 2, dir = (w >> 1) & 1, nh = w & 1;
    const int l31 = lane & 31, hi = lane >> 5, l15 = lane & 15, q4 = lane >> 4;
    LAS unsigned char* Hb = C.lds + (il * 2 + dir) * (2 * 32 * HP);
    const int srow = (l31 & 3) + 4 * (l31 >> 3) + 16 * ((l31 >> 2) & 1);
    for (int it0 = blockIdx.x; it0 < NB * 16; it0 += gridDim.x) {
        const int item = it0 * 2 + il, b = item >> 5, g = item & 31;
        const int dg = dir * 32 + g, n = nh * 32 + l31;
        const float2 lam = lamb[dg * 64 + n];
        float lpr[16], lpi[16]; { float pr = lam.x, pi = lam.y;
#pragma unroll
            for (int r = 0; r < 16; ++r) { lpr[r] = pr; lpi[r] = pi; const float nr = pr * lam.x - pi * lam.y, ni = pr * lam.y + pi * lam.x; pr = nr; pi = ni; } }
        bf16x8 bre, bim; { const float2* bp = bbar + ((size_t)(dg * 64 + n)) * 16 + 8 * hi;
#pragma unroll
            for (int e = 0; e < 8; ++e) { const float2 v = bp[e]; bre[e] = (short)f2bf(v.x); bim[e] = (short)f2bf(v.y); } }
        bf16x8 cf[4]; { const float* cre = P.in[I_CRE] + ((size_t)dg * 16 + l15) * 64; const float* cim = P.in[I_CIM] + ((size_t)dg * 16 + l15) * 64;
#pragma unroll
            for (int ks = 0; ks < 4; ++ks) { const f32x4 a = *(const f32x4*)(cre + 16 * ks + 4 * q4), m = *(const f32x4*)(cim + 16 * ks + 4 * q4);
                cf[ks][0] = (short)f2bf(a.x); cf[ks][1] = (short)f2bf(-m.x); cf[ks][2] = (short)f2bf(a.y); cf[ks][3] = (short)f2bf(-m.y);
                cf[ks][4] = (short)f2bf(a.z); cf[ks][5] = (short)f2bf(-m.z); cf[ks][6] = (short)f2bf(a.w); cf[ks][7] = (short)f2bf(-m.w); } }
        const f32x4 dsk = *(const f32x4*)(P.in[I_S5D] + g * 16 + 4 * q4);
        float cr = 0.f, ci = 0.f;
#define S5_UROW(kk) ({ const int S_ = 32 * (kk) + srow; (S_ < CTXL) ? ((size_t)TL + (size_t)b * CTXL + (dir == 0 ? S_ : CTXL - 1 - S_)) : ((size_t)b * SEQ + (dir == 0 ? S_ - CTXL : SEQ - 1 - (S_ - CTXL))); })
        bf16x8 ua_next = *(const bf16x8*)(U + S5_UROW(0) * 512 + g * 16 + 8 * hi);
        for (int k = 0; k < 72; ++k) {
            const bf16x8 ua = ua_next;
            if (k + 1 < 72) ua_next = *(const bf16x8*)(U + S5_UROW(k + 1) * 512 + g * 16 + 8 * hi);
            const int sl = 32 * (k - 8) + 16 * nh + l15;
            const int tok = dir == 0 ? sl : SEQ - 1 - sl; const int lt = tok >> 5;
            const size_t o = ((size_t)b * SEQ + (k >= 8 ? tok : 0)) * 512 + g * 16 + 4 * q4;
            const bool first = dir == 0 ? (lt < 32) : (lt >= 32);
            f32x4 pk = {0.f, 0.f, 0.f, 0.f}; v2u uu = {0u, 0u};
            if (k >= 8 && !first) {
                pk.x = __hip_atomic_load(YA + o, __ATOMIC_RELAXED, __HIP_MEMORY_SCOPE_AGENT); pk.y = __hip_atomic_load(YA + o + 1, __ATOMIC_RELAXED, __HIP_MEMORY_SCOPE_AGENT);
                pk.z = __hip_atomic_load(YA + o + 2, __ATOMIC_RELAXED, __HIP_MEMORY_SCOPE_AGENT); pk.w = __hip_atomic_load(YA + o + 3, __ATOMIC_RELAXED, __HIP_MEMORY_SCOPE_AGENT);
                uu = *(const v2u*)(U + o);
            }
            {
              f32x16 br = {}, bi = {};
              br = __builtin_amdgcn_mfma_f32_32x32x16_bf16(ua, bre, br, 0, 0, 0);
              bi = __builtin_amdgcn_mfma_f32_32x32x16_bf16(ua, bim, bi, 0, 0, 0);
              float sr = hi ? 0.f : cr, si = hi ? 0.f : ci;
#pragma unroll
              for (int r = 0; r < 16; ++r) { const float nr = lam.x * sr - lam.y * si + br[r], ni = lam.x * si + lam.y * sr + bi[r]; sr = nr; si = ni; br[r] = sr; bi[r] = si; }
              float er = __shfl_xor(sr, 32), ei = __shfl_xor(si, 32); if (!hi) { er = 0.f; ei = 0.f; }
              { const f32x2 er2 = {er, er}, ei2 = {ei, ei};
#pragma unroll
              for (int r = 0; r < 16; r += 2) { const f32x2 pr2 = {lpr[r], lpr[r + 1]}, pi2 = {lpi[r], lpi[r + 1]}; f32x2 b2 = {br[r], br[r + 1]}, i2 = {bi[r], bi[r + 1]};
                  b2 = b2 + pr2 * er2 - pi2 * ei2; i2 = i2 + pr2 * ei2 + pi2 * er2; br[r] = b2.x; br[r + 1] = b2.y; bi[r] = i2.x; bi[r + 1] = i2.y; } }
              cr = __shfl_xor(br[15], 32); ci = __shfl_xor(bi[15], 32);
              LAS unsigned char* hb = Hb + (k & 1) * (32 * HP) + (16 * hi) * HP + 4 * n;
#pragma unroll
              for (int r = 0; r < 16; ++r) *(LAS unsigned*)(hb + r * HP) = pk2(br[r], bi[r]);
            }
            asm volatile("s_waitcnt lgkmcnt(0)\n\ts_barrier" ::: "memory");
            if (k >= 8) {
                const LAS unsigned char* hr = Hb + (k & 1) * (32 * HP) + (16 * nh + l15) * HP + 16 * q4;
                f32x4 y = {0.f, 0.f, 0.f, 0.f};
#pragma unroll
                for (int ks = 0; ks < 4; ++ks) { const bf16x8 hf = *(const LAS bf16x8*)(hr + 64 * ks); y = __builtin_amdgcn_mfma_f32_16x16x32_bf16(cf[ks], hf, y, 0, 0, 0); }
                if (first) { *(f32x4*)(YA + o) = y; }
                else {
                    const f32x4 uf = {bf2f(uu.x & 0xffffu), bf2f(uu.x >> 16), bf2f(uu.y & 0xffffu), bf2f(uu.y >> 16)};
                    const f32x4 t = y + pk + dsk * uf;
                    v2u ov; ov.x = pk2(gelu_tanh(t.x), gelu_tanh(t.y)); ov.y = pk2(gelu_tanh(t.z), gelu_tanh(t.w)); *(v2u*)(GS + o) = ov;
                }
            }
            if (k == 39) asm volatile("s_waitcnt vmcnt(0)\n\ts_barrier" ::: "memory");
        }
#undef S5_UROW
        asm volatile("s_waitcnt vmcnt(0) lgkmcnt(0)\n\ts_barrier" ::: "memory");
    }
}

__global__ void __launch_bounds__(NTHR, 2) fwd_kernel(Params prm) {
    extern __shared__ __attribute__((aligned(16))) unsigned char lds_raw[];
    Ctx C; C.p = &prm; C.ws = prm.ws; C.lds = (LAS unsigned char*)lds_raw;
    C.tid = threadIdx.x; C.lane = C.tid & 63; C.wave = __builtin_amdgcn_readfirstlane(C.tid >> 6);
    C.gw = blockIdx.x * NWAVE + C.wave; C.ngw = gridDim.x * NWAVE;
    constexpr int LDS_MISC = 147456 - 512;
    volatile LAS unsigned* misc = (volatile LAS unsigned*)(C.lds + LDS_MISC);
    if (C.tid < 64) misc[C.tid] = 0u;
    __syncthreads();
    unsigned* ctl = (unsigned*)(C.ws + WS_CTL);
    XcdBarrier bar; bar.bar = ctl + CW_BAR; bar.x = 0; bar.st = nullptr;
#if MK_ONE_LAUNCH
    bar = xcd_barrier_post(ctl + CW_BAR, misc + 8);
#define SEAM(k) do { if (lo <= (k) && (k) + 1 < hi) xcd_barrier(bar); } while (0)
#else
#define SEAM(k) do { } while (0)
#endif
    const int lo = prm.ph_lo, hi = prm.ph_hi;
#define IN(k) (lo <= (k) && (k) < hi)
#if MK_PROBE
    volatile LAS unsigned long long* ts_ = (volatile LAS unsigned long long*)(C.lds + LDS_MISC + 64);
#define STAMP(k) do { if (blockIdx.x == 0 && C.tid == 0) ts_[(k) + 1] = __builtin_amdgcn_s_memrealtime(); } while (0)
    if (blockIdx.x == 0 && C.tid == 0) ts_[0] = __builtin_amdgcn_s_memrealtime();
#else
#define STAMP(k) do { } while (0)
#endif
    const Params& P = prm;
    bf16* Hb = (bf16*)(C.ws + WS_H); bf16* XC = (bf16*)(C.ws + WS_XC);
#define MOE_MAP(layer) do { LAS int* tm_ = (LAS int*)(C.lds + 131072); LAS int* cl_ = tm_ + 320; \
        if (C.wave == 0) { const unsigned* cnt_ = (const unsigned*)(C.ws + WS_CTL) + CW_CNT + 64 * (layer); const int mc_ = C.lane < 32 ? (int)__hip_atomic_load(cnt_ + (C.lane & 31), __ATOMIC_RELAXED, __HIP_MEMORY_SCOPE_AGENT) : 0; const int mp_ = (mc_ + 255) & ~255; int in_ = mp_; \
            _Pragma("unroll") for (int o_ = 1; o_ < 32; o_ <<= 1) { const int t_ = __shfl_up(in_, o_); if ((C.lane & 31) >= o_) in_ += t_; } const int ps_ = in_ - mp_; \
            if (C.lane < 32) { for (int t_ = ps_ / 256; t_ < (ps_ + mp_) / 256; ++t_) tm_[t_] = C.lane | ((t_ * 256 - ps_) << 8); cl_[C.lane] = mc_; if (C.lane == 31) cl_[32] = (ps_ + mp_) / 256; } } \
        __syncthreads(); } while (0)
#define MOE_GEMM1(layer) do { MOE_MAP(layer); const LAS int* tm_ = (const LAS int*)(C.lds + 131072); const int ntl_ = __builtin_amdgcn_readfirstlane(tm_[320 + 32]); pg8::Gemm g{Hb, (const bf16*)(C.ws + WS_W13), 0, 1024, D}; \
        pg8::GroupedOrder<true> S{tm_, tm_ + 320, (const int*)(C.ws + WS_LIST), ntl_ * 4, 4, (int)gridDim.x, (int)blockIdx.x, LCAP, D * 2, (size_t)1024 * 1024 * 2}; pg8::EpiSwiglu E{(bf16*)(C.ws + WS_G13)}; \
        pg8::gemm_phase<pg8::EpiSwiglu, pg8::GroupedOrder<true>, true, true>(C.lds, g, S, E); } while (0)
#define MOE_GEMM2(layer) do { MOE_MAP(layer); const LAS int* tm_ = (const LAS int*)(C.lds + 131072); const int ntl_ = __builtin_amdgcn_readfirstlane(tm_[320 + 32]); pg8::Gemm g{(const bf16*)(C.ws + WS_G13), (const bf16*)(C.ws + WS_W2), 0, 1024, EH}; \
        pg8::GroupedOrder<false> S{tm_, tm_ + 320, (const int*)(C.ws + WS_LIST), ntl_ * 4, 4, (int)gridDim.x, (int)blockIdx.x, LCAP, EH * 2, (size_t)1024 * 512 * 2}; pg8::EpiStore E{(bf16*)(C.ws + WS_XS), D}; \
        pg8::gemm_phase<pg8::EpiStore, pg8::GroupedOrder<false>, true, true>(C.lds, g, S, E); } while (0)
    if (IN(0)) { phase_prologue(C); SEAM(0); STAMP(0); }
    if (IN(1)) { phase_norm_mix0(C); SEAM(1); STAMP(1); }
    if (IN(2)) { pg8::Gemm g{Hb, (const bf16*)(C.ws + WS_WIN0), TT, MIXW, D}; pg8::StaticOrder S; S.init(TT, MIXW, gridDim.x, blockIdx.x); pg8::EpiStore E{(bf16*)(C.ws + WS_P), MIXW};
        pg8::gemm_phase<pg8::EpiStore, pg8::StaticOrder, true, true, true>(C.lds, g, S, E); SEAM(2); STAMP(2); }
    if (IN(3)) { phase_qkprep(C); SEAM(3); STAMP(3); }
    if (IN(4)) { phase_gmlp_fast(C); phase_attn_fast(C, (char*)lds_raw); SEAM(4); STAMP(4); }
    if (IN(5)) { pg8::Gemm g{Hb, (const bf16*)(C.ws + WS_WOUT0), TT, D, D}; pg8::StaticOrder S; S.init(TT, D, gridDim.x, blockIdx.x); pg8::EpiResid E{P.in[I_X], P.in[I_CTX], (const float*)(C.ws + WS_MOD), XC, 0};
        pg8::gemm_phase<pg8::EpiResid, pg8::StaticOrder, true, true, true>(C.lds, g, S, E); SEAM(5); STAMP(5); }
    if (IN(6)) { phase_router_fast(C, 0, TT); SEAM(6); STAMP(6); }
    if (IN(8)) { MOE_GEMM1(0); SEAM(8); STAMP(8); }
    if (IN(9)) { MOE_GEMM2(0); SEAM(9); STAMP(9); }
    if (IN(10)) { phase_combine_norm_mix1(C); SEAM(10); STAMP(10); }
    if (IN(11)) { pg8::Gemm g{Hb, (const bf16*)(C.ws + WS_WS5IN), TT, 512, D}; pg8::StaticOrder S; S.init(TT, 512, gridDim.x, blockIdx.x); pg8::EpiStore E{(bf16*)(C.ws + WS_U), 512};
        pg8::gemm_phase<pg8::EpiStore, pg8::StaticOrder, true, true, true>(C.lds, g, S, E); SEAM(11); STAMP(11); }
    if (IN(12)) { phase_s5_fast(C); SEAM(12); STAMP(12); }
    if (IN(13)) { pg8::Gemm g{(const bf16*)(C.ws + WS_GS), (const bf16*)(C.ws + WS_WGLU), TL, 512, 512}; pg8::StaticOrder S; S.init(TL, 512, gridDim.x, blockIdx.x); pg8::EpiGlu E{(const bf16*)(C.ws + WS_GS), P.in[I_BGLU], (bf16*)(C.ws + WS_GG)};
        pg8::gemm_phase<pg8::EpiGlu, pg8::StaticOrder, true, true, true>(C.lds, g, S, E); SEAM(13); STAMP(13); }
    if (IN(14)) { pg8::Gemm g{(const bf16*)(C.ws + WS_GG), (const bf16*)(C.ws + WS_WS5OUT), TL, D, 512}; pg8::StaticOrder S; S.init(TL, D, gridDim.x, blockIdx.x); pg8::EpiResid E{P.in[I_X], P.in[I_CTX], (const float*)(C.ws + WS_MOD) + (size_t)17 * 6 * D, XC, 1};
        pg8::gemm_phase<pg8::EpiResid, pg8::StaticOrder, true, true, true>(C.lds, g, S, E); SEAM(14); STAMP(14); }
    if (IN(15)) { phase_router_fast(C, 1, TL); SEAM(15); STAMP(15); }
    if (IN(17)) { MOE_GEMM1(1); SEAM(17); STAMP(17); }
    if (IN(18)) { MOE_GEMM2(1); SEAM(18); STAMP(18); }
    if (IN(19)) { phase_final(C); STAMP(19); }
#if MK_PROBE
    if (blockIdx.x == 0 && C.tid == 0) {
        ts_[8] = ts_[7]; ts_[17] = ts_[16];
        const unsigned long long tA = ts_[PROBE_A_HI + 1] - ts_[PROBE_A_LO], tB = ts_[PROBE_B_HI + 1] - ts_[PROBE_B_LO];
        const unsigned long long spin = 16ull * tA + 1000000ull * ((tB + 500ull) / 1000ull);
        const unsigned long long t0 = __builtin_amdgcn_s_memrealtime();
        while (__builtin_amdgcn_s_memrealtime() - t0 < spin) __builtin_amdgcn_s_sleep(8);
    }
#endif
#undef IN
#undef SEAM
}

extern "C" void kernel_launch(void* const* d_in, const int* in_sizes, int n_in, void* d_out, int out_size, void* d_ws, size_t ws_size, hipStream_t stream) {
    constexpr int LDS_BYTES = 147456;
    static int grid = 0;
    if (grid == 0) {
        if (n_in != 35 || out_size != TL * D || ws_size < WS_END) { fprintf(stderr, "kernel_launch: unexpected shapes (n_in %d out %d ws %zu)\n", n_in, out_size, ws_size); grid = -1; return; }
        int dev = 0, cus = 0;
        if (hipGetDevice(&dev) != hipSuccess || hipDeviceGetAttribute(&cus, hipDeviceAttributeMultiprocessorCount, dev) != hipSuccess) { grid = -1; return; }
        if (hipFuncSetAttribute((const void*)fwd_kernel, hipFuncAttributeMaxDynamicSharedMemorySize, LDS_BYTES) != hipSuccess) { fprintf(stderr, "kernel_launch: hipFuncSetAttribute failed\n"); grid = -1; return; }
        (void)hipGetLastError();
        grid = cus;
    }
    if (grid < 0) return;
    (void)hipMemsetAsync((char*)d_ws + WS_CTL, 0, CTL_BYTES, stream);
    Params p{};
    for (int i = 0; i < 35; ++i) p.in[i] = (const float*)d_in[i];
    p.out = (float*)d_out; p.ws = (unsigned char*)d_ws;
#if MK_ONE_LAUNCH
    p.ph_lo = 0; p.ph_hi = NPHASE;
    hipLaunchKernelGGL(fwd_kernel, dim3(grid), dim3(NTHR), LDS_BYTES, stream, p);
#else
    for (int k = 0; k < NPHASE; ++k) { p.ph_lo = k; p.ph_hi = k + 1; hipLaunchKernelGGL(fwd_kernel, dim3(grid), dim3(NTHR), LDS_BYTES, stream, p); }
#endif
}
```

```cpp
#include <hip/hip_runtime.h>
#include <cstdio>
#include <cstdint>

#ifndef MK_ONE_LAUNCH
#define MK_ONE_LAUNCH 1
#endif
#ifndef MK_SIMPLE_ORDER
#define MK_SIMPLE_ORDER 0
#endif
#ifndef MK_KROT
#define MK_KROT 0
#endif
#ifndef MK_PROBE
#define MK_PROBE 0
#endif
#define PROBE_A_LO 4
#define PROBE_A_HI 4
#define PROBE_B_LO 8
#define PROBE_B_HI 9

constexpr int D = 1024, NB = 16, SEQ = 2048, CTXL = 256;
constexpr int TL = NB * SEQ, TC = NB * CTXL, TT = TL + TC;
constexpr int KVL = CTXL + SEQ;
constexpr int MIXW = 1792, NEXP = 32, EH = 512;
constexpr int NSLOT = 81920;
constexpr float EPS = 1e-6f;
constexpr float QSCALE = 0.125f * 1.4426950408889634f;
constexpr int NTHR = 512, NWAVE = 8;
constexpr int NPHASE = 20;

constexpr size_t MiB = 1u << 20;
constexpr size_t WS_CTL = 0, CTL_BYTES = 1 * MiB;
constexpr size_t WS_MOD = 1 * MiB;
constexpr size_t WS_TAB = 2 * MiB;
constexpr size_t TAB_ROPE = 0, TAB_LAMB = 16384, TAB_BBAR = 65536, TAB_WR = 640 * 1024;
constexpr size_t WS_ROUTE = 3 * MiB;
constexpr size_t RT_E = 0, RT_P = 320 * 1024, RT_W = 640 * 1024, RT_S = 960 * 1024, RT_TILE = 1280 * 1024, RT_NT = 1280 * 1024 + 4096;
constexpr size_t WS_WIN0 = 6 * MiB, WS_WOUT0 = 10 * MiB, WS_WS5IN = 12 * MiB, WS_WGLU = 13 * MiB, WS_WS5OUT = 14 * MiB;
constexpr size_t WS_WSP = 15 * MiB;
constexpr size_t WS_W13 = 16 * MiB, WS_W2 = 80 * MiB;
constexpr size_t WS_XC = 112 * MiB;
constexpr size_t WS_H = 256 * MiB;
constexpr size_t WS_P = 328 * MiB;
constexpr size_t WS_Q = 454 * MiB, WS_K = 490 * MiB, WS_V = 499 * MiB;
constexpr size_t WS_XS = 328 * MiB;
constexpr size_t WS_G13 = 488 * MiB;
constexpr size_t WS_U = 328 * MiB, WS_GS = 364 * MiB, WS_GG = 396 * MiB, WS_YACC = 428 * MiB;
constexpr size_t WS_LIST = 568 * MiB;
constexpr int LCAP = 36864;
constexpr size_t WS_END = 574 * MiB;
constexpr int CW_CNT = 64;
constexpr int CW_BAR = 4096;

#define STAMP_AT(idx) do { if (MK_PROBE && blockIdx.x == 0 && threadIdx.x == 0) ((volatile __attribute__((address_space(3))) unsigned long long*)(C.lds + 147456 - 512 + 64))[idx] = __builtin_amdgcn_s_memrealtime(); } while (0)
#define LAS __attribute__((address_space(3)))
typedef unsigned short bf16;
typedef unsigned v4u __attribute__((ext_vector_type(4)));
typedef unsigned v2u __attribute__((ext_vector_type(2)));
typedef float f32x4 __attribute__((ext_vector_type(4)));
typedef float f32x2 __attribute__((ext_vector_type(2)));
__device__ __forceinline__ float bf2f(unsigned u) { return __uint_as_float(u << 16); }
typedef __bf16 bf16x2_t __attribute__((ext_vector_type(2)));
__device__ __forceinline__ unsigned pk2(float lo, float hi) { const f32x2 v = {lo, hi}; return __builtin_bit_cast(unsigned, __builtin_convertvector(v, bf16x2_t)); }
__device__ __forceinline__ unsigned f2bf(float f) { return pk2(f, 0.f) & 0xffffu; }
__device__ __forceinline__ float wave_sum(float v) {
#pragma unroll
    for (int o = 1; o < 64; o <<= 1) v += __shfl_xor(v, o);
    return v;
}
__device__ __forceinline__ float wave_max(float v) {
#pragma unroll
    for (int o = 1; o < 64; o <<= 1) v = fmaxf(v, __shfl_xor(v, o));
    return v;
}
__device__ __forceinline__ float gelu_tanh(float x) { const float u2 = -1.5957691216057308f * (x + 0.044715f * x * x * x); return x * __builtin_amdgcn_rcpf(1.f + __expf(u2)); }
__device__ __forceinline__ float sigmoidf_(float x) { return 1.f / (1.f + __expf(-x)); }
__device__ __forceinline__ float silu_(float x) { return x / (1.f + __expf(-x)); }
__device__ __forceinline__ void unpack8(const v4u w, float* f) {
    f[0] = bf2f(w.x & 0xffffu); f[1] = bf2f(w.x >> 16); f[2] = bf2f(w.y & 0xffffu); f[3] = bf2f(w.y >> 16);
    f[4] = bf2f(w.z & 0xffffu); f[5] = bf2f(w.z >> 16); f[6] = bf2f(w.w & 0xffffu); f[7] = bf2f(w.w >> 16);
}

#define XB_TMO      128
#define XB_XCNT(j)  (256  + 64 * (j))
#define XB_XSUB(j)  (1280 + 64 * (j))
#define XB_XGEN(j)  (2304 + 64 * (j))
#define XB_TOP      3328
#define XB_TOPGEN   3392
#define XCD_BAR_WORDS 3456
#define XB_SPIN_CAP (1u << 28)
__device__ __forceinline__ unsigned xb_ld(unsigned* p)              { return __hip_atomic_load(p, __ATOMIC_RELAXED, __HIP_MEMORY_SCOPE_AGENT); }
__device__ __forceinline__ unsigned xb_add(unsigned* p, unsigned v) { return __hip_atomic_fetch_add(p, v, __ATOMIC_RELAXED, __HIP_MEMORY_SCOPE_AGENT); }
__device__ __forceinline__ unsigned xb_xcc_id() { return (unsigned)__builtin_amdgcn_s_getreg((3 << 11) | 20) & 0xFu; }
#define XB_SPIN(cond, bar) do { unsigned _sp = 0; while (cond) { __builtin_amdgcn_s_sleep(1); \
    if ((++_sp & 255u) == 0u) { if (xb_ld(&(bar)[XB_TMO])) break; if (_sp > XB_SPIN_CAP) { atomicAdd(&(bar)[XB_TMO], 1u); break; } } } } while (0)
struct XcdBarrier { unsigned* bar; unsigned x; volatile LAS unsigned* st; };
__device__ __forceinline__ XcdBarrier xcd_barrier_post(unsigned* bar, volatile LAS unsigned* st) {
    XcdBarrier b; b.bar = bar; b.x = xb_xcc_id(); b.st = st;
    if (threadIdx.x == 0) (void)xb_add(&bar[XB_XCNT(b.x)], 1u);
    return b;
}
__device__ __forceinline__ void xcd_barrier_complete(unsigned* bar, unsigned x, unsigned& nloc, unsigned& nx) {
    const unsigned G = gridDim.x * gridDim.y * gridDim.z;
    unsigned sum, cnt, mine, sp = 0u;
    for (;;) {
        sum = 0u; cnt = 0u; mine = 0u;
#pragma unroll
        for (unsigned j = 0; j < 16; ++j) { const unsigned c = xb_ld(&bar[XB_XCNT(j)]); sum += c; cnt += (c > 0u) ? 1u : 0u; mine = (j == x) ? c : mine; }
        if (sum == G) break;
        __builtin_amdgcn_s_sleep(1);
        if ((++sp & 255u) == 0u) { if (xb_ld(&bar[XB_TMO])) break; if (sp > XB_SPIN_CAP) { atomicAdd(&bar[XB_TMO], 1u); break; } }
    }
    nloc = mine > 0u ? mine : 1u; nx = cnt > 0u ? cnt : 1u;
}
__device__ __forceinline__ void xcd_barrier(const XcdBarrier& b) {
    asm volatile("s_waitcnt vmcnt(0)" ::: "memory");
    __syncthreads();
    if (threadIdx.x == 0) {
        unsigned* bar = b.bar;
        __builtin_amdgcn_s_waitcnt(0);
        unsigned nloc = b.st[0], nx = b.st[1];
        if (nloc == 0u) { xcd_barrier_complete(bar, b.x, nloc, nx); b.st[0] = nloc; b.st[1] = nx; }
        const unsigned old = xb_add(&bar[XB_XSUB(b.x)], 1u);
        const unsigned gen = old / nloc;
        if (old + 1u == (gen + 1u) * nloc) {
            __builtin_amdgcn_fence(__ATOMIC_RELEASE, "agent");
            asm volatile("s_waitcnt vmcnt(0)" ::: "memory");
            const unsigned og = xb_add(&bar[XB_TOP], 1u);
            const unsigned tg = og / nx;
            if (og + 1u == (tg + 1u) * nx) xb_add(&bar[XB_TOPGEN], 1u);
            else XB_SPIN(xb_ld(&bar[XB_TOPGEN]) == tg, bar);
            __builtin_amdgcn_fence(__ATOMIC_ACQUIRE, "agent");
            xb_add(&bar[XB_XGEN(b.x)], 1u);
            asm volatile("s_waitcnt vmcnt(0)" ::: "memory");
        } else {
            XB_SPIN(xb_ld(&bar[XB_XGEN(b.x)]) == gen, bar);
            __builtin_amdgcn_fence(__ATOMIC_ACQUIRE, "agent");
            asm volatile("s_waitcnt vmcnt(0)" ::: "memory");
        }
    }
    __syncthreads();
}

namespace pg8 {
#define PG8_LAS __attribute__((address_space(3)))
typedef unsigned short bf16_t;
typedef short bf16x8 __attribute__((ext_vector_type(8)));
typedef float f32x4 __attribute__((ext_vector_type(4)));
typedef unsigned u32x4 __attribute__((ext_vector_type(4)));
constexpr int BM = 256, BK = 64, HALF = 128, HTB = HALF * BK * 2  , STAGE_BYTES = 8 * HTB, NXCD = 8, WGM = 8;

__host__ __device__ __forceinline__ int lds_byte(int r, int c) { const int st = (r >> 4) * 2 + (c >> 5), rr = r & 15, cc = c & 31, ob = rr * 64 + cc * 2; return st * 1024 + (ob ^ (((ob >> 9) & 1) << 5)); }
__host__ __device__ __forceinline__ void stage_rc(int b, int& R, int& C) { const int st = b / 1024, sb = b % 1024, swz = sb ^ (((sb >> 9) & 1) << 5); R = (st >> 1) * 16 + swz / 64; C = (st & 1) * 32 + (swz % 64) / 2; }
__host__ __device__ __forceinline__ int perm32(int rho) { const int n = rho >> 4, i = rho & 15; return 8 * (i >> 2) + 4 * n + (i & 3); }

struct Unit { int pm, pn; size_t bo; int aux; };
struct Gemm { const bf16_t* A; const bf16_t* Bt; int M, N, K; };

struct StaticOrder {
    static constexpr bool GATHER = false;
    int nM, nN, nwg, G, c;
    __host__ __device__ void init(int M, int N, int G_, int c_) { nM = M / BM; nN = N / BM; nwg = nM * nN; G = G_; c = c_; }
    __host__ __device__ bool next(int i, Unit& u) const {
        const long L = (long)i * G + c; if (L >= nwg) return false;
        if (MK_SIMPLE_ORDER) { u.pm = (int)L / nN; u.pn = (int)L % nN; u.bo = 0; u.aux = 0; return true; }
        int wgid = (int)L; { const int q = nwg / NXCD, r = nwg % NXCD, xcd = wgid % NXCD, off = wgid / NXCD; wgid = (xcd < r ? xcd * (q + 1) : r * (q + 1) + (xcd - r) * q) + off; }
        const int nig = WGM * nN, gid = wgid / nig, fm = gid * WGM, gsz = (nM - fm) < WGM ? (nM - fm) : WGM;
        u.pm = fm + ((wgid % nig) % gsz); u.pn = (wgid % nig) / gsz; u.bo = 0; u.aux = 0; return true;
    }
    __device__ __forceinline__ void a_ready(const Unit&) const {}
    __device__ __forceinline__ void done(const Unit&) const {}
};

typedef __bf16 bf16x2_c __attribute__((ext_vector_type(2))); typedef float f32x2_c __attribute__((ext_vector_type(2)));
__device__ __forceinline__ unsigned cvt_pk_bf16(float lo, float hi) { const f32x2_c v = {lo, hi}; return __builtin_bit_cast(unsigned, __builtin_convertvector(v, bf16x2_c)); }
typedef float f32x2 __attribute__((ext_vector_type(2)));
__device__ __forceinline__ f32x2 gelu_pk(f32x2 v) {
    const f32x2 av = __builtin_elementwise_abs(v), d = av * 0.2316418882f + 1.0f;
    f32x2 t; t.x = __builtin_amdgcn_rcpf(d.x); t.y = __builtin_amdgcn_rcpf(d.y);
    f32x2 q = t * 0.5307027145f + (-0.7265760135f); q = q * t + 0.7107068705f; q = q * t + (-0.142248368f); q = q * t + 0.127414796f; q = q * t;
    const f32x2 s = (v * v) * (-0.72134752044f);
    f32x2 e; e.x = __builtin_amdgcn_exp2f(s.x); e.y = __builtin_amdgcn_exp2f(s.y);
    const f32x2 m = v * (q * e), r = v - m;
    f32x2 o; o.x = v.x < 0.f ? m.x : r.x; o.y = v.y < 0.f ? m.y : r.y; return o;
}

template <class Epi, class Sched, bool ALIGN_EPI = false, bool SP2 = false, bool KROT = false>
__device__ __forceinline__ void gemm_phase(PG8_LAS unsigned char* lds, const Gemm g, const Sched& S, const Epi& E) {
    const int tid = threadIdx.x, wid = __builtin_amdgcn_readfirstlane(tid >> 6), lane = tid & 63, wr = wid >> 2, wc = wid & 3, fr = lane & 15, fq = lane >> 4;
    const int K = g.K, nt = K / BK;
    const int kmask = nt - 1, rot = (MK_KROT && KROT) ? (int)((blockIdx.x * 3u + (blockIdx.x >> 3)) & (unsigned)kmask) : 0;
#define PG8_KO(j) ((size_t)(((j) + rot) & kmask) * kstep)
    unsigned voffA[2], voffB[2];
    unsigned vC[2][2], vN[2][2];
#pragma unroll
    for (int i = 0; i < 2; ++i) { int R, C; stage_rc(tid * 16 + i * 8192, R, C); const int Rb = Epi::PERM ? ((R & ~31) + perm32(R & 31)) : R;
        voffA[i] = (unsigned)(R * K + C) * 2u; voffB[i] = (unsigned)(Rb * K + C) * 2u; }
    const size_t kstep = (size_t)(BK * 2);
    const size_t hstep = (size_t)HALF * K * 2;
    const size_t tstep = 2 * hstep;
    const unsigned ldsw = (unsigned)wid * 1024u;
    const int aoff = lds_byte(wr * 64 + fr, fq * 8), boff = lds_byte(wc * 32 + fr, fq * 8);
#define PG8_SA(b, h) (((b) * 2 + (h)) * HTB)
#define PG8_SB(b, h) ((4 + (b) * 2 + (h)) * HTB)
#define PG8_STAGE(bufoff, gbase, voff) do { _Pragma("unroll") for (int _i = 0; _i < 2; ++_i) \
        __builtin_amdgcn_global_load_lds((const unsigned*)((const char*)(gbase) + (voff)[_i]), (PG8_LAS unsigned*)(lds + (bufoff) + ldsw + _i * 8192), 16, 0, 0); } while (0)
#define PG8_STAGE_A(bufoff, gbase, h, nx) do { _Pragma("unroll") for (int _i = 0; _i < 2; ++_i) { \
        const unsigned _vo = Sched::GATHER ? ((nx) ? vN[h][_i] : vC[h][_i]) : (unsigned)((h) * hstep) + voffA[_i]; \
        __builtin_amdgcn_global_load_lds((const unsigned*)((const char*)(gbase) + _vo), (PG8_LAS unsigned*)(lds + (bufoff) + ldsw + _i * 8192), 16, 0, 0); } } while (0)
#define PG8_LDA(dst, b, h) do { _Pragma("unroll") for (int m = 0; m < 4; ++m) _Pragma("unroll") for (int k = 0; k < 2; ++k) dst[m][k] = *(const PG8_LAS bf16x8*)(lds + PG8_SA(b, h) + aoff + m * 2048 + k * 1024); } while (0)
#define PG8_LDB(dst, b, h) do { _Pragma("unroll") for (int n = 0; n < 2; ++n) _Pragma("unroll") for (int k = 0; k < 2; ++k) dst[n][k] = *(const PG8_LAS bf16x8*)(lds + PG8_SB(b, h) + boff + n * 2048 + k * 1024); } while (0)
#define PG8_MMA(ai, bj, At, Bt) do { __builtin_amdgcn_s_setprio(1); _Pragma("unroll") for (int m = 0; m < 4; ++m) _Pragma("unroll") for (int n = 0; n < 2; ++n) _Pragma("unroll") for (int k = 0; k < 2; ++k) \
        acc[ai][bj][m][n] = __builtin_amdgcn_mfma_f32_16x16x32_bf16(Bt[n][k], At[m][k], acc[ai][bj][m][n], 0, 0, 0); __builtin_amdgcn_s_setprio(0); } while (0)
#define PG8_WAIT_V(n) asm volatile("s_waitcnt vmcnt(" #n ")" ::: "memory")
#define PG8_WAIT_L(n) asm volatile("s_waitcnt lgkmcnt(" #n ")" ::: "memory")
#define PG8_BAR __builtin_amdgcn_s_barrier()
#define PG8_SCHED __builtin_amdgcn_sched_barrier(0)
    Unit cur, nxt; int ui = 0;
    if (!S.next(0, cur)) return;
    f32x4 acc[2][2][4][2];
#pragma unroll
    for (int a = 0; a < 2; ++a)
#pragma unroll
        for (int b = 0; b < 2; ++b)
#pragma unroll
            for (int m = 0; m < 4; ++m)
#pragma unroll
                for (int n = 0; n < 2; ++n) acc[a][b][m][n] = (f32x4){0.f, 0.f, 0.f, 0.f};
    bf16x8 At[4][2], B0[2][2], B1[2][2];
    const char* cA = (const char*)g.A + (Sched::GATHER ? (size_t)0 : (size_t)cur.pm * tstep); const char* cB = (const char*)g.Bt + cur.bo + (size_t)cur.pn * tstep;
    S.a_ready(cur);
#define PG8_VOFF(dst, un) do { _Pragma("unroll") for (int _h = 0; _h < 2; ++_h) _Pragma("unroll") for (int _i = 0; _i < 2; ++_i) { int R_, C_; stage_rc(tid * 16 + _i * 8192, R_, C_); dst[_h][_i] = S.a_off(un, _h * HALF + R_) + (unsigned)C_ * 2u; } } while (0)
    if constexpr (Sched::GATHER) { PG8_VOFF(vC, cur); }
    if constexpr (SP2) {
        PG8_STAGE(PG8_SB(0, 0), cB + PG8_KO(0), voffB); PG8_STAGE(PG8_SB(0, 1), cB + hstep + PG8_KO(0), voffB); PG8_STAGE_A(PG8_SA(0, 0), cA + PG8_KO(0), 0, false); PG8_STAGE_A(PG8_SA(0, 1), cA + PG8_KO(0), 1, false);
        if (wr == 1) PG8_BAR;
        PG8_WAIT_V(2); PG8_BAR;
        PG8_STAGE(PG8_SB(1, 0), cB + PG8_KO(1), voffB); PG8_STAGE_A(PG8_SA(1, 0), cA + PG8_KO(1), 0, false); PG8_STAGE(PG8_SB(1, 1), cB + hstep + PG8_KO(1), voffB);
        PG8_WAIT_V(6); PG8_BAR;
    } else {
        PG8_STAGE(PG8_SB(0, 0), cB, voffB); PG8_STAGE_A(PG8_SA(0, 0), cA, 0, false); PG8_STAGE(PG8_SB(0, 1), cB + hstep, voffB); PG8_STAGE_A(PG8_SA(0, 1), cA, 1, false);
        if (wr == 1) PG8_BAR;
        PG8_WAIT_V(4); PG8_BAR;
        PG8_STAGE(PG8_SB(1, 0), cB + PG8_KO(1), voffB); PG8_STAGE_A(PG8_SA(1, 0), cA + PG8_KO(1), 0, false); PG8_STAGE(PG8_SB(1, 1), cB + hstep + PG8_KO(1), voffB);
        PG8_WAIT_V(6); PG8_BAR;
    }
    for (;;) {
        const bool has_next = S.next(ui + 1, nxt);
        if constexpr (Sched::GATHER) { if (has_next) { PG8_VOFF(vN, nxt); } else { vN[0][0] = vC[0][0]; vN[0][1] = vC[0][1]; vN[1][0] = vC[1][0]; vN[1][1] = vC[1][1]; } }
        const char* nA = (has_next && !Sched::GATHER) ? (const char*)g.A + (size_t)nxt.pm * tstep : cA; const char* nB = has_next ? (const char*)g.Bt + nxt.bo + (size_t)nxt.pn * tstep : cB;
        for (int t = 0; t < nt; t += 2) {
            const bool last = (t == nt - 2);
            const char* a1 = cA + PG8_KO(t + 1);
            const char* a2 = last ? nA + PG8_KO(0) : cA + PG8_KO(t + 2); const char* b2 = last ? nB + PG8_KO(0) : cB + PG8_KO(t + 2);
            const char* a3 = last ? nA + PG8_KO(1) : cA + PG8_KO(t + 3); const char* b3 = last ? nB + PG8_KO(1) : cB + PG8_KO(t + 3);
            if (last && has_next) S.a_ready(nxt);
            if constexpr (SP2) {
            PG8_LDB(B0, 0, 0); PG8_LDB(B1, 0, 1); PG8_SCHED; PG8_LDA(At, 0, 0); PG8_STAGE_A(PG8_SA(1, 1), a1, 1, false);
            PG8_WAIT_V(8); PG8_WAIT_L(0); PG8_BAR; PG8_MMA(0, 0, At, B0); PG8_MMA(0, 1, At, B1); PG8_BAR; PG8_SCHED;
            PG8_LDA(At, 0, 1); PG8_STAGE(PG8_SB(0, 0), b2, voffB); PG8_STAGE(PG8_SB(0, 1), b2 + hstep, voffB); PG8_STAGE_A(PG8_SA(0, 0), a2, 0, last);
            PG8_WAIT_V(8); PG8_WAIT_L(0); PG8_BAR; PG8_MMA(1, 0, At, B0); PG8_MMA(1, 1, At, B1); PG8_BAR; PG8_SCHED;
            PG8_LDB(B0, 1, 0); PG8_LDB(B1, 1, 1); PG8_SCHED; PG8_LDA(At, 1, 0); PG8_STAGE_A(PG8_SA(0, 1), a2, 1, last);
            PG8_WAIT_V(8); PG8_WAIT_L(0); PG8_BAR; PG8_MMA(0, 0, At, B0); PG8_MMA(0, 1, At, B1); PG8_BAR; PG8_SCHED;
            PG8_LDA(At, 1, 1); PG8_STAGE(PG8_SB(1, 0), b3, voffB); PG8_STAGE(PG8_SB(1, 1), b3 + hstep, voffB); PG8_STAGE_A(PG8_SA(1, 0), a3, 0, last);
            PG8_WAIT_V(8); PG8_WAIT_L(0); PG8_BAR; PG8_MMA(1, 0, At, B0); PG8_MMA(1, 1, At, B1); PG8_BAR; PG8_SCHED;
            } else {
            PG8_LDB(B0, 0, 0); PG8_SCHED; PG8_LDA(At, 0, 0); PG8_STAGE_A(PG8_SA(1, 1), a1, 1, false);
            PG8_WAIT_L(8); PG8_BAR; PG8_WAIT_L(0); PG8_MMA(0, 0, At, B0); PG8_BAR; PG8_SCHED;
            PG8_LDB(B1, 0, 1); PG8_STAGE(PG8_SB(0, 0), b2, voffB);
            PG8_BAR; PG8_WAIT_L(0); PG8_MMA(0, 1, At, B1); PG8_BAR;
            PG8_LDA(At, 0, 1); PG8_STAGE_A(PG8_SA(0, 0), a2, 0, last);
            PG8_BAR; PG8_WAIT_L(0); PG8_MMA(1, 0, At, B0); PG8_BAR; PG8_SCHED;
            PG8_STAGE(PG8_SB(0, 1), b2 + hstep, voffB);
            PG8_WAIT_V(6); PG8_BAR; PG8_MMA(1, 1, At, B1); PG8_BAR;
            PG8_LDB(B0, 1, 0); PG8_SCHED; PG8_LDA(At, 1, 0); PG8_STAGE_A(PG8_SA(0, 1), a2, 1, last);
            PG8_WAIT_L(8); PG8_BAR; PG8_WAIT_L(0); PG8_MMA(0, 0, At, B0); PG8_BAR; PG8_SCHED;
            PG8_LDB(B1, 1, 1); PG8_STAGE(PG8_SB(1, 0), b3, voffB);
            PG8_BAR; PG8_WAIT_L(0); PG8_MMA(0, 1, At, B1); PG8_BAR;
            PG8_LDA(At, 1, 1); PG8_STAGE_A(PG8_SA(1, 0), a3, 0, last);
            PG8_BAR; PG8_WAIT_L(0); PG8_MMA(1, 0, At, B0); PG8_BAR; PG8_SCHED;
            PG8_STAGE(PG8_SB(1, 1), b3 + hstep, voffB);
            PG8_WAIT_V(6); PG8_BAR; PG8_MMA(1, 1, At, B1); PG8_BAR;
            }
        }
        if constexpr (ALIGN_EPI) { if (wr == 0) PG8_BAR; }
        if constexpr (!Epi::AFTER_DRAIN) { E(acc, cur, wr, wc, fr, fq); S.done(cur); }
        if (!has_next) break;
#pragma unroll
        for (int a = 0; a < 2; ++a)
#pragma unroll
            for (int b = 0; b < 2; ++b)
#pragma unroll
                for (int m = 0; m < 4; ++m)
#pragma unroll
                    for (int n = 0; n < 2; ++n) acc[a][b][m][n] = (f32x4){0.f, 0.f, 0.f, 0.f};
        cur = nxt; cA = nA; cB = nB; ++ui;
        if constexpr (Sched::GATHER) { vC[0][0] = vN[0][0]; vC[0][1] = vN[0][1]; vC[1][0] = vN[1][0]; vC[1][1] = vN[1][1]; }
        if constexpr (ALIGN_EPI) { if (wr == 1) PG8_BAR; }
    }
    PG8_WAIT_V(0);
    if constexpr (!ALIGN_EPI) { if (wr == 0) PG8_BAR; }
    PG8_BAR;
    if constexpr (Epi::AFTER_DRAIN) { E.fused(acc, cur, wr, wc, fr, fq, lds, wid, lane); S.done(cur); }
#undef PG8_VOFF
#undef PG8_KO
#undef PG8_SA
#undef PG8_SB
#undef PG8_STAGE
#undef PG8_STAGE_A
#undef PG8_LDA
#undef PG8_LDB
#undef PG8_MMA
#undef PG8_WAIT_V
#undef PG8_WAIT_L
#undef PG8_BAR
#undef PG8_SCHED
}
}

namespace pg8 {
template <bool GATHER_>
struct GroupedOrder {
    static constexpr bool GATHER = GATHER_;
    const PG8_LAS int* tmap; const PG8_LAS int* cntl; const int* list; int nU, nN, G, c, lcap, rowbytes; size_t estride;
    __device__ __forceinline__ bool next(int i, Unit& u) const { const long L = (long)i * G + c; if (L >= nU) return false; const int t = (int)L / nN; const int m = __builtin_amdgcn_readfirstlane(tmap[t]);
        u.pm = t; u.pn = (int)L % nN; u.bo = (size_t)(m & 255) * estride; u.aux = m; return true; }
    __device__ __forceinline__ unsigned a_off(const Unit& u, int R) const { const int e = u.aux & 255, p0 = u.aux >> 8, ce = cntl[e]; int p = p0 + R; p = p < ce ? p : ce - 1; return (unsigned)list[(size_t)e * lcap + p] * (unsigned)rowbytes; }
    __device__ __forceinline__ void a_ready(const Unit&) const {}
    __device__ __forceinline__ void done(const Unit&) const {}
};
__device__ __forceinline__ u32x4 pack8(const f32x4 a, const f32x4 b) { u32x4 w; w.x = cvt_pk_bf16(a[0], a[1]); w.y = cvt_pk_bf16(a[2], a[3]); w.z = cvt_pk_bf16(b[0], b[1]); w.w = cvt_pk_bf16(b[2], b[3]); return w; }
struct EpiStore {
    static constexpr bool PERM = true, AFTER_DRAIN = false; bf16_t* O; int ldc;
    __device__ __forceinline__ void operator()(const f32x4 (&acc)[2][2][4][2], const Unit& u, int wr, int wc, int fr, int fq) const {
        const int row0 = u.pm * BM + wr * 64 + fr, col0 = u.pn * BM + wc * 32 + 8 * fq;
#pragma unroll
        for (int ai = 0; ai < 2; ++ai)
#pragma unroll
            for (int m = 0; m < 4; ++m) { bf16_t* rowp = O + (size_t)(row0 + ai * HALF + m * 16) * ldc + col0;
#pragma unroll
                for (int bj = 0; bj < 2; ++bj) *(u32x4*)(rowp + bj * HALF) = pack8(acc[ai][bj][m][0], acc[ai][bj][m][1]); }
    }
};
__device__ __forceinline__ f32x4 silu4(const f32x4 v) { f32x4 r;
#pragma unroll
    for (int i = 0; i < 4; ++i) r[i] = v[i] * __builtin_amdgcn_rcpf(1.f + __expf(-v[i])); return r; }
__device__ __forceinline__ f32x4 sigm4(const f32x4 v) { f32x4 r;
#pragma unroll
    for (int i = 0; i < 4; ++i) r[i] = __builtin_amdgcn_rcpf(1.f + __expf(-v[i])); return r; }
struct EpiSwiglu {
    static constexpr bool PERM = true, AFTER_DRAIN = false; bf16_t* G;
    __device__ __forceinline__ void operator()(const f32x4 (&acc)[2][2][4][2], const Unit& u, int wr, int wc, int fr, int fq) const {
        const int row0 = u.pm * BM + wr * 64 + fr, col0 = u.pn * HALF + wc * 32 + 8 * fq;
#pragma unroll
        for (int ai = 0; ai < 2; ++ai)
#pragma unroll
            for (int m = 0; m < 4; ++m) *(u32x4*)(G + (size_t)(row0 + ai * HALF + m * 16) * 512 + col0) = pack8(silu4(acc[ai][0][m][0]) * acc[ai][1][m][0], silu4(acc[ai][0][m][1]) * acc[ai][1][m][1]);
    }
};
__device__ __forceinline__ void unpack8f(const u32x4 w, f32x4& a, f32x4& b) {
    a[0] = __uint_as_float(w.x << 16); a[1] = __uint_as_float(w.x & 0xffff0000u); a[2] = __uint_as_float(w.y << 16); a[3] = __uint_as_float(w.y & 0xffff0000u);
    b[0] = __uint_as_float(w.z << 16); b[1] = __uint_as_float(w.z & 0xffff0000u); b[2] = __uint_as_float(w.w << 16); b[3] = __uint_as_float(w.w & 0xffff0000u); }
struct EpiGlu {
    static constexpr bool PERM = true, AFTER_DRAIN = false; const bf16_t* GS; const float* b; bf16_t* GG;
    __device__ __forceinline__ void operator()(const f32x4 (&acc)[2][2][4][2], const Unit& u, int wr, int wc, int fr, int fq) const {
        const int row0 = u.pm * BM + wr * 64 + fr, col0 = u.pn * BM + wc * 32 + 8 * fq;
#pragma unroll
        for (int bj = 0; bj < 2; ++bj) { const int c = col0 + bj * HALF; const f32x4 b0 = *(const f32x4*)(b + c), b1 = *(const f32x4*)(b + c + 4);
#pragma unroll
            for (int ai = 0; ai < 2; ++ai)
#pragma unroll
                for (int m = 0; m < 4; ++m) { const size_t o = (size_t)(row0 + ai * HALF + m * 16) * 512 + c; f32x4 g0, g1; unpack8f(*(const u32x4*)(GS + o), g0, g1);
                    *(u32x4*)(GG + o) = pack8(g0 * sigm4(acc[ai][bj][m][0] + b0), g1 * sigm4(acc[ai][bj][m][1] + b1)); } }
    }
};
struct EpiResid {
    static constexpr bool PERM = true, AFTER_DRAIN = false;
    const float* x; const float* ctx; const float* mod; bf16_t* XC; int inplace;
    __device__ __forceinline__ void operator()(const f32x4 (&acc)[2][2][4][2], const Unit& u, int wr, int wc, int fr, int fq) const {
        const int R0 = u.pm * BM; const int ci = R0 < 32768 ? (R0 >> 11) : 16;
        const float* base = R0 < 32768 ? x + (size_t)R0 * 1024 : ctx + (size_t)(R0 - 32768) * 1024;
        bf16_t* out = XC + (size_t)R0 * 1024; const float* gate = mod + ((size_t)ci * 6 + 2) * 1024;
        const int rl0 = wr * 64 + fr, col0 = u.pn * BM + wc * 32 + 8 * fq;
#pragma unroll
        for (int bj = 0; bj < 2; ++bj) { const int c = col0 + bj * HALF; const f32x4 g0 = *(const f32x4*)(gate + c), g1 = *(const f32x4*)(gate + c + 4);
#pragma unroll
            for (int ai = 0; ai < 2; ++ai)
#pragma unroll
                for (int m = 0; m < 4; ++m) { const size_t o = (size_t)(rl0 + ai * HALF + m * 16) * 1024 + c; f32x4 b0, b1;
                    if (inplace) unpack8f(*(const u32x4*)(out + o), b0, b1); else { b0 = *(const f32x4*)(base + o); b1 = *(const f32x4*)(base + o + 4); }
                    *(u32x4*)(out + o) = pack8(b0 + g0 * acc[ai][bj][m][0], b1 + g1 * acc[ai][bj][m][1]); } }
    }
};
}

#include <hip/hip_bf16.h>
#include <cmath>
namespace attn_body {
using bf16=__hip_bfloat16;
using bf16x8=__attribute__((ext_vector_type(8)))short;
using s16x4=__attribute__((ext_vector_type(4)))short;
using f32x16=__attribute__((ext_vector_type(16)))float;
using u32x4=__attribute__((ext_vector_type(4)))unsigned;
constexpr int D=64,QP=512,KP=128,OP=1024;
constexpr int NW=8,QBLK=32,QB=QBLK*NW,KVBLK=64;
constexpr int ATTN_UNIT_ROWS=QB;
__device__ __forceinline__ int crow(int r,int hi){return (r&3)+8*(r>>2)+4*hi;}
#define SBAR() __builtin_amdgcn_sched_barrier(0)
__device__ __forceinline__ void cmask(f32x16&p0,f32x16&p1,int jb,int qrel,int hi){
  const float NEG=-INFINITY; int kb=64*jb+4*hi;
  #pragma unroll
  for(int r=0;r<16;++r){int kv=kb+(r&3)+8*(r>>2); if(kv>qrel)p0[r]=NEG; if(kv+32>qrel)p1[r]=NEG;}
}

constexpr int NSLOT=3, SLOTB=8192;
constexpr int LDS_K=0, LDS_V=NSLOT*SLOTB, LDS_WS=2*NSLOT*SLOTB, LDS_OST=LDS_WS+NW*64*4, LDS_BYTES=LDS_OST+NW*4096;
constexpr float C2=0.125f*1.4426950408889634f;
__device__ __forceinline__ void glds16(const void*gsrc,unsigned lds_dst){unsigned keep;
  asm volatile("s_mov_b32 %0, m0\n\ts_mov_b32 m0, %2\n\ts_nop 0\n\tglobal_load_lds_dwordx4 %1, off\n\ts_mov_b32 m0, %0":"=&s"(keep):"v"(gsrc),"s"(lds_dst):"memory");}
__device__ __forceinline__ float max3f(float a,float b,float c){float r;asm("v_max3_f32 %0, %1, %2, %3":"=v"(r):"v"(a),"v"(b),"v"(c));return r;}
__device__ __forceinline__ float max2f(float a,float b){float r;asm("v_max_f32_e32 %0, %1, %2":"=v"(r):"v"(a),"v"(b));return r;}
__device__ __forceinline__ float fadd_s(float a,float b){float r;asm("v_add_f32_e32 %0, %1, %2":"=v"(r):"v"(a),"v"(b));return r;}
__device__ __forceinline__ float fsub_s(float a,float b){float r;asm("v_sub_f32_e32 %0, %1, %2":"=v"(r):"v"(a),"v"(b));return r;}
typedef float f32x2_t __attribute__((ext_vector_type(2))); typedef __bf16 bf16x2_t __attribute__((ext_vector_type(2)));
__device__ __forceinline__ unsigned cvtpk_s(float lo,float hi){f32x2_t v={lo,hi};bf16x2_t b=__builtin_convertvector(v,bf16x2_t);return __builtin_bit_cast(unsigned,b);}
#define WAIT_BAR(N) asm volatile("s_waitcnt vmcnt(" #N ") lgkmcnt(0)\n\ts_barrier":::"memory")

__device__ __forceinline__ void qkt(f32x16&p0,f32x16&p1,const char*Kslot,const bf16x8*qr,const f32x16&negm,int r32,int hi){
  const char*kb=Kslot+hi*1024+r32*16;
  #pragma unroll
  for(int d0=0;d0<4;++d0){
    const bf16x8 b0=*reinterpret_cast<const bf16x8*>(kb+d0*2048);
    const bf16x8 b1=*reinterpret_cast<const bf16x8*>(kb+d0*2048+512);
    if(d0==0){p0=__builtin_amdgcn_mfma_f32_32x32x16_bf16(b0,qr[0],negm,0,0,0);p1=__builtin_amdgcn_mfma_f32_32x32x16_bf16(b1,qr[0],negm,0,0,0);}
    else{p0=__builtin_amdgcn_mfma_f32_32x32x16_bf16(b0,qr[d0],p0,0,0,0);p1=__builtin_amdgcn_mfma_f32_32x32x16_bf16(b1,qr[d0],p1,0,0,0);}}
}
typedef __attribute__((address_space(3))) const char* lds_cptr;
typedef short v4i16_t __attribute__((ext_vector_type(4)));
__device__ __forceinline__ void kload8(bf16x8*kf,lds_cptr kp){
  kf[0]=*(const __attribute__((address_space(3))) bf16x8*)(kp);      kf[1]=*(const __attribute__((address_space(3))) bf16x8*)(kp+512);
  kf[2]=*(const __attribute__((address_space(3))) bf16x8*)(kp+2048); kf[3]=*(const __attribute__((address_space(3))) bf16x8*)(kp+2560);
  kf[4]=*(const __attribute__((address_space(3))) bf16x8*)(kp+4096); kf[5]=*(const __attribute__((address_space(3))) bf16x8*)(kp+4608);
  kf[6]=*(const __attribute__((address_space(3))) bf16x8*)(kp+6144); kf[7]=*(const __attribute__((address_space(3))) bf16x8*)(kp+6656);
}
__device__ __forceinline__ void kload2(bf16x8*kf,lds_cptr kp,int j){ kf[2*j]=*(const __attribute__((address_space(3))) bf16x8*)(kp+j*2048); kf[2*j+1]=*(const __attribute__((address_space(3))) bf16x8*)(kp+j*2048+512); }
__device__ __forceinline__ s16x4 vtr(lds_cptr p){ return __builtin_bit_cast(s16x4,__builtin_amdgcn_ds_read_tr16_b64_v4i16((__attribute__((address_space(3))) v4i16_t*)p)); }
__device__ __forceinline__ float rowmax(const f32x16&p0,const f32x16&p1){
  float a=max3f(p0[0],p0[1],p1[0]),b=max3f(p0[2],p0[3],p1[1]);a=max3f(a,p1[2],p1[3]);
  #pragma unroll
  for(int r=4;r<16;r+=4){a=max3f(a,p0[r],p0[r+1]);b=max3f(b,p0[r+2],p0[r+3]);a=max3f(a,p1[r],p1[r+1]);b=max3f(b,p1[r+2],p1[r+3]);}
  const float m=max2f(a,b);
  auto rr=__builtin_amdgcn_permlane32_swap(__float_as_uint(m),__float_as_uint(m),false,false);
  return max2f(__uint_as_float(rr[0]),__uint_as_float(rr[1]));
}
__device__ __forceinline__ void pv(f32x16*o,int vb,bf16x8 pa0,bf16x8 pa1,bf16x8 pa2,bf16x8 pa3){
  #pragma unroll
  for(int d0=0;d0<2;++d0){s16x4 lo[4],hi[4];
    #pragma unroll
    for(int ks=0;ks<4;++ks){
      asm volatile("ds_read_b64_tr_b16 %0,%1 offset:%c2":"=&v"(lo[ks]):"v"(vb),"i"(d0*4096+ks*1024):"memory");
      asm volatile("ds_read_b64_tr_b16 %0,%1 offset:%c2":"=&v"(hi[ks]):"v"(vb),"i"(d0*4096+ks*1024+512):"memory");}
    asm volatile("s_waitcnt lgkmcnt(0)":::"memory");SBAR();
    #define PK(k) (bf16x8){lo[k][0],lo[k][1],lo[k][2],lo[k][3],hi[k][0],hi[k][1],hi[k][2],hi[k][3]}
    o[d0]=__builtin_amdgcn_mfma_f32_32x32x16_bf16(pa0,PK(0),o[d0],0,0,0);
    o[d0]=__builtin_amdgcn_mfma_f32_32x32x16_bf16(pa1,PK(1),o[d0],0,0,0);
    o[d0]=__builtin_amdgcn_mfma_f32_32x32x16_bf16(pa2,PK(2),o[d0],0,0,0);
    o[d0]=__builtin_amdgcn_mfma_f32_32x32x16_bf16(pa3,PK(3),o[d0],0,0,0);
    #undef PK
  }
}

#ifndef ATTN_STORE16
#define ATTN_STORE16(p,v) (*(u32x4*)(p)=(v))
#endif
template<int THRL> __device__ __forceinline__ void attn_unit(const bf16*Q0,const bf16*__restrict__ Kh,const bf16*__restrict__ Vh,bf16*O0,const int NT,char*shm){
  const int tid=threadIdx.x,lane=tid&63,r32=lane&31,hi=lane>>5; const int wid=__builtin_amdgcn_readfirstlane(tid>>6);
  const bf16*Qw=Q0+(long)(wid*QBLK)*QP;
  const unsigned lds0=(unsigned)(uintptr_t)shm;
  float*wsf=(float*)(shm+LDS_WS)+wid*64;
  const bf16*ksrc=Kh+(long)lane*KP+wid*8;
  const bf16*vsrc=Vh+(long)(16*(wid&3)+(lane>>2))*KP+(wid>>2)*32+(lane&3)*8;
  const unsigned kdst=lds0+LDS_K+wid*1024, vdst=lds0+LDS_V+wid*1024;
  #define DMA_K(t,slot) glds16(ksrc+(long)(t)*KVBLK*KP,(unsigned)__builtin_amdgcn_readfirstlane(kdst+(slot)))
  #define DMA_V(t,slot) glds16(vsrc+(long)(t)*KVBLK*KP,(unsigned)__builtin_amdgcn_readfirstlane(vdst+(slot)))
  const int vb0=(int)(lds0+LDS_V)+((lane>>4)&1)*32+(lane&3)*8+(4*hi+((lane&15)>>2))*64;
  const char*Kbase=shm+LDS_K; bf16x8 kf[8];
  const lds_cptr shm3=(lds_cptr)shm; const lds_cptr kp0=shm3+LDS_K+hi*1024+r32*16; const lds_cptr vp0=shm3+LDS_V+((lane>>4)&1)*32+(lane&3)*8+(4*hi+((lane&15)>>2))*64;
  DMA_K(0,0);DMA_V(0,0);DMA_K(1,SLOTB);
  bf16x8 qr[4];
  #pragma unroll
  for(int d0=0;d0<4;++d0)qr[d0]=*reinterpret_cast<const bf16x8*>(&Qw[(long)r32*QP+d0*16+hi*8]);
  float mhat=0.f,l_reg=0.f;f32x16 o[2];o[0]=f32x16{};o[1]=f32x16{};f32x16 negm=f32x16{};asm volatile("":"+v"(negm));
  #define CMASK(P0,P1,t) do{}while(0)
  bool resc=false;
  #define START(P0,P1) do{ const float rm=rowmax(P0,P1); resc=false; \
    { const float dl=rm; mhat=fadd_s(mhat,dl); \
      _Pragma("unroll") for(int r=0;r<16;++r){P0[r]=fsub_s(P0[r],dl);P1[r]=fsub_s(P1[r],dl);} \
      _Pragma("unroll") for(int r=0;r<16;++r)negm[r]=-mhat; asm volatile("":"+v"(negm)); } \
    _Pragma("unroll") for(int r=0;r<16;++r)P0[r]=__builtin_amdgcn_exp2f(P0[r]); }while(0)
  #define RESC() do{ if(resc){ asm volatile("s_waitcnt lgkmcnt(0)":::"memory"); \
      _Pragma("unroll") for(int d_=0;d_<2;++d_) _Pragma("unroll") for(int r=0;r<16;++r)o[d_][r]*=wsf[crow(r,hi)]; } }while(0)
  f32x16 pA0,pA1,pB0,pB1;
  int sl_prev=0,sl_cur=0,sl_next=SLOTB;
  #define ROT() do{sl_prev=sl_cur;sl_cur=sl_next;sl_next=(sl_next==(NSLOT-1)*SLOTB)?0:sl_next+SLOTB;}while(0)
  DMA_K(2,2*SLOTB);
  WAIT_BAR(3);
  qkt(pA0,pA1,Kbase,qr,negm,r32,hi);asm volatile("s_nop 15\n\ts_nop 7":"+v"(pA0),"+v"(pA1));CMASK(pA0,pA1,0);
  START(pA0,pA1);
  _Pragma("unroll") for(int r=0;r<16;++r)pA1[r]=__builtin_amdgcn_exp2f(pA1[r]);
  WAIT_BAR(0);
  DMA_K(3,0);DMA_V(1,SLOTB);
  ROT();
  kload8(kf,kp0+sl_cur);
  WAIT_BAR(2);
  s16x4 vlo[8],vhi[8]; u32x4 pw0,pw1,pw2,pw3;
  #define PKW(P,B) cvtpk_s(P[B],P[B+1])
  #define PAF(k) __builtin_bit_cast(bf16x8,pw##k)
  #define VFR(i) (bf16x8){vlo[i][0],vlo[i][1],vlo[i][2],vlo[i][3],vhi[i][0],vhi[i][1],vhi[i][2],vhi[i][3]}
  #define PIN(x) asm volatile("":"+v"(x))
  #define MX3(a,b,c) __builtin_fmaxf(__builtin_fmaxf((a),(b)),(c))
  #define GAPA(MF,A0,A1,A2,A3,W0,W1,PW) do{ MF; sacc+=A0; sacc+=A1; sacc+=A2; sacc+=A3; PIN(sacc); W0; W1; PIN(PW); SBAR(); }while(0)
  #define EX(v) __builtin_amdgcn_exp2f(v)
  #define GAPB(MF,X,B) do{ MF; X[B]=EX(X[B]); X[B+1]=EX(X[B+1]); X[B+2]=EX(X[B+2]); X[B+3]=EX(X[B+3]); PIN(X); SBAR(); }while(0)
  #define VRD(i) do{ vlo[i]=vtr(vp_+(((i)>>2)*4096+((i)&3)*1024)); vhi[i]=vtr(vp_+(((i)>>2)*4096+((i)&3)*1024+512)); }while(0)
  #define KRD(G,j) do{ if(G){ kload2(kf,kp0+sl_next,j); SBAR(); } }while(0)
  #define STEP(C0,C1,P0,P1,t,GK,GV,GL) do{ SBAR(); \
    const lds_cptr vp_=vp0+sl_prev; \
    VRD(0); SBAR(); float sacc=(P0[0]+P0[1]); \
    GAPA(C0=__builtin_amdgcn_mfma_f32_32x32x16_bf16(kf[0],qr[0],negm,0,0,0), P0[2],P0[3],P0[4],P0[5],     pw0[0]=PKW(P0,0), pw0[1]=PKW(P0,2), pw0); \
    VRD(4); SBAR(); GAPA(C1=__builtin_amdgcn_mfma_f32_32x32x16_bf16(kf[1],qr[0],negm,0,0,0), P0[6],P0[7],P0[8],P0[9],     pw0[2]=PKW(P0,4), pw0[3]=PKW(P0,6), pw0); \
    VRD(1); SBAR(); GAPA(C0=__builtin_amdgcn_mfma_f32_32x32x16_bf16(kf[2],qr[1],C0,0,0,0),   P0[10],P0[11],P0[12],P0[13], pw1[0]=PKW(P0,8), pw1[1]=PKW(P0,10), pw1); \
    VRD(5); SBAR(); GAPA(C1=__builtin_amdgcn_mfma_f32_32x32x16_bf16(kf[3],qr[1],C1,0,0,0),   P0[14],P0[15],P1[0],P1[1],   pw1[2]=PKW(P0,12),pw1[3]=PKW(P0,14), pw1); \
    VRD(2); SBAR(); GAPA(C0=__builtin_amdgcn_mfma_f32_32x32x16_bf16(kf[4],qr[2],C0,0,0,0),   P1[2],P1[3],P1[4],P1[5],     pw2[0]=PKW(P1,0), pw2[1]=PKW(P1,2), pw2); \
    VRD(6); SBAR(); GAPA(C1=__builtin_amdgcn_mfma_f32_32x32x16_bf16(kf[5],qr[2],C1,0,0,0),   P1[6],P1[7],P1[8],P1[9],     pw2[2]=PKW(P1,4), pw2[3]=PKW(P1,6), pw2); \
    VRD(3); SBAR(); GAPA(C0=__builtin_amdgcn_mfma_f32_32x32x16_bf16(kf[6],qr[3],C0,0,0,0),   P1[10],P1[11],P1[12],P1[13], pw3[0]=PKW(P1,8), pw3[1]=PKW(P1,10), pw3); \
    VRD(7); SBAR(); GAPA(C1=__builtin_amdgcn_mfma_f32_32x32x16_bf16(kf[7],qr[3],C1,0,0,0),   P1[14],P1[15],0.f,0.f,       pw3[2]=PKW(P1,12),pw3[3]=PKW(P1,14), pw3); \
    l_reg+=sacc; \
    if(GK){DMA_K((t)+3,sl_cur);} if(GV){DMA_V((t)+1,sl_next);} \
    CMASK(C0,C1,t); \
    { float a=MX3(C0[0],C0[1],C1[0]),b=MX3(C0[2],C0[3],C1[1]); a=MX3(a,C1[2],C1[3]); \
      _Pragma("unroll") for(int r=4;r<16;r+=4){a=MX3(a,C0[r],C0[r+1]);b=MX3(b,C0[r+2],C0[r+3]);a=MX3(a,C1[r],C1[r+1]);b=MX3(b,C1[r+2],C1[r+3]);} \
      float rm=__builtin_fmaxf(a,b); { auto rr=__builtin_amdgcn_permlane32_swap(__float_as_uint(rm),__float_as_uint(rm),false,false); rm=__builtin_fmaxf(__uint_as_float(rr[0]),__uint_as_float(rr[1])); } \
      resc=false; \
      if(__builtin_expect(__any(rm>(float)THRL),0)){ const float dl=__builtin_fmaxf(rm,0.f); mhat+=dl; \
        _Pragma("unroll") for(int r=0;r<16;++r){C0[r]-=dl;C1[r]-=dl;} \
        _Pragma("unroll") for(int r=0;r<16;++r)negm[r]=-mhat; asm volatile("":"+v"(negm)); \
        const float f=__builtin_amdgcn_exp2f(-dl); l_reg*=f; if(hi==0)wsf[r32]=f; resc=true; } } \
    SBAR(); \
    GAPB(o[0]=__builtin_amdgcn_mfma_f32_32x32x16_bf16(PAF(0),VFR(0),o[0],0,0,0), C0,0); \
    GAPB(o[1]=__builtin_amdgcn_mfma_f32_32x32x16_bf16(PAF(0),VFR(4),o[1],0,0,0), C0,4); \
    KRD(GL,0); GAPB(o[0]=__builtin_amdgcn_mfma_f32_32x32x16_bf16(PAF(1),VFR(1),o[0],0,0,0), C0,8); \
    KRD(GL,1); GAPB(o[1]=__builtin_amdgcn_mfma_f32_32x32x16_bf16(PAF(1),VFR(5),o[1],0,0,0), C0,12); \
    KRD(GL,2); GAPB(o[0]=__builtin_amdgcn_mfma_f32_32x32x16_bf16(PAF(2),VFR(2),o[0],0,0,0), C1,0); \
    KRD(GL,3); GAPB(o[1]=__builtin_amdgcn_mfma_f32_32x32x16_bf16(PAF(2),VFR(6),o[1],0,0,0), C1,4); \
    GAPB(o[0]=__builtin_amdgcn_mfma_f32_32x32x16_bf16(PAF(3),VFR(3),o[0],0,0,0), C1,8); \
    GAPB(o[1]=__builtin_amdgcn_mfma_f32_32x32x16_bf16(PAF(3),VFR(7),o[1],0,0,0), C1,12); \
    }while(0)
  int t=1;
  #undef CMASK
  #define CMASK(P0,P1,t) do{}while(0)
  for(;t+5<NT;t+=2){
    STEP(pB0,pB1,pA0,pA1,t,true,true,true);     WAIT_BAR(2); RESC(); ROT();
    STEP(pA0,pA1,pB0,pB1,t+1,true,true,true);   WAIT_BAR(2); RESC(); ROT();
  }
  #undef CMASK
  #define CMASK(P0,P1,t) do{}while(0)
  #define ENDW(tt) do{ if((tt)+3<NT){WAIT_BAR(2);} else if((tt)+2<NT){WAIT_BAR(1);} else {WAIT_BAR(0);} }while(0)
  for(;t+1<NT;t+=2){
    STEP(pB0,pB1,pA0,pA1,t,(t+3<NT),(t+1<NT),(t+1<NT));       ENDW(t);   RESC(); ROT();
    STEP(pA0,pA1,pB0,pB1,t+1,(t+4<NT),(t+2<NT),(t+2<NT));     ENDW(t+1); RESC(); ROT();
  }
  STEP(pB0,pB1,pA0,pA1,NT-1,false,false,false); RESC();
  { float sacc=pB0[0]+pB0[1]; _Pragma("unroll") for(int r=2;r<16;++r)sacc+=pB0[r]; _Pragma("unroll") for(int r=0;r<16;++r)sacc+=pB1[r]; l_reg+=sacc;
    pw0=(u32x4){PKW(pB0,0),PKW(pB0,2),PKW(pB0,4),PKW(pB0,6)};pw1=(u32x4){PKW(pB0,8),PKW(pB0,10),PKW(pB0,12),PKW(pB0,14)};pw2=(u32x4){PKW(pB1,0),PKW(pB1,2),PKW(pB1,4),PKW(pB1,6)};pw3=(u32x4){PKW(pB1,8),PKW(pB1,10),PKW(pB1,12),PKW(pB1,14)};
    SBAR(); pv(o,vb0+sl_cur,PAF(0),PAF(1),PAF(2),PAF(3)); }
  #undef PKW
  #undef PAF
  #undef VFR
  #undef PIN
  #undef MX3
  #undef GAPA
  #undef GAPB
  #undef EX
  #undef VRD
  #undef KRD
  #undef STEP
  #undef ENDW
  {auto rr=__builtin_amdgcn_permlane32_swap(__float_as_uint(l_reg),__float_as_uint(l_reg),false,false);l_reg=__uint_as_float(rr[0])+__uint_as_float(rr[1]);}
  if(hi==0)wsf[32+r32]=l_reg;asm volatile("s_waitcnt lgkmcnt(0)":::"memory");
  float rli[16];
  #pragma unroll
  for(int r=0;r<16;++r)rli[r]=__builtin_amdgcn_rcpf(wsf[32+crow(r,hi)]);
  bf16*Ow=O0+(long)(wid*QBLK)*OP;
  { bf16*stg=(bf16*)(shm+LDS_OST)+wid*2048;
    #pragma unroll
    for(int r=0;r<16;++r){const int orow=crow(r,hi);
      #pragma unroll
      for(int d0=0;d0<2;++d0)stg[orow*64+d0*32+r32]=__float2bfloat16(o[d0][r]*rli[r]);}
    asm volatile("s_waitcnt lgkmcnt(0)":::"memory");
    #pragma unroll
    for(int i=0;i<4;++i){const int row=i*8+(lane>>3),ch=lane&7; const u32x4 v=*(const u32x4*)(stg+row*64+ch*8); ATTN_STORE16(Ow+(long)row*OP+ch*8,v);} }
  asm volatile("s_waitcnt lgkmcnt(0)\n\ts_barrier":::"memory");
  #undef DMA_K
  #undef DMA_V
  #undef CMASK
  #undef START
  #undef RESC
  #undef ROT
}
constexpr int ATTN_LDS_BYTES=LDS_BYTES;
#undef SBAR
#undef WAIT_BAR
}

struct Params {
    const float* in[35];
    float* out;
    unsigned char* ws;
    int ph_lo, ph_hi;
};
enum { I_X = 0, I_C, I_CTX, I_CCTX, I_WMOD, I_BMOD, I_GMIX, I_GFFN, I_MIXWIN, I_MIXWOUT, I_QG, I_KG, I_LNG, I_WSP, I_BSP,
       I_S5WIN, I_ARE, I_AIM, I_LOGDT, I_BRE, I_BIM, I_CRE, I_CIM, I_S5D, I_WGLU, I_BGLU, I_S5WOUT,
       I_WGRP, I_BGRP, I_WRT, I_BRT, I_W1, I_W3, I_W2, I_FING };

struct Ctx {
    const Params* p;
    unsigned char* ws;
    LAS unsigned char* lds;
    int tid, lane, wave, gw, ngw;
};
__device__ __forceinline__ const float* xin_row(const Params& P, int r) { return r < TL ? P.in[I_X] + (size_t)r * D : P.in[I_CTX] + (size_t)(r - TL) * D; }
__device__ __forceinline__ int cond_of(int r) { return r < TL ? (r >> 11) : 16; }
__device__ __forceinline__ const float* mod_vec(const Ctx& C, int layer, int ci, int k) { return (const float*)(C.ws + WS_MOD) + ((size_t)(layer * 17 + ci) * 6 + k) * D; }

__device__ __forceinline__ void dsincos(double a, double& s, double& c) {
    const double TWO_PI_HI = 6.283185307179586, TWO_PI_LO = 2.4492935982947064e-16;
    const double k = rint(a * 0.15915494309189535);
    double r = fma(-k, TWO_PI_HI, a); r = fma(-k, TWO_PI_LO, r);
    const double r2 = r * r; double ct = 1.0, st = r, cs = 1.0, ss = r;
#pragma unroll 1
    for (int i = 1; i <= 15; ++i) { ct *= -r2 / (double)((2 * i - 1) * (2 * i)); cs += ct; st *= -r2 / (double)((2 * i) * (2 * i + 1)); ss += st; }
    s = ss; c = cs;
}

struct TItem { const float* src; int N, k0, n0; bf16* dst; int dp; };
__device__ __forceinline__ void t_load(const TItem& t, int lane, float (&r)[32]) {
#pragma unroll
    for (int i = 0; i < 32; ++i) r[i] = t.src[(size_t)(t.k0 + 2 * i + (lane >> 5)) * t.N + t.n0 + (lane & 31)];
}
__device__ __forceinline__ void t_store(const TItem& t, int lane, const float (&r)[32], LAS float* scr) {
#pragma unroll
    for (int i = 0; i < 32; ++i) scr[(2 * i + (lane >> 5)) * 33 + (lane & 31)] = r[i];
    asm volatile("s_waitcnt lgkmcnt(0)" ::: "memory");
    const int c = lane & 7;
#pragma unroll
    for (int j = 0; j < 4; ++j) { const int n = (lane >> 3) + 8 * j; const LAS float* s = scr + (8 * c) * 33 + n;
        v4u o; o.x = pk2(s[0 * 33], s[1 * 33]); o.y = pk2(s[2 * 33], s[3 * 33]); o.z = pk2(s[4 * 33], s[5 * 33]); o.w = pk2(s[6 * 33], s[7 * 33]);
        *(v4u*)(t.dst + (size_t)n * t.dp + 8 * c) = o; }
    asm volatile("s_waitcnt lgkmcnt(0)" ::: "memory");
}
__device__ __forceinline__ TItem mat_item(const float* W, int K, int N, bf16* WT, int it) {
    const int nblk = N / 32, kb = it / nblk, nb = it % nblk;
    return TItem{W, N, kb * 64, nb * 32, WT + (size_t)(nb * 32) * K + kb * 64, K};
}
constexpr int MOE_ITEMS = NEXP * 768;
__device__ __forceinline__ TItem moe_item(const Ctx& C, int layer, int it) {
    const Params& P = *C.p;
    const int e = it / 768, r = it % 768, kind = r / 256, j = r % 256;
    if (kind < 2) {
        const float* src = (kind == 0 ? P.in[I_W1] : P.in[I_W3]) + ((size_t)layer * NEXP + e) * D * EH;
        const int kb = j / 16, nb = j % 16, k0 = kb * 64, n0 = nb * 32;
        const int drow = (n0 / 128) * 256 + (n0 % 128) + (kind == 1 ? 128 : 0);
        return TItem{src, EH, k0, n0, (bf16*)(C.ws + WS_W13) + (size_t)e * 1024 * 1024 + (size_t)drow * 1024 + k0, 1024};
    }
    const float* src = P.in[I_W2] + ((size_t)layer * NEXP + e) * EH * D;
    const int kb = j / 32, nb = j % 32, k0 = kb * 64, n0 = nb * 32;
    return TItem{src, D, k0, n0, (bf16*)(C.ws + WS_W2) + (size_t)e * 1024 * 512 + (size_t)n0 * 512 + k0, 512};
}
constexpr int TI0 = 16 * 56, TI1 = 16 * 32, TI2 = 16 * 16, TI3 = 8 * 16, TI4 = 8 * 32, NSMALL = TI0 + TI1 + TI2 + TI3 + TI4;
__device__ __forceinline__ TItem conv_item(const Ctx& C, int layer, int nsmall, int it) {
    const Params& P = *C.p; int r = it;
    if (r < nsmall) {
        if (r < TI0) return mat_item(P.in[I_MIXWIN], D, MIXW, (bf16*)(C.ws + WS_WIN0), r); r -= TI0;
        if (r < TI1) return mat_item(P.in[I_MIXWOUT], D, D, (bf16*)(C.ws + WS_WOUT0), r); r -= TI1;
        if (r < TI2) return mat_item(P.in[I_S5WIN], D, 512, (bf16*)(C.ws + WS_WS5IN), r); r -= TI2;
        if (r < TI3) return mat_item(P.in[I_WGLU], 512, 512, (bf16*)(C.ws + WS_WGLU), r); r -= TI3;
        return mat_item(P.in[I_S5WOUT], 512, D, (bf16*)(C.ws + WS_WS5OUT), r);
    }
    return moe_item(C, layer, r - nsmall);
}
__device__ __forceinline__ void convert_items(const Ctx& C, int layer, int nsmall) {
    LAS float* scr = (LAS float*)(C.lds + C.wave * 16384);
    const int total = nsmall + MOE_ITEMS, n = C.ngw;
    for (int it = C.gw; it < total; it += 2 * n) {
        const bool two = it + n < total;
        const TItem ta = conv_item(C, layer, nsmall, it), tb = conv_item(C, layer, nsmall, two ? it + n : it);
        float ra[32], rb[32];
        t_load(ta, C.lane, ra); if (two) t_load(tb, C.lane, rb);
        t_store(ta, C.lane, ra, scr); if (two) t_store(tb, C.lane, rb, scr);
    }
}

__device__ __forceinline__ void phase_prologue(const Ctx& C) {
    const Params& P = *C.p;
    {
        LAS float* s = (LAS float*)C.lds;
        LAS float* red = (LAS float*)(C.lds + 17 * 1024 * 4);
        bool have_s = false;
        for (int u = blockIdx.x; u < 192; u += gridDim.x) {
            if (!have_s) {
                for (int i = C.tid; i < 17 * 1024; i += NTHR) { const int ci = i >> 10, k = i & 1023; const float v = ci < 16 ? P.in[I_C][ci * D + k] : P.in[I_CCTX][k]; s[i] = silu_(v); }
                have_s = true; __syncthreads();
            }
            const int layer = u / 96, jg = u % 96, kq = C.tid >> 6, jc = C.tid & 63;
            const float* w = P.in[I_WMOD] + (size_t)layer * D * 6144 + jg * 64 + jc;
            float acc[17];
#pragma unroll
            for (int i = 0; i < 17; ++i) acc[i] = 0.f;
            for (int k0 = kq * 128; k0 < kq * 128 + 128; k0 += 16) {
                float wv[16];
#pragma unroll
                for (int j = 0; j < 16; ++j) wv[j] = w[(size_t)(k0 + j) * 6144];
#pragma unroll
                for (int j = 0; j < 16; ++j)
#pragma unroll
                    for (int i = 0; i < 17; ++i) acc[i] += s[i * 1024 + k0 + j] * wv[j]; }
#pragma unroll
            for (int i = 0; i < 17; ++i) red[(kq * 17 + i) * 64 + jc] = acc[i];
            __syncthreads();
            for (int o = C.tid; o < 17 * 64; o += NTHR) { const int ci = o >> 6, c = o & 63; float v = 0.f;
#pragma unroll
                for (int q = 0; q < 8; ++q) v += red[(q * 17 + ci) * 64 + c];
                const int j = jg * 64 + c; v += P.in[I_BMOD][layer * 6144 + j];
                ((float*)(C.ws + WS_MOD))[((size_t)(layer * 17 + ci)) * 6144 + j] = v; }
            __syncthreads();
        }
        __syncthreads();
    }
    {
        const int gt = blockIdx.x * NTHR + C.tid, ngt = gridDim.x * NTHR;
        float2* rope = (float2*)(C.ws + WS_TAB + TAB_ROPE);
        for (int i = gt; i < 64 * 16; i += ngt) { const int pos = i >> 4, f = i & 15;
            const double th = exp(-(double)f * (9.210340371976184 / 16.0)); double s, c; dsincos((double)pos * th, s, c); rope[i] = make_float2((float)c, (float)s); }
        float2* lamb = (float2*)(C.ws + WS_TAB + TAB_LAMB); float2* bbar = (float2*)(C.ws + WS_TAB + TAB_BBAR);
        for (int i = gt; i < 2 * 32 * 64; i += ngt) {
            const int dg = i >> 6;
            const double are = P.in[I_ARE][i], aim = P.in[I_AIM][i], dt = exp((double)P.in[I_LOGDT][dg]);
            double s, c; dsincos(aim * dt, s, c); const double mag = exp(are * dt), lr = mag * c, li = mag * s;
            lamb[i] = make_float2((float)lr, (float)li);
            const double den = are * are + aim * aim, nr = lr - 1.0, ni = li;
            const double cr = (nr * are + ni * aim) / den, cim = (ni * are - nr * aim) / den;
            for (int p = 0; p < 16; ++p) { const double br = P.in[I_BRE][(size_t)i * 16 + p], bi = P.in[I_BIM][(size_t)i * 16 + p];
                bbar[(size_t)i * 16 + p] = make_float2((float)(cr * br - cim * bi), (float)(cr * bi + cim * br)); }
        }
    }
    {
        const int gt = blockIdx.x * NTHR + C.tid, ngt = gridDim.x * NTHR;
        bf16* wrt = (bf16*)(C.ws + WS_TAB + TAB_WR);
        for (int idx = gt; idx < 2 * 32 * 3 * 64; idx += ngt) {
            const int ln = idx & 63, jb = (idx >> 6) % 3, kk = (idx / 192) & 31, l = idx / (192 * 32);
            const int i = ln & 15, q = ln >> 4, grp = i >> 2, r = i & 3;
            float hi8[8], lo8[8];
#pragma unroll
            for (int e = 0; e < 8; ++e) { const int k = 32 * kk + 8 * q + e;
                const float w = jb < 2 ? P.in[I_WRT][((size_t)l * D + k) * 32 + grp * 8 + jb * 4 + r] : (r == 0 ? P.in[I_WGRP][((size_t)l * D + k) * 4 + grp] : 0.f);
                const float h = bf2f(f2bf(w)); hi8[e] = h; lo8[e] = w - h; }
            v4u oh, ol; oh.x = pk2(hi8[0], hi8[1]); oh.y = pk2(hi8[2], hi8[3]); oh.z = pk2(hi8[4], hi8[5]); oh.w = pk2(hi8[6], hi8[7]);
            ol.x = pk2(lo8[0], lo8[1]); ol.y = pk2(lo8[2], lo8[3]); ol.z = pk2(lo8[4], lo8[5]); ol.w = pk2(lo8[6], lo8[7]);
            const size_t base = ((((size_t)l * 32 + kk) * 3 + jb) * 2) * 64 + ln;
            *(v4u*)(wrt + base * 8) = oh; *(v4u*)(wrt + (base + 64) * 8) = ol;
        }
    }
    {
        const int gt = blockIdx.x * NTHR + C.tid, ngt = gridDim.x * NTHR; bf16* w16 = (bf16*)(C.ws + WS_WSP);
        for (int i = gt; i < 8 * 128 * 128 / 4; i += ngt) { const f32x4 v = *(const f32x4*)(P.in[I_WSP] + 4 * (size_t)i); v2u o; o.x = pk2(v.x, v.y); o.y = pk2(v.z, v.w); *(v2u*)(w16 + 4 * (size_t)i) = o; }
    }
    convert_items(C, 0, NSMALL);
}

__device__ __forceinline__ void load_row16(const float* row, int lane, f32x4 (&v)[4]) {
#pragma unroll
    for (int j = 0; j < 4; ++j) v[j] = *(const f32x4*)(row + 4 * lane + 256 * j);
}
__device__ __forceinline__ float row_rstd(const f32x4 (&v)[4]) {
    float s = 0.f;
#pragma unroll
    for (int j = 0; j < 4; ++j) s += (v[j].x * v[j].x + v[j].y * v[j].y) + (v[j].z * v[j].z + v[j].w * v[j].w);
    return rsqrtf(wave_sum(s) * (1.f / D) + EPS);
}
__device__ __forceinline__ void modulate16(f32x4 (&v)[4], float rstd, const float* g, const float* scale, const float* shift, int lane) {
#pragma unroll
    for (int j = 0; j < 4; ++j) { const int c = 4 * lane + 256 * j; const f32x4 gg = *(const f32x4*)(g + c), sc = *(const f32x4*)(scale + c), sh = *(const f32x4*)(shift + c);
        v[j] = v[j] * rstd * gg * (sc + 1.f) + sh; }
}
__device__ __forceinline__ void store_row16_bf16(bf16* row, int lane, const f32x4 (&v)[4]) {
#pragma unroll
    for (int j = 0; j < 4; ++j) { v2u o; o.x = pk2(v[j].x, v[j].y); o.y = pk2(v[j].z, v[j].w); *(v2u*)(row + 4 * lane + 256 * j) = o; }
}

__device__ __forceinline__ void phase_norm_mix0(const Ctx& C) {
    const Params& P = *C.p; bf16* H = (bf16*)(C.ws + WS_H);
    f32x4 a[4], b[4]; const int n = C.ngw; int r = C.gw;
    if (r < TT) load_row16(xin_row(P, r), C.lane, a);
    if (r + n < TT) load_row16(xin_row(P, r + n), C.lane, b);
#define NM0_ROW(buf, rr, rnext) do { f32x4 v[4] = {buf[0], buf[1], buf[2], buf[3]}; if ((rnext) < TT) load_row16(xin_row(P, (rnext)), C.lane, buf); \
        const float rstd = row_rstd(v); const int ci = cond_of(rr); modulate16(v, rstd, P.in[I_GMIX], mod_vec(C, 0, ci, 1), mod_vec(C, 0, ci, 0), C.lane); store_row16_bf16(H + (size_t)(rr) * D, C.lane, v); } while (0)
    for (; r < TT; r += 2 * n) { NM0_ROW(a, r, r + 2 * n); if (r + n < TT) NM0_ROW(b, r + n, r + 3 * n); }
#undef NM0_ROW
}

__device__ __forceinline__ void qk_norm_rope(float (&v)[8], const float* gain, bool lat, int t, int lane, const float2* rope) {
    float ss = 0.f;
#pragma unroll
    for (int j = 0; j < 8; ++j) ss += v[j] * v[j];
    ss += __shfl_xor(ss, 1); ss += __shfl_xor(ss, 2); ss += __shfl_xor(ss, 4);
    const float rstd = rsqrtf(ss * (1.f / 64.f) + EPS);
    const int l8 = lane & 7;
#pragma unroll
    for (int j = 0; j < 8; ++j) v[j] = v[j] * rstd * gain[l8 * 8 + j];
    const int quarter = l8 >> 1, pos = (quarter < 2) ? (t >> 6) : (t & 63);
#pragma unroll
    for (int j = 0; j < 8; ++j) {
        const float pv = __shfl_xor(v[j], 2);
        if (lat) { const float2 cs = rope[pos * 16 + (lane & 1) * 8 + j];
            v[j] = (quarter & 1) ? (v[j] * cs.x + pv * cs.y) : (v[j] * cs.x - pv * cs.y); }
    }
}
__device__ __forceinline__ void phase_qkprep(const Ctx& C) {
    const Params& P = *C.p; const bf16* Pb = (const bf16*)(C.ws + WS_P); bf16* Q = (bf16*)(C.ws + WS_Q); bf16* Kb = (bf16*)(C.ws + WS_K); bf16* Vb = (bf16*)(C.ws + WS_V);
    const float2* rope = (const float2*)(C.ws + WS_TAB + TAB_ROPE);
    struct Raw { v4u q, k, v, g; };
    const int l16 = C.lane & 15, n = C.ngw;
#define QK_LOAD(dst, rr) do { const bf16* pr_ = Pb + (size_t)(rr) * MIXW; dst.q = *(const v4u*)(pr_ + 8 * C.lane); dst.k = *(const v4u*)(pr_ + 512 + 8 * l16); dst.v = *(const v4u*)(pr_ + 640 + 8 * l16); dst.g = *(const v4u*)(pr_ + 1280 + 8 * C.lane); } while (0)
#define QK_ROW(buf, rr, rnext) do { const Raw w_ = buf; if ((rnext) < TT) QK_LOAD(buf, (rnext)); const int r = (rr); \
        const bool lat = r < TL; const int t = lat ? (r & 2047) : 0; \
        const size_t kvrow = lat ? (size_t)(r >> 11) * KVL + CTXL + (r & 2047) : (size_t)((r - TL) >> 8) * KVL + ((r - TL) & 255); \
        { float v[8]; unpack8(w_.q, v); qk_norm_rope(v, P.in[I_QG], lat, t, C.lane, rope); \
          v4u o; o.x = pk2(v[0] * QSCALE, v[1] * QSCALE); o.y = pk2(v[2] * QSCALE, v[3] * QSCALE); o.z = pk2(v[4] * QSCALE, v[5] * QSCALE); o.w = pk2(v[6] * QSCALE, v[7] * QSCALE); \
          *(v4u*)(Q + (size_t)r * 512 + 8 * C.lane) = o; } \
        { float v[8]; unpack8(w_.k, v); qk_norm_rope(v, P.in[I_KG], lat, t, C.lane, rope); \
          if (C.lane < 16) { v4u o; o.x = pk2(v[0], v[1]); o.y = pk2(v[2], v[3]); o.z = pk2(v[4], v[5]); o.w = pk2(v[6], v[7]); *(v4u*)(Kb + kvrow * 128 + 8 * l16) = o; *(v4u*)(Vb + kvrow * 128 + 8 * l16) = w_.v; } } \
        { float v[8]; unpack8(w_.g, v); float sm = 0.f; \
          _Pragma("unroll") for (int j = 0; j < 8; ++j) { v[j] = gelu_tanh(v[j]); sm += v[j]; } \
          const float mean = wave_sum(sm) * (1.f / 512.f); float qq = 0.f; \
          _Pragma("unroll") for (int j = 0; j < 8; ++j) { const float d = v[j] - mean; qq += d * d; } \
          const float rstd = rsqrtf(wave_sum(qq) * (1.f / 512.f) + EPS); \
          if (C.lane == 0) ((float2*)(C.ws + WS_ROUTE + RT_S))[r] = make_float2(mean, rstd); } } while (0)
    Raw a, b; int r0 = C.gw;
    if (r0 < TT) QK_LOAD(a, r0);
    if (r0 + n < TT) QK_LOAD(b, r0 + n);
    for (; r0 < TT; r0 += 2 * n) { QK_ROW(a, r0, r0 + 2 * n); if (r0 + n < TT) QK_ROW(b, r0 + n, r0 + 3 * n); }
#undef QK_LOAD
#undef QK_ROW
}

__device__ __forceinline__ unsigned gm_off_b(unsigned row, unsigned ch) { return 256u * row + 16u * (ch ^ (((row & 3u) << 2) | ((row >> 2) & 3u))); }
__device__ __forceinline__ void phase_gmlp_fast(const Ctx& C) {
    typedef short bf16x8 __attribute__((ext_vector_type(8)));
    typedef short s16x4 __attribute__((ext_vector_type(4)));
    typedef float f32x16 __attribute__((ext_vector_type(16)));
    const Params& P = *C.p; const bf16* Pb = (const bf16*)(C.ws + WS_P); bf16* OG = (bf16*)(C.ws + WS_H); const bf16* W16 = (const bf16*)(C.ws + WS_WSP);
    const float2* lns = (const float2*)(C.ws + WS_ROUTE + RT_S);
    const int tid = C.tid, lane = C.lane, w = C.wave, l31 = lane & 31, hi = lane >> 5;
    const int gsel = w >> 2, pb = w & 3;
    for (int u = blockIdx.x; u < (TT / 128) * 4; u += gridDim.x) {
        const int ch_ = u >> 2, gp = u & 3;
        { const int row = tid >> 2; const size_t grow = (size_t)ch_ * 128 + row; const float2 st = lns[grow];
#pragma unroll
          for (int i = 0; i < 4; ++i) { const int c16 = (tid & 3) + 4 * i; float v[8]; unpack8(*(const v4u*)(Pb + grow * MIXW + 1280 + 128 * gp + 8 * c16), v);
              const float* lg = P.in[I_LNG] + 128 * gp + 8 * c16;
#pragma unroll
              for (int j = 0; j < 8; ++j) v[j] = (gelu_tanh(v[j]) - st.x) * st.y * lg[j];
              v4u o; o.x = pk2(v[0], v[1]); o.y = pk2(v[2], v[3]); o.z = pk2(v[4], v[5]); o.w = pk2(v[6], v[7]);
              *(LAS v4u*)(C.lds + (row >> 5) * 8192 + gm_off_b(row & 31, c16)) = o; } }
        __syncthreads();
        const int g = 2 * gp + gsel;
        f32x16 acc[2]; acc[0] = f32x16{}; acc[1] = f32x16{};
        const bf16* wrow = W16 + ((size_t)g * 128 + 32 * pb + l31) * 128 + 8 * hi;
#pragma unroll
        for (int k8 = 0; k8 < 8; ++k8) {
            const bf16x8 xf = *(const bf16x8*)(wrow + 16 * k8);
            const unsigned rb = k8 >> 1, ks = k8 & 1;
#pragma unroll
            for (int db = 0; db < 2; ++db) { const unsigned c = 2 * gsel + db, blk = (lane >> 4) & 1, q = (lane & 15) >> 2, p2 = lane & 3;
                s16x4 t0, t1;
                { const unsigned a0 = rb * 8192 + gm_off_b(16 * ks + 8 * hi + q, 4 * c + 2 * blk + (p2 >> 1)) + 8 * (p2 & 1);
                  const unsigned a1 = rb * 8192 + gm_off_b(16 * ks + 8 * hi + 4 + q, 4 * c + 2 * blk + (p2 >> 1)) + 8 * (p2 & 1);
                  t0 = __builtin_bit_cast(s16x4, __builtin_amdgcn_ds_read_tr16_b64_v4i16((LAS s16x4*)(C.lds + a0)));
                  t1 = __builtin_bit_cast(s16x4, __builtin_amdgcn_ds_read_tr16_b64_v4i16((LAS s16x4*)(C.lds + a1))); }
                const bf16x8 yf = {t0[0], t0[1], t0[2], t0[3], t1[0], t1[1], t1[2], t1[3]};
                acc[db] = __builtin_amdgcn_mfma_f32_32x32x16_bf16(xf, yf, acc[db], 0, 0, 0); }
        }
        const float* bsp = P.in[I_BSP] + g * 128 + 32 * pb;
#pragma unroll
        for (int r = 0; r < 16; ++r) { const int pl = (r & 3) + 8 * (r >> 2) + 4 * hi; const size_t grow = (size_t)ch_ * 128 + 32 * pb + pl; const float bb = bsp[pl];
#pragma unroll
            for (int db = 0; db < 2; ++db) { const int col = 64 * g + 32 * db + l31; const float uu = gelu_tanh(bf2f(Pb[grow * MIXW + 768 + col]));
                OG[grow * D + 512 + col] = (bf16)f2bf(uu * (acc[db][r] + bb)); } }
        __syncthreads();
    }
}

__device__ __forceinline__ void phase_attn_fast(const Ctx& C, char* lds_generic) {
    typedef attn_body::bf16 abf;
    const abf* Q = (const abf*)(C.ws + WS_Q); const abf* Kb = (const abf*)(C.ws + WS_K); const abf* Vb = (const abf*)(C.ws + WS_V); abf* OG = (abf*)(C.ws + WS_H);
    const int G = gridDim.x, bx = blockIdx.x; const int vcu = (G % 8 == 0) ? (bx % 8) * (G / 8) + bx / 8 : bx;
    const int per = (1024 + G - 1) / G, perc = (128 + G - 1) / G;
    for (int i = 0; i < per + perc; ++i) {
        int b, h, nt; size_t qrow;
        if (i < per) { const int u = vcu * per + i; if (u >= 1024) continue; const int qb = u & 7, hg = (u >> 3) & 3, bk = u >> 5; b = bk >> 1; h = (bk & 1) * 4 + hg; qrow = (size_t)b * SEQ + qb * 256; nt = KVL / 64; }
        else { const int u = vcu + (i - per) * G; if (u >= 128) continue; b = u >> 3; h = u & 7; qrow = (size_t)TL + (size_t)b * CTXL; nt = CTXL / 64; }
        const size_t kvo = (size_t)b * KVL * 128 + (h >> 2) * 64;
        attn_body::attn_unit<8>(Q + qrow * 512 + h * 64, Kb + kvo, Vb + kvo, OG + qrow * 1024 + h * 64, nt, lds_generic);
    }
}

__device__ __forceinline__ void phase_router_fast(const Ctx& C, int layer, int nrows) {
    typedef short bf16x8 __attribute__((ext_vector_type(8)));
    const Params& P = *C.p; const bf16* XC = (const bf16*)(C.ws + WS_XC); bf16* F = (bf16*)(C.ws + WS_H);
    int* asg_e = (int*)(C.ws + WS_ROUTE + RT_E); int* asg_p = (int*)(C.ws + WS_ROUTE + RT_P); float* asg_w = (float*)(C.ws + WS_ROUTE + RT_W); int* list = (int*)(C.ws + WS_LIST);
    unsigned* cnt = (unsigned*)(C.ws + WS_CTL) + CW_CNT + 64 * layer;
    const int l15 = C.lane & 15, q4 = C.lane >> 4;
    LAS float* ab = (LAS float*)(C.lds + C.wave * 8192);
    LAS unsigned* lcnt = (LAS unsigned*)(C.lds + 65536);
    if (C.tid < 64) lcnt[C.tid] = 0u;
    __syncthreads();
    int cur_ci = -1;
    const int nitems = nrows / 16, nrounds = (nitems + C.ngw - 1) / C.ngw;
    for (int rd = 0; rd < nrounds; ++rd) {
        const int it_raw = C.gw + rd * C.ngw; const bool valid = it_raw < nitems; const int it = valid ? it_raw : nitems - 1;
        const int row = it * 16 + l15, ci = cond_of(it * 16);
        if (ci != cur_ci) {
            const float* sc = mod_vec(C, layer, ci, 4); const float* sh = mod_vec(C, layer, ci, 3); const float* g0 = P.in[I_GFFN] + layer * D;
#pragma unroll
            for (int j = 0; j < 4; ++j) { const int c = 4 * C.lane + 256 * j; const f32x4 g4 = *(const f32x4*)(g0 + c), s4 = *(const f32x4*)(sc + c), h4 = *(const f32x4*)(sh + c); const f32x4 a4 = g4 * (s4 + 1.f);
                *(LAS f32x4*)(ab + c) = a4; *(LAS f32x4*)(ab + 1024 + c) = h4; }
            asm volatile("s_waitcnt lgkmcnt(0)" ::: "memory"); cur_ci = ci;
        }
        const bf16* xr = XC + (size_t)row * D + 8 * q4;
        float ss = 0.f;
#pragma unroll 16
        for (int kk = 0; kk < 32; ++kk) { pg8::f32x4 a, b; pg8::unpack8f(*(const pg8::u32x4*)(xr + 32 * kk), a, b); ss += (a.x * a.x + a.y * a.y) + (a.z * a.z + a.w * a.w) + (b.x * b.x + b.y * b.y) + (b.z * b.z + b.w * b.w); }
        ss += __shfl_xor(ss, 16); ss += __shfl_xor(ss, 32);
        const float rstd = rsqrtf(ss * (1.f / D) + EPS);
        f32x4 acc[3]; acc[0] = (f32x4){0.f, 0.f, 0.f, 0.f}; acc[1] = acc[0]; acc[2] = acc[0];
        bf16* frow = F + (size_t)row * D + 8 * q4;
        const LAS float* abl = ab + 8 * q4;
        {
            const unsigned char* wsrc = (const unsigned char*)((const bf16x8*)(C.ws + WS_TAB + TAB_WR) + (size_t)layer * (32 * 3 * 2 * 64)) + C.tid * 16;
            LAS unsigned char* wl0 = C.lds + 67584;
#define RS_GLOAD(sb_, ga, gb, gc, xq) do { ga = *(const pg8::u32x4*)(wsrc + (sb_) * 24576); gb = *(const pg8::u32x4*)(wsrc + (sb_) * 24576 + 8192); gc = *(const pg8::u32x4*)(wsrc + (sb_) * 24576 + 16384); \
                _Pragma("unroll") for (int j = 0; j < 4; ++j) xq[j] = *(const pg8::u32x4*)(xr + 128 * (sb_) + 32 * j); } while (0)
#define RS_LWRITE(sb_, ga, gb, gc) do { LAS unsigned char* wn = wl0 + ((sb_) & 1) * 24576 + C.tid * 16; *(LAS pg8::u32x4*)(wn) = ga; *(LAS pg8::u32x4*)(wn + 8192) = gb; *(LAS pg8::u32x4*)(wn + 16384) = gc; } while (0)
#define RS_FRAGS(sb_, j_, wf_, tb_) do { const LAS unsigned char* wl = wl0 + ((sb_) & 1) * 24576 + C.lane * 16; const int c_ = 128 * (sb_) + 32 * (j_); \
                _Pragma("unroll") for (int jb = 0; jb < 3; ++jb) { wf_[jb][0] = *(const LAS bf16x8*)(wl + (((j_) * 3 + jb) * 2) * 1024); wf_[jb][1] = *(const LAS bf16x8*)(wl + (((j_) * 3 + jb) * 2 + 1) * 1024); } \
                tb_[0] = *(const LAS f32x4*)(abl + c_); tb_[1] = *(const LAS f32x4*)(abl + c_ + 4); tb_[2] = *(const LAS f32x4*)(abl + 1024 + c_); tb_[3] = *(const LAS f32x4*)(abl + 1024 + c_ + 4); } while (0)
#define RS_STEP(sb_, j_, xv_, wf_, tb_, NEXT) do { const int c = 128 * (sb_) + 32 * (j_); \
                pg8::f32x4 x0, x1; pg8::unpack8f(xv_, x0, x1); \
                const f32x4 f0 = x0 * rstd * tb_[0] + tb_[2]; \
                const f32x4 f1 = x1 * rstd * tb_[1] + tb_[3]; \
                const pg8::u32x4 fh = pg8::pack8(f0, f1); if (valid) *(pg8::u32x4*)(frow + c) = fh; \
                pg8::f32x4 r0, r1; pg8::unpack8f(fh, r0, r1); \
                const pg8::u32x4 fl = pg8::pack8(f0 - r0, f1 - r1); \
                const bf16x8 ah = __builtin_bit_cast(bf16x8, fh), al = __builtin_bit_cast(bf16x8, fl); \
                NEXT; \
                _Pragma("unroll") for (int jb = 0; jb < 3; ++jb) { \
                    acc[jb] = __builtin_amdgcn_mfma_f32_16x16x32_bf16(wf_[jb][0], ah, acc[jb], 0, 0, 0); \
                    acc[jb] = __builtin_amdgcn_mfma_f32_16x16x32_bf16(wf_[jb][0], al, acc[jb], 0, 0, 0); \
                    acc[jb] = __builtin_amdgcn_mfma_f32_16x16x32_bf16(wf_[jb][1], ah, acc[jb], 0, 0, 0); } } while (0)
#define RS_COMP(sb_, xq) do { bf16x8 wA[3][2], wB[3][2]; f32x4 tA[4], tB[4]; \
                RS_FRAGS(sb_, 0, wA, tA); \
                RS_STEP(sb_, 0, xq[0], wA, tA, RS_FRAGS(sb_, 1, wB, tB)); \
                RS_STEP(sb_, 1, xq[1], wB, tB, RS_FRAGS(sb_, 2, wA, tA)); \
                RS_STEP(sb_, 2, xq[2], wA, tA, RS_FRAGS(sb_, 3, wB, tB)); \
                RS_STEP(sb_, 3, xq[3], wB, tB, (void)0); } while (0)
#define RS_SYNC() do { asm volatile("s_waitcnt lgkmcnt(0)" ::: "memory"); __builtin_amdgcn_s_barrier(); } while (0)
            if (layer == 1) STAMP_AT(22);
            pg8::u32x4 a0, a1, a2, b0, b1, b2, xa[4], xb[4], xc[4];
            RS_GLOAD(0, a0, a1, a2, xc); RS_GLOAD(1, b0, b1, b2, xb);
            __builtin_amdgcn_s_barrier();
            RS_LWRITE(0, a0, a1, a2); RS_SYNC();
#pragma unroll 1
            for (int sb = 0; sb < 8; sb += 2) {
                if (sb + 2 < 8) RS_GLOAD(sb + 2, a0, a1, a2, xa);
                RS_COMP(sb, xc);
                RS_LWRITE(sb + 1, b0, b1, b2); RS_SYNC();
#pragma unroll
                for (int j = 0; j < 4; ++j) xc[j] = xb[j];
                if (sb + 3 < 8) RS_GLOAD(sb + 3, b0, b1, b2, xb);
                RS_COMP(sb + 1, xc);
                if (sb + 2 < 8) { RS_LWRITE(sb + 2, a0, a1, a2);
#pragma unroll
                    for (int j = 0; j < 4; ++j) xc[j] = xa[j]; }
                RS_SYNC();
            }
            if (layer == 1) STAMP_AT(23);
#undef RS_GLOAD
#undef RS_LWRITE
#undef RS_COMP
#undef RS_STEP
#undef RS_FRAGS
#undef RS_SYNC
        }
        const float* brt = P.in[I_BRT] + layer * 32 + q4 * 8;
        float e[8];
#pragma unroll
        for (int r = 0; r < 4; ++r) { e[r] = acc[0][r] + brt[r]; e[4 + r] = acc[1][r] + brt[4 + r]; }
        const float gl = acc[2][0] + P.in[I_BGRP][layer * 4 + q4];
        float gm = gl; int gi = q4;
#pragma unroll
        for (int st = 16; st <= 32; st <<= 1) { const float og = __shfl_xor(gm, st); const int oi = __shfl_xor(gi, st); if (og > gm || (og == gm && oi < gi)) { gm = og; gi = oi; } }
        float den = __expf(gl - gm); den += __shfl_xor(den, 16); den += __shfl_xor(den, 32);
        if (valid && q4 == gi) {
            const float gw_ = 1.f / den;
            int i0 = 0; float v0 = e[0];
#pragma unroll
            for (int i = 1; i < 8; ++i) if (e[i] > v0) { v0 = e[i]; i0 = i; }
            int i1 = -1; float v1 = -INFINITY;
#pragma unroll
            for (int i = 0; i < 8; ++i) if (i != i0 && e[i] > v1) { v1 = e[i]; i1 = i; }
            if (i1 < 0) i1 = (i0 + 1) & 7;
            const float e1 = __expf(v1 - v0), w0 = gw_ / (1.f + e1), w1 = gw_ * e1 / (1.f + e1);
            const int ea = (gi & 3) * 8 + i0, eb = (gi & 3) * 8 + i1;
            const unsigned pa = __hip_atomic_fetch_add(lcnt + ea, 1u, __ATOMIC_RELAXED, __HIP_MEMORY_SCOPE_WORKGROUP);
            const unsigned pb = __hip_atomic_fetch_add(lcnt + eb, 1u, __ATOMIC_RELAXED, __HIP_MEMORY_SCOPE_WORKGROUP);
            asg_e[2 * row] = ea; asg_e[2 * row + 1] = eb; asg_p[2 * row] = (int)pa; asg_p[2 * row + 1] = (int)pb; asg_w[2 * row] = w0; asg_w[2 * row + 1] = w1;
        }
    }
    if (layer == 0) STAMP_AT(21);
    asm volatile("s_waitcnt vmcnt(0) lgkmcnt(0)" ::: "memory");
    __syncthreads();
    if (C.tid < 32) { const unsigned n = lcnt[C.tid]; lcnt[32 + C.tid] = n ? __hip_atomic_fetch_add(cnt + C.tid, n, __ATOMIC_RELAXED, __HIP_MEMORY_SCOPE_AGENT) : 0u; }
    __syncthreads();
    for (int it = C.gw; it < nrows / 16; it += C.ngw) {
        if (C.lane < 32) { const int idx = 2 * (it * 16 + (C.lane & 15)) + (C.lane >> 4);
            const int e = __hip_atomic_load(asg_e + idx, __ATOMIC_RELAXED, __HIP_MEMORY_SCOPE_AGENT); const int p = __hip_atomic_load(asg_p + idx, __ATOMIC_RELAXED, __HIP_MEMORY_SCOPE_AGENT) + (int)lcnt[32 + e];
            asg_p[idx] = p; list[(size_t)e * LCAP + p] = idx >> 1; }
    }
}

__device__ __forceinline__ int wave_pstart(const Ctx& C, int layer) {
    const unsigned* cnt = (const unsigned*)(C.ws + WS_CTL) + CW_CNT + 64 * layer;
    const int mc = C.lane < 32 ? (int)__hip_atomic_load(cnt + (C.lane & 31), __ATOMIC_RELAXED, __HIP_MEMORY_SCOPE_AGENT) : 0; const int mp = (mc + 255) & ~255; int in = mp;
#pragma unroll
    for (int o = 1; o < 32; o <<= 1) { const int t = __shfl_up(in, o); if ((C.lane & 31) >= o) in += t; }
    return in - mp;
}
struct CombRaw { v2u x[4], ya[4], yb[4]; float w0, w1; };
__device__ __forceinline__ void comb_load(const Ctx& C, int r, int ps, CombRaw& o) {
    const bf16* Y2 = (const bf16*)(C.ws + WS_XS); const bf16* XC = (const bf16*)(C.ws + WS_XC); const float* asg_w = (const float*)(C.ws + WS_ROUTE + RT_W);
    const int* asg_e = (const int*)(C.ws + WS_ROUTE + RT_E); const int* asg_p = (const int*)(C.ws + WS_ROUTE + RT_P);
    const int s0 = __shfl(ps, asg_e[2 * r]) + asg_p[2 * r], s1 = __shfl(ps, asg_e[2 * r + 1]) + asg_p[2 * r + 1]; o.w0 = asg_w[2 * r]; o.w1 = asg_w[2 * r + 1];
#pragma unroll
    for (int j = 0; j < 4; ++j) { const int c = 4 * C.lane + 256 * j; o.x[j] = *(const v2u*)(XC + (size_t)r * D + c); o.ya[j] = *(const v2u*)(Y2 + (size_t)s0 * D + c); o.yb[j] = *(const v2u*)(Y2 + (size_t)s1 * D + c); }
}
__device__ __forceinline__ void comb_calc(const Ctx& C, int layer, int r, const CombRaw& w, f32x4 (&v)[4]) {
    const float* gate = mod_vec(C, layer, cond_of(r), 5); const float w0 = w.w0, w1 = w.w1;
#pragma unroll
    for (int j = 0; j < 4; ++j) { const int c = 4 * C.lane + 256 * j; const v2u xx = w.x[j], a = w.ya[j], b = w.yb[j]; const f32x4 g = *(const f32x4*)(gate + c);
        v[j].x = bf2f(xx.x & 0xffffu) + g.x * (w0 * bf2f(a.x & 0xffffu) + w1 * bf2f(b.x & 0xffffu)); v[j].y = bf2f(xx.x >> 16) + g.y * (w0 * bf2f(a.x >> 16) + w1 * bf2f(b.x >> 16));
        v[j].z = bf2f(xx.y & 0xffffu) + g.z * (w0 * bf2f(a.y & 0xffffu) + w1 * bf2f(b.y & 0xffffu)); v[j].w = bf2f(xx.y >> 16) + g.w * (w0 * bf2f(a.y >> 16) + w1 * bf2f(b.y >> 16)); }
}
__device__ __forceinline__ void phase_combine_norm_mix1(const Ctx& C) {
    const Params& P = *C.p; bf16* XC = (bf16*)(C.ws + WS_XC); bf16* H = (bf16*)(C.ws + WS_H);
    const int ps = wave_pstart(C, 0), n = C.ngw;
#define CN_ROW(buf, rr, rnext) do { const CombRaw w_ = buf; if ((rnext) < TT) comb_load(C, (rnext), ps, buf); f32x4 v[4]; comb_calc(C, 0, (rr), w_, v); \
        store_row16_bf16(XC + (size_t)(rr) * D, C.lane, v); const float rstd = row_rstd(v); const int ci = cond_of(rr); \
        modulate16(v, rstd, P.in[I_GMIX] + D, mod_vec(C, 1, ci, 1), mod_vec(C, 1, ci, 0), C.lane); store_row16_bf16(H + (size_t)(rr) * D, C.lane, v); } while (0)
    CombRaw a, b; int r = C.gw;
    if (r < TT) comb_load(C, r, ps, a);
    if (r + n < TT) comb_load(C, r + n, ps, b);
    for (; r < TT; r += 2 * n) { CN_ROW(a, r, r + 2 * n); if (r + n < TT) CN_ROW(b, r + n, r + 3 * n); }
#undef CN_ROW
    convert_items(C, 1, 0);
}
__device__ __forceinline__ void phase_final(const Ctx& C) {
    const Params& P = *C.p;
    const int ps = wave_pstart(C, 1), n = C.ngw;
#define FN_ROW(buf, rr, rnext) do { const CombRaw w_ = buf; if ((rnext) < TL) comb_load(C, (rnext), ps, buf); f32x4 v[4]; comb_calc(C, 1, (rr), w_, v); const float rstd = row_rstd(v); \
        _Pragma("unroll") for (int j = 0; j < 4; ++j) { const int c = 4 * C.lane + 256 * j; const f32x4 g = *(const f32x4*)(P.in[I_FING] + c); *(f32x4*)(P.out + (size_t)(rr) * D + c) = v[j] * rstd * g; } } while (0)
    CombRaw a, b; int r = C.gw;
    if (r < TL) comb_load(C, r, ps, a);
    if (r + n < TL) comb_load(C, r + n, ps, b);
    for (; r < TL; r += 2 * n) { FN_ROW(a, r, r + 2 * n); if (r + n < TL) FN_ROW(b, r + n, r + 3 * n); }
#undef FN_ROW
}

__device__ __forceinline__ void phase_s5_fast(const Ctx& C) {
    typedef short bf16x8 __attribute__((ext_vector_type(8)));
    typedef float f32x16 __attribute__((ext_vector_type(16)));
    const Params& P = *C.p; const bf16* U = (const bf16*)(C.ws + WS_U); bf16* GS = (bf16*)(C.ws + WS_GS); float* YA = (float*)(C.ws + WS_YACC);
    const float2* lamb = (const float2*)(C.ws + WS_TAB + TAB_LAMB); const float2* bbar = (const float2*)(C.ws + WS_TAB + TAB_BBAR);
    constexpr int HP = 272;
    const int lane = C.lane, w = C.wave, il = w >> 2, dir = (w >> 1) & 1, nh = w & 1;
    const int l31 = lane & 31, hi = lane >> 5, l15 = lane & 15, q4 = lane >> 4;
    LAS unsigned char* Hb = C.lds + (il * 2 + dir) * (2 * 32 * HP);
    const int srow = (l31 & 3) + 4 * (l31 >> 3) + 16 * ((l31 >> 2) & 1);
    for (int it0 = blockIdx.x; it0 < NB * 16; it0 += gridDim.x) {
        const int item = it0 * 2 + il, b = item >> 5, g = item & 31;
        const int dg = dir * 32 + g, n = nh * 32 + l31;
        const float2 lam = lamb[dg * 64 + n];
        float lpr[16], lpi[16]; { float pr = lam.x, pi = lam.y;
#pragma unroll
            for (int r = 0; r < 16; ++r) { lpr[r] = pr; lpi[r] = pi; const float nr = pr * lam.x - pi * lam.y, ni = pr * lam.y + pi * lam.x; pr = nr; pi = ni; } }
        bf16x8 bre, bim; { const float2* bp = bbar + ((size_t)(dg * 64 + n)) * 16 + 8 * hi;
#pragma unroll
            for (int e = 0; e < 8; ++e) { const float2 v = bp[e]; bre[e] = (short)f2bf(v.x); bim[e] = (short)f2bf(v.y); } }
        bf16x8 cf[4]; { const float* cre = P.in[I_CRE] + ((size_t)dg * 16 + l15) * 64; const float* cim = P.in[I_CIM] + ((size_t)dg * 16 + l15) * 64;
#pragma unroll
            for (int ks = 0; ks < 4; ++ks) { const f32x4 a = *(const f32x4*)(cre + 16 * ks + 4 * q4), m = *(const f32x4*)(cim + 16 * ks + 4 * q4);
                cf[ks][0] = (short)f2bf(a.x); cf[ks][1] = (short)f2bf(-m.x); cf[ks][2] = (short)f2bf(a.y); cf[ks][3] = (short)f2bf(-m.y);
                cf[ks][4] = (short)f2bf(a.z); cf[ks][5] = (short)f2bf(-m.z); cf[ks][6] = (short)f2bf(a.w); cf[ks][7] = (short)f2bf(-m.w); } }
        const f32x4 dsk = *(const f32x4*)(P.in[I_S5D] + g * 16 + 4 * q4);
        float cr = 0.f, ci = 0.f;
#define S5_UROW(kk) ({ const int S_ = 32 * (kk) + srow; (S_ < CTXL) ? ((size_t)TL + (size_t)b * CTXL + (dir == 0 ? S_ : CTXL - 1 - S_)) : ((size_t)b * SEQ + (dir == 0 ? S_ - CTXL : SEQ - 1 - (S_ - CTXL))); })
        bf16x8 ua_next = *(const bf16x8*)(U + S5_UROW(0) * 512 + g * 16 + 8 * hi);
        for (int k = 0; k < 72; ++k) {
            const bf16x8 ua = ua_next;
            if (k + 1 < 72) ua_next = *(const bf16x8*)(U + S5_UROW(k + 1) * 512 + g * 16 + 8 * hi);
            const int sl = 32 * (k - 8) + 16 * nh + l15;
            const int tok = dir == 0 ? sl : SEQ - 1 - sl; const int lt = tok >> 5;
            const size_t o = ((size_t)b * SEQ + (k >= 8 ? tok : 0)) * 512 + g * 16 + 4 * q4;
            const bool first = dir == 0 ? (lt < 32) : (lt >= 32);
            f32x4 pk = {0.f, 0.f, 0.f, 0.f}; v2u uu = {0u, 0u};
            if (k >= 8 && !first) {
                pk.x = __hip_atomic_load(YA + o, __ATOMIC_RELAXED, __HIP_MEMORY_SCOPE_AGENT); pk.y = __hip_atomic_load(YA + o + 1, __ATOMIC_RELAXED, __HIP_MEMORY_SCOPE_AGENT);
                pk.z = __hip_atomic_load(YA + o + 2, __ATOMIC_RELAXED, __HIP_MEMORY_SCOPE_AGENT); pk.w = __hip_atomic_load(YA + o + 3, __ATOMIC_RELAXED, __HIP_MEMORY_SCOPE_AGENT);
                uu = *(const v2u*)(U + o);
            }
            {
              f32x16 br = {}, bi = {};
              br = __builtin_amdgcn_mfma_f32_32x32x16_bf16(ua, bre, br, 0, 0, 0);
              bi = __builtin_amdgcn_mfma_f32_32x32x16_bf16(ua, bim, bi, 0, 0, 0);
              float sr = hi ? 0.f : cr, si = hi ? 0.f : ci;
#pragma unroll
              for (int r = 0; r < 16; ++r) { const float nr = lam.x * sr - lam.y * si + br[r], ni = lam.x * si + lam.y * sr + bi[r]; sr = nr; si = ni; br[r] = sr; bi[r] = si; }
              float er = __shfl_xor(sr, 32), ei = __shfl_xor(si, 32); if (!hi) { er = 0.f; ei = 0.f; }
              { const f32x2 er2 = {er, er}, ei2 = {ei, ei};
#pragma unroll
              for (int r = 0; r < 16; r += 2) { const f32x2 pr2 = {lpr[r], lpr[r + 1]}, pi2 = {lpi[r], lpi[r + 1]}; f32x2 b2 = {br[r], br[r + 1]}, i2 = {bi[r], bi[r + 1]};
                  b2 = b2 + pr2 * er2 - pi2 * ei2; i2 = i2 + pr2 * ei2 + pi2 * er2; br[r] = b2.x; br[r + 1] = b2.y; bi[r] = i2.x; bi[r + 1] = i2.y; } }
              cr = __shfl_xor(br[15], 32); ci = __shfl_xor(bi[15], 32);
              LAS unsigned char* hb = Hb + (k & 1) * (32 * HP) + (16 * hi) * HP + 4 * n;
#pragma unroll
              for (int r = 0; r < 16; ++r) *(LAS unsigned*)(hb + r * HP) = pk2(br[r], bi[r]);
            }
            asm volatile("s_waitcnt lgkmcnt(0)\n\ts_barrier" ::: "memory");
            if (k >= 8) {
                const LAS unsigned char* hr = Hb + (k & 1) * (32 * HP) + (16 * nh + l15) * HP + 16 * q4;
                f32x4 y = {0.f, 0.f, 0.f, 0.f};
#pragma unroll
                for (int ks = 0; ks < 4; ++ks) { const bf16x8 hf = *(const LAS bf16x8*)(hr + 64 * ks); y = __builtin_amdgcn_mfma_f32_16x16x32_bf16(cf[ks], hf, y, 0, 0, 0); }
                if (first) { *(f32x4*)(YA + o) = y; }
                else {
                    const f32x4 uf = {bf2f(uu.x & 0xffffu), bf2f(uu.x >> 16), bf2f(uu.y & 0xffffu), bf2f(uu.y >> 16)};
                    const f32x4 t = y + pk + dsk * uf;
                    v2u ov; ov.x = pk2(gelu_tanh(t.x), gelu_tanh(t.y)); ov.y = pk2(gelu_tanh(t.z), gelu_tanh(t.w)); *(v2u*)(GS + o) = ov;
                }
            }
            if (k == 39) asm volatile("s_waitcnt vmcnt(0)\n\ts_barrier" ::: "memory");
        }
#undef S5_UROW
        asm volatile("s_waitcnt vmcnt(0) lgkmcnt(0)\n\ts_barrier" ::: "memory");
    }
}

__global__ void __launch_bounds__(NTHR, 2) fwd_kernel(Params prm) {
    extern __shared__ __attribute__((aligned(16))) unsigned char lds_raw[];
    Ctx C; C.p = &prm; C.ws = prm.ws; C.lds = (LAS unsigned char*)lds_raw;
    C.tid = threadIdx.x; C.lane = C.tid & 63; C.wave = __builtin_amdgcn_readfirstlane(C.tid >> 6);
    C.gw = blockIdx.x * NWAVE + C.wave; C.ngw = gridDim.x * NWAVE;
    constexpr int LDS_MISC = 147456 - 512;
    volatile LAS unsigned* misc = (volatile LAS unsigned*)(C.lds + LDS_MISC);
    if (C.tid < 64) misc[C.tid] = 0u;
    __syncthreads();
    unsigned* ctl = (unsigned*)(C.ws + WS_CTL);
    XcdBarrier bar; bar.bar = ctl + CW_BAR; bar.x = 0; bar.st = nullptr;
#if MK_ONE_LAUNCH
    bar = xcd_barrier_post(ctl + CW_BAR, misc + 8);
#define SEAM(k) do { if (lo <= (k) && (k) + 1 < hi) xcd_barrier(bar); } while (0)
#else
#define SEAM(k) do { } while (0)
#endif
    const int lo = prm.ph_lo, hi = prm.ph_hi;
#define IN(k) (lo <= (k) && (k) < hi)
#if MK_PROBE
    volatile LAS unsigned long long* ts_ = (volatile LAS unsigned long long*)(C.lds + LDS_MISC + 64);
#define STAMP(k) do { if (blockIdx.x == 0 && C.tid == 0) ts_[(k) + 1] = __builtin_amdgcn_s_memrealtime(); } while (0)
    if (blockIdx.x == 0 && C.tid == 0) ts_[0] = __builtin_amdgcn_s_memrealtime();
#else
#define STAMP(k) do { } while (0)
#endif
    const Params& P = prm;
    bf16* Hb = (bf16*)(C.ws + WS_H); bf16* XC = (bf16*)(C.ws + WS_XC);
#define MOE_MAP(layer) do { LAS int* tm_ = (LAS int*)(C.lds + 131072); LAS int* cl_ = tm_ + 320; \
        if (C.wave == 0) { const unsigned* cnt_ = (const unsigned*)(C.ws + WS_CTL) + CW_CNT + 64 * (layer); const int mc_ = C.lane < 32 ? (int)__hip_atomic_load(cnt_ + (C.lane & 31), __ATOMIC_RELAXED, __HIP_MEMORY_SCOPE_AGENT) : 0; const int mp_ = (mc_ + 255) & ~255; int in_ = mp_; \
            _Pragma("unroll") for (int o_ = 1; o_ < 32; o_ <<= 1) { const int t_ = __shfl_up(in_, o_); if ((C.lane & 31) >= o_) in_ += t_; } const int ps_ = in_ - mp_; \
            if (C.lane < 32) { for (int t_ = ps_ / 256; t_ < (ps_ + mp_) / 256; ++t_) tm_[t_] = C.lane | ((t_ * 256 - ps_) << 8); cl_[C.lane] = mc_; if (C.lane == 31) cl_[32] = (ps_ + mp_) / 256; } } \
        __syncthreads(); } while (0)
#define MOE_GEMM1(layer) do { MOE_MAP(layer); const LAS int* tm_ = (const LAS int*)(C.lds + 131072); const int ntl_ = __builtin_amdgcn_readfirstlane(tm_[320 + 32]); pg8::Gemm g{Hb, (const bf16*)(C.ws + WS_W13), 0, 1024, D}; \
        pg8::GroupedOrder<true> S{tm_, tm_ + 320, (const int*)(C.ws + WS_LIST), ntl_ * 4, 4, (int)gridDim.x, (int)blockIdx.x, LCAP, D * 2, (size_t)1024 * 1024 * 2}; pg8::EpiSwiglu E{(bf16*)(C.ws + WS_G13)}; \
        pg8::gemm_phase<pg8::EpiSwiglu, pg8::GroupedOrder<true>, true, true>(C.lds, g, S, E); } while (0)
#define MOE_GEMM2(layer) do { MOE_MAP(layer); const LAS int* tm_ = (const LAS int*)(C.lds + 131072); const int ntl_ = __builtin_amdgcn_readfirstlane(tm_[320 + 32]); pg8::Gemm g{(const bf16*)(C.ws + WS_G13), (const bf16*)(C.ws + WS_W2), 0, 1024, EH}; \
        pg8::GroupedOrder<false> S{tm_, tm_ + 320, (const int*)(C.ws + WS_LIST), ntl_ * 4, 4, (int)gridDim.x, (int)blockIdx.x, LCAP, EH * 2, (size_t)1024 * 512 * 2}; pg8::EpiStore E{(bf16*)(C.ws + WS_XS), D}; \
        pg8::gemm_phase<pg8::EpiStore, pg8::GroupedOrder<false>, true, true>(C.lds, g, S, E); } while (0)
    if (IN(0)) { phase_prologue(C); SEAM(0); STAMP(0); }
    if (IN(1)) { phase_norm_mix0(C); SEAM(1); STAMP(1); }
    if (IN(2)) { pg8::Gemm g{Hb, (const bf16*)(C.ws + WS_WIN0), TT, MIXW, D}; pg8::StaticOrder S; S.init(TT, MIXW, gridDim.x, blockIdx.x); pg8::EpiStore E{(bf16*)(C.ws + WS_P), MIXW};
        pg8::gemm_phase<pg8::EpiStore, pg8::StaticOrder, true, true, true>(C.lds, g, S, E); SEAM(2); STAMP(2); }
    if (IN(3)) { phase_qkprep(C); SEAM(3); STAMP(3); }
    if (IN(4)) { phase_gmlp_fast(C); phase_attn_fast(C, (char*)lds_raw); SEAM(4); STAMP(4); }
    if (IN(5)) { pg8::Gemm g{Hb, (const bf16*)(C.ws + WS_WOUT0), TT, D, D}; pg8::StaticOrder S; S.init(TT, D, gridDim.x, blockIdx.x); pg8::EpiResid E{P.in[I_X], P.in[I_CTX], (const float*)(C.ws + WS_MOD), XC, 0};
        pg8::gemm_phase<pg8::EpiResid, pg8::StaticOrder, true, true, true>(C.lds, g, S, E); SEAM(5); STAMP(5); }
    if (IN(6)) { phase_router_fast(C, 0, TT); SEAM(6); STAMP(6); }
    if (IN(8)) { MOE_GEMM1(0); SEAM(8); STAMP(8); }
    if (IN(9)) { MOE_GEMM2(0); SEAM(9); STAMP(9); }
    if (IN(10)) { phase_combine_norm_mix1(C); SEAM(10); STAMP(10); }
    if (IN(11)) { pg8::Gemm g{Hb, (const bf16*)(C.ws + WS_WS5IN), TT, 512, D}; pg8::StaticOrder S; S.init(TT, 512, gridDim.x, blockIdx.x); pg8::EpiStore E{(bf16*)(C.ws + WS_U), 512};
        pg8::gemm_phase<pg8::EpiStore, pg8::StaticOrder, true, true, true>(C.lds, g, S, E); SEAM(11); STAMP(11); }
    if (IN(12)) { phase_s5_fast(C); SEAM(12); STAMP(12); }
    if (IN(13)) { pg8::Gemm g{(const bf16*)(C.ws + WS_GS), (const bf16*)(C.ws + WS_WGLU), TL, 512, 512}; pg8::StaticOrder S; S.init(TL, 512, gridDim.x, blockIdx.x); pg8::EpiGlu E{(const bf16*)(C.ws + WS_GS), P.in[I_BGLU], (bf16*)(C.ws + WS_GG)};
        pg8::gemm_phase<pg8::EpiGlu, pg8::StaticOrder, true, true, true>(C.lds, g, S, E); SEAM(13); STAMP(13); }
    if (IN(14)) { pg8::Gemm g{(const bf16*)(C.ws + WS_GG), (const bf16*)(C.ws + WS_WS5OUT), TL, D, 512}; pg8::StaticOrder S; S.init(TL, D, gridDim.x, blockIdx.x); pg8::EpiResid E{P.in[I_X], P.in[I_CTX], (const float*)(C.ws + WS_MOD) + (size_t)17 * 6 * D, XC, 1};
        pg8::gemm_phase<pg8::EpiResid, pg8::StaticOrder, true, true, true>(C.lds, g, S, E); SEAM(14); STAMP(14); }
    if (IN(15)) { phase_router_fast(C, 1, TL); SEAM(15); STAMP(15); }
    if (IN(17)) { MOE_GEMM1(1); SEAM(17); STAMP(17); }
    if (IN(18)) { MOE_GEMM2(1); SEAM(18); STAMP(18); }
    if (IN(19)) { phase_final(C); STAMP(19); }
#if MK_PROBE
    if (blockIdx.x == 0 && C.tid == 0) {
        ts_[8] = ts_[7]; ts_[17] = ts_[16];
        const unsigned long long tA = ts_[PROBE_A_HI + 1] - ts_[PROBE_A_LO], tB = ts_[PROBE_B_HI + 1] - ts_[PROBE_B_LO];
        const unsigned long long spin = 16ull * tA + 1000000ull * ((tB + 500ull) / 1000ull);
        const unsigned long long t0 = __builtin_amdgcn_s_memrealtime();
        while (__builtin_amdgcn_s_memrealtime() - t0 < spin) __builtin_amdgcn_s_sleep(8);
    }
#endif
#undef IN
#undef SEAM
}

extern "C" void kernel_launch(void* const* d_in, const int* in_sizes, int n_in, void* d_out, int out_size, void* d_ws, size_t ws_size, hipStream_t stream) {
    constexpr int LDS_BYTES = 147456;
    static int grid = 0;
    if (grid == 0) {
        if (n_in != 35 || out_size != TL * D || ws_size < WS_END) { fprintf(stderr, "kernel_launch: unexpected shapes (n_in %d out %d ws %zu)\n", n_in, out_size, ws_size); grid = -1; return; }
        int dev = 0, cus = 0;
        if (hipGetDevice(&dev) != hipSuccess || hipDeviceGetAttribute(&cus, hipDeviceAttributeMultiprocessorCount, dev) != hipSuccess) { grid = -1; return; }
        if (hipFuncSetAttribute((const void*)fwd_kernel, hipFuncAttributeMaxDynamicSharedMemorySize, LDS_BYTES) != hipSuccess) { fprintf(stderr, "kernel_launch: hipFuncSetAttribute failed\n"); grid = -1; return; }
        (void)hipGetLastError();
        grid = cus;
    }
    if (grid < 0) return;
    (void)hipMemsetAsync((char*)d_ws + WS_CTL, 0, CTL_BYTES, stream);
    Params p{};
    for (int i = 0; i < 35; ++i) p.in[i] = (const float*)d_in[i];
    p.out = (float*)d_out; p.ws = (unsigned char*)d_ws;
#if MK_ONE_LAUNCH
    p.ph_lo = 0; p.ph_hi = NPHASE;
    hipLaunchKernelGGL(fwd_kernel, dim3(grid), dim3(NTHR), LDS_BYTES, stream, p);
#else
    for (int k = 0; k < NPHASE; ++k) { p.ph_lo = k; p.ph_hi = k + 1; hipLaunchKernelGGL(fwd_kernel, dim3(grid), dim3(NTHR), LDS_BYTES, stream, p); }
#endif
}
```

```cpp
#include <hip/hip_runtime.h>
#include <cstdio>
#include <cstdint>
#include <type_traits>

#ifndef MK_ONE_LAUNCH
#define MK_ONE_LAUNCH 1
#endif
#ifndef MK_SIMPLE_ORDER
#define MK_SIMPLE_ORDER 0
#endif
#ifndef MK_KROT
#define MK_KROT 0
#endif
#ifndef MK_PROBE
#define MK_PROBE 0
#endif
#define PROBE_A_LO 4
#define PROBE_A_HI 4
#define PROBE_B_LO 8
#define PROBE_B_HI 9

constexpr int D = 1024, NB = 16, SEQ = 2048, CTXL = 256;
constexpr int TL = NB * SEQ, TC = NB * CTXL, TT = TL + TC;
constexpr int KVL = CTXL + SEQ;
constexpr int MIXW = 1792, NEXP = 32, EH = 512;
constexpr int NSLOT = 81920;
constexpr float EPS = 1e-6f;
constexpr float QSCALE = 0.125f * 1.4426950408889634f;
constexpr int NTHR = 512, NWAVE = 8;
constexpr float W13_SCALE = 32.f, W2_SCALE = 16.f, G13_SCALE = 4.f;
constexpr int NPHASE = 20;

constexpr size_t MiB = 1u << 20;
constexpr size_t WS_CTL = 0, CTL_BYTES = 1 * MiB;
constexpr size_t WS_MOD = 1 * MiB;
constexpr size_t WS_TAB = 2 * MiB;
constexpr size_t TAB_ROPE = 0, TAB_LAMB = 16384, TAB_BBAR = 65536, TAB_WR = 640 * 1024;
constexpr size_t WS_ROUTE = 3 * MiB;
constexpr size_t RT_E = 0, RT_P = 320 * 1024, RT_W = 640 * 1024, RT_S = 960 * 1024, RT_TILE = 1280 * 1024, RT_NT = 1280 * 1024 + 4096;
constexpr size_t WS_WIN0 = 6 * MiB, WS_WOUT0 = 10 * MiB, WS_WS5IN = 12 * MiB, WS_WGLU = 13 * MiB, WS_WS5OUT = 14 * MiB;
constexpr size_t WS_WSP = 15 * MiB;
constexpr size_t WS_W13 = 16 * MiB, WS_W2 = 80 * MiB;
constexpr size_t WS_XC = 112 * MiB;
constexpr size_t WS_H = 256 * MiB;
constexpr size_t WS_P = 328 * MiB;
constexpr size_t WS_Q = 454 * MiB, WS_K = 490 * MiB, WS_V = 499 * MiB;
constexpr size_t WS_XS = 328 * MiB;
constexpr size_t WS_G13 = 488 * MiB;
constexpr size_t WS_U = 328 * MiB, WS_GS = 364 * MiB, WS_GG = 396 * MiB, WS_YACC = 428 * MiB;
constexpr size_t WS_LIST = 568 * MiB;
constexpr int LCAP = 36864;
constexpr size_t WS_END = 574 * MiB;
constexpr int CW_CNT = 64;
constexpr int CW_BAR = 4096;

__device__ __forceinline__ int lane_id_now() { int l; asm volatile("v_mbcnt_lo_u32_b32 %0, -1, 0\n\tv_mbcnt_hi_u32_b32 %0, -1, %0\n\ts_nop 0" : "=v"(l)); return l; }
#define STAMP_AT(idx) do { if (MK_PROBE && blockIdx.x == 0 && threadIdx.x == 0) ((volatile __attribute__((address_space(3))) unsigned long long*)(C.lds + 147456 - 512 + 64))[idx] = __builtin_amdgcn_s_memrealtime(); } while (0)
#define LAS __attribute__((address_space(3)))
typedef unsigned short bf16;
typedef unsigned v4u __attribute__((ext_vector_type(4)));
typedef unsigned v2u __attribute__((ext_vector_type(2)));
typedef float f32x4 __attribute__((ext_vector_type(4)));
typedef float f32x2 __attribute__((ext_vector_type(2)));
__device__ __forceinline__ float bf2f(unsigned u) { return __uint_as_float(u << 16); }
typedef __bf16 bf16x2_t __attribute__((ext_vector_type(2)));
__device__ __forceinline__ unsigned pk2(float lo, float hi) { const f32x2 v = {lo, hi}; return __builtin_bit_cast(unsigned, __builtin_convertvector(v, bf16x2_t)); }
__device__ __forceinline__ unsigned f2bf(float f) { return pk2(f, 0.f) & 0xffffu; }
__device__ __forceinline__ float wave_sum(float v) {
#pragma unroll
    for (int o = 1; o < 64; o <<= 1) v += __shfl_xor(v, o);
    return v;
}
__device__ __forceinline__ float wave_max(float v) {
#pragma unroll
    for (int o = 1; o < 64; o <<= 1) v = fmaxf(v, __shfl_xor(v, o));
    return v;
}
__device__ __forceinline__ float gelu_tanh(float x) { const float u2 = -1.5957691216057308f * (x + 0.044715f * x * x * x); return x * __builtin_amdgcn_rcpf(1.f + __expf(u2)); }
__device__ __forceinline__ float sigmoidf_(float x) { return 1.f / (1.f + __expf(-x)); }
__device__ __forceinline__ float silu_(float x) { return x / (1.f + __expf(-x)); }
__device__ __forceinline__ void unpack8(const v4u w, float* f) {
    f[0] = bf2f(w.x & 0xffffu); f[1] = bf2f(w.x >> 16); f[2] = bf2f(w.y & 0xffffu); f[3] = bf2f(w.y >> 16);
    f[4] = bf2f(w.z & 0xffffu); f[5] = bf2f(w.z >> 16); f[6] = bf2f(w.w & 0xffffu); f[7] = bf2f(w.w >> 16);
}

#define XB_TMO      128
#define XB_XCNT(j)  (256  + 64 * (j))
#define XB_XSUB(j)  (1280 + 64 * (j))
#define XB_XGEN(j)  (2304 + 64 * (j))
#define XB_TOP      3328
#define XB_TOPGEN   3392
#define XCD_BAR_WORDS 3456
#define XB_SPIN_CAP (1u << 28)
__device__ __forceinline__ unsigned xb_ld(unsigned* p)              { return __hip_atomic_load(p, __ATOMIC_RELAXED, __HIP_MEMORY_SCOPE_AGENT); }
__device__ __forceinline__ unsigned xb_add(unsigned* p, unsigned v) { return __hip_atomic_fetch_add(p, v, __ATOMIC_RELAXED, __HIP_MEMORY_SCOPE_AGENT); }
__device__ __forceinline__ unsigned xb_xcc_id() { return (unsigned)__builtin_amdgcn_s_getreg((3 << 11) | 20) & 0xFu; }
#define XB_SPIN(cond, bar) do { unsigned _sp = 0; while (cond) { __builtin_amdgcn_s_sleep(1); \
    if ((++_sp & 255u) == 0u) { if (xb_ld(&(bar)[XB_TMO])) break; if (_sp > XB_SPIN_CAP) { atomicAdd(&(bar)[XB_TMO], 1u); break; } } } } while (0)
struct XcdBarrier { unsigned* bar; unsigned x; volatile LAS unsigned* st; };
__device__ __forceinline__ XcdBarrier xcd_barrier_post(unsigned* bar, volatile LAS unsigned* st) {
    XcdBarrier b; b.bar = bar; b.x = xb_xcc_id(); b.st = st;
    if (threadIdx.x == 0) (void)xb_add(&bar[XB_XCNT(b.x)], 1u);
    return b;
}
__device__ __forceinline__ void xcd_barrier_complete(unsigned* bar, unsigned x, unsigned& nloc, unsigned& nx) {
    const unsigned G = gridDim.x * gridDim.y * gridDim.z;
    unsigned sum, cnt, mine, sp = 0u;
    for (;;) {
        sum = 0u; cnt = 0u; mine = 0u;
#pragma unroll
        for (unsigned j = 0; j < 16; ++j) { const unsigned c = xb_ld(&bar[XB_XCNT(j)]); sum += c; cnt += (c > 0u) ? 1u : 0u; mine = (j == x) ? c : mine; }
        if (sum == G) break;
        __builtin_amdgcn_s_sleep(1);
        if ((++sp & 255u) == 0u) { if (xb_ld(&bar[XB_TMO])) break; if (sp > XB_SPIN_CAP) { atomicAdd(&bar[XB_TMO], 1u); break; } }
    }
    nloc = mine > 0u ? mine : 1u; nx = cnt > 0u ? cnt : 1u;
}
__device__ __forceinline__ void xcd_barrier(const XcdBarrier& b) {
    asm volatile("s_waitcnt vmcnt(0)" ::: "memory");
    __syncthreads();
    if (threadIdx.x == 0) {
        unsigned* bar = b.bar;
        __builtin_amdgcn_s_waitcnt(0);
        unsigned nloc = b.st[0], nx = b.st[1];
        if (nloc == 0u) { xcd_barrier_complete(bar, b.x, nloc, nx); b.st[0] = nloc; b.st[1] = nx; }
        const unsigned old = xb_add(&bar[XB_XSUB(b.x)], 1u);
        const unsigned gen = old / nloc;
        if (old + 1u == (gen + 1u) * nloc) {
            __builtin_amdgcn_fence(__ATOMIC_RELEASE, "agent");
            asm volatile("s_waitcnt vmcnt(0)" ::: "memory");
            const unsigned og = xb_add(&bar[XB_TOP], 1u);
            const unsigned tg = og / nx;
            if (og + 1u == (tg + 1u) * nx) xb_add(&bar[XB_TOPGEN], 1u);
            else XB_SPIN(xb_ld(&bar[XB_TOPGEN]) == tg, bar);
            __builtin_amdgcn_fence(__ATOMIC_ACQUIRE, "agent");
            xb_add(&bar[XB_XGEN(b.x)], 1u);
            asm volatile("s_waitcnt vmcnt(0)" ::: "memory");
        } else {
            XB_SPIN(xb_ld(&bar[XB_XGEN(b.x)]) == gen, bar);
            __builtin_amdgcn_fence(__ATOMIC_ACQUIRE, "agent");
            asm volatile("s_waitcnt vmcnt(0)" ::: "memory");
        }
    }
    __syncthreads();
}

namespace pg8 {
#define PG8_LAS __attribute__((address_space(3)))
typedef unsigned short bf16_t;
typedef short bf16x8 __attribute__((ext_vector_type(8)));
typedef float f32x4 __attribute__((ext_vector_type(4)));
typedef unsigned u32x4 __attribute__((ext_vector_type(4)));
typedef int i32x4 __attribute__((ext_vector_type(4)));
typedef unsigned u32x2 __attribute__((ext_vector_type(2)));
constexpr int BM = 256, BK = 64, HALF = 128, HTB = HALF * BK * 2  , STAGE_BYTES = 8 * HTB, NXCD = 8, WGM = 8;

__host__ __device__ __forceinline__ int lds_byte(int r, int c) { const int st = (r >> 4) * 2 + (c >> 5), rr = r & 15, cc = c & 31, ob = rr * 64 + cc * 2; return st * 1024 + (ob ^ (((ob >> 9) & 1) << 5)); }
__host__ __device__ __forceinline__ void stage_rc(int b, int& R, int& C) { const int st = b / 1024, sb = b % 1024, swz = sb ^ (((sb >> 9) & 1) << 5); R = (st >> 1) * 16 + swz / 64; C = (st & 1) * 32 + (swz % 64) / 2; }
__host__ __device__ __forceinline__ int perm32(int rho) { const int n = rho >> 4, i = rho & 15; return 8 * (i >> 2) + 4 * n + (i & 3); }

struct Unit { int pm, pn; size_t bo; int aux; };
struct Gemm { const bf16_t* A; const bf16_t* Bt; int M, N, K; };

struct StaticOrder {
    static constexpr bool GATHER = false;
    int nM, nN, nwg, G, c;
    __host__ __device__ void init(int M, int N, int G_, int c_) { nM = M / BM; nN = N / BM; nwg = nM * nN; G = G_; c = c_; }
    __host__ __device__ bool next(int i, Unit& u) const {
        const long L = (long)i * G + c; if (L >= nwg) return false;
        if (MK_SIMPLE_ORDER) { u.pm = (int)L / nN; u.pn = (int)L % nN; u.bo = 0; u.aux = 0; return true; }
        int wgid = (int)L; { const int q = nwg / NXCD, r = nwg % NXCD, xcd = wgid % NXCD, off = wgid / NXCD; wgid = (xcd < r ? xcd * (q + 1) : r * (q + 1) + (xcd - r) * q) + off; }
        const int nig = WGM * nN, gid = wgid / nig, fm = gid * WGM, gsz = (nM - fm) < WGM ? (nM - fm) : WGM;
        u.pm = fm + ((wgid % nig) % gsz); u.pn = (wgid % nig) / gsz; u.bo = 0; u.aux = 0; return true;
    }
    __device__ __forceinline__ void a_ready(const Unit&) const {}
    __device__ __forceinline__ void done(const Unit&) const {}
};

typedef __bf16 bf16x2_c __attribute__((ext_vector_type(2))); typedef float f32x2_c __attribute__((ext_vector_type(2)));
__device__ __forceinline__ unsigned cvt_pk_bf16(float lo, float hi) { const f32x2_c v = {lo, hi}; return __builtin_bit_cast(unsigned, __builtin_convertvector(v, bf16x2_c)); }
typedef float f32x2 __attribute__((ext_vector_type(2)));
__device__ __forceinline__ f32x2 gelu_pk(f32x2 v) {
    const f32x2 av = __builtin_elementwise_abs(v), d = av * 0.2316418882f + 1.0f;
    f32x2 t; t.x = __builtin_amdgcn_rcpf(d.x); t.y = __builtin_amdgcn_rcpf(d.y);
    f32x2 q = t * 0.5307027145f + (-0.7265760135f); q = q * t + 0.7107068705f; q = q * t + (-0.142248368f); q = q * t + 0.127414796f; q = q * t;
    const f32x2 s = (v * v) * (-0.72134752044f);
    f32x2 e; e.x = __builtin_amdgcn_exp2f(s.x); e.y = __builtin_amdgcn_exp2f(s.y);
    const f32x2 m = v * (q * e), r = v - m;
    f32x2 o; o.x = v.x < 0.f ? m.x : r.x; o.y = v.y < 0.f ? m.y : r.y; return o;
}

template <class Epi, class Sched, bool ALIGN_EPI = false, bool SP2 = false, bool KROT = false, bool FP8 = false>
__device__ __forceinline__ void gemm_phase(PG8_LAS unsigned char* lds, const Gemm g, const Sched& S, const Epi& E, const int wave_id) {
    const int wid = __builtin_amdgcn_readfirstlane(wave_id), lane = lane_id_now(), tid = wid * 64 + lane, wr = wid >> 2, wc = wid & 3, fr = lane & 15, fq = lane >> 4;
    const int K = g.K, nt = K / BK;
    const int kmask = nt - 1, rot = (MK_KROT && KROT) ? (int)((blockIdx.x * 3u + (blockIdx.x >> 3)) & (unsigned)kmask) : 0;
#define PG8_KO(j) ((size_t)(((j) + rot) & kmask) * kstep)
    unsigned voffA[2], voffB[2];
    unsigned vC[2][2], vN[2][2];
#pragma unroll
    for (int i = 0; i < 2; ++i) { int R, C; stage_rc(tid * 16 + i * 8192, R, C); const int Rb = Epi::PERM ? ((R & ~31) + perm32(R & 31)) : R;
        voffA[i] = (unsigned)(R * K + C) * 2u; voffB[i] = (unsigned)(Rb * K + C) * 2u; }
    const size_t kstep = (size_t)(BK * 2);
    const size_t hstep = (size_t)HALF * K * 2;
    const size_t tstep = 2 * hstep;
    const unsigned ldsw = (unsigned)wid * 1024u;
    const int aoff = lds_byte(wr * 64 + fr, fq * 8), boff = lds_byte(wc * 32 + fr, fq * 8);
#define PG8_SA(b, h) (((b) * 2 + (h)) * HTB)
#define PG8_SB(b, h) ((4 + (b) * 2 + (h)) * HTB)
#define PG8_STAGE(bufoff, gbase, voff) do { _Pragma("unroll") for (int _i = 0; _i < 2; ++_i) \
        __builtin_amdgcn_global_load_lds((const unsigned*)((const char*)(gbase) + (voff)[_i]), (PG8_LAS unsigned*)(lds + (bufoff) + ldsw + _i * 8192), 16, 0, 0); } while (0)
#define PG8_STAGE_A(bufoff, gbase, h, nx) do { _Pragma("unroll") for (int _i = 0; _i < 2; ++_i) { \
        const unsigned _vo = Sched::GATHER ? ((nx) ? vN[h][_i] : vC[h][_i]) : (unsigned)((h) * hstep) + voffA[_i]; \
        __builtin_amdgcn_global_load_lds((const unsigned*)((const char*)(gbase) + _vo), (PG8_LAS unsigned*)(lds + (bufoff) + ldsw + _i * 8192), 16, 0, 0); } } while (0)
#define PG8_LDA(dst, b, h) do { _Pragma("unroll") for (int m = 0; m < 4; ++m) { if constexpr (FP8) { dst[m].lo = *(const PG8_LAS i32x4*)(lds + PG8_SA(b, h) + aoff + m * 2048); dst[m].hi = *(const PG8_LAS i32x4*)(lds + PG8_SA(b, h) + aoff + m * 2048 + 1024); } \
        else { _Pragma("unroll") for (int k = 0; k < 2; ++k) dst[m][k] = *(const PG8_LAS bf16x8*)(lds + PG8_SA(b, h) + aoff + m * 2048 + k * 1024); } } } while (0)
#define PG8_LDB(dst, b, h) do { _Pragma("unroll") for (int n = 0; n < 2; ++n) { if constexpr (FP8) { dst[n].lo = *(const PG8_LAS i32x4*)(lds + PG8_SB(b, h) + boff + n * 2048); dst[n].hi = *(const PG8_LAS i32x4*)(lds + PG8_SB(b, h) + boff + n * 2048 + 1024); } \
        else { _Pragma("unroll") for (int k = 0; k < 2; ++k) dst[n][k] = *(const PG8_LAS bf16x8*)(lds + PG8_SB(b, h) + boff + n * 2048 + k * 1024); } } } while (0)
#define PG8_CAT(x0, x1) __builtin_shufflevector(__builtin_bit_cast(i32x4, x0), __builtin_bit_cast(i32x4, x1), 0, 1, 2, 3, 4, 5, 6, 7)
#define PG8_MMA(ai, bj, At, Bt) do { __builtin_amdgcn_s_setprio(1); \
        if constexpr (FP8) { _Pragma("unroll") for (int m = 0; m < 4; ++m) _Pragma("unroll") for (int n = 0; n < 2; ++n) \
            acc[ai][bj][m][n] = __builtin_amdgcn_mfma_scale_f32_16x16x128_f8f6f4(Bt[n], At[m], acc[ai][bj][m][n], 0, 0, 0, 127, 0, 127); } \
        if constexpr (FP8) { asm volatile("" : "+v"(acc[ai][bj][0][0]), "+v"(acc[ai][bj][0][1]), "+v"(acc[ai][bj][1][0]), "+v"(acc[ai][bj][1][1]), "+v"(acc[ai][bj][2][0]), "+v"(acc[ai][bj][2][1]), "+v"(acc[ai][bj][3][0]), "+v"(acc[ai][bj][3][1])); }     \
        else { _Pragma("unroll") for (int m = 0; m < 4; ++m) _Pragma("unroll") for (int n = 0; n < 2; ++n) _Pragma("unroll") for (int k = 0; k < 2; ++k) \
            acc[ai][bj][m][n] = __builtin_amdgcn_mfma_f32_16x16x32_bf16(Bt[n][k], At[m][k], acc[ai][bj][m][n], 0, 0, 0); } \
        __builtin_amdgcn_s_setprio(0); } while (0)
#define PG8_WAIT_V(n) asm volatile("s_waitcnt vmcnt(" #n ")" ::: "memory")
#define PG8_WAIT_L(n) asm volatile("s_waitcnt lgkmcnt(" #n ")" ::: "memory")
#define PG8_BAR __builtin_amdgcn_s_barrier()
#define PG8_SCHED __builtin_amdgcn_sched_barrier(0)
    Unit cur, nxt; int ui = 0;
    if (!S.next(0, cur)) return;
    f32x4 acc[2][2][4][2];
#pragma unroll
    for (int a = 0; a < 2; ++a)
#pragma unroll
        for (int b = 0; b < 2; ++b)
#pragma unroll
            for (int m = 0; m < 4; ++m)
#pragma unroll
                for (int n = 0; n < 2; ++n) acc[a][b][m][n] = (f32x4){0.f, 0.f, 0.f, 0.f};
    typedef int i32x8 __attribute__((ext_vector_type(8)));
    typedef int i32x8 __attribute__((ext_vector_type(8)));
    typename std::conditional<FP8, i32x8[4], bf16x8[4][2]>::type At; typename std::conditional<FP8, i32x8[2], bf16x8[2][2]>::type B0, B1;
    const char* cA = (const char*)g.A + (Sched::GATHER ? (size_t)0 : (size_t)cur.pm * tstep); const char* cB = (const char*)g.Bt + cur.bo + (size_t)cur.pn * tstep;
    S.a_ready(cur);
#define PG8_VOFF(dst, un) do { _Pragma("unroll") for (int _h = 0; _h < 2; ++_h) _Pragma("unroll") for (int _i = 0; _i < 2; ++_i) { int R_, C_; stage_rc(tid * 16 + _i * 8192, R_, C_); dst[_h][_i] = S.a_off(un, _h * HALF + R_) + (unsigned)C_ * 2u; } } while (0)
    if constexpr (Sched::GATHER) { PG8_VOFF(vC, cur); }
    if constexpr (SP2) {
        PG8_STAGE(PG8_SB(0, 0), cB + PG8_KO(0), voffB); PG8_STAGE(PG8_SB(0, 1), cB + hstep + PG8_KO(0), voffB); PG8_STAGE_A(PG8_SA(0, 0), cA + PG8_KO(0), 0, false); PG8_STAGE_A(PG8_SA(0, 1), cA + PG8_KO(0), 1, false);
        if (wr == 1) PG8_BAR;
        PG8_WAIT_V(2); PG8_BAR;
        PG8_STAGE(PG8_SB(1, 0), cB + PG8_KO(1), voffB); PG8_STAGE_A(PG8_SA(1, 0), cA + PG8_KO(1), 0, false); PG8_STAGE(PG8_SB(1, 1), cB + hstep + PG8_KO(1), voffB);
        PG8_WAIT_V(6); PG8_BAR;
    } else {
        PG8_STAGE(PG8_SB(0, 0), cB, voffB); PG8_STAGE_A(PG8_SA(0, 0), cA, 0, false); PG8_STAGE(PG8_SB(0, 1), cB + hstep, voffB); PG8_STAGE_A(PG8_SA(0, 1), cA, 1, false);
        if (wr == 1) PG8_BAR;
        PG8_WAIT_V(4); PG8_BAR;
        PG8_STAGE(PG8_SB(1, 0), cB + PG8_KO(1), voffB); PG8_STAGE_A(PG8_SA(1, 0), cA + PG8_KO(1), 0, false); PG8_STAGE(PG8_SB(1, 1), cB + hstep + PG8_KO(1), voffB);
        PG8_WAIT_V(6); PG8_BAR;
    }
    for (;;) {
        const bool has_next = S.next(ui + 1, nxt);
        if constexpr (Sched::GATHER) { if (has_next) { PG8_VOFF(vN, nxt); } else { vN[0][0] = vC[0][0]; vN[0][1] = vC[0][1]; vN[1][0] = vC[1][0]; vN[1][1] = vC[1][1]; } }
        const char* nA = (has_next && !Sched::GATHER) ? (const char*)g.A + (size_t)nxt.pm * tstep : cA; const char* nB = has_next ? (const char*)g.Bt + nxt.bo + (size_t)nxt.pn * tstep : cB;
#pragma unroll 1
        for (int t = 0; t < nt; t += 2) {
            const bool last = (t == nt - 2);
            const char* a1 = cA + PG8_KO(t + 1);
            const char* a2 = last ? nA + PG8_KO(0) : cA + PG8_KO(t + 2); const char* b2 = last ? nB + PG8_KO(0) : cB + PG8_KO(t + 2);
            const char* a3 = last ? nA + PG8_KO(1) : cA + PG8_KO(t + 3); const char* b3 = last ? nB + PG8_KO(1) : cB + PG8_KO(t + 3);
            if (last && has_next) S.a_ready(nxt);
            if constexpr (SP2) {
            PG8_LDB(B0, 0, 0); PG8_LDB(B1, 0, 1); PG8_SCHED; PG8_LDA(At, 0, 0); PG8_STAGE_A(PG8_SA(1, 1), a1, 1, false);
            PG8_WAIT_V(8); PG8_WAIT_L(0); PG8_BAR; PG8_MMA(0, 0, At, B0); PG8_MMA(0, 1, At, B1); PG8_BAR; PG8_SCHED;
            PG8_LDA(At, 0, 1); PG8_STAGE(PG8_SB(0, 0), b2, voffB); PG8_STAGE(PG8_SB(0, 1), b2 + hstep, voffB); PG8_STAGE_A(PG8_SA(0, 0), a2, 0, last);
            PG8_WAIT_V(8); PG8_WAIT_L(0); PG8_BAR; PG8_MMA(1, 0, At, B0); PG8_MMA(1, 1, At, B1); PG8_BAR; PG8_SCHED;
            PG8_LDB(B0, 1, 0); PG8_LDB(B1, 1, 1); PG8_SCHED; PG8_LDA(At, 1, 0); PG8_STAGE_A(PG8_SA(0, 1), a2, 1, last);
            PG8_WAIT_V(8); PG8_WAIT_L(0); PG8_BAR; PG8_MMA(0, 0, At, B0); PG8_MMA(0, 1, At, B1); PG8_BAR; PG8_SCHED;
            PG8_LDA(At, 1, 1); PG8_STAGE(PG8_SB(1, 0), b3, voffB); PG8_STAGE(PG8_SB(1, 1), b3 + hstep, voffB); PG8_STAGE_A(PG8_SA(1, 0), a3, 0, last);
            PG8_WAIT_V(8); PG8_WAIT_L(0); PG8_BAR; PG8_MMA(1, 0, At, B0); PG8_MMA(1, 1, At, B1); PG8_BAR; PG8_SCHED;
            } else {
            PG8_LDB(B0, 0, 0); PG8_SCHED; PG8_LDA(At, 0, 0); PG8_STAGE_A(PG8_SA(1, 1), a1, 1, false);
            PG8_WAIT_L(8); PG8_BAR; PG8_WAIT_L(0); PG8_MMA(0, 0, At, B0); PG8_BAR; PG8_SCHED;
            PG8_LDB(B1, 0, 1); PG8_STAGE(PG8_SB(0, 0), b2, voffB);
            PG8_BAR; PG8_WAIT_L(0); PG8_MMA(0, 1, At, B1); PG8_BAR;
            PG8_LDA(At, 0, 1); PG8_STAGE_A(PG8_SA(0, 0), a2, 0, last);
            PG8_BAR; PG8_WAIT_L(0); PG8_MMA(1, 0, At, B0); PG8_BAR; PG8_SCHED;
            PG8_STAGE(PG8_SB(0, 1), b2 + hstep, voffB);
            PG8_WAIT_V(6); PG8_BAR; PG8_MMA(1, 1, At, B1); PG8_BAR;
            PG8_LDB(B0, 1, 0); PG8_SCHED; PG8_LDA(At, 1, 0); PG8_STAGE_A(PG8_SA(0, 1), a2, 1, last);
            PG8_WAIT_L(8); PG8_BAR; PG8_WAIT_L(0); PG8_MMA(0, 0, At, B0); PG8_BAR; PG8_SCHED;
            PG8_LDB(B1, 1, 1); PG8_STAGE(PG8_SB(1, 0), b3, voffB);
            PG8_BAR; PG8_WAIT_L(0); PG8_MMA(0, 1, At, B1); PG8_BAR;
            PG8_LDA(At, 1, 1); PG8_STAGE_A(PG8_SA(1, 0), a3, 0, last);
            PG8_BAR; PG8_WAIT_L(0); PG8_MMA(1, 0, At, B0); PG8_BAR; PG8_SCHED;
            PG8_STAGE(PG8_SB(1, 1), b3 + hstep, voffB);
            PG8_WAIT_V(6); PG8_BAR; PG8_MMA(1, 1, At, B1); PG8_BAR;
            }
        }
        if constexpr (ALIGN_EPI) { if (wr == 0) PG8_BAR; }
        if constexpr (!Epi::AFTER_DRAIN) { E(acc, cur, wr, wc, fr, fq); S.done(cur); }
        if (!has_next) break;
#pragma unroll
        for (int a = 0; a < 2; ++a)
#pragma unroll
            for (int b = 0; b < 2; ++b)
#pragma unroll
                for (int m = 0; m < 4; ++m)
#pragma unroll
                    for (int n = 0; n < 2; ++n) acc[a][b][m][n] = (f32x4){0.f, 0.f, 0.f, 0.f};
        cur = nxt; cA = nA; cB = nB; ++ui;
        if constexpr (Sched::GATHER) { vC[0][0] = vN[0][0]; vC[0][1] = vN[0][1]; vC[1][0] = vN[1][0]; vC[1][1] = vN[1][1]; }
        if constexpr (ALIGN_EPI) { if (wr == 1) PG8_BAR; }
    }
    PG8_WAIT_V(0);
    if constexpr (!ALIGN_EPI) { if (wr == 0) PG8_BAR; }
    PG8_BAR;
    if constexpr (Epi::AFTER_DRAIN) { E.fused(acc, cur, wr, wc, fr, fq, lds, wid, lane); S.done(cur); }
#undef PG8_VOFF
#undef PG8_KO
#undef PG8_SA
#undef PG8_SB
#undef PG8_STAGE
#undef PG8_STAGE_A
#undef PG8_LDA
#undef PG8_LDB
#undef PG8_MMA
#undef PG8_CAT
#undef PG8_WAIT_V
#undef PG8_WAIT_L
#undef PG8_BAR
#undef PG8_SCHED
}
}

namespace pg8 {
template <bool GATHER_>
struct GroupedOrder {
    static constexpr bool GATHER = GATHER_;
    const PG8_LAS int* tmap; const PG8_LAS int* cntl; const int* list; int nU, nN, G, c, lcap, rowbytes; size_t estride;
    __device__ __forceinline__ bool next(int i, Unit& u) const { const long L = (long)i * G + c; if (L >= nU) return false; const int t = (int)L / nN; const int m = __builtin_amdgcn_readfirstlane(tmap[t]);
        u.pm = t; u.pn = (int)L % nN; u.bo = (size_t)(m & 255) * estride; u.aux = m; return true; }
    __device__ __forceinline__ unsigned a_off(const Unit& u, int R) const { const int e = u.aux & 255, p0 = u.aux >> 8, ce = cntl[e]; int p = p0 + R; p = p < ce ? p : ce - 1; return (unsigned)list[(size_t)e * lcap + p] * (unsigned)rowbytes; }
    __device__ __forceinline__ void a_ready(const Unit&) const {}
    __device__ __forceinline__ void done(const Unit&) const {}
};
__device__ __forceinline__ u32x4 pack8(const f32x4 a, const f32x4 b) { u32x4 w; w.x = cvt_pk_bf16(a[0], a[1]); w.y = cvt_pk_bf16(a[2], a[3]); w.z = cvt_pk_bf16(b[0], b[1]); w.w = cvt_pk_bf16(b[2], b[3]); return w; }
struct EpiStore {
    static constexpr bool PERM = true, AFTER_DRAIN = false; bf16_t* O; int ldc;
    __device__ __forceinline__ void operator()(const f32x4 (&acc)[2][2][4][2], const Unit& u, int wr, int wc, int fr, int fq) const {
        const int row0 = u.pm * BM + wr * 64 + fr, col0 = u.pn * BM + wc * 32 + 8 * fq;
#pragma unroll
        for (int ai = 0; ai < 2; ++ai)
#pragma unroll
            for (int m = 0; m < 4; ++m) { bf16_t* rowp = O + (size_t)(row0 + ai * HALF + m * 16) * ldc + col0;
#pragma unroll
                for (int bj = 0; bj < 2; ++bj) *(u32x4*)(rowp + bj * HALF) = pack8(acc[ai][bj][m][0], acc[ai][bj][m][1]); }
    }
};
__device__ __forceinline__ f32x4 silu4(const f32x4 v) { f32x4 r;
#pragma unroll
    for (int i = 0; i < 4; ++i) r[i] = v[i] * __builtin_amdgcn_rcpf(1.f + __expf(-v[i])); return r; }
__device__ __forceinline__ f32x4 sigm4(const f32x4 v) { f32x4 r;
#pragma unroll
    for (int i = 0; i < 4; ++i) r[i] = __builtin_amdgcn_rcpf(1.f + __expf(-v[i])); return r; }
__device__ __forceinline__ u32x2 pack8_fp8(const f32x4 a, const f32x4 b) { int w0 = 0, w1 = 0;
    w0 = __builtin_amdgcn_cvt_pk_fp8_f32(a[0], a[1], w0, false); w0 = __builtin_amdgcn_cvt_pk_fp8_f32(a[2], a[3], w0, true);
    w1 = __builtin_amdgcn_cvt_pk_fp8_f32(b[0], b[1], w1, false); w1 = __builtin_amdgcn_cvt_pk_fp8_f32(b[2], b[3], w1, true); u32x2 r; r.x = (unsigned)w0; r.y = (unsigned)w1; return r; }
struct EpiSwiglu {
    static constexpr bool PERM = true, AFTER_DRAIN = false; bf16_t* G; float s;
    __device__ __forceinline__ void operator()(const f32x4 (&acc)[2][2][4][2], const Unit& u, int wr, int wc, int, int) const {
        const int ln = lane_id_now(), fr = ln & 15, fq = ln >> 4;
        const int row0 = u.pm * BM + wr * 64 + fr, col0 = u.pn * HALF + wc * 32 + 8 * fq;
#pragma unroll
        for (int ai = 0; ai < 2; ++ai)
#pragma unroll
            for (int m = 0; m < 4; ++m) *(u32x4*)(G + (size_t)(row0 + ai * HALF + m * 16) * 512 + col0) = pack8(silu4(acc[ai][0][m][0] * s) * (acc[ai][1][m][0] * s), silu4(acc[ai][0][m][1] * s) * (acc[ai][1][m][1] * s));
    }
};
struct EpiStoreScaled {
    static constexpr bool PERM = true, AFTER_DRAIN = false; bf16_t* O; int ldc; float s;
    __device__ __forceinline__ void operator()(const f32x4 (&acc)[2][2][4][2], const Unit& u, int wr, int wc, int fr, int fq) const {
        int row0 = u.pm * BM + wr * 64 + fr; const int col0 = u.pn * BM + wc * 32 + 8 * fq;
        asm volatile("" : "+v"(row0));
#pragma unroll
        for (int ai = 0; ai < 2; ++ai)
#pragma unroll
            for (int m = 0; m < 4; ++m) { bf16_t* rowp = O + (size_t)(row0 + ai * HALF + m * 16) * ldc + col0;
#pragma unroll
                for (int bj = 0; bj < 2; ++bj) *(u32x4*)(rowp + bj * HALF) = pack8(acc[ai][bj][m][0] * s, acc[ai][bj][m][1] * s); }
    }
};
__device__ __forceinline__ void unpack8f(const u32x4 w, f32x4& a, f32x4& b) {
    a[0] = __uint_as_float(w.x << 16); a[1] = __uint_as_float(w.x & 0xffff0000u); a[2] = __uint_as_float(w.y << 16); a[3] = __uint_as_float(w.y & 0xffff0000u);
    b[0] = __uint_as_float(w.z << 16); b[1] = __uint_as_float(w.z & 0xffff0000u); b[2] = __uint_as_float(w.w << 16); b[3] = __uint_as_float(w.w & 0xffff0000u); }
struct EpiGlu {
    static constexpr bool PERM = true, AFTER_DRAIN = false; const bf16_t* GS; const float* b; bf16_t* GG;
    __device__ __forceinline__ void operator()(const f32x4 (&acc)[2][2][4][2], const Unit& u, int wr, int wc, int fr, int fq) const {
        const int row0 = u.pm * BM + wr * 64 + fr, col0 = u.pn * BM + wc * 32 + 8 * fq;
#pragma unroll
        for (int bj = 0; bj < 2; ++bj) { const int c = col0 + bj * HALF; const f32x4 b0 = *(const f32x4*)(b + c), b1 = *(const f32x4*)(b + c + 4);
#pragma unroll
            for (int ai = 0; ai < 2; ++ai)
#pragma unroll
                for (int m = 0; m < 4; ++m) { const size_t o = (size_t)(row0 + ai * HALF + m * 16) * 512 + c; f32x4 g0, g1; unpack8f(*(const u32x4*)(GS + o), g0, g1);
                    *(u32x4*)(GG + o) = pack8(g0 * sigm4(acc[ai][bj][m][0] + b0), g1 * sigm4(acc[ai][bj][m][1] + b1)); } }
    }
};
struct EpiResid {
    static constexpr bool PERM = true, AFTER_DRAIN = false;
    const float* x; const float* ctx; const float* mod; bf16_t* XC; int inplace;
    __device__ __forceinline__ void operator()(const f32x4 (&acc)[2][2][4][2], const Unit& u, int wr, int wc, int fr, int fq) const {
        const int R0 = u.pm * BM; const int ci = R0 < 32768 ? (R0 >> 11) : 16;
        const float* base = R0 < 32768 ? x + (size_t)R0 * 1024 : ctx + (size_t)(R0 - 32768) * 1024;
        bf16_t* out = XC + (size_t)R0 * 1024; const float* gate = mod + ((size_t)ci * 6 + 2) * 1024;
        const int rl0 = wr * 64 + fr, col0 = u.pn * BM + wc * 32 + 8 * fq;
#pragma unroll
        for (int bj = 0; bj < 2; ++bj) { const int c = col0 + bj * HALF; const f32x4 g0 = *(const f32x4*)(gate + c), g1 = *(const f32x4*)(gate + c + 4);
#pragma unroll
            for (int ai = 0; ai < 2; ++ai)
#pragma unroll
                for (int m = 0; m < 4; ++m) { const size_t o = (size_t)(rl0 + ai * HALF + m * 16) * 1024 + c; f32x4 b0, b1;
                    if (inplace) unpack8f(*(const u32x4*)(out + o), b0, b1); else { b0 = *(const f32x4*)(base + o); b1 = *(const f32x4*)(base + o + 4); }
                    *(u32x4*)(out + o) = pack8(b0 + g0 * acc[ai][bj][m][0], b1 + g1 * acc[ai][bj][m][1]); } }
    }
};
}

#include <hip/hip_bf16.h>
#include <cmath>
namespace attn_body {
using bf16=__hip_bfloat16;
using bf16x8=__attribute__((ext_vector_type(8)))short;
using s16x4=__attribute__((ext_vector_type(4)))short;
using f32x16=__attribute__((ext_vector_type(16)))float;
using u32x4=__attribute__((ext_vector_type(4)))unsigned;
constexpr int D=64,QP=512,KP=128,OP=1024;
constexpr int NW=8,QBLK=32,QB=QBLK*NW,KVBLK=64;
constexpr int ATTN_UNIT_ROWS=QB;
__device__ __forceinline__ int crow(int r,int hi){return (r&3)+8*(r>>2)+4*hi;}
#define SBAR() __builtin_amdgcn_sched_barrier(0)
__device__ __forceinline__ void cmask(f32x16&p0,f32x16&p1,int jb,int qrel,int hi){
  const float NEG=-INFINITY; int kb=64*jb+4*hi;
  #pragma unroll
  for(int r=0;r<16;++r){int kv=kb+(r&3)+8*(r>>2); if(kv>qrel)p0[r]=NEG; if(kv+32>qrel)p1[r]=NEG;}
}

constexpr int NSLOT=3, SLOTB=8192;
constexpr int LDS_K=0, LDS_V=NSLOT*SLOTB, LDS_WS=2*NSLOT*SLOTB, LDS_OST=LDS_WS+NW*64*4, LDS_BYTES=LDS_OST+NW*4096;
constexpr float C2=0.125f*1.4426950408889634f;
__device__ __forceinline__ void glds16(const void*gsrc,unsigned lds_dst){unsigned keep;
  asm volatile("s_mov_b32 %0, m0\n\ts_mov_b32 m0, %2\n\ts_nop 0\n\tglobal_load_lds_dwordx4 %1, off\n\ts_mov_b32 m0, %0":"=&s"(keep):"v"(gsrc),"s"(lds_dst):"memory");}
__device__ __forceinline__ float max3f(float a,float b,float c){float r;asm("v_max3_f32 %0, %1, %2, %3":"=v"(r):"v"(a),"v"(b),"v"(c));return r;}
__device__ __forceinline__ float max2f(float a,float b){float r;asm("v_max_f32_e32 %0, %1, %2":"=v"(r):"v"(a),"v"(b));return r;}
__device__ __forceinline__ float fadd_s(float a,float b){float r;asm("v_add_f32_e32 %0, %1, %2":"=v"(r):"v"(a),"v"(b));return r;}
__device__ __forceinline__ float fsub_s(float a,float b){float r;asm("v_sub_f32_e32 %0, %1, %2":"=v"(r):"v"(a),"v"(b));return r;}
typedef float f32x2_t __attribute__((ext_vector_type(2))); typedef __bf16 bf16x2_t __attribute__((ext_vector_type(2)));
__device__ __forceinline__ unsigned cvtpk_s(float lo,float hi){f32x2_t v={lo,hi};bf16x2_t b=__builtin_convertvector(v,bf16x2_t);return __builtin_bit_cast(unsigned,b);}
#define WAIT_BAR(N) asm volatile("s_waitcnt vmcnt(" #N ") lgkmcnt(0)\n\ts_barrier":::"memory")

__device__ __forceinline__ void qkt(f32x16&p0,f32x16&p1,const char*Kslot,const bf16x8*qr,const f32x16&negm,int r32,int hi){
  const char*kb=Kslot+hi*1024+r32*16;
  #pragma unroll
  for(int d0=0;d0<4;++d0){
    const bf16x8 b0=*reinterpret_cast<const bf16x8*>(kb+d0*2048);
    const bf16x8 b1=*reinterpret_cast<const bf16x8*>(kb+d0*2048+512);
    if(d0==0){p0=__builtin_amdgcn_mfma_f32_32x32x16_bf16(b0,qr[0],negm,0,0,0);p1=__builtin_amdgcn_mfma_f32_32x32x16_bf16(b1,qr[0],negm,0,0,0);}
    else{p0=__builtin_amdgcn_mfma_f32_32x32x16_bf16(b0,qr[d0],p0,0,0,0);p1=__builtin_amdgcn_mfma_f32_32x32x16_bf16(b1,qr[d0],p1,0,0,0);}}
}
typedef __attribute__((address_space(3))) const char* lds_cptr;
typedef short v4i16_t __attribute__((ext_vector_type(4)));
__device__ __forceinline__ void kload8(bf16x8*kf,lds_cptr kp){
  kf[0]=*(const __attribute__((address_space(3))) bf16x8*)(kp);      kf[1]=*(const __attribute__((address_space(3))) bf16x8*)(kp+512);
  kf[2]=*(const __attribute__((address_space(3))) bf16x8*)(kp+2048); kf[3]=*(const __attribute__((address_space(3))) bf16x8*)(kp+2560);
  kf[4]=*(const __attribute__((address_space(3))) bf16x8*)(kp+4096); kf[5]=*(const __attribute__((address_space(3))) bf16x8*)(kp+4608);
  kf[6]=*(const __attribute__((address_space(3))) bf16x8*)(kp+6144); kf[7]=*(const __attribute__((address_space(3))) bf16x8*)(kp+6656);
}
__device__ __forceinline__ void kload2(bf16x8*kf,lds_cptr kp,int j){ kf[2*j]=*(const __attribute__((address_space(3))) bf16x8*)(kp+j*2048); kf[2*j+1]=*(const __attribute__((address_space(3))) bf16x8*)(kp+j*2048+512); }
__device__ __forceinline__ s16x4 vtr(lds_cptr p){ return __builtin_bit_cast(s16x4,__builtin_amdgcn_ds_read_tr16_b64_v4i16((__attribute__((address_space(3))) v4i16_t*)p)); }
__device__ __forceinline__ float rowmax(const f32x16&p0,const f32x16&p1){
  float a=max3f(p0[0],p0[1],p1[0]),b=max3f(p0[2],p0[3],p1[1]);a=max3f(a,p1[2],p1[3]);
  #pragma unroll
  for(int r=4;r<16;r+=4){a=max3f(a,p0[r],p0[r+1]);b=max3f(b,p0[r+2],p0[r+3]);a=max3f(a,p1[r],p1[r+1]);b=max3f(b,p1[r+2],p1[r+3]);}
  const float m=max2f(a,b);
  auto rr=__builtin_amdgcn_permlane32_swap(__float_as_uint(m),__float_as_uint(m),false,false);
  return max2f(__uint_as_float(rr[0]),__uint_as_float(rr[1]));
}
__device__ __forceinline__ void pv(f32x16*o,int vb,bf16x8 pa0,bf16x8 pa1,bf16x8 pa2,bf16x8 pa3){
  #pragma unroll
  for(int d0=0;d0<2;++d0){s16x4 lo[4],hi[4];
    #pragma unroll
    for(int ks=0;ks<4;++ks){
      asm volatile("ds_read_b64_tr_b16 %0,%1 offset:%c2":"=&v"(lo[ks]):"v"(vb),"i"(d0*4096+ks*1024):"memory");
      asm volatile("ds_read_b64_tr_b16 %0,%1 offset:%c2":"=&v"(hi[ks]):"v"(vb),"i"(d0*4096+ks*1024+512):"memory");}
    asm volatile("s_waitcnt lgkmcnt(0)":::"memory");SBAR();
    #define PK(k) (bf16x8){lo[k][0],lo[k][1],lo[k][2],lo[k][3],hi[k][0],hi[k][1],hi[k][2],hi[k][3]}
    o[d0]=__builtin_amdgcn_mfma_f32_32x32x16_bf16(pa0,PK(0),o[d0],0,0,0);
    o[d0]=__builtin_amdgcn_mfma_f32_32x32x16_bf16(pa1,PK(1),o[d0],0,0,0);
    o[d0]=__builtin_amdgcn_mfma_f32_32x32x16_bf16(pa2,PK(2),o[d0],0,0,0);
    o[d0]=__builtin_amdgcn_mfma_f32_32x32x16_bf16(pa3,PK(3),o[d0],0,0,0);
    #undef PK
  }
}

#ifndef ATTN_STORE16
#define ATTN_STORE16(p,v) (*(u32x4*)(p)=(v))
#endif
template<int THRL> __device__ __forceinline__ void attn_unit(const bf16*Q0,const bf16*__restrict__ Kh,const bf16*__restrict__ Vh,bf16*O0,const int NT,char*shm){
  const int tid=threadIdx.x,lane=tid&63,r32=lane&31,hi=lane>>5; const int wid=__builtin_amdgcn_readfirstlane(tid>>6);
  const bf16*Qw=Q0+(long)(wid*QBLK)*QP;
  const unsigned lds0=(unsigned)(uintptr_t)shm;
  float*wsf=(float*)(shm+LDS_WS)+wid*64;
  const bf16*ksrc=Kh+(long)lane*KP+wid*8;
  const bf16*vsrc=Vh+(long)(16*(wid&3)+(lane>>2))*KP+(wid>>2)*32+(lane&3)*8;
  const unsigned kdst=lds0+LDS_K+wid*1024, vdst=lds0+LDS_V+wid*1024;
  #define DMA_K(t,slot) glds16(ksrc+(long)(t)*KVBLK*KP,(unsigned)__builtin_amdgcn_readfirstlane(kdst+(slot)))
  #define DMA_V(t,slot) glds16(vsrc+(long)(t)*KVBLK*KP,(unsigned)__builtin_amdgcn_readfirstlane(vdst+(slot)))
  const int vb0=(int)(lds0+LDS_V)+((lane>>4)&1)*32+(lane&3)*8+(4*hi+((lane&15)>>2))*64;
  const char*Kbase=shm+LDS_K; bf16x8 kf[8];
  const lds_cptr shm3=(lds_cptr)shm; const lds_cptr kp0=shm3+LDS_K+hi*1024+r32*16; const lds_cptr vp0=shm3+LDS_V+((lane>>4)&1)*32+(lane&3)*8+(4*hi+((lane&15)>>2))*64;
  DMA_K(0,0);DMA_V(0,0);DMA_K(1,SLOTB);
  bf16x8 qr[4];
  #pragma unroll
  for(int d0=0;d0<4;++d0)qr[d0]=*reinterpret_cast<const bf16x8*>(&Qw[(long)r32*QP+d0*16+hi*8]);
  float mhat=0.f,l_reg=0.f;f32x16 o[2];o[0]=f32x16{};o[1]=f32x16{};f32x16 negm=f32x16{};asm volatile("":"+v"(negm));
  #define CMASK(P0,P1,t) do{}while(0)
  bool resc=false;
  #define START(P0,P1) do{ const float rm=rowmax(P0,P1); resc=false; \
    { const float dl=rm; mhat=fadd_s(mhat,dl); \
      _Pragma("unroll") for(int r=0;r<16;++r){P0[r]=fsub_s(P0[r],dl);P1[r]=fsub_s(P1[r],dl);} \
      _Pragma("unroll") for(int r=0;r<16;++r)negm[r]=-mhat; asm volatile("":"+v"(negm)); } \
    _Pragma("unroll") for(int r=0;r<16;++r)P0[r]=__builtin_amdgcn_exp2f(P0[r]); }while(0)
  #define RESC() do{ if(resc){ asm volatile("s_waitcnt lgkmcnt(0)":::"memory"); \
      _Pragma("unroll") for(int d_=0;d_<2;++d_) _Pragma("unroll") for(int r=0;r<16;++r)o[d_][r]*=wsf[crow(r,hi)]; } }while(0)
  f32x16 pA0,pA1,pB0,pB1;
  int sl_prev=0,sl_cur=0,sl_next=SLOTB;
  #define ROT() do{sl_prev=sl_cur;sl_cur=sl_next;sl_next=(sl_next==(NSLOT-1)*SLOTB)?0:sl_next+SLOTB;}while(0)
  DMA_K(2,2*SLOTB);
  WAIT_BAR(3);
  qkt(pA0,pA1,Kbase,qr,negm,r32,hi);asm volatile("s_nop 15\n\ts_nop 7":"+v"(pA0),"+v"(pA1));CMASK(pA0,pA1,0);
  START(pA0,pA1);
  _Pragma("unroll") for(int r=0;r<16;++r)pA1[r]=__builtin_amdgcn_exp2f(pA1[r]);
  WAIT_BAR(0);
  DMA_K(3,0);DMA_V(1,SLOTB);
  ROT();
  kload8(kf,kp0+sl_cur);
  WAIT_BAR(2);
  s16x4 vlo[8],vhi[8]; u32x4 pw0,pw1,pw2,pw3;
  #define PKW(P,B) cvtpk_s(P[B],P[B+1])
  #define PAF(k) __builtin_bit_cast(bf16x8,pw##k)
  #define VFR(i) (bf16x8){vlo[i][0],vlo[i][1],vlo[i][2],vlo[i][3],vhi[i][0],vhi[i][1],vhi[i][2],vhi[i][3]}
  #define PIN(x) asm volatile("":"+v"(x))
  #define MX3(a,b,c) __builtin_fmaxf(__builtin_fmaxf((a),(b)),(c))
  #define GAPA(MF,A0,A1,A2,A3,W0,W1,PW) do{ MF; sacc+=A0; sacc+=A1; sacc+=A2; sacc+=A3; PIN(sacc); W0; W1; PIN(PW); SBAR(); }while(0)
  #define EX(v) __builtin_amdgcn_exp2f(v)
  #define GAPB(MF,X,B) do{ MF; X[B]=EX(X[B]); X[B+1]=EX(X[B+1]); X[B+2]=EX(X[B+2]); X[B+3]=EX(X[B+3]); PIN(X); SBAR(); }while(0)
  #define VRD(i) do{ vlo[i]=vtr(vp_+(((i)>>2)*4096+((i)&3)*1024)); vhi[i]=vtr(vp_+(((i)>>2)*4096+((i)&3)*1024+512)); }while(0)
  #define KRD(G,j) do{ if(G){ kload2(kf,kp0+sl_next,j); SBAR(); } }while(0)
  #define STEP(C0,C1,P0,P1,t,GK,GV,GL) do{ SBAR(); \
    const lds_cptr vp_=vp0+sl_prev; \
    VRD(0); SBAR(); float sacc=(P0[0]+P0[1]); \
    GAPA(C0=__builtin_amdgcn_mfma_f32_32x32x16_bf16(kf[0],qr[0],negm,0,0,0), P0[2],P0[3],P0[4],P0[5],     pw0[0]=PKW(P0,0), pw0[1]=PKW(P0,2), pw0); \
    VRD(4); SBAR(); GAPA(C1=__builtin_amdgcn_mfma_f32_32x32x16_bf16(kf[1],qr[0],negm,0,0,0), P0[6],P0[7],P0[8],P0[9],     pw0[2]=PKW(P0,4), pw0[3]=PKW(P0,6), pw0); \
    VRD(1); SBAR(); GAPA(C0=__builtin_amdgcn_mfma_f32_32x32x16_bf16(kf[2],qr[1],C0,0,0,0),   P0[10],P0[11],P0[12],P0[13], pw1[0]=PKW(P0,8), pw1[1]=PKW(P0,10), pw1); \
    VRD(5); SBAR(); GAPA(C1=__builtin_amdgcn_mfma_f32_32x32x16_bf16(kf[3],qr[1],C1,0,0,0),   P0[14],P0[15],P1[0],P1[1],   pw1[2]=PKW(P0,12),pw1[3]=PKW(P0,14), pw1); \
    VRD(2); SBAR(); GAPA(C0=__builtin_amdgcn_mfma_f32_32x32x16_bf16(kf[4],qr[2],C0,0,0,0),   P1[2],P1[3],P1[4],P1[5],     pw2[0]=PKW(P1,0), pw2[1]=PKW(P1,2), pw2); \
    VRD(6); SBAR(); GAPA(C1=__builtin_amdgcn_mfma_f32_32x32x16_bf16(kf[5],qr[2],C1,0,0,0),   P1[6],P1[7],P1[8],P1[9],     pw2[2]=PKW(P1,4), pw2[3]=PKW(P1,6), pw2); \
    VRD(3); SBAR(); GAPA(C0=__builtin_amdgcn_mfma_f32_32x32x16_bf16(kf[6],qr[3],C0,0,0,0),   P1[10],P1[11],P1[12],P1[13], pw3[0]=PKW(P1,8), pw3[1]=PKW(P1,10), pw3); \
    VRD(7); SBAR(); GAPA(C1=__builtin_amdgcn_mfma_f32_32x32x16_bf16(kf[7],qr[3],C1,0,0,0),   P1[14],P1[15],0.f,0.f,       pw3[2]=PKW(P1,12),pw3[3]=PKW(P1,14), pw3); \
    l_reg+=sacc; \
    if(GK){DMA_K((t)+3,sl_cur);} if(GV){DMA_V((t)+1,sl_next);} \
    CMASK(C0,C1,t); \
    { float a=MX3(C0[0],C0[1],C1[0]),b=MX3(C0[2],C0[3],C1[1]); a=MX3(a,C1[2],C1[3]); \
      _Pragma("unroll") for(int r=4;r<16;r+=4){a=MX3(a,C0[r],C0[r+1]);b=MX3(b,C0[r+2],C0[r+3]);a=MX3(a,C1[r],C1[r+1]);b=MX3(b,C1[r+2],C1[r+3]);} \
      float rm=__builtin_fmaxf(a,b); { auto rr=__builtin_amdgcn_permlane32_swap(__float_as_uint(rm),__float_as_uint(rm),false,false); rm=__builtin_fmaxf(__uint_as_float(rr[0]),__uint_as_float(rr[1])); } \
      resc=false; \
      if(__builtin_expect(__any(rm>(float)THRL),0)){ const float dl=__builtin_fmaxf(rm,0.f); mhat+=dl; \
        _Pragma("unroll") for(int r=0;r<16;++r){C0[r]-=dl;C1[r]-=dl;} \
        _Pragma("unroll") for(int r=0;r<16;++r)negm[r]=-mhat; asm volatile("":"+v"(negm)); \
        const float f=__builtin_amdgcn_exp2f(-dl); l_reg*=f; if(hi==0)wsf[r32]=f; resc=true; } } \
    SBAR(); \
    GAPB(o[0]=__builtin_amdgcn_mfma_f32_32x32x16_bf16(PAF(0),VFR(0),o[0],0,0,0), C0,0); \
    GAPB(o[1]=__builtin_amdgcn_mfma_f32_32x32x16_bf16(PAF(0),VFR(4),o[1],0,0,0), C0,4); \
    KRD(GL,0); GAPB(o[0]=__builtin_amdgcn_mfma_f32_32x32x16_bf16(PAF(1),VFR(1),o[0],0,0,0), C0,8); \
    KRD(GL,1); GAPB(o[1]=__builtin_amdgcn_mfma_f32_32x32x16_bf16(PAF(1),VFR(5),o[1],0,0,0), C0,12); \
    KRD(GL,2); GAPB(o[0]=__builtin_amdgcn_mfma_f32_32x32x16_bf16(PAF(2),VFR(2),o[0],0,0,0), C1,0); \
    KRD(GL,3); GAPB(o[1]=__builtin_amdgcn_mfma_f32_32x32x16_bf16(PAF(2),VFR(6),o[1],0,0,0), C1,4); \
    GAPB(o[0]=__builtin_amdgcn_mfma_f32_32x32x16_bf16(PAF(3),VFR(3),o[0],0,0,0), C1,8); \
    GAPB(o[1]=__builtin_amdgcn_mfma_f32_32x32x16_bf16(PAF(3),VFR(7),o[1],0,0,0), C1,12); \
    }while(0)
  int t=1;
  #undef CMASK
  #define CMASK(P0,P1,t) do{}while(0)
  for(;t+5<NT;t+=2){
    STEP(pB0,pB1,pA0,pA1,t,true,true,true);     WAIT_BAR(2); RESC(); ROT();
    STEP(pA0,pA1,pB0,pB1,t+1,true,true,true);   WAIT_BAR(2); RESC(); ROT();
  }
  #undef CMASK
  #define CMASK(P0,P1,t) do{}while(0)
  #define ENDW(tt) do{ if((tt)+3<NT){WAIT_BAR(2);} else if((tt)+2<NT){WAIT_BAR(1);} else {WAIT_BAR(0);} }while(0)
  for(;t+1<NT;t+=2){
    STEP(pB0,pB1,pA0,pA1,t,(t+3<NT),(t+1<NT),(t+1<NT));       ENDW(t);   RESC(); ROT();
    STEP(pA0,pA1,pB0,pB1,t+1,(t+4<NT),(t+2<NT),(t+2<NT));     ENDW(t+1); RESC(); ROT();
  }
  STEP(pB0,pB1,pA0,pA1,NT-1,false,false,false); RESC();
  { float sacc=pB0[0]+pB0[1]; _Pragma("unroll") for(int r=2;r<16;++r)sacc+=pB0[r]; _Pragma("unroll") for(int r=0;r<16;++r)sacc+=pB1[r]; l_reg+=sacc;
    pw0=(u32x4){PKW(pB0,0),PKW(pB0,2),PKW(pB0,4),PKW(pB0,6)};pw1=(u32x4){PKW(pB0,8),PKW(pB0,10),PKW(pB0,12),PKW(pB0,14)};pw2=(u32x4){PKW(pB1,0),PKW(pB1,2),PKW(pB1,4),PKW(pB1,6)};pw3=(u32x4){PKW(pB1,8),PKW(pB1,10),PKW(pB1,12),PKW(pB1,14)};
    SBAR(); pv(o,vb0+sl_cur,PAF(0),PAF(1),PAF(2),PAF(3)); }
  #undef PKW
  #undef PAF
  #undef VFR
  #undef PIN
  #undef MX3
  #undef GAPA
  #undef GAPB
  #undef EX
  #undef VRD
  #undef KRD
  #undef STEP
  #undef ENDW
  {auto rr=__builtin_amdgcn_permlane32_swap(__float_as_uint(l_reg),__float_as_uint(l_reg),false,false);l_reg=__uint_as_float(rr[0])+__uint_as_float(rr[1]);}
  if(hi==0)wsf[32+r32]=l_reg;asm volatile("s_waitcnt lgkmcnt(0)":::"memory");
  float rli[16];
  #pragma unroll
  for(int r=0;r<16;++r)rli[r]=__builtin_amdgcn_rcpf(wsf[32+crow(r,hi)]);
  bf16*Ow=O0+(long)(wid*QBLK)*OP;
  { bf16*stg=(bf16*)(shm+LDS_OST)+wid*2048;
    #pragma unroll
    for(int r=0;r<16;++r){const int orow=crow(r,hi);
      #pragma unroll
      for(int d0=0;d0<2;++d0)stg[orow*64+d0*32+r32]=__float2bfloat16(o[d0][r]*rli[r]);}
    asm volatile("s_waitcnt lgkmcnt(0)":::"memory");
    #pragma unroll
    for(int i=0;i<4;++i){const int row=i*8+(lane>>3),ch=lane&7; const u32x4 v=*(const u32x4*)(stg+row*64+ch*8); ATTN_STORE16(Ow+(long)row*OP+ch*8,v);} }
  asm volatile("s_waitcnt lgkmcnt(0)\n\ts_barrier":::"memory");
  #undef DMA_K
  #undef DMA_V
  #undef CMASK
  #undef START
  #undef RESC
  #undef ROT
}
constexpr int ATTN_LDS_BYTES=LDS_BYTES;
#undef SBAR
#undef WAIT_BAR
}

struct Params {
    const float* in[35];
    float* out;
    unsigned char* ws;
    int ph_lo, ph_hi;
};
enum { I_X = 0, I_C, I_CTX, I_CCTX, I_WMOD, I_BMOD, I_GMIX, I_GFFN, I_MIXWIN, I_MIXWOUT, I_QG, I_KG, I_LNG, I_WSP, I_BSP,
       I_S5WIN, I_ARE, I_AIM, I_LOGDT, I_BRE, I_BIM, I_CRE, I_CIM, I_S5D, I_WGLU, I_BGLU, I_S5WOUT,
       I_WGRP, I_BGRP, I_WRT, I_BRT, I_W1, I_W3, I_W2, I_FING };

struct Ctx {
    const Params* p;
    unsigned char* ws;
    LAS unsigned char* lds;
    int tid, lane, wave, gw, ngw;
};
__device__ __forceinline__ const float* xin_row(const Params& P, int r) { return r < TL ? P.in[I_X] + (size_t)r * D : P.in[I_CTX] + (size_t)(r - TL) * D; }
__device__ __forceinline__ int cond_of(int r) { return r < TL ? (r >> 11) : 16; }
__device__ __forceinline__ const float* mod_vec(const Ctx& C, int layer, int ci, int k) { return (const float*)(C.ws + WS_MOD) + ((size_t)(layer * 17 + ci) * 6 + k) * D; }

__device__ __forceinline__ void dsincos(double a, double& s, double& c) {
    const double TWO_PI_HI = 6.283185307179586, TWO_PI_LO = 2.4492935982947064e-16;
    const double k = rint(a * 0.15915494309189535);
    double r = fma(-k, TWO_PI_HI, a); r = fma(-k, TWO_PI_LO, r);
    const double r2 = r * r; double ct = 1.0, st = r, cs = 1.0, ss = r;
#pragma unroll 1
    for (int i = 1; i <= 15; ++i) { ct *= -r2 / (double)((2 * i - 1) * (2 * i)); cs += ct; st *= -r2 / (double)((2 * i) * (2 * i + 1)); ss += st; }
    s = ss; c = cs;
}

struct TItem { const float* src; int N, k0, n0; bf16* dst; int dp; float f8s; };
__device__ __forceinline__ void t_load(const TItem& t, int lane, float (&r)[32]) {
#pragma unroll
    for (int i = 0; i < 32; ++i) r[i] = t.src[(size_t)(t.k0 + 2 * i + (lane >> 5)) * t.N + t.n0 + (lane & 31)];
}
__device__ __forceinline__ void t_store(const TItem& t, int lane, const float (&r)[32], LAS float* scr) {
#pragma unroll
    for (int i = 0; i < 32; ++i) scr[(2 * i + (lane >> 5)) * 33 + (lane & 31)] = r[i];
    asm volatile("s_waitcnt lgkmcnt(0)" ::: "memory");
    const int c = lane & 7;
    if (t.f8s != 0.f) {
#pragma unroll
        for (int j = 0; j < 4; ++j) { const int n = (lane >> 3) + 8 * j; const LAS float* s = scr + (8 * c) * 33 + n; const float q = t.f8s;
            *(pg8::u32x2*)((unsigned char*)t.dst + (size_t)n * t.dp + 8 * c) = pg8::pack8_fp8((f32x4){s[0 * 33] * q, s[1 * 33] * q, s[2 * 33] * q, s[3 * 33] * q}, (f32x4){s[4 * 33] * q, s[5 * 33] * q, s[6 * 33] * q, s[7 * 33] * q}); }
    } else {
#pragma unroll
        for (int j = 0; j < 4; ++j) { const int n = (lane >> 3) + 8 * j; const LAS float* s = scr + (8 * c) * 33 + n;
            v4u o; o.x = pk2(s[0 * 33], s[1 * 33]); o.y = pk2(s[2 * 33], s[3 * 33]); o.z = pk2(s[4 * 33], s[5 * 33]); o.w = pk2(s[6 * 33], s[7 * 33]);
            *(v4u*)(t.dst + (size_t)n * t.dp + 8 * c) = o; }
    }
    asm volatile("s_waitcnt lgkmcnt(0)" ::: "memory");
}
__device__ __forceinline__ TItem mat_item(const float* W, int K, int N, bf16* WT, int it) {
    const int nblk = N / 32, kb = it / nblk, nb = it % nblk;
    return TItem{W, N, kb * 64, nb * 32, WT + (size_t)(nb * 32) * K + kb * 64, K, 0.f};
}
constexpr int MOE_ITEMS = NEXP * 768;
__device__ __forceinline__ TItem moe_item(const Ctx& C, int layer, int it) {
    const Params& P = *C.p;
    const int e = it / 768, r = it % 768, kind = r / 256, j = r % 256;
    if (kind < 2) {
        const float* src = (kind == 0 ? P.in[I_W1] : P.in[I_W3]) + ((size_t)layer * NEXP + e) * D * EH;
        const int kb = j / 16, nb = j % 16, k0 = kb * 64, n0 = nb * 32;
        const int drow = (n0 / 128) * 256 + (n0 % 128) + (kind == 1 ? 128 : 0);
        return TItem{src, EH, k0, n0, (bf16*)((unsigned char*)(C.ws + WS_W13) + (size_t)e * 1024 * 1024 + (size_t)drow * 1024 + k0), 1024, W13_SCALE};
    }
    const float* src = P.in[I_W2] + ((size_t)layer * NEXP + e) * EH * D;
    const int kb = j / 32, nb = j % 32, k0 = kb * 64, n0 = nb * 32;
    return TItem{src, D, k0, n0, (bf16*)(C.ws + WS_W2) + (size_t)e * 1024 * 512 + (size_t)n0 * 512 + k0, 512, 0.f};
}
constexpr int TI0 = 16 * 56, TI1 = 16 * 32, TI2 = 16 * 16, TI3 = 8 * 16, TI4 = 8 * 32, NSMALL = TI0 + TI1 + TI2 + TI3 + TI4;
__device__ __forceinline__ TItem conv_item(const Ctx& C, int layer, int nsmall, int it) {
    const Params& P = *C.p; int r = it;
    if (r < nsmall) {
        if (r < TI0) return mat_item(P.in[I_MIXWIN], D, MIXW, (bf16*)(C.ws + WS_WIN0), r); r -= TI0;
        if (r < TI1) return mat_item(P.in[I_MIXWOUT], D, D, (bf16*)(C.ws + WS_WOUT0), r); r -= TI1;
        if (r < TI2) return mat_item(P.in[I_S5WIN], D, 512, (bf16*)(C.ws + WS_WS5IN), r); r -= TI2;
        if (r < TI3) return mat_item(P.in[I_WGLU], 512, 512, (bf16*)(C.ws + WS_WGLU), r); r -= TI3;
        return mat_item(P.in[I_S5WOUT], 512, D, (bf16*)(C.ws + WS_WS5OUT), r);
    }
    return moe_item(C, layer, r - nsmall);
}
__device__ __forceinline__ void convert_items(const Ctx& C, int layer, int nsmall) {
    LAS float* scr = (LAS float*)(C.lds + C.wave * 16384);
    const int total = nsmall + MOE_ITEMS, n = C.ngw;
    for (int it = C.gw; it < total; it += 2 * n) {
        const bool two = it + n < total;
        const TItem ta = conv_item(C, layer, nsmall, it), tb = conv_item(C, layer, nsmall, two ? it + n : it);
        float ra[32], rb[32];
        t_load(ta, C.lane, ra); if (two) t_load(tb, C.lane, rb);
        t_store(ta, C.lane, ra, scr); if (two) t_store(tb, C.lane, rb, scr);
    }
}

__device__ __forceinline__ void phase_prologue(const Ctx& C) {
    const Params& P = *C.p;
    {
        LAS float* s = (LAS float*)C.lds;
        LAS float* red = (LAS float*)(C.lds + 17 * 1024 * 4);
        bool have_s = false;
        for (int u = blockIdx.x; u < 192; u += gridDim.x) {
            if (!have_s) {
                for (int i = C.tid; i < 17 * 1024; i += NTHR) { const int ci = i >> 10, k = i & 1023; const float v = ci < 16 ? P.in[I_C][ci * D + k] : P.in[I_CCTX][k]; s[i] = silu_(v); }
                have_s = true; __syncthreads();
            }
            const int layer = u / 96, jg = u % 96, kq = C.tid >> 6, jc = C.tid & 63;
            const float* w = P.in[I_WMOD] + (size_t)layer * D * 6144 + jg * 64 + jc;
            float acc[17];
#pragma unroll
            for (int i = 0; i < 17; ++i) acc[i] = 0.f;
            for (int k0 = kq * 128; k0 < kq * 128 + 128; k0 += 16) {
                float wv[16];
#pragma unroll
                for (int j = 0; j < 16; ++j) wv[j] = w[(size_t)(k0 + j) * 6144];
#pragma unroll
                for (int j = 0; j < 16; ++j)
#pragma unroll
                    for (int i = 0; i < 17; ++i) acc[i] += s[i * 1024 + k0 + j] * wv[j]; }
#pragma unroll
            for (int i = 0; i < 17; ++i) red[(kq * 17 + i) * 64 + jc] = acc[i];
            __syncthreads();
            for (int o = C.tid; o < 17 * 64; o += NTHR) { const int ci = o >> 6, c = o & 63; float v = 0.f;
#pragma unroll
                for (int q = 0; q < 8; ++q) v += red[(q * 17 + ci) * 64 + c];
                const int j = jg * 64 + c; v += P.in[I_BMOD][layer * 6144 + j];
                ((float*)(C.ws + WS_MOD))[((size_t)(layer * 17 + ci)) * 6144 + j] = v; }
            __syncthreads();
        }
        __syncthreads();
    }
    {
        const int gt = blockIdx.x * NTHR + C.tid, ngt = gridDim.x * NTHR;
        float2* rope = (float2*)(C.ws + WS_TAB + TAB_ROPE);
        for (int i = gt; i < 64 * 16; i += ngt) { const int pos = i >> 4, f = i & 15;
            const double th = exp(-(double)f * (9.210340371976184 / 16.0)); double s, c; dsincos((double)pos * th, s, c); rope[i] = make_float2((float)c, (float)s); }
        float2* lamb = (float2*)(C.ws + WS_TAB + TAB_LAMB); float2* bbar = (float2*)(C.ws + WS_TAB + TAB_BBAR);
        for (int i = gt; i < 2 * 32 * 64; i += ngt) {
            const int dg = i >> 6;
            const double are = P.in[I_ARE][i], aim = P.in[I_AIM][i], dt = exp((double)P.in[I_LOGDT][dg]);
            double s, c; dsincos(aim * dt, s, c); const double mag = exp(are * dt), lr = mag * c, li = mag * s;
            lamb[i] = make_float2((float)lr, (float)li);
            const double den = are * are + aim * aim, nr = lr - 1.0, ni = li;
            const double cr = (nr * are + ni * aim) / den, cim = (ni * are - nr * aim) / den;
            for (int p = 0; p < 16; ++p) { const double br = P.in[I_BRE][(size_t)i * 16 + p], bi = P.in[I_BIM][(size_t)i * 16 + p];
                bbar[(size_t)i * 16 + p] = make_float2((float)(cr * br - cim * bi), (float)(cr * bi + cim * br)); }
        }
    }
    {
        const int gt = blockIdx.x * NTHR + C.tid, ngt = gridDim.x * NTHR;
        bf16* wrt = (bf16*)(C.ws + WS_TAB + TAB_WR);
        for (int idx = gt; idx < 2 * 32 * 3 * 64; idx += ngt) {
            const int ln = idx & 63, jb = (idx >> 6) % 3, kk = (idx / 192) & 31, l = idx / (192 * 32);
            const int i = ln & 15, q = ln >> 4, grp = i >> 2, r = i & 3;
            float hi8[8], lo8[8];
#pragma unroll
            for (int e = 0; e < 8; ++e) { const int k = 32 * kk + 8 * q + e;
                const float w = jb < 2 ? P.in[I_WRT][((size_t)l * D + k) * 32 + grp * 8 + jb * 4 + r] : (r == 0 ? P.in[I_WGRP][((size_t)l * D + k) * 4 + grp] : 0.f);
                const float h = bf2f(f2bf(w)); hi8[e] = h; lo8[e] = w - h; }
            v4u oh, ol; oh.x = pk2(hi8[0], hi8[1]); oh.y = pk2(hi8[2], hi8[3]); oh.z = pk2(hi8[4], hi8[5]); oh.w = pk2(hi8[6], hi8[7]);
            ol.x = pk2(lo8[0], lo8[1]); ol.y = pk2(lo8[2], lo8[3]); ol.z = pk2(lo8[4], lo8[5]); ol.w = pk2(lo8[6], lo8[7]);
            const size_t base = ((((size_t)l * 32 + kk) * 3 + jb) * 2) * 64 + ln;
            *(v4u*)(wrt + base * 8) = oh; *(v4u*)(wrt + (base + 64) * 8) = ol;
        }
    }
    {
        const int gt = blockIdx.x * NTHR + C.tid, ngt = gridDim.x * NTHR; bf16* w16 = (bf16*)(C.ws + WS_WSP);
        for (int i = gt; i < 8 * 128 * 128 / 4; i += ngt) { const f32x4 v = *(const f32x4*)(P.in[I_WSP] + 4 * (size_t)i); v2u o; o.x = pk2(v.x, v.y); o.y = pk2(v.z, v.w); *(v2u*)(w16 + 4 * (size_t)i) = o; }
    }
    convert_items(C, 0, NSMALL);
}

__device__ __forceinline__ void load_row16(const float* row, int lane, f32x4 (&v)[4]) {
#pragma unroll
    for (int j = 0; j < 4; ++j) v[j] = *(const f32x4*)(row + 4 * lane + 256 * j);
}
__device__ __forceinline__ float row_rstd(const f32x4 (&v)[4]) {
    float s = 0.f;
#pragma unroll
    for (int j = 0; j < 4; ++j) s += (v[j].x * v[j].x + v[j].y * v[j].y) + (v[j].z * v[j].z + v[j].w * v[j].w);
    return rsqrtf(wave_sum(s) * (1.f / D) + EPS);
}
__device__ __forceinline__ void modulate16(f32x4 (&v)[4], float rstd, const float* g, const float* scale, const float* shift, int lane) {
#pragma unroll
    for (int j = 0; j < 4; ++j) { const int c = 4 * lane + 256 * j; const f32x4 gg = *(const f32x4*)(g + c), sc = *(const f32x4*)(scale + c), sh = *(const f32x4*)(shift + c);
        v[j] = v[j] * rstd * gg * (sc + 1.f) + sh; }
}
__device__ __forceinline__ void store_row16_bf16(bf16* row, int lane, const f32x4 (&v)[4]) {
#pragma unroll
    for (int j = 0; j < 4; ++j) { v2u o; o.x = pk2(v[j].x, v[j].y); o.y = pk2(v[j].z, v[j].w); *(v2u*)(row + 4 * lane + 256 * j) = o; }
}

__device__ __forceinline__ void phase_norm_mix0(const Ctx& C) {
    const Params& P = *C.p; bf16* H = (bf16*)(C.ws + WS_H);
    f32x4 a[4], b[4]; const int n = C.ngw; int r = C.gw;
    if (r < TT) load_row16(xin_row(P, r), C.lane, a);
    if (r + n < TT) load_row16(xin_row(P, r + n), C.lane, b);
#define NM0_ROW(buf, rr, rnext) do { f32x4 v[4] = {buf[0], buf[1], buf[2], buf[3]}; if ((rnext) < TT) load_row16(xin_row(P, (rnext)), C.lane, buf); \
        const float rstd = row_rstd(v); const int ci = cond_of(rr); modulate16(v, rstd, P.in[I_GMIX], mod_vec(C, 0, ci, 1), mod_vec(C, 0, ci, 0), C.lane); store_row16_bf16(H + (size_t)(rr) * D, C.lane, v); } while (0)
    for (; r < TT; r += 2 * n) { NM0_ROW(a, r, r + 2 * n); if (r + n < TT) NM0_ROW(b, r + n, r + 3 * n); }
#undef NM0_ROW
}

__device__ __forceinline__ void qk_norm_rope(float (&v)[8], const float* gain, bool lat, int t, int lane, const float2* rope) {
    float ss = 0.f;
#pragma unroll
    for (int j = 0; j < 8; ++j) ss += v[j] * v[j];
    ss += __shfl_xor(ss, 1); ss += __shfl_xor(ss, 2); ss += __shfl_xor(ss, 4);
    const float rstd = rsqrtf(ss * (1.f / 64.f) + EPS);
    const int l8 = lane & 7;
#pragma unroll
    for (int j = 0; j < 8; ++j) v[j] = v[j] * rstd * gain[l8 * 8 + j];
    const int quarter = l8 >> 1, pos = (quarter < 2) ? (t >> 6) : (t & 63);
#pragma unroll
    for (int j = 0; j < 8; ++j) {
        const float pv = __shfl_xor(v[j], 2);
        if (lat) { const float2 cs = rope[pos * 16 + (lane & 1) * 8 + j];
            v[j] = (quarter & 1) ? (v[j] * cs.x + pv * cs.y) : (v[j] * cs.x - pv * cs.y); }
    }
}
__device__ __forceinline__ void phase_qkprep(const Ctx& C) {
    const Params& P = *C.p; const bf16* Pb = (const bf16*)(C.ws + WS_P); bf16* Q = (bf16*)(C.ws + WS_Q); bf16* Kb = (bf16*)(C.ws + WS_K); bf16* Vb = (bf16*)(C.ws + WS_V);
    const float2* rope = (const float2*)(C.ws + WS_TAB + TAB_ROPE);
    struct Raw { v4u q, k, v, g; };
    const int l16 = C.lane & 15, n = C.ngw;
#define QK_LOAD(dst, rr) do { const bf16* pr_ = Pb + (size_t)(rr) * MIXW; dst.q = *(const v4u*)(pr_ + 8 * C.lane); dst.k = *(const v4u*)(pr_ + 512 + 8 * l16); dst.v = *(const v4u*)(pr_ + 640 + 8 * l16); dst.g = *(const v4u*)(pr_ + 1280 + 8 * C.lane); } while (0)
#define QK_ROW(buf, rr, rnext) do { const Raw w_ = buf; if ((rnext) < TT) QK_LOAD(buf, (rnext)); const int r = (rr); \
        const bool lat = r < TL; const int t = lat ? (r & 2047) : 0; \
        const size_t kvrow = lat ? (size_t)(r >> 11) * KVL + CTXL + (r & 2047) : (size_t)((r - TL) >> 8) * KVL + ((r - TL) & 255); \
        { float v[8]; unpack8(w_.q, v); qk_norm_rope(v, P.in[I_QG], lat, t, C.lane, rope); \
          v4u o; o.x = pk2(v[0] * QSCALE, v[1] * QSCALE); o.y = pk2(v[2] * QSCALE, v[3] * QSCALE); o.z = pk2(v[4] * QSCALE, v[5] * QSCALE); o.w = pk2(v[6] * QSCALE, v[7] * QSCALE); \
          *(v4u*)(Q + (size_t)r * 512 + 8 * C.lane) = o; } \
        { float v[8]; unpack8(w_.k, v); qk_norm_rope(v, P.in[I_KG], lat, t, C.lane, rope); \
          if (C.lane < 16) { v4u o; o.x = pk2(v[0], v[1]); o.y = pk2(v[2], v[3]); o.z = pk2(v[4], v[5]); o.w = pk2(v[6], v[7]); *(v4u*)(Kb + kvrow * 128 + 8 * l16) = o; *(v4u*)(Vb + kvrow * 128 + 8 * l16) = w_.v; } } \
        { float v[8]; unpack8(w_.g, v); float sm = 0.f; \
          _Pragma("unroll") for (int j = 0; j < 8; ++j) { v[j] = gelu_tanh(v[j]); sm += v[j]; } \
          const float mean = wave_sum(sm) * (1.f / 512.f); float qq = 0.f; \
          _Pragma("unroll") for (int j = 0; j < 8; ++j) { const float d = v[j] - mean; qq += d * d; } \
          const float rstd = rsqrtf(wave_sum(qq) * (1.f / 512.f) + EPS); \
          if (C.lane == 0) ((float2*)(C.ws + WS_ROUTE + RT_S))[r] = make_float2(mean, rstd); } } while (0)
    Raw a, b; int r0 = C.gw;
    if (r0 < TT) QK_LOAD(a, r0);
    if (r0 + n < TT) QK_LOAD(b, r0 + n);
    for (; r0 < TT; r0 += 2 * n) { QK_ROW(a, r0, r0 + 2 * n); if (r0 + n < TT) QK_ROW(b, r0 + n, r0 + 3 * n); }
#undef QK_LOAD
#undef QK_ROW
}

__device__ __forceinline__ unsigned gm_off_b(unsigned row, unsigned ch) { return 256u * row + 16u * (ch ^ (((row & 3u) << 2) | ((row >> 2) & 3u))); }
__device__ __forceinline__ void phase_gmlp_fast(const Ctx& C) {
    typedef short bf16x8 __attribute__((ext_vector_type(8)));
    typedef short s16x4 __attribute__((ext_vector_type(4)));
    typedef float f32x16 __attribute__((ext_vector_type(16)));
    const Params& P = *C.p; const bf16* Pb = (const bf16*)(C.ws + WS_P); bf16* OG = (bf16*)(C.ws + WS_H); const bf16* W16 = (const bf16*)(C.ws + WS_WSP);
    const float2* lns = (const float2*)(C.ws + WS_ROUTE + RT_S);
    const int tid = C.tid, lane = C.lane, w = C.wave, l31 = lane & 31, hi = lane >> 5;
    const int gsel = w >> 2, pb = w & 3;
    for (int u = blockIdx.x; u < (TT / 128) * 4; u += gridDim.x) {
        const int ch_ = u >> 2, gp = u & 3;
        { const int row = tid >> 2; const size_t grow = (size_t)ch_ * 128 + row; const float2 st = lns[grow];
#pragma unroll
          for (int i = 0; i < 4; ++i) { const int c16 = (tid & 3) + 4 * i; float v[8]; unpack8(*(const v4u*)(Pb + grow * MIXW + 1280 + 128 * gp + 8 * c16), v);
              const float* lg = P.in[I_LNG] + 128 * gp + 8 * c16;
#pragma unroll
              for (int j = 0; j < 8; ++j) v[j] = (gelu_tanh(v[j]) - st.x) * st.y * lg[j];
              v4u o; o.x = pk2(v[0], v[1]); o.y = pk2(v[2], v[3]); o.z = pk2(v[4], v[5]); o.w = pk2(v[6], v[7]);
              *(LAS v4u*)(C.lds + (row >> 5) * 8192 + gm_off_b(row & 31, c16)) = o; } }
        __syncthreads();
        const int g = 2 * gp + gsel;
        f32x16 acc[2]; acc[0] = f32x16{}; acc[1] = f32x16{};
        const bf16* wrow = W16 + ((size_t)g * 128 + 32 * pb + l31) * 128 + 8 * hi;
#pragma unroll
        for (int k8 = 0; k8 < 8; ++k8) {
            const bf16x8 xf = *(const bf16x8*)(wrow + 16 * k8);
            const unsigned rb = k8 >> 1, ks = k8 & 1;
#pragma unroll
            for (int db = 0; db < 2; ++db) { const unsigned c = 2 * gsel + db, blk = (lane >> 4) & 1, q = (lane & 15) >> 2, p2 = lane & 3;
                s16x4 t0, t1;
                { const unsigned a0 = rb * 8192 + gm_off_b(16 * ks + 8 * hi + q, 4 * c + 2 * blk + (p2 >> 1)) + 8 * (p2 & 1);
                  const unsigned a1 = rb * 8192 + gm_off_b(16 * ks + 8 * hi + 4 + q, 4 * c + 2 * blk + (p2 >> 1)) + 8 * (p2 & 1);
                  t0 = __builtin_bit_cast(s16x4, __builtin_amdgcn_ds_read_tr16_b64_v4i16((LAS s16x4*)(C.lds + a0)));
                  t1 = __builtin_bit_cast(s16x4, __builtin_amdgcn_ds_read_tr16_b64_v4i16((LAS s16x4*)(C.lds + a1))); }
                const bf16x8 yf = {t0[0], t0[1], t0[2], t0[3], t1[0], t1[1], t1[2], t1[3]};
                acc[db] = __builtin_amdgcn_mfma_f32_32x32x16_bf16(xf, yf, acc[db], 0, 0, 0); }
        }
        const float* bsp = P.in[I_BSP] + g * 128 + 32 * pb;
#pragma unroll
        for (int r = 0; r < 16; ++r) { const int pl = (r & 3) + 8 * (r >> 2) + 4 * hi; const size_t grow = (size_t)ch_ * 128 + 32 * pb + pl; const float bb = bsp[pl];
#pragma unroll
            for (int db = 0; db < 2; ++db) { const int col = 64 * g + 32 * db + l31; const float uu = gelu_tanh(bf2f(Pb[grow * MIXW + 768 + col]));
                OG[grow * D + 512 + col] = (bf16)f2bf(uu * (acc[db][r] + bb)); } }
        __syncthreads();
    }
}

__device__ __forceinline__ void phase_attn_fast(const Ctx& C, char* lds_generic) {
    typedef attn_body::bf16 abf;
    const abf* Q = (const abf*)(C.ws + WS_Q); const abf* Kb = (const abf*)(C.ws + WS_K); const abf* Vb = (const abf*)(C.ws + WS_V); abf* OG = (abf*)(C.ws + WS_H);
    const int G = gridDim.x, bx = blockIdx.x; const int vcu = (G % 8 == 0) ? (bx % 8) * (G / 8) + bx / 8 : bx;
    const int per = (1024 + G - 1) / G, perc = (128 + G - 1) / G;
    for (int i = 0; i < per + perc; ++i) {
        int b, h, nt; size_t qrow;
        if (i < per) { const int u = vcu * per + i; if (u >= 1024) continue; const int qb = u & 7, hg = (u >> 3) & 3, bk = u >> 5; b = bk >> 1; h = (bk & 1) * 4 + hg; qrow = (size_t)b * SEQ + qb * 256; nt = KVL / 64; }
        else { const int u = vcu + (i - per) * G; if (u >= 128) continue; b = u >> 3; h = u & 7; qrow = (size_t)TL + (size_t)b * CTXL; nt = CTXL / 64; }
        const size_t kvo = (size_t)b * KVL * 128 + (h >> 2) * 64;
        attn_body::attn_unit<8>(Q + qrow * 512 + h * 64, Kb + kvo, Vb + kvo, OG + qrow * 1024 + h * 64, nt, lds_generic);
    }
}

__device__ __forceinline__ void phase_router_fast(const Ctx& C, int layer, int nrows) {
    typedef short bf16x8 __attribute__((ext_vector_type(8)));
    const Params& P = *C.p; const bf16* XC = (const bf16*)(C.ws + WS_XC); bf16* F = (bf16*)(C.ws + WS_H);
    int* asg_e = (int*)(C.ws + WS_ROUTE + RT_E); int* asg_p = (int*)(C.ws + WS_ROUTE + RT_P); float* asg_w = (float*)(C.ws + WS_ROUTE + RT_W); int* list = (int*)(C.ws + WS_LIST);
    unsigned* cnt = (unsigned*)(C.ws + WS_CTL) + CW_CNT + 64 * layer;
    const int l15 = C.lane & 15, q4 = C.lane >> 4;
    LAS float* ab = (LAS float*)(C.lds + C.wave * 8192);
    LAS unsigned* lcnt = (LAS unsigned*)(C.lds + 65536);
    if (C.tid < 64) lcnt[C.tid] = 0u;
    __syncthreads();
    int cur_ci = -1;
    const int nitems = nrows / 16, nrounds = (nitems + C.ngw - 1) / C.ngw;
    for (int rd = 0; rd < nrounds; ++rd) {
        const int it_raw = C.gw + rd * C.ngw; const bool valid = it_raw < nitems; const int it = valid ? it_raw : nitems - 1;
        const int row = it * 16 + l15, ci = cond_of(it * 16);
        if (ci != cur_ci) {
            const float* sc = mod_vec(C, layer, ci, 4); const float* sh = mod_vec(C, layer, ci, 3); const float* g0 = P.in[I_GFFN] + layer * D;
#pragma unroll
            for (int j = 0; j < 4; ++j) { const int c = 4 * C.lane + 256 * j; const f32x4 g4 = *(const f32x4*)(g0 + c), s4 = *(const f32x4*)(sc + c), h4 = *(const f32x4*)(sh + c); const f32x4 a4 = g4 * (s4 + 1.f);
                *(LAS f32x4*)(ab + c) = a4; *(LAS f32x4*)(ab + 1024 + c) = h4; }
            asm volatile("s_waitcnt lgkmcnt(0)" ::: "memory"); cur_ci = ci;
        }
        const bf16* xr = XC + (size_t)row * D + 8 * q4;
        float ss = 0.f;
#pragma unroll 16
        for (int kk = 0; kk < 32; ++kk) { pg8::f32x4 a, b; pg8::unpack8f(*(const pg8::u32x4*)(xr + 32 * kk), a, b); ss += (a.x * a.x + a.y * a.y) + (a.z * a.z + a.w * a.w) + (b.x * b.x + b.y * b.y) + (b.z * b.z + b.w * b.w); }
        ss += __shfl_xor(ss, 16); ss += __shfl_xor(ss, 32);
        const float rstd = rsqrtf(ss * (1.f / D) + EPS);
        f32x4 acc[3]; acc[0] = (f32x4){0.f, 0.f, 0.f, 0.f}; acc[1] = acc[0]; acc[2] = acc[0];
        unsigned char* frow = (unsigned char*)F + (size_t)row * D + 8 * q4;
        const LAS float* abl = ab + 8 * q4;
        {
            const unsigned char* wsrc = (const unsigned char*)((const bf16x8*)(C.ws + WS_TAB + TAB_WR) + (size_t)layer * (32 * 3 * 2 * 64)) + C.tid * 16;
            LAS unsigned char* wl0 = C.lds + 67584;
#define RS_GLOAD(sb_, ga, gb, gc, xq) do { ga = *(const pg8::u32x4*)(wsrc + (sb_) * 24576); gb = *(const pg8::u32x4*)(wsrc + (sb_) * 24576 + 8192); gc = *(const pg8::u32x4*)(wsrc + (sb_) * 24576 + 16384); \
                _Pragma("unroll") for (int j = 0; j < 4; ++j) xq[j] = *(const pg8::u32x4*)(xr + 128 * (sb_) + 32 * j); } while (0)
#define RS_LWRITE(sb_, ga, gb, gc) do { LAS unsigned char* wn = wl0 + ((sb_) & 1) * 24576 + C.tid * 16; *(LAS pg8::u32x4*)(wn) = ga; *(LAS pg8::u32x4*)(wn + 8192) = gb; *(LAS pg8::u32x4*)(wn + 16384) = gc; } while (0)
#define RS_FRAGS(sb_, j_, wf_, tb_) do { const LAS unsigned char* wl = wl0 + ((sb_) & 1) * 24576 + C.lane * 16; const int c_ = 128 * (sb_) + 32 * (j_); \
                _Pragma("unroll") for (int jb = 0; jb < 3; ++jb) { wf_[jb][0] = *(const LAS bf16x8*)(wl + (((j_) * 3 + jb) * 2) * 1024); wf_[jb][1] = *(const LAS bf16x8*)(wl + (((j_) * 3 + jb) * 2 + 1) * 1024); } \
                tb_[0] = *(const LAS f32x4*)(abl + c_); tb_[1] = *(const LAS f32x4*)(abl + c_ + 4); tb_[2] = *(const LAS f32x4*)(abl + 1024 + c_); tb_[3] = *(const LAS f32x4*)(abl + 1024 + c_ + 4); } while (0)
#define RS_STEP(sb_, j_, xv_, wf_, tb_, NEXT) do { const int c = 128 * (sb_) + 32 * (j_); \
                pg8::f32x4 x0, x1; pg8::unpack8f(xv_, x0, x1); \
                const f32x4 f0 = x0 * rstd * tb_[0] + tb_[2]; \
                const f32x4 f1 = x1 * rstd * tb_[1] + tb_[3]; \
                const pg8::u32x4 fh = pg8::pack8(f0, f1); if (valid) *(pg8::u32x2*)(frow + c) = pg8::pack8_fp8(f0, f1); \
                pg8::f32x4 r0, r1; pg8::unpack8f(fh, r0, r1); \
                const pg8::u32x4 fl = pg8::pack8(f0 - r0, f1 - r1); \
                const bf16x8 ah = __builtin_bit_cast(bf16x8, fh), al = __builtin_bit_cast(bf16x8, fl); \
                NEXT; \
                _Pragma("unroll") for (int jb = 0; jb < 3; ++jb) { \
                    acc[jb] = __builtin_amdgcn_mfma_f32_16x16x32_bf16(wf_[jb][0], ah, acc[jb], 0, 0, 0); \
                    acc[jb] = __builtin_amdgcn_mfma_f32_16x16x32_bf16(wf_[jb][0], al, acc[jb], 0, 0, 0); \
                    acc[jb] = __builtin_amdgcn_mfma_f32_16x16x32_bf16(wf_[jb][1], ah, acc[jb], 0, 0, 0); } } while (0)
#define RS_COMP(sb_, xq) do { bf16x8 wA[3][2], wB[3][2]; f32x4 tA[4], tB[4]; \
                RS_FRAGS(sb_, 0, wA, tA); \
                RS_STEP(sb_, 0, xq[0], wA, tA, RS_FRAGS(sb_, 1, wB, tB)); \
                RS_STEP(sb_, 1, xq[1], wB, tB, RS_FRAGS(sb_, 2, wA, tA)); \
                RS_STEP(sb_, 2, xq[2], wA, tA, RS_FRAGS(sb_, 3, wB, tB)); \
                RS_STEP(sb_, 3, xq[3], wB, tB, (void)0); } while (0)
#define RS_SYNC() do { asm volatile("s_waitcnt lgkmcnt(0)" ::: "memory"); __builtin_amdgcn_s_barrier(); } while (0)
            if (layer == 1) STAMP_AT(22);
            pg8::u32x4 a0, a1, a2, b0, b1, b2, xa[4], xb[4], xc[4];
            RS_GLOAD(0, a0, a1, a2, xc); RS_GLOAD(1, b0, b1, b2, xb);
            __builtin_amdgcn_s_barrier();
            RS_LWRITE(0, a0, a1, a2); RS_SYNC();
#pragma unroll 1
            for (int sb = 0; sb < 8; sb += 2) {
                if (sb + 2 < 8) RS_GLOAD(sb + 2, a0, a1, a2, xa);
                RS_COMP(sb, xc);
                RS_LWRITE(sb + 1, b0, b1, b2); RS_SYNC();
#pragma unroll
                for (int j = 0; j < 4; ++j) xc[j] = xb[j];
                if (sb + 3 < 8) RS_GLOAD(sb + 3, b0, b1, b2, xb);
                RS_COMP(sb + 1, xc);
                if (sb + 2 < 8) { RS_LWRITE(sb + 2, a0, a1, a2);
#pragma unroll
                    for (int j = 0; j < 4; ++j) xc[j] = xa[j]; }
                RS_SYNC();
            }
            if (layer == 1) STAMP_AT(23);
#undef RS_GLOAD
#undef RS_LWRITE
#undef RS_COMP
#undef RS_STEP
#undef RS_FRAGS
#undef RS_SYNC
        }
        const float* brt = P.in[I_BRT] + layer * 32 + q4 * 8;
        float e[8];
#pragma unroll
        for (int r = 0; r < 4; ++r) { e[r] = acc[0][r] + brt[r]; e[4 + r] = acc[1][r] + brt[4 + r]; }
        const float gl = acc[2][0] + P.in[I_BGRP][layer * 4 + q4];
        float gm = gl; int gi = q4;
#pragma unroll
        for (int st = 16; st <= 32; st <<= 1) { const float og = __shfl_xor(gm, st); const int oi = __shfl_xor(gi, st); if (og > gm || (og == gm && oi < gi)) { gm = og; gi = oi; } }
        float den = __expf(gl - gm); den += __shfl_xor(den, 16); den += __shfl_xor(den, 32);
        if (valid && q4 == gi) {
            const float gw_ = 1.f / den;
            int i0 = 0; float v0 = e[0];
#pragma unroll
            for (int i = 1; i < 8; ++i) if (e[i] > v0) { v0 = e[i]; i0 = i; }
            int i1 = -1; float v1 = -INFINITY;
#pragma unroll
            for (int i = 0; i < 8; ++i) if (i != i0 && e[i] > v1) { v1 = e[i]; i1 = i; }
            if (i1 < 0) i1 = (i0 + 1) & 7;
            const float e1 = __expf(v1 - v0), w0 = gw_ / (1.f + e1), w1 = gw_ * e1 / (1.f + e1);
            const int ea = (gi & 3) * 8 + i0, eb = (gi & 3) * 8 + i1;
            const unsigned pa = __hip_atomic_fetch_add(lcnt + ea, 1u, __ATOMIC_RELAXED, __HIP_MEMORY_SCOPE_WORKGROUP);
            const unsigned pb = __hip_atomic_fetch_add(lcnt + eb, 1u, __ATOMIC_RELAXED, __HIP_MEMORY_SCOPE_WORKGROUP);
            asg_e[2 * row] = ea; asg_e[2 * row + 1] = eb; asg_p[2 * row] = (int)pa; asg_p[2 * row + 1] = (int)pb; asg_w[2 * row] = w0; asg_w[2 * row + 1] = w1;
        }
    }
    if (layer == 0) STAMP_AT(21);
    asm volatile("s_waitcnt vmcnt(0) lgkmcnt(0)" ::: "memory");
    __syncthreads();
    if (C.tid < 32) { const unsigned n = lcnt[C.tid]; lcnt[32 + C.tid] = n ? __hip_atomic_fetch_add(cnt + C.tid, n, __ATOMIC_RELAXED, __HIP_MEMORY_SCOPE_AGENT) : 0u; }
    __syncthreads();
    for (int it = C.gw; it < nrows / 16; it += C.ngw) {
        if (C.lane < 32) { const int idx = 2 * (it * 16 + (C.lane & 15)) + (C.lane >> 4);
            const int e = __hip_atomic_load(asg_e + idx, __ATOMIC_RELAXED, __HIP_MEMORY_SCOPE_AGENT); const int p = __hip_atomic_load(asg_p + idx, __ATOMIC_RELAXED, __HIP_MEMORY_SCOPE_AGENT) + (int)lcnt[32 + e];
            asg_p[idx] = p; list[(size_t)e * LCAP + p] = idx >> 1; }
    }
}

__device__ __forceinline__ int wave_pstart(const Ctx& C, int layer) {
    const unsigned* cnt = (const unsigned*)(C.ws + WS_CTL) + CW_CNT + 64 * layer;
    const int mc = C.lane < 32 ? (int)__hip_atomic_load(cnt + (C.lane & 31), __ATOMIC_RELAXED, __HIP_MEMORY_SCOPE_AGENT) : 0; const int mp = (mc + 255) & ~255; int in = mp;
#pragma unroll
    for (int o = 1; o < 32; o <<= 1) { const int t = __shfl_up(in, o); if ((C.lane & 31) >= o) in += t; }
    return in - mp;
}
struct CombRaw { v2u x[4], ya[4], yb[4]; float w0, w1; };
__device__ __forceinline__ void comb_load(const Ctx& C, int r, int ps, CombRaw& o) {
    const bf16* Y2 = (const bf16*)(C.ws + WS_XS); const bf16* XC = (const bf16*)(C.ws + WS_XC); const float* asg_w = (const float*)(C.ws + WS_ROUTE + RT_W);
    const int* asg_e = (const int*)(C.ws + WS_ROUTE + RT_E); const int* asg_p = (const int*)(C.ws + WS_ROUTE + RT_P);
    const int s0 = __shfl(ps, asg_e[2 * r]) + asg_p[2 * r], s1 = __shfl(ps, asg_e[2 * r + 1]) + asg_p[2 * r + 1]; o.w0 = asg_w[2 * r]; o.w1 = asg_w[2 * r + 1];
#pragma unroll
    for (int j = 0; j < 4; ++j) { const int c = 4 * C.lane + 256 * j; o.x[j] = *(const v2u*)(XC + (size_t)r * D + c); o.ya[j] = *(const v2u*)(Y2 + (size_t)s0 * D + c); o.yb[j] = *(const v2u*)(Y2 + (size_t)s1 * D + c); }
}
__device__ __forceinline__ void comb_calc(const Ctx& C, int layer, int r, const CombRaw& w, f32x4 (&v)[4]) {
    const float* gate = mod_vec(C, layer, cond_of(r), 5); const float w0 = w.w0, w1 = w.w1;
#pragma unroll
    for (int j = 0; j < 4; ++j) { const int c = 4 * C.lane + 256 * j; const v2u xx = w.x[j], a = w.ya[j], b = w.yb[j]; const f32x4 g = *(const f32x4*)(gate + c);
        v[j].x = bf2f(xx.x & 0xffffu) + g.x * (w0 * bf2f(a.x & 0xffffu) + w1 * bf2f(b.x & 0xffffu)); v[j].y = bf2f(xx.x >> 16) + g.y * (w0 * bf2f(a.x >> 16) + w1 * bf2f(b.x >> 16));
        v[j].z = bf2f(xx.y & 0xffffu) + g.z * (w0 * bf2f(a.y & 0xffffu) + w1 * bf2f(b.y & 0xffffu)); v[j].w = bf2f(xx.y >> 16) + g.w * (w0 * bf2f(a.y >> 16) + w1 * bf2f(b.y >> 16)); }
}
__device__ __forceinline__ void phase_combine_norm_mix1(const Ctx& C) {
    const Params& P = *C.p; bf16* XC = (bf16*)(C.ws + WS_XC); bf16* H = (bf16*)(C.ws + WS_H);
    const int ps = wave_pstart(C, 0), n = C.ngw;
#define CN_ROW(buf, rr, rnext) do { const CombRaw w_ = buf; if ((rnext) < TT) comb_load(C, (rnext), ps, buf); f32x4 v[4]; comb_calc(C, 0, (rr), w_, v); \
        store_row16_bf16(XC + (size_t)(rr) * D, C.lane, v); const float rstd = row_rstd(v); const int ci = cond_of(rr); \
        modulate16(v, rstd, P.in[I_GMIX] + D, mod_vec(C, 1, ci, 1), mod_vec(C, 1, ci, 0), C.lane); store_row16_bf16(H + (size_t)(rr) * D, C.lane, v); } while (0)
    CombRaw a, b; int r = C.gw;
    if (r < TT) comb_load(C, r, ps, a);
    if (r + n < TT) comb_load(C, r + n, ps, b);
    for (; r < TT; r += 2 * n) { CN_ROW(a, r, r + 2 * n); if (r + n < TT) CN_ROW(b, r + n, r + 3 * n); }
#undef CN_ROW
    convert_items(C, 1, 0);
}
__device__ __forceinline__ void phase_final(const Ctx& C) {
    const Params& P = *C.p;
    const int ps = wave_pstart(C, 1), n = C.ngw;
#define FN_ROW(buf, rr, rnext) do { const CombRaw w_ = buf; if ((rnext) < TL) comb_load(C, (rnext), ps, buf); f32x4 v[4]; comb_calc(C, 1, (rr), w_, v); const float rstd = row_rstd(v); \
        _Pragma("unroll") for (int j = 0; j < 4; ++j) { const int c = 4 * C.lane + 256 * j; const f32x4 g = *(const f32x4*)(P.in[I_FING] + c); *(f32x4*)(P.out + (size_t)(rr) * D + c) = v[j] * rstd * g; } } while (0)
    CombRaw a, b; int r = C.gw;
    if (r < TL) comb_load(C, r, ps, a);
    if (r + n < TL) comb_load(C, r + n, ps, b);
    for (; r < TL; r += 2 * n) { FN_ROW(a, r, r + 2 * n); if (r + n < TL) FN_ROW(b, r + n, r + 3 * n); }
#undef FN_ROW
}

__device__ __forceinline__ void phase_s5_fast(const Ctx& C) {
    typedef short bf16x8 __attribute__((ext_vector_type(8)));
    typedef float f32x16 __attribute__((ext_vector_type(16)));
    const Params& P = *C.p; const bf16* U = (const bf16*)(C.ws + WS_U); bf16* GS = (bf16*)(C.ws + WS_GS); float* YA = (float*)(C.ws + WS_YACC);
    const float2* lamb = (const float2*)(C.ws + WS_TAB + TAB_LAMB); const float2* bbar = (const float2*)(C.ws + WS_TAB + TAB_BBAR);
    constexpr int HP = 272;
    const int lane = C.lane, w = C.wave, il = w >> 2, dir = (w >> 1) & 1, nh = w & 1;
    const int l31 = lane & 31, hi = lane >> 5, l15 = lane & 15, q4 = lane >> 4;
    LAS unsigned char* Hb = C.lds + (il * 2 + dir) * (2 * 32 * HP);
    const int srow = (l31 & 3) + 4 * (l31 >> 3) + 16 * ((l31 >> 2) & 1);
    for (int it0 = blockIdx.x; it0 < NB * 16; it0 += gridDim.x) {
        const int item = it0 * 2 + il, b = item >> 5, g = item & 31;
        const int dg = dir * 32 + g, n = nh * 32 + l31;
        const float2 lam = lamb[dg * 64 + n];
        float lpr[16], lpi[16]; { float pr = lam.x, pi = lam.y;
#pragma unroll
            for (int r = 0; r < 16; ++r) { lpr[r] = pr; lpi[r] = pi; const float nr = pr * lam.x - pi * lam.y, ni = pr * lam.y + pi * lam.x; pr = nr; pi = ni; } }
        bf16x8 bre, bim; { const float2* bp = bbar + ((size_t)(dg * 64 + n)) * 16 + 8 * hi;
#pragma unroll
            for (int e = 0; e < 8; ++e) { const float2 v = bp[e]; bre[e] = (short)f2bf(v.x); bim[e] = (short)f2bf(v.y); } }
        bf16x8 cf[4]; { const float* cre = P.in[I_CRE] + ((size_t)dg * 16 + l15) * 64; const float* cim = P.in[I_CIM] + ((size_t)dg * 16 + l15) * 64;
#pragma unroll
            for (int ks = 0; ks < 4; ++ks) { const f32x4 a = *(const f32x4*)(cre + 16 * ks + 4 * q4), m = *(const f32x4*)(cim + 16 * ks + 4 * q4);
                cf[ks][0] = (short)f2bf(a.x); cf[ks][1] = (short)f2bf(-m.x); cf[ks][2] = (short)f2bf(a.y); cf[ks][3] = (short)f2bf(-m.y);
                cf[ks][4] = (short)f2bf(a.z); cf[ks][5] = (short)f2bf(-m.z); cf[ks][6] = (short)f2bf(a.w); cf[ks][7] = (short)f2bf(-m.w); } }
        const f32x4 dsk = *(const f32x4*)(P.in[I_S5D] + g * 16 + 4 * q4);
        float cr = 0.f, ci = 0.f;
#define S5_UROW(kk) ({ const int S_ = 32 * (kk) + srow; (S_ < CTXL) ? ((size_t)TL + (size_t)b * CTXL + (dir == 0 ? S_ : CTXL - 1 - S_)) : ((size_t)b * SEQ + (dir == 0 ? S_ - CTXL : SEQ - 1 - (S_ - CTXL))); })
        bf16x8 ua_next = *(const bf16x8*)(U + S5_UROW(0) * 512 + g * 16 + 8 * hi);
        for (int k = 0; k < 72; ++k) {
            const bf16x8 ua = ua_next;
            if (k + 1 < 72) ua_next = *(const bf16x8*)(U + S5_UROW(k + 1) * 512 + g * 16 + 8 * hi);
            const int sl = 32 * (k - 8) + 16 * nh + l15;
            const int tok = dir == 0 ? sl : SEQ - 1 - sl; const int lt = tok >> 5;
            const size_t o = ((size_t)b * SEQ + (k >= 8 ? tok : 0)) * 512 + g * 16 + 4 * q4;
            const bool first = dir == 0 ? (lt < 32) : (lt >= 32);
            f32x4 pk = {0.f, 0.f, 0.f, 0.f}; v2u uu = {0u, 0u};
            if (k >= 8 && !first) {
                pk.x = __hip_atomic_load(YA + o, __ATOMIC_RELAXED, __HIP_MEMORY_SCOPE_AGENT); pk.y = __hip_atomic_load(YA + o + 1, __ATOMIC_RELAXED, __HIP_MEMORY_SCOPE_AGENT);
                pk.z = __hip_atomic_load(YA + o + 2, __ATOMIC_RELAXED, __HIP_MEMORY_SCOPE_AGENT); pk.w = __hip_atomic_load(YA + o + 3, __ATOMIC_RELAXED, __HIP_MEMORY_SCOPE_AGENT);
                uu = *(const v2u*)(U + o);
            }
            {
              f32x16 br = {}, bi = {};
              br = __builtin_amdgcn_mfma_f32_32x32x16_bf16(ua, bre, br, 0, 0, 0);
              bi = __builtin_amdgcn_mfma_f32_32x32x16_bf16(ua, bim, bi, 0, 0, 0);
              float sr = hi ? 0.f : cr, si = hi ? 0.f : ci;
#pragma unroll
              for (int r = 0; r < 16; ++r) { const float nr = lam.x * sr - lam.y * si + br[r], ni = lam.x * si + lam.y * sr + bi[r]; sr = nr; si = ni; br[r] = sr; bi[r] = si; }
              float er = __shfl_xor(sr, 32), ei = __shfl_xor(si, 32); if (!hi) { er = 0.f; ei = 0.f; }
              { const f32x2 er2 = {er, er}, ei2 = {ei, ei};
#pragma unroll
              for (int r = 0; r < 16; r += 2) { const f32x2 pr2 = {lpr[r], lpr[r + 1]}, pi2 = {lpi[r], lpi[r + 1]}; f32x2 b2 = {br[r], br[r + 1]}, i2 = {bi[r], bi[r + 1]};
                  b2 = b2 + pr2 * er2 - pi2 * ei2; i2 = i2 + pr2 * ei2 + pi2 * er2; br[r] = b2.x; br[r + 1] = b2.y; bi[r] = i2.x; bi[r + 1] = i2.y; } }
              cr = __shfl_xor(br[15], 32); ci = __shfl_xor(bi[15], 32);
              LAS unsigned char* hb = Hb + (k & 1) * (32 * HP) + (16 * hi) * HP + 4 * n;
#pragma unroll
              for (int r = 0; r < 16; ++r) *(LAS unsigned*)(hb + r * HP) = pk2(br[r], bi[r]);
            }
            asm volatile("s_waitcnt lgkmcnt(0)\n\ts_barrier" ::: "memory");
            if (k >= 8) {
                const LAS unsigned char* hr = Hb + (k & 1) * (32 * HP) + (16 * nh + l15) * HP + 16 * q4;
                f32x4 y = {0.f, 0.f, 0.f, 0.f};
#pragma unroll
                for (int ks = 0; ks < 4; ++ks) { const bf16x8 hf = *(const LAS bf16x8*)(hr + 64 * ks); y = __builtin_amdgcn_mfma_f32_16x16x32_bf16(cf[ks], hf, y, 0, 0, 0); }
                if (first) { *(f32x4*)(YA + o) = y; }
                else {
                    const f32x4 uf = {bf2f(uu.x & 0xffffu), bf2f(uu.x >> 16), bf2f(uu.y & 0xffffu), bf2f(uu.y >> 16)};
                    const f32x4 t = y + pk + dsk * uf;
                    v2u ov; ov.x = pk2(gelu_tanh(t.x), gelu_tanh(t.y)); ov.y = pk2(gelu_tanh(t.z), gelu_tanh(t.w)); *(v2u*)(GS + o) = ov;
                }
            }
            if (k == 39) asm volatile("s_waitcnt vmcnt(0)\n\ts_barrier" ::: "memory");
        }
#undef S5_UROW
        asm volatile("s_waitcnt vmcnt(0) lgkmcnt(0)\n\ts_barrier" ::: "memory");
    }
}

__global__ void __launch_bounds__(NTHR, 2) fwd_kernel(Params prm) {
    extern __shared__ __attribute__((aligned(16))) unsigned char lds_raw[];
    Ctx C; C.p = &prm; C.ws = prm.ws; C.lds = (LAS unsigned char*)lds_raw;
    C.tid = threadIdx.x; C.lane = C.tid & 63; C.wave = __builtin_amdgcn_readfirstlane(C.tid >> 6);
    C.gw = blockIdx.x * NWAVE + C.wave; C.ngw = gridDim.x * NWAVE;
    constexpr int LDS_MISC = 147456 - 512;
    volatile LAS unsigned* misc = (volatile LAS unsigned*)(C.lds + LDS_MISC);
    if (C.tid < 64) misc[C.tid] = 0u;
    __syncthreads();
    unsigned* ctl = (unsigned*)(C.ws + WS_CTL);
    XcdBarrier bar; bar.bar = ctl + CW_BAR; bar.x = 0; bar.st = nullptr;
#if MK_ONE_LAUNCH
    bar = xcd_barrier_post(ctl + CW_BAR, misc + 8);
#define SEAM(k) do { if (lo <= (k) && (k) + 1 < hi) xcd_barrier(bar); } while (0)
#else
#define SEAM(k) do { } while (0)
#endif
    const int lo = prm.ph_lo, hi = prm.ph_hi;
#define IN(k) ((C.lane = lane_id_now(), C.tid = C.wave * 64 + C.lane, true) && lo <= (k) && (k) < hi)
#if MK_PROBE
    volatile LAS unsigned long long* ts_ = (volatile LAS unsigned long long*)(C.lds + LDS_MISC + 64);
#define STAMP(k) do { if (blockIdx.x == 0 && C.tid == 0) ts_[(k) + 1] = __builtin_amdgcn_s_memrealtime(); } while (0)
    if (blockIdx.x == 0 && C.tid == 0) ts_[0] = __builtin_amdgcn_s_memrealtime();
#else
#define STAMP(k) do { } while (0)
#endif
    const Params& P = prm;
    bf16* Hb = (bf16*)(C.ws + WS_H); bf16* XC = (bf16*)(C.ws + WS_XC);
#define MOE_MAP(layer) do { LAS int* tm_ = (LAS int*)(C.lds + 131072); LAS int* cl_ = tm_ + 320; \
        if (C.wave == 0) { const unsigned* cnt_ = (const unsigned*)(C.ws + WS_CTL) + CW_CNT + 64 * (layer); const int mc_ = C.lane < 32 ? (int)__hip_atomic_load(cnt_ + (C.lane & 31), __ATOMIC_RELAXED, __HIP_MEMORY_SCOPE_AGENT) : 0; const int mp_ = (mc_ + 255) & ~255; int in_ = mp_; \
            _Pragma("unroll") for (int o_ = 1; o_ < 32; o_ <<= 1) { const int t_ = __shfl_up(in_, o_); if ((C.lane & 31) >= o_) in_ += t_; } const int ps_ = in_ - mp_; \
            if (C.lane < 32) { for (int t_ = ps_ / 256; t_ < (ps_ + mp_) / 256; ++t_) tm_[t_] = C.lane | ((t_ * 256 - ps_) << 8); cl_[C.lane] = mc_; if (C.lane == 31) cl_[32] = (ps_ + mp_) / 256; } } \
        __syncthreads(); } while (0)
#define MOE_GEMM1(layer) do { MOE_MAP(layer); const LAS int* tm_ = (const LAS int*)(C.lds + 131072); const int ntl_ = __builtin_amdgcn_readfirstlane(tm_[320 + 32]); pg8::Gemm g{Hb, (const bf16*)(C.ws + WS_W13), 0, 1024, 512}; \
        pg8::GroupedOrder<true> S{tm_, tm_ + 320, (const int*)(C.ws + WS_LIST), ntl_ * 4, 4, (int)gridDim.x, (int)blockIdx.x, LCAP, 1024, (size_t)1024 * 1024}; pg8::EpiSwiglu E{(bf16*)(C.ws + WS_G13), 1.f / W13_SCALE}; \
        pg8::gemm_phase<pg8::EpiSwiglu, pg8::GroupedOrder<true>, true, false, false, true>(C.lds, g, S, E, C.wave); } while (0)
#define MOE_GEMM2(layer) do { MOE_MAP(layer); const LAS int* tm_ = (const LAS int*)(C.lds + 131072); const int ntl_ = __builtin_amdgcn_readfirstlane(tm_[320 + 32]); pg8::Gemm g{(const bf16*)(C.ws + WS_G13), (const bf16*)(C.ws + WS_W2), 0, 1024, EH}; \
        pg8::GroupedOrder<false> S{tm_, tm_ + 320, (const int*)(C.ws + WS_LIST), ntl_ * 4, 4, (int)gridDim.x, (int)blockIdx.x, LCAP, EH * 2, (size_t)1024 * 512 * 2}; pg8::EpiStore E{(bf16*)(C.ws + WS_XS), D}; \
        pg8::gemm_phase<pg8::EpiStore, pg8::GroupedOrder<false>, true, true>(C.lds, g, S, E, C.wave); } while (0)
    if (IN(0)) { phase_prologue(C); SEAM(0); STAMP(0); }
    if (IN(1)) { phase_norm_mix0(C); SEAM(1); STAMP(1); }
    if (IN(2)) { pg8::Gemm g{Hb, (const bf16*)(C.ws + WS_WIN0), TT, MIXW, D}; pg8::StaticOrder S; S.init(TT, MIXW, gridDim.x, blockIdx.x); pg8::EpiStore E{(bf16*)(C.ws + WS_P), MIXW};
        pg8::gemm_phase<pg8::EpiStore, pg8::StaticOrder, true, true, true>(C.lds, g, S, E, C.wave); SEAM(2); STAMP(2); }
    if (IN(3)) { phase_qkprep(C); SEAM(3); STAMP(3); }
    if (IN(4)) { phase_gmlp_fast(C); phase_attn_fast(C, (char*)lds_raw); SEAM(4); STAMP(4); }
    if (IN(5)) { pg8::Gemm g{Hb, (const bf16*)(C.ws + WS_WOUT0), TT, D, D}; pg8::StaticOrder S; S.init(TT, D, gridDim.x, blockIdx.x); pg8::EpiResid E{P.in[I_X], P.in[I_CTX], (const float*)(C.ws + WS_MOD), XC, 0};
        pg8::gemm_phase<pg8::EpiResid, pg8::StaticOrder, true, true, true>(C.lds, g, S, E, C.wave); SEAM(5); STAMP(5); }
    if (IN(6)) { phase_router_fast(C, 0, TT); SEAM(6); STAMP(6); }
    if (IN(8)) { MOE_GEMM1(0); SEAM(8); STAMP(8); }
    if (IN(9)) { MOE_GEMM2(0); SEAM(9); STAMP(9); }
    if (IN(10)) { phase_combine_norm_mix1(C); SEAM(10); STAMP(10); }
    if (IN(11)) { pg8::Gemm g{Hb, (const bf16*)(C.ws + WS_WS5IN), TT, 512, D}; pg8::StaticOrder S; S.init(TT, 512, gridDim.x, blockIdx.x); pg8::EpiStore E{(bf16*)(C.ws + WS_U), 512};
        pg8::gemm_phase<pg8::EpiStore, pg8::StaticOrder, true, true, true>(C.lds, g, S, E, C.wave); SEAM(11); STAMP(11); }
    if (IN(12)) { phase_s5_fast(C); SEAM(12); STAMP(12); }
    if (IN(13)) { pg8::Gemm g{(const bf16*)(C.ws + WS_GS), (const bf16*)(C.ws + WS_WGLU), TL, 512, 512}; pg8::StaticOrder S; S.init(TL, 512, gridDim.x, blockIdx.x); pg8::EpiGlu E{(const bf16*)(C.ws + WS_GS), P.in[I_BGLU], (bf16*)(C.ws + WS_GG)};
        pg8::gemm_phase<pg8::EpiGlu, pg8::StaticOrder, true, true, true>(C.lds, g, S, E, C.wave); SEAM(13); STAMP(13); }
    if (IN(14)) { pg8::Gemm g{(const bf16*)(C.ws + WS_GG), (const bf16*)(C.ws + WS_WS5OUT), TL, D, 512}; pg8::StaticOrder S; S.init(TL, D, gridDim.x, blockIdx.x); pg8::EpiResid E{P.in[I_X], P.in[I_CTX], (const float*)(C.ws + WS_MOD) + (size_t)17 * 6 * D, XC, 1};
        pg8::gemm_phase<pg8::EpiResid, pg8::StaticOrder, true, true, true>(C.lds, g, S, E, C.wave); SEAM(14); STAMP(14); }
    if (IN(15)) { phase_router_fast(C, 1, TL); SEAM(15); STAMP(15); }
    if (IN(17)) { MOE_GEMM1(1); SEAM(17); STAMP(17); }
    if (IN(18)) { MOE_GEMM2(1); SEAM(18); STAMP(18); }
    if (IN(19)) { phase_final(C); STAMP(19); }
#if MK_PROBE
    if (blockIdx.x == 0 && C.tid == 0) {
        ts_[8] = ts_[7]; ts_[17] = ts_[16];
        const unsigned long long tA = ts_[PROBE_A_HI + 1] - ts_[PROBE_A_LO], tB = ts_[PROBE_B_HI + 1] - ts_[PROBE_B_LO];
        const unsigned long long spin = 16ull * tA + 1000000ull * ((tB + 500ull) / 1000ull);
        const unsigned long long t0 = __builtin_amdgcn_s_memrealtime();
        while (__builtin_amdgcn_s_memrealtime() - t0 < spin) __builtin_amdgcn_s_sleep(8);
    }
#endif
#undef IN
#undef SEAM
}

extern "C" void kernel_launch(void* const* d_in, const int* in_sizes, int n_in, void* d_out, int out_size, void* d_ws, size_t ws_size, hipStream_t stream) {
    constexpr int LDS_BYTES = 147456;
    static int grid = 0;
    if (grid == 0) {
        if (n_in != 35 || out_size != TL * D || ws_size < WS_END) { fprintf(stderr, "kernel_launch: unexpected shapes (n_in %d out %d ws %zu)\n", n_in, out_size, ws_size); grid = -1; return; }
        int dev = 0, cus = 0;
        if (hipGetDevice(&dev) != hipSuccess || hipDeviceGetAttribute(&cus, hipDeviceAttributeMultiprocessorCount, dev) != hipSuccess) { grid = -1; return; }
        if (hipFuncSetAttribute((const void*)fwd_kernel, hipFuncAttributeMaxDynamicSharedMemorySize, LDS_BYTES) != hipSuccess) { fprintf(stderr, "kernel_launch: hipFuncSetAttribute failed\n"); grid = -1; return; }
        (void)hipGetLastError();
        grid = cus;
    }
    if (grid < 0) return;
    (void)hipMemsetAsync((char*)d_ws + WS_CTL, 0, CTL_BYTES, stream);
    Params p{};
    for (int i = 0; i < 35; ++i) p.in[i] = (const float*)d_in[i];
    p.out = (float*)d_out; p.ws = (unsigned char*)d_ws;
#if MK_ONE_LAUNCH
    p.ph_lo = 0; p.ph_hi = NPHASE;
    hipLaunchKernelGGL(fwd_kernel, dim3(grid), dim3(NTHR), LDS_BYTES, stream, p);
#else
    for (int k = 0; k < NPHASE; ++k) { p.ph_lo = k; p.ph_hi = k + 1; hipLaunchKernelGGL(fwd_kernel, dim3(grid), dim3(NTHR), LDS_BYTES, stream, p); }
#endif
}
```

```cpp
#include <hip/hip_runtime.h>
#include <cstdio>
#include <cstdint>
#include <type_traits>

#ifndef MK_ONE_LAUNCH
#define MK_ONE_LAUNCH 1
#endif
#ifndef MK_SIMPLE_ORDER
#define MK_SIMPLE_ORDER 0
#endif
#ifndef MK_KROT
#define MK_KROT 0
#endif
#ifndef MK_PROBE
#define MK_PROBE 0
#endif
#define PROBE_A_LO 4
#define PROBE_A_HI 4
#define PROBE_B_LO 8
#define PROBE_B_HI 9

constexpr int D = 1024, NB = 16, SEQ = 2048, CTXL = 256;
constexpr int TL = NB * SEQ, TC = NB * CTXL, TT = TL + TC;
constexpr int KVL = CTXL + SEQ;
constexpr int MIXW = 1792, NEXP = 32, EH = 512;
constexpr int NSLOT = 81920;
constexpr float EPS = 1e-6f;
constexpr float QSCALE = 0.125f * 1.4426950408889634f;
constexpr int NTHR = 512, NWAVE = 8;
constexpr float W13_SCALE = 32.f, W2_SCALE = 16.f, G13_SCALE = 4.f;
constexpr int NPHASE = 20;

constexpr size_t MiB = 1u << 20;
constexpr size_t WS_CTL = 0, CTL_BYTES = 1 * MiB;
constexpr size_t WS_MOD = 1 * MiB;
constexpr size_t WS_TAB = 2 * MiB;
constexpr size_t TAB_ROPE = 0, TAB_LAMB = 16384, TAB_BBAR = 65536, TAB_WR = 640 * 1024;
constexpr size_t WS_ROUTE = 3 * MiB;
constexpr size_t RT_E = 0, RT_P = 320 * 1024, RT_W = 640 * 1024, RT_S = 960 * 1024, RT_TILE = 1280 * 1024, RT_NT = 1280 * 1024 + 4096;
constexpr size_t WS_WIN0 = 6 * MiB, WS_WOUT0 = 10 * MiB, WS_WS5IN = 12 * MiB, WS_WGLU = 13 * MiB, WS_WS5OUT = 14 * MiB;
constexpr size_t WS_WSP = 15 * MiB;
constexpr size_t WS_W13 = 16 * MiB, WS_W2 = 80 * MiB;
constexpr size_t WS_XC = 112 * MiB;
constexpr size_t WS_H = 256 * MiB;
constexpr size_t WS_P = 328 * MiB;
constexpr size_t WS_Q = 454 * MiB, WS_K = 490 * MiB, WS_V = 499 * MiB;
constexpr size_t WS_XS = 328 * MiB;
constexpr size_t WS_G13 = 488 * MiB;
constexpr size_t WS_U = 328 * MiB, WS_GS = 364 * MiB, WS_GG = 396 * MiB, WS_YACC = 428 * MiB;
constexpr size_t WS_LIST = 568 * MiB;
constexpr int LCAP = 36864;
constexpr size_t WS_END = 574 * MiB;
constexpr int CW_CNT = 64;
constexpr int CW_BAR = 4096;

__device__ __forceinline__ int lane_id_now() { int l; asm volatile("v_mbcnt_lo_u32_b32 %0, -1, 0\n\tv_mbcnt_hi_u32_b32 %0, -1, %0\n\ts_nop 0" : "=v"(l)); return l; }
#define STAMP_AT(idx) do { if (MK_PROBE && blockIdx.x == 0 && threadIdx.x == 0) ((volatile __attribute__((address_space(3))) unsigned long long*)(C.lds + 147456 - 512 + 64))[idx] = __builtin_amdgcn_s_memrealtime(); } while (0)
#define LAS __attribute__((address_space(3)))
typedef unsigned short bf16;
typedef unsigned v4u __attribute__((ext_vector_type(4)));
typedef unsigned v2u __attribute__((ext_vector_type(2)));
typedef float f32x4 __attribute__((ext_vector_type(4)));
typedef float f32x2 __attribute__((ext_vector_type(2)));
__device__ __forceinline__ float bf2f(unsigned u) { return __uint_as_float(u << 16); }
typedef __bf16 bf16x2_t __attribute__((ext_vector_type(2)));
__device__ __forceinline__ unsigned pk2(float lo, float hi) { const f32x2 v = {lo, hi}; return __builtin_bit_cast(unsigned, __builtin_convertvector(v, bf16x2_t)); }
__device__ __forceinline__ unsigned f2bf(float f) { return pk2(f, 0.f) & 0xffffu; }
__device__ __forceinline__ float wave_sum(float v) {
#pragma unroll
    for (int o = 1; o < 64; o <<= 1) v += __shfl_xor(v, o);
    return v;
}
__device__ __forceinline__ float wave_max(float v) {
#pragma unroll
    for (int o = 1; o < 64; o <<= 1) v = fmaxf(v, __shfl_xor(v, o));
    return v;
}
__device__ __forceinline__ float gelu_tanh(float x) { const float u2 = -1.5957691216057308f * (x + 0.044715f * x * x * x); return x * __builtin_amdgcn_rcpf(1.f + __expf(u2)); }
__device__ __forceinline__ float sigmoidf_(float x) { return 1.f / (1.f + __expf(-x)); }
__device__ __forceinline__ float silu_(float x) { return x / (1.f + __expf(-x)); }
__device__ __forceinline__ void unpack8(const v4u w, float* f) {
    f[0] = bf2f(w.x & 0xffffu); f[1] = bf2f(w.x >> 16); f[2] = bf2f(w.y & 0xffffu); f[3] = bf2f(w.y >> 16);
    f[4] = bf2f(w.z & 0xffffu); f[5] = bf2f(w.z >> 16); f[6] = bf2f(w.w & 0xffffu); f[7] = bf2f(w.w >> 16);
}

#define XB_TMO      128
#define XB_XCNT(j)  (256  + 64 * (j))
#define XB_XSUB(j)  (1280 + 64 * (j))
#define XB_XGEN(j)  (2304 + 64 * (j))
#define XB_TOP      3328
#define XB_TOPGEN   3392
#define XCD_BAR_WORDS 3456
#define XB_SPIN_CAP (1u << 28)
__device__ __forceinline__ unsigned xb_ld(unsigned* p)              { return __hip_atomic_load(p, __ATOMIC_RELAXED, __HIP_MEMORY_SCOPE_AGENT); }
__device__ __forceinline__ unsigned xb_add(unsigned* p, unsigned v) { return __hip_atomic_fetch_add(p, v, __ATOMIC_RELAXED, __HIP_MEMORY_SCOPE_AGENT); }
__device__ __forceinline__ unsigned xb_xcc_id() { return (unsigned)__builtin_amdgcn_s_getreg((3 << 11) | 20) & 0xFu; }
#define XB_SPIN(cond, bar) do { unsigned _sp = 0; while (cond) { __builtin_amdgcn_s_sleep(1); \
    if ((++_sp & 255u) == 0u) { if (xb_ld(&(bar)[XB_TMO])) break; if (_sp > XB_SPIN_CAP) { atomicAdd(&(bar)[XB_TMO], 1u); break; } } } } while (0)
struct XcdBarrier { unsigned* bar; unsigned x; volatile LAS unsigned* st; };
__device__ __forceinline__ XcdBarrier xcd_barrier_post(unsigned* bar, volatile LAS unsigned* st) {
    XcdBarrier b; b.bar = bar; b.x = xb_xcc_id(); b.st = st;
    if (threadIdx.x == 0) (void)xb_add(&bar[XB_XCNT(b.x)], 1u);
    return b;
}
__device__ __forceinline__ void xcd_barrier_complete(unsigned* bar, unsigned x, unsigned& nloc, unsigned& nx) {
    const unsigned G = gridDim.x * gridDim.y * gridDim.z;
    unsigned sum, cnt, mine, sp = 0u;
    for (;;) {
        sum = 0u; cnt = 0u; mine = 0u;
#pragma unroll
        for (unsigned j = 0; j < 16; ++j) { const unsigned c = xb_ld(&bar[XB_XCNT(j)]); sum += c; cnt += (c > 0u) ? 1u : 0u; mine = (j == x) ? c : mine; }
        if (sum == G) break;
        __builtin_amdgcn_s_sleep(1);
        if ((++sp & 255u) == 0u) { if (xb_ld(&bar[XB_TMO])) break; if (sp > XB_SPIN_CAP) { atomicAdd(&bar[XB_TMO], 1u); break; } }
    }
    nloc = mine > 0u ? mine : 1u; nx = cnt > 0u ? cnt : 1u;
}
__device__ __forceinline__ void xcd_barrier(const XcdBarrier& b) {
    asm volatile("s_waitcnt vmcnt(0)" ::: "memory");
    __syncthreads();
    if (threadIdx.x == 0) {
        unsigned* bar = b.bar;
        __builtin_amdgcn_s_waitcnt(0);
        unsigned nloc = b.st[0], nx = b.st[1];
        if (nloc == 0u) { xcd_barrier_complete(bar, b.x, nloc, nx); b.st[0] = nloc; b.st[1] = nx; }
        const unsigned old = xb_add(&bar[XB_XSUB(b.x)], 1u);
        const unsigned gen = old / nloc;
        if (old + 1u == (gen + 1u) * nloc) {
            __builtin_amdgcn_fence(__ATOMIC_RELEASE, "agent");
            asm volatile("s_waitcnt vmcnt(0)" ::: "memory");
            const unsigned og = xb_add(&bar[XB_TOP], 1u);
            const unsigned tg = og / nx;
            if (og + 1u == (tg + 1u) * nx) xb_add(&bar[XB_TOPGEN], 1u);
            else XB_SPIN(xb_ld(&bar[XB_TOPGEN]) == tg, bar);
            __builtin_amdgcn_fence(__ATOMIC_ACQUIRE, "agent");
            xb_add(&bar[XB_XGEN(b.x)], 1u);
            asm volatile("s_waitcnt vmcnt(0)" ::: "memory");
        } else {
            XB_SPIN(xb_ld(&bar[XB_XGEN(b.x)]) == gen, bar);
            __builtin_amdgcn_fence(__ATOMIC_ACQUIRE, "agent");
            asm volatile("s_waitcnt vmcnt(0)" ::: "memory");
        }
    }
    __syncthreads();
}

namespace pg8 {
#define PG8_LAS __attribute__((address_space(3)))
typedef unsigned short bf16_t;
typedef short bf16x8 __attribute__((ext_vector_type(8)));
typedef float f32x4 __attribute__((ext_vector_type(4)));
typedef unsigned u32x4 __attribute__((ext_vector_type(4)));
typedef int i32x4 __attribute__((ext_vector_type(4)));
typedef unsigned u32x2 __attribute__((ext_vector_type(2)));
constexpr int BM = 256, BK = 64, HALF = 128, HTB = HALF * BK * 2  , STAGE_BYTES = 8 * HTB, NXCD = 8, WGM = 8;

__host__ __device__ __forceinline__ int lds_byte(int r, int c) { const int st = (r >> 4) * 2 + (c >> 5), rr = r & 15, cc = c & 31, ob = rr * 64 + cc * 2; return st * 1024 + (ob ^ (((ob >> 9) & 1) << 5)); }
__host__ __device__ __forceinline__ void stage_rc(int b, int& R, int& C) { const int st = b / 1024, sb = b % 1024, swz = sb ^ (((sb >> 9) & 1) << 5); R = (st >> 1) * 16 + swz / 64; C = (st & 1) * 32 + (swz % 64) / 2; }
__host__ __device__ __forceinline__ int perm32(int rho) { const int n = rho >> 4, i = rho & 15; return 8 * (i >> 2) + 4 * n + (i & 3); }

struct Unit { int pm, pn; size_t bo; int aux; };
struct Gemm { const bf16_t* A; const bf16_t* Bt; int M, N, K; };

struct StaticOrder {
    static constexpr bool GATHER = false;
    int nM, nN, nwg, G, c;
    __host__ __device__ void init(int M, int N, int G_, int c_) { nM = M / BM; nN = N / BM; nwg = nM * nN; G = G_; c = c_; }
    __host__ __device__ bool next(int i, Unit& u) const {
        const long L = (long)i * G + c; if (L >= nwg) return false;
        if (MK_SIMPLE_ORDER) { u.pm = (int)L / nN; u.pn = (int)L % nN; u.bo = 0; u.aux = 0; return true; }
        int wgid = (int)L; { const int q = nwg / NXCD, r = nwg % NXCD, xcd = wgid % NXCD, off = wgid / NXCD; wgid = (xcd < r ? xcd * (q + 1) : r * (q + 1) + (xcd - r) * q) + off; }
        const int nig = WGM * nN, gid = wgid / nig, fm = gid * WGM, gsz = (nM - fm) < WGM ? (nM - fm) : WGM;
        u.pm = fm + ((wgid % nig) % gsz); u.pn = (wgid % nig) / gsz; u.bo = 0; u.aux = 0; return true;
    }
    __device__ __forceinline__ void a_ready(const Unit&) const {}
    __device__ __forceinline__ void done(const Unit&) const {}
};

typedef __bf16 bf16x2_c __attribute__((ext_vector_type(2))); typedef float f32x2_c __attribute__((ext_vector_type(2)));
__device__ __forceinline__ unsigned cvt_pk_bf16(float lo, float hi) { const f32x2_c v = {lo, hi}; return __builtin_bit_cast(unsigned, __builtin_convertvector(v, bf16x2_c)); }
typedef float f32x2 __attribute__((ext_vector_type(2)));
__device__ __forceinline__ f32x2 gelu_pk(f32x2 v) {
    const f32x2 av = __builtin_elementwise_abs(v), d = av * 0.2316418882f + 1.0f;
    f32x2 t; t.x = __builtin_amdgcn_rcpf(d.x); t.y = __builtin_amdgcn_rcpf(d.y);
    f32x2 q = t * 0.5307027145f + (-0.7265760135f); q = q * t + 0.7107068705f; q = q * t + (-0.142248368f); q = q * t + 0.127414796f; q = q * t;
    const f32x2 s = (v * v) * (-0.72134752044f);
    f32x2 e; e.x = __builtin_amdgcn_exp2f(s.x); e.y = __builtin_amdgcn_exp2f(s.y);
    const f32x2 m = v * (q * e), r = v - m;
    f32x2 o; o.x = v.x < 0.f ? m.x : r.x; o.y = v.y < 0.f ? m.y : r.y; return o;
}

template <class Epi, class Sched, bool ALIGN_EPI = false, bool SP2 = false, bool KROT = false, bool FP8 = false>
__device__ __forceinline__ void gemm_phase(PG8_LAS unsigned char* lds, const Gemm g, const Sched& S, const Epi& E, const int wave_id) {
    const int wid = __builtin_amdgcn_readfirstlane(wave_id), lane = lane_id_now(), tid = wid * 64 + lane, wr = wid >> 2, wc = wid & 3, fr = lane & 15, fq = lane >> 4;
    const int K = g.K, nt = K / BK;
    const int kmask = nt - 1, rot = (MK_KROT && KROT) ? (int)((blockIdx.x * 3u + (blockIdx.x >> 3)) & (unsigned)kmask) : 0;
#define PG8_KO(j) ((size_t)(((j) + rot) & kmask) * kstep)
    unsigned voffA[2], voffB[2];
    unsigned vC[2][2], vN[2][2];
#pragma unroll
    for (int i = 0; i < 2; ++i) { int R, C; stage_rc(tid * 16 + i * 8192, R, C); const int Rb = Epi::PERM ? ((R & ~31) + perm32(R & 31)) : R;
        voffA[i] = (unsigned)(R * K + C) * 2u; voffB[i] = (unsigned)(Rb * K + C) * 2u; }
    const size_t kstep = (size_t)(BK * 2);
    const size_t hstep = (size_t)HALF * K * 2;
    const size_t tstep = 2 * hstep;
    const unsigned ldsw = (unsigned)wid * 1024u;
    const int aoff = lds_byte(wr * 64 + fr, fq * 8), boff = lds_byte(wc * 32 + fr, fq * 8);
#define PG8_SA(b, h) (((b) * 2 + (h)) * HTB)
#define PG8_SB(b, h) ((4 + (b) * 2 + (h)) * HTB)
#define PG8_STAGE(bufoff, gbase, voff) do { _Pragma("unroll") for (int _i = 0; _i < 2; ++_i) \
        __builtin_amdgcn_global_load_lds((const unsigned*)((const char*)(gbase) + (voff)[_i]), (PG8_LAS unsigned*)(lds + (bufoff) + ldsw + _i * 8192), 16, 0, 0); } while (0)
#define PG8_STAGE_A(bufoff, gbase, h, nx) do { _Pragma("unroll") for (int _i = 0; _i < 2; ++_i) { \
        const unsigned _vo = Sched::GATHER ? ((nx) ? vN[h][_i] : vC[h][_i]) : (unsigned)((h) * hstep) + voffA[_i]; \
        __builtin_amdgcn_global_load_lds((const unsigned*)((const char*)(gbase) + _vo), (PG8_LAS unsigned*)(lds + (bufoff) + ldsw + _i * 8192), 16, 0, 0); } } while (0)
#define PG8_LDA(dst, b, h) do { _Pragma("unroll") for (int m = 0; m < 4; ++m) { if constexpr (FP8) { dst[m].lo = *(const PG8_LAS i32x4*)(lds + PG8_SA(b, h) + aoff + m * 2048); dst[m].hi = *(const PG8_LAS i32x4*)(lds + PG8_SA(b, h) + aoff + m * 2048 + 1024); } \
        else { _Pragma("unroll") for (int k = 0; k < 2; ++k) dst[m][k] = *(const PG8_LAS bf16x8*)(lds + PG8_SA(b, h) + aoff + m * 2048 + k * 1024); } } } while (0)
#define PG8_LDB(dst, b, h) do { _Pragma("unroll") for (int n = 0; n < 2; ++n) { if constexpr (FP8) { dst[n].lo = *(const PG8_LAS i32x4*)(lds + PG8_SB(b, h) + boff + n * 2048); dst[n].hi = *(const PG8_LAS i32x4*)(lds + PG8_SB(b, h) + boff + n * 2048 + 1024); } \
        else { _Pragma("unroll") for (int k = 0; k < 2; ++k) dst[n][k] = *(const PG8_LAS bf16x8*)(lds + PG8_SB(b, h) + boff + n * 2048 + k * 1024); } } } while (0)
#define PG8_CAT(x0, x1) __builtin_shufflevector(__builtin_bit_cast(i32x4, x0), __builtin_bit_cast(i32x4, x1), 0, 1, 2, 3, 4, 5, 6, 7)
#define PG8_MMA(ai, bj, At, Bt) do { __builtin_amdgcn_s_setprio(1); \
        if constexpr (FP8) { _Pragma("unroll") for (int m = 0; m < 4; ++m) _Pragma("unroll") for (int n = 0; n < 2; ++n) \
            acc[ai][bj][m][n] = __builtin_amdgcn_mfma_scale_f32_16x16x128_f8f6f4(Bt[n], At[m], acc[ai][bj][m][n], 0, 0, 0, 127, 0, 127); } \
        if constexpr (FP8) { asm volatile("" : "+v"(acc[ai][bj][0][0]), "+v"(acc[ai][bj][0][1]), "+v"(acc[ai][bj][1][0]), "+v"(acc[ai][bj][1][1]), "+v"(acc[ai][bj][2][0]), "+v"(acc[ai][bj][2][1]), "+v"(acc[ai][bj][3][0]), "+v"(acc[ai][bj][3][1])); }     \
        else { _Pragma("unroll") for (int m = 0; m < 4; ++m) _Pragma("unroll") for (int n = 0; n < 2; ++n) _Pragma("unroll") for (int k = 0; k < 2; ++k) \
            acc[ai][bj][m][n] = __builtin_amdgcn_mfma_f32_16x16x32_bf16(Bt[n][k], At[m][k], acc[ai][bj][m][n], 0, 0, 0); } \
        __builtin_amdgcn_s_setprio(0); } while (0)
#define PG8_WAIT_V(n) asm volatile("s_waitcnt vmcnt(" #n ")" ::: "memory")
#define PG8_WAIT_L(n) asm volatile("s_waitcnt lgkmcnt(" #n ")" ::: "memory")
#define PG8_BAR __builtin_amdgcn_s_barrier()
#define PG8_SCHED __builtin_amdgcn_sched_barrier(0)
    Unit cur, nxt; int ui = 0;
    if (!S.next(0, cur)) return;
    f32x4 acc[2][2][4][2];
#pragma unroll
    for (int a = 0; a < 2; ++a)
#pragma unroll
        for (int b = 0; b < 2; ++b)
#pragma unroll
            for (int m = 0; m < 4; ++m)
#pragma unroll
                for (int n = 0; n < 2; ++n) acc[a][b][m][n] = (f32x4){0.f, 0.f, 0.f, 0.f};
    typedef int i32x8 __attribute__((ext_vector_type(8)));
    typedef int i32x8 __attribute__((ext_vector_type(8)));
    typename std::conditional<FP8, i32x8[4], bf16x8[4][2]>::type At; typename std::conditional<FP8, i32x8[2], bf16x8[2][2]>::type B0, B1;
    const char* cA = (const char*)g.A + (Sched::GATHER ? (size_t)0 : (size_t)cur.pm * tstep); const char* cB = (const char*)g.Bt + cur.bo + (size_t)cur.pn * tstep;
    S.a_ready(cur);
#define PG8_VOFF(dst, un) do { _Pragma("unroll") for (int _h = 0; _h < 2; ++_h) _Pragma("unroll") for (int _i = 0; _i < 2; ++_i) { int R_, C_; stage_rc(tid * 16 + _i * 8192, R_, C_); dst[_h][_i] = S.a_off(un, _h * HALF + R_) + (unsigned)C_ * 2u; } } while (0)
    if constexpr (Sched::GATHER) { PG8_VOFF(vC, cur); }
    if constexpr (SP2) {
        PG8_STAGE(PG8_SB(0, 0), cB + PG8_KO(0), voffB); PG8_STAGE(PG8_SB(0, 1), cB + hstep + PG8_KO(0), voffB); PG8_STAGE_A(PG8_SA(0, 0), cA + PG8_KO(0), 0, false); PG8_STAGE_A(PG8_SA(0, 1), cA + PG8_KO(0), 1, false);
        if (wr == 1) PG8_BAR;
        PG8_WAIT_V(2); PG8_BAR;
        PG8_STAGE(PG8_SB(1, 0), cB + PG8_KO(1), voffB); PG8_STAGE_A(PG8_SA(1, 0), cA + PG8_KO(1), 0, false); PG8_STAGE(PG8_SB(1, 1), cB + hstep + PG8_KO(1), voffB);
        PG8_WAIT_V(6); PG8_BAR;
    } else {
        PG8_STAGE(PG8_SB(0, 0), cB, voffB); PG8_STAGE_A(PG8_SA(0, 0), cA, 0, false); PG8_STAGE(PG8_SB(0, 1), cB + hstep, voffB); PG8_STAGE_A(PG8_SA(0, 1), cA, 1, false);
        if (wr == 1) PG8_BAR;
        PG8_WAIT_V(4); PG8_BAR;
        PG8_STAGE(PG8_SB(1, 0), cB + PG8_KO(1), voffB); PG8_STAGE_A(PG8_SA(1, 0), cA + PG8_KO(1), 0, false); PG8_STAGE(PG8_SB(1, 1), cB + hstep + PG8_KO(1), voffB);
        PG8_WAIT_V(6); PG8_BAR;
    }
    for (;;) {
        const bool has_next = S.next(ui + 1, nxt);
        if constexpr (Sched::GATHER) { if (has_next) { PG8_VOFF(vN, nxt); } else { vN[0][0] = vC[0][0]; vN[0][1] = vC[0][1]; vN[1][0] = vC[1][0]; vN[1][1] = vC[1][1]; } }
        const char* nA = (has_next && !Sched::GATHER) ? (const char*)g.A + (size_t)nxt.pm * tstep : cA; const char* nB = has_next ? (const char*)g.Bt + nxt.bo + (size_t)nxt.pn * tstep : cB;
#pragma unroll 1
        for (int t = 0; t < nt; t += 2) {
            const bool last = (t == nt - 2);
            const char* a1 = cA + PG8_KO(t + 1);
            const char* a2 = last ? nA + PG8_KO(0) : cA + PG8_KO(t + 2); const char* b2 = last ? nB + PG8_KO(0) : cB + PG8_KO(t + 2);
            const char* a3 = last ? nA + PG8_KO(1) : cA + PG8_KO(t + 3); const char* b3 = last ? nB + PG8_KO(1) : cB + PG8_KO(t + 3);
            if (last && has_next) S.a_ready(nxt);
            if constexpr (SP2) {
            PG8_LDB(B0, 0, 0); PG8_LDB(B1, 0, 1); PG8_SCHED; PG8_LDA(At, 0, 0); PG8_STAGE_A(PG8_SA(1, 1), a1, 1, false);
            PG8_WAIT_V(8); PG8_WAIT_L(0); PG8_BAR; PG8_MMA(0, 0, At, B0); PG8_MMA(0, 1, At, B1); PG8_BAR; PG8_SCHED;
            PG8_LDA(At, 0, 1); PG8_STAGE(PG8_SB(0, 0), b2, voffB); PG8_STAGE(PG8_SB(0, 1), b2 + hstep, voffB); PG8_STAGE_A(PG8_SA(0, 0), a2, 0, last);
            PG8_WAIT_V(8); PG8_WAIT_L(0); PG8_BAR; PG8_MMA(1, 0, At, B0); PG8_MMA(1, 1, At, B1); PG8_BAR; PG8_SCHED;
            PG8_LDB(B0, 1, 0); PG8_LDB(B1, 1, 1); PG8_SCHED; PG8_LDA(At, 1, 0); PG8_STAGE_A(PG8_SA(0, 1), a2, 1, last);
            PG8_WAIT_V(8); PG8_WAIT_L(0); PG8_BAR; PG8_MMA(0, 0, At, B0); PG8_MMA(0, 1, At, B1); PG8_BAR; PG8_SCHED;
            PG8_LDA(At, 1, 1); PG8_STAGE(PG8_SB(1, 0), b3, voffB); PG8_STAGE(PG8_SB(1, 1), b3 + hstep, voffB); PG8_STAGE_A(PG8_SA(1, 0), a3, 0, last);
            PG8_WAIT_V(8); PG8_WAIT_L(0); PG8_BAR; PG8_MMA(1, 0, At, B0); PG8_MMA(1, 1, At, B1); PG8_BAR; PG8_SCHED;
            } else {
            PG8_LDB(B0, 0, 0); PG8_SCHED; PG8_LDA(At, 0, 0); PG8_STAGE_A(PG8_SA(1, 1), a1, 1, false);
            PG8_WAIT_L(8); PG8_BAR; PG8_WAIT_L(0); PG8_MMA(0, 0, At, B0); PG8_BAR; PG8_SCHED;
            PG8_LDB(B1, 0, 1); PG8_STAGE(PG8_SB(0, 0), b2, voffB);
            PG8_BAR; PG8_WAIT_L(0); PG8_MMA(0, 1, At, B1); PG8_BAR;
            PG8_LDA(At, 0, 1); PG8_STAGE_A(PG8_SA(0, 0), a2, 0, last);
            PG8_BAR; PG8_WAIT_L(0); PG8_MMA(1, 0, At, B0); PG8_BAR; PG8_SCHED;
            PG8_STAGE(PG8_SB(0, 1), b2 + hstep, voffB);
            PG8_WAIT_V(6); PG8_BAR; PG8_MMA(1, 1, At, B1); PG8_BAR;
            PG8_LDB(B0, 1, 0); PG8_SCHED; PG8_LDA(At, 1, 0); PG8_STAGE_A(PG8_SA(0, 1), a2, 1, last);
            PG8_WAIT_L(8); PG8_BAR; PG8_WAIT_L(0); PG8_MMA(0, 0, At, B0); PG8_BAR; PG8_SCHED;
            PG8_LDB(B1, 1, 1); PG8_STAGE(PG8_SB(1, 0), b3, voffB);
            PG8_BAR; PG8_WAIT_L(0); PG8_MMA(0, 1, At, B1); PG8_BAR;
            PG8_LDA(At, 1, 1); PG8_STAGE_A(PG8_SA(1, 0), a3, 0, last);
            PG8_BAR; PG8_WAIT_L(0); PG8_MMA(1, 0, At, B0); PG8_BAR; PG8_SCHED;
            PG8_STAGE(PG8_SB(1, 1), b3 + hstep, voffB);
            PG8_WAIT_V(6); PG8_BAR; PG8_MMA(1, 1, At, B1); PG8_BAR;
            }
        }
        if constexpr (ALIGN_EPI) { if (wr == 0) PG8_BAR; }
        if constexpr (!Epi::AFTER_DRAIN) { E(acc, cur, wr, wc, fr, fq); S.done(cur); }
        if (!has_next) break;
#pragma unroll
        for (int a = 0; a < 2; ++a)
#pragma unroll
            for (int b = 0; b < 2; ++b)
#pragma unroll
                for (int m = 0; m < 4; ++m)
#pragma unroll
                    for (int n = 0; n < 2; ++n) acc[a][b][m][n] = (f32x4){0.f, 0.f, 0.f, 0.f};
        cur = nxt; cA = nA; cB = nB; ++ui;
        if constexpr (Sched::GATHER) { vC[0][0] = vN[0][0]; vC[0][1] = vN[0][1]; vC[1][0] = vN[1][0]; vC[1][1] = vN[1][1]; }
        if constexpr (ALIGN_EPI) { if (wr == 1) PG8_BAR; }
    }
    PG8_WAIT_V(0);
    if constexpr (!ALIGN_EPI) { if (wr == 0) PG8_BAR; }
    PG8_BAR;
    if constexpr (Epi::AFTER_DRAIN) { E.fused(acc, cur, wr, wc, fr, fq, lds, wid, lane); S.done(cur); }
#undef PG8_VOFF
#undef PG8_KO
#undef PG8_SA
#undef PG8_SB
#undef PG8_STAGE
#undef PG8_STAGE_A
#undef PG8_LDA
#undef PG8_LDB
#undef PG8_MMA
#undef PG8_CAT
#undef PG8_WAIT_V
#undef PG8_WAIT_L
#undef PG8_BAR
#undef PG8_SCHED
}
}

namespace pg8 {
template <bool GATHER_>
struct GroupedOrder {
    static constexpr bool GATHER = GATHER_;
    const PG8_LAS int* tmap; const PG8_LAS int* cntl; const int* list; int nU, nN, G, c, lcap, rowbytes; size_t estride;
    __device__ __forceinline__ bool next(int i, Unit& u) const { const long L = (long)i * G + c; if (L >= nU) return false; const int t = (int)L / nN; const int m = __builtin_amdgcn_readfirstlane(tmap[t]);
        u.pm = t; u.pn = (int)L % nN; u.bo = (size_t)(m & 255) * estride; u.aux = m; return true; }
    __device__ __forceinline__ unsigned a_off(const Unit& u, int R) const { const int e = u.aux & 255, p0 = u.aux >> 8, ce = cntl[e]; int p = p0 + R; p = p < ce ? p : ce - 1; return (unsigned)list[(size_t)e * lcap + p] * (unsigned)rowbytes; }
    __device__ __forceinline__ void a_ready(const Unit&) const {}
    __device__ __forceinline__ void done(const Unit&) const {}
};
__device__ __forceinline__ u32x4 pack8(const f32x4 a, const f32x4 b) { u32x4 w; w.x = cvt_pk_bf16(a[0], a[1]); w.y = cvt_pk_bf16(a[2], a[3]); w.z = cvt_pk_bf16(b[0], b[1]); w.w = cvt_pk_bf16(b[2], b[3]); return w; }
struct EpiStore {
    static constexpr bool PERM = true, AFTER_DRAIN = false; bf16_t* O; int ldc;
    __device__ __forceinline__ void operator()(const f32x4 (&acc)[2][2][4][2], const Unit& u, int wr, int wc, int fr, int fq) const {
        const int row0 = u.pm * BM + wr * 64 + fr, col0 = u.pn * BM + wc * 32 + 8 * fq;
#pragma unroll
        for (int ai = 0; ai < 2; ++ai)
#pragma unroll
            for (int m = 0; m < 4; ++m) { bf16_t* rowp = O + (size_t)(row0 + ai * HALF + m * 16) * ldc + col0;
#pragma unroll
                for (int bj = 0; bj < 2; ++bj) *(u32x4*)(rowp + bj * HALF) = pack8(acc[ai][bj][m][0], acc[ai][bj][m][1]); }
    }
};
__device__ __forceinline__ f32x4 silu4(const f32x4 v) { f32x4 r;
#pragma unroll
    for (int i = 0; i < 4; ++i) r[i] = v[i] * __builtin_amdgcn_rcpf(1.f + __expf(-v[i])); return r; }
__device__ __forceinline__ f32x4 sigm4(const f32x4 v) { f32x4 r;
#pragma unroll
    for (int i = 0; i < 4; ++i) r[i] = __builtin_amdgcn_rcpf(1.f + __expf(-v[i])); return r; }
__device__ __forceinline__ u32x2 pack8_fp8(const f32x4 a, const f32x4 b) { int w0 = 0, w1 = 0;
    w0 = __builtin_amdgcn_cvt_pk_fp8_f32(a[0], a[1], w0, false); w0 = __builtin_amdgcn_cvt_pk_fp8_f32(a[2], a[3], w0, true);
    w1 = __builtin_amdgcn_cvt_pk_fp8_f32(b[0], b[1], w1, false); w1 = __builtin_amdgcn_cvt_pk_fp8_f32(b[2], b[3], w1, true); u32x2 r; r.x = (unsigned)w0; r.y = (unsigned)w1; return r; }
struct EpiSwiglu {
    static constexpr bool PERM = true, AFTER_DRAIN = false; bf16_t* G; float s;
    __device__ __forceinline__ void operator()(const f32x4 (&acc)[2][2][4][2], const Unit& u, int wr, int wc, int, int) const {
        const int ln = lane_id_now(), fr = ln & 15, fq = ln >> 4;
        const int row0 = u.pm * BM + wr * 64 + fr, col0 = u.pn * HALF + wc * 32 + 8 * fq;
#pragma unroll
        for (int ai = 0; ai < 2; ++ai)
#pragma unroll
            for (int m = 0; m < 4; ++m) *(u32x4*)(G + (size_t)(row0 + ai * HALF + m * 16) * 512 + col0) = pack8(silu4(acc[ai][0][m][0] * s) * (acc[ai][1][m][0] * s), silu4(acc[ai][0][m][1] * s) * (acc[ai][1][m][1] * s));
    }
};
struct EpiStoreScaled {
    static constexpr bool PERM = true, AFTER_DRAIN = false; bf16_t* O; int ldc; float s;
    __device__ __forceinline__ void operator()(const f32x4 (&acc)[2][2][4][2], const Unit& u, int wr, int wc, int fr, int fq) const {
        int row0 = u.pm * BM + wr * 64 + fr; const int col0 = u.pn * BM + wc * 32 + 8 * fq;
        asm volatile("" : "+v"(row0));
#pragma unroll
        for (int ai = 0; ai < 2; ++ai)
#pragma unroll
            for (int m = 0; m < 4; ++m) { bf16_t* rowp = O + (size_t)(row0 + ai * HALF + m * 16) * ldc + col0;
#pragma unroll
                for (int bj = 0; bj < 2; ++bj) *(u32x4*)(rowp + bj * HALF) = pack8(acc[ai][bj][m][0] * s, acc[ai][bj][m][1] * s); }
    }
};
__device__ __forceinline__ void unpack8f(const u32x4 w, f32x4& a, f32x4& b) {
    a[0] = __uint_as_float(w.x << 16); a[1] = __uint_as_float(w.x & 0xffff0000u); a[2] = __uint_as_float(w.y << 16); a[3] = __uint_as_float(w.y & 0xffff0000u);
    b[0] = __uint_as_float(w.z << 16); b[1] = __uint_as_float(w.z & 0xffff0000u); b[2] = __uint_as_float(w.w << 16); b[3] = __uint_as_float(w.w & 0xffff0000u); }
struct EpiGlu {
    static constexpr bool PERM = true, AFTER_DRAIN = false; const bf16_t* GS; const float* b; bf16_t* GG;
    __device__ __forceinline__ void operator()(const f32x4 (&acc)[2][2][4][2], const Unit& u, int wr, int wc, int fr, int fq) const {
        const int row0 = u.pm * BM + wr * 64 + fr, col0 = u.pn * BM + wc * 32 + 8 * fq;
#pragma unroll
        for (int bj = 0; bj < 2; ++bj) { const int c = col0 + bj * HALF; const f32x4 b0 = *(const f32x4*)(b + c), b1 = *(const f32x4*)(b + c + 4);
#pragma unroll
            for (int ai = 0; ai < 2; ++ai)
#pragma unroll
                for (int m = 0; m < 4; ++m) { const size_t o = (size_t)(row0 + ai * HALF + m * 16) * 512 + c; f32x4 g0, g1; unpack8f(*(const u32x4*)(GS + o), g0, g1);
                    *(u32x4*)(GG + o) = pack8(g0 * sigm4(acc[ai][bj][m][0] + b0), g1 * sigm4(acc[ai][bj][m][1] + b1)); } }
    }
};
struct EpiResid {
    static constexpr bool PERM = true, AFTER_DRAIN = false;
    const float* x; const float* ctx; const float* mod; bf16_t* XC; int inplace;
    __device__ __forceinline__ void operator()(const f32x4 (&acc)[2][2][4][2], const Unit& u, int wr, int wc, int fr, int fq) const {
        const int R0 = u.pm * BM; const int ci = R0 < 32768 ? (R0 >> 11) : 16;
        const float* base = R0 < 32768 ? x + (size_t)R0 * 1024 : ctx + (size_t)(R0 - 32768) * 1024;
        bf16_t* out = XC + (size_t)R0 * 1024; const float* gate = mod + ((size_t)ci * 6 + 2) * 1024;
        const int rl0 = wr * 64 + fr, col0 = u.pn * BM + wc * 32 + 8 * fq;
#pragma unroll
        for (int bj = 0; bj < 2; ++bj) { const int c = col0 + bj * HALF; const f32x4 g0 = *(const f32x4*)(gate + c), g1 = *(const f32x4*)(gate + c + 4);
#pragma unroll
            for (int ai = 0; ai < 2; ++ai)
#pragma unroll
                for (int m = 0; m < 4; ++m) { const size_t o = (size_t)(rl0 + ai * HALF + m * 16) * 1024 + c; f32x4 b0, b1;
                    if (inplace) unpack8f(*(const u32x4*)(out + o), b0, b1); else { b0 = *(const f32x4*)(base + o); b1 = *(const f32x4*)(base + o + 4); }
                    *(u32x4*)(out + o) = pack8(b0 + g0 * acc[ai][bj][m][0], b1 + g1 * acc[ai][bj][m][1]); } }
    }
};
}

#include <hip/hip_bf16.h>
#include <cmath>
namespace attn_body {
using bf16=__hip_bfloat16;
using bf16x8=__attribute__((ext_vector_type(8)))short;
using s16x4=__attribute__((ext_vector_type(4)))short;
using f32x16=__attribute__((ext_vector_type(16)))float;
using u32x4=__attribute__((ext_vector_type(4)))unsigned;
constexpr int D=64,QP=512,KP=128,OP=1024;
constexpr int NW=8,QBLK=32,QB=QBLK*NW,KVBLK=64;
constexpr int ATTN_UNIT_ROWS=QB;
__device__ __forceinline__ int crow(int r,int hi){return (r&3)+8*(r>>2)+4*hi;}
#define SBAR() __builtin_amdgcn_sched_barrier(0)
__device__ __forceinline__ void cmask(f32x16&p0,f32x16&p1,int jb,int qrel,int hi){
  const float NEG=-INFINITY; int kb=64*jb+4*hi;
  #pragma unroll
  for(int r=0;r<16;++r){int kv=kb+(r&3)+8*(r>>2); if(kv>qrel)p0[r]=NEG; if(kv+32>qrel)p1[r]=NEG;}
}

constexpr int NSLOT=3, SLOTB=8192;
constexpr int LDS_K=0, LDS_V=NSLOT*SLOTB, LDS_WS=2*NSLOT*SLOTB, LDS_OST=LDS_WS+NW*64*4, LDS_BYTES=LDS_OST+NW*4096;
constexpr float C2=0.125f*1.4426950408889634f;
__device__ __forceinline__ void glds16(const void*gsrc,unsigned lds_dst){unsigned keep;
  asm volatile("s_mov_b32 %0, m0\n\ts_mov_b32 m0, %2\n\ts_nop 0\n\tglobal_load_lds_dwordx4 %1, off\n\ts_mov_b32 m0, %0":"=&s"(keep):"v"(gsrc),"s"(lds_dst):"memory");}
__device__ __forceinline__ float max3f(float a,float b,float c){float r;asm("v_max3_f32 %0, %1, %2, %3":"=v"(r):"v"(a),"v"(b),"v"(c));return r;}
__device__ __forceinline__ float max2f(float a,float b){float r;asm("v_max_f32_e32 %0, %1, %2":"=v"(r):"v"(a),"v"(b));return r;}
__device__ __forceinline__ float fadd_s(float a,float b){float r;asm("v_add_f32_e32 %0, %1, %2":"=v"(r):"v"(a),"v"(b));return r;}
__device__ __forceinline__ float fsub_s(float a,float b){float r;asm("v_sub_f32_e32 %0, %1, %2":"=v"(r):"v"(a),"v"(b));return r;}
typedef float f32x2_t __attribute__((ext_vector_type(2))); typedef __bf16 bf16x2_t __attribute__((ext_vector_type(2)));
__device__ __forceinline__ unsigned cvtpk_s(float lo,float hi){f32x2_t v={lo,hi};bf16x2_t b=__builtin_convertvector(v,bf16x2_t);return __builtin_bit_cast(unsigned,b);}
#define WAIT_BAR(N) asm volatile("s_waitcnt vmcnt(" #N ") lgkmcnt(0)\n\ts_barrier":::"memory")

__device__ __forceinline__ void qkt(f32x16&p0,f32x16&p1,const char*Kslot,const bf16x8*qr,const f32x16&negm,int r32,int hi){
  const char*kb=Kslot+hi*1024+r32*16;
  #pragma unroll
  for(int d0=0;d0<4;++d0){
    const bf16x8 b0=*reinterpret_cast<const bf16x8*>(kb+d0*2048);
    const bf16x8 b1=*reinterpret_cast<const bf16x8*>(kb+d0*2048+512);
    if(d0==0){p0=__builtin_amdgcn_mfma_f32_32x32x16_bf16(b0,qr[0],negm,0,0,0);p1=__builtin_amdgcn_mfma_f32_32x32x16_bf16(b1,qr[0],negm,0,0,0);}
    else{p0=__builtin_amdgcn_mfma_f32_32x32x16_bf16(b0,qr[d0],p0,0,0,0);p1=__builtin_amdgcn_mfma_f32_32x32x16_bf16(b1,qr[d0],p1,0,0,0);}}
}
typedef __attribute__((address_space(3))) const char* lds_cptr;
typedef short v4i16_t __attribute__((ext_vector_type(4)));
__device__ __forceinline__ void kload8(bf16x8*kf,lds_cptr kp){
  kf[0]=*(const __attribute__((address_space(3))) bf16x8*)(kp);      kf[1]=*(const __attribute__((address_space(3))) bf16x8*)(kp+512);
  kf[2]=*(const __attribute__((address_space(3))) bf16x8*)(kp+2048); kf[3]=*(const __attribute__((address_space(3))) bf16x8*)(kp+2560);
  kf[4]=*(const __attribute__((address_space(3))) bf16x8*)(kp+4096); kf[5]=*(const __attribute__((address_space(3))) bf16x8*)(kp+4608);
  kf[6]=*(const __attribute__((address_space(3))) bf16x8*)(kp+6144); kf[7]=*(const __attribute__((address_space(3))) bf16x8*)(kp+6656);
}
__device__ __forceinline__ void kload2(bf16x8*kf,lds_cptr kp,int j){ kf[2*j]=*(const __attribute__((address_space(3))) bf16x8*)(kp+j*2048); kf[2*j+1]=*(const __attribute__((address_space(3))) bf16x8*)(kp+j*2048+512); }
__device__ __forceinline__ s16x4 vtr(lds_cptr p){ return __builtin_bit_cast(s16x4,__builtin_amdgcn_ds_read_tr16_b64_v4i16((__attribute__((address_space(3))) v4i16_t*)p)); }
__device__ __forceinline__ float rowmax(const f32x16&p0,const f32x16&p1){
  float a=max3f(p0[0],p0[1],p1[0]),b=max3f(p0[2],p0[3],p1[1]);a=max3f(a,p1[2],p1[3]);
  #pragma unroll
  for(int r=4;r<16;r+=4){a=max3f(a,p0[r],p0[r+1]);b=max3f(b,p0[r+2],p0[r+3]);a=max3f(a,p1[r],p1[r+1]);b=max3f(b,p1[r+2],p1[r+3]);}
  const float m=max2f(a,b);
  auto rr=__builtin_amdgcn_permlane32_swap(__float_as_uint(m),__float_as_uint(m),false,false);
  return max2f(__uint_as_float(rr[0]),__uint_as_float(rr[1]));
}
__device__ __forceinline__ void pv(f32x16*o,int vb,bf16x8 pa0,bf16x8 pa1,bf16x8 pa2,bf16x8 pa3){
  #pragma unroll
  for(int d0=0;d0<2;++d0){s16x4 lo[4],hi[4];
    #pragma unroll
    for(int ks=0;ks<4;++ks){
      asm volatile("ds_read_b64_tr_b16 %0,%1 offset:%c2":"=&v"(lo[ks]):"v"(vb),"i"(d0*4096+ks*1024):"memory");
      asm volatile("ds_read_b64_tr_b16 %0,%1 offset:%c2":"=&v"(hi[ks]):"v"(vb),"i"(d0*4096+ks*1024+512):"memory");}
    asm volatile("s_waitcnt lgkmcnt(0)":::"memory");SBAR();
    #define PK(k) (bf16x8){lo[k][0],lo[k][1],lo[k][2],lo[k][3],hi[k][0],hi[k][1],hi[k][2],hi[k][3]}
    o[d0]=__builtin_amdgcn_mfma_f32_32x32x16_bf16(pa0,PK(0),o[d0],0,0,0);
    o[d0]=__builtin_amdgcn_mfma_f32_32x32x16_bf16(pa1,PK(1),o[d0],0,0,0);
    o[d0]=__builtin_amdgcn_mfma_f32_32x32x16_bf16(pa2,PK(2),o[d0],0,0,0);
    o[d0]=__builtin_amdgcn_mfma_f32_32x32x16_bf16(pa3,PK(3),o[d0],0,0,0);
    #undef PK
  }
}

#ifndef ATTN_STORE16
#define ATTN_STORE16(p,v) (*(u32x4*)(p)=(v))
#endif
template<int THRL> __device__ __forceinline__ void attn_unit(const bf16*Q0,const bf16*__restrict__ Kh,const bf16*__restrict__ Vh,bf16*O0,const int NT,char*shm){
  const int tid=threadIdx.x,lane=tid&63,r32=lane&31,hi=lane>>5; const int wid=__builtin_amdgcn_readfirstlane(tid>>6);
  const bf16*Qw=Q0+(long)(wid*QBLK)*QP;
  const unsigned lds0=(unsigned)(uintptr_t)shm;
  float*wsf=(float*)(shm+LDS_WS)+wid*64;
  const bf16*ksrc=Kh+(long)lane*KP+wid*8;
  const bf16*vsrc=Vh+(long)(16*(wid&3)+(lane>>2))*KP+(wid>>2)*32+(lane&3)*8;
  const unsigned kdst=lds0+LDS_K+wid*1024, vdst=lds0+LDS_V+wid*1024;
  #define DMA_K(t,slot) glds16(ksrc+(long)(t)*KVBLK*KP,(unsigned)__builtin_amdgcn_readfirstlane(kdst+(slot)))
  #define DMA_V(t,slot) glds16(vsrc+(long)(t)*KVBLK*KP,(unsigned)__builtin_amdgcn_readfirstlane(vdst+(slot)))
  const int vb0=(int)(lds0+LDS_V)+((lane>>4)&1)*32+(lane&3)*8+(4*hi+((lane&15)>>2))*64;
  const char*Kbase=shm+LDS_K; bf16x8 kf[8];
  const lds_cptr shm3=(lds_cptr)shm; const lds_cptr kp0=shm3+LDS_K+hi*1024+r32*16; const lds_cptr vp0=shm3+LDS_V+((lane>>4)&1)*32+(lane&3)*8+(4*hi+((lane&15)>>2))*64;
  DMA_K(0,0);DMA_V(0,0);DMA_K(1,SLOTB);
  bf16x8 qr[4];
  #pragma unroll
  for(int d0=0;d0<4;++d0)qr[d0]=*reinterpret_cast<const bf16x8*>(&Qw[(long)r32*QP+d0*16+hi*8]);
  float mhat=0.f,l_reg=0.f;f32x16 o[2];o[0]=f32x16{};o[1]=f32x16{};f32x16 negm=f32x16{};asm volatile("":"+v"(negm));
  #define CMASK(P0,P1,t) do{}while(0)
  bool resc=false;
  #define START(P0,P1) do{ const float rm=rowmax(P0,P1); resc=false; \
    { const float dl=rm; mhat=fadd_s(mhat,dl); \
      _Pragma("unroll") for(int r=0;r<16;++r){P0[r]=fsub_s(P0[r],dl);P1[r]=fsub_s(P1[r],dl);} \
      _Pragma("unroll") for(int r=0;r<16;++r)negm[r]=-mhat; asm volatile("":"+v"(negm)); } \
    _Pragma("unroll") for(int r=0;r<16;++r)P0[r]=__builtin_amdgcn_exp2f(P0[r]); }while(0)
  #define RESC() do{ if(resc){ asm volatile("s_waitcnt lgkmcnt(0)":::"memory"); \
      _Pragma("unroll") for(int d_=0;d_<2;++d_) _Pragma("unroll") for(int r=0;r<16;++r)o[d_][r]*=wsf[crow(r,hi)]; } }while(0)
  f32x16 pA0,pA1,pB0,pB1;
  int sl_prev=0,sl_cur=0,sl_next=SLOTB;
  #define ROT() do{sl_prev=sl_cur;sl_cur=sl_next;sl_next=(sl_next==(NSLOT-1)*SLOTB)?0:sl_next+SLOTB;}while(0)
  DMA_K(2,2*SLOTB);
  WAIT_BAR(3);
  qkt(pA0,pA1,Kbase,qr,negm,r32,hi);asm volatile("s_nop 15\n\ts_nop 7":"+v"(pA0),"+v"(pA1));CMASK(pA0,pA1,0);
  START(pA0,pA1);
  _Pragma("unroll") for(int r=0;r<16;++r)pA1[r]=__builtin_amdgcn_exp2f(pA1[r]);
  WAIT_BAR(0);
  DMA_K(3,0);DMA_V(1,SLOTB);
  ROT();
  kload8(kf,kp0+sl_cur);
  WAIT_BAR(2);
  s16x4 vlo[8],vhi[8]; u32x4 pw0,pw1,pw2,pw3;
  #define PKW(P,B) cvtpk_s(P[B],P[B+1])
  #define PAF(k) __builtin_bit_cast(bf16x8,pw##k)
  #define VFR(i) (bf16x8){vlo[i][0],vlo[i][1],vlo[i][2],vlo[i][3],vhi[i][0],vhi[i][1],vhi[i][2],vhi[i][3]}
  #define PIN(x) asm volatile("":"+v"(x))
  #define MX3(a,b,c) __builtin_fmaxf(__builtin_fmaxf((a),(b)),(c))
  #define GAPA(MF,A0,A1,A2,A3,W0,W1,PW) do{ MF; sacc+=A0; sacc+=A1; sacc+=A2; sacc+=A3; PIN(sacc); W0; W1; PIN(PW); SBAR(); }while(0)
  #define EX(v) __builtin_amdgcn_exp2f(v)
  #define GAPB(MF,X,B) do{ MF; X[B]=EX(X[B]); X[B+1]=EX(X[B+1]); X[B+2]=EX(X[B+2]); X[B+3]=EX(X[B+3]); PIN(X); SBAR(); }while(0)
  #define VRD(i) do{ vlo[i]=vtr(vp_+(((i)>>2)*4096+((i)&3)*1024)); vhi[i]=vtr(vp_+(((i)>>2)*4096+((i)&3)*1024+512)); }while(0)
  #define KRD(G,j) do{ if(G){ kload2(kf,kp0+sl_next,j); SBAR(); } }while(0)
  #define STEP(C0,C1,P0,P1,t,GK,GV,GL) do{ SBAR(); \
    const lds_cptr vp_=vp0+sl_prev; \
    VRD(0); SBAR(); float sacc=(P0[0]+P0[1]); \
    GAPA(C0=__builtin_amdgcn_mfma_f32_32x32x16_bf16(kf[0],qr[0],negm,0,0,0), P0[2],P0[3],P0[4],P0[5],     pw0[0]=PKW(P0,0), pw0[1]=PKW(P0,2), pw0); \
    VRD(4); SBAR(); GAPA(C1=__builtin_amdgcn_mfma_f32_32x32x16_bf16(kf[1],qr[0],negm,0,0,0), P0[6],P0[7],P0[8],P0[9],     pw0[2]=PKW(P0,4), pw0[3]=PKW(P0,6), pw0); \
    VRD(1); SBAR(); GAPA(C0=__builtin_amdgcn_mfma_f32_32x32x16_bf16(kf[2],qr[1],C0,0,0,0),   P0[10],P0[11],P0[12],P0[13], pw1[0]=PKW(P0,8), pw1[1]=PKW(P0,10), pw1); \
    VRD(5); SBAR(); GAPA(C1=__builtin_amdgcn_mfma_f32_32x32x16_bf16(kf[3],qr[1],C1,0,0,0),   P0[14],P0[15],P1[0],P1[1],   pw1[2]=PKW(P0,12),pw1[3]=PKW(P0,14), pw1); \
    VRD(2); SBAR(); GAPA(C0=__builtin_amdgcn_mfma_f32_32x32x16_bf16(kf[4],qr[2],C0,0,0,0),   P1[2],P1[3],P1[4],P1[5],     pw2[0]=PKW(P1,0), pw2[1]=PKW(P1,2), pw2); \
    VRD(6); SBAR(); GAPA(C1=__builtin_amdgcn_mfma_f32_32x32x16_bf16(kf[5],qr[2],C1,0,0,0),   P1[6],P1[7],P1[8],P1[9],     pw2[2]=PKW(P1,4), pw2[3]=PKW(P1,6), pw2); \
    VRD(3); SBAR(); GAPA(C0=__builtin_amdgcn_mfma_f32_32x32x16_bf16(kf[6],qr[3],C0,0,0,0),   P1[10],P1[11],P1[12],P1[13], pw3[0]=PKW(P1,8), pw3[1]=PKW(P1,10), pw3); \
    VRD(7); SBAR(); GAPA(C1=__builtin_amdgcn_mfma_f32_32x32x16_bf16(kf[7],qr[3],C1,0,0,0),   P1[14],P1[15],0.f,0.f,       pw3[2]=PKW(P1,12),pw3[3]=PKW(P1,14), pw3); \
    l_reg+=sacc; \
    if(GK){DMA_K((t)+3,sl_cur);} if(GV){DMA_V((t)+1,sl_next);} \
    CMASK(C0,C1,t); \
    { float a=MX3(C0[0],C0[1],C1[0]),b=MX3(C0[2],C0[3],C1[1]); a=MX3(a,C1[2],C1[3]); \
      _Pragma("unroll") for(int r=4;r<16;r+=4){a=MX3(a,C0[r],C0[r+1]);b=MX3(b,C0[r+2],C0[r+3]);a=MX3(a,C1[r],C1[r+1]);b=MX3(b,C1[r+2],C1[r+3]);} \
      float rm=__builtin_fmaxf(a,b); { auto rr=__builtin_amdgcn_permlane32_swap(__float_as_uint(rm),__float_as_uint(rm),false,false); rm=__builtin_fmaxf(__uint_as_float(rr[0]),__uint_as_float(rr[1])); } \
      resc=false; \
      if(__builtin_expect(__any(rm>(float)THRL),0)){ const float dl=__builtin_fmaxf(rm,0.f); mhat+=dl; \
        _Pragma("unroll") for(int r=0;r<16;++r){C0[r]-=dl;C1[r]-=dl;} \
        _Pragma("unroll") for(int r=0;r<16;++r)negm[r]=-mhat; asm volatile("":"+v"(negm)); \
        const float f=__builtin_amdgcn_exp2f(-dl); l_reg*=f; if(hi==0)wsf[r32]=f; resc=true; } } \
    SBAR(); \
    GAPB(o[0]=__builtin_amdgcn_mfma_f32_32x32x16_bf16(PAF(0),VFR(0),o[0],0,0,0), C0,0); \
    GAPB(o[1]=__builtin_amdgcn_mfma_f32_32x32x16_bf16(PAF(0),VFR(4),o[1],0,0,0), C0,4); \
    KRD(GL,0); GAPB(o[0]=__builtin_amdgcn_mfma_f32_32x32x16_bf16(PAF(1),VFR(1),o[0],0,0,0), C0,8); \
    KRD(GL,1); GAPB(o[1]=__builtin_amdgcn_mfma_f32_32x32x16_bf16(PAF(1),VFR(5),o[1],0,0,0), C0,12); \
    KRD(GL,2); GAPB(o[0]=__builtin_amdgcn_mfma_f32_32x32x16_bf16(PAF(2),VFR(2),o[0],0,0,0), C1,0); \
    KRD(GL,3); GAPB(o[1]=__builtin_amdgcn_mfma_f32_32x32x16_bf16(PAF(2),VFR(6),o[1],0,0,0), C1,4); \
    GAPB(o[0]=__builtin_amdgcn_mfma_f32_32x32x16_bf16(PAF(3),VFR(3),o[0],0,0,0), C1,8); \
    GAPB(o[1]=__builtin_amdgcn_mfma_f32_32x32x16_bf16(PAF(3),VFR(7),o[1],0,0,0), C1,12); \
    }while(0)
  int t=1;
  #undef CMASK
  #define CMASK(P0,P1,t) do{}while(0)
  for(;t+5<NT;t+=2){
    STEP(pB0,pB1,pA0,pA1,t,true,true,true);     WAIT_BAR(2); RESC(); ROT();
    STEP(pA0,pA1,pB0,pB1,t+1,true,true,true);   WAIT_BAR(2); RESC(); ROT();
  }
  #undef CMASK
  #define CMASK(P0,P1,t) do{}while(0)
  #define ENDW(tt) do{ if((tt)+3<NT){WAIT_BAR(2);} else if((tt)+2<NT){WAIT_BAR(1);} else {WAIT_BAR(0);} }while(0)
  for(;t+1<NT;t+=2){
    STEP(pB0,pB1,pA0,pA1,t,(t+3<NT),(t+1<NT),(t+1<NT));       ENDW(t);   RESC(); ROT();
    STEP(pA0,pA1,pB0,pB1,t+1,(t+4<NT),(t+2<NT),(t+2<NT));     ENDW(t+1); RESC(); ROT();
  }
  STEP(pB0,pB1,pA0,pA1,NT-1,false,false,false); RESC();
  { float sacc=pB0[0]+pB0[1]; _Pragma("unroll") for(int r=2;r<16;++r)sacc+=pB0[r]; _Pragma("unroll") for(int r=0;r<16;++r)sacc+=pB1[r]; l_reg+=sacc;
    pw0=(u32x4){PKW(pB0,0),PKW(pB0,2),PKW(pB0,4),PKW(pB0,6)};pw1=(u32x4){PKW(pB0,8),PKW(pB0,10),PKW(pB0,12),PKW(pB0,14)};pw2=(u32x4){PKW(pB1,0),PKW(pB1,2),PKW(pB1,4),PKW(pB1,6)};pw3=(u32x4){PKW(pB1,8),PKW(pB1,10),PKW(pB1,12),PKW(pB1,14)};
    SBAR(); pv(o,vb0+sl_cur,PAF(0),PAF(1),PAF(2),PAF(3)); }
  #undef PKW
  #undef PAF
  #undef VFR
  #undef PIN
  #undef MX3
  #undef GAPA
  #undef GAPB
  #undef EX
  #undef VRD
  #undef KRD
  #undef STEP
  #undef ENDW
  {auto rr=__builtin_amdgcn_permlane32_swap(__float_as_uint(l_reg),__float_as_uint(l_reg),false,false);l_reg=__uint_as_float(rr[0])+__uint_as_float(rr[1]);}
  if(hi==0)wsf[32+r32]=l_reg;asm volatile("s_waitcnt lgkmcnt(0)":::"memory");
  float rli[16];
  #pragma unroll
  for(int r=0;r<16;++r)rli[r]=__builtin_amdgcn_rcpf(wsf[32+crow(r,hi)]);
  bf16*Ow=O0+(long)(wid*QBLK)*OP;
  { bf16*stg=(bf16*)(shm+LDS_OST)+wid*2048;
    #pragma unroll
    for(int r=0;r<16;++r){const int orow=crow(r,hi);
      #pragma unroll
      for(int d0=0;d0<2;++d0)stg[orow*64+d0*32+r32]=__float2bfloat16(o[d0][r]*rli[r]);}
    asm volatile("s_waitcnt lgkmcnt(0)":::"memory");
    #pragma unroll
    for(int i=0;i<4;++i){const int row=i*8+(lane>>3),ch=lane&7; const u32x4 v=*(const u32x4*)(stg+row*64+ch*8); ATTN_STORE16(Ow+(long)row*OP+ch*8,v);} }
  asm volatile("s_waitcnt lgkmcnt(0)\n\ts_barrier":::"memory");
  #undef DMA_K
  #undef DMA_V
  #undef CMASK
  #undef START
  #undef RESC
  #undef ROT
}
constexpr int ATTN_LDS_BYTES=LDS_BYTES;
#undef SBAR
#undef WAIT_BAR
}

struct Params {
    const float* in[35];
    float* out;
    unsigned char* ws;
    int ph_lo, ph_hi;
};
enum { I_X = 0, I_C, I_CTX, I_CCTX, I_WMOD, I_BMOD, I_GMIX, I_GFFN, I_MIXWIN, I_MIXWOUT, I_QG, I_KG, I_LNG, I_WSP, I_BSP,
       I_S5WIN, I_ARE, I_AIM, I_LOGDT, I_BRE, I_BIM, I_CRE, I_CIM, I_S5D, I_WGLU, I_BGLU, I_S5WOUT,
       I_WGRP, I_BGRP, I_WRT, I_BRT, I_W1, I_W3, I_W2, I_FING };

struct Ctx {
    const Params* p;
    unsigned char* ws;
    LAS unsigned char* lds;
    int tid, lane, wave, gw, ngw;
};
__device__ __forceinline__ const float* xin_row(const Params& P, int r) { return r < TL ? P.in[I_X] + (size_t)r * D : P.in[I_CTX] + (size_t)(r - TL) * D; }
__device__ __forceinline__ int cond_of(int r) { return r < TL ? (r >> 11) : 16; }
__device__ __forceinline__ const float* mod_vec(const Ctx& C, int layer, int ci, int k) { return (const float*)(C.ws + WS_MOD) + ((size_t)(layer * 17 + ci) * 6 + k) * D; }

__device__ __forceinline__ void dsincos(double a, double& s, double& c) {
    const double TWO_PI_HI = 6.283185307179586, TWO_PI_LO = 2.4492935982947064e-16;
    const double k = rint(a * 0.15915494309189535);
    double r = fma(-k, TWO_PI_HI, a); r = fma(-k, TWO_PI_LO, r);
    const double r2 = r * r; double ct = 1.0, st = r, cs = 1.0, ss = r;
#pragma unroll 1
    for (int i = 1; i <= 15; ++i) { ct *= -r2 / (double)((2 * i - 1) * (2 * i)); cs += ct; st *= -r2 / (double)((2 * i) * (2 * i + 1)); ss += st; }
    s = ss; c = cs;
}

struct TItem { const float* src; int N, k0, n0; bf16* dst; int dp; float f8s; };
__device__ __forceinline__ void t_load(const TItem& t, int lane, float (&r)[32]) {
#pragma unroll
    for (int i = 0; i < 32; ++i) r[i] = t.src[(size_t)(t.k0 + 2 * i + (lane >> 5)) * t.N + t.n0 + (lane & 31)];
}
__device__ __forceinline__ void t_store(const TItem& t, int lane, const float (&r)[32], LAS float* scr) {
#pragma unroll
    for (int i = 0; i < 32; ++i) scr[(2 * i + (lane >> 5)) * 33 + (lane & 31)] = r[i];
    asm volatile("s_waitcnt lgkmcnt(0)" ::: "memory");
    const int c = lane & 7;
    if (t.f8s != 0.f) {
#pragma unroll
        for (int j = 0; j < 4; ++j) { const int n = (lane >> 3) + 8 * j; const LAS float* s = scr + (8 * c) * 33 + n; const float q = t.f8s;
            *(pg8::u32x2*)((unsigned char*)t.dst + (size_t)n * t.dp + 8 * c) = pg8::pack8_fp8((f32x4){s[0 * 33] * q, s[1 * 33] * q, s[2 * 33] * q, s[3 * 33] * q}, (f32x4){s[4 * 33] * q, s[5 * 33] * q, s[6 * 33] * q, s[7 * 33] * q}); }
    } else {
#pragma unroll
        for (int j = 0; j < 4; ++j) { const int n = (lane >> 3) + 8 * j; const LAS float* s = scr + (8 * c) * 33 + n;
            v4u o; o.x = pk2(s[0 * 33], s[1 * 33]); o.y = pk2(s[2 * 33], s[3 * 33]); o.z = pk2(s[4 * 33], s[5 * 33]); o.w = pk2(s[6 * 33], s[7 * 33]);
            *(v4u*)(t.dst + (size_t)n * t.dp + 8 * c) = o; }
    }
    asm volatile("s_waitcnt lgkmcnt(0)" ::: "memory");
}
__device__ __forceinline__ TItem mat_item(const float* W, int K, int N, bf16* WT, int it) {
    const int nblk = N / 32, kb = it / nblk, nb = it % nblk;
    return TItem{W, N, kb * 64, nb * 32, WT + (size_t)(nb * 32) * K + kb * 64, K, 0.f};
}
constexpr int MOE_ITEMS = NEXP * 768;
__device__ __forceinline__ TItem moe_item(const Ctx& C, int layer, int it) {
    const Params& P = *C.p;
    const int e = it / 768, r = it % 768, kind = r / 256, j = r % 256;
    if (kind < 2) {
        const float* src = (kind == 0 ? P.in[I_W1] : P.in[I_W3]) + ((size_t)layer * NEXP + e) * D * EH;
        const int kb = j / 16, nb = j % 16, k0 = kb * 64, n0 = nb * 32;
        const int drow = (n0 / 128) * 256 + (n0 % 128) + (kind == 1 ? 128 : 0);
        return TItem{src, EH, k0, n0, (bf16*)((unsigned char*)(C.ws + WS_W13) + (size_t)e * 1024 * 1024 + (size_t)drow * 1024 + k0), 1024, W13_SCALE};
    }
    const float* src = P.in[I_W2] + ((size_t)layer * NEXP + e) * EH * D;
    const int kb = j / 32, nb = j % 32, k0 = kb * 64, n0 = nb * 32;
    return TItem{src, D, k0, n0, (bf16*)(C.ws + WS_W2) + (size_t)e * 1024 * 512 + (size_t)n0 * 512 + k0, 512, 0.f};
}
constexpr int TI0 = 16 * 56, TI1 = 16 * 32, TI2 = 16 * 16, TI3 = 8 * 16, TI4 = 8 * 32, NSMALL = TI0 + TI1 + TI2 + TI3 + TI4;
__device__ __forceinline__ TItem conv_item(const Ctx& C, int layer, int nsmall, int it) {
    const Params& P = *C.p; int r = it;
    if (r < nsmall) {
        if (r < TI0) return mat_item(P.in[I_MIXWIN], D, MIXW, (bf16*)(C.ws + WS_WIN0), r); r -= TI0;
        if (r < TI1) return mat_item(P.in[I_MIXWOUT], D, D, (bf16*)(C.ws + WS_WOUT0), r); r -= TI1;
        if (r < TI2) return mat_item(P.in[I_S5WIN], D, 512, (bf16*)(C.ws + WS_WS5IN), r); r -= TI2;
        if (r < TI3) return mat_item(P.in[I_WGLU], 512, 512, (bf16*)(C.ws + WS_WGLU), r); r -= TI3;
        return mat_item(P.in[I_S5WOUT], 512, D, (bf16*)(C.ws + WS_WS5OUT), r);
    }
    return moe_item(C, layer, r - nsmall);
}
__device__ __forceinline__ void convert_items(const Ctx& C, int layer, int nsmall) {
    LAS float* scr = (LAS float*)(C.lds + C.wave * 16384);
    const int total = nsmall + MOE_ITEMS, n = C.ngw;
    for (int it = C.gw; it < total; it += 2 * n) {
        const bool two = it + n < total;
        const TItem ta = conv_item(C, layer, nsmall, it), tb = conv_item(C, layer, nsmall, two ? it + n : it);
        float ra[32], rb[32];
        t_load(ta, C.lane, ra); if (two) t_load(tb, C.lane, rb);
        t_store(ta, C.lane, ra, scr); if (two) t_store(tb, C.lane, rb, scr);
    }
}

__device__ __forceinline__ void phase_prologue(const Ctx& C) {
    const Params& P = *C.p;
    {
        LAS float* s = (LAS float*)C.lds;
        LAS float* red = (LAS float*)(C.lds + 17 * 1024 * 4);
        bool have_s = false;
        for (int u = blockIdx.x; u < 192; u += gridDim.x) {
            if (!have_s) {
                for (int i = C.tid; i < 17 * 1024; i += NTHR) { const int ci = i >> 10, k = i & 1023; const float v = ci < 16 ? P.in[I_C][ci * D + k] : P.in[I_CCTX][k]; s[i] = silu_(v); }
                have_s = true; __syncthreads();
            }
            const int layer = u / 96, jg = u % 96, kq = C.tid >> 6, jc = C.tid & 63;
            const float* w = P.in[I_WMOD] + (size_t)layer * D * 6144 + jg * 64 + jc;
            float acc[17];
#pragma unroll
            for (int i = 0; i < 17; ++i) acc[i] = 0.f;
            for (int k0 = kq * 128; k0 < kq * 128 + 128; k0 += 16) {
                float wv[16];
#pragma unroll
                for (int j = 0; j < 16; ++j) wv[j] = w[(size_t)(k0 + j) * 6144];
#pragma unroll
                for (int j = 0; j < 16; ++j)
#pragma unroll
                    for (int i = 0; i < 17; ++i) acc[i] += s[i * 1024 + k0 + j] * wv[j]; }
#pragma unroll
            for (int i = 0; i < 17; ++i) red[(kq * 17 + i) * 64 + jc] = acc[i];
            __syncthreads();
            for (int o = C.tid; o < 17 * 64; o += NTHR) { const int ci = o >> 6, c = o & 63; float v = 0.f;
#pragma unroll
                for (int q = 0; q < 8; ++q) v += red[(q * 17 + ci) * 64 + c];
                const int j = jg * 64 + c; v += P.in[I_BMOD][layer * 6144 + j];
                ((float*)(C.ws + WS_MOD))[((size_t)(layer * 17 + ci)) * 6144 + j] = v; }
            __syncthreads();
        }
        __syncthreads();
    }
    {
        const int gt = blockIdx.x * NTHR + C.tid, ngt = gridDim.x * NTHR;
        float2* rope = (float2*)(C.ws + WS_TAB + TAB_ROPE);
        for (int i = gt; i < 64 * 16; i += ngt) { const int pos = i >> 4, f = i & 15;
            const double th = exp(-(double)f * (9.210340371976184 / 16.0)); double s, c; dsincos((double)pos * th, s, c); rope[i] = make_float2((float)c, (float)s); }
        float2* lamb = (float2*)(C.ws + WS_TAB + TAB_LAMB); float2* bbar = (float2*)(C.ws + WS_TAB + TAB_BBAR);
        for (int i = gt; i < 2 * 32 * 64; i += ngt) {
            const int dg = i >> 6;
            const double are = P.in[I_ARE][i], aim = P.in[I_AIM][i], dt = exp((double)P.in[I_LOGDT][dg]);
            double s, c; dsincos(aim * dt, s, c); const double mag = exp(are * dt), lr = mag * c, li = mag * s;
            lamb[i] = make_float2((float)lr, (float)li);
            const double den = are * are + aim * aim, nr = lr - 1.0, ni = li;
            const double cr = (nr * are + ni * aim) / den, cim = (ni * are - nr * aim) / den;
            for (int p = 0; p < 16; ++p) { const double br = P.in[I_BRE][(size_t)i * 16 + p], bi = P.in[I_BIM][(size_t)i * 16 + p];
                bbar[(size_t)i * 16 + p] = make_float2((float)(cr * br - cim * bi), (float)(cr * bi + cim * br)); }
        }
    }
    {
        const int gt = blockIdx.x * NTHR + C.tid, ngt = gridDim.x * NTHR;
        bf16* wrt = (bf16*)(C.ws + WS_TAB + TAB_WR);
        for (int idx = gt; idx < 2 * 32 * 3 * 64; idx += ngt) {
            const int ln = idx & 63, jb = (idx >> 6) % 3, kk = (idx / 192) & 31, l = idx / (192 * 32);
            const int i = ln & 15, q = ln >> 4, grp = i >> 2, r = i & 3;
            float hi8[8], lo8[8];
#pragma unroll
            for (int e = 0; e < 8; ++e) { const int k = 32 * kk + 8 * q + e;
                const float w = jb < 2 ? P.in[I_WRT][((size_t)l * D + k) * 32 + grp * 8 + jb * 4 + r] : (r == 0 ? P.in[I_WGRP][((size_t)l * D + k) * 4 + grp] : 0.f);
                const float h = bf2f(f2bf(w)); hi8[e] = h; lo8[e] = w - h; }
            v4u oh, ol; oh.x = pk2(hi8[0], hi8[1]); oh.y = pk2(hi8[2], hi8[3]); oh.z = pk2(hi8[4], hi8[5]); oh.w = pk2(hi8[6], hi8[7]);
            ol.x = pk2(lo8[0], lo8[1]); ol.y = pk2(lo8[2], lo8[3]); ol.z = pk2(lo8[4], lo8[5]); ol.w = pk2(lo8[6], lo8[7]);
            const size_t base = ((((size_t)l * 32 + kk) * 3 + jb) * 2) * 64 + ln;
            *(v4u*)(wrt + base * 8) = oh; *(v4u*)(wrt + (base + 64) * 8) = ol;
        }
    }
    {
        const int gt = blockIdx.x * NTHR + C.tid, ngt = gridDim.x * NTHR; bf16* w16 = (bf16*)(C.ws + WS_WSP);
        for (int i = gt; i < 8 * 128 * 128 / 4; i += ngt) { const f32x4 v = *(const f32x4*)(P.in[I_WSP] + 4 * (size_t)i); v2u o; o.x = pk2(v.x, v.y); o.y = pk2(v.z, v.w); *(v2u*)(w16 + 4 * (size_t)i) = o; }
    }
    convert_items(C, 0, NSMALL);
}

__device__ __forceinline__ void load_row16(const float* row, int lane, f32x4 (&v)[4]) {
#pragma unroll
    for (int j = 0; j < 4; ++j) v[j] = *(const f32x4*)(row + 4 * lane + 256 * j);
}
__device__ __forceinline__ float row_rstd(const f32x4 (&v)[4]) {
    float s = 0.f;
#pragma unroll
    for (int j = 0; j < 4; ++j) s += (v[j].x * v[j].x + v[j].y * v[j].y) + (v[j].z * v[j].z + v[j].w * v[j].w);
    return rsqrtf(wave_sum(s) * (1.f / D) + EPS);
}
__device__ __forceinline__ void modulate16(f32x4 (&v)[4], float rstd, const float* g, const float* scale, const float* shift, int lane) {
#pragma unroll
    for (int j = 0; j < 4; ++j) { const int c = 4 * lane + 256 * j; const f32x4 gg = *(const f32x4*)(g + c), sc = *(const f32x4*)(scale + c), sh = *(const f32x4*)(shift + c);
        v[j] = v[j] * rstd * gg * (sc + 1.f) + sh; }
}
__device__ __forceinline__ void store_row16_bf16(bf16* row, int lane, const f32x4 (&v)[4]) {
#pragma unroll
    for (int j = 0; j < 4; ++j) { v2u o; o.x = pk2(v[j].x, v[j].y); o.y = pk2(v[j].z, v[j].w); *(v2u*)(row + 4 * lane + 256 * j) = o; }
}

__device__ __forceinline__ void phase_norm_mix0(const Ctx& C) {
    const Params& P = *C.p; bf16* H = (bf16*)(C.ws + WS_H);
    f32x4 a[4], b[4]; const int n = C.ngw; int r = C.gw;
    if (r < TT) load_row16(xin_row(P, r), C.lane, a);
    if (r + n < TT) load_row16(xin_row(P, r + n), C.lane, b);
#define NM0_ROW(buf, rr, rnext) do { f32x4 v[4] = {buf[0], buf[1], buf[2], buf[3]}; if ((rnext) < TT) load_row16(xin_row(P, (rnext)), C.lane, buf); \
        const float rstd = row_rstd(v); const int ci = cond_of(rr); modulate16(v, rstd, P.in[I_GMIX], mod_vec(C, 0, ci, 1), mod_vec(C, 0, ci, 0), C.lane); store_row16_bf16(H + (size_t)(rr) * D, C.lane, v); } while (0)
    for (; r < TT; r += 2 * n) { NM0_ROW(a, r, r + 2 * n); if (r + n < TT) NM0_ROW(b, r + n, r + 3 * n); }
#undef NM0_ROW
}

__device__ __forceinline__ void qk_norm_rope(float (&v)[8], const float* gain, bool lat, int t, int lane, const float2* rope) {
    float ss = 0.f;
#pragma unroll
    for (int j = 0; j < 8; ++j) ss += v[j] * v[j];
    ss += __shfl_xor(ss, 1); ss += __shfl_xor(ss, 2); ss += __shfl_xor(ss, 4);
    const float rstd = rsqrtf(ss * (1.f / 64.f) + EPS);
    const int l8 = lane & 7;
#pragma unroll
    for (int j = 0; j < 8; ++j) v[j] = v[j] * rstd * gain[l8 * 8 + j];
    const int quarter = l8 >> 1, pos = (quarter < 2) ? (t >> 6) : (t & 63);
#pragma unroll
    for (int j = 0; j < 8; ++j) {
        const float pv = __shfl_xor(v[j], 2);
        if (lat) { const float2 cs = rope[pos * 16 + (lane & 1) * 8 + j];
            v[j] = (quarter & 1) ? (v[j] * cs.x + pv * cs.y) : (v[j] * cs.x - pv * cs.y); }
    }
}
__device__ __forceinline__ void phase_qkprep(const Ctx& C) {
    const Params& P = *C.p; const bf16* Pb = (const bf16*)(C.ws + WS_P); bf16* Q = (bf16*)(C.ws + WS_Q); bf16* Kb = (bf16*)(C.ws + WS_K); bf16* Vb = (bf16*)(C.ws + WS_V);
    const float2* rope = (const float2*)(C.ws + WS_TAB + TAB_ROPE);
    struct Raw { v4u q, k, v, g; };
    const int l16 = C.lane & 15, n = C.ngw;
#define QK_LOAD(dst, rr) do { const bf16* pr_ = Pb + (size_t)(rr) * MIXW; dst.q = *(const v4u*)(pr_ + 8 * C.lane); dst.k = *(const v4u*)(pr_ + 512 + 8 * l16); dst.v = *(const v4u*)(pr_ + 640 + 8 * l16); dst.g = *(const v4u*)(pr_ + 1280 + 8 * C.lane); } while (0)
#define QK_ROW(buf, rr, rnext) do { const Raw w_ = buf; if ((rnext) < TT) QK_LOAD(buf, (rnext)); const int r = (rr); \
        const bool lat = r < TL; const int t = lat ? (r & 2047) : 0; \
        const size_t kvrow = lat ? (size_t)(r >> 11) * KVL + CTXL + (r & 2047) : (size_t)((r - TL) >> 8) * KVL + ((r - TL) & 255); \
        { float v[8]; unpack8(w_.q, v); qk_norm_rope(v, P.in[I_QG], lat, t, C.lane, rope); \
          v4u o; o.x = pk2(v[0] * QSCALE, v[1] * QSCALE); o.y = pk2(v[2] * QSCALE, v[3] * QSCALE); o.z = pk2(v[4] * QSCALE, v[5] * QSCALE); o.w = pk2(v[6] * QSCALE, v[7] * QSCALE); \
          *(v4u*)(Q + (size_t)r * 512 + 8 * C.lane) = o; } \
        { float v[8]; unpack8(w_.k, v); qk_norm_rope(v, P.in[I_KG], lat, t, C.lane, rope); \
          if (C.lane < 16) { v4u o; o.x = pk2(v[0], v[1]); o.y = pk2(v[2], v[3]); o.z = pk2(v[4], v[5]); o.w = pk2(v[6], v[7]); *(v4u*)(Kb + kvrow * 128 + 8 * l16) = o; *(v4u*)(Vb + kvrow * 128 + 8 * l16) = w_.v; } } \
        { float v[8]; unpack8(w_.g, v); float sm = 0.f; \
          _Pragma("unroll") for (int j = 0; j < 8; ++j) { v[j] = gelu_tanh(v[j]); sm += v[j]; } \
          const float mean = wave_sum(sm) * (1.f / 512.f); float qq = 0.f; \
          _Pragma("unroll") for (int j = 0; j < 8; ++j) { const float d = v[j] - mean; qq += d * d; } \
          const float rstd = rsqrtf(wave_sum(qq) * (1.f / 512.f) + EPS); \
          if (C.lane == 0) ((float2*)(C.ws + WS_ROUTE + RT_S))[r] = make_float2(mean, rstd); } } while (0)
    Raw a, b; int r0 = C.gw;
    if (r0 < TT) QK_LOAD(a, r0);
    if (r0 + n < TT) QK_LOAD(b, r0 + n);
    for (; r0 < TT; r0 += 2 * n) { QK_ROW(a, r0, r0 + 2 * n); if (r0 + n < TT) QK_ROW(b, r0 + n, r0 + 3 * n); }
#undef QK_LOAD
#undef QK_ROW
}

__device__ __forceinline__ unsigned gm_off_b(unsigned row, unsigned ch) { return 256u * row + 16u * (ch ^ (((row & 3u) << 2) | ((row >> 2) & 3u))); }
__device__ __forceinline__ void phase_gmlp_fast(const Ctx& C) {
    typedef short bf16x8 __attribute__((ext_vector_type(8)));
    typedef short s16x4 __attribute__((ext_vector_type(4)));
    typedef float f32x16 __attribute__((ext_vector_type(16)));
    const Params& P = *C.p; const bf16* Pb = (const bf16*)(C.ws + WS_P); bf16* OG = (bf16*)(C.ws + WS_H); const bf16* W16 = (const bf16*)(C.ws + WS_WSP);
    const float2* lns = (const float2*)(C.ws + WS_ROUTE + RT_S);
    const int tid = C.tid, lane = C.lane, w = C.wave, l31 = lane & 31, hi = lane >> 5;
    const int gsel = w >> 2, pb = w & 3;
    for (int u = blockIdx.x; u < (TT / 128) * 4; u += gridDim.x) {
        const int ch_ = u >> 2, gp = u & 3;
        { const int row = tid >> 2; const size_t grow = (size_t)ch_ * 128 + row; const float2 st = lns[grow];
#pragma unroll
          for (int i = 0; i < 4; ++i) { const int c16 = (tid & 3) + 4 * i; float v[8]; unpack8(*(const v4u*)(Pb + grow * MIXW + 1280 + 128 * gp + 8 * c16), v);
              const float* lg = P.in[I_LNG] + 128 * gp + 8 * c16;
#pragma unroll
              for (int j = 0; j < 8; ++j) v[j] = (gelu_tanh(v[j]) - st.x) * st.y * lg[j];
              v4u o; o.x = pk2(v[0], v[1]); o.y = pk2(v[2], v[3]); o.z = pk2(v[4], v[5]); o.w = pk2(v[6], v[7]);
              *(LAS v4u*)(C.lds + (row >> 5) * 8192 + gm_off_b(row & 31, c16)) = o; } }
        __syncthreads();
        const int g = 2 * gp + gsel;
        f32x16 acc[2]; acc[0] = f32x16{}; acc[1] = f32x16{};
        const bf16* wrow = W16 + ((size_t)g * 128 + 32 * pb + l31) * 128 + 8 * hi;
#pragma unroll
        for (int k8 = 0; k8 < 8; ++k8) {
            const bf16x8 xf = *(const bf16x8*)(wrow + 16 * k8);
            const unsigned rb = k8 >> 1, ks = k8 & 1;
#pragma unroll
            for (int db = 0; db < 2; ++db) { const unsigned c = 2 * gsel + db, blk = (lane >> 4) & 1, q = (lane & 15) >> 2, p2 = lane & 3;
                s16x4 t0, t1;
                { const unsigned a0 = rb * 8192 + gm_off_b(16 * ks + 8 * hi + q, 4 * c + 2 * blk + (p2 >> 1)) + 8 * (p2 & 1);
                  const unsigned a1 = rb * 8192 + gm_off_b(16 * ks + 8 * hi + 4 + q, 4 * c + 2 * blk + (p2 >> 1)) + 8 * (p2 & 1);
                  t0 = __builtin_bit_cast(s16x4, __builtin_amdgcn_ds_read_tr16_b64_v4i16((LAS s16x4*)(C.lds + a0)));
                  t1 = __builtin_bit_cast(s16x4, __builtin_amdgcn_ds_read_tr16_b64_v4i16((LAS s16x4*)(C.lds + a1))); }
                const bf16x8 yf = {t0[0], t0[1], t0[2], t0[3], t1[0], t1[1], t1[2], t1[3]};
                acc[db] = __builtin_amdgcn_mfma_f32_32x32x16_bf16(xf, yf, acc[db], 0, 0, 0); }
        }
        const float* bsp = P.in[I_BSP] + g * 128 + 32 * pb;
#pragma unroll
        for (int r = 0; r < 16; ++r) { const int pl = (r & 3) + 8 * (r >> 2) + 4 * hi; const size_t grow = (size_t)ch_ * 128 + 32 * pb + pl; const float bb = bsp[pl];
#pragma unroll
            for (int db = 0; db < 2; ++db) { const int col = 64 * g + 32 * db + l31; const float uu = gelu_tanh(bf2f(Pb[grow * MIXW + 768 + col]));
                OG[grow * D + 512 + col] = (bf16)f2bf(uu * (acc[db][r] + bb)); } }
        __syncthreads();
    }
}

__device__ __forceinline__ void phase_attn_fast(const Ctx& C, char* lds_generic) {
    typedef attn_body::bf16 abf;
    const abf* Q = (const abf*)(C.ws + WS_Q); const abf* Kb = (const abf*)(C.ws + WS_K); const abf* Vb = (const abf*)(C.ws + WS_V); abf* OG = (abf*)(C.ws + WS_H);
    const int G = gridDim.x, bx = blockIdx.x; const int vcu = (G % 8 == 0) ? (bx % 8) * (G / 8) + bx / 8 : bx;
    const int per = (1024 + G - 1) / G, perc = (128 + G - 1) / G;
    for (int i = 0; i < per + perc; ++i) {
        int b, h, nt; size_t qrow;
        if (i < per) { const int u = vcu * per + i; if (u >= 1024) continue; const int qb = u & 7, hg = (u >> 3) & 3, bk = u >> 5; b = bk >> 1; h = (bk & 1) * 4 + hg; qrow = (size_t)b * SEQ + qb * 256; nt = KVL / 64; }
        else { const int u = vcu + (i - per) * G; if (u >= 128) continue; b = u >> 3; h = u & 7; qrow = (size_t)TL + (size_t)b * CTXL; nt = CTXL / 64; }
        const size_t kvo = (size_t)b * KVL * 128 + (h >> 2) * 64;
        attn_body::attn_unit<8>(Q + qrow * 512 + h * 64, Kb + kvo, Vb + kvo, OG + qrow * 1024 + h * 64, nt, lds_generic);
    }
}

__device__ __forceinline__ void phase_router_fast(const Ctx& C, int layer, int nrows) {
    typedef short bf16x8 __attribute__((ext_vector_type(8)));
    const Params& P = *C.p; const bf16* XC = (const bf16*)(C.ws + WS_XC); bf16* F = (bf16*)(C.ws + WS_H);
    int* asg_e = (int*)(C.ws + WS_ROUTE + RT_E); int* asg_p = (int*)(C.ws + WS_ROUTE + RT_P); float* asg_w = (float*)(C.ws + WS_ROUTE + RT_W); int* list = (int*)(C.ws + WS_LIST);
    unsigned* cnt = (unsigned*)(C.ws + WS_CTL) + CW_CNT + 64 * layer;
    const int l15 = C.lane & 15, q4 = C.lane >> 4;
    LAS float* ab = (LAS float*)(C.lds + C.wave * 8192);
    LAS unsigned* lcnt = (LAS unsigned*)(C.lds + 65536);
    if (C.tid < 64) lcnt[C.tid] = 0u;
    __syncthreads();
    int cur_ci = -1;
    const int nitems = nrows / 16, nrounds = (nitems + C.ngw - 1) / C.ngw;
    for (int rd = 0; rd < nrounds; ++rd) {
        const int it_raw = C.gw + rd * C.ngw; const bool valid = it_raw < nitems; const int it = valid ? it_raw : nitems - 1;
        const int row = it * 16 + l15, ci = cond_of(it * 16);
        if (ci != cur_ci) {
            const float* sc = mod_vec(C, layer, ci, 4); const float* sh = mod_vec(C, layer, ci, 3); const float* g0 = P.in[I_GFFN] + layer * D;
#pragma unroll
            for (int j = 0; j < 4; ++j) { const int c = 4 * C.lane + 256 * j; const f32x4 g4 = *(const f32x4*)(g0 + c), s4 = *(const f32x4*)(sc + c), h4 = *(const f32x4*)(sh + c); const f32x4 a4 = g4 * (s4 + 1.f);
                *(LAS f32x4*)(ab + c) = a4; *(LAS f32x4*)(ab + 1024 + c) = h4; }
            asm volatile("s_waitcnt lgkmcnt(0)" ::: "memory"); cur_ci = ci;
        }
        const bf16* xr = XC + (size_t)row * D + 8 * q4;
        float ss = 0.f;
#pragma unroll 16
        for (int kk = 0; kk < 32; ++kk) { pg8::f32x4 a, b; pg8::unpack8f(*(const pg8::u32x4*)(xr + 32 * kk), a, b); ss += (a.x * a.x + a.y * a.y) + (a.z * a.z + a.w * a.w) + (b.x * b.x + b.y * b.y) + (b.z * b.z + b.w * b.w); }
        ss += __shfl_xor(ss, 16); ss += __shfl_xor(ss, 32);
        const float rstd = rsqrtf(ss * (1.f / D) + EPS);
        f32x4 acc[3]; acc[0] = (f32x4){0.f, 0.f, 0.f, 0.f}; acc[1] = acc[0]; acc[2] = acc[0];
        unsigned char* frow = (unsigned char*)F + (size_t)row * D + 8 * q4;
        const LAS float* abl = ab + 8 * q4;
        {
            const unsigned char* wsrc = (const unsigned char*)((const bf16x8*)(C.ws + WS_TAB + TAB_WR) + (size_t)layer * (32 * 3 * 2 * 64)) + C.tid * 16;
            LAS unsigned char* wl0 = C.lds + 67584;
#define RS_GLOAD(sb_, ga, gb, gc, xq) do { ga = *(const pg8::u32x4*)(wsrc + (sb_) * 24576); gb = *(const pg8::u32x4*)(wsrc + (sb_) * 24576 + 8192); gc = *(const pg8::u32x4*)(wsrc + (sb_) * 24576 + 16384); \
                _Pragma("unroll") for (int j = 0; j < 4; ++j) xq[j] = *(const pg8::u32x4*)(xr + 128 * (sb_) + 32 * j); } while (0)
#define RS_LWRITE(sb_, ga, gb, gc) do { LAS unsigned char* wn = wl0 + ((sb_) & 1) * 24576 + C.tid * 16; *(LAS pg8::u32x4*)(wn) = ga; *(LAS pg8::u32x4*)(wn + 8192) = gb; *(LAS pg8::u32x4*)(wn + 16384) = gc; } while (0)
#define RS_FRAGS(sb_, j_, wf_, tb_) do { const LAS unsigned char* wl = wl0 + ((sb_) & 1) * 24576 + C.lane * 16; const int c_ = 128 * (sb_) + 32 * (j_); \
                _Pragma("unroll") for (int jb = 0; jb < 3; ++jb) { wf_[jb][0] = *(const LAS bf16x8*)(wl + (((j_) * 3 + jb) * 2) * 1024); wf_[jb][1] = *(const LAS bf16x8*)(wl + (((j_) * 3 + jb) * 2 + 1) * 1024); } \
                tb_[0] = *(const LAS f32x4*)(abl + c_); tb_[1] = *(const LAS f32x4*)(abl + c_ + 4); tb_[2] = *(const LAS f32x4*)(abl + 1024 + c_); tb_[3] = *(const LAS f32x4*)(abl + 1024 + c_ + 4); } while (0)
#define RS_STEP(sb_, j_, xv_, wf_, tb_, NEXT) do { const int c = 128 * (sb_) + 32 * (j_); \
                pg8::f32x4 x0, x1; pg8::unpack8f(xv_, x0, x1); \
                const f32x4 f0 = x0 * rstd * tb_[0] + tb_[2]; \
                const f32x4 f1 = x1 * rstd * tb_[1] + tb_[3]; \
                const pg8::u32x4 fh = pg8::pack8(f0, f1); if (valid) *(pg8::u32x2*)(frow + c) = pg8::pack8_fp8(f0, f1); \
                pg8::f32x4 r0, r1; pg8::unpack8f(fh, r0, r1); \
                const pg8::u32x4 fl = pg8::pack8(f0 - r0, f1 - r1); \
                const bf16x8 ah = __builtin_bit_cast(bf16x8, fh), al = __builtin_bit_cast(bf16x8, fl); \
                NEXT; \
                _Pragma("unroll") for (int jb = 0; jb < 3; ++jb) { \
                    acc[jb] = __builtin_amdgcn_mfma_f32_16x16x32_bf16(wf_[jb][0], ah, acc[jb], 0, 0, 0); \
                    acc[jb] = __builtin_amdgcn_mfma_f32_16x16x32_bf16(wf_[jb][0], al, acc[jb], 0, 0, 0); \
                    acc[jb] = __builtin_amdgcn_mfma_f32_16x16x32_bf16(wf_[jb][1], ah, acc[jb], 0, 0, 0); } } while (0)
#define RS_COMP(sb_, xq) do { bf16x8 wA[3][2], wB[3][2]; f32x4 tA[4], tB[4]; \
                RS_FRAGS(sb_, 0, wA, tA); \
                RS_STEP(sb_, 0, xq[0], wA, tA, RS_FRAGS(sb_, 1, wB, tB)); \
                RS_STEP(sb_, 1, xq[1], wB, tB, RS_FRAGS(sb_, 2, wA, tA)); \
                RS_STEP(sb_, 2, xq[2], wA, tA, RS_FRAGS(sb_, 3, wB, tB)); \
                RS_STEP(sb_, 3, xq[3], wB, tB, (void)0); } while (0)
#define RS_SYNC() do { asm volatile("s_waitcnt lgkmcnt(0)" ::: "memory"); __builtin_amdgcn_s_barrier(); } while (0)
            if (layer == 1) STAMP_AT(22);
            pg8::u32x4 a0, a1, a2, b0, b1, b2, xa[4], xb[4], xc[4];
            RS_GLOAD(0, a0, a1, a2, xc); RS_GLOAD(1, b0, b1, b2, xb);
            __builtin_amdgcn_s_barrier();
            RS_LWRITE(0, a0, a1, a2); RS_SYNC();
#pragma unroll 1
            for (int sb = 0; sb < 8; sb += 2) {
                if (sb + 2 < 8) RS_GLOAD(sb + 2, a0, a1, a2, xa);
                RS_COMP(sb, xc);
                RS_LWRITE(sb + 1, b0, b1, b2); RS_SYNC();
#pragma unroll
                for (int j = 0; j < 4; ++j) xc[j] = xb[j];
                if (sb + 3 < 8) RS_GLOAD(sb + 3, b0, b1, b2, xb);
                RS_COMP(sb + 1, xc);
                if (sb + 2 < 8) { RS_LWRITE(sb + 2, a0, a1, a2);
#pragma unroll
                    for (int j = 0; j < 4; ++j) xc[j] = xa[j]; }
                RS_SYNC();
            }
            if (layer == 1) STAMP_AT(23);
#undef RS_GLOAD
#undef RS_LWRITE
#undef RS_COMP
#undef RS_STEP
#undef RS_FRAGS
#undef RS_SYNC
        }
        const float* brt = P.in[I_BRT] + layer * 32 + q4 * 8;
        float e[8];
#pragma unroll
        for (int r = 0; r < 4; ++r) { e[r] = acc[0][r] + brt[r]; e[4 + r] = acc[1][r] + brt[4 + r]; }
        const float gl = acc[2][0] + P.in[I_BGRP][layer * 4 + q4];
        float gm = gl; int gi = q4;
#pragma unroll
        for (int st = 16; st <= 32; st <<= 1) { const float og = __shfl_xor(gm, st); const int oi = __shfl_xor(gi, st); if (og > gm || (og == gm && oi < gi)) { gm = og; gi = oi; } }
        float den = __expf(gl - gm); den += __shfl_xor(den, 16); den += __shfl_xor(den, 32);
        if (valid && q4 == gi) {
            const float gw_ = 1.f / den;
            int i0 = 0; float v0 = e[0];
#pragma unroll
            for (int i = 1; i < 8; ++i) if (e[i] > v0) { v0 = e[i]; i0 = i; }
            int i1 = -1; float v1 = -INFINITY;
#pragma unroll
            for (int i = 0; i < 8; ++i) if (i != i0 && e[i] > v1) { v1 = e[i]; i1 = i; }
            if (i1 < 0) i1 = (i0 + 1) & 7;
            const float e1 = __expf(v1 - v0), w0 = gw_ / (1.f + e1), w1 = gw_ * e1 / (1.f + e1);
            const int ea = (gi & 3) * 8 + i0, eb = (gi & 3) * 8 + i1;
            const unsigned pa = __hip_atomic_fetch_add(lcnt + ea, 1u, __ATOMIC_RELAXED, __HIP_MEMORY_SCOPE_WORKGROUP);
            const unsigned pb = __hip_atomic_fetch_add(lcnt + eb, 1u, __ATOMIC_RELAXED, __HIP_MEMORY_SCOPE_WORKGROUP);
            asg_e[2 * row] = ea; asg_e[2 * row + 1] = eb; asg_p[2 * row] = (int)pa; asg_p[2 * row + 1] = (int)pb; asg_w[2 * row] = w0; asg_w[2 * row + 1] = w1;
        }
    }
    if (layer == 0) STAMP_AT(21);
    asm volatile("s_waitcnt vmcnt(0) lgkmcnt(0)" ::: "memory");
    __syncthreads();
    if (C.tid < 32) { const unsigned n = lcnt[C.tid]; lcnt[32 + C.tid] = n ? __hip_atomic_fetch_add(cnt + C.tid, n, __ATOMIC_RELAXED, __HIP_MEMORY_SCOPE_AGENT) : 0u; }
    __syncthreads();
    for (int it = C.gw; it < nrows / 16; it += C.ngw) {
        if (C.lane < 32) { const int idx = 2 * (it * 16 + (C.lane & 15)) + (C.lane >> 4);
            const int e = __hip_atomic_load(asg_e + idx, __ATOMIC_RELAXED, __HIP_MEMORY_SCOPE_AGENT); const int p = __hip_atomic_load(asg_p + idx, __ATOMIC_RELAXED, __HIP_MEMORY_SCOPE_AGENT) + (int)lcnt[32 + e];
            asg_p[idx] = p; list[(size_t)e * LCAP + p] = idx >> 1; }
    }
}

__device__ __forceinline__ int wave_pstart(const Ctx& C, int layer) {
    const unsigned* cnt = (const unsigned*)(C.ws + WS_CTL) + CW_CNT + 64 * layer;
    const int mc = C.lane < 32 ? (int)__hip_atomic_load(cnt + (C.lane & 31), __ATOMIC_RELAXED, __HIP_MEMORY_SCOPE_AGENT) : 0; const int mp = (mc + 255) & ~255; int in = mp;
#pragma unroll
    for (int o = 1; o < 32; o <<= 1) { const int t = __shfl_up(in, o); if ((C.lane & 31) >= o) in += t; }
    return in - mp;
}
struct CombRaw { v2u x[4], ya[4], yb[4]; float w0, w1; };
__device__ __forceinline__ void comb_load(const Ctx& C, int r, int ps, CombRaw& o) {
    const bf16* Y2 = (const bf16*)(C.ws + WS_XS); const bf16* XC = (const bf16*)(C.ws + WS_XC); const float* asg_w = (const float*)(C.ws + WS_ROUTE + RT_W);
    const int* asg_e = (const int*)(C.ws + WS_ROUTE + RT_E); const int* asg_p = (const int*)(C.ws + WS_ROUTE + RT_P);
    const int s0 = __shfl(ps, asg_e[2 * r]) + asg_p[2 * r], s1 = __shfl(ps, asg_e[2 * r + 1]) + asg_p[2 * r + 1]; o.w0 = asg_w[2 * r]; o.w1 = asg_w[2 * r + 1];
#pragma unroll
    for (int j = 0; j < 4; ++j) { const int c = 4 * C.lane + 256 * j; o.x[j] = *(const v2u*)(XC + (size_t)r * D + c); o.ya[j] = *(const v2u*)(Y2 + (size_t)s0 * D + c); o.yb[j] = *(const v2u*)(Y2 + (size_t)s1 * D + c); }
}
__device__ __forceinline__ void comb_calc(const Ctx& C, int layer, int r, const CombRaw& w, f32x4 (&v)[4]) {
    const float* gate = mod_vec(C, layer, cond_of(r), 5); const float w0 = w.w0, w1 = w.w1;
#pragma unroll
    for (int j = 0; j < 4; ++j) { const int c = 4 * C.lane + 256 * j; const v2u xx = w.x[j], a = w.ya[j], b = w.yb[j]; const f32x4 g = *(const f32x4*)(gate + c);
        v[j].x = bf2f(xx.x & 0xffffu) + g.x * (w0 * bf2f(a.x & 0xffffu) + w1 * bf2f(b.x & 0xffffu)); v[j].y = bf2f(xx.x >> 16) + g.y * (w0 * bf2f(a.x >> 16) + w1 * bf2f(b.x >> 16));
        v[j].z = bf2f(xx.y & 0xffffu) + g.z * (w0 * bf2f(a.y & 0xffffu) + w1 * bf2f(b.y & 0xffffu)); v[j].w = bf2f(xx.y >> 16) + g.w * (w0 * bf2f(a.y >> 16) + w1 * bf2f(b.y >> 16)); }
}
__device__ __forceinline__ void phase_combine_norm_mix1(const Ctx& C) {
    const Params& P = *C.p; bf16* XC = (bf16*)(C.ws + WS_XC); bf16* H = (bf16*)(C.ws + WS_H);
    const int ps = wave_pstart(C, 0), n = C.ngw;
#define CN_ROW(buf, rr, rnext) do { const CombRaw w_ = buf; if ((rnext) < TT) comb_load(C, (rnext), ps, buf); f32x4 v[4]; comb_calc(C, 0, (rr), w_, v); \
        store_row16_bf16(XC + (size_t)(rr) * D, C.lane, v); const float rstd = row_rstd(v); const int ci = cond_of(rr); \
        modulate16(v, rstd, P.in[I_GMIX] + D, mod_vec(C, 1, ci, 1), mod_vec(C, 1, ci, 0), C.lane); store_row16_bf16(H + (size_t)(rr) * D, C.lane, v); } while (0)
    CombRaw a, b; int r = C.gw;
    if (r < TT) comb_load(C, r, ps, a);
    if (r + n < TT) comb_load(C, r + n, ps, b);
    for (; r < TT; r += 2 * n) { CN_ROW(a, r, r + 2 * n); if (r + n < TT) CN_ROW(b, r + n, r + 3 * n); }
#undef CN_ROW
    convert_items(C, 1, 0);
}
__device__ __forceinline__ void phase_final(const Ctx& C) {
    const Params& P = *C.p;
    const int ps = wave_pstart(C, 1), n = C.ngw;
#define FN_ROW(buf, rr, rnext) do { const CombRaw w_ = buf; if ((rnext) < TL) comb_load(C, (rnext), ps, buf); f32x4 v[4]; comb_calc(C, 1, (rr), w_, v); const float rstd = row_rstd(v); \
        _Pragma("unroll") for (int j = 0; j < 4; ++j) { const int c = 4 * C.lane + 256 * j; const f32x4 g = *(const f32x4*)(P.in[I_FING] + c); *(f32x4*)(P.out + (size_t)(rr) * D + c) = v[j] * rstd * g; } } while (0)
    CombRaw a, b; int r = C.gw;
    if (r < TL) comb_load(C, r, ps, a);
    if (r + n < TL) comb_load(C, r + n, ps, b);
    for (; r < TL; r += 2 * n) { FN_ROW(a, r, r + 2 * n); if (r + n < TL) FN_ROW(b, r + n, r + 3 * n); }
#undef FN_ROW
}

__device__ __forceinline__ void phase_s5_fast(const Ctx& C) {
    typedef short bf16x8 __attribute__((ext_vector_type(8)));
    typedef float f32x16 __attribute__((ext_vector_type(16)));
    const Params& P = *C.p; const bf16* U = (const bf16*)(C.ws + WS_U); bf16* GS = (bf16*)(C.ws + WS_GS); float* YA = (float*)(C.ws + WS_YACC);
    const float2* lamb = (const float2*)(C.ws + WS_TAB + TAB_LAMB); const float2* bbar = (const float2*)(C.ws + WS_TAB + TAB_BBAR);
    constexpr int HP = 272;
    const int lane = C.lane, w = C.wave, il = w >> 2, dir = (w >> 1) & 1, nh = w & 1;
    const int l31 = lane & 31, hi = lane >> 5, l15 = lane & 15, q4 = lane >> 4;
    LAS unsigned char* Hb = C.lds + (il * 2 + dir) * (2 * 32 * HP);
    const int srow = 16 * ((l31 >> 2) & 1) + 2 * (l31 >> 3) + ((l31 >> 1) & 1);
    for (int it0 = blockIdx.x; it0 < NB * 16; it0 += gridDim.x) {
        const int item = it0 * 2 + il, b = item >> 5, g = item & 31;
        const int dg = dir * 32 + g, n = nh * 32 + l31;
        const float2 lam = lamb[dg * 64 + n];
        f32x2 p2[16]; { f32x2 p = {lam.x, lam.y};
#pragma unroll
            for (int r = 0; r < 16; ++r) { p2[r] = p; p = (f32x2){p.x * lam.x - p.y * lam.y, p.x * lam.y + p.y * lam.x}; } }
        const f32x2 lx2 = {lam.x, lam.x}, ly2 = {-lam.y, lam.y};
        bf16x8 bre, bim; { const float2* bp = bbar + ((size_t)(dg * 64 + n)) * 16 + 8 * hi;
#pragma unroll
            for (int e = 0; e < 8; ++e) { const float2 v = bp[e]; bre[e] = (short)f2bf(v.x); bim[e] = (short)f2bf(v.y); } }
        bf16x8 cf[4]; { const float* cre = P.in[I_CRE] + ((size_t)dg * 16 + l15) * 64; const float* cim = P.in[I_CIM] + ((size_t)dg * 16 + l15) * 64;
#pragma unroll
            for (int ks = 0; ks < 4; ++ks) { const f32x4 a = *(const f32x4*)(cre + 16 * ks + 4 * q4), m = *(const f32x4*)(cim + 16 * ks + 4 * q4);
                cf[ks][0] = (short)f2bf(a.x); cf[ks][1] = (short)f2bf(-m.x); cf[ks][2] = (short)f2bf(a.y); cf[ks][3] = (short)f2bf(-m.y);
                cf[ks][4] = (short)f2bf(a.z); cf[ks][5] = (short)f2bf(-m.z); cf[ks][6] = (short)f2bf(a.w); cf[ks][7] = (short)f2bf(-m.w); } }
        const f32x4 dsk = *(const f32x4*)(P.in[I_S5D] + g * 16 + 4 * q4);
        f32x2 carry = {0.f, 0.f};
#define S5_UROW(kk, off) ({ const int S_ = 32 * (kk) + srow + (off); (S_ < CTXL) ? ((size_t)TL + (size_t)b * CTXL + (dir == 0 ? S_ : CTXL - 1 - S_)) : ((size_t)b * SEQ + (dir == 0 ? S_ - CTXL : SEQ - 1 - (S_ - CTXL))); })
        const bool odd = l31 & 1;
#define S5_ULD(kk, off) (*(const bf16x8*)(U + S5_UROW(kk, off) * 512 + g * 16 + 8 * hi))
        bf16x8 ux1 = S5_ULD(0, 0), uy1 = S5_ULD(0, 8), ux2 = S5_ULD(1, 0), uy2 = S5_ULD(1, 8), ux3 = S5_ULD(2, 0), uy3 = S5_ULD(2, 8);
        f32x4 pk_n = {0.f, 0.f, 0.f, 0.f}; v2u uu_n = {0u, 0u};
        for (int k = 0; k < 72; ++k) {
            const bf16x8 ux = ux1, uy = uy1; ux1 = ux2; uy1 = uy2; ux2 = ux3; uy2 = uy3;
            if (k + 3 < 72) { ux3 = S5_ULD(k + 3, 0); uy3 = S5_ULD(k + 3, 8); }
            const int sl = 32 * (k - 8) + 16 * nh + l15;
            const int tok = dir == 0 ? sl : SEQ - 1 - sl; const int lt = tok >> 5;
            const size_t o = ((size_t)b * SEQ + (k >= 8 ? tok : 0)) * 512 + g * 16 + 4 * q4;
            const bool first = dir == 0 ? (lt < 32) : (lt >= 32);
#define S5_RLOAD(oo, pk_, uu_) do { pk_.x = __hip_atomic_load(YA + (oo), __ATOMIC_RELAXED, __HIP_MEMORY_SCOPE_AGENT); pk_.y = __hip_atomic_load(YA + (oo) + 1, __ATOMIC_RELAXED, __HIP_MEMORY_SCOPE_AGENT); \
                pk_.z = __hip_atomic_load(YA + (oo) + 2, __ATOMIC_RELAXED, __HIP_MEMORY_SCOPE_AGENT); pk_.w = __hip_atomic_load(YA + (oo) + 3, __ATOMIC_RELAXED, __HIP_MEMORY_SCOPE_AGENT); uu_ = *(const v2u*)(U + (oo)); } while (0)
            f32x4 pk = pk_n; v2u uu = uu_n;
            if (k == 40) S5_RLOAD(o, pk, uu);
            if (k >= 40 && k + 1 < 72) { const int sl1 = 32 * (k + 1 - 8) + 16 * nh + l15; const int tok1 = dir == 0 ? sl1 : SEQ - 1 - sl1; const size_t o1 = ((size_t)b * SEQ + tok1) * 512 + g * 16 + 4 * q4; S5_RLOAD(o1, pk_n, uu_n); }
            {
              const bf16x8 zf = {0, 0, 0, 0, 0, 0, 0, 0};
              f32x16 X = {}, Y = {};
              X = __builtin_amdgcn_mfma_f32_32x32x16_bf16(odd ? zf : ux, bre, X, 0, 0, 0); X = __builtin_amdgcn_mfma_f32_32x32x16_bf16(odd ? ux : zf, bim, X, 0, 0, 0);
              Y = __builtin_amdgcn_mfma_f32_32x32x16_bf16(odd ? zf : uy, bre, Y, 0, 0, 0); Y = __builtin_amdgcn_mfma_f32_32x32x16_bf16(odd ? uy : zf, bim, Y, 0, 0, 0);
              f32x2 s2 = hi ? (f32x2){0.f, 0.f} : carry;
#pragma unroll
              for (int q = 0; q < 8; ++q) { const f32x2 bq = {X[2 * q], X[2 * q + 1]}, sw = {s2.y, s2.x}; s2 = lx2 * s2 + bq; s2 = ly2 * sw + s2; X[2 * q] = s2.x; X[2 * q + 1] = s2.y; }
#pragma unroll
              for (int q = 0; q < 8; ++q) { const f32x2 bq = {Y[2 * q], Y[2 * q + 1]}, sw = {s2.y, s2.x}; s2 = lx2 * s2 + bq; s2 = ly2 * sw + s2; Y[2 * q] = s2.x; Y[2 * q + 1] = s2.y; }
              float er = __shfl_xor(s2.x, 32), ei = __shfl_xor(s2.y, 32); if (!hi) { er = 0.f; ei = 0.f; }
              const f32x2 er2 = {er, er}, ei2 = {ei, ei};
#pragma unroll
              for (int q = 0; q < 8; ++q) { const f32x2 p = p2[q], ps = {-p.y, p.x}; f32x2 h = {X[2 * q], X[2 * q + 1]}; h = er2 * p + h; h = ei2 * ps + h; X[2 * q] = h.x; X[2 * q + 1] = h.y; }
#pragma unroll
              for (int q = 0; q < 8; ++q) { const f32x2 p = p2[8 + q], ps = {-p.y, p.x}; f32x2 h = {Y[2 * q], Y[2 * q + 1]}; h = er2 * p + h; h = ei2 * ps + h; Y[2 * q] = h.x; Y[2 * q + 1] = h.y; }
              carry = (f32x2){__shfl_xor(Y[14], 32), __shfl_xor(Y[15], 32)};
              LAS unsigned char* hb = Hb + (k & 1) * (32 * HP) + (16 * hi) * HP + 4 * n;
#pragma unroll
              for (int q = 0; q < 8; ++q) { *(LAS unsigned*)(hb + q * HP) = pk2(X[2 * q], X[2 * q + 1]); *(LAS unsigned*)(hb + (8 + q) * HP) = pk2(Y[2 * q], Y[2 * q + 1]); }
            }
            asm volatile("s_waitcnt lgkmcnt(0)\n\ts_barrier" ::: "memory");
            if (k >= 8) {
                const LAS unsigned char* hr = Hb + (k & 1) * (32 * HP) + (16 * nh + l15) * HP + 16 * q4;
                f32x4 y = {0.f, 0.f, 0.f, 0.f};
#pragma unroll
                for (int ks = 0; ks < 4; ++ks) { const bf16x8 hf = *(const LAS bf16x8*)(hr + 64 * ks); y = __builtin_amdgcn_mfma_f32_16x16x32_bf16(cf[ks], hf, y, 0, 0, 0); }
                if (first) { *(f32x4*)(YA + o) = y; }
                else {
                    const f32x4 uf = {bf2f(uu.x & 0xffffu), bf2f(uu.x >> 16), bf2f(uu.y & 0xffffu), bf2f(uu.y >> 16)};
                    const f32x4 t = y + pk + dsk * uf;
                    v2u ov; ov.x = pk2(gelu_tanh(t.x), gelu_tanh(t.y)); ov.y = pk2(gelu_tanh(t.z), gelu_tanh(t.w)); *(v2u*)(GS + o) = ov;
                }
            }
            if (k == 39) asm volatile("s_waitcnt vmcnt(0)\n\ts_barrier" ::: "memory");
        }
#undef S5_UROW
#undef S5_ULD
#undef S5_RLOAD
        asm volatile("s_waitcnt vmcnt(0) lgkmcnt(0)\n\ts_barrier" ::: "memory");
    }
}

__global__ void __launch_bounds__(NTHR, 2) fwd_kernel(Params prm) {
    extern __shared__ __attribute__((aligned(16))) unsigned char lds_raw[];
    Ctx C; C.p = &prm; C.ws = prm.ws; C.lds = (LAS unsigned char*)lds_raw;
    C.tid = threadIdx.x; C.lane = C.tid & 63; C.wave = __builtin_amdgcn_readfirstlane(C.tid >> 6);
    C.gw = blockIdx.x * NWAVE + C.wave; C.ngw = gridDim.x * NWAVE;
    constexpr int LDS_MISC = 147456 - 512;
    volatile LAS unsigned* misc = (volatile LAS unsigned*)(C.lds + LDS_MISC);
    if (C.tid < 64) misc[C.tid] = 0u;
    __syncthreads();
    unsigned* ctl = (unsigned*)(C.ws + WS_CTL);
    XcdBarrier bar; bar.bar = ctl + CW_BAR; bar.x = 0; bar.st = nullptr;
#if MK_ONE_LAUNCH
    bar = xcd_barrier_post(ctl + CW_BAR, misc + 8);
#define SEAM(k) do { if (lo <= (k) && (k) + 1 < hi) xcd_barrier(bar); } while (0)
#else
#define SEAM(k) do { } while (0)
#endif
    const int lo = prm.ph_lo, hi = prm.ph_hi;
#define IN(k) ((C.lane = lane_id_now(), C.tid = C.wave * 64 + C.lane, true) && lo <= (k) && (k) < hi)
#if MK_PROBE
    volatile LAS unsigned long long* ts_ = (volatile LAS unsigned long long*)(C.lds + LDS_MISC + 64);
#define STAMP(k) do { if (blockIdx.x == 0 && C.tid == 0) ts_[(k) + 1] = __builtin_amdgcn_s_memrealtime(); } while (0)
    if (blockIdx.x == 0 && C.tid == 0) ts_[0] = __builtin_amdgcn_s_memrealtime();
#else
#define STAMP(k) do { } while (0)
#endif
    const Params& P = prm;
    bf16* Hb = (bf16*)(C.ws + WS_H); bf16* XC = (bf16*)(C.ws + WS_XC);
#define MOE_MAP(layer) do { LAS int* tm_ = (LAS int*)(C.lds + 131072); LAS int* cl_ = tm_ + 320; \
        if (C.wave == 0) { const unsigned* cnt_ = (const unsigned*)(C.ws + WS_CTL) + CW_CNT + 64 * (layer); const int mc_ = C.lane < 32 ? (int)__hip_atomic_load(cnt_ + (C.lane & 31), __ATOMIC_RELAXED, __HIP_MEMORY_SCOPE_AGENT) : 0; const int mp_ = (mc_ + 255) & ~255; int in_ = mp_; \
            _Pragma("unroll") for (int o_ = 1; o_ < 32; o_ <<= 1) { const int t_ = __shfl_up(in_, o_); if ((C.lane & 31) >= o_) in_ += t_; } const int ps_ = in_ - mp_; \
            if (C.lane < 32) { for (int t_ = ps_ / 256; t_ < (ps_ + mp_) / 256; ++t_) tm_[t_] = C.lane | ((t_ * 256 - ps_) << 8); cl_[C.lane] = mc_; if (C.lane == 31) cl_[32] = (ps_ + mp_) / 256; } } \
        __syncthreads(); } while (0)
#define MOE_GEMM1(layer) do { MOE_MAP(layer); const LAS int* tm_ = (const LAS int*)(C.lds + 131072); const int ntl_ = __builtin_amdgcn_readfirstlane(tm_[320 + 32]); pg8::Gemm g{Hb, (const bf16*)(C.ws + WS_W13), 0, 1024, 512}; \
        pg8::GroupedOrder<true> S{tm_, tm_ + 320, (const int*)(C.ws + WS_LIST), ntl_ * 4, 4, (int)gridDim.x, (int)blockIdx.x, LCAP, 1024, (size_t)1024 * 1024}; pg8::EpiSwiglu E{(bf16*)(C.ws + WS_G13), 1.f / W13_SCALE}; \
        pg8::gemm_phase<pg8::EpiSwiglu, pg8::GroupedOrder<true>, true, false, false, true>(C.lds, g, S, E, C.wave); } while (0)
#define MOE_GEMM2(layer) do { MOE_MAP(layer); const LAS int* tm_ = (const LAS int*)(C.lds + 131072); const int ntl_ = __builtin_amdgcn_readfirstlane(tm_[320 + 32]); pg8::Gemm g{(const bf16*)(C.ws + WS_G13), (const bf16*)(C.ws + WS_W2), 0, 1024, EH}; \
        pg8::GroupedOrder<false> S{tm_, tm_ + 320, (const int*)(C.ws + WS_LIST), ntl_ * 4, 4, (int)gridDim.x, (int)blockIdx.x, LCAP, EH * 2, (size_t)1024 * 512 * 2}; pg8::EpiStore E{(bf16*)(C.ws + WS_XS), D}; \
        pg8::gemm_phase<pg8::EpiStore, pg8::GroupedOrder<false>, true, true>(C.lds, g, S, E, C.wave); } while (0)
    if (IN(0)) { phase_prologue(C); SEAM(0); STAMP(0); }
    if (IN(1)) { phase_norm_mix0(C); SEAM(1); STAMP(1); }
    if (IN(2)) { pg8::Gemm g{Hb, (const bf16*)(C.ws + WS_WIN0), TT, MIXW, D}; pg8::StaticOrder S; S.init(TT, MIXW, gridDim.x, blockIdx.x); pg8::EpiStore E{(bf16*)(C.ws + WS_P), MIXW};
        pg8::gemm_phase<pg8::EpiStore, pg8::StaticOrder, true, true, true>(C.lds, g, S, E, C.wave); SEAM(2); STAMP(2); }
    if (IN(3)) { phase_qkprep(C); SEAM(3); STAMP(3); }
    if (IN(4)) { phase_gmlp_fast(C); phase_attn_fast(C, (char*)lds_raw); SEAM(4); STAMP(4); }
    if (IN(5)) { pg8::Gemm g{Hb, (const bf16*)(C.ws + WS_WOUT0), TT, D, D}; pg8::StaticOrder S; S.init(TT, D, gridDim.x, blockIdx.x); pg8::EpiResid E{P.in[I_X], P.in[I_CTX], (const float*)(C.ws + WS_MOD), XC, 0};
        pg8::gemm_phase<pg8::EpiResid, pg8::StaticOrder, true, true, true>(C.lds, g, S, E, C.wave); SEAM(5); STAMP(5); }
    if (IN(6)) { phase_router_fast(C, 0, TT); SEAM(6); STAMP(6); }
    if (IN(8)) { MOE_GEMM1(0); SEAM(8); STAMP(8); }
    if (IN(9)) { MOE_GEMM2(0); SEAM(9); STAMP(9); }
    if (IN(10)) { phase_combine_norm_mix1(C); SEAM(10); STAMP(10); }
    if (IN(11)) { pg8::Gemm g{Hb, (const bf16*)(C.ws + WS_WS5IN), TT, 512, D}; pg8::StaticOrder S; S.init(TT, 512, gridDim.x, blockIdx.x); pg8::EpiStore E{(bf16*)(C.ws + WS_U), 512};
        pg8::gemm_phase<pg8::EpiStore, pg8::StaticOrder, true, true, true>(C.lds, g, S, E, C.wave); SEAM(11); STAMP(11); }
    if (IN(12)) { phase_s5_fast(C); SEAM(12); STAMP(12); }
    if (IN(13)) { pg8::Gemm g{(const bf16*)(C.ws + WS_GS), (const bf16*)(C.ws + WS_WGLU), TL, 512, 512}; pg8::StaticOrder S; S.init(TL, 512, gridDim.x, blockIdx.x); pg8::EpiGlu E{(const bf16*)(C.ws + WS_GS), P.in[I_BGLU], (bf16*)(C.ws + WS_GG)};
        pg8::gemm_phase<pg8::EpiGlu, pg8::StaticOrder, true, true, true>(C.lds, g, S, E, C.wave); SEAM(13); STAMP(13); }
    if (IN(14)) { pg8::Gemm g{(const bf16*)(C.ws + WS_GG), (const bf16*)(C.ws + WS_WS5OUT), TL, D, 512}; pg8::StaticOrder S; S.init(TL, D, gridDim.x, blockIdx.x); pg8::EpiResid E{P.in[I_X], P.in[I_CTX], (const float*)(C.ws + WS_MOD) + (size_t)17 * 6 * D, XC, 1};
        pg8::gemm_phase<pg8::EpiResid, pg8::StaticOrder, true, true, true>(C.lds, g, S, E, C.wave); SEAM(14); STAMP(14); }
    if (IN(15)) { phase_router_fast(C, 1, TL); SEAM(15); STAMP(15); }
    if (IN(17)) { MOE_GEMM1(1); SEAM(17); STAMP(17); }
    if (IN(18)) { MOE_GEMM2(1); SEAM(18); STAMP(18); }
    if (IN(19)) { phase_final(C); STAMP(19); }
#if MK_PROBE
    if (blockIdx.x == 0 && C.tid == 0) {
        ts_[8] = ts_[7]; ts_[17] = ts_[16];
        const unsigned long long tA = ts_[PROBE_A_HI + 1] - ts_[PROBE_A_LO], tB = ts_[PROBE_B_HI + 1] - ts_[PROBE_B_LO];
        const unsigned long long spin = 16ull * tA + 1000000ull * ((tB + 500ull) / 1000ull);
        const unsigned long long t0 = __builtin_amdgcn_s_memrealtime();
        while (__builtin_amdgcn_s_memrealtime() - t0 < spin) __builtin_amdgcn_s_sleep(8);
    }
#endif
#undef IN
#undef SEAM
}

extern "C" void kernel_launch(void* const* d_in, const int* in_sizes, int n_in, void* d_out, int out_size, void* d_ws, size_t ws_size, hipStream_t stream) {
    constexpr int LDS_BYTES = 147456;
    static int grid = 0;
    if (grid == 0) {
        if (n_in != 35 || out_size != TL * D || ws_size < WS_END) { fprintf(stderr, "kernel_launch: unexpected shapes (n_in %d out %d ws %zu)\n", n_in, out_size, ws_size); grid = -1; return; }
        int dev = 0, cus = 0;
        if (hipGetDevice(&dev) != hipSuccess || hipDeviceGetAttribute(&cus, hipDeviceAttributeMultiprocessorCount, dev) != hipSuccess) { grid = -1; return; }
        if (hipFuncSetAttribute((const void*)fwd_kernel, hipFuncAttributeMaxDynamicSharedMemorySize, LDS_BYTES) != hipSuccess) { fprintf(stderr, "kernel_launch: hipFuncSetAttribute failed\n"); grid = -1; return; }
        (void)hipGetLastError();
        grid = cus;
    }
    if (grid < 0) return;
    (void)hipMemsetAsync((char*)d_ws + WS_CTL, 0, CTL_BYTES, stream);
    Params p{};
    for (int i = 0; i < 35; ++i) p.in[i] = (const float*)d_in[i];
    p.out = (float*)d_out; p.ws = (unsigned char*)d_ws;
#if MK_ONE_LAUNCH
    p.ph_lo = 0; p.ph_hi = NPHASE;
    hipLaunchKernelGGL(fwd_kernel, dim3(grid), dim3(NTHR), LDS_BYTES, stream, p);
#else
    for (int k = 0; k < NPHASE; ++k) { p.ph_lo = k; p.ph_hi = k + 1; hipLaunchKernelGGL(fwd_kernel, dim3(grid), dim3(NTHR), LDS_BYTES, stream, p); }
#endif
}
```

```cpp
#include <hip/hip_runtime.h>
#include <cstdio>
#include <cstdint>
#include <type_traits>

#ifndef MK_ONE_LAUNCH
#define MK_ONE_LAUNCH 1
#endif
#ifndef MK_SIMPLE_ORDER
#define MK_SIMPLE_ORDER 0
#endif
#ifndef MK_KROT
#define MK_KROT 0
#endif
#ifndef MK_PROBE
#define MK_PROBE 0
#endif
#define PROBE_A_LO 4
#define PROBE_A_HI 4
#define PROBE_B_LO 8
#define PROBE_B_HI 9

constexpr int D = 1024, NB = 16, SEQ = 2048, CTXL = 256;
constexpr int TL = NB * SEQ, TC = NB * CTXL, TT = TL + TC;
constexpr int KVL = CTXL + SEQ;
constexpr int MIXW = 1792, NEXP = 32, EH = 512;
constexpr int NSLOT = 81920;
constexpr float EPS = 1e-6f;
constexpr float QSCALE = 0.125f * 1.4426950408889634f;
constexpr int NTHR = 512, NWAVE = 8;
constexpr float W13_SCALE = 32.f;
constexpr float G_SCALE = 8.f;
constexpr int NPHASE = 20;

constexpr size_t MiB = 1u << 20;
constexpr size_t WS_CTL = 0, CTL_BYTES = 1 * MiB;
constexpr size_t WS_MOD = 1 * MiB;
constexpr size_t WS_TAB = 2 * MiB;
constexpr size_t TAB_ROPE = 0, TAB_LAMB = 16384, TAB_BBAR = 65536, TAB_WR = 640 * 1024;
constexpr size_t WS_ROUTE = 3 * MiB;
constexpr size_t RT_E = 0, RT_P = 320 * 1024, RT_W = 640 * 1024, RT_S = 960 * 1024, RT_TILE = 1280 * 1024, RT_NT = 1280 * 1024 + 4096;
constexpr size_t WS_WIN0 = 6 * MiB, WS_WOUT0 = 10 * MiB, WS_WS5IN = 12 * MiB, WS_WGLU = 13 * MiB, WS_WS5OUT = 14 * MiB;
constexpr size_t WS_WSP = 15 * MiB;
constexpr size_t WS_W13 = 16 * MiB, WS_W2 = 80 * MiB;
constexpr size_t WS_W13B = 184 * MiB, WS_W2B = 216 * MiB;
constexpr int L0_A = 10240, L0_B = L0_A + 6144;
constexpr int L1_A = 2048, L1_B = L1_A + 4096, L1_C = L1_B + 7168;
constexpr size_t WS_XC = 112 * MiB;
constexpr size_t WS_H = 256 * MiB;
constexpr size_t WS_P = 328 * MiB;
constexpr size_t WS_Q = 454 * MiB, WS_K = 490 * MiB, WS_V = 499 * MiB;
constexpr size_t WS_XS = 328 * MiB;
constexpr size_t WS_G13 = 488 * MiB;
constexpr size_t WS_U = 328 * MiB, WS_GS = 364 * MiB, WS_GG = 396 * MiB, WS_YACC = 428 * MiB;
constexpr size_t WS_LIST = 568 * MiB;
constexpr int LCAP = 36864;
constexpr size_t WS_END = 574 * MiB;
constexpr int CW_CNT = 64;
constexpr int CW_BAR = 4096;

__device__ __forceinline__ int lane_id_now() { int l; asm volatile("v_mbcnt_lo_u32_b32 %0, -1, 0\n\tv_mbcnt_hi_u32_b32 %0, -1, %0\n\ts_nop 0" : "=v"(l)); return l; }
#define STAMP_AT(idx) do { if (MK_PROBE && blockIdx.x == 0 && C.wave == 0 && lane_id_now() == 0) ((volatile __attribute__((address_space(3))) unsigned long long*)(C.lds + 147456 - 512 + 64))[idx] = __builtin_amdgcn_s_memrealtime(); } while (0)
#define LAS __attribute__((address_space(3)))
typedef unsigned short bf16;
typedef unsigned v4u __attribute__((ext_vector_type(4)));
typedef unsigned v2u __attribute__((ext_vector_type(2)));
typedef float f32x4 __attribute__((ext_vector_type(4)));
typedef float f32x2 __attribute__((ext_vector_type(2)));
__device__ __forceinline__ float bf2f(unsigned u) { return __uint_as_float(u << 16); }
typedef __bf16 bf16x2_t __attribute__((ext_vector_type(2)));
__device__ __forceinline__ unsigned pk2(float lo, float hi) { const f32x2 v = {lo, hi}; return __builtin_bit_cast(unsigned, __builtin_convertvector(v, bf16x2_t)); }
__device__ __forceinline__ unsigned f2bf(float f) { return pk2(f, 0.f) & 0xffffu; }
__device__ __forceinline__ float wave_sum(float v) {
#pragma unroll
    for (int o = 1; o < 64; o <<= 1) v += __shfl_xor(v, o);
    return v;
}
__device__ __forceinline__ float wave_max(float v) {
#pragma unroll
    for (int o = 1; o < 64; o <<= 1) v = fmaxf(v, __shfl_xor(v, o));
    return v;
}
__device__ __forceinline__ float gelu_tanh(float x) { const float u2 = -1.5957691216057308f * (x + 0.044715f * x * x * x); return x * __builtin_amdgcn_rcpf(1.f + __expf(u2)); }
__device__ __forceinline__ float sigmoidf_(float x) { return 1.f / (1.f + __expf(-x)); }
__device__ __forceinline__ float silu_(float x) { return x / (1.f + __expf(-x)); }
__device__ __forceinline__ void unpack8(const v4u w, float* f) {
    f[0] = bf2f(w.x & 0xffffu); f[1] = bf2f(w.x >> 16); f[2] = bf2f(w.y & 0xffffu); f[3] = bf2f(w.y >> 16);
    f[4] = bf2f(w.z & 0xffffu); f[5] = bf2f(w.z >> 16); f[6] = bf2f(w.w & 0xffffu); f[7] = bf2f(w.w >> 16);
}

#define XB_TMO      128
#define XB_XCNT(j)  (256  + 64 * (j))
#define XB_XSUB(j)  (1280 + 64 * (j))
#define XB_XGEN(j)  (2304 + 64 * (j))
#define XB_TOP      3328
#define XB_TOPGEN   3392
#define XCD_BAR_WORDS 3456
#define XB_SPIN_CAP (1u << 28)
__device__ __forceinline__ unsigned xb_ld(unsigned* p)              { return __hip_atomic_load(p, __ATOMIC_RELAXED, __HIP_MEMORY_SCOPE_AGENT); }
__device__ __forceinline__ unsigned xb_add(unsigned* p, unsigned v) { return __hip_atomic_fetch_add(p, v, __ATOMIC_RELAXED, __HIP_MEMORY_SCOPE_AGENT); }
__device__ __forceinline__ unsigned xb_xcc_id() { return (unsigned)__builtin_amdgcn_s_getreg((3 << 11) | 20) & 0xFu; }
#define XB_SPIN(cond, bar) do { unsigned _sp = 0; while (cond) { __builtin_amdgcn_s_sleep(1); \
    if ((++_sp & 255u) == 0u) { if (xb_ld(&(bar)[XB_TMO])) break; if (_sp > XB_SPIN_CAP) { atomicAdd(&(bar)[XB_TMO], 1u); break; } } } } while (0)
struct XcdBarrier { unsigned* bar; unsigned x; volatile LAS unsigned* st; };
__device__ __forceinline__ XcdBarrier xcd_barrier_post(unsigned* bar, volatile LAS unsigned* st) {
    XcdBarrier b; b.bar = bar; b.x = xb_xcc_id(); b.st = st;
    if (threadIdx.x == 0) (void)xb_add(&bar[XB_XCNT(b.x)], 1u);
    return b;
}
__device__ __forceinline__ void xcd_barrier_complete(unsigned* bar, unsigned x, unsigned& nloc, unsigned& nx) {
    const unsigned G = gridDim.x * gridDim.y * gridDim.z;
    unsigned sum, cnt, mine, sp = 0u;
    for (;;) {
        sum = 0u; cnt = 0u; mine = 0u;
#pragma unroll
        for (unsigned j = 0; j < 16; ++j) { const unsigned c = xb_ld(&bar[XB_XCNT(j)]); sum += c; cnt += (c > 0u) ? 1u : 0u; mine = (j == x) ? c : mine; }
        if (sum == G) break;
        __builtin_amdgcn_s_sleep(1);
        if ((++sp & 255u) == 0u) { if (xb_ld(&bar[XB_TMO])) break; if (sp > XB_SPIN_CAP) { atomicAdd(&bar[XB_TMO], 1u); break; } }
    }
    nloc = mine > 0u ? mine : 1u; nx = cnt > 0u ? cnt : 1u;
}
__device__ __forceinline__ void xcd_barrier(const XcdBarrier& b) {
    asm volatile("s_waitcnt vmcnt(0)" ::: "memory");
    __syncthreads();
    if (threadIdx.x == 0) {
        unsigned* bar = b.bar;
        __builtin_amdgcn_s_waitcnt(0);
        unsigned nloc = b.st[0], nx = b.st[1];
        if (nloc == 0u) { xcd_barrier_complete(bar, b.x, nloc, nx); b.st[0] = nloc; b.st[1] = nx; }
        const unsigned old = xb_add(&bar[XB_XSUB(b.x)], 1u);
        const unsigned gen = old / nloc;
        if (old + 1u == (gen + 1u) * nloc) {
            __builtin_amdgcn_fence(__ATOMIC_RELEASE, "agent");
            asm volatile("s_waitcnt vmcnt(0)" ::: "memory");
            const unsigned og = xb_add(&bar[XB_TOP], 1u);
            const unsigned tg = og / nx;
            if (og + 1u == (tg + 1u) * nx) xb_add(&bar[XB_TOPGEN], 1u);
            else XB_SPIN(xb_ld(&bar[XB_TOPGEN]) == tg, bar);
            __builtin_amdgcn_fence(__ATOMIC_ACQUIRE, "agent");
            xb_add(&bar[XB_XGEN(b.x)], 1u);
            asm volatile("s_waitcnt vmcnt(0)" ::: "memory");
        } else {
            XB_SPIN(xb_ld(&bar[XB_XGEN(b.x)]) == gen, bar);
            __builtin_amdgcn_fence(__ATOMIC_ACQUIRE, "agent");
            asm volatile("s_waitcnt vmcnt(0)" ::: "memory");
        }
    }
    __syncthreads();
}

namespace pg8 {
#define PG8_LAS __attribute__((address_space(3)))
typedef unsigned short bf16_t;
typedef short bf16x8 __attribute__((ext_vector_type(8)));
typedef float f32x4 __attribute__((ext_vector_type(4)));
typedef unsigned u32x4 __attribute__((ext_vector_type(4)));
typedef int i32x4 __attribute__((ext_vector_type(4)));
typedef unsigned u32x2 __attribute__((ext_vector_type(2)));
constexpr int BM = 256, BK = 64, HALF = 128, HTB = HALF * BK * 2  , STAGE_BYTES = 8 * HTB, NXCD = 8, WGM = 8;

__host__ __device__ __forceinline__ int lds_byte(int r, int c) { const int st = (r >> 4) * 2 + (c >> 5), rr = r & 15, cc = c & 31, ob = rr * 64 + cc * 2; return st * 1024 + (ob ^ (((ob >> 9) & 1) << 5)); }
__host__ __device__ __forceinline__ void stage_rc(int b, int& R, int& C) { const int st = b / 1024, sb = b % 1024, swz = sb ^ (((sb >> 9) & 1) << 5); R = (st >> 1) * 16 + swz / 64; C = (st & 1) * 32 + (swz % 64) / 2; }
__host__ __device__ __forceinline__ int perm32(int rho) { const int n = rho >> 4, i = rho & 15; return 8 * (i >> 2) + 4 * n + (i & 3); }

struct Unit { int pm, pn; size_t bo; int aux; };
struct Gemm { const bf16_t* A; const bf16_t* Bt; int M, N, K; };

struct StaticOrder {
    static constexpr bool GATHER = false;
    int nM, nN, nwg, G, c;
    __host__ __device__ void init(int M, int N, int G_, int c_) { nM = M / BM; nN = N / BM; nwg = nM * nN; G = G_; c = c_; }
    __host__ __device__ bool next(int i, Unit& u) const {
        const long L = (long)i * G + c; if (L >= nwg) return false;
        if (MK_SIMPLE_ORDER) { u.pm = (int)L / nN; u.pn = (int)L % nN; u.bo = 0; u.aux = 0; return true; }
        int wgid = (int)L; { const int q = nwg / NXCD, r = nwg % NXCD, xcd = wgid % NXCD, off = wgid / NXCD; wgid = (xcd < r ? xcd * (q + 1) : r * (q + 1) + (xcd - r) * q) + off; }
        const int nig = WGM * nN, gid = wgid / nig, fm = gid * WGM, gsz = (nM - fm) < WGM ? (nM - fm) : WGM;
        u.pm = fm + ((wgid % nig) % gsz); u.pn = (wgid % nig) / gsz; u.bo = 0; u.aux = 0; return true;
    }
    __device__ __forceinline__ void a_ready(const Unit&) const {}
    __device__ __forceinline__ void done(const Unit&) const {}
};

typedef __bf16 bf16x2_c __attribute__((ext_vector_type(2))); typedef float f32x2_c __attribute__((ext_vector_type(2)));
__device__ __forceinline__ unsigned cvt_pk_bf16(float lo, float hi) { const f32x2_c v = {lo, hi}; return __builtin_bit_cast(unsigned, __builtin_convertvector(v, bf16x2_c)); }
typedef float f32x2 __attribute__((ext_vector_type(2)));
__device__ __forceinline__ f32x2 gelu_pk(f32x2 v) {
    const f32x2 av = __builtin_elementwise_abs(v), d = av * 0.2316418882f + 1.0f;
    f32x2 t; t.x = __builtin_amdgcn_rcpf(d.x); t.y = __builtin_amdgcn_rcpf(d.y);
    f32x2 q = t * 0.5307027145f + (-0.7265760135f); q = q * t + 0.7107068705f; q = q * t + (-0.142248368f); q = q * t + 0.127414796f; q = q * t;
    const f32x2 s = (v * v) * (-0.72134752044f);
    f32x2 e; e.x = __builtin_amdgcn_exp2f(s.x); e.y = __builtin_amdgcn_exp2f(s.y);
    const f32x2 m = v * (q * e), r = v - m;
    f32x2 o; o.x = v.x < 0.f ? m.x : r.x; o.y = v.y < 0.f ? m.y : r.y; return o;
}

template <class Epi, class Sched, bool ALIGN_EPI = false, bool SP2 = false, bool KROT = false, bool FP8 = false>
__device__ __forceinline__ void gemm_phase(PG8_LAS unsigned char* lds, const Gemm g, const Sched& S, const Epi& E, const int wave_id) {
    const int wid = __builtin_amdgcn_readfirstlane(wave_id), lane = lane_id_now(), tid = wid * 64 + lane, wr = wid >> 2, wc = wid & 3, fr = lane & 15, fq = lane >> 4;
    const int K = g.K, nt = K / BK;
    const int kmask = nt - 1, rot = (MK_KROT && KROT) ? (int)((blockIdx.x * 3u + (blockIdx.x >> 3)) & (unsigned)kmask) : 0;
#define PG8_KO(j) ((size_t)(((j) + rot) & kmask) * kstep)
    unsigned voffA[2], voffB[2];
    unsigned vC[2][2], vN[2][2];
#pragma unroll
    for (int i = 0; i < 2; ++i) { int R, C; stage_rc(tid * 16 + i * 8192, R, C); const int Rb = Epi::PERM ? ((R & ~31) + perm32(R & 31)) : R;
        voffA[i] = (unsigned)(R * K + C) * 2u; voffB[i] = (unsigned)(Rb * K + C) * 2u; }
    const size_t kstep = (size_t)(BK * 2);
    const size_t hstep = (size_t)HALF * K * 2;
    const size_t tstep = 2 * hstep;
    const unsigned ldsw = (unsigned)wid * 1024u;
    const int aoff = lds_byte(wr * 64 + fr, fq * 8), boff = lds_byte(wc * 32 + fr, fq * 8);
#define PG8_SA(b, h) (((b) * 2 + (h)) * HTB)
#define PG8_SB(b, h) ((4 + (b) * 2 + (h)) * HTB)
#define PG8_STAGE(bufoff, gbase, voff) do { _Pragma("unroll") for (int _i = 0; _i < 2; ++_i) \
        __builtin_amdgcn_global_load_lds((const unsigned*)((const char*)(gbase) + (voff)[_i]), (PG8_LAS unsigned*)(lds + (bufoff) + ldsw + _i * 8192), 16, 0, 0); } while (0)
#define PG8_STAGE_A(bufoff, gbase, h, nx) do { _Pragma("unroll") for (int _i = 0; _i < 2; ++_i) { \
        const unsigned _vo = Sched::GATHER ? ((nx) ? vN[h][_i] : vC[h][_i]) : (unsigned)((h) * hstep) + voffA[_i]; \
        __builtin_amdgcn_global_load_lds((const unsigned*)((const char*)(gbase) + _vo), (PG8_LAS unsigned*)(lds + (bufoff) + ldsw + _i * 8192), 16, 0, 0); } } while (0)
#define PG8_LDA(dst, b, h) do { _Pragma("unroll") for (int m = 0; m < 4; ++m) { if constexpr (FP8) { dst[m].lo = *(const PG8_LAS i32x4*)(lds + PG8_SA(b, h) + aoff + m * 2048); dst[m].hi = *(const PG8_LAS i32x4*)(lds + PG8_SA(b, h) + aoff + m * 2048 + 1024); } \
        else { _Pragma("unroll") for (int k = 0; k < 2; ++k) dst[m][k] = *(const PG8_LAS bf16x8*)(lds + PG8_SA(b, h) + aoff + m * 2048 + k * 1024); } } } while (0)
#define PG8_LDB(dst, b, h) do { _Pragma("unroll") for (int n = 0; n < 2; ++n) { if constexpr (FP8) { dst[n].lo = *(const PG8_LAS i32x4*)(lds + PG8_SB(b, h) + boff + n * 2048); dst[n].hi = *(const PG8_LAS i32x4*)(lds + PG8_SB(b, h) + boff + n * 2048 + 1024); } \
        else { _Pragma("unroll") for (int k = 0; k < 2; ++k) dst[n][k] = *(const PG8_LAS bf16x8*)(lds + PG8_SB(b, h) + boff + n * 2048 + k * 1024); } } } while (0)
#define PG8_CAT(x0, x1) __builtin_shufflevector(__builtin_bit_cast(i32x4, x0), __builtin_bit_cast(i32x4, x1), 0, 1, 2, 3, 4, 5, 6, 7)
#define PG8_MMA(ai, bj, At, Bt) do { __builtin_amdgcn_s_setprio(1); \
        if constexpr (FP8) { _Pragma("unroll") for (int m = 0; m < 4; ++m) _Pragma("unroll") for (int n = 0; n < 2; ++n) \
            acc[ai][bj][m][n] = __builtin_amdgcn_mfma_scale_f32_16x16x128_f8f6f4(Bt[n], At[m], acc[ai][bj][m][n], 0, 0, 0, 127, 0, 127); } \
        if constexpr (FP8) { asm volatile("" : "+v"(acc[ai][bj][0][0]), "+v"(acc[ai][bj][0][1]), "+v"(acc[ai][bj][1][0]), "+v"(acc[ai][bj][1][1]), "+v"(acc[ai][bj][2][0]), "+v"(acc[ai][bj][2][1]), "+v"(acc[ai][bj][3][0]), "+v"(acc[ai][bj][3][1])); }     \
        else { _Pragma("unroll") for (int m = 0; m < 4; ++m) _Pragma("unroll") for (int n = 0; n < 2; ++n) _Pragma("unroll") for (int k = 0; k < 2; ++k) \
            acc[ai][bj][m][n] = __builtin_amdgcn_mfma_f32_16x16x32_bf16(Bt[n][k], At[m][k], acc[ai][bj][m][n], 0, 0, 0); } \
        __builtin_amdgcn_s_setprio(0); } while (0)
#define PG8_WAIT_V(n) asm volatile("s_waitcnt vmcnt(" #n ")" ::: "memory")
#define PG8_WAIT_L(n) asm volatile("s_waitcnt lgkmcnt(" #n ")" ::: "memory")
#define PG8_BAR __builtin_amdgcn_s_barrier()
#define PG8_SCHED __builtin_amdgcn_sched_barrier(0)
    Unit cur, nxt; int ui = 0;
    if (!S.next(0, cur)) return;
    f32x4 acc[2][2][4][2];
#pragma unroll
    for (int a = 0; a < 2; ++a)
#pragma unroll
        for (int b = 0; b < 2; ++b)
#pragma unroll
            for (int m = 0; m < 4; ++m)
#pragma unroll
                for (int n = 0; n < 2; ++n) acc[a][b][m][n] = (f32x4){0.f, 0.f, 0.f, 0.f};
    typedef int i32x8 __attribute__((ext_vector_type(8)));
    typedef int i32x8 __attribute__((ext_vector_type(8)));
    typename std::conditional<FP8, i32x8[4], bf16x8[4][2]>::type At; typename std::conditional<FP8, i32x8[2], bf16x8[2][2]>::type B0, B1;
    const char* cA = (const char*)g.A + (Sched::GATHER ? (size_t)0 : (size_t)cur.pm * tstep); const char* cB = (const char*)g.Bt + cur.bo + (size_t)cur.pn * tstep;
    S.a_ready(cur);
#define PG8_VOFF(dst, un) do { _Pragma("unroll") for (int _h = 0; _h < 2; ++_h) _Pragma("unroll") for (int _i = 0; _i < 2; ++_i) { int R_, C_; stage_rc(tid * 16 + _i * 8192, R_, C_); dst[_h][_i] = S.a_off(un, _h * HALF + R_) + (unsigned)C_ * 2u; } } while (0)
    if constexpr (Sched::GATHER) { PG8_VOFF(vC, cur); }
    if constexpr (SP2) {
        PG8_STAGE(PG8_SB(0, 0), cB + PG8_KO(0), voffB); PG8_STAGE(PG8_SB(0, 1), cB + hstep + PG8_KO(0), voffB); PG8_STAGE_A(PG8_SA(0, 0), cA + PG8_KO(0), 0, false); PG8_STAGE_A(PG8_SA(0, 1), cA + PG8_KO(0), 1, false);
        if (wr == 1) PG8_BAR;
        PG8_WAIT_V(2); PG8_BAR;
        PG8_STAGE(PG8_SB(1, 0), cB + PG8_KO(1), voffB); PG8_STAGE_A(PG8_SA(1, 0), cA + PG8_KO(1), 0, false); PG8_STAGE(PG8_SB(1, 1), cB + hstep + PG8_KO(1), voffB);
        PG8_WAIT_V(6); PG8_BAR;
    } else {
        PG8_STAGE(PG8_SB(0, 0), cB, voffB); PG8_STAGE_A(PG8_SA(0, 0), cA, 0, false); PG8_STAGE(PG8_SB(0, 1), cB + hstep, voffB); PG8_STAGE_A(PG8_SA(0, 1), cA, 1, false);
        if (wr == 1) PG8_BAR;
        PG8_WAIT_V(4); PG8_BAR;
        PG8_STAGE(PG8_SB(1, 0), cB + PG8_KO(1), voffB); PG8_STAGE_A(PG8_SA(1, 0), cA + PG8_KO(1), 0, false); PG8_STAGE(PG8_SB(1, 1), cB + hstep + PG8_KO(1), voffB);
        PG8_WAIT_V(6); PG8_BAR;
    }
    for (;;) {
        const bool has_next = S.next(ui + 1, nxt);
        if constexpr (Sched::GATHER) { if (has_next) { PG8_VOFF(vN, nxt); } else { vN[0][0] = vC[0][0]; vN[0][1] = vC[0][1]; vN[1][0] = vC[1][0]; vN[1][1] = vC[1][1]; } }
        const char* nA = (has_next && !Sched::GATHER) ? (const char*)g.A + (size_t)nxt.pm * tstep : cA; const char* nB = has_next ? (const char*)g.Bt + nxt.bo + (size_t)nxt.pn * tstep : cB;
#pragma unroll 1
        for (int t = 0; t < nt; t += 2) {
            const bool last = (t == nt - 2);
            const char* a1 = cA + PG8_KO(t + 1);
            const char* a2 = last ? nA + PG8_KO(0) : cA + PG8_KO(t + 2); const char* b2 = last ? nB + PG8_KO(0) : cB + PG8_KO(t + 2);
            const char* a3 = last ? nA + PG8_KO(1) : cA + PG8_KO(t + 3); const char* b3 = last ? nB + PG8_KO(1) : cB + PG8_KO(t + 3);
            if (last && has_next) S.a_ready(nxt);
            if constexpr (SP2) {
            PG8_LDB(B0, 0, 0); PG8_LDB(B1, 0, 1); PG8_SCHED; PG8_LDA(At, 0, 0); PG8_STAGE_A(PG8_SA(1, 1), a1, 1, false);
            PG8_WAIT_V(8); PG8_WAIT_L(0); PG8_BAR; PG8_MMA(0, 0, At, B0); PG8_MMA(0, 1, At, B1); PG8_BAR; PG8_SCHED;
            PG8_LDA(At, 0, 1); PG8_STAGE(PG8_SB(0, 0), b2, voffB); PG8_STAGE(PG8_SB(0, 1), b2 + hstep, voffB); PG8_STAGE_A(PG8_SA(0, 0), a2, 0, last);
            PG8_WAIT_V(8); PG8_WAIT_L(0); PG8_BAR; PG8_MMA(1, 0, At, B0); PG8_MMA(1, 1, At, B1); PG8_BAR; PG8_SCHED;
            PG8_LDB(B0, 1, 0); PG8_LDB(B1, 1, 1); PG8_SCHED; PG8_LDA(At, 1, 0); PG8_STAGE_A(PG8_SA(0, 1), a2, 1, last);
            PG8_WAIT_V(8); PG8_WAIT_L(0); PG8_BAR; PG8_MMA(0, 0, At, B0); PG8_MMA(0, 1, At, B1); PG8_BAR; PG8_SCHED;
            PG8_LDA(At, 1, 1); PG8_STAGE(PG8_SB(1, 0), b3, voffB); PG8_STAGE(PG8_SB(1, 1), b3 + hstep, voffB); PG8_STAGE_A(PG8_SA(1, 0), a3, 0, last);
            PG8_WAIT_V(8); PG8_WAIT_L(0); PG8_BAR; PG8_MMA(1, 0, At, B0); PG8_MMA(1, 1, At, B1); PG8_BAR; PG8_SCHED;
            } else {
            PG8_LDB(B0, 0, 0); PG8_SCHED; PG8_LDA(At, 0, 0); PG8_STAGE_A(PG8_SA(1, 1), a1, 1, false);
            PG8_WAIT_L(8); PG8_BAR; PG8_WAIT_L(0); PG8_MMA(0, 0, At, B0); PG8_BAR; PG8_SCHED;
            PG8_LDB(B1, 0, 1); PG8_STAGE(PG8_SB(0, 0), b2, voffB);
            PG8_BAR; PG8_WAIT_L(0); PG8_MMA(0, 1, At, B1); PG8_BAR;
            PG8_LDA(At, 0, 1); PG8_STAGE_A(PG8_SA(0, 0), a2, 0, last);
            PG8_BAR; PG8_WAIT_L(0); PG8_MMA(1, 0, At, B0); PG8_BAR; PG8_SCHED;
            PG8_STAGE(PG8_SB(0, 1), b2 + hstep, voffB);
            PG8_WAIT_V(6); PG8_BAR; PG8_MMA(1, 1, At, B1); PG8_BAR;
            PG8_LDB(B0, 1, 0); PG8_SCHED; PG8_LDA(At, 1, 0); PG8_STAGE_A(PG8_SA(0, 1), a2, 1, last);
            PG8_WAIT_L(8); PG8_BAR; PG8_WAIT_L(0); PG8_MMA(0, 0, At, B0); PG8_BAR; PG8_SCHED;
            PG8_LDB(B1, 1, 1); PG8_STAGE(PG8_SB(1, 0), b3, voffB);
            PG8_BAR; PG8_WAIT_L(0); PG8_MMA(0, 1, At, B1); PG8_BAR;
            PG8_LDA(At, 1, 1); PG8_STAGE_A(PG8_SA(1, 0), a3, 0, last);
            PG8_BAR; PG8_WAIT_L(0); PG8_MMA(1, 0, At, B0); PG8_BAR; PG8_SCHED;
            PG8_STAGE(PG8_SB(1, 1), b3 + hstep, voffB);
            PG8_WAIT_V(6); PG8_BAR; PG8_MMA(1, 1, At, B1); PG8_BAR;
            }
        }
        if constexpr (ALIGN_EPI) { if (wr == 0) PG8_BAR; }
        if constexpr (!Epi::AFTER_DRAIN) { E(acc, cur, wr, wc, fr, fq); S.done(cur); }
        if (!has_next) break;
#pragma unroll
        for (int a = 0; a < 2; ++a)
#pragma unroll
            for (int b = 0; b < 2; ++b)
#pragma unroll
                for (int m = 0; m < 4; ++m)
#pragma unroll
                    for (int n = 0; n < 2; ++n) acc[a][b][m][n] = (f32x4){0.f, 0.f, 0.f, 0.f};
        cur = nxt; cA = nA; cB = nB; ++ui;
        if constexpr (Sched::GATHER) { vC[0][0] = vN[0][0]; vC[0][1] = vN[0][1]; vC[1][0] = vN[1][0]; vC[1][1] = vN[1][1]; }
        if constexpr (ALIGN_EPI) { if (wr == 1) PG8_BAR; }
    }
    PG8_WAIT_V(0);
    if constexpr (!ALIGN_EPI) { if (wr == 0) PG8_BAR; }
    PG8_BAR;
    if constexpr (Epi::AFTER_DRAIN) { E.fused(acc, cur, wr, wc, fr, fq, lds, wid, lane); S.done(cur); }
#undef PG8_VOFF
#undef PG8_KO
#undef PG8_SA
#undef PG8_SB
#undef PG8_STAGE
#undef PG8_STAGE_A
#undef PG8_LDA
#undef PG8_LDB
#undef PG8_MMA
#undef PG8_CAT
#undef PG8_WAIT_V
#undef PG8_WAIT_L
#undef PG8_BAR
#undef PG8_SCHED
}
}

namespace pg8 {
template <bool GATHER_>
struct GroupedOrder {
    static constexpr bool GATHER = GATHER_;
    const PG8_LAS int* tmap; const PG8_LAS int* cntl; const int* list; int nU, nN, G, c, lcap, rowbytes; size_t estride;
    __device__ __forceinline__ bool next(int i, Unit& u) const { const int ntl = nU / nN, n8 = (ntl + 7) >> 3, x = c & 7, t0 = x * n8; int nt = ntl - t0; nt = nt < 0 ? 0 : (nt > n8 ? n8 : nt);
        const int v = (c >> 3) + (G >> 3) * i; if ((G & 7) != 0 || v >= nt * nN) { if ((G & 7) == 0) return false; const long L = (long)i * G + c; if (L >= nU) return false; const int t_ = (int)L / nN; const int m_ = __builtin_amdgcn_readfirstlane(tmap[t_]); u.pm = t_; u.pn = (int)L % nN; u.bo = (size_t)(m_ & 255) * estride; u.aux = m_; return true; }
        const int t = t0 + v / nN; const int m = __builtin_amdgcn_readfirstlane(tmap[t]);
        u.pm = t; u.pn = v % nN; u.bo = (size_t)(m & 255) * estride; u.aux = m; return true; }
    __device__ __forceinline__ unsigned a_off(const Unit& u, int R) const { const int e = u.aux & 255, p0 = u.aux >> 8, ce = cntl[e]; int p = p0 + R; p = p < ce ? p : ce - 1; return (unsigned)list[(size_t)e * lcap + p] * (unsigned)rowbytes; }
    __device__ __forceinline__ void a_ready(const Unit&) const {}
    __device__ __forceinline__ void done(const Unit&) const {}
};
__device__ __forceinline__ u32x4 pack8(const f32x4 a, const f32x4 b) { u32x4 w; w.x = cvt_pk_bf16(a[0], a[1]); w.y = cvt_pk_bf16(a[2], a[3]); w.z = cvt_pk_bf16(b[0], b[1]); w.w = cvt_pk_bf16(b[2], b[3]); return w; }
struct EpiStore {
    static constexpr bool PERM = true, AFTER_DRAIN = false; bf16_t* O; int ldc; float s;
    __device__ __forceinline__ void operator()(const f32x4 (&acc)[2][2][4][2], const Unit& u, int wr, int wc, int, int) const {
        const int ln = lane_id_now(), fr = ln & 15, fq = ln >> 4;
        const int row0 = u.pm * BM + wr * 64 + fr, col0 = u.pn * BM + wc * 32 + 8 * fq;
#pragma unroll
        for (int ai = 0; ai < 2; ++ai)
#pragma unroll
            for (int m = 0; m < 4; ++m) { bf16_t* rowp = O + (size_t)(row0 + ai * HALF + m * 16) * ldc + col0;
#pragma unroll
                for (int bj = 0; bj < 2; ++bj) *(u32x4*)(rowp + bj * HALF) = pack8(acc[ai][bj][m][0] * s, acc[ai][bj][m][1] * s); }
    }
};

struct EpiInProj {
    static constexpr bool PERM = true, AFTER_DRAIN = false;
    bf16_t* O; bf16_t* Kb; bf16_t* Vb; const float* kg; const float* rope; PG8_LAS float* xch;
    float s;
    float* part;
    __device__ __forceinline__ void operator()(const f32x4 (&acc)[2][2][4][2], const Unit& u, int wr, int wc, int, int) const {
        const int ln = lane_id_now(), fr = ln & 15, fq = ln >> 4;
        if (u.pn != 2) {
            const int row0 = u.pm * BM + wr * 64 + fr, col0 = u.pn * BM + wc * 32 + 8 * fq;
            if (u.pn < 2) {
#pragma unroll
                for (int ai = 0; ai < 2; ++ai)
#pragma unroll
                    for (int m = 0; m < 4; ++m) { bf16_t* rowp = O + (size_t)(row0 + ai * HALF + m * 16) * 1792 + col0;
#pragma unroll
                        for (int bj = 0; bj < 2; ++bj) *(u32x4*)(rowp + bj * HALF) = pack8(acc[ai][bj][m][0] * s, acc[ai][bj][m][1] * s); }
                return;
            }
            const bool stats = u.pn >= 5;
#pragma unroll
            for (int ai = 0; ai < 2; ++ai)
#pragma unroll
                for (int m = 0; m < 4; ++m) { bf16_t* rowp = O + (size_t)(row0 + ai * HALF + m * 16) * 1792 + col0; float s1 = 0.f, s2 = 0.f;
#pragma unroll
                    for (int bj = 0; bj < 2; ++bj) { f32x4 ga, gb;
#pragma unroll
                        for (int i = 0; i < 4; ++i) { const float x = acc[ai][bj][m][0][i] * s, y = acc[ai][bj][m][1][i] * s;
                            ga[i] = x * __builtin_amdgcn_rcpf(1.f + __expf(-1.5957691216057308f * (x + 0.044715f * x * x * x)));
                            gb[i] = y * __builtin_amdgcn_rcpf(1.f + __expf(-1.5957691216057308f * (y + 0.044715f * y * y * y))); }
                        const u32x4 w = pack8(ga, gb); *(u32x4*)(rowp + bj * HALF) = w;
                        if (stats) { const float r0 = __uint_as_float(w.x << 16), r1 = __uint_as_float(w.x & 0xffff0000u), r2 = __uint_as_float(w.y << 16), r3 = __uint_as_float(w.y & 0xffff0000u),
                                                 r4 = __uint_as_float(w.z << 16), r5 = __uint_as_float(w.z & 0xffff0000u), r6 = __uint_as_float(w.w << 16), r7 = __uint_as_float(w.w & 0xffff0000u);
                            s1 += ((r0 + r1) + (r2 + r3)) + ((r4 + r5) + (r6 + r7)); s2 += ((r0 * r0 + r1 * r1) + (r2 * r2 + r3 * r3)) + ((r4 * r4 + r5 * r5) + (r6 * r6 + r7 * r7)); } }
                    if (stats) { s1 += __shfl_xor(s1, 16); s1 += __shfl_xor(s1, 32); s2 += __shfl_xor(s2, 16); s2 += __shfl_xor(s2, 32);
                        if (fq == 0) { float* pp = part + ((size_t)(row0 + ai * HALF + m * 16) * 8 + (u.pn - 5) * 4 + wc) * 2; pp[0] = s1; pp[1] = s2; } } }
            return;
        }
        const int R0 = u.pm * BM; const bool lat = R0 < 32768;
        const size_t kvbase = lat ? (size_t)(R0 >> 11) * 2304 + 256 + (R0 & 2047) : (size_t)((R0 - 32768) >> 8) * 2304;
#pragma unroll
        for (int ai = 0; ai < 2; ++ai)
#pragma unroll
            for (int m = 0; m < 4; ++m) { const f32x4 a = acc[ai][0][m][0], b = acc[ai][0][m][1];
                float sq = (a[0] * a[0] + a[1] * a[1]) + (a[2] * a[2] + a[3] * a[3]) + (b[0] * b[0] + b[1] * b[1]) + (b[2] * b[2] + b[3] * b[3]);
                sq += __shfl_xor(sq, 16); sq += __shfl_xor(sq, 32);
                if (fq == 0) xch[(ai * HALF + wr * 64 + m * 16 + fr) * 4 + wc] = sq; }
        asm volatile("s_waitcnt lgkmcnt(0)\n\ts_barrier" ::: "memory");
        const int dh = 32 * (wc & 1) + 8 * fq;
        const f32x4 g0 = *(const f32x4*)(kg + dh), g1 = *(const f32x4*)(kg + dh + 4);
        const bool x2 = (fq & 2) != 0;
#pragma unroll
        for (int ai = 0; ai < 2; ++ai)
#pragma unroll
            for (int m = 0; m < 4; ++m) { const int rl = ai * HALF + wr * 64 + m * 16 + fr;
                const float tot = xch[rl * 4 + wc] + xch[rl * 4 + (wc ^ 1)]; const float rs = rsqrtf(tot * (s * s * (1.f / 64.f)) + 1e-6f) * s;
                f32x4 a = acc[ai][0][m][0] * rs * g0, b = acc[ai][0][m][1] * rs * g1;
                f32x4 pa, pb;
#pragma unroll
                for (int i = 0; i < 4; ++i) { pa[i] = __shfl_xor(a[i], 32); pb[i] = __shfl_xor(b[i], 32); }
                if (lat) { const int t = (R0 & 2047) + rl; const int pos = (wc & 1) ? (t & 63) : (t >> 6);
                    const float* rp = rope + ((size_t)pos * 16 + 8 * (fq & 1)) * 2;
                    const f32x4 c0 = *(const f32x4*)(rp), c1 = *(const f32x4*)(rp + 4), c2 = *(const f32x4*)(rp + 8), c3 = *(const f32x4*)(rp + 12);
                    const f32x4 cs = {c0[0], c0[2], c1[0], c1[2]}, sn = {c0[1], c0[3], c1[1], c1[3]}, cs2 = {c2[0], c2[2], c3[0], c3[2]}, sn2 = {c2[1], c2[3], c3[1], c3[3]};
                    a = x2 ? (a * cs + pa * sn) : (a * cs - pa * sn); b = x2 ? (b * cs2 + pb * sn2) : (b * cs2 - pb * sn2); }
                const size_t o = (kvbase + rl) * 128 + 32 * wc + 8 * fq;
                *(u32x4*)(Kb + o) = pack8(a, b); *(u32x4*)(Vb + o) = pack8(acc[ai][1][m][0] * s, acc[ai][1][m][1] * s); }
        asm volatile("s_waitcnt lgkmcnt(0)\n\ts_barrier" ::: "memory");
    }
};
__device__ __forceinline__ f32x4 silu4(const f32x4 v) { f32x4 r;
#pragma unroll
    for (int i = 0; i < 4; ++i) r[i] = v[i] * __builtin_amdgcn_rcpf(1.f + __expf(-v[i])); return r; }
__device__ __forceinline__ f32x4 sigm4(const f32x4 v) { f32x4 r;
#pragma unroll
    for (int i = 0; i < 4; ++i) r[i] = __builtin_amdgcn_rcpf(1.f + __expf(-v[i])); return r; }
__device__ __forceinline__ u32x2 pack8_fp8(const f32x4 a, const f32x4 b) { int w0 = 0, w1 = 0;
    w0 = __builtin_amdgcn_cvt_pk_fp8_f32(a[0], a[1], w0, false); w0 = __builtin_amdgcn_cvt_pk_fp8_f32(a[2], a[3], w0, true);
    w1 = __builtin_amdgcn_cvt_pk_fp8_f32(b[0], b[1], w1, false); w1 = __builtin_amdgcn_cvt_pk_fp8_f32(b[2], b[3], w1, true); u32x2 r; r.x = (unsigned)w0; r.y = (unsigned)w1; return r; }
__device__ __forceinline__ f32x4 clamp8(const f32x4 v) { f32x4 r;
#pragma unroll
    for (int i = 0; i < 4; ++i) r[i] = __builtin_amdgcn_fmed3f(v[i], -448.f, 448.f); return r; }
struct EpiSwiglu {
    static constexpr bool PERM = true, AFTER_DRAIN = false; unsigned char* G; float s, so;
    __device__ __forceinline__ void operator()(const f32x4 (&acc)[2][2][4][2], const Unit& u, int wr, int wc, int, int) const {
        const int ln = lane_id_now(), fr = ln & 15, fq = ln >> 4;
        const int row0 = u.pm * BM + wr * 64 + fr, col0 = u.pn * HALF + wc * 32 + 8 * fq;
#pragma unroll
        for (int ai = 0; ai < 2; ++ai)
#pragma unroll
            for (int m = 0; m < 4; ++m) *(u32x2*)(G + (size_t)(row0 + ai * HALF + m * 16) * 512 + col0) = pack8_fp8(clamp8(silu4(acc[ai][0][m][0] * s) * (acc[ai][1][m][0] * (s * so))), clamp8(silu4(acc[ai][0][m][1] * s) * (acc[ai][1][m][1] * (s * so))));
    }
};
__device__ __forceinline__ void unpack8f(const u32x4 w, f32x4& a, f32x4& b) {
    a[0] = __uint_as_float(w.x << 16); a[1] = __uint_as_float(w.x & 0xffff0000u); a[2] = __uint_as_float(w.y << 16); a[3] = __uint_as_float(w.y & 0xffff0000u);
    b[0] = __uint_as_float(w.z << 16); b[1] = __uint_as_float(w.z & 0xffff0000u); b[2] = __uint_as_float(w.w << 16); b[3] = __uint_as_float(w.w & 0xffff0000u); }
struct EpiGlu {
    static constexpr bool PERM = true, AFTER_DRAIN = false; const bf16_t* GS; const float* b; bf16_t* GG;
    __device__ __forceinline__ void operator()(const f32x4 (&acc)[2][2][4][2], const Unit& u, int wr, int wc, int fr, int fq) const {
        const int row0 = u.pm * BM + wr * 64 + fr, col0 = u.pn * BM + wc * 32 + 8 * fq;
#pragma unroll
        for (int bj = 0; bj < 2; ++bj) { const int c = col0 + bj * HALF; const f32x4 b0 = *(const f32x4*)(b + c), b1 = *(const f32x4*)(b + c + 4);
#pragma unroll
            for (int ai = 0; ai < 2; ++ai)
#pragma unroll
                for (int m = 0; m < 4; ++m) { const size_t o = (size_t)(row0 + ai * HALF + m * 16) * 512 + c; f32x4 g0, g1; unpack8f(*(const u32x4*)(GS + o), g0, g1);
                    *(u32x4*)(GG + o) = pack8(g0 * sigm4(acc[ai][bj][m][0] + b0), g1 * sigm4(acc[ai][bj][m][1] + b1)); } }
    }
};
struct EpiResid {
    static constexpr bool PERM = true, AFTER_DRAIN = false;
    const float* x; const float* ctx; const float* mod; bf16_t* XC; int inplace;
    __device__ __forceinline__ void operator()(const f32x4 (&acc)[2][2][4][2], const Unit& u, int wr, int wc, int fr, int fq) const {
        const int R0 = u.pm * BM; const int ci = R0 < 32768 ? (R0 >> 11) : 16;
        const float* base = R0 < 32768 ? x + (size_t)R0 * 1024 : ctx + (size_t)(R0 - 32768) * 1024;
        bf16_t* out = XC + (size_t)R0 * 1024; const float* gate = mod + ((size_t)ci * 6 + 2) * 1024;
        const int rl0 = wr * 64 + fr, col0 = u.pn * BM + wc * 32 + 8 * fq;
#pragma unroll
        for (int bj = 0; bj < 2; ++bj) { const int c = col0 + bj * HALF; const f32x4 g0 = *(const f32x4*)(gate + c), g1 = *(const f32x4*)(gate + c + 4);
#pragma unroll
            for (int ai = 0; ai < 2; ++ai)
#pragma unroll
                for (int m = 0; m < 4; ++m) { const size_t o = (size_t)(rl0 + ai * HALF + m * 16) * 1024 + c; f32x4 b0, b1;
                    if (inplace) unpack8f(*(const u32x4*)(out + o), b0, b1); else { b0 = *(const f32x4*)(base + o); b1 = *(const f32x4*)(base + o + 4); }
                    *(u32x4*)(out + o) = pack8(b0 + g0 * acc[ai][bj][m][0], b1 + g1 * acc[ai][bj][m][1]); } }
    }
};
}

#include <hip/hip_bf16.h>
#include <cmath>
namespace attn_body {
using bf16=__hip_bfloat16;
using bf16x8=__attribute__((ext_vector_type(8)))short;
using s16x4=__attribute__((ext_vector_type(4)))short;
using f32x16=__attribute__((ext_vector_type(16)))float;
using u32x4=__attribute__((ext_vector_type(4)))unsigned;
constexpr int D=64,QP=1792,KP=128,OP=1024;
constexpr int NW=8,QBLK=32,QB=QBLK*NW,KVBLK=64;
constexpr int ATTN_UNIT_ROWS=QB;
__device__ __forceinline__ int crow(int r,int hi){return (r&3)+8*(r>>2)+4*hi;}
#define SBAR() __builtin_amdgcn_sched_barrier(0)
__device__ __forceinline__ void cmask(f32x16&p0,f32x16&p1,int jb,int qrel,int hi){
  const float NEG=-INFINITY; int kb=64*jb+4*hi;
  #pragma unroll
  for(int r=0;r<16;++r){int kv=kb+(r&3)+8*(r>>2); if(kv>qrel)p0[r]=NEG; if(kv+32>qrel)p1[r]=NEG;}
}

constexpr int NSLOT=3, SLOTB=8192;
constexpr int LDS_K=0, LDS_V=NSLOT*SLOTB, LDS_WS=2*NSLOT*SLOTB, LDS_OST=LDS_WS+NW*64*4, LDS_BYTES=LDS_OST+NW*4096;
constexpr float C2=0.125f*1.4426950408889634f;
__device__ __forceinline__ void glds16(const void*gsrc,unsigned lds_dst){unsigned keep;
  asm volatile("s_mov_b32 %0, m0\n\ts_mov_b32 m0, %2\n\ts_nop 0\n\tglobal_load_lds_dwordx4 %1, off\n\ts_mov_b32 m0, %0":"=&s"(keep):"v"(gsrc),"s"(lds_dst):"memory");}
__device__ __forceinline__ float max3f(float a,float b,float c){float r;asm("v_max3_f32 %0, %1, %2, %3":"=v"(r):"v"(a),"v"(b),"v"(c));return r;}
__device__ __forceinline__ float max2f(float a,float b){float r;asm("v_max_f32_e32 %0, %1, %2":"=v"(r):"v"(a),"v"(b));return r;}
__device__ __forceinline__ float fadd_s(float a,float b){float r;asm("v_add_f32_e32 %0, %1, %2":"=v"(r):"v"(a),"v"(b));return r;}
__device__ __forceinline__ float fsub_s(float a,float b){float r;asm("v_sub_f32_e32 %0, %1, %2":"=v"(r):"v"(a),"v"(b));return r;}
typedef float f32x2_t __attribute__((ext_vector_type(2))); typedef __bf16 bf16x2_t __attribute__((ext_vector_type(2)));
__device__ __forceinline__ unsigned cvtpk_s(float lo,float hi){f32x2_t v={lo,hi};bf16x2_t b=__builtin_convertvector(v,bf16x2_t);return __builtin_bit_cast(unsigned,b);}
#define WAIT_BAR(N) asm volatile("s_waitcnt vmcnt(" #N ") lgkmcnt(0)\n\ts_barrier":::"memory")

__device__ __forceinline__ void qkt(f32x16&p0,f32x16&p1,const char*Kslot,const bf16x8*qr,const f32x16&negm,int r32,int hi){
  const char*kb=Kslot+hi*1024+r32*16;
  #pragma unroll
  for(int d0=0;d0<4;++d0){
    const bf16x8 b0=*reinterpret_cast<const bf16x8*>(kb+d0*2048);
    const bf16x8 b1=*reinterpret_cast<const bf16x8*>(kb+d0*2048+512);
    if(d0==0){p0=__builtin_amdgcn_mfma_f32_32x32x16_bf16(b0,qr[0],negm,0,0,0);p1=__builtin_amdgcn_mfma_f32_32x32x16_bf16(b1,qr[0],negm,0,0,0);}
    else{p0=__builtin_amdgcn_mfma_f32_32x32x16_bf16(b0,qr[d0],p0,0,0,0);p1=__builtin_amdgcn_mfma_f32_32x32x16_bf16(b1,qr[d0],p1,0,0,0);}}
}
typedef __attribute__((address_space(3))) const char* lds_cptr;
typedef short v4i16_t __attribute__((ext_vector_type(4)));
__device__ __forceinline__ void kload8(bf16x8*kf,lds_cptr kp){
  kf[0]=*(const __attribute__((address_space(3))) bf16x8*)(kp);      kf[1]=*(const __attribute__((address_space(3))) bf16x8*)(kp+512);
  kf[2]=*(const __attribute__((address_space(3))) bf16x8*)(kp+2048); kf[3]=*(const __attribute__((address_space(3))) bf16x8*)(kp+2560);
  kf[4]=*(const __attribute__((address_space(3))) bf16x8*)(kp+4096); kf[5]=*(const __attribute__((address_space(3))) bf16x8*)(kp+4608);
  kf[6]=*(const __attribute__((address_space(3))) bf16x8*)(kp+6144); kf[7]=*(const __attribute__((address_space(3))) bf16x8*)(kp+6656);
}
__device__ __forceinline__ void kload2(bf16x8*kf,lds_cptr kp,int j){ kf[2*j]=*(const __attribute__((address_space(3))) bf16x8*)(kp+j*2048); kf[2*j+1]=*(const __attribute__((address_space(3))) bf16x8*)(kp+j*2048+512); }
__device__ __forceinline__ s16x4 vtr(lds_cptr p){ return __builtin_bit_cast(s16x4,__builtin_amdgcn_ds_read_tr16_b64_v4i16((__attribute__((address_space(3))) v4i16_t*)p)); }
__device__ __forceinline__ float rowmax(const f32x16&p0,const f32x16&p1){
  float a=max3f(p0[0],p0[1],p1[0]),b=max3f(p0[2],p0[3],p1[1]);a=max3f(a,p1[2],p1[3]);
  #pragma unroll
  for(int r=4;r<16;r+=4){a=max3f(a,p0[r],p0[r+1]);b=max3f(b,p0[r+2],p0[r+3]);a=max3f(a,p1[r],p1[r+1]);b=max3f(b,p1[r+2],p1[r+3]);}
  const float m=max2f(a,b);
  auto rr=__builtin_amdgcn_permlane32_swap(__float_as_uint(m),__float_as_uint(m),false,false);
  return max2f(__uint_as_float(rr[0]),__uint_as_float(rr[1]));
}
__device__ __forceinline__ void pv(f32x16*o,int vb,bf16x8 pa0,bf16x8 pa1,bf16x8 pa2,bf16x8 pa3){
  #pragma unroll
  for(int d0=0;d0<2;++d0){s16x4 lo[4],hi[4];
    #pragma unroll
    for(int ks=0;ks<4;++ks){
      asm volatile("ds_read_b64_tr_b16 %0,%1 offset:%c2":"=&v"(lo[ks]):"v"(vb),"i"(d0*4096+ks*1024):"memory");
      asm volatile("ds_read_b64_tr_b16 %0,%1 offset:%c2":"=&v"(hi[ks]):"v"(vb),"i"(d0*4096+ks*1024+512):"memory");}
    asm volatile("s_waitcnt lgkmcnt(0)":::"memory");SBAR();
    #define PK(k) (bf16x8){lo[k][0],lo[k][1],lo[k][2],lo[k][3],hi[k][0],hi[k][1],hi[k][2],hi[k][3]}
    o[d0]=__builtin_amdgcn_mfma_f32_32x32x16_bf16(pa0,PK(0),o[d0],0,0,0);
    o[d0]=__builtin_amdgcn_mfma_f32_32x32x16_bf16(pa1,PK(1),o[d0],0,0,0);
    o[d0]=__builtin_amdgcn_mfma_f32_32x32x16_bf16(pa2,PK(2),o[d0],0,0,0);
    o[d0]=__builtin_amdgcn_mfma_f32_32x32x16_bf16(pa3,PK(3),o[d0],0,0,0);
    #undef PK
  }
}

#ifndef ATTN_STORE16
#define ATTN_STORE16(p,v) (*(u32x4*)(p)=(v))
#endif
template<int THRL> __device__ __forceinline__ void attn_unit(const bf16*Q0,const bf16*__restrict__ Kh,const bf16*__restrict__ Vh,bf16*O0,const int NT,char*shm,const float*qg,const float2*rope,const int tq0){
  const int tid=threadIdx.x,lane=tid&63,r32=lane&31,hi=lane>>5; const int wid=__builtin_amdgcn_readfirstlane(tid>>6);
  const bf16*Qw=Q0+(long)(wid*QBLK)*QP;
  const unsigned lds0=(unsigned)(uintptr_t)shm;
  float*wsf=(float*)(shm+LDS_WS)+wid*64;
  const bf16*ksrc=Kh+(long)lane*KP+wid*8;
  const bf16*vsrc=Vh+(long)(16*(wid&3)+(lane>>2))*KP+(wid>>2)*32+(lane&3)*8;
  const unsigned kdst=lds0+LDS_K+wid*1024, vdst=lds0+LDS_V+wid*1024;
  #define DMA_K(t,slot) glds16(ksrc+(long)(t)*KVBLK*KP,(unsigned)__builtin_amdgcn_readfirstlane(kdst+(slot)))
  #define DMA_V(t,slot) glds16(vsrc+(long)(t)*KVBLK*KP,(unsigned)__builtin_amdgcn_readfirstlane(vdst+(slot)))
  const int vb0=(int)(lds0+LDS_V)+((lane>>4)&1)*32+(lane&3)*8+(4*hi+((lane&15)>>2))*64;
  const char*Kbase=shm+LDS_K; bf16x8 kf[8];
  const lds_cptr shm3=(lds_cptr)shm; const lds_cptr kp0=shm3+LDS_K+hi*1024+r32*16; const lds_cptr vp0=shm3+LDS_V+((lane>>4)&1)*32+(lane&3)*8+(4*hi+((lane&15)>>2))*64;
  DMA_K(0,0);DMA_V(0,0);DMA_K(1,SLOTB);
  bf16x8 qr[4];
  #pragma unroll
  for(int d0=0;d0<4;++d0)qr[d0]=*reinterpret_cast<const bf16x8*>(&Qw[(long)r32*QP+d0*16+hi*8]);
  { float qf[4][8]; float ss=0.f;
    #pragma unroll
    for(int d0=0;d0<4;++d0){
      #pragma unroll
      for(int j=0;j<8;++j){ const float v=__uint_as_float(((unsigned)(unsigned short)qr[d0][j])<<16); qf[d0][j]=v; ss+=v*v; } }
    ss+=__shfl_xor(ss,32);
    const float rs=rsqrtf(ss*(1.f/64.f)+1e-6f);
    #pragma unroll
    for(int d0=0;d0<4;++d0){
      #pragma unroll
      for(int j=0;j<8;++j) qf[d0][j]*=rs*qg[16*d0+8*hi+j]; }
    if(tq0>=0){ const int t=tq0+wid*QBLK+r32; const float2*rr=rope+(t>>6)*16+8*hi; const float2*rc=rope+(t&63)*16+8*hi;
      #pragma unroll
      for(int j=0;j<8;++j){ const float2 a=rr[j],c=rc[j];
        const float x1=qf[0][j],x2=qf[1][j]; qf[0][j]=x1*a.x-x2*a.y; qf[1][j]=x2*a.x+x1*a.y;
        const float y1=qf[2][j],y2=qf[3][j]; qf[2][j]=y1*c.x-y2*c.y; qf[3][j]=y2*c.x+y1*c.y; } }
    #pragma unroll
    for(int d0=0;d0<4;++d0){ u32x4 w; w.x=cvtpk_s(qf[d0][0]*C2,qf[d0][1]*C2); w.y=cvtpk_s(qf[d0][2]*C2,qf[d0][3]*C2); w.z=cvtpk_s(qf[d0][4]*C2,qf[d0][5]*C2); w.w=cvtpk_s(qf[d0][6]*C2,qf[d0][7]*C2); qr[d0]=__builtin_bit_cast(bf16x8,w); } }
  float mhat=0.f,l_reg=0.f;f32x16 o[2];o[0]=f32x16{};o[1]=f32x16{};f32x16 negm=f32x16{};asm volatile("":"+v"(negm));
  #define CMASK(P0,P1,t) do{}while(0)
  bool resc=false;
  #define START(P0,P1) do{ const float rm=rowmax(P0,P1); resc=false; \
    { const float dl=rm; mhat=fadd_s(mhat,dl); \
      _Pragma("unroll") for(int r=0;r<16;++r){P0[r]=fsub_s(P0[r],dl);P1[r]=fsub_s(P1[r],dl);} \
      _Pragma("unroll") for(int r=0;r<16;++r)negm[r]=-mhat; asm volatile("":"+v"(negm)); } \
    _Pragma("unroll") for(int r=0;r<16;++r)P0[r]=__builtin_amdgcn_exp2f(P0[r]); }while(0)
  #define RESC() do{ if(resc){ asm volatile("s_waitcnt lgkmcnt(0)":::"memory"); \
      _Pragma("unroll") for(int d_=0;d_<2;++d_) _Pragma("unroll") for(int r=0;r<16;++r)o[d_][r]*=wsf[crow(r,hi)]; } }while(0)
  f32x16 pA0,pA1,pB0,pB1;
  int sl_prev=0,sl_cur=0,sl_next=SLOTB;
  #define ROT() do{sl_prev=sl_cur;sl_cur=sl_next;sl_next=(sl_next==(NSLOT-1)*SLOTB)?0:sl_next+SLOTB;}while(0)
  DMA_K(2,2*SLOTB);
  WAIT_BAR(3);
  qkt(pA0,pA1,Kbase,qr,negm,r32,hi);asm volatile("s_nop 15\n\ts_nop 7":"+v"(pA0),"+v"(pA1));CMASK(pA0,pA1,0);
  START(pA0,pA1);
  _Pragma("unroll") for(int r=0;r<16;++r)pA1[r]=__builtin_amdgcn_exp2f(pA1[r]);
  WAIT_BAR(0);
  DMA_K(3,0);DMA_V(1,SLOTB);
  ROT();
  kload8(kf,kp0+sl_cur);
  WAIT_BAR(2);
  s16x4 vlo[8],vhi[8]; u32x4 pw0,pw1,pw2,pw3;
  #define PKW(P,B) cvtpk_s(P[B],P[B+1])
  #define PAF(k) __builtin_bit_cast(bf16x8,pw##k)
  #define VFR(i) (bf16x8){vlo[i][0],vlo[i][1],vlo[i][2],vlo[i][3],vhi[i][0],vhi[i][1],vhi[i][2],vhi[i][3]}
  #define PIN(x) asm volatile("":"+v"(x))
  #define MX3(a,b,c) __builtin_fmaxf(__builtin_fmaxf((a),(b)),(c))
  #define GAPA(MF,A0,A1,A2,A3,W0,W1,PW) do{ MF; sacc+=A0; sacc+=A1; sacc+=A2; sacc+=A3; PIN(sacc); W0; W1; PIN(PW); SBAR(); }while(0)
  #define EX(v) __builtin_amdgcn_exp2f(v)
  #define GAPB(MF,X,B) do{ MF; X[B]=EX(X[B]); X[B+1]=EX(X[B+1]); X[B+2]=EX(X[B+2]); X[B+3]=EX(X[B+3]); PIN(X); SBAR(); }while(0)
  #define VRD(i) do{ vlo[i]=vtr(vp_+(((i)>>2)*4096+((i)&3)*1024)); vhi[i]=vtr(vp_+(((i)>>2)*4096+((i)&3)*1024+512)); }while(0)
  #define KRD(G,j) do{ if(G){ kload2(kf,kp0+sl_next,j); SBAR(); } }while(0)
  #define STEP(C0,C1,P0,P1,t,GK,GV,GL) do{ SBAR(); \
    const lds_cptr vp_=vp0+sl_prev; \
    VRD(0); SBAR(); float sacc=(P0[0]+P0[1]); \
    GAPA(C0=__builtin_amdgcn_mfma_f32_32x32x16_bf16(kf[0],qr[0],negm,0,0,0), P0[2],P0[3],P0[4],P0[5],     pw0[0]=PKW(P0,0), pw0[1]=PKW(P0,2), pw0); \
    VRD(4); SBAR(); GAPA(C1=__builtin_amdgcn_mfma_f32_32x32x16_bf16(kf[1],qr[0],negm,0,0,0), P0[6],P0[7],P0[8],P0[9],     pw0[2]=PKW(P0,4), pw0[3]=PKW(P0,6), pw0); \
    VRD(1); SBAR(); GAPA(C0=__builtin_amdgcn_mfma_f32_32x32x16_bf16(kf[2],qr[1],C0,0,0,0),   P0[10],P0[11],P0[12],P0[13], pw1[0]=PKW(P0,8), pw1[1]=PKW(P0,10), pw1); \
    VRD(5); SBAR(); GAPA(C1=__builtin_amdgcn_mfma_f32_32x32x16_bf16(kf[3],qr[1],C1,0,0,0),   P0[14],P0[15],P1[0],P1[1],   pw1[2]=PKW(P0,12),pw1[3]=PKW(P0,14), pw1); \
    VRD(2); SBAR(); GAPA(C0=__builtin_amdgcn_mfma_f32_32x32x16_bf16(kf[4],qr[2],C0,0,0,0),   P1[2],P1[3],P1[4],P1[5],     pw2[0]=PKW(P1,0), pw2[1]=PKW(P1,2), pw2); \
    VRD(6); SBAR(); GAPA(C1=__builtin_amdgcn_mfma_f32_32x32x16_bf16(kf[5],qr[2],C1,0,0,0),   P1[6],P1[7],P1[8],P1[9],     pw2[2]=PKW(P1,4), pw2[3]=PKW(P1,6), pw2); \
    VRD(3); SBAR(); GAPA(C0=__builtin_amdgcn_mfma_f32_32x32x16_bf16(kf[6],qr[3],C0,0,0,0),   P1[10],P1[11],P1[12],P1[13], pw3[0]=PKW(P1,8), pw3[1]=PKW(P1,10), pw3); \
    VRD(7); SBAR(); GAPA(C1=__builtin_amdgcn_mfma_f32_32x32x16_bf16(kf[7],qr[3],C1,0,0,0),   P1[14],P1[15],0.f,0.f,       pw3[2]=PKW(P1,12),pw3[3]=PKW(P1,14), pw3); \
    l_reg+=sacc; \
    if(GK){DMA_K((t)+3,sl_cur);} if(GV){DMA_V((t)+1,sl_next);} \
    CMASK(C0,C1,t); \
    { float a=MX3(C0[0],C0[1],C1[0]),b=MX3(C0[2],C0[3],C1[1]); a=MX3(a,C1[2],C1[3]); \
      _Pragma("unroll") for(int r=4;r<16;r+=4){a=MX3(a,C0[r],C0[r+1]);b=MX3(b,C0[r+2],C0[r+3]);a=MX3(a,C1[r],C1[r+1]);b=MX3(b,C1[r+2],C1[r+3]);} \
      float rm=__builtin_fmaxf(a,b); { auto rr=__builtin_amdgcn_permlane32_swap(__float_as_uint(rm),__float_as_uint(rm),false,false); rm=__builtin_fmaxf(__uint_as_float(rr[0]),__uint_as_float(rr[1])); } \
      resc=false; \
      if(__builtin_expect(__any(rm>(float)THRL),0)){ const float dl=__builtin_fmaxf(rm,0.f); mhat+=dl; \
        _Pragma("unroll") for(int r=0;r<16;++r){C0[r]-=dl;C1[r]-=dl;} \
        _Pragma("unroll") for(int r=0;r<16;++r)negm[r]=-mhat; asm volatile("":"+v"(negm)); \
        const float f=__builtin_amdgcn_exp2f(-dl); l_reg*=f; if(hi==0)wsf[r32]=f; resc=true; } } \
    SBAR(); \
    GAPB(o[0]=__builtin_amdgcn_mfma_f32_32x32x16_bf16(PAF(0),VFR(0),o[0],0,0,0), C0,0); \
    GAPB(o[1]=__builtin_amdgcn_mfma_f32_32x32x16_bf16(PAF(0),VFR(4),o[1],0,0,0), C0,4); \
    KRD(GL,0); GAPB(o[0]=__builtin_amdgcn_mfma_f32_32x32x16_bf16(PAF(1),VFR(1),o[0],0,0,0), C0,8); \
    KRD(GL,1); GAPB(o[1]=__builtin_amdgcn_mfma_f32_32x32x16_bf16(PAF(1),VFR(5),o[1],0,0,0), C0,12); \
    KRD(GL,2); GAPB(o[0]=__builtin_amdgcn_mfma_f32_32x32x16_bf16(PAF(2),VFR(2),o[0],0,0,0), C1,0); \
    KRD(GL,3); GAPB(o[1]=__builtin_amdgcn_mfma_f32_32x32x16_bf16(PAF(2),VFR(6),o[1],0,0,0), C1,4); \
    GAPB(o[0]=__builtin_amdgcn_mfma_f32_32x32x16_bf16(PAF(3),VFR(3),o[0],0,0,0), C1,8); \
    GAPB(o[1]=__builtin_amdgcn_mfma_f32_32x32x16_bf16(PAF(3),VFR(7),o[1],0,0,0), C1,12); \
    }while(0)
  int t=1;
  #undef CMASK
  #define CMASK(P0,P1,t) do{}while(0)
  for(;t+5<NT;t+=2){
    STEP(pB0,pB1,pA0,pA1,t,true,true,true);     WAIT_BAR(2); RESC(); ROT();
    STEP(pA0,pA1,pB0,pB1,t+1,true,true,true);   WAIT_BAR(2); RESC(); ROT();
  }
  #undef CMASK
  #define CMASK(P0,P1,t) do{}while(0)
  #define ENDW(tt) do{ if((tt)+3<NT){WAIT_BAR(2);} else if((tt)+2<NT){WAIT_BAR(1);} else {WAIT_BAR(0);} }while(0)
  for(;t+1<NT;t+=2){
    STEP(pB0,pB1,pA0,pA1,t,(t+3<NT),(t+1<NT),(t+1<NT));       ENDW(t);   RESC(); ROT();
    STEP(pA0,pA1,pB0,pB1,t+1,(t+4<NT),(t+2<NT),(t+2<NT));     ENDW(t+1); RESC(); ROT();
  }
  STEP(pB0,pB1,pA0,pA1,NT-1,false,false,false); RESC();
  { float sacc=pB0[0]+pB0[1]; _Pragma("unroll") for(int r=2;r<16;++r)sacc+=pB0[r]; _Pragma("unroll") for(int r=0;r<16;++r)sacc+=pB1[r]; l_reg+=sacc;
    pw0=(u32x4){PKW(pB0,0),PKW(pB0,2),PKW(pB0,4),PKW(pB0,6)};pw1=(u32x4){PKW(pB0,8),PKW(pB0,10),PKW(pB0,12),PKW(pB0,14)};pw2=(u32x4){PKW(pB1,0),PKW(pB1,2),PKW(pB1,4),PKW(pB1,6)};pw3=(u32x4){PKW(pB1,8),PKW(pB1,10),PKW(pB1,12),PKW(pB1,14)};
    SBAR(); pv(o,vb0+sl_cur,PAF(0),PAF(1),PAF(2),PAF(3)); }
  #undef PKW
  #undef PAF
  #undef VFR
  #undef PIN
  #undef MX3
  #undef GAPA
  #undef GAPB
  #undef EX
  #undef VRD
  #undef KRD
  #undef STEP
  #undef ENDW
  {auto rr=__builtin_amdgcn_permlane32_swap(__float_as_uint(l_reg),__float_as_uint(l_reg),false,false);l_reg=__uint_as_float(rr[0])+__uint_as_float(rr[1]);}
  if(hi==0)wsf[32+r32]=l_reg;asm volatile("s_waitcnt lgkmcnt(0)":::"memory");
  float rli[16];
  #pragma unroll
  for(int r=0;r<16;++r)rli[r]=__builtin_amdgcn_rcpf(wsf[32+crow(r,hi)]);
  bf16*Ow=O0+(long)(wid*QBLK)*OP;
  { bf16*stg=(bf16*)(shm+LDS_OST)+wid*2048;
    #pragma unroll
    for(int r=0;r<16;++r){const int orow=crow(r,hi);
      #pragma unroll
      for(int d0=0;d0<2;++d0)stg[orow*64+d0*32+r32]=__float2bfloat16(o[d0][r]*rli[r]);}
    asm volatile("s_waitcnt lgkmcnt(0)":::"memory");
    #pragma unroll
    for(int i=0;i<4;++i){const int row=i*8+(lane>>3),ch=lane&7; const u32x4 v=*(const u32x4*)(stg+row*64+ch*8); ATTN_STORE16(Ow+(long)row*OP+ch*8,v);} }
  asm volatile("s_waitcnt lgkmcnt(0)\n\ts_barrier":::"memory");
  #undef DMA_K
  #undef DMA_V
  #undef CMASK
  #undef START
  #undef RESC
  #undef ROT
}
constexpr int ATTN_LDS_BYTES=LDS_BYTES;
#undef SBAR
#undef WAIT_BAR
}

struct Params {
    const float* in[35];
    float* out;
    unsigned char* ws;
    int ph_lo, ph_hi;
};
enum { I_X = 0, I_C, I_CTX, I_CCTX, I_WMOD, I_BMOD, I_GMIX, I_GFFN, I_MIXWIN, I_MIXWOUT, I_QG, I_KG, I_LNG, I_WSP, I_BSP,
       I_S5WIN, I_ARE, I_AIM, I_LOGDT, I_BRE, I_BIM, I_CRE, I_CIM, I_S5D, I_WGLU, I_BGLU, I_S5WOUT,
       I_WGRP, I_BGRP, I_WRT, I_BRT, I_W1, I_W3, I_W2, I_FING };

struct Ctx {
    const Params* p;
    unsigned char* ws;
    LAS unsigned char* lds;
    int tid, lane, wave, gw, ngw;
};
__device__ __forceinline__ const float* xin_row(const Params& P, int r) { return r < TL ? P.in[I_X] + (size_t)r * D : P.in[I_CTX] + (size_t)(r - TL) * D; }
__device__ __forceinline__ int cond_of(int r) { return r < TL ? (r >> 11) : 16; }
__device__ __forceinline__ const float* mod_vec(const Ctx& C, int layer, int ci, int k) { return (const float*)(C.ws + WS_MOD) + ((size_t)(layer * 17 + ci) * 6 + k) * D; }

__device__ __forceinline__ void dsincos(double a, double& s, double& c) {
    const double TWO_PI_HI = 6.283185307179586, TWO_PI_LO = 2.4492935982947064e-16;
    const double k = rint(a * 0.15915494309189535);
    double r = fma(-k, TWO_PI_HI, a); r = fma(-k, TWO_PI_LO, r);
    const double r2 = r * r; double ct = 1.0, st = r, cs = 1.0, ss = r;
#pragma unroll 1
    for (int i = 1; i <= 15; ++i) { ct *= -r2 / (double)((2 * i - 1) * (2 * i)); cs += ct; st *= -r2 / (double)((2 * i) * (2 * i + 1)); ss += st; }
    s = ss; c = cs;
}

struct TItem { const float* src; int N, k0, n0; bf16* dst; int dp; float f8s; };
__device__ __forceinline__ void t_load(const TItem& t, int lane, float (&r)[32]) {
#pragma unroll
    for (int i = 0; i < 32; ++i) r[i] = __builtin_nontemporal_load(t.src + (size_t)(t.k0 + 2 * i + (lane >> 5)) * t.N + t.n0 + (lane & 31));
}
__device__ __forceinline__ void t_store(const TItem& t, int lane, const float (&r)[32], LAS float* scr) {
#pragma unroll
    for (int i = 0; i < 32; ++i) scr[(2 * i + (lane >> 5)) * 33 + (lane & 31)] = r[i];
    asm volatile("s_waitcnt lgkmcnt(0)" ::: "memory");
    const int c = lane & 7;
    if (t.f8s != 0.f) {
#pragma unroll
        for (int j = 0; j < 4; ++j) { const int n = (lane >> 3) + 8 * j; const LAS float* s = scr + (8 * c) * 33 + n; const float q = t.f8s;
            *(pg8::u32x2*)((unsigned char*)t.dst + (size_t)n * t.dp + 8 * c) = pg8::pack8_fp8((f32x4){s[0 * 33] * q, s[1 * 33] * q, s[2 * 33] * q, s[3 * 33] * q}, (f32x4){s[4 * 33] * q, s[5 * 33] * q, s[6 * 33] * q, s[7 * 33] * q}); }
    } else {
#pragma unroll
        for (int j = 0; j < 4; ++j) { const int n = (lane >> 3) + 8 * j; const LAS float* s = scr + (8 * c) * 33 + n;
            v4u o; o.x = pk2(s[0 * 33], s[1 * 33]); o.y = pk2(s[2 * 33], s[3 * 33]); o.z = pk2(s[4 * 33], s[5 * 33]); o.w = pk2(s[6 * 33], s[7 * 33]);
            *(v4u*)(t.dst + (size_t)n * t.dp + 8 * c) = o; }
    }
    asm volatile("s_waitcnt lgkmcnt(0)" ::: "memory");
}
__device__ __forceinline__ TItem mat_item(const float* W, int K, int N, bf16* WT, int it) {
    const int nblk = N / 32, kb = it / nblk, nb = it % nblk;
    return TItem{W, N, kb * 64, nb * 32, WT + (size_t)(nb * 32) * K + kb * 64, K, 0.f};
}
__device__ __forceinline__ TItem mat_item_f8(const float* W, int K, int N, unsigned char* WT, int it, float f8s) {
    const int nblk = N / 32, kb = it / nblk, nb = it % nblk;
    return TItem{W, N, kb * 64, nb * 32, (bf16*)(WT + (size_t)(nb * 32) * K + kb * 64), K, f8s};
}
constexpr int MOE_ITEMS = NEXP * 768;
__device__ __forceinline__ TItem moe_item(const Ctx& C, int layer, int it) {
    const Params& P = *C.p;
    const int e = it / 768, r = it % 768, kind = r / 256, j = r % 256;
    if (kind < 2) {
        const float* src = (kind == 0 ? P.in[I_W1] : P.in[I_W3]) + ((size_t)layer * NEXP + e) * D * EH;
        const int kb = j / 16, nb = j % 16, k0 = kb * 64, n0 = nb * 32;
        const int drow = (n0 / 128) * 256 + (n0 % 128) + (kind == 1 ? 128 : 0);
        return TItem{src, EH, k0, n0, (bf16*)((unsigned char*)(C.ws + (layer ? WS_W13B : WS_W13)) + (size_t)e * 1024 * 1024 + (size_t)drow * 1024 + k0), 1024, W13_SCALE};
    }
    const float* src = P.in[I_W2] + ((size_t)layer * NEXP + e) * EH * D;
    const int kb = j / 32, nb = j % 32, k0 = kb * 64, n0 = nb * 32;
    return TItem{src, D, k0, n0, (bf16*)((unsigned char*)(C.ws + (layer ? WS_W2B : WS_W2)) + (size_t)e * 1024 * 512 + (size_t)n0 * 512 + k0), 512, W13_SCALE};
}
constexpr int TI0 = 16 * 56, TI1 = 16 * 32, TI2 = 16 * 16, TI3 = 8 * 16, TI4 = 8 * 32, NSMALL = TI0 + TI1 + TI2 + TI3 + TI4;
__device__ __forceinline__ TItem conv_item(const Ctx& C, int layer, int nsmall, int it) {
    const Params& P = *C.p; int r = it;
    if (r < nsmall) {
        if (r < TI0) return mat_item_f8(P.in[I_MIXWIN], D, MIXW, (unsigned char*)(C.ws + WS_WIN0), r, W13_SCALE); r -= TI0;
        if (r < TI1) return mat_item(P.in[I_MIXWOUT], D, D, (bf16*)(C.ws + WS_WOUT0), r); r -= TI1;
        if (r < TI2) return mat_item(P.in[I_S5WIN], D, 512, (bf16*)(C.ws + WS_WS5IN), r); r -= TI2;
        if (r < TI3) return mat_item(P.in[I_WGLU], 512, 512, (bf16*)(C.ws + WS_WGLU), r); r -= TI3;
        return mat_item(P.in[I_S5WOUT], 512, D, (bf16*)(C.ws + WS_WS5OUT), r);
    }
    return moe_item(C, layer, r - nsmall);
}
template <class ItemFn>
__device__ __forceinline__ void convert_seq(const Ctx& C, int first, int n, int hi, const ItemFn& item) {
    LAS float* scr = (LAS float*)(C.lds + C.wave * 16384);
    float ra[32], rb[32], rc[32], rd[32];
    int it = first;
    if (it >= hi) return;
    TItem ta = item(it), tb = item(it + n < hi ? it + n : it), tc = ta, td = ta;
    t_load(ta, C.lane, ra); if (it + n < hi) t_load(tb, C.lane, rb);
    for (;;) {
        const int it2 = it + 2 * n;
        if (it2 < hi) { tc = item(it2); t_load(tc, C.lane, rc); if (it2 + n < hi) { td = item(it2 + n); t_load(td, C.lane, rd); } }
        t_store(ta, C.lane, ra, scr); if (it + n < hi) t_store(tb, C.lane, rb, scr);
        if (it2 >= hi) break;
        const int it3 = it2 + 2 * n;
        if (it3 < hi) { ta = item(it3); t_load(ta, C.lane, ra); if (it3 + n < hi) { tb = item(it3 + n); t_load(tb, C.lane, rb); } }
        t_store(tc, C.lane, rc, scr); if (it2 + n < hi) t_store(td, C.lane, rd, scr);
        if (it3 >= hi) break;
        it = it3;
    }
}
__device__ __forceinline__ void convert_items(const Ctx& C, int layer, int nsmall) {
    const int total = nsmall + (gridDim.x == 256 ? L0_A : MOE_ITEMS);
    convert_seq(C, C.gw, C.ngw, total, [&](int it) { return conv_item(C, layer, nsmall, it); });
}

__device__ __forceinline__ void convert_range(const Ctx& C, int layer, int lo, int hi, int b0) {
    if ((int)blockIdx.x < b0) return;
    convert_seq(C, lo + ((int)blockIdx.x - b0) * NWAVE + C.wave, ((int)gridDim.x - b0) * NWAVE, hi, [&](int it) { return moe_item(C, layer, it); });
}

__device__ __forceinline__ void phase_prologue(const Ctx& C) {
    const Params& P = *C.p;
    {
        LAS float* s = (LAS float*)C.lds;
        LAS float* red = (LAS float*)(C.lds + 17 * 1024 * 4);
        bool have_s = false;
        for (int u = blockIdx.x; u < 192; u += gridDim.x) {
            if (!have_s) {
                for (int i = C.tid; i < 17 * 1024; i += NTHR) { const int ci = i >> 10, k = i & 1023; const float v = ci < 16 ? P.in[I_C][ci * D + k] : P.in[I_CCTX][k]; s[i] = silu_(v); }
                have_s = true; __syncthreads();
            }
            const int layer = u / 96, jg = u % 96, kq = C.tid >> 6, jc = C.tid & 63;
            const float* w = P.in[I_WMOD] + (size_t)layer * D * 6144 + jg * 64 + jc;
            float acc[17];
#pragma unroll
            for (int i = 0; i < 17; ++i) acc[i] = 0.f;
            for (int k0 = kq * 128; k0 < kq * 128 + 128; k0 += 16) {
                float wv[16];
#pragma unroll
                for (int j = 0; j < 16; ++j) wv[j] = w[(size_t)(k0 + j) * 6144];
#pragma unroll
                for (int j = 0; j < 16; ++j)
#pragma unroll
                    for (int i = 0; i < 17; ++i) acc[i] += s[i * 1024 + k0 + j] * wv[j]; }
#pragma unroll
            for (int i = 0; i < 17; ++i) red[(kq * 17 + i) * 64 + jc] = acc[i];
            __syncthreads();
            for (int o = C.tid; o < 17 * 64; o += NTHR) { const int ci = o >> 6, c = o & 63; float v = 0.f;
#pragma unroll
                for (int q = 0; q < 8; ++q) v += red[(q * 17 + ci) * 64 + c];
                const int j = jg * 64 + c; v += P.in[I_BMOD][layer * 6144 + j];
                ((float*)(C.ws + WS_MOD))[((size_t)(layer * 17 + ci)) * 6144 + j] = v; }
            __syncthreads();
        }
        __syncthreads();
    }
    {
        const int gt = blockIdx.x * NTHR + C.tid, ngt = gridDim.x * NTHR;
        float2* rope = (float2*)(C.ws + WS_TAB + TAB_ROPE);
        for (int i = gt; i < 64 * 16; i += ngt) { const int pos = i >> 4, f = i & 15;
            const double th = exp(-(double)f * (9.210340371976184 / 16.0)); double s, c; dsincos((double)pos * th, s, c); rope[i] = make_float2((float)c, (float)s); }
        float2* lamb = (float2*)(C.ws + WS_TAB + TAB_LAMB); float2* bbar = (float2*)(C.ws + WS_TAB + TAB_BBAR);
        for (int i = gt; i < 2 * 32 * 64; i += ngt) {
            const int dg = i >> 6;
            const double are = P.in[I_ARE][i], aim = P.in[I_AIM][i], dt = exp((double)P.in[I_LOGDT][dg]);
            double s, c; dsincos(aim * dt, s, c); const double mag = exp(are * dt), lr = mag * c, li = mag * s;
            lamb[i] = make_float2((float)lr, (float)li);
            const double den = are * are + aim * aim, nr = lr - 1.0, ni = li;
            const double cr = (nr * are + ni * aim) / den, cim = (ni * are - nr * aim) / den;
            for (int p = 0; p < 16; ++p) { const double br = P.in[I_BRE][(size_t)i * 16 + p], bi = P.in[I_BIM][(size_t)i * 16 + p];
                bbar[(size_t)i * 16 + p] = make_float2((float)(cr * br - cim * bi), (float)(cr * bi + cim * br)); }
        }
    }
    {
        const int gt = blockIdx.x * NTHR + C.tid, ngt = gridDim.x * NTHR;
        bf16* wrt = (bf16*)(C.ws + WS_TAB + TAB_WR);
        for (int idx = gt; idx < 2 * 32 * 3 * 64; idx += ngt) {
            const int ln = idx & 63, jb = (idx >> 6) % 3, kk = (idx / 192) & 31, l = idx / (192 * 32);
            const int i = ln & 15, q = ln >> 4, grp = i >> 2, r = i & 3;
            float hi8[8], lo8[8];
#pragma unroll
            for (int e = 0; e < 8; ++e) { const int k = 32 * kk + 8 * q + e;
                const float w = jb < 2 ? P.in[I_WRT][((size_t)l * D + k) * 32 + grp * 8 + jb * 4 + r] : (r == 0 ? P.in[I_WGRP][((size_t)l * D + k) * 4 + grp] : 0.f);
                const float h = bf2f(f2bf(w)); hi8[e] = h; lo8[e] = w - h; }
            v4u oh, ol; oh.x = pk2(hi8[0], hi8[1]); oh.y = pk2(hi8[2], hi8[3]); oh.z = pk2(hi8[4], hi8[5]); oh.w = pk2(hi8[6], hi8[7]);
            ol.x = pk2(lo8[0], lo8[1]); ol.y = pk2(lo8[2], lo8[3]); ol.z = pk2(lo8[4], lo8[5]); ol.w = pk2(lo8[6], lo8[7]);
            const size_t base = ((((size_t)l * 32 + kk) * 3 + jb) * 2) * 64 + ln;
            *(v4u*)(wrt + base * 8) = oh; *(v4u*)(wrt + (base + 64) * 8) = ol;
        }
    }
    {
        const int gt = blockIdx.x * NTHR + C.tid, ngt = gridDim.x * NTHR; bf16* w16 = (bf16*)(C.ws + WS_WSP);
        for (int i = gt; i < 8 * 128 * 128 / 4; i += ngt) { const f32x4 v = *(const f32x4*)(P.in[I_WSP] + 4 * (size_t)i); v2u o; o.x = pk2(v.x, v.y); o.y = pk2(v.z, v.w); *(v2u*)(w16 + 4 * (size_t)i) = o; }
    }
    convert_items(C, 0, NSMALL);
}

__device__ __forceinline__ void load_row16(const float* row, int lane, f32x4 (&v)[4]) {
#pragma unroll
    for (int j = 0; j < 4; ++j) v[j] = *(const f32x4*)(row + 4 * lane + 256 * j);
}
__device__ __forceinline__ float row_rstd(const f32x4 (&v)[4]) {
    float s = 0.f;
#pragma unroll
    for (int j = 0; j < 4; ++j) s += (v[j].x * v[j].x + v[j].y * v[j].y) + (v[j].z * v[j].z + v[j].w * v[j].w);
    return rsqrtf(wave_sum(s) * (1.f / D) + EPS);
}
__device__ __forceinline__ void modulate16(f32x4 (&v)[4], float rstd, const float* g, const float* scale, const float* shift, int lane) {
#pragma unroll
    for (int j = 0; j < 4; ++j) { const int c = 4 * lane + 256 * j; const f32x4 gg = *(const f32x4*)(g + c), sc = *(const f32x4*)(scale + c), sh = *(const f32x4*)(shift + c);
        v[j] = v[j] * rstd * gg * (sc + 1.f) + sh; }
}
__device__ __forceinline__ void store_row16_bf16(bf16* row, int lane, const f32x4 (&v)[4]) {
#pragma unroll
    for (int j = 0; j < 4; ++j) { v2u o; o.x = pk2(v[j].x, v[j].y); o.y = pk2(v[j].z, v[j].w); *(v2u*)(row + 4 * lane + 256 * j) = o; }
}

__device__ __forceinline__ void store_row16_fp8(unsigned char* row, int lane, const f32x4 (&v)[4]) {
#pragma unroll
    for (int j = 0; j < 4; ++j) { int w = 0; w = __builtin_amdgcn_cvt_pk_fp8_f32(v[j].x, v[j].y, w, false); w = __builtin_amdgcn_cvt_pk_fp8_f32(v[j].z, v[j].w, w, true); *(int*)(row + 4 * lane + 256 * j) = w; }
}

__device__ __forceinline__ void phase_norm_mix0(const Ctx& C) {
    const Params& P = *C.p; unsigned char* H = (unsigned char*)(C.ws + WS_H);
    f32x4 a[4], b[4]; const int n = C.ngw; int r = C.gw;
    if (r < TT) load_row16(xin_row(P, r), C.lane, a);
    if (r + n < TT) load_row16(xin_row(P, r + n), C.lane, b);
#define NM0_ROW(buf, rr, rnext) do { f32x4 v[4] = {buf[0], buf[1], buf[2], buf[3]}; if ((rnext) < TT) load_row16(xin_row(P, (rnext)), C.lane, buf); \
        const float rstd = row_rstd(v); const int ci = cond_of(rr); modulate16(v, rstd, P.in[I_GMIX], mod_vec(C, 0, ci, 1), mod_vec(C, 0, ci, 0), C.lane); store_row16_fp8(H + (size_t)(rr) * D, C.lane, v); } while (0)
    for (; r < TT; r += 2 * n) { NM0_ROW(a, r, r + 2 * n); if (r + n < TT) NM0_ROW(b, r + n, r + 3 * n); }
#undef NM0_ROW
}

__device__ __forceinline__ unsigned gm_off_b(unsigned row, unsigned ch) { return 256u * row + 16u * (ch ^ (((row & 3u) << 2) | ((row >> 2) & 3u))); }
__device__ __forceinline__ void phase_gmlp_fast(const Ctx& C) {
    typedef short bf16x8 __attribute__((ext_vector_type(8)));
    typedef short s16x4 __attribute__((ext_vector_type(4)));
    typedef float f32x16 __attribute__((ext_vector_type(16)));
    const Params& P = *C.p; const bf16* Pb = (const bf16*)(C.ws + WS_P); bf16* OG = (bf16*)(C.ws + WS_H); const bf16* W16 = (const bf16*)(C.ws + WS_WSP);
    const float* lnp = (const float*)(C.ws + WS_Q);
    const int tid = C.tid, lane = C.lane, w = C.wave, l31 = lane & 31, hi = lane >> 5;
    const int gsel = w >> 2, pb = w & 3;
    const int nU = (TT / 128) * 4, arow = tid >> 2;
    v4u ra[4]; float2 st = make_float2(0.f, 0.f);
#define GM_ALOAD(uu_) do { const size_t gr_ = (size_t)((uu_) >> 2) * 128 + arow; { const f32x4 pq = *(const f32x4*)(lnp + gr_ * 16 + 4 * (tid & 3)); st = make_float2(pq.x + pq.z, pq.y + pq.w); } \
        _Pragma("unroll") for (int i = 0; i < 4; ++i) ra[i] = *(const v4u*)(Pb + gr_ * MIXW + 1280 + 128 * ((uu_) & 3) + 8 * ((tid & 3) + 4 * i)); } while (0)
    if ((int)blockIdx.x < nU) GM_ALOAD((int)blockIdx.x);
    for (int u = blockIdx.x; u < nU; u += gridDim.x) {
        const int ch_ = u >> 2, gp = u & 3, g = 2 * gp + gsel;
        bf16x8 xf[8]; const bf16* wrow = W16 + ((size_t)g * 128 + 32 * pb + l31) * 128 + 8 * hi;
#pragma unroll
        for (int k8 = 0; k8 < 8; ++k8) xf[k8] = *(const bf16x8*)(wrow + 16 * k8);
        { float s1 = st.x, s2 = st.y; s1 += __shfl_xor(s1, 1); s1 += __shfl_xor(s1, 2); s2 += __shfl_xor(s2, 1); s2 += __shfl_xor(s2, 2);
          const float mean_ = s1 * (1.f / 512.f); const float2 sc = make_float2(mean_, rsqrtf(fmaxf(s2 * (1.f / 512.f) - mean_ * mean_, 0.f) + EPS));
#pragma unroll
          for (int i = 0; i < 4; ++i) { const int c16 = (tid & 3) + 4 * i; float v[8]; unpack8(ra[i], v);
              const float* lg = P.in[I_LNG] + 128 * gp + 8 * c16;
#pragma unroll
              for (int j = 0; j < 8; ++j) v[j] = (v[j] - sc.x) * sc.y * lg[j];
              v4u o; o.x = pk2(v[0], v[1]); o.y = pk2(v[2], v[3]); o.z = pk2(v[4], v[5]); o.w = pk2(v[6], v[7]);
              *(LAS v4u*)(C.lds + (arow >> 5) * 8192 + gm_off_b(arow & 31, c16)) = o; } }
        if (u + (int)gridDim.x < nU) GM_ALOAD(u + (int)gridDim.x);
        __syncthreads();
        f32x16 acc[2]; acc[0] = f32x16{}; acc[1] = f32x16{};
#pragma unroll
        for (int k8 = 0; k8 < 8; ++k8) {
            const unsigned rb = k8 >> 1, ks = k8 & 1;
#pragma unroll
            for (int db = 0; db < 2; ++db) { const unsigned c = 2 * gsel + db, blk = (lane >> 4) & 1, q = (lane & 15) >> 2, p2 = lane & 3;
                s16x4 t0, t1;
                { const unsigned a0 = rb * 8192 + gm_off_b(16 * ks + 8 * hi + q, 4 * c + 2 * blk + (p2 >> 1)) + 8 * (p2 & 1);
                  const unsigned a1 = rb * 8192 + gm_off_b(16 * ks + 8 * hi + 4 + q, 4 * c + 2 * blk + (p2 >> 1)) + 8 * (p2 & 1);
                  t0 = __builtin_bit_cast(s16x4, __builtin_amdgcn_ds_read_tr16_b64_v4i16((LAS s16x4*)(C.lds + a0)));
                  t1 = __builtin_bit_cast(s16x4, __builtin_amdgcn_ds_read_tr16_b64_v4i16((LAS s16x4*)(C.lds + a1))); }
                const bf16x8 yf = {t0[0], t0[1], t0[2], t0[3], t1[0], t1[1], t1[2], t1[3]};
                acc[db] = __builtin_amdgcn_mfma_f32_32x32x16_bf16(xf[k8], yf, acc[db], 0, 0, 0); }
        }
        const float* bsp = P.in[I_BSP] + g * 128 + 32 * pb;
#pragma unroll
        for (int r = 0; r < 16; ++r) { const int pl = (r & 3) + 8 * (r >> 2) + 4 * hi; const size_t grow = (size_t)ch_ * 128 + 32 * pb + pl; const float bb = bsp[pl];
#pragma unroll
            for (int db = 0; db < 2; ++db) { const int col = 64 * g + 32 * db + l31; const float uu = bf2f(Pb[grow * MIXW + 768 + col]);
                OG[grow * D + 512 + col] = (bf16)f2bf(uu * (acc[db][r] + bb)); } }
        __syncthreads();
    }
#undef GM_ALOAD
}

__device__ __forceinline__ void phase_attn_fast(const Ctx& C, char* lds_generic) {
    typedef attn_body::bf16 abf;
    const abf* Q = (const abf*)(C.ws + WS_P); const abf* Kb = (const abf*)(C.ws + WS_K); const abf* Vb = (const abf*)(C.ws + WS_V); abf* OG = (abf*)(C.ws + WS_H);
    const int G = gridDim.x, bx = blockIdx.x; const int vcu = (G % 8 == 0) ? (bx % 8) * (G / 8) + bx / 8 : bx;
    const int per = (1024 + G - 1) / G, perc = (128 + G - 1) / G;
    for (int i = 0; i < per + perc; ++i) {
        int b, h, nt, tq0; size_t qrow;
        if (i < per) { const int u = vcu * per + i; if (u >= 1024) continue; const int qb = u & 7, hg = (u >> 3) & 3, bk = u >> 5; b = bk >> 1; h = (bk & 1) * 4 + hg; qrow = (size_t)b * SEQ + qb * 256; nt = KVL / 64; tq0 = qb * 256; }
        else { const int u = vcu + (i - per) * G; if (u >= 128) continue; b = u >> 3; h = u & 7; qrow = (size_t)TL + (size_t)b * CTXL; nt = CTXL / 64; tq0 = -1; }
        const size_t kvo = (size_t)b * KVL * 128 + (h >> 2) * 64;
        attn_body::attn_unit<8>(Q + qrow * MIXW + h * 64, Kb + kvo, Vb + kvo, OG + qrow * 1024 + h * 64, nt, lds_generic, C.p->in[I_QG], (const float2*)(C.ws + WS_TAB + TAB_ROPE), tq0);
    }
}

__device__ __forceinline__ void phase_router_fast(const Ctx& C, int layer, int nrows) {
    typedef short bf16x8 __attribute__((ext_vector_type(8)));
    const Params& P = *C.p; const bf16* XC = (const bf16*)(C.ws + WS_XC); bf16* F = (bf16*)(C.ws + WS_H);
    int* asg_e = (int*)(C.ws + WS_ROUTE + RT_E); int* asg_p = (int*)(C.ws + WS_ROUTE + RT_P); float* asg_w = (float*)(C.ws + WS_ROUTE + RT_W); int* list = (int*)(C.ws + WS_LIST);
    unsigned* cnt = (unsigned*)(C.ws + WS_CTL) + CW_CNT + 64 * layer;
    const int l15 = C.lane & 15, q4 = C.lane >> 4;
    LAS float* ab = (LAS float*)(C.lds + C.wave * 8192);
    LAS unsigned* lcnt = (LAS unsigned*)(C.lds + 65536);
    if (C.tid < 64) lcnt[C.tid] = 0u;
    __syncthreads();
    int cur_ci = -1;
    const int nitems = nrows / 16;
    for (int rd = 0; (int)blockIdx.x * NWAVE + rd * C.ngw < nitems; ++rd) {
        const int it_raw = C.gw + rd * C.ngw; const bool valid = it_raw < nitems; const int it = valid ? it_raw : nitems - 1;
        const int row = it * 16 + l15, ci = cond_of(it * 16);
        if (ci != cur_ci) {
            const float* sc = mod_vec(C, layer, ci, 4); const float* sh = mod_vec(C, layer, ci, 3); const float* g0 = P.in[I_GFFN] + layer * D;
#pragma unroll
            for (int j = 0; j < 4; ++j) { const int c = 4 * C.lane + 256 * j; const f32x4 g4 = *(const f32x4*)(g0 + c), s4 = *(const f32x4*)(sc + c), h4 = *(const f32x4*)(sh + c); const f32x4 a4 = g4 * (s4 + 1.f);
                *(LAS f32x4*)(ab + c) = a4; *(LAS f32x4*)(ab + 1024 + c) = h4; }
            asm volatile("s_waitcnt lgkmcnt(0)" ::: "memory"); cur_ci = ci;
        }
        const bf16* xr = XC + (size_t)row * D + 8 * q4;
        float ss = 0.f;
#pragma unroll 16
        for (int kk = 0; kk < 32; ++kk) { pg8::f32x4 a, b; pg8::unpack8f(*(const pg8::u32x4*)(xr + 32 * kk), a, b); ss += (a.x * a.x + a.y * a.y) + (a.z * a.z + a.w * a.w) + (b.x * b.x + b.y * b.y) + (b.z * b.z + b.w * b.w); }
        ss += __shfl_xor(ss, 16); ss += __shfl_xor(ss, 32);
        const float rstd = rsqrtf(ss * (1.f / D) + EPS);
        f32x4 acc[3]; acc[0] = (f32x4){0.f, 0.f, 0.f, 0.f}; acc[1] = acc[0]; acc[2] = acc[0];
        unsigned char* frow = (unsigned char*)F + (size_t)row * D + 8 * q4;
        const LAS float* abl = ab + 8 * q4;
        {
            const unsigned char* wsrc = (const unsigned char*)((const bf16x8*)(C.ws + WS_TAB + TAB_WR) + (size_t)layer * (32 * 3 * 2 * 64)) + C.tid * 16;
            LAS unsigned char* wl0 = C.lds + 67584;
#define RS_GLOAD(sb_, ga, gb, gc, xq) do { ga = *(const pg8::u32x4*)(wsrc + (sb_) * 24576); gb = *(const pg8::u32x4*)(wsrc + (sb_) * 24576 + 8192); gc = *(const pg8::u32x4*)(wsrc + (sb_) * 24576 + 16384); \
                _Pragma("unroll") for (int j = 0; j < 4; ++j) xq[j] = *(const pg8::u32x4*)(xr + 128 * (sb_) + 32 * j); } while (0)
#define RS_LWRITE(sb_, ga, gb, gc) do { LAS unsigned char* wn = wl0 + ((sb_) & 1) * 24576 + C.tid * 16; *(LAS pg8::u32x4*)(wn) = ga; *(LAS pg8::u32x4*)(wn + 8192) = gb; *(LAS pg8::u32x4*)(wn + 16384) = gc; } while (0)
#define RS_FRAGS(sb_, j_, wf_, tb_) do { const LAS unsigned char* wl = wl0 + ((sb_) & 1) * 24576 + C.lane * 16; const int c_ = 128 * (sb_) + 32 * (j_); \
                _Pragma("unroll") for (int jb = 0; jb < 3; ++jb) { wf_[jb][0] = *(const LAS bf16x8*)(wl + (((j_) * 3 + jb) * 2) * 1024); wf_[jb][1] = *(const LAS bf16x8*)(wl + (((j_) * 3 + jb) * 2 + 1) * 1024); } \
                tb_[0] = *(const LAS f32x4*)(abl + c_); tb_[1] = *(const LAS f32x4*)(abl + c_ + 4); tb_[2] = *(const LAS f32x4*)(abl + 1024 + c_); tb_[3] = *(const LAS f32x4*)(abl + 1024 + c_ + 4); } while (0)
#define RS_STEP(sb_, j_, xv_, wf_, tb_, NEXT) do { const int c = 128 * (sb_) + 32 * (j_); \
                pg8::f32x4 x0, x1; pg8::unpack8f(xv_, x0, x1); \
                const f32x4 f0 = x0 * rstd * tb_[0] + tb_[2]; \
                const f32x4 f1 = x1 * rstd * tb_[1] + tb_[3]; \
                const pg8::u32x4 fh = pg8::pack8(f0, f1); if (valid) *(pg8::u32x2*)(frow + c) = pg8::pack8_fp8(f0, f1); \
                pg8::f32x4 r0, r1; pg8::unpack8f(fh, r0, r1); \
                const pg8::u32x4 fl = pg8::pack8(f0 - r0, f1 - r1); \
                const bf16x8 ah = __builtin_bit_cast(bf16x8, fh), al = __builtin_bit_cast(bf16x8, fl); \
                NEXT; \
                _Pragma("unroll") for (int jb = 0; jb < 3; ++jb) { \
                    acc[jb] = __builtin_amdgcn_mfma_f32_16x16x32_bf16(wf_[jb][0], ah, acc[jb], 0, 0, 0); \
                    acc[jb] = __builtin_amdgcn_mfma_f32_16x16x32_bf16(wf_[jb][0], al, acc[jb], 0, 0, 0); \
                    acc[jb] = __builtin_amdgcn_mfma_f32_16x16x32_bf16(wf_[jb][1], ah, acc[jb], 0, 0, 0); } } while (0)
#define RS_COMP(sb_, xq) do { bf16x8 wA[3][2], wB[3][2]; f32x4 tA[4], tB[4]; \
                RS_FRAGS(sb_, 0, wA, tA); \
                RS_STEP(sb_, 0, xq[0], wA, tA, RS_FRAGS(sb_, 1, wB, tB)); \
                RS_STEP(sb_, 1, xq[1], wB, tB, RS_FRAGS(sb_, 2, wA, tA)); \
                RS_STEP(sb_, 2, xq[2], wA, tA, RS_FRAGS(sb_, 3, wB, tB)); \
                RS_STEP(sb_, 3, xq[3], wB, tB, (void)0); } while (0)
#define RS_SYNC() do { asm volatile("s_waitcnt lgkmcnt(0)" ::: "memory"); __builtin_amdgcn_s_barrier(); } while (0)
            if (layer == 1) STAMP_AT(22);
            pg8::u32x4 a0, a1, a2, b0, b1, b2, xa[4], xb[4], xc[4];
            RS_GLOAD(0, a0, a1, a2, xc); RS_GLOAD(1, b0, b1, b2, xb);
            __builtin_amdgcn_s_barrier();
            RS_LWRITE(0, a0, a1, a2); RS_SYNC();
#pragma unroll 1
            for (int sb = 0; sb < 8; sb += 2) {
                if (sb + 2 < 8) RS_GLOAD(sb + 2, a0, a1, a2, xa);
                RS_COMP(sb, xc);
                RS_LWRITE(sb + 1, b0, b1, b2); RS_SYNC();
#pragma unroll
                for (int j = 0; j < 4; ++j) xc[j] = xb[j];
                if (sb + 3 < 8) RS_GLOAD(sb + 3, b0, b1, b2, xb);
                RS_COMP(sb + 1, xc);
                if (sb + 2 < 8) { RS_LWRITE(sb + 2, a0, a1, a2);
#pragma unroll
                    for (int j = 0; j < 4; ++j) xc[j] = xa[j]; }
                RS_SYNC();
            }
            if (layer == 1) STAMP_AT(23);
#undef RS_GLOAD
#undef RS_LWRITE
#undef RS_COMP
#undef RS_STEP
#undef RS_FRAGS
#undef RS_SYNC
        }
        const float* brt = P.in[I_BRT] + layer * 32 + q4 * 8;
        float e[8];
#pragma unroll
        for (int r = 0; r < 4; ++r) { e[r] = acc[0][r] + brt[r]; e[4 + r] = acc[1][r] + brt[4 + r]; }
        const float gl = acc[2][0] + P.in[I_BGRP][layer * 4 + q4];
        float gm = gl; int gi = q4;
#pragma unroll
        for (int st = 16; st <= 32; st <<= 1) { const float og = __shfl_xor(gm, st); const int oi = __shfl_xor(gi, st); if (og > gm || (og == gm && oi < gi)) { gm = og; gi = oi; } }
        float den = __expf(gl - gm); den += __shfl_xor(den, 16); den += __shfl_xor(den, 32);
        if (valid && q4 == gi) {
            const float gw_ = 1.f / den;
            int i0 = 0; float v0 = e[0];
#pragma unroll
            for (int i = 1; i < 8; ++i) if (e[i] > v0) { v0 = e[i]; i0 = i; }
            int i1 = -1; float v1 = -INFINITY;
#pragma unroll
            for (int i = 0; i < 8; ++i) if (i != i0 && e[i] > v1) { v1 = e[i]; i1 = i; }
            if (i1 < 0) i1 = (i0 + 1) & 7;
            const float e1 = __expf(v1 - v0), w0 = gw_ / (1.f + e1), w1 = gw_ * e1 / (1.f + e1);
            const int ea = (gi & 3) * 8 + i0, eb = (gi & 3) * 8 + i1;
            const unsigned pa = __hip_atomic_fetch_add(lcnt + ea, 1u, __ATOMIC_RELAXED, __HIP_MEMORY_SCOPE_WORKGROUP);
            const unsigned pb = __hip_atomic_fetch_add(lcnt + eb, 1u, __ATOMIC_RELAXED, __HIP_MEMORY_SCOPE_WORKGROUP);
            asg_e[2 * row] = ea; asg_e[2 * row + 1] = eb; asg_p[2 * row] = (int)pa; asg_p[2 * row + 1] = (int)pb; asg_w[2 * row] = w0; asg_w[2 * row + 1] = w1;
        }
    }
    if (layer == 0) STAMP_AT(21);
    asm volatile("s_waitcnt vmcnt(0) lgkmcnt(0)" ::: "memory");
    __syncthreads();
    if (C.tid < 32) { const unsigned n = lcnt[C.tid]; lcnt[32 + C.tid] = n ? __hip_atomic_fetch_add(cnt + C.tid, n, __ATOMIC_RELAXED, __HIP_MEMORY_SCOPE_AGENT) : 0u; }
    __syncthreads();
    for (int it = C.gw; it < nrows / 16; it += C.ngw) {
        if (C.lane < 32) { const int idx = 2 * (it * 16 + (C.lane & 15)) + (C.lane >> 4);
            const int e = __hip_atomic_load(asg_e + idx, __ATOMIC_RELAXED, __HIP_MEMORY_SCOPE_AGENT); const int p = __hip_atomic_load(asg_p + idx, __ATOMIC_RELAXED, __HIP_MEMORY_SCOPE_AGENT) + (int)lcnt[32 + e];
            asg_p[idx] = p; list[(size_t)e * LCAP + p] = idx >> 1; }
    }
}

__device__ __forceinline__ int wave_pstart(const Ctx& C, int layer) {
    const unsigned* cnt = (const unsigned*)(C.ws + WS_CTL) + CW_CNT + 64 * layer;
    const int mc = C.lane < 32 ? (int)__hip_atomic_load(cnt + (C.lane & 31), __ATOMIC_RELAXED, __HIP_MEMORY_SCOPE_AGENT) : 0; const int mp = (mc + 255) & ~255; int in = mp;
#pragma unroll
    for (int o = 1; o < 32; o <<= 1) { const int t = __shfl_up(in, o); if ((C.lane & 31) >= o) in += t; }
    return in - mp;
}
struct CombRaw { v2u x[4], ya[4], yb[4]; float w0, w1; };
__device__ __forceinline__ void comb_load(const Ctx& C, int r, int ps, CombRaw& o) {
    const bf16* Y2 = (const bf16*)(C.ws + WS_XS); const bf16* XC = (const bf16*)(C.ws + WS_XC); const float* asg_w = (const float*)(C.ws + WS_ROUTE + RT_W);
    const int* asg_e = (const int*)(C.ws + WS_ROUTE + RT_E); const int* asg_p = (const int*)(C.ws + WS_ROUTE + RT_P);
    const int s0 = __shfl(ps, asg_e[2 * r]) + asg_p[2 * r], s1 = __shfl(ps, asg_e[2 * r + 1]) + asg_p[2 * r + 1]; o.w0 = asg_w[2 * r]; o.w1 = asg_w[2 * r + 1];
#pragma unroll
    for (int j = 0; j < 4; ++j) { const int c = 4 * C.lane + 256 * j; o.x[j] = *(const v2u*)(XC + (size_t)r * D + c); o.ya[j] = *(const v2u*)(Y2 + (size_t)s0 * D + c); o.yb[j] = *(const v2u*)(Y2 + (size_t)s1 * D + c); }
}
__device__ __forceinline__ void comb_calc(const Ctx& C, int layer, int r, const CombRaw& w, f32x4 (&v)[4]) {
    const float* gate = mod_vec(C, layer, cond_of(r), 5); const float w0 = w.w0, w1 = w.w1;
#pragma unroll
    for (int j = 0; j < 4; ++j) { const int c = 4 * C.lane + 256 * j; const v2u xx = w.x[j], a = w.ya[j], b = w.yb[j]; const f32x4 g = *(const f32x4*)(gate + c);
        v[j].x = bf2f(xx.x & 0xffffu) + g.x * (w0 * bf2f(a.x & 0xffffu) + w1 * bf2f(b.x & 0xffffu)); v[j].y = bf2f(xx.x >> 16) + g.y * (w0 * bf2f(a.x >> 16) + w1 * bf2f(b.x >> 16));
        v[j].z = bf2f(xx.y & 0xffffu) + g.z * (w0 * bf2f(a.y & 0xffffu) + w1 * bf2f(b.y & 0xffffu)); v[j].w = bf2f(xx.y >> 16) + g.w * (w0 * bf2f(a.y >> 16) + w1 * bf2f(b.y >> 16)); }
}
__device__ __forceinline__ void phase_combine_norm_mix1(const Ctx& C) {
    const Params& P = *C.p; bf16* XC = (bf16*)(C.ws + WS_XC); bf16* H = (bf16*)(C.ws + WS_H);
    const int ps = wave_pstart(C, 0), n = C.ngw;
#define CN_ROW(buf, rr, rnext) do { const CombRaw w_ = buf; if ((rnext) < TT) comb_load(C, (rnext), ps, buf); f32x4 v[4]; comb_calc(C, 0, (rr), w_, v); \
        store_row16_bf16(XC + (size_t)(rr) * D, C.lane, v); const float rstd = row_rstd(v); const int ci = cond_of(rr); \
        modulate16(v, rstd, P.in[I_GMIX] + D, mod_vec(C, 1, ci, 1), mod_vec(C, 1, ci, 0), C.lane); store_row16_bf16(H + (size_t)(rr) * D, C.lane, v); } while (0)
    CombRaw a, b; int r = C.gw;
    if (r < TT) comb_load(C, r, ps, a);
    if (r + n < TT) comb_load(C, r + n, ps, b);
    for (; r < TT; r += 2 * n) { CN_ROW(a, r, r + 2 * n); if (r + n < TT) CN_ROW(b, r + n, r + 3 * n); }
#undef CN_ROW
    { const bool early = gridDim.x == 256; if (early) convert_range(C, 1, 0, L1_A, 0); convert_range(C, 1, early ? L1_C : 0, MOE_ITEMS, 0); }
}
__device__ __forceinline__ void phase_final(const Ctx& C) {
    const Params& P = *C.p;
    const int ps = wave_pstart(C, 1), n = C.ngw;
#define FN_ROW(buf, rr, rnext) do { const CombRaw w_ = buf; if ((rnext) < TL) comb_load(C, (rnext), ps, buf); f32x4 v[4]; comb_calc(C, 1, (rr), w_, v); const float rstd = row_rstd(v); \
        _Pragma("unroll") for (int j = 0; j < 4; ++j) { const int c = 4 * C.lane + 256 * j; const f32x4 g = *(const f32x4*)(P.in[I_FING] + c); __builtin_nontemporal_store(v[j] * rstd * g, (f32x4*)(P.out + (size_t)(rr) * D + c)); } } while (0)
    CombRaw a, b; int r = C.gw;
    if (r < TL) comb_load(C, r, ps, a);
    if (r + n < TL) comb_load(C, r + n, ps, b);
    for (; r < TL; r += 2 * n) { FN_ROW(a, r, r + 2 * n); if (r + n < TL) FN_ROW(b, r + n, r + 3 * n); }
#undef FN_ROW
}

__device__ __forceinline__ void phase_s5_fast(const Ctx& C) {
    typedef short bf16x8 __attribute__((ext_vector_type(8)));
    typedef float f32x16 __attribute__((ext_vector_type(16)));
    const Params& P = *C.p; const bf16* U = (const bf16*)(C.ws + WS_U); bf16* GS = (bf16*)(C.ws + WS_GS); float* YA = (float*)(C.ws + WS_YACC);
    const float2* lamb = (const float2*)(C.ws + WS_TAB + TAB_LAMB); const float2* bbar = (const float2*)(C.ws + WS_TAB + TAB_BBAR);
    constexpr int HP = 272;
    const int lane = C.lane, w = C.wave, il = w >> 2, dir = (w >> 1) & 1, nh = w & 1;
    const int l31 = lane & 31, hi = lane >> 5, l15 = lane & 15, q4 = lane >> 4;
    LAS unsigned char* Hb = C.lds + (il * 2 + dir) * (2 * 32 * HP);
    const int srow = 16 * ((l31 >> 2) & 1) + 2 * (l31 >> 3) + ((l31 >> 1) & 1);
    for (int it0 = blockIdx.x; it0 < NB * 16; it0 += gridDim.x) {
        const int item = it0 * 2 + il, b = item >> 5, g = item & 31;
        const int dg = dir * 32 + g, n = nh * 32 + l31;
        const float2 lam = lamb[dg * 64 + n];
        f32x2 p2[16]; { f32x2 p = {lam.x, lam.y};
#pragma unroll
            for (int r = 0; r < 16; ++r) { p2[r] = p; p = (f32x2){p.x * lam.x - p.y * lam.y, p.x * lam.y + p.y * lam.x}; } }
        const f32x2 lx2 = {lam.x, lam.x}, ly2 = {-lam.y, lam.y};
        bf16x8 bre, bim; { const float2* bp = bbar + ((size_t)(dg * 64 + n)) * 16 + 8 * hi;
#pragma unroll
            for (int e = 0; e < 8; ++e) { const float2 v = bp[e]; bre[e] = (short)f2bf(v.x); bim[e] = (short)f2bf(v.y); } }
        bf16x8 cf[4]; { const float* cre = P.in[I_CRE] + ((size_t)dg * 16 + l15) * 64; const float* cim = P.in[I_CIM] + ((size_t)dg * 16 + l15) * 64;
#pragma unroll
            for (int ks = 0; ks < 4; ++ks) { const f32x4 a = *(const f32x4*)(cre + 16 * ks + 4 * q4), m = *(const f32x4*)(cim + 16 * ks + 4 * q4);
                cf[ks][0] = (short)f2bf(a.x); cf[ks][1] = (short)f2bf(-m.x); cf[ks][2] = (short)f2bf(a.y); cf[ks][3] = (short)f2bf(-m.y);
                cf[ks][4] = (short)f2bf(a.z); cf[ks][5] = (short)f2bf(-m.z); cf[ks][6] = (short)f2bf(a.w); cf[ks][7] = (short)f2bf(-m.w); } }
        const f32x4 dsk = *(const f32x4*)(P.in[I_S5D] + g * 16 + 4 * q4);
        f32x2 carry = {0.f, 0.f};
#define S5_UROW(kk, off) ({ const int S_ = 32 * (kk) + srow + (off); (S_ < CTXL) ? ((size_t)TL + (size_t)b * CTXL + (dir == 0 ? S_ : CTXL - 1 - S_)) : ((size_t)b * SEQ + (dir == 0 ? S_ - CTXL : SEQ - 1 - (S_ - CTXL))); })
        const bool odd = l31 & 1;
#define S5_ULD(kk, off) (*(const bf16x8*)(U + S5_UROW(kk, off) * 512 + g * 16 + 8 * hi))
        bf16x8 ux1 = S5_ULD(0, 0), uy1 = S5_ULD(0, 8), ux2 = S5_ULD(1, 0), uy2 = S5_ULD(1, 8), ux3 = S5_ULD(2, 0), uy3 = S5_ULD(2, 8);
        f32x4 pk_n = {0.f, 0.f, 0.f, 0.f}; v2u uu_n = {0u, 0u};
        for (int k = 0; k < 72; ++k) {
            const bf16x8 ux = ux1, uy = uy1; ux1 = ux2; uy1 = uy2; ux2 = ux3; uy2 = uy3;
            if (k + 3 < 72) { ux3 = S5_ULD(k + 3, 0); uy3 = S5_ULD(k + 3, 8); }
            const int sl = 32 * (k - 8) + 16 * nh + l15;
            const int tok = dir == 0 ? sl : SEQ - 1 - sl; const int lt = tok >> 5;
            const size_t o = ((size_t)b * SEQ + (k >= 8 ? tok : 0)) * 512 + g * 16 + 4 * q4;
            const bool first = dir == 0 ? (lt < 32) : (lt >= 32);
#define S5_RLOAD(oo, pk_, uu_) do { pk_.x = __hip_atomic_load(YA + (oo), __ATOMIC_RELAXED, __HIP_MEMORY_SCOPE_AGENT); pk_.y = __hip_atomic_load(YA + (oo) + 1, __ATOMIC_RELAXED, __HIP_MEMORY_SCOPE_AGENT); \
                pk_.z = __hip_atomic_load(YA + (oo) + 2, __ATOMIC_RELAXED, __HIP_MEMORY_SCOPE_AGENT); pk_.w = __hip_atomic_load(YA + (oo) + 3, __ATOMIC_RELAXED, __HIP_MEMORY_SCOPE_AGENT); uu_ = *(const v2u*)(U + (oo)); } while (0)
            f32x4 pk = pk_n; v2u uu = uu_n;
            if (k == 40) S5_RLOAD(o, pk, uu);
            if (k >= 40 && k + 1 < 72) { const int sl1 = 32 * (k + 1 - 8) + 16 * nh + l15; const int tok1 = dir == 0 ? sl1 : SEQ - 1 - sl1; const size_t o1 = ((size_t)b * SEQ + tok1) * 512 + g * 16 + 4 * q4; S5_RLOAD(o1, pk_n, uu_n); }
            {
              const bf16x8 zf = {0, 0, 0, 0, 0, 0, 0, 0};
              f32x16 X = {}, Y = {};
              X = __builtin_amdgcn_mfma_f32_32x32x16_bf16(odd ? zf : ux, bre, X, 0, 0, 0); X = __builtin_amdgcn_mfma_f32_32x32x16_bf16(odd ? ux : zf, bim, X, 0, 0, 0);
              Y = __builtin_amdgcn_mfma_f32_32x32x16_bf16(odd ? zf : uy, bre, Y, 0, 0, 0); Y = __builtin_amdgcn_mfma_f32_32x32x16_bf16(odd ? uy : zf, bim, Y, 0, 0, 0);
              f32x2 s2 = hi ? (f32x2){0.f, 0.f} : carry;
#pragma unroll
              for (int q = 0; q < 8; ++q) { const f32x2 bq = {X[2 * q], X[2 * q + 1]}, sw = {s2.y, s2.x}; s2 = lx2 * s2 + bq; s2 = ly2 * sw + s2; X[2 * q] = s2.x; X[2 * q + 1] = s2.y; }
#pragma unroll
              for (int q = 0; q < 8; ++q) { const f32x2 bq = {Y[2 * q], Y[2 * q + 1]}, sw = {s2.y, s2.x}; s2 = lx2 * s2 + bq; s2 = ly2 * sw + s2; Y[2 * q] = s2.x; Y[2 * q + 1] = s2.y; }
              float er = __shfl_xor(s2.x, 32), ei = __shfl_xor(s2.y, 32); if (!hi) { er = 0.f; ei = 0.f; }
              const f32x2 er2 = {er, er}, ei2 = {ei, ei};
#pragma unroll
              for (int q = 0; q < 8; ++q) { const f32x2 p = p2[q], ps = {-p.y, p.x}; f32x2 h = {X[2 * q], X[2 * q + 1]}; h = er2 * p + h; h = ei2 * ps + h; X[2 * q] = h.x; X[2 * q + 1] = h.y; }
#pragma unroll
              for (int q = 0; q < 8; ++q) { const f32x2 p = p2[8 + q], ps = {-p.y, p.x}; f32x2 h = {Y[2 * q], Y[2 * q + 1]}; h = er2 * p + h; h = ei2 * ps + h; Y[2 * q] = h.x; Y[2 * q + 1] = h.y; }
              carry = (f32x2){__shfl_xor(Y[14], 32), __shfl_xor(Y[15], 32)};
              LAS unsigned char* hb = Hb + (k & 1) * (32 * HP) + (16 * hi) * HP + 4 * n;
#pragma unroll
              for (int q = 0; q < 8; ++q) { *(LAS unsigned*)(hb + q * HP) = pk2(X[2 * q], X[2 * q + 1]); *(LAS unsigned*)(hb + (8 + q) * HP) = pk2(Y[2 * q], Y[2 * q + 1]); }
            }
            asm volatile("s_waitcnt lgkmcnt(0)\n\ts_barrier" ::: "memory");
            if (k >= 8) {
                const LAS unsigned char* hr = Hb + (k & 1) * (32 * HP) + (16 * nh + l15) * HP + 16 * q4;
                f32x4 y = {0.f, 0.f, 0.f, 0.f};
#pragma unroll
                for (int ks = 0; ks < 4; ++ks) { const bf16x8 hf = *(const LAS bf16x8*)(hr + 64 * ks); y = __builtin_amdgcn_mfma_f32_16x16x32_bf16(cf[ks], hf, y, 0, 0, 0); }
                if (first) { *(f32x4*)(YA + o) = y; }
                else {
                    const f32x4 uf = {bf2f(uu.x & 0xffffu), bf2f(uu.x >> 16), bf2f(uu.y & 0xffffu), bf2f(uu.y >> 16)};
                    const f32x4 t = y + pk + dsk * uf;
                    v2u ov; ov.x = pk2(gelu_tanh(t.x), gelu_tanh(t.y)); ov.y = pk2(gelu_tanh(t.z), gelu_tanh(t.w)); *(v2u*)(GS + o) = ov;
                }
            }
            if (k == 39) asm volatile("s_waitcnt vmcnt(0)\n\ts_barrier" ::: "memory");
        }
#undef S5_UROW
#undef S5_ULD
#undef S5_RLOAD
        asm volatile("s_waitcnt vmcnt(0) lgkmcnt(0)\n\ts_barrier" ::: "memory");
    }
}

__global__ void __launch_bounds__(NTHR, 2) fwd_kernel(Params prm) {
    extern __shared__ __attribute__((aligned(16))) unsigned char lds_raw[];
    Ctx C; C.p = &prm; C.ws = prm.ws; C.lds = (LAS unsigned char*)lds_raw;
    C.tid = threadIdx.x; C.lane = C.tid & 63; C.wave = __builtin_amdgcn_readfirstlane(C.tid >> 6);
    C.gw = blockIdx.x * NWAVE + C.wave; C.ngw = gridDim.x * NWAVE;
    constexpr int LDS_MISC = 147456 - 512;
    volatile LAS unsigned* misc = (volatile LAS unsigned*)(C.lds + LDS_MISC);
    if (C.tid < 64) misc[C.tid] = 0u;
    __syncthreads();
    unsigned* ctl = (unsigned*)(C.ws + WS_CTL);
    XcdBarrier bar; bar.bar = ctl + CW_BAR; bar.x = 0; bar.st = nullptr;
#if MK_ONE_LAUNCH
    bar = xcd_barrier_post(ctl + CW_BAR, misc + 8);
#define SEAM(k) do { if (lo <= (k) && (k) + 1 < hi) xcd_barrier(bar); } while (0)
#else
#define SEAM(k) do { } while (0)
#endif
    const int lo = prm.ph_lo, hi = prm.ph_hi;
#define IN(k) ((C.lane = lane_id_now(), C.tid = C.wave * 64 + C.lane, true) && lo <= (k) && (k) < hi)
#if MK_PROBE
#define STAMP(k) STAMP_AT((k) + 1)
    STAMP_AT(0);
#else
#define STAMP(k) do { } while (0)
#endif
    const Params& P = prm;
    bf16* Hb = (bf16*)(C.ws + WS_H); bf16* XC = (bf16*)(C.ws + WS_XC);
#define MOE_MAP(layer) do { LAS int* tm_ = (LAS int*)(C.lds + 131072); LAS int* cl_ = tm_ + 320; \
        if (C.wave == 0) { const unsigned* cnt_ = (const unsigned*)(C.ws + WS_CTL) + CW_CNT + 64 * (layer); const int mc_ = C.lane < 32 ? (int)__hip_atomic_load(cnt_ + (C.lane & 31), __ATOMIC_RELAXED, __HIP_MEMORY_SCOPE_AGENT) : 0; const int mp_ = (mc_ + 255) & ~255; int in_ = mp_; \
            _Pragma("unroll") for (int o_ = 1; o_ < 32; o_ <<= 1) { const int t_ = __shfl_up(in_, o_); if ((C.lane & 31) >= o_) in_ += t_; } const int ps_ = in_ - mp_; \
            if (C.lane < 32) { for (int t_ = ps_ / 256; t_ < (ps_ + mp_) / 256; ++t_) tm_[t_] = C.lane | ((t_ * 256 - ps_) << 8); cl_[C.lane] = mc_; if (C.lane == 31) cl_[32] = (ps_ + mp_) / 256; } } \
        __syncthreads(); } while (0)
#define MOE_GEMM1(layer) do { MOE_MAP(layer); const LAS int* tm_ = (const LAS int*)(C.lds + 131072); const int ntl_ = __builtin_amdgcn_readfirstlane(tm_[320 + 32]); pg8::Gemm g{Hb, (const bf16*)(C.ws + ((layer) ? WS_W13B : WS_W13)), 0, 1024, 512}; \
        pg8::GroupedOrder<true> S{tm_, tm_ + 320, (const int*)(C.ws + WS_LIST), ntl_ * 4, 4, (int)gridDim.x, (int)blockIdx.x, LCAP, 1024, (size_t)1024 * 1024}; pg8::EpiSwiglu E{(unsigned char*)(C.ws + WS_G13), 1.f / W13_SCALE, G_SCALE}; \
        pg8::gemm_phase<pg8::EpiSwiglu, pg8::GroupedOrder<true>, true, false, false, true>(C.lds, g, S, E, C.wave); } while (0)
#define MOE_GEMM2(layer) do { MOE_MAP(layer); int kk_ = EH / 2; asm volatile("" : "+s"(kk_));     \
        const LAS int* tm_ = (const LAS int*)(C.lds + 131072); const int ntl_ = __builtin_amdgcn_readfirstlane(tm_[320 + 32]); pg8::Gemm g{(const bf16*)(C.ws + WS_G13), (const bf16*)(C.ws + ((layer) ? WS_W2B : WS_W2)), 0, 1024, kk_}; \
        pg8::GroupedOrder<false> S{tm_, tm_ + 320, (const int*)(C.ws + WS_LIST), ntl_ * 4, 4, (int)gridDim.x, (int)blockIdx.x, LCAP, EH, (size_t)1024 * 512}; pg8::EpiStore E{(bf16*)(C.ws + WS_XS), D, 1.f / (W13_SCALE * G_SCALE)}; \
        pg8::gemm_phase<pg8::EpiStore, pg8::GroupedOrder<false>, true, false, false, true>(C.lds, g, S, E, C.wave); } while (0)
    if (IN(0)) { phase_prologue(C); SEAM(0); STAMP(0); }
    if (IN(1)) { phase_norm_mix0(C); SEAM(1); STAMP(1); }
    if (IN(2)) { pg8::Gemm g{Hb, (const bf16*)(C.ws + WS_WIN0), TT, MIXW, D / 2};
        pg8::StaticOrder S; S.init(TT, MIXW, gridDim.x, blockIdx.x); pg8::EpiInProj E{(bf16*)(C.ws + WS_P), (bf16*)(C.ws + WS_K), (bf16*)(C.ws + WS_V), P.in[I_KG], (const float*)(C.ws + WS_TAB + TAB_ROPE), (LAS float*)(C.lds + 135168), 1.f / W13_SCALE, (float*)(C.ws + WS_Q)};
        pg8::gemm_phase<pg8::EpiInProj, pg8::StaticOrder, true, false, false, true>(C.lds, g, S, E, C.wave); SEAM(2); STAMP(2); }
    if (IN(4)) { phase_gmlp_fast(C); phase_attn_fast(C, (char*)lds_raw); SEAM(4); STAMP(4); }
    if (IN(5)) { pg8::Gemm g{Hb, (const bf16*)(C.ws + WS_WOUT0), TT, D, D}; pg8::StaticOrder S; S.init(TT, D, gridDim.x, blockIdx.x); pg8::EpiResid E{P.in[I_X], P.in[I_CTX], (const float*)(C.ws + WS_MOD), XC, 0};
        pg8::gemm_phase<pg8::EpiResid, pg8::StaticOrder, true, true, true>(C.lds, g, S, E, C.wave);
        if (gridDim.x == 256) { __syncthreads(); convert_range(C, 0, L0_A, L0_B, 64); }
        SEAM(5); STAMP(5); }
    if (IN(6)) { phase_router_fast(C, 0, TT); if (gridDim.x == 256) { __syncthreads(); convert_range(C, 0, L0_B, MOE_ITEMS, 32); } SEAM(6); STAMP(6); }
    if (IN(8)) { MOE_GEMM1(0); SEAM(8); STAMP(8); }
    if (IN(9)) { MOE_GEMM2(0); if (gridDim.x == 256) { __syncthreads(); convert_range(C, 1, L1_A, L1_B, 192); } SEAM(9); STAMP(9); }
    if (IN(10)) { phase_combine_norm_mix1(C); SEAM(10); STAMP(10); }
    if (IN(11)) { pg8::Gemm g{Hb, (const bf16*)(C.ws + WS_WS5IN), TT, 512, D}; pg8::StaticOrder S; S.init(TT, 512, gridDim.x, blockIdx.x); pg8::EpiStore E{(bf16*)(C.ws + WS_U), 512, 1.f};
        pg8::gemm_phase<pg8::EpiStore, pg8::StaticOrder, true, true, true>(C.lds, g, S, E, C.wave);
        if (gridDim.x == 256) { __syncthreads(); convert_range(C, 1, L1_B, L1_C, 32); }
        SEAM(11); STAMP(11); }
    if (IN(12)) { phase_s5_fast(C); SEAM(12); STAMP(12); }
    if (IN(13)) { pg8::Gemm g{(const bf16*)(C.ws + WS_GS), (const bf16*)(C.ws + WS_WGLU), TL, 512, 512}; pg8::StaticOrder S; S.init(TL, 512, gridDim.x, blockIdx.x); pg8::EpiGlu E{(const bf16*)(C.ws + WS_GS), P.in[I_BGLU], (bf16*)(C.ws + WS_GG)};
        pg8::gemm_phase<pg8::EpiGlu, pg8::StaticOrder, true, true, true>(C.lds, g, S, E, C.wave); SEAM(13); STAMP(13); }
    if (IN(14)) { pg8::Gemm g{(const bf16*)(C.ws + WS_GG), (const bf16*)(C.ws + WS_WS5OUT), TL, D, 512}; pg8::StaticOrder S; S.init(TL, D, gridDim.x, blockIdx.x); pg8::EpiResid E{P.in[I_X], P.in[I_CTX], (const float*)(C.ws + WS_MOD) + (size_t)17 * 6 * D, XC, 1};
        pg8::gemm_phase<pg8::EpiResid, pg8::StaticOrder, true, true, true>(C.lds, g, S, E, C.wave); SEAM(14); STAMP(14); }
    if (IN(15)) { phase_router_fast(C, 1, TL); SEAM(15); STAMP(15); }
    if (IN(17)) { MOE_GEMM1(1); SEAM(17); STAMP(17); }
    if (IN(18)) { MOE_GEMM2(1); SEAM(18); STAMP(18); }
    if (IN(19)) { phase_final(C); STAMP(19); }
#if MK_PROBE
    if (blockIdx.x == 0 && C.wave == 0 && lane_id_now() == 0) {
        volatile LAS unsigned long long* ts_ = (volatile LAS unsigned long long*)(C.lds + LDS_MISC + 64);
        ts_[8] = ts_[7]; ts_[17] = ts_[16];
        const unsigned long long tA = ts_[PROBE_A_HI + 1] - ts_[PROBE_A_LO], tB = ts_[PROBE_B_HI + 1] - ts_[PROBE_B_LO];
        const unsigned long long spin = 16ull * tA + 1000000ull * ((tB + 500ull) / 1000ull);
        const unsigned long long t0 = __builtin_amdgcn_s_memrealtime();
        while (__builtin_amdgcn_s_memrealtime() - t0 < spin) __builtin_amdgcn_s_sleep(8);
    }
#endif
#undef IN
#undef SEAM
}

extern "C" void kernel_launch(void* const* d_in, const int* in_sizes, int n_in, void* d_out, int out_size, void* d_ws, size_t ws_size, hipStream_t stream) {
    constexpr int LDS_BYTES = 147456;
    static int grid = 0;
    if (grid == 0) {
        if (n_in != 35 || out_size != TL * D || ws_size < WS_END) { fprintf(stderr, "kernel_launch: unexpected shapes (n_in %d out %d ws %zu)\n", n_in, out_size, ws_size); grid = -1; return; }
        int dev = 0, cus = 0;
        if (hipGetDevice(&dev) != hipSuccess || hipDeviceGetAttribute(&cus, hipDeviceAttributeMultiprocessorCount, dev) != hipSuccess) { grid = -1; return; }
        if (hipFuncSetAttribute((const void*)fwd_kernel, hipFuncAttributeMaxDynamicSharedMemorySize, LDS_BYTES) != hipSuccess) { fprintf(stderr, "kernel_launch: hipFuncSetAttribute failed\n"); grid = -1; return; }
        (void)hipGetLastError();
        grid = cus;
    }
    if (grid < 0) return;
    (void)hipMemsetAsync((char*)d_ws + WS_CTL, 0, CTL_BYTES, stream);
    Params p{};
    for (int i = 0; i < 35; ++i) p.in[i] = (const float*)d_in[i];
    p.out = (float*)d_out; p.ws = (unsigned char*)d_ws;
#if MK_ONE_LAUNCH
    p.ph_lo = 0; p.ph_hi = NPHASE;
    hipLaunchKernelGGL(fwd_kernel, dim3(grid), dim3(NTHR), LDS_BYTES, stream, p);
#else
    for (int k = 0; k < NPHASE; ++k) { p.ph_lo = k; p.ph_hi = k + 1; hipLaunchKernelGGL(fwd_kernel, dim3(grid), dim3(NTHR), LDS_BYTES, stream, p); }
#endif
}
```

```cpp
#include <hip/hip_runtime.h>
#include <cstdio>
#include <cstdint>
#include <type_traits>

#ifndef MK_ONE_LAUNCH
#define MK_ONE_LAUNCH 1
#endif
#ifndef MK_SIMPLE_ORDER
#define MK_SIMPLE_ORDER 0
#endif
#ifndef MK_KROT
#define MK_KROT 0
#endif
#ifndef MK_PROBE
#define MK_PROBE 0
#endif
#define PROBE_A_LO 4
#define PROBE_A_HI 4
#define PROBE_B_LO 8
#define PROBE_B_HI 9

constexpr int D = 1024, NB = 16, SEQ = 2048, CTXL = 256;
constexpr int TL = NB * SEQ, TC = NB * CTXL, TT = TL + TC;
constexpr int KVL = CTXL + SEQ;
constexpr int MIXW = 1792, NEXP = 32, EH = 512;
constexpr int NSLOT = 81920;
constexpr float EPS = 1e-6f;
constexpr float QSCALE = 0.125f * 1.4426950408889634f;
constexpr int NTHR = 512, NWAVE = 8;
constexpr float W13_SCALE = 32.f;
constexpr float G_SCALE = 8.f;
constexpr int NPHASE = 20;

constexpr size_t MiB = 1u << 20;
constexpr size_t WS_CTL = 0, CTL_BYTES = 1 * MiB;
constexpr size_t WS_MOD = 1 * MiB;
constexpr size_t WS_TAB = 2 * MiB;
constexpr size_t TAB_ROPE = 0, TAB_LAMB = 16384, TAB_BBAR = 65536, TAB_WR = 640 * 1024;
constexpr size_t WS_ROUTE = 3 * MiB;
constexpr size_t RT_E = 0, RT_P = 320 * 1024, RT_W = 640 * 1024, RT_S = 960 * 1024, RT_TILE = 1280 * 1024, RT_NT = 1280 * 1024 + 4096;
constexpr size_t WS_WIN0 = 6 * MiB, WS_WOUT0 = 10 * MiB, WS_WS5IN = 12 * MiB, WS_WGLU = 13 * MiB, WS_WS5OUT = 14 * MiB;
constexpr size_t WS_WSP = 15 * MiB;
constexpr size_t WS_W13 = 16 * MiB, WS_W2 = 80 * MiB;
constexpr size_t WS_W13B = 184 * MiB, WS_W2B = 216 * MiB;
constexpr int L0_A = 4096, L0_B = L0_A + 0;
constexpr int L1_A = 2048, L1_B = L1_A + 4096, L1_C = L1_B + 7168;
constexpr size_t WS_XC = 112 * MiB;
constexpr size_t WS_H = 256 * MiB;
constexpr size_t WS_P = 328 * MiB;
constexpr size_t WS_Q = 454 * MiB, WS_K = 490 * MiB, WS_V = 499 * MiB;
constexpr size_t WS_XS = 328 * MiB;
constexpr size_t WS_G13 = 488 * MiB;
constexpr size_t WS_U = 328 * MiB, WS_GS = 364 * MiB, WS_GG = 396 * MiB, WS_YACC = 428 * MiB;
constexpr size_t WS_LIST = 568 * MiB;
constexpr int LCAP = 36864;
constexpr size_t WS_END = 574 * MiB;
constexpr int CW_CNT = 64;
constexpr int CW_BAR = 4096;

__device__ __forceinline__ int lane_id_now() { int l; asm volatile("v_mbcnt_lo_u32_b32 %0, -1, 0\n\tv_mbcnt_hi_u32_b32 %0, -1, %0\n\ts_nop 0" : "=v"(l)); return l; }
#define STAMP_AT(idx) do { if (MK_PROBE && blockIdx.x == 0 && C.wave == 0 && lane_id_now() == 0) ((volatile __attribute__((address_space(3))) unsigned long long*)(C.lds + 147456 - 512 + 64))[idx] = __builtin_amdgcn_s_memrealtime(); } while (0)
#define LAS __attribute__((address_space(3)))
typedef unsigned short bf16;
typedef unsigned v4u __attribute__((ext_vector_type(4)));
typedef unsigned v2u __attribute__((ext_vector_type(2)));
typedef float f32x4 __attribute__((ext_vector_type(4)));
typedef float f32x2 __attribute__((ext_vector_type(2)));
__device__ __forceinline__ float bf2f(unsigned u) { return __uint_as_float(u << 16); }
typedef __bf16 bf16x2_t __attribute__((ext_vector_type(2)));
__device__ __forceinline__ unsigned pk2(float lo, float hi) { const f32x2 v = {lo, hi}; return __builtin_bit_cast(unsigned, __builtin_convertvector(v, bf16x2_t)); }
__device__ __forceinline__ unsigned f2bf(float f) { return pk2(f, 0.f) & 0xffffu; }
__device__ __forceinline__ float wave_sum(float v) {
#pragma unroll
    for (int o = 1; o < 64; o <<= 1) v += __shfl_xor(v, o);
    return v;
}
__device__ __forceinline__ float wave_max(float v) {
#pragma unroll
    for (int o = 1; o < 64; o <<= 1) v = fmaxf(v, __shfl_xor(v, o));
    return v;
}
__device__ __forceinline__ float gelu_tanh(float x) { const float u2 = -1.5957691216057308f * (x + 0.044715f * x * x * x); return x * __builtin_amdgcn_rcpf(1.f + __expf(u2)); }
__device__ __forceinline__ float sigmoidf_(float x) { return 1.f / (1.f + __expf(-x)); }
__device__ __forceinline__ float silu_(float x) { return x / (1.f + __expf(-x)); }
__device__ __forceinline__ void unpack8(const v4u w, float* f) {
    f[0] = bf2f(w.x & 0xffffu); f[1] = bf2f(w.x >> 16); f[2] = bf2f(w.y & 0xffffu); f[3] = bf2f(w.y >> 16);
    f[4] = bf2f(w.z & 0xffffu); f[5] = bf2f(w.z >> 16); f[6] = bf2f(w.w & 0xffffu); f[7] = bf2f(w.w >> 16);
}

#define XB_TMO      128
#define XB_XCNT(j)  (256  + 64 * (j))
#define XB_XSUB(j)  (1280 + 64 * (j))
#define XB_XGEN(j)  (2304 + 64 * (j))
#define XB_TOP      3328
#define XB_TOPGEN   3392
#define XCD_BAR_WORDS 3456
#define XB_SPIN_CAP (1u << 28)
__device__ __forceinline__ unsigned xb_ld(unsigned* p)              { return __hip_atomic_load(p, __ATOMIC_RELAXED, __HIP_MEMORY_SCOPE_AGENT); }
__device__ __forceinline__ unsigned xb_add(unsigned* p, unsigned v) { return __hip_atomic_fetch_add(p, v, __ATOMIC_RELAXED, __HIP_MEMORY_SCOPE_AGENT); }
__device__ __forceinline__ unsigned xb_xcc_id() { return (unsigned)__builtin_amdgcn_s_getreg((3 << 11) | 20) & 0xFu; }
#define XB_SPIN(cond, bar) do { unsigned _sp = 0; while (cond) { __builtin_amdgcn_s_sleep(1); \
    if ((++_sp & 255u) == 0u) { if (xb_ld(&(bar)[XB_TMO])) break; if (_sp > XB_SPIN_CAP) { atomicAdd(&(bar)[XB_TMO], 1u); break; } } } } while (0)
struct XcdBarrier { unsigned* bar; unsigned x; volatile LAS unsigned* st; };
__device__ __forceinline__ XcdBarrier xcd_barrier_post(unsigned* bar, volatile LAS unsigned* st) {
    XcdBarrier b; b.bar = bar; b.x = xb_xcc_id(); b.st = st;
    if (threadIdx.x == 0) (void)xb_add(&bar[XB_XCNT(b.x)], 1u);
    return b;
}
__device__ __forceinline__ void xcd_barrier_complete(unsigned* bar, unsigned x, unsigned& nloc, unsigned& nx) {
    const unsigned G = gridDim.x * gridDim.y * gridDim.z;
    unsigned sum, cnt, mine, sp = 0u;
    for (;;) {
        sum = 0u; cnt = 0u; mine = 0u;
#pragma unroll
        for (unsigned j = 0; j < 16; ++j) { const unsigned c = xb_ld(&bar[XB_XCNT(j)]); sum += c; cnt += (c > 0u) ? 1u : 0u; mine = (j == x) ? c : mine; }
        if (sum == G) break;
        __builtin_amdgcn_s_sleep(1);
        if ((++sp & 255u) == 0u) { if (xb_ld(&bar[XB_TMO])) break; if (sp > XB_SPIN_CAP) { atomicAdd(&bar[XB_TMO], 1u); break; } }
    }
    nloc = mine > 0u ? mine : 1u; nx = cnt > 0u ? cnt : 1u;
}
__device__ __forceinline__ void xcd_barrier(const XcdBarrier& b) {
    asm volatile("s_waitcnt vmcnt(0)" ::: "memory");
    __syncthreads();
    if (threadIdx.x == 0) {
        unsigned* bar = b.bar;
        __builtin_amdgcn_s_waitcnt(0);
        unsigned nloc = b.st[0], nx = b.st[1];
        if (nloc == 0u) { xcd_barrier_complete(bar, b.x, nloc, nx); b.st[0] = nloc; b.st[1] = nx; }
        const unsigned old = xb_add(&bar[XB_XSUB(b.x)], 1u);
        const unsigned gen = old / nloc;
        if (old + 1u == (gen + 1u) * nloc) {
            __builtin_amdgcn_fence(__ATOMIC_RELEASE, "agent");
            asm volatile("s_waitcnt vmcnt(0)" ::: "memory");
            const unsigned og = xb_add(&bar[XB_TOP], 1u);
            const unsigned tg = og / nx;
            if (og + 1u == (tg + 1u) * nx) xb_add(&bar[XB_TOPGEN], 1u);
            else XB_SPIN(xb_ld(&bar[XB_TOPGEN]) == tg, bar);
            __builtin_amdgcn_fence(__ATOMIC_ACQUIRE, "agent");
            xb_add(&bar[XB_XGEN(b.x)], 1u);
            asm volatile("s_waitcnt vmcnt(0)" ::: "memory");
        } else {
            XB_SPIN(xb_ld(&bar[XB_XGEN(b.x)]) == gen, bar);
            __builtin_amdgcn_fence(__ATOMIC_ACQUIRE, "agent");
            asm volatile("s_waitcnt vmcnt(0)" ::: "memory");
        }
    }
    __syncthreads();
}

namespace pg8 {
#define PG8_LAS __attribute__((address_space(3)))
typedef unsigned short bf16_t;
typedef short bf16x8 __attribute__((ext_vector_type(8)));
typedef float f32x4 __attribute__((ext_vector_type(4)));
typedef unsigned u32x4 __attribute__((ext_vector_type(4)));
typedef int i32x4 __attribute__((ext_vector_type(4)));
typedef unsigned u32x2 __attribute__((ext_vector_type(2)));
constexpr int BM = 256, BK = 64, HALF = 128, HTB = HALF * BK * 2  , STAGE_BYTES = 8 * HTB, NXCD = 8, WGM = 8;

__host__ __device__ __forceinline__ int lds_byte(int r, int c) { const int st = (r >> 4) * 2 + (c >> 5), rr = r & 15, cc = c & 31, ob = rr * 64 + cc * 2; return st * 1024 + (ob ^ (((ob >> 9) & 1) << 5)); }
__host__ __device__ __forceinline__ void stage_rc(int b, int& R, int& C) { const int st = b / 1024, sb = b % 1024, swz = sb ^ (((sb >> 9) & 1) << 5); R = (st >> 1) * 16 + swz / 64; C = (st & 1) * 32 + (swz % 64) / 2; }
__host__ __device__ __forceinline__ int perm32(int rho) { const int n = rho >> 4, i = rho & 15; return 8 * (i >> 2) + 4 * n + (i & 3); }

struct Unit { int pm, pn; size_t bo; int aux; };
struct Gemm { const bf16_t* A; const bf16_t* Bt; int M, N, K; };

struct StaticOrder {
    static constexpr bool GATHER = false;
    int nM, nN, nwg, G, c;
    __host__ __device__ void init(int M, int N, int G_, int c_) { nM = M / BM; nN = N / BM; nwg = nM * nN; G = G_; c = c_; }
    __host__ __device__ bool next(int i, Unit& u) const {
        const long L = (long)i * G + c; if (L >= nwg) return false;
        if (MK_SIMPLE_ORDER) { u.pm = (int)L / nN; u.pn = (int)L % nN; u.bo = 0; u.aux = 0; return true; }
        int wgid = (int)L; { const int q = nwg / NXCD, r = nwg % NXCD, xcd = wgid % NXCD, off = wgid / NXCD; wgid = (xcd < r ? xcd * (q + 1) : r * (q + 1) + (xcd - r) * q) + off; }
        const int nig = WGM * nN, gid = wgid / nig, fm = gid * WGM, gsz = (nM - fm) < WGM ? (nM - fm) : WGM;
        u.pm = fm + ((wgid % nig) % gsz); u.pn = (wgid % nig) / gsz; u.bo = 0; u.aux = 0; return true;
    }
    __device__ __forceinline__ void a_ready(const Unit&) const {}
    __device__ __forceinline__ void done(const Unit&) const {}
};

typedef __bf16 bf16x2_c __attribute__((ext_vector_type(2))); typedef float f32x2_c __attribute__((ext_vector_type(2)));
__device__ __forceinline__ unsigned cvt_pk_bf16(float lo, float hi) { const f32x2_c v = {lo, hi}; return __builtin_bit_cast(unsigned, __builtin_convertvector(v, bf16x2_c)); }
typedef float f32x2 __attribute__((ext_vector_type(2)));
__device__ __forceinline__ f32x2 gelu_pk(f32x2 v) {
    const f32x2 av = __builtin_elementwise_abs(v), d = av * 0.2316418882f + 1.0f;
    f32x2 t; t.x = __builtin_amdgcn_rcpf(d.x); t.y = __builtin_amdgcn_rcpf(d.y);
    f32x2 q = t * 0.5307027145f + (-0.7265760135f); q = q * t + 0.7107068705f; q = q * t + (-0.142248368f); q = q * t + 0.127414796f; q = q * t;
    const f32x2 s = (v * v) * (-0.72134752044f);
    f32x2 e; e.x = __builtin_amdgcn_exp2f(s.x); e.y = __builtin_amdgcn_exp2f(s.y);
    const f32x2 m = v * (q * e), r = v - m;
    f32x2 o; o.x = v.x < 0.f ? m.x : r.x; o.y = v.y < 0.f ? m.y : r.y; return o;
}

template <class Epi, class Sched, bool ALIGN_EPI = false, bool SP2 = false, bool KROT = false, bool FP8 = false>
__device__ __forceinline__ void gemm_phase(PG8_LAS unsigned char* lds, const Gemm g, const Sched& S, const Epi& E, const int wave_id) {
    const int wid = __builtin_amdgcn_readfirstlane(wave_id), lane = lane_id_now(), tid = wid * 64 + lane, wr = wid >> 2, wc = wid & 3, fr = lane & 15, fq = lane >> 4;
    const int K = g.K, nt = K / BK;
    const int kmask = nt - 1, rot = (MK_KROT && KROT) ? (int)((blockIdx.x * 3u + (blockIdx.x >> 3)) & (unsigned)kmask) : 0;
#define PG8_KO(j) ((size_t)(((j) + rot) & kmask) * kstep)
    unsigned voffA[2], voffB[2];
    unsigned vC[2][2], vN[2][2];
#pragma unroll
    for (int i = 0; i < 2; ++i) { int R, C; stage_rc(tid * 16 + i * 8192, R, C); const int Rb = Epi::PERM ? ((R & ~31) + perm32(R & 31)) : R;
        voffA[i] = (unsigned)(R * K + C) * 2u; voffB[i] = (unsigned)(Rb * K + C) * 2u; }
    const size_t kstep = (size_t)(BK * 2);
    const size_t hstep = (size_t)HALF * K * 2;
    const size_t tstep = 2 * hstep;
    const unsigned ldsw = (unsigned)wid * 1024u;
    const int aoff = lds_byte(wr * 64 + fr, fq * 8), boff = lds_byte(wc * 32 + fr, fq * 8);
#define PG8_SA(b, h) (((b) * 2 + (h)) * HTB)
#define PG8_SB(b, h) ((4 + (b) * 2 + (h)) * HTB)
#define PG8_STAGE(bufoff, gbase, voff) do { _Pragma("unroll") for (int _i = 0; _i < 2; ++_i) \
        __builtin_amdgcn_global_load_lds((const unsigned*)((const char*)(gbase) + (voff)[_i]), (PG8_LAS unsigned*)(lds + (bufoff) + ldsw + _i * 8192), 16, 0, 0); } while (0)
#define PG8_STAGE_A(bufoff, gbase, h, nx) do { _Pragma("unroll") for (int _i = 0; _i < 2; ++_i) { \
        const unsigned _vo = Sched::GATHER ? ((nx) ? vN[h][_i] : vC[h][_i]) : (unsigned)((h) * hstep) + voffA[_i]; \
        __builtin_amdgcn_global_load_lds((const unsigned*)((const char*)(gbase) + _vo), (PG8_LAS unsigned*)(lds + (bufoff) + ldsw + _i * 8192), 16, 0, 0); } } while (0)
#define PG8_LDA(dst, b, h) do { _Pragma("unroll") for (int m = 0; m < 4; ++m) { if constexpr (FP8) { dst[m].lo = *(const PG8_LAS i32x4*)(lds + PG8_SA(b, h) + aoff + m * 2048); dst[m].hi = *(const PG8_LAS i32x4*)(lds + PG8_SA(b, h) + aoff + m * 2048 + 1024); } \
        else { _Pragma("unroll") for (int k = 0; k < 2; ++k) dst[m][k] = *(const PG8_LAS bf16x8*)(lds + PG8_SA(b, h) + aoff + m * 2048 + k * 1024); } } } while (0)
#define PG8_LDB(dst, b, h) do { _Pragma("unroll") for (int n = 0; n < 2; ++n) { if constexpr (FP8) { dst[n].lo = *(const PG8_LAS i32x4*)(lds + PG8_SB(b, h) + boff + n * 2048); dst[n].hi = *(const PG8_LAS i32x4*)(lds + PG8_SB(b, h) + boff + n * 2048 + 1024); } \
        else { _Pragma("unroll") for (int k = 0; k < 2; ++k) dst[n][k] = *(const PG8_LAS bf16x8*)(lds + PG8_SB(b, h) + boff + n * 2048 + k * 1024); } } } while (0)
#define PG8_CAT(x0, x1) __builtin_shufflevector(__builtin_bit_cast(i32x4, x0), __builtin_bit_cast(i32x4, x1), 0, 1, 2, 3, 4, 5, 6, 7)
#define PG8_MMA(ai, bj, At, Bt) do { __builtin_amdgcn_s_setprio(1); \
        if constexpr (FP8) { _Pragma("unroll") for (int m = 0; m < 4; ++m) _Pragma("unroll") for (int n = 0; n < 2; ++n) \
            acc[ai][bj][m][n] = __builtin_amdgcn_mfma_scale_f32_16x16x128_f8f6f4(Bt[n], At[m], acc[ai][bj][m][n], 0, 0, 0, 127, 0, 127); } \
        if constexpr (FP8) { asm volatile("" : "+v"(acc[ai][bj][0][0]), "+v"(acc[ai][bj][0][1]), "+v"(acc[ai][bj][1][0]), "+v"(acc[ai][bj][1][1]), "+v"(acc[ai][bj][2][0]), "+v"(acc[ai][bj][2][1]), "+v"(acc[ai][bj][3][0]), "+v"(acc[ai][bj][3][1])); }     \
        else { _Pragma("unroll") for (int m = 0; m < 4; ++m) _Pragma("unroll") for (int n = 0; n < 2; ++n) _Pragma("unroll") for (int k = 0; k < 2; ++k) \
            acc[ai][bj][m][n] = __builtin_amdgcn_mfma_f32_16x16x32_bf16(Bt[n][k], At[m][k], acc[ai][bj][m][n], 0, 0, 0); } \
        __builtin_amdgcn_s_setprio(0); } while (0)
#define PG8_WAIT_V(n) asm volatile("s_waitcnt vmcnt(" #n ")" ::: "memory")
#define PG8_WAIT_L(n) asm volatile("s_waitcnt lgkmcnt(" #n ")" ::: "memory")
#define PG8_BAR __builtin_amdgcn_s_barrier()
#define PG8_SCHED __builtin_amdgcn_sched_barrier(0)
    Unit cur, nxt; int ui = 0;
    if (!S.next(0, cur)) return;
    f32x4 acc[2][2][4][2];
#pragma unroll
    for (int a = 0; a < 2; ++a)
#pragma unroll
        for (int b = 0; b < 2; ++b)
#pragma unroll
            for (int m = 0; m < 4; ++m)
#pragma unroll
                for (int n = 0; n < 2; ++n) acc[a][b][m][n] = (f32x4){0.f, 0.f, 0.f, 0.f};
    typedef int i32x8 __attribute__((ext_vector_type(8)));
    typedef int i32x8 __attribute__((ext_vector_type(8)));
    typename std::conditional<FP8, i32x8[4], bf16x8[4][2]>::type At; typename std::conditional<FP8, i32x8[2], bf16x8[2][2]>::type B0, B1;
    const char* cA = (const char*)g.A + (Sched::GATHER ? (size_t)0 : (size_t)cur.pm * tstep); const char* cB = (const char*)g.Bt + cur.bo + (size_t)cur.pn * tstep;
    S.a_ready(cur);
#define PG8_VOFF(dst, un) do { _Pragma("unroll") for (int _h = 0; _h < 2; ++_h) _Pragma("unroll") for (int _i = 0; _i < 2; ++_i) { int R_, C_; stage_rc(tid * 16 + _i * 8192, R_, C_); dst[_h][_i] = S.a_off(un, _h * HALF + R_) + (unsigned)C_ * 2u; } } while (0)
    if constexpr (Sched::GATHER) { PG8_VOFF(vC, cur); }
    if constexpr (SP2) {
        PG8_STAGE(PG8_SB(0, 0), cB + PG8_KO(0), voffB); PG8_STAGE(PG8_SB(0, 1), cB + hstep + PG8_KO(0), voffB); PG8_STAGE_A(PG8_SA(0, 0), cA + PG8_KO(0), 0, false); PG8_STAGE_A(PG8_SA(0, 1), cA + PG8_KO(0), 1, false);
        if (wr == 1) PG8_BAR;
        PG8_WAIT_V(2); PG8_BAR;
        PG8_STAGE(PG8_SB(1, 0), cB + PG8_KO(1), voffB); PG8_STAGE_A(PG8_SA(1, 0), cA + PG8_KO(1), 0, false); PG8_STAGE(PG8_SB(1, 1), cB + hstep + PG8_KO(1), voffB);
        PG8_WAIT_V(6); PG8_BAR;
    } else {
        PG8_STAGE(PG8_SB(0, 0), cB, voffB); PG8_STAGE_A(PG8_SA(0, 0), cA, 0, false); PG8_STAGE(PG8_SB(0, 1), cB + hstep, voffB); PG8_STAGE_A(PG8_SA(0, 1), cA, 1, false);
        if (wr == 1) PG8_BAR;
        PG8_WAIT_V(4); PG8_BAR;
        PG8_STAGE(PG8_SB(1, 0), cB + PG8_KO(1), voffB); PG8_STAGE_A(PG8_SA(1, 0), cA + PG8_KO(1), 0, false); PG8_STAGE(PG8_SB(1, 1), cB + hstep + PG8_KO(1), voffB);
        PG8_WAIT_V(6); PG8_BAR;
    }
    for (;;) {
        const bool has_next = S.next(ui + 1, nxt);
        if constexpr (Sched::GATHER) { if (has_next) { PG8_VOFF(vN, nxt); } else { vN[0][0] = vC[0][0]; vN[0][1] = vC[0][1]; vN[1][0] = vC[1][0]; vN[1][1] = vC[1][1]; } }
        const char* nA = (has_next && !Sched::GATHER) ? (const char*)g.A + (size_t)nxt.pm * tstep : cA; const char* nB = has_next ? (const char*)g.Bt + nxt.bo + (size_t)nxt.pn * tstep : cB;
#pragma unroll 1
        for (int t = 0; t < nt; t += 2) {
            const bool last = (t == nt - 2);
            const char* a1 = cA + PG8_KO(t + 1);
            const char* a2 = last ? nA + PG8_KO(0) : cA + PG8_KO(t + 2); const char* b2 = last ? nB + PG8_KO(0) : cB + PG8_KO(t + 2);
            const char* a3 = last ? nA + PG8_KO(1) : cA + PG8_KO(t + 3); const char* b3 = last ? nB + PG8_KO(1) : cB + PG8_KO(t + 3);
            if (last && has_next) S.a_ready(nxt);
            if constexpr (SP2) {
            PG8_LDB(B0, 0, 0); PG8_LDB(B1, 0, 1); PG8_SCHED; PG8_LDA(At, 0, 0); PG8_STAGE_A(PG8_SA(1, 1), a1, 1, false);
            PG8_WAIT_V(8); PG8_WAIT_L(0); PG8_BAR; PG8_MMA(0, 0, At, B0); PG8_MMA(0, 1, At, B1); PG8_BAR; PG8_SCHED;
            PG8_LDA(At, 0, 1); PG8_STAGE(PG8_SB(0, 0), b2, voffB); PG8_STAGE(PG8_SB(0, 1), b2 + hstep, voffB); PG8_STAGE_A(PG8_SA(0, 0), a2, 0, last);
            PG8_WAIT_V(8); PG8_WAIT_L(0); PG8_BAR; PG8_MMA(1, 0, At, B0); PG8_MMA(1, 1, At, B1); PG8_BAR; PG8_SCHED;
            PG8_LDB(B0, 1, 0); PG8_LDB(B1, 1, 1); PG8_SCHED; PG8_LDA(At, 1, 0); PG8_STAGE_A(PG8_SA(0, 1), a2, 1, last);
            PG8_WAIT_V(8); PG8_WAIT_L(0); PG8_BAR; PG8_MMA(0, 0, At, B0); PG8_MMA(0, 1, At, B1); PG8_BAR; PG8_SCHED;
            PG8_LDA(At, 1, 1); PG8_STAGE(PG8_SB(1, 0), b3, voffB); PG8_STAGE(PG8_SB(1, 1), b3 + hstep, voffB); PG8_STAGE_A(PG8_SA(1, 0), a3, 0, last);
            PG8_WAIT_V(8); PG8_WAIT_L(0); PG8_BAR; PG8_MMA(1, 0, At, B0); PG8_MMA(1, 1, At, B1); PG8_BAR; PG8_SCHED;
            } else {
            PG8_LDB(B0, 0, 0); PG8_SCHED; PG8_LDA(At, 0, 0); PG8_STAGE_A(PG8_SA(1, 1), a1, 1, false);
            PG8_WAIT_L(8); PG8_BAR; PG8_WAIT_L(0); PG8_MMA(0, 0, At, B0); PG8_BAR; PG8_SCHED;
            PG8_LDB(B1, 0, 1); PG8_STAGE(PG8_SB(0, 0), b2, voffB);
            PG8_BAR; PG8_WAIT_L(0); PG8_MMA(0, 1, At, B1); PG8_BAR;
            PG8_LDA(At, 0, 1); PG8_STAGE_A(PG8_SA(0, 0), a2, 0, last);
            PG8_BAR; PG8_WAIT_L(0); PG8_MMA(1, 0, At, B0); PG8_BAR; PG8_SCHED;
            PG8_STAGE(PG8_SB(0, 1), b2 + hstep, voffB);
            PG8_WAIT_V(6); PG8_BAR; PG8_MMA(1, 1, At, B1); PG8_BAR;
            PG8_LDB(B0, 1, 0); PG8_SCHED; PG8_LDA(At, 1, 0); PG8_STAGE_A(PG8_SA(0, 1), a2, 1, last);
            PG8_WAIT_L(8); PG8_BAR; PG8_WAIT_L(0); PG8_MMA(0, 0, At, B0); PG8_BAR; PG8_SCHED;
            PG8_LDB(B1, 1, 1); PG8_STAGE(PG8_SB(1, 0), b3, voffB);
            PG8_BAR; PG8_WAIT_L(0); PG8_MMA(0, 1, At, B1); PG8_BAR;
            PG8_LDA(At, 1, 1); PG8_STAGE_A(PG8_SA(1, 0), a3, 0, last);
            PG8_BAR; PG8_WAIT_L(0); PG8_MMA(1, 0, At, B0); PG8_BAR; PG8_SCHED;
            PG8_STAGE(PG8_SB(1, 1), b3 + hstep, voffB);
            PG8_WAIT_V(6); PG8_BAR; PG8_MMA(1, 1, At, B1); PG8_BAR;
            }
        }
        if constexpr (ALIGN_EPI) { if (wr == 0) PG8_BAR; }
        if constexpr (!Epi::AFTER_DRAIN) { E(acc, cur, wr, wc, fr, fq); S.done(cur); }
        if (!has_next) break;
#pragma unroll
        for (int a = 0; a < 2; ++a)
#pragma unroll
            for (int b = 0; b < 2; ++b)
#pragma unroll
                for (int m = 0; m < 4; ++m)
#pragma unroll
                    for (int n = 0; n < 2; ++n) acc[a][b][m][n] = (f32x4){0.f, 0.f, 0.f, 0.f};
        cur = nxt; cA = nA; cB = nB; ++ui;
        if constexpr (Sched::GATHER) { vC[0][0] = vN[0][0]; vC[0][1] = vN[0][1]; vC[1][0] = vN[1][0]; vC[1][1] = vN[1][1]; }
        if constexpr (ALIGN_EPI) { if (wr == 1) PG8_BAR; }
    }
    PG8_WAIT_V(0);
    if constexpr (!ALIGN_EPI) { if (wr == 0) PG8_BAR; }
    PG8_BAR;
    if constexpr (Epi::AFTER_DRAIN) { E.fused(acc, cur, wr, wc, fr, fq, lds, wid, lane); S.done(cur); }
#undef PG8_VOFF
#undef PG8_KO
#undef PG8_SA
#undef PG8_SB
#undef PG8_STAGE
#undef PG8_STAGE_A
#undef PG8_LDA
#undef PG8_LDB
#undef PG8_MMA
#undef PG8_CAT
#undef PG8_WAIT_V
#undef PG8_WAIT_L
#undef PG8_BAR
#undef PG8_SCHED
}
}

namespace pg8 {
template <bool GATHER_>
struct GroupedOrder {
    static constexpr bool GATHER = GATHER_;
    const PG8_LAS int* tmap; const PG8_LAS int* cntl; const int* list; int nU, nN, G, c, lcap, rowbytes; size_t estride;
    __device__ __forceinline__ bool next(int i, Unit& u) const { const int ntl = nU / nN, n8 = (ntl + 7) >> 3, x = c & 7, t0 = x * n8; int nt = ntl - t0; nt = nt < 0 ? 0 : (nt > n8 ? n8 : nt);
        const int v = (c >> 3) + (G >> 3) * i; if ((G & 7) != 0 || v >= nt * nN) { if ((G & 7) == 0) return false; const long L = (long)i * G + c; if (L >= nU) return false; const int t_ = (int)L / nN; const int m_ = __builtin_amdgcn_readfirstlane(tmap[t_]); u.pm = t_; u.pn = (int)L % nN; u.bo = (size_t)(m_ & 255) * estride; u.aux = m_; return true; }
        const int t = t0 + v / nN; const int m = __builtin_amdgcn_readfirstlane(tmap[t]);
        u.pm = t; u.pn = v % nN; u.bo = (size_t)(m & 255) * estride; u.aux = m; return true; }
    __device__ __forceinline__ unsigned a_off(const Unit& u, int R) const { const int e = u.aux & 255, p0 = u.aux >> 8, ce = cntl[e]; int p = p0 + R; p = p < ce ? p : ce - 1; return (unsigned)list[(size_t)e * lcap + p] * (unsigned)rowbytes; }
    __device__ __forceinline__ void a_ready(const Unit&) const {}
    __device__ __forceinline__ void done(const Unit&) const {}
};
__device__ __forceinline__ u32x4 pack8(const f32x4 a, const f32x4 b) { u32x4 w; w.x = cvt_pk_bf16(a[0], a[1]); w.y = cvt_pk_bf16(a[2], a[3]); w.z = cvt_pk_bf16(b[0], b[1]); w.w = cvt_pk_bf16(b[2], b[3]); return w; }
struct EpiStore {
    static constexpr bool PERM = true, AFTER_DRAIN = false; bf16_t* O; int ldc; float s;
    __device__ __forceinline__ void operator()(const f32x4 (&acc)[2][2][4][2], const Unit& u, int wr, int wc, int, int) const {
        const int ln = lane_id_now(), fr = ln & 15, fq = ln >> 4;
        const int row0 = u.pm * BM + wr * 64 + fr, col0 = u.pn * BM + wc * 32 + 8 * fq;
#pragma unroll
        for (int ai = 0; ai < 2; ++ai)
#pragma unroll
            for (int m = 0; m < 4; ++m) { bf16_t* rowp = O + (size_t)(row0 + ai * HALF + m * 16) * ldc + col0;
#pragma unroll
                for (int bj = 0; bj < 2; ++bj) *(u32x4*)(rowp + bj * HALF) = pack8(acc[ai][bj][m][0] * s, acc[ai][bj][m][1] * s); }
    }
};

struct EpiInProj {
    static constexpr bool PERM = true, AFTER_DRAIN = false;
    bf16_t* O; bf16_t* Kb; bf16_t* Vb; const float* kg; const float* rope; PG8_LAS float* xch;
    float s;
    float* part;
    __device__ __forceinline__ void operator()(const f32x4 (&acc)[2][2][4][2], const Unit& u, int wr, int wc, int, int) const {
        const int ln = lane_id_now(), fr = ln & 15, fq = ln >> 4;
        if (u.pn != 2) {
            const int row0 = u.pm * BM + wr * 64 + fr, col0 = u.pn * BM + wc * 32 + 8 * fq;
            if (u.pn < 2) {
#pragma unroll
                for (int ai = 0; ai < 2; ++ai)
#pragma unroll
                    for (int m = 0; m < 4; ++m) { bf16_t* rowp = O + (size_t)(row0 + ai * HALF + m * 16) * 1792 + col0;
#pragma unroll
                        for (int bj = 0; bj < 2; ++bj) *(u32x4*)(rowp + bj * HALF) = pack8(acc[ai][bj][m][0] * s, acc[ai][bj][m][1] * s); }
                return;
            }
            const bool stats = u.pn >= 5;
#pragma unroll
            for (int ai = 0; ai < 2; ++ai)
#pragma unroll
                for (int m = 0; m < 4; ++m) { bf16_t* rowp = O + (size_t)(row0 + ai * HALF + m * 16) * 1792 + col0; float s1 = 0.f, s2 = 0.f;
#pragma unroll
                    for (int bj = 0; bj < 2; ++bj) { f32x4 ga, gb;
#pragma unroll
                        for (int i = 0; i < 4; ++i) { const float x = acc[ai][bj][m][0][i] * s, y = acc[ai][bj][m][1][i] * s;
                            ga[i] = x * __builtin_amdgcn_rcpf(1.f + __expf(-1.5957691216057308f * (x + 0.044715f * x * x * x)));
                            gb[i] = y * __builtin_amdgcn_rcpf(1.f + __expf(-1.5957691216057308f * (y + 0.044715f * y * y * y))); }
                        const u32x4 w = pack8(ga, gb); *(u32x4*)(rowp + bj * HALF) = w;
                        if (stats) { const float r0 = __uint_as_float(w.x << 16), r1 = __uint_as_float(w.x & 0xffff0000u), r2 = __uint_as_float(w.y << 16), r3 = __uint_as_float(w.y & 0xffff0000u),
                                                 r4 = __uint_as_float(w.z << 16), r5 = __uint_as_float(w.z & 0xffff0000u), r6 = __uint_as_float(w.w << 16), r7 = __uint_as_float(w.w & 0xffff0000u);
                            s1 += ((r0 + r1) + (r2 + r3)) + ((r4 + r5) + (r6 + r7)); s2 += ((r0 * r0 + r1 * r1) + (r2 * r2 + r3 * r3)) + ((r4 * r4 + r5 * r5) + (r6 * r6 + r7 * r7)); } }
                    if (stats) { s1 += __shfl_xor(s1, 16); s1 += __shfl_xor(s1, 32); s2 += __shfl_xor(s2, 16); s2 += __shfl_xor(s2, 32);
                        if (fq == 0) { float* pp = part + ((size_t)(row0 + ai * HALF + m * 16) * 8 + (u.pn - 5) * 4 + wc) * 2; pp[0] = s1; pp[1] = s2; } } }
            return;
        }
        const int R0 = u.pm * BM; const bool lat = R0 < 32768;
        const size_t kvbase = lat ? (size_t)(R0 >> 11) * 2304 + 256 + (R0 & 2047) : (size_t)((R0 - 32768) >> 8) * 2304;
#pragma unroll
        for (int ai = 0; ai < 2; ++ai)
#pragma unroll
            for (int m = 0; m < 4; ++m) { const f32x4 a = acc[ai][0][m][0], b = acc[ai][0][m][1];
                float sq = (a[0] * a[0] + a[1] * a[1]) + (a[2] * a[2] + a[3] * a[3]) + (b[0] * b[0] + b[1] * b[1]) + (b[2] * b[2] + b[3] * b[3]);
                sq += __shfl_xor(sq, 16); sq += __shfl_xor(sq, 32);
                if (fq == 0) xch[(ai * HALF + wr * 64 + m * 16 + fr) * 4 + wc] = sq; }
        asm volatile("s_waitcnt lgkmcnt(0)\n\ts_barrier" ::: "memory");
        const int dh = 32 * (wc & 1) + 8 * fq;
        const f32x4 g0 = *(const f32x4*)(kg + dh), g1 = *(const f32x4*)(kg + dh + 4);
        const bool x2 = (fq & 2) != 0;
#pragma unroll
        for (int ai = 0; ai < 2; ++ai)
#pragma unroll
            for (int m = 0; m < 4; ++m) { const int rl = ai * HALF + wr * 64 + m * 16 + fr;
                const float tot = xch[rl * 4 + wc] + xch[rl * 4 + (wc ^ 1)]; const float rs = rsqrtf(tot * (s * s * (1.f / 64.f)) + 1e-6f) * s;
                f32x4 a = acc[ai][0][m][0] * rs * g0, b = acc[ai][0][m][1] * rs * g1;
                f32x4 pa, pb;
#pragma unroll
                for (int i = 0; i < 4; ++i) { pa[i] = __shfl_xor(a[i], 32); pb[i] = __shfl_xor(b[i], 32); }
                if (lat) { const int t = (R0 & 2047) + rl; const int pos = (wc & 1) ? (t & 63) : (t >> 6);
                    const float* rp = rope + ((size_t)pos * 16 + 8 * (fq & 1)) * 2;
                    const f32x4 c0 = *(const f32x4*)(rp), c1 = *(const f32x4*)(rp + 4), c2 = *(const f32x4*)(rp + 8), c3 = *(const f32x4*)(rp + 12);
                    const f32x4 cs = {c0[0], c0[2], c1[0], c1[2]}, sn = {c0[1], c0[3], c1[1], c1[3]}, cs2 = {c2[0], c2[2], c3[0], c3[2]}, sn2 = {c2[1], c2[3], c3[1], c3[3]};
                    a = x2 ? (a * cs + pa * sn) : (a * cs - pa * sn); b = x2 ? (b * cs2 + pb * sn2) : (b * cs2 - pb * sn2); }
                const size_t o = (kvbase + rl) * 128 + 32 * wc + 8 * fq;
                *(u32x4*)(Kb + o) = pack8(a, b); *(u32x4*)(Vb + o) = pack8(acc[ai][1][m][0] * s, acc[ai][1][m][1] * s); }
        asm volatile("s_waitcnt lgkmcnt(0)\n\ts_barrier" ::: "memory");
    }
};
__device__ __forceinline__ f32x4 silu4(const f32x4 v) { f32x4 r;
#pragma unroll
    for (int i = 0; i < 4; ++i) r[i] = v[i] * __builtin_amdgcn_rcpf(1.f + __expf(-v[i])); return r; }
__device__ __forceinline__ f32x4 sigm4(const f32x4 v) { f32x4 r;
#pragma unroll
    for (int i = 0; i < 4; ++i) r[i] = __builtin_amdgcn_rcpf(1.f + __expf(-v[i])); return r; }
__device__ __forceinline__ u32x2 pack8_fp8(const f32x4 a, const f32x4 b) { int w0 = 0, w1 = 0;
    w0 = __builtin_amdgcn_cvt_pk_fp8_f32(a[0], a[1], w0, false); w0 = __builtin_amdgcn_cvt_pk_fp8_f32(a[2], a[3], w0, true);
    w1 = __builtin_amdgcn_cvt_pk_fp8_f32(b[0], b[1], w1, false); w1 = __builtin_amdgcn_cvt_pk_fp8_f32(b[2], b[3], w1, true); u32x2 r; r.x = (unsigned)w0; r.y = (unsigned)w1; return r; }
__device__ __forceinline__ f32x4 clamp8(const f32x4 v) { f32x4 r;
#pragma unroll
    for (int i = 0; i < 4; ++i) r[i] = __builtin_amdgcn_fmed3f(v[i], -448.f, 448.f); return r; }
struct EpiSwiglu {
    static constexpr bool PERM = true, AFTER_DRAIN = false; unsigned char* G; float s, so;
    __device__ __forceinline__ void operator()(const f32x4 (&acc)[2][2][4][2], const Unit& u, int wr, int wc, int, int) const {
        const int ln = lane_id_now(), fr = ln & 15, fq = ln >> 4;
        const int row0 = u.pm * BM + wr * 64 + fr, col0 = u.pn * HALF + wc * 32 + 8 * fq;
#pragma unroll
        for (int ai = 0; ai < 2; ++ai)
#pragma unroll
            for (int m = 0; m < 4; ++m) *(u32x2*)(G + (size_t)(row0 + ai * HALF + m * 16) * 512 + col0) = pack8_fp8(clamp8(silu4(acc[ai][0][m][0] * s) * (acc[ai][1][m][0] * (s * so))), clamp8(silu4(acc[ai][0][m][1] * s) * (acc[ai][1][m][1] * (s * so))));
    }
};
__device__ __forceinline__ void unpack8f(const u32x4 w, f32x4& a, f32x4& b) {
    a[0] = __uint_as_float(w.x << 16); a[1] = __uint_as_float(w.x & 0xffff0000u); a[2] = __uint_as_float(w.y << 16); a[3] = __uint_as_float(w.y & 0xffff0000u);
    b[0] = __uint_as_float(w.z << 16); b[1] = __uint_as_float(w.z & 0xffff0000u); b[2] = __uint_as_float(w.w << 16); b[3] = __uint_as_float(w.w & 0xffff0000u); }
struct EpiGlu {
    static constexpr bool PERM = true, AFTER_DRAIN = false; const bf16_t* GS; const float* b; bf16_t* GG;
    __device__ __forceinline__ void operator()(const f32x4 (&acc)[2][2][4][2], const Unit& u, int wr, int wc, int fr, int fq) const {
        const int row0 = u.pm * BM + wr * 64 + fr, col0 = u.pn * BM + wc * 32 + 8 * fq;
#pragma unroll
        for (int bj = 0; bj < 2; ++bj) { const int c = col0 + bj * HALF; const f32x4 b0 = *(const f32x4*)(b + c), b1 = *(const f32x4*)(b + c + 4);
#pragma unroll
            for (int ai = 0; ai < 2; ++ai)
#pragma unroll
                for (int m = 0; m < 4; ++m) { const size_t o = (size_t)(row0 + ai * HALF + m * 16) * 512 + c; f32x4 g0, g1; unpack8f(*(const u32x4*)(GS + o), g0, g1);
                    *(u32x4*)(GG + o) = pack8(g0 * sigm4(acc[ai][bj][m][0] + b0), g1 * sigm4(acc[ai][bj][m][1] + b1)); } }
    }
};
struct EpiResid {
    static constexpr bool PERM = true, AFTER_DRAIN = false;
    const float* x; const float* ctx; const float* mod; bf16_t* XC; int inplace;
    __device__ __forceinline__ void operator()(const f32x4 (&acc)[2][2][4][2], const Unit& u, int wr, int wc, int fr, int fq) const {
        const int R0 = u.pm * BM; const int ci = R0 < 32768 ? (R0 >> 11) : 16;
        const float* base = R0 < 32768 ? x + (size_t)R0 * 1024 : ctx + (size_t)(R0 - 32768) * 1024;
        bf16_t* out = XC + (size_t)R0 * 1024; const float* gate = mod + ((size_t)ci * 6 + 2) * 1024;
        const int rl0 = wr * 64 + fr, col0 = u.pn * BM + wc * 32 + 8 * fq;
#pragma unroll
        for (int bj = 0; bj < 2; ++bj) { const int c = col0 + bj * HALF; const f32x4 g0 = *(const f32x4*)(gate + c), g1 = *(const f32x4*)(gate + c + 4);
#pragma unroll
            for (int ai = 0; ai < 2; ++ai)
#pragma unroll
                for (int m = 0; m < 4; ++m) { const size_t o = (size_t)(rl0 + ai * HALF + m * 16) * 1024 + c; f32x4 b0, b1;
                    if (inplace) unpack8f(*(const u32x4*)(out + o), b0, b1); else { b0 = *(const f32x4*)(base + o); b1 = *(const f32x4*)(base + o + 4); }
                    *(u32x4*)(out + o) = pack8(b0 + g0 * acc[ai][bj][m][0], b1 + g1 * acc[ai][bj][m][1]); } }
    }
};
}

#include <hip/hip_bf16.h>
#include <cmath>
namespace attn_body {
using bf16=__hip_bfloat16;
using bf16x8=__attribute__((ext_vector_type(8)))short;
using s16x4=__attribute__((ext_vector_type(4)))short;
using f32x16=__attribute__((ext_vector_type(16)))float;
using u32x4=__attribute__((ext_vector_type(4)))unsigned;
constexpr int D=64,QP=1792,KP=128,OP=1024;
constexpr int NW=8,QBLK=32,QB=QBLK*NW,KVBLK=64;
constexpr int ATTN_UNIT_ROWS=QB;
__device__ __forceinline__ int crow(int r,int hi){return (r&3)+8*(r>>2)+4*hi;}
#define SBAR() __builtin_amdgcn_sched_barrier(0)
__device__ __forceinline__ void cmask(f32x16&p0,f32x16&p1,int jb,int qrel,int hi){
  const float NEG=-INFINITY; int kb=64*jb+4*hi;
  #pragma unroll
  for(int r=0;r<16;++r){int kv=kb+(r&3)+8*(r>>2); if(kv>qrel)p0[r]=NEG; if(kv+32>qrel)p1[r]=NEG;}
}

constexpr int NSLOT=3, SLOTB=8192;
constexpr int LDS_K=0, LDS_V=NSLOT*SLOTB, LDS_WS=2*NSLOT*SLOTB, LDS_OST=LDS_WS+NW*64*4, LDS_BYTES=LDS_OST+NW*4096;
constexpr float C2=0.125f*1.4426950408889634f;
__device__ __forceinline__ void glds16(const void*gsrc,unsigned lds_dst){unsigned keep;
  asm volatile("s_mov_b32 %0, m0\n\ts_mov_b32 m0, %2\n\ts_nop 0\n\tglobal_load_lds_dwordx4 %1, off\n\ts_mov_b32 m0, %0":"=&s"(keep):"v"(gsrc),"s"(lds_dst):"memory");}
__device__ __forceinline__ float max3f(float a,float b,float c){float r;asm("v_max3_f32 %0, %1, %2, %3":"=v"(r):"v"(a),"v"(b),"v"(c));return r;}
__device__ __forceinline__ float max2f(float a,float b){float r;asm("v_max_f32_e32 %0, %1, %2":"=v"(r):"v"(a),"v"(b));return r;}
__device__ __forceinline__ float fadd_s(float a,float b){float r;asm("v_add_f32_e32 %0, %1, %2":"=v"(r):"v"(a),"v"(b));return r;}
__device__ __forceinline__ float fsub_s(float a,float b){float r;asm("v_sub_f32_e32 %0, %1, %2":"=v"(r):"v"(a),"v"(b));return r;}
typedef float f32x2_t __attribute__((ext_vector_type(2))); typedef __bf16 bf16x2_t __attribute__((ext_vector_type(2)));
__device__ __forceinline__ unsigned cvtpk_s(float lo,float hi){f32x2_t v={lo,hi};bf16x2_t b=__builtin_convertvector(v,bf16x2_t);return __builtin_bit_cast(unsigned,b);}
#define WAIT_BAR(N) asm volatile("s_waitcnt vmcnt(" #N ") lgkmcnt(0)\n\ts_barrier":::"memory")

__device__ __forceinline__ void qkt(f32x16&p0,f32x16&p1,const char*Kslot,const bf16x8*qr,const f32x16&negm,int r32,int hi){
  const char*kb=Kslot+hi*1024+r32*16;
  #pragma unroll
  for(int d0=0;d0<4;++d0){
    const bf16x8 b0=*reinterpret_cast<const bf16x8*>(kb+d0*2048);
    const bf16x8 b1=*reinterpret_cast<const bf16x8*>(kb+d0*2048+512);
    if(d0==0){p0=__builtin_amdgcn_mfma_f32_32x32x16_bf16(b0,qr[0],negm,0,0,0);p1=__builtin_amdgcn_mfma_f32_32x32x16_bf16(b1,qr[0],negm,0,0,0);}
    else{p0=__builtin_amdgcn_mfma_f32_32x32x16_bf16(b0,qr[d0],p0,0,0,0);p1=__builtin_amdgcn_mfma_f32_32x32x16_bf16(b1,qr[d0],p1,0,0,0);}}
}
typedef __attribute__((address_space(3))) const char* lds_cptr;
typedef short v4i16_t __attribute__((ext_vector_type(4)));
__device__ __forceinline__ void kload8(bf16x8*kf,lds_cptr kp){
  kf[0]=*(const __attribute__((address_space(3))) bf16x8*)(kp);      kf[1]=*(const __attribute__((address_space(3))) bf16x8*)(kp+512);
  kf[2]=*(const __attribute__((address_space(3))) bf16x8*)(kp+2048); kf[3]=*(const __attribute__((address_space(3))) bf16x8*)(kp+2560);
  kf[4]=*(const __attribute__((address_space(3))) bf16x8*)(kp+4096); kf[5]=*(const __attribute__((address_space(3))) bf16x8*)(kp+4608);
  kf[6]=*(const __attribute__((address_space(3))) bf16x8*)(kp+6144); kf[7]=*(const __attribute__((address_space(3))) bf16x8*)(kp+6656);
}
__device__ __forceinline__ void kload2(bf16x8*kf,lds_cptr kp,int j){ kf[2*j]=*(const __attribute__((address_space(3))) bf16x8*)(kp+j*2048); kf[2*j+1]=*(const __attribute__((address_space(3))) bf16x8*)(kp+j*2048+512); }
__device__ __forceinline__ s16x4 vtr(lds_cptr p){ return __builtin_bit_cast(s16x4,__builtin_amdgcn_ds_read_tr16_b64_v4i16((__attribute__((address_space(3))) v4i16_t*)p)); }
__device__ __forceinline__ float rowmax(const f32x16&p0,const f32x16&p1){
  float a=max3f(p0[0],p0[1],p1[0]),b=max3f(p0[2],p0[3],p1[1]);a=max3f(a,p1[2],p1[3]);
  #pragma unroll
  for(int r=4;r<16;r+=4){a=max3f(a,p0[r],p0[r+1]);b=max3f(b,p0[r+2],p0[r+3]);a=max3f(a,p1[r],p1[r+1]);b=max3f(b,p1[r+2],p1[r+3]);}
  const float m=max2f(a,b);
  auto rr=__builtin_amdgcn_permlane32_swap(__float_as_uint(m),__float_as_uint(m),false,false);
  return max2f(__uint_as_float(rr[0]),__uint_as_float(rr[1]));
}
__device__ __forceinline__ void pv(f32x16*o,int vb,bf16x8 pa0,bf16x8 pa1,bf16x8 pa2,bf16x8 pa3){
  #pragma unroll
  for(int d0=0;d0<2;++d0){s16x4 lo[4],hi[4];
    #pragma unroll
    for(int ks=0;ks<4;++ks){
      asm volatile("ds_read_b64_tr_b16 %0,%1 offset:%c2":"=&v"(lo[ks]):"v"(vb),"i"(d0*4096+ks*1024):"memory");
      asm volatile("ds_read_b64_tr_b16 %0,%1 offset:%c2":"=&v"(hi[ks]):"v"(vb),"i"(d0*4096+ks*1024+512):"memory");}
    asm volatile("s_waitcnt lgkmcnt(0)":::"memory");SBAR();
    #define PK(k) (bf16x8){lo[k][0],lo[k][1],lo[k][2],lo[k][3],hi[k][0],hi[k][1],hi[k][2],hi[k][3]}
    o[d0]=__builtin_amdgcn_mfma_f32_32x32x16_bf16(pa0,PK(0),o[d0],0,0,0);
    o[d0]=__builtin_amdgcn_mfma_f32_32x32x16_bf16(pa1,PK(1),o[d0],0,0,0);
    o[d0]=__builtin_amdgcn_mfma_f32_32x32x16_bf16(pa2,PK(2),o[d0],0,0,0);
    o[d0]=__builtin_amdgcn_mfma_f32_32x32x16_bf16(pa3,PK(3),o[d0],0,0,0);
    #undef PK
  }
}

#ifndef ATTN_STORE16
#define ATTN_STORE16(p,v) (*(u32x4*)(p)=(v))
#endif
template<int THRL> __device__ __forceinline__ void attn_unit(const bf16*Q0,const bf16*__restrict__ Kh,const bf16*__restrict__ Vh,bf16*O0,const int NT,char*shm,const float*qg,const float2*rope,const int tq0){
  const int tid=threadIdx.x,lane=tid&63,r32=lane&31,hi=lane>>5; const int wid=__builtin_amdgcn_readfirstlane(tid>>6);
  const bf16*Qw=Q0+(long)(wid*QBLK)*QP;
  const unsigned lds0=(unsigned)(uintptr_t)shm;
  float*wsf=(float*)(shm+LDS_WS)+wid*64;
  const bf16*ksrc=Kh+(long)lane*KP+wid*8;
  const bf16*vsrc=Vh+(long)(16*(wid&3)+(lane>>2))*KP+(wid>>2)*32+(lane&3)*8;
  const unsigned kdst=lds0+LDS_K+wid*1024, vdst=lds0+LDS_V+wid*1024;
  #define DMA_K(t,slot) glds16(ksrc+(long)(t)*KVBLK*KP,(unsigned)__builtin_amdgcn_readfirstlane(kdst+(slot)))
  #define DMA_V(t,slot) glds16(vsrc+(long)(t)*KVBLK*KP,(unsigned)__builtin_amdgcn_readfirstlane(vdst+(slot)))
  const int vb0=(int)(lds0+LDS_V)+((lane>>4)&1)*32+(lane&3)*8+(4*hi+((lane&15)>>2))*64;
  const char*Kbase=shm+LDS_K; bf16x8 kf[8];
  const lds_cptr shm3=(lds_cptr)shm; const lds_cptr kp0=shm3+LDS_K+hi*1024+r32*16; const lds_cptr vp0=shm3+LDS_V+((lane>>4)&1)*32+(lane&3)*8+(4*hi+((lane&15)>>2))*64;
  DMA_K(0,0);DMA_V(0,0);DMA_K(1,SLOTB);
  bf16x8 qr[4];
  #pragma unroll
  for(int d0=0;d0<4;++d0)qr[d0]=*reinterpret_cast<const bf16x8*>(&Qw[(long)r32*QP+d0*16+hi*8]);
  { float qf[4][8]; float ss=0.f;
    #pragma unroll
    for(int d0=0;d0<4;++d0){
      #pragma unroll
      for(int j=0;j<8;++j){ const float v=__uint_as_float(((unsigned)(unsigned short)qr[d0][j])<<16); qf[d0][j]=v; ss+=v*v; } }
    ss+=__shfl_xor(ss,32);
    const float rs=rsqrtf(ss*(1.f/64.f)+1e-6f);
    #pragma unroll
    for(int d0=0;d0<4;++d0){
      #pragma unroll
      for(int j=0;j<8;++j) qf[d0][j]*=rs*qg[16*d0+8*hi+j]; }
    if(tq0>=0){ const int t=tq0+wid*QBLK+r32; const float2*rr=rope+(t>>6)*16+8*hi; const float2*rc=rope+(t&63)*16+8*hi;
      #pragma unroll
      for(int j=0;j<8;++j){ const float2 a=rr[j],c=rc[j];
        const float x1=qf[0][j],x2=qf[1][j]; qf[0][j]=x1*a.x-x2*a.y; qf[1][j]=x2*a.x+x1*a.y;
        const float y1=qf[2][j],y2=qf[3][j]; qf[2][j]=y1*c.x-y2*c.y; qf[3][j]=y2*c.x+y1*c.y; } }
    #pragma unroll
    for(int d0=0;d0<4;++d0){ u32x4 w; w.x=cvtpk_s(qf[d0][0]*C2,qf[d0][1]*C2); w.y=cvtpk_s(qf[d0][2]*C2,qf[d0][3]*C2); w.z=cvtpk_s(qf[d0][4]*C2,qf[d0][5]*C2); w.w=cvtpk_s(qf[d0][6]*C2,qf[d0][7]*C2); qr[d0]=__builtin_bit_cast(bf16x8,w); } }
  float mhat=0.f,l_reg=0.f;f32x16 o[2];o[0]=f32x16{};o[1]=f32x16{};f32x16 negm=f32x16{};asm volatile("":"+v"(negm));
  #define CMASK(P0,P1,t) do{}while(0)
  bool resc=false;
  #define START(P0,P1) do{ const float rm=rowmax(P0,P1); resc=false; \
    { const float dl=rm; mhat=fadd_s(mhat,dl); \
      _Pragma("unroll") for(int r=0;r<16;++r){P0[r]=fsub_s(P0[r],dl);P1[r]=fsub_s(P1[r],dl);} \
      _Pragma("unroll") for(int r=0;r<16;++r)negm[r]=-mhat; asm volatile("":"+v"(negm)); } \
    _Pragma("unroll") for(int r=0;r<16;++r)P0[r]=__builtin_amdgcn_exp2f(P0[r]); }while(0)
  #define RESC() do{ if(resc){ asm volatile("s_waitcnt lgkmcnt(0)":::"memory"); \
      _Pragma("unroll") for(int d_=0;d_<2;++d_) _Pragma("unroll") for(int r=0;r<16;++r)o[d_][r]*=wsf[crow(r,hi)]; } }while(0)
  f32x16 pA0,pA1,pB0,pB1;
  int sl_prev=0,sl_cur=0,sl_next=SLOTB;
  #define ROT() do{sl_prev=sl_cur;sl_cur=sl_next;sl_next=(sl_next==(NSLOT-1)*SLOTB)?0:sl_next+SLOTB;}while(0)
  DMA_K(2,2*SLOTB);
  WAIT_BAR(3);
  qkt(pA0,pA1,Kbase,qr,negm,r32,hi);asm volatile("s_nop 15\n\ts_nop 7":"+v"(pA0),"+v"(pA1));CMASK(pA0,pA1,0);
  START(pA0,pA1);
  _Pragma("unroll") for(int r=0;r<16;++r)pA1[r]=__builtin_amdgcn_exp2f(pA1[r]);
  WAIT_BAR(0);
  DMA_K(3,0);DMA_V(1,SLOTB);
  ROT();
  kload8(kf,kp0+sl_cur);
  WAIT_BAR(2);
  s16x4 vlo[8],vhi[8]; u32x4 pw0,pw1,pw2,pw3;
  #define PKW(P,B) cvtpk_s(P[B],P[B+1])
  #define PAF(k) __builtin_bit_cast(bf16x8,pw##k)
  #define VFR(i) (bf16x8){vlo[i][0],vlo[i][1],vlo[i][2],vlo[i][3],vhi[i][0],vhi[i][1],vhi[i][2],vhi[i][3]}
  #define PIN(x) asm volatile("":"+v"(x))
  #define MX3(a,b,c) __builtin_fmaxf(__builtin_fmaxf((a),(b)),(c))
  #define GAPA(MF,A0,A1,A2,A3,W0,W1,PW) do{ MF; sacc+=A0; sacc+=A1; sacc+=A2; sacc+=A3; PIN(sacc); W0; W1; PIN(PW); SBAR(); }while(0)
  #define EX(v) __builtin_amdgcn_exp2f(v)
  #define GAPB(MF,X,B) do{ MF; X[B]=EX(X[B]); X[B+1]=EX(X[B+1]); X[B+2]=EX(X[B+2]); X[B+3]=EX(X[B+3]); PIN(X); SBAR(); }while(0)
  #define VRD(i) do{ vlo[i]=vtr(vp_+(((i)>>2)*4096+((i)&3)*1024)); vhi[i]=vtr(vp_+(((i)>>2)*4096+((i)&3)*1024+512)); }while(0)
  #define KRD(G,j) do{ if(G){ kload2(kf,kp0+sl_next,j); SBAR(); } }while(0)
  #define STEP(C0,C1,P0,P1,t,GK,GV,GL) do{ SBAR(); \
    const lds_cptr vp_=vp0+sl_prev; \
    VRD(0); SBAR(); float sacc=(P0[0]+P0[1]); \
    GAPA(C0=__builtin_amdgcn_mfma_f32_32x32x16_bf16(kf[0],qr[0],negm,0,0,0), P0[2],P0[3],P0[4],P0[5],     pw0[0]=PKW(P0,0), pw0[1]=PKW(P0,2), pw0); \
    VRD(4); SBAR(); GAPA(C1=__builtin_amdgcn_mfma_f32_32x32x16_bf16(kf[1],qr[0],negm,0,0,0), P0[6],P0[7],P0[8],P0[9],     pw0[2]=PKW(P0,4), pw0[3]=PKW(P0,6), pw0); \
    VRD(1); SBAR(); GAPA(C0=__builtin_amdgcn_mfma_f32_32x32x16_bf16(kf[2],qr[1],C0,0,0,0),   P0[10],P0[11],P0[12],P0[13], pw1[0]=PKW(P0,8), pw1[1]=PKW(P0,10), pw1); \
    VRD(5); SBAR(); GAPA(C1=__builtin_amdgcn_mfma_f32_32x32x16_bf16(kf[3],qr[1],C1,0,0,0),   P0[14],P0[15],P1[0],P1[1],   pw1[2]=PKW(P0,12),pw1[3]=PKW(P0,14), pw1); \
    VRD(2); SBAR(); GAPA(C0=__builtin_amdgcn_mfma_f32_32x32x16_bf16(kf[4],qr[2],C0,0,0,0),   P1[2],P1[3],P1[4],P1[5],     pw2[0]=PKW(P1,0), pw2[1]=PKW(P1,2), pw2); \
    VRD(6); SBAR(); GAPA(C1=__builtin_amdgcn_mfma_f32_32x32x16_bf16(kf[5],qr[2],C1,0,0,0),   P1[6],P1[7],P1[8],P1[9],     pw2[2]=PKW(P1,4), pw2[3]=PKW(P1,6), pw2); \
    VRD(3); SBAR(); GAPA(C0=__builtin_amdgcn_mfma_f32_32x32x16_bf16(kf[6],qr[3],C0,0,0,0),   P1[10],P1[11],P1[12],P1[13], pw3[0]=PKW(P1,8), pw3[1]=PKW(P1,10), pw3); \
    VRD(7); SBAR(); GAPA(C1=__builtin_amdgcn_mfma_f32_32x32x16_bf16(kf[7],qr[3],C1,0,0,0),   P1[14],P1[15],0.f,0.f,       pw3[2]=PKW(P1,12),pw3[3]=PKW(P1,14), pw3); \
    l_reg+=sacc; \
    if(GK){DMA_K((t)+3,sl_cur);} if(GV){DMA_V((t)+1,sl_next);} \
    CMASK(C0,C1,t); \
    { float a=MX3(C0[0],C0[1],C1[0]),b=MX3(C0[2],C0[3],C1[1]); a=MX3(a,C1[2],C1[3]); \
      _Pragma("unroll") for(int r=4;r<16;r+=4){a=MX3(a,C0[r],C0[r+1]);b=MX3(b,C0[r+2],C0[r+3]);a=MX3(a,C1[r],C1[r+1]);b=MX3(b,C1[r+2],C1[r+3]);} \
      float rm=__builtin_fmaxf(a,b); { auto rr=__builtin_amdgcn_permlane32_swap(__float_as_uint(rm),__float_as_uint(rm),false,false); rm=__builtin_fmaxf(__uint_as_float(rr[0]),__uint_as_float(rr[1])); } \
      resc=false; \
      if(__builtin_expect(__any(rm>(float)THRL),0)){ const float dl=__builtin_fmaxf(rm,0.f); mhat+=dl; \
        _Pragma("unroll") for(int r=0;r<16;++r){C0[r]-=dl;C1[r]-=dl;} \
        _Pragma("unroll") for(int r=0;r<16;++r)negm[r]=-mhat; asm volatile("":"+v"(negm)); \
        const float f=__builtin_amdgcn_exp2f(-dl); l_reg*=f; if(hi==0)wsf[r32]=f; resc=true; } } \
    SBAR(); \
    GAPB(o[0]=__builtin_amdgcn_mfma_f32_32x32x16_bf16(PAF(0),VFR(0),o[0],0,0,0), C0,0); \
    GAPB(o[1]=__builtin_amdgcn_mfma_f32_32x32x16_bf16(PAF(0),VFR(4),o[1],0,0,0), C0,4); \
    KRD(GL,0); GAPB(o[0]=__builtin_amdgcn_mfma_f32_32x32x16_bf16(PAF(1),VFR(1),o[0],0,0,0), C0,8); \
    KRD(GL,1); GAPB(o[1]=__builtin_amdgcn_mfma_f32_32x32x16_bf16(PAF(1),VFR(5),o[1],0,0,0), C0,12); \
    KRD(GL,2); GAPB(o[0]=__builtin_amdgcn_mfma_f32_32x32x16_bf16(PAF(2),VFR(2),o[0],0,0,0), C1,0); \
    KRD(GL,3); GAPB(o[1]=__builtin_amdgcn_mfma_f32_32x32x16_bf16(PAF(2),VFR(6),o[1],0,0,0), C1,4); \
    GAPB(o[0]=__builtin_amdgcn_mfma_f32_32x32x16_bf16(PAF(3),VFR(3),o[0],0,0,0), C1,8); \
    GAPB(o[1]=__builtin_amdgcn_mfma_f32_32x32x16_bf16(PAF(3),VFR(7),o[1],0,0,0), C1,12); \
    }while(0)
  int t=1;
  #undef CMASK
  #define CMASK(P0,P1,t) do{}while(0)
  for(;t+5<NT;t+=2){
    STEP(pB0,pB1,pA0,pA1,t,true,true,true);     WAIT_BAR(2); RESC(); ROT();
    STEP(pA0,pA1,pB0,pB1,t+1,true,true,true);   WAIT_BAR(2); RESC(); ROT();
  }
  #undef CMASK
  #define CMASK(P0,P1,t) do{}while(0)
  #define ENDW(tt) do{ if((tt)+3<NT){WAIT_BAR(2);} else if((tt)+2<NT){WAIT_BAR(1);} else {WAIT_BAR(0);} }while(0)
  for(;t+1<NT;t+=2){
    STEP(pB0,pB1,pA0,pA1,t,(t+3<NT),(t+1<NT),(t+1<NT));       ENDW(t);   RESC(); ROT();
    STEP(pA0,pA1,pB0,pB1,t+1,(t+4<NT),(t+2<NT),(t+2<NT));     ENDW(t+1); RESC(); ROT();
  }
  STEP(pB0,pB1,pA0,pA1,NT-1,false,false,false); RESC();
  { float sacc=pB0[0]+pB0[1]; _Pragma("unroll") for(int r=2;r<16;++r)sacc+=pB0[r]; _Pragma("unroll") for(int r=0;r<16;++r)sacc+=pB1[r]; l_reg+=sacc;
    pw0=(u32x4){PKW(pB0,0),PKW(pB0,2),PKW(pB0,4),PKW(pB0,6)};pw1=(u32x4){PKW(pB0,8),PKW(pB0,10),PKW(pB0,12),PKW(pB0,14)};pw2=(u32x4){PKW(pB1,0),PKW(pB1,2),PKW(pB1,4),PKW(pB1,6)};pw3=(u32x4){PKW(pB1,8),PKW(pB1,10),PKW(pB1,12),PKW(pB1,14)};
    SBAR(); pv(o,vb0+sl_cur,PAF(0),PAF(1),PAF(2),PAF(3)); }
  #undef PKW
  #undef PAF
  #undef VFR
  #undef PIN
  #undef MX3
  #undef GAPA
  #undef GAPB
  #undef EX
  #undef VRD
  #undef KRD
  #undef STEP
  #undef ENDW
  {auto rr=__builtin_amdgcn_permlane32_swap(__float_as_uint(l_reg),__float_as_uint(l_reg),false,false);l_reg=__uint_as_float(rr[0])+__uint_as_float(rr[1]);}
  if(hi==0)wsf[32+r32]=l_reg;asm volatile("s_waitcnt lgkmcnt(0)":::"memory");
  float rli[16];
  #pragma unroll
  for(int r=0;r<16;++r)rli[r]=__builtin_amdgcn_rcpf(wsf[32+crow(r,hi)]);
  bf16*Ow=O0+(long)(wid*QBLK)*OP;
  { bf16*stg=(bf16*)(shm+LDS_OST)+wid*2048;
    #pragma unroll
    for(int r=0;r<16;++r){const int orow=crow(r,hi);
      #pragma unroll
      for(int d0=0;d0<2;++d0)stg[orow*64+d0*32+r32]=__float2bfloat16(o[d0][r]*rli[r]);}
    asm volatile("s_waitcnt lgkmcnt(0)":::"memory");
    #pragma unroll
    for(int i=0;i<4;++i){const int row=i*8+(lane>>3),ch=lane&7; const u32x4 v=*(const u32x4*)(stg+row*64+ch*8); ATTN_STORE16(Ow+(long)row*OP+ch*8,v);} }
  asm volatile("s_waitcnt lgkmcnt(0)\n\ts_barrier":::"memory");
  #undef DMA_K
  #undef DMA_V
  #undef CMASK
  #undef START
  #undef RESC
  #undef ROT
}
constexpr int ATTN_LDS_BYTES=LDS_BYTES;
#undef SBAR
#undef WAIT_BAR
}

struct Params {
    const float* in[35];
    float* out;
    unsigned char* ws;
    int ph_lo, ph_hi;
};
enum { I_X = 0, I_C, I_CTX, I_CCTX, I_WMOD, I_BMOD, I_GMIX, I_GFFN, I_MIXWIN, I_MIXWOUT, I_QG, I_KG, I_LNG, I_WSP, I_BSP,
       I_S5WIN, I_ARE, I_AIM, I_LOGDT, I_BRE, I_BIM, I_CRE, I_CIM, I_S5D, I_WGLU, I_BGLU, I_S5WOUT,
       I_WGRP, I_BGRP, I_WRT, I_BRT, I_W1, I_W3, I_W2, I_FING };

struct Ctx {
    const Params* p;
    unsigned char* ws;
    LAS unsigned char* lds;
    int tid, lane, wave, gw, ngw;
};
__device__ __forceinline__ const float* xin_row(const Params& P, int r) { return r < TL ? P.in[I_X] + (size_t)r * D : P.in[I_CTX] + (size_t)(r - TL) * D; }
__device__ __forceinline__ int cond_of(int r) { return r < TL ? (r >> 11) : 16; }
__device__ __forceinline__ const float* mod_vec(const Ctx& C, int layer, int ci, int k) { return (const float*)(C.ws + WS_MOD) + ((size_t)(layer * 17 + ci) * 6 + k) * D; }

__device__ __forceinline__ void dsincos(double a, double& s, double& c) {
    const double TWO_PI_HI = 6.283185307179586, TWO_PI_LO = 2.4492935982947064e-16;
    const double k = rint(a * 0.15915494309189535);
    double r = fma(-k, TWO_PI_HI, a); r = fma(-k, TWO_PI_LO, r);
    const double r2 = r * r; double ct = 1.0, st = r, cs = 1.0, ss = r;
#pragma unroll 1
    for (int i = 1; i <= 15; ++i) { ct *= -r2 / (double)((2 * i - 1) * (2 * i)); cs += ct; st *= -r2 / (double)((2 * i) * (2 * i + 1)); ss += st; }
    s = ss; c = cs;
}

struct TItem { const float* src; int N, k0, n0; bf16* dst; int dp; float f8s; };
__device__ __forceinline__ void t_load(const TItem& t, int lane, float (&r)[32]) {
#pragma unroll
    for (int i = 0; i < 32; ++i) r[i] = __builtin_nontemporal_load(t.src + (size_t)(t.k0 + 2 * i + (lane >> 5)) * t.N + t.n0 + (lane & 31));
}
__device__ __forceinline__ void t_store(const TItem& t, int lane, const float (&r)[32], LAS float* scr) {
#pragma unroll
    for (int i = 0; i < 32; ++i) scr[(2 * i + (lane >> 5)) * 33 + (lane & 31)] = r[i];
    asm volatile("s_waitcnt lgkmcnt(0)" ::: "memory");
    const int c = lane & 7;
    if (t.f8s != 0.f) {
#pragma unroll
        for (int j = 0; j < 4; ++j) { const int n = (lane >> 3) + 8 * j; const LAS float* s = scr + (8 * c) * 33 + n; const float q = t.f8s;
            *(pg8::u32x2*)((unsigned char*)t.dst + (size_t)n * t.dp + 8 * c) = pg8::pack8_fp8((f32x4){s[0 * 33] * q, s[1 * 33] * q, s[2 * 33] * q, s[3 * 33] * q}, (f32x4){s[4 * 33] * q, s[5 * 33] * q, s[6 * 33] * q, s[7 * 33] * q}); }
    } else {
#pragma unroll
        for (int j = 0; j < 4; ++j) { const int n = (lane >> 3) + 8 * j; const LAS float* s = scr + (8 * c) * 33 + n;
            v4u o; o.x = pk2(s[0 * 33], s[1 * 33]); o.y = pk2(s[2 * 33], s[3 * 33]); o.z = pk2(s[4 * 33], s[5 * 33]); o.w = pk2(s[6 * 33], s[7 * 33]);
            *(v4u*)(t.dst + (size_t)n * t.dp + 8 * c) = o; }
    }
    asm volatile("s_waitcnt lgkmcnt(0)" ::: "memory");
}
__device__ __forceinline__ TItem mat_item(const float* W, int K, int N, bf16* WT, int it) {
    const int nblk = N / 32, kb = it / nblk, nb = it % nblk;
    return TItem{W, N, kb * 64, nb * 32, WT + (size_t)(nb * 32) * K + kb * 64, K, 0.f};
}
__device__ __forceinline__ TItem mat_item_f8(const float* W, int K, int N, unsigned char* WT, int it, float f8s) {
    const int nblk = N / 32, kb = it / nblk, nb = it % nblk;
    return TItem{W, N, kb * 64, nb * 32, (bf16*)(WT + (size_t)(nb * 32) * K + kb * 64), K, f8s};
}
constexpr int MOE_ITEMS = NEXP * 768;
__device__ __forceinline__ TItem moe_item(const Ctx& C, int layer, int it) {
    const Params& P = *C.p;
    const int e = it / 768, r = it % 768, kind = r / 256, j = r % 256;
    if (kind < 2) {
        const float* src = (kind == 0 ? P.in[I_W1] : P.in[I_W3]) + ((size_t)layer * NEXP + e) * D * EH;
        const int kb = j / 16, nb = j % 16, k0 = kb * 64, n0 = nb * 32;
        const int drow = (n0 / 128) * 256 + (n0 % 128) + (kind == 1 ? 128 : 0);
        return TItem{src, EH, k0, n0, (bf16*)((unsigned char*)(C.ws + (layer ? WS_W13B : WS_W13)) + (size_t)e * 1024 * 1024 + (size_t)drow * 1024 + k0), 1024, W13_SCALE};
    }
    const float* src = P.in[I_W2] + ((size_t)layer * NEXP + e) * EH * D;
    const int kb = j / 32, nb = j % 32, k0 = kb * 64, n0 = nb * 32;
    return TItem{src, D, k0, n0, (bf16*)((unsigned char*)(C.ws + (layer ? WS_W2B : WS_W2)) + (size_t)e * 1024 * 512 + (size_t)n0 * 512 + k0), 512, W13_SCALE};
}
constexpr int TI0 = 16 * 56, TI1 = 16 * 32, TI2 = 16 * 16, TI3 = 8 * 16, TI4 = 8 * 32, NSMALL = TI0 + TI1 + TI2 + TI3 + TI4;
__device__ __forceinline__ TItem conv_item(const Ctx& C, int layer, int nsmall, int it) {
    const Params& P = *C.p; int r = it;
    if (r < nsmall) {
        if (r < TI0) return mat_item_f8(P.in[I_MIXWIN], D, MIXW, (unsigned char*)(C.ws + WS_WIN0), r, W13_SCALE); r -= TI0;
        if (r < TI1) return mat_item(P.in[I_MIXWOUT], D, D, (bf16*)(C.ws + WS_WOUT0), r); r -= TI1;
        if (r < TI2) return mat_item(P.in[I_S5WIN], D, 512, (bf16*)(C.ws + WS_WS5IN), r); r -= TI2;
        if (r < TI3) return mat_item(P.in[I_WGLU], 512, 512, (bf16*)(C.ws + WS_WGLU), r); r -= TI3;
        return mat_item(P.in[I_S5WOUT], 512, D, (bf16*)(C.ws + WS_WS5OUT), r);
    }
    return moe_item(C, layer, r - nsmall);
}
__device__ __forceinline__ void convert_items(const Ctx& C, int layer, int nsmall) {
    LAS float* scr = (LAS float*)(C.lds + C.wave * 16384);
    const int total = nsmall + (gridDim.x == 256 ? L0_A : MOE_ITEMS), n = C.ngw;
    for (int it = C.gw; it < total; it += 2 * n) {
        const bool two = it + n < total;
        const TItem ta = conv_item(C, layer, nsmall, it), tb = conv_item(C, layer, nsmall, two ? it + n : it);
        float ra[32], rb[32];
        t_load(ta, C.lane, ra); if (two) t_load(tb, C.lane, rb);
        t_store(ta, C.lane, ra, scr); if (two) t_store(tb, C.lane, rb, scr);
    }
}

__device__ __forceinline__ void convert_range(const Ctx& C, int layer, int lo, int hi, int b0) {
    if ((int)blockIdx.x < b0) return;
    LAS float* scr = (LAS float*)(C.lds + C.wave * 16384);
    const int n = ((int)gridDim.x - b0) * NWAVE;
    for (int it = lo + ((int)blockIdx.x - b0) * NWAVE + C.wave; it < hi; it += 2 * n) {
        const bool two = it + n < hi;
        const TItem ta = moe_item(C, layer, it), tb = moe_item(C, layer, two ? it + n : it);
        float ra[32], rb[32];
        t_load(ta, C.lane, ra); if (two) t_load(tb, C.lane, rb);
        t_store(ta, C.lane, ra, scr); if (two) t_store(tb, C.lane, rb, scr);
    }
}

__device__ __forceinline__ void phase_prologue(const Ctx& C) {
    const Params& P = *C.p;
    {
        LAS float* s = (LAS float*)C.lds;
        LAS float* red = (LAS float*)(C.lds + 17 * 1024 * 4);
        bool have_s = false;
        for (int u = blockIdx.x; u < 192; u += gridDim.x) {
            if (!have_s) {
                for (int i = C.tid; i < 17 * 1024; i += NTHR) { const int ci = i >> 10, k = i & 1023; const float v = ci < 16 ? P.in[I_C][ci * D + k] : P.in[I_CCTX][k]; s[i] = silu_(v); }
                have_s = true; __syncthreads();
            }
            const int layer = u / 96, jg = u % 96, kq = C.tid >> 6, jc = C.tid & 63;
            const float* w = P.in[I_WMOD] + (size_t)layer * D * 6144 + jg * 64 + jc;
            float acc[17];
#pragma unroll
            for (int i = 0; i < 17; ++i) acc[i] = 0.f;
            for (int k0 = kq * 128; k0 < kq * 128 + 128; k0 += 16) {
                float wv[16];
#pragma unroll
                for (int j = 0; j < 16; ++j) wv[j] = w[(size_t)(k0 + j) * 6144];
#pragma unroll
                for (int j = 0; j < 16; ++j)
#pragma unroll
                    for (int i = 0; i < 17; ++i) acc[i] += s[i * 1024 + k0 + j] * wv[j]; }
#pragma unroll
            for (int i = 0; i < 17; ++i) red[(kq * 17 + i) * 64 + jc] = acc[i];
            __syncthreads();
            for (int o = C.tid; o < 17 * 64; o += NTHR) { const int ci = o >> 6, c = o & 63; float v = 0.f;
#pragma unroll
                for (int q = 0; q < 8; ++q) v += red[(q * 17 + ci) * 64 + c];
                const int j = jg * 64 + c; v += P.in[I_BMOD][layer * 6144 + j];
                ((float*)(C.ws + WS_MOD))[((size_t)(layer * 17 + ci)) * 6144 + j] = v; }
            __syncthreads();
        }
        __syncthreads();
    }
    {
        const int gt = blockIdx.x * NTHR + C.tid, ngt = gridDim.x * NTHR;
        float2* rope = (float2*)(C.ws + WS_TAB + TAB_ROPE);
        for (int i = gt; i < 64 * 16; i += ngt) { const int pos = i >> 4, f = i & 15;
            const double th = exp(-(double)f * (9.210340371976184 / 16.0)); double s, c; dsincos((double)pos * th, s, c); rope[i] = make_float2((float)c, (float)s); }
        float2* lamb = (float2*)(C.ws + WS_TAB + TAB_LAMB); float2* bbar = (float2*)(C.ws + WS_TAB + TAB_BBAR);
        for (int i = gt; i < 2 * 32 * 64; i += ngt) {
            const int dg = i >> 6;
            const double are = P.in[I_ARE][i], aim = P.in[I_AIM][i], dt = exp((double)P.in[I_LOGDT][dg]);
            double s, c; dsincos(aim * dt, s, c); const double mag = exp(are * dt), lr = mag * c, li = mag * s;
            lamb[i] = make_float2((float)lr, (float)li);
            const double den = are * are + aim * aim, nr = lr - 1.0, ni = li;
            const double cr = (nr * are + ni * aim) / den, cim = (ni * are - nr * aim) / den;
            for (int p = 0; p < 16; ++p) { const double br = P.in[I_BRE][(size_t)i * 16 + p], bi = P.in[I_BIM][(size_t)i * 16 + p];
                bbar[(size_t)i * 16 + p] = make_float2((float)(cr * br - cim * bi), (float)(cr * bi + cim * br)); }
        }
    }
    {
        const int gt = blockIdx.x * NTHR + C.tid, ngt = gridDim.x * NTHR;
        bf16* wrt = (bf16*)(C.ws + WS_TAB + TAB_WR);
        for (int idx = gt; idx < 2 * 32 * 3 * 64; idx += ngt) {
            const int ln = idx & 63, jb = (idx >> 6) % 3, kk = (idx / 192) & 31, l = idx / (192 * 32);
            const int i = ln & 15, q = ln >> 4, grp = i >> 2, r = i & 3;
            float hi8[8], lo8[8];
#pragma unroll
            for (int e = 0; e < 8; ++e) { const int k = 32 * kk + 8 * q + e;
                const float w = jb < 2 ? P.in[I_WRT][((size_t)l * D + k) * 32 + grp * 8 + jb * 4 + r] : (r == 0 ? P.in[I_WGRP][((size_t)l * D + k) * 4 + grp] : 0.f);
                const float h = bf2f(f2bf(w)); hi8[e] = h; lo8[e] = w - h; }
            v4u oh, ol; oh.x = pk2(hi8[0], hi8[1]); oh.y = pk2(hi8[2], hi8[3]); oh.z = pk2(hi8[4], hi8[5]); oh.w = pk2(hi8[6], hi8[7]);
            ol.x = pk2(lo8[0], lo8[1]); ol.y = pk2(lo8[2], lo8[3]); ol.z = pk2(lo8[4], lo8[5]); ol.w = pk2(lo8[6], lo8[7]);
            const size_t base = ((((size_t)l * 32 + kk) * 3 + jb) * 2) * 64 + ln;
            *(v4u*)(wrt + base * 8) = oh; *(v4u*)(wrt + (base + 64) * 8) = ol;
        }
    }
    {
        const int gt = blockIdx.x * NTHR + C.tid, ngt = gridDim.x * NTHR; bf16* w16 = (bf16*)(C.ws + WS_WSP);
        for (int i = gt; i < 8 * 128 * 128 / 4; i += ngt) { const f32x4 v = *(const f32x4*)(P.in[I_WSP] + 4 * (size_t)i); v2u o; o.x = pk2(v.x, v.y); o.y = pk2(v.z, v.w); *(v2u*)(w16 + 4 * (size_t)i) = o; }
    }
    convert_items(C, 0, NSMALL);
}

__device__ __forceinline__ void load_row16(const float* row, int lane, f32x4 (&v)[4]) {
#pragma unroll
    for (int j = 0; j < 4; ++j) v[j] = *(const f32x4*)(row + 4 * lane + 256 * j);
}
__device__ __forceinline__ float row_rstd(const f32x4 (&v)[4]) {
    float s = 0.f;
#pragma unroll
    for (int j = 0; j < 4; ++j) s += (v[j].x * v[j].x + v[j].y * v[j].y) + (v[j].z * v[j].z + v[j].w * v[j].w);
    return rsqrtf(wave_sum(s) * (1.f / D) + EPS);
}
__device__ __forceinline__ void modulate16(f32x4 (&v)[4], float rstd, const float* g, const float* scale, const float* shift, int lane) {
#pragma unroll
    for (int j = 0; j < 4; ++j) { const int c = 4 * lane + 256 * j; const f32x4 gg = *(const f32x4*)(g + c), sc = *(const f32x4*)(scale + c), sh = *(const f32x4*)(shift + c);
        v[j] = v[j] * rstd * gg * (sc + 1.f) + sh; }
}
__device__ __forceinline__ void store_row16_bf16(bf16* row, int lane, const f32x4 (&v)[4]) {
#pragma unroll
    for (int j = 0; j < 4; ++j) { v2u o; o.x = pk2(v[j].x, v[j].y); o.y = pk2(v[j].z, v[j].w); *(v2u*)(row + 4 * lane + 256 * j) = o; }
}

__device__ __forceinline__ void store_row16_fp8(unsigned char* row, int lane, const f32x4 (&v)[4]) {
#pragma unroll
    for (int j = 0; j < 4; ++j) { int w = 0; w = __builtin_amdgcn_cvt_pk_fp8_f32(v[j].x, v[j].y, w, false); w = __builtin_amdgcn_cvt_pk_fp8_f32(v[j].z, v[j].w, w, true); *(int*)(row + 4 * lane + 256 * j) = w; }
}

__device__ __forceinline__ void phase_norm_mix0(const Ctx& C) {
    const Params& P = *C.p; unsigned char* H = (unsigned char*)(C.ws + WS_H);
    f32x4 a[4], b[4]; const int n = C.ngw; int r = C.gw;
    if (r < TT) load_row16(xin_row(P, r), C.lane, a);
    if (r + n < TT) load_row16(xin_row(P, r + n), C.lane, b);
#define NM0_ROW(buf, rr, rnext) do { f32x4 v[4] = {buf[0], buf[1], buf[2], buf[3]}; if ((rnext) < TT) load_row16(xin_row(P, (rnext)), C.lane, buf); \
        const float rstd = row_rstd(v); const int ci = cond_of(rr); modulate16(v, rstd, P.in[I_GMIX], mod_vec(C, 0, ci, 1), mod_vec(C, 0, ci, 0), C.lane); store_row16_fp8(H + (size_t)(rr) * D, C.lane, v); } while (0)
    for (; r < TT; r += 2 * n) { NM0_ROW(a, r, r + 2 * n); if (r + n < TT) NM0_ROW(b, r + n, r + 3 * n); }
#undef NM0_ROW
}

__device__ __forceinline__ unsigned gm_off_b(unsigned row, unsigned ch) { return 256u * row + 16u * (ch ^ (((row & 3u) << 2) | ((row >> 2) & 3u))); }
__device__ __forceinline__ void phase_gmlp_fast(const Ctx& C) {
    typedef short bf16x8 __attribute__((ext_vector_type(8)));
    typedef short s16x4 __attribute__((ext_vector_type(4)));
    typedef float f32x16 __attribute__((ext_vector_type(16)));
    const Params& P = *C.p; const bf16* Pb = (const bf16*)(C.ws + WS_P); bf16* OG = (bf16*)(C.ws + WS_H); const bf16* W16 = (const bf16*)(C.ws + WS_WSP);
    const float* lnp = (const float*)(C.ws + WS_Q);
    const int tid = C.tid, lane = C.lane, w = C.wave, l31 = lane & 31, hi = lane >> 5;
    const int gsel = w >> 2, pb = w & 3;
    const int nU = (TT / 128) * 4, arow = tid >> 2;
    v4u ra[4]; float2 st = make_float2(0.f, 0.f);
#define GM_ALOAD(uu_) do { const size_t gr_ = (size_t)((uu_) >> 2) * 128 + arow; { const f32x4 pq = *(const f32x4*)(lnp + gr_ * 16 + 4 * (tid & 3)); st = make_float2(pq.x + pq.z, pq.y + pq.w); } \
        _Pragma("unroll") for (int i = 0; i < 4; ++i) ra[i] = *(const v4u*)(Pb + gr_ * MIXW + 1280 + 128 * ((uu_) & 3) + 8 * ((tid & 3) + 4 * i)); } while (0)
    if ((int)blockIdx.x < nU) GM_ALOAD((int)blockIdx.x);
    for (int u = blockIdx.x; u < nU; u += gridDim.x) {
        const int ch_ = u >> 2, gp = u & 3, g = 2 * gp + gsel;
        bf16x8 xf[8]; const bf16* wrow = W16 + ((size_t)g * 128 + 32 * pb + l31) * 128 + 8 * hi;
#pragma unroll
        for (int k8 = 0; k8 < 8; ++k8) xf[k8] = *(const bf16x8*)(wrow + 16 * k8);
        { float s1 = st.x, s2 = st.y; s1 += __shfl_xor(s1, 1); s1 += __shfl_xor(s1, 2); s2 += __shfl_xor(s2, 1); s2 += __shfl_xor(s2, 2);
          const float mean_ = s1 * (1.f / 512.f); const float2 sc = make_float2(mean_, rsqrtf(fmaxf(s2 * (1.f / 512.f) - mean_ * mean_, 0.f) + EPS));
#pragma unroll
          for (int i = 0; i < 4; ++i) { const int c16 = (tid & 3) + 4 * i; float v[8]; unpack8(ra[i], v);
              const float* lg = P.in[I_LNG] + 128 * gp + 8 * c16;
#pragma unroll
              for (int j = 0; j < 8; ++j) v[j] = (v[j] - sc.x) * sc.y * lg[j];
              v4u o; o.x = pk2(v[0], v[1]); o.y = pk2(v[2], v[3]); o.z = pk2(v[4], v[5]); o.w = pk2(v[6], v[7]);
              *(LAS v4u*)(C.lds + (arow >> 5) * 8192 + gm_off_b(arow & 31, c16)) = o; } }
        if (u + (int)gridDim.x < nU) GM_ALOAD(u + (int)gridDim.x);
        __syncthreads();
        f32x16 acc[2]; acc[0] = f32x16{}; acc[1] = f32x16{};
#pragma unroll
        for (int k8 = 0; k8 < 8; ++k8) {
            const unsigned rb = k8 >> 1, ks = k8 & 1;
#pragma unroll
            for (int db = 0; db < 2; ++db) { const unsigned c = 2 * gsel + db, blk = (lane >> 4) & 1, q = (lane & 15) >> 2, p2 = lane & 3;
                s16x4 t0, t1;
                { const unsigned a0 = rb * 8192 + gm_off_b(16 * ks + 8 * hi + q, 4 * c + 2 * blk + (p2 >> 1)) + 8 * (p2 & 1);
                  const unsigned a1 = rb * 8192 + gm_off_b(16 * ks + 8 * hi + 4 + q, 4 * c + 2 * blk + (p2 >> 1)) + 8 * (p2 & 1);
                  t0 = __builtin_bit_cast(s16x4, __builtin_amdgcn_ds_read_tr16_b64_v4i16((LAS s16x4*)(C.lds + a0)));
                  t1 = __builtin_bit_cast(s16x4, __builtin_amdgcn_ds_read_tr16_b64_v4i16((LAS s16x4*)(C.lds + a1))); }
                const bf16x8 yf = {t0[0], t0[1], t0[2], t0[3], t1[0], t1[1], t1[2], t1[3]};
                acc[db] = __builtin_amdgcn_mfma_f32_32x32x16_bf16(xf[k8], yf, acc[db], 0, 0, 0); }
        }
        const float* bsp = P.in[I_BSP] + g * 128 + 32 * pb;
#pragma unroll
        for (int r = 0; r < 16; ++r) { const int pl = (r & 3) + 8 * (r >> 2) + 4 * hi; const size_t grow = (size_t)ch_ * 128 + 32 * pb + pl; const float bb = bsp[pl];
#pragma unroll
            for (int db = 0; db < 2; ++db) { const int col = 64 * g + 32 * db + l31; const float uu = bf2f(Pb[grow * MIXW + 768 + col]);
                OG[grow * D + 512 + col] = (bf16)f2bf(uu * (acc[db][r] + bb)); } }
        __syncthreads();
    }
#undef GM_ALOAD
}

__device__ __forceinline__ void phase_attn_fast(const Ctx& C, char* lds_generic) {
    typedef attn_body::bf16 abf;
    const abf* Q = (const abf*)(C.ws + WS_P); const abf* Kb = (const abf*)(C.ws + WS_K); const abf* Vb = (const abf*)(C.ws + WS_V); abf* OG = (abf*)(C.ws + WS_H);
    const int G = gridDim.x, bx = blockIdx.x; const int vcu = (G % 8 == 0) ? (bx % 8) * (G / 8) + bx / 8 : bx;
    const int per = (1024 + G - 1) / G, perc = (128 + G - 1) / G;
    for (int i = 0; i < per + perc; ++i) {
        int b, h, nt, tq0; size_t qrow;
        if (i < per) { const int u = vcu * per + i; if (u >= 1024) continue; const int qb = u & 7, hg = (u >> 3) & 3, bk = u >> 5; b = bk >> 1; h = (bk & 1) * 4 + hg; qrow = (size_t)b * SEQ + qb * 256; nt = KVL / 64; tq0 = qb * 256; }
        else { const int u = vcu + (i - per) * G; if (u >= 128) continue; b = u >> 3; h = u & 7; qrow = (size_t)TL + (size_t)b * CTXL; nt = CTXL / 64; tq0 = -1; }
        const size_t kvo = (size_t)b * KVL * 128 + (h >> 2) * 64;
        attn_body::attn_unit<8>(Q + qrow * MIXW + h * 64, Kb + kvo, Vb + kvo, OG + qrow * 1024 + h * 64, nt, lds_generic, C.p->in[I_QG], (const float2*)(C.ws + WS_TAB + TAB_ROPE), tq0);
    }
}

__device__ __forceinline__ void phase_router_fast(const Ctx& C, int layer, int nrows) {
    typedef short bf16x8 __attribute__((ext_vector_type(8)));
    const Params& P = *C.p; const bf16* XC = (const bf16*)(C.ws + WS_XC); bf16* F = (bf16*)(C.ws + WS_H);
    int* asg_e = (int*)(C.ws + WS_ROUTE + RT_E); int* asg_p = (int*)(C.ws + WS_ROUTE + RT_P); float* asg_w = (float*)(C.ws + WS_ROUTE + RT_W); int* list = (int*)(C.ws + WS_LIST);
    unsigned* cnt = (unsigned*)(C.ws + WS_CTL) + CW_CNT + 64 * layer;
    const int l15 = C.lane & 15, q4 = C.lane >> 4;
    LAS float* ab = (LAS float*)(C.lds + C.wave * 8192);
    LAS unsigned* lcnt = (LAS unsigned*)(C.lds + 65536);
    if (C.tid < 64) lcnt[C.tid] = 0u;
    __syncthreads();
    int cur_ci = -1;
    const int nitems = nrows / 16;
    for (int rd = 0; (int)blockIdx.x * NWAVE + rd * C.ngw < nitems; ++rd) {
        const int it_raw = C.gw + rd * C.ngw; const bool valid = it_raw < nitems; const int it = valid ? it_raw : nitems - 1;
        const int row = it * 16 + l15, ci = cond_of(it * 16);
        if (ci != cur_ci) {
            const float* sc = mod_vec(C, layer, ci, 4); const float* sh = mod_vec(C, layer, ci, 3); const float* g0 = P.in[I_GFFN] + layer * D;
#pragma unroll
            for (int j = 0; j < 4; ++j) { const int c = 4 * C.lane + 256 * j; const f32x4 g4 = *(const f32x4*)(g0 + c), s4 = *(const f32x4*)(sc + c), h4 = *(const f32x4*)(sh + c); const f32x4 a4 = g4 * (s4 + 1.f);
                *(LAS f32x4*)(ab + c) = a4; *(LAS f32x4*)(ab + 1024 + c) = h4; }
            asm volatile("s_waitcnt lgkmcnt(0)" ::: "memory"); cur_ci = ci;
        }
        const bf16* xr = XC + (size_t)row * D + 8 * q4;
        float ss = 0.f;
#pragma unroll 16
        for (int kk = 0; kk < 32; ++kk) { pg8::f32x4 a, b; pg8::unpack8f(*(const pg8::u32x4*)(xr + 32 * kk), a, b); ss += (a.x * a.x + a.y * a.y) + (a.z * a.z + a.w * a.w) + (b.x * b.x + b.y * b.y) + (b.z * b.z + b.w * b.w); }
        ss += __shfl_xor(ss, 16); ss += __shfl_xor(ss, 32);
        const float rstd = rsqrtf(ss * (1.f / D) + EPS);
        f32x4 acc[3]; acc[0] = (f32x4){0.f, 0.f, 0.f, 0.f}; acc[1] = acc[0]; acc[2] = acc[0];
        unsigned char* frow = (unsigned char*)F + (size_t)row * D + 8 * q4;
        const LAS float* abl = ab + 8 * q4;
        {
            const unsigned char* wsrc = (const unsigned char*)((const bf16x8*)(C.ws + WS_TAB + TAB_WR) + (size_t)layer * (32 * 3 * 2 * 64)) + C.tid * 16;
            LAS unsigned char* wl0 = C.lds + 67584;
#define RS_GLOAD(sb_, ga, gb, gc, xq) do { ga = *(const pg8::u32x4*)(wsrc + (sb_) * 24576); gb = *(const pg8::u32x4*)(wsrc + (sb_) * 24576 + 8192); gc = *(const pg8::u32x4*)(wsrc + (sb_) * 24576 + 16384); \
                _Pragma("unroll") for (int j = 0; j < 4; ++j) xq[j] = *(const pg8::u32x4*)(xr + 128 * (sb_) + 32 * j); } while (0)
#define RS_LWRITE(sb_, ga, gb, gc) do { LAS unsigned char* wn = wl0 + ((sb_) & 1) * 24576 + C.tid * 16; *(LAS pg8::u32x4*)(wn) = ga; *(LAS pg8::u32x4*)(wn + 8192) = gb; *(LAS pg8::u32x4*)(wn + 16384) = gc; } while (0)
#define RS_FRAGS(sb_, j_, wf_, tb_) do { const LAS unsigned char* wl = wl0 + ((sb_) & 1) * 24576 + C.lane * 16; const int c_ = 128 * (sb_) + 32 * (j_); \
                _Pragma("unroll") for (int jb = 0; jb < 3; ++jb) { wf_[jb][0] = *(const LAS bf16x8*)(wl + (((j_) * 3 + jb) * 2) * 1024); wf_[jb][1] = *(const LAS bf16x8*)(wl + (((j_) * 3 + jb) * 2 + 1) * 1024); } \
                tb_[0] = *(const LAS f32x4*)(abl + c_); tb_[1] = *(const LAS f32x4*)(abl + c_ + 4); tb_[2] = *(const LAS f32x4*)(abl + 1024 + c_); tb_[3] = *(const LAS f32x4*)(abl + 1024 + c_ + 4); } while (0)
#define RS_STEP(sb_, j_, xv_, wf_, tb_, NEXT) do { const int c = 128 * (sb_) + 32 * (j_); \
                pg8::f32x4 x0, x1; pg8::unpack8f(xv_, x0, x1); \
                const f32x4 f0 = x0 * rstd * tb_[0] + tb_[2]; \
                const f32x4 f1 = x1 * rstd * tb_[1] + tb_[3]; \
                const pg8::u32x4 fh = pg8::pack8(f0, f1); if (valid) *(pg8::u32x2*)(frow + c) = pg8::pack8_fp8(f0, f1); \
                pg8::f32x4 r0, r1; pg8::unpack8f(fh, r0, r1); \
                const pg8::u32x4 fl = pg8::pack8(f0 - r0, f1 - r1); \
                const bf16x8 ah = __builtin_bit_cast(bf16x8, fh), al = __builtin_bit_cast(bf16x8, fl); \
                NEXT; \
                _Pragma("unroll") for (int jb = 0; jb < 3; ++jb) { \
                    acc[jb] = __builtin_amdgcn_mfma_f32_16x16x32_bf16(wf_[jb][0], ah, acc[jb], 0, 0, 0); \
                    acc[jb] = __builtin_amdgcn_mfma_f32_16x16x32_bf16(wf_[jb][0], al, acc[jb], 0, 0, 0); \
                    acc[jb] = __builtin_amdgcn_mfma_f32_16x16x32_bf16(wf_[jb][1], ah, acc[jb], 0, 0, 0); } } while (0)
#define RS_COMP(sb_, xq) do { bf16x8 wA[3][2], wB[3][2]; f32x4 tA[4], tB[4]; \
                RS_FRAGS(sb_, 0, wA, tA); \
                RS_STEP(sb_, 0, xq[0], wA, tA, RS_FRAGS(sb_, 1, wB, tB)); \
                RS_STEP(sb_, 1, xq[1], wB, tB, RS_FRAGS(sb_, 2, wA, tA)); \
                RS_STEP(sb_, 2, xq[2], wA, tA, RS_FRAGS(sb_, 3, wB, tB)); \
                RS_STEP(sb_, 3, xq[3], wB, tB, (void)0); } while (0)
#define RS_SYNC() do { asm volatile("s_waitcnt lgkmcnt(0)" ::: "memory"); __builtin_amdgcn_s_barrier(); } while (0)
            if (layer == 1) STAMP_AT(22);
            pg8::u32x4 a0, a1, a2, b0, b1, b2, xa[4], xb[4], xc[4];
            RS_GLOAD(0, a0, a1, a2, xc); RS_GLOAD(1, b0, b1, b2, xb);
            __builtin_amdgcn_s_barrier();
            RS_LWRITE(0, a0, a1, a2); RS_SYNC();
#pragma unroll 1
            for (int sb = 0; sb < 8; sb += 2) {
                if (sb + 2 < 8) RS_GLOAD(sb + 2, a0, a1, a2, xa);
                RS_COMP(sb, xc);
                RS_LWRITE(sb + 1, b0, b1, b2); RS_SYNC();
#pragma unroll
                for (int j = 0; j < 4; ++j) xc[j] = xb[j];
                if (sb + 3 < 8) RS_GLOAD(sb + 3, b0, b1, b2, xb);
                RS_COMP(sb + 1, xc);
                if (sb + 2 < 8) { RS_LWRITE(sb + 2, a0, a1, a2);
#pragma unroll
                    for (int j = 0; j < 4; ++j) xc[j] = xa[j]; }
                RS_SYNC();
            }
            if (layer == 1) STAMP_AT(23);
#undef RS_GLOAD
#undef RS_LWRITE
#undef RS_COMP
#undef RS_STEP
#undef RS_FRAGS
#undef RS_SYNC
        }
        const float* brt = P.in[I_BRT] + layer * 32 + q4 * 8;
        float e[8];
#pragma unroll
        for (int r = 0; r < 4; ++r) { e[r] = acc[0][r] + brt[r]; e[4 + r] = acc[1][r] + brt[4 + r]; }
        const float gl = acc[2][0] + P.in[I_BGRP][layer * 4 + q4];
        float gm = gl; int gi = q4;
#pragma unroll
        for (int st = 16; st <= 32; st <<= 1) { const float og = __shfl_xor(gm, st); const int oi = __shfl_xor(gi, st); if (og > gm || (og == gm && oi < gi)) { gm = og; gi = oi; } }
        float den = __expf(gl - gm); den += __shfl_xor(den, 16); den += __shfl_xor(den, 32);
        if (valid && q4 == gi) {
            const float gw_ = 1.f / den;
            int i0 = 0; float v0 = e[0];
#pragma unroll
            for (int i = 1; i < 8; ++i) if (e[i] > v0) { v0 = e[i]; i0 = i; }
            int i1 = -1; float v1 = -INFINITY;
#pragma unroll
            for (int i = 0; i < 8; ++i) if (i != i0 && e[i] > v1) { v1 = e[i]; i1 = i; }
            if (i1 < 0) i1 = (i0 + 1) & 7;
            const float e1 = __expf(v1 - v0), w0 = gw_ / (1.f + e1), w1 = gw_ * e1 / (1.f + e1);
            const int ea = (gi & 3) * 8 + i0, eb = (gi & 3) * 8 + i1;
            const unsigned pa = __hip_atomic_fetch_add(lcnt + ea, 1u, __ATOMIC_RELAXED, __HIP_MEMORY_SCOPE_WORKGROUP);
            const unsigned pb = __hip_atomic_fetch_add(lcnt + eb, 1u, __ATOMIC_RELAXED, __HIP_MEMORY_SCOPE_WORKGROUP);
            asg_e[2 * row] = ea; asg_e[2 * row + 1] = eb; asg_p[2 * row] = (int)pa; asg_p[2 * row + 1] = (int)pb; asg_w[2 * row] = w0; asg_w[2 * row + 1] = w1;
        }
    }
    if (layer == 0) STAMP_AT(21);
    asm volatile("s_waitcnt vmcnt(0) lgkmcnt(0)" ::: "memory");
    __syncthreads();
    if (C.tid < 32) { const unsigned n = lcnt[C.tid]; lcnt[32 + C.tid] = n ? __hip_atomic_fetch_add(cnt + C.tid, n, __ATOMIC_RELAXED, __HIP_MEMORY_SCOPE_AGENT) : 0u; }
    __syncthreads();
    for (int it = C.gw; it < nrows / 16; it += C.ngw) {
        if (C.lane < 32) { const int idx = 2 * (it * 16 + (C.lane & 15)) + (C.lane >> 4);
            const int e = __hip_atomic_load(asg_e + idx, __ATOMIC_RELAXED, __HIP_MEMORY_SCOPE_AGENT); const int p = __hip_atomic_load(asg_p + idx, __ATOMIC_RELAXED, __HIP_MEMORY_SCOPE_AGENT) + (int)lcnt[32 + e];
            asg_p[idx] = p; list[(size_t)e * LCAP + p] = idx >> 1; }
    }
}

__device__ __forceinline__ int wave_pstart(const Ctx& C, int layer) {
    const unsigned* cnt = (const unsigned*)(C.ws + WS_CTL) + CW_CNT + 64 * layer;
    const int mc = C.lane < 32 ? (int)__hip_atomic_load(cnt + (C.lane & 31), __ATOMIC_RELAXED, __HIP_MEMORY_SCOPE_AGENT) : 0; const int mp = (mc + 255) & ~255; int in = mp;
#pragma unroll
    for (int o = 1; o < 32; o <<= 1) { const int t = __shfl_up(in, o); if ((C.lane & 31) >= o) in += t; }
    return in - mp;
}
struct CombRaw { v2u x[4], ya[4], yb[4]; float w0, w1; };
__device__ __forceinline__ void comb_load(const Ctx& C, int r, int ps, CombRaw& o) {
    const bf16* Y2 = (const bf16*)(C.ws + WS_XS); const bf16* XC = (const bf16*)(C.ws + WS_XC); const float* asg_w = (const float*)(C.ws + WS_ROUTE + RT_W);
    const int* asg_e = (const int*)(C.ws + WS_ROUTE + RT_E); const int* asg_p = (const int*)(C.ws + WS_ROUTE + RT_P);
    const int s0 = __shfl(ps, asg_e[2 * r]) + asg_p[2 * r], s1 = __shfl(ps, asg_e[2 * r + 1]) + asg_p[2 * r + 1]; o.w0 = asg_w[2 * r]; o.w1 = asg_w[2 * r + 1];
#pragma unroll
    for (int j = 0; j < 4; ++j) { const int c = 4 * C.lane + 256 * j; o.x[j] = *(const v2u*)(XC + (size_t)r * D + c); o.ya[j] = *(const v2u*)(Y2 + (size_t)s0 * D + c); o.yb[j] = *(const v2u*)(Y2 + (size_t)s1 * D + c); }
}
__device__ __forceinline__ void comb_calc(const Ctx& C, int layer, int r, const CombRaw& w, f32x4 (&v)[4]) {
    const float* gate = mod_vec(C, layer, cond_of(r), 5); const float w0 = w.w0, w1 = w.w1;
#pragma unroll
    for (int j = 0; j < 4; ++j) { const int c = 4 * C.lane + 256 * j; const v2u xx = w.x[j], a = w.ya[j], b = w.yb[j]; const f32x4 g = *(const f32x4*)(gate + c);
        v[j].x = bf2f(xx.x & 0xffffu) + g.x * (w0 * bf2f(a.x & 0xffffu) + w1 * bf2f(b.x & 0xffffu)); v[j].y = bf2f(xx.x >> 16) + g.y * (w0 * bf2f(a.x >> 16) + w1 * bf2f(b.x >> 16));
        v[j].z = bf2f(xx.y & 0xffffu) + g.z * (w0 * bf2f(a.y & 0xffffu) + w1 * bf2f(b.y & 0xffffu)); v[j].w = bf2f(xx.y >> 16) + g.w * (w0 * bf2f(a.y >> 16) + w1 * bf2f(b.y >> 16)); }
}
__device__ __forceinline__ void phase_combine_norm_mix1(const Ctx& C) {
    const Params& P = *C.p; bf16* XC = (bf16*)(C.ws + WS_XC); bf16* H = (bf16*)(C.ws + WS_H);
    const int ps = wave_pstart(C, 0), n = C.ngw;
#define CN_ROW(buf, rr, rnext) do { const CombRaw w_ = buf; if ((rnext) < TT) comb_load(C, (rnext), ps, buf); f32x4 v[4]; comb_calc(C, 0, (rr), w_, v); \
        store_row16_bf16(XC + (size_t)(rr) * D, C.lane, v); const float rstd = row_rstd(v); const int ci = cond_of(rr); \
        modulate16(v, rstd, P.in[I_GMIX] + D, mod_vec(C, 1, ci, 1), mod_vec(C, 1, ci, 0), C.lane); store_row16_bf16(H + (size_t)(rr) * D, C.lane, v); } while (0)
    CombRaw a, b; int r = C.gw;
    if (r < TT) comb_load(C, r, ps, a);
    if (r + n < TT) comb_load(C, r + n, ps, b);
    for (; r < TT; r += 2 * n) { CN_ROW(a, r, r + 2 * n); if (r + n < TT) CN_ROW(b, r + n, r + 3 * n); }
#undef CN_ROW
    { const bool early = gridDim.x == 256; if (early) convert_range(C, 1, 0, L1_A, 0); convert_range(C, 1, early ? L1_C : 0, MOE_ITEMS, 0); }
}
__device__ __forceinline__ void phase_final(const Ctx& C) {
    const Params& P = *C.p;
    const int ps = wave_pstart(C, 1), n = C.ngw;
#define FN_ROW(buf, rr, rnext) do { const CombRaw w_ = buf; if ((rnext) < TL) comb_load(C, (rnext), ps, buf); f32x4 v[4]; comb_calc(C, 1, (rr), w_, v); const float rstd = row_rstd(v); \
        _Pragma("unroll") for (int j = 0; j < 4; ++j) { const int c = 4 * C.lane + 256 * j; const f32x4 g = *(const f32x4*)(P.in[I_FING] + c); __builtin_nontemporal_store(v[j] * rstd * g, (f32x4*)(P.out + (size_t)(rr) * D + c)); } } while (0)
    CombRaw a, b; int r = C.gw;
    if (r < TL) comb_load(C, r, ps, a);
    if (r + n < TL) comb_load(C, r + n, ps, b);
    for (; r < TL; r += 2 * n) { FN_ROW(a, r, r + 2 * n); if (r + n < TL) FN_ROW(b, r + n, r + 3 * n); }
#undef FN_ROW
}

__device__ __forceinline__ void phase_s5_fast(const Ctx& C) {
    typedef short bf16x8 __attribute__((ext_vector_type(8)));
    typedef float f32x16 __attribute__((ext_vector_type(16)));
    const Params& P = *C.p; const bf16* U = (const bf16*)(C.ws + WS_U); bf16* GS = (bf16*)(C.ws + WS_GS); float* YA = (float*)(C.ws + WS_YACC);
    const float2* lamb = (const float2*)(C.ws + WS_TAB + TAB_LAMB); const float2* bbar = (const float2*)(C.ws + WS_TAB + TAB_BBAR);
    constexpr int HP = 272;
    const int lane = C.lane, w = C.wave, il = w >> 2, dir = (w >> 1) & 1, nh = w & 1;
    const int l31 = lane & 31, hi = lane >> 5, l15 = lane & 15, q4 = lane >> 4;
    LAS unsigned char* Hb = C.lds + (il * 2 + dir) * (2 * 32 * HP);
    const int srow = 16 * ((l31 >> 2) & 1) + 2 * (l31 >> 3) + ((l31 >> 1) & 1);
    for (int it0 = blockIdx.x; it0 < NB * 16; it0 += gridDim.x) {
        const int item = it0 * 2 + il, b = item >> 5, g = item & 31;
        const int dg = dir * 32 + g, n = nh * 32 + l31;
        const float2 lam = lamb[dg * 64 + n];
        f32x2 p2[16]; { f32x2 p = {lam.x, lam.y};
#pragma unroll
            for (int r = 0; r < 16; ++r) { p2[r] = p; p = (f32x2){p.x * lam.x - p.y * lam.y, p.x * lam.y + p.y * lam.x}; } }
        const f32x2 lx2 = {lam.x, lam.x}, ly2 = {-lam.y, lam.y};
        bf16x8 bre, bim; { const float2* bp = bbar + ((size_t)(dg * 64 + n)) * 16 + 8 * hi;
#pragma unroll
            for (int e = 0; e < 8; ++e) { const float2 v = bp[e]; bre[e] = (short)f2bf(v.x); bim[e] = (short)f2bf(v.y); } }
        bf16x8 cf[4]; { const float* cre = P.in[I_CRE] + ((size_t)dg * 16 + l15) * 64; const float* cim = P.in[I_CIM] + ((size_t)dg * 16 + l15) * 64;
#pragma unroll
            for (int ks = 0; ks < 4; ++ks) { const f32x4 a = *(const f32x4*)(cre + 16 * ks + 4 * q4), m = *(const f32x4*)(cim + 16 * ks + 4 * q4);
                cf[ks][0] = (short)f2bf(a.x); cf[ks][1] = (short)f2bf(-m.x); cf[ks][2] = (short)f2bf(a.y); cf[ks][3] = (short)f2bf(-m.y);
                cf[ks][4] = (short)f2bf(a.z); cf[ks][5] = (short)f2bf(-m.z); cf[ks][6] = (short)f2bf(a.w); cf[ks][7] = (short)f2bf(-m.w); } }
        const f32x4 dsk = *(const f32x4*)(P.in[I_S5D] + g * 16 + 4 * q4);
        f32x2 carry = {0.f, 0.f};
#define S5_UROW(kk, off) ({ const int S_ = 32 * (kk) + srow + (off); (S_ < CTXL) ? ((size_t)TL + (size_t)b * CTXL + (dir == 0 ? S_ : CTXL - 1 - S_)) : ((size_t)b * SEQ + (dir == 0 ? S_ - CTXL : SEQ - 1 - (S_ - CTXL))); })
        const bool odd = l31 & 1;
#define S5_ULD(kk, off) (*(const bf16x8*)(U + S5_UROW(kk, off) * 512 + g * 16 + 8 * hi))
        bf16x8 ux1 = S5_ULD(0, 0), uy1 = S5_ULD(0, 8), ux2 = S5_ULD(1, 0), uy2 = S5_ULD(1, 8), ux3 = S5_ULD(2, 0), uy3 = S5_ULD(2, 8);
        f32x4 pk_n = {0.f, 0.f, 0.f, 0.f}; v2u uu_n = {0u, 0u};
        for (int k = 0; k < 72; ++k) {
            const bf16x8 ux = ux1, uy = uy1; ux1 = ux2; uy1 = uy2; ux2 = ux3; uy2 = uy3;
            if (k + 3 < 72) { ux3 = S5_ULD(k + 3, 0); uy3 = S5_ULD(k + 3, 8); }
            const int sl = 32 * (k - 8) + 16 * nh + l15;
            const int tok = dir == 0 ? sl : SEQ - 1 - sl; const int lt = tok >> 5;
            const size_t o = ((size_t)b * SEQ + (k >= 8 ? tok : 0)) * 512 + g * 16 + 4 * q4;
            const bool first = dir == 0 ? (lt < 32) : (lt >= 32);
#define S5_RLOAD(oo, pk_, uu_) do { pk_.x = __hip_atomic_load(YA + (oo), __ATOMIC_RELAXED, __HIP_MEMORY_SCOPE_AGENT); pk_.y = __hip_atomic_load(YA + (oo) + 1, __ATOMIC_RELAXED, __HIP_MEMORY_SCOPE_AGENT); \
                pk_.z = __hip_atomic_load(YA + (oo) + 2, __ATOMIC_RELAXED, __HIP_MEMORY_SCOPE_AGENT); pk_.w = __hip_atomic_load(YA + (oo) + 3, __ATOMIC_RELAXED, __HIP_MEMORY_SCOPE_AGENT); uu_ = *(const v2u*)(U + (oo)); } while (0)
            f32x4 pk = pk_n; v2u uu = uu_n;
            if (k == 40) S5_RLOAD(o, pk, uu);
            if (k >= 40 && k + 1 < 72) { const int sl1 = 32 * (k + 1 - 8) + 16 * nh + l15; const int tok1 = dir == 0 ? sl1 : SEQ - 1 - sl1; const size_t o1 = ((size_t)b * SEQ + tok1) * 512 + g * 16 + 4 * q4; S5_RLOAD(o1, pk_n, uu_n); }
            {
              const bf16x8 zf = {0, 0, 0, 0, 0, 0, 0, 0};
              f32x16 X = {}, Y = {};
              X = __builtin_amdgcn_mfma_f32_32x32x16_bf16(odd ? zf : ux, bre, X, 0, 0, 0); X = __builtin_amdgcn_mfma_f32_32x32x16_bf16(odd ? ux : zf, bim, X, 0, 0, 0);
              Y = __builtin_amdgcn_mfma_f32_32x32x16_bf16(odd ? zf : uy, bre, Y, 0, 0, 0); Y = __builtin_amdgcn_mfma_f32_32x32x16_bf16(odd ? uy : zf, bim, Y, 0, 0, 0);
              f32x2 s2 = hi ? (f32x2){0.f, 0.f} : carry;
#pragma unroll
              for (int q = 0; q < 8; ++q) { const f32x2 bq = {X[2 * q], X[2 * q + 1]}, sw = {s2.y, s2.x}; s2 = lx2 * s2 + bq; s2 = ly2 * sw + s2; X[2 * q] = s2.x; X[2 * q + 1] = s2.y; }
#pragma unroll
              for (int q = 0; q < 8; ++q) { const f32x2 bq = {Y[2 * q], Y[2 * q + 1]}, sw = {s2.y, s2.x}; s2 = lx2 * s2 + bq; s2 = ly2 * sw + s2; Y[2 * q] = s2.x; Y[2 * q + 1] = s2.y; }
              float er = __shfl_xor(s2.x, 32), ei = __shfl_xor(s2.y, 32); if (!hi) { er = 0.f; ei = 0.f; }
              const f32x2 er2 = {er, er}, ei2 = {ei, ei};
#pragma unroll
              for (int q = 0; q < 8; ++q) { const f32x2 p = p2[q], ps = {-p.y, p.x}; f32x2 h = {X[2 * q], X[2 * q + 1]}; h = er2 * p + h; h = ei2 * ps + h; X[2 * q] = h.x; X[2 * q + 1] = h.y; }
#pragma unroll
              for (int q = 0; q < 8; ++q) { const f32x2 p = p2[8 + q], ps = {-p.y, p.x}; f32x2 h = {Y[2 * q], Y[2 * q + 1]}; h = er2 * p + h; h = ei2 * ps + h; Y[2 * q] = h.x; Y[2 * q + 1] = h.y; }
              carry = (f32x2){__shfl_xor(Y[14], 32), __shfl_xor(Y[15], 32)};
              LAS unsigned char* hb = Hb + (k & 1) * (32 * HP) + (16 * hi) * HP + 4 * n;
#pragma unroll
              for (int q = 0; q < 8; ++q) { *(LAS unsigned*)(hb + q * HP) = pk2(X[2 * q], X[2 * q + 1]); *(LAS unsigned*)(hb + (8 + q) * HP) = pk2(Y[2 * q], Y[2 * q + 1]); }
            }
            asm volatile("s_waitcnt lgkmcnt(0)\n\ts_barrier" ::: "memory");
            if (k >= 8) {
                const LAS unsigned char* hr = Hb + (k & 1) * (32 * HP) + (16 * nh + l15) * HP + 16 * q4;
                f32x4 y = {0.f, 0.f, 0.f, 0.f};
#pragma unroll
                for (int ks = 0; ks < 4; ++ks) { const bf16x8 hf = *(const LAS bf16x8*)(hr + 64 * ks); y = __builtin_amdgcn_mfma_f32_16x16x32_bf16(cf[ks], hf, y, 0, 0, 0); }
                if (first) { *(f32x4*)(YA + o) = y; }
                else {
                    const f32x4 uf = {bf2f(uu.x & 0xffffu), bf2f(uu.x >> 16), bf2f(uu.y & 0xffffu), bf2f(uu.y >> 16)};
                    const f32x4 t = y + pk + dsk * uf;
                    v2u ov; ov.x = pk2(gelu_tanh(t.x), gelu_tanh(t.y)); ov.y = pk2(gelu_tanh(t.z), gelu_tanh(t.w)); *(v2u*)(GS + o) = ov;
                }
            }
            if (k == 39) asm volatile("s_waitcnt vmcnt(0)\n\ts_barrier" ::: "memory");
        }
#undef S5_UROW
#undef S5_ULD
#undef S5_RLOAD
        asm volatile("s_waitcnt vmcnt(0) lgkmcnt(0)\n\ts_barrier" ::: "memory");
    }
}

__global__ void __launch_bounds__(NTHR, 2) fwd_kernel(Params prm) {
    extern __shared__ __attribute__((aligned(16))) unsigned char lds_raw[];
    Ctx C; C.p = &prm; C.ws = prm.ws; C.lds = (LAS unsigned char*)lds_raw;
    C.tid = threadIdx.x; C.lane = C.tid & 63; C.wave = __builtin_amdgcn_readfirstlane(C.tid >> 6);
    C.gw = blockIdx.x * NWAVE + C.wave; C.ngw = gridDim.x * NWAVE;
    constexpr int LDS_MISC = 147456 - 512;
    volatile LAS unsigned* misc = (volatile LAS unsigned*)(C.lds + LDS_MISC);
    if (C.tid < 64) misc[C.tid] = 0u;
    __syncthreads();
    unsigned* ctl = (unsigned*)(C.ws + WS_CTL);
    XcdBarrier bar; bar.bar = ctl + CW_BAR; bar.x = 0; bar.st = nullptr;
#if MK_ONE_LAUNCH
    bar = xcd_barrier_post(ctl + CW_BAR, misc + 8);
#define SEAM(k) do { if (lo <= (k) && (k) + 1 < hi) xcd_barrier(bar); } while (0)
#else
#define SEAM(k) do { } while (0)
#endif
    const int lo = prm.ph_lo, hi = prm.ph_hi;
#define IN(k) ((C.lane = lane_id_now(), C.tid = C.wave * 64 + C.lane, true) && lo <= (k) && (k) < hi)
#if MK_PROBE
#define STAMP(k) STAMP_AT((k) + 1)
    STAMP_AT(0);
#else
#define STAMP(k) do { } while (0)
#endif
    const Params& P = prm;
    bf16* Hb = (bf16*)(C.ws + WS_H); bf16* XC = (bf16*)(C.ws + WS_XC);
#define MOE_MAP(layer) do { LAS int* tm_ = (LAS int*)(C.lds + 131072); LAS int* cl_ = tm_ + 320; \
        if (C.wave == 0) { const unsigned* cnt_ = (const unsigned*)(C.ws + WS_CTL) + CW_CNT + 64 * (layer); const int mc_ = C.lane < 32 ? (int)__hip_atomic_load(cnt_ + (C.lane & 31), __ATOMIC_RELAXED, __HIP_MEMORY_SCOPE_AGENT) : 0; const int mp_ = (mc_ + 255) & ~255; int in_ = mp_; \
            _Pragma("unroll") for (int o_ = 1; o_ < 32; o_ <<= 1) { const int t_ = __shfl_up(in_, o_); if ((C.lane & 31) >= o_) in_ += t_; } const int ps_ = in_ - mp_; \
            if (C.lane < 32) { for (int t_ = ps_ / 256; t_ < (ps_ + mp_) / 256; ++t_) tm_[t_] = C.lane | ((t_ * 256 - ps_) << 8); cl_[C.lane] = mc_; if (C.lane == 31) cl_[32] = (ps_ + mp_) / 256; } } \
        __syncthreads(); } while (0)
#define MOE_GEMM1(layer) do { MOE_MAP(layer); const LAS int* tm_ = (const LAS int*)(C.lds + 131072); const int ntl_ = __builtin_amdgcn_readfirstlane(tm_[320 + 32]); pg8::Gemm g{Hb, (const bf16*)(C.ws + ((layer) ? WS_W13B : WS_W13)), 0, 1024, 512}; \
        pg8::GroupedOrder<true> S{tm_, tm_ + 320, (const int*)(C.ws + WS_LIST), ntl_ * 4, 4, (int)gridDim.x, (int)blockIdx.x, LCAP, 1024, (size_t)1024 * 1024}; pg8::EpiSwiglu E{(unsigned char*)(C.ws + WS_G13), 1.f / W13_SCALE, G_SCALE}; \
        pg8::gemm_phase<pg8::EpiSwiglu, pg8::GroupedOrder<true>, true, false, false, true>(C.lds, g, S, E, C.wave); } while (0)
#define MOE_GEMM2(layer) do { MOE_MAP(layer); int kk_ = EH / 2; asm volatile("" : "+s"(kk_));     \
        const LAS int* tm_ = (const LAS int*)(C.lds + 131072); const int ntl_ = __builtin_amdgcn_readfirstlane(tm_[320 + 32]); pg8::Gemm g{(const bf16*)(C.ws + WS_G13), (const bf16*)(C.ws + ((layer) ? WS_W2B : WS_W2)), 0, 1024, kk_}; \
        pg8::GroupedOrder<false> S{tm_, tm_ + 320, (const int*)(C.ws + WS_LIST), ntl_ * 4, 4, (int)gridDim.x, (int)blockIdx.x, LCAP, EH, (size_t)1024 * 512}; pg8::EpiStore E{(bf16*)(C.ws + WS_XS), D, 1.f / (W13_SCALE * G_SCALE)}; \
        pg8::gemm_phase<pg8::EpiStore, pg8::GroupedOrder<false>, true, false, false, true>(C.lds, g, S, E, C.wave); } while (0)
    if (IN(0)) { phase_prologue(C); SEAM(0); STAMP(0); }
    if (IN(1)) { phase_norm_mix0(C); SEAM(1); STAMP(1); }
    if (IN(2)) { pg8::Gemm g{Hb, (const bf16*)(C.ws + WS_WIN0), TT, MIXW, D / 2};
        pg8::StaticOrder S; S.init(TT, MIXW, gridDim.x, blockIdx.x); pg8::EpiInProj E{(bf16*)(C.ws + WS_P), (bf16*)(C.ws + WS_K), (bf16*)(C.ws + WS_V), P.in[I_KG], (const float*)(C.ws + WS_TAB + TAB_ROPE), (LAS float*)(C.lds + 135168), 1.f / W13_SCALE, (float*)(C.ws + WS_Q)};
        pg8::gemm_phase<pg8::EpiInProj, pg8::StaticOrder, true, false, false, true>(C.lds, g, S, E, C.wave); SEAM(2); STAMP(2); }
    if (IN(4)) { phase_gmlp_fast(C); phase_attn_fast(C, (char*)lds_raw); SEAM(4); STAMP(4); }
    if (IN(5)) { pg8::Gemm g{Hb, (const bf16*)(C.ws + WS_WOUT0), TT, D, D}; pg8::StaticOrder S; S.init(TT, D, gridDim.x, blockIdx.x); pg8::EpiResid E{P.in[I_X], P.in[I_CTX], (const float*)(C.ws + WS_MOD), XC, 0};
        pg8::gemm_phase<pg8::EpiResid, pg8::StaticOrder, true, true, true>(C.lds, g, S, E, C.wave);
        if (gridDim.x == 256) { __syncthreads(); convert_range(C, 0, L0_A, L0_B, 64); }
        SEAM(5); STAMP(5); }
    if (IN(6)) { phase_router_fast(C, 0, TT); if (gridDim.x == 256) { __syncthreads(); convert_range(C, 0, L0_B, MOE_ITEMS, 32); } SEAM(6); STAMP(6); }
    if (IN(8)) { MOE_GEMM1(0); SEAM(8); STAMP(8); }
    if (IN(9)) { MOE_GEMM2(0); if (gridDim.x == 256) { __syncthreads(); convert_range(C, 1, L1_A, L1_B, 192); } SEAM(9); STAMP(9); }
    if (IN(10)) { phase_combine_norm_mix1(C); SEAM(10); STAMP(10); }
    if (IN(11)) { pg8::Gemm g{Hb, (const bf16*)(C.ws + WS_WS5IN), TT, 512, D}; pg8::StaticOrder S; S.init(TT, 512, gridDim.x, blockIdx.x); pg8::EpiStore E{(bf16*)(C.ws + WS_U), 512, 1.f};
        pg8::gemm_phase<pg8::EpiStore, pg8::StaticOrder, true, true, true>(C.lds, g, S, E, C.wave);
        if (gridDim.x == 256) { __syncthreads(); convert_range(C, 1, L1_B, L1_C, 32); }
        SEAM(11); STAMP(11); }
    if (IN(12)) { phase_s5_fast(C); SEAM(12); STAMP(12); }
    if (IN(13)) { pg8::Gemm g{(const bf16*)(C.ws + WS_GS), (const bf16*)(C.ws + WS_WGLU), TL, 512, 512}; pg8::StaticOrder S; S.init(TL, 512, gridDim.x, blockIdx.x); pg8::EpiGlu E{(const bf16*)(C.ws + WS_GS), P.in[I_BGLU], (bf16*)(C.ws + WS_GG)};
        pg8::gemm_phase<pg8::EpiGlu, pg8::StaticOrder, true, true, true>(C.lds, g, S, E, C.wave); SEAM(13); STAMP(13); }
    if (IN(14)) { pg8::Gemm g{(const bf16*)(C.ws + WS_GG), (const bf16*)(C.ws + WS_WS5OUT), TL, D, 512}; pg8::StaticOrder S; S.init(TL, D, gridDim.x, blockIdx.x); pg8::EpiResid E{P.in[I_X], P.in[I_CTX], (const float*)(C.ws + WS_MOD) + (size_t)17 * 6 * D, XC, 1};
        pg8::gemm_phase<pg8::EpiResid, pg8::StaticOrder, true, true, true>(C.lds, g, S, E, C.wave); SEAM(14); STAMP(14); }
    if (IN(15)) { phase_router_fast(C, 1, TL); SEAM(15); STAMP(15); }
    if (IN(17)) { MOE_GEMM1(1); SEAM(17); STAMP(17); }
    if (IN(18)) { MOE_GEMM2(1); SEAM(18); STAMP(18); }
    if (IN(19)) { phase_final(C); STAMP(19); }
#if MK_PROBE
    if (blockIdx.x == 0 && C.wave == 0 && lane_id_now() == 0) {
        volatile LAS unsigned long long* ts_ = (volatile LAS unsigned long long*)(C.lds + LDS_MISC + 64);
        ts_[8] = ts_[7]; ts_[17] = ts_[16];
        const unsigned long long tA = ts_[PROBE_A_HI + 1] - ts_[PROBE_A_LO], tB = ts_[PROBE_B_HI + 1] - ts_[PROBE_B_LO];
        const unsigned long long spin = 16ull * tA + 1000000ull * ((tB + 500ull) / 1000ull);
        const unsigned long long t0 = __builtin_amdgcn_s_memrealtime();
        while (__builtin_amdgcn_s_memrealtime() - t0 < spin) __builtin_amdgcn_s_sleep(8);
    }
#endif
#undef IN
#undef SEAM
}

extern "C" void kernel_launch(void* const* d_in, const int* in_sizes, int n_in, void* d_out, int out_size, void* d_ws, size_t ws_size, hipStream_t stream) {
    constexpr int LDS_BYTES = 147456;
    static int grid = 0;
    if (grid == 0) {
        if (n_in != 35 || out_size != TL * D || ws_size < WS_END) { fprintf(stderr, "kernel_launch: unexpected shapes (n_in %d out %d ws %zu)\n", n_in, out_size, ws_size); grid = -1; return; }
        int dev = 0, cus = 0;
        if (hipGetDevice(&dev) != hipSuccess || hipDeviceGetAttribute(&cus, hipDeviceAttributeMultiprocessorCount, dev) != hipSuccess) { grid = -1; return; }
        if (hipFuncSetAttribute((const void*)fwd_kernel, hipFuncAttributeMaxDynamicSharedMemorySize, LDS_BYTES) != hipSuccess) { fprintf(stderr, "kernel_launch: hipFuncSetAttribute failed\n"); grid = -1; return; }
        (void)hipGetLastError();
        grid = cus;
    }
    if (grid < 0) return;
    (void)hipMemsetAsync((char*)d_ws + WS_CTL, 0, CTL_BYTES, stream);
    Params p{};
    for (int i = 0; i < 35; ++i) p.in[i] = (const float*)d_in[i];
    p.out = (float*)d_out; p.ws = (unsigned char*)d_ws;
#if MK_ONE_LAUNCH
    p.ph_lo = 0; p.ph_hi = NPHASE;
    hipLaunchKernelGGL(fwd_kernel, dim3(grid), dim3(NTHR), LDS_BYTES, stream, p);
#else
    for (int k = 0; k < NPHASE; ++k) { p.ph_lo = k; p.ph_hi = k + 1; hipLaunchKernelGGL(fwd_kernel, dim3(grid), dim3(NTHR), LDS_BYTES, stream, p); }
#endif
}
```

```cpp
#include <hip/hip_runtime.h>
#include <cstdio>
#include <cstdint>
#include <type_traits>

#ifndef MK_ONE_LAUNCH
#define MK_ONE_LAUNCH 1
#endif
#ifndef MK_SIMPLE_ORDER
#define MK_SIMPLE_ORDER 0
#endif
#ifndef MK_KROT
#define MK_KROT 0
#endif
#ifndef MK_PROBE
#define MK_PROBE 0
#endif
#define PROBE_A_LO 4
#define PROBE_A_HI 4
#define PROBE_B_LO 8
#define PROBE_B_HI 9

constexpr int D = 1024, NB = 16, SEQ = 2048, CTXL = 256;
constexpr int TL = NB * SEQ, TC = NB * CTXL, TT = TL + TC;
constexpr int KVL = CTXL + SEQ;
constexpr int MIXW = 1792, NEXP = 32, EH = 512;
constexpr int NSLOT = 81920;
constexpr float EPS = 1e-6f;
constexpr float QSCALE = 0.125f * 1.4426950408889634f;
constexpr int NTHR = 512, NWAVE = 8;
constexpr float W13_SCALE = 32.f;
constexpr float G_SCALE = 8.f;
constexpr int NPHASE = 20;

constexpr size_t MiB = 1u << 20;
constexpr size_t WS_CTL = 0, CTL_BYTES = 1 * MiB;
constexpr size_t WS_MOD = 1 * MiB;
constexpr size_t WS_TAB = 2 * MiB;
constexpr size_t TAB_ROPE = 0, TAB_LAMB = 16384, TAB_BBAR = 65536, TAB_WR = 640 * 1024;
constexpr size_t WS_ROUTE = 3 * MiB;
constexpr size_t RT_E = 0, RT_P = 320 * 1024, RT_W = 640 * 1024, RT_S = 960 * 1024, RT_TILE = 1280 * 1024, RT_NT = 1280 * 1024 + 4096;
constexpr size_t WS_WIN0 = 6 * MiB, WS_WOUT0 = 10 * MiB, WS_WS5IN = 12 * MiB, WS_WGLU = 13 * MiB, WS_WS5OUT = 14 * MiB;
constexpr size_t WS_WSP = 15 * MiB;
constexpr size_t WS_W13 = 16 * MiB, WS_W2 = 80 * MiB;
constexpr size_t WS_W13B = 184 * MiB, WS_W2B = 216 * MiB;
constexpr int L0_A = 4096, L0_B = L0_A + 0;
constexpr int L1_A = 2048, L1_B = L1_A + 4096, L1_C = L1_B + 7168;
constexpr size_t WS_XC = 112 * MiB;
constexpr size_t WS_H = 256 * MiB;
constexpr size_t WS_P = 328 * MiB;
constexpr size_t WS_Q = 454 * MiB, WS_K = 490 * MiB, WS_V = 499 * MiB;
constexpr size_t WS_XS = 328 * MiB;
constexpr size_t WS_G13 = 488 * MiB;
constexpr size_t WS_U = 328 * MiB, WS_GS = 364 * MiB, WS_GG = 396 * MiB, WS_YACC = 428 * MiB;
constexpr size_t WS_LIST = 568 * MiB;
constexpr int LCAP = 36864;
constexpr size_t WS_END = 574 * MiB;
constexpr int CW_CNT = 64;
constexpr int CW_BAR = 4096;

__device__ __forceinline__ int lane_id_now() { int l; asm volatile("v_mbcnt_lo_u32_b32 %0, -1, 0\n\tv_mbcnt_hi_u32_b32 %0, -1, %0\n\ts_nop 0" : "=v"(l)); return l; }
#define STAMP_AT(idx) do { if (MK_PROBE && blockIdx.x == 0 && C.wave == 0 && lane_id_now() == 0) ((volatile __attribute__((address_space(3))) unsigned long long*)(C.lds + 147456 - 512 + 64))[idx] = __builtin_amdgcn_s_memrealtime(); } while (0)
#define LAS __attribute__((address_space(3)))
typedef unsigned short bf16;
typedef unsigned v4u __attribute__((ext_vector_type(4)));
typedef unsigned v2u __attribute__((ext_vector_type(2)));
typedef float f32x4 __attribute__((ext_vector_type(4)));
typedef float f32x2 __attribute__((ext_vector_type(2)));
__device__ __forceinline__ float bf2f(unsigned u) { return __uint_as_float(u << 16); }
typedef __bf16 bf16x2_t __attribute__((ext_vector_type(2)));
__device__ __forceinline__ unsigned pk2(float lo, float hi) { const f32x2 v = {lo, hi}; return __builtin_bit_cast(unsigned, __builtin_convertvector(v, bf16x2_t)); }
__device__ __forceinline__ unsigned f2bf(float f) { return pk2(f, 0.f) & 0xffffu; }
__device__ __forceinline__ float wave_sum(float v) {
#pragma unroll
    for (int o = 1; o < 64; o <<= 1) v += __shfl_xor(v, o);
    return v;
}
__device__ __forceinline__ float wave_max(float v) {
#pragma unroll
    for (int o = 1; o < 64; o <<= 1) v = fmaxf(v, __shfl_xor(v, o));
    return v;
}
__device__ __forceinline__ float gelu_tanh(float x) { const float u2 = -1.5957691216057308f * (x + 0.044715f * x * x * x); return x * __builtin_amdgcn_rcpf(1.f + __expf(u2)); }
__device__ __forceinline__ float sigmoidf_(float x) { return 1.f / (1.f + __expf(-x)); }
__device__ __forceinline__ float silu_(float x) { return x / (1.f + __expf(-x)); }
__device__ __forceinline__ void unpack8(const v4u w, float* f) {
    f[0] = bf2f(w.x & 0xffffu); f[1] = bf2f(w.x >> 16); f[2] = bf2f(w.y & 0xffffu); f[3] = bf2f(w.y >> 16);
    f[4] = bf2f(w.z & 0xffffu); f[5] = bf2f(w.z >> 16); f[6] = bf2f(w.w & 0xffffu); f[7] = bf2f(w.w >> 16);
}

#define XB_TMO      128
#define XB_XCNT(j)  (256  + 64 * (j))
#define XB_XSUB(j)  (1280 + 64 * (j))
#define XB_XGEN(j)  (2304 + 64 * (j))
#define XB_TOP      3328
#define XB_TOPGEN   3392
#define XCD_BAR_WORDS 3456
#define XB_SPIN_CAP (1u << 28)
__device__ __forceinline__ unsigned xb_ld(unsigned* p)              { return __hip_atomic_load(p, __ATOMIC_RELAXED, __HIP_MEMORY_SCOPE_AGENT); }
__device__ __forceinline__ unsigned xb_add(unsigned* p, unsigned v) { return __hip_atomic_fetch_add(p, v, __ATOMIC_RELAXED, __HIP_MEMORY_SCOPE_AGENT); }
__device__ __forceinline__ unsigned xb_xcc_id() { return (unsigned)__builtin_amdgcn_s_getreg((3 << 11) | 20) & 0xFu; }
#define XB_SPIN(cond, bar) do { unsigned _sp = 0; while (cond) { __builtin_amdgcn_s_sleep(1); \
    if ((++_sp & 255u) == 0u) { if (xb_ld(&(bar)[XB_TMO])) break; if (_sp > XB_SPIN_CAP) { atomicAdd(&(bar)[XB_TMO], 1u); break; } } } } while (0)
struct XcdBarrier { unsigned* bar; unsigned x; volatile LAS unsigned* st; };
__device__ __forceinline__ XcdBarrier xcd_barrier_post(unsigned* bar, volatile LAS unsigned* st) {
    XcdBarrier b; b.bar = bar; b.x = xb_xcc_id(); b.st = st;
    if (threadIdx.x == 0) (void)xb_add(&bar[XB_XCNT(b.x)], 1u);
    return b;
}
__device__ __forceinline__ void xcd_barrier_complete(unsigned* bar, unsigned x, unsigned& nloc, unsigned& nx) {
    const unsigned G = gridDim.x * gridDim.y * gridDim.z;
    unsigned sum, cnt, mine, sp = 0u;
    for (;;) {
        sum = 0u; cnt = 0u; mine = 0u;
#pragma unroll
        for (unsigned j = 0; j < 16; ++j) { const unsigned c = xb_ld(&bar[XB_XCNT(j)]); sum += c; cnt += (c > 0u) ? 1u : 0u; mine = (j == x) ? c : mine; }
        if (sum == G) break;
        __builtin_amdgcn_s_sleep(1);
        if ((++sp & 255u) == 0u) { if (xb_ld(&bar[XB_TMO])) break; if (sp > XB_SPIN_CAP) { atomicAdd(&bar[XB_TMO], 1u); break; } }
    }
    nloc = mine > 0u ? mine : 1u; nx = cnt > 0u ? cnt : 1u;
}
__device__ __forceinline__ void xcd_barrier(const XcdBarrier& b) {
    asm volatile("s_waitcnt vmcnt(0)" ::: "memory");
    __syncthreads();
    if (threadIdx.x == 0) {
        unsigned* bar = b.bar;
        __builtin_amdgcn_s_waitcnt(0);
        unsigned nloc = b.st[0], nx = b.st[1];
        if (nloc == 0u) { xcd_barrier_complete(bar, b.x, nloc, nx); b.st[0] = nloc; b.st[1] = nx; }
        const unsigned old = xb_add(&bar[XB_XSUB(b.x)], 1u);
        const unsigned gen = old / nloc;
        if (old + 1u == (gen + 1u) * nloc) {
            __builtin_amdgcn_fence(__ATOMIC_RELEASE, "agent");
            asm volatile("s_waitcnt vmcnt(0)" ::: "memory");
            const unsigned og = xb_add(&bar[XB_TOP], 1u);
            const unsigned tg = og / nx;
            if (og + 1u == (tg + 1u) * nx) xb_add(&bar[XB_TOPGEN], 1u);
            else XB_SPIN(xb_ld(&bar[XB_TOPGEN]) == tg, bar);
            __builtin_amdgcn_fence(__ATOMIC_ACQUIRE, "agent");
            xb_add(&bar[XB_XGEN(b.x)], 1u);
            asm volatile("s_waitcnt vmcnt(0)" ::: "memory");
        } else {
            XB_SPIN(xb_ld(&bar[XB_XGEN(b.x)]) == gen, bar);
            __builtin_amdgcn_fence(__ATOMIC_ACQUIRE, "agent");
            asm volatile("s_waitcnt vmcnt(0)" ::: "memory");
        }
    }
    __syncthreads();
}

namespace pg8 {
#define PG8_LAS __attribute__((address_space(3)))
typedef unsigned short bf16_t;
typedef short bf16x8 __attribute__((ext_vector_type(8)));
typedef float f32x4 __attribute__((ext_vector_type(4)));
typedef unsigned u32x4 __attribute__((ext_vector_type(4)));
typedef int i32x4 __attribute__((ext_vector_type(4)));
typedef unsigned u32x2 __attribute__((ext_vector_type(2)));
constexpr int BM = 256, BK = 64, HALF = 128, HTB = HALF * BK * 2  , STAGE_BYTES = 8 * HTB, NXCD = 8, WGM = 8;

__host__ __device__ __forceinline__ int lds_byte(int r, int c) { const int st = (r >> 4) * 2 + (c >> 5), rr = r & 15, cc = c & 31, ob = rr * 64 + cc * 2; return st * 1024 + (ob ^ (((ob >> 9) & 1) << 5)); }
__host__ __device__ __forceinline__ void stage_rc(int b, int& R, int& C) { const int st = b / 1024, sb = b % 1024, swz = sb ^ (((sb >> 9) & 1) << 5); R = (st >> 1) * 16 + swz / 64; C = (st & 1) * 32 + (swz % 64) / 2; }
__host__ __device__ __forceinline__ int perm32(int rho) { const int n = rho >> 4, i = rho & 15; return 8 * (i >> 2) + 4 * n + (i & 3); }

struct Unit { int pm, pn; size_t bo; int aux; int half; };
struct Gemm { const bf16_t* A; const bf16_t* Bt; int M, N, K; };

template <bool HALVES>
struct StaticOrderT {
    static constexpr bool GATHER = false;
    int nM, nN, nwg, G, c, halves;
    __host__ __device__ void init(int M, int N, int G_, int c_, int halves_ = 0) { nM = M / BM; nN = N / BM; nwg = nM * nN; G = G_; c = c_; halves = HALVES && halves_ && (G_ & 15) == 0; }
    __host__ __device__ bool next(int i, Unit& u) const {
        long L = (long)i * G + c; u.half = 0;
        if (HALVES && halves) { const int il = nwg / G, rem = nwg - il * G; if (i == il && rem > 0 && 2 * rem <= G) { const int j = (c >> 4) * 8 + (c & 7); if (j >= rem) return false; L = (long)il * G + j; u.half = 1 + ((c >> 3) & 1); } }
        if (L >= nwg) return false;
        if (MK_SIMPLE_ORDER) { u.pm = (int)L / nN; u.pn = (int)L % nN; u.bo = 0; u.aux = 0; return true; }
        int wgid = (int)L; { const int q = nwg / NXCD, r = nwg % NXCD, xcd = wgid % NXCD, off = wgid / NXCD; wgid = (xcd < r ? xcd * (q + 1) : r * (q + 1) + (xcd - r) * q) + off; }
        const int nig = WGM * nN, gid = wgid / nig, fm = gid * WGM, gsz = (nM - fm) < WGM ? (nM - fm) : WGM;
        u.pm = fm + ((wgid % nig) % gsz); u.pn = (wgid % nig) / gsz; u.bo = 0; u.aux = 0; return true;
    }
    __device__ __forceinline__ void a_ready(const Unit&) const {}
    __device__ __forceinline__ void done(const Unit&) const {}
};
typedef StaticOrderT<false> StaticOrder; typedef StaticOrderT<true> StaticOrderH;

typedef __bf16 bf16x2_c __attribute__((ext_vector_type(2))); typedef float f32x2_c __attribute__((ext_vector_type(2)));
__device__ __forceinline__ unsigned cvt_pk_bf16(float lo, float hi) { const f32x2_c v = {lo, hi}; return __builtin_bit_cast(unsigned, __builtin_convertvector(v, bf16x2_c)); }
typedef float f32x2 __attribute__((ext_vector_type(2)));
__device__ __forceinline__ f32x2 gelu_pk(f32x2 v) {
    const f32x2 av = __builtin_elementwise_abs(v), d = av * 0.2316418882f + 1.0f;
    f32x2 t; t.x = __builtin_amdgcn_rcpf(d.x); t.y = __builtin_amdgcn_rcpf(d.y);
    f32x2 q = t * 0.5307027145f + (-0.7265760135f); q = q * t + 0.7107068705f; q = q * t + (-0.142248368f); q = q * t + 0.127414796f; q = q * t;
    const f32x2 s = (v * v) * (-0.72134752044f);
    f32x2 e; e.x = __builtin_amdgcn_exp2f(s.x); e.y = __builtin_amdgcn_exp2f(s.y);
    const f32x2 m = v * (q * e), r = v - m;
    f32x2 o; o.x = v.x < 0.f ? m.x : r.x; o.y = v.y < 0.f ? m.y : r.y; return o;
}

template <class Epi, class Sched, bool ALIGN_EPI = false, bool SP2 = false, bool KROT = false, bool FP8 = false>
__device__ __forceinline__ void gemm_phase(PG8_LAS unsigned char* lds, const Gemm g, const Sched& S, const Epi& E, const int wave_id) {
    const int wid = __builtin_amdgcn_readfirstlane(wave_id), lane = lane_id_now(), tid = wid * 64 + lane, wr = wid >> 2, wc = wid & 3, fr = lane & 15, fq = lane >> 4;
    const int K = g.K, nt = K / BK;
    const int kmask = nt - 1, rot = (MK_KROT && KROT) ? (int)((blockIdx.x * 3u + (blockIdx.x >> 3)) & (unsigned)kmask) : 0;
#define PG8_KO(j) ((size_t)(((j) + rot) & kmask) * kstep)
    unsigned voffA[2], voffB[2];
    unsigned vC[2][2], vN[2][2];
#pragma unroll
    for (int i = 0; i < 2; ++i) { int R, C; stage_rc(tid * 16 + i * 8192, R, C); const int Rb = Epi::PERM ? ((R & ~31) + perm32(R & 31)) : R;
        voffA[i] = (unsigned)(R * K + C) * 2u; voffB[i] = (unsigned)(Rb * K + C) * 2u; }
    const size_t kstep = (size_t)(BK * 2);
    const size_t hstep = (size_t)HALF * K * 2;
    const size_t tstep = 2 * hstep;
    const unsigned ldsw = (unsigned)wid * 1024u;
    const int aoff = lds_byte(wr * 64 + fr, fq * 8), boff = lds_byte(wc * 32 + fr, fq * 8);
#define PG8_SA(b, h) (((b) * 2 + (h)) * HTB)
#define PG8_SB(b, h) ((4 + (b) * 2 + (h)) * HTB)
#define PG8_STAGE(bufoff, gbase, voff) do { _Pragma("unroll") for (int _i = 0; _i < 2; ++_i) \
        __builtin_amdgcn_global_load_lds((const unsigned*)((const char*)(gbase) + (voff)[_i]), (PG8_LAS unsigned*)(lds + (bufoff) + ldsw + _i * 8192), 16, 0, 0); } while (0)
#define PG8_STAGE_A(bufoff, gbase, h, nx) do { _Pragma("unroll") for (int _i = 0; _i < 2; ++_i) { \
        const unsigned _vo = Sched::GATHER ? ((nx) ? vN[h][_i] : vC[h][_i]) : (unsigned)((h) * hstep) + voffA[_i]; \
        __builtin_amdgcn_global_load_lds((const unsigned*)((const char*)(gbase) + _vo), (PG8_LAS unsigned*)(lds + (bufoff) + ldsw + _i * 8192), 16, 0, 0); } } while (0)
#define PG8_LDA(dst, b, h) do { _Pragma("unroll") for (int m = 0; m < 4; ++m) { if constexpr (FP8) { dst[m].lo = *(const PG8_LAS i32x4*)(lds + PG8_SA(b, h) + aoff + m * 2048); dst[m].hi = *(const PG8_LAS i32x4*)(lds + PG8_SA(b, h) + aoff + m * 2048 + 1024); } \
        else { _Pragma("unroll") for (int k = 0; k < 2; ++k) dst[m][k] = *(const PG8_LAS bf16x8*)(lds + PG8_SA(b, h) + aoff + m * 2048 + k * 1024); } } } while (0)
#define PG8_LDB(dst, b, h) do { _Pragma("unroll") for (int n = 0; n < 2; ++n) { if constexpr (FP8) { dst[n].lo = *(const PG8_LAS i32x4*)(lds + PG8_SB(b, h) + boff + n * 2048); dst[n].hi = *(const PG8_LAS i32x4*)(lds + PG8_SB(b, h) + boff + n * 2048 + 1024); } \
        else { _Pragma("unroll") for (int k = 0; k < 2; ++k) dst[n][k] = *(const PG8_LAS bf16x8*)(lds + PG8_SB(b, h) + boff + n * 2048 + k * 1024); } } } while (0)
#define PG8_CAT(x0, x1) __builtin_shufflevector(__builtin_bit_cast(i32x4, x0), __builtin_bit_cast(i32x4, x1), 0, 1, 2, 3, 4, 5, 6, 7)
#define PG8_MMA(ai, bj, At, Bt) do { __builtin_amdgcn_s_setprio(1); \
        if constexpr (FP8) { _Pragma("unroll") for (int m = 0; m < 4; ++m) _Pragma("unroll") for (int n = 0; n < 2; ++n) \
            acc[ai][bj][m][n] = __builtin_amdgcn_mfma_scale_f32_16x16x128_f8f6f4(Bt[n], At[m], acc[ai][bj][m][n], 0, 0, 0, 127, 0, 127); } \
        if constexpr (FP8) { asm volatile("" : "+v"(acc[ai][bj][0][0]), "+v"(acc[ai][bj][0][1]), "+v"(acc[ai][bj][1][0]), "+v"(acc[ai][bj][1][1]), "+v"(acc[ai][bj][2][0]), "+v"(acc[ai][bj][2][1]), "+v"(acc[ai][bj][3][0]), "+v"(acc[ai][bj][3][1])); }     \
        else { _Pragma("unroll") for (int m = 0; m < 4; ++m) _Pragma("unroll") for (int n = 0; n < 2; ++n) _Pragma("unroll") for (int k = 0; k < 2; ++k) \
            acc[ai][bj][m][n] = __builtin_amdgcn_mfma_f32_16x16x32_bf16(Bt[n][k], At[m][k], acc[ai][bj][m][n], 0, 0, 0); } \
        __builtin_amdgcn_s_setprio(0); } while (0)
#define PG8_WAIT_V(n) asm volatile("s_waitcnt vmcnt(" #n ")" ::: "memory")
#define PG8_WAIT_L(n) asm volatile("s_waitcnt lgkmcnt(" #n ")" ::: "memory")
#define PG8_BAR __builtin_amdgcn_s_barrier()
#define PG8_SCHED __builtin_amdgcn_sched_barrier(0)
    Unit cur, nxt; int ui = 0;
    if (!S.next(0, cur)) return;
    f32x4 acc[2][2][4][2];
#pragma unroll
    for (int a = 0; a < 2; ++a)
#pragma unroll
        for (int b = 0; b < 2; ++b)
#pragma unroll
            for (int m = 0; m < 4; ++m)
#pragma unroll
                for (int n = 0; n < 2; ++n) acc[a][b][m][n] = (f32x4){0.f, 0.f, 0.f, 0.f};
    typedef int i32x8 __attribute__((ext_vector_type(8)));
    typedef int i32x8 __attribute__((ext_vector_type(8)));
    typename std::conditional<FP8, i32x8[4], bf16x8[4][2]>::type At; typename std::conditional<FP8, i32x8[2], bf16x8[2][2]>::type B0, B1;
    const char* cA = (const char*)g.A + (Sched::GATHER ? (size_t)0 : (size_t)cur.pm * tstep); const char* cB = (const char*)g.Bt + cur.bo + (size_t)cur.pn * tstep;
    S.a_ready(cur);
#define PG8_VOFF(dst, un) do { _Pragma("unroll") for (int _h = 0; _h < 2; ++_h) _Pragma("unroll") for (int _i = 0; _i < 2; ++_i) { int R_, C_; stage_rc(tid * 16 + _i * 8192, R_, C_); dst[_h][_i] = S.a_off(un, _h * HALF + R_) + (unsigned)C_ * 2u; } } while (0)
    if constexpr (Sched::GATHER) { PG8_VOFF(vC, cur); }
    if constexpr (SP2) {
        PG8_STAGE(PG8_SB(0, 0), cB + PG8_KO(0), voffB); PG8_STAGE(PG8_SB(0, 1), cB + hstep + PG8_KO(0), voffB); PG8_STAGE_A(PG8_SA(0, 0), cA + PG8_KO(0), 0, false); PG8_STAGE_A(PG8_SA(0, 1), cA + PG8_KO(0), 1, false);
        if (wr == 1) PG8_BAR;
        PG8_WAIT_V(2); PG8_BAR;
        PG8_STAGE(PG8_SB(1, 0), cB + PG8_KO(1), voffB); PG8_STAGE_A(PG8_SA(1, 0), cA + PG8_KO(1), 0, false); PG8_STAGE(PG8_SB(1, 1), cB + hstep + PG8_KO(1), voffB);
        PG8_WAIT_V(6); PG8_BAR;
    } else {
        PG8_STAGE(PG8_SB(0, 0), cB, voffB); PG8_STAGE_A(PG8_SA(0, 0), cA, 0, false); PG8_STAGE(PG8_SB(0, 1), cB + hstep, voffB); PG8_STAGE_A(PG8_SA(0, 1), cA, 1, false);
        if (wr == 1) PG8_BAR;
        PG8_WAIT_V(4); PG8_BAR;
        PG8_STAGE(PG8_SB(1, 0), cB + PG8_KO(1), voffB); PG8_STAGE_A(PG8_SA(1, 0), cA + PG8_KO(1), 0, false); PG8_STAGE(PG8_SB(1, 1), cB + hstep + PG8_KO(1), voffB);
        PG8_WAIT_V(6); PG8_BAR;
    }
    for (;;) {
        const bool has_next = S.next(ui + 1, nxt);
        if constexpr (Sched::GATHER) { if (has_next) { PG8_VOFF(vN, nxt); } else { vN[0][0] = vC[0][0]; vN[0][1] = vC[0][1]; vN[1][0] = vC[1][0]; vN[1][1] = vC[1][1]; } }
        const char* nA = (has_next && !Sched::GATHER) ? (const char*)g.A + (size_t)nxt.pm * tstep : cA; const char* nB = has_next ? (const char*)g.Bt + nxt.bo + (size_t)nxt.pn * tstep : cB;
        const bool mh0 = cur.half != 2, mh1 = cur.half != 1;
#pragma unroll 1
        for (int t = 0; t < nt; t += 2) {
            const bool last = (t == nt - 2);
            const char* a1 = cA + PG8_KO(t + 1);
            const char* a2 = last ? nA + PG8_KO(0) : cA + PG8_KO(t + 2); const char* b2 = last ? nB + PG8_KO(0) : cB + PG8_KO(t + 2);
            const char* a3 = last ? nA + PG8_KO(1) : cA + PG8_KO(t + 3); const char* b3 = last ? nB + PG8_KO(1) : cB + PG8_KO(t + 3);
            if (last && has_next) S.a_ready(nxt);
            if constexpr (SP2) {
            PG8_LDB(B0, 0, 0); PG8_LDB(B1, 0, 1); PG8_SCHED; PG8_LDA(At, 0, 0); PG8_STAGE_A(PG8_SA(1, 1), a1, 1, false);
            PG8_WAIT_V(8); PG8_WAIT_L(0); PG8_BAR; if (mh0) PG8_MMA(0, 0, At, B0); if (mh0) PG8_MMA(0, 1, At, B1); PG8_BAR; PG8_SCHED;
            PG8_LDA(At, 0, 1); PG8_STAGE(PG8_SB(0, 0), b2, voffB); PG8_STAGE(PG8_SB(0, 1), b2 + hstep, voffB); PG8_STAGE_A(PG8_SA(0, 0), a2, 0, last);
            PG8_WAIT_V(8); PG8_WAIT_L(0); PG8_BAR; if (mh1) PG8_MMA(1, 0, At, B0); if (mh1) PG8_MMA(1, 1, At, B1); PG8_BAR; PG8_SCHED;
            PG8_LDB(B0, 1, 0); PG8_LDB(B1, 1, 1); PG8_SCHED; PG8_LDA(At, 1, 0); PG8_STAGE_A(PG8_SA(0, 1), a2, 1, last);
            PG8_WAIT_V(8); PG8_WAIT_L(0); PG8_BAR; if (mh0) PG8_MMA(0, 0, At, B0); if (mh0) PG8_MMA(0, 1, At, B1); PG8_BAR; PG8_SCHED;
            PG8_LDA(At, 1, 1); PG8_STAGE(PG8_SB(1, 0), b3, voffB); PG8_STAGE(PG8_SB(1, 1), b3 + hstep, voffB); PG8_STAGE_A(PG8_SA(1, 0), a3, 0, last);
            PG8_WAIT_V(8); PG8_WAIT_L(0); PG8_BAR; if (mh1) PG8_MMA(1, 0, At, B0); if (mh1) PG8_MMA(1, 1, At, B1); PG8_BAR; PG8_SCHED;
            } else {
            PG8_LDB(B0, 0, 0); PG8_SCHED; PG8_LDA(At, 0, 0); PG8_STAGE_A(PG8_SA(1, 1), a1, 1, false);
            PG8_WAIT_L(8); PG8_BAR; PG8_WAIT_L(0); if (mh0) PG8_MMA(0, 0, At, B0); PG8_BAR; PG8_SCHED;
            PG8_LDB(B1, 0, 1); PG8_STAGE(PG8_SB(0, 0), b2, voffB);
            PG8_BAR; PG8_WAIT_L(0); if (mh0) PG8_MMA(0, 1, At, B1); PG8_BAR;
            PG8_LDA(At, 0, 1); PG8_STAGE_A(PG8_SA(0, 0), a2, 0, last);
            PG8_BAR; PG8_WAIT_L(0); if (mh1) PG8_MMA(1, 0, At, B0); PG8_BAR; PG8_SCHED;
            PG8_STAGE(PG8_SB(0, 1), b2 + hstep, voffB);
            PG8_WAIT_V(6); PG8_BAR; if (mh1) PG8_MMA(1, 1, At, B1); PG8_BAR;
            PG8_LDB(B0, 1, 0); PG8_SCHED; PG8_LDA(At, 1, 0); PG8_STAGE_A(PG8_SA(0, 1), a2, 1, last);
            PG8_WAIT_L(8); PG8_BAR; PG8_WAIT_L(0); if (mh0) PG8_MMA(0, 0, At, B0); PG8_BAR; PG8_SCHED;
            PG8_LDB(B1, 1, 1); PG8_STAGE(PG8_SB(1, 0), b3, voffB);
            PG8_BAR; PG8_WAIT_L(0); if (mh0) PG8_MMA(0, 1, At, B1); PG8_BAR;
            PG8_LDA(At, 1, 1); PG8_STAGE_A(PG8_SA(1, 0), a3, 0, last);
            PG8_BAR; PG8_WAIT_L(0); if (mh1) PG8_MMA(1, 0, At, B0); PG8_BAR; PG8_SCHED;
            PG8_STAGE(PG8_SB(1, 1), b3 + hstep, voffB);
            PG8_WAIT_V(6); PG8_BAR; if (mh1) PG8_MMA(1, 1, At, B1); PG8_BAR;
            }
        }
        if constexpr (ALIGN_EPI) { if (wr == 0) PG8_BAR; }
        if constexpr (!Epi::AFTER_DRAIN) { E(acc, cur, wr, wc, fr, fq); S.done(cur); }
        if (!has_next) break;
#pragma unroll
        for (int a = 0; a < 2; ++a)
#pragma unroll
            for (int b = 0; b < 2; ++b)
#pragma unroll
                for (int m = 0; m < 4; ++m)
#pragma unroll
                    for (int n = 0; n < 2; ++n) acc[a][b][m][n] = (f32x4){0.f, 0.f, 0.f, 0.f};
        cur = nxt; cA = nA; cB = nB; ++ui;
        if constexpr (Sched::GATHER) { vC[0][0] = vN[0][0]; vC[0][1] = vN[0][1]; vC[1][0] = vN[1][0]; vC[1][1] = vN[1][1]; }
        if constexpr (ALIGN_EPI) { if (wr == 1) PG8_BAR; }
    }
    PG8_WAIT_V(0);
    if constexpr (!ALIGN_EPI) { if (wr == 0) PG8_BAR; }
    PG8_BAR;
    if constexpr (Epi::AFTER_DRAIN) { E.fused(acc, cur, wr, wc, fr, fq, lds, wid, lane); S.done(cur); }
#undef PG8_VOFF
#undef PG8_KO
#undef PG8_SA
#undef PG8_SB
#undef PG8_STAGE
#undef PG8_STAGE_A
#undef PG8_LDA
#undef PG8_LDB
#undef PG8_MMA
#undef PG8_CAT
#undef PG8_WAIT_V
#undef PG8_WAIT_L
#undef PG8_BAR
#undef PG8_SCHED
}
}

namespace pg8 {
template <bool GATHER_>
struct GroupedOrder {
    static constexpr bool GATHER = GATHER_;
    const PG8_LAS int* tmap; const PG8_LAS int* cntl; const int* list; int nU, nN, G, c, lcap, rowbytes; size_t estride;
    __device__ __forceinline__ bool next(int i, Unit& u) const { const int ntl = nU / nN, n8 = (ntl + 7) >> 3, x = c & 7, t0 = x * n8; int nt = ntl - t0; nt = nt < 0 ? 0 : (nt > n8 ? n8 : nt);
        int v = (c >> 3) + (G >> 3) * i; u.half = 0;
        if (G == 256) { const int tot = nt * nN, fr = tot >> 5, rem = tot - (fr << 5); if (i == fr && rem > 0 && rem <= 16) { const int j = c >> 3; if ((j >> 1) >= rem) return false; v = (fr << 5) + (j >> 1); u.half = 1 + (j & 1); } }
        if ((G & 7) != 0 || v >= nt * nN) { if ((G & 7) == 0) return false; const long L = (long)i * G + c; if (L >= nU) return false; const int t_ = (int)L / nN; const int m_ = __builtin_amdgcn_readfirstlane(tmap[t_]); u.pm = t_; u.pn = (int)L % nN; u.bo = (size_t)(m_ & 255) * estride; u.aux = m_; return true; }
        const int t = t0 + v / nN; const int m = __builtin_amdgcn_readfirstlane(tmap[t]);
        u.pm = t; u.pn = v % nN; u.bo = (size_t)(m & 255) * estride; u.aux = m; return true; }
    __device__ __forceinline__ unsigned a_off(const Unit& u, int R) const { const int e = u.aux & 255, p0 = u.aux >> 8, ce = cntl[e]; int p = p0 + R; p = p < ce ? p : ce - 1; return (unsigned)list[(size_t)e * lcap + p] * (unsigned)rowbytes; }
    __device__ __forceinline__ void a_ready(const Unit&) const {}
    __device__ __forceinline__ void done(const Unit&) const {}
};
__device__ __forceinline__ u32x4 pack8(const f32x4 a, const f32x4 b) { u32x4 w; w.x = cvt_pk_bf16(a[0], a[1]); w.y = cvt_pk_bf16(a[2], a[3]); w.z = cvt_pk_bf16(b[0], b[1]); w.w = cvt_pk_bf16(b[2], b[3]); return w; }
struct EpiStore {
    static constexpr bool PERM = true, AFTER_DRAIN = false; bf16_t* O; int ldc; float s;
    __device__ __forceinline__ void operator()(const f32x4 (&acc)[2][2][4][2], const Unit& u, int wr, int wc, int, int) const {
        const int ln = lane_id_now(), fr = ln & 15, fq = ln >> 4;
        const int row0 = u.pm * BM + wr * 64 + fr, col0 = u.pn * BM + wc * 32 + 8 * fq;
#pragma unroll
        for (int ai = 0; ai < 2; ++ai) { if (u.half != 0 && ai != u.half - 1) continue;
#pragma unroll
            for (int m = 0; m < 4; ++m) { bf16_t* rowp = O + (size_t)(row0 + ai * HALF + m * 16) * ldc + col0;
#pragma unroll
                for (int bj = 0; bj < 2; ++bj) *(u32x4*)(rowp + bj * HALF) = pack8(acc[ai][bj][m][0] * s, acc[ai][bj][m][1] * s); } }
    }
};

struct EpiInProj {
    static constexpr bool PERM = true, AFTER_DRAIN = false;
    bf16_t* O; bf16_t* Kb; bf16_t* Vb; const float* kg; const float* rope; PG8_LAS float* xch;
    float s;
    float* part;
    __device__ __forceinline__ void operator()(const f32x4 (&acc)[2][2][4][2], const Unit& u, int wr, int wc, int, int) const {
        const int ln = lane_id_now(), fr = ln & 15, fq = ln >> 4;
        if (u.pn != 2) {
            const int row0 = u.pm * BM + wr * 64 + fr, col0 = u.pn * BM + wc * 32 + 8 * fq;
            if (u.pn < 2) {
#pragma unroll
                for (int ai = 0; ai < 2; ++ai)
#pragma unroll
                    for (int m = 0; m < 4; ++m) { bf16_t* rowp = O + (size_t)(row0 + ai * HALF + m * 16) * 1792 + col0;
#pragma unroll
                        for (int bj = 0; bj < 2; ++bj) *(u32x4*)(rowp + bj * HALF) = pack8(acc[ai][bj][m][0] * s, acc[ai][bj][m][1] * s); }
                return;
            }
            const bool stats = u.pn >= 5;
#pragma unroll
            for (int ai = 0; ai < 2; ++ai)
#pragma unroll
                for (int m = 0; m < 4; ++m) { bf16_t* rowp = O + (size_t)(row0 + ai * HALF + m * 16) * 1792 + col0; float s1 = 0.f, s2 = 0.f;
#pragma unroll
                    for (int bj = 0; bj < 2; ++bj) { f32x4 ga, gb;
#pragma unroll
                        for (int i = 0; i < 4; ++i) { const float x = acc[ai][bj][m][0][i] * s, y = acc[ai][bj][m][1][i] * s;
                            ga[i] = x * __builtin_amdgcn_rcpf(1.f + __expf(-1.5957691216057308f * (x + 0.044715f * x * x * x)));
                            gb[i] = y * __builtin_amdgcn_rcpf(1.f + __expf(-1.5957691216057308f * (y + 0.044715f * y * y * y))); }
                        const u32x4 w = pack8(ga, gb); *(u32x4*)(rowp + bj * HALF) = w;
                        if (stats) { const float r0 = __uint_as_float(w.x << 16), r1 = __uint_as_float(w.x & 0xffff0000u), r2 = __uint_as_float(w.y << 16), r3 = __uint_as_float(w.y & 0xffff0000u),
                                                 r4 = __uint_as_float(w.z << 16), r5 = __uint_as_float(w.z & 0xffff0000u), r6 = __uint_as_float(w.w << 16), r7 = __uint_as_float(w.w & 0xffff0000u);
                            s1 += ((r0 + r1) + (r2 + r3)) + ((r4 + r5) + (r6 + r7)); s2 += ((r0 * r0 + r1 * r1) + (r2 * r2 + r3 * r3)) + ((r4 * r4 + r5 * r5) + (r6 * r6 + r7 * r7)); } }
                    if (stats) { s1 += __shfl_xor(s1, 16); s1 += __shfl_xor(s1, 32); s2 += __shfl_xor(s2, 16); s2 += __shfl_xor(s2, 32);
                        if (fq == 0) { float* pp = part + ((size_t)(row0 + ai * HALF + m * 16) * 8 + (u.pn - 5) * 4 + wc) * 2; pp[0] = s1; pp[1] = s2; } } }
            return;
        }
        const int R0 = u.pm * BM; const bool lat = R0 < 32768;
        const size_t kvbase = lat ? (size_t)(R0 >> 11) * 2304 + 256 + (R0 & 2047) : (size_t)((R0 - 32768) >> 8) * 2304;
#pragma unroll
        for (int ai = 0; ai < 2; ++ai)
#pragma unroll
            for (int m = 0; m < 4; ++m) { const f32x4 a = acc[ai][0][m][0], b = acc[ai][0][m][1];
                float sq = (a[0] * a[0] + a[1] * a[1]) + (a[2] * a[2] + a[3] * a[3]) + (b[0] * b[0] + b[1] * b[1]) + (b[2] * b[2] + b[3] * b[3]);
                sq += __shfl_xor(sq, 16); sq += __shfl_xor(sq, 32);
                if (fq == 0) xch[(ai * HALF + wr * 64 + m * 16 + fr) * 4 + wc] = sq; }
        asm volatile("s_waitcnt lgkmcnt(0)\n\ts_barrier" ::: "memory");
        const int dh = 32 * (wc & 1) + 8 * fq;
        const f32x4 g0 = *(const f32x4*)(kg + dh), g1 = *(const f32x4*)(kg + dh + 4);
        const bool x2 = (fq & 2) != 0;
#pragma unroll
        for (int ai = 0; ai < 2; ++ai)
#pragma unroll
            for (int m = 0; m < 4; ++m) { const int rl = ai * HALF + wr * 64 + m * 16 + fr;
                const float tot = xch[rl * 4 + wc] + xch[rl * 4 + (wc ^ 1)]; const float rs = rsqrtf(tot * (s * s * (1.f / 64.f)) + 1e-6f) * s;
                f32x4 a = acc[ai][0][m][0] * rs * g0, b = acc[ai][0][m][1] * rs * g1;
                f32x4 pa, pb;
#pragma unroll
                for (int i = 0; i < 4; ++i) { pa[i] = __shfl_xor(a[i], 32); pb[i] = __shfl_xor(b[i], 32); }
                if (lat) { const int t = (R0 & 2047) + rl; const int pos = (wc & 1) ? (t & 63) : (t >> 6);
                    const float* rp = rope + ((size_t)pos * 16 + 8 * (fq & 1)) * 2;
                    const f32x4 c0 = *(const f32x4*)(rp), c1 = *(const f32x4*)(rp + 4), c2 = *(const f32x4*)(rp + 8), c3 = *(const f32x4*)(rp + 12);
                    const f32x4 cs = {c0[0], c0[2], c1[0], c1[2]}, sn = {c0[1], c0[3], c1[1], c1[3]}, cs2 = {c2[0], c2[2], c3[0], c3[2]}, sn2 = {c2[1], c2[3], c3[1], c3[3]};
                    a = x2 ? (a * cs + pa * sn) : (a * cs - pa * sn); b = x2 ? (b * cs2 + pb * sn2) : (b * cs2 - pb * sn2); }
                const size_t o = (kvbase + rl) * 128 + 32 * wc + 8 * fq;
                *(u32x4*)(Kb + o) = pack8(a, b); *(u32x4*)(Vb + o) = pack8(acc[ai][1][m][0] * s, acc[ai][1][m][1] * s); }
        asm volatile("s_waitcnt lgkmcnt(0)\n\ts_barrier" ::: "memory");
    }
};
__device__ __forceinline__ f32x4 silu4(const f32x4 v) { f32x4 r;
#pragma unroll
    for (int i = 0; i < 4; ++i) r[i] = v[i] * __builtin_amdgcn_rcpf(1.f + __expf(-v[i])); return r; }
__device__ __forceinline__ f32x4 sigm4(const f32x4 v) { f32x4 r;
#pragma unroll
    for (int i = 0; i < 4; ++i) r[i] = __builtin_amdgcn_rcpf(1.f + __expf(-v[i])); return r; }
__device__ __forceinline__ u32x2 pack8_fp8(const f32x4 a, const f32x4 b) { int w0 = 0, w1 = 0;
    w0 = __builtin_amdgcn_cvt_pk_fp8_f32(a[0], a[1], w0, false); w0 = __builtin_amdgcn_cvt_pk_fp8_f32(a[2], a[3], w0, true);
    w1 = __builtin_amdgcn_cvt_pk_fp8_f32(b[0], b[1], w1, false); w1 = __builtin_amdgcn_cvt_pk_fp8_f32(b[2], b[3], w1, true); u32x2 r; r.x = (unsigned)w0; r.y = (unsigned)w1; return r; }
__device__ __forceinline__ f32x4 clamp8(const f32x4 v) { f32x4 r;
#pragma unroll
    for (int i = 0; i < 4; ++i) r[i] = __builtin_amdgcn_fmed3f(v[i], -448.f, 448.f); return r; }
struct EpiSwiglu {
    static constexpr bool PERM = true, AFTER_DRAIN = false; unsigned char* G; float s, so;
    __device__ __forceinline__ void operator()(const f32x4 (&acc)[2][2][4][2], const Unit& u, int wr, int wc, int, int) const {
        const int ln = lane_id_now(), fr = ln & 15, fq = ln >> 4;
        const int row0 = u.pm * BM + wr * 64 + fr, col0 = u.pn * HALF + wc * 32 + 8 * fq;
#pragma unroll
        for (int ai = 0; ai < 2; ++ai) { if (u.half != 0 && ai != u.half - 1) continue;
#pragma unroll
            for (int m = 0; m < 4; ++m) *(u32x2*)(G + (size_t)(row0 + ai * HALF + m * 16) * 512 + col0) = pack8_fp8(clamp8(silu4(acc[ai][0][m][0] * s) * (acc[ai][1][m][0] * (s * so))), clamp8(silu4(acc[ai][0][m][1] * s) * (acc[ai][1][m][1] * (s * so)))); }
    }
};
__device__ __forceinline__ void unpack8f(const u32x4 w, f32x4& a, f32x4& b) {
    a[0] = __uint_as_float(w.x << 16); a[1] = __uint_as_float(w.x & 0xffff0000u); a[2] = __uint_as_float(w.y << 16); a[3] = __uint_as_float(w.y & 0xffff0000u);
    b[0] = __uint_as_float(w.z << 16); b[1] = __uint_as_float(w.z & 0xffff0000u); b[2] = __uint_as_float(w.w << 16); b[3] = __uint_as_float(w.w & 0xffff0000u); }
struct EpiGlu {
    static constexpr bool PERM = true, AFTER_DRAIN = false; const bf16_t* GS; const float* b; bf16_t* GG;
    __device__ __forceinline__ void operator()(const f32x4 (&acc)[2][2][4][2], const Unit& u, int wr, int wc, int fr, int fq) const {
        const int row0 = u.pm * BM + wr * 64 + fr, col0 = u.pn * BM + wc * 32 + 8 * fq;
#pragma unroll
        for (int bj = 0; bj < 2; ++bj) { const int c = col0 + bj * HALF; const f32x4 b0 = *(const f32x4*)(b + c), b1 = *(const f32x4*)(b + c + 4);
#pragma unroll
            for (int ai = 0; ai < 2; ++ai) { if (u.half != 0 && ai != u.half - 1) continue;
#pragma unroll
                for (int m = 0; m < 4; ++m) { const size_t o = (size_t)(row0 + ai * HALF + m * 16) * 512 + c; f32x4 g0, g1; unpack8f(*(const u32x4*)(GS + o), g0, g1);
                    *(u32x4*)(GG + o) = pack8(g0 * sigm4(acc[ai][bj][m][0] + b0), g1 * sigm4(acc[ai][bj][m][1] + b1)); } } }
    }
};
struct EpiResid {
    static constexpr bool PERM = true, AFTER_DRAIN = false;
    const float* x; const float* ctx; const float* mod; bf16_t* XC; int inplace;
    __device__ __forceinline__ void operator()(const f32x4 (&acc)[2][2][4][2], const Unit& u, int wr, int wc, int fr, int fq) const {
        const int R0 = u.pm * BM; const int ci = R0 < 32768 ? (R0 >> 11) : 16;
        const float* base = R0 < 32768 ? x + (size_t)R0 * 1024 : ctx + (size_t)(R0 - 32768) * 1024;
        bf16_t* out = XC + (size_t)R0 * 1024; const float* gate = mod + ((size_t)ci * 6 + 2) * 1024;
        const int rl0 = wr * 64 + fr, col0 = u.pn * BM + wc * 32 + 8 * fq;
#pragma unroll
        for (int bj = 0; bj < 2; ++bj) { const int c = col0 + bj * HALF; const f32x4 g0 = *(const f32x4*)(gate + c), g1 = *(const f32x4*)(gate + c + 4);
#pragma unroll
            for (int ai = 0; ai < 2; ++ai) { if (u.half != 0 && ai != u.half - 1) continue;
#pragma unroll
                for (int m = 0; m < 4; ++m) { const size_t o = (size_t)(rl0 + ai * HALF + m * 16) * 1024 + c; f32x4 b0, b1;
                    if (inplace) unpack8f(*(const u32x4*)(out + o), b0, b1); else { b0 = *(const f32x4*)(base + o); b1 = *(const f32x4*)(base + o + 4); }
                    *(u32x4*)(out + o) = pack8(b0 + g0 * acc[ai][bj][m][0], b1 + g1 * acc[ai][bj][m][1]); } } }
    }
};
}

#include <hip/hip_bf16.h>
#include <cmath>
namespace attn_body {
using bf16=__hip_bfloat16;
using bf16x8=__attribute__((ext_vector_type(8)))short;
using s16x4=__attribute__((ext_vector_type(4)))short;
using f32x16=__attribute__((ext_vector_type(16)))float;
using u32x4=__attribute__((ext_vector_type(4)))unsigned;
constexpr int D=64,QP=1792,KP=128,OP=1024;
constexpr int NW=8,QBLK=32,QB=QBLK*NW,KVBLK=64;
constexpr int ATTN_UNIT_ROWS=QB;
__device__ __forceinline__ int crow(int r,int hi){return (r&3)+8*(r>>2)+4*hi;}
#define SBAR() __builtin_amdgcn_sched_barrier(0)
__device__ __forceinline__ void cmask(f32x16&p0,f32x16&p1,int jb,int qrel,int hi){
  const float NEG=-INFINITY; int kb=64*jb+4*hi;
  #pragma unroll
  for(int r=0;r<16;++r){int kv=kb+(r&3)+8*(r>>2); if(kv>qrel)p0[r]=NEG; if(kv+32>qrel)p1[r]=NEG;}
}

constexpr int NSLOT=3, SLOTB=8192;
constexpr int LDS_K=0, LDS_V=NSLOT*SLOTB, LDS_WS=2*NSLOT*SLOTB, LDS_OST=LDS_WS+NW*64*4, LDS_BYTES=LDS_OST+NW*4096;
constexpr float C2=0.125f*1.4426950408889634f;
__device__ __forceinline__ void glds16(const void*gsrc,unsigned lds_dst){unsigned keep;
  asm volatile("s_mov_b32 %0, m0\n\ts_mov_b32 m0, %2\n\ts_nop 0\n\tglobal_load_lds_dwordx4 %1, off\n\ts_mov_b32 m0, %0":"=&s"(keep):"v"(gsrc),"s"(lds_dst):"memory");}
__device__ __forceinline__ float max3f(float a,float b,float c){float r;asm("v_max3_f32 %0, %1, %2, %3":"=v"(r):"v"(a),"v"(b),"v"(c));return r;}
__device__ __forceinline__ float max2f(float a,float b){float r;asm("v_max_f32_e32 %0, %1, %2":"=v"(r):"v"(a),"v"(b));return r;}
__device__ __forceinline__ float fadd_s(float a,float b){float r;asm("v_add_f32_e32 %0, %1, %2":"=v"(r):"v"(a),"v"(b));return r;}
__device__ __forceinline__ float fsub_s(float a,float b){float r;asm("v_sub_f32_e32 %0, %1, %2":"=v"(r):"v"(a),"v"(b));return r;}
typedef float f32x2_t __attribute__((ext_vector_type(2))); typedef __bf16 bf16x2_t __attribute__((ext_vector_type(2)));
__device__ __forceinline__ unsigned cvtpk_s(float lo,float hi){f32x2_t v={lo,hi};bf16x2_t b=__builtin_convertvector(v,bf16x2_t);return __builtin_bit_cast(unsigned,b);}
#define WAIT_BAR(N) asm volatile("s_waitcnt vmcnt(" #N ") lgkmcnt(0)\n\ts_barrier":::"memory")

__device__ __forceinline__ void qkt(f32x16&p0,f32x16&p1,const char*Kslot,const bf16x8*qr,const f32x16&negm,int r32,int hi){
  const char*kb=Kslot+hi*1024+r32*16;
  #pragma unroll
  for(int d0=0;d0<4;++d0){
    const bf16x8 b0=*reinterpret_cast<const bf16x8*>(kb+d0*2048);
    const bf16x8 b1=*reinterpret_cast<const bf16x8*>(kb+d0*2048+512);
    if(d0==0){p0=__builtin_amdgcn_mfma_f32_32x32x16_bf16(b0,qr[0],negm,0,0,0);p1=__builtin_amdgcn_mfma_f32_32x32x16_bf16(b1,qr[0],negm,0,0,0);}
    else{p0=__builtin_amdgcn_mfma_f32_32x32x16_bf16(b0,qr[d0],p0,0,0,0);p1=__builtin_amdgcn_mfma_f32_32x32x16_bf16(b1,qr[d0],p1,0,0,0);}}
}
typedef __attribute__((address_space(3))) const char* lds_cptr;
typedef short v4i16_t __attribute__((ext_vector_type(4)));
__device__ __forceinline__ void kload8(bf16x8*kf,lds_cptr kp){
  kf[0]=*(const __attribute__((address_space(3))) bf16x8*)(kp);      kf[1]=*(const __attribute__((address_space(3))) bf16x8*)(kp+512);
  kf[2]=*(const __attribute__((address_space(3))) bf16x8*)(kp+2048); kf[3]=*(const __attribute__((address_space(3))) bf16x8*)(kp+2560);
  kf[4]=*(const __attribute__((address_space(3))) bf16x8*)(kp+4096); kf[5]=*(const __attribute__((address_space(3))) bf16x8*)(kp+4608);
  kf[6]=*(const __attribute__((address_space(3))) bf16x8*)(kp+6144); kf[7]=*(const __attribute__((address_space(3))) bf16x8*)(kp+6656);
}
__device__ __forceinline__ void kload2(bf16x8*kf,lds_cptr kp,int j){ kf[2*j]=*(const __attribute__((address_space(3))) bf16x8*)(kp+j*2048); kf[2*j+1]=*(const __attribute__((address_space(3))) bf16x8*)(kp+j*2048+512); }
__device__ __forceinline__ s16x4 vtr(lds_cptr p){ return __builtin_bit_cast(s16x4,__builtin_amdgcn_ds_read_tr16_b64_v4i16((__attribute__((address_space(3))) v4i16_t*)p)); }
__device__ __forceinline__ float rowmax(const f32x16&p0,const f32x16&p1){
  float a=max3f(p0[0],p0[1],p1[0]),b=max3f(p0[2],p0[3],p1[1]);a=max3f(a,p1[2],p1[3]);
  #pragma unroll
  for(int r=4;r<16;r+=4){a=max3f(a,p0[r],p0[r+1]);b=max3f(b,p0[r+2],p0[r+3]);a=max3f(a,p1[r],p1[r+1]);b=max3f(b,p1[r+2],p1[r+3]);}
  const float m=max2f(a,b);
  auto rr=__builtin_amdgcn_permlane32_swap(__float_as_uint(m),__float_as_uint(m),false,false);
  return max2f(__uint_as_float(rr[0]),__uint_as_float(rr[1]));
}
__device__ __forceinline__ void pv(f32x16*o,int vb,bf16x8 pa0,bf16x8 pa1,bf16x8 pa2,bf16x8 pa3){
  #pragma unroll
  for(int d0=0;d0<2;++d0){s16x4 lo[4],hi[4];
    #pragma unroll
    for(int ks=0;ks<4;++ks){
      asm volatile("ds_read_b64_tr_b16 %0,%1 offset:%c2":"=&v"(lo[ks]):"v"(vb),"i"(d0*4096+ks*1024):"memory");
      asm volatile("ds_read_b64_tr_b16 %0,%1 offset:%c2":"=&v"(hi[ks]):"v"(vb),"i"(d0*4096+ks*1024+512):"memory");}
    asm volatile("s_waitcnt lgkmcnt(0)":::"memory");SBAR();
    #define PK(k) (bf16x8){lo[k][0],lo[k][1],lo[k][2],lo[k][3],hi[k][0],hi[k][1],hi[k][2],hi[k][3]}
    o[d0]=__builtin_amdgcn_mfma_f32_32x32x16_bf16(pa0,PK(0),o[d0],0,0,0);
    o[d0]=__builtin_amdgcn_mfma_f32_32x32x16_bf16(pa1,PK(1),o[d0],0,0,0);
    o[d0]=__builtin_amdgcn_mfma_f32_32x32x16_bf16(pa2,PK(2),o[d0],0,0,0);
    o[d0]=__builtin_amdgcn_mfma_f32_32x32x16_bf16(pa3,PK(3),o[d0],0,0,0);
    #undef PK
  }
}

#ifndef ATTN_STORE16
#define ATTN_STORE16(p,v) (*(u32x4*)(p)=(v))
#endif
template<int THRL> __device__ __forceinline__ void attn_unit(const bf16*Q0,const bf16*__restrict__ Kh,const bf16*__restrict__ Vh,bf16*O0,const int NT,char*shm,const float*qg,const float2*rope,const int tq0){
  const int tid=threadIdx.x,lane=tid&63,r32=lane&31,hi=lane>>5; const int wid=__builtin_amdgcn_readfirstlane(tid>>6);
  const bf16*Qw=Q0+(long)(wid*QBLK)*QP;
  const unsigned lds0=(unsigned)(uintptr_t)shm;
  float*wsf=(float*)(shm+LDS_WS)+wid*64;
  const bf16*ksrc=Kh+(long)lane*KP+wid*8;
  const bf16*vsrc=Vh+(long)(16*(wid&3)+(lane>>2))*KP+(wid>>2)*32+(lane&3)*8;
  const unsigned kdst=lds0+LDS_K+wid*1024, vdst=lds0+LDS_V+wid*1024;
  #define DMA_K(t,slot) glds16(ksrc+(long)(t)*KVBLK*KP,(unsigned)__builtin_amdgcn_readfirstlane(kdst+(slot)))
  #define DMA_V(t,slot) glds16(vsrc+(long)(t)*KVBLK*KP,(unsigned)__builtin_amdgcn_readfirstlane(vdst+(slot)))
  const int vb0=(int)(lds0+LDS_V)+((lane>>4)&1)*32+(lane&3)*8+(4*hi+((lane&15)>>2))*64;
  const char*Kbase=shm+LDS_K; bf16x8 kf[8];
  const lds_cptr shm3=(lds_cptr)shm; const lds_cptr kp0=shm3+LDS_K+hi*1024+r32*16; const lds_cptr vp0=shm3+LDS_V+((lane>>4)&1)*32+(lane&3)*8+(4*hi+((lane&15)>>2))*64;
  DMA_K(0,0);DMA_V(0,0);DMA_K(1,SLOTB);
  bf16x8 qr[4];
  #pragma unroll
  for(int d0=0;d0<4;++d0)qr[d0]=*reinterpret_cast<const bf16x8*>(&Qw[(long)r32*QP+d0*16+hi*8]);
  { float qf[4][8]; float ss=0.f;
    #pragma unroll
    for(int d0=0;d0<4;++d0){
      #pragma unroll
      for(int j=0;j<8;++j){ const float v=__uint_as_float(((unsigned)(unsigned short)qr[d0][j])<<16); qf[d0][j]=v; ss+=v*v; } }
    ss+=__shfl_xor(ss,32);
    const float rs=rsqrtf(ss*(1.f/64.f)+1e-6f);
    #pragma unroll
    for(int d0=0;d0<4;++d0){
      #pragma unroll
      for(int j=0;j<8;++j) qf[d0][j]*=rs*qg[16*d0+8*hi+j]; }
    if(tq0>=0){ const int t=tq0+wid*QBLK+r32; const float2*rr=rope+(t>>6)*16+8*hi; const float2*rc=rope+(t&63)*16+8*hi;
      #pragma unroll
      for(int j=0;j<8;++j){ const float2 a=rr[j],c=rc[j];
        const float x1=qf[0][j],x2=qf[1][j]; qf[0][j]=x1*a.x-x2*a.y; qf[1][j]=x2*a.x+x1*a.y;
        const float y1=qf[2][j],y2=qf[3][j]; qf[2][j]=y1*c.x-y2*c.y; qf[3][j]=y2*c.x+y1*c.y; } }
    #pragma unroll
    for(int d0=0;d0<4;++d0){ u32x4 w; w.x=cvtpk_s(qf[d0][0]*C2,qf[d0][1]*C2); w.y=cvtpk_s(qf[d0][2]*C2,qf[d0][3]*C2); w.z=cvtpk_s(qf[d0][4]*C2,qf[d0][5]*C2); w.w=cvtpk_s(qf[d0][6]*C2,qf[d0][7]*C2); qr[d0]=__builtin_bit_cast(bf16x8,w); } }
  float mhat=0.f,l_reg=0.f;f32x16 o[2];o[0]=f32x16{};o[1]=f32x16{};f32x16 negm=f32x16{};asm volatile("":"+v"(negm));
  #define CMASK(P0,P1,t) do{}while(0)
  bool resc=false;
  #define START(P0,P1) do{ const float rm=rowmax(P0,P1); resc=false; \
    { const float dl=rm; mhat=fadd_s(mhat,dl); \
      _Pragma("unroll") for(int r=0;r<16;++r){P0[r]=fsub_s(P0[r],dl);P1[r]=fsub_s(P1[r],dl);} \
      _Pragma("unroll") for(int r=0;r<16;++r)negm[r]=-mhat; asm volatile("":"+v"(negm)); } \
    _Pragma("unroll") for(int r=0;r<16;++r)P0[r]=__builtin_amdgcn_exp2f(P0[r]); }while(0)
  #define RESC() do{ if(resc){ asm volatile("s_waitcnt lgkmcnt(0)":::"memory"); \
      _Pragma("unroll") for(int d_=0;d_<2;++d_) _Pragma("unroll") for(int r=0;r<16;++r)o[d_][r]*=wsf[crow(r,hi)]; } }while(0)
  f32x16 pA0,pA1,pB0,pB1;
  int sl_prev=0,sl_cur=0,sl_next=SLOTB;
  #define ROT() do{sl_prev=sl_cur;sl_cur=sl_next;sl_next=(sl_next==(NSLOT-1)*SLOTB)?0:sl_next+SLOTB;}while(0)
  DMA_K(2,2*SLOTB);
  WAIT_BAR(3);
  qkt(pA0,pA1,Kbase,qr,negm,r32,hi);asm volatile("s_nop 15\n\ts_nop 7":"+v"(pA0),"+v"(pA1));CMASK(pA0,pA1,0);
  START(pA0,pA1);
  _Pragma("unroll") for(int r=0;r<16;++r)pA1[r]=__builtin_amdgcn_exp2f(pA1[r]);
  WAIT_BAR(0);
  DMA_K(3,0);DMA_V(1,SLOTB);
  ROT();
  kload8(kf,kp0+sl_cur);
  WAIT_BAR(2);
  s16x4 vlo[8],vhi[8]; u32x4 pw0,pw1,pw2,pw3;
  #define PKW(P,B) cvtpk_s(P[B],P[B+1])
  #define PAF(k) __builtin_bit_cast(bf16x8,pw##k)
  #define VFR(i) (bf16x8){vlo[i][0],vlo[i][1],vlo[i][2],vlo[i][3],vhi[i][0],vhi[i][1],vhi[i][2],vhi[i][3]}
  #define PIN(x) asm volatile("":"+v"(x))
  #define MX3(a,b,c) __builtin_fmaxf(__builtin_fmaxf((a),(b)),(c))
  #define GAPA(MF,A0,A1,A2,A3,W0,W1,PW) do{ MF; sacc+=A0; sacc+=A1; sacc+=A2; sacc+=A3; PIN(sacc); W0; W1; PIN(PW); SBAR(); }while(0)
  #define EX(v) __builtin_amdgcn_exp2f(v)
  #define GAPB(MF,X,B) do{ MF; X[B]=EX(X[B]); X[B+1]=EX(X[B+1]); X[B+2]=EX(X[B+2]); X[B+3]=EX(X[B+3]); PIN(X); SBAR(); }while(0)
  #define VRD(i) do{ vlo[i]=vtr(vp_+(((i)>>2)*4096+((i)&3)*1024)); vhi[i]=vtr(vp_+(((i)>>2)*4096+((i)&3)*1024+512)); }while(0)
  #define KRD(G,j) do{ if(G){ kload2(kf,kp0+sl_next,j); SBAR(); } }while(0)
  #define STEP(C0,C1,P0,P1,t,GK,GV,GL) do{ SBAR(); \
    const lds_cptr vp_=vp0+sl_prev; \
    VRD(0); SBAR(); float sacc=(P0[0]+P0[1]); \
    GAPA(C0=__builtin_amdgcn_mfma_f32_32x32x16_bf16(kf[0],qr[0],negm,0,0,0), P0[2],P0[3],P0[4],P0[5],     pw0[0]=PKW(P0,0), pw0[1]=PKW(P0,2), pw0); \
    VRD(4); SBAR(); GAPA(C1=__builtin_amdgcn_mfma_f32_32x32x16_bf16(kf[1],qr[0],negm,0,0,0), P0[6],P0[7],P0[8],P0[9],     pw0[2]=PKW(P0,4), pw0[3]=PKW(P0,6), pw0); \
    VRD(1); SBAR(); GAPA(C0=__builtin_amdgcn_mfma_f32_32x32x16_bf16(kf[2],qr[1],C0,0,0,0),   P0[10],P0[11],P0[12],P0[13], pw1[0]=PKW(P0,8), pw1[1]=PKW(P0,10), pw1); \
    VRD(5); SBAR(); GAPA(C1=__builtin_amdgcn_mfma_f32_32x32x16_bf16(kf[3],qr[1],C1,0,0,0),   P0[14],P0[15],P1[0],P1[1],   pw1[2]=PKW(P0,12),pw1[3]=PKW(P0,14), pw1); \
    VRD(2); SBAR(); GAPA(C0=__builtin_amdgcn_mfma_f32_32x32x16_bf16(kf[4],qr[2],C0,0,0,0),   P1[2],P1[3],P1[4],P1[5],     pw2[0]=PKW(P1,0), pw2[1]=PKW(P1,2), pw2); \
    VRD(6); SBAR(); GAPA(C1=__builtin_amdgcn_mfma_f32_32x32x16_bf16(kf[5],qr[2],C1,0,0,0),   P1[6],P1[7],P1[8],P1[9],     pw2[2]=PKW(P1,4), pw2[3]=PKW(P1,6), pw2); \
    VRD(3); SBAR(); GAPA(C0=__builtin_amdgcn_mfma_f32_32x32x16_bf16(kf[6],qr[3],C0,0,0,0),   P1[10],P1[11],P1[12],P1[13], pw3[0]=PKW(P1,8), pw3[1]=PKW(P1,10), pw3); \
    VRD(7); SBAR(); GAPA(C1=__builtin_amdgcn_mfma_f32_32x32x16_bf16(kf[7],qr[3],C1,0,0,0),   P1[14],P1[15],0.f,0.f,       pw3[2]=PKW(P1,12),pw3[3]=PKW(P1,14), pw3); \
    l_reg+=sacc; \
    if(GK){DMA_K((t)+3,sl_cur);} if(GV){DMA_V((t)+1,sl_next);} \
    CMASK(C0,C1,t); \
    { float a=MX3(C0[0],C0[1],C1[0]),b=MX3(C0[2],C0[3],C1[1]); a=MX3(a,C1[2],C1[3]); \
      _Pragma("unroll") for(int r=4;r<16;r+=4){a=MX3(a,C0[r],C0[r+1]);b=MX3(b,C0[r+2],C0[r+3]);a=MX3(a,C1[r],C1[r+1]);b=MX3(b,C1[r+2],C1[r+3]);} \
      float rm=__builtin_fmaxf(a,b); { auto rr=__builtin_amdgcn_permlane32_swap(__float_as_uint(rm),__float_as_uint(rm),false,false); rm=__builtin_fmaxf(__uint_as_float(rr[0]),__uint_as_float(rr[1])); } \
      resc=false; \
      if(__builtin_expect(__any(rm>(float)THRL),0)){ const float dl=__builtin_fmaxf(rm,0.f); mhat+=dl; \
        _Pragma("unroll") for(int r=0;r<16;++r){C0[r]-=dl;C1[r]-=dl;} \
        _Pragma("unroll") for(int r=0;r<16;++r)negm[r]=-mhat; asm volatile("":"+v"(negm)); \
        const float f=__builtin_amdgcn_exp2f(-dl); l_reg*=f; if(hi==0)wsf[r32]=f; resc=true; } } \
    SBAR(); \
    GAPB(o[0]=__builtin_amdgcn_mfma_f32_32x32x16_bf16(PAF(0),VFR(0),o[0],0,0,0), C0,0); \
    GAPB(o[1]=__builtin_amdgcn_mfma_f32_32x32x16_bf16(PAF(0),VFR(4),o[1],0,0,0), C0,4); \
    KRD(GL,0); GAPB(o[0]=__builtin_amdgcn_mfma_f32_32x32x16_bf16(PAF(1),VFR(1),o[0],0,0,0), C0,8); \
    KRD(GL,1); GAPB(o[1]=__builtin_amdgcn_mfma_f32_32x32x16_bf16(PAF(1),VFR(5),o[1],0,0,0), C0,12); \
    KRD(GL,2); GAPB(o[0]=__builtin_amdgcn_mfma_f32_32x32x16_bf16(PAF(2),VFR(2),o[0],0,0,0), C1,0); \
    KRD(GL,3); GAPB(o[1]=__builtin_amdgcn_mfma_f32_32x32x16_bf16(PAF(2),VFR(6),o[1],0,0,0), C1,4); \
    GAPB(o[0]=__builtin_amdgcn_mfma_f32_32x32x16_bf16(PAF(3),VFR(3),o[0],0,0,0), C1,8); \
    GAPB(o[1]=__builtin_amdgcn_mfma_f32_32x32x16_bf16(PAF(3),VFR(7),o[1],0,0,0), C1,12); \
    }while(0)
  int t=1;
  #undef CMASK
  #define CMASK(P0,P1,t) do{}while(0)
  for(;t+5<NT;t+=2){
    STEP(pB0,pB1,pA0,pA1,t,true,true,true);     WAIT_BAR(2); RESC(); ROT();
    STEP(pA0,pA1,pB0,pB1,t+1,true,true,true);   WAIT_BAR(2); RESC(); ROT();
  }
  #undef CMASK
  #define CMASK(P0,P1,t) do{}while(0)
  #define ENDW(tt) do{ if((tt)+3<NT){WAIT_BAR(2);} else if((tt)+2<NT){WAIT_BAR(1);} else {WAIT_BAR(0);} }while(0)
  for(;t+1<NT;t+=2){
    STEP(pB0,pB1,pA0,pA1,t,(t+3<NT),(t+1<NT),(t+1<NT));       ENDW(t);   RESC(); ROT();
    STEP(pA0,pA1,pB0,pB1,t+1,(t+4<NT),(t+2<NT),(t+2<NT));     ENDW(t+1); RESC(); ROT();
  }
  STEP(pB0,pB1,pA0,pA1,NT-1,false,false,false); RESC();
  { float sacc=pB0[0]+pB0[1]; _Pragma("unroll") for(int r=2;r<16;++r)sacc+=pB0[r]; _Pragma("unroll") for(int r=0;r<16;++r)sacc+=pB1[r]; l_reg+=sacc;
    pw0=(u32x4){PKW(pB0,0),PKW(pB0,2),PKW(pB0,4),PKW(pB0,6)};pw1=(u32x4){PKW(pB0,8),PKW(pB0,10),PKW(pB0,12),PKW(pB0,14)};pw2=(u32x4){PKW(pB1,0),PKW(pB1,2),PKW(pB1,4),PKW(pB1,6)};pw3=(u32x4){PKW(pB1,8),PKW(pB1,10),PKW(pB1,12),PKW(pB1,14)};
    SBAR(); pv(o,vb0+sl_cur,PAF(0),PAF(1),PAF(2),PAF(3)); }
  #undef PKW
  #undef PAF
  #undef VFR
  #undef PIN
  #undef MX3
  #undef GAPA
  #undef GAPB
  #undef EX
  #undef VRD
  #undef KRD
  #undef STEP
  #undef ENDW
  {auto rr=__builtin_amdgcn_permlane32_swap(__float_as_uint(l_reg),__float_as_uint(l_reg),false,false);l_reg=__uint_as_float(rr[0])+__uint_as_float(rr[1]);}
  if(hi==0)wsf[32+r32]=l_reg;asm volatile("s_waitcnt lgkmcnt(0)":::"memory");
  float rli[16];
  #pragma unroll
  for(int r=0;r<16;++r)rli[r]=__builtin_amdgcn_rcpf(wsf[32+crow(r,hi)]);
  bf16*Ow=O0+(long)(wid*QBLK)*OP;
  { bf16*stg=(bf16*)(shm+LDS_OST)+wid*2048;
    #pragma unroll
    for(int r=0;r<16;++r){const int orow=crow(r,hi);
      #pragma unroll
      for(int d0=0;d0<2;++d0)stg[orow*64+d0*32+r32]=__float2bfloat16(o[d0][r]*rli[r]);}
    asm volatile("s_waitcnt lgkmcnt(0)":::"memory");
    #pragma unroll
    for(int i=0;i<4;++i){const int row=i*8+(lane>>3),ch=lane&7; const u32x4 v=*(const u32x4*)(stg+row*64+ch*8); ATTN_STORE16(Ow+(long)row*OP+ch*8,v);} }
  asm volatile("s_waitcnt lgkmcnt(0)\n\ts_barrier":::"memory");
  #undef DMA_K
  #undef DMA_V
  #undef CMASK
  #undef START
  #undef RESC
  #undef ROT
}
constexpr int ATTN_LDS_BYTES=LDS_BYTES;
#undef SBAR
#undef WAIT_BAR
}

struct Params {
    const float* in[35];
    float* out;
    unsigned char* ws;
    int ph_lo, ph_hi;
};
enum { I_X = 0, I_C, I_CTX, I_CCTX, I_WMOD, I_BMOD, I_GMIX, I_GFFN, I_MIXWIN, I_MIXWOUT, I_QG, I_KG, I_LNG, I_WSP, I_BSP,
       I_S5WIN, I_ARE, I_AIM, I_LOGDT, I_BRE, I_BIM, I_CRE, I_CIM, I_S5D, I_WGLU, I_BGLU, I_S5WOUT,
       I_WGRP, I_BGRP, I_WRT, I_BRT, I_W1, I_W3, I_W2, I_FING };

struct Ctx {
    const Params* p;
    unsigned char* ws;
    LAS unsigned char* lds;
    int tid, lane, wave, gw, ngw;
};
__device__ __forceinline__ const float* xin_row(const Params& P, int r) { return r < TL ? P.in[I_X] + (size_t)r * D : P.in[I_CTX] + (size_t)(r - TL) * D; }
__device__ __forceinline__ int cond_of(int r) { return r < TL ? (r >> 11) : 16; }
__device__ __forceinline__ const float* mod_vec(const Ctx& C, int layer, int ci, int k) { return (const float*)(C.ws + WS_MOD) + ((size_t)(layer * 17 + ci) * 6 + k) * D; }

__device__ __forceinline__ void dsincos(double a, double& s, double& c) {
    const double TWO_PI_HI = 6.283185307179586, TWO_PI_LO = 2.4492935982947064e-16;
    const double k = rint(a * 0.15915494309189535);
    double r = fma(-k, TWO_PI_HI, a); r = fma(-k, TWO_PI_LO, r);
    const double r2 = r * r; double ct = 1.0, st = r, cs = 1.0, ss = r;
#pragma unroll 1
    for (int i = 1; i <= 15; ++i) { ct *= -r2 / (double)((2 * i - 1) * (2 * i)); cs += ct; st *= -r2 / (double)((2 * i) * (2 * i + 1)); ss += st; }
    s = ss; c = cs;
}

struct TItem { const float* src; int N, k0, n0; bf16* dst; int dp; float f8s; };
__device__ __forceinline__ void t_load(const TItem& t, int lane, float (&r)[32]) {
#pragma unroll
    for (int i = 0; i < 32; ++i) r[i] = __builtin_nontemporal_load(t.src + (size_t)(t.k0 + 2 * i + (lane >> 5)) * t.N + t.n0 + (lane & 31));
}
__device__ __forceinline__ void t_store(const TItem& t, int lane, const float (&r)[32], LAS float* scr) {
#pragma unroll
    for (int i = 0; i < 32; ++i) scr[(2 * i + (lane >> 5)) * 33 + (lane & 31)] = r[i];
    asm volatile("s_waitcnt lgkmcnt(0)" ::: "memory");
    const int c = lane & 7;
    if (t.f8s != 0.f) {
#pragma unroll
        for (int j = 0; j < 4; ++j) { const int n = (lane >> 3) + 8 * j; const LAS float* s = scr + (8 * c) * 33 + n; const float q = t.f8s;
            *(pg8::u32x2*)((unsigned char*)t.dst + (size_t)n * t.dp + 8 * c) = pg8::pack8_fp8((f32x4){s[0 * 33] * q, s[1 * 33] * q, s[2 * 33] * q, s[3 * 33] * q}, (f32x4){s[4 * 33] * q, s[5 * 33] * q, s[6 * 33] * q, s[7 * 33] * q}); }
    } else {
#pragma unroll
        for (int j = 0; j < 4; ++j) { const int n = (lane >> 3) + 8 * j; const LAS float* s = scr + (8 * c) * 33 + n;
            v4u o; o.x = pk2(s[0 * 33], s[1 * 33]); o.y = pk2(s[2 * 33], s[3 * 33]); o.z = pk2(s[4 * 33], s[5 * 33]); o.w = pk2(s[6 * 33], s[7 * 33]);
            *(v4u*)(t.dst + (size_t)n * t.dp + 8 * c) = o; }
    }
    asm volatile("s_waitcnt lgkmcnt(0)" ::: "memory");
}
__device__ __forceinline__ TItem mat_item(const float* W, int K, int N, bf16* WT, int it) {
    const int nblk = N / 32, kb = it / nblk, nb = it % nblk;
    return TItem{W, N, kb * 64, nb * 32, WT + (size_t)(nb * 32) * K + kb * 64, K, 0.f};
}
__device__ __forceinline__ TItem mat_item_f8(const float* W, int K, int N, unsigned char* WT, int it, float f8s) {
    const int nblk = N / 32, kb = it / nblk, nb = it % nblk;
    return TItem{W, N, kb * 64, nb * 32, (bf16*)(WT + (size_t)(nb * 32) * K + kb * 64), K, f8s};
}
constexpr int MOE_ITEMS = NEXP * 768;
__device__ __forceinline__ TItem moe_item(const Ctx& C, int layer, int it) {
    const Params& P = *C.p;
    const int e = it / 768, r = it % 768, kind = r / 256, j = r % 256;
    if (kind < 2) {
        const float* src = (kind == 0 ? P.in[I_W1] : P.in[I_W3]) + ((size_t)layer * NEXP + e) * D * EH;
        const int kb = j / 16, nb = j % 16, k0 = kb * 64, n0 = nb * 32;
        const int drow = (n0 / 128) * 256 + (n0 % 128) + (kind == 1 ? 128 : 0);
        return TItem{src, EH, k0, n0, (bf16*)((unsigned char*)(C.ws + (layer ? WS_W13B : WS_W13)) + (size_t)e * 1024 * 1024 + (size_t)drow * 1024 + k0), 1024, W13_SCALE};
    }
    const float* src = P.in[I_W2] + ((size_t)layer * NEXP + e) * EH * D;
    const int kb = j / 32, nb = j % 32, k0 = kb * 64, n0 = nb * 32;
    return TItem{src, D, k0, n0, (bf16*)((unsigned char*)(C.ws + (layer ? WS_W2B : WS_W2)) + (size_t)e * 1024 * 512 + (size_t)n0 * 512 + k0), 512, W13_SCALE};
}
constexpr int TI0 = 16 * 56, TI1 = 16 * 32, TI2 = 16 * 16, TI3 = 8 * 16, TI4 = 8 * 32, NSMALL = TI0 + TI1 + TI2 + TI3 + TI4;
__device__ __forceinline__ TItem conv_item(const Ctx& C, int layer, int nsmall, int it) {
    const Params& P = *C.p; int r = it;
    if (r < nsmall) {
        if (r < TI0) return mat_item_f8(P.in[I_MIXWIN], D, MIXW, (unsigned char*)(C.ws + WS_WIN0), r, W13_SCALE); r -= TI0;
        if (r < TI1) return mat_item(P.in[I_MIXWOUT], D, D, (bf16*)(C.ws + WS_WOUT0), r); r -= TI1;
        if (r < TI2) return mat_item(P.in[I_S5WIN], D, 512, (bf16*)(C.ws + WS_WS5IN), r); r -= TI2;
        if (r < TI3) return mat_item(P.in[I_WGLU], 512, 512, (bf16*)(C.ws + WS_WGLU), r); r -= TI3;
        return mat_item(P.in[I_S5WOUT], 512, D, (bf16*)(C.ws + WS_WS5OUT), r);
    }
    return moe_item(C, layer, r - nsmall);
}
__device__ __forceinline__ void convert_items(const Ctx& C, int layer, int nsmall) {
    LAS float* scr = (LAS float*)(C.lds + C.wave * 16384);
    const int total = nsmall + (gridDim.x == 256 ? L0_A : MOE_ITEMS), n = C.ngw;
    for (int it = C.gw; it < total; it += 2 * n) {
        const bool two = it + n < total;
        const TItem ta = conv_item(C, layer, nsmall, it), tb = conv_item(C, layer, nsmall, two ? it + n : it);
        float ra[32], rb[32];
        t_load(ta, C.lane, ra); if (two) t_load(tb, C.lane, rb);
        t_store(ta, C.lane, ra, scr); if (two) t_store(tb, C.lane, rb, scr);
    }
}

__device__ __forceinline__ void convert_range(const Ctx& C, int layer, int lo, int hi, int b0) {
    if ((int)blockIdx.x < b0) return;
    LAS float* scr = (LAS float*)(C.lds + C.wave * 16384);
    const int n = ((int)gridDim.x - b0) * NWAVE;
    for (int it = lo + ((int)blockIdx.x - b0) * NWAVE + C.wave; it < hi; it += 2 * n) {
        const bool two = it + n < hi;
        const TItem ta = moe_item(C, layer, it), tb = moe_item(C, layer, two ? it + n : it);
        float ra[32], rb[32];
        t_load(ta, C.lane, ra); if (two) t_load(tb, C.lane, rb);
        t_store(ta, C.lane, ra, scr); if (two) t_store(tb, C.lane, rb, scr);
    }
}

__device__ __forceinline__ void phase_prologue(const Ctx& C) {
    const Params& P = *C.p;
    {
        LAS float* s = (LAS float*)C.lds;
        LAS float* red = (LAS float*)(C.lds + 17 * 1024 * 4);
        bool have_s = false;
        for (int u = blockIdx.x; u < 192; u += gridDim.x) {
            if (!have_s) {
                for (int i = C.tid; i < 17 * 1024; i += NTHR) { const int ci = i >> 10, k = i & 1023; const float v = ci < 16 ? P.in[I_C][ci * D + k] : P.in[I_CCTX][k]; s[i] = silu_(v); }
                have_s = true; __syncthreads();
            }
            const int layer = u / 96, jg = u % 96, kq = C.tid >> 6, jc = C.tid & 63;
            const float* w = P.in[I_WMOD] + (size_t)layer * D * 6144 + jg * 64 + jc;
            float acc[17];
#pragma unroll
            for (int i = 0; i < 17; ++i) acc[i] = 0.f;
            for (int k0 = kq * 128; k0 < kq * 128 + 128; k0 += 16) {
                float wv[16];
#pragma unroll
                for (int j = 0; j < 16; ++j) wv[j] = w[(size_t)(k0 + j) * 6144];
#pragma unroll
                for (int j = 0; j < 16; ++j)
#pragma unroll
                    for (int i = 0; i < 17; ++i) acc[i] += s[i * 1024 + k0 + j] * wv[j]; }
#pragma unroll
            for (int i = 0; i < 17; ++i) red[(kq * 17 + i) * 64 + jc] = acc[i];
            __syncthreads();
            for (int o = C.tid; o < 17 * 64; o += NTHR) { const int ci = o >> 6, c = o & 63; float v = 0.f;
#pragma unroll
                for (int q = 0; q < 8; ++q) v += red[(q * 17 + ci) * 64 + c];
                const int j = jg * 64 + c; v += P.in[I_BMOD][layer * 6144 + j];
                ((float*)(C.ws + WS_MOD))[((size_t)(layer * 17 + ci)) * 6144 + j] = v; }
            __syncthreads();
        }
        __syncthreads();
    }
    {
        const int gt = blockIdx.x * NTHR + C.tid, ngt = gridDim.x * NTHR;
        float2* rope = (float2*)(C.ws + WS_TAB + TAB_ROPE);
        for (int i = gt; i < 64 * 16; i += ngt) { const int pos = i >> 4, f = i & 15;
            const double th = exp(-(double)f * (9.210340371976184 / 16.0)); double s, c; dsincos((double)pos * th, s, c); rope[i] = make_float2((float)c, (float)s); }
        float2* lamb = (float2*)(C.ws + WS_TAB + TAB_LAMB); float2* bbar = (float2*)(C.ws + WS_TAB + TAB_BBAR);
        for (int i = gt; i < 2 * 32 * 64; i += ngt) {
            const int dg = i >> 6;
            const double are = P.in[I_ARE][i], aim = P.in[I_AIM][i], dt = exp((double)P.in[I_LOGDT][dg]);
            double s, c; dsincos(aim * dt, s, c); const double mag = exp(are * dt), lr = mag * c, li = mag * s;
            lamb[i] = make_float2((float)lr, (float)li);
            const double den = are * are + aim * aim, nr = lr - 1.0, ni = li;
            const double cr = (nr * are + ni * aim) / den, cim = (ni * are - nr * aim) / den;
            for (int p = 0; p < 16; ++p) { const double br = P.in[I_BRE][(size_t)i * 16 + p], bi = P.in[I_BIM][(size_t)i * 16 + p];
                bbar[(size_t)i * 16 + p] = make_float2((float)(cr * br - cim * bi), (float)(cr * bi + cim * br)); }
        }
    }
    {
        const int gt = blockIdx.x * NTHR + C.tid, ngt = gridDim.x * NTHR;
        bf16* wrt = (bf16*)(C.ws + WS_TAB + TAB_WR);
        for (int idx = gt; idx < 2 * 32 * 3 * 64; idx += ngt) {
            const int ln = idx & 63, jb = (idx >> 6) % 3, kk = (idx / 192) & 31, l = idx / (192 * 32);
            const int i = ln & 15, q = ln >> 4, grp = i >> 2, r = i & 3;
            float hi8[8], lo8[8];
#pragma unroll
            for (int e = 0; e < 8; ++e) { const int k = 32 * kk + 8 * q + e;
                const float w = jb < 2 ? P.in[I_WRT][((size_t)l * D + k) * 32 + grp * 8 + jb * 4 + r] : (r == 0 ? P.in[I_WGRP][((size_t)l * D + k) * 4 + grp] : 0.f);
                const float h = bf2f(f2bf(w)); hi8[e] = h; lo8[e] = w - h; }
            v4u oh, ol; oh.x = pk2(hi8[0], hi8[1]); oh.y = pk2(hi8[2], hi8[3]); oh.z = pk2(hi8[4], hi8[5]); oh.w = pk2(hi8[6], hi8[7]);
            ol.x = pk2(lo8[0], lo8[1]); ol.y = pk2(lo8[2], lo8[3]); ol.z = pk2(lo8[4], lo8[5]); ol.w = pk2(lo8[6], lo8[7]);
            const size_t base = ((((size_t)l * 32 + kk) * 3 + jb) * 2) * 64 + ln;
            *(v4u*)(wrt + base * 8) = oh; *(v4u*)(wrt + (base + 64) * 8) = ol;
        }
    }
    {
        const int gt = blockIdx.x * NTHR + C.tid, ngt = gridDim.x * NTHR; bf16* w16 = (bf16*)(C.ws + WS_WSP);
        for (int i = gt; i < 8 * 128 * 128 / 4; i += ngt) { const f32x4 v = *(const f32x4*)(P.in[I_WSP] + 4 * (size_t)i); v2u o; o.x = pk2(v.x, v.y); o.y = pk2(v.z, v.w); *(v2u*)(w16 + 4 * (size_t)i) = o; }
    }
    convert_items(C, 0, NSMALL);
}

__device__ __forceinline__ void load_row16(const float* row, int lane, f32x4 (&v)[4]) {
#pragma unroll
    for (int j = 0; j < 4; ++j) v[j] = *(const f32x4*)(row + 4 * lane + 256 * j);
}
__device__ __forceinline__ float row_rstd(const f32x4 (&v)[4]) {
    float s = 0.f;
#pragma unroll
    for (int j = 0; j < 4; ++j) s += (v[j].x * v[j].x + v[j].y * v[j].y) + (v[j].z * v[j].z + v[j].w * v[j].w);
    return rsqrtf(wave_sum(s) * (1.f / D) + EPS);
}
__device__ __forceinline__ void modulate16(f32x4 (&v)[4], float rstd, const float* g, const float* scale, const float* shift, int lane) {
#pragma unroll
    for (int j = 0; j < 4; ++j) { const int c = 4 * lane + 256 * j; const f32x4 gg = *(const f32x4*)(g + c), sc = *(const f32x4*)(scale + c), sh = *(const f32x4*)(shift + c);
        v[j] = v[j] * rstd * gg * (sc + 1.f) + sh; }
}
__device__ __forceinline__ void store_row16_bf16(bf16* row, int lane, const f32x4 (&v)[4]) {
#pragma unroll
    for (int j = 0; j < 4; ++j) { v2u o; o.x = pk2(v[j].x, v[j].y); o.y = pk2(v[j].z, v[j].w); *(v2u*)(row + 4 * lane + 256 * j) = o; }
}

__device__ __forceinline__ void store_row16_fp8(unsigned char* row, int lane, const f32x4 (&v)[4]) {
#pragma unroll
    for (int j = 0; j < 4; ++j) { int w = 0; w = __builtin_amdgcn_cvt_pk_fp8_f32(v[j].x, v[j].y, w, false); w = __builtin_amdgcn_cvt_pk_fp8_f32(v[j].z, v[j].w, w, true); *(int*)(row + 4 * lane + 256 * j) = w; }
}

__device__ __forceinline__ void phase_norm_mix0(const Ctx& C) {
    const Params& P = *C.p; unsigned char* H = (unsigned char*)(C.ws + WS_H);
    f32x4 a[4], b[4]; const int n = C.ngw; int r = C.gw;
    if (r < TT) load_row16(xin_row(P, r), C.lane, a);
    if (r + n < TT) load_row16(xin_row(P, r + n), C.lane, b);
#define NM0_ROW(buf, rr, rnext) do { f32x4 v[4] = {buf[0], buf[1], buf[2], buf[3]}; if ((rnext) < TT) load_row16(xin_row(P, (rnext)), C.lane, buf); \
        const float rstd = row_rstd(v); const int ci = cond_of(rr); modulate16(v, rstd, P.in[I_GMIX], mod_vec(C, 0, ci, 1), mod_vec(C, 0, ci, 0), C.lane); store_row16_fp8(H + (size_t)(rr) * D, C.lane, v); } while (0)
    for (; r < TT; r += 2 * n) { NM0_ROW(a, r, r + 2 * n); if (r + n < TT) NM0_ROW(b, r + n, r + 3 * n); }
#undef NM0_ROW
}

__device__ __forceinline__ unsigned gm_off_b(unsigned row, unsigned ch) { return 256u * row + 16u * (ch ^ (((row & 3u) << 2) | ((row >> 2) & 3u))); }
__device__ __forceinline__ void phase_gmlp_fast(const Ctx& C) {
    typedef short bf16x8 __attribute__((ext_vector_type(8)));
    typedef short s16x4 __attribute__((ext_vector_type(4)));
    typedef float f32x16 __attribute__((ext_vector_type(16)));
    const Params& P = *C.p; const bf16* Pb = (const bf16*)(C.ws + WS_P); bf16* OG = (bf16*)(C.ws + WS_H); const bf16* W16 = (const bf16*)(C.ws + WS_WSP);
    const float* lnp = (const float*)(C.ws + WS_Q);
    const int tid = C.tid, lane = C.lane, w = C.wave, l31 = lane & 31, hi = lane >> 5;
    const int gsel = w >> 2, pb = w & 3;
    const int nU = (TT / 128) * 4, arow = tid >> 2;
    v4u ra[4]; float2 st = make_float2(0.f, 0.f);
#define GM_ALOAD(uu_) do { const size_t gr_ = (size_t)((uu_) >> 2) * 128 + arow; { const f32x4 pq = *(const f32x4*)(lnp + gr_ * 16 + 4 * (tid & 3)); st = make_float2(pq.x + pq.z, pq.y + pq.w); } \
        _Pragma("unroll") for (int i = 0; i < 4; ++i) ra[i] = *(const v4u*)(Pb + gr_ * MIXW + 1280 + 128 * ((uu_) & 3) + 8 * ((tid & 3) + 4 * i)); } while (0)
    if ((int)blockIdx.x < nU) GM_ALOAD((int)blockIdx.x);
    for (int u = blockIdx.x; u < nU; u += gridDim.x) {
        const int ch_ = u >> 2, gp = u & 3, g = 2 * gp + gsel;
        bf16x8 xf[8]; const bf16* wrow = W16 + ((size_t)g * 128 + 32 * pb + l31) * 128 + 8 * hi;
#pragma unroll
        for (int k8 = 0; k8 < 8; ++k8) xf[k8] = *(const bf16x8*)(wrow + 16 * k8);
        { float s1 = st.x, s2 = st.y; s1 += __shfl_xor(s1, 1); s1 += __shfl_xor(s1, 2); s2 += __shfl_xor(s2, 1); s2 += __shfl_xor(s2, 2);
          const float mean_ = s1 * (1.f / 512.f); const float2 sc = make_float2(mean_, rsqrtf(fmaxf(s2 * (1.f / 512.f) - mean_ * mean_, 0.f) + EPS));
#pragma unroll
          for (int i = 0; i < 4; ++i) { const int c16 = (tid & 3) + 4 * i; float v[8]; unpack8(ra[i], v);
              const float* lg = P.in[I_LNG] + 128 * gp + 8 * c16;
#pragma unroll
              for (int j = 0; j < 8; ++j) v[j] = (v[j] - sc.x) * sc.y * lg[j];
              v4u o; o.x = pk2(v[0], v[1]); o.y = pk2(v[2], v[3]); o.z = pk2(v[4], v[5]); o.w = pk2(v[6], v[7]);
              *(LAS v4u*)(C.lds + (arow >> 5) * 8192 + gm_off_b(arow & 31, c16)) = o; } }
        if (u + (int)gridDim.x < nU) GM_ALOAD(u + (int)gridDim.x);
        __syncthreads();
        f32x16 acc[2]; acc[0] = f32x16{}; acc[1] = f32x16{};
#pragma unroll
        for (int k8 = 0; k8 < 8; ++k8) {
            const unsigned rb = k8 >> 1, ks = k8 & 1;
#pragma unroll
            for (int db = 0; db < 2; ++db) { const unsigned c = 2 * gsel + db, blk = (lane >> 4) & 1, q = (lane & 15) >> 2, p2 = lane & 3;
                s16x4 t0, t1;
                { const unsigned a0 = rb * 8192 + gm_off_b(16 * ks + 8 * hi + q, 4 * c + 2 * blk + (p2 >> 1)) + 8 * (p2 & 1);
                  const unsigned a1 = rb * 8192 + gm_off_b(16 * ks + 8 * hi + 4 + q, 4 * c + 2 * blk + (p2 >> 1)) + 8 * (p2 & 1);
                  t0 = __builtin_bit_cast(s16x4, __builtin_amdgcn_ds_read_tr16_b64_v4i16((LAS s16x4*)(C.lds + a0)));
                  t1 = __builtin_bit_cast(s16x4, __builtin_amdgcn_ds_read_tr16_b64_v4i16((LAS s16x4*)(C.lds + a1))); }
                const bf16x8 yf = {t0[0], t0[1], t0[2], t0[3], t1[0], t1[1], t1[2], t1[3]};
                acc[db] = __builtin_amdgcn_mfma_f32_32x32x16_bf16(xf[k8], yf, acc[db], 0, 0, 0); }
        }
        const float* bsp = P.in[I_BSP] + g * 128 + 32 * pb;
#pragma unroll
        for (int r = 0; r < 16; ++r) { const int pl = (r & 3) + 8 * (r >> 2) + 4 * hi; const size_t grow = (size_t)ch_ * 128 + 32 * pb + pl; const float bb = bsp[pl];
#pragma unroll
            for (int db = 0; db < 2; ++db) { const int col = 64 * g + 32 * db + l31; const float uu = bf2f(Pb[grow * MIXW + 768 + col]);
                OG[grow * D + 512 + col] = (bf16)f2bf(uu * (acc[db][r] + bb)); } }
        __syncthreads();
    }
#undef GM_ALOAD
}

__device__ __forceinline__ void phase_attn_fast(const Ctx& C, char* lds_generic) {
    typedef attn_body::bf16 abf;
    const abf* Q = (const abf*)(C.ws + WS_P); const abf* Kb = (const abf*)(C.ws + WS_K); const abf* Vb = (const abf*)(C.ws + WS_V); abf* OG = (abf*)(C.ws + WS_H);
    const int G = gridDim.x, bx = blockIdx.x; const int vcu = (G % 8 == 0) ? (bx % 8) * (G / 8) + bx / 8 : bx;
    const int per = (1024 + G - 1) / G, perc = (128 + G - 1) / G;
    for (int i = 0; i < per + perc; ++i) {
        int b, h, nt, tq0; size_t qrow;
        if (i < per) { const int u = vcu * per + i; if (u >= 1024) continue; const int qb = u & 7, hg = (u >> 3) & 3, bk = u >> 5; b = bk >> 1; h = (bk & 1) * 4 + hg; qrow = (size_t)b * SEQ + qb * 256; nt = KVL / 64; tq0 = qb * 256; }
        else { const int u = vcu + (i - per) * G; if (u >= 128) continue; b = u >> 3; h = u & 7; qrow = (size_t)TL + (size_t)b * CTXL; nt = CTXL / 64; tq0 = -1; }
        const size_t kvo = (size_t)b * KVL * 128 + (h >> 2) * 64;
        attn_body::attn_unit<8>(Q + qrow * MIXW + h * 64, Kb + kvo, Vb + kvo, OG + qrow * 1024 + h * 64, nt, lds_generic, C.p->in[I_QG], (const float2*)(C.ws + WS_TAB + TAB_ROPE), tq0);
    }
}

__device__ __forceinline__ void phase_router_fast(const Ctx& C, int layer, int nrows) {
    typedef short bf16x8 __attribute__((ext_vector_type(8)));
    const Params& P = *C.p; const bf16* XC = (const bf16*)(C.ws + WS_XC); bf16* F = (bf16*)(C.ws + WS_H);
    int* asg_e = (int*)(C.ws + WS_ROUTE + RT_E); int* asg_p = (int*)(C.ws + WS_ROUTE + RT_P); float* asg_w = (float*)(C.ws + WS_ROUTE + RT_W); int* list = (int*)(C.ws + WS_LIST);
    unsigned* cnt = (unsigned*)(C.ws + WS_CTL) + CW_CNT + 64 * layer;
    const int l15 = C.lane & 15, q4 = C.lane >> 4;
    LAS float* ab = (LAS float*)(C.lds + C.wave * 8192);
    LAS unsigned* lcnt = (LAS unsigned*)(C.lds + 65536);
    if (C.tid < 64) lcnt[C.tid] = 0u;
    __syncthreads();
    int cur_ci = -1;
    const int nitems = nrows / 16;
    for (int rd = 0; (int)blockIdx.x * NWAVE + rd * C.ngw < nitems; ++rd) {
        const int it_raw = C.gw + rd * C.ngw; const bool valid = it_raw < nitems; const int it = valid ? it_raw : nitems - 1;
        const int row = it * 16 + l15, ci = cond_of(it * 16);
        if (ci != cur_ci) {
            const float* sc = mod_vec(C, layer, ci, 4); const float* sh = mod_vec(C, layer, ci, 3); const float* g0 = P.in[I_GFFN] + layer * D;
#pragma unroll
            for (int j = 0; j < 4; ++j) { const int c = 4 * C.lane + 256 * j; const f32x4 g4 = *(const f32x4*)(g0 + c), s4 = *(const f32x4*)(sc + c), h4 = *(const f32x4*)(sh + c); const f32x4 a4 = g4 * (s4 + 1.f);
                *(LAS f32x4*)(ab + c) = a4; *(LAS f32x4*)(ab + 1024 + c) = h4; }
            asm volatile("s_waitcnt lgkmcnt(0)" ::: "memory"); cur_ci = ci;
        }
        const bf16* xr = XC + (size_t)row * D + 8 * q4;
        float ss = 0.f;
#pragma unroll 16
        for (int kk = 0; kk < 32; ++kk) { pg8::f32x4 a, b; pg8::unpack8f(*(const pg8::u32x4*)(xr + 32 * kk), a, b); ss += (a.x * a.x + a.y * a.y) + (a.z * a.z + a.w * a.w) + (b.x * b.x + b.y * b.y) + (b.z * b.z + b.w * b.w); }
        ss += __shfl_xor(ss, 16); ss += __shfl_xor(ss, 32);
        const float rstd = rsqrtf(ss * (1.f / D) + EPS);
        f32x4 acc[3]; acc[0] = (f32x4){0.f, 0.f, 0.f, 0.f}; acc[1] = acc[0]; acc[2] = acc[0];
        unsigned char* frow = (unsigned char*)F + (size_t)row * D + 8 * q4;
        const LAS float* abl = ab + 8 * q4;
        {
            const unsigned char* wsrc = (const unsigned char*)((const bf16x8*)(C.ws + WS_TAB + TAB_WR) + (size_t)layer * (32 * 3 * 2 * 64)) + C.tid * 16;
            LAS unsigned char* wl0 = C.lds + 67584;
#define RS_GLOAD(sb_, ga, gb, gc, xq) do { ga = *(const pg8::u32x4*)(wsrc + (sb_) * 24576); gb = *(const pg8::u32x4*)(wsrc + (sb_) * 24576 + 8192); gc = *(const pg8::u32x4*)(wsrc + (sb_) * 24576 + 16384); \
                _Pragma("unroll") for (int j = 0; j < 4; ++j) xq[j] = *(const pg8::u32x4*)(xr + 128 * (sb_) + 32 * j); } while (0)
#define RS_LWRITE(sb_, ga, gb, gc) do { LAS unsigned char* wn = wl0 + ((sb_) & 1) * 24576 + C.tid * 16; *(LAS pg8::u32x4*)(wn) = ga; *(LAS pg8::u32x4*)(wn + 8192) = gb; *(LAS pg8::u32x4*)(wn + 16384) = gc; } while (0)
#define RS_FRAGS(sb_, j_, wf_, tb_) do { const LAS unsigned char* wl = wl0 + ((sb_) & 1) * 24576 + C.lane * 16; const int c_ = 128 * (sb_) + 32 * (j_); \
                _Pragma("unroll") for (int jb = 0; jb < 3; ++jb) { wf_[jb][0] = *(const LAS bf16x8*)(wl + (((j_) * 3 + jb) * 2) * 1024); wf_[jb][1] = *(const LAS bf16x8*)(wl + (((j_) * 3 + jb) * 2 + 1) * 1024); } \
                tb_[0] = *(const LAS f32x4*)(abl + c_); tb_[1] = *(const LAS f32x4*)(abl + c_ + 4); tb_[2] = *(const LAS f32x4*)(abl + 1024 + c_); tb_[3] = *(const LAS f32x4*)(abl + 1024 + c_ + 4); } while (0)
#define RS_STEP(sb_, j_, xv_, wf_, tb_, NEXT) do { const int c = 128 * (sb_) + 32 * (j_); \
                pg8::f32x4 x0, x1; pg8::unpack8f(xv_, x0, x1); \
                const f32x4 f0 = x0 * rstd * tb_[0] + tb_[2]; \
                const f32x4 f1 = x1 * rstd * tb_[1] + tb_[3]; \
                const pg8::u32x4 fh = pg8::pack8(f0, f1); if (valid) *(pg8::u32x2*)(frow + c) = pg8::pack8_fp8(f0, f1); \
                pg8::f32x4 r0, r1; pg8::unpack8f(fh, r0, r1); \
                const pg8::u32x4 fl = pg8::pack8(f0 - r0, f1 - r1); \
                const bf16x8 ah = __builtin_bit_cast(bf16x8, fh), al = __builtin_bit_cast(bf16x8, fl); \
                NEXT; \
                _Pragma("unroll") for (int jb = 0; jb < 3; ++jb) { \
                    acc[jb] = __builtin_amdgcn_mfma_f32_16x16x32_bf16(wf_[jb][0], ah, acc[jb], 0, 0, 0); \
                    acc[jb] = __builtin_amdgcn_mfma_f32_16x16x32_bf16(wf_[jb][0], al, acc[jb], 0, 0, 0); \
                    acc[jb] = __builtin_amdgcn_mfma_f32_16x16x32_bf16(wf_[jb][1], ah, acc[jb], 0, 0, 0); } } while (0)
#define RS_COMP(sb_, xq) do { bf16x8 wA[3][2], wB[3][2]; f32x4 tA[4], tB[4]; \
                RS_FRAGS(sb_, 0, wA, tA); \
                RS_STEP(sb_, 0, xq[0], wA, tA, RS_FRAGS(sb_, 1, wB, tB)); \
                RS_STEP(sb_, 1, xq[1], wB, tB, RS_FRAGS(sb_, 2, wA, tA)); \
                RS_STEP(sb_, 2, xq[2], wA, tA, RS_FRAGS(sb_, 3, wB, tB)); \
                RS_STEP(sb_, 3, xq[3], wB, tB, (void)0); } while (0)
#define RS_SYNC() do { asm volatile("s_waitcnt lgkmcnt(0)" ::: "memory"); __builtin_amdgcn_s_barrier(); } while (0)
            if (layer == 1) STAMP_AT(22);
            pg8::u32x4 a0, a1, a2, b0, b1, b2, xa[4], xb[4], xc[4];
            RS_GLOAD(0, a0, a1, a2, xc); RS_GLOAD(1, b0, b1, b2, xb);
            __builtin_amdgcn_s_barrier();
            RS_LWRITE(0, a0, a1, a2); RS_SYNC();
#pragma unroll 1
            for (int sb = 0; sb < 8; sb += 2) {
                if (sb + 2 < 8) RS_GLOAD(sb + 2, a0, a1, a2, xa);
                RS_COMP(sb, xc);
                RS_LWRITE(sb + 1, b0, b1, b2); RS_SYNC();
#pragma unroll
                for (int j = 0; j < 4; ++j) xc[j] = xb[j];
                if (sb + 3 < 8) RS_GLOAD(sb + 3, b0, b1, b2, xb);
                RS_COMP(sb + 1, xc);
                if (sb + 2 < 8) { RS_LWRITE(sb + 2, a0, a1, a2);
#pragma unroll
                    for (int j = 0; j < 4; ++j) xc[j] = xa[j]; }
                RS_SYNC();
            }
            if (layer == 1) STAMP_AT(23);
#undef RS_GLOAD
#undef RS_LWRITE
#undef RS_COMP
#undef RS_STEP
#undef RS_FRAGS
#undef RS_SYNC
        }
        const float* brt = P.in[I_BRT] + layer * 32 + q4 * 8;
        float e[8];
#pragma unroll
        for (int r = 0; r < 4; ++r) { e[r] = acc[0][r] + brt[r]; e[4 + r] = acc[1][r] + brt[4 + r]; }
        const float gl = acc[2][0] + P.in[I_BGRP][layer * 4 + q4];
        float gm = gl; int gi = q4;
#pragma unroll
        for (int st = 16; st <= 32; st <<= 1) { const float og = __shfl_xor(gm, st); const int oi = __shfl_xor(gi, st); if (og > gm || (og == gm && oi < gi)) { gm = og; gi = oi; } }
        float den = __expf(gl - gm); den += __shfl_xor(den, 16); den += __shfl_xor(den, 32);
        if (valid && q4 == gi) {
            const float gw_ = 1.f / den;
            int i0 = 0; float v0 = e[0];
#pragma unroll
            for (int i = 1; i < 8; ++i) if (e[i] > v0) { v0 = e[i]; i0 = i; }
            int i1 = -1; float v1 = -INFINITY;
#pragma unroll
            for (int i = 0; i < 8; ++i) if (i != i0 && e[i] > v1) { v1 = e[i]; i1 = i; }
            if (i1 < 0) i1 = (i0 + 1) & 7;
            const float e1 = __expf(v1 - v0), w0 = gw_ / (1.f + e1), w1 = gw_ * e1 / (1.f + e1);
            const int ea = (gi & 3) * 8 + i0, eb = (gi & 3) * 8 + i1;
            const unsigned pa = __hip_atomic_fetch_add(lcnt + ea, 1u, __ATOMIC_RELAXED, __HIP_MEMORY_SCOPE_WORKGROUP);
            const unsigned pb = __hip_atomic_fetch_add(lcnt + eb, 1u, __ATOMIC_RELAXED, __HIP_MEMORY_SCOPE_WORKGROUP);
            asg_e[2 * row] = ea; asg_e[2 * row + 1] = eb; asg_p[2 * row] = (int)pa; asg_p[2 * row + 1] = (int)pb; asg_w[2 * row] = w0; asg_w[2 * row + 1] = w1;
        }
    }
    if (layer == 0) STAMP_AT(21);
    asm volatile("s_waitcnt vmcnt(0) lgkmcnt(0)" ::: "memory");
    __syncthreads();
    if (C.tid < 32) { const unsigned n = lcnt[C.tid]; lcnt[32 + C.tid] = n ? __hip_atomic_fetch_add(cnt + C.tid, n, __ATOMIC_RELAXED, __HIP_MEMORY_SCOPE_AGENT) : 0u; }
    __syncthreads();
    for (int it = C.gw; it < nrows / 16; it += C.ngw) {
        if (C.lane < 32) { const int idx = 2 * (it * 16 + (C.lane & 15)) + (C.lane >> 4);
            const int e = __hip_atomic_load(asg_e + idx, __ATOMIC_RELAXED, __HIP_MEMORY_SCOPE_AGENT); const int p = __hip_atomic_load(asg_p + idx, __ATOMIC_RELAXED, __HIP_MEMORY_SCOPE_AGENT) + (int)lcnt[32 + e];
            asg_p[idx] = p; list[(size_t)e * LCAP + p] = idx >> 1; }
    }
}

__device__ __forceinline__ int wave_pstart(const Ctx& C, int layer) {
    const unsigned* cnt = (const unsigned*)(C.ws + WS_CTL) + CW_CNT + 64 * layer;
    const int mc = C.lane < 32 ? (int)__hip_atomic_load(cnt + (C.lane & 31), __ATOMIC_RELAXED, __HIP_MEMORY_SCOPE_AGENT) : 0; const int mp = (mc + 255) & ~255; int in = mp;
#pragma unroll
    for (int o = 1; o < 32; o <<= 1) { const int t = __shfl_up(in, o); if ((C.lane & 31) >= o) in += t; }
    return in - mp;
}
struct CombRaw { v2u x[4], ya[4], yb[4]; float w0, w1; };
__device__ __forceinline__ void comb_load(const Ctx& C, int r, int ps, CombRaw& o) {
    const bf16* Y2 = (const bf16*)(C.ws + WS_XS); const bf16* XC = (const bf16*)(C.ws + WS_XC); const float* asg_w = (const float*)(C.ws + WS_ROUTE + RT_W);
    const int* asg_e = (const int*)(C.ws + WS_ROUTE + RT_E); const int* asg_p = (const int*)(C.ws + WS_ROUTE + RT_P);
    const int s0 = __shfl(ps, asg_e[2 * r]) + asg_p[2 * r], s1 = __shfl(ps, asg_e[2 * r + 1]) + asg_p[2 * r + 1]; o.w0 = asg_w[2 * r]; o.w1 = asg_w[2 * r + 1];
#pragma unroll
    for (int j = 0; j < 4; ++j) { const int c = 4 * C.lane + 256 * j; o.x[j] = *(const v2u*)(XC + (size_t)r * D + c); o.ya[j] = *(const v2u*)(Y2 + (size_t)s0 * D + c); o.yb[j] = *(const v2u*)(Y2 + (size_t)s1 * D + c); }
}
__device__ __forceinline__ void comb_calc(const Ctx& C, int layer, int r, const CombRaw& w, f32x4 (&v)[4]) {
    const float* gate = mod_vec(C, layer, cond_of(r), 5); const float w0 = w.w0, w1 = w.w1;
#pragma unroll
    for (int j = 0; j < 4; ++j) { const int c = 4 * C.lane + 256 * j; const v2u xx = w.x[j], a = w.ya[j], b = w.yb[j]; const f32x4 g = *(const f32x4*)(gate + c);
        v[j].x = bf2f(xx.x & 0xffffu) + g.x * (w0 * bf2f(a.x & 0xffffu) + w1 * bf2f(b.x & 0xffffu)); v[j].y = bf2f(xx.x >> 16) + g.y * (w0 * bf2f(a.x >> 16) + w1 * bf2f(b.x >> 16));
        v[j].z = bf2f(xx.y & 0xffffu) + g.z * (w0 * bf2f(a.y & 0xffffu) + w1 * bf2f(b.y & 0xffffu)); v[j].w = bf2f(xx.y >> 16) + g.w * (w0 * bf2f(a.y >> 16) + w1 * bf2f(b.y >> 16)); }
}
__device__ __forceinline__ void phase_combine_norm_mix1(const Ctx& C) {
    const Params& P = *C.p; bf16* XC = (bf16*)(C.ws + WS_XC); bf16* H = (bf16*)(C.ws + WS_H);
    const int ps = wave_pstart(C, 0), n = C.ngw;
#define CN_ROW(buf, rr, rnext) do { const CombRaw w_ = buf; if ((rnext) < TT) comb_load(C, (rnext), ps, buf); f32x4 v[4]; comb_calc(C, 0, (rr), w_, v); \
        store_row16_bf16(XC + (size_t)(rr) * D, C.lane, v); const float rstd = row_rstd(v); const int ci = cond_of(rr); \
        modulate16(v, rstd, P.in[I_GMIX] + D, mod_vec(C, 1, ci, 1), mod_vec(C, 1, ci, 0), C.lane); store_row16_bf16(H + (size_t)(rr) * D, C.lane, v); } while (0)
    CombRaw a, b; int r = C.gw;
    if (r < TT) comb_load(C, r, ps, a);
    if (r + n < TT) comb_load(C, r + n, ps, b);
    for (; r < TT; r += 2 * n) { CN_ROW(a, r, r + 2 * n); if (r + n < TT) CN_ROW(b, r + n, r + 3 * n); }
#undef CN_ROW
    { const bool early = gridDim.x == 256; if (early) convert_range(C, 1, 0, L1_A, 0); convert_range(C, 1, early ? L1_C : 0, MOE_ITEMS, 0); }
}
__device__ __forceinline__ void phase_final(const Ctx& C) {
    const Params& P = *C.p;
    const int ps = wave_pstart(C, 1), n = C.ngw;
#define FN_ROW(buf, rr, rnext) do { const CombRaw w_ = buf; if ((rnext) < TL) comb_load(C, (rnext), ps, buf); f32x4 v[4]; comb_calc(C, 1, (rr), w_, v); const float rstd = row_rstd(v); \
        _Pragma("unroll") for (int j = 0; j < 4; ++j) { const int c = 4 * C.lane + 256 * j; const f32x4 g = *(const f32x4*)(P.in[I_FING] + c); __builtin_nontemporal_store(v[j] * rstd * g, (f32x4*)(P.out + (size_t)(rr) * D + c)); } } while (0)
    CombRaw a, b; int r = C.gw;
    if (r < TL) comb_load(C, r, ps, a);
    if (r + n < TL) comb_load(C, r + n, ps, b);
    for (; r < TL; r += 2 * n) { FN_ROW(a, r, r + 2 * n); if (r + n < TL) FN_ROW(b, r + n, r + 3 * n); }
#undef FN_ROW
}

__device__ __forceinline__ void phase_s5_fast(const Ctx& C) {
    typedef short bf16x8 __attribute__((ext_vector_type(8)));
    typedef float f32x16 __attribute__((ext_vector_type(16)));
    const Params& P = *C.p; const bf16* U = (const bf16*)(C.ws + WS_U); bf16* GS = (bf16*)(C.ws + WS_GS); float* YA = (float*)(C.ws + WS_YACC);
    const float2* lamb = (const float2*)(C.ws + WS_TAB + TAB_LAMB); const float2* bbar = (const float2*)(C.ws + WS_TAB + TAB_BBAR);
    constexpr int HP = 272;
    const int lane = C.lane, w = C.wave, il = w >> 2, dir = (w >> 1) & 1, nh = w & 1;
    const int l31 = lane & 31, hi = lane >> 5, l15 = lane & 15, q4 = lane >> 4;
    LAS unsigned char* Hb = C.lds + (il * 2 + dir) * (2 * 32 * HP);
    const int srow = 16 * ((l31 >> 2) & 1) + 2 * (l31 >> 3) + ((l31 >> 1) & 1);
    for (int it0 = blockIdx.x; it0 < NB * 16; it0 += gridDim.x) {
        const int item = it0 * 2 + il, b = item >> 5, g = item & 31;
        const int dg = dir * 32 + g, n = nh * 32 + l31;
        const float2 lam = lamb[dg * 64 + n];
        f32x2 p2[16]; { f32x2 p = {lam.x, lam.y};
#pragma unroll
            for (int r = 0; r < 16; ++r) { p2[r] = p; p = (f32x2){p.x * lam.x - p.y * lam.y, p.x * lam.y + p.y * lam.x}; } }
        const f32x2 lx2 = {lam.x, lam.x}, ly2 = {-lam.y, lam.y};
        bf16x8 bre, bim; { const float2* bp = bbar + ((size_t)(dg * 64 + n)) * 16 + 8 * hi;
#pragma unroll
            for (int e = 0; e < 8; ++e) { const float2 v = bp[e]; bre[e] = (short)f2bf(v.x); bim[e] = (short)f2bf(v.y); } }
        bf16x8 cf[4]; { const float* cre = P.in[I_CRE] + ((size_t)dg * 16 + l15) * 64; const float* cim = P.in[I_CIM] + ((size_t)dg * 16 + l15) * 64;
#pragma unroll
            for (int ks = 0; ks < 4; ++ks) { const f32x4 a = *(const f32x4*)(cre + 16 * ks + 4 * q4), m = *(const f32x4*)(cim + 16 * ks + 4 * q4);
                cf[ks][0] = (short)f2bf(a.x); cf[ks][1] = (short)f2bf(-m.x); cf[ks][2] = (short)f2bf(a.y); cf[ks][3] = (short)f2bf(-m.y);
                cf[ks][4] = (short)f2bf(a.z); cf[ks][5] = (short)f2bf(-m.z); cf[ks][6] = (short)f2bf(a.w); cf[ks][7] = (short)f2bf(-m.w); } }
        const f32x4 dsk = *(const f32x4*)(P.in[I_S5D] + g * 16 + 4 * q4);
        f32x2 carry = {0.f, 0.f};
#define S5_UROW(kk, off) ({ const int S_ = 32 * (kk) + srow + (off); (S_ < CTXL) ? ((size_t)TL + (size_t)b * CTXL + (dir == 0 ? S_ : CTXL - 1 - S_)) : ((size_t)b * SEQ + (dir == 0 ? S_ - CTXL : SEQ - 1 - (S_ - CTXL))); })
        const bool odd = l31 & 1;
#define S5_ULD(kk, off) (*(const bf16x8*)(U + S5_UROW(kk, off) * 512 + g * 16 + 8 * hi))
        bf16x8 ux1 = S5_ULD(0, 0), uy1 = S5_ULD(0, 8), ux2 = S5_ULD(1, 0), uy2 = S5_ULD(1, 8), ux3 = S5_ULD(2, 0), uy3 = S5_ULD(2, 8);
        f32x4 pk_n = {0.f, 0.f, 0.f, 0.f}; v2u uu_n = {0u, 0u};
        for (int k = 0; k < 72; ++k) {
            const bf16x8 ux = ux1, uy = uy1; ux1 = ux2; uy1 = uy2; ux2 = ux3; uy2 = uy3;
            if (k + 3 < 72) { ux3 = S5_ULD(k + 3, 0); uy3 = S5_ULD(k + 3, 8); }
            const int sl = 32 * (k - 8) + 16 * nh + l15;
            const int tok = dir == 0 ? sl : SEQ - 1 - sl; const int lt = tok >> 5;
            const size_t o = ((size_t)b * SEQ + (k >= 8 ? tok : 0)) * 512 + g * 16 + 4 * q4;
            const bool first = dir == 0 ? (lt < 32) : (lt >= 32);
#define S5_RLOAD(oo, pk_, uu_) do { pk_.x = __hip_atomic_load(YA + (oo), __ATOMIC_RELAXED, __HIP_MEMORY_SCOPE_AGENT); pk_.y = __hip_atomic_load(YA + (oo) + 1, __ATOMIC_RELAXED, __HIP_MEMORY_SCOPE_AGENT); \
                pk_.z = __hip_atomic_load(YA + (oo) + 2, __ATOMIC_RELAXED, __HIP_MEMORY_SCOPE_AGENT); pk_.w = __hip_atomic_load(YA + (oo) + 3, __ATOMIC_RELAXED, __HIP_MEMORY_SCOPE_AGENT); uu_ = *(const v2u*)(U + (oo)); } while (0)
            f32x4 pk = pk_n; v2u uu = uu_n;
            if (k == 40) S5_RLOAD(o, pk, uu);
            if (k >= 40 && k + 1 < 72) { const int sl1 = 32 * (k + 1 - 8) + 16 * nh + l15; const int tok1 = dir == 0 ? sl1 : SEQ - 1 - sl1; const size_t o1 = ((size_t)b * SEQ + tok1) * 512 + g * 16 + 4 * q4; S5_RLOAD(o1, pk_n, uu_n); }
            {
              const bf16x8 zf = {0, 0, 0, 0, 0, 0, 0, 0};
              f32x16 X = {}, Y = {};
              X = __builtin_amdgcn_mfma_f32_32x32x16_bf16(odd ? zf : ux, bre, X, 0, 0, 0); X = __builtin_amdgcn_mfma_f32_32x32x16_bf16(odd ? ux : zf, bim, X, 0, 0, 0);
              Y = __builtin_amdgcn_mfma_f32_32x32x16_bf16(odd ? zf : uy, bre, Y, 0, 0, 0); Y = __builtin_amdgcn_mfma_f32_32x32x16_bf16(odd ? uy : zf, bim, Y, 0, 0, 0);
              f32x2 s2 = hi ? (f32x2){0.f, 0.f} : carry;
#pragma unroll
              for (int q = 0; q < 8; ++q) { const f32x2 bq = {X[2 * q], X[2 * q + 1]}, sw = {s2.y, s2.x}; s2 = lx2 * s2 + bq; s2 = ly2 * sw + s2; X[2 * q] = s2.x; X[2 * q + 1] = s2.y; }
#pragma unroll
              for (int q = 0; q < 8; ++q) { const f32x2 bq = {Y[2 * q], Y[2 * q + 1]}, sw = {s2.y, s2.x}; s2 = lx2 * s2 + bq; s2 = ly2 * sw + s2; Y[2 * q] = s2.x; Y[2 * q + 1] = s2.y; }
              float er = __shfl_xor(s2.x, 32), ei = __shfl_xor(s2.y, 32); if (!hi) { er = 0.f; ei = 0.f; }
              const f32x2 er2 = {er, er}, ei2 = {ei, ei};
#pragma unroll
              for (int q = 0; q < 8; ++q) { const f32x2 p = p2[q], ps = {-p.y, p.x}; f32x2 h = {X[2 * q], X[2 * q + 1]}; h = er2 * p + h; h = ei2 * ps + h; X[2 * q] = h.x; X[2 * q + 1] = h.y; }
#pragma unroll
              for (int q = 0; q < 8; ++q) { const f32x2 p = p2[8 + q], ps = {-p.y, p.x}; f32x2 h = {Y[2 * q], Y[2 * q + 1]}; h = er2 * p + h; h = ei2 * ps + h; Y[2 * q] = h.x; Y[2 * q + 1] = h.y; }
              carry = (f32x2){__shfl_xor(Y[14], 32), __shfl_xor(Y[15], 32)};
              LAS unsigned char* hb = Hb + (k & 1) * (32 * HP) + (16 * hi) * HP + 4 * n;
#pragma unroll
              for (int q = 0; q < 8; ++q) { *(LAS unsigned*)(hb + q * HP) = pk2(X[2 * q], X[2 * q + 1]); *(LAS unsigned*)(hb + (8 + q) * HP) = pk2(Y[2 * q], Y[2 * q + 1]); }
            }
            asm volatile("s_waitcnt lgkmcnt(0)\n\ts_barrier" ::: "memory");
            if (k >= 8) {
                const LAS unsigned char* hr = Hb + (k & 1) * (32 * HP) + (16 * nh + l15) * HP + 16 * q4;
                f32x4 y = {0.f, 0.f, 0.f, 0.f};
#pragma unroll
                for (int ks = 0; ks < 4; ++ks) { const bf16x8 hf = *(const LAS bf16x8*)(hr + 64 * ks); y = __builtin_amdgcn_mfma_f32_16x16x32_bf16(cf[ks], hf, y, 0, 0, 0); }
                if (first) { *(f32x4*)(YA + o) = y; }
                else {
                    const f32x4 uf = {bf2f(uu.x & 0xffffu), bf2f(uu.x >> 16), bf2f(uu.y & 0xffffu), bf2f(uu.y >> 16)};
                    const f32x4 t = y + pk + dsk * uf;
                    v2u ov; ov.x = pk2(gelu_tanh(t.x), gelu_tanh(t.y)); ov.y = pk2(gelu_tanh(t.z), gelu_tanh(t.w)); *(v2u*)(GS + o) = ov;
                }
            }
            if (k == 39) asm volatile("s_waitcnt vmcnt(0)\n\ts_barrier" ::: "memory");
        }
#undef S5_UROW
#undef S5_ULD
#undef S5_RLOAD
        asm volatile("s_waitcnt vmcnt(0) lgkmcnt(0)\n\ts_barrier" ::: "memory");
    }
}

__global__ void __launch_bounds__(NTHR, 2) fwd_kernel(Params prm) {
    extern __shared__ __attribute__((aligned(16))) unsigned char lds_raw[];
    Ctx C; C.p = &prm; C.ws = prm.ws; C.lds = (LAS unsigned char*)lds_raw;
    C.tid = threadIdx.x; C.lane = C.tid & 63; C.wave = __builtin_amdgcn_readfirstlane(C.tid >> 6);
    C.gw = blockIdx.x * NWAVE + C.wave; C.ngw = gridDim.x * NWAVE;
    constexpr int LDS_MISC = 147456 - 512;
    volatile LAS unsigned* misc = (volatile LAS unsigned*)(C.lds + LDS_MISC);
    if (C.tid < 64) misc[C.tid] = 0u;
    __syncthreads();
    unsigned* ctl = (unsigned*)(C.ws + WS_CTL);
    XcdBarrier bar; bar.bar = ctl + CW_BAR; bar.x = 0; bar.st = nullptr;
#if MK_ONE_LAUNCH
    bar = xcd_barrier_post(ctl + CW_BAR, misc + 8);
#define SEAM(k) do { if (lo <= (k) && (k) + 1 < hi) xcd_barrier(bar); } while (0)
#else
#define SEAM(k) do { } while (0)
#endif
    const int lo = prm.ph_lo, hi = prm.ph_hi;
#define IN(k) ((C.lane = lane_id_now(), C.tid = C.wave * 64 + C.lane, true) && lo <= (k) && (k) < hi)
#if MK_PROBE
#define STAMP(k) STAMP_AT((k) + 1)
    STAMP_AT(0);
#else
#define STAMP(k) do { } while (0)
#endif
    const Params& P = prm;
    bf16* Hb = (bf16*)(C.ws + WS_H); bf16* XC = (bf16*)(C.ws + WS_XC);
#define MOE_MAP(layer) do { LAS int* tm_ = (LAS int*)(C.lds + 131072); LAS int* cl_ = tm_ + 320; \
        if (C.wave == 0) { const unsigned* cnt_ = (const unsigned*)(C.ws + WS_CTL) + CW_CNT + 64 * (layer); const int mc_ = C.lane < 32 ? (int)__hip_atomic_load(cnt_ + (C.lane & 31), __ATOMIC_RELAXED, __HIP_MEMORY_SCOPE_AGENT) : 0; const int mp_ = (mc_ + 255) & ~255; int in_ = mp_; \
            _Pragma("unroll") for (int o_ = 1; o_ < 32; o_ <<= 1) { const int t_ = __shfl_up(in_, o_); if ((C.lane & 31) >= o_) in_ += t_; } const int ps_ = in_ - mp_; \
            if (C.lane < 32) { for (int t_ = ps_ / 256; t_ < (ps_ + mp_) / 256; ++t_) tm_[t_] = C.lane | ((t_ * 256 - ps_) << 8); cl_[C.lane] = mc_; if (C.lane == 31) cl_[32] = (ps_ + mp_) / 256; } } \
        __syncthreads(); } while (0)
#define MOE_GEMM1(layer) do { MOE_MAP(layer); const LAS int* tm_ = (const LAS int*)(C.lds + 131072); const int ntl_ = __builtin_amdgcn_readfirstlane(tm_[320 + 32]); pg8::Gemm g{Hb, (const bf16*)(C.ws + ((layer) ? WS_W13B : WS_W13)), 0, 1024, 512}; \
        pg8::GroupedOrder<true> S{tm_, tm_ + 320, (const int*)(C.ws + WS_LIST), ntl_ * 4, 4, (int)gridDim.x, (int)blockIdx.x, LCAP, 1024, (size_t)1024 * 1024}; pg8::EpiSwiglu E{(unsigned char*)(C.ws + WS_G13), 1.f / W13_SCALE, G_SCALE}; \
        pg8::gemm_phase<pg8::EpiSwiglu, pg8::GroupedOrder<true>, true, false, false, true>(C.lds, g, S, E, C.wave); } while (0)
#define MOE_GEMM2(layer) do { MOE_MAP(layer); int kk_ = EH / 2; asm volatile("" : "+s"(kk_));     \
        const LAS int* tm_ = (const LAS int*)(C.lds + 131072); const int ntl_ = __builtin_amdgcn_readfirstlane(tm_[320 + 32]); pg8::Gemm g{(const bf16*)(C.ws + WS_G13), (const bf16*)(C.ws + ((layer) ? WS_W2B : WS_W2)), 0, 1024, kk_}; \
        pg8::GroupedOrder<false> S{tm_, tm_ + 320, (const int*)(C.ws + WS_LIST), ntl_ * 4, 4, (int)gridDim.x, (int)blockIdx.x, LCAP, EH, (size_t)1024 * 512}; pg8::EpiStore E{(bf16*)(C.ws + WS_XS), D, 1.f / (W13_SCALE * G_SCALE)}; \
        pg8::gemm_phase<pg8::EpiStore, pg8::GroupedOrder<false>, true, false, false, true>(C.lds, g, S, E, C.wave); } while (0)
    if (IN(0)) { phase_prologue(C); SEAM(0); STAMP(0); }
    if (IN(1)) { phase_norm_mix0(C); SEAM(1); STAMP(1); }
    if (IN(2)) { pg8::Gemm g{Hb, (const bf16*)(C.ws + WS_WIN0), TT, MIXW, D / 2};
        pg8::StaticOrder S; S.init(TT, MIXW, gridDim.x, blockIdx.x); pg8::EpiInProj E{(bf16*)(C.ws + WS_P), (bf16*)(C.ws + WS_K), (bf16*)(C.ws + WS_V), P.in[I_KG], (const float*)(C.ws + WS_TAB + TAB_ROPE), (LAS float*)(C.lds + 135168), 1.f / W13_SCALE, (float*)(C.ws + WS_Q)};
        pg8::gemm_phase<pg8::EpiInProj, pg8::StaticOrder, true, false, false, true>(C.lds, g, S, E, C.wave); SEAM(2); STAMP(2); }
    if (IN(4)) { phase_gmlp_fast(C); phase_attn_fast(C, (char*)lds_raw); SEAM(4); STAMP(4); }
    if (IN(5)) { pg8::Gemm g{Hb, (const bf16*)(C.ws + WS_WOUT0), TT, D, D}; pg8::StaticOrderH S; S.init(TT, D, gridDim.x, blockIdx.x, 1); pg8::EpiResid E{P.in[I_X], P.in[I_CTX], (const float*)(C.ws + WS_MOD), XC, 0};
        pg8::gemm_phase<pg8::EpiResid, pg8::StaticOrderH, true, true, true>(C.lds, g, S, E, C.wave);
        if (gridDim.x == 256) { __syncthreads(); convert_range(C, 0, L0_A, L0_B, 64); }
        SEAM(5); STAMP(5); }
    if (IN(6)) { phase_router_fast(C, 0, TT); if (gridDim.x == 256) { __syncthreads(); convert_range(C, 0, L0_B, MOE_ITEMS, 32); } SEAM(6); STAMP(6); }
    if (IN(8)) { MOE_GEMM1(0); SEAM(8); STAMP(8); }
    if (IN(9)) { MOE_GEMM2(0); if (gridDim.x == 256) { __syncthreads(); convert_range(C, 1, L1_A, L1_B, 192); } SEAM(9); STAMP(9); }
    if (IN(10)) { phase_combine_norm_mix1(C); SEAM(10); STAMP(10); }
    if (IN(11)) { pg8::Gemm g{Hb, (const bf16*)(C.ws + WS_WS5IN), TT, 512, D}; pg8::StaticOrderH S; S.init(TT, 512, gridDim.x, blockIdx.x, 1); pg8::EpiStore E{(bf16*)(C.ws + WS_U), 512, 1.f};
        pg8::gemm_phase<pg8::EpiStore, pg8::StaticOrderH, true, true, true>(C.lds, g, S, E, C.wave);
        if (gridDim.x == 256) { __syncthreads(); convert_range(C, 1, L1_B, L1_C, 64); }
        SEAM(11); STAMP(11); }
    if (IN(12)) { phase_s5_fast(C); SEAM(12); STAMP(12); }
    if (IN(13)) { pg8::Gemm g{(const bf16*)(C.ws + WS_GS), (const bf16*)(C.ws + WS_WGLU), TL, 512, 512}; pg8::StaticOrder S; S.init(TL, 512, gridDim.x, blockIdx.x); pg8::EpiGlu E{(const bf16*)(C.ws + WS_GS), P.in[I_BGLU], (bf16*)(C.ws + WS_GG)};
        pg8::gemm_phase<pg8::EpiGlu, pg8::StaticOrder, true, true, true>(C.lds, g, S, E, C.wave); SEAM(13); STAMP(13); }
    if (IN(14)) { pg8::Gemm g{(const bf16*)(C.ws + WS_GG), (const bf16*)(C.ws + WS_WS5OUT), TL, D, 512}; pg8::StaticOrder S; S.init(TL, D, gridDim.x, blockIdx.x); pg8::EpiResid E{P.in[I_X], P.in[I_CTX], (const float*)(C.ws + WS_MOD) + (size_t)17 * 6 * D, XC, 1};
        pg8::gemm_phase<pg8::EpiResid, pg8::StaticOrder, true, true, true>(C.lds, g, S, E, C.wave); SEAM(14); STAMP(14); }
    if (IN(15)) { phase_router_fast(C, 1, TL); SEAM(15); STAMP(15); }
    if (IN(17)) { MOE_GEMM1(1); SEAM(17); STAMP(17); }
    if (IN(18)) { MOE_GEMM2(1); SEAM(18); STAMP(18); }
    if (IN(19)) { phase_final(C); STAMP(19); }
#if MK_PROBE
    if (blockIdx.x == 0 && C.wave == 0 && lane_id_now() == 0) {
        volatile LAS unsigned long long* ts_ = (volatile LAS unsigned long long*)(C.lds + LDS_MISC + 64);
        ts_[8] = ts_[7]; ts_[17] = ts_[16];
        const unsigned long long tA = ts_[PROBE_A_HI + 1] - ts_[PROBE_A_LO], tB = ts_[PROBE_B_HI + 1] - ts_[PROBE_B_LO];
        const unsigned long long spin = 16ull * tA + 1000000ull * ((tB + 500ull) / 1000ull);
        const unsigned long long t0 = __builtin_amdgcn_s_memrealtime();
        while (__builtin_amdgcn_s_memrealtime() - t0 < spin) __builtin_amdgcn_s_sleep(8);
    }
#endif
#undef IN
#undef SEAM
}

extern "C" void kernel_launch(void* const* d_in, const int* in_sizes, int n_in, void* d_out, int out_size, void* d_ws, size_t ws_size, hipStream_t stream) {
    constexpr int LDS_BYTES = 147456;
    static int grid = 0;
    if (grid == 0) {
        if (n_in != 35 || out_size != TL * D || ws_size < WS_END) { fprintf(stderr, "kernel_launch: unexpected shapes (n_in %d out %d ws %zu)\n", n_in, out_size, ws_size); grid = -1; return; }
        int dev = 0, cus = 0;
        if (hipGetDevice(&dev) != hipSuccess || hipDeviceGetAttribute(&cus, hipDeviceAttributeMultiprocessorCount, dev) != hipSuccess) { grid = -1; return; }
        if (hipFuncSetAttribute((const void*)fwd_kernel, hipFuncAttributeMaxDynamicSharedMemorySize, LDS_BYTES) != hipSuccess) { fprintf(stderr, "kernel_launch: hipFuncSetAttribute failed\n"); grid = -1; return; }
        (void)hipGetLastError();
        grid = cus;
    }
    if (grid < 0) return;
    (void)hipMemsetAsync((char*)d_ws + WS_CTL, 0, CTL_BYTES, stream);
    Params p{};
    for (int i = 0; i < 35; ++i) p.in[i] = (const float*)d_in[i];
    p.out = (float*)d_out; p.ws = (unsigned char*)d_ws;
#if MK_ONE_LAUNCH
    p.ph_lo = 0; p.ph_hi = NPHASE;
    hipLaunchKernelGGL(fwd_kernel, dim3(grid), dim3(NTHR), LDS_BYTES, stream, p);
#else
    for (int k = 0; k < NPHASE; ++k) { p.ph_lo = k; p.ph_hi = k + 1; hipLaunchKernelGGL(fwd_kernel, dim3(grid), dim3(NTHR), LDS_BYTES, stream, p); }
#endif
}
```

```cpp
#include <hip/hip_runtime.h>
#include <cstdio>
#include <cstdint>
#include <type_traits>

#ifndef MK_ONE_LAUNCH
#define MK_ONE_LAUNCH 1
#endif
#ifndef MK_SIMPLE_ORDER
#define MK_SIMPLE_ORDER 0
#endif
#ifndef MK_KROT
#define MK_KROT 0
#endif
#ifndef MK_PROBE
#define MK_PROBE 0
#endif
#define PROBE_A_LO 4
#define PROBE_A_HI 4
#define PROBE_B_LO 8
#define PROBE_B_HI 9

constexpr int D = 1024, NB = 16, SEQ = 2048, CTXL = 256;
constexpr int TL = NB * SEQ, TC = NB * CTXL, TT = TL + TC;
constexpr int KVL = CTXL + SEQ;
constexpr int MIXW = 1792, NEXP = 32, EH = 512;
constexpr int NSLOT = 81920;
constexpr float EPS = 1e-6f;
constexpr float QSCALE = 0.125f * 1.4426950408889634f;
constexpr int NTHR = 512, NWAVE = 8;
constexpr float W13_SCALE = 32.f;
constexpr float G_SCALE = 8.f;
constexpr int NPHASE = 20;

constexpr size_t MiB = 1u << 20;
constexpr size_t WS_CTL = 0, CTL_BYTES = 1 * MiB;
constexpr size_t WS_MOD = 1 * MiB;
constexpr size_t WS_TAB = 2 * MiB;
constexpr size_t TAB_ROPE = 0, TAB_LAMB = 16384, TAB_BBAR = 65536, TAB_WR = 640 * 1024;
constexpr size_t WS_ROUTE = 3 * MiB;
constexpr size_t RT_E = 0, RT_P = 320 * 1024, RT_W = 640 * 1024, RT_S = 960 * 1024, RT_TILE = 1280 * 1024, RT_NT = 1280 * 1024 + 4096;
constexpr size_t WS_WIN0 = 6 * MiB, WS_WOUT0 = 10 * MiB, WS_WS5IN = 12 * MiB, WS_WGLU = 13 * MiB, WS_WS5OUT = 14 * MiB;
constexpr size_t WS_WSP = 15 * MiB;
constexpr size_t WS_W13 = 16 * MiB, WS_W2 = 80 * MiB;
constexpr size_t WS_W13B = 184 * MiB, WS_W2B = 216 * MiB;
constexpr int L0_A = 4096, L0_B = L0_A + 0;
constexpr int L1_A = 2048, L1_B = L1_A + 4096, L1_C = L1_B + 7168;
constexpr size_t WS_XC = 112 * MiB;
constexpr size_t WS_H = 256 * MiB;
constexpr size_t WS_P = 328 * MiB;
constexpr size_t WS_Q = 454 * MiB, WS_K = 490 * MiB, WS_V = 499 * MiB;
constexpr size_t WS_XS = 328 * MiB;
constexpr size_t WS_G13 = 488 * MiB;
constexpr size_t WS_U = 328 * MiB, WS_GS = 364 * MiB, WS_GG = 396 * MiB, WS_YACC = 428 * MiB;
constexpr size_t WS_LIST = 568 * MiB;
constexpr int LCAP = 36864;
constexpr size_t WS_END = 574 * MiB;
constexpr int CW_CNT = 64;
constexpr int CW_BAR = 4096;

__device__ __forceinline__ int lane_id_now() { int l; asm volatile("v_mbcnt_lo_u32_b32 %0, -1, 0\n\tv_mbcnt_hi_u32_b32 %0, -1, %0\n\ts_nop 0" : "=v"(l)); return l; }
#define STAMP_AT(idx) do { if (MK_PROBE && blockIdx.x == 0 && C.wave == 0 && lane_id_now() == 0) ((volatile __attribute__((address_space(3))) unsigned long long*)(C.lds + 147456 - 512 + 64))[idx] = __builtin_amdgcn_s_memrealtime(); } while (0)
#define LAS __attribute__((address_space(3)))
typedef unsigned short bf16;
typedef unsigned v4u __attribute__((ext_vector_type(4)));
typedef unsigned v2u __attribute__((ext_vector_type(2)));
typedef float f32x4 __attribute__((ext_vector_type(4)));
typedef float f32x2 __attribute__((ext_vector_type(2)));
__device__ __forceinline__ float bf2f(unsigned u) { return __uint_as_float(u << 16); }
typedef __bf16 bf16x2_t __attribute__((ext_vector_type(2)));
__device__ __forceinline__ unsigned pk2(float lo, float hi) { const f32x2 v = {lo, hi}; return __builtin_bit_cast(unsigned, __builtin_convertvector(v, bf16x2_t)); }
__device__ __forceinline__ unsigned f2bf(float f) { return pk2(f, 0.f) & 0xffffu; }
__device__ __forceinline__ float wave_sum(float v) {
#pragma unroll
    for (int o = 1; o < 64; o <<= 1) v += __shfl_xor(v, o);
    return v;
}
__device__ __forceinline__ float wave_max(float v) {
#pragma unroll
    for (int o = 1; o < 64; o <<= 1) v = fmaxf(v, __shfl_xor(v, o));
    return v;
}
__device__ __forceinline__ float gelu_tanh(float x) { const float u2 = -1.5957691216057308f * (x + 0.044715f * x * x * x); return x * __builtin_amdgcn_rcpf(1.f + __expf(u2)); }
__device__ __forceinline__ float sigmoidf_(float x) { return 1.f / (1.f + __expf(-x)); }
__device__ __forceinline__ float silu_(float x) { return x / (1.f + __expf(-x)); }
__device__ __forceinline__ void unpack8(const v4u w, float* f) {
    f[0] = bf2f(w.x & 0xffffu); f[1] = bf2f(w.x >> 16); f[2] = bf2f(w.y & 0xffffu); f[3] = bf2f(w.y >> 16);
    f[4] = bf2f(w.z & 0xffffu); f[5] = bf2f(w.z >> 16); f[6] = bf2f(w.w & 0xffffu); f[7] = bf2f(w.w >> 16);
}

#define XB_TMO      128
#define XB_XCNT(j)  (256  + 64 * (j))
#define XB_XSUB(j)  (1280 + 64 * (j))
#define XB_XGEN(j)  (2304 + 64 * (j))
#define XB_TOP      3328
#define XB_TOPGEN   3392
#define XCD_BAR_WORDS 3456
#define XB_SPIN_CAP (1u << 28)
__device__ __forceinline__ unsigned xb_ld(unsigned* p)              { return __hip_atomic_load(p, __ATOMIC_RELAXED, __HIP_MEMORY_SCOPE_AGENT); }
__device__ __forceinline__ unsigned xb_add(unsigned* p, unsigned v) { return __hip_atomic_fetch_add(p, v, __ATOMIC_RELAXED, __HIP_MEMORY_SCOPE_AGENT); }
__device__ __forceinline__ unsigned xb_xcc_id() { return (unsigned)__builtin_amdgcn_s_getreg((3 << 11) | 20) & 0xFu; }
#define XB_SPIN(cond, bar) do { unsigned _sp = 0; while (cond) { __builtin_amdgcn_s_sleep(1); \
    if ((++_sp & 255u) == 0u) { if (xb_ld(&(bar)[XB_TMO])) break; if (_sp > XB_SPIN_CAP) { atomicAdd(&(bar)[XB_TMO], 1u); break; } } } } while (0)
struct XcdBarrier { unsigned* bar; unsigned x; volatile LAS unsigned* st; };
__device__ __forceinline__ XcdBarrier xcd_barrier_post(unsigned* bar, volatile LAS unsigned* st) {
    XcdBarrier b; b.bar = bar; b.x = xb_xcc_id(); b.st = st;
    if (threadIdx.x == 0) (void)xb_add(&bar[XB_XCNT(b.x)], 1u);
    return b;
}
__device__ __forceinline__ void xcd_barrier_complete(unsigned* bar, unsigned x, unsigned& nloc, unsigned& nx) {
    const unsigned G = gridDim.x * gridDim.y * gridDim.z;
    unsigned sum, cnt, mine, sp = 0u;
    for (;;) {
        sum = 0u; cnt = 0u; mine = 0u;
#pragma unroll
        for (unsigned j = 0; j < 16; ++j) { const unsigned c = xb_ld(&bar[XB_XCNT(j)]); sum += c; cnt += (c > 0u) ? 1u : 0u; mine = (j == x) ? c : mine; }
        if (sum == G) break;
        __builtin_amdgcn_s_sleep(1);
        if ((++sp & 255u) == 0u) { if (xb_ld(&bar[XB_TMO])) break; if (sp > XB_SPIN_CAP) { atomicAdd(&bar[XB_TMO], 1u); break; } }
    }
    nloc = mine > 0u ? mine : 1u; nx = cnt > 0u ? cnt : 1u;
}
__device__ __forceinline__ void xcd_barrier(const XcdBarrier& b) {
    asm volatile("s_waitcnt vmcnt(0)" ::: "memory");
    __syncthreads();
    if (threadIdx.x == 0) {
        unsigned* bar = b.bar;
        __builtin_amdgcn_s_waitcnt(0);
        unsigned nloc = b.st[0], nx = b.st[1];
        if (nloc == 0u) { xcd_barrier_complete(bar, b.x, nloc, nx); b.st[0] = nloc; b.st[1] = nx; }
        const unsigned old = xb_add(&bar[XB_XSUB(b.x)], 1u);
        const unsigned gen = old / nloc;
        if (old + 1u == (gen + 1u) * nloc) {
            __builtin_amdgcn_fence(__ATOMIC_RELEASE, "agent");
            asm volatile("s_waitcnt vmcnt(0)" ::: "memory");
            const unsigned og = xb_add(&bar[XB_TOP], 1u);
            const unsigned tg = og / nx;
            if (og + 1u == (tg + 1u) * nx) xb_add(&bar[XB_TOPGEN], 1u);
            else XB_SPIN(xb_ld(&bar[XB_TOPGEN]) == tg, bar);
            __builtin_amdgcn_fence(__ATOMIC_ACQUIRE, "agent");
            xb_add(&bar[XB_XGEN(b.x)], 1u);
            asm volatile("s_waitcnt vmcnt(0)" ::: "memory");
        } else {
            XB_SPIN(xb_ld(&bar[XB_XGEN(b.x)]) == gen, bar);
            __builtin_amdgcn_fence(__ATOMIC_ACQUIRE, "agent");
            asm volatile("s_waitcnt vmcnt(0)" ::: "memory");
        }
    }
    __syncthreads();
}

namespace pg8 {
#define PG8_LAS __attribute__((address_space(3)))
typedef unsigned short bf16_t;
typedef short bf16x8 __attribute__((ext_vector_type(8)));
typedef float f32x4 __attribute__((ext_vector_type(4)));
typedef unsigned u32x4 __attribute__((ext_vector_type(4)));
typedef int i32x4 __attribute__((ext_vector_type(4)));
typedef unsigned u32x2 __attribute__((ext_vector_type(2)));
constexpr int BM = 256, BK = 64, HALF = 128, HTB = HALF * BK * 2  , STAGE_BYTES = 8 * HTB, NXCD = 8, WGM = 8;

__host__ __device__ __forceinline__ int lds_byte(int r, int c) { const int st = (r >> 4) * 2 + (c >> 5), rr = r & 15, cc = c & 31, ob = rr * 64 + cc * 2; return st * 1024 + (ob ^ (((ob >> 9) & 1) << 5)); }
__host__ __device__ __forceinline__ void stage_rc(int b, int& R, int& C) { const int st = b / 1024, sb = b % 1024, swz = sb ^ (((sb >> 9) & 1) << 5); R = (st >> 1) * 16 + swz / 64; C = (st & 1) * 32 + (swz % 64) / 2; }
__host__ __device__ __forceinline__ int perm32(int rho) { const int n = rho >> 4, i = rho & 15; return 8 * (i >> 2) + 4 * n + (i & 3); }

struct Unit { int pm, pn; size_t bo; int aux; int half; };
struct Gemm { const bf16_t* A; const bf16_t* Bt; int M, N, K; };

template <bool HALVES>
struct StaticOrderT {
    static constexpr bool GATHER = false;
    int nM, nN, nwg, G, c, halves;
    __host__ __device__ void init(int M, int N, int G_, int c_, int halves_ = 0) { nM = M / BM; nN = N / BM; nwg = nM * nN; G = G_; c = c_; halves = HALVES && halves_ && (G_ & 15) == 0; }
    __host__ __device__ bool next(int i, Unit& u) const {
        long L = (long)i * G + c; u.half = 0;
        if (HALVES && halves) { const int il = nwg / G, rem = nwg - il * G; if (i == il && rem > 0 && 2 * rem <= G) { const int j = (c >> 4) * 8 + (c & 7); if (j >= rem) return false; L = (long)il * G + j; u.half = 1 + ((c >> 3) & 1); } }
        if (L >= nwg) return false;
        if (MK_SIMPLE_ORDER) { u.pm = (int)L / nN; u.pn = (int)L % nN; u.bo = 0; u.aux = 0; return true; }
        int wgid = (int)L; { const int q = nwg / NXCD, r = nwg % NXCD, xcd = wgid % NXCD, off = wgid / NXCD; wgid = (xcd < r ? xcd * (q + 1) : r * (q + 1) + (xcd - r) * q) + off; }
        const int nig = WGM * nN, gid = wgid / nig, fm = gid * WGM, gsz = (nM - fm) < WGM ? (nM - fm) : WGM;
        u.pm = fm + ((wgid % nig) % gsz); u.pn = (wgid % nig) / gsz; u.bo = 0; u.aux = 0; return true;
    }
    __device__ __forceinline__ void a_ready(const Unit&) const {}
    __device__ __forceinline__ void done(const Unit&) const {}
};
typedef StaticOrderT<false> StaticOrder; typedef StaticOrderT<true> StaticOrderH;

typedef __bf16 bf16x2_c __attribute__((ext_vector_type(2))); typedef float f32x2_c __attribute__((ext_vector_type(2)));
__device__ __forceinline__ unsigned cvt_pk_bf16(float lo, float hi) { const f32x2_c v = {lo, hi}; return __builtin_bit_cast(unsigned, __builtin_convertvector(v, bf16x2_c)); }
typedef float f32x2 __attribute__((ext_vector_type(2)));
__device__ __forceinline__ f32x2 gelu_pk(f32x2 v) {
    const f32x2 av = __builtin_elementwise_abs(v), d = av * 0.2316418882f + 1.0f;
    f32x2 t; t.x = __builtin_amdgcn_rcpf(d.x); t.y = __builtin_amdgcn_rcpf(d.y);
    f32x2 q = t * 0.5307027145f + (-0.7265760135f); q = q * t + 0.7107068705f; q = q * t + (-0.142248368f); q = q * t + 0.127414796f; q = q * t;
    const f32x2 s = (v * v) * (-0.72134752044f);
    f32x2 e; e.x = __builtin_amdgcn_exp2f(s.x); e.y = __builtin_amdgcn_exp2f(s.y);
    const f32x2 m = v * (q * e), r = v - m;
    f32x2 o; o.x = v.x < 0.f ? m.x : r.x; o.y = v.y < 0.f ? m.y : r.y; return o;
}

template <class Epi, class Sched, bool ALIGN_EPI = false, bool SP2 = false, bool KROT = false, bool FP8 = false>
__device__ __forceinline__ void gemm_phase(PG8_LAS unsigned char* lds, const Gemm g, const Sched& S, const Epi& E, const int wave_id) {
    const int wid = __builtin_amdgcn_readfirstlane(wave_id), lane = lane_id_now(), tid = wid * 64 + lane, wr = wid >> 2, wc = wid & 3, fr = lane & 15, fq = lane >> 4;
    const int K = g.K, nt = K / BK;
    const int kmask = nt - 1, rot = (MK_KROT && KROT) ? (int)((blockIdx.x * 3u + (blockIdx.x >> 3)) & (unsigned)kmask) : 0;
#define PG8_KO(j) ((size_t)(((j) + rot) & kmask) * kstep)
    unsigned voffA[2], voffB[2];
    unsigned vC[2][2], vN[2][2];
#pragma unroll
    for (int i = 0; i < 2; ++i) { int R, C; stage_rc(tid * 16 + i * 8192, R, C); const int Rb = Epi::PERM ? ((R & ~31) + perm32(R & 31)) : R;
        voffA[i] = (unsigned)(R * K + C) * 2u; voffB[i] = (unsigned)(Rb * K + C) * 2u; }
    const size_t kstep = (size_t)(BK * 2);
    const size_t hstep = (size_t)HALF * K * 2;
    const size_t tstep = 2 * hstep;
    const unsigned ldsw = (unsigned)wid * 1024u;
    const int aoff = lds_byte(wr * 64 + fr, fq * 8), boff = lds_byte(wc * 32 + fr, fq * 8);
#define PG8_SA(b, h) (((b) * 2 + (h)) * HTB)
#define PG8_SB(b, h) ((4 + (b) * 2 + (h)) * HTB)
#define PG8_STAGE(bufoff, gbase, voff) do { _Pragma("unroll") for (int _i = 0; _i < 2; ++_i) \
        __builtin_amdgcn_global_load_lds((const unsigned*)((const char*)(gbase) + (voff)[_i]), (PG8_LAS unsigned*)(lds + (bufoff) + ldsw + _i * 8192), 16, 0, 0); } while (0)
#define PG8_STAGE_A(bufoff, gbase, h, nx) do { _Pragma("unroll") for (int _i = 0; _i < 2; ++_i) { \
        const unsigned _vo = Sched::GATHER ? ((nx) ? vN[h][_i] : vC[h][_i]) : (unsigned)((h) * hstep) + voffA[_i]; \
        __builtin_amdgcn_global_load_lds((const unsigned*)((const char*)(gbase) + _vo), (PG8_LAS unsigned*)(lds + (bufoff) + ldsw + _i * 8192), 16, 0, 0); } } while (0)
#define PG8_LDA(dst, b, h) do { _Pragma("unroll") for (int m = 0; m < 4; ++m) { if constexpr (FP8) { dst[m].lo = *(const PG8_LAS i32x4*)(lds + PG8_SA(b, h) + aoff + m * 2048); dst[m].hi = *(const PG8_LAS i32x4*)(lds + PG8_SA(b, h) + aoff + m * 2048 + 1024); } \
        else { _Pragma("unroll") for (int k = 0; k < 2; ++k) dst[m][k] = *(const PG8_LAS bf16x8*)(lds + PG8_SA(b, h) + aoff + m * 2048 + k * 1024); } } } while (0)
#define PG8_LDB(dst, b, h) do { _Pragma("unroll") for (int n = 0; n < 2; ++n) { if constexpr (FP8) { dst[n].lo = *(const PG8_LAS i32x4*)(lds + PG8_SB(b, h) + boff + n * 2048); dst[n].hi = *(const PG8_LAS i32x4*)(lds + PG8_SB(b, h) + boff + n * 2048 + 1024); } \
        else { _Pragma("unroll") for (int k = 0; k < 2; ++k) dst[n][k] = *(const PG8_LAS bf16x8*)(lds + PG8_SB(b, h) + boff + n * 2048 + k * 1024); } } } while (0)
#define PG8_CAT(x0, x1) __builtin_shufflevector(__builtin_bit_cast(i32x4, x0), __builtin_bit_cast(i32x4, x1), 0, 1, 2, 3, 4, 5, 6, 7)
#define PG8_MMA(ai, bj, At, Bt) do { __builtin_amdgcn_s_setprio(1); \
        if constexpr (FP8) { _Pragma("unroll") for (int m = 0; m < 4; ++m) _Pragma("unroll") for (int n = 0; n < 2; ++n) \
            acc[ai][bj][m][n] = __builtin_amdgcn_mfma_scale_f32_16x16x128_f8f6f4(Bt[n], At[m], acc[ai][bj][m][n], 0, 0, 0, 127, 0, 127); } \
        if constexpr (FP8) { asm volatile("" : "+v"(acc[ai][bj][0][0]), "+v"(acc[ai][bj][0][1]), "+v"(acc[ai][bj][1][0]), "+v"(acc[ai][bj][1][1]), "+v"(acc[ai][bj][2][0]), "+v"(acc[ai][bj][2][1]), "+v"(acc[ai][bj][3][0]), "+v"(acc[ai][bj][3][1])); }     \
        else { _Pragma("unroll") for (int m = 0; m < 4; ++m) _Pragma("unroll") for (int n = 0; n < 2; ++n) _Pragma("unroll") for (int k = 0; k < 2; ++k) \
            acc[ai][bj][m][n] = __builtin_amdgcn_mfma_f32_16x16x32_bf16(Bt[n][k], At[m][k], acc[ai][bj][m][n], 0, 0, 0); } \
        __builtin_amdgcn_s_setprio(0); } while (0)
#define PG8_WAIT_V(n) asm volatile("s_waitcnt vmcnt(" #n ")" ::: "memory")
#define PG8_WAIT_L(n) asm volatile("s_waitcnt lgkmcnt(" #n ")" ::: "memory")
#define PG8_BAR __builtin_amdgcn_s_barrier()
#define PG8_SCHED __builtin_amdgcn_sched_barrier(0)
    Unit cur, nxt; int ui = 0;
    if (!S.next(0, cur)) return;
    f32x4 acc[2][2][4][2];
#pragma unroll
    for (int a = 0; a < 2; ++a)
#pragma unroll
        for (int b = 0; b < 2; ++b)
#pragma unroll
            for (int m = 0; m < 4; ++m)
#pragma unroll
                for (int n = 0; n < 2; ++n) acc[a][b][m][n] = (f32x4){0.f, 0.f, 0.f, 0.f};
    typedef int i32x8 __attribute__((ext_vector_type(8)));
    typedef int i32x8 __attribute__((ext_vector_type(8)));
    typename std::conditional<FP8, i32x8[4], bf16x8[4][2]>::type At; typename std::conditional<FP8, i32x8[2], bf16x8[2][2]>::type B0, B1;
    const char* cA = (const char*)g.A + (Sched::GATHER ? (size_t)0 : (size_t)cur.pm * tstep); const char* cB = (const char*)g.Bt + cur.bo + (size_t)cur.pn * tstep;
    S.a_ready(cur);
#define PG8_VOFF(dst, un) do { _Pragma("unroll") for (int _h = 0; _h < 2; ++_h) _Pragma("unroll") for (int _i = 0; _i < 2; ++_i) { int R_, C_; stage_rc(tid * 16 + _i * 8192, R_, C_); dst[_h][_i] = S.a_off(un, _h * HALF + R_) + (unsigned)C_ * 2u; } } while (0)
    if constexpr (Sched::GATHER) { PG8_VOFF(vC, cur); }
    if constexpr (SP2) {
        PG8_STAGE(PG8_SB(0, 0), cB + PG8_KO(0), voffB); PG8_STAGE(PG8_SB(0, 1), cB + hstep + PG8_KO(0), voffB); PG8_STAGE_A(PG8_SA(0, 0), cA + PG8_KO(0), 0, false); PG8_STAGE_A(PG8_SA(0, 1), cA + PG8_KO(0), 1, false);
        if (wr == 1) PG8_BAR;
        PG8_WAIT_V(2); PG8_BAR;
        PG8_STAGE(PG8_SB(1, 0), cB + PG8_KO(1), voffB); PG8_STAGE_A(PG8_SA(1, 0), cA + PG8_KO(1), 0, false); PG8_STAGE(PG8_SB(1, 1), cB + hstep + PG8_KO(1), voffB);
        PG8_WAIT_V(6); PG8_BAR;
    } else {
        PG8_STAGE(PG8_SB(0, 0), cB, voffB); PG8_STAGE_A(PG8_SA(0, 0), cA, 0, false); PG8_STAGE(PG8_SB(0, 1), cB + hstep, voffB); PG8_STAGE_A(PG8_SA(0, 1), cA, 1, false);
        if (wr == 1) PG8_BAR;
        PG8_WAIT_V(4); PG8_BAR;
        PG8_STAGE(PG8_SB(1, 0), cB + PG8_KO(1), voffB); PG8_STAGE_A(PG8_SA(1, 0), cA + PG8_KO(1), 0, false); PG8_STAGE(PG8_SB(1, 1), cB + hstep + PG8_KO(1), voffB);
        PG8_WAIT_V(6); PG8_BAR;
    }
    for (;;) {
        const bool has_next = S.next(ui + 1, nxt);
        if constexpr (Sched::GATHER) { if (has_next) { PG8_VOFF(vN, nxt); } else { vN[0][0] = vC[0][0]; vN[0][1] = vC[0][1]; vN[1][0] = vC[1][0]; vN[1][1] = vC[1][1]; } }
        const char* nA = (has_next && !Sched::GATHER) ? (const char*)g.A + (size_t)nxt.pm * tstep : cA; const char* nB = has_next ? (const char*)g.Bt + nxt.bo + (size_t)nxt.pn * tstep : cB;
        const bool mh0 = cur.half != 2, mh1 = cur.half != 1;
#pragma unroll 1
        for (int t = 0; t < nt; t += 2) {
            const bool last = (t == nt - 2);
            const char* a1 = cA + PG8_KO(t + 1);
            const char* a2 = last ? nA + PG8_KO(0) : cA + PG8_KO(t + 2); const char* b2 = last ? nB + PG8_KO(0) : cB + PG8_KO(t + 2);
            const char* a3 = last ? nA + PG8_KO(1) : cA + PG8_KO(t + 3); const char* b3 = last ? nB + PG8_KO(1) : cB + PG8_KO(t + 3);
            if (last && has_next) S.a_ready(nxt);
            if constexpr (SP2) {
            PG8_LDB(B0, 0, 0); PG8_LDB(B1, 0, 1); PG8_SCHED; PG8_LDA(At, 0, 0); PG8_STAGE_A(PG8_SA(1, 1), a1, 1, false);
            PG8_WAIT_V(8); PG8_WAIT_L(0); PG8_BAR; if (mh0) PG8_MMA(0, 0, At, B0); if (mh0) PG8_MMA(0, 1, At, B1); PG8_BAR; PG8_SCHED;
            PG8_LDA(At, 0, 1); PG8_STAGE(PG8_SB(0, 0), b2, voffB); PG8_STAGE(PG8_SB(0, 1), b2 + hstep, voffB); PG8_STAGE_A(PG8_SA(0, 0), a2, 0, last);
            PG8_WAIT_V(8); PG8_WAIT_L(0); PG8_BAR; if (mh1) PG8_MMA(1, 0, At, B0); if (mh1) PG8_MMA(1, 1, At, B1); PG8_BAR; PG8_SCHED;
            PG8_LDB(B0, 1, 0); PG8_LDB(B1, 1, 1); PG8_SCHED; PG8_LDA(At, 1, 0); PG8_STAGE_A(PG8_SA(0, 1), a2, 1, last);
            PG8_WAIT_V(8); PG8_WAIT_L(0); PG8_BAR; if (mh0) PG8_MMA(0, 0, At, B0); if (mh0) PG8_MMA(0, 1, At, B1); PG8_BAR; PG8_SCHED;
            PG8_LDA(At, 1, 1); PG8_STAGE(PG8_SB(1, 0), b3, voffB); PG8_STAGE(PG8_SB(1, 1), b3 + hstep, voffB); PG8_STAGE_A(PG8_SA(1, 0), a3, 0, last);
            PG8_WAIT_V(8); PG8_WAIT_L(0); PG8_BAR; if (mh1) PG8_MMA(1, 0, At, B0); if (mh1) PG8_MMA(1, 1, At, B1); PG8_BAR; PG8_SCHED;
            } else {
            PG8_LDB(B0, 0, 0); PG8_SCHED; PG8_LDA(At, 0, 0); PG8_STAGE_A(PG8_SA(1, 1), a1, 1, false);
            PG8_WAIT_L(8); PG8_BAR; PG8_WAIT_L(0); if (mh0) PG8_MMA(0, 0, At, B0); PG8_BAR; PG8_SCHED;
            PG8_LDB(B1, 0, 1); PG8_STAGE(PG8_SB(0, 0), b2, voffB);
            PG8_BAR; PG8_WAIT_L(0); if (mh0) PG8_MMA(0, 1, At, B1); PG8_BAR;
            PG8_LDA(At, 0, 1); PG8_STAGE_A(PG8_SA(0, 0), a2, 0, last);
            PG8_BAR; PG8_WAIT_L(0); if (mh1) PG8_MMA(1, 0, At, B0); PG8_BAR; PG8_SCHED;
            PG8_STAGE(PG8_SB(0, 1), b2 + hstep, voffB);
            PG8_WAIT_V(6); PG8_BAR; if (mh1) PG8_MMA(1, 1, At, B1); PG8_BAR;
            PG8_LDB(B0, 1, 0); PG8_SCHED; PG8_LDA(At, 1, 0); PG8_STAGE_A(PG8_SA(0, 1), a2, 1, last);
            PG8_WAIT_L(8); PG8_BAR; PG8_WAIT_L(0); if (mh0) PG8_MMA(0, 0, At, B0); PG8_BAR; PG8_SCHED;
            PG8_LDB(B1, 1, 1); PG8_STAGE(PG8_SB(1, 0), b3, voffB);
            PG8_BAR; PG8_WAIT_L(0); if (mh0) PG8_MMA(0, 1, At, B1); PG8_BAR;
            PG8_LDA(At, 1, 1); PG8_STAGE_A(PG8_SA(1, 0), a3, 0, last);
            PG8_BAR; PG8_WAIT_L(0); if (mh1) PG8_MMA(1, 0, At, B0); PG8_BAR; PG8_SCHED;
            PG8_STAGE(PG8_SB(1, 1), b3 + hstep, voffB);
            PG8_WAIT_V(6); PG8_BAR; if (mh1) PG8_MMA(1, 1, At, B1); PG8_BAR;
            }
        }
        if constexpr (ALIGN_EPI) { if (wr == 0) PG8_BAR; }
        if constexpr (!Epi::AFTER_DRAIN) { E(acc, cur, wr, wc, fr, fq); S.done(cur); }
        if (!has_next) break;
#pragma unroll
        for (int a = 0; a < 2; ++a)
#pragma unroll
            for (int b = 0; b < 2; ++b)
#pragma unroll
                for (int m = 0; m < 4; ++m)
#pragma unroll
                    for (int n = 0; n < 2; ++n) acc[a][b][m][n] = (f32x4){0.f, 0.f, 0.f, 0.f};
        cur = nxt; cA = nA; cB = nB; ++ui;
        if constexpr (Sched::GATHER) { vC[0][0] = vN[0][0]; vC[0][1] = vN[0][1]; vC[1][0] = vN[1][0]; vC[1][1] = vN[1][1]; }
        if constexpr (ALIGN_EPI) { if (wr == 1) PG8_BAR; }
    }
    PG8_WAIT_V(0);
    if constexpr (!ALIGN_EPI) { if (wr == 0) PG8_BAR; }
    PG8_BAR;
    if constexpr (Epi::AFTER_DRAIN) { E.fused(acc, cur, wr, wc, fr, fq, lds, wid, lane); S.done(cur); }
#undef PG8_VOFF
#undef PG8_KO
#undef PG8_SA
#undef PG8_SB
#undef PG8_STAGE
#undef PG8_STAGE_A
#undef PG8_LDA
#undef PG8_LDB
#undef PG8_MMA
#undef PG8_CAT
#undef PG8_WAIT_V
#undef PG8_WAIT_L
#undef PG8_BAR
#undef PG8_SCHED
}
}

namespace pg8 {
template <bool GATHER_>
struct GroupedOrder {
    static constexpr bool GATHER = GATHER_;
    const PG8_LAS int* tmap; const PG8_LAS int* cntl; const int* list; int nU, nN, G, c, lcap, rowbytes; size_t estride;
    __device__ __forceinline__ bool next(int i, Unit& u) const { const int ntl = nU / nN, n8 = (ntl + 7) >> 3, x = c & 7, t0 = x * n8; int nt = ntl - t0; nt = nt < 0 ? 0 : (nt > n8 ? n8 : nt);
        int v = (c >> 3) + (G >> 3) * i; u.half = 0;
        if (G == 256) { const int tot = nt * nN, fr = tot >> 5, rem = tot - (fr << 5); if (i == fr && rem > 0 && rem <= 16) { const int j = c >> 3; if ((j >> 1) >= rem) return false; v = (fr << 5) + (j >> 1); u.half = 1 + (j & 1); } }
        if ((G & 7) != 0 || v >= nt * nN) { if ((G & 7) == 0) return false; const long L = (long)i * G + c; if (L >= nU) return false; const int t_ = (int)L / nN; const int m_ = __builtin_amdgcn_readfirstlane(tmap[t_]); u.pm = t_; u.pn = (int)L % nN; u.bo = (size_t)(m_ & 255) * estride; u.aux = m_; return true; }
        const int t = t0 + v / nN; const int m = __builtin_amdgcn_readfirstlane(tmap[t]);
        u.pm = t; u.pn = v % nN; u.bo = (size_t)(m & 255) * estride; u.aux = m; return true; }
    __device__ __forceinline__ unsigned a_off(const Unit& u, int R) const { const int e = u.aux & 255, p0 = u.aux >> 8, ce = cntl[e]; int p = p0 + R; p = p < ce ? p : ce - 1; return (unsigned)list[(size_t)e * lcap + p] * (unsigned)rowbytes; }
    __device__ __forceinline__ void a_ready(const Unit&) const {}
    __device__ __forceinline__ void done(const Unit&) const {}
};
__device__ __forceinline__ u32x4 pack8(const f32x4 a, const f32x4 b) { u32x4 w; w.x = cvt_pk_bf16(a[0], a[1]); w.y = cvt_pk_bf16(a[2], a[3]); w.z = cvt_pk_bf16(b[0], b[1]); w.w = cvt_pk_bf16(b[2], b[3]); return w; }
struct EpiStore {
    static constexpr bool PERM = true, AFTER_DRAIN = false; bf16_t* O; int ldc; float s;
    __device__ __forceinline__ void operator()(const f32x4 (&acc)[2][2][4][2], const Unit& u, int wr, int wc, int, int) const {
        const int ln = lane_id_now(), fr = ln & 15, fq = ln >> 4;
        const int row0 = u.pm * BM + wr * 64 + fr, col0 = u.pn * BM + wc * 32 + 8 * fq;
#pragma unroll
        for (int ai = 0; ai < 2; ++ai) { if (u.half != 0 && ai != u.half - 1) continue;
#pragma unroll
            for (int m = 0; m < 4; ++m) { bf16_t* rowp = O + (size_t)(row0 + ai * HALF + m * 16) * ldc + col0;
#pragma unroll
                for (int bj = 0; bj < 2; ++bj) *(u32x4*)(rowp + bj * HALF) = pack8(acc[ai][bj][m][0] * s, acc[ai][bj][m][1] * s); } }
    }
};

struct EpiInProj {
    static constexpr bool PERM = true, AFTER_DRAIN = false;
    bf16_t* O; bf16_t* Kb; bf16_t* Vb; const float* kg; const float* rope; PG8_LAS float* xch;
    float s;
    float* part;
    __device__ __forceinline__ void operator()(const f32x4 (&acc)[2][2][4][2], const Unit& u, int wr, int wc, int, int) const {
        const int ln = lane_id_now(), fr = ln & 15, fq = ln >> 4;
        if (u.pn != 2) {
            const int row0 = u.pm * BM + wr * 64 + fr, col0 = u.pn * BM + wc * 32 + 8 * fq;
            if (u.pn < 2) {
#pragma unroll
                for (int ai = 0; ai < 2; ++ai)
#pragma unroll
                    for (int m = 0; m < 4; ++m) { bf16_t* rowp = O + (size_t)(row0 + ai * HALF + m * 16) * 1792 + col0;
#pragma unroll
                        for (int bj = 0; bj < 2; ++bj) *(u32x4*)(rowp + bj * HALF) = pack8(acc[ai][bj][m][0] * s, acc[ai][bj][m][1] * s); }
                return;
            }
            const bool stats = u.pn >= 5;
#pragma unroll
            for (int ai = 0; ai < 2; ++ai)
#pragma unroll
                for (int m = 0; m < 4; ++m) { bf16_t* rowp = O + (size_t)(row0 + ai * HALF + m * 16) * 1792 + col0; float s1 = 0.f, s2 = 0.f;
#pragma unroll
                    for (int bj = 0; bj < 2; ++bj) { f32x4 ga, gb;
#pragma unroll
                        for (int i = 0; i < 4; ++i) { const float x = acc[ai][bj][m][0][i] * s, y = acc[ai][bj][m][1][i] * s;
                            ga[i] = x * __builtin_amdgcn_rcpf(1.f + __expf(-1.5957691216057308f * (x + 0.044715f * x * x * x)));
                            gb[i] = y * __builtin_amdgcn_rcpf(1.f + __expf(-1.5957691216057308f * (y + 0.044715f * y * y * y))); }
                        const u32x4 w = pack8(ga, gb); *(u32x4*)(rowp + bj * HALF) = w;
                        if (stats) { const float r0 = __uint_as_float(w.x << 16), r1 = __uint_as_float(w.x & 0xffff0000u), r2 = __uint_as_float(w.y << 16), r3 = __uint_as_float(w.y & 0xffff0000u),
                                                 r4 = __uint_as_float(w.z << 16), r5 = __uint_as_float(w.z & 0xffff0000u), r6 = __uint_as_float(w.w << 16), r7 = __uint_as_float(w.w & 0xffff0000u);
                            s1 += ((r0 + r1) + (r2 + r3)) + ((r4 + r5) + (r6 + r7)); s2 += ((r0 * r0 + r1 * r1) + (r2 * r2 + r3 * r3)) + ((r4 * r4 + r5 * r5) + (r6 * r6 + r7 * r7)); } }
                    if (stats) { s1 += __shfl_xor(s1, 16); s1 += __shfl_xor(s1, 32); s2 += __shfl_xor(s2, 16); s2 += __shfl_xor(s2, 32);
                        if (fq == 0) { float* pp = part + ((size_t)(row0 + ai * HALF + m * 16) * 8 + (u.pn - 5) * 4 + wc) * 2; pp[0] = s1; pp[1] = s2; } } }
            return;
        }
        const int R0 = u.pm * BM; const bool lat = R0 < 32768;
        const size_t kvbase = lat ? (size_t)(R0 >> 11) * 2304 + 256 + (R0 & 2047) : (size_t)((R0 - 32768) >> 8) * 2304;
#pragma unroll
        for (int ai = 0; ai < 2; ++ai)
#pragma unroll
            for (int m = 0; m < 4; ++m) { const f32x4 a = acc[ai][0][m][0], b = acc[ai][0][m][1];
                float sq = (a[0] * a[0] + a[1] * a[1]) + (a[2] * a[2] + a[3] * a[3]) + (b[0] * b[0] + b[1] * b[1]) + (b[2] * b[2] + b[3] * b[3]);
                sq += __shfl_xor(sq, 16); sq += __shfl_xor(sq, 32);
                if (fq == 0) xch[(ai * HALF + wr * 64 + m * 16 + fr) * 4 + wc] = sq; }
        asm volatile("s_waitcnt lgkmcnt(0)\n\ts_barrier" ::: "memory");
        const int dh = 32 * (wc & 1) + 8 * fq;
        const f32x4 g0 = *(const f32x4*)(kg + dh), g1 = *(const f32x4*)(kg + dh + 4);
        const bool x2 = (fq & 2) != 0;
#pragma unroll
        for (int ai = 0; ai < 2; ++ai)
#pragma unroll
            for (int m = 0; m < 4; ++m) { const int rl = ai * HALF + wr * 64 + m * 16 + fr;
                const float tot = xch[rl * 4 + wc] + xch[rl * 4 + (wc ^ 1)]; const float rs = rsqrtf(tot * (s * s * (1.f / 64.f)) + 1e-6f) * s;
                f32x4 a = acc[ai][0][m][0] * rs * g0, b = acc[ai][0][m][1] * rs * g1;
                f32x4 pa, pb;
#pragma unroll
                for (int i = 0; i < 4; ++i) { pa[i] = __shfl_xor(a[i], 32); pb[i] = __shfl_xor(b[i], 32); }
                if (lat) { const int t = (R0 & 2047) + rl; const int pos = (wc & 1) ? (t & 63) : (t >> 6);
                    const float* rp = rope + ((size_t)pos * 16 + 8 * (fq & 1)) * 2;
                    const f32x4 c0 = *(const f32x4*)(rp), c1 = *(const f32x4*)(rp + 4), c2 = *(const f32x4*)(rp + 8), c3 = *(const f32x4*)(rp + 12);
                    const f32x4 cs = {c0[0], c0[2], c1[0], c1[2]}, sn = {c0[1], c0[3], c1[1], c1[3]}, cs2 = {c2[0], c2[2], c3[0], c3[2]}, sn2 = {c2[1], c2[3], c3[1], c3[3]};
                    a = x2 ? (a * cs + pa * sn) : (a * cs - pa * sn); b = x2 ? (b * cs2 + pb * sn2) : (b * cs2 - pb * sn2); }
                const size_t o = (kvbase + rl) * 128 + 32 * wc + 8 * fq;
                *(u32x4*)(Kb + o) = pack8(a, b); *(u32x4*)(Vb + o) = pack8(acc[ai][1][m][0] * s, acc[ai][1][m][1] * s); }
        asm volatile("s_waitcnt lgkmcnt(0)\n\ts_barrier" ::: "memory");
    }
};
__device__ __forceinline__ f32x4 silu4(const f32x4 v) { f32x4 r;
#pragma unroll
    for (int i = 0; i < 4; ++i) r[i] = v[i] * __builtin_amdgcn_rcpf(1.f + __expf(-v[i])); return r; }
__device__ __forceinline__ f32x4 sigm4(const f32x4 v) { f32x4 r;
#pragma unroll
    for (int i = 0; i < 4; ++i) r[i] = __builtin_amdgcn_rcpf(1.f + __expf(-v[i])); return r; }
__device__ __forceinline__ u32x2 pack8_fp8(const f32x4 a, const f32x4 b) { int w0 = 0, w1 = 0;
    w0 = __builtin_amdgcn_cvt_pk_fp8_f32(a[0], a[1], w0, false); w0 = __builtin_amdgcn_cvt_pk_fp8_f32(a[2], a[3], w0, true);
    w1 = __builtin_amdgcn_cvt_pk_fp8_f32(b[0], b[1], w1, false); w1 = __builtin_amdgcn_cvt_pk_fp8_f32(b[2], b[3], w1, true); u32x2 r; r.x = (unsigned)w0; r.y = (unsigned)w1; return r; }
__device__ __forceinline__ f32x4 clamp8(const f32x4 v) { f32x4 r;
#pragma unroll
    for (int i = 0; i < 4; ++i) r[i] = __builtin_amdgcn_fmed3f(v[i], -448.f, 448.f); return r; }
struct EpiSwiglu {
    static constexpr bool PERM = true, AFTER_DRAIN = false; unsigned char* G; float s, so;
    __device__ __forceinline__ void operator()(const f32x4 (&acc)[2][2][4][2], const Unit& u, int wr, int wc, int, int) const {
        const int ln = lane_id_now(), fr = ln & 15, fq = ln >> 4;
        const int row0 = u.pm * BM + wr * 64 + fr, col0 = u.pn * HALF + wc * 32 + 8 * fq;
#pragma unroll
        for (int ai = 0; ai < 2; ++ai) { if (u.half != 0 && ai != u.half - 1) continue;
#pragma unroll
            for (int m = 0; m < 4; ++m) *(u32x2*)(G + (size_t)(row0 + ai * HALF + m * 16) * 512 + col0) = pack8_fp8(clamp8(silu4(acc[ai][0][m][0] * s) * (acc[ai][1][m][0] * (s * so))), clamp8(silu4(acc[ai][0][m][1] * s) * (acc[ai][1][m][1] * (s * so)))); }
    }
};
__device__ __forceinline__ void unpack8f(const u32x4 w, f32x4& a, f32x4& b) {
    a[0] = __uint_as_float(w.x << 16); a[1] = __uint_as_float(w.x & 0xffff0000u); a[2] = __uint_as_float(w.y << 16); a[3] = __uint_as_float(w.y & 0xffff0000u);
    b[0] = __uint_as_float(w.z << 16); b[1] = __uint_as_float(w.z & 0xffff0000u); b[2] = __uint_as_float(w.w << 16); b[3] = __uint_as_float(w.w & 0xffff0000u); }
struct EpiGlu {
    static constexpr bool PERM = true, AFTER_DRAIN = false; const bf16_t* GS; const float* b; bf16_t* GG;
    __device__ __forceinline__ void operator()(const f32x4 (&acc)[2][2][4][2], const Unit& u, int wr, int wc, int fr, int fq) const {
        const int row0 = u.pm * BM + wr * 64 + fr, col0 = u.pn * BM + wc * 32 + 8 * fq;
#pragma unroll
        for (int bj = 0; bj < 2; ++bj) { const int c = col0 + bj * HALF; const f32x4 b0 = *(const f32x4*)(b + c), b1 = *(const f32x4*)(b + c + 4);
#pragma unroll
            for (int ai = 0; ai < 2; ++ai) { if (u.half != 0 && ai != u.half - 1) continue;
#pragma unroll
                for (int m = 0; m < 4; ++m) { const size_t o = (size_t)(row0 + ai * HALF + m * 16) * 512 + c; f32x4 g0, g1; unpack8f(*(const u32x4*)(GS + o), g0, g1);
                    *(u32x4*)(GG + o) = pack8(g0 * sigm4(acc[ai][bj][m][0] + b0), g1 * sigm4(acc[ai][bj][m][1] + b1)); } } }
    }
};
struct EpiResid {
    static constexpr bool PERM = true, AFTER_DRAIN = false;
    const float* x; const float* ctx; const float* mod; bf16_t* XC; int inplace;
    __device__ __forceinline__ void operator()(const f32x4 (&acc)[2][2][4][2], const Unit& u, int wr, int wc, int fr, int fq) const {
        const int R0 = u.pm * BM; const int ci = R0 < 32768 ? (R0 >> 11) : 16;
        const float* base = R0 < 32768 ? x + (size_t)R0 * 1024 : ctx + (size_t)(R0 - 32768) * 1024;
        bf16_t* out = XC + (size_t)R0 * 1024; const float* gate = mod + ((size_t)ci * 6 + 2) * 1024;
        const int rl0 = wr * 64 + fr, col0 = u.pn * BM + wc * 32 + 8 * fq;
#pragma unroll
        for (int bj = 0; bj < 2; ++bj) { const int c = col0 + bj * HALF; const f32x4 g0 = *(const f32x4*)(gate + c), g1 = *(const f32x4*)(gate + c + 4);
#pragma unroll
            for (int ai = 0; ai < 2; ++ai) { if (u.half != 0 && ai != u.half - 1) continue;
#pragma unroll
                for (int m = 0; m < 4; ++m) { const size_t o = (size_t)(rl0 + ai * HALF + m * 16) * 1024 + c; f32x4 b0, b1;
                    if (inplace) unpack8f(*(const u32x4*)(out + o), b0, b1); else { b0 = *(const f32x4*)(base + o); b1 = *(const f32x4*)(base + o + 4); }
                    *(u32x4*)(out + o) = pack8(b0 + g0 * acc[ai][bj][m][0], b1 + g1 * acc[ai][bj][m][1]); } } }
    }
};
}

#include <hip/hip_bf16.h>
#include <cmath>
namespace attn_body {
using bf16=__hip_bfloat16;
using bf16x8=__attribute__((ext_vector_type(8)))short;
using s16x4=__attribute__((ext_vector_type(4)))short;
using f32x16=__attribute__((ext_vector_type(16)))float;
using u32x4=__attribute__((ext_vector_type(4)))unsigned;
constexpr int D=64,QP=1792,KP=128,OP=1024;
constexpr int NW=8,QBLK=32,QB=QBLK*NW,KVBLK=64;
constexpr int ATTN_UNIT_ROWS=QB;
__device__ __forceinline__ int crow(int r,int hi){return (r&3)+8*(r>>2)+4*hi;}
#define SBAR() __builtin_amdgcn_sched_barrier(0)
__device__ __forceinline__ void cmask(f32x16&p0,f32x16&p1,int jb,int qrel,int hi){
  const float NEG=-INFINITY; int kb=64*jb+4*hi;
  #pragma unroll
  for(int r=0;r<16;++r){int kv=kb+(r&3)+8*(r>>2); if(kv>qrel)p0[r]=NEG; if(kv+32>qrel)p1[r]=NEG;}
}

constexpr int NSLOT=3, SLOTB=8192;
constexpr int LDS_K=0, LDS_V=NSLOT*SLOTB, LDS_WS=2*NSLOT*SLOTB, LDS_OST=LDS_WS+NW*64*4, LDS_BYTES=LDS_OST+NW*4096;
constexpr float C2=0.125f*1.4426950408889634f;
__device__ __forceinline__ void glds16(const void*gsrc,unsigned lds_dst){unsigned keep;
  asm volatile("s_mov_b32 %0, m0\n\ts_mov_b32 m0, %2\n\ts_nop 0\n\tglobal_load_lds_dwordx4 %1, off\n\ts_mov_b32 m0, %0":"=&s"(keep):"v"(gsrc),"s"(lds_dst):"memory");}
__device__ __forceinline__ float max3f(float a,float b,float c){float r;asm("v_max3_f32 %0, %1, %2, %3":"=v"(r):"v"(a),"v"(b),"v"(c));return r;}
__device__ __forceinline__ float max2f(float a,float b){float r;asm("v_max_f32_e32 %0, %1, %2":"=v"(r):"v"(a),"v"(b));return r;}
__device__ __forceinline__ float fadd_s(float a,float b){float r;asm("v_add_f32_e32 %0, %1, %2":"=v"(r):"v"(a),"v"(b));return r;}
__device__ __forceinline__ float fsub_s(float a,float b){float r;asm("v_sub_f32_e32 %0, %1, %2":"=v"(r):"v"(a),"v"(b));return r;}
typedef float f32x2_t __attribute__((ext_vector_type(2))); typedef __bf16 bf16x2_t __attribute__((ext_vector_type(2)));
__device__ __forceinline__ unsigned cvtpk_s(float lo,float hi){f32x2_t v={lo,hi};bf16x2_t b=__builtin_convertvector(v,bf16x2_t);return __builtin_bit_cast(unsigned,b);}
#define WAIT_BAR(N) asm volatile("s_waitcnt vmcnt(" #N ") lgkmcnt(0)\n\ts_barrier":::"memory")

__device__ __forceinline__ void qkt(f32x16&p0,f32x16&p1,const char*Kslot,const bf16x8*qr,const f32x16&negm,int r32,int hi){
  const char*kb=Kslot+hi*1024+r32*16;
  #pragma unroll
  for(int d0=0;d0<4;++d0){
    const bf16x8 b0=*reinterpret_cast<const bf16x8*>(kb+d0*2048);
    const bf16x8 b1=*reinterpret_cast<const bf16x8*>(kb+d0*2048+512);
    if(d0==0){p0=__builtin_amdgcn_mfma_f32_32x32x16_bf16(b0,qr[0],negm,0,0,0);p1=__builtin_amdgcn_mfma_f32_32x32x16_bf16(b1,qr[0],negm,0,0,0);}
    else{p0=__builtin_amdgcn_mfma_f32_32x32x16_bf16(b0,qr[d0],p0,0,0,0);p1=__builtin_amdgcn_mfma_f32_32x32x16_bf16(b1,qr[d0],p1,0,0,0);}}
}
typedef __attribute__((address_space(3))) const char* lds_cptr;
typedef short v4i16_t __attribute__((ext_vector_type(4)));
__device__ __forceinline__ void kload8(bf16x8*kf,lds_cptr kp){
  kf[0]=*(const __attribute__((address_space(3))) bf16x8*)(kp);      kf[1]=*(const __attribute__((address_space(3))) bf16x8*)(kp+512);
  kf[2]=*(const __attribute__((address_space(3))) bf16x8*)(kp+2048); kf[3]=*(const __attribute__((address_space(3))) bf16x8*)(kp+2560);
  kf[4]=*(const __attribute__((address_space(3))) bf16x8*)(kp+4096); kf[5]=*(const __attribute__((address_space(3))) bf16x8*)(kp+4608);
  kf[6]=*(const __attribute__((address_space(3))) bf16x8*)(kp+6144); kf[7]=*(const __attribute__((address_space(3))) bf16x8*)(kp+6656);
}
__device__ __forceinline__ void kload2(bf16x8*kf,lds_cptr kp,int j){ kf[2*j]=*(const __attribute__((address_space(3))) bf16x8*)(kp+j*2048); kf[2*j+1]=*(const __attribute__((address_space(3))) bf16x8*)(kp+j*2048+512); }
__device__ __forceinline__ s16x4 vtr(lds_cptr p){ return __builtin_bit_cast(s16x4,__builtin_amdgcn_ds_read_tr16_b64_v4i16((__attribute__((address_space(3))) v4i16_t*)p)); }
__device__ __forceinline__ float rowmax(const f32x16&p0,const f32x16&p1){
  float a=max3f(p0[0],p0[1],p1[0]),b=max3f(p0[2],p0[3],p1[1]);a=max3f(a,p1[2],p1[3]);
  #pragma unroll
  for(int r=4;r<16;r+=4){a=max3f(a,p0[r],p0[r+1]);b=max3f(b,p0[r+2],p0[r+3]);a=max3f(a,p1[r],p1[r+1]);b=max3f(b,p1[r+2],p1[r+3]);}
  const float m=max2f(a,b);
  auto rr=__builtin_amdgcn_permlane32_swap(__float_as_uint(m),__float_as_uint(m),false,false);
  return max2f(__uint_as_float(rr[0]),__uint_as_float(rr[1]));
}
__device__ __forceinline__ void pv(f32x16*o,int vb,bf16x8 pa0,bf16x8 pa1,bf16x8 pa2,bf16x8 pa3){
  #pragma unroll
  for(int d0=0;d0<2;++d0){s16x4 lo[4],hi[4];
    #pragma unroll
    for(int ks=0;ks<4;++ks){
      asm volatile("ds_read_b64_tr_b16 %0,%1 offset:%c2":"=&v"(lo[ks]):"v"(vb),"i"(d0*4096+ks*1024):"memory");
      asm volatile("ds_read_b64_tr_b16 %0,%1 offset:%c2":"=&v"(hi[ks]):"v"(vb),"i"(d0*4096+ks*1024+512):"memory");}
    asm volatile("s_waitcnt lgkmcnt(0)":::"memory");SBAR();
    #define PK(k) (bf16x8){lo[k][0],lo[k][1],lo[k][2],lo[k][3],hi[k][0],hi[k][1],hi[k][2],hi[k][3]}
    o[d0]=__builtin_amdgcn_mfma_f32_32x32x16_bf16(pa0,PK(0),o[d0],0,0,0);
    o[d0]=__builtin_amdgcn_mfma_f32_32x32x16_bf16(pa1,PK(1),o[d0],0,0,0);
    o[d0]=__builtin_amdgcn_mfma_f32_32x32x16_bf16(pa2,PK(2),o[d0],0,0,0);
    o[d0]=__builtin_amdgcn_mfma_f32_32x32x16_bf16(pa3,PK(3),o[d0],0,0,0);
    #undef PK
  }
}

#ifndef ATTN_STORE16
#define ATTN_STORE16(p,v) (*(u32x4*)(p)=(v))
#endif
template<int THRL> __device__ __forceinline__ void attn_unit(const bf16*Q0,const bf16*__restrict__ Kh,const bf16*__restrict__ Vh,bf16*O0,const int NT,char*shm,const float*qg,const float2*rope,const int tq0){
  const int tid=threadIdx.x,lane=tid&63,r32=lane&31,hi=lane>>5; const int wid=__builtin_amdgcn_readfirstlane(tid>>6);
  const bf16*Qw=Q0+(long)(wid*QBLK)*QP;
  const unsigned lds0=(unsigned)(uintptr_t)shm;
  float*wsf=(float*)(shm+LDS_WS)+wid*64;
  const bf16*ksrc=Kh+(long)lane*KP+wid*8;
  const bf16*vsrc=Vh+(long)(16*(wid&3)+(lane>>2))*KP+(wid>>2)*32+(lane&3)*8;
  const unsigned kdst=lds0+LDS_K+wid*1024, vdst=lds0+LDS_V+wid*1024;
  #define DMA_K(t,slot) glds16(ksrc+(long)(t)*KVBLK*KP,(unsigned)__builtin_amdgcn_readfirstlane(kdst+(slot)))
  #define DMA_V(t,slot) glds16(vsrc+(long)(t)*KVBLK*KP,(unsigned)__builtin_amdgcn_readfirstlane(vdst+(slot)))
  const int vb0=(int)(lds0+LDS_V)+((lane>>4)&1)*32+(lane&3)*8+(4*hi+((lane&15)>>2))*64;
  const char*Kbase=shm+LDS_K; bf16x8 kf[8];
  const lds_cptr shm3=(lds_cptr)shm; const lds_cptr kp0=shm3+LDS_K+hi*1024+r32*16; const lds_cptr vp0=shm3+LDS_V+((lane>>4)&1)*32+(lane&3)*8+(4*hi+((lane&15)>>2))*64;
  DMA_K(0,0);DMA_V(0,0);DMA_K(1,SLOTB);
  bf16x8 qr[4];
  #pragma unroll
  for(int d0=0;d0<4;++d0)qr[d0]=*reinterpret_cast<const bf16x8*>(&Qw[(long)r32*QP+d0*16+hi*8]);
  { float qf[4][8]; float ss=0.f;
    #pragma unroll
    for(int d0=0;d0<4;++d0){
      #pragma unroll
      for(int j=0;j<8;++j){ const float v=__uint_as_float(((unsigned)(unsigned short)qr[d0][j])<<16); qf[d0][j]=v; ss+=v*v; } }
    ss+=__shfl_xor(ss,32);
    const float rs=rsqrtf(ss*(1.f/64.f)+1e-6f);
    #pragma unroll
    for(int d0=0;d0<4;++d0){
      #pragma unroll
      for(int j=0;j<8;++j) qf[d0][j]*=rs*qg[16*d0+8*hi+j]; }
    if(tq0>=0){ const int t=tq0+wid*QBLK+r32; const float2*rr=rope+(t>>6)*16+8*hi; const float2*rc=rope+(t&63)*16+8*hi;
      #pragma unroll
      for(int j=0;j<8;++j){ const float2 a=rr[j],c=rc[j];
        const float x1=qf[0][j],x2=qf[1][j]; qf[0][j]=x1*a.x-x2*a.y; qf[1][j]=x2*a.x+x1*a.y;
        const float y1=qf[2][j],y2=qf[3][j]; qf[2][j]=y1*c.x-y2*c.y; qf[3][j]=y2*c.x+y1*c.y; } }
    #pragma unroll
    for(int d0=0;d0<4;++d0){ u32x4 w; w.x=cvtpk_s(qf[d0][0]*C2,qf[d0][1]*C2); w.y=cvtpk_s(qf[d0][2]*C2,qf[d0][3]*C2); w.z=cvtpk_s(qf[d0][4]*C2,qf[d0][5]*C2); w.w=cvtpk_s(qf[d0][6]*C2,qf[d0][7]*C2); qr[d0]=__builtin_bit_cast(bf16x8,w); } }
  float mhat=0.f,l_reg=0.f;f32x16 o[2];o[0]=f32x16{};o[1]=f32x16{};f32x16 negm=f32x16{};asm volatile("":"+v"(negm));
  #define CMASK(P0,P1,t) do{}while(0)
  bool resc=false;
  #define START(P0,P1) do{ const float rm=rowmax(P0,P1); resc=false; \
    { const float dl=rm; mhat=fadd_s(mhat,dl); \
      _Pragma("unroll") for(int r=0;r<16;++r){P0[r]=fsub_s(P0[r],dl);P1[r]=fsub_s(P1[r],dl);} \
      _Pragma("unroll") for(int r=0;r<16;++r)negm[r]=-mhat; asm volatile("":"+v"(negm)); } \
    _Pragma("unroll") for(int r=0;r<16;++r)P0[r]=__builtin_amdgcn_exp2f(P0[r]); }while(0)
  #define RESC() do{ if(resc){ asm volatile("s_waitcnt lgkmcnt(0)":::"memory"); \
      _Pragma("unroll") for(int d_=0;d_<2;++d_) _Pragma("unroll") for(int r=0;r<16;++r)o[d_][r]*=wsf[crow(r,hi)]; } }while(0)
  f32x16 pA0,pA1,pB0,pB1;
  int sl_prev=0,sl_cur=0,sl_next=SLOTB;
  #define ROT() do{sl_prev=sl_cur;sl_cur=sl_next;sl_next=(sl_next==(NSLOT-1)*SLOTB)?0:sl_next+SLOTB;}while(0)
  DMA_K(2,2*SLOTB);
  WAIT_BAR(3);
  qkt(pA0,pA1,Kbase,qr,negm,r32,hi);asm volatile("s_nop 15\n\ts_nop 7":"+v"(pA0),"+v"(pA1));CMASK(pA0,pA1,0);
  START(pA0,pA1);
  _Pragma("unroll") for(int r=0;r<16;++r)pA1[r]=__builtin_amdgcn_exp2f(pA1[r]);
  WAIT_BAR(0);
  DMA_K(3,0);DMA_V(1,SLOTB);
  ROT();
  kload8(kf,kp0+sl_cur);
  WAIT_BAR(2);
  s16x4 vlo[8],vhi[8]; u32x4 pw0,pw1,pw2,pw3;
  #define PKW(P,B) cvtpk_s(P[B],P[B+1])
  #define PAF(k) __builtin_bit_cast(bf16x8,pw##k)
  #define VFR(i) (bf16x8){vlo[i][0],vlo[i][1],vlo[i][2],vlo[i][3],vhi[i][0],vhi[i][1],vhi[i][2],vhi[i][3]}
  #define PIN(x) asm volatile("":"+v"(x))
  #define MX3(a,b,c) __builtin_fmaxf(__builtin_fmaxf((a),(b)),(c))
  #define GAPA(MF,A0,A1,A2,A3,W0,W1,PW) do{ MF; sacc+=A0; sacc+=A1; sacc+=A2; sacc+=A3; PIN(sacc); W0; W1; PIN(PW); SBAR(); }while(0)
  #define EX(v) __builtin_amdgcn_exp2f(v)
  #define GAPB(MF,X,B) do{ MF; X[B]=EX(X[B]); X[B+1]=EX(X[B+1]); X[B+2]=EX(X[B+2]); X[B+3]=EX(X[B+3]); PIN(X); SBAR(); }while(0)
  #define VRD(i) do{ vlo[i]=vtr(vp_+(((i)>>2)*4096+((i)&3)*1024)); vhi[i]=vtr(vp_+(((i)>>2)*4096+((i)&3)*1024+512)); }while(0)
  #define KRD(G,j) do{ if(G){ kload2(kf,kp0+sl_next,j); SBAR(); } }while(0)
  #define STEP(C0,C1,P0,P1,t,GK,GV,GL) do{ SBAR(); \
    const lds_cptr vp_=vp0+sl_prev; \
    VRD(0); SBAR(); float sacc=(P0[0]+P0[1]); \
    GAPA(C0=__builtin_amdgcn_mfma_f32_32x32x16_bf16(kf[0],qr[0],negm,0,0,0), P0[2],P0[3],P0[4],P0[5],     pw0[0]=PKW(P0,0), pw0[1]=PKW(P0,2), pw0); \
    VRD(4); SBAR(); GAPA(C1=__builtin_amdgcn_mfma_f32_32x32x16_bf16(kf[1],qr[0],negm,0,0,0), P0[6],P0[7],P0[8],P0[9],     pw0[2]=PKW(P0,4), pw0[3]=PKW(P0,6), pw0); \
    VRD(1); SBAR(); GAPA(C0=__builtin_amdgcn_mfma_f32_32x32x16_bf16(kf[2],qr[1],C0,0,0,0),   P0[10],P0[11],P0[12],P0[13], pw1[0]=PKW(P0,8), pw1[1]=PKW(P0,10), pw1); \
    VRD(5); SBAR(); GAPA(C1=__builtin_amdgcn_mfma_f32_32x32x16_bf16(kf[3],qr[1],C1,0,0,0),   P0[14],P0[15],P1[0],P1[1],   pw1[2]=PKW(P0,12),pw1[3]=PKW(P0,14), pw1); \
    VRD(2); SBAR(); GAPA(C0=__builtin_amdgcn_mfma_f32_32x32x16_bf16(kf[4],qr[2],C0,0,0,0),   P1[2],P1[3],P1[4],P1[5],     pw2[0]=PKW(P1,0), pw2[1]=PKW(P1,2), pw2); \
    VRD(6); SBAR(); GAPA(C1=__builtin_amdgcn_mfma_f32_32x32x16_bf16(kf[5],qr[2],C1,0,0,0),   P1[6],P1[7],P1[8],P1[9],     pw2[2]=PKW(P1,4), pw2[3]=PKW(P1,6), pw2); \
    VRD(3); SBAR(); GAPA(C0=__builtin_amdgcn_mfma_f32_32x32x16_bf16(kf[6],qr[3],C0,0,0,0),   P1[10],P1[11],P1[12],P1[13], pw3[0]=PKW(P1,8), pw3[1]=PKW(P1,10), pw3); \
    VRD(7); SBAR(); GAPA(C1=__builtin_amdgcn_mfma_f32_32x32x16_bf16(kf[7],qr[3],C1,0,0,0),   P1[14],P1[15],0.f,0.f,       pw3[2]=PKW(P1,12),pw3[3]=PKW(P1,14), pw3); \
    l_reg+=sacc; \
    if(GK){DMA_K((t)+3,sl_cur);} if(GV){DMA_V((t)+1,sl_next);} \
    CMASK(C0,C1,t); \
    { float a=MX3(C0[0],C0[1],C1[0]),b=MX3(C0[2],C0[3],C1[1]); a=MX3(a,C1[2],C1[3]); \
      _Pragma("unroll") for(int r=4;r<16;r+=4){a=MX3(a,C0[r],C0[r+1]);b=MX3(b,C0[r+2],C0[r+3]);a=MX3(a,C1[r],C1[r+1]);b=MX3(b,C1[r+2],C1[r+3]);} \
      float rm=__builtin_fmaxf(a,b); { auto rr=__builtin_amdgcn_permlane32_swap(__float_as_uint(rm),__float_as_uint(rm),false,false); rm=__builtin_fmaxf(__uint_as_float(rr[0]),__uint_as_float(rr[1])); } \
      resc=false; \
      if(__builtin_expect(__any(rm>(float)THRL),0)){ const float dl=__builtin_fmaxf(rm,0.f); mhat+=dl; \
        _Pragma("unroll") for(int r=0;r<16;++r){C0[r]-=dl;C1[r]-=dl;} \
        _Pragma("unroll") for(int r=0;r<16;++r)negm[r]=-mhat; asm volatile("":"+v"(negm)); \
        const float f=__builtin_amdgcn_exp2f(-dl); l_reg*=f; if(hi==0)wsf[r32]=f; resc=true; } } \
    SBAR(); \
    GAPB(o[0]=__builtin_amdgcn_mfma_f32_32x32x16_bf16(PAF(0),VFR(0),o[0],0,0,0), C0,0); \
    GAPB(o[1]=__builtin_amdgcn_mfma_f32_32x32x16_bf16(PAF(0),VFR(4),o[1],0,0,0), C0,4); \
    KRD(GL,0); GAPB(o[0]=__builtin_amdgcn_mfma_f32_32x32x16_bf16(PAF(1),VFR(1),o[0],0,0,0), C0,8); \
    KRD(GL,1); GAPB(o[1]=__builtin_amdgcn_mfma_f32_32x32x16_bf16(PAF(1),VFR(5),o[1],0,0,0), C0,12); \
    KRD(GL,2); GAPB(o[0]=__builtin_amdgcn_mfma_f32_32x32x16_bf16(PAF(2),VFR(2),o[0],0,0,0), C1,0); \
    KRD(GL,3); GAPB(o[1]=__builtin_amdgcn_mfma_f32_32x32x16_bf16(PAF(2),VFR(6),o[1],0,0,0), C1,4); \
    GAPB(o[0]=__builtin_amdgcn_mfma_f32_32x32x16_bf16(PAF(3),VFR(3),o[0],0,0,0), C1,8); \
    GAPB(o[1]=__builtin_amdgcn_mfma_f32_32x32x16_bf16(PAF(3),VFR(7),o[1],0,0,0), C1,12); \
    }while(0)
  int t=1;
  #undef CMASK
  #define CMASK(P0,P1,t) do{}while(0)
  for(;t+5<NT;t+=2){
    STEP(pB0,pB1,pA0,pA1,t,true,true,true);     WAIT_BAR(2); RESC(); ROT();
    STEP(pA0,pA1,pB0,pB1,t+1,true,true,true);   WAIT_BAR(2); RESC(); ROT();
  }
  #undef CMASK
  #define CMASK(P0,P1,t) do{}while(0)
  #define ENDW(tt) do{ if((tt)+3<NT){WAIT_BAR(2);} else if((tt)+2<NT){WAIT_BAR(1);} else {WAIT_BAR(0);} }while(0)
  for(;t+1<NT;t+=2){
    STEP(pB0,pB1,pA0,pA1,t,(t+3<NT),(t+1<NT),(t+1<NT));       ENDW(t);   RESC(); ROT();
    STEP(pA0,pA1,pB0,pB1,t+1,(t+4<NT),(t+2<NT),(t+2<NT));     ENDW(t+1); RESC(); ROT();
  }
  STEP(pB0,pB1,pA0,pA1,NT-1,false,false,false); RESC();
  { float sacc=pB0[0]+pB0[1]; _Pragma("unroll") for(int r=2;r<16;++r)sacc+=pB0[r]; _Pragma("unroll") for(int r=0;r<16;++r)sacc+=pB1[r]; l_reg+=sacc;
    pw0=(u32x4){PKW(pB0,0),PKW(pB0,2),PKW(pB0,4),PKW(pB0,6)};pw1=(u32x4){PKW(pB0,8),PKW(pB0,10),PKW(pB0,12),PKW(pB0,14)};pw2=(u32x4){PKW(pB1,0),PKW(pB1,2),PKW(pB1,4),PKW(pB1,6)};pw3=(u32x4){PKW(pB1,8),PKW(pB1,10),PKW(pB1,12),PKW(pB1,14)};
    SBAR(); pv(o,vb0+sl_cur,PAF(0),PAF(1),PAF(2),PAF(3)); }
  #undef PKW
  #undef PAF
  #undef VFR
  #undef PIN
  #undef MX3
  #undef GAPA
  #undef GAPB
  #undef EX
  #undef VRD
  #undef KRD
  #undef STEP
  #undef ENDW
  {auto rr=__builtin_amdgcn_permlane32_swap(__float_as_uint(l_reg),__float_as_uint(l_reg),false,false);l_reg=__uint_as_float(rr[0])+__uint_as_float(rr[1]);}
  if(hi==0)wsf[32+r32]=l_reg;asm volatile("s_waitcnt lgkmcnt(0)":::"memory");
  float rli[16];
  #pragma unroll
  for(int r=0;r<16;++r)rli[r]=__builtin_amdgcn_rcpf(wsf[32+crow(r,hi)]);
  bf16*Ow=O0+(long)(wid*QBLK)*OP;
  { bf16*stg=(bf16*)(shm+LDS_OST)+wid*2048;
    #pragma unroll
    for(int r=0;r<16;++r){const int orow=crow(r,hi);
      #pragma unroll
      for(int d0=0;d0<2;++d0)stg[orow*64+d0*32+r32]=__float2bfloat16(o[d0][r]*rli[r]);}
    asm volatile("s_waitcnt lgkmcnt(0)":::"memory");
    #pragma unroll
    for(int i=0;i<4;++i){const int row=i*8+(lane>>3),ch=lane&7; const u32x4 v=*(const u32x4*)(stg+row*64+ch*8); ATTN_STORE16(Ow+(long)row*OP+ch*8,v);} }
  asm volatile("s_waitcnt lgkmcnt(0)\n\ts_barrier":::"memory");
  #undef DMA_K
  #undef DMA_V
  #undef CMASK
  #undef START
  #undef RESC
  #undef ROT
}
constexpr int ATTN_LDS_BYTES=LDS_BYTES;
#undef SBAR
#undef WAIT_BAR
}

struct Params {
    const float* in[35];
    float* out;
    unsigned char* ws;
    int ph_lo, ph_hi;
};
enum { I_X = 0, I_C, I_CTX, I_CCTX, I_WMOD, I_BMOD, I_GMIX, I_GFFN, I_MIXWIN, I_MIXWOUT, I_QG, I_KG, I_LNG, I_WSP, I_BSP,
       I_S5WIN, I_ARE, I_AIM, I_LOGDT, I_BRE, I_BIM, I_CRE, I_CIM, I_S5D, I_WGLU, I_BGLU, I_S5WOUT,
       I_WGRP, I_BGRP, I_WRT, I_BRT, I_W1, I_W3, I_W2, I_FING };

struct Ctx {
    const Params* p;
    unsigned char* ws;
    LAS unsigned char* lds;
    int tid, lane, wave, gw, ngw;
};
__device__ __forceinline__ const float* xin_row(const Params& P, int r) { return r < TL ? P.in[I_X] + (size_t)r * D : P.in[I_CTX] + (size_t)(r - TL) * D; }
__device__ __forceinline__ int cond_of(int r) { return r < TL ? (r >> 11) : 16; }
__device__ __forceinline__ const float* mod_vec(const Ctx& C, int layer, int ci, int k) { return (const float*)(C.ws + WS_MOD) + ((size_t)(layer * 17 + ci) * 6 + k) * D; }

__device__ __forceinline__ void dsincos(double a, double& s, double& c) {
    const double TWO_PI_HI = 6.283185307179586, TWO_PI_LO = 2.4492935982947064e-16;
    const double k = rint(a * 0.15915494309189535);
    double r = fma(-k, TWO_PI_HI, a); r = fma(-k, TWO_PI_LO, r);
    const double r2 = r * r; double ct = 1.0, st = r, cs = 1.0, ss = r;
#pragma unroll 1
    for (int i = 1; i <= 15; ++i) { ct *= -r2 / (double)((2 * i - 1) * (2 * i)); cs += ct; st *= -r2 / (double)((2 * i) * (2 * i + 1)); ss += st; }
    s = ss; c = cs;
}

struct TItem { const float* src; int N, k0, n0; bf16* dst; int dp; float f8s; };
__device__ __forceinline__ void t_load(const TItem& t, int lane, float (&r)[32]) {
#pragma unroll
    for (int i = 0; i < 32; ++i) r[i] = __builtin_nontemporal_load(t.src + (size_t)(t.k0 + 2 * i + (lane >> 5)) * t.N + t.n0 + (lane & 31));
}
__device__ __forceinline__ void t_store(const TItem& t, int lane, const float (&r)[32], LAS float* scr) {
#pragma unroll
    for (int i = 0; i < 32; ++i) scr[(2 * i + (lane >> 5)) * 33 + (lane & 31)] = r[i];
    asm volatile("s_waitcnt lgkmcnt(0)" ::: "memory");
    const int c = lane & 7;
    if (t.f8s != 0.f) {
#pragma unroll
        for (int j = 0; j < 4; ++j) { const int n = (lane >> 3) + 8 * j; const LAS float* s = scr + (8 * c) * 33 + n; const float q = t.f8s;
            *(pg8::u32x2*)((unsigned char*)t.dst + (size_t)n * t.dp + 8 * c) = pg8::pack8_fp8((f32x4){s[0 * 33] * q, s[1 * 33] * q, s[2 * 33] * q, s[3 * 33] * q}, (f32x4){s[4 * 33] * q, s[5 * 33] * q, s[6 * 33] * q, s[7 * 33] * q}); }
    } else {
#pragma unroll
        for (int j = 0; j < 4; ++j) { const int n = (lane >> 3) + 8 * j; const LAS float* s = scr + (8 * c) * 33 + n;
            v4u o; o.x = pk2(s[0 * 33], s[1 * 33]); o.y = pk2(s[2 * 33], s[3 * 33]); o.z = pk2(s[4 * 33], s[5 * 33]); o.w = pk2(s[6 * 33], s[7 * 33]);
            *(v4u*)(t.dst + (size_t)n * t.dp + 8 * c) = o; }
    }
    asm volatile("s_waitcnt lgkmcnt(0)" ::: "memory");
}
__device__ __forceinline__ TItem mat_item(const float* W, int K, int N, bf16* WT, int it) {
    const int nblk = N / 32, kb = it / nblk, nb = it % nblk;
    return TItem{W, N, kb * 64, nb * 32, WT + (size_t)(nb * 32) * K + kb * 64, K, 0.f};
}
__device__ __forceinline__ TItem mat_item_f8(const float* W, int K, int N, unsigned char* WT, int it, float f8s) {
    const int nblk = N / 32, kb = it / nblk, nb = it % nblk;
    return TItem{W, N, kb * 64, nb * 32, (bf16*)(WT + (size_t)(nb * 32) * K + kb * 64), K, f8s};
}
constexpr int MOE_ITEMS = NEXP * 768;
__device__ __forceinline__ TItem moe_item(const Ctx& C, int layer, int it) {
    const Params& P = *C.p;
    const int e = it / 768, r = it % 768, kind = r / 256, j = r % 256;
    if (kind < 2) {
        const float* src = (kind == 0 ? P.in[I_W1] : P.in[I_W3]) + ((size_t)layer * NEXP + e) * D * EH;
        const int kb = j / 16, nb = j % 16, k0 = kb * 64, n0 = nb * 32;
        const int drow = (n0 / 128) * 256 + (n0 % 128) + (kind == 1 ? 128 : 0);
        return TItem{src, EH, k0, n0, (bf16*)((unsigned char*)(C.ws + (layer ? WS_W13B : WS_W13)) + (size_t)e * 1024 * 1024 + (size_t)drow * 1024 + k0), 1024, W13_SCALE};
    }
    const float* src = P.in[I_W2] + ((size_t)layer * NEXP + e) * EH * D;
    const int kb = j / 32, nb = j % 32, k0 = kb * 64, n0 = nb * 32;
    return TItem{src, D, k0, n0, (bf16*)((unsigned char*)(C.ws + (layer ? WS_W2B : WS_W2)) + (size_t)e * 1024 * 512 + (size_t)n0 * 512 + k0), 512, W13_SCALE};
}
constexpr int TI0 = 16 * 56, TI1 = 16 * 32, TI2 = 16 * 16, TI3 = 8 * 16, TI4 = 8 * 32, NSMALL = TI0 + TI1 + TI2 + TI3 + TI4;
__device__ __forceinline__ TItem conv_item(const Ctx& C, int layer, int nsmall, int it) {
    const Params& P = *C.p; int r = it;
    if (r < nsmall) {
        if (r < TI0) return mat_item_f8(P.in[I_MIXWIN], D, MIXW, (unsigned char*)(C.ws + WS_WIN0), r, W13_SCALE); r -= TI0;
        if (r < TI1) return mat_item(P.in[I_MIXWOUT], D, D, (bf16*)(C.ws + WS_WOUT0), r); r -= TI1;
        if (r < TI2) return mat_item(P.in[I_S5WIN], D, 512, (bf16*)(C.ws + WS_WS5IN), r); r -= TI2;
        if (r < TI3) return mat_item(P.in[I_WGLU], 512, 512, (bf16*)(C.ws + WS_WGLU), r); r -= TI3;
        return mat_item(P.in[I_S5WOUT], 512, D, (bf16*)(C.ws + WS_WS5OUT), r);
    }
    return moe_item(C, layer, r - nsmall);
}
__device__ __forceinline__ void convert_items(const Ctx& C, int layer, int nsmall) {
    LAS float* scr = (LAS float*)(C.lds + C.wave * 16384);
    const int total = nsmall + (gridDim.x == 256 ? L0_A : MOE_ITEMS), n = C.ngw;
    for (int it = C.gw; it < total; it += 2 * n) {
        const bool two = it + n < total;
        const TItem ta = conv_item(C, layer, nsmall, it), tb = conv_item(C, layer, nsmall, two ? it + n : it);
        float ra[32], rb[32];
        t_load(ta, C.lane, ra); if (two) t_load(tb, C.lane, rb);
        t_store(ta, C.lane, ra, scr); if (two) t_store(tb, C.lane, rb, scr);
    }
}

__device__ __forceinline__ void convert_range(const Ctx& C, int layer, int lo, int hi, int b0) {
    if ((int)blockIdx.x < b0) return;
    LAS float* scr = (LAS float*)(C.lds + C.wave * 16384);
    const int n = ((int)gridDim.x - b0) * NWAVE;
    for (int it = lo + ((int)blockIdx.x - b0) * NWAVE + C.wave; it < hi; it += 2 * n) {
        const bool two = it + n < hi;
        const TItem ta = moe_item(C, layer, it), tb = moe_item(C, layer, two ? it + n : it);
        float ra[32], rb[32];
        t_load(ta, C.lane, ra); if (two) t_load(tb, C.lane, rb);
        t_store(ta, C.lane, ra, scr); if (two) t_store(tb, C.lane, rb, scr);
    }
}

__device__ __forceinline__ void phase_prologue(const Ctx& C) {
    const Params& P = *C.p;
    {
        LAS float* s = (LAS float*)C.lds;
        LAS float* red = (LAS float*)(C.lds + 17 * 1024 * 4);
        bool have_s = false;
        for (int u = blockIdx.x; u < 192; u += gridDim.x) {
            if (!have_s) {
                for (int i = C.tid; i < 17 * 1024; i += NTHR) { const int ci = i >> 10, k = i & 1023; const float v = ci < 16 ? P.in[I_C][ci * D + k] : P.in[I_CCTX][k]; s[i] = silu_(v); }
                have_s = true; __syncthreads();
            }
            const int layer = u / 96, jg = u % 96, kq = C.tid >> 6, jc = C.tid & 63;
            const float* w = P.in[I_WMOD] + (size_t)layer * D * 6144 + jg * 64 + jc;
            float acc[17];
#pragma unroll
            for (int i = 0; i < 17; ++i) acc[i] = 0.f;
            for (int k0 = kq * 128; k0 < kq * 128 + 128; k0 += 16) {
                float wv[16];
#pragma unroll
                for (int j = 0; j < 16; ++j) wv[j] = w[(size_t)(k0 + j) * 6144];
#pragma unroll
                for (int j = 0; j < 16; ++j)
#pragma unroll
                    for (int i = 0; i < 17; ++i) acc[i] += s[i * 1024 + k0 + j] * wv[j]; }
#pragma unroll
            for (int i = 0; i < 17; ++i) red[(kq * 17 + i) * 64 + jc] = acc[i];
            __syncthreads();
            for (int o = C.tid; o < 17 * 64; o += NTHR) { const int ci = o >> 6, c = o & 63; float v = 0.f;
#pragma unroll
                for (int q = 0; q < 8; ++q) v += red[(q * 17 + ci) * 64 + c];
                const int j = jg * 64 + c; v += P.in[I_BMOD][layer * 6144 + j];
                ((float*)(C.ws + WS_MOD))[((size_t)(layer * 17 + ci)) * 6144 + j] = v; }
            __syncthreads();
        }
        __syncthreads();
    }
    {
        const int gt = blockIdx.x * NTHR + C.tid, ngt = gridDim.x * NTHR;
        float2* rope = (float2*)(C.ws + WS_TAB + TAB_ROPE);
        for (int i = gt; i < 64 * 16; i += ngt) { const int pos = i >> 4, f = i & 15;
            const double th = exp(-(double)f * (9.210340371976184 / 16.0)); double s, c; dsincos((double)pos * th, s, c); rope[i] = make_float2((float)c, (float)s); }
        float2* lamb = (float2*)(C.ws + WS_TAB + TAB_LAMB); float2* bbar = (float2*)(C.ws + WS_TAB + TAB_BBAR);
        for (int i = gt; i < 2 * 32 * 64; i += ngt) {
            const int dg = i >> 6;
            const double are = P.in[I_ARE][i], aim = P.in[I_AIM][i], dt = exp((double)P.in[I_LOGDT][dg]);
            double s, c; dsincos(aim * dt, s, c); const double mag = exp(are * dt), lr = mag * c, li = mag * s;
            lamb[i] = make_float2((float)lr, (float)li);
            const double den = are * are + aim * aim, nr = lr - 1.0, ni = li;
            const double cr = (nr * are + ni * aim) / den, cim = (ni * are - nr * aim) / den;
            for (int p = 0; p < 16; ++p) { const double br = P.in[I_BRE][(size_t)i * 16 + p], bi = P.in[I_BIM][(size_t)i * 16 + p];
                bbar[(size_t)i * 16 + p] = make_float2((float)(cr * br - cim * bi), (float)(cr * bi + cim * br)); }
        }
    }
    {
        const int gt = blockIdx.x * NTHR + C.tid, ngt = gridDim.x * NTHR;
        bf16* wrt = (bf16*)(C.ws + WS_TAB + TAB_WR);
        for (int idx = gt; idx < 2 * 32 * 3 * 64; idx += ngt) {
            const int ln = idx & 63, jb = (idx >> 6) % 3, kk = (idx / 192) & 31, l = idx / (192 * 32);
            const int i = ln & 15, q = ln >> 4, grp = i >> 2, r = i & 3;
            float hi8[8], lo8[8];
#pragma unroll
            for (int e = 0; e < 8; ++e) { const int k = 32 * kk + 8 * q + e;
                const float w = jb < 2 ? P.in[I_WRT][((size_t)l * D + k) * 32 + grp * 8 + jb * 4 + r] : (r == 0 ? P.in[I_WGRP][((size_t)l * D + k) * 4 + grp] : 0.f);
                const float h = bf2f(f2bf(w)); hi8[e] = h; lo8[e] = w - h; }
            v4u oh, ol; oh.x = pk2(hi8[0], hi8[1]); oh.y = pk2(hi8[2], hi8[3]); oh.z = pk2(hi8[4], hi8[5]); oh.w = pk2(hi8[6], hi8[7]);
            ol.x = pk2(lo8[0], lo8[1]); ol.y = pk2(lo8[2], lo8[3]); ol.z = pk2(lo8[4], lo8[5]); ol.w = pk2(lo8[6], lo8[7]);
            const size_t base = ((((size_t)l * 32 + kk) * 3 + jb) * 2) * 64 + ln;
            *(v4u*)(wrt + base * 8) = oh; *(v4u*)(wrt + (base + 64) * 8) = ol;
        }
    }
    {
        const int gt = blockIdx.x * NTHR + C.tid, ngt = gridDim.x * NTHR; bf16* w16 = (bf16*)(C.ws + WS_WSP);
        for (int i = gt; i < 8 * 128 * 128 / 4; i += ngt) { const f32x4 v = *(const f32x4*)(P.in[I_WSP] + 4 * (size_t)i); v2u o; o.x = pk2(v.x, v.y); o.y = pk2(v.z, v.w); *(v2u*)(w16 + 4 * (size_t)i) = o; }
    }
    convert_items(C, 0, NSMALL);
}

__device__ __forceinline__ void load_row16(const float* row, int lane, f32x4 (&v)[4]) {
#pragma unroll
    for (int j = 0; j < 4; ++j) v[j] = *(const f32x4*)(row + 4 * lane + 256 * j);
}
__device__ __forceinline__ float row_rstd(const f32x4 (&v)[4]) {
    float s = 0.f;
#pragma unroll
    for (int j = 0; j < 4; ++j) s += (v[j].x * v[j].x + v[j].y * v[j].y) + (v[j].z * v[j].z + v[j].w * v[j].w);
    return rsqrtf(wave_sum(s) * (1.f / D) + EPS);
}
__device__ __forceinline__ void modulate16(f32x4 (&v)[4], float rstd, const float* g, const float* scale, const float* shift, int lane) {
#pragma unroll
    for (int j = 0; j < 4; ++j) { const int c = 4 * lane + 256 * j; const f32x4 gg = *(const f32x4*)(g + c), sc = *(const f32x4*)(scale + c), sh = *(const f32x4*)(shift + c);
        v[j] = v[j] * rstd * gg * (sc + 1.f) + sh; }
}
__device__ __forceinline__ void store_row16_bf16(bf16* row, int lane, const f32x4 (&v)[4]) {
#pragma unroll
    for (int j = 0; j < 4; ++j) { v2u o; o.x = pk2(v[j].x, v[j].y); o.y = pk2(v[j].z, v[j].w); *(v2u*)(row + 4 * lane + 256 * j) = o; }
}

__device__ __forceinline__ void store_row16_fp8(unsigned char* row, int lane, const f32x4 (&v)[4]) {
#pragma unroll
    for (int j = 0; j < 4; ++j) { int w = 0; w = __builtin_amdgcn_cvt_pk_fp8_f32(v[j].x, v[j].y, w, false); w = __builtin_amdgcn_cvt_pk_fp8_f32(v[j].z, v[j].w, w, true); *(int*)(row + 4 * lane + 256 * j) = w; }
}

__device__ __forceinline__ void phase_norm_mix0(const Ctx& C) {
    const Params& P = *C.p; unsigned char* H = (unsigned char*)(C.ws + WS_H);
    f32x4 a[4], b[4]; const int n = C.ngw; int r = C.gw;
    if (r < TT) load_row16(xin_row(P, r), C.lane, a);
    if (r + n < TT) load_row16(xin_row(P, r + n), C.lane, b);
#define NM0_ROW(buf, rr, rnext) do { f32x4 v[4] = {buf[0], buf[1], buf[2], buf[3]}; if ((rnext) < TT) load_row16(xin_row(P, (rnext)), C.lane, buf); \
        const float rstd = row_rstd(v); const int ci = cond_of(rr); modulate16(v, rstd, P.in[I_GMIX], mod_vec(C, 0, ci, 1), mod_vec(C, 0, ci, 0), C.lane); store_row16_fp8(H + (size_t)(rr) * D, C.lane, v); } while (0)
    for (; r < TT; r += 2 * n) { NM0_ROW(a, r, r + 2 * n); if (r + n < TT) NM0_ROW(b, r + n, r + 3 * n); }
#undef NM0_ROW
}

__device__ __forceinline__ unsigned gm_off_b(unsigned row, unsigned ch) { return 256u * row + 16u * (ch ^ (((row & 3u) << 2) | ((row >> 2) & 3u))); }
__device__ __forceinline__ void phase_gmlp_fast(const Ctx& C) {
    typedef short bf16x8 __attribute__((ext_vector_type(8)));
    typedef short s16x4 __attribute__((ext_vector_type(4)));
    typedef float f32x16 __attribute__((ext_vector_type(16)));
    const Params& P = *C.p; const bf16* Pb = (const bf16*)(C.ws + WS_P); bf16* OG = (bf16*)(C.ws + WS_H); const bf16* W16 = (const bf16*)(C.ws + WS_WSP);
    const float* lnp = (const float*)(C.ws + WS_Q);
    const int tid = C.tid, lane = C.lane, w = C.wave, l31 = lane & 31, hi = lane >> 5;
    const int gsel = w >> 2, pb = w & 3;
    const int nU = (TT / 128) * 4, arow = tid >> 2;
    v4u ra[4]; float2 st = make_float2(0.f, 0.f);
#define GM_ALOAD(uu_) do { const size_t gr_ = (size_t)((uu_) >> 2) * 128 + arow; { const f32x4 pq = *(const f32x4*)(lnp + gr_ * 16 + 4 * (tid & 3)); st = make_float2(pq.x + pq.z, pq.y + pq.w); } \
        _Pragma("unroll") for (int i = 0; i < 4; ++i) ra[i] = *(const v4u*)(Pb + gr_ * MIXW + 1280 + 128 * ((uu_) & 3) + 8 * ((tid & 3) + 4 * i)); } while (0)
    if ((int)blockIdx.x < nU) GM_ALOAD((int)blockIdx.x);
    for (int u = blockIdx.x; u < nU; u += gridDim.x) {
        const int ch_ = u >> 2, gp = u & 3, g = 2 * gp + gsel;
        bf16x8 xf[8]; const bf16* wrow = W16 + ((size_t)g * 128 + 32 * pb + l31) * 128 + 8 * hi;
#pragma unroll
        for (int k8 = 0; k8 < 8; ++k8) xf[k8] = *(const bf16x8*)(wrow + 16 * k8);
        { float s1 = st.x, s2 = st.y; s1 += __shfl_xor(s1, 1); s1 += __shfl_xor(s1, 2); s2 += __shfl_xor(s2, 1); s2 += __shfl_xor(s2, 2);
          const float mean_ = s1 * (1.f / 512.f); const float2 sc = make_float2(mean_, rsqrtf(fmaxf(s2 * (1.f / 512.f) - mean_ * mean_, 0.f) + EPS));
#pragma unroll
          for (int i = 0; i < 4; ++i) { const int c16 = (tid & 3) + 4 * i; float v[8]; unpack8(ra[i], v);
              const float* lg = P.in[I_LNG] + 128 * gp + 8 * c16;
#pragma unroll
              for (int j = 0; j < 8; ++j) v[j] = (v[j] - sc.x) * sc.y * lg[j];
              v4u o; o.x = pk2(v[0], v[1]); o.y = pk2(v[2], v[3]); o.z = pk2(v[4], v[5]); o.w = pk2(v[6], v[7]);
              *(LAS v4u*)(C.lds + (arow >> 5) * 8192 + gm_off_b(arow & 31, c16)) = o; } }
        if (u + (int)gridDim.x < nU) GM_ALOAD(u + (int)gridDim.x);
        __syncthreads();
        f32x16 acc[2]; acc[0] = f32x16{}; acc[1] = f32x16{};
#pragma unroll
        for (int k8 = 0; k8 < 8; ++k8) {
            const unsigned rb = k8 >> 1, ks = k8 & 1;
#pragma unroll
            for (int db = 0; db < 2; ++db) { const unsigned c = 2 * gsel + db, blk = (lane >> 4) & 1, q = (lane & 15) >> 2, p2 = lane & 3;
                s16x4 t0, t1;
                { const unsigned a0 = rb * 8192 + gm_off_b(16 * ks + 8 * hi + q, 4 * c + 2 * blk + (p2 >> 1)) + 8 * (p2 & 1);
                  const unsigned a1 = rb * 8192 + gm_off_b(16 * ks + 8 * hi + 4 + q, 4 * c + 2 * blk + (p2 >> 1)) + 8 * (p2 & 1);
                  t0 = __builtin_bit_cast(s16x4, __builtin_amdgcn_ds_read_tr16_b64_v4i16((LAS s16x4*)(C.lds + a0)));
                  t1 = __builtin_bit_cast(s16x4, __builtin_amdgcn_ds_read_tr16_b64_v4i16((LAS s16x4*)(C.lds + a1))); }
                const bf16x8 yf = {t0[0], t0[1], t0[2], t0[3], t1[0], t1[1], t1[2], t1[3]};
                acc[db] = __builtin_amdgcn_mfma_f32_32x32x16_bf16(xf[k8], yf, acc[db], 0, 0, 0); }
        }
        const float* bsp = P.in[I_BSP] + g * 128 + 32 * pb;
#pragma unroll
        for (int r = 0; r < 16; ++r) { const int pl = (r & 3) + 8 * (r >> 2) + 4 * hi; const size_t grow = (size_t)ch_ * 128 + 32 * pb + pl; const float bb = bsp[pl];
#pragma unroll
            for (int db = 0; db < 2; ++db) { const int col = 64 * g + 32 * db + l31; const float uu = bf2f(Pb[grow * MIXW + 768 + col]);
                OG[grow * D + 512 + col] = (bf16)f2bf(uu * (acc[db][r] + bb)); } }
        __syncthreads();
    }
#undef GM_ALOAD
}

__device__ __forceinline__ void phase_attn_fast(const Ctx& C, char* lds_generic) {
    typedef attn_body::bf16 abf;
    const abf* Q = (const abf*)(C.ws + WS_P); const abf* Kb = (const abf*)(C.ws + WS_K); const abf* Vb = (const abf*)(C.ws + WS_V); abf* OG = (abf*)(C.ws + WS_H);
    const int G = gridDim.x, bx = blockIdx.x; const int vcu = (G % 8 == 0) ? (bx % 8) * (G / 8) + bx / 8 : bx;
    const int per = (1024 + G - 1) / G, perc = (128 + G - 1) / G;
    for (int i = 0; i < per + perc; ++i) {
        int b, h, nt, tq0; size_t qrow;
        if (i < per) { const int u = vcu * per + i; if (u >= 1024) continue; const int qb = u & 7, hg = (u >> 3) & 3, bk = u >> 5; b = bk >> 1; h = (bk & 1) * 4 + hg; qrow = (size_t)b * SEQ + qb * 256; nt = KVL / 64; tq0 = qb * 256; }
        else { const int u = (G == 256 ? bx - 128 : vcu) + (i - per) * G; if (u < 0 || u >= 128) continue;   b = u >> 3; h = u & 7; qrow = (size_t)TL + (size_t)b * CTXL; nt = CTXL / 64; tq0 = -1; }
        const size_t kvo = (size_t)b * KVL * 128 + (h >> 2) * 64;
        attn_body::attn_unit<8>(Q + qrow * MIXW + h * 64, Kb + kvo, Vb + kvo, OG + qrow * 1024 + h * 64, nt, lds_generic, C.p->in[I_QG], (const float2*)(C.ws + WS_TAB + TAB_ROPE), tq0);
    }
}

__device__ __forceinline__ void phase_router_fast(const Ctx& C, int layer, int nrows) {
    typedef short bf16x8 __attribute__((ext_vector_type(8)));
    const Params& P = *C.p; const bf16* XC = (const bf16*)(C.ws + WS_XC); bf16* F = (bf16*)(C.ws + WS_H);
    int* asg_e = (int*)(C.ws + WS_ROUTE + RT_E); int* asg_p = (int*)(C.ws + WS_ROUTE + RT_P); float* asg_w = (float*)(C.ws + WS_ROUTE + RT_W); int* list = (int*)(C.ws + WS_LIST);
    unsigned* cnt = (unsigned*)(C.ws + WS_CTL) + CW_CNT + 64 * layer;
    const int l15 = C.lane & 15, q4 = C.lane >> 4;
    LAS float* ab = (LAS float*)(C.lds + C.wave * 8192);
    LAS unsigned* lcnt = (LAS unsigned*)(C.lds + 65536);
    if (C.tid < 64) lcnt[C.tid] = 0u;
    __syncthreads();
    int cur_ci = -1;
    const int nitems = nrows / 16;
    for (int rd = 0; (int)blockIdx.x * NWAVE + rd * C.ngw < nitems; ++rd) {
        const int it_raw = C.gw + rd * C.ngw; const bool valid = it_raw < nitems; const int it = valid ? it_raw : nitems - 1;
        const int row = it * 16 + l15, ci = cond_of(it * 16);
        if (ci != cur_ci) {
            const float* sc = mod_vec(C, layer, ci, 4); const float* sh = mod_vec(C, layer, ci, 3); const float* g0 = P.in[I_GFFN] + layer * D;
#pragma unroll
            for (int j = 0; j < 4; ++j) { const int c = 4 * C.lane + 256 * j; const f32x4 g4 = *(const f32x4*)(g0 + c), s4 = *(const f32x4*)(sc + c), h4 = *(const f32x4*)(sh + c); const f32x4 a4 = g4 * (s4 + 1.f);
                *(LAS f32x4*)(ab + c) = a4; *(LAS f32x4*)(ab + 1024 + c) = h4; }
            asm volatile("s_waitcnt lgkmcnt(0)" ::: "memory"); cur_ci = ci;
        }
        const bf16* xr = XC + (size_t)row * D + 8 * q4;
        float ss = 0.f;
#pragma unroll 16
        for (int kk = 0; kk < 32; ++kk) { pg8::f32x4 a, b; pg8::unpack8f(*(const pg8::u32x4*)(xr + 32 * kk), a, b); ss += (a.x * a.x + a.y * a.y) + (a.z * a.z + a.w * a.w) + (b.x * b.x + b.y * b.y) + (b.z * b.z + b.w * b.w); }
        ss += __shfl_xor(ss, 16); ss += __shfl_xor(ss, 32);
        const float rstd = rsqrtf(ss * (1.f / D) + EPS);
        f32x4 acc[3]; acc[0] = (f32x4){0.f, 0.f, 0.f, 0.f}; acc[1] = acc[0]; acc[2] = acc[0];
        unsigned char* frow = (unsigned char*)F + (size_t)row * D + 8 * q4;
        const LAS float* abl = ab + 8 * q4;
        {
            const unsigned char* wsrc = (const unsigned char*)((const bf16x8*)(C.ws + WS_TAB + TAB_WR) + (size_t)layer * (32 * 3 * 2 * 64)) + C.tid * 16;
            LAS unsigned char* wl0 = C.lds + 67584;
#define RS_GLOAD(sb_, ga, gb, gc, xq) do { ga = *(const pg8::u32x4*)(wsrc + (sb_) * 24576); gb = *(const pg8::u32x4*)(wsrc + (sb_) * 24576 + 8192); gc = *(const pg8::u32x4*)(wsrc + (sb_) * 24576 + 16384); \
                _Pragma("unroll") for (int j = 0; j < 4; ++j) xq[j] = *(const pg8::u32x4*)(xr + 128 * (sb_) + 32 * j); } while (0)
#define RS_LWRITE(sb_, ga, gb, gc) do { LAS unsigned char* wn = wl0 + ((sb_) & 1) * 24576 + C.tid * 16; *(LAS pg8::u32x4*)(wn) = ga; *(LAS pg8::u32x4*)(wn + 8192) = gb; *(LAS pg8::u32x4*)(wn + 16384) = gc; } while (0)
#define RS_FRAGS(sb_, j_, wf_, tb_) do { const LAS unsigned char* wl = wl0 + ((sb_) & 1) * 24576 + C.lane * 16; const int c_ = 128 * (sb_) + 32 * (j_); \
                _Pragma("unroll") for (int jb = 0; jb < 3; ++jb) { wf_[jb][0] = *(const LAS bf16x8*)(wl + (((j_) * 3 + jb) * 2) * 1024); wf_[jb][1] = *(const LAS bf16x8*)(wl + (((j_) * 3 + jb) * 2 + 1) * 1024); } \
                tb_[0] = *(const LAS f32x4*)(abl + c_); tb_[1] = *(const LAS f32x4*)(abl + c_ + 4); tb_[2] = *(const LAS f32x4*)(abl + 1024 + c_); tb_[3] = *(const LAS f32x4*)(abl + 1024 + c_ + 4); } while (0)
#define RS_STEP(sb_, j_, xv_, wf_, tb_, NEXT) do { const int c = 128 * (sb_) + 32 * (j_); \
                pg8::f32x4 x0, x1; pg8::unpack8f(xv_, x0, x1); \
                const f32x4 f0 = x0 * rstd * tb_[0] + tb_[2]; \
                const f32x4 f1 = x1 * rstd * tb_[1] + tb_[3]; \
                const pg8::u32x4 fh = pg8::pack8(f0, f1); if (valid) *(pg8::u32x2*)(frow + c) = pg8::pack8_fp8(f0, f1); \
                pg8::f32x4 r0, r1; pg8::unpack8f(fh, r0, r1); \
                const pg8::u32x4 fl = pg8::pack8(f0 - r0, f1 - r1); \
                const bf16x8 ah = __builtin_bit_cast(bf16x8, fh), al = __builtin_bit_cast(bf16x8, fl); \
                NEXT; \
                _Pragma("unroll") for (int jb = 0; jb < 3; ++jb) { \
                    acc[jb] = __builtin_amdgcn_mfma_f32_16x16x32_bf16(wf_[jb][0], ah, acc[jb], 0, 0, 0); \
                    acc[jb] = __builtin_amdgcn_mfma_f32_16x16x32_bf16(wf_[jb][0], al, acc[jb], 0, 0, 0); \
                    acc[jb] = __builtin_amdgcn_mfma_f32_16x16x32_bf16(wf_[jb][1], ah, acc[jb], 0, 0, 0); } } while (0)
#define RS_COMP(sb_, xq) do { bf16x8 wA[3][2], wB[3][2]; f32x4 tA[4], tB[4]; \
                RS_FRAGS(sb_, 0, wA, tA); \
                RS_STEP(sb_, 0, xq[0], wA, tA, RS_FRAGS(sb_, 1, wB, tB)); \
                RS_STEP(sb_, 1, xq[1], wB, tB, RS_FRAGS(sb_, 2, wA, tA)); \
                RS_STEP(sb_, 2, xq[2], wA, tA, RS_FRAGS(sb_, 3, wB, tB)); \
                RS_STEP(sb_, 3, xq[3], wB, tB, (void)0); } while (0)
#define RS_SYNC() do { asm volatile("s_waitcnt lgkmcnt(0)" ::: "memory"); __builtin_amdgcn_s_barrier(); } while (0)
            if (layer == 1) STAMP_AT(22);
            pg8::u32x4 a0, a1, a2, b0, b1, b2, xa[4], xb[4], xc[4];
            RS_GLOAD(0, a0, a1, a2, xc); RS_GLOAD(1, b0, b1, b2, xb);
            __builtin_amdgcn_s_barrier();
            RS_LWRITE(0, a0, a1, a2); RS_SYNC();
#pragma unroll 1
            for (int sb = 0; sb < 8; sb += 2) {
                if (sb + 2 < 8) RS_GLOAD(sb + 2, a0, a1, a2, xa);
                RS_COMP(sb, xc);
                RS_LWRITE(sb + 1, b0, b1, b2); RS_SYNC();
#pragma unroll
                for (int j = 0; j < 4; ++j) xc[j] = xb[j];
                if (sb + 3 < 8) RS_GLOAD(sb + 3, b0, b1, b2, xb);
                RS_COMP(sb + 1, xc);
                if (sb + 2 < 8) { RS_LWRITE(sb + 2, a0, a1, a2);
#pragma unroll
                    for (int j = 0; j < 4; ++j) xc[j] = xa[j]; }
                RS_SYNC();
            }
            if (layer == 1) STAMP_AT(23);
#undef RS_GLOAD
#undef RS_LWRITE
#undef RS_COMP
#undef RS_STEP
#undef RS_FRAGS
#undef RS_SYNC
        }
        const float* brt = P.in[I_BRT] + layer * 32 + q4 * 8;
        float e[8];
#pragma unroll
        for (int r = 0; r < 4; ++r) { e[r] = acc[0][r] + brt[r]; e[4 + r] = acc[1][r] + brt[4 + r]; }
        const float gl = acc[2][0] + P.in[I_BGRP][layer * 4 + q4];
        float gm = gl; int gi = q4;
#pragma unroll
        for (int st = 16; st <= 32; st <<= 1) { const float og = __shfl_xor(gm, st); const int oi = __shfl_xor(gi, st); if (og > gm || (og == gm && oi < gi)) { gm = og; gi = oi; } }
        float den = __expf(gl - gm); den += __shfl_xor(den, 16); den += __shfl_xor(den, 32);
        if (valid && q4 == gi) {
            const float gw_ = 1.f / den;
            int i0 = 0; float v0 = e[0];
#pragma unroll
            for (int i = 1; i < 8; ++i) if (e[i] > v0) { v0 = e[i]; i0 = i; }
            int i1 = -1; float v1 = -INFINITY;
#pragma unroll
            for (int i = 0; i < 8; ++i) if (i != i0 && e[i] > v1) { v1 = e[i]; i1 = i; }
            if (i1 < 0) i1 = (i0 + 1) & 7;
            const float e1 = __expf(v1 - v0), w0 = gw_ / (1.f + e1), w1 = gw_ * e1 / (1.f + e1);
            const int ea = (gi & 3) * 8 + i0, eb = (gi & 3) * 8 + i1;
            const unsigned pa = __hip_atomic_fetch_add(lcnt + ea, 1u, __ATOMIC_RELAXED, __HIP_MEMORY_SCOPE_WORKGROUP);
            const unsigned pb = __hip_atomic_fetch_add(lcnt + eb, 1u, __ATOMIC_RELAXED, __HIP_MEMORY_SCOPE_WORKGROUP);
            asg_e[2 * row] = ea; asg_e[2 * row + 1] = eb; asg_p[2 * row] = (int)pa; asg_p[2 * row + 1] = (int)pb; asg_w[2 * row] = w0; asg_w[2 * row + 1] = w1;
        }
    }
    if (layer == 0) STAMP_AT(21);
    asm volatile("s_waitcnt vmcnt(0) lgkmcnt(0)" ::: "memory");
    __syncthreads();
    if (C.tid < 32) { const unsigned n = lcnt[C.tid]; lcnt[32 + C.tid] = n ? __hip_atomic_fetch_add(cnt + C.tid, n, __ATOMIC_RELAXED, __HIP_MEMORY_SCOPE_AGENT) : 0u; }
    __syncthreads();
    for (int it = C.gw; it < nrows / 16; it += C.ngw) {
        if (C.lane < 32) { const int idx = 2 * (it * 16 + (C.lane & 15)) + (C.lane >> 4);
            const int e = __hip_atomic_load(asg_e + idx, __ATOMIC_RELAXED, __HIP_MEMORY_SCOPE_AGENT); const int p = __hip_atomic_load(asg_p + idx, __ATOMIC_RELAXED, __HIP_MEMORY_SCOPE_AGENT) + (int)lcnt[32 + e];
            asg_p[idx] = p; list[(size_t)e * LCAP + p] = idx >> 1; }
    }
}

__device__ __forceinline__ int wave_pstart(const Ctx& C, int layer) {
    const unsigned* cnt = (const unsigned*)(C.ws + WS_CTL) + CW_CNT + 64 * layer;
    const int mc = C.lane < 32 ? (int)__hip_atomic_load(cnt + (C.lane & 31), __ATOMIC_RELAXED, __HIP_MEMORY_SCOPE_AGENT) : 0; const int mp = (mc + 255) & ~255; int in = mp;
#pragma unroll
    for (int o = 1; o < 32; o <<= 1) { const int t = __shfl_up(in, o); if ((C.lane & 31) >= o) in += t; }
    return in - mp;
}
struct CombRaw { v2u x[4], ya[4], yb[4]; float w0, w1; };
__device__ __forceinline__ void comb_load(const Ctx& C, int r, int ps, CombRaw& o) {
    const bf16* Y2 = (const bf16*)(C.ws + WS_XS); const bf16* XC = (const bf16*)(C.ws + WS_XC); const float* asg_w = (const float*)(C.ws + WS_ROUTE + RT_W);
    const int* asg_e = (const int*)(C.ws + WS_ROUTE + RT_E); const int* asg_p = (const int*)(C.ws + WS_ROUTE + RT_P);
    const int s0 = __shfl(ps, asg_e[2 * r]) + asg_p[2 * r], s1 = __shfl(ps, asg_e[2 * r + 1]) + asg_p[2 * r + 1]; o.w0 = asg_w[2 * r]; o.w1 = asg_w[2 * r + 1];
#pragma unroll
    for (int j = 0; j < 4; ++j) { const int c = 4 * C.lane + 256 * j; o.x[j] = *(const v2u*)(XC + (size_t)r * D + c); o.ya[j] = *(const v2u*)(Y2 + (size_t)s0 * D + c); o.yb[j] = *(const v2u*)(Y2 + (size_t)s1 * D + c); }
}
__device__ __forceinline__ void comb_calc(const Ctx& C, int layer, int r, const CombRaw& w, f32x4 (&v)[4]) {
    const float* gate = mod_vec(C, layer, cond_of(r), 5); const float w0 = w.w0, w1 = w.w1;
#pragma unroll
    for (int j = 0; j < 4; ++j) { const int c = 4 * C.lane + 256 * j; const v2u xx = w.x[j], a = w.ya[j], b = w.yb[j]; const f32x4 g = *(const f32x4*)(gate + c);
        v[j].x = bf2f(xx.x & 0xffffu) + g.x * (w0 * bf2f(a.x & 0xffffu) + w1 * bf2f(b.x & 0xffffu)); v[j].y = bf2f(xx.x >> 16) + g.y * (w0 * bf2f(a.x >> 16) + w1 * bf2f(b.x >> 16));
        v[j].z = bf2f(xx.y & 0xffffu) + g.z * (w0 * bf2f(a.y & 0xffffu) + w1 * bf2f(b.y & 0xffffu)); v[j].w = bf2f(xx.y >> 16) + g.w * (w0 * bf2f(a.y >> 16) + w1 * bf2f(b.y >> 16)); }
}
__device__ __forceinline__ void phase_combine_norm_mix1(const Ctx& C) {
    const Params& P = *C.p; bf16* XC = (bf16*)(C.ws + WS_XC); bf16* H = (bf16*)(C.ws + WS_H);
    const int ps = wave_pstart(C, 0), n = C.ngw;
#define CN_ROW(buf, rr, rnext) do { const CombRaw w_ = buf; if ((rnext) < TT) comb_load(C, (rnext), ps, buf); f32x4 v[4]; comb_calc(C, 0, (rr), w_, v); \
        store_row16_bf16(XC + (size_t)(rr) * D, C.lane, v); const float rstd = row_rstd(v); const int ci = cond_of(rr); \
        modulate16(v, rstd, P.in[I_GMIX] + D, mod_vec(C, 1, ci, 1), mod_vec(C, 1, ci, 0), C.lane); store_row16_bf16(H + (size_t)(rr) * D, C.lane, v); } while (0)
    CombRaw a, b; int r = C.gw;
    if (r < TT) comb_load(C, r, ps, a);
    if (r + n < TT) comb_load(C, r + n, ps, b);
    for (; r < TT; r += 2 * n) { CN_ROW(a, r, r + 2 * n); if (r + n < TT) CN_ROW(b, r + n, r + 3 * n); }
#undef CN_ROW
    { const bool early = gridDim.x == 256; if (early) convert_range(C, 1, 0, L1_A, 0); convert_range(C, 1, early ? L1_C : 0, MOE_ITEMS, 0); }
}
__device__ __forceinline__ void phase_final(const Ctx& C) {
    const Params& P = *C.p;
    const int ps = wave_pstart(C, 1), n = C.ngw;
#define FN_ROW(buf, rr, rnext) do { const CombRaw w_ = buf; if ((rnext) < TL) comb_load(C, (rnext), ps, buf); f32x4 v[4]; comb_calc(C, 1, (rr), w_, v); const float rstd = row_rstd(v); \
        _Pragma("unroll") for (int j = 0; j < 4; ++j) { const int c = 4 * C.lane + 256 * j; const f32x4 g = *(const f32x4*)(P.in[I_FING] + c); __builtin_nontemporal_store(v[j] * rstd * g, (f32x4*)(P.out + (size_t)(rr) * D + c)); } } while (0)
    CombRaw a, b; int r = C.gw;
    if (r < TL) comb_load(C, r, ps, a);
    if (r + n < TL) comb_load(C, r + n, ps, b);
    for (; r < TL; r += 2 * n) { FN_ROW(a, r, r + 2 * n); if (r + n < TL) FN_ROW(b, r + n, r + 3 * n); }
#undef FN_ROW
}

__device__ __forceinline__ void phase_s5_fast(const Ctx& C) {
    typedef short bf16x8 __attribute__((ext_vector_type(8)));
    typedef float f32x16 __attribute__((ext_vector_type(16)));
    const Params& P = *C.p; const bf16* U = (const bf16*)(C.ws + WS_U); bf16* GS = (bf16*)(C.ws + WS_GS); float* YA = (float*)(C.ws + WS_YACC);
    const float2* lamb = (const float2*)(C.ws + WS_TAB + TAB_LAMB); const float2* bbar = (const float2*)(C.ws + WS_TAB + TAB_BBAR);
    constexpr int HP = 272;
    const int lane = C.lane, w = C.wave, il = w >> 2, dir = (w >> 1) & 1, nh = w & 1;
    const int l31 = lane & 31, hi = lane >> 5, l15 = lane & 15, q4 = lane >> 4;
    LAS unsigned char* Hb = C.lds + (il * 2 + dir) * (2 * 32 * HP);
    const int srow = 16 * ((l31 >> 2) & 1) + 2 * (l31 >> 3) + ((l31 >> 1) & 1);
    for (int it0 = blockIdx.x; it0 < NB * 16; it0 += gridDim.x) {
        const int item = it0 * 2 + il, b = item >> 5, g = item & 31;
        const int dg = dir * 32 + g, n = nh * 32 + l31;
        const float2 lam = lamb[dg * 64 + n];
        f32x2 p2[16]; { f32x2 p = {lam.x, lam.y};
#pragma unroll
            for (int r = 0; r < 16; ++r) { p2[r] = p; p = (f32x2){p.x * lam.x - p.y * lam.y, p.x * lam.y + p.y * lam.x}; } }
        const f32x2 lx2 = {lam.x, lam.x}, ly2 = {-lam.y, lam.y};
        bf16x8 bre, bim; { const float2* bp = bbar + ((size_t)(dg * 64 + n)) * 16 + 8 * hi;
#pragma unroll
            for (int e = 0; e < 8; ++e) { const float2 v = bp[e]; bre[e] = (short)f2bf(v.x); bim[e] = (short)f2bf(v.y); } }
        bf16x8 cf[4]; { const float* cre = P.in[I_CRE] + ((size_t)dg * 16 + l15) * 64; const float* cim = P.in[I_CIM] + ((size_t)dg * 16 + l15) * 64;
#pragma unroll
            for (int ks = 0; ks < 4; ++ks) { const f32x4 a = *(const f32x4*)(cre + 16 * ks + 4 * q4), m = *(const f32x4*)(cim + 16 * ks + 4 * q4);
                cf[ks][0] = (short)f2bf(a.x); cf[ks][1] = (short)f2bf(-m.x); cf[ks][2] = (short)f2bf(a.y); cf[ks][3] = (short)f2bf(-m.y);
                cf[ks][4] = (short)f2bf(a.z); cf[ks][5] = (short)f2bf(-m.z); cf[ks][6] = (short)f2bf(a.w); cf[ks][7] = (short)f2bf(-m.w); } }
        const f32x4 dsk = *(const f32x4*)(P.in[I_S5D] + g * 16 + 4 * q4);
        f32x2 carry = {0.f, 0.f};
#define S5_UROW(kk, off) ({ const int S_ = 32 * (kk) + srow + (off); (S_ < CTXL) ? ((size_t)TL + (size_t)b * CTXL + (dir == 0 ? S_ : CTXL - 1 - S_)) : ((size_t)b * SEQ + (dir == 0 ? S_ - CTXL : SEQ - 1 - (S_ - CTXL))); })
        const bool odd = l31 & 1;
#define S5_ULD(kk, off) (*(const bf16x8*)(U + S5_UROW(kk, off) * 512 + g * 16 + 8 * hi))
        bf16x8 ux1 = S5_ULD(0, 0), uy1 = S5_ULD(0, 8), ux2 = S5_ULD(1, 0), uy2 = S5_ULD(1, 8), ux3 = S5_ULD(2, 0), uy3 = S5_ULD(2, 8);
        f32x4 pk_n = {0.f, 0.f, 0.f, 0.f}; v2u uu_n = {0u, 0u};
        for (int k = 0; k < 72; ++k) {
            const bf16x8 ux = ux1, uy = uy1; ux1 = ux2; uy1 = uy2; ux2 = ux3; uy2 = uy3;
            if (k + 3 < 72) { ux3 = S5_ULD(k + 3, 0); uy3 = S5_ULD(k + 3, 8); }
            const int sl = 32 * (k - 8) + 16 * nh + l15;
            const int tok = dir == 0 ? sl : SEQ - 1 - sl; const int lt = tok >> 5;
            const size_t o = ((size_t)b * SEQ + (k >= 8 ? tok : 0)) * 512 + g * 16 + 4 * q4;
            const bool first = dir == 0 ? (lt < 32) : (lt >= 32);
#define S5_RLOAD(oo, pk_, uu_) do { pk_.x = __hip_atomic_load(YA + (oo), __ATOMIC_RELAXED, __HIP_MEMORY_SCOPE_AGENT); pk_.y = __hip_atomic_load(YA + (oo) + 1, __ATOMIC_RELAXED, __HIP_MEMORY_SCOPE_AGENT); \
                pk_.z = __hip_atomic_load(YA + (oo) + 2, __ATOMIC_RELAXED, __HIP_MEMORY_SCOPE_AGENT); pk_.w = __hip_atomic_load(YA + (oo) + 3, __ATOMIC_RELAXED, __HIP_MEMORY_SCOPE_AGENT); uu_ = *(const v2u*)(U + (oo)); } while (0)
            f32x4 pk = pk_n; v2u uu = uu_n;
            if (k == 40) S5_RLOAD(o, pk, uu);
            if (k >= 40 && k + 1 < 72) { const int sl1 = 32 * (k + 1 - 8) + 16 * nh + l15; const int tok1 = dir == 0 ? sl1 : SEQ - 1 - sl1; const size_t o1 = ((size_t)b * SEQ + tok1) * 512 + g * 16 + 4 * q4; S5_RLOAD(o1, pk_n, uu_n); }
            {
              const bf16x8 zf = {0, 0, 0, 0, 0, 0, 0, 0};
              f32x16 X = {}, Y = {};
              X = __builtin_amdgcn_mfma_f32_32x32x16_bf16(odd ? zf : ux, bre, X, 0, 0, 0); X = __builtin_amdgcn_mfma_f32_32x32x16_bf16(odd ? ux : zf, bim, X, 0, 0, 0);
              Y = __builtin_amdgcn_mfma_f32_32x32x16_bf16(odd ? zf : uy, bre, Y, 0, 0, 0); Y = __builtin_amdgcn_mfma_f32_32x32x16_bf16(odd ? uy : zf, bim, Y, 0, 0, 0);
              f32x2 s2 = hi ? (f32x2){0.f, 0.f} : carry;
#pragma unroll
              for (int q = 0; q < 8; ++q) { const f32x2 bq = {X[2 * q], X[2 * q + 1]}, sw = {s2.y, s2.x}; s2 = lx2 * s2 + bq; s2 = ly2 * sw + s2; X[2 * q] = s2.x; X[2 * q + 1] = s2.y; }
#pragma unroll
              for (int q = 0; q < 8; ++q) { const f32x2 bq = {Y[2 * q], Y[2 * q + 1]}, sw = {s2.y, s2.x}; s2 = lx2 * s2 + bq; s2 = ly2 * sw + s2; Y[2 * q] = s2.x; Y[2 * q + 1] = s2.y; }
              float er = __shfl_xor(s2.x, 32), ei = __shfl_xor(s2.y, 32); if (!hi) { er = 0.f; ei = 0.f; }
              const f32x2 er2 = {er, er}, ei2 = {ei, ei};
#pragma unroll
              for (int q = 0; q < 8; ++q) { const f32x2 p = p2[q], ps = {-p.y, p.x}; f32x2 h = {X[2 * q], X[2 * q + 1]}; h = er2 * p + h; h = ei2 * ps + h; X[2 * q] = h.x; X[2 * q + 1] = h.y; }
#pragma unroll
              for (int q = 0; q < 8; ++q) { const f32x2 p = p2[8 + q], ps = {-p.y, p.x}; f32x2 h = {Y[2 * q], Y[2 * q + 1]}; h = er2 * p + h; h = ei2 * ps + h; Y[2 * q] = h.x; Y[2 * q + 1] = h.y; }
              carry = (f32x2){__shfl_xor(Y[14], 32), __shfl_xor(Y[15], 32)};
              LAS unsigned char* hb = Hb + (k & 1) * (32 * HP) + (16 * hi) * HP + 4 * n;
#pragma unroll
              for (int q = 0; q < 8; ++q) { *(LAS unsigned*)(hb + q * HP) = pk2(X[2 * q], X[2 * q + 1]); *(LAS unsigned*)(hb + (8 + q) * HP) = pk2(Y[2 * q], Y[2 * q + 1]); }
            }
            asm volatile("s_waitcnt lgkmcnt(0)\n\ts_barrier" ::: "memory");
            if (k >= 8) {
                const LAS unsigned char* hr = Hb + (k & 1) * (32 * HP) + (16 * nh + l15) * HP + 16 * q4;
                f32x4 y = {0.f, 0.f, 0.f, 0.f};
#pragma unroll
                for (int ks = 0; ks < 4; ++ks) { const bf16x8 hf = *(const LAS bf16x8*)(hr + 64 * ks); y = __builtin_amdgcn_mfma_f32_16x16x32_bf16(cf[ks], hf, y, 0, 0, 0); }
                if (first) { *(f32x4*)(YA + o) = y; }
                else {
                    const f32x4 uf = {bf2f(uu.x & 0xffffu), bf2f(uu.x >> 16), bf2f(uu.y & 0xffffu), bf2f(uu.y >> 16)};
                    const f32x4 t = y + pk + dsk * uf;
                    v2u ov; ov.x = pk2(gelu_tanh(t.x), gelu_tanh(t.y)); ov.y = pk2(gelu_tanh(t.z), gelu_tanh(t.w)); *(v2u*)(GS + o) = ov;
                }
            }
            if (k == 39) asm volatile("s_waitcnt vmcnt(0)\n\ts_barrier" ::: "memory");
        }
#undef S5_UROW
#undef S5_ULD
#undef S5_RLOAD
        asm volatile("s_waitcnt vmcnt(0) lgkmcnt(0)\n\ts_barrier" ::: "memory");
    }
}

__global__ void __launch_bounds__(NTHR, 2) fwd_kernel(Params prm) {
    extern __shared__ __attribute__((aligned(16))) unsigned char lds_raw[];
    Ctx C; C.p = &prm; C.ws = prm.ws; C.lds = (LAS unsigned char*)lds_raw;
    C.tid = threadIdx.x; C.lane = C.tid & 63; C.wave = __builtin_amdgcn_readfirstlane(C.tid >> 6);
    C.gw = blockIdx.x * NWAVE + C.wave; C.ngw = gridDim.x * NWAVE;
    constexpr int LDS_MISC = 147456 - 512;
    volatile LAS unsigned* misc = (volatile LAS unsigned*)(C.lds + LDS_MISC);
    if (C.tid < 64) misc[C.tid] = 0u;
    __syncthreads();
    unsigned* ctl = (unsigned*)(C.ws + WS_CTL);
    XcdBarrier bar; bar.bar = ctl + CW_BAR; bar.x = 0; bar.st = nullptr;
#if MK_ONE_LAUNCH
    bar = xcd_barrier_post(ctl + CW_BAR, misc + 8);
#define SEAM(k) do { if (lo <= (k) && (k) + 1 < hi) xcd_barrier(bar); } while (0)
#else
#define SEAM(k) do { } while (0)
#endif
    const int lo = prm.ph_lo, hi = prm.ph_hi;
#define IN(k) ((C.lane = lane_id_now(), C.tid = C.wave * 64 + C.lane, true) && lo <= (k) && (k) < hi)
#if MK_PROBE
#define STAMP(k) STAMP_AT((k) + 1)
    STAMP_AT(0);
#else
#define STAMP(k) do { } while (0)
#endif
    const Params& P = prm;
    bf16* Hb = (bf16*)(C.ws + WS_H); bf16* XC = (bf16*)(C.ws + WS_XC);
#define MOE_MAP(layer) do { LAS int* tm_ = (LAS int*)(C.lds + 131072); LAS int* cl_ = tm_ + 320; \
        if (C.wave == 0) { const unsigned* cnt_ = (const unsigned*)(C.ws + WS_CTL) + CW_CNT + 64 * (layer); const int mc_ = C.lane < 32 ? (int)__hip_atomic_load(cnt_ + (C.lane & 31), __ATOMIC_RELAXED, __HIP_MEMORY_SCOPE_AGENT) : 0; const int mp_ = (mc_ + 255) & ~255; int in_ = mp_; \
            _Pragma("unroll") for (int o_ = 1; o_ < 32; o_ <<= 1) { const int t_ = __shfl_up(in_, o_); if ((C.lane & 31) >= o_) in_ += t_; } const int ps_ = in_ - mp_; \
            if (C.lane < 32) { for (int t_ = ps_ / 256; t_ < (ps_ + mp_) / 256; ++t_) tm_[t_] = C.lane | ((t_ * 256 - ps_) << 8); cl_[C.lane] = mc_; if (C.lane == 31) cl_[32] = (ps_ + mp_) / 256; } } \
        __syncthreads(); } while (0)
#define MOE_GEMM1(layer) do { MOE_MAP(layer); const LAS int* tm_ = (const LAS int*)(C.lds + 131072); const int ntl_ = __builtin_amdgcn_readfirstlane(tm_[320 + 32]); pg8::Gemm g{Hb, (const bf16*)(C.ws + ((layer) ? WS_W13B : WS_W13)), 0, 1024, 512}; \
        pg8::GroupedOrder<true> S{tm_, tm_ + 320, (const int*)(C.ws + WS_LIST), ntl_ * 4, 4, (int)gridDim.x, (int)blockIdx.x, LCAP, 1024, (size_t)1024 * 1024}; pg8::EpiSwiglu E{(unsigned char*)(C.ws + WS_G13), 1.f / W13_SCALE, G_SCALE}; \
        pg8::gemm_phase<pg8::EpiSwiglu, pg8::GroupedOrder<true>, true, false, false, true>(C.lds, g, S, E, C.wave); } while (0)
#define MOE_GEMM2(layer) do { MOE_MAP(layer); int kk_ = EH / 2; asm volatile("" : "+s"(kk_));     \
        const LAS int* tm_ = (const LAS int*)(C.lds + 131072); const int ntl_ = __builtin_amdgcn_readfirstlane(tm_[320 + 32]); pg8::Gemm g{(const bf16*)(C.ws + WS_G13), (const bf16*)(C.ws + ((layer) ? WS_W2B : WS_W2)), 0, 1024, kk_}; \
        pg8::GroupedOrder<false> S{tm_, tm_ + 320, (const int*)(C.ws + WS_LIST), ntl_ * 4, 4, (int)gridDim.x, (int)blockIdx.x, LCAP, EH, (size_t)1024 * 512}; pg8::EpiStore E{(bf16*)(C.ws + WS_XS), D, 1.f / (W13_SCALE * G_SCALE)}; \
        pg8::gemm_phase<pg8::EpiStore, pg8::GroupedOrder<false>, true, false, false, true>(C.lds, g, S, E, C.wave); } while (0)
    if (IN(0)) { phase_prologue(C); SEAM(0); STAMP(0); }
    if (IN(1)) { phase_norm_mix0(C); SEAM(1); STAMP(1); }
    if (IN(2)) { pg8::Gemm g{Hb, (const bf16*)(C.ws + WS_WIN0), TT, MIXW, D / 2};
        pg8::StaticOrder S; S.init(TT, MIXW, gridDim.x, blockIdx.x); pg8::EpiInProj E{(bf16*)(C.ws + WS_P), (bf16*)(C.ws + WS_K), (bf16*)(C.ws + WS_V), P.in[I_KG], (const float*)(C.ws + WS_TAB + TAB_ROPE), (LAS float*)(C.lds + 135168), 1.f / W13_SCALE, (float*)(C.ws + WS_Q)};
        pg8::gemm_phase<pg8::EpiInProj, pg8::StaticOrder, true, false, false, true>(C.lds, g, S, E, C.wave); SEAM(2); STAMP(2); }
    if (IN(4)) { phase_gmlp_fast(C); phase_attn_fast(C, (char*)lds_raw); SEAM(4); STAMP(4); }
    if (IN(5)) { pg8::Gemm g{Hb, (const bf16*)(C.ws + WS_WOUT0), TT, D, D}; pg8::StaticOrderH S; S.init(TT, D, gridDim.x, blockIdx.x, 1); pg8::EpiResid E{P.in[I_X], P.in[I_CTX], (const float*)(C.ws + WS_MOD), XC, 0};
        pg8::gemm_phase<pg8::EpiResid, pg8::StaticOrderH, true, true, true>(C.lds, g, S, E, C.wave);
        if (gridDim.x == 256) { __syncthreads(); convert_range(C, 0, L0_A, L0_B, 64); }
        SEAM(5); STAMP(5); }
    if (IN(6)) { phase_router_fast(C, 0, TT); if (gridDim.x == 256) { __syncthreads(); convert_range(C, 0, L0_B, MOE_ITEMS, 32); } SEAM(6); STAMP(6); }
    if (IN(8)) { MOE_GEMM1(0); SEAM(8); STAMP(8); }
    if (IN(9)) { MOE_GEMM2(0); if (gridDim.x == 256) { __syncthreads(); convert_range(C, 1, L1_A, L1_B, 192); } SEAM(9); STAMP(9); }
    if (IN(10)) { phase_combine_norm_mix1(C); SEAM(10); STAMP(10); }
    if (IN(11)) { pg8::Gemm g{Hb, (const bf16*)(C.ws + WS_WS5IN), TT, 512, D}; pg8::StaticOrderH S; S.init(TT, 512, gridDim.x, blockIdx.x, 1); pg8::EpiStore E{(bf16*)(C.ws + WS_U), 512, 1.f};
        pg8::gemm_phase<pg8::EpiStore, pg8::StaticOrderH, true, true, true>(C.lds, g, S, E, C.wave);
        if (gridDim.x == 256) { __syncthreads(); convert_range(C, 1, L1_B, L1_C, 64); }
        SEAM(11); STAMP(11); }
    if (IN(12)) { phase_s5_fast(C); SEAM(12); STAMP(12); }
    if (IN(13)) { pg8::Gemm g{(const bf16*)(C.ws + WS_GS), (const bf16*)(C.ws + WS_WGLU), TL, 512, 512}; pg8::StaticOrder S; S.init(TL, 512, gridDim.x, blockIdx.x); pg8::EpiGlu E{(const bf16*)(C.ws + WS_GS), P.in[I_BGLU], (bf16*)(C.ws + WS_GG)};
        pg8::gemm_phase<pg8::EpiGlu, pg8::StaticOrder, true, true, true>(C.lds, g, S, E, C.wave); SEAM(13); STAMP(13); }
    if (IN(14)) { pg8::Gemm g{(const bf16*)(C.ws + WS_GG), (const bf16*)(C.ws + WS_WS5OUT), TL, D, 512}; pg8::StaticOrder S; S.init(TL, D, gridDim.x, blockIdx.x); pg8::EpiResid E{P.in[I_X], P.in[I_CTX], (const float*)(C.ws + WS_MOD) + (size_t)17 * 6 * D, XC, 1};
        pg8::gemm_phase<pg8::EpiResid, pg8::StaticOrder, true, true, true>(C.lds, g, S, E, C.wave); SEAM(14); STAMP(14); }
    if (IN(15)) { phase_router_fast(C, 1, TL); SEAM(15); STAMP(15); }
    if (IN(17)) { MOE_GEMM1(1); SEAM(17); STAMP(17); }
    if (IN(18)) { MOE_GEMM2(1); SEAM(18); STAMP(18); }
    if (IN(19)) { phase_final(C); STAMP(19); }
#if MK_PROBE
    if (blockIdx.x == 0 && C.wave == 0 && lane_id_now() == 0) {
        volatile LAS unsigned long long* ts_ = (volatile LAS unsigned long long*)(C.lds + LDS_MISC + 64);
        ts_[8] = ts_[7]; ts_[17] = ts_[16];
        const unsigned long long tA = ts_[PROBE_A_HI + 1] - ts_[PROBE_A_LO], tB = ts_[PROBE_B_HI + 1] - ts_[PROBE_B_LO];
        const unsigned long long spin = 16ull * tA + 1000000ull * ((tB + 500ull) / 1000ull);
        const unsigned long long t0 = __builtin_amdgcn_s_memrealtime();
        while (__builtin_amdgcn_s_memrealtime() - t0 < spin) __builtin_amdgcn_s_sleep(8);
    }
#endif
#undef IN
#undef SEAM
}

extern "C" void kernel_launch(void* const* d_in, const int* in_sizes, int n_in, void* d_out, int out_size, void* d_ws, size_t ws_size, hipStream_t stream) {
    constexpr int LDS_BYTES = 147456;
    static int grid = 0;
    if (grid == 0) {
        if (n_in != 35 || out_size != TL * D || ws_size < WS_END) { fprintf(stderr, "kernel_launch: unexpected shapes (n_in %d out %d ws %zu)\n", n_in, out_size, ws_size); grid = -1; return; }
        int dev = 0, cus = 0;
        if (hipGetDevice(&dev) != hipSuccess || hipDeviceGetAttribute(&cus, hipDeviceAttributeMultiprocessorCount, dev) != hipSuccess) { grid = -1; return; }
        if (hipFuncSetAttribute((const void*)fwd_kernel, hipFuncAttributeMaxDynamicSharedMemorySize, LDS_BYTES) != hipSuccess) { fprintf(stderr, "kernel_launch: hipFuncSetAttribute failed\n"); grid = -1; return; }
        (void)hipGetLastError();
        grid = cus;
    }
    if (grid < 0) return;
    (void)hipMemsetAsync((char*)d_ws + WS_CTL, 0, CTL_BYTES, stream);
    Params p{};
    for (int i = 0; i < 35; ++i) p.in[i] = (const float*)d_in[i];
    p.out = (float*)d_out; p.ws = (unsigned char*)d_ws;
#if MK_ONE_LAUNCH
    p.ph_lo = 0; p.ph_hi = NPHASE;
    hipLaunchKernelGGL(fwd_kernel, dim3(grid), dim3(NTHR), LDS_BYTES, stream, p);
#else
    for (int k = 0; k < NPHASE; ++k) { p.ph_lo = k; p.ph_hi = k + 1; hipLaunchKernelGGL(fwd_kernel, dim3(grid), dim3(NTHR), LDS_BYTES, stream, p); }
#endif
}
```

```cpp
#include <hip/hip_runtime.h>
#include <cstdio>
#include <cstdint>
#include <type_traits>

#ifndef MK_ONE_LAUNCH
#define MK_ONE_LAUNCH 1
#endif
#ifndef MK_SIMPLE_ORDER
#define MK_SIMPLE_ORDER 0
#endif
#ifndef MK_KROT
#define MK_KROT 0
#endif
#ifndef MK_PROBE
#define MK_PROBE 0
#endif
#define PROBE_A_LO 4
#define PROBE_A_HI 4
#define PROBE_B_LO 8
#define PROBE_B_HI 9

constexpr int D = 1024, NB = 16, SEQ = 2048, CTXL = 256;
constexpr int TL = NB * SEQ, TC = NB * CTXL, TT = TL + TC;
constexpr int KVL = CTXL + SEQ;
constexpr int MIXW = 1792, NEXP = 32, EH = 512;
constexpr int NSLOT = 81920;
constexpr float EPS = 1e-6f;
constexpr float QSCALE = 0.125f * 1.4426950408889634f;
constexpr int NTHR = 512, NWAVE = 8;
constexpr float W13_SCALE = 32.f;
constexpr float G_SCALE = 8.f;
constexpr float O_SCALE = 64.f;
constexpr int OGP = 1536;
constexpr float Y_SCALE = 16.f;
constexpr int NPHASE = 20;

constexpr size_t MiB = 1u << 20;
constexpr size_t WS_CTL = 0, CTL_BYTES = 40960;
constexpr size_t WS_MOD = 1 * MiB;
constexpr size_t WS_TAB = 2 * MiB;
constexpr size_t TAB_ROPE = 0, TAB_LAMB = 16384, TAB_BBAR = 65536, TAB_WR = 640 * 1024;
constexpr size_t WS_ROUTE = 3 * MiB;
constexpr size_t RT_E = 0, RT_P = 320 * 1024, RT_W = 640 * 1024, RT_S = 960 * 1024, RT_TILE = 1280 * 1024, RT_NT = 1280 * 1024 + 4096;
constexpr size_t WS_WIN0 = 6 * MiB, WS_WOUT0 = 10 * MiB, WS_WS5IN = 12 * MiB, WS_WGLU = 13 * MiB, WS_WS5OUT = 14 * MiB;
constexpr size_t WS_WSP = 15 * MiB;
constexpr size_t WS_W13 = 16 * MiB, WS_W2 = 80 * MiB;
constexpr size_t WS_W13B = 184 * MiB, WS_W2B = 216 * MiB;
constexpr int L0_A = 4096, L0_B = L0_A + 0;
constexpr int P0_SPLIT = 3072;
constexpr int L1_A = 1024, L1_P9 = L1_A + 1536, L1_B = L1_P9 + 1536, L1_C = L1_B + 10240, L1_D = L1_C + 10240;
constexpr size_t WS_XC = 112 * MiB;
constexpr size_t WS_H = 256 * MiB;
constexpr size_t WS_P = 328 * MiB;
constexpr size_t WS_Q = 454 * MiB, WS_K = 490 * MiB, WS_V = 499 * MiB;
constexpr size_t WS_XS = 328 * MiB;
constexpr size_t WS_G13 = 488 * MiB;
constexpr size_t WS_U = 328 * MiB, WS_GS = 364 * MiB, WS_GG = 396 * MiB, WS_YACC = 428 * MiB;
constexpr size_t WS_LIST = 568 * MiB;
constexpr int LCAP = 36864;
constexpr size_t WS_END = 574 * MiB;
constexpr int CW_CNT = 8192, CW_CNT_L = 1024, CW_CNT_S = 32;
constexpr int CW_BAR = 4096;

__device__ __forceinline__ int lane_id_now() { int l; asm volatile("v_mbcnt_lo_u32_b32 %0, -1, 0\n\tv_mbcnt_hi_u32_b32 %0, -1, %0\n\ts_nop 0" : "=v"(l)); return l; }
#define STAMP_AT(idx) do { if (MK_PROBE && blockIdx.x == 0 && C.wave == 0 && lane_id_now() == 0) ((volatile __attribute__((address_space(3))) unsigned long long*)(C.lds + 147456 - 512 + 64))[idx] = __builtin_amdgcn_s_memrealtime(); } while (0)
#define LAS __attribute__((address_space(3)))
typedef unsigned short bf16;
typedef unsigned v4u __attribute__((ext_vector_type(4)));
typedef unsigned v2u __attribute__((ext_vector_type(2)));
typedef float f32x4 __attribute__((ext_vector_type(4)));
typedef float f32x2 __attribute__((ext_vector_type(2)));
__device__ __forceinline__ float bf2f(unsigned u) { return __uint_as_float(u << 16); }
typedef __bf16 bf16x2_t __attribute__((ext_vector_type(2)));
__device__ __forceinline__ unsigned pk2(float lo, float hi) { const f32x2 v = {lo, hi}; return __builtin_bit_cast(unsigned, __builtin_convertvector(v, bf16x2_t)); }
__device__ __forceinline__ unsigned f2bf(float f) { return pk2(f, 0.f) & 0xffffu; }
__device__ __forceinline__ float wave_sum(float v) {
#pragma unroll
    for (int o = 1; o < 64; o <<= 1) v += __shfl_xor(v, o);
    return v;
}
__device__ __forceinline__ float wave_max(float v) {
#pragma unroll
    for (int o = 1; o < 64; o <<= 1) v = fmaxf(v, __shfl_xor(v, o));
    return v;
}
__device__ __forceinline__ float gelu_tanh(float x) { const float u2 = -1.5957691216057308f * (x + 0.044715f * x * x * x); return x * __builtin_amdgcn_rcpf(1.f + __expf(u2)); }
__device__ __forceinline__ float sigmoidf_(float x) { return 1.f / (1.f + __expf(-x)); }
__device__ __forceinline__ float silu_(float x) { return x / (1.f + __expf(-x)); }
__device__ __forceinline__ void unpack8(const v4u w, float* f) {
    f[0] = bf2f(w.x & 0xffffu); f[1] = bf2f(w.x >> 16); f[2] = bf2f(w.y & 0xffffu); f[3] = bf2f(w.y >> 16);
    f[4] = bf2f(w.z & 0xffffu); f[5] = bf2f(w.z >> 16); f[6] = bf2f(w.w & 0xffffu); f[7] = bf2f(w.w >> 16);
}

#define XB_TMO      128
#define XB_XCNT(j)  (256  + 64 * (j))
#define XB_XSUB(j)  (1280 + 64 * (j))
#define XB_XGEN(j)  (2304 + 64 * (j))
#define XB_TOP      3328
#define XB_TOPGEN   3392
#define XCD_BAR_WORDS 3456
#define XB_SPIN_CAP (1u << 28)
__device__ __forceinline__ unsigned xb_ld(unsigned* p)              { return __hip_atomic_load(p, __ATOMIC_RELAXED, __HIP_MEMORY_SCOPE_AGENT); }
__device__ __forceinline__ unsigned xb_add(unsigned* p, unsigned v) { return __hip_atomic_fetch_add(p, v, __ATOMIC_RELAXED, __HIP_MEMORY_SCOPE_AGENT); }
__device__ __forceinline__ unsigned xb_xcc_id() { return (unsigned)__builtin_amdgcn_s_getreg((3 << 11) | 20) & 0xFu; }
#define XB_SPIN(cond, bar) do { unsigned _sp = 0; while (cond) { __builtin_amdgcn_s_sleep(1); \
    if ((++_sp & 255u) == 0u) { if (xb_ld(&(bar)[XB_TMO])) break; if (_sp > XB_SPIN_CAP) { atomicAdd(&(bar)[XB_TMO], 1u); break; } } } } while (0)
struct XcdBarrier { unsigned* bar; unsigned x; volatile LAS unsigned* st; };
__device__ __forceinline__ XcdBarrier xcd_barrier_post(unsigned* bar, volatile LAS unsigned* st) {
    XcdBarrier b; b.bar = bar; b.x = xb_xcc_id(); b.st = st;
    if (threadIdx.x == 0) (void)xb_add(&bar[XB_XCNT(b.x)], 1u);
    return b;
}
__device__ __forceinline__ void xcd_barrier_complete(unsigned* bar, unsigned x, unsigned& nloc, unsigned& nx) {
    const unsigned G = gridDim.x * gridDim.y * gridDim.z;
    unsigned sum, cnt, mine, sp = 0u;
    for (;;) {
        sum = 0u; cnt = 0u; mine = 0u;
#pragma unroll
        for (unsigned j = 0; j < 16; ++j) { const unsigned c = xb_ld(&bar[XB_XCNT(j)]); sum += c; cnt += (c > 0u) ? 1u : 0u; mine = (j == x) ? c : mine; }
        if (sum == G) break;
        __builtin_amdgcn_s_sleep(1);
        if ((++sp & 255u) == 0u) { if (xb_ld(&bar[XB_TMO])) break; if (sp > XB_SPIN_CAP) { atomicAdd(&bar[XB_TMO], 1u); break; } }
    }
    nloc = mine > 0u ? mine : 1u; nx = cnt > 0u ? cnt : 1u;
}
__device__ __forceinline__ void xcd_barrier(const XcdBarrier& b) {
    asm volatile("s_waitcnt vmcnt(0)" ::: "memory");
    __syncthreads();
    if (threadIdx.x == 0) {
        unsigned* bar = b.bar;
        __builtin_amdgcn_s_waitcnt(0);
        unsigned nloc = b.st[0], nx = b.st[1];
        if (nloc == 0u) { xcd_barrier_complete(bar, b.x, nloc, nx); b.st[0] = nloc; b.st[1] = nx; }
        const unsigned old = xb_add(&bar[XB_XSUB(b.x)], 1u);
        const unsigned gen = old / nloc;
        if (old + 1u == (gen + 1u) * nloc) {
            __builtin_amdgcn_fence(__ATOMIC_RELEASE, "agent");
            asm volatile("s_waitcnt vmcnt(0)" ::: "memory");
            const unsigned og = xb_add(&bar[XB_TOP], 1u);
            const unsigned tg = og / nx;
            if (og + 1u == (tg + 1u) * nx) xb_add(&bar[XB_TOPGEN], 1u);
            else XB_SPIN(xb_ld(&bar[XB_TOPGEN]) == tg, bar);
            __builtin_amdgcn_fence(__ATOMIC_ACQUIRE, "agent");
            xb_add(&bar[XB_XGEN(b.x)], 1u);
            asm volatile("s_waitcnt vmcnt(0)" ::: "memory");
        } else {
            XB_SPIN(xb_ld(&bar[XB_XGEN(b.x)]) == gen, bar);
            __builtin_amdgcn_fence(__ATOMIC_ACQUIRE, "agent");
            asm volatile("s_waitcnt vmcnt(0)" ::: "memory");
        }
    }
    __syncthreads();
}

namespace pg8 {
#define PG8_LAS __attribute__((address_space(3)))
typedef unsigned short bf16_t;
typedef short bf16x8 __attribute__((ext_vector_type(8)));
typedef float f32x4 __attribute__((ext_vector_type(4)));
typedef unsigned u32x4 __attribute__((ext_vector_type(4)));
typedef int i32x4 __attribute__((ext_vector_type(4)));
typedef unsigned u32x2 __attribute__((ext_vector_type(2)));
constexpr int BM = 256, BK = 64, HALF = 128, HTB = HALF * BK * 2  , STAGE_BYTES = 8 * HTB, NXCD = 8, WGM = 8;

__host__ __device__ __forceinline__ int lds_byte(int r, int c) { const int st = (r >> 4) * 2 + (c >> 5), rr = r & 15, cc = c & 31, ob = rr * 64 + cc * 2; return st * 1024 + (ob ^ (((ob >> 9) & 1) << 5)); }
__host__ __device__ __forceinline__ void stage_rc(int b, int& R, int& C) { const int st = b / 1024, sb = b % 1024, swz = sb ^ (((sb >> 9) & 1) << 5); R = (st >> 1) * 16 + swz / 64; C = (st & 1) * 32 + (swz % 64) / 2; }
__host__ __device__ __forceinline__ int perm32(int rho) { const int n = rho >> 4, i = rho & 15; return 8 * (i >> 2) + 4 * n + (i & 3); }

struct Unit { int pm, pn; size_t bo; int aux; int half; };
struct Gemm { const bf16_t* A; const bf16_t* Bt; int M, N, K; };

template <bool HALVES>
struct StaticOrderT {
    static constexpr bool GATHER = false;
    int nM, nN, nwg, G, c, halves;
    __host__ __device__ void init(int M, int N, int G_, int c_, int halves_ = 0) { nM = M / BM; nN = N / BM; nwg = nM * nN; G = G_; c = c_; halves = HALVES && halves_ && (G_ & 15) == 0; }
    __host__ __device__ bool next(int i, Unit& u) const {
        long L = (long)i * G + c; u.half = 0;
        if (HALVES && halves) { const int il = nwg / G, rem = nwg - il * G; if (i == il && rem > 0 && 2 * rem <= G) { const int j = (c >> 4) * 8 + (c & 7); if (j >= rem) return false; L = (long)il * G + j; u.half = 1 + ((c >> 3) & 1); } }
        if (L >= nwg) return false;
        if (MK_SIMPLE_ORDER) { u.pm = (int)L / nN; u.pn = (int)L % nN; u.bo = 0; u.aux = 0; return true; }
        int wgid = (int)L; { const int q = nwg / NXCD, r = nwg % NXCD, xcd = wgid % NXCD, off = wgid / NXCD; wgid = (xcd < r ? xcd * (q + 1) : r * (q + 1) + (xcd - r) * q) + off; }
        const int nig = WGM * nN, gid = wgid / nig, fm = gid * WGM, gsz = (nM - fm) < WGM ? (nM - fm) : WGM;
        u.pm = fm + ((wgid % nig) % gsz); u.pn = (wgid % nig) / gsz; u.bo = 0; u.aux = 0; return true;
    }
    __device__ __forceinline__ void a_ready(const Unit&) const {}
    __device__ __forceinline__ void done(const Unit&) const {}
};
typedef StaticOrderT<false> StaticOrder; typedef StaticOrderT<true> StaticOrderH;

typedef __bf16 bf16x2_c __attribute__((ext_vector_type(2))); typedef float f32x2_c __attribute__((ext_vector_type(2)));
__device__ __forceinline__ unsigned cvt_pk_bf16(float lo, float hi) { const f32x2_c v = {lo, hi}; return __builtin_bit_cast(unsigned, __builtin_convertvector(v, bf16x2_c)); }
typedef float f32x2 __attribute__((ext_vector_type(2)));
__device__ __forceinline__ f32x2 gelu_pk(f32x2 v) {
    const f32x2 av = __builtin_elementwise_abs(v), d = av * 0.2316418882f + 1.0f;
    f32x2 t; t.x = __builtin_amdgcn_rcpf(d.x); t.y = __builtin_amdgcn_rcpf(d.y);
    f32x2 q = t * 0.5307027145f + (-0.7265760135f); q = q * t + 0.7107068705f; q = q * t + (-0.142248368f); q = q * t + 0.127414796f; q = q * t;
    const f32x2 s = (v * v) * (-0.72134752044f);
    f32x2 e; e.x = __builtin_amdgcn_exp2f(s.x); e.y = __builtin_amdgcn_exp2f(s.y);
    const f32x2 m = v * (q * e), r = v - m;
    f32x2 o; o.x = v.x < 0.f ? m.x : r.x; o.y = v.y < 0.f ? m.y : r.y; return o;
}

template <class Epi, class Sched, bool ALIGN_EPI = false, bool SP2 = false, bool KROT = false, bool FP8 = false, int MIX = 0>
__device__ __forceinline__ void gemm_phase(PG8_LAS unsigned char* lds, const Gemm g, const Sched& S, const Epi& E, const int wave_id) {
    const int wid = __builtin_amdgcn_readfirstlane(wave_id), lane = lane_id_now(), tid = wid * 64 + lane, wr = wid >> 2, wc = wid & 3, fr = lane & 15, fq = lane >> 4;
    const int K = g.K, nt = K / BK;
    const int kmask = nt - 1, rot = (MK_KROT && KROT) ? (int)((blockIdx.x * 3u + (blockIdx.x >> 3)) & (unsigned)kmask) : 0;
#define PG8_KO(j) ((size_t)((MK_KROT && KROT) ? (((j) + rot) & kmask) : (j)) * kstep)
    unsigned voffA[2], voffB[2];
    unsigned vC[2][2], vN[2][2];
#pragma unroll
    for (int i = 0; i < 2; ++i) { int R, C; stage_rc(tid * 16 + i * 8192, R, C); const int Rb = Epi::PERM ? ((R & ~31) + perm32(R & 31)) : R;
        voffA[i] = (unsigned)(R * K + C) * 2u; voffB[i] = (unsigned)(Rb * K + C) * 2u; }
    const size_t kstep = (size_t)(BK * 2);
    const size_t hstep = (size_t)HALF * K * 2;
    const size_t tstep = 2 * hstep;
    const unsigned ldsw = (unsigned)wid * 1024u;
    const int aoff = lds_byte(wr * 64 + fr, fq * 8), boff = lds_byte(wc * 32 + fr, fq * 8);
#define PG8_SA(b, h) (((b) * 2 + (h)) * HTB)
#define PG8_SB(b, h) ((4 + (b) * 2 + (h)) * HTB)
#define PG8_STAGE(bufoff, gbase, voff) do { _Pragma("unroll") for (int _i = 0; _i < 2; ++_i) \
        __builtin_amdgcn_global_load_lds((const unsigned*)((const char*)(gbase) + (voff)[_i]), (PG8_LAS unsigned*)(lds + (bufoff) + ldsw + _i * 8192), 16, 0, 0); } while (0)
#define PG8_STAGE_A(bufoff, gbase, h, nx) do { _Pragma("unroll") for (int _i = 0; _i < 2; ++_i) { \
        const unsigned _vo = Sched::GATHER ? ((nx) ? vN[h][_i] : vC[h][_i]) : voffA[_i]; \
        __builtin_amdgcn_global_load_lds((const unsigned*)((const char*)(gbase) + (Sched::GATHER ? (size_t)0 : (size_t)(h) * hstep) + _vo), (PG8_LAS unsigned*)(lds + (bufoff) + ldsw + _i * 8192), 16, 0, 0); } } while (0)
#define PG8_LDA(dst, b, h) do { _Pragma("unroll") for (int m = 0; m < 4; ++m) { if constexpr (FP8 || MIX > 0) { dst[m].lo = *(const PG8_LAS i32x4*)(lds + PG8_SA(b, h) + aoff + m * 2048); dst[m].hi = *(const PG8_LAS i32x4*)(lds + PG8_SA(b, h) + aoff + m * 2048 + 1024); } \
        else { _Pragma("unroll") for (int k = 0; k < 2; ++k) dst[m][k] = *(const PG8_LAS bf16x8*)(lds + PG8_SA(b, h) + aoff + m * 2048 + k * 1024); } } } while (0)
#define PG8_LDB(dst, b, h) do { _Pragma("unroll") for (int n = 0; n < 2; ++n) { if constexpr (FP8 || MIX > 0) { dst[n].lo = *(const PG8_LAS i32x4*)(lds + PG8_SB(b, h) + boff + n * 2048); dst[n].hi = *(const PG8_LAS i32x4*)(lds + PG8_SB(b, h) + boff + n * 2048 + 1024); } \
        else { _Pragma("unroll") for (int k = 0; k < 2; ++k) dst[n][k] = *(const PG8_LAS bf16x8*)(lds + PG8_SB(b, h) + boff + n * 2048 + k * 1024); } } } while (0)
#define PG8_CAT(x0, x1) __builtin_shufflevector(__builtin_bit_cast(i32x4, x0), __builtin_bit_cast(i32x4, x1), 0, 1, 2, 3, 4, 5, 6, 7)
#define PG8_MMA(ai, bj, At, Bt) do { __builtin_amdgcn_s_setprio(1); \
        if constexpr (FP8) { _Pragma("unroll") for (int m = 0; m < 4; ++m) _Pragma("unroll") for (int n = 0; n < 2; ++n) \
            acc[ai][bj][m][n] = __builtin_amdgcn_mfma_scale_f32_16x16x128_f8f6f4(Bt[n], At[m], acc[ai][bj][m][n], 0, 0, 0, 127, 0, 127); } \
        if constexpr (FP8) { asm volatile("" : "+v"(acc[ai][bj][0][0]), "+v"(acc[ai][bj][0][1]), "+v"(acc[ai][bj][1][0]), "+v"(acc[ai][bj][1][1]), "+v"(acc[ai][bj][2][0]), "+v"(acc[ai][bj][2][1]), "+v"(acc[ai][bj][3][0]), "+v"(acc[ai][bj][3][1])); }     \
        else if constexpr (MIX > 0) {     \
          if constexpr (mixf8) { _Pragma("unroll") for (int m = 0; m < 4; ++m) _Pragma("unroll") for (int n = 0; n < 2; ++n) \
                acc[ai][bj][m][n] = __builtin_amdgcn_mfma_scale_f32_16x16x128_f8f6f4(Bt[n], At[m], acc[ai][bj][m][n], 0, 0, 0, 127, 0, 127); \
              asm volatile("" : "+v"(acc[ai][bj][0][0]), "+v"(acc[ai][bj][0][1]), "+v"(acc[ai][bj][1][0]), "+v"(acc[ai][bj][1][1]), "+v"(acc[ai][bj][2][0]), "+v"(acc[ai][bj][2][1]), "+v"(acc[ai][bj][3][0]), "+v"(acc[ai][bj][3][1])); } \
          else { _Pragma("unroll") for (int m = 0; m < 4; ++m) _Pragma("unroll") for (int n = 0; n < 2; ++n) { \
                const i32x4 bl_ = Bt[n].lo, bh_ = Bt[n].hi, al_ = At[m].lo, ah_ = At[m].hi;     \
                acc[ai][bj][m][n] = __builtin_amdgcn_mfma_f32_16x16x32_bf16(__builtin_bit_cast(bf16x8, bl_), __builtin_bit_cast(bf16x8, al_), acc[ai][bj][m][n], 0, 0, 0); \
                acc[ai][bj][m][n] = __builtin_amdgcn_mfma_f32_16x16x32_bf16(__builtin_bit_cast(bf16x8, bh_), __builtin_bit_cast(bf16x8, ah_), acc[ai][bj][m][n], 0, 0, 0); } } } \
        else { _Pragma("unroll") for (int m = 0; m < 4; ++m) _Pragma("unroll") for (int n = 0; n < 2; ++n) _Pragma("unroll") for (int k = 0; k < 2; ++k) \
            acc[ai][bj][m][n] = __builtin_amdgcn_mfma_f32_16x16x32_bf16(Bt[n][k], At[m][k], acc[ai][bj][m][n], 0, 0, 0); } \
        __builtin_amdgcn_s_setprio(0); } while (0)
#define PG8_WAIT_V(n) asm volatile("s_waitcnt vmcnt(" #n ")" ::: "memory")
#define PG8_WAIT_L(n) asm volatile("s_waitcnt lgkmcnt(" #n ")" ::: "memory")
#define PG8_BAR __builtin_amdgcn_s_barrier()
#define PG8_SCHED __builtin_amdgcn_sched_barrier(0)
    Unit cur, nxt; int ui = 0;
    if (!S.next(0, cur)) return;
    f32x4 acc[2][2][4][2];
#pragma unroll
    for (int a = 0; a < 2; ++a)
#pragma unroll
        for (int b = 0; b < 2; ++b)
#pragma unroll
            for (int m = 0; m < 4; ++m)
#pragma unroll
                for (int n = 0; n < 2; ++n) acc[a][b][m][n] = (f32x4){0.f, 0.f, 0.f, 0.f};
    typedef int i32x8 __attribute__((ext_vector_type(8)));
    typedef int i32x8 __attribute__((ext_vector_type(8)));
    typename std::conditional<(FP8 || MIX > 0), i32x8[4], bf16x8[4][2]>::type At; typename std::conditional<(FP8 || MIX > 0), i32x8[2], bf16x8[2][2]>::type B0, B1;
    const char* cA = (const char*)g.A + (Sched::GATHER ? (size_t)0 : (size_t)cur.pm * tstep); const char* cB = (const char*)g.Bt + cur.bo + (size_t)cur.pn * tstep;
    S.a_ready(cur);
#define PG8_VOFF(dst, un) do { _Pragma("unroll") for (int _h = 0; _h < 2; ++_h) _Pragma("unroll") for (int _i = 0; _i < 2; ++_i) { int R_, C_; stage_rc(tid * 16 + _i * 8192, R_, C_); dst[_h][_i] = S.a_off(un, _h * HALF + R_) + (unsigned)C_ * 2u; } } while (0)
    if constexpr (Sched::GATHER) { PG8_VOFF(vC, cur); }
    if constexpr (SP2) {
        PG8_STAGE(PG8_SB(0, 0), cB + PG8_KO(0), voffB); PG8_STAGE(PG8_SB(0, 1), cB + hstep + PG8_KO(0), voffB); PG8_STAGE_A(PG8_SA(0, 0), cA + PG8_KO(0), 0, false); PG8_STAGE_A(PG8_SA(0, 1), cA + PG8_KO(0), 1, false);
        if (wr == 1) PG8_BAR;
        PG8_WAIT_V(2); PG8_BAR;
        PG8_STAGE(PG8_SB(1, 0), cB + PG8_KO(1), voffB); PG8_STAGE_A(PG8_SA(1, 0), cA + PG8_KO(1), 0, false); PG8_STAGE(PG8_SB(1, 1), cB + hstep + PG8_KO(1), voffB);
        PG8_WAIT_V(6); PG8_BAR;
    } else {
        PG8_STAGE(PG8_SB(0, 0), cB, voffB); PG8_STAGE_A(PG8_SA(0, 0), cA, 0, false); PG8_STAGE(PG8_SB(0, 1), cB + hstep, voffB); PG8_STAGE_A(PG8_SA(0, 1), cA, 1, false);
        if (wr == 1) PG8_BAR;
        PG8_WAIT_V(4); PG8_BAR;
        PG8_STAGE(PG8_SB(1, 0), cB + PG8_KO(1), voffB); PG8_STAGE_A(PG8_SA(1, 0), cA + PG8_KO(1), 0, false); PG8_STAGE(PG8_SB(1, 1), cB + hstep + PG8_KO(1), voffB);
        PG8_WAIT_V(6); PG8_BAR;
    }
    for (;;) {
        const bool has_next = S.next(ui + 1, nxt);
        if constexpr (Sched::GATHER) { if (has_next) { PG8_VOFF(vN, nxt); } else { vN[0][0] = vC[0][0]; vN[0][1] = vC[0][1]; vN[1][0] = vC[1][0]; vN[1][1] = vC[1][1]; } }
        const char* nA = (has_next && !Sched::GATHER) ? (const char*)g.A + (size_t)nxt.pm * tstep : cA; const char* nB = has_next ? (const char*)g.Bt + nxt.bo + (size_t)nxt.pn * tstep : cB;
        const bool mh0 = cur.half != 2, mh1 = cur.half != 1;
        if constexpr (MIX > 0) {
        auto kiter = [&](const int t, auto f8c) __attribute__((always_inline)) {
            const bool last = (t == nt - 2); constexpr bool mixf8 = decltype(f8c)::value; (void)mixf8;
            const char* a1 = cA + PG8_KO(t + 1);
            const char* a2 = last ? nA + PG8_KO(0) : cA + PG8_KO(t + 2); const char* b2 = last ? nB + PG8_KO(0) : cB + PG8_KO(t + 2);
            const char* a3 = last ? nA + PG8_KO(1) : cA + PG8_KO(t + 3); const char* b3 = last ? nB + PG8_KO(1) : cB + PG8_KO(t + 3);
            if (last && has_next) S.a_ready(nxt);
            if constexpr (SP2) {
            PG8_LDB(B0, 0, 0); PG8_LDB(B1, 0, 1); PG8_SCHED; PG8_LDA(At, 0, 0); PG8_STAGE_A(PG8_SA(1, 1), a1, 1, false);
            PG8_WAIT_V(8); PG8_WAIT_L(0); PG8_BAR; if (mh0) PG8_MMA(0, 0, At, B0); if (mh0) PG8_MMA(0, 1, At, B1); PG8_BAR; PG8_SCHED;
            PG8_LDA(At, 0, 1); PG8_STAGE(PG8_SB(0, 0), b2, voffB); PG8_STAGE(PG8_SB(0, 1), b2 + hstep, voffB); PG8_STAGE_A(PG8_SA(0, 0), a2, 0, last);
            PG8_WAIT_V(8); PG8_WAIT_L(0); PG8_BAR; if (mh1) PG8_MMA(1, 0, At, B0); if (mh1) PG8_MMA(1, 1, At, B1); PG8_BAR; PG8_SCHED;
            PG8_LDB(B0, 1, 0); PG8_LDB(B1, 1, 1); PG8_SCHED; PG8_LDA(At, 1, 0); PG8_STAGE_A(PG8_SA(0, 1), a2, 1, last);
            PG8_WAIT_V(8); PG8_WAIT_L(0); PG8_BAR; if (mh0) PG8_MMA(0, 0, At, B0); if (mh0) PG8_MMA(0, 1, At, B1); PG8_BAR; PG8_SCHED;
            PG8_LDA(At, 1, 1); PG8_STAGE(PG8_SB(1, 0), b3, voffB); PG8_STAGE(PG8_SB(1, 1), b3 + hstep, voffB); PG8_STAGE_A(PG8_SA(1, 0), a3, 0, last);
            PG8_WAIT_V(8); PG8_WAIT_L(0); PG8_BAR; if (mh1) PG8_MMA(1, 0, At, B0); if (mh1) PG8_MMA(1, 1, At, B1); PG8_BAR; PG8_SCHED;
            } else {
            PG8_LDB(B0, 0, 0); PG8_SCHED; PG8_LDA(At, 0, 0); PG8_STAGE_A(PG8_SA(1, 1), a1, 1, false);
            PG8_WAIT_L(8); PG8_BAR; PG8_WAIT_L(0); if (mh0) PG8_MMA(0, 0, At, B0); PG8_BAR; PG8_SCHED;
            PG8_LDB(B1, 0, 1); PG8_STAGE(PG8_SB(0, 0), b2, voffB);
            PG8_BAR; PG8_WAIT_L(0); if (mh0) PG8_MMA(0, 1, At, B1); PG8_BAR;
            PG8_LDA(At, 0, 1); PG8_STAGE_A(PG8_SA(0, 0), a2, 0, last);
            PG8_BAR; PG8_WAIT_L(0); if (mh1) PG8_MMA(1, 0, At, B0); PG8_BAR; PG8_SCHED;
            PG8_STAGE(PG8_SB(0, 1), b2 + hstep, voffB);
            PG8_WAIT_V(6); PG8_BAR; if (mh1) PG8_MMA(1, 1, At, B1); PG8_BAR;
            PG8_LDB(B0, 1, 0); PG8_SCHED; PG8_LDA(At, 1, 0); PG8_STAGE_A(PG8_SA(0, 1), a2, 1, last);
            PG8_WAIT_L(8); PG8_BAR; PG8_WAIT_L(0); if (mh0) PG8_MMA(0, 0, At, B0); PG8_BAR; PG8_SCHED;
            PG8_LDB(B1, 1, 1); PG8_STAGE(PG8_SB(1, 0), b3, voffB);
            PG8_BAR; PG8_WAIT_L(0); if (mh0) PG8_MMA(0, 1, At, B1); PG8_BAR;
            PG8_LDA(At, 1, 1); PG8_STAGE_A(PG8_SA(1, 0), a3, 0, last);
            PG8_BAR; PG8_WAIT_L(0); if (mh1) PG8_MMA(1, 0, At, B0); PG8_BAR; PG8_SCHED;
            PG8_STAGE(PG8_SB(1, 1), b3 + hstep, voffB);
            PG8_WAIT_V(6); PG8_BAR; if (mh1) PG8_MMA(1, 1, At, B1); PG8_BAR;
            }
                };
#pragma unroll 1
            for (int t = 0; t < MIX; t += 2) kiter(t, std::true_type{});
#pragma unroll 1
            for (int t = MIX; t < nt; t += 2) kiter(t, std::false_type{});
        } else {
#pragma unroll 1
        for (int t = 0; t < nt; t += 2) {
            const bool last = (t == nt - 2); constexpr bool mixf8 = false; (void)mixf8;
            const char* a1 = cA + PG8_KO(t + 1);
            const char* a2 = last ? nA + PG8_KO(0) : cA + PG8_KO(t + 2); const char* b2 = last ? nB + PG8_KO(0) : cB + PG8_KO(t + 2);
            const char* a3 = last ? nA + PG8_KO(1) : cA + PG8_KO(t + 3); const char* b3 = last ? nB + PG8_KO(1) : cB + PG8_KO(t + 3);
            if (last && has_next) S.a_ready(nxt);
            if constexpr (SP2) {
            PG8_LDB(B0, 0, 0); PG8_LDB(B1, 0, 1); PG8_SCHED; PG8_LDA(At, 0, 0); PG8_STAGE_A(PG8_SA(1, 1), a1, 1, false);
            PG8_WAIT_V(8); PG8_WAIT_L(0); PG8_BAR; if (mh0) PG8_MMA(0, 0, At, B0); if (mh0) PG8_MMA(0, 1, At, B1); PG8_BAR; PG8_SCHED;
            PG8_LDA(At, 0, 1); PG8_STAGE(PG8_SB(0, 0), b2, voffB); PG8_STAGE(PG8_SB(0, 1), b2 + hstep, voffB); PG8_STAGE_A(PG8_SA(0, 0), a2, 0, last);
            PG8_WAIT_V(8); PG8_WAIT_L(0); PG8_BAR; if (mh1) PG8_MMA(1, 0, At, B0); if (mh1) PG8_MMA(1, 1, At, B1); PG8_BAR; PG8_SCHED;
            PG8_LDB(B0, 1, 0); PG8_LDB(B1, 1, 1); PG8_SCHED; PG8_LDA(At, 1, 0); PG8_STAGE_A(PG8_SA(0, 1), a2, 1, last);
            PG8_WAIT_V(8); PG8_WAIT_L(0); PG8_BAR; if (mh0) PG8_MMA(0, 0, At, B0); if (mh0) PG8_MMA(0, 1, At, B1); PG8_BAR; PG8_SCHED;
            PG8_LDA(At, 1, 1); PG8_STAGE(PG8_SB(1, 0), b3, voffB); PG8_STAGE(PG8_SB(1, 1), b3 + hstep, voffB); PG8_STAGE_A(PG8_SA(1, 0), a3, 0, last);
            PG8_WAIT_V(8); PG8_WAIT_L(0); PG8_BAR; if (mh1) PG8_MMA(1, 0, At, B0); if (mh1) PG8_MMA(1, 1, At, B1); PG8_BAR; PG8_SCHED;
            } else {
            PG8_LDB(B0, 0, 0); PG8_SCHED; PG8_LDA(At, 0, 0); PG8_STAGE_A(PG8_SA(1, 1), a1, 1, false);
            PG8_WAIT_L(8); PG8_BAR; PG8_WAIT_L(0); if (mh0) PG8_MMA(0, 0, At, B0); PG8_BAR; PG8_SCHED;
            PG8_LDB(B1, 0, 1); PG8_STAGE(PG8_SB(0, 0), b2, voffB);
            PG8_BAR; PG8_WAIT_L(0); if (mh0) PG8_MMA(0, 1, At, B1); PG8_BAR;
            PG8_LDA(At, 0, 1); PG8_STAGE_A(PG8_SA(0, 0), a2, 0, last);
            PG8_BAR; PG8_WAIT_L(0); if (mh1) PG8_MMA(1, 0, At, B0); PG8_BAR; PG8_SCHED;
            PG8_STAGE(PG8_SB(0, 1), b2 + hstep, voffB);
            PG8_WAIT_V(6); PG8_BAR; if (mh1) PG8_MMA(1, 1, At, B1); PG8_BAR;
            PG8_LDB(B0, 1, 0); PG8_SCHED; PG8_LDA(At, 1, 0); PG8_STAGE_A(PG8_SA(0, 1), a2, 1, last);
            PG8_WAIT_L(8); PG8_BAR; PG8_WAIT_L(0); if (mh0) PG8_MMA(0, 0, At, B0); PG8_BAR; PG8_SCHED;
            PG8_LDB(B1, 1, 1); PG8_STAGE(PG8_SB(1, 0), b3, voffB);
            PG8_BAR; PG8_WAIT_L(0); if (mh0) PG8_MMA(0, 1, At, B1); PG8_BAR;
            PG8_LDA(At, 1, 1); PG8_STAGE_A(PG8_SA(1, 0), a3, 0, last);
            PG8_BAR; PG8_WAIT_L(0); if (mh1) PG8_MMA(1, 0, At, B0); PG8_BAR; PG8_SCHED;
            PG8_STAGE(PG8_SB(1, 1), b3 + hstep, voffB);
            PG8_WAIT_V(6); PG8_BAR; if (mh1) PG8_MMA(1, 1, At, B1); PG8_BAR;
            }
                }
        }
        if constexpr (ALIGN_EPI) { if (wr == 0) PG8_BAR; }
        if constexpr (!Epi::AFTER_DRAIN) { E(acc, cur, wr, wc, fr, fq); S.done(cur); }
        if (!has_next) break;
#pragma unroll
        for (int a = 0; a < 2; ++a)
#pragma unroll
            for (int b = 0; b < 2; ++b)
#pragma unroll
                for (int m = 0; m < 4; ++m)
#pragma unroll
                    for (int n = 0; n < 2; ++n) acc[a][b][m][n] = (f32x4){0.f, 0.f, 0.f, 0.f};
        cur = nxt; cA = nA; cB = nB; ++ui;
        if constexpr (Sched::GATHER) { vC[0][0] = vN[0][0]; vC[0][1] = vN[0][1]; vC[1][0] = vN[1][0]; vC[1][1] = vN[1][1]; }
        if constexpr (ALIGN_EPI) { if (wr == 1) PG8_BAR; }
    }
    PG8_WAIT_V(0);
    if constexpr (!ALIGN_EPI) { if (wr == 0) PG8_BAR; }
    PG8_BAR;
    if constexpr (Epi::AFTER_DRAIN) { E.fused(acc, cur, wr, wc, fr, fq, lds, wid, lane); S.done(cur); }
#undef PG8_VOFF
#undef PG8_KO
#undef PG8_SA
#undef PG8_SB
#undef PG8_STAGE
#undef PG8_STAGE_A
#undef PG8_LDA
#undef PG8_LDB
#undef PG8_MMA
#undef PG8_CAT
#undef PG8_WAIT_V
#undef PG8_WAIT_L
#undef PG8_BAR
#undef PG8_SCHED
}
}

namespace pg8 {
template <bool GATHER_>
struct GroupedOrder {
    static constexpr bool GATHER = GATHER_;
    const PG8_LAS int* tmap; const PG8_LAS int* cntl; const int* list; int nU, nN, G, c, lcap, rowbytes; size_t estride;
    __device__ __forceinline__ bool next(int i, Unit& u) const { const int ntl = nU / nN, n8 = (ntl + 7) >> 3, x = c & 7, t0 = x * n8; int nt = ntl - t0; nt = nt < 0 ? 0 : (nt > n8 ? n8 : nt);
        int v = (c >> 3) + (G >> 3) * i; u.half = 0;
        if (G == 256) { const int tot = nt * nN, fr = tot >> 5, rem = tot - (fr << 5); if (i == fr && rem > 0 && rem <= 16) { const int j = c >> 3; if ((j >> 1) >= rem) return false; v = (fr << 5) + (j >> 1); u.half = 1 + (j & 1); } }
        if ((G & 7) != 0 || v >= nt * nN) { if ((G & 7) == 0) return false; const long L = (long)i * G + c; if (L >= nU) return false; const int t_ = (int)L / nN; const int m_ = __builtin_amdgcn_readfirstlane(tmap[t_]); u.pm = t_; u.pn = (int)L % nN; u.bo = (size_t)(m_ & 255) * estride; u.aux = m_; return true; }
        const int t = t0 + v / nN; const int m = __builtin_amdgcn_readfirstlane(tmap[t]);
        u.pm = t; u.pn = v % nN; u.bo = (size_t)(m & 255) * estride; u.aux = m; return true; }
    __device__ __forceinline__ unsigned a_off(const Unit& u, int R) const { const int e = u.aux & 255, p0 = u.aux >> 8, ce = cntl[e]; int p = p0 + R; p = p < ce ? p : ce - 1; return (unsigned)list[(size_t)e * lcap + p] * (unsigned)rowbytes; }
    __device__ __forceinline__ void a_ready(const Unit&) const {}
    __device__ __forceinline__ void done(const Unit&) const {}
};
__device__ __forceinline__ u32x4 pack8(const f32x4 a, const f32x4 b) { u32x4 w; w.x = cvt_pk_bf16(a[0], a[1]); w.y = cvt_pk_bf16(a[2], a[3]); w.z = cvt_pk_bf16(b[0], b[1]); w.w = cvt_pk_bf16(b[2], b[3]); return w; }
struct EpiStore {
    static constexpr bool PERM = true, AFTER_DRAIN = false; bf16_t* O; int ldc; float s;
    __device__ __forceinline__ void operator()(const f32x4 (&acc)[2][2][4][2], const Unit& u, int wr, int wc, int, int) const {
        const int ln = lane_id_now(), fr = ln & 15, fq = ln >> 4;
        const int row0 = u.pm * BM + wr * 64 + fr, col0 = u.pn * BM + wc * 32 + 8 * fq;
#pragma unroll
        for (int ai = 0; ai < 2; ++ai) { if (u.half != 0 && ai != u.half - 1) continue;
#pragma unroll
            for (int m = 0; m < 4; ++m) { bf16_t* rowp = O + (size_t)(row0 + ai * HALF + m * 16) * ldc + col0;
#pragma unroll
                for (int bj = 0; bj < 2; ++bj) *(u32x4*)(rowp + bj * HALF) = pack8(acc[ai][bj][m][0] * s, acc[ai][bj][m][1] * s); } }
    }
};

__device__ __forceinline__ f32x4 gelu_tanh4(const f32x4 x) {
    const f32x2_c a = {x[0], x[1]}, b = {x[2], x[3]};
    const f32x2_c ta = (a * a) * (-0.10294324f) + (-2.3022082f), tb = (b * b) * (-0.10294324f) + (-2.3022082f);
    const f32x2_c ua = a * ta, ub = b * tb;
    f32x2_c ea, eb; ea.x = __builtin_amdgcn_exp2f(ua.x); ea.y = __builtin_amdgcn_exp2f(ua.y); eb.x = __builtin_amdgcn_exp2f(ub.x); eb.y = __builtin_amdgcn_exp2f(ub.y);
    const f32x2_c da = ea + 1.f, db = eb + 1.f;
    f32x2_c ra, rb; ra.x = __builtin_amdgcn_rcpf(da.x); ra.y = __builtin_amdgcn_rcpf(da.y); rb.x = __builtin_amdgcn_rcpf(db.x); rb.y = __builtin_amdgcn_rcpf(db.y);
    const f32x2_c ya = a * ra, yb = b * rb;
    return (f32x4){ya.x, ya.y, yb.x, yb.y};
}
struct EpiInProj {
    static constexpr bool PERM = true, AFTER_DRAIN = false;
    bf16_t* O; bf16_t* Kb; bf16_t* Vb; const float* kg; const float* rope; PG8_LAS float* xch;
    float s;
    float* part;
    __device__ __forceinline__ void operator()(const f32x4 (&acc)[2][2][4][2], const Unit& u, int wr, int wc, int, int) const {
        const int ln = lane_id_now(), fr = ln & 15, fq = ln >> 4;
        if (u.pn != 2) {
            const int row0 = u.pm * BM + wr * 64 + fr, col0 = u.pn * BM + wc * 32 + 8 * fq;
            if (u.pn < 2) {
#pragma unroll
                for (int ai = 0; ai < 2; ++ai)
#pragma unroll
                    for (int m = 0; m < 4; ++m) { unsigned char* rowp = (unsigned char*)(O + (size_t)(row0 + ai * HALF + m * 16) * 1792) + col0;
#pragma unroll
                        for (int bj = 0; bj < 2; ++bj) { const f32x4 a = acc[ai][bj][m][0] * s, b = acc[ai][bj][m][1] * s; int w0 = 0, w1 = 0;
                            w0 = __builtin_amdgcn_cvt_pk_fp8_f32(a[0], a[1], w0, false); w0 = __builtin_amdgcn_cvt_pk_fp8_f32(a[2], a[3], w0, true);
                            w1 = __builtin_amdgcn_cvt_pk_fp8_f32(b[0], b[1], w1, false); w1 = __builtin_amdgcn_cvt_pk_fp8_f32(b[2], b[3], w1, true);
                            u32x2 w; w.x = (unsigned)w0; w.y = (unsigned)w1; *(u32x2*)(rowp + bj * HALF) = w; } }
                return;
            }
            const bool stats = u.pn >= 5;
#pragma unroll
            for (int ai = 0; ai < 2; ++ai)
#pragma unroll
                for (int m = 0; m < 4; ++m) { bf16_t* rowp = O + (size_t)(row0 + ai * HALF + m * 16) * 1792 + col0; float s1 = 0.f, s2 = 0.f;
#pragma unroll
                    for (int bj = 0; bj < 2; ++bj) { const f32x4 ga = gelu_tanh4(acc[ai][bj][m][0] * s), gb = gelu_tanh4(acc[ai][bj][m][1] * s);
                        const u32x4 w = pack8(ga, gb); *(u32x4*)(rowp + bj * HALF) = w;
                        if (stats) { const float r0 = __uint_as_float(w.x << 16), r1 = __uint_as_float(w.x & 0xffff0000u), r2 = __uint_as_float(w.y << 16), r3 = __uint_as_float(w.y & 0xffff0000u),
                                                 r4 = __uint_as_float(w.z << 16), r5 = __uint_as_float(w.z & 0xffff0000u), r6 = __uint_as_float(w.w << 16), r7 = __uint_as_float(w.w & 0xffff0000u);
                            s1 += ((r0 + r1) + (r2 + r3)) + ((r4 + r5) + (r6 + r7)); s2 += ((r0 * r0 + r1 * r1) + (r2 * r2 + r3 * r3)) + ((r4 * r4 + r5 * r5) + (r6 * r6 + r7 * r7)); } }
                    if (stats) { s1 += __shfl_xor(s1, 16); s1 += __shfl_xor(s1, 32); s2 += __shfl_xor(s2, 16); s2 += __shfl_xor(s2, 32);
                        if (fq == 0) { float* pp = part + ((size_t)(row0 + ai * HALF + m * 16) * 8 + (u.pn - 5) * 4 + wc) * 2; pp[0] = s1; pp[1] = s2; } } }
            return;
        }
        const int R0 = u.pm * BM; const bool lat = R0 < 32768;
        const size_t kvbase = lat ? (size_t)(R0 >> 11) * 2304 + 256 + (R0 & 2047) : (size_t)((R0 - 32768) >> 8) * 2304;
#pragma unroll
        for (int ai = 0; ai < 2; ++ai)
#pragma unroll
            for (int m = 0; m < 4; ++m) { const f32x4 a = acc[ai][0][m][0], b = acc[ai][0][m][1];
                float sq = (a[0] * a[0] + a[1] * a[1]) + (a[2] * a[2] + a[3] * a[3]) + (b[0] * b[0] + b[1] * b[1]) + (b[2] * b[2] + b[3] * b[3]);
                sq += __shfl_xor(sq, 16); sq += __shfl_xor(sq, 32);
                if (fq == 0) xch[(ai * HALF + wr * 64 + m * 16 + fr) * 4 + wc] = sq; }
        asm volatile("s_waitcnt lgkmcnt(0)\n\ts_barrier" ::: "memory");
        const int dh = 32 * (wc & 1) + 8 * fq;
        const f32x4 g0 = *(const f32x4*)(kg + dh), g1 = *(const f32x4*)(kg + dh + 4);
        const bool x2 = (fq & 2) != 0;
#pragma unroll
        for (int ai = 0; ai < 2; ++ai)
#pragma unroll
            for (int m = 0; m < 4; ++m) { const int rl = ai * HALF + wr * 64 + m * 16 + fr;
                const float tot = xch[rl * 4 + wc] + xch[rl * 4 + (wc ^ 1)]; const float rs = rsqrtf(tot * (s * s * (1.f / 64.f)) + 1e-6f) * s;
                f32x4 a = acc[ai][0][m][0] * rs * g0, b = acc[ai][0][m][1] * rs * g1;
                f32x4 pa, pb;
#pragma unroll
                for (int i = 0; i < 4; ++i) { pa[i] = __shfl_xor(a[i], 32); pb[i] = __shfl_xor(b[i], 32); }
                if (lat) { const int t = (R0 & 2047) + rl; const int pos = (wc & 1) ? (t & 63) : (t >> 6);
                    const float* rp = rope + ((size_t)pos * 16 + 8 * (fq & 1)) * 2;
                    const f32x4 c0 = *(const f32x4*)(rp), c1 = *(const f32x4*)(rp + 4), c2 = *(const f32x4*)(rp + 8), c3 = *(const f32x4*)(rp + 12);
                    const f32x4 cs = {c0[0], c0[2], c1[0], c1[2]}, sn = {c0[1], c0[3], c1[1], c1[3]}, cs2 = {c2[0], c2[2], c3[0], c3[2]}, sn2 = {c2[1], c2[3], c3[1], c3[3]};
                    a = x2 ? (a * cs + pa * sn) : (a * cs - pa * sn); b = x2 ? (b * cs2 + pb * sn2) : (b * cs2 - pb * sn2); }
                const size_t o = (kvbase + rl) * 128 + 32 * wc + 8 * fq;
                *(u32x4*)(Kb + o) = pack8(a, b); *(u32x4*)(Vb + o) = pack8(acc[ai][1][m][0] * s, acc[ai][1][m][1] * s); }
        asm volatile("s_waitcnt lgkmcnt(0)\n\ts_barrier" ::: "memory");
    }
};
__device__ __forceinline__ f32x4 sigm4(const f32x4 v) {
    const f32x2_c a = {v[0], v[1]}, b = {v[2], v[3]}; const f32x2_c ua = a * (-1.4426950408889634f), ub = b * (-1.4426950408889634f);
    f32x2_c ea, eb; ea.x = __builtin_amdgcn_exp2f(ua.x); ea.y = __builtin_amdgcn_exp2f(ua.y); eb.x = __builtin_amdgcn_exp2f(ub.x); eb.y = __builtin_amdgcn_exp2f(ub.y);
    const f32x2_c da = ea + 1.f, db = eb + 1.f;
    return (f32x4){__builtin_amdgcn_rcpf(da.x), __builtin_amdgcn_rcpf(da.y), __builtin_amdgcn_rcpf(db.x), __builtin_amdgcn_rcpf(db.y)};
}
__device__ __forceinline__ f32x4 silu4(const f32x4 v) { return v * sigm4(v); }
__device__ __forceinline__ u32x2 pack8_fp8(const f32x4 a, const f32x4 b) { int w0 = 0, w1 = 0;
    w0 = __builtin_amdgcn_cvt_pk_fp8_f32(a[0], a[1], w0, false); w0 = __builtin_amdgcn_cvt_pk_fp8_f32(a[2], a[3], w0, true);
    w1 = __builtin_amdgcn_cvt_pk_fp8_f32(b[0], b[1], w1, false); w1 = __builtin_amdgcn_cvt_pk_fp8_f32(b[2], b[3], w1, true); u32x2 r; r.x = (unsigned)w0; r.y = (unsigned)w1; return r; }
__device__ __forceinline__ f32x4 clamp8(const f32x4 v) { f32x4 r;
#pragma unroll
    for (int i = 0; i < 4; ++i) r[i] = __builtin_amdgcn_fmed3f(v[i], -448.f, 448.f); return r; }
struct EpiSwiglu {
    static constexpr bool PERM = true, AFTER_DRAIN = false; unsigned char* G; float s, so;
    __device__ __forceinline__ void operator()(const f32x4 (&acc)[2][2][4][2], const Unit& u, int wr, int wc, int, int) const {
        const int ln = lane_id_now(), fr = ln & 15, fq = ln >> 4;
        const int row0 = u.pm * BM + wr * 64 + fr, col0 = u.pn * HALF + wc * 32 + 8 * fq;
#pragma unroll
        for (int ai = 0; ai < 2; ++ai) { if (u.half != 0 && ai != u.half - 1) continue;
#pragma unroll
            for (int m = 0; m < 4; ++m) *(u32x2*)(G + (size_t)(row0 + ai * HALF + m * 16) * 512 + col0) = pack8_fp8(clamp8(silu4(acc[ai][0][m][0] * s) * (acc[ai][1][m][0] * (s * so))), clamp8(silu4(acc[ai][0][m][1] * s) * (acc[ai][1][m][1] * (s * so)))); }
    }
};
struct EpiStoreF8 {
    static constexpr bool PERM = true, AFTER_DRAIN = false; unsigned char* O; int ldc; float s;
    __device__ __forceinline__ void operator()(const f32x4 (&acc)[2][2][4][2], const Unit& u, int wr, int wc, int, int) const {
        const int ln = lane_id_now(), fr = ln & 15, fq = ln >> 4;
        const int row0 = u.pm * BM + wr * 64 + fr, col0 = u.pn * BM + wc * 32 + 8 * fq;
#pragma unroll
        for (int ai = 0; ai < 2; ++ai) { if (u.half != 0 && ai != u.half - 1) continue;
#pragma unroll
            for (int m = 0; m < 4; ++m) { unsigned char* rowp = O + (size_t)(row0 + ai * HALF + m * 16) * ldc + col0;
#pragma unroll
                for (int bj = 0; bj < 2; ++bj) *(u32x2*)(rowp + bj * HALF) = pack8_fp8(clamp8(acc[ai][bj][m][0] * s), clamp8(acc[ai][bj][m][1] * s)); } }
    }
};
__device__ __forceinline__ void unpack8f(const u32x4 w, f32x4& a, f32x4& b) {
    a[0] = __uint_as_float(w.x << 16); a[1] = __uint_as_float(w.x & 0xffff0000u); a[2] = __uint_as_float(w.y << 16); a[3] = __uint_as_float(w.y & 0xffff0000u);
    b[0] = __uint_as_float(w.z << 16); b[1] = __uint_as_float(w.z & 0xffff0000u); b[2] = __uint_as_float(w.w << 16); b[3] = __uint_as_float(w.w & 0xffff0000u); }
struct EpiGlu {
    static constexpr bool PERM = true, AFTER_DRAIN = false; const bf16_t* GS; const float* b; bf16_t* GG;
    __device__ __forceinline__ void operator()(const f32x4 (&acc)[2][2][4][2], const Unit& u, int wr, int wc, int fr, int fq) const {
        const int row0 = u.pm * BM + wr * 64 + fr, col0 = u.pn * BM + wc * 32 + 8 * fq;
#pragma unroll
        for (int bj = 0; bj < 2; ++bj) { const int c = col0 + bj * HALF; const f32x4 b0 = *(const f32x4*)(b + c), b1 = *(const f32x4*)(b + c + 4);
#pragma unroll
            for (int ai = 0; ai < 2; ++ai) { if (u.half != 0 && ai != u.half - 1) continue;
#pragma unroll
                for (int m = 0; m < 4; ++m) { const size_t o = (size_t)(row0 + ai * HALF + m * 16) * 512 + c; f32x4 g0, g1; unpack8f(*(const u32x4*)(GS + o), g0, g1);
                    *(u32x4*)(GG + o) = pack8(g0 * sigm4(acc[ai][bj][m][0] + b0), g1 * sigm4(acc[ai][bj][m][1] + b1)); } } }
    }
};
struct EpiResid {
    static constexpr bool PERM = true, AFTER_DRAIN = false;
    const float* x; const float* ctx; const float* mod; bf16_t* XC; int inplace; float s;
    __device__ __forceinline__ void operator()(const f32x4 (&acc)[2][2][4][2], const Unit& u, int wr, int wc, int fr, int fq) const {
        const int R0 = u.pm * BM; const int ci = R0 < 32768 ? (R0 >> 11) : 16;
        const float* base = R0 < 32768 ? x + (size_t)R0 * 1024 : ctx + (size_t)(R0 - 32768) * 1024;
        bf16_t* out = XC + (size_t)R0 * 1024; const float* gate = mod + ((size_t)ci * 6 + 2) * 1024;
        const int rl0 = wr * 64 + fr, col0 = u.pn * BM + wc * 32 + 8 * fq;
#pragma unroll
        for (int bj = 0; bj < 2; ++bj) { const int c = col0 + bj * HALF; const f32x4 g0 = *(const f32x4*)(gate + c) * s, g1 = *(const f32x4*)(gate + c + 4) * s;
#pragma unroll
            for (int ai = 0; ai < 2; ++ai) { if (u.half != 0 && ai != u.half - 1) continue;
#pragma unroll
                for (int m = 0; m < 4; ++m) { const size_t o = (size_t)(rl0 + ai * HALF + m * 16) * 1024 + c; f32x4 b0, b1;
                    if (inplace) unpack8f(*(const u32x4*)(out + o), b0, b1); else { b0 = *(const f32x4*)(base + o); b1 = *(const f32x4*)(base + o + 4); }
                    *(u32x4*)(out + o) = pack8(b0 + g0 * acc[ai][bj][m][0], b1 + g1 * acc[ai][bj][m][1]); } } }
    }
};
}

#include <hip/hip_bf16.h>
#include <cmath>
namespace attn_body {
using bf16=__hip_bfloat16;
using bf16x8=__attribute__((ext_vector_type(8)))short;
using s16x4=__attribute__((ext_vector_type(4)))short;
using f32x16=__attribute__((ext_vector_type(16)))float;
using u32x4=__attribute__((ext_vector_type(4)))unsigned;
constexpr int D=64,QP=1792,KP=128,OP=1024,OPB=1536; constexpr float OSC=64.f;
constexpr int NW=8,QBLK=32,QB=QBLK*NW,KVBLK=64;
constexpr int ATTN_UNIT_ROWS=QB;
__device__ __forceinline__ int crow(int r,int hi){return (r&3)+8*(r>>2)+4*hi;}
#define SBAR() __builtin_amdgcn_sched_barrier(0)
__device__ __forceinline__ void cmask(f32x16&p0,f32x16&p1,int jb,int qrel,int hi){
  const float NEG=-INFINITY; int kb=64*jb+4*hi;
  #pragma unroll
  for(int r=0;r<16;++r){int kv=kb+(r&3)+8*(r>>2); if(kv>qrel)p0[r]=NEG; if(kv+32>qrel)p1[r]=NEG;}
}

constexpr int NSLOT=3, SLOTB=8192;
constexpr int LDS_K=0, LDS_V=NSLOT*SLOTB, LDS_WS=2*NSLOT*SLOTB, LDS_OST=LDS_WS+NW*64*4, LDS_BYTES=LDS_OST+NW*4096;
constexpr float C2=0.125f*1.4426950408889634f;
__device__ __forceinline__ void glds16(const void*gsrc,unsigned lds_dst){unsigned keep;
  asm volatile("s_mov_b32 %0, m0\n\ts_mov_b32 m0, %2\n\ts_nop 0\n\tglobal_load_lds_dwordx4 %1, off\n\ts_mov_b32 m0, %0":"=&s"(keep):"v"(gsrc),"s"(lds_dst):"memory");}
__device__ __forceinline__ float max3f(float a,float b,float c){float r;asm("v_max3_f32 %0, %1, %2, %3":"=v"(r):"v"(a),"v"(b),"v"(c));return r;}
__device__ __forceinline__ float max2f(float a,float b){float r;asm("v_max_f32_e32 %0, %1, %2":"=v"(r):"v"(a),"v"(b));return r;}
__device__ __forceinline__ float fadd_s(float a,float b){float r;asm("v_add_f32_e32 %0, %1, %2":"=v"(r):"v"(a),"v"(b));return r;}
__device__ __forceinline__ float fsub_s(float a,float b){float r;asm("v_sub_f32_e32 %0, %1, %2":"=v"(r):"v"(a),"v"(b));return r;}
typedef float f32x2_t __attribute__((ext_vector_type(2))); typedef __bf16 bf16x2_t __attribute__((ext_vector_type(2)));
__device__ __forceinline__ unsigned cvtpk_s(float lo,float hi){f32x2_t v={lo,hi};bf16x2_t b=__builtin_convertvector(v,bf16x2_t);return __builtin_bit_cast(unsigned,b);}
#define WAIT_BAR(N) asm volatile("s_waitcnt vmcnt(" #N ") lgkmcnt(0)\n\ts_barrier":::"memory")

__device__ __forceinline__ void qkt(f32x16&p0,f32x16&p1,const char*Kslot,const bf16x8*qr,const f32x16&negm,int r32,int hi){
  const char*kb=Kslot+hi*1024+r32*16;
  #pragma unroll
  for(int d0=0;d0<4;++d0){
    const bf16x8 b0=*reinterpret_cast<const bf16x8*>(kb+d0*2048);
    const bf16x8 b1=*reinterpret_cast<const bf16x8*>(kb+d0*2048+512);
    if(d0==0){p0=__builtin_amdgcn_mfma_f32_32x32x16_bf16(b0,qr[0],negm,0,0,0);p1=__builtin_amdgcn_mfma_f32_32x32x16_bf16(b1,qr[0],negm,0,0,0);}
    else{p0=__builtin_amdgcn_mfma_f32_32x32x16_bf16(b0,qr[d0],p0,0,0,0);p1=__builtin_amdgcn_mfma_f32_32x32x16_bf16(b1,qr[d0],p1,0,0,0);}}
}
typedef __attribute__((address_space(3))) const char* lds_cptr;
typedef short v4i16_t __attribute__((ext_vector_type(4)));
__device__ __forceinline__ void kload8(bf16x8*kf,lds_cptr kp){
  kf[0]=*(const __attribute__((address_space(3))) bf16x8*)(kp);      kf[1]=*(const __attribute__((address_space(3))) bf16x8*)(kp+512);
  kf[2]=*(const __attribute__((address_space(3))) bf16x8*)(kp+2048); kf[3]=*(const __attribute__((address_space(3))) bf16x8*)(kp+2560);
  kf[4]=*(const __attribute__((address_space(3))) bf16x8*)(kp+4096); kf[5]=*(const __attribute__((address_space(3))) bf16x8*)(kp+4608);
  kf[6]=*(const __attribute__((address_space(3))) bf16x8*)(kp+6144); kf[7]=*(const __attribute__((address_space(3))) bf16x8*)(kp+6656);
}
__device__ __forceinline__ void kload2(bf16x8*kf,lds_cptr kp,int j){ kf[2*j]=*(const __attribute__((address_space(3))) bf16x8*)(kp+j*2048); kf[2*j+1]=*(const __attribute__((address_space(3))) bf16x8*)(kp+j*2048+512); }
__device__ __forceinline__ s16x4 vtr(lds_cptr p){ return __builtin_bit_cast(s16x4,__builtin_amdgcn_ds_read_tr16_b64_v4i16((__attribute__((address_space(3))) v4i16_t*)p)); }
__device__ __forceinline__ float rowmax(const f32x16&p0,const f32x16&p1){
  float a=max3f(p0[0],p0[1],p1[0]),b=max3f(p0[2],p0[3],p1[1]);a=max3f(a,p1[2],p1[3]);
  #pragma unroll
  for(int r=4;r<16;r+=4){a=max3f(a,p0[r],p0[r+1]);b=max3f(b,p0[r+2],p0[r+3]);a=max3f(a,p1[r],p1[r+1]);b=max3f(b,p1[r+2],p1[r+3]);}
  const float m=max2f(a,b);
  auto rr=__builtin_amdgcn_permlane32_swap(__float_as_uint(m),__float_as_uint(m),false,false);
  return max2f(__uint_as_float(rr[0]),__uint_as_float(rr[1]));
}
__device__ __forceinline__ void pv(f32x16*o,int vb,bf16x8 pa0,bf16x8 pa1,bf16x8 pa2,bf16x8 pa3){
  #pragma unroll
  for(int d0=0;d0<2;++d0){s16x4 lo[4],hi[4];
    #pragma unroll
    for(int ks=0;ks<4;++ks){
      asm volatile("ds_read_b64_tr_b16 %0,%1 offset:%c2":"=&v"(lo[ks]):"v"(vb),"i"(d0*4096+ks*1024):"memory");
      asm volatile("ds_read_b64_tr_b16 %0,%1 offset:%c2":"=&v"(hi[ks]):"v"(vb),"i"(d0*4096+ks*1024+512):"memory");}
    asm volatile("s_waitcnt lgkmcnt(0)":::"memory");SBAR();
    #define PK(k) (bf16x8){lo[k][0],lo[k][1],lo[k][2],lo[k][3],hi[k][0],hi[k][1],hi[k][2],hi[k][3]}
    o[d0]=__builtin_amdgcn_mfma_f32_32x32x16_bf16(pa0,PK(0),o[d0],0,0,0);
    o[d0]=__builtin_amdgcn_mfma_f32_32x32x16_bf16(pa1,PK(1),o[d0],0,0,0);
    o[d0]=__builtin_amdgcn_mfma_f32_32x32x16_bf16(pa2,PK(2),o[d0],0,0,0);
    o[d0]=__builtin_amdgcn_mfma_f32_32x32x16_bf16(pa3,PK(3),o[d0],0,0,0);
    #undef PK
  }
}

#ifndef ATTN_STORE16
#define ATTN_STORE16(p,v) (*(u32x4*)(p)=(v))
#endif
template<int THRL> __device__ __forceinline__ void attn_unit(const bf16*Q0,const bf16*__restrict__ Kh,const bf16*__restrict__ Vh,unsigned char*O0,const int NT,char*shm,const float*qg,const float2*rope,const int tq0){
  const int tid=threadIdx.x,lane=tid&63,r32=lane&31,hi=lane>>5; const int wid=__builtin_amdgcn_readfirstlane(tid>>6);
  const unsigned char*Qwb=(const unsigned char*)Q0+(long)(wid*QBLK)*QP*2;
  const unsigned lds0=(unsigned)(uintptr_t)shm;
  float*wsf=(float*)(shm+LDS_WS)+wid*64;
  const bf16*ksrc=Kh+(long)lane*KP+wid*8;
  const bf16*vsrc=Vh+(long)(16*(wid&3)+(lane>>2))*KP+(wid>>2)*32+(lane&3)*8;
  const unsigned kdst=lds0+LDS_K+wid*1024, vdst=lds0+LDS_V+wid*1024;
  #define DMA_K(t,slot) glds16(ksrc+(long)(t)*KVBLK*KP,(unsigned)__builtin_amdgcn_readfirstlane(kdst+(slot)))
  #define DMA_V(t,slot) glds16(vsrc+(long)(t)*KVBLK*KP,(unsigned)__builtin_amdgcn_readfirstlane(vdst+(slot)))
  const int vb0=(int)(lds0+LDS_V)+((lane>>4)&1)*32+(lane&3)*8+(4*hi+((lane&15)>>2))*64;
  const char*Kbase=shm+LDS_K; bf16x8 kf[8];
  const lds_cptr shm3=(lds_cptr)shm; const lds_cptr kp0=shm3+LDS_K+hi*1024+r32*16; const lds_cptr vp0=shm3+LDS_V+((lane>>4)&1)*32+(lane&3)*8+(4*hi+((lane&15)>>2))*64;
  DMA_K(0,0);DMA_V(0,0);DMA_K(1,SLOTB);
  bf16x8 qr[4]; u32x4 q8a,q8b;
  { const unsigned char*qp_=Qwb+(long)r32*QP*2+hi*8;
    const unsigned long long w0=*(const unsigned long long*)(qp_),w1=*(const unsigned long long*)(qp_+16),w2=*(const unsigned long long*)(qp_+32),w3=*(const unsigned long long*)(qp_+48);
    q8a.x=(unsigned)w0;q8a.y=(unsigned)(w0>>32);q8a.z=(unsigned)w1;q8a.w=(unsigned)(w1>>32);q8b.x=(unsigned)w2;q8b.y=(unsigned)(w2>>32);q8b.z=(unsigned)w3;q8b.w=(unsigned)(w3>>32); }
  { float qf[4][8]; float ss=0.f;
    #pragma unroll
    for(int d0=0;d0<4;++d0){ const unsigned lo_=d0==0?q8a.x:d0==1?q8a.z:d0==2?q8b.x:q8b.z, hi_=d0==0?q8a.y:d0==1?q8a.w:d0==2?q8b.y:q8b.w;
      const auto f01=__builtin_amdgcn_cvt_pk_f32_fp8((int)lo_,false),f23=__builtin_amdgcn_cvt_pk_f32_fp8((int)lo_,true),f45=__builtin_amdgcn_cvt_pk_f32_fp8((int)hi_,false),f67=__builtin_amdgcn_cvt_pk_f32_fp8((int)hi_,true);
      qf[d0][0]=f01[0];qf[d0][1]=f01[1];qf[d0][2]=f23[0];qf[d0][3]=f23[1];qf[d0][4]=f45[0];qf[d0][5]=f45[1];qf[d0][6]=f67[0];qf[d0][7]=f67[1];
      #pragma unroll
      for(int j=0;j<8;++j) ss+=qf[d0][j]*qf[d0][j]; }
    ss+=__shfl_xor(ss,32);
    const float rs=rsqrtf(ss*(1.f/64.f)+1e-6f);
    #pragma unroll
    for(int d0=0;d0<4;++d0){
      #pragma unroll
      for(int j=0;j<8;++j) qf[d0][j]*=rs*qg[16*d0+8*hi+j]; }
    if(tq0>=0){ const int t=tq0+wid*QBLK+r32; const float2*rr=rope+(t>>6)*16+8*hi; const float2*rc=rope+(t&63)*16+8*hi;
      #pragma unroll
      for(int j=0;j<8;++j){ const float2 a=rr[j],c=rc[j];
        const float x1=qf[0][j],x2=qf[1][j]; qf[0][j]=x1*a.x-x2*a.y; qf[1][j]=x2*a.x+x1*a.y;
        const float y1=qf[2][j],y2=qf[3][j]; qf[2][j]=y1*c.x-y2*c.y; qf[3][j]=y2*c.x+y1*c.y; } }
    #pragma unroll
    for(int d0=0;d0<4;++d0){ u32x4 w; w.x=cvtpk_s(qf[d0][0]*C2,qf[d0][1]*C2); w.y=cvtpk_s(qf[d0][2]*C2,qf[d0][3]*C2); w.z=cvtpk_s(qf[d0][4]*C2,qf[d0][5]*C2); w.w=cvtpk_s(qf[d0][6]*C2,qf[d0][7]*C2); qr[d0]=__builtin_bit_cast(bf16x8,w); } }
  float mhat=0.f,l_reg=0.f;f32x16 o[2];o[0]=f32x16{};o[1]=f32x16{};f32x16 negm=f32x16{};asm volatile("":"+v"(negm));
  #define CMASK(P0,P1,t) do{}while(0)
  bool resc=false;
  #define START(P0,P1) do{ const float rm=rowmax(P0,P1); resc=false; \
    { const float dl=rm; mhat=fadd_s(mhat,dl); \
      _Pragma("unroll") for(int r=0;r<16;++r){P0[r]=fsub_s(P0[r],dl);P1[r]=fsub_s(P1[r],dl);} \
      _Pragma("unroll") for(int r=0;r<16;++r)negm[r]=-mhat; asm volatile("":"+v"(negm)); } \
    _Pragma("unroll") for(int r=0;r<16;++r)P0[r]=__builtin_amdgcn_exp2f(P0[r]); }while(0)
  #define RESC() do{ if(resc){ asm volatile("s_waitcnt lgkmcnt(0)":::"memory"); \
      _Pragma("unroll") for(int d_=0;d_<2;++d_) _Pragma("unroll") for(int r=0;r<16;++r)o[d_][r]*=wsf[crow(r,hi)]; } }while(0)
  f32x16 pA0,pA1,pB0,pB1;
  int sl_prev=0,sl_cur=0,sl_next=SLOTB;
  #define ROT() do{sl_prev=sl_cur;sl_cur=sl_next;sl_next=(sl_next==(NSLOT-1)*SLOTB)?0:sl_next+SLOTB;}while(0)
  DMA_K(2,2*SLOTB);
  WAIT_BAR(3);
  qkt(pA0,pA1,Kbase,qr,negm,r32,hi);asm volatile("s_nop 15\n\ts_nop 7":"+v"(pA0),"+v"(pA1));CMASK(pA0,pA1,0);
  START(pA0,pA1);
  _Pragma("unroll") for(int r=0;r<16;++r)pA1[r]=__builtin_amdgcn_exp2f(pA1[r]);
  WAIT_BAR(0);
  DMA_K(3,0);DMA_V(1,SLOTB);
  ROT();
  kload8(kf,kp0+sl_cur);
  WAIT_BAR(2);
  s16x4 vlo[8],vhi[8]; u32x4 pw0,pw1,pw2,pw3;
  #define PKW(P,B) cvtpk_s(P[B],P[B+1])
  #define PAF(k) __builtin_bit_cast(bf16x8,pw##k)
  #define VFR(i) (bf16x8){vlo[i][0],vlo[i][1],vlo[i][2],vlo[i][3],vhi[i][0],vhi[i][1],vhi[i][2],vhi[i][3]}
  #define PIN(x) asm volatile("":"+v"(x))
  #define MX3(a,b,c) __builtin_fmaxf(__builtin_fmaxf((a),(b)),(c))
  #define GAPA(MF,A0,A1,A2,A3,W0,W1,PW) do{ MF; sacc+=A0; sacc+=A1; sacc+=A2; sacc+=A3; PIN(sacc); W0; W1; PIN(PW); SBAR(); }while(0)
  #define EX(v) __builtin_amdgcn_exp2f(v)
  #define GAPB(MF,X,B) do{ MF; X[B]=EX(X[B]); X[B+1]=EX(X[B+1]); X[B+2]=EX(X[B+2]); X[B+3]=EX(X[B+3]); PIN(X); SBAR(); }while(0)
  #define VRD(i) do{ vlo[i]=vtr(vp_+(((i)>>2)*4096+((i)&3)*1024)); vhi[i]=vtr(vp_+(((i)>>2)*4096+((i)&3)*1024+512)); }while(0)
  #define KRD(G,j) do{ if(G){ kload2(kf,kp0+sl_next,j); SBAR(); } }while(0)
  #define STEP(C0,C1,P0,P1,t,GK,GV,GL) do{ SBAR(); \
    const lds_cptr vp_=vp0+sl_prev; \
    VRD(0); SBAR(); float sacc=(P0[0]+P0[1]); \
    GAPA(C0=__builtin_amdgcn_mfma_f32_32x32x16_bf16(kf[0],qr[0],negm,0,0,0), P0[2],P0[3],P0[4],P0[5],     pw0[0]=PKW(P0,0), pw0[1]=PKW(P0,2), pw0); \
    VRD(4); SBAR(); GAPA(C1=__builtin_amdgcn_mfma_f32_32x32x16_bf16(kf[1],qr[0],negm,0,0,0), P0[6],P0[7],P0[8],P0[9],     pw0[2]=PKW(P0,4), pw0[3]=PKW(P0,6), pw0); \
    VRD(1); SBAR(); GAPA(C0=__builtin_amdgcn_mfma_f32_32x32x16_bf16(kf[2],qr[1],C0,0,0,0),   P0[10],P0[11],P0[12],P0[13], pw1[0]=PKW(P0,8), pw1[1]=PKW(P0,10), pw1); \
    VRD(5); SBAR(); GAPA(C1=__builtin_amdgcn_mfma_f32_32x32x16_bf16(kf[3],qr[1],C1,0,0,0),   P0[14],P0[15],P1[0],P1[1],   pw1[2]=PKW(P0,12),pw1[3]=PKW(P0,14), pw1); \
    VRD(2); SBAR(); GAPA(C0=__builtin_amdgcn_mfma_f32_32x32x16_bf16(kf[4],qr[2],C0,0,0,0),   P1[2],P1[3],P1[4],P1[5],     pw2[0]=PKW(P1,0), pw2[1]=PKW(P1,2), pw2); \
    VRD(6); SBAR(); GAPA(C1=__builtin_amdgcn_mfma_f32_32x32x16_bf16(kf[5],qr[2],C1,0,0,0),   P1[6],P1[7],P1[8],P1[9],     pw2[2]=PKW(P1,4), pw2[3]=PKW(P1,6), pw2); \
    VRD(3); SBAR(); GAPA(C0=__builtin_amdgcn_mfma_f32_32x32x16_bf16(kf[6],qr[3],C0,0,0,0),   P1[10],P1[11],P1[12],P1[13], pw3[0]=PKW(P1,8), pw3[1]=PKW(P1,10), pw3); \
    VRD(7); SBAR(); GAPA(C1=__builtin_amdgcn_mfma_f32_32x32x16_bf16(kf[7],qr[3],C1,0,0,0),   P1[14],P1[15],0.f,0.f,       pw3[2]=PKW(P1,12),pw3[3]=PKW(P1,14), pw3); \
    l_reg+=sacc; \
    if(GK){DMA_K((t)+3,sl_cur);} if(GV){DMA_V((t)+1,sl_next);} \
    CMASK(C0,C1,t); \
    { float a=MX3(C0[0],C0[1],C1[0]),b=MX3(C0[2],C0[3],C1[1]); a=MX3(a,C1[2],C1[3]); \
      _Pragma("unroll") for(int r=4;r<16;r+=4){a=MX3(a,C0[r],C0[r+1]);b=MX3(b,C0[r+2],C0[r+3]);a=MX3(a,C1[r],C1[r+1]);b=MX3(b,C1[r+2],C1[r+3]);} \
      float rm=__builtin_fmaxf(a,b); { auto rr=__builtin_amdgcn_permlane32_swap(__float_as_uint(rm),__float_as_uint(rm),false,false); rm=__builtin_fmaxf(__uint_as_float(rr[0]),__uint_as_float(rr[1])); } \
      resc=false; \
      if(__builtin_expect(__any(rm>(float)THRL),0)){ const float dl=__builtin_fmaxf(rm,0.f); mhat+=dl; \
        _Pragma("unroll") for(int r=0;r<16;++r){C0[r]-=dl;C1[r]-=dl;} \
        _Pragma("unroll") for(int r=0;r<16;++r)negm[r]=-mhat; asm volatile("":"+v"(negm)); \
        const float f=__builtin_amdgcn_exp2f(-dl); l_reg*=f; if(hi==0)wsf[r32]=f; resc=true; } } \
    SBAR(); \
    GAPB(o[0]=__builtin_amdgcn_mfma_f32_32x32x16_bf16(PAF(0),VFR(0),o[0],0,0,0), C0,0); \
    GAPB(o[1]=__builtin_amdgcn_mfma_f32_32x32x16_bf16(PAF(0),VFR(4),o[1],0,0,0), C0,4); \
    KRD(GL,0); GAPB(o[0]=__builtin_amdgcn_mfma_f32_32x32x16_bf16(PAF(1),VFR(1),o[0],0,0,0), C0,8); \
    KRD(GL,1); GAPB(o[1]=__builtin_amdgcn_mfma_f32_32x32x16_bf16(PAF(1),VFR(5),o[1],0,0,0), C0,12); \
    KRD(GL,2); GAPB(o[0]=__builtin_amdgcn_mfma_f32_32x32x16_bf16(PAF(2),VFR(2),o[0],0,0,0), C1,0); \
    KRD(GL,3); GAPB(o[1]=__builtin_amdgcn_mfma_f32_32x32x16_bf16(PAF(2),VFR(6),o[1],0,0,0), C1,4); \
    GAPB(o[0]=__builtin_amdgcn_mfma_f32_32x32x16_bf16(PAF(3),VFR(3),o[0],0,0,0), C1,8); \
    GAPB(o[1]=__builtin_amdgcn_mfma_f32_32x32x16_bf16(PAF(3),VFR(7),o[1],0,0,0), C1,12); \
    }while(0)
  int t=1;
  #undef CMASK
  #define CMASK(P0,P1,t) do{}while(0)
  for(;t+5<NT;t+=2){
    STEP(pB0,pB1,pA0,pA1,t,true,true,true);     WAIT_BAR(2); RESC(); ROT();
    STEP(pA0,pA1,pB0,pB1,t+1,true,true,true);   WAIT_BAR(2); RESC(); ROT();
  }
  #undef CMASK
  #define CMASK(P0,P1,t) do{}while(0)
  #define ENDW(tt) do{ if((tt)+3<NT){WAIT_BAR(2);} else if((tt)+2<NT){WAIT_BAR(1);} else {WAIT_BAR(0);} }while(0)
  for(;t+1<NT;t+=2){
    STEP(pB0,pB1,pA0,pA1,t,(t+3<NT),(t+1<NT),(t+1<NT));       ENDW(t);   RESC(); ROT();
    STEP(pA0,pA1,pB0,pB1,t+1,(t+4<NT),(t+2<NT),(t+2<NT));     ENDW(t+1); RESC(); ROT();
  }
  STEP(pB0,pB1,pA0,pA1,NT-1,false,false,false); RESC();
  { float sacc=pB0[0]+pB0[1]; _Pragma("unroll") for(int r=2;r<16;++r)sacc+=pB0[r]; _Pragma("unroll") for(int r=0;r<16;++r)sacc+=pB1[r]; l_reg+=sacc;
    pw0=(u32x4){PKW(pB0,0),PKW(pB0,2),PKW(pB0,4),PKW(pB0,6)};pw1=(u32x4){PKW(pB0,8),PKW(pB0,10),PKW(pB0,12),PKW(pB0,14)};pw2=(u32x4){PKW(pB1,0),PKW(pB1,2),PKW(pB1,4),PKW(pB1,6)};pw3=(u32x4){PKW(pB1,8),PKW(pB1,10),PKW(pB1,12),PKW(pB1,14)};
    SBAR(); pv(o,vb0+sl_cur,PAF(0),PAF(1),PAF(2),PAF(3)); }
  #undef PKW
  #undef PAF
  #undef VFR
  #undef PIN
  #undef MX3
  #undef GAPA
  #undef GAPB
  #undef EX
  #undef VRD
  #undef KRD
  #undef STEP
  #undef ENDW
  {auto rr=__builtin_amdgcn_permlane32_swap(__float_as_uint(l_reg),__float_as_uint(l_reg),false,false);l_reg=__uint_as_float(rr[0])+__uint_as_float(rr[1]);}
  if(hi==0)wsf[32+r32]=l_reg;asm volatile("s_waitcnt lgkmcnt(0)":::"memory");
  float rli[16];
  #pragma unroll
  for(int r=0;r<16;++r)rli[r]=__builtin_amdgcn_rcpf(wsf[32+crow(r,hi)]);
  unsigned char*Ow=O0+(long)(wid*QBLK)*OPB;
  { unsigned char*stg=(unsigned char*)(shm+LDS_OST)+wid*4096;
    #pragma unroll
    for(int r=0;r<16;++r){const int orow=crow(r,hi);
      #pragma unroll
      for(int d0=0;d0<2;++d0){ const float v_=__builtin_amdgcn_fmed3f(o[d0][r]*rli[r]*OSC,-448.f,448.f); stg[orow*64+d0*32+r32]=(unsigned char)(__builtin_amdgcn_cvt_pk_fp8_f32(v_,v_,0,false)&0xff); } }
    asm volatile("s_waitcnt lgkmcnt(0)":::"memory");
    #pragma unroll
    for(int i=0;i<2;++i){const int row=i*16+(lane>>2),ch=lane&3; const u32x4 v=*(const u32x4*)(stg+row*64+ch*16); ATTN_STORE16(Ow+(long)row*OPB+ch*16,v);} }
  asm volatile("s_waitcnt lgkmcnt(0)\n\ts_barrier":::"memory");
  #undef DMA_K
  #undef DMA_V
  #undef CMASK
  #undef START
  #undef RESC
  #undef ROT
}
constexpr int ATTN_LDS_BYTES=LDS_BYTES;
#undef SBAR
#undef WAIT_BAR
}

struct Params {
    const float* in[35];
    float* out;
    unsigned char* ws;
    int ph_lo, ph_hi;
};
enum { I_X = 0, I_C, I_CTX, I_CCTX, I_WMOD, I_BMOD, I_GMIX, I_GFFN, I_MIXWIN, I_MIXWOUT, I_QG, I_KG, I_LNG, I_WSP, I_BSP,
       I_S5WIN, I_ARE, I_AIM, I_LOGDT, I_BRE, I_BIM, I_CRE, I_CIM, I_S5D, I_WGLU, I_BGLU, I_S5WOUT,
       I_WGRP, I_BGRP, I_WRT, I_BRT, I_W1, I_W3, I_W2, I_FING };

struct Ctx {
    const Params* p;
    unsigned char* ws;
    LAS unsigned char* lds;
    int tid, lane, wave, gw, ngw;
};
__device__ __forceinline__ const float* xin_row(const Params& P, int r) { return r < TL ? P.in[I_X] + (size_t)r * D : P.in[I_CTX] + (size_t)(r - TL) * D; }
__device__ __forceinline__ int cond_of(int r) { return r < TL ? (r >> 11) : 16; }
__device__ __forceinline__ const float* mod_vec(const Ctx& C, int layer, int ci, int k) { return (const float*)(C.ws + WS_MOD) + ((size_t)(layer * 17 + ci) * 6 + k) * D; }

__device__ __forceinline__ void dsincos(double a, double& s, double& c) {
    const double TWO_PI_HI = 6.283185307179586, TWO_PI_LO = 2.4492935982947064e-16;
    const double k = rint(a * 0.15915494309189535);
    double r = fma(-k, TWO_PI_HI, a); r = fma(-k, TWO_PI_LO, r);
    const double r2 = r * r; double ct = 1.0, st = r, cs = 1.0, ss = r;
#pragma unroll
    for (int i = 1; i <= 15; ++i) { ct *= r2 * (-1.0 / (double)((2 * i - 1) * (2 * i))); cs += ct; st *= r2 * (-1.0 / (double)((2 * i) * (2 * i + 1))); ss += st; }
    s = ss; c = cs;
}

struct TItem { const float* src; int N, k0, n0; bf16* dst; int dp; float f8s; float bs; };
__device__ __forceinline__ void t_load(const TItem& t, int lane, float (&r)[32]) {
    const char* base = (const char*)(t.src + (size_t)t.k0 * t.N + t.n0); unsigned off = ((unsigned)(lane >> 5) * (unsigned)t.N + (unsigned)(lane & 31)) * 4u; const unsigned step = 8u * (unsigned)t.N;
#pragma unroll
    for (int i = 0; i < 32; ++i) { r[i] = __builtin_nontemporal_load((const float*)(base + off)); off += step; }
}
__device__ __forceinline__ void t_store(const TItem& t, int lane, const float (&r)[32], LAS float* scr) {
    if (t.f8s != 0.f) {
        unsigned e[16], o[16];
#pragma unroll
        for (int i = 0; i < 16; ++i) { const pg8::u32x2 sw = __builtin_amdgcn_permlane32_swap(__float_as_uint(r[i]), __float_as_uint(r[16 + i]), false, false); e[i] = sw.x; o[i] = sw.y; }
        const float q = t.f8s; int wv[8];
#pragma unroll
        for (int j = 0; j < 8; ++j) { const f32x2 a = (f32x2){__uint_as_float(e[2 * j]), __uint_as_float(o[2 * j])} * q, b = (f32x2){__uint_as_float(e[2 * j + 1]), __uint_as_float(o[2 * j + 1])} * q;
            int w = 0; w = __builtin_amdgcn_cvt_pk_fp8_f32(a.x, a.y, w, false); w = __builtin_amdgcn_cvt_pk_fp8_f32(b.x, b.y, w, true); wv[j] = w; }
        LAS unsigned char* img = (LAS unsigned char*)scr;
        LAS unsigned char* wp = img + (lane & 31) * 80 + 32 * (lane >> 5);
        *(LAS pg8::u32x4*)wp = (pg8::u32x4){(unsigned)wv[0], (unsigned)wv[1], (unsigned)wv[2], (unsigned)wv[3]}; *(LAS pg8::u32x4*)(wp + 16) = (pg8::u32x4){(unsigned)wv[4], (unsigned)wv[5], (unsigned)wv[6], (unsigned)wv[7]};
        asm volatile("s_waitcnt lgkmcnt(0)" ::: "memory");
#pragma unroll
        for (int sI = 0; sI < 2; ++sI) { const int n = (lane >> 2) + 16 * sI, qd = lane & 3;
            const pg8::u32x4 v = *(const LAS pg8::u32x4*)(img + n * 80 + 16 * qd);
            *(pg8::u32x4*)((unsigned char*)t.dst + (size_t)n * t.dp + 16 * qd) = v; }
        asm volatile("s_waitcnt lgkmcnt(0)" ::: "memory");
        return;
    }
#pragma unroll
    for (int i = 0; i < 32; ++i) scr[(2 * i + (lane >> 5)) * 33 + (lane & 31)] = r[i];
    asm volatile("s_waitcnt lgkmcnt(0)" ::: "memory");
    const int c = lane & 7;
    if (t.f8s != 0.f) {
#pragma unroll
        for (int j = 0; j < 4; ++j) { const int n = (lane >> 3) + 8 * j; const LAS float* s = scr + (8 * c) * 33 + n; const float q = t.f8s;
            *(pg8::u32x2*)((unsigned char*)t.dst + (size_t)n * t.dp + 8 * c) = pg8::pack8_fp8((f32x4){s[0 * 33] * q, s[1 * 33] * q, s[2 * 33] * q, s[3 * 33] * q}, (f32x4){s[4 * 33] * q, s[5 * 33] * q, s[6 * 33] * q, s[7 * 33] * q}); }
    } else {
#pragma unroll
        for (int j = 0; j < 4; ++j) { const int n = (lane >> 3) + 8 * j; const LAS float* s = scr + (8 * c) * 33 + n;
            const float q = t.bs != 0.f ? t.bs : 1.f; v4u o; o.x = pk2(s[0 * 33] * q, s[1 * 33] * q); o.y = pk2(s[2 * 33] * q, s[3 * 33] * q); o.z = pk2(s[4 * 33] * q, s[5 * 33] * q); o.w = pk2(s[6 * 33] * q, s[7 * 33] * q);
            *(v4u*)(t.dst + (size_t)n * t.dp + 8 * c) = o; }
    }
    asm volatile("s_waitcnt lgkmcnt(0)" ::: "memory");
}
__device__ __forceinline__ TItem mat_item(const float* W, int K, int N, bf16* WT, int it) {
    const int nblk = N / 32, kb = it / nblk, nb = it % nblk;
    return TItem{W, N, kb * 64, nb * 32, WT + (size_t)(nb * 32) * K + kb * 64, K, 0.f};
}
__device__ __forceinline__ TItem mat_item_f8(const float* W, int K, int N, unsigned char* WT, int it, float f8s) {
    const int nblk = N / 32, kb = it / nblk, nb = it % nblk;
    return TItem{W, N, kb * 64, nb * 32, (bf16*)(WT + (size_t)(nb * 32) * K + kb * 64), K, f8s};
}
constexpr int MOE_ITEMS = NEXP * 768;
__device__ __forceinline__ TItem moe_item(const Ctx& C, int layer, int it) {
    const Params& P = *C.p;
    const int e = it / 768, r = it % 768, kind = r / 256, j = r % 256;
    if (kind < 2) {
        const float* src = (kind == 0 ? P.in[I_W1] : P.in[I_W3]) + ((size_t)layer * NEXP + e) * D * EH;
        const int kb = j / 16, nb = j % 16, k0 = kb * 64, n0 = nb * 32;
        const int drow = (n0 / 128) * 256 + (n0 % 128) + (kind == 1 ? 128 : 0);
        return TItem{src, EH, k0, n0, (bf16*)((unsigned char*)(C.ws + (layer ? WS_W13B : WS_W13)) + (size_t)e * 1024 * 1024 + (size_t)drow * 1024 + k0), 1024, W13_SCALE};
    }
    const float* src = P.in[I_W2] + ((size_t)layer * NEXP + e) * EH * D;
    const int kb = j / 32, nb = j % 32, k0 = kb * 64, n0 = nb * 32;
    return TItem{src, D, k0, n0, (bf16*)((unsigned char*)(C.ws + (layer ? WS_W2B : WS_W2)) + (size_t)e * 1024 * 512 + (size_t)n0 * 512 + k0), 512, W13_SCALE};
}
constexpr int TI0 = 16 * 56, TI1 = 16 * 32, TI2 = 16 * 16, TI3 = 8 * 16, TI4 = 8 * 32, NSMALL = TI0 + TI1 + TI2 + TI3 + TI4;
__device__ __forceinline__ TItem conv_item(const Ctx& C, int layer, int nsmall, int it) {
    const Params& P = *C.p; int r = it;
    if (r < nsmall) {
        if (r < TI0) return mat_item_f8(P.in[I_MIXWIN], D, MIXW, (unsigned char*)(C.ws + WS_WIN0), r, W13_SCALE); r -= TI0;
        if (r < TI1) { const int kb = r / 32, nb = r % 32; unsigned char* wb = (unsigned char*)(C.ws + WS_WOUT0) + (size_t)(nb * 32) * OGP;
            if (kb < 8) return TItem{P.in[I_MIXWOUT], D, kb * 64, nb * 32, (bf16*)(wb + kb * 64), OGP, W13_SCALE, 0.f};
            return TItem{P.in[I_MIXWOUT], D, kb * 64, nb * 32, (bf16*)(wb + 512 + (kb - 8) * 128), OGP / 2, 0.f, W13_SCALE * O_SCALE}; }
        r -= TI1;
        if (r < TI2) return mat_item(P.in[I_S5WIN], D, 512, (bf16*)(C.ws + WS_WS5IN), r); r -= TI2;
        if (r < TI3) return mat_item(P.in[I_WGLU], 512, 512, (bf16*)(C.ws + WS_WGLU), r); r -= TI3;
        return mat_item(P.in[I_S5WOUT], 512, D, (bf16*)(C.ws + WS_WS5OUT), r);
    }
    return moe_item(C, layer, r - nsmall);
}
__device__ __forceinline__ void convert_items(const Ctx& C, int layer, int nsmall) {
    LAS float* scr = (LAS float*)(C.lds + C.wave * 16384);
    const int total = nsmall + (gridDim.x == 256 ? L0_A : MOE_ITEMS);
    const bool deal = gridDim.x == 256 && total > P0_SPLIT, late = deal && blockIdx.x >= 192;
    const int lo = late ? P0_SPLIT : 0, hi = deal && !late ? P0_SPLIT : total, n = deal ? (late ? 64 * NWAVE : 192 * NWAVE) : C.ngw, w0 = deal ? (late ? C.gw - 192 * NWAVE : C.gw) : C.gw;
    for (int it = lo + (w0 / NWAVE) * 2 * NWAVE + C.wave; it < hi; it += 2 * n) {
        const bool two = it + NWAVE < hi;
        const TItem ta = conv_item(C, layer, nsmall, it), tb = conv_item(C, layer, nsmall, two ? it + NWAVE : it);
        float ra[32], rb[32];
        t_load(ta, C.lane, ra); if (two) t_load(tb, C.lane, rb);
        t_store(ta, C.lane, ra, scr); if (two) t_store(tb, C.lane, rb, scr);
    }
}

__device__ __forceinline__ void convert_range(const Ctx& C, int layer, int lo, int hi, int b0) {
    if ((int)blockIdx.x < b0) return;
    LAS float* scr = (LAS float*)(C.lds + C.wave * 16384);
    const int n = ((int)gridDim.x - b0) * NWAVE;
    for (int it = lo + ((int)blockIdx.x - b0) * 2 * NWAVE + C.wave; it < hi; it += 2 * n) {
        const bool two = it + NWAVE < hi;
        const TItem ta = moe_item(C, layer, it), tb = moe_item(C, layer, two ? it + NWAVE : it);
        float ra[32], rb[32];
        t_load(ta, C.lane, ra); if (two) t_load(tb, C.lane, rb);
        t_store(ta, C.lane, ra, scr); if (two) t_store(tb, C.lane, rb, scr);
    }
}

__device__ __forceinline__ void phase_prologue(const Ctx& C) {
    const Params& P = *C.p;
    {
        LAS float* s = (LAS float*)C.lds;
        LAS float* red = (LAS float*)(C.lds + 17 * 1024 * 4);
        bool have_s = false;
        for (int u = blockIdx.x; u < 192; u += gridDim.x) {
            if (!have_s) {
                float cv[34];
#pragma unroll
                for (int j = 0; j < 34; ++j) { const int i = C.tid + j * NTHR, ci = i >> 10, k = i & 1023; cv[j] = ci < 16 ? P.in[I_C][ci * D + k] : P.in[I_CCTX][k]; }
#pragma unroll
                for (int j = 0; j < 34; ++j) s[C.tid + j * NTHR] = silu_(cv[j]);
                have_s = true; __syncthreads();
            }
            STAMP_AT(27);
            const int layer = u / 96, jg = u % 96, cg = C.lane & 15, ksl = 4 * C.wave + (C.lane >> 4);
            const float* w = P.in[I_WMOD] + (size_t)layer * D * 6144 + (size_t)(32 * ksl) * 6144 + jg * 64 + 4 * cg;
            const LAS float* sk = s + 32 * ksl;
            f32x2 acc[17][2];
#pragma unroll
            for (int i = 0; i < 17; ++i) { acc[i][0] = (f32x2){0.f, 0.f}; acc[i][1] = (f32x2){0.f, 0.f}; }
#pragma unroll 1
            for (int k0 = 0; k0 < 32; k0 += 16) {
                f32x4 wv[16];
#pragma unroll
                for (int j = 0; j < 16; ++j) wv[j] = *(const f32x4*)(w + (size_t)(k0 + j) * 6144);
#pragma unroll
                for (int j4 = 0; j4 < 16; j4 += 4)
#pragma unroll
                    for (int i = 0; i < 17; ++i) { const f32x4 sv = *(const LAS f32x4*)(sk + i * 1024 + k0 + j4);
#pragma unroll
                        for (int jj = 0; jj < 4; ++jj) { const f32x2 s2 = {sv[jj], sv[jj]}; acc[i][0] = s2 * (f32x2){wv[j4 + jj].x, wv[j4 + jj].y} + acc[i][0]; acc[i][1] = s2 * (f32x2){wv[j4 + jj].z, wv[j4 + jj].w} + acc[i][1]; } }
            }
            STAMP_AT(28);
#pragma unroll
            for (int i = 0; i < 17; ++i)
#pragma unroll
                for (int h = 0; h < 2; ++h) { f32x2 v = acc[i][h]; v.x += __shfl_xor(v.x, 16); v.y += __shfl_xor(v.y, 16); v.x += __shfl_xor(v.x, 32); v.y += __shfl_xor(v.y, 32); acc[i][h] = v; }
            if (C.lane < 16) {
#pragma unroll
                for (int i = 0; i < 17; ++i) *(LAS f32x4*)(red + (C.wave * 17 + i) * 64 + 4 * cg) = (f32x4){acc[i][0].x, acc[i][0].y, acc[i][1].x, acc[i][1].y}; }
            __syncthreads();
            for (int o = C.tid; o < 17 * 64; o += NTHR) { const int ci = o >> 6, c = o & 63; float v = 0.f;
#pragma unroll
                for (int q = 0; q < 8; ++q) v += red[(q * 17 + ci) * 64 + c];
                const int j = jg * 64 + c; v += P.in[I_BMOD][layer * 6144 + j];
                ((float*)(C.ws + WS_MOD))[((size_t)(layer * 17 + ci)) * 6144 + j] = v; }
            __syncthreads();
        }
        __syncthreads();
    }
    STAMP_AT(24);
    {
        const bool idle64 = gridDim.x == 256;
        const int gt = idle64 ? ((int)blockIdx.x >= 192 && C.tid < 64 ? 64 * C.tid + ((int)blockIdx.x - 192) : (1 << 30)) : blockIdx.x * NTHR + C.tid, ngt = idle64 ? 4096 : gridDim.x * NTHR;
        float2* rope = (float2*)(C.ws + WS_TAB + TAB_ROPE);
        for (int i = gt; i < 64 * 16; i += ngt) { const int pos = i >> 4, f = i & 15;
            const double th = exp(-(double)f * (9.210340371976184 / 16.0)); double s, c; dsincos((double)pos * th, s, c); rope[i] = make_float2((float)c, (float)s); }
        float2* lamb = (float2*)(C.ws + WS_TAB + TAB_LAMB); float2* bbar = (float2*)(C.ws + WS_TAB + TAB_BBAR);
        for (int i = gt; i < 2 * 32 * 64; i += ngt) {
            const int dg = i >> 6;
            const double are = P.in[I_ARE][i], aim = P.in[I_AIM][i], dt = exp((double)P.in[I_LOGDT][dg]);
            double s, c; dsincos(aim * dt, s, c); const double mag = exp(are * dt), lr = mag * c, li = mag * s;
            lamb[i] = make_float2((float)lr, (float)li);
            const double den = are * are + aim * aim, nr = lr - 1.0, ni = li;
            const double iden = 1.0 / den, cr = (nr * are + ni * aim) * iden, cim = (ni * are - nr * aim) * iden;
            for (int p = 0; p < 16; ++p) { const double br = P.in[I_BRE][(size_t)i * 16 + p], bi = P.in[I_BIM][(size_t)i * 16 + p];
                bbar[(size_t)i * 16 + p] = make_float2((float)(cr * br - cim * bi), (float)(cr * bi + cim * br)); }
        }
    }
    {
        const int gt = blockIdx.x * NTHR + C.tid, ngt = gridDim.x * NTHR;
        bf16* wrt = (bf16*)(C.ws + WS_TAB + TAB_WR);
        for (int idx = gt; idx < 2 * 32 * 3 * 64; idx += ngt) {
            const int ln = idx & 63, jb = (idx >> 6) % 3, kk = (idx / 192) & 31, l = idx / (192 * 32);
            const int i = ln & 15, q = ln >> 4, grp = i >> 2, r = i & 3;
            float hi8[8], lo8[8];
#pragma unroll
            for (int e = 0; e < 8; ++e) { const int k = 32 * kk + 8 * q + e;
                const float w = jb < 2 ? P.in[I_WRT][((size_t)l * D + k) * 32 + grp * 8 + jb * 4 + r] : (r == 0 ? P.in[I_WGRP][((size_t)l * D + k) * 4 + grp] : 0.f);
                const float h = bf2f(f2bf(w)); hi8[e] = h; lo8[e] = w - h; }
            v4u oh, ol; oh.x = pk2(hi8[0], hi8[1]); oh.y = pk2(hi8[2], hi8[3]); oh.z = pk2(hi8[4], hi8[5]); oh.w = pk2(hi8[6], hi8[7]);
            ol.x = pk2(lo8[0], lo8[1]); ol.y = pk2(lo8[2], lo8[3]); ol.z = pk2(lo8[4], lo8[5]); ol.w = pk2(lo8[6], lo8[7]);
            const size_t base = ((((size_t)l * 32 + kk) * 3 + jb) * 2) * 64 + ln;
            *(v4u*)(wrt + base * 8) = oh; *(v4u*)(wrt + (base + 64) * 8) = ol;
        }
    }
    {
        const int gt = blockIdx.x * NTHR + C.tid, ngt = gridDim.x * NTHR; bf16* w16 = (bf16*)(C.ws + WS_WSP);
        for (int i = gt; i < 8 * 128 * 128 / 4; i += ngt) { const f32x4 v = *(const f32x4*)(P.in[I_WSP] + 4 * (size_t)i); v2u o; o.x = pk2(v.x, v.y); o.y = pk2(v.z, v.w); *(v2u*)(w16 + 4 * (size_t)i) = o; }
    }
    STAMP_AT(25);
    convert_items(C, 0, NSMALL);
    STAMP_AT(26);
}

__device__ __forceinline__ void load_row16(const float* row, int lane, f32x4 (&v)[4]) {
#pragma unroll
    for (int j = 0; j < 4; ++j) v[j] = __builtin_nontemporal_load((const f32x4*)(row + 4 * lane + 256 * j));
}
__device__ __forceinline__ float row_rstd(const f32x4 (&v)[4]) {
    float s = 0.f;
#pragma unroll
    for (int j = 0; j < 4; ++j) s += (v[j].x * v[j].x + v[j].y * v[j].y) + (v[j].z * v[j].z + v[j].w * v[j].w);
    return rsqrtf(wave_sum(s) * (1.f / D) + EPS);
}
__device__ __forceinline__ void modulate16(f32x4 (&v)[4], float rstd, const float* g, const float* scale, const float* shift, int lane) {
#pragma unroll
    for (int j = 0; j < 4; ++j) { const int c = 4 * lane + 256 * j; const f32x4 gg = *(const f32x4*)(g + c), sc = *(const f32x4*)(scale + c), sh = *(const f32x4*)(shift + c);
        v[j] = v[j] * rstd * gg * (sc + 1.f) + sh; }
}
__device__ __forceinline__ void store_row16_bf16(bf16* row, int lane, const f32x4 (&v)[4]) {
#pragma unroll
    for (int j = 0; j < 4; ++j) { v2u o; o.x = pk2(v[j].x, v[j].y); o.y = pk2(v[j].z, v[j].w); *(v2u*)(row + 4 * lane + 256 * j) = o; }
}

__device__ __forceinline__ void store_row16_fp8(unsigned char* row, int lane, const f32x4 (&v)[4]) {
#pragma unroll
    for (int j = 0; j < 4; ++j) { int w = 0; w = __builtin_amdgcn_cvt_pk_fp8_f32(v[j].x, v[j].y, w, false); w = __builtin_amdgcn_cvt_pk_fp8_f32(v[j].z, v[j].w, w, true); *(int*)(row + 4 * lane + 256 * j) = w; }
}

__device__ __forceinline__ void phase_norm_mix0(const Ctx& C) {
    const Params& P = *C.p; unsigned char* H = (unsigned char*)(C.ws + WS_H);
    if (TT % C.ngw == 0) {
        const int per = TT / C.ngw, r0 = C.gw * per; int cur = -1; f32x4 mA[4], mB[4];
        f32x4 a[4], b[4];
        load_row16(xin_row(P, r0), C.lane, a); if (1 < per) load_row16(xin_row(P, r0 + 1), C.lane, b);
#define NM0_ROW2(buf, i_) do { const int rr = r0 + (i_); f32x4 v[4] = {buf[0], buf[1], buf[2], buf[3]}; if ((i_) + 2 < per) load_row16(xin_row(P, rr + 2), C.lane, buf); \
            const int ci = cond_of(rr); if (ci != cur) { const float* g_ = P.in[I_GMIX]; const float* sc_ = mod_vec(C, 0, ci, 1); const float* sh_ = mod_vec(C, 0, ci, 0); \
                _Pragma("unroll") for (int j = 0; j < 4; ++j) { const int c = 4 * C.lane + 256 * j; mA[j] = *(const f32x4*)(g_ + c) * (*(const f32x4*)(sc_ + c) + 1.f); mB[j] = *(const f32x4*)(sh_ + c); } cur = ci; } \
            const float rstd = row_rstd(v); _Pragma("unroll") for (int j = 0; j < 4; ++j) v[j] = v[j] * rstd * mA[j] + mB[j]; store_row16_fp8(H + (size_t)rr * D, C.lane, v); } while (0)
        for (int i = 0; i < per; i += 2) { NM0_ROW2(a, i); if (i + 1 < per) NM0_ROW2(b, i + 1); }
#undef NM0_ROW2
        return;
    }
    f32x4 a[4], b[4]; const int n = C.ngw; int r = C.gw;
    if (r < TT) load_row16(xin_row(P, r), C.lane, a);
    if (r + n < TT) load_row16(xin_row(P, r + n), C.lane, b);
#define NM0_ROW(buf, rr, rnext) do { f32x4 v[4] = {buf[0], buf[1], buf[2], buf[3]}; if ((rnext) < TT) load_row16(xin_row(P, (rnext)), C.lane, buf); \
        const float rstd = row_rstd(v); const int ci = cond_of(rr); modulate16(v, rstd, P.in[I_GMIX], mod_vec(C, 0, ci, 1), mod_vec(C, 0, ci, 0), C.lane); store_row16_fp8(H + (size_t)(rr) * D, C.lane, v); } while (0)
    for (; r < TT; r += 2 * n) { NM0_ROW(a, r, r + 2 * n); if (r + n < TT) NM0_ROW(b, r + n, r + 3 * n); }
#undef NM0_ROW
}

__device__ __forceinline__ unsigned gm_off_b(unsigned row, unsigned ch) { return 256u * row + 16u * (ch ^ (((row & 3u) << 2) | ((row >> 2) & 3u))); }
__device__ __forceinline__ void phase_gmlp_fast(const Ctx& C) {
    typedef short bf16x8 __attribute__((ext_vector_type(8)));
    typedef short s16x4 __attribute__((ext_vector_type(4)));
    typedef float f32x16 __attribute__((ext_vector_type(16)));
    const Params& P = *C.p; const bf16* Pb = (const bf16*)(C.ws + WS_P); bf16* OG = (bf16*)(C.ws + WS_H); const bf16* W16 = (const bf16*)(C.ws + WS_WSP);
    const float* lnp = (const float*)(C.ws + WS_Q);
    const int tid = C.tid, lane = C.lane, w = C.wave, l31 = lane & 31, hi = lane >> 5;
    const int gsel = w >> 2, pb = w & 3;
    const int nU = (TT / 128) * 4, arow = tid >> 2;
    v4u ra[4]; float2 st = make_float2(0.f, 0.f);
#define GM_ALOAD(uu_) do { const size_t gr_ = (size_t)((uu_) >> 2) * 128 + arow; { const f32x4 pq = *(const f32x4*)(lnp + gr_ * 16 + 4 * (tid & 3)); st = make_float2(pq.x + pq.z, pq.y + pq.w); } \
        _Pragma("unroll") for (int i = 0; i < 4; ++i) ra[i] = *(const v4u*)(Pb + gr_ * MIXW + 1280 + 128 * ((uu_) & 3) + 8 * ((tid & 3) + 4 * i)); } while (0)
    if ((int)blockIdx.x < nU) GM_ALOAD((int)blockIdx.x);
    LAS float* t_lng = (LAS float*)(C.lds + 36864); LAS float* t_bsp = (LAS float*)(C.lds + 40960);
    t_lng[tid] = P.in[I_LNG][tid]; t_bsp[tid] = P.in[I_BSP][tid]; t_bsp[tid + 512] = P.in[I_BSP][tid + 512];
    __syncthreads();
    const bool same_gp = (gridDim.x & 3) == 0;
    bf16x8 xf[8];
    { const int g0_ = 2 * ((int)blockIdx.x & 3) + gsel; const bf16* wrow = W16 + ((size_t)g0_ * 128 + 32 * pb + l31) * 128 + 8 * hi;
#pragma unroll
      for (int k8 = 0; k8 < 8; ++k8) xf[k8] = *(const bf16x8*)(wrow + 16 * k8); }
    for (int u = blockIdx.x; u < nU; u += gridDim.x) {
        const int ch_ = u >> 2, gp = u & 3, g = 2 * gp + gsel;
        if (!same_gp) { const bf16* wrow = W16 + ((size_t)g * 128 + 32 * pb + l31) * 128 + 8 * hi;
#pragma unroll
            for (int k8 = 0; k8 < 8; ++k8) xf[k8] = *(const bf16x8*)(wrow + 16 * k8); }
        { float s1 = st.x, s2 = st.y; s1 += __shfl_xor(s1, 1); s1 += __shfl_xor(s1, 2); s2 += __shfl_xor(s2, 1); s2 += __shfl_xor(s2, 2);
          const float mean_ = s1 * (1.f / 512.f); const float2 sc = make_float2(mean_, rsqrtf(fmaxf(s2 * (1.f / 512.f) - mean_ * mean_, 0.f) + EPS));
#pragma unroll
          for (int i = 0; i < 4; ++i) { const int c16 = (tid & 3) + 4 * i; float v[8]; unpack8(ra[i], v);
              const LAS float* lg = t_lng + 128 * gp + 8 * c16;
#pragma unroll
              for (int j = 0; j < 8; ++j) v[j] = (v[j] - sc.x) * sc.y * lg[j];
              v4u o; o.x = pk2(v[0], v[1]); o.y = pk2(v[2], v[3]); o.z = pk2(v[4], v[5]); o.w = pk2(v[6], v[7]);
              *(LAS v4u*)(C.lds + (arow >> 5) * 8192 + gm_off_b(arow & 31, c16)) = o; } }
        if (u + (int)gridDim.x < nU) GM_ALOAD(u + (int)gridDim.x);
        __syncthreads();
        unsigned short ur[16][2];
#pragma unroll
        for (int r = 0; r < 16; ++r) { const int pl = (r & 3) + 8 * (r >> 2) + 4 * hi; const size_t grow = (size_t)ch_ * 128 + 32 * pb + pl;
#pragma unroll
            for (int db = 0; db < 2; ++db) ur[r][db] = *(const unsigned short*)(Pb + grow * MIXW + 768 + 64 * g + 32 * db + l31); }
        f32x16 acc[2]; acc[0] = f32x16{}; acc[1] = f32x16{};
#pragma unroll
        for (int k8 = 0; k8 < 8; ++k8) {
            const unsigned rb = k8 >> 1, ks = k8 & 1;
#pragma unroll
            for (int db = 0; db < 2; ++db) { const unsigned c = 2 * gsel + db, blk = (lane >> 4) & 1, q = (lane & 15) >> 2, p2 = lane & 3;
                s16x4 t0, t1;
                { const unsigned a0 = rb * 8192 + gm_off_b(16 * ks + 8 * hi + q, 4 * c + 2 * blk + (p2 >> 1)) + 8 * (p2 & 1);
                  const unsigned a1 = rb * 8192 + gm_off_b(16 * ks + 8 * hi + 4 + q, 4 * c + 2 * blk + (p2 >> 1)) + 8 * (p2 & 1);
                  t0 = __builtin_bit_cast(s16x4, __builtin_amdgcn_ds_read_tr16_b64_v4i16((LAS s16x4*)(C.lds + a0)));
                  t1 = __builtin_bit_cast(s16x4, __builtin_amdgcn_ds_read_tr16_b64_v4i16((LAS s16x4*)(C.lds + a1))); }
                const bf16x8 yf = {t0[0], t0[1], t0[2], t0[3], t1[0], t1[1], t1[2], t1[3]};
                acc[db] = __builtin_amdgcn_mfma_f32_32x32x16_bf16(xf[k8], yf, acc[db], 0, 0, 0); }
        }
        const LAS float* bsp = t_bsp + g * 128 + 32 * pb;
#pragma unroll
        for (int r = 0; r < 16; ++r) { const int pl = (r & 3) + 8 * (r >> 2) + 4 * hi; const size_t grow = (size_t)ch_ * 128 + 32 * pb + pl; const float bb = bsp[pl];
#pragma unroll
            for (int db = 0; db < 2; ++db) { const int col = 64 * g + 32 * db + l31; const float uu = bf2f(ur[r][db]);
                *(bf16*)((unsigned char*)OG + grow * OGP + 512 + 2 * col) = (bf16)f2bf(uu * (acc[db][r] + bb)); } }
        __syncthreads();
    }
#undef GM_ALOAD
}

__device__ __forceinline__ void phase_attn_fast(const Ctx& C, char* lds_generic) {
    typedef attn_body::bf16 abf;
    const abf* Q = (const abf*)(C.ws + WS_P); const abf* Kb = (const abf*)(C.ws + WS_K); const abf* Vb = (const abf*)(C.ws + WS_V); abf* OG = (abf*)(C.ws + WS_H);
    const int G = gridDim.x, bx = blockIdx.x; const int vcu = (G % 8 == 0) ? (bx % 8) * (G / 8) + bx / 8 : bx;
    const int per = (1024 + G - 1) / G, perc = (128 + G - 1) / G;
    for (int i = 0; i < per + perc; ++i) {
        int b, h, nt, tq0; size_t qrow;
        if (i < per) { const int u = vcu * per + i; if (u >= 1024) continue; const int qb = u & 7, hg = (u >> 3) & 3, bk = u >> 5; b = bk >> 1; h = (bk & 1) * 4 + hg; qrow = (size_t)b * SEQ + qb * 256; nt = KVL / 64; tq0 = qb * 256; }
        else { const int u = (G == 256 ? bx - 128 : vcu) + (i - per) * G; if (u < 0 || u >= 128) continue;   b = u >> 3; h = u & 7; qrow = (size_t)TL + (size_t)b * CTXL; nt = CTXL / 64; tq0 = -1; }
        const size_t kvo = (size_t)b * KVL * 128 + (h >> 2) * 64;
        attn_body::attn_unit<8>((const abf*)((const unsigned char*)(Q + qrow * MIXW) + h * 64), Kb + kvo, Vb + kvo, (unsigned char*)OG + qrow * OGP + h * 64, nt, lds_generic, C.p->in[I_QG], (const float2*)(C.ws + WS_TAB + TAB_ROPE), tq0);
    }
}

__device__ __forceinline__ void phase_router_fast(const Ctx& C, int layer, int nrows) {
    typedef short bf16x8 __attribute__((ext_vector_type(8)));
    const Params& P = *C.p; const bf16* XC = (const bf16*)(C.ws + WS_XC); bf16* F = (bf16*)(C.ws + WS_H);
    int* asg_e = (int*)(C.ws + WS_ROUTE + RT_E); int* asg_p = (int*)(C.ws + WS_ROUTE + RT_P); float* asg_w = (float*)(C.ws + WS_ROUTE + RT_W); int* list = (int*)(C.ws + WS_LIST);
    unsigned* cnt = (unsigned*)(C.ws + WS_CTL) + CW_CNT + CW_CNT_L * layer;
    const int l15 = C.lane & 15, q4 = C.lane >> 4;
    LAS float* ab = (LAS float*)(C.lds + C.wave * 8192);
    LAS unsigned* lcnt = (LAS unsigned*)(C.lds + 65536);
    if (C.tid < 64) lcnt[C.tid] = 0u;
    __syncthreads();
    int cur_ci = -1;
    const int nitems = nrows / 16;
    for (int rd = 0; (int)blockIdx.x * NWAVE + rd * C.ngw < nitems; ++rd) {
        const int it_raw = C.gw + rd * C.ngw; const bool valid = it_raw < nitems; const int it = valid ? it_raw : nitems - 1;
        const int row = it * 16 + l15, ci = cond_of(it * 16);
        if (ci != cur_ci) {
            const float* sc = mod_vec(C, layer, ci, 4); const float* sh = mod_vec(C, layer, ci, 3); const float* g0 = P.in[I_GFFN] + layer * D;
#pragma unroll
            for (int j = 0; j < 4; ++j) { const int c = 4 * C.lane + 256 * j; const f32x4 g4 = *(const f32x4*)(g0 + c), s4 = *(const f32x4*)(sc + c), h4 = *(const f32x4*)(sh + c); const f32x4 a4 = g4 * (s4 + 1.f);
                *(LAS f32x4*)(ab + c) = a4; *(LAS f32x4*)(ab + 1024 + c) = h4; }
            asm volatile("s_waitcnt lgkmcnt(0)" ::: "memory"); cur_ci = ci;
        }
        const bf16* xr = XC + (size_t)row * D + 8 * q4;
        float ss = 0.f;
#pragma unroll 16
        for (int kk = 0; kk < 32; ++kk) { pg8::f32x4 a, b; pg8::unpack8f(*(const pg8::u32x4*)(xr + 32 * kk), a, b); ss += (a.x * a.x + a.y * a.y) + (a.z * a.z + a.w * a.w) + (b.x * b.x + b.y * b.y) + (b.z * b.z + b.w * b.w); }
        ss += __shfl_xor(ss, 16); ss += __shfl_xor(ss, 32);
        const float rstd = rsqrtf(ss * (1.f / D) + EPS);
        f32x4 acc[3], acc2[3], acc3[3]; acc[0] = (f32x4){0.f, 0.f, 0.f, 0.f}; acc[1] = acc[0]; acc[2] = acc[0];
#pragma unroll
        for (int jb = 0; jb < 3; ++jb) { acc2[jb] = acc[0]; acc3[jb] = acc[0]; }
        unsigned char* frow = (unsigned char*)F + (size_t)row * D + 8 * q4;
        const LAS float* abl = ab + 8 * q4;
        {
            const unsigned char* wsrc = (const unsigned char*)((const bf16x8*)(C.ws + WS_TAB + TAB_WR) + (size_t)layer * (32 * 3 * 2 * 64)) + C.tid * 16;
            LAS unsigned char* wl0 = C.lds + 67584;
#define RS_GLOAD(sb_, ga, gb, gc, xq) do { ga = *(const pg8::u32x4*)(wsrc + (sb_) * 24576); gb = *(const pg8::u32x4*)(wsrc + (sb_) * 24576 + 8192); gc = *(const pg8::u32x4*)(wsrc + (sb_) * 24576 + 16384); \
                _Pragma("unroll") for (int j = 0; j < 4; ++j) xq[j] = *(const pg8::u32x4*)(xr + 128 * (sb_) + 32 * j); } while (0)
#define RS_LWRITE(sb_, ga, gb, gc) do { LAS unsigned char* wn = wl0 + ((sb_) & 1) * 24576 + C.tid * 16; *(LAS pg8::u32x4*)(wn) = ga; *(LAS pg8::u32x4*)(wn + 8192) = gb; *(LAS pg8::u32x4*)(wn + 16384) = gc; } while (0)
#define RS_FRAGS(sb_, j_, wf_, tb_) do { const LAS unsigned char* wl = wl0 + ((sb_) & 1) * 24576 + C.lane * 16; const int c_ = 128 * (sb_) + 32 * (j_); \
                _Pragma("unroll") for (int jb = 0; jb < 3; ++jb) { wf_[jb][0] = *(const LAS bf16x8*)(wl + (((j_) * 3 + jb) * 2) * 1024); wf_[jb][1] = *(const LAS bf16x8*)(wl + (((j_) * 3 + jb) * 2 + 1) * 1024); } \
                tb_[0] = *(const LAS f32x4*)(abl + c_); tb_[1] = *(const LAS f32x4*)(abl + c_ + 4); tb_[2] = *(const LAS f32x4*)(abl + 1024 + c_); tb_[3] = *(const LAS f32x4*)(abl + 1024 + c_ + 4); } while (0)
#define RS_STEP(sb_, j_, xv_, wf_, tb_, NEXT) do { const int c = 128 * (sb_) + 32 * (j_); \
                pg8::f32x4 x0, x1; pg8::unpack8f(xv_, x0, x1); \
                const f32x4 f0 = x0 * rstd * tb_[0] + tb_[2]; \
                const f32x4 f1 = x1 * rstd * tb_[1] + tb_[3]; \
                const pg8::u32x4 fh = pg8::pack8(f0, f1); if (valid) *(pg8::u32x2*)(frow + c) = pg8::pack8_fp8(f0, f1); \
                pg8::f32x4 r0, r1; pg8::unpack8f(fh, r0, r1); \
                const pg8::u32x4 fl = pg8::pack8(f0 - r0, f1 - r1); \
                const bf16x8 ah = __builtin_bit_cast(bf16x8, fh), al = __builtin_bit_cast(bf16x8, fl); \
                NEXT; \
                _Pragma("unroll") for (int jb = 0; jb < 3; ++jb) { \
                    acc[jb] = __builtin_amdgcn_mfma_f32_16x16x32_bf16(wf_[jb][0], ah, acc[jb], 0, 0, 0); \
                    acc2[jb] = __builtin_amdgcn_mfma_f32_16x16x32_bf16(wf_[jb][0], al, acc2[jb], 0, 0, 0); \
                    acc3[jb] = __builtin_amdgcn_mfma_f32_16x16x32_bf16(wf_[jb][1], ah, acc3[jb], 0, 0, 0); } } while (0)
#define RS_COMP(sb_, xq) do { bf16x8 wA[3][2], wB[3][2]; f32x4 tA[4], tB[4]; \
                RS_FRAGS(sb_, 0, wA, tA); \
                RS_STEP(sb_, 0, xq[0], wA, tA, RS_FRAGS(sb_, 1, wB, tB)); \
                RS_STEP(sb_, 1, xq[1], wB, tB, RS_FRAGS(sb_, 2, wA, tA)); \
                RS_STEP(sb_, 2, xq[2], wA, tA, RS_FRAGS(sb_, 3, wB, tB)); \
                RS_STEP(sb_, 3, xq[3], wB, tB, (void)0); } while (0)
#define RS_SYNC() do { asm volatile("s_waitcnt lgkmcnt(0)" ::: "memory"); __builtin_amdgcn_s_barrier(); } while (0)
            if (layer == 1) STAMP_AT(22);
            pg8::u32x4 a0, a1, a2, b0, b1, b2, xa[4], xb[4], xc[4];
            RS_GLOAD(0, a0, a1, a2, xc); RS_GLOAD(1, b0, b1, b2, xb);
            __builtin_amdgcn_s_barrier();
            RS_LWRITE(0, a0, a1, a2); RS_SYNC();
#pragma unroll 1
            for (int sb = 0; sb < 8; sb += 2) {
                if (sb + 2 < 8) RS_GLOAD(sb + 2, a0, a1, a2, xa);
                RS_COMP(sb, xc);
                RS_LWRITE(sb + 1, b0, b1, b2); RS_SYNC();
#pragma unroll
                for (int j = 0; j < 4; ++j) xc[j] = xb[j];
                if (sb + 3 < 8) RS_GLOAD(sb + 3, b0, b1, b2, xb);
                RS_COMP(sb + 1, xc);
                if (sb + 2 < 8) { RS_LWRITE(sb + 2, a0, a1, a2);
#pragma unroll
                    for (int j = 0; j < 4; ++j) xc[j] = xa[j]; }
                RS_SYNC();
            }
            if (layer == 1) STAMP_AT(23);
#undef RS_GLOAD
#undef RS_LWRITE
#undef RS_COMP
#undef RS_STEP
#undef RS_FRAGS
#undef RS_SYNC
        }
#pragma unroll
        for (int jb = 0; jb < 3; ++jb) acc[jb] = acc[jb] + (acc2[jb] + acc3[jb]);
        const float* brt = P.in[I_BRT] + layer * 32 + q4 * 8;
        float e[8];
#pragma unroll
        for (int r = 0; r < 4; ++r) { e[r] = acc[0][r] + brt[r]; e[4 + r] = acc[1][r] + brt[4 + r]; }
        const float gl = acc[2][0] + P.in[I_BGRP][layer * 4 + q4];
        float gm = gl; int gi = q4;
#pragma unroll
        for (int st = 16; st <= 32; st <<= 1) { const float og = __shfl_xor(gm, st); const int oi = __shfl_xor(gi, st); if (og > gm || (og == gm && oi < gi)) { gm = og; gi = oi; } }
        float den = __expf(gl - gm); den += __shfl_xor(den, 16); den += __shfl_xor(den, 32);
        if (valid && q4 == gi) {
            const float gw_ = 1.f / den;
            int i0 = 0; float v0 = e[0];
#pragma unroll
            for (int i = 1; i < 8; ++i) if (e[i] > v0) { v0 = e[i]; i0 = i; }
            int i1 = -1; float v1 = -INFINITY;
#pragma unroll
            for (int i = 0; i < 8; ++i) if (i != i0 && e[i] > v1) { v1 = e[i]; i1 = i; }
            if (i1 < 0) i1 = (i0 + 1) & 7;
            const float e1 = __expf(v1 - v0), w0 = gw_ / (1.f + e1), w1 = gw_ * e1 / (1.f + e1);
            const int ea = (gi & 3) * 8 + i0, eb = (gi & 3) * 8 + i1;
            const unsigned pa = __hip_atomic_fetch_add(lcnt + ea, 1u, __ATOMIC_RELAXED, __HIP_MEMORY_SCOPE_WORKGROUP);
            const unsigned pb = __hip_atomic_fetch_add(lcnt + eb, 1u, __ATOMIC_RELAXED, __HIP_MEMORY_SCOPE_WORKGROUP);
            asg_e[2 * row] = ea; asg_e[2 * row + 1] = eb; asg_p[2 * row] = (int)pa; asg_p[2 * row + 1] = (int)pb; asg_w[2 * row] = w0; asg_w[2 * row + 1] = w1;
        }
    }
    if (layer == 0) STAMP_AT(21);
    asm volatile("s_waitcnt vmcnt(0) lgkmcnt(0)" ::: "memory");
    __syncthreads();
    if (C.tid < 32) { const unsigned n = lcnt[C.tid]; lcnt[32 + C.tid] = n ? __hip_atomic_fetch_add(cnt + CW_CNT_S * C.tid, n, __ATOMIC_RELAXED, __HIP_MEMORY_SCOPE_AGENT) : 0u; }
    __syncthreads();
    for (int it = C.gw; it < nrows / 16; it += C.ngw) {
        if (C.lane < 32) { const int idx = 2 * (it * 16 + (C.lane & 15)) + (C.lane >> 4);
            const int e = __hip_atomic_load(asg_e + idx, __ATOMIC_RELAXED, __HIP_MEMORY_SCOPE_AGENT); const int p = __hip_atomic_load(asg_p + idx, __ATOMIC_RELAXED, __HIP_MEMORY_SCOPE_AGENT) + (int)lcnt[32 + e];
            asg_p[idx] = p; list[(size_t)e * LCAP + p] = idx >> 1; }
    }
}

__device__ __forceinline__ int wave_pstart(const Ctx& C, int layer) {
    const unsigned* cnt = (const unsigned*)(C.ws + WS_CTL) + CW_CNT + CW_CNT_L * layer;
    const int mc = C.lane < 32 ? (int)__hip_atomic_load(cnt + CW_CNT_S * (C.lane & 31), __ATOMIC_RELAXED, __HIP_MEMORY_SCOPE_AGENT) : 0; const int mp = (mc + 255) & ~255; int in = mp;
#pragma unroll
    for (int o = 1; o < 32; o <<= 1) { const int t = __shfl_up(in, o); if ((C.lane & 31) >= o) in += t; }
    return in - mp;
}
struct CombRaw { v2u x[4]; unsigned ya[4], yb[4]; float w0, w1; };
__device__ __forceinline__ void comb_load(const Ctx& C, int r, int ps, CombRaw& o) {
    const unsigned char* Y2 = (const unsigned char*)(C.ws + WS_XS); const bf16* XC = (const bf16*)(C.ws + WS_XC); const float* asg_w = (const float*)(C.ws + WS_ROUTE + RT_W);
    const int* asg_e = (const int*)(C.ws + WS_ROUTE + RT_E); const int* asg_p = (const int*)(C.ws + WS_ROUTE + RT_P);
    const int s0 = __shfl(ps, asg_e[2 * r]) + asg_p[2 * r], s1 = __shfl(ps, asg_e[2 * r + 1]) + asg_p[2 * r + 1]; o.w0 = asg_w[2 * r]; o.w1 = asg_w[2 * r + 1];
#pragma unroll
    for (int j = 0; j < 4; ++j) { const int c = 4 * C.lane + 256 * j; o.x[j] = *(const v2u*)(XC + (size_t)r * D + c); o.ya[j] = __builtin_nontemporal_load((const unsigned*)(Y2 + (size_t)s0 * D + c)); o.yb[j] = __builtin_nontemporal_load((const unsigned*)(Y2 + (size_t)s1 * D + c)); }
}
__device__ __forceinline__ void comb_load_s(const Ctx& C, int r, int i, int slot_all, float w_all, CombRaw& o) {
    const unsigned char* Y2 = (const unsigned char*)(C.ws + WS_XS); const bf16* XC = (const bf16*)(C.ws + WS_XC);
    const int s0 = __shfl(slot_all, 2 * i), s1 = __shfl(slot_all, 2 * i + 1); o.w0 = __shfl(w_all, 2 * i); o.w1 = __shfl(w_all, 2 * i + 1);
#pragma unroll
    for (int j = 0; j < 4; ++j) { const int c = 4 * C.lane + 256 * j; o.x[j] = *(const v2u*)(XC + (size_t)r * D + c); o.ya[j] = *(const unsigned*)(Y2 + (size_t)s0 * D + c); o.yb[j] = *(const unsigned*)(Y2 + (size_t)s1 * D + c); }
}
__device__ __forceinline__ void comb_calc(const Ctx& C, int layer, int r, const CombRaw& w, f32x4 (&v)[4]) {
    const float* gate = mod_vec(C, layer, cond_of(r), 5); const float w0 = w.w0 * (1.f / Y_SCALE), w1 = w.w1 * (1.f / Y_SCALE);
#pragma unroll
    for (int j = 0; j < 4; ++j) { const int c = 4 * C.lane + 256 * j; const v2u xx = w.x[j]; const f32x4 g = *(const f32x4*)(gate + c);
        const f32x2 a01 = __builtin_amdgcn_cvt_pk_f32_fp8((int)w.ya[j], false), a23 = __builtin_amdgcn_cvt_pk_f32_fp8((int)w.ya[j], true), b01 = __builtin_amdgcn_cvt_pk_f32_fp8((int)w.yb[j], false), b23 = __builtin_amdgcn_cvt_pk_f32_fp8((int)w.yb[j], true);
        v[j].x = bf2f(xx.x & 0xffffu) + g.x * (w0 * a01.x + w1 * b01.x); v[j].y = bf2f(xx.x >> 16) + g.y * (w0 * a01.y + w1 * b01.y);
        v[j].z = bf2f(xx.y & 0xffffu) + g.z * (w0 * a23.x + w1 * b23.x); v[j].w = bf2f(xx.y >> 16) + g.w * (w0 * a23.y + w1 * b23.y); }
}
__device__ __forceinline__ void comb_calc_g(const CombRaw& w, const f32x4 (&gt)[4], f32x4 (&v)[4]) {
    const float w0 = w.w0 * (1.f / Y_SCALE), w1 = w.w1 * (1.f / Y_SCALE);
#pragma unroll
    for (int j = 0; j < 4; ++j) { const v2u xx = w.x[j]; const f32x4 g = gt[j];
        const f32x2 a01 = __builtin_amdgcn_cvt_pk_f32_fp8((int)w.ya[j], false), a23 = __builtin_amdgcn_cvt_pk_f32_fp8((int)w.ya[j], true), b01 = __builtin_amdgcn_cvt_pk_f32_fp8((int)w.yb[j], false), b23 = __builtin_amdgcn_cvt_pk_f32_fp8((int)w.yb[j], true);
        v[j].x = bf2f(xx.x & 0xffffu) + g.x * (w0 * a01.x + w1 * b01.x); v[j].y = bf2f(xx.x >> 16) + g.y * (w0 * a01.y + w1 * b01.y);
        v[j].z = bf2f(xx.y & 0xffffu) + g.z * (w0 * a23.x + w1 * b23.x); v[j].w = bf2f(xx.y >> 16) + g.w * (w0 * a23.y + w1 * b23.y); }
}
__device__ __forceinline__ void phase_combine_norm_mix1(const Ctx& C) {
    const Params& P = *C.p; bf16* XC = (bf16*)(C.ws + WS_XC); bf16* H = (bf16*)(C.ws + WS_H);
    const int ps = wave_pstart(C, 0), n = C.ngw;
#define CN_ROW(buf, rr, rnext) do { const CombRaw w_ = buf; if ((rnext) < TT) comb_load(C, (rnext), ps, buf); f32x4 v[4]; comb_calc(C, 0, (rr), w_, v); \
        store_row16_bf16(XC + (size_t)(rr) * D, C.lane, v); const float rstd = row_rstd(v); const int ci = cond_of(rr); \
        modulate16(v, rstd, P.in[I_GMIX] + D, mod_vec(C, 1, ci, 1), mod_vec(C, 1, ci, 0), C.lane); store_row16_bf16(H + (size_t)(rr) * D, C.lane, v); } while (0)
    if (TT % n == 0) {
        const int per = TT / n, r0 = C.gw * per; int cur = -1; f32x4 gt[4], mA[4], mB[4];
        int slot_all = 0; float w_all = 0.f;
        { const int L = C.lane < 2 * per ? C.lane : 0; const int e_ = ((const int*)(C.ws + WS_ROUTE + RT_E))[2 * r0 + L], p_ = ((const int*)(C.ws + WS_ROUTE + RT_P))[2 * r0 + L]; w_all = ((const float*)(C.ws + WS_ROUTE + RT_W))[2 * r0 + L]; slot_all = __shfl(ps, e_) + p_; }
#define CN_ROW2(buf, i_) do { const int rr = r0 + (i_); const CombRaw w_ = buf; if ((i_) + 4 < per) comb_load_s(C, rr + 4, (i_) + 4, slot_all, w_all, buf); \
            const int ci = cond_of(rr); if (ci != cur) { const float* gate_ = mod_vec(C, 0, ci, 5); const float* g_ = P.in[I_GMIX] + D; const float* sc_ = mod_vec(C, 1, ci, 1); const float* sh_ = mod_vec(C, 1, ci, 0); \
                _Pragma("unroll") for (int j = 0; j < 4; ++j) { const int c = 4 * C.lane + 256 * j; gt[j] = *(const f32x4*)(gate_ + c); mA[j] = *(const f32x4*)(g_ + c) * (*(const f32x4*)(sc_ + c) + 1.f); mB[j] = *(const f32x4*)(sh_ + c); } cur = ci; } \
            f32x4 v[4]; comb_calc_g(w_, gt, v); store_row16_bf16(XC + (size_t)rr * D, C.lane, v); const float rstd = row_rstd(v); \
            _Pragma("unroll") for (int j = 0; j < 4; ++j) v[j] = v[j] * rstd * mA[j] + mB[j]; store_row16_bf16(H + (size_t)rr * D, C.lane, v); } while (0)
        CombRaw a, b, c4, d4;
        comb_load_s(C, r0, 0, slot_all, w_all, a); if (1 < per) comb_load_s(C, r0 + 1, 1, slot_all, w_all, b); if (2 < per) comb_load_s(C, r0 + 2, 2, slot_all, w_all, c4); if (3 < per) comb_load_s(C, r0 + 3, 3, slot_all, w_all, d4);
        for (int i = 0; i < per; i += 4) { CN_ROW2(a, i); if (i + 1 < per) CN_ROW2(b, i + 1); if (i + 2 < per) CN_ROW2(c4, i + 2); if (i + 3 < per) CN_ROW2(d4, i + 3); }
#undef CN_ROW2
    } else {
    CombRaw a, b, c4, d4; int r = C.gw;
    if (r < TT) comb_load(C, r, ps, a);
    if (r + n < TT) comb_load(C, r + n, ps, b);
    if (r + 2 * n < TT) comb_load(C, r + 2 * n, ps, c4);
    if (r + 3 * n < TT) comb_load(C, r + 3 * n, ps, d4);
    for (; r < TT; r += 4 * n) { CN_ROW(a, r, r + 4 * n); if (r + n < TT) CN_ROW(b, r + n, r + 5 * n); if (r + 2 * n < TT) CN_ROW(c4, r + 2 * n, r + 6 * n); if (r + 3 * n < TT) CN_ROW(d4, r + 3 * n, r + 7 * n); }
#undef CN_ROW
    }
    { const bool early = gridDim.x == 256; if (early) convert_range(C, 1, 0, L1_A, 0); convert_range(C, 1, early ? L1_D : 0, MOE_ITEMS, 0); }
}
__device__ __forceinline__ void phase_final(const Ctx& C) {
    const Params& P = *C.p;
    const int ps = wave_pstart(C, 1), n = C.ngw;
#define FN_ROW(buf, rr, rnext) do { const CombRaw w_ = buf; if ((rnext) < TL) comb_load(C, (rnext), ps, buf); f32x4 v[4]; comb_calc(C, 1, (rr), w_, v); const float rstd = row_rstd(v); \
        _Pragma("unroll") for (int j = 0; j < 4; ++j) { const int c = 4 * C.lane + 256 * j; const f32x4 g = *(const f32x4*)(P.in[I_FING] + c); __builtin_nontemporal_store(v[j] * rstd * g, (f32x4*)(P.out + (size_t)(rr) * D + c)); } } while (0)
    if (TL % n == 0 && SEQ % (TL / n) == 0) {
        const int per = TL / n, r0 = C.gw * per; const float* gate = mod_vec(C, 1, cond_of(r0), 5);
        int slot_all = 0; float w_all = 0.f;
        { const int L = C.lane < 2 * per ? C.lane : 0; const int e_ = ((const int*)(C.ws + WS_ROUTE + RT_E))[2 * r0 + L], p_ = ((const int*)(C.ws + WS_ROUTE + RT_P))[2 * r0 + L]; w_all = ((const float*)(C.ws + WS_ROUTE + RT_W))[2 * r0 + L]; slot_all = __shfl(ps, e_) + p_; }
        f32x4 gt[4], fg[4];
#pragma unroll
        for (int j = 0; j < 4; ++j) { const int c = 4 * C.lane + 256 * j; gt[j] = *(const f32x4*)(gate + c); fg[j] = *(const f32x4*)(P.in[I_FING] + c); }
#define FN_ROW2(buf, i_) do { const int rr = r0 + (i_); const CombRaw w_ = buf; if ((i_) + 4 < per) comb_load_s(C, rr + 4, (i_) + 4, slot_all, w_all, buf); f32x4 v[4]; comb_calc_g(w_, gt, v); const float rstd = row_rstd(v); \
            _Pragma("unroll") for (int j = 0; j < 4; ++j) { const int c = 4 * C.lane + 256 * j; __builtin_nontemporal_store(v[j] * rstd * fg[j], (f32x4*)(P.out + (size_t)rr * D + c)); } } while (0)
        CombRaw a, b, c4, d4;
        comb_load_s(C, r0, 0, slot_all, w_all, a); if (1 < per) comb_load_s(C, r0 + 1, 1, slot_all, w_all, b); if (2 < per) comb_load_s(C, r0 + 2, 2, slot_all, w_all, c4); if (3 < per) comb_load_s(C, r0 + 3, 3, slot_all, w_all, d4);
        for (int i = 0; i < per; i += 4) { FN_ROW2(a, i); if (i + 1 < per) FN_ROW2(b, i + 1); if (i + 2 < per) FN_ROW2(c4, i + 2); if (i + 3 < per) FN_ROW2(d4, i + 3); }
#undef FN_ROW2
        return;
    }
    CombRaw a, b, c4, d4; int r = C.gw;
    if (r < TL) comb_load(C, r, ps, a);
    if (r + n < TL) comb_load(C, r + n, ps, b);
    if (r + 2 * n < TL) comb_load(C, r + 2 * n, ps, c4);
    if (r + 3 * n < TL) comb_load(C, r + 3 * n, ps, d4);
    for (; r < TL; r += 4 * n) { FN_ROW(a, r, r + 4 * n); if (r + n < TL) FN_ROW(b, r + n, r + 5 * n); if (r + 2 * n < TL) FN_ROW(c4, r + 2 * n, r + 6 * n); if (r + 3 * n < TL) FN_ROW(d4, r + 3 * n, r + 7 * n); }
#undef FN_ROW
}

__device__ __forceinline__ void phase_s5_fast(const Ctx& C) {
    typedef short bf16x8 __attribute__((ext_vector_type(8)));
    typedef float f32x16 __attribute__((ext_vector_type(16)));
    const Params& P = *C.p; const bf16* U = (const bf16*)(C.ws + WS_U); bf16* GS = (bf16*)(C.ws + WS_GS); float* YA = (float*)(C.ws + WS_YACC);
    const float2* lamb = (const float2*)(C.ws + WS_TAB + TAB_LAMB); const float2* bbar = (const float2*)(C.ws + WS_TAB + TAB_BBAR);
    constexpr int HP = 272;
    const int lane = C.lane, w = C.wave, il = w >> 2, dir = (w >> 1) & 1, nh = w & 1;
    const int l31 = lane & 31, hi = lane >> 5, l15 = lane & 15, q4 = lane >> 4;
    LAS unsigned char* Hb = C.lds + (il * 2 + dir) * (2 * 32 * HP);
    const int srow = 16 * ((l31 >> 2) & 1) + 2 * (l31 >> 3) + ((l31 >> 1) & 1);
    for (int it0 = blockIdx.x; it0 < NB * 16; it0 += gridDim.x) {
        const int item = it0 * 2 + il, b = item >> 5, g = item & 31;
        const int dg = dir * 32 + g, n = nh * 32 + l31;
        const float2 lam = lamb[dg * 64 + n];
        f32x2 p2[16]; { f32x2 p = {lam.x, lam.y};
#pragma unroll
            for (int r = 0; r < 16; ++r) { p2[r] = p; p = (f32x2){p.x * lam.x - p.y * lam.y, p.x * lam.y + p.y * lam.x}; } }
        const f32x2 lx2 = {lam.x, lam.x}, ly2 = {-lam.y, lam.y};
        bf16x8 bre, bim; { const float2* bp = bbar + ((size_t)(dg * 64 + n)) * 16 + 8 * hi;
#pragma unroll
            for (int e = 0; e < 8; ++e) { const float2 v = bp[e]; bre[e] = (short)f2bf(v.x); bim[e] = (short)f2bf(v.y); } }
        bf16x8 cf[4]; { const float* cre = P.in[I_CRE] + ((size_t)dg * 16 + l15) * 64; const float* cim = P.in[I_CIM] + ((size_t)dg * 16 + l15) * 64;
#pragma unroll
            for (int ks = 0; ks < 4; ++ks) { const f32x4 a = *(const f32x4*)(cre + 16 * ks + 4 * q4), m = *(const f32x4*)(cim + 16 * ks + 4 * q4);
                cf[ks][0] = (short)f2bf(a.x); cf[ks][1] = (short)f2bf(-m.x); cf[ks][2] = (short)f2bf(a.y); cf[ks][3] = (short)f2bf(-m.y);
                cf[ks][4] = (short)f2bf(a.z); cf[ks][5] = (short)f2bf(-m.z); cf[ks][6] = (short)f2bf(a.w); cf[ks][7] = (short)f2bf(-m.w); } }
        const f32x4 dsk = *(const f32x4*)(P.in[I_S5D] + g * 16 + 4 * q4);
        f32x2 carry = {0.f, 0.f};
#define S5_UROW(kk, off) ({ const int S_ = 32 * (kk) + srow + (off); (S_ < CTXL) ? ((size_t)TL + (size_t)b * CTXL + (dir == 0 ? S_ : CTXL - 1 - S_)) : ((size_t)b * SEQ + (dir == 0 ? S_ - CTXL : SEQ - 1 - (S_ - CTXL))); })
        const bool odd = l31 & 1;
#define S5_ULD(kk, off) (*(const bf16x8*)(U + S5_UROW(kk, off) * 512 + g * 16 + 8 * hi))
        bf16x8 ux1 = S5_ULD(0, 0), uy1 = S5_ULD(0, 8), ux2 = S5_ULD(1, 0), uy2 = S5_ULD(1, 8), ux3 = S5_ULD(2, 0), uy3 = S5_ULD(2, 8);
        f32x4 pk_n = {0.f, 0.f, 0.f, 0.f}; v2u uu_n = {0u, 0u};
        for (int k = 0; k < 72; ++k) {
            const bf16x8 ux = ux1, uy = uy1; ux1 = ux2; uy1 = uy2; ux2 = ux3; uy2 = uy3;
            if (k + 3 < 72) { ux3 = S5_ULD(k + 3, 0); uy3 = S5_ULD(k + 3, 8); }
            const int sl = 32 * (k - 8) + 16 * nh + l15;
            const int tok = dir == 0 ? sl : SEQ - 1 - sl; const int lt = tok >> 5;
            const size_t o = ((size_t)b * SEQ + (k >= 8 ? tok : 0)) * 512 + g * 16 + 4 * q4;
            const bool first = dir == 0 ? (lt < 32) : (lt >= 32);
#define S5_RLOAD(oo, pk_, uu_) do { pk_.x = __hip_atomic_load(YA + (oo), __ATOMIC_RELAXED, __HIP_MEMORY_SCOPE_AGENT); pk_.y = __hip_atomic_load(YA + (oo) + 1, __ATOMIC_RELAXED, __HIP_MEMORY_SCOPE_AGENT); \
                pk_.z = __hip_atomic_load(YA + (oo) + 2, __ATOMIC_RELAXED, __HIP_MEMORY_SCOPE_AGENT); pk_.w = __hip_atomic_load(YA + (oo) + 3, __ATOMIC_RELAXED, __HIP_MEMORY_SCOPE_AGENT); uu_ = *(const v2u*)(U + (oo)); } while (0)
            f32x4 pk = pk_n; v2u uu = uu_n;
            if (k == 40) S5_RLOAD(o, pk, uu);
            if (k >= 40 && k + 1 < 72) { const int sl1 = 32 * (k + 1 - 8) + 16 * nh + l15; const int tok1 = dir == 0 ? sl1 : SEQ - 1 - sl1; const size_t o1 = ((size_t)b * SEQ + tok1) * 512 + g * 16 + 4 * q4; S5_RLOAD(o1, pk_n, uu_n); }
            {
              const bf16x8 zf = {0, 0, 0, 0, 0, 0, 0, 0};
              f32x16 X = {}, Y = {};
              X = __builtin_amdgcn_mfma_f32_32x32x16_bf16(odd ? zf : ux, bre, X, 0, 0, 0); X = __builtin_amdgcn_mfma_f32_32x32x16_bf16(odd ? ux : zf, bim, X, 0, 0, 0);
              Y = __builtin_amdgcn_mfma_f32_32x32x16_bf16(odd ? zf : uy, bre, Y, 0, 0, 0); Y = __builtin_amdgcn_mfma_f32_32x32x16_bf16(odd ? uy : zf, bim, Y, 0, 0, 0);
              f32x2 s2 = hi ? (f32x2){0.f, 0.f} : carry;
#pragma unroll
              for (int q = 0; q < 8; ++q) { const f32x2 bq = {X[2 * q], X[2 * q + 1]}, sw = {s2.y, s2.x}; s2 = lx2 * s2 + bq; s2 = ly2 * sw + s2; X[2 * q] = s2.x; X[2 * q + 1] = s2.y; }
#pragma unroll
              for (int q = 0; q < 8; ++q) { const f32x2 bq = {Y[2 * q], Y[2 * q + 1]}, sw = {s2.y, s2.x}; s2 = lx2 * s2 + bq; s2 = ly2 * sw + s2; Y[2 * q] = s2.x; Y[2 * q + 1] = s2.y; }
              float er = __shfl_xor(s2.x, 32), ei = __shfl_xor(s2.y, 32); if (!hi) { er = 0.f; ei = 0.f; }
              const f32x2 er2 = {er, er}, ei2 = {ei, ei};
#pragma unroll
              for (int q = 0; q < 8; ++q) { const f32x2 p = p2[q], ps = {-p.y, p.x}; f32x2 h = {X[2 * q], X[2 * q + 1]}; h = er2 * p + h; h = ei2 * ps + h; X[2 * q] = h.x; X[2 * q + 1] = h.y; }
#pragma unroll
              for (int q = 0; q < 8; ++q) { const f32x2 p = p2[8 + q], ps = {-p.y, p.x}; f32x2 h = {Y[2 * q], Y[2 * q + 1]}; h = er2 * p + h; h = ei2 * ps + h; Y[2 * q] = h.x; Y[2 * q + 1] = h.y; }
              carry = (f32x2){__shfl_xor(Y[14], 32), __shfl_xor(Y[15], 32)};
              LAS unsigned char* hb = Hb + (k & 1) * (32 * HP) + (16 * hi) * HP + 4 * n;
#pragma unroll
              for (int q = 0; q < 8; ++q) { *(LAS unsigned*)(hb + q * HP) = pk2(X[2 * q], X[2 * q + 1]); *(LAS unsigned*)(hb + (8 + q) * HP) = pk2(Y[2 * q], Y[2 * q + 1]); }
            }
            asm volatile("s_waitcnt lgkmcnt(0)\n\ts_barrier" ::: "memory");
            if (k >= 8) {
                const LAS unsigned char* hr = Hb + (k & 1) * (32 * HP) + (16 * nh + l15) * HP + 16 * q4;
                f32x4 y = {0.f, 0.f, 0.f, 0.f};
#pragma unroll
                for (int ks = 0; ks < 4; ++ks) { const bf16x8 hf = *(const LAS bf16x8*)(hr + 64 * ks); y = __builtin_amdgcn_mfma_f32_16x16x32_bf16(cf[ks], hf, y, 0, 0, 0); }
                if (first) { *(f32x4*)(YA + o) = y; }
                else {
                    const f32x4 uf = {bf2f(uu.x & 0xffffu), bf2f(uu.x >> 16), bf2f(uu.y & 0xffffu), bf2f(uu.y >> 16)};
                    const f32x4 t = y + pk + dsk * uf;
                    const f32x4 gq = pg8::gelu_tanh4(t); v2u ov; ov.x = pk2(gq.x, gq.y); ov.y = pk2(gq.z, gq.w); *(v2u*)(GS + o) = ov;
                }
            }
            if (k == 39) asm volatile("s_waitcnt vmcnt(0)\n\ts_barrier" ::: "memory");
        }
#undef S5_UROW
#undef S5_ULD
#undef S5_RLOAD
        asm volatile("s_waitcnt vmcnt(0) lgkmcnt(0)\n\ts_barrier" ::: "memory");
    }
}

__global__ void __launch_bounds__(NTHR, 2) fwd_kernel(Params prm) {
    extern __shared__ __attribute__((aligned(16))) unsigned char lds_raw[];
    Ctx C; C.p = &prm; C.ws = prm.ws; C.lds = (LAS unsigned char*)lds_raw;
    C.tid = threadIdx.x; C.lane = C.tid & 63; C.wave = __builtin_amdgcn_readfirstlane(C.tid >> 6);
    C.gw = blockIdx.x * NWAVE + C.wave; C.ngw = gridDim.x * NWAVE;
    constexpr int LDS_MISC = 147456 - 512;
    volatile LAS unsigned* misc = (volatile LAS unsigned*)(C.lds + LDS_MISC);
    if (C.tid < 64) misc[C.tid] = 0u;
    __syncthreads();
    unsigned* ctl = (unsigned*)(C.ws + WS_CTL);
    XcdBarrier bar; bar.bar = ctl + CW_BAR; bar.x = 0; bar.st = nullptr;
#if MK_ONE_LAUNCH
    bar = xcd_barrier_post(ctl + CW_BAR, misc + 8);
#define SEAM(k) do { if (lo <= (k) && (k) + 1 < hi) xcd_barrier(bar); } while (0)
#else
#define SEAM(k) do { } while (0)
#endif
    const int lo = prm.ph_lo, hi = prm.ph_hi;
#define IN(k) ((C.lane = lane_id_now(), C.tid = C.wave * 64 + C.lane, true) && lo <= (k) && (k) < hi)
#if MK_PROBE
#define STAMP(k) STAMP_AT((k) + 1)
    STAMP_AT(0);
#else
#define STAMP(k) do { } while (0)
#endif
    const Params& P = prm;
    bf16* Hb = (bf16*)(C.ws + WS_H); bf16* XC = (bf16*)(C.ws + WS_XC);
#define MOE_MAP(layer) do { LAS int* tm_ = (LAS int*)(C.lds + 131072); LAS int* cl_ = tm_ + 320; \
        if (C.wave == 0) { const unsigned* cnt_ = (const unsigned*)(C.ws + WS_CTL) + CW_CNT + CW_CNT_L * (layer); const int mc_ = C.lane < 32 ? (int)__hip_atomic_load(cnt_ + CW_CNT_S * (C.lane & 31), __ATOMIC_RELAXED, __HIP_MEMORY_SCOPE_AGENT) : 0; const int mp_ = (mc_ + 255) & ~255; int in_ = mp_; \
            _Pragma("unroll") for (int o_ = 1; o_ < 32; o_ <<= 1) { const int t_ = __shfl_up(in_, o_); if ((C.lane & 31) >= o_) in_ += t_; } const int ps_ = in_ - mp_; \
            if (C.lane < 32) { for (int t_ = ps_ / 256; t_ < (ps_ + mp_) / 256; ++t_) tm_[t_] = C.lane | ((t_ * 256 - ps_) << 8); cl_[C.lane] = mc_; if (C.lane == 31) cl_[32] = (ps_ + mp_) / 256; } } \
        __syncthreads(); } while (0)
#define MOE_GEMM1(layer) do { MOE_MAP(layer); const LAS int* tm_ = (const LAS int*)(C.lds + 131072); const int ntl_ = __builtin_amdgcn_readfirstlane(tm_[320 + 32]); pg8::Gemm g{Hb, (const bf16*)(C.ws + ((layer) ? WS_W13B : WS_W13)), 0, 1024, 512}; \
        pg8::GroupedOrder<true> S{tm_, tm_ + 320, (const int*)(C.ws + WS_LIST), ntl_ * 4, 4, (int)gridDim.x, (int)blockIdx.x, LCAP, 1024, (size_t)1024 * 1024}; pg8::EpiSwiglu E{(unsigned char*)(C.ws + WS_G13), 1.f / W13_SCALE, G_SCALE}; \
        pg8::gemm_phase<pg8::EpiSwiglu, pg8::GroupedOrder<true>, true, false, false, true>(C.lds, g, S, E, C.wave); } while (0)
#define MOE_GEMM2(layer) do { MOE_MAP(layer); int kk_ = EH / 2; asm volatile("" : "+s"(kk_));     \
        const LAS int* tm_ = (const LAS int*)(C.lds + 131072); const int ntl_ = __builtin_amdgcn_readfirstlane(tm_[320 + 32]); pg8::Gemm g{(const bf16*)(C.ws + WS_G13), (const bf16*)(C.ws + ((layer) ? WS_W2B : WS_W2)), 0, 1024, kk_}; \
        pg8::GroupedOrder<false> S{tm_, tm_ + 320, (const int*)(C.ws + WS_LIST), ntl_ * 4, 4, (int)gridDim.x, (int)blockIdx.x, LCAP, EH, (size_t)1024 * 512}; pg8::EpiStoreF8 E{(unsigned char*)(C.ws + WS_XS), D, Y_SCALE / (W13_SCALE * G_SCALE)}; \
        pg8::gemm_phase<pg8::EpiStoreF8, pg8::GroupedOrder<false>, true, false, false, true>(C.lds, g, S, E, C.wave); } while (0)
    if (IN(0)) { phase_prologue(C); SEAM(0); STAMP(0); }
    if (IN(1)) { phase_norm_mix0(C); SEAM(1); STAMP(1); }
    if (IN(2)) { pg8::Gemm g{Hb, (const bf16*)(C.ws + WS_WIN0), TT, MIXW, D / 2};
        pg8::StaticOrder S; S.init(TT, MIXW, gridDim.x, blockIdx.x); pg8::EpiInProj E{(bf16*)(C.ws + WS_P), (bf16*)(C.ws + WS_K), (bf16*)(C.ws + WS_V), P.in[I_KG], (const float*)(C.ws + WS_TAB + TAB_ROPE), (LAS float*)(C.lds + 135168), 1.f / W13_SCALE, (float*)(C.ws + WS_Q)};
        pg8::gemm_phase<pg8::EpiInProj, pg8::StaticOrder, true, false, false, true>(C.lds, g, S, E, C.wave); SEAM(2); STAMP(2); }
    if (IN(4)) { phase_gmlp_fast(C); phase_attn_fast(C, (char*)lds_raw); SEAM(4); STAMP(4); }
    if (IN(5)) { pg8::Gemm g{Hb, (const bf16*)(C.ws + WS_WOUT0), TT, D, OGP / 2};
        pg8::StaticOrderH S; S.init(TT, D, gridDim.x, blockIdx.x, 1); pg8::EpiResid E{P.in[I_X], P.in[I_CTX], (const float*)(C.ws + WS_MOD), XC, 0, 1.f / (W13_SCALE * O_SCALE)};
        pg8::gemm_phase<pg8::EpiResid, pg8::StaticOrderH, true, true, false, false, 4>(C.lds, g, S, E, C.wave);
        if (gridDim.x == 256) { __syncthreads(); convert_range(C, 0, L0_A, L0_B, 64); convert_range(C, 1, L1_C, L1_D, 128); }
        SEAM(5); STAMP(5); }
    if (IN(6)) { phase_router_fast(C, 0, TT); if (gridDim.x == 256) { __syncthreads(); convert_range(C, 0, L0_B, MOE_ITEMS, 32); } SEAM(6); STAMP(6); }
    if (IN(8)) { MOE_GEMM1(0); if (gridDim.x == 256) { __syncthreads(); convert_range(C, 1, L1_P9, L1_B, 192); } SEAM(8); STAMP(8); }
    if (IN(9)) { MOE_GEMM2(0); if (gridDim.x == 256) { __syncthreads(); convert_range(C, 1, L1_A, L1_P9, 192); } SEAM(9); STAMP(9); }
    if (IN(10)) { phase_combine_norm_mix1(C); SEAM(10); STAMP(10); }
    if (IN(11)) { pg8::Gemm g{Hb, (const bf16*)(C.ws + WS_WS5IN), TT, 512, D}; pg8::StaticOrderH S; S.init(TT, 512, gridDim.x, blockIdx.x, 1); pg8::EpiStore E{(bf16*)(C.ws + WS_U), 512, 1.f};
        pg8::gemm_phase<pg8::EpiStore, pg8::StaticOrderH, true, true, true>(C.lds, g, S, E, C.wave);
        if (gridDim.x == 256) { __syncthreads(); convert_range(C, 1, L1_B, L1_C, 64); }
        SEAM(11); STAMP(11); }
    if (IN(12)) { phase_s5_fast(C); SEAM(12); STAMP(12); }
    if (IN(13)) { pg8::Gemm g{(const bf16*)(C.ws + WS_GS), (const bf16*)(C.ws + WS_WGLU), TL, 512, 512}; pg8::StaticOrder S; S.init(TL, 512, gridDim.x, blockIdx.x); pg8::EpiGlu E{(const bf16*)(C.ws + WS_GS), P.in[I_BGLU], (bf16*)(C.ws + WS_GG)};
        pg8::gemm_phase<pg8::EpiGlu, pg8::StaticOrder, true, true, true>(C.lds, g, S, E, C.wave); SEAM(13); STAMP(13); }
    if (IN(14)) { pg8::Gemm g{(const bf16*)(C.ws + WS_GG), (const bf16*)(C.ws + WS_WS5OUT), TL, D, 512}; pg8::StaticOrder S; S.init(TL, D, gridDim.x, blockIdx.x); pg8::EpiResid E{P.in[I_X], P.in[I_CTX], (const float*)(C.ws + WS_MOD) + (size_t)17 * 6 * D, XC, 1, 1.f};
        pg8::gemm_phase<pg8::EpiResid, pg8::StaticOrder, true, true, true>(C.lds, g, S, E, C.wave); SEAM(14); STAMP(14); }
    if (IN(15)) { phase_router_fast(C, 1, TL); SEAM(15); STAMP(15); }
    if (IN(17)) { MOE_GEMM1(1); SEAM(17); STAMP(17); }
    if (IN(18)) { MOE_GEMM2(1); SEAM(18); STAMP(18); }
    if (IN(19)) { phase_final(C); STAMP(19); }
#if MK_PROBE
    if (blockIdx.x == 0 && C.wave == 0 && lane_id_now() == 0) {
        volatile LAS unsigned long long* ts_ = (volatile LAS unsigned long long*)(C.lds + LDS_MISC + 64);
        ts_[8] = ts_[7]; ts_[17] = ts_[16];
        const unsigned long long tA = ts_[PROBE_A_HI + 1] - ts_[PROBE_A_LO], tB = ts_[PROBE_B_HI + 1] - ts_[PROBE_B_LO];
        const unsigned long long spin = 16ull * tA + 1000000ull * ((tB + 500ull) / 1000ull);
        const unsigned long long t0 = __builtin_amdgcn_s_memrealtime();
        while (__builtin_amdgcn_s_memrealtime() - t0 < spin) __builtin_amdgcn_s_sleep(8);
    }
#endif
#undef IN
#undef SEAM
}

extern "C" void kernel_launch(void* const* d_in, const int* in_sizes, int n_in, void* d_out, int out_size, void* d_ws, size_t ws_size, hipStream_t stream) {
    constexpr int LDS_BYTES = 147456;
    static int grid = 0;
    if (grid == 0) {
        if (n_in != 35 || out_size != TL * D || ws_size < WS_END) { fprintf(stderr, "kernel_launch: unexpected shapes (n_in %d out %d ws %zu)\n", n_in, out_size, ws_size); grid = -1; return; }
        int dev = 0, cus = 0;
        if (hipGetDevice(&dev) != hipSuccess || hipDeviceGetAttribute(&cus, hipDeviceAttributeMultiprocessorCount, dev) != hipSuccess) { grid = -1; return; }
        if (hipFuncSetAttribute((const void*)fwd_kernel, hipFuncAttributeMaxDynamicSharedMemorySize, LDS_BYTES) != hipSuccess) { fprintf(stderr, "kernel_launch: hipFuncSetAttribute failed\n"); grid = -1; return; }
        (void)hipGetLastError();
        grid = cus;
    }
    if (grid < 0) return;
    (void)hipMemsetAsync((char*)d_ws + WS_CTL, 0, CTL_BYTES, stream);
    Params p{};
    for (int i = 0; i < 35; ++i) p.in[i] = (const float*)d_in[i];
    p.out = (float*)d_out; p.ws = (unsigned char*)d_ws;
#if MK_ONE_LAUNCH
    p.ph_lo = 0; p.ph_hi = NPHASE;
    hipLaunchKernelGGL(fwd_kernel, dim3(grid), dim3(NTHR), LDS_BYTES, stream, p);
#else
    for (int k = 0; k < NPHASE; ++k) { p.ph_lo = k; p.ph_hi = k + 1; hipLaunchKernelGGL(fwd_kernel, dim3(grid), dim3(NTHR), LDS_BYTES, stream, p); }
#endif
}
```
